# Optimizing an MI355X kernel written in HIP

```python
import math
import jax, jax.numpy as jnp
from jax import lax
import numpy as np

D_MODEL = 1024
BATCH = 4
SEQ = 8192
DEPTH = 4

HEAD_DIM = 64
N_HEADS = D_MODEL // HEAD_DIM
MIX_WIDTH = N_HEADS * HEAD_DIM
N_HEADS_MOBA = N_HEADS // 4
N_HEADS_SB = N_HEADS // 4
N_HEADS_DIL = N_HEADS - N_HEADS_MOBA - N_HEADS_SB
MOBA_BLOCK = 256
MOBA_TOPK = 3
MOBA_QCHUNK = 32
SB_QBLOCK = 128
DIL_CONFIGS = ((128, 1), (512, 4), (2048, 16))
N_GROUPS = 4
EXPERTS_PER_GROUP = 4
MOE_TOPK = 2
D_EXPERT = D_MODEL // 4
NORM_EPS = 1e-6
NEG_INF = -1e30

kernel_name = "hymba_moba_stickbreak_dilated_hmoe"


def rms_norm(x, g):
    xf = x.astype(jnp.float32)
    y = xf * lax.rsqrt(jnp.mean(xf * xf, axis=-1, keepdims=True) + NORM_EPS)
    return (y * g.astype(jnp.float32)).astype(x.dtype)


def alibi_slopes(n):
    return jnp.asarray(2.0 ** (-8.0 * np.arange(1, n + 1, dtype=np.float32) / n), dtype=jnp.float32)


def moba_attention(q, k, v, slopes):
    B, H, S, hd = q.shape
    blk, qc = MOBA_BLOCK, MOBA_QCHUNK
    n_blk = -(-S // blk)
    s_pad = n_blk * blk
    pad = ((0, 0), (0, 0), (0, s_pad - S), (0, 0))
    q, k, v = jnp.pad(q, pad), jnp.pad(k, pad), jnp.pad(v, pad)
    k_blk = k.reshape(B, H, n_blk, blk, hd)
    v_blk = v.reshape(B, H, n_blk, blk, hd)
    k_mean = jnp.mean(k_blk.astype(jnp.float32), axis=3)
    n_sel = max(1, min(MOBA_TOPK, n_blk - 1))
    scale = hd ** -0.5
    n_chunks = s_pad // qc
    q_chunks = q.reshape(B, H, n_chunks, qc, hd).transpose(2, 0, 1, 3, 4)
    b_ix = jnp.arange(B)[:, None, None, None]
    h_ix = jnp.arange(H)[None, :, None, None]
    m = slopes[None, :, None, None]

    def chunk(args):
        q_c, c = args
        t0 = c * qc
        own = t0 // blk
        t = t0 + jnp.arange(qc)
        qf = q_c.astype(jnp.float32)
        gate = jnp.einsum('bhqd,bhnd->bhqn', qf, k_mean)
        gate = jnp.where(jnp.arange(n_blk) < own, gate, NEG_INF)
        _, sel = lax.top_k(gate, n_sel)
        sel_ok = sel < own
        k_sel = k_blk[b_ix, h_ix, sel].astype(jnp.float32)
        v_sel = v_blk[b_ix, h_ix, sel].astype(jnp.float32)
        pos_sel = sel[..., None] * blk + jnp.arange(blk)
        s_sel = jnp.einsum('bhqd,bhqnkd->bhqnk', qf, k_sel) * scale
        s_sel = s_sel - m[..., None] * (t[:, None, None] - pos_sel).astype(jnp.float32)
        s_sel = jnp.where(sel_ok[..., None], s_sel, NEG_INF).reshape(B, H, qc, n_sel * blk)
        k_own = lax.dynamic_slice_in_dim(k, own * blk, blk, axis=2).astype(jnp.float32)
        v_own = lax.dynamic_slice_in_dim(v, own * blk, blk, axis=2).astype(jnp.float32)
        dist = t[:, None] - (own * blk + jnp.arange(blk))[None, :]
        s_own = jnp.einsum('bhqd,bhkd->bhqk', qf, k_own) * scale - m * dist.astype(jnp.float32)
        s_own = jnp.where(dist >= 0, s_own, NEG_INF)
        p = jax.nn.softmax(jnp.concatenate([s_sel, s_own], axis=-1), axis=-1)
        p_sel = p[..., :n_sel * blk].reshape(B, H, qc, n_sel, blk)
        p_own = p[..., n_sel * blk:]
        o = (jnp.einsum('bhqnk,bhqnkd->bhqd', p_sel, v_sel)
             + jnp.einsum('bhqk,bhkd->bhqd', p_own, v_own))
        return o.astype(v.dtype)

    o = lax.map(chunk, (q_chunks, jnp.arange(n_chunks)))
    return o.transpose(1, 2, 0, 3, 4).reshape(B, H, s_pad, hd)[:, :, :S]


def stick_breaking_attention(q, k, v):
    B, H, S, hd = q.shape
    qb = SB_QBLOCK
    n_qb = S // qb
    scale = hd ** -0.5
    k_pos = jnp.arange(S)
    q_blocks = q.reshape(B, H, n_qb, qb, hd).transpose(2, 0, 1, 3, 4)
    kf = k.astype(jnp.float32)
    vf = v.astype(jnp.float32)

    def block(args):
        q_b, i = args
        t = i * qb + jnp.arange(qb)
        z = jnp.einsum('bhqd,bhkd->bhqk', q_b.astype(jnp.float32), kf) * scale
        past = k_pos[None, :] < t[:, None]
        log_not = jnp.where(past, jax.nn.log_sigmoid(-z), 0.0)
        tail = lax.cumsum(log_not, axis=3, reverse=True) - log_not
        a = jnp.where(past, jnp.exp(jax.nn.log_sigmoid(z) + tail), 0.0)
        return jnp.einsum('bhqk,bhkd->bhqd', a, vf).astype(v.dtype)

    o = lax.map(block, (q_blocks, jnp.arange(n_qb)))
    return o.transpose(1, 2, 0, 3, 4).reshape(B, H, S, hd)


def dilated_branch(q, k, v, slopes, window, dilation):
    B, H, S, hd = q.shape
    n = window // dilation
    L = S // dilation
    n_blk = -(-L // n)
    l_pad = n_blk * n

    def to_blocks(t):
        t = t.reshape(B, H, L, dilation, hd).transpose(0, 1, 3, 2, 4)
        t = jnp.pad(t, ((0, 0), (0, 0), (0, 0), (0, l_pad - L), (0, 0)))
        return t.reshape(B, H, dilation, n_blk, n, hd)

    def with_prev(t):
        prev = jnp.pad(t, ((0, 0), (0, 0), (0, 0), (1, 0), (0, 0), (0, 0)))[:, :, :, :-1]
        return jnp.concatenate([prev, t], axis=4)

    qb = to_blocks(q).astype(jnp.float32)
    kb = with_prev(to_blocks(k)).astype(jnp.float32)
    vb = with_prev(to_blocks(v)).astype(jnp.float32)
    delta = jnp.arange(n)[:, None] + n - jnp.arange(2 * n)[None, :]
    k_sub = jnp.arange(n_blk)[:, None] * n - n + jnp.arange(2 * n)[None, :]
    valid = ((delta >= 0) & (delta <= n))[None] & (k_sub >= 0)[:, None, :]
    s = jnp.einsum('bhrnqd,bhrnkd->bhrnqk', qb, kb) * (hd ** -0.5)
    s = s - slopes[:, None, None, None, None] * (delta * dilation).astype(jnp.float32)
    s = jnp.where(valid, s, NEG_INF)
    s_max = jnp.max(s, axis=-1, keepdims=True)
    p = jnp.exp(s - s_max)
    den = jnp.sum(p, axis=-1, keepdims=True)
    o = jnp.einsum('bhrnqk,bhrnkd->bhrnqd', p, vb) / den
    lse = (s_max + jnp.log(den))[..., 0]

    def from_blocks(t):
        t = t.reshape((B, H, dilation, l_pad) + t.shape[5:])[:, :, :, :L]
        t = jnp.moveaxis(t, 2, 3)
        return t.reshape((B, H, S) + t.shape[4:])

    return from_blocks(o), from_blocks(lse)


def dilated_mixture(q, k, v, slopes):
    outs, lses = [], []
    for window, dilation in DIL_CONFIGS:
        o, lse = dilated_branch(q, k, v, slopes, window, dilation)
        outs.append(o)
        lses.append(lse)
    wts = jax.nn.softmax(jnp.stack(lses), axis=0)
    o = jnp.einsum('cbhs,cbhsd->bhsd', wts, jnp.stack(outs))
    return o.astype(v.dtype)


def mixer_sublayer(x, ln_g, w_in, mix_g, w_out):
    B, S, _ = x.shape
    h = rms_norm(x, ln_g)
    qkv = (h @ w_in).reshape(B, S, 3, N_HEADS, HEAD_DIM).transpose(2, 0, 3, 1, 4)
    q, k, v = qkv[0], qkv[1], qkv[2]
    a = N_HEADS_MOBA
    b = N_HEADS_MOBA + N_HEADS_SB
    o_a = moba_attention(q[:, :a], k[:, :a], v[:, :a], alibi_slopes(N_HEADS_MOBA))
    o_b = stick_breaking_attention(q[:, a:b], k[:, a:b], v[:, a:b])
    o_c = dilated_mixture(q[:, b:], k[:, b:], v[:, b:], alibi_slopes(N_HEADS_DIL))

    def merge(o):
        return o.transpose(0, 2, 1, 3).reshape(B, S, -1)

    wa, wb = a * HEAD_DIM, b * HEAD_DIM
    y = jnp.concatenate([rms_norm(merge(o_a), mix_g[:wa]),
                         rms_norm(merge(o_b), mix_g[wa:wb]),
                         rms_norm(merge(o_c), mix_g[wb:])], axis=-1)
    return x + (y @ w_out).astype(x.dtype)


def hierarchical_moe(h, w_gr, b_gr, w_er, b_er, w_gate, w_up, w_down):
    f32 = jnp.float32
    hf = h.astype(f32)
    g_prob = jax.nn.softmax(hf @ w_gr.astype(f32) + b_gr.astype(f32), axis=-1)
    g_w, g_idx = lax.top_k(g_prob, 1)
    g_onehot = jax.nn.one_hot(g_idx[..., 0], N_GROUPS, dtype=f32)
    e_logits = jnp.einsum('bsd,gde->bsge', hf, w_er.astype(f32)) + b_er.astype(f32)
    e_logits = jnp.einsum('bsge,bsg->bse', e_logits, g_onehot)
    e_val, e_idx = lax.top_k(e_logits, MOE_TOPK)
    e_w = jax.nn.softmax(e_val, axis=-1) * g_w
    within = jnp.sum(jax.nn.one_hot(e_idx, EXPERTS_PER_GROUP, dtype=f32) * e_w[..., None], axis=-2)
    combine = g_onehot[..., None] * within[:, :, None, :]
    y = jnp.zeros(hf.shape, f32)
    for g in range(N_GROUPS):
        gate = jnp.einsum('bsd,edf->bsef', h, w_gate[g])
        up = jnp.einsum('bsd,edf->bsef', h, w_up[g])
        act = jax.nn.silu(gate) * up * combine[:, :, g, :, None].astype(h.dtype)
        y = y + jnp.einsum('bsef,efd->bsd', act, w_down[g]).astype(f32)
    return y.astype(h.dtype)


def setup_inputs(seed: int = 0) -> dict:
    key = jax.random.key(seed)
    ks = jax.random.split(key, 16)
    f32 = jnp.float32
    D = D_MODEL

    def nrm(k, shape, scale):
        return jax.random.normal(k, shape, f32) * scale

    return {
        "x": nrm(ks[0], (BATCH, SEQ, D), 1.0),
        "ln1_g": 1.0 + nrm(ks[1], (DEPTH, D), 0.02),
        "w_in": nrm(ks[2], (DEPTH, D, 3 * MIX_WIDTH), D ** -0.5),
        "mix_norm_g": 1.0 + nrm(ks[3], (DEPTH, MIX_WIDTH), 0.02),
        "w_out": nrm(ks[4], (DEPTH, MIX_WIDTH, D), MIX_WIDTH ** -0.5),
        "ln2_g": 1.0 + nrm(ks[5], (DEPTH, D), 0.02),
        "w_group_router": nrm(ks[6], (DEPTH, D, N_GROUPS), D ** -0.5),
        "b_group_router": nrm(ks[7], (DEPTH, N_GROUPS), 0.01),
        "w_expert_router": nrm(ks[8], (DEPTH, N_GROUPS, D, EXPERTS_PER_GROUP), D ** -0.5),
        "b_expert_router": nrm(ks[9], (DEPTH, N_GROUPS, EXPERTS_PER_GROUP), 0.01),
        "w_gate": nrm(ks[10], (DEPTH, N_GROUPS, EXPERTS_PER_GROUP, D, D_EXPERT), D ** -0.5),
        "w_up": nrm(ks[11], (DEPTH, N_GROUPS, EXPERTS_PER_GROUP, D, D_EXPERT), D ** -0.5),
        "w_down": nrm(ks[12], (DEPTH, N_GROUPS, EXPERTS_PER_GROUP, D_EXPERT, D), D_EXPERT ** -0.5),
        "final_norm_g": 1.0 + nrm(ks[13], (D,), 0.02),
    }


def reference(x, ln1_g, w_in, mix_norm_g, w_out, ln2_g, w_group_router, b_group_router,
              w_expert_router, b_expert_router, w_gate, w_up, w_down, final_norm_g):
    for l in range(DEPTH):
        x = mixer_sublayer(x, ln1_g[l], w_in[l], mix_norm_g[l], w_out[l])
        x = x + hierarchical_moe(rms_norm(x, ln2_g[l]), w_group_router[l], b_group_router[l],
                                 w_expert_router[l], b_expert_router[l],
                                 w_gate[l], w_up[l], w_down[l])
    return rms_norm(x, final_norm_g)
```

```cpp
#include <hip/hip_runtime.h>
#include <cstdio>
#include <cstdint>

#define LAS __attribute__((address_space(3)))
#define GAS __attribute__((address_space(1)))
typedef unsigned short bf16_t;
typedef short bf16x8 __attribute__((ext_vector_type(8)));
typedef float f32x4 __attribute__((ext_vector_type(4)));
typedef float f32x2 __attribute__((ext_vector_type(2)));
typedef unsigned u32x4 __attribute__((ext_vector_type(4)));
typedef unsigned u32x2 __attribute__((ext_vector_type(2)));

constexpr int BATCH = 4, SEQ = 8192, DM = 1024, DEPTH = 4, T = BATCH * SEQ, NH = 16, HD = 64;
constexpr int NQKV = 3 * DM, NEXP = 16, DEXP = 256, NACT = NEXP * DEXP;
constexpr float NORM_EPS = 1e-6f;
constexpr float LOG2E = 1.4426950408889634f;
constexpr float QSCALE = 0.125f * LOG2E;
constexpr int NWAVES = 8, NTHREADS = 512;

constexpr size_t MiB = 1u << 20;
constexpr size_t WS_CTL = 0, CTL_ZERO_BYTES = 1 * MiB;
constexpr size_t WS_WIN = 2 * MiB;
constexpr size_t WS_WOUT = 26 * MiB;
constexpr size_t WS_WG = 34 * MiB;
constexpr size_t WS_WU = 66 * MiB;
constexpr size_t WS_WD = 98 * MiB;
constexpr size_t WS_KMEAN = 130 * MiB;
constexpr size_t WS_COMB = 131 * MiB;
constexpr size_t WS_HB = 134 * MiB;
constexpr size_t WS_Q = 198 * MiB, WS_K = 262 * MiB, WS_V = 326 * MiB, WS_O = 390 * MiB;
constexpr size_t WS_ACT = WS_Q;
constexpr size_t WS_END = 454 * MiB;
constexpr int CW_BAR = 4096;

constexpr int RING_BYTES = 131072;
constexpr int LDSCTL_OFF = RING_BYTES, MISC_OFF = LDSCTL_OFF + 320;
constexpr int LDS_BYTES = 147456;

__device__ __forceinline__ unsigned f2bf(float f) { unsigned u = __builtin_bit_cast(unsigned, f); return (u + 0x7fffu + ((u >> 16) & 1u)) >> 16; }
__device__ __forceinline__ unsigned pk2(float lo, float hi) { return f2bf(lo) | (f2bf(hi) << 16); }
__device__ __forceinline__ float bflo(unsigned w) { return __builtin_bit_cast(float, w << 16); }
__device__ __forceinline__ float bfhi(unsigned w) { return __builtin_bit_cast(float, w & 0xffff0000u); }
__device__ __forceinline__ float wave_sum(float v) {
#pragma unroll
    for (int o = 1; o < 64; o <<= 1) v += __shfl_xor(v, o);
    return v;
}
__device__ __forceinline__ float half_sum(float v) {
#pragma unroll
    for (int o = 1; o < 32; o <<= 1) v += __shfl_xor(v, o);
    return v;
}
#define LDS_WAIT() asm volatile("s_waitcnt lgkmcnt(0)" ::: "memory")
#define LAUNDER_V(x) asm volatile("" : "+v"(x))
#define LAUNDER_S(x) asm volatile("" : "+s"(x))

namespace pg8 {
constexpr int BM = 256, BK = 64, HALF = 128, HTB = HALF * BK * 2, STAGE_BYTES = 8 * HTB, NXCD = 8, WGM = 8;
__host__ __device__ __forceinline__ int lds_byte(int r, int c) { const int st = (r >> 4) * 2 + (c >> 5), rr = r & 15, cc = c & 31, ob = rr * 64 + cc * 2; return st * 1024 + (ob ^ (((ob >> 9) & 1) << 5)); }
__host__ __device__ __forceinline__ void stage_rc(int b, int& R, int& C) { const int st = b / 1024, sb = b % 1024, swz = sb ^ (((sb >> 9) & 1) << 5); R = (st >> 1) * 16 + swz / 64; C = (st & 1) * 32 + (swz % 64) / 2; }
__host__ __device__ __forceinline__ int perm32(int rho) { const int n = rho >> 4, i = rho & 15; return 8 * (i >> 2) + 4 * n + (i & 3); }

struct Unit { int pm, pn; };
struct Gemm { const char* A; const char* B; int lda, ldb, K; long tstepA, tstepB, hstepB; };

struct StaticOrder {
    int nM, nN, nwg, G, c;
    __host__ __device__ void init(int nM_, int nN_, int G_, int c_) { nM = nM_; nN = nN_; nwg = nM * nN; G = G_; c = c_; }
    __host__ __device__ bool next(int i, Unit& u) const {
        const long L = (long)i * G + c; if (L >= nwg) return false;
        int wgid = (int)L; { const int q = nwg / NXCD, r = nwg % NXCD, xcd = wgid % NXCD, off = wgid / NXCD; wgid = (xcd < r ? xcd * (q + 1) : r * (q + 1) + (xcd - r) * q) + off; }
        const int nig = WGM * nN, gid = wgid / nig, fm = gid * WGM, gsz = (nM - fm) < WGM ? (nM - fm) : WGM;
        u.pm = fm + ((wgid % nig) % gsz); u.pn = (wgid % nig) / gsz; return true;
    }
};

__device__ __forceinline__ unsigned cvt_pk_bf16(float lo, float hi) { unsigned r; asm volatile("v_cvt_pk_bf16_f32 %0, %1, %2" : "=v"(r) : "v"(lo), "v"(hi)); return r; }

struct EpiQKV {
    static constexpr bool PERM = true;
    bf16_t* O; size_t split_stride; float scale0;
    __device__ __forceinline__ void operator()(const f32x4 (&acc)[2][2][4][2], const Unit& u, int wr, int wc, int fr, int fq) const {
        const int row0 = u.pm * BM + wr * 64 + fr; int colt = u.pn * BM;
        const int t = colt / DM; bf16_t* base = O + (size_t)t * split_stride; colt -= t * DM; const float sc = (t == 0) ? scale0 : 1.f;
        const int col0 = colt + wc * 32 + 8 * fq;
#pragma unroll
        for (int ai = 0; ai < 2; ++ai)
#pragma unroll
            for (int m = 0; m < 4; ++m) { bf16_t* rowp = base + (size_t)(row0 + ai * HALF + m * 16) * DM + col0;
#pragma unroll
                for (int bj = 0; bj < 2; ++bj) { f32x4 v0 = acc[ai][bj][m][0] * sc, v1 = acc[ai][bj][m][1] * sc;
                    u32x4 w; w.x = cvt_pk_bf16(v0[0], v0[1]); w.y = cvt_pk_bf16(v0[2], v0[3]); w.z = cvt_pk_bf16(v1[0], v1[1]); w.w = cvt_pk_bf16(v1[2], v1[3]);
                    *(u32x4*)(rowp + bj * HALF) = w; } }
    }
};
struct EpiResAdd {
    static constexpr bool PERM = false;
    const float* base; float* out;
    __device__ __forceinline__ void operator()(const f32x4 (&acc)[2][2][4][2], const Unit& u, int wr, int wc, int fr, int fq) const {
        const int col0 = u.pn * BM + wc * 32 + 4 * fq;
#pragma unroll
        for (int ai = 0; ai < 2; ++ai)
#pragma unroll
            for (int m = 0; m < 4; ++m) { const size_t off = (size_t)(u.pm * BM + ai * HALF + wr * 64 + m * 16 + fr) * DM + col0;
#pragma unroll
                for (int bj = 0; bj < 2; ++bj)
#pragma unroll
                    for (int n = 0; n < 2; ++n) { const f32x4 bs = *(const f32x4*)(base + off + bj * HALF + n * 16); *(f32x4*)(out + off + bj * HALF + n * 16) = bs + acc[ai][bj][m][n]; } }
    }
};
struct EpiGateUpDense {
    static constexpr bool PERM = true;
    bf16_t* act; const float* comb;
    __device__ __forceinline__ void operator()(const f32x4 (&acc)[2][2][4][2], const Unit& u, int wr, int wc, int fr, int fq) const {
        const int e = u.pn >> 1, c0 = (u.pn & 1) * HALF;
        const int col0 = e * DEXP + c0 + wc * 32 + 8 * fq;
#pragma unroll
        for (int ai = 0; ai < 2; ++ai)
#pragma unroll
            for (int m = 0; m < 4; ++m) { const int row = u.pm * BM + ai * HALF + wr * 64 + m * 16 + fr;
                const float cw = comb[(size_t)row * NEXP + e];
                float o[8];
#pragma unroll
                for (int n = 0; n < 2; ++n)
#pragma unroll
                    for (int j = 0; j < 4; ++j) { const float g = acc[ai][0][m][n][j], up = acc[ai][1][m][n][j];
                        const float sg = g * __builtin_amdgcn_rcpf(1.f + __builtin_amdgcn_exp2f(-g * LOG2E));
                        o[n * 4 + j] = sg * up * cw; }
                u32x4 w; w.x = cvt_pk_bf16(o[0], o[1]); w.y = cvt_pk_bf16(o[2], o[3]); w.z = cvt_pk_bf16(o[4], o[5]); w.w = cvt_pk_bf16(o[6], o[7]);
                *(u32x4*)(act + (size_t)row * NACT + col0) = w; }
    }
};

template <class Epi, class Sched>
__device__ __forceinline__ void gemm_phase(LAS unsigned char* lds, const Gemm g, const Sched& S, const Epi& E) {
    int tid_l = threadIdx.x; asm volatile("" : "+v"(tid_l));
    const int tid = tid_l, wid = __builtin_amdgcn_readfirstlane(tid >> 6), lane = tid & 63, wr = wid >> 2, wc = wid & 3, fr = lane & 15, fq = lane >> 4;
    const int K = g.K, nt = K / BK;
    unsigned voffA[2], voffB[2];
#pragma unroll
    for (int i = 0; i < 2; ++i) { int R, C; stage_rc(tid * 16 + i * 8192, R, C); const int Rb = Epi::PERM ? ((R & ~31) + perm32(R & 31)) : R;
        voffA[i] = (unsigned)(R * g.lda + C) * 2u; voffB[i] = (unsigned)(Rb * g.ldb + C) * 2u; }
    const size_t kstep = (size_t)(BK * 2);
    const size_t hstepA = (size_t)HALF * g.lda * 2;
    const long hstepB = g.hstepB;
    const unsigned ldsw = (unsigned)wid * 1024u;
    const int aoff = lds_byte(wr * 64 + fr, fq * 8), boff = lds_byte(wc * 32 + fr, fq * 8);
#define PG8_SA(b, h) (((b) * 2 + (h)) * HTB)
#define PG8_SB(b, h) ((4 + (b) * 2 + (h)) * HTB)
#define PG8_STAGE(bufoff, gbase, voff) do { _Pragma("unroll") for (int _i = 0; _i < 2; ++_i) \
        __builtin_amdgcn_global_load_lds((const unsigned*)((const char*)(gbase) + (voff)[_i]), (LAS unsigned*)(lds + (bufoff) + ldsw + _i * 8192), 16, 0, 0); } while (0)
#define PG8_LDA(dst, b, h) do { _Pragma("unroll") for (int m = 0; m < 4; ++m) _Pragma("unroll") for (int k = 0; k < 2; ++k) dst[m][k] = *(const LAS bf16x8*)(lds + PG8_SA(b, h) + aoff + m * 2048 + k * 1024); } while (0)
#define PG8_LDB(dst, b, h) do { _Pragma("unroll") for (int n = 0; n < 2; ++n) _Pragma("unroll") for (int k = 0; k < 2; ++k) dst[n][k] = *(const LAS bf16x8*)(lds + PG8_SB(b, h) + boff + n * 2048 + k * 1024); } while (0)
#define PG8_MMA(ai, bj, At, Bt) do { __builtin_amdgcn_s_setprio(1); _Pragma("unroll") for (int m = 0; m < 4; ++m) _Pragma("unroll") for (int n = 0; n < 2; ++n) _Pragma("unroll") for (int k = 0; k < 2; ++k) \
        acc[ai][bj][m][n] = __builtin_amdgcn_mfma_f32_16x16x32_bf16(Bt[n][k], At[m][k], acc[ai][bj][m][n], 0, 0, 0); __builtin_amdgcn_s_setprio(0); } while (0)
#define PG8_WAIT_V(n) asm volatile("s_waitcnt vmcnt(" #n ")" ::: "memory")
#define PG8_WAIT_L(n) asm volatile("s_waitcnt lgkmcnt(" #n ")" ::: "memory")
#define PG8_BAR __builtin_amdgcn_s_barrier()
#define PG8_SCHED __builtin_amdgcn_sched_barrier(0)
    Unit cur, nxt; int ui = 0;
    if (!S.next(0, cur)) return;
    f32x4 acc[2][2][4][2];
#pragma unroll
    for (int a = 0; a < 2; ++a)
#pragma unroll
        for (int b = 0; b < 2; ++b)
#pragma unroll
            for (int m = 0; m < 4; ++m)
#pragma unroll
                for (int n = 0; n < 2; ++n) acc[a][b][m][n] = (f32x4){0.f, 0.f, 0.f, 0.f};
    bf16x8 At[4][2], B0[2][2], B1[2][2];
    const char* cA = g.A + (size_t)cur.pm * g.tstepA; const char* cB = g.B + (size_t)cur.pn * g.tstepB;
    PG8_STAGE(PG8_SB(0, 0), cB, voffB); PG8_STAGE(PG8_SB(0, 1), cB + hstepB, voffB); PG8_STAGE(PG8_SA(0, 0), cA, voffA); PG8_STAGE(PG8_SA(0, 1), cA + hstepA, voffA);
    if (wr == 1) PG8_BAR;
    PG8_WAIT_V(2); PG8_BAR;
    PG8_STAGE(PG8_SB(1, 0), cB + kstep, voffB); PG8_STAGE(PG8_SA(1, 0), cA + kstep, voffA); PG8_STAGE(PG8_SB(1, 1), cB + hstepB + kstep, voffB);
    PG8_WAIT_V(6); PG8_BAR;
    for (;;) {
        const bool has_next = S.next(ui + 1, nxt);
        const char* nA = has_next ? g.A + (size_t)nxt.pm * g.tstepA : cA; const char* nB = has_next ? g.B + (size_t)nxt.pn * g.tstepB : cB;
        for (int t = 0; t < nt; t += 2) {
            const bool last = (t == nt - 2);
            const char* a1 = cA + (size_t)(t + 1) * kstep;
            const char* a2 = last ? nA : cA + (size_t)(t + 2) * kstep; const char* b2 = last ? nB : cB + (size_t)(t + 2) * kstep;
            const char* a3 = a2 + kstep; const char* b3 = b2 + kstep;
            PG8_LDB(B0, 0, 0); PG8_LDB(B1, 0, 1); PG8_SCHED; PG8_LDA(At, 0, 0); PG8_STAGE(PG8_SA(1, 1), a1 + hstepA, voffA);
            PG8_WAIT_V(8); PG8_WAIT_L(0); PG8_BAR; PG8_MMA(0, 0, At, B0); PG8_MMA(0, 1, At, B1); PG8_BAR; PG8_SCHED;
            PG8_LDA(At, 0, 1); PG8_STAGE(PG8_SB(0, 0), b2, voffB); PG8_STAGE(PG8_SB(0, 1), b2 + hstepB, voffB); PG8_STAGE(PG8_SA(0, 0), a2, voffA);
            PG8_WAIT_V(8); PG8_WAIT_L(0); PG8_BAR; PG8_MMA(1, 0, At, B0); PG8_MMA(1, 1, At, B1); PG8_BAR; PG8_SCHED;
            PG8_LDB(B0, 1, 0); PG8_LDB(B1, 1, 1); PG8_SCHED; PG8_LDA(At, 1, 0); PG8_STAGE(PG8_SA(0, 1), a2 + hstepA, voffA);
            PG8_WAIT_V(8); PG8_WAIT_L(0); PG8_BAR; PG8_MMA(0, 0, At, B0); PG8_MMA(0, 1, At, B1); PG8_BAR; PG8_SCHED;
            PG8_LDA(At, 1, 1); PG8_STAGE(PG8_SB(1, 0), b3, voffB); PG8_STAGE(PG8_SB(1, 1), b3 + hstepB, voffB); PG8_STAGE(PG8_SA(1, 0), a3, voffA);
            PG8_WAIT_V(8); PG8_WAIT_L(0); PG8_BAR; PG8_MMA(1, 0, At, B0); PG8_MMA(1, 1, At, B1); PG8_BAR; PG8_SCHED;
        }
        if (wr == 0) PG8_BAR;
        E(acc, cur, wr, wc, fr, fq);
        if (!has_next) break;
#pragma unroll
        for (int a = 0; a < 2; ++a)
#pragma unroll
            for (int b = 0; b < 2; ++b)
#pragma unroll
                for (int m = 0; m < 4; ++m)
#pragma unroll
                    for (int n = 0; n < 2; ++n) acc[a][b][m][n] = (f32x4){0.f, 0.f, 0.f, 0.f};
        cur = nxt; cA = nA; cB = nB; ++ui;
        if (wr == 1) PG8_BAR;
    }
    PG8_WAIT_V(0);
    PG8_BAR;
#undef PG8_SA
#undef PG8_SB
#undef PG8_STAGE
#undef PG8_LDA
#undef PG8_LDB
#undef PG8_MMA
#undef PG8_WAIT_V
#undef PG8_WAIT_L
#undef PG8_BAR
#undef PG8_SCHED
}
}

#define XB_TMO      128
#define XB_XCNT(j)  (256  + 64 * (j))
#define XB_XSUB(j)  (1280 + 64 * (j))
#define XB_XGEN(j)  (2304 + 64 * (j))
#define XB_TOP      3328
#define XB_TOPGEN   3392
#define XCD_BAR_WORDS 3456
#define XB_SPIN_CAP (1u << 18)
__device__ __forceinline__ unsigned xb_ld(unsigned* p)              { return __hip_atomic_load(p, __ATOMIC_RELAXED, __HIP_MEMORY_SCOPE_AGENT); }
__device__ __forceinline__ unsigned xb_add(unsigned* p, unsigned v) { return __hip_atomic_fetch_add(p, v, __ATOMIC_RELAXED, __HIP_MEMORY_SCOPE_AGENT); }
__device__ __forceinline__ unsigned xb_xcc_id() { return (unsigned)__builtin_amdgcn_s_getreg((3 << 11) | 20) & 0xFu; }
#define XB_SPIN(cond, bar) do { unsigned _sp = 0; while (cond) { __builtin_amdgcn_s_sleep(1); \
    if ((++_sp & 255u) == 0u) { if (xb_ld(&(bar)[XB_TMO])) break; if (_sp > XB_SPIN_CAP) { atomicAdd(&(bar)[XB_TMO], 1u); break; } } } } while (0)
struct XcdBarrier { unsigned* bar; unsigned x; volatile LAS unsigned* st; };
__device__ __forceinline__ XcdBarrier xcd_barrier_post(unsigned* bar, volatile LAS unsigned* st) {
    XcdBarrier b; b.bar = bar; b.x = xb_xcc_id(); b.st = st;
    if (threadIdx.x == 0) (void)xb_add(&bar[XB_XCNT(b.x)], 1u);
    return b;
}
__device__ __forceinline__ void xcd_barrier_complete(unsigned* bar, unsigned x, unsigned& nloc, unsigned& nx) {
    const unsigned G = gridDim.x * gridDim.y * gridDim.z;
    unsigned sum, cnt, mine, sp = 0u;
    for (;;) {
        sum = 0u; cnt = 0u; mine = 0u;
#pragma unroll
        for (unsigned j = 0; j < 16; ++j) { const unsigned c = xb_ld(&bar[XB_XCNT(j)]); sum += c; cnt += (c > 0u) ? 1u : 0u; mine = (j == x) ? c : mine; }
        if (sum == G) break;
        __builtin_amdgcn_s_sleep(1);
        if ((++sp & 255u) == 0u) { if (xb_ld(&bar[XB_TMO])) break; if (sp > XB_SPIN_CAP) { atomicAdd(&bar[XB_TMO], 1u); break; } }
    }
    nloc = mine > 0u ? mine : 1u; nx = cnt > 0u ? cnt : 1u;
}
__device__ __forceinline__ void xcd_barrier(const XcdBarrier& b) {
    asm volatile("s_waitcnt vmcnt(0)" ::: "memory");
    __syncthreads();
    if (threadIdx.x == 0) {
        unsigned* bar = b.bar;
        __builtin_amdgcn_s_waitcnt(0);
        unsigned nloc = b.st[0], nx = b.st[1];
        if (nloc == 0u) { xcd_barrier_complete(bar, b.x, nloc, nx); b.st[0] = nloc; b.st[1] = nx; }
        const unsigned old = xb_add(&bar[XB_XSUB(b.x)], 1u);
        const unsigned gen = old / nloc;
        if (old + 1u == (gen + 1u) * nloc) {
            __builtin_amdgcn_fence(__ATOMIC_RELEASE, "agent");
            asm volatile("s_waitcnt vmcnt(0)" ::: "memory");
            const unsigned og = xb_add(&bar[XB_TOP], 1u);
            const unsigned tg = og / nx;
            if (og + 1u == (tg + 1u) * nx) xb_add(&bar[XB_TOPGEN], 1u);
            else XB_SPIN(xb_ld(&bar[XB_TOPGEN]) == tg, bar);
            __builtin_amdgcn_fence(__ATOMIC_ACQUIRE, "agent");
            xb_add(&bar[XB_XGEN(b.x)], 1u);
            asm volatile("s_waitcnt vmcnt(0)" ::: "memory");
        } else {
            XB_SPIN(xb_ld(&bar[XB_XGEN(b.x)]) == gen, bar);
            __builtin_amdgcn_fence(__ATOMIC_ACQUIRE, "agent");
            asm volatile("s_waitcnt vmcnt(0)" ::: "memory");
        }
    }
    __syncthreads();
}

struct Args {
    const float* x; const float* ln1_g; const float* w_in; const float* mix_g; const float* w_out; const float* ln2_g;
    const float* w_gr; const float* b_gr; const float* w_er; const float* b_er; const float* w_gate; const float* w_up; const float* w_down; const float* fin_g;
    float* out; unsigned char* ws; int ph_lo, ph_hi, li, pad;
};

__device__ __forceinline__ void transpose_item(const float* W, int K, int N, bf16_t* WT, int dpitch, int dcol, LAS float* scr, int item, int lane) {
    const int nblk = N / 32, kb = item / nblk, nb = item % nblk, k0 = 64 * kb, n0 = 32 * nb;
#pragma unroll 8
    for (int i = 0; i < 32; ++i) { const int kk = 2 * i + (lane >> 5); scr[kk * 33 + (lane & 31)] = W[(size_t)(k0 + kk) * N + n0 + (lane & 31)]; }
    LDS_WAIT(); asm volatile("" ::: "memory");
    const int c = lane & 7;
#pragma unroll
    for (int j = 0; j < 4; ++j) { const int n = (lane >> 3) + 8 * j; const LAS float* s = scr + (8 * c) * 33 + n;
        u32x4 o; o.x = pk2(s[0 * 33], s[1 * 33]); o.y = pk2(s[2 * 33], s[3 * 33]); o.z = pk2(s[4 * 33], s[5 * 33]); o.w = pk2(s[6 * 33], s[7 * 33]);
        *(u32x4*)(WT + (size_t)(n0 + n) * dpitch + dcol + k0 + 8 * c) = o; }
    LDS_WAIT(); asm volatile("" ::: "memory");
}
__device__ __forceinline__ void phase_prologue(const Args& a, LAS unsigned char* lds, int gw, int NGW, int wave, int lane) {
    LAS float* scr = (LAS float*)(lds + wave * 16384);
    constexpr int I_IN = (DM / 64) * (NQKV / 32);
    constexpr int I_OUT = (DM / 64) * (DM / 32);
    constexpr int I_G = (DM / 64) * (DEXP / 32);
    constexpr int I_D = (DEXP / 64) * (DM / 32);
    constexpr int N_IN = DEPTH * I_IN, N_OUT = DEPTH * I_OUT, N_G = DEPTH * NEXP * I_G, N_D = DEPTH * NEXP * I_D;
    constexpr int NITEMS = N_IN + N_OUT + 2 * N_G + N_D;
    bf16_t* WinT = (bf16_t*)(a.ws + WS_WIN); bf16_t* WoutT = (bf16_t*)(a.ws + WS_WOUT); bf16_t* WgT = (bf16_t*)(a.ws + WS_WG); bf16_t* WuT = (bf16_t*)(a.ws + WS_WU); bf16_t* WdT = (bf16_t*)(a.ws + WS_WD);
    for (int it = gw; it < NITEMS; it += NGW) {
        int r = it;
        if (r < N_IN) { const int l = r / I_IN; transpose_item(a.w_in + (size_t)l * DM * NQKV, DM, NQKV, WinT + (size_t)l * NQKV * DM, DM, 0, scr, r % I_IN, lane); continue; } r -= N_IN;
        if (r < N_OUT) { const int l = r / I_OUT; transpose_item(a.w_out + (size_t)l * DM * DM, DM, DM, WoutT + (size_t)l * DM * DM, DM, 0, scr, r % I_OUT, lane); continue; } r -= N_OUT;
        if (r < N_G) { const int le = r / I_G; transpose_item(a.w_gate + (size_t)le * DM * DEXP, DM, DEXP, WgT + (size_t)le * DEXP * DM, DM, 0, scr, r % I_G, lane); continue; } r -= N_G;
        if (r < N_G) { const int le = r / I_G; transpose_item(a.w_up + (size_t)le * DM * DEXP, DM, DEXP, WuT + (size_t)le * DEXP * DM, DM, 0, scr, r % I_G, lane); continue; } r -= N_G;
        { const int le = r / I_D, l = le / NEXP, e = le % NEXP; transpose_item(a.w_down + (size_t)le * DEXP * DM, DEXP, DM, WdT + (size_t)l * DM * NACT, NACT, e * DEXP, scr, r % I_D, lane); }
    }
}

__device__ __forceinline__ void phase_norm1(const float* x, const float* g, bf16_t* hb, int gw, int NGW, int lane) {
    f32x4 gv[4];
#pragma unroll
    for (int j = 0; j < 4; ++j) gv[j] = *((const f32x4*)g + lane + 64 * j);
    for (int m = gw; m < T; m += NGW) {
        const f32x4* xr = (const f32x4*)(x + (size_t)m * DM) + lane;
        f32x4 v[4]; float s = 0.f;
#pragma unroll
        for (int j = 0; j < 4; ++j) { v[j] = xr[64 * j]; s += (v[j].x * v[j].x + v[j].y * v[j].y) + (v[j].z * v[j].z + v[j].w * v[j].w); }
        const float rstd = 1.0f / sqrtf(wave_sum(s) * (1.f / DM) + NORM_EPS);
        u32x2* o8 = (u32x2*)(hb + (size_t)m * DM) + lane;
#pragma unroll
        for (int j = 0; j < 4; ++j) { u32x2 w; w.x = pk2(v[j].x * rstd * gv[j].x, v[j].y * rstd * gv[j].y); w.y = pk2(v[j].z * rstd * gv[j].z, v[j].w * rstd * gv[j].w); o8[64 * j] = w; }
    }
}
__device__ __forceinline__ void phase_mixnorm(const bf16_t* ob, const float* g, bf16_t* yb, int gw, int NGW, int lane) {
    float g0[8], g1[8];
#pragma unroll
    for (int j = 0; j < 8; ++j) { g0[j] = g[8 * lane + j]; g1[j] = g[512 + 8 * lane + j]; }
    for (int m = gw; m < T; m += NGW) {
        const u32x4 a = *((const u32x4*)(ob + (size_t)m * DM) + lane), c = *((const u32x4*)(ob + (size_t)m * DM + 512) + lane);
        float va[8] = {bflo(a.x), bfhi(a.x), bflo(a.y), bfhi(a.y), bflo(a.z), bfhi(a.z), bflo(a.w), bfhi(a.w)};
        float vc[8] = {bflo(c.x), bfhi(c.x), bflo(c.y), bfhi(c.y), bflo(c.z), bfhi(c.z), bflo(c.w), bfhi(c.w)};
        float sa = 0.f, sc = 0.f;
#pragma unroll
        for (int j = 0; j < 8; ++j) { sa += va[j] * va[j]; sc += vc[j] * vc[j]; }
        sa = half_sum(sa); sc = wave_sum(sc);
        const float ra = 1.0f / sqrtf(sa * (1.f / 256.f) + NORM_EPS), rc = 1.0f / sqrtf(sc * (1.f / 512.f) + NORM_EPS);
        u32x4 oa, oc;
        oa.x = pk2(va[0] * ra * g0[0], va[1] * ra * g0[1]); oa.y = pk2(va[2] * ra * g0[2], va[3] * ra * g0[3]); oa.z = pk2(va[4] * ra * g0[4], va[5] * ra * g0[5]); oa.w = pk2(va[6] * ra * g0[6], va[7] * ra * g0[7]);
        oc.x = pk2(vc[0] * rc * g1[0], vc[1] * rc * g1[1]); oc.y = pk2(vc[2] * rc * g1[2], vc[3] * rc * g1[3]); oc.z = pk2(vc[4] * rc * g1[4], vc[5] * rc * g1[5]); oc.w = pk2(vc[6] * rc * g1[6], vc[7] * rc * g1[7]);
        *((u32x4*)(yb + (size_t)m * DM) + lane) = oa; *((u32x4*)(yb + (size_t)m * DM + 512) + lane) = oc;
    }
}
__device__ __forceinline__ void phase_route(const float* x, const float* g, const float* wgr, const float* bgr, const float* wer, const float* ber,
                                            bf16_t* hb, float* comb, int gw, int NGW, int lane) {
    f32x4 gv[4];
#pragma unroll
    for (int j = 0; j < 4; ++j) gv[j] = *((const f32x4*)g + lane + 64 * j);
    for (int m = gw; m < T; m += NGW) {
        const f32x4* xr = (const f32x4*)(x + (size_t)m * DM) + lane;
        f32x4 v[4]; float s = 0.f;
#pragma unroll
        for (int j = 0; j < 4; ++j) { v[j] = xr[64 * j]; s += (v[j].x * v[j].x + v[j].y * v[j].y) + (v[j].z * v[j].z + v[j].w * v[j].w); }
        const float rstd = 1.0f / sqrtf(wave_sum(s) * (1.f / DM) + NORM_EPS);
        u32x2* o8 = (u32x2*)(hb + (size_t)m * DM) + lane;
#pragma unroll
        for (int j = 0; j < 4; ++j) { v[j] = v[j] * rstd * gv[j]; u32x2 w; w.x = pk2(v[j].x, v[j].y); w.y = pk2(v[j].z, v[j].w); o8[64 * j] = w; }
        f32x4 gl = (f32x4){0.f, 0.f, 0.f, 0.f};
#pragma unroll
        for (int j = 0; j < 4; ++j) { const f32x4* wp = (const f32x4*)wgr + (size_t)(4 * lane + 256 * j);
            gl += wp[0] * v[j].x; gl += wp[1] * v[j].y; gl += wp[2] * v[j].z; gl += wp[3] * v[j].w; }
        gl.x = wave_sum(gl.x) + bgr[0]; gl.y = wave_sum(gl.y) + bgr[1]; gl.z = wave_sum(gl.z) + bgr[2]; gl.w = wave_sum(gl.w) + bgr[3];
        int gi = 0; float gm = gl.x;
        if (gl.y > gm) { gm = gl.y; gi = 1; } if (gl.z > gm) { gm = gl.z; gi = 2; } if (gl.w > gm) { gm = gl.w; gi = 3; }
        const float gden = __expf(gl.x - gm) + __expf(gl.y - gm) + __expf(gl.z - gm) + __expf(gl.w - gm);
        const float gw_ = 1.0f / gden;
        const float* we = wer + (size_t)gi * DM * 4;
        f32x4 el = (f32x4){0.f, 0.f, 0.f, 0.f};
#pragma unroll
        for (int j = 0; j < 4; ++j) { const f32x4* wp = (const f32x4*)we + (size_t)(4 * lane + 256 * j);
            el += wp[0] * v[j].x; el += wp[1] * v[j].y; el += wp[2] * v[j].z; el += wp[3] * v[j].w; }
        float e[4] = {wave_sum(el.x) + ber[gi * 4 + 0], wave_sum(el.y) + ber[gi * 4 + 1], wave_sum(el.z) + ber[gi * 4 + 2], wave_sum(el.w) + ber[gi * 4 + 3]};
        int i1 = 0; float v1 = e[0];
#pragma unroll
        for (int k = 1; k < 4; ++k) if (e[k] > v1) { v1 = e[k]; i1 = k; }
        int i2 = -1; float v2 = -INFINITY;
#pragma unroll
        for (int k = 0; k < 4; ++k) if (k != i1 && e[k] > v2) { v2 = e[k]; i2 = k; }
        const float p2 = __expf(v2 - v1), inv = 1.0f / (1.0f + p2);
        const float w1 = inv * gw_, w2 = p2 * inv * gw_;
        if (lane < 16) { const int ge = lane >> 2, ee = lane & 3; float cw = 0.f; if (ge == gi) { if (ee == i1) cw = w1; else if (ee == i2) cw = w2; } comb[(size_t)m * NEXP + lane] = cw; }
    }
}
__device__ __forceinline__ void phase_final(float* x, const float* g, int gw, int NGW, int lane) {
    f32x4 gv[4];
#pragma unroll
    for (int j = 0; j < 4; ++j) gv[j] = *((const f32x4*)g + lane + 64 * j);
    for (int m = gw; m < T; m += NGW) {
        f32x4* xr = (f32x4*)(x + (size_t)m * DM) + lane;
        f32x4 v[4]; float s = 0.f;
#pragma unroll
        for (int j = 0; j < 4; ++j) { v[j] = xr[64 * j]; s += (v[j].x * v[j].x + v[j].y * v[j].y) + (v[j].z * v[j].z + v[j].w * v[j].w); }
        const float rstd = 1.0f / sqrtf(wave_sum(s) * (1.f / DM) + NORM_EPS);
#pragma unroll
        for (int j = 0; j < 4; ++j) xr[64 * j] = v[j] * rstd * gv[j];
    }
}
__device__ __forceinline__ void phase_kmean(const bf16_t* kb, float* kmean, int gw, int NGW, int lane) {
    for (int it = gw; it < BATCH * 4 * 32; it += NGW) {
        const int b = it >> 7, h = (it >> 5) & 3, blk = it & 31;
        const bf16_t* base = kb + ((size_t)b * SEQ + (size_t)blk * 256) * DM + h * HD + (lane & 7) * 8;
        float acc[8] = {0.f, 0.f, 0.f, 0.f, 0.f, 0.f, 0.f, 0.f};
#pragma unroll 4
        for (int i = 0; i < 32; ++i) { const u32x4 w = *(const u32x4*)(base + (size_t)((lane >> 3) + 8 * i) * DM);
            acc[0] += bflo(w.x); acc[1] += bfhi(w.x); acc[2] += bflo(w.y); acc[3] += bfhi(w.y); acc[4] += bflo(w.z); acc[5] += bfhi(w.z); acc[6] += bflo(w.w); acc[7] += bfhi(w.w); }
#pragma unroll
        for (int j = 0; j < 8; ++j) { acc[j] += __shfl_xor(acc[j], 8); acc[j] += __shfl_xor(acc[j], 16); acc[j] += __shfl_xor(acc[j], 32); }
        if (lane < 8) {
            float* o = kmean + (size_t)it * HD + lane * 8;
#pragma unroll
            for (int j = 0; j < 8; ++j) o[j] = acc[j] * (1.f / 256.f);
        }
    }
}

__device__ __forceinline__ void ld_row64(float (&r)[64], const bf16_t* p) {
#pragma unroll
    for (int c = 0; c < 8; ++c) { const u32x4 w = *((const u32x4*)p + c);
        r[8 * c + 0] = bflo(w.x); r[8 * c + 1] = bfhi(w.x); r[8 * c + 2] = bflo(w.y); r[8 * c + 3] = bfhi(w.y); r[8 * c + 4] = bflo(w.z); r[8 * c + 5] = bfhi(w.z); r[8 * c + 6] = bflo(w.w); r[8 * c + 7] = bfhi(w.w); }
}
__device__ __forceinline__ float dot_row64(const float (&q)[64], const bf16_t* p) {
    float s0 = 0.f, s1 = 0.f;
#pragma unroll
    for (int c = 0; c < 8; ++c) { const u32x4 w = *((const u32x4*)p + c);
        s0 += q[8 * c + 0] * bflo(w.x); s1 += q[8 * c + 1] * bfhi(w.x); s0 += q[8 * c + 2] * bflo(w.y); s1 += q[8 * c + 3] * bfhi(w.y);
        s0 += q[8 * c + 4] * bflo(w.z); s1 += q[8 * c + 5] * bfhi(w.z); s0 += q[8 * c + 6] * bflo(w.w); s1 += q[8 * c + 7] * bfhi(w.w); }
    return s0 + s1;
}
__device__ __forceinline__ void axpy_row64(float (&o)[64], float p, const bf16_t* vp) {
#pragma unroll
    for (int c = 0; c < 8; ++c) { const u32x4 w = *((const u32x4*)vp + c);
        o[8 * c + 0] += p * bflo(w.x); o[8 * c + 1] += p * bfhi(w.x); o[8 * c + 2] += p * bflo(w.y); o[8 * c + 3] += p * bfhi(w.y);
        o[8 * c + 4] += p * bflo(w.z); o[8 * c + 5] += p * bfhi(w.z); o[8 * c + 6] += p * bflo(w.w); o[8 * c + 7] += p * bfhi(w.w); }
}
__device__ __forceinline__ void st_row64(bf16_t* p, const float (&o)[64], float sc) {
#pragma unroll
    for (int c = 0; c < 8; ++c) { u32x4 w; w.x = pk2(o[8 * c] * sc, o[8 * c + 1] * sc); w.y = pk2(o[8 * c + 2] * sc, o[8 * c + 3] * sc); w.z = pk2(o[8 * c + 4] * sc, o[8 * c + 5] * sc); w.w = pk2(o[8 * c + 6] * sc, o[8 * c + 7] * sc); *((u32x4*)p + c) = w; }
}
#define OSM_STEP(sc, vrow) do { const float sc_ = (sc); if (sc_ > m_) { const float al = __builtin_amdgcn_exp2f(m_ - sc_); l_ *= al; _Pragma("unroll") for (int d_ = 0; d_ < 64; ++d_) o_[d_] *= al; m_ = sc_; } \
    const float p_ = __builtin_amdgcn_exp2f(sc_ - m_); l_ += p_; axpy_row64(o_, p_, (vrow)); } while (0)

__device__ __forceinline__ void naive_moba(const bf16_t* qb, const bf16_t* kb, const bf16_t* vb, const float* kmean, bf16_t* ob, int item, int tid) {
    const int b = item >> 6, h = (item >> 4) & 3, t = (item & 15) * 512 + tid, own = t >> 8;
    const size_t rowq = ((size_t)b * SEQ + t) * DM + h * HD;
    const bf16_t* kh = kb + (size_t)b * SEQ * DM + h * HD; const bf16_t* vh = vb + (size_t)b * SEQ * DM + h * HD;
    const float slope2 = exp2f(-2.0f * (float)(h + 1)) * LOG2E;
    float q_[64]; ld_row64(q_, qb + rowq);
    float bv0 = -INFINITY, bv1 = -INFINITY, bv2 = -INFINITY; int bi0 = -1, bi1 = -1, bi2 = -1;
    const float* km = kmean + (size_t)(b * 4 + h) * 32 * HD;
    for (int n = 0; n < own; ++n) {
        float gsum = 0.f;
#pragma unroll
        for (int d = 0; d < 64; ++d) gsum += q_[d] * km[n * HD + d];
        if (gsum > bv0) { bv2 = bv1; bi2 = bi1; bv1 = bv0; bi1 = bi0; bv0 = gsum; bi0 = n; }
        else if (gsum > bv1) { bv2 = bv1; bi2 = bi1; bv1 = gsum; bi1 = n; }
        else if (gsum > bv2) { bv2 = gsum; bi2 = n; }
    }
    float o_[64];
#pragma unroll
    for (int d = 0; d < 64; ++d) o_[d] = 0.f;
    float m_ = -INFINITY, l_ = 0.f;
    for (int s = 0; s < 3; ++s) {
        const int blk = (s == 0) ? bi0 : (s == 1) ? bi1 : bi2;
        if (blk < 0) continue;
        for (int j = 0; j < 256; ++j) { const int pos = blk * 256 + j;
            const float sc = dot_row64(q_, kh + (size_t)pos * DM) - slope2 * (float)(t - pos);
            OSM_STEP(sc, vh + (size_t)pos * DM); }
    }
    for (int pos = own * 256; pos <= t; ++pos) {
        const float sc = dot_row64(q_, kh + (size_t)pos * DM) - slope2 * (float)(t - pos);
        OSM_STEP(sc, vh + (size_t)pos * DM); }
    st_row64(ob + rowq, o_, 1.0f / l_);
}
__device__ __forceinline__ void naive_sb(const bf16_t* qb, const bf16_t* kb, const bf16_t* vb, bf16_t* ob, int item, int tid) {
    const int b = item >> 6, h = 4 + ((item >> 4) & 3), t = (item & 15) * 512 + tid;
    const size_t rowq = ((size_t)b * SEQ + t) * DM + h * HD;
    const bf16_t* kh = kb + (size_t)b * SEQ * DM + h * HD; const bf16_t* vh = vb + (size_t)b * SEQ * DM + h * HD;
    float q_[64]; ld_row64(q_, qb + rowq);
    float o_[64];
#pragma unroll
    for (int d = 0; d < 64; ++d) o_[d] = 0.f;
    float tail = 0.f;
    for (int s = t - 1; s >= 0 && tail > -150.f; --s) {
        const float z = dot_row64(q_, kh + (size_t)s * DM);
        const float lp = __builtin_amdgcn_logf(1.0f + __builtin_amdgcn_exp2f(-fabsf(z)));
        const float lnot = -(fmaxf(z, 0.f) + lp);
        const float aw = __builtin_amdgcn_exp2f(z + lnot + tail);
        axpy_row64(o_, aw, vh + (size_t)s * DM);
        tail += lnot;
    }
    st_row64(ob + rowq, o_, 1.0f);
}
__device__ __forceinline__ void naive_dil(const bf16_t* qb, const bf16_t* kb, const bf16_t* vb, bf16_t* ob, int item, int tid) {
    const int b = item >> 7, h = 8 + ((item >> 4) & 7), t = (item & 15) * 512 + tid;
    const size_t rowq = ((size_t)b * SEQ + t) * DM + h * HD;
    const bf16_t* kh = kb + (size_t)b * SEQ * DM + h * HD; const bf16_t* vh = vb + (size_t)b * SEQ * DM + h * HD;
    const float slope2 = exp2f(-(float)(h - 8 + 1)) * LOG2E;
    float q_[64]; ld_row64(q_, qb + rowq);
    float o_[64];
#pragma unroll
    for (int d = 0; d < 64; ++d) o_[d] = 0.f;
    float m_ = -INFINITY, l_ = 0.f;
    for (int c = 0; c < 3; ++c) {
        const int dil = (c == 0) ? 1 : (c == 1) ? 4 : 16;
        for (int dl = 0; dl <= 128; ++dl) { const int pos = t - dl * dil; if (pos < 0) break;
            const float sc = dot_row64(q_, kh + (size_t)pos * DM) - slope2 * (float)(dl * dil);
            OSM_STEP(sc, vh + (size_t)pos * DM); }
    }
    st_row64(ob + rowq, o_, 1.0f / l_);
}

constexpr int PH_PRO = 0, PH_L0 = 1, PH_PER_LAYER = 9, PH_FINAL = PH_L0 + DEPTH * PH_PER_LAYER, PH_COUNT = PH_FINAL + 1;
typedef const __attribute__((address_space(4))) Args* KArgP;
#define KARG() ({ KArgP p_ = (KArgP)__builtin_amdgcn_kernarg_segment_ptr(); asm volatile("" : "+s"(p_)); p_; })
#define PHASE_IDS int lane_p = lane, tid_p = tid, gw_p = gw; LAUNDER_V(lane_p); LAUNDER_V(tid_p); LAUNDER_S(gw_p)
__global__ void __launch_bounds__(NTHREADS, 2) fwd(Args a_unused) {
    extern __shared__ __attribute__((aligned(16))) unsigned char lds_raw[];
    LAS unsigned char* lds = (LAS unsigned char*)lds_raw;
    volatile LAS unsigned* MISC = (volatile LAS unsigned*)(lds + MISC_OFF);
    const int tid = threadIdx.x, lane = tid & 63, wave = __builtin_amdgcn_readfirstlane(tid >> 6);
    const int G = gridDim.x, bx = blockIdx.x;
    const int vcu = (G % 8 == 0) ? (bx % 8) * (G / 8) + bx / 8 : bx;
    const int gw = vcu * NWAVES + wave, NGW = G * NWAVES;
    for (int u = tid; u < (LDS_BYTES - LDSCTL_OFF) / 4; u += NTHREADS) ((LAS unsigned*)(lds + LDSCTL_OFF))[u] = 0u;
    __syncthreads();
    int lo, hi; XcdBarrier bar;
    { KArgP ka = KARG(); lo = ka->ph_lo; hi = ka->ph_hi; unsigned* ctl = (unsigned*)(ka->ws + WS_CTL); bar = xcd_barrier_post(ctl + CW_BAR + ka->li * XCD_BAR_WORDS, MISC + 8); }
#define IN(k) (lo <= (k) && (k) < hi)
#define SEAM(k) do { if (IN(k) && IN((k) + 1)) xcd_barrier(bar); } while (0)
#define WSP(T_, off) ((T_*)(ws + (off)))

    if (IN(PH_PRO)) { KArgP ka = KARG(); PHASE_IDS; Args a; a.ws = ka->ws; a.w_in = ka->w_in; a.w_out = ka->w_out; a.w_gate = ka->w_gate; a.w_up = ka->w_up; a.w_down = ka->w_down; phase_prologue(a, lds, gw_p, NGW, wave, lane_p); } SEAM(PH_PRO);

    for (int l = 0; l < DEPTH; ++l) {
        const int p0 = PH_L0 + l * PH_PER_LAYER;
        if (hi <= p0 || lo >= p0 + PH_PER_LAYER) continue;
        if (IN(p0 + 0)) { KArgP ka = KARG(); PHASE_IDS; unsigned char* ws = ka->ws; const float* xin = (l == 0) ? ka->x : ka->out;
            phase_norm1(xin, ka->ln1_g + (size_t)l * DM, WSP(bf16_t, WS_HB), gw_p, NGW, lane_p); } SEAM(p0 + 0);
        if (IN(p0 + 1)) { KArgP ka = KARG(); PHASE_IDS; unsigned char* ws = ka->ws;
            pg8::Gemm g{(const char*)(ws + WS_HB), (const char*)(ws + WS_WIN) + (size_t)l * NQKV * DM * 2, DM, DM, DM, (long)256 * DM * 2, (long)256 * DM * 2, (long)128 * DM * 2};
            pg8::StaticOrder S; S.init(T / 256, NQKV / 256, G, bx);
            pg8::EpiQKV E{WSP(bf16_t, WS_Q), (size_t)(WS_K - WS_Q) / 2, QSCALE};
            pg8::gemm_phase<pg8::EpiQKV, pg8::StaticOrder>(lds, g, S, E);
        } SEAM(p0 + 1);
        if (IN(p0 + 2)) { KArgP ka = KARG(); PHASE_IDS; unsigned char* ws = ka->ws; phase_kmean(WSP(bf16_t, WS_K), WSP(float, WS_KMEAN), gw_p, NGW, lane_p); } SEAM(p0 + 2);
        if (IN(p0 + 3)) { KArgP ka = KARG(); PHASE_IDS; unsigned char* ws = ka->ws;
            const bf16_t* QB = WSP(bf16_t, WS_Q); const bf16_t* KB = WSP(bf16_t, WS_K); const bf16_t* VB = WSP(bf16_t, WS_V); bf16_t* OB = WSP(bf16_t, WS_O);
            for (int it = vcu; it < 256; it += G) naive_moba(QB, KB, VB, WSP(float, WS_KMEAN), OB, it, tid_p);
            for (int it = vcu; it < 256; it += G) naive_sb(QB, KB, VB, OB, it, tid_p);
            for (int it = vcu; it < 512; it += G) naive_dil(QB, KB, VB, OB, it, tid_p);
        } SEAM(p0 + 3);
        if (IN(p0 + 4)) { KArgP ka = KARG(); PHASE_IDS; unsigned char* ws = ka->ws; phase_mixnorm(WSP(bf16_t, WS_O), ka->mix_g + (size_t)l * DM, WSP(bf16_t, WS_HB), gw_p, NGW, lane_p); } SEAM(p0 + 4);
        if (IN(p0 + 5)) { KArgP ka = KARG(); PHASE_IDS; unsigned char* ws = ka->ws; const float* xin = (l == 0) ? ka->x : ka->out;
            pg8::Gemm g{(const char*)(ws + WS_HB), (const char*)(ws + WS_WOUT) + (size_t)l * DM * DM * 2, DM, DM, DM, (long)256 * DM * 2, (long)256 * DM * 2, (long)128 * DM * 2};
            pg8::StaticOrder S; S.init(T / 256, DM / 256, G, bx);
            pg8::EpiResAdd E{xin, ka->out};
            pg8::gemm_phase<pg8::EpiResAdd, pg8::StaticOrder>(lds, g, S, E);
        } SEAM(p0 + 5);
        if (IN(p0 + 6)) { KArgP ka = KARG(); PHASE_IDS; unsigned char* ws = ka->ws;
            phase_route(ka->out, ka->ln2_g + (size_t)l * DM, ka->w_gr + (size_t)l * DM * 4, ka->b_gr + l * 4, ka->w_er + (size_t)l * 4 * DM * 4, ka->b_er + l * 16, WSP(bf16_t, WS_HB), WSP(float, WS_COMB), gw_p, NGW, lane_p); } SEAM(p0 + 6);
        if (IN(p0 + 7)) { KArgP ka = KARG(); PHASE_IDS; unsigned char* ws = ka->ws;
            pg8::Gemm g{(const char*)(ws + WS_HB), (const char*)(ws + WS_WG) + (size_t)l * NACT * DM * 2, DM, DM, DM, (long)256 * DM * 2, (long)128 * DM * 2, (long)(WS_WU - WS_WG)};
            pg8::StaticOrder S; S.init(T / 256, 2 * NEXP, G, bx);
            pg8::EpiGateUpDense E{WSP(bf16_t, WS_ACT), WSP(float, WS_COMB)};
            pg8::gemm_phase<pg8::EpiGateUpDense, pg8::StaticOrder>(lds, g, S, E);
        } SEAM(p0 + 7);
        if (IN(p0 + 8)) { KArgP ka = KARG(); PHASE_IDS; unsigned char* ws = ka->ws;
            pg8::Gemm g{(const char*)(ws + WS_ACT), (const char*)(ws + WS_WD) + (size_t)l * DM * NACT * 2, NACT, NACT, NACT, (long)256 * NACT * 2, (long)256 * NACT * 2, (long)128 * NACT * 2};
            pg8::StaticOrder S; S.init(T / 256, DM / 256, G, bx);
            pg8::EpiResAdd E{ka->out, ka->out};
            pg8::gemm_phase<pg8::EpiResAdd, pg8::StaticOrder>(lds, g, S, E);
        } SEAM(p0 + 8);
    }
    if (IN(PH_FINAL)) { KArgP ka = KARG(); PHASE_IDS; phase_final(ka->out, ka->fin_g, gw_p, NGW, lane_p); }
#undef IN
#undef SEAM
#undef WSP
}

#ifndef N_LAUNCH_MODE
#define N_LAUNCH_MODE 0
#endif
extern "C" void kernel_launch(void* const* d_in, const int* in_sizes, int n_in, void* d_out, int out_size, void* d_ws, size_t ws_size, hipStream_t stream) {
    static int grid = 0;
    if (grid == 0) {
        if (n_in != 14 || in_sizes[0] != T * DM || out_size != T * DM || ws_size < WS_END) { fprintf(stderr, "kernel_launch: unexpected shapes (n_in %d in0 %d out %d ws %zu)\n", n_in, n_in > 0 ? in_sizes[0] : -1, out_size, ws_size); grid = -1; return; }
        int dev = 0, cus = 0, per_cu = 0;
        if (hipGetDevice(&dev) != hipSuccess || hipDeviceGetAttribute(&cus, hipDeviceAttributeMultiprocessorCount, dev) != hipSuccess) { grid = -1; return; }
        if (hipFuncSetAttribute((const void*)fwd, hipFuncAttributeMaxDynamicSharedMemorySize, LDS_BYTES) != hipSuccess) { fprintf(stderr, "kernel_launch: hipFuncSetAttribute failed\n"); grid = -1; return; }
        if (hipOccupancyMaxActiveBlocksPerMultiprocessor(&per_cu, (const void*)fwd, NTHREADS, LDS_BYTES) != hipSuccess || per_cu < 1) fprintf(stderr, "kernel_launch: occupancy query says %d\n", per_cu);
        (void)hipGetLastError();
        grid = cus;
    }
    if (grid < 0) return;
    if (hipMemsetAsync((char*)d_ws + WS_CTL, 0, CTL_ZERO_BYTES, stream) != hipSuccess) return;
    Args a{};
    a.x = (const float*)d_in[0]; a.ln1_g = (const float*)d_in[1]; a.w_in = (const float*)d_in[2]; a.mix_g = (const float*)d_in[3]; a.w_out = (const float*)d_in[4]; a.ln2_g = (const float*)d_in[5];
    a.w_gr = (const float*)d_in[6]; a.b_gr = (const float*)d_in[7]; a.w_er = (const float*)d_in[8]; a.b_er = (const float*)d_in[9]; a.w_gate = (const float*)d_in[10]; a.w_up = (const float*)d_in[11];
    a.w_down = (const float*)d_in[12]; a.fin_g = (const float*)d_in[13];
    a.out = (float*)d_out; a.ws = (unsigned char*)d_ws; a.pad = 0;
#if N_LAUNCH_MODE == 1
    a.ph_lo = 0; a.ph_hi = PH_COUNT; a.li = 0;
    hipLaunchKernelGGL(fwd, dim3(grid), dim3(NTHREADS), LDS_BYTES, stream, a);
#else
    for (int p = 0; p < PH_COUNT; ++p) { a.ph_lo = p; a.ph_hi = p + 1; a.li = p; hipLaunchKernelGGL(fwd, dim3(grid), dim3(NTHREADS), LDS_BYTES, stream, a); }
#endif
}
```

```cpp
#include <hip/hip_runtime.h>
#include <cstdio>
#include <cstdint>

#define LAS __attribute__((address_space(3)))
#define GAS __attribute__((address_space(1)))
typedef unsigned short bf16_t;
typedef short bf16x8 __attribute__((ext_vector_type(8)));
typedef float f32x4 __attribute__((ext_vector_type(4)));
typedef float f32x2 __attribute__((ext_vector_type(2)));
typedef unsigned u32x4 __attribute__((ext_vector_type(4)));
typedef unsigned u32x2 __attribute__((ext_vector_type(2)));

constexpr int BATCH = 4, SEQ = 8192, DM = 1024, DEPTH = 4, T = BATCH * SEQ, NH = 16, HD = 64;
constexpr int NQKV = 3 * DM, NEXP = 16, DEXP = 256, NACT = NEXP * DEXP;
constexpr float NORM_EPS = 1e-6f;
constexpr float LOG2E = 1.4426950408889634f;
constexpr float QSCALE = 0.125f * LOG2E;
constexpr int NWAVES = 8, NTHREADS = 512;

constexpr size_t MiB = 1u << 20;
constexpr size_t WS_CTL = 0, CTL_ZERO_BYTES = 1 * MiB;
constexpr size_t WS_WIN = 2 * MiB;
constexpr size_t WS_WOUT = 26 * MiB;
constexpr size_t WS_WG = 34 * MiB;
constexpr size_t WS_WU = 66 * MiB;
constexpr size_t WS_WD = 98 * MiB;
constexpr size_t WS_KMEAN = 130 * MiB;
constexpr size_t WS_COMB = 131 * MiB;
constexpr size_t WS_HB = 134 * MiB;
constexpr size_t WS_Q = 198 * MiB, WS_K = 262 * MiB, WS_V = 326 * MiB, WS_O = 390 * MiB;
constexpr size_t WS_ACT = WS_Q;
constexpr size_t WS_END = 454 * MiB;
constexpr int CW_BAR = 4096;

constexpr int RING_BYTES = 131072;
constexpr int LDSCTL_OFF = RING_BYTES, MISC_OFF = LDSCTL_OFF + 320;
constexpr int LDS_BYTES = 147456;

__device__ __forceinline__ unsigned f2bf(float f) { unsigned u = __builtin_bit_cast(unsigned, f); return (u + 0x7fffu + ((u >> 16) & 1u)) >> 16; }
__device__ __forceinline__ unsigned pk2(float lo, float hi) { return f2bf(lo) | (f2bf(hi) << 16); }
__device__ __forceinline__ float bflo(unsigned w) { return __builtin_bit_cast(float, w << 16); }
__device__ __forceinline__ float bfhi(unsigned w) { return __builtin_bit_cast(float, w & 0xffff0000u); }
__device__ __forceinline__ float wave_sum(float v) {
#pragma unroll
    for (int o = 1; o < 64; o <<= 1) v += __shfl_xor(v, o);
    return v;
}
__device__ __forceinline__ float half_sum(float v) {
#pragma unroll
    for (int o = 1; o < 32; o <<= 1) v += __shfl_xor(v, o);
    return v;
}
#define LDS_WAIT() asm volatile("s_waitcnt lgkmcnt(0)" ::: "memory")
#define LAUNDER_V(x) asm volatile("" : "+v"(x))
#define LAUNDER_S(x) asm volatile("" : "+s"(x))

namespace pg8 {
constexpr int BM = 256, BK = 64, HALF = 128, HTB = HALF * BK * 2, STAGE_BYTES = 8 * HTB, NXCD = 8, WGM = 8;
__host__ __device__ __forceinline__ int lds_byte(int r, int c) { const int st = (r >> 4) * 2 + (c >> 5), rr = r & 15, cc = c & 31, ob = rr * 64 + cc * 2; return st * 1024 + (ob ^ (((ob >> 9) & 1) << 5)); }
__host__ __device__ __forceinline__ void stage_rc(int b, int& R, int& C) { const int st = b / 1024, sb = b % 1024, swz = sb ^ (((sb >> 9) & 1) << 5); R = (st >> 1) * 16 + swz / 64; C = (st & 1) * 32 + (swz % 64) / 2; }
__host__ __device__ __forceinline__ int perm32(int rho) { const int n = rho >> 4, i = rho & 15; return 8 * (i >> 2) + 4 * n + (i & 3); }

struct Unit { int pm, pn; };
struct Gemm { const char* A; const char* B; int lda, ldb, K; long tstepA, tstepB, hstepB; };

struct StaticOrder {
    int nM, nN, nwg, G, c;
    __host__ __device__ void init(int nM_, int nN_, int G_, int c_) { nM = nM_; nN = nN_; nwg = nM * nN; G = G_; c = c_; }
    __host__ __device__ bool next(int i, Unit& u) const {
        const long L = (long)i * G + c; if (L >= nwg) return false;
        int wgid = (int)L; { const int q = nwg / NXCD, r = nwg % NXCD, xcd = wgid % NXCD, off = wgid / NXCD; wgid = (xcd < r ? xcd * (q + 1) : r * (q + 1) + (xcd - r) * q) + off; }
        const int nig = WGM * nN, gid = wgid / nig, fm = gid * WGM, gsz = (nM - fm) < WGM ? (nM - fm) : WGM;
        u.pm = fm + ((wgid % nig) % gsz); u.pn = (wgid % nig) / gsz; return true;
    }
};

__device__ __forceinline__ unsigned cvt_pk_bf16(float lo, float hi) { unsigned r; asm volatile("v_cvt_pk_bf16_f32 %0, %1, %2" : "=v"(r) : "v"(lo), "v"(hi)); return r; }

struct EpiQKV {
    static constexpr bool PERM = true;
    bf16_t* O; size_t split_stride; float scale0;
    __device__ __forceinline__ void operator()(const f32x4 (&acc)[2][2][4][2], const Unit& u, int wr, int wc, int fr, int fq) const {
        const int row0 = u.pm * BM + wr * 64 + fr; int colt = u.pn * BM;
        const int t = colt / DM; bf16_t* base = O + (size_t)t * split_stride; colt -= t * DM; const float sc = (t == 0) ? scale0 : 1.f;
        const int col0 = colt + wc * 32 + 8 * fq;
#pragma unroll
        for (int ai = 0; ai < 2; ++ai)
#pragma unroll
            for (int m = 0; m < 4; ++m) { bf16_t* rowp = base + (size_t)(row0 + ai * HALF + m * 16) * DM + col0;
#pragma unroll
                for (int bj = 0; bj < 2; ++bj) { f32x4 v0 = acc[ai][bj][m][0] * sc, v1 = acc[ai][bj][m][1] * sc;
                    u32x4 w; w.x = cvt_pk_bf16(v0[0], v0[1]); w.y = cvt_pk_bf16(v0[2], v0[3]); w.z = cvt_pk_bf16(v1[0], v1[1]); w.w = cvt_pk_bf16(v1[2], v1[3]);
                    *(u32x4*)(rowp + bj * HALF) = w; } }
    }
};
struct EpiResAdd {
    static constexpr bool PERM = false;
    const float* base; float* out;
    __device__ __forceinline__ void operator()(const f32x4 (&acc)[2][2][4][2], const Unit& u, int wr, int wc, int fr, int fq) const {
        const int col0 = u.pn * BM + wc * 32 + 4 * fq;
#pragma unroll
        for (int ai = 0; ai < 2; ++ai)
#pragma unroll
            for (int m = 0; m < 4; ++m) { const size_t off = (size_t)(u.pm * BM + ai * HALF + wr * 64 + m * 16 + fr) * DM + col0;
#pragma unroll
                for (int bj = 0; bj < 2; ++bj)
#pragma unroll
                    for (int n = 0; n < 2; ++n) { const f32x4 bs = *(const f32x4*)(base + off + bj * HALF + n * 16); *(f32x4*)(out + off + bj * HALF + n * 16) = bs + acc[ai][bj][m][n]; } }
    }
};
struct EpiGateUpDense {
    static constexpr bool PERM = true;
    bf16_t* act; const float* comb;
    __device__ __forceinline__ void operator()(const f32x4 (&acc)[2][2][4][2], const Unit& u, int wr, int wc, int fr, int fq) const {
        const int e = u.pn >> 1, c0 = (u.pn & 1) * HALF;
        const int col0 = e * DEXP + c0 + wc * 32 + 8 * fq;
#pragma unroll
        for (int ai = 0; ai < 2; ++ai)
#pragma unroll
            for (int m = 0; m < 4; ++m) { const int row = u.pm * BM + ai * HALF + wr * 64 + m * 16 + fr;
                const float cw = comb[(size_t)row * NEXP + e];
                float o[8];
#pragma unroll
                for (int n = 0; n < 2; ++n)
#pragma unroll
                    for (int j = 0; j < 4; ++j) { const float g = acc[ai][0][m][n][j], up = acc[ai][1][m][n][j];
                        const float sg = g * __builtin_amdgcn_rcpf(1.f + __builtin_amdgcn_exp2f(-g * LOG2E));
                        o[n * 4 + j] = sg * up * cw; }
                u32x4 w; w.x = cvt_pk_bf16(o[0], o[1]); w.y = cvt_pk_bf16(o[2], o[3]); w.z = cvt_pk_bf16(o[4], o[5]); w.w = cvt_pk_bf16(o[6], o[7]);
                *(u32x4*)(act + (size_t)row * NACT + col0) = w; }
    }
};

template <class Epi, class Sched>
__device__ __forceinline__ void gemm_phase(LAS unsigned char* lds, const Gemm g, const Sched& S, const Epi& E) {
    int tid_l = threadIdx.x; asm volatile("" : "+v"(tid_l));
    const int tid = tid_l, wid = __builtin_amdgcn_readfirstlane(tid >> 6), lane = tid & 63, wr = wid >> 2, wc = wid & 3, fr = lane & 15, fq = lane >> 4;
    const int K = g.K, nt = K / BK;
    unsigned voffA[2], voffB[2];
#pragma unroll
    for (int i = 0; i < 2; ++i) { int R, C; stage_rc(tid * 16 + i * 8192, R, C); const int Rb = Epi::PERM ? ((R & ~31) + perm32(R & 31)) : R;
        voffA[i] = (unsigned)(R * g.lda + C) * 2u; voffB[i] = (unsigned)(Rb * g.ldb + C) * 2u; }
    const size_t kstep = (size_t)(BK * 2);
    const size_t hstepA = (size_t)HALF * g.lda * 2;
    const long hstepB = g.hstepB;
    const unsigned ldsw = (unsigned)wid * 1024u;
    const int aoff = lds_byte(wr * 64 + fr, fq * 8), boff = lds_byte(wc * 32 + fr, fq * 8);
#define PG8_SA(b, h) (((b) * 2 + (h)) * HTB)
#define PG8_SB(b, h) ((4 + (b) * 2 + (h)) * HTB)
#define PG8_STAGE(bufoff, gbase, voff) do { _Pragma("unroll") for (int _i = 0; _i < 2; ++_i) \
        __builtin_amdgcn_global_load_lds((const unsigned*)((const char*)(gbase) + (voff)[_i]), (LAS unsigned*)(lds + (bufoff) + ldsw + _i * 8192), 16, 0, 0); } while (0)
#define PG8_LDA(dst, b, h) do { _Pragma("unroll") for (int m = 0; m < 4; ++m) _Pragma("unroll") for (int k = 0; k < 2; ++k) dst[m][k] = *(const LAS bf16x8*)(lds + PG8_SA(b, h) + aoff + m * 2048 + k * 1024); } while (0)
#define PG8_LDB(dst, b, h) do { _Pragma("unroll") for (int n = 0; n < 2; ++n) _Pragma("unroll") for (int k = 0; k < 2; ++k) dst[n][k] = *(const LAS bf16x8*)(lds + PG8_SB(b, h) + boff + n * 2048 + k * 1024); } while (0)
#define PG8_MMA(ai, bj, At, Bt) do { __builtin_amdgcn_s_setprio(1); _Pragma("unroll") for (int m = 0; m < 4; ++m) _Pragma("unroll") for (int n = 0; n < 2; ++n) _Pragma("unroll") for (int k = 0; k < 2; ++k) \
        acc[ai][bj][m][n] = __builtin_amdgcn_mfma_f32_16x16x32_bf16(Bt[n][k], At[m][k], acc[ai][bj][m][n], 0, 0, 0); __builtin_amdgcn_s_setprio(0); } while (0)
#define PG8_WAIT_V(n) asm volatile("s_waitcnt vmcnt(" #n ")" ::: "memory")
#define PG8_WAIT_L(n) asm volatile("s_waitcnt lgkmcnt(" #n ")" ::: "memory")
#define PG8_BAR __builtin_amdgcn_s_barrier()
#define PG8_SCHED __builtin_amdgcn_sched_barrier(0)
    Unit cur, nxt; int ui = 0;
    if (!S.next(0, cur)) return;
    f32x4 acc[2][2][4][2];
#pragma unroll
    for (int a = 0; a < 2; ++a)
#pragma unroll
        for (int b = 0; b < 2; ++b)
#pragma unroll
            for (int m = 0; m < 4; ++m)
#pragma unroll
                for (int n = 0; n < 2; ++n) acc[a][b][m][n] = (f32x4){0.f, 0.f, 0.f, 0.f};
    bf16x8 At[4][2], B0[2][2], B1[2][2];
    const char* cA = g.A + (size_t)cur.pm * g.tstepA; const char* cB = g.B + (size_t)cur.pn * g.tstepB;
    PG8_STAGE(PG8_SB(0, 0), cB, voffB); PG8_STAGE(PG8_SB(0, 1), cB + hstepB, voffB); PG8_STAGE(PG8_SA(0, 0), cA, voffA); PG8_STAGE(PG8_SA(0, 1), cA + hstepA, voffA);
    if (wr == 1) PG8_BAR;
    PG8_WAIT_V(2); PG8_BAR;
    PG8_STAGE(PG8_SB(1, 0), cB + kstep, voffB); PG8_STAGE(PG8_SA(1, 0), cA + kstep, voffA); PG8_STAGE(PG8_SB(1, 1), cB + hstepB + kstep, voffB);
    PG8_WAIT_V(6); PG8_BAR;
    for (;;) {
        const bool has_next = S.next(ui + 1, nxt);
        const char* nA = has_next ? g.A + (size_t)nxt.pm * g.tstepA : cA; const char* nB = has_next ? g.B + (size_t)nxt.pn * g.tstepB : cB;
        for (int t = 0; t < nt; t += 2) {
            const bool last = (t == nt - 2);
            const char* a1 = cA + (size_t)(t + 1) * kstep;
            const char* a2 = last ? nA : cA + (size_t)(t + 2) * kstep; const char* b2 = last ? nB : cB + (size_t)(t + 2) * kstep;
            const char* a3 = a2 + kstep; const char* b3 = b2 + kstep;
            PG8_LDB(B0, 0, 0); PG8_LDB(B1, 0, 1); PG8_SCHED; PG8_LDA(At, 0, 0); PG8_STAGE(PG8_SA(1, 1), a1 + hstepA, voffA);
            PG8_WAIT_V(8); PG8_WAIT_L(0); PG8_BAR; PG8_MMA(0, 0, At, B0); PG8_MMA(0, 1, At, B1); PG8_BAR; PG8_SCHED;
            PG8_LDA(At, 0, 1); PG8_STAGE(PG8_SB(0, 0), b2, voffB); PG8_STAGE(PG8_SB(0, 1), b2 + hstepB, voffB); PG8_STAGE(PG8_SA(0, 0), a2, voffA);
            PG8_WAIT_V(8); PG8_WAIT_L(0); PG8_BAR; PG8_MMA(1, 0, At, B0); PG8_MMA(1, 1, At, B1); PG8_BAR; PG8_SCHED;
            PG8_LDB(B0, 1, 0); PG8_LDB(B1, 1, 1); PG8_SCHED; PG8_LDA(At, 1, 0); PG8_STAGE(PG8_SA(0, 1), a2 + hstepA, voffA);
            PG8_WAIT_V(8); PG8_WAIT_L(0); PG8_BAR; PG8_MMA(0, 0, At, B0); PG8_MMA(0, 1, At, B1); PG8_BAR; PG8_SCHED;
            PG8_LDA(At, 1, 1); PG8_STAGE(PG8_SB(1, 0), b3, voffB); PG8_STAGE(PG8_SB(1, 1), b3 + hstepB, voffB); PG8_STAGE(PG8_SA(1, 0), a3, voffA);
            PG8_WAIT_V(8); PG8_WAIT_L(0); PG8_BAR; PG8_MMA(1, 0, At, B0); PG8_MMA(1, 1, At, B1); PG8_BAR; PG8_SCHED;
        }
        if (wr == 0) PG8_BAR;
        E(acc, cur, wr, wc, fr, fq);
        if (!has_next) break;
#pragma unroll
        for (int a = 0; a < 2; ++a)
#pragma unroll
            for (int b = 0; b < 2; ++b)
#pragma unroll
                for (int m = 0; m < 4; ++m)
#pragma unroll
                    for (int n = 0; n < 2; ++n) acc[a][b][m][n] = (f32x4){0.f, 0.f, 0.f, 0.f};
        cur = nxt; cA = nA; cB = nB; ++ui;
        if (wr == 1) PG8_BAR;
    }
    PG8_WAIT_V(0);
    PG8_BAR;
#undef PG8_SA
#undef PG8_SB
#undef PG8_STAGE
#undef PG8_LDA
#undef PG8_LDB
#undef PG8_MMA
#undef PG8_WAIT_V
#undef PG8_WAIT_L
#undef PG8_BAR
#undef PG8_SCHED
}
}

#define XB_TMO      128
#define XB_XCNT(j)  (256  + 64 * (j))
#define XB_XSUB(j)  (1280 + 64 * (j))
#define XB_XGEN(j)  (2304 + 64 * (j))
#define XB_TOP      3328
#define XB_TOPGEN   3392
#define XCD_BAR_WORDS 3456
#define XB_SPIN_CAP (1u << 18)
__device__ __forceinline__ unsigned xb_ld(unsigned* p)              { return __hip_atomic_load(p, __ATOMIC_RELAXED, __HIP_MEMORY_SCOPE_AGENT); }
__device__ __forceinline__ unsigned xb_add(unsigned* p, unsigned v) { return __hip_atomic_fetch_add(p, v, __ATOMIC_RELAXED, __HIP_MEMORY_SCOPE_AGENT); }
__device__ __forceinline__ unsigned xb_xcc_id() { return (unsigned)__builtin_amdgcn_s_getreg((3 << 11) | 20) & 0xFu; }
#define XB_SPIN(cond, bar) do { unsigned _sp = 0; while (cond) { __builtin_amdgcn_s_sleep(1); \
    if ((++_sp & 255u) == 0u) { if (xb_ld(&(bar)[XB_TMO])) break; if (_sp > XB_SPIN_CAP) { atomicAdd(&(bar)[XB_TMO], 1u); break; } } } } while (0)
struct XcdBarrier { unsigned* bar; unsigned x; volatile LAS unsigned* st; };
__device__ __forceinline__ XcdBarrier xcd_barrier_post(unsigned* bar, volatile LAS unsigned* st) {
    XcdBarrier b; b.bar = bar; b.x = xb_xcc_id(); b.st = st;
    if (threadIdx.x == 0) (void)xb_add(&bar[XB_XCNT(b.x)], 1u);
    return b;
}
__device__ __forceinline__ void xcd_barrier_complete(unsigned* bar, unsigned x, unsigned& nloc, unsigned& nx) {
    const unsigned G = gridDim.x * gridDim.y * gridDim.z;
    unsigned sum, cnt, mine, sp = 0u;
    for (;;) {
        sum = 0u; cnt = 0u; mine = 0u;
#pragma unroll
        for (unsigned j = 0; j < 16; ++j) { const unsigned c = xb_ld(&bar[XB_XCNT(j)]); sum += c; cnt += (c > 0u) ? 1u : 0u; mine = (j == x) ? c : mine; }
        if (sum == G) break;
        __builtin_amdgcn_s_sleep(1);
        if ((++sp & 255u) == 0u) { if (xb_ld(&bar[XB_TMO])) break; if (sp > XB_SPIN_CAP) { atomicAdd(&bar[XB_TMO], 1u); break; } }
    }
    nloc = mine > 0u ? mine : 1u; nx = cnt > 0u ? cnt : 1u;
}
__device__ __forceinline__ void xcd_barrier(const XcdBarrier& b) {
    asm volatile("s_waitcnt vmcnt(0)" ::: "memory");
    __syncthreads();
    if (threadIdx.x == 0) {
        unsigned* bar = b.bar;
        __builtin_amdgcn_s_waitcnt(0);
        unsigned nloc = b.st[0], nx = b.st[1];
        if (nloc == 0u) { xcd_barrier_complete(bar, b.x, nloc, nx); b.st[0] = nloc; b.st[1] = nx; }
        const unsigned old = xb_add(&bar[XB_XSUB(b.x)], 1u);
        const unsigned gen = old / nloc;
        if (old + 1u == (gen + 1u) * nloc) {
            __builtin_amdgcn_fence(__ATOMIC_RELEASE, "agent");
            asm volatile("s_waitcnt vmcnt(0)" ::: "memory");
            const unsigned og = xb_add(&bar[XB_TOP], 1u);
            const unsigned tg = og / nx;
            if (og + 1u == (tg + 1u) * nx) xb_add(&bar[XB_TOPGEN], 1u);
            else XB_SPIN(xb_ld(&bar[XB_TOPGEN]) == tg, bar);
            __builtin_amdgcn_fence(__ATOMIC_ACQUIRE, "agent");
            xb_add(&bar[XB_XGEN(b.x)], 1u);
            asm volatile("s_waitcnt vmcnt(0)" ::: "memory");
        } else {
            XB_SPIN(xb_ld(&bar[XB_XGEN(b.x)]) == gen, bar);
            __builtin_amdgcn_fence(__ATOMIC_ACQUIRE, "agent");
            asm volatile("s_waitcnt vmcnt(0)" ::: "memory");
        }
    }
    __syncthreads();
}

struct Args {
    const float* x; const float* ln1_g; const float* w_in; const float* mix_g; const float* w_out; const float* ln2_g;
    const float* w_gr; const float* b_gr; const float* w_er; const float* b_er; const float* w_gate; const float* w_up; const float* w_down; const float* fin_g;
    float* out; unsigned char* ws; int ph_lo, ph_hi, li, pad;
};

__device__ __forceinline__ void transpose_item(const float* W, int K, int N, bf16_t* WT, int dpitch, int dcol, LAS float* scr, int item, int lane) {
    const int nblk = N / 32, kb = item / nblk, nb = item % nblk, k0 = 64 * kb, n0 = 32 * nb;
#pragma unroll 8
    for (int i = 0; i < 32; ++i) { const int kk = 2 * i + (lane >> 5); scr[kk * 33 + (lane & 31)] = W[(size_t)(k0 + kk) * N + n0 + (lane & 31)]; }
    LDS_WAIT(); asm volatile("" ::: "memory");
    const int c = lane & 7;
#pragma unroll
    for (int j = 0; j < 4; ++j) { const int n = (lane >> 3) + 8 * j; const LAS float* s = scr + (8 * c) * 33 + n;
        u32x4 o; o.x = pk2(s[0 * 33], s[1 * 33]); o.y = pk2(s[2 * 33], s[3 * 33]); o.z = pk2(s[4 * 33], s[5 * 33]); o.w = pk2(s[6 * 33], s[7 * 33]);
        *(u32x4*)(WT + (size_t)(n0 + n) * dpitch + dcol + k0 + 8 * c) = o; }
    LDS_WAIT(); asm volatile("" ::: "memory");
}
__device__ __forceinline__ void phase_prologue(const Args& a, LAS unsigned char* lds, int gw, int NGW, int wave, int lane) {
    LAS float* scr = (LAS float*)(lds + wave * 16384);
    constexpr int I_IN = (DM / 64) * (NQKV / 32);
    constexpr int I_OUT = (DM / 64) * (DM / 32);
    constexpr int I_G = (DM / 64) * (DEXP / 32);
    constexpr int I_D = (DEXP / 64) * (DM / 32);
    constexpr int N_IN = DEPTH * I_IN, N_OUT = DEPTH * I_OUT, N_G = DEPTH * NEXP * I_G, N_D = DEPTH * NEXP * I_D;
    constexpr int NITEMS = N_IN + N_OUT + 2 * N_G + N_D;
    bf16_t* WinT = (bf16_t*)(a.ws + WS_WIN); bf16_t* WoutT = (bf16_t*)(a.ws + WS_WOUT); bf16_t* WgT = (bf16_t*)(a.ws + WS_WG); bf16_t* WuT = (bf16_t*)(a.ws + WS_WU); bf16_t* WdT = (bf16_t*)(a.ws + WS_WD);
    for (int it = gw; it < NITEMS; it += NGW) {
        int r = it;
        if (r < N_IN) { const int l = r / I_IN; transpose_item(a.w_in + (size_t)l * DM * NQKV, DM, NQKV, WinT + (size_t)l * NQKV * DM, DM, 0, scr, r % I_IN, lane); continue; } r -= N_IN;
        if (r < N_OUT) { const int l = r / I_OUT; transpose_item(a.w_out + (size_t)l * DM * DM, DM, DM, WoutT + (size_t)l * DM * DM, DM, 0, scr, r % I_OUT, lane); continue; } r -= N_OUT;
        if (r < N_G) { const int le = r / I_G; transpose_item(a.w_gate + (size_t)le * DM * DEXP, DM, DEXP, WgT + (size_t)le * DEXP * DM, DM, 0, scr, r % I_G, lane); continue; } r -= N_G;
        if (r < N_G) { const int le = r / I_G; transpose_item(a.w_up + (size_t)le * DM * DEXP, DM, DEXP, WuT + (size_t)le * DEXP * DM, DM, 0, scr, r % I_G, lane); continue; } r -= N_G;
        { const int le = r / I_D, l = le / NEXP, e = le % NEXP; transpose_item(a.w_down + (size_t)le * DEXP * DM, DEXP, DM, WdT + (size_t)l * DM * NACT, NACT, e * DEXP, scr, r % I_D, lane); }
    }
}

__device__ __forceinline__ void phase_norm1(const float* x, const float* g, bf16_t* hb, int gw, int NGW, int lane) {
    f32x4 gv[4];
#pragma unroll
    for (int j = 0; j < 4; ++j) gv[j] = *((const f32x4*)g + lane + 64 * j);
    for (int m = gw; m < T; m += NGW) {
        const f32x4* xr = (const f32x4*)(x + (size_t)m * DM) + lane;
        f32x4 v[4]; float s = 0.f;
#pragma unroll
        for (int j = 0; j < 4; ++j) { v[j] = xr[64 * j]; s += (v[j].x * v[j].x + v[j].y * v[j].y) + (v[j].z * v[j].z + v[j].w * v[j].w); }
        const float rstd = 1.0f / sqrtf(wave_sum(s) * (1.f / DM) + NORM_EPS);
        u32x2* o8 = (u32x2*)(hb + (size_t)m * DM) + lane;
#pragma unroll
        for (int j = 0; j < 4; ++j) { u32x2 w; w.x = pk2(v[j].x * rstd * gv[j].x, v[j].y * rstd * gv[j].y); w.y = pk2(v[j].z * rstd * gv[j].z, v[j].w * rstd * gv[j].w); o8[64 * j] = w; }
    }
}
__device__ __forceinline__ void phase_mixnorm(const bf16_t* ob, const float* g, bf16_t* yb, int gw, int NGW, int lane) {
    float g0[8], g1[8];
#pragma unroll
    for (int j = 0; j < 8; ++j) { g0[j] = g[8 * lane + j]; g1[j] = g[512 + 8 * lane + j]; }
    for (int m = gw; m < T; m += NGW) {
        const u32x4 a = *((const u32x4*)(ob + (size_t)m * DM) + lane), c = *((const u32x4*)(ob + (size_t)m * DM + 512) + lane);
        float va[8] = {bflo(a.x), bfhi(a.x), bflo(a.y), bfhi(a.y), bflo(a.z), bfhi(a.z), bflo(a.w), bfhi(a.w)};
        float vc[8] = {bflo(c.x), bfhi(c.x), bflo(c.y), bfhi(c.y), bflo(c.z), bfhi(c.z), bflo(c.w), bfhi(c.w)};
        float sa = 0.f, sc = 0.f;
#pragma unroll
        for (int j = 0; j < 8; ++j) { sa += va[j] * va[j]; sc += vc[j] * vc[j]; }
        sa = half_sum(sa); sc = wave_sum(sc);
        const float ra = 1.0f / sqrtf(sa * (1.f / 256.f) + NORM_EPS), rc = 1.0f / sqrtf(sc * (1.f / 512.f) + NORM_EPS);
        u32x4 oa, oc;
        oa.x = pk2(va[0] * ra * g0[0], va[1] * ra * g0[1]); oa.y = pk2(va[2] * ra * g0[2], va[3] * ra * g0[3]); oa.z = pk2(va[4] * ra * g0[4], va[5] * ra * g0[5]); oa.w = pk2(va[6] * ra * g0[6], va[7] * ra * g0[7]);
        oc.x = pk2(vc[0] * rc * g1[0], vc[1] * rc * g1[1]); oc.y = pk2(vc[2] * rc * g1[2], vc[3] * rc * g1[3]); oc.z = pk2(vc[4] * rc * g1[4], vc[5] * rc * g1[5]); oc.w = pk2(vc[6] * rc * g1[6], vc[7] * rc * g1[7]);
        *((u32x4*)(yb + (size_t)m * DM) + lane) = oa; *((u32x4*)(yb + (size_t)m * DM + 512) + lane) = oc;
    }
}
__device__ __forceinline__ void phase_route(const float* x, const float* g, const float* wgr, const float* bgr, const float* wer, const float* ber,
                                            bf16_t* hb, float* comb, int gw, int NGW, int lane) {
    f32x4 gv[4];
#pragma unroll
    for (int j = 0; j < 4; ++j) gv[j] = *((const f32x4*)g + lane + 64 * j);
    for (int m = gw; m < T; m += NGW) {
        const f32x4* xr = (const f32x4*)(x + (size_t)m * DM) + lane;
        f32x4 v[4]; float s = 0.f;
#pragma unroll
        for (int j = 0; j < 4; ++j) { v[j] = xr[64 * j]; s += (v[j].x * v[j].x + v[j].y * v[j].y) + (v[j].z * v[j].z + v[j].w * v[j].w); }
        const float rstd = 1.0f / sqrtf(wave_sum(s) * (1.f / DM) + NORM_EPS);
        u32x2* o8 = (u32x2*)(hb + (size_t)m * DM) + lane;
#pragma unroll
        for (int j = 0; j < 4; ++j) { v[j] = v[j] * rstd * gv[j]; u32x2 w; w.x = pk2(v[j].x, v[j].y); w.y = pk2(v[j].z, v[j].w); o8[64 * j] = w; }
        f32x4 gl = (f32x4){0.f, 0.f, 0.f, 0.f};
#pragma unroll
        for (int j = 0; j < 4; ++j) { const f32x4* wp = (const f32x4*)wgr + (size_t)(4 * lane + 256 * j);
            gl += wp[0] * v[j].x; gl += wp[1] * v[j].y; gl += wp[2] * v[j].z; gl += wp[3] * v[j].w; }
        gl.x = wave_sum(gl.x) + bgr[0]; gl.y = wave_sum(gl.y) + bgr[1]; gl.z = wave_sum(gl.z) + bgr[2]; gl.w = wave_sum(gl.w) + bgr[3];
        int gi = 0; float gm = gl.x;
        if (gl.y > gm) { gm = gl.y; gi = 1; } if (gl.z > gm) { gm = gl.z; gi = 2; } if (gl.w > gm) { gm = gl.w; gi = 3; }
        const float gden = __expf(gl.x - gm) + __expf(gl.y - gm) + __expf(gl.z - gm) + __expf(gl.w - gm);
        const float gw_ = 1.0f / gden;
        const float* we = wer + (size_t)gi * DM * 4;
        f32x4 el = (f32x4){0.f, 0.f, 0.f, 0.f};
#pragma unroll
        for (int j = 0; j < 4; ++j) { const f32x4* wp = (const f32x4*)we + (size_t)(4 * lane + 256 * j);
            el += wp[0] * v[j].x; el += wp[1] * v[j].y; el += wp[2] * v[j].z; el += wp[3] * v[j].w; }
        float e[4] = {wave_sum(el.x) + ber[gi * 4 + 0], wave_sum(el.y) + ber[gi * 4 + 1], wave_sum(el.z) + ber[gi * 4 + 2], wave_sum(el.w) + ber[gi * 4 + 3]};
        int i1 = 0; float v1 = e[0];
#pragma unroll
        for (int k = 1; k < 4; ++k) if (e[k] > v1) { v1 = e[k]; i1 = k; }
        int i2 = -1; float v2 = -INFINITY;
#pragma unroll
        for (int k = 0; k < 4; ++k) if (k != i1 && e[k] > v2) { v2 = e[k]; i2 = k; }
        const float p2 = __expf(v2 - v1), inv = 1.0f / (1.0f + p2);
        const float w1 = inv * gw_, w2 = p2 * inv * gw_;
        if (lane < 16) { const int ge = lane >> 2, ee = lane & 3; float cw = 0.f; if (ge == gi) { if (ee == i1) cw = w1; else if (ee == i2) cw = w2; } comb[(size_t)m * NEXP + lane] = cw; }
    }
}
__device__ __forceinline__ void phase_final(float* x, const float* g, int gw, int NGW, int lane) {
    f32x4 gv[4];
#pragma unroll
    for (int j = 0; j < 4; ++j) gv[j] = *((const f32x4*)g + lane + 64 * j);
    for (int m = gw; m < T; m += NGW) {
        f32x4* xr = (f32x4*)(x + (size_t)m * DM) + lane;
        f32x4 v[4]; float s = 0.f;
#pragma unroll
        for (int j = 0; j < 4; ++j) { v[j] = xr[64 * j]; s += (v[j].x * v[j].x + v[j].y * v[j].y) + (v[j].z * v[j].z + v[j].w * v[j].w); }
        const float rstd = 1.0f / sqrtf(wave_sum(s) * (1.f / DM) + NORM_EPS);
#pragma unroll
        for (int j = 0; j < 4; ++j) xr[64 * j] = v[j] * rstd * gv[j];
    }
}
__device__ __forceinline__ void phase_kmean(const bf16_t* kb, float* kmean, int gw, int NGW, int lane) {
    for (int it = gw; it < BATCH * 4 * 32; it += NGW) {
        const int b = it >> 7, h = (it >> 5) & 3, blk = it & 31;
        const bf16_t* base = kb + ((size_t)b * SEQ + (size_t)blk * 256) * DM + h * HD + (lane & 7) * 8;
        float acc[8] = {0.f, 0.f, 0.f, 0.f, 0.f, 0.f, 0.f, 0.f};
#pragma unroll 4
        for (int i = 0; i < 32; ++i) { const u32x4 w = *(const u32x4*)(base + (size_t)((lane >> 3) + 8 * i) * DM);
            acc[0] += bflo(w.x); acc[1] += bfhi(w.x); acc[2] += bflo(w.y); acc[3] += bfhi(w.y); acc[4] += bflo(w.z); acc[5] += bfhi(w.z); acc[6] += bflo(w.w); acc[7] += bfhi(w.w); }
#pragma unroll
        for (int j = 0; j < 8; ++j) { acc[j] += __shfl_xor(acc[j], 8); acc[j] += __shfl_xor(acc[j], 16); acc[j] += __shfl_xor(acc[j], 32); }
        if (lane < 8) {
            float* o = kmean + (size_t)it * HD + lane * 8;
#pragma unroll
            for (int j = 0; j < 8; ++j) o[j] = acc[j] * (1.f / 256.f);
        }
    }
}

__device__ __forceinline__ void ld_row64(float (&r)[64], const bf16_t* p) {
#pragma unroll
    for (int c = 0; c < 8; ++c) { const u32x4 w = *((const u32x4*)p + c);
        r[8 * c + 0] = bflo(w.x); r[8 * c + 1] = bfhi(w.x); r[8 * c + 2] = bflo(w.y); r[8 * c + 3] = bfhi(w.y); r[8 * c + 4] = bflo(w.z); r[8 * c + 5] = bfhi(w.z); r[8 * c + 6] = bflo(w.w); r[8 * c + 7] = bfhi(w.w); }
}
__device__ __forceinline__ float dot_row64(const float (&q)[64], const bf16_t* p) {
    float s0 = 0.f, s1 = 0.f;
#pragma unroll
    for (int c = 0; c < 8; ++c) { const u32x4 w = *((const u32x4*)p + c);
        s0 += q[8 * c + 0] * bflo(w.x); s1 += q[8 * c + 1] * bfhi(w.x); s0 += q[8 * c + 2] * bflo(w.y); s1 += q[8 * c + 3] * bfhi(w.y);
        s0 += q[8 * c + 4] * bflo(w.z); s1 += q[8 * c + 5] * bfhi(w.z); s0 += q[8 * c + 6] * bflo(w.w); s1 += q[8 * c + 7] * bfhi(w.w); }
    return s0 + s1;
}
__device__ __forceinline__ void axpy_row64(float (&o)[64], float p, const bf16_t* vp) {
#pragma unroll
    for (int c = 0; c < 8; ++c) { const u32x4 w = *((const u32x4*)vp + c);
        o[8 * c + 0] += p * bflo(w.x); o[8 * c + 1] += p * bfhi(w.x); o[8 * c + 2] += p * bflo(w.y); o[8 * c + 3] += p * bfhi(w.y);
        o[8 * c + 4] += p * bflo(w.z); o[8 * c + 5] += p * bfhi(w.z); o[8 * c + 6] += p * bflo(w.w); o[8 * c + 7] += p * bfhi(w.w); }
}
__device__ __forceinline__ void st_row64(bf16_t* p, const float (&o)[64], float sc) {
#pragma unroll
    for (int c = 0; c < 8; ++c) { u32x4 w; w.x = pk2(o[8 * c] * sc, o[8 * c + 1] * sc); w.y = pk2(o[8 * c + 2] * sc, o[8 * c + 3] * sc); w.z = pk2(o[8 * c + 4] * sc, o[8 * c + 5] * sc); w.w = pk2(o[8 * c + 6] * sc, o[8 * c + 7] * sc); *((u32x4*)p + c) = w; }
}
#define OSM_STEP(sc, vrow) do { const float sc_ = (sc); if (sc_ > m_) { const float al = __builtin_amdgcn_exp2f(m_ - sc_); l_ *= al; _Pragma("unroll") for (int d_ = 0; d_ < 64; ++d_) o_[d_] *= al; m_ = sc_; } \
    const float p_ = __builtin_amdgcn_exp2f(sc_ - m_); l_ += p_; axpy_row64(o_, p_, (vrow)); } while (0)

__device__ __forceinline__ void naive_moba(const bf16_t* qb, const bf16_t* kb, const bf16_t* vb, const float* kmean, bf16_t* ob, int item, int tid) {
    const int b = item >> 6, h = (item >> 4) & 3, t = (item & 15) * 512 + tid, own = t >> 8;
    const size_t rowq = ((size_t)b * SEQ + t) * DM + h * HD;
    const bf16_t* kh = kb + (size_t)b * SEQ * DM + h * HD; const bf16_t* vh = vb + (size_t)b * SEQ * DM + h * HD;
    const float slope2 = exp2f(-2.0f * (float)(h + 1)) * LOG2E;
    float q_[64]; ld_row64(q_, qb + rowq);
    float bv0 = -INFINITY, bv1 = -INFINITY, bv2 = -INFINITY; int bi0 = -1, bi1 = -1, bi2 = -1;
    const float* km = kmean + (size_t)(b * 4 + h) * 32 * HD;
    for (int n = 0; n < own; ++n) {
        float gsum = 0.f;
#pragma unroll
        for (int d = 0; d < 64; ++d) gsum += q_[d] * km[n * HD + d];
        if (gsum > bv0) { bv2 = bv1; bi2 = bi1; bv1 = bv0; bi1 = bi0; bv0 = gsum; bi0 = n; }
        else if (gsum > bv1) { bv2 = bv1; bi2 = bi1; bv1 = gsum; bi1 = n; }
        else if (gsum > bv2) { bv2 = gsum; bi2 = n; }
    }
    float o_[64];
#pragma unroll
    for (int d = 0; d < 64; ++d) o_[d] = 0.f;
    float m_ = -INFINITY, l_ = 0.f;
    for (int s = 0; s < 3; ++s) {
        const int blk = (s == 0) ? bi0 : (s == 1) ? bi1 : bi2;
        if (blk < 0) continue;
        for (int j = 0; j < 256; ++j) { const int pos = blk * 256 + j;
            const float sc = dot_row64(q_, kh + (size_t)pos * DM) - slope2 * (float)(t - pos);
            OSM_STEP(sc, vh + (size_t)pos * DM); }
    }
    for (int pos = own * 256; pos <= t; ++pos) {
        const float sc = dot_row64(q_, kh + (size_t)pos * DM) - slope2 * (float)(t - pos);
        OSM_STEP(sc, vh + (size_t)pos * DM); }
    st_row64(ob + rowq, o_, 1.0f / l_);
}
__device__ __forceinline__ void naive_sb(const bf16_t* qb, const bf16_t* kb, const bf16_t* vb, bf16_t* ob, int item, int tid) {
    const int b = item >> 6, h = 4 + ((item >> 4) & 3), t = (item & 15) * 512 + tid;
    const size_t rowq = ((size_t)b * SEQ + t) * DM + h * HD;
    const bf16_t* kh = kb + (size_t)b * SEQ * DM + h * HD; const bf16_t* vh = vb + (size_t)b * SEQ * DM + h * HD;
    float q_[64]; ld_row64(q_, qb + rowq);
    float o_[64];
#pragma unroll
    for (int d = 0; d < 64; ++d) o_[d] = 0.f;
    float tail = 0.f;
    for (int s = t - 1; s >= 0 && tail > -150.f; --s) {
        const float z = dot_row64(q_, kh + (size_t)s * DM);
        const float lp = __builtin_amdgcn_logf(1.0f + __builtin_amdgcn_exp2f(-fabsf(z)));
        const float lnot = -(fmaxf(z, 0.f) + lp);
        const float aw = __builtin_amdgcn_exp2f(z + lnot + tail);
        axpy_row64(o_, aw, vh + (size_t)s * DM);
        tail += lnot;
    }
    st_row64(ob + rowq, o_, 1.0f);
}
__device__ __forceinline__ void naive_dil(const bf16_t* qb, const bf16_t* kb, const bf16_t* vb, bf16_t* ob, int item, int tid) {
    const int b = item >> 7, h = 8 + ((item >> 4) & 7), t = (item & 15) * 512 + tid;
    const size_t rowq = ((size_t)b * SEQ + t) * DM + h * HD;
    const bf16_t* kh = kb + (size_t)b * SEQ * DM + h * HD; const bf16_t* vh = vb + (size_t)b * SEQ * DM + h * HD;
    const float slope2 = exp2f(-(float)(h - 8 + 1)) * LOG2E;
    float q_[64]; ld_row64(q_, qb + rowq);
    float o_[64];
#pragma unroll
    for (int d = 0; d < 64; ++d) o_[d] = 0.f;
    float m_ = -INFINITY, l_ = 0.f;
    for (int c = 0; c < 3; ++c) {
        const int dil = (c == 0) ? 1 : (c == 1) ? 4 : 16;
        for (int dl = 0; dl <= 128; ++dl) { const int pos = t - dl * dil; if (pos < 0) break;
            const float sc = dot_row64(q_, kh + (size_t)pos * DM) - slope2 * (float)(dl * dil);
            OSM_STEP(sc, vh + (size_t)pos * DM); }
    }
    st_row64(ob + rowq, o_, 1.0f / l_);
}

constexpr int PH_PRO = 0, PH_L0 = 1, PH_PER_LAYER = 9, PH_FINAL = PH_L0 + DEPTH * PH_PER_LAYER, PH_COUNT = PH_FINAL + 1;
typedef const __attribute__((address_space(4))) Args* KArgP;
#define KARG() ({ KArgP p_ = (KArgP)__builtin_amdgcn_kernarg_segment_ptr(); asm volatile("" : "+s"(p_)); p_; })
#define PHASE_IDS int lane_p = lane, tid_p = tid, gw_p = gw; LAUNDER_V(lane_p); LAUNDER_V(tid_p); LAUNDER_S(gw_p)
__global__ void __launch_bounds__(NTHREADS, 2) fwd(Args a_unused) {
    extern __shared__ __attribute__((aligned(16))) unsigned char lds_raw[];
    LAS unsigned char* lds = (LAS unsigned char*)lds_raw;
    volatile LAS unsigned* MISC = (volatile LAS unsigned*)(lds + MISC_OFF);
    const int tid = threadIdx.x, lane = tid & 63, wave = __builtin_amdgcn_readfirstlane(tid >> 6);
    const int G = gridDim.x, bx = blockIdx.x;
    const int vcu = (G % 8 == 0) ? (bx % 8) * (G / 8) + bx / 8 : bx;
    const int gw = vcu * NWAVES + wave, NGW = G * NWAVES;
    for (int u = tid; u < (LDS_BYTES - LDSCTL_OFF) / 4; u += NTHREADS) ((LAS unsigned*)(lds + LDSCTL_OFF))[u] = 0u;
    __syncthreads();
    int lo, hi; XcdBarrier bar;
    { KArgP ka = KARG(); lo = ka->ph_lo; hi = ka->ph_hi; unsigned* ctl = (unsigned*)(ka->ws + WS_CTL); bar = xcd_barrier_post(ctl + CW_BAR + ka->li * XCD_BAR_WORDS, MISC + 8); }
#define IN(k) (lo <= (k) && (k) < hi)
#define SEAM(k) do { if (IN(k) && IN((k) + 1)) xcd_barrier(bar); } while (0)
#define WSP(T_, off) ((T_*)(ws + (off)))

    if (IN(PH_PRO)) { KArgP ka = KARG(); PHASE_IDS; Args a; a.ws = ka->ws; a.w_in = ka->w_in; a.w_out = ka->w_out; a.w_gate = ka->w_gate; a.w_up = ka->w_up; a.w_down = ka->w_down; phase_prologue(a, lds, gw_p, NGW, wave, lane_p); } SEAM(PH_PRO);

    for (int l = 0; l < DEPTH; ++l) {
        const int p0 = PH_L0 + l * PH_PER_LAYER;
        if (hi <= p0 || lo >= p0 + PH_PER_LAYER) continue;
        if (IN(p0 + 0)) { KArgP ka = KARG(); PHASE_IDS; unsigned char* ws = ka->ws; const float* xin = (l == 0) ? ka->x : ka->out;
            phase_norm1(xin, ka->ln1_g + (size_t)l * DM, WSP(bf16_t, WS_HB), gw_p, NGW, lane_p); } SEAM(p0 + 0);
        if (IN(p0 + 1)) { KArgP ka = KARG(); PHASE_IDS; unsigned char* ws = ka->ws;
            pg8::Gemm g{(const char*)(ws + WS_HB), (const char*)(ws + WS_WIN) + (size_t)l * NQKV * DM * 2, DM, DM, DM, (long)256 * DM * 2, (long)256 * DM * 2, (long)128 * DM * 2};
            pg8::StaticOrder S; S.init(T / 256, NQKV / 256, G, bx);
            pg8::EpiQKV E{WSP(bf16_t, WS_Q), (size_t)(WS_K - WS_Q) / 2, QSCALE};
            pg8::gemm_phase<pg8::EpiQKV, pg8::StaticOrder>(lds, g, S, E);
        } SEAM(p0 + 1);
        if (IN(p0 + 2)) { KArgP ka = KARG(); PHASE_IDS; unsigned char* ws = ka->ws; phase_kmean(WSP(bf16_t, WS_K), WSP(float, WS_KMEAN), gw_p, NGW, lane_p); } SEAM(p0 + 2);
        if (IN(p0 + 3)) { KArgP ka = KARG(); PHASE_IDS; unsigned char* ws = ka->ws;
            const bf16_t* QB = WSP(bf16_t, WS_Q); const bf16_t* KB = WSP(bf16_t, WS_K); const bf16_t* VB = WSP(bf16_t, WS_V); bf16_t* OB = WSP(bf16_t, WS_O);
            for (int it = vcu; it < 256; it += G) naive_moba(QB, KB, VB, WSP(float, WS_KMEAN), OB, it, tid_p);
            for (int it = vcu; it < 256; it += G) naive_sb(QB, KB, VB, OB, it, tid_p);
            for (int it = vcu; it < 512; it += G) naive_dil(QB, KB, VB, OB, it, tid_p);
        } SEAM(p0 + 3);
        if (IN(p0 + 4)) { KArgP ka = KARG(); PHASE_IDS; unsigned char* ws = ka->ws; phase_mixnorm(WSP(bf16_t, WS_O), ka->mix_g + (size_t)l * DM, WSP(bf16_t, WS_HB), gw_p, NGW, lane_p); } SEAM(p0 + 4);
        if (IN(p0 + 5)) { KArgP ka = KARG(); PHASE_IDS; unsigned char* ws = ka->ws; const float* xin = (l == 0) ? ka->x : ka->out;
            pg8::Gemm g{(const char*)(ws + WS_HB), (const char*)(ws + WS_WOUT) + (size_t)l * DM * DM * 2, DM, DM, DM, (long)256 * DM * 2, (long)256 * DM * 2, (long)128 * DM * 2};
            pg8::StaticOrder S; S.init(T / 256, DM / 256, G, bx);
            pg8::EpiResAdd E{xin, ka->out};
            pg8::gemm_phase<pg8::EpiResAdd, pg8::StaticOrder>(lds, g, S, E);
        } SEAM(p0 + 5);
        if (IN(p0 + 6)) { KArgP ka = KARG(); PHASE_IDS; unsigned char* ws = ka->ws;
            phase_route(ka->out, ka->ln2_g + (size_t)l * DM, ka->w_gr + (size_t)l * DM * 4, ka->b_gr + l * 4, ka->w_er + (size_t)l * 4 * DM * 4, ka->b_er + l * 16, WSP(bf16_t, WS_HB), WSP(float, WS_COMB), gw_p, NGW, lane_p); } SEAM(p0 + 6);
        if (IN(p0 + 7)) { KArgP ka = KARG(); PHASE_IDS; unsigned char* ws = ka->ws;
            pg8::Gemm g{(const char*)(ws + WS_HB), (const char*)(ws + WS_WG) + (size_t)l * NACT * DM * 2, DM, DM, DM, (long)256 * DM * 2, (long)128 * DM * 2, (long)(WS_WU - WS_WG)};
            pg8::StaticOrder S; S.init(T / 256, 2 * NEXP, G, bx);
            pg8::EpiGateUpDense E{WSP(bf16_t, WS_ACT), WSP(float, WS_COMB)};
            pg8::gemm_phase<pg8::EpiGateUpDense, pg8::StaticOrder>(lds, g, S, E);
        } SEAM(p0 + 7);
        if (IN(p0 + 8)) { KArgP ka = KARG(); PHASE_IDS; unsigned char* ws = ka->ws;
            pg8::Gemm g{(const char*)(ws + WS_ACT), (const char*)(ws + WS_WD) + (size_t)l * DM * NACT * 2, NACT, NACT, NACT, (long)256 * NACT * 2, (long)256 * NACT * 2, (long)128 * NACT * 2};
            pg8::StaticOrder S; S.init(T / 256, DM / 256, G, bx);
            pg8::EpiResAdd E{ka->out, ka->out};
            pg8::gemm_phase<pg8::EpiResAdd, pg8::StaticOrder>(lds, g, S, E);
        } SEAM(p0 + 8);
    }
    if (IN(PH_FINAL)) { KArgP ka = KARG(); PHASE_IDS; phase_final(ka->out, ka->fin_g, gw_p, NGW, lane_p); }
#undef IN
#undef SEAM
#undef WSP
}

#ifndef N_LAUNCH_MODE
#define N_LAUNCH_MODE 1
#endif
extern "C" void kernel_launch(void* const* d_in, const int* in_sizes, int n_in, void* d_out, int out_size, void* d_ws, size_t ws_size, hipStream_t stream) {
    static int grid = 0;
    if (grid == 0) {
        if (n_in != 14 || in_sizes[0] != T * DM || out_size != T * DM || ws_size < WS_END) { fprintf(stderr, "kernel_launch: unexpected shapes (n_in %d in0 %d out %d ws %zu)\n", n_in, n_in > 0 ? in_sizes[0] : -1, out_size, ws_size); grid = -1; return; }
        int dev = 0, cus = 0, per_cu = 0;
        if (hipGetDevice(&dev) != hipSuccess || hipDeviceGetAttribute(&cus, hipDeviceAttributeMultiprocessorCount, dev) != hipSuccess) { grid = -1; return; }
        if (hipFuncSetAttribute((const void*)fwd, hipFuncAttributeMaxDynamicSharedMemorySize, LDS_BYTES) != hipSuccess) { fprintf(stderr, "kernel_launch: hipFuncSetAttribute failed\n"); grid = -1; return; }
        if (hipOccupancyMaxActiveBlocksPerMultiprocessor(&per_cu, (const void*)fwd, NTHREADS, LDS_BYTES) != hipSuccess || per_cu < 1) fprintf(stderr, "kernel_launch: occupancy query says %d\n", per_cu);
        (void)hipGetLastError();
        grid = cus;
    }
    if (grid < 0) return;
    if (hipMemsetAsync((char*)d_ws + WS_CTL, 0, CTL_ZERO_BYTES, stream) != hipSuccess) return;
    Args a{};
    a.x = (const float*)d_in[0]; a.ln1_g = (const float*)d_in[1]; a.w_in = (const float*)d_in[2]; a.mix_g = (const float*)d_in[3]; a.w_out = (const float*)d_in[4]; a.ln2_g = (const float*)d_in[5];
    a.w_gr = (const float*)d_in[6]; a.b_gr = (const float*)d_in[7]; a.w_er = (const float*)d_in[8]; a.b_er = (const float*)d_in[9]; a.w_gate = (const float*)d_in[10]; a.w_up = (const float*)d_in[11];
    a.w_down = (const float*)d_in[12]; a.fin_g = (const float*)d_in[13];
    a.out = (float*)d_out; a.ws = (unsigned char*)d_ws; a.pad = 0;
#if N_LAUNCH_MODE == 1
    a.ph_lo = 0; a.ph_hi = PH_COUNT; a.li = 0;
    hipLaunchKernelGGL(fwd, dim3(grid), dim3(NTHREADS), LDS_BYTES, stream, a);
#else
    for (int p = 0; p < PH_COUNT; ++p) { a.ph_lo = p; a.ph_hi = p + 1; a.li = p; hipLaunchKernelGGL(fwd, dim3(grid), dim3(NTHREADS), LDS_BYTES, stream, a); }
#endif
}
```

```cpp
#include <hip/hip_runtime.h>
#include <cstdio>
#include <cstdint>

#define LAS __attribute__((address_space(3)))
#define GAS __attribute__((address_space(1)))
typedef unsigned short bf16_t;
typedef short bf16x8 __attribute__((ext_vector_type(8)));
typedef float f32x4 __attribute__((ext_vector_type(4)));
typedef float f32x2 __attribute__((ext_vector_type(2)));
typedef unsigned u32x4 __attribute__((ext_vector_type(4)));
typedef unsigned u32x2 __attribute__((ext_vector_type(2)));

#ifndef ATT_MOBA
#define ATT_MOBA 1
#endif
#ifndef ATT_SB
#define ATT_SB 1
#endif
#ifndef ATT_DIL
#define ATT_DIL 1
#endif
constexpr int BATCH = 4, SEQ = 8192, DM = 1024, DEPTH = 4, T = BATCH * SEQ, NH = 16, HD = 64;
constexpr int NQKV = 3 * DM, NEXP = 16, DEXP = 256, NACT = NEXP * DEXP;
constexpr float NORM_EPS = 1e-6f;
constexpr float LOG2E = 1.4426950408889634f;
constexpr float QSCALE = 0.125f * LOG2E;
constexpr int NWAVES = 8, NTHREADS = 512;

constexpr size_t MiB = 1u << 20;
constexpr size_t WS_CTL = 0, CTL_ZERO_BYTES = 1 * MiB;
constexpr size_t WS_WIN = 2 * MiB;
constexpr size_t WS_WOUT = 26 * MiB;
constexpr size_t WS_WG = 34 * MiB;
constexpr size_t WS_WU = 66 * MiB;
constexpr size_t WS_WD = 98 * MiB;
constexpr size_t WS_KMEAN = 130 * MiB;
constexpr size_t WS_COMB = 131 * MiB;
constexpr size_t WS_HB = 134 * MiB;
constexpr size_t WS_Q = 198 * MiB, WS_K = 262 * MiB, WS_V = 326 * MiB, WS_O = 390 * MiB;
constexpr size_t WS_ACT = WS_Q;
constexpr size_t WS_LSE = 454 * MiB;
constexpr size_t WS_END = 458 * MiB;
constexpr int CW_BAR = 4096;

constexpr int RING_BYTES = 131072;
constexpr int LDSCTL_OFF = RING_BYTES, MISC_OFF = LDSCTL_OFF + 320;
constexpr int LDS_BYTES = 147456;

__device__ __forceinline__ unsigned f2bf(float f) { unsigned u = __builtin_bit_cast(unsigned, f); return (u + 0x7fffu + ((u >> 16) & 1u)) >> 16; }
__device__ __forceinline__ unsigned pk2(float lo, float hi) { return f2bf(lo) | (f2bf(hi) << 16); }
__device__ __forceinline__ float bflo(unsigned w) { return __builtin_bit_cast(float, w << 16); }
__device__ __forceinline__ float bfhi(unsigned w) { return __builtin_bit_cast(float, w & 0xffff0000u); }
__device__ __forceinline__ float wave_sum(float v) {
#pragma unroll
    for (int o = 1; o < 64; o <<= 1) v += __shfl_xor(v, o);
    return v;
}
__device__ __forceinline__ float half_sum(float v) {
#pragma unroll
    for (int o = 1; o < 32; o <<= 1) v += __shfl_xor(v, o);
    return v;
}
#define LDS_WAIT() asm volatile("s_waitcnt lgkmcnt(0)" ::: "memory")
#define LAUNDER_V(x) asm volatile("" : "+v"(x))
#define LAUNDER_S(x) asm volatile("" : "+s"(x))

namespace pg8 {
constexpr int BM = 256, BK = 64, HALF = 128, HTB = HALF * BK * 2, STAGE_BYTES = 8 * HTB, NXCD = 8, WGM = 8;
__host__ __device__ __forceinline__ int lds_byte(int r, int c) { const int st = (r >> 4) * 2 + (c >> 5), rr = r & 15, cc = c & 31, ob = rr * 64 + cc * 2; return st * 1024 + (ob ^ (((ob >> 9) & 1) << 5)); }
__host__ __device__ __forceinline__ void stage_rc(int b, int& R, int& C) { const int st = b / 1024, sb = b % 1024, swz = sb ^ (((sb >> 9) & 1) << 5); R = (st >> 1) * 16 + swz / 64; C = (st & 1) * 32 + (swz % 64) / 2; }
__host__ __device__ __forceinline__ int perm32(int rho) { const int n = rho >> 4, i = rho & 15; return 8 * (i >> 2) + 4 * n + (i & 3); }

struct Unit { int pm, pn; };
struct Gemm { const char* A; const char* B; int lda, ldb, K; long tstepA, tstepB, hstepB; };

struct StaticOrder {
    int nM, nN, nwg, G, c;
    __host__ __device__ void init(int nM_, int nN_, int G_, int c_) { nM = nM_; nN = nN_; nwg = nM * nN; G = G_; c = c_; }
    __host__ __device__ bool next(int i, Unit& u) const {
        const long L = (long)i * G + c; if (L >= nwg) return false;
        int wgid = (int)L; { const int q = nwg / NXCD, r = nwg % NXCD, xcd = wgid % NXCD, off = wgid / NXCD; wgid = (xcd < r ? xcd * (q + 1) : r * (q + 1) + (xcd - r) * q) + off; }
        const int nig = WGM * nN, gid = wgid / nig, fm = gid * WGM, gsz = (nM - fm) < WGM ? (nM - fm) : WGM;
        u.pm = fm + ((wgid % nig) % gsz); u.pn = (wgid % nig) / gsz; return true;
    }
};

__device__ __forceinline__ unsigned cvt_pk_bf16(float lo, float hi) { unsigned r; asm volatile("v_cvt_pk_bf16_f32 %0, %1, %2" : "=v"(r) : "v"(lo), "v"(hi)); return r; }

struct EpiQKV {
    static constexpr bool PERM = true;
    bf16_t* O; size_t split_stride; float scale0;
    __device__ __forceinline__ void operator()(const f32x4 (&acc)[2][2][4][2], const Unit& u, int wr, int wc, int fr, int fq) const {
        const int row0 = u.pm * BM + wr * 64 + fr; int colt = u.pn * BM;
        const int t = colt / DM; bf16_t* base = O + (size_t)t * split_stride; colt -= t * DM; const float sc = (t == 0) ? scale0 : 1.f;
        const int col0 = colt + wc * 32 + 8 * fq;
#pragma unroll
        for (int ai = 0; ai < 2; ++ai)
#pragma unroll
            for (int m = 0; m < 4; ++m) { bf16_t* rowp = base + (size_t)(row0 + ai * HALF + m * 16) * DM + col0;
#pragma unroll
                for (int bj = 0; bj < 2; ++bj) { f32x4 v0 = acc[ai][bj][m][0] * sc, v1 = acc[ai][bj][m][1] * sc;
                    u32x4 w; w.x = cvt_pk_bf16(v0[0], v0[1]); w.y = cvt_pk_bf16(v0[2], v0[3]); w.z = cvt_pk_bf16(v1[0], v1[1]); w.w = cvt_pk_bf16(v1[2], v1[3]);
                    *(u32x4*)(rowp + bj * HALF) = w; } }
    }
};
struct EpiResAdd {
    static constexpr bool PERM = false;
    const float* base; float* out;
    __device__ __forceinline__ void operator()(const f32x4 (&acc)[2][2][4][2], const Unit& u, int wr, int wc, int fr, int fq) const {
        const int col0 = u.pn * BM + wc * 32 + 4 * fq;
#pragma unroll
        for (int ai = 0; ai < 2; ++ai)
#pragma unroll
            for (int m = 0; m < 4; ++m) { const size_t off = (size_t)(u.pm * BM + ai * HALF + wr * 64 + m * 16 + fr) * DM + col0;
#pragma unroll
                for (int bj = 0; bj < 2; ++bj)
#pragma unroll
                    for (int n = 0; n < 2; ++n) { const f32x4 bs = *(const f32x4*)(base + off + bj * HALF + n * 16); *(f32x4*)(out + off + bj * HALF + n * 16) = bs + acc[ai][bj][m][n]; } }
    }
};
struct EpiGateUpDense {
    static constexpr bool PERM = true;
    bf16_t* act; const float* comb;
    __device__ __forceinline__ void operator()(const f32x4 (&acc)[2][2][4][2], const Unit& u, int wr, int wc, int fr, int fq) const {
        const int e = u.pn >> 1, c0 = (u.pn & 1) * HALF;
        const int col0 = e * DEXP + c0 + wc * 32 + 8 * fq;
#pragma unroll
        for (int ai = 0; ai < 2; ++ai)
#pragma unroll
            for (int m = 0; m < 4; ++m) { const int row = u.pm * BM + ai * HALF + wr * 64 + m * 16 + fr;
                const float cw = comb[(size_t)row * NEXP + e];
                float o[8];
#pragma unroll
                for (int n = 0; n < 2; ++n)
#pragma unroll
                    for (int j = 0; j < 4; ++j) { const float g = acc[ai][0][m][n][j], up = acc[ai][1][m][n][j];
                        const float sg = g * __builtin_amdgcn_rcpf(1.f + __builtin_amdgcn_exp2f(-g * LOG2E));
                        o[n * 4 + j] = sg * up * cw; }
                u32x4 w; w.x = cvt_pk_bf16(o[0], o[1]); w.y = cvt_pk_bf16(o[2], o[3]); w.z = cvt_pk_bf16(o[4], o[5]); w.w = cvt_pk_bf16(o[6], o[7]);
                *(u32x4*)(act + (size_t)row * NACT + col0) = w; }
    }
};

template <class Epi, class Sched>
__device__ __forceinline__ void gemm_phase(LAS unsigned char* lds, const Gemm g, const Sched& S, const Epi& E) {
    int tid_l = threadIdx.x; asm volatile("" : "+v"(tid_l));
    const int tid = tid_l, wid = __builtin_amdgcn_readfirstlane(tid >> 6), lane = tid & 63, wr = wid >> 2, wc = wid & 3, fr = lane & 15, fq = lane >> 4;
    const int K = g.K, nt = K / BK;
    unsigned voffA[2], voffB[2];
#pragma unroll
    for (int i = 0; i < 2; ++i) { int R, C; stage_rc(tid * 16 + i * 8192, R, C); const int Rb = Epi::PERM ? ((R & ~31) + perm32(R & 31)) : R;
        voffA[i] = (unsigned)(R * g.lda + C) * 2u; voffB[i] = (unsigned)(Rb * g.ldb + C) * 2u; }
    const size_t kstep = (size_t)(BK * 2);
    const size_t hstepA = (size_t)HALF * g.lda * 2;
    const long hstepB = g.hstepB;
    const unsigned ldsw = (unsigned)wid * 1024u;
    const int aoff = lds_byte(wr * 64 + fr, fq * 8), boff = lds_byte(wc * 32 + fr, fq * 8);
#define PG8_SA(b, h) (((b) * 2 + (h)) * HTB)
#define PG8_SB(b, h) ((4 + (b) * 2 + (h)) * HTB)
#define PG8_STAGE(bufoff, gbase, voff) do { _Pragma("unroll") for (int _i = 0; _i < 2; ++_i) \
        __builtin_amdgcn_global_load_lds((const unsigned*)((const char*)(gbase) + (voff)[_i]), (LAS unsigned*)(lds + (bufoff) + ldsw + _i * 8192), 16, 0, 0); } while (0)
#define PG8_LDA(dst, b, h) do { _Pragma("unroll") for (int m = 0; m < 4; ++m) _Pragma("unroll") for (int k = 0; k < 2; ++k) dst[m][k] = *(const LAS bf16x8*)(lds + PG8_SA(b, h) + aoff + m * 2048 + k * 1024); } while (0)
#define PG8_LDB(dst, b, h) do { _Pragma("unroll") for (int n = 0; n < 2; ++n) _Pragma("unroll") for (int k = 0; k < 2; ++k) dst[n][k] = *(const LAS bf16x8*)(lds + PG8_SB(b, h) + boff + n * 2048 + k * 1024); } while (0)
#define PG8_MMA(ai, bj, At, Bt) do { __builtin_amdgcn_s_setprio(1); _Pragma("unroll") for (int m = 0; m < 4; ++m) _Pragma("unroll") for (int n = 0; n < 2; ++n) _Pragma("unroll") for (int k = 0; k < 2; ++k) \
        acc[ai][bj][m][n] = __builtin_amdgcn_mfma_f32_16x16x32_bf16(Bt[n][k], At[m][k], acc[ai][bj][m][n], 0, 0, 0); __builtin_amdgcn_s_setprio(0); } while (0)
#define PG8_WAIT_V(n) asm volatile("s_waitcnt vmcnt(" #n ")" ::: "memory")
#define PG8_WAIT_L(n) asm volatile("s_waitcnt lgkmcnt(" #n ")" ::: "memory")
#define PG8_BAR __builtin_amdgcn_s_barrier()
#define PG8_SCHED __builtin_amdgcn_sched_barrier(0)
    Unit cur, nxt; int ui = 0;
    if (!S.next(0, cur)) return;
    f32x4 acc[2][2][4][2];
#pragma unroll
    for (int a = 0; a < 2; ++a)
#pragma unroll
        for (int b = 0; b < 2; ++b)
#pragma unroll
            for (int m = 0; m < 4; ++m)
#pragma unroll
                for (int n = 0; n < 2; ++n) acc[a][b][m][n] = (f32x4){0.f, 0.f, 0.f, 0.f};
    bf16x8 At[4][2], B0[2][2], B1[2][2];
    const char* cA = g.A + (size_t)cur.pm * g.tstepA; const char* cB = g.B + (size_t)cur.pn * g.tstepB;
    PG8_STAGE(PG8_SB(0, 0), cB, voffB); PG8_STAGE(PG8_SB(0, 1), cB + hstepB, voffB); PG8_STAGE(PG8_SA(0, 0), cA, voffA); PG8_STAGE(PG8_SA(0, 1), cA + hstepA, voffA);
    if (wr == 1) PG8_BAR;
    PG8_WAIT_V(2); PG8_BAR;
    PG8_STAGE(PG8_SB(1, 0), cB + kstep, voffB); PG8_STAGE(PG8_SA(1, 0), cA + kstep, voffA); PG8_STAGE(PG8_SB(1, 1), cB + hstepB + kstep, voffB);
    PG8_WAIT_V(6); PG8_BAR;
    for (;;) {
        const bool has_next = S.next(ui + 1, nxt);
        const char* nA = has_next ? g.A + (size_t)nxt.pm * g.tstepA : cA; const char* nB = has_next ? g.B + (size_t)nxt.pn * g.tstepB : cB;
        for (int t = 0; t < nt; t += 2) {
            const bool last = (t == nt - 2);
            const char* a1 = cA + (size_t)(t + 1) * kstep;
            const char* a2 = last ? nA : cA + (size_t)(t + 2) * kstep; const char* b2 = last ? nB : cB + (size_t)(t + 2) * kstep;
            const char* a3 = a2 + kstep; const char* b3 = b2 + kstep;
            PG8_LDB(B0, 0, 0); PG8_LDB(B1, 0, 1); PG8_SCHED; PG8_LDA(At, 0, 0); PG8_STAGE(PG8_SA(1, 1), a1 + hstepA, voffA);
            PG8_WAIT_V(8); PG8_WAIT_L(0); PG8_BAR; PG8_MMA(0, 0, At, B0); PG8_MMA(0, 1, At, B1); PG8_BAR; PG8_SCHED;
            PG8_LDA(At, 0, 1); PG8_STAGE(PG8_SB(0, 0), b2, voffB); PG8_STAGE(PG8_SB(0, 1), b2 + hstepB, voffB); PG8_STAGE(PG8_SA(0, 0), a2, voffA);
            PG8_WAIT_V(8); PG8_WAIT_L(0); PG8_BAR; PG8_MMA(1, 0, At, B0); PG8_MMA(1, 1, At, B1); PG8_BAR; PG8_SCHED;
            PG8_LDB(B0, 1, 0); PG8_LDB(B1, 1, 1); PG8_SCHED; PG8_LDA(At, 1, 0); PG8_STAGE(PG8_SA(0, 1), a2 + hstepA, voffA);
            PG8_WAIT_V(8); PG8_WAIT_L(0); PG8_BAR; PG8_MMA(0, 0, At, B0); PG8_MMA(0, 1, At, B1); PG8_BAR; PG8_SCHED;
            PG8_LDA(At, 1, 1); PG8_STAGE(PG8_SB(1, 0), b3, voffB); PG8_STAGE(PG8_SB(1, 1), b3 + hstepB, voffB); PG8_STAGE(PG8_SA(1, 0), a3, voffA);
            PG8_WAIT_V(8); PG8_WAIT_L(0); PG8_BAR; PG8_MMA(1, 0, At, B0); PG8_MMA(1, 1, At, B1); PG8_BAR; PG8_SCHED;
        }
        if (wr == 0) PG8_BAR;
        E(acc, cur, wr, wc, fr, fq);
        if (!has_next) break;
#pragma unroll
        for (int a = 0; a < 2; ++a)
#pragma unroll
            for (int b = 0; b < 2; ++b)
#pragma unroll
                for (int m = 0; m < 4; ++m)
#pragma unroll
                    for (int n = 0; n < 2; ++n) acc[a][b][m][n] = (f32x4){0.f, 0.f, 0.f, 0.f};
        cur = nxt; cA = nA; cB = nB; ++ui;
        if (wr == 1) PG8_BAR;
    }
    PG8_WAIT_V(0);
    PG8_BAR;
#undef PG8_SA
#undef PG8_SB
#undef PG8_STAGE
#undef PG8_LDA
#undef PG8_LDB
#undef PG8_MMA
#undef PG8_WAIT_V
#undef PG8_WAIT_L
#undef PG8_BAR
#undef PG8_SCHED
}
}

#define XB_TMO      128
#define XB_XCNT(j)  (256  + 64 * (j))
#define XB_XSUB(j)  (1280 + 64 * (j))
#define XB_XGEN(j)  (2304 + 64 * (j))
#define XB_TOP      3328
#define XB_TOPGEN   3392
#define XCD_BAR_WORDS 3456
#define XB_SPIN_CAP (1u << 18)
__device__ __forceinline__ unsigned xb_ld(unsigned* p)              { return __hip_atomic_load(p, __ATOMIC_RELAXED, __HIP_MEMORY_SCOPE_AGENT); }
__device__ __forceinline__ unsigned xb_add(unsigned* p, unsigned v) { return __hip_atomic_fetch_add(p, v, __ATOMIC_RELAXED, __HIP_MEMORY_SCOPE_AGENT); }
__device__ __forceinline__ unsigned xb_xcc_id() { return (unsigned)__builtin_amdgcn_s_getreg((3 << 11) | 20) & 0xFu; }
#define XB_SPIN(cond, bar) do { unsigned _sp = 0; while (cond) { __builtin_amdgcn_s_sleep(1); \
    if ((++_sp & 255u) == 0u) { if (xb_ld(&(bar)[XB_TMO])) break; if (_sp > XB_SPIN_CAP) { atomicAdd(&(bar)[XB_TMO], 1u); break; } } } } while (0)
struct XcdBarrier { unsigned* bar; unsigned x; volatile LAS unsigned* st; };
__device__ __forceinline__ XcdBarrier xcd_barrier_post(unsigned* bar, volatile LAS unsigned* st) {
    XcdBarrier b; b.bar = bar; b.x = xb_xcc_id(); b.st = st;
    if (threadIdx.x == 0) (void)xb_add(&bar[XB_XCNT(b.x)], 1u);
    return b;
}
__device__ __forceinline__ void xcd_barrier_complete(unsigned* bar, unsigned x, unsigned& nloc, unsigned& nx) {
    const unsigned G = gridDim.x * gridDim.y * gridDim.z;
    unsigned sum, cnt, mine, sp = 0u;
    for (;;) {
        sum = 0u; cnt = 0u; mine = 0u;
#pragma unroll
        for (unsigned j = 0; j < 16; ++j) { const unsigned c = xb_ld(&bar[XB_XCNT(j)]); sum += c; cnt += (c > 0u) ? 1u : 0u; mine = (j == x) ? c : mine; }
        if (sum == G) break;
        __builtin_amdgcn_s_sleep(1);
        if ((++sp & 255u) == 0u) { if (xb_ld(&bar[XB_TMO])) break; if (sp > XB_SPIN_CAP) { atomicAdd(&bar[XB_TMO], 1u); break; } }
    }
    nloc = mine > 0u ? mine : 1u; nx = cnt > 0u ? cnt : 1u;
}
__device__ __forceinline__ void xcd_barrier(const XcdBarrier& b) {
    asm volatile("s_waitcnt vmcnt(0)" ::: "memory");
    __syncthreads();
    if (threadIdx.x == 0) {
        unsigned* bar = b.bar;
        __builtin_amdgcn_s_waitcnt(0);
        unsigned nloc = b.st[0], nx = b.st[1];
        if (nloc == 0u) { xcd_barrier_complete(bar, b.x, nloc, nx); b.st[0] = nloc; b.st[1] = nx; }
        const unsigned old = xb_add(&bar[XB_XSUB(b.x)], 1u);
        const unsigned gen = old / nloc;
        if (old + 1u == (gen + 1u) * nloc) {
            __builtin_amdgcn_fence(__ATOMIC_RELEASE, "agent");
            asm volatile("s_waitcnt vmcnt(0)" ::: "memory");
            const unsigned og = xb_add(&bar[XB_TOP], 1u);
            const unsigned tg = og / nx;
            if (og + 1u == (tg + 1u) * nx) xb_add(&bar[XB_TOPGEN], 1u);
            else XB_SPIN(xb_ld(&bar[XB_TOPGEN]) == tg, bar);
            __builtin_amdgcn_fence(__ATOMIC_ACQUIRE, "agent");
            xb_add(&bar[XB_XGEN(b.x)], 1u);
            asm volatile("s_waitcnt vmcnt(0)" ::: "memory");
        } else {
            XB_SPIN(xb_ld(&bar[XB_XGEN(b.x)]) == gen, bar);
            __builtin_amdgcn_fence(__ATOMIC_ACQUIRE, "agent");
            asm volatile("s_waitcnt vmcnt(0)" ::: "memory");
        }
    }
    __syncthreads();
}

struct Args {
    const float* x; const float* ln1_g; const float* w_in; const float* mix_g; const float* w_out; const float* ln2_g;
    const float* w_gr; const float* b_gr; const float* w_er; const float* b_er; const float* w_gate; const float* w_up; const float* w_down; const float* fin_g;
    float* out; unsigned char* ws; int ph_lo, ph_hi, li, pad;
};

__device__ __forceinline__ void transpose_item(const float* W, int K, int N, bf16_t* WT, int dpitch, int dcol, LAS float* scr, int item, int lane) {
    const int nblk = N / 32, kb = item / nblk, nb = item % nblk, k0 = 64 * kb, n0 = 32 * nb;
#pragma unroll 8
    for (int i = 0; i < 32; ++i) { const int kk = 2 * i + (lane >> 5); scr[kk * 33 + (lane & 31)] = W[(size_t)(k0 + kk) * N + n0 + (lane & 31)]; }
    LDS_WAIT(); asm volatile("" ::: "memory");
    const int c = lane & 7;
#pragma unroll
    for (int j = 0; j < 4; ++j) { const int n = (lane >> 3) + 8 * j; const LAS float* s = scr + (8 * c) * 33 + n;
        u32x4 o; o.x = pk2(s[0 * 33], s[1 * 33]); o.y = pk2(s[2 * 33], s[3 * 33]); o.z = pk2(s[4 * 33], s[5 * 33]); o.w = pk2(s[6 * 33], s[7 * 33]);
        *(u32x4*)(WT + (size_t)(n0 + n) * dpitch + dcol + k0 + 8 * c) = o; }
    LDS_WAIT(); asm volatile("" ::: "memory");
}
__device__ __forceinline__ void phase_prologue(const Args& a, LAS unsigned char* lds, int gw, int NGW, int wave, int lane) {
    LAS float* scr = (LAS float*)(lds + wave * 16384);
    constexpr int I_IN = (DM / 64) * (NQKV / 32);
    constexpr int I_OUT = (DM / 64) * (DM / 32);
    constexpr int I_G = (DM / 64) * (DEXP / 32);
    constexpr int I_D = (DEXP / 64) * (DM / 32);
    constexpr int N_IN = DEPTH * I_IN, N_OUT = DEPTH * I_OUT, N_G = DEPTH * NEXP * I_G, N_D = DEPTH * NEXP * I_D;
    constexpr int NITEMS = N_IN + N_OUT + 2 * N_G + N_D;
    bf16_t* WinT = (bf16_t*)(a.ws + WS_WIN); bf16_t* WoutT = (bf16_t*)(a.ws + WS_WOUT); bf16_t* WgT = (bf16_t*)(a.ws + WS_WG); bf16_t* WuT = (bf16_t*)(a.ws + WS_WU); bf16_t* WdT = (bf16_t*)(a.ws + WS_WD);
    for (int it = gw; it < NITEMS; it += NGW) {
        int r = it;
        if (r < N_IN) { const int l = r / I_IN; transpose_item(a.w_in + (size_t)l * DM * NQKV, DM, NQKV, WinT + (size_t)l * NQKV * DM, DM, 0, scr, r % I_IN, lane); continue; } r -= N_IN;
        if (r < N_OUT) { const int l = r / I_OUT; transpose_item(a.w_out + (size_t)l * DM * DM, DM, DM, WoutT + (size_t)l * DM * DM, DM, 0, scr, r % I_OUT, lane); continue; } r -= N_OUT;
        if (r < N_G) { const int le = r / I_G; transpose_item(a.w_gate + (size_t)le * DM * DEXP, DM, DEXP, WgT + (size_t)le * DEXP * DM, DM, 0, scr, r % I_G, lane); continue; } r -= N_G;
        if (r < N_G) { const int le = r / I_G; transpose_item(a.w_up + (size_t)le * DM * DEXP, DM, DEXP, WuT + (size_t)le * DEXP * DM, DM, 0, scr, r % I_G, lane); continue; } r -= N_G;
        { const int le = r / I_D, l = le / NEXP, e = le % NEXP; transpose_item(a.w_down + (size_t)le * DEXP * DM, DEXP, DM, WdT + (size_t)l * DM * NACT, NACT, e * DEXP, scr, r % I_D, lane); }
    }
}

__device__ __forceinline__ void phase_norm1(const float* x, const float* g, bf16_t* hb, int gw, int NGW, int lane) {
    f32x4 gv[4];
#pragma unroll
    for (int j = 0; j < 4; ++j) gv[j] = *((const f32x4*)g + lane + 64 * j);
    for (int m = gw; m < T; m += NGW) {
        const f32x4* xr = (const f32x4*)(x + (size_t)m * DM) + lane;
        f32x4 v[4]; float s = 0.f;
#pragma unroll
        for (int j = 0; j < 4; ++j) { v[j] = xr[64 * j]; s += (v[j].x * v[j].x + v[j].y * v[j].y) + (v[j].z * v[j].z + v[j].w * v[j].w); }
        const float rstd = 1.0f / sqrtf(wave_sum(s) * (1.f / DM) + NORM_EPS);
        u32x2* o8 = (u32x2*)(hb + (size_t)m * DM) + lane;
#pragma unroll
        for (int j = 0; j < 4; ++j) { u32x2 w; w.x = pk2(v[j].x * rstd * gv[j].x, v[j].y * rstd * gv[j].y); w.y = pk2(v[j].z * rstd * gv[j].z, v[j].w * rstd * gv[j].w); o8[64 * j] = w; }
    }
}
__device__ __forceinline__ void phase_mixnorm(const bf16_t* ob, bf16_t* hb, const float* lse, const float* g, int gw, int NGW, int lane) {
    float g0[8], g1[8];
#pragma unroll
    for (int j = 0; j < 8; ++j) { g0[j] = g[8 * lane + j]; g1[j] = g[512 + 8 * lane + j]; }
    const int hh = lane >> 3;
    for (int m = gw; m < T; m += NGW) {
        const u32x4 a = *((const u32x4*)(ob + (size_t)m * DM) + lane), c0 = *((const u32x4*)(ob + (size_t)m * DM + 512) + lane);
        const u32x4 c1 = *((const u32x4*)(hb + (size_t)m * DM) + lane), c2 = *((const u32x4*)(hb + (size_t)m * DM + 512) + lane);
        const float l0 = lse[(size_t)m * 8 + hh], l1 = lse[(size_t)T * 8 + (size_t)m * 8 + hh], l2 = lse[(size_t)2 * T * 8 + (size_t)m * 8 + hh];
        const float mx = fmaxf(l0, fmaxf(l1, l2));
        float w0 = __builtin_amdgcn_exp2f(l0 - mx), w1 = __builtin_amdgcn_exp2f(l1 - mx), w2 = __builtin_amdgcn_exp2f(l2 - mx);
        const float inv = 1.0f / (w0 + w1 + w2); w0 *= inv; w1 *= inv; w2 *= inv;
        float va[8] = {bflo(a.x), bfhi(a.x), bflo(a.y), bfhi(a.y), bflo(a.z), bfhi(a.z), bflo(a.w), bfhi(a.w)};
        const float x0[8] = {bflo(c0.x), bfhi(c0.x), bflo(c0.y), bfhi(c0.y), bflo(c0.z), bfhi(c0.z), bflo(c0.w), bfhi(c0.w)};
        const float x1[8] = {bflo(c1.x), bfhi(c1.x), bflo(c1.y), bfhi(c1.y), bflo(c1.z), bfhi(c1.z), bflo(c1.w), bfhi(c1.w)};
        const float x2[8] = {bflo(c2.x), bfhi(c2.x), bflo(c2.y), bfhi(c2.y), bflo(c2.z), bfhi(c2.z), bflo(c2.w), bfhi(c2.w)};
        float vc[8];
        float sa = 0.f, sc = 0.f;
#pragma unroll
        for (int j = 0; j < 8; ++j) { vc[j] = w0 * x0[j] + w1 * x1[j] + w2 * x2[j]; sa += va[j] * va[j]; sc += vc[j] * vc[j]; }
        sa = half_sum(sa); sc = wave_sum(sc);
        const float ra = 1.0f / sqrtf(sa * (1.f / 256.f) + NORM_EPS), rc = 1.0f / sqrtf(sc * (1.f / 512.f) + NORM_EPS);
        u32x4 oa, oc;
        oa.x = pk2(va[0] * ra * g0[0], va[1] * ra * g0[1]); oa.y = pk2(va[2] * ra * g0[2], va[3] * ra * g0[3]); oa.z = pk2(va[4] * ra * g0[4], va[5] * ra * g0[5]); oa.w = pk2(va[6] * ra * g0[6], va[7] * ra * g0[7]);
        oc.x = pk2(vc[0] * rc * g1[0], vc[1] * rc * g1[1]); oc.y = pk2(vc[2] * rc * g1[2], vc[3] * rc * g1[3]); oc.z = pk2(vc[4] * rc * g1[4], vc[5] * rc * g1[5]); oc.w = pk2(vc[6] * rc * g1[6], vc[7] * rc * g1[7]);
        *((u32x4*)(hb + (size_t)m * DM) + lane) = oa; *((u32x4*)(hb + (size_t)m * DM + 512) + lane) = oc;
    }
}
__device__ __forceinline__ void phase_route(const float* x, const float* g, const float* wgr, const float* bgr, const float* wer, const float* ber,
                                            bf16_t* hb, float* comb, int gw, int NGW, int lane) {
    f32x4 gv[4];
#pragma unroll
    for (int j = 0; j < 4; ++j) gv[j] = *((const f32x4*)g + lane + 64 * j);
    for (int m = gw; m < T; m += NGW) {
        const f32x4* xr = (const f32x4*)(x + (size_t)m * DM) + lane;
        f32x4 v[4]; float s = 0.f;
#pragma unroll
        for (int j = 0; j < 4; ++j) { v[j] = xr[64 * j]; s += (v[j].x * v[j].x + v[j].y * v[j].y) + (v[j].z * v[j].z + v[j].w * v[j].w); }
        const float rstd = 1.0f / sqrtf(wave_sum(s) * (1.f / DM) + NORM_EPS);
        u32x2* o8 = (u32x2*)(hb + (size_t)m * DM) + lane;
#pragma unroll
        for (int j = 0; j < 4; ++j) { v[j] = v[j] * rstd * gv[j]; u32x2 w; w.x = pk2(v[j].x, v[j].y); w.y = pk2(v[j].z, v[j].w); o8[64 * j] = w; }
        f32x4 gl = (f32x4){0.f, 0.f, 0.f, 0.f};
#pragma unroll
        for (int j = 0; j < 4; ++j) { const f32x4* wp = (const f32x4*)wgr + (size_t)(4 * lane + 256 * j);
            gl += wp[0] * v[j].x; gl += wp[1] * v[j].y; gl += wp[2] * v[j].z; gl += wp[3] * v[j].w; }
        gl.x = wave_sum(gl.x) + bgr[0]; gl.y = wave_sum(gl.y) + bgr[1]; gl.z = wave_sum(gl.z) + bgr[2]; gl.w = wave_sum(gl.w) + bgr[3];
        int gi = 0; float gm = gl.x;
        if (gl.y > gm) { gm = gl.y; gi = 1; } if (gl.z > gm) { gm = gl.z; gi = 2; } if (gl.w > gm) { gm = gl.w; gi = 3; }
        const float gden = __expf(gl.x - gm) + __expf(gl.y - gm) + __expf(gl.z - gm) + __expf(gl.w - gm);
        const float gw_ = 1.0f / gden;
        const float* we = wer + (size_t)gi * DM * 4;
        f32x4 el = (f32x4){0.f, 0.f, 0.f, 0.f};
#pragma unroll
        for (int j = 0; j < 4; ++j) { const f32x4* wp = (const f32x4*)we + (size_t)(4 * lane + 256 * j);
            el += wp[0] * v[j].x; el += wp[1] * v[j].y; el += wp[2] * v[j].z; el += wp[3] * v[j].w; }
        float e[4] = {wave_sum(el.x) + ber[gi * 4 + 0], wave_sum(el.y) + ber[gi * 4 + 1], wave_sum(el.z) + ber[gi * 4 + 2], wave_sum(el.w) + ber[gi * 4 + 3]};
        int i1 = 0; float v1 = e[0];
#pragma unroll
        for (int k = 1; k < 4; ++k) if (e[k] > v1) { v1 = e[k]; i1 = k; }
        int i2 = -1; float v2 = -INFINITY;
#pragma unroll
        for (int k = 0; k < 4; ++k) if (k != i1 && e[k] > v2) { v2 = e[k]; i2 = k; }
        const float p2 = __expf(v2 - v1), inv = 1.0f / (1.0f + p2);
        const float w1 = inv * gw_, w2 = p2 * inv * gw_;
        if (lane < 16) { const int ge = lane >> 2, ee = lane & 3; float cw = 0.f; if (ge == gi) { if (ee == i1) cw = w1; else if (ee == i2) cw = w2; } comb[(size_t)m * NEXP + lane] = cw; }
    }
}
__device__ __forceinline__ void phase_final(float* x, const float* g, int gw, int NGW, int lane) {
    f32x4 gv[4];
#pragma unroll
    for (int j = 0; j < 4; ++j) gv[j] = *((const f32x4*)g + lane + 64 * j);
    for (int m = gw; m < T; m += NGW) {
        f32x4* xr = (f32x4*)(x + (size_t)m * DM) + lane;
        f32x4 v[4]; float s = 0.f;
#pragma unroll
        for (int j = 0; j < 4; ++j) { v[j] = xr[64 * j]; s += (v[j].x * v[j].x + v[j].y * v[j].y) + (v[j].z * v[j].z + v[j].w * v[j].w); }
        const float rstd = 1.0f / sqrtf(wave_sum(s) * (1.f / DM) + NORM_EPS);
#pragma unroll
        for (int j = 0; j < 4; ++j) xr[64 * j] = v[j] * rstd * gv[j];
    }
}
__device__ __forceinline__ void phase_kmean(const bf16_t* kb, float* kmean, int gw, int NGW, int lane) {
    for (int it = gw; it < BATCH * 4 * 32; it += NGW) {
        const int b = it >> 7, h = (it >> 5) & 3, blk = it & 31;
        const bf16_t* base = kb + ((size_t)b * SEQ + (size_t)blk * 256) * DM + h * HD + (lane & 7) * 8;
        float acc[8] = {0.f, 0.f, 0.f, 0.f, 0.f, 0.f, 0.f, 0.f};
#pragma unroll 4
        for (int i = 0; i < 32; ++i) { const u32x4 w = *(const u32x4*)(base + (size_t)((lane >> 3) + 8 * i) * DM);
            acc[0] += bflo(w.x); acc[1] += bfhi(w.x); acc[2] += bflo(w.y); acc[3] += bfhi(w.y); acc[4] += bflo(w.z); acc[5] += bfhi(w.z); acc[6] += bflo(w.w); acc[7] += bfhi(w.w); }
#pragma unroll
        for (int j = 0; j < 8; ++j) { acc[j] += __shfl_xor(acc[j], 8); acc[j] += __shfl_xor(acc[j], 16); acc[j] += __shfl_xor(acc[j], 32); }
        if (lane < 8) {
            float* o = kmean + (size_t)it * HD + lane * 8;
#pragma unroll
            for (int j = 0; j < 8; ++j) o[j] = acc[j] * (1.f / 256.f);
        }
    }
}

__device__ __forceinline__ void ld_row64(float (&r)[64], const bf16_t* p) {
#pragma unroll
    for (int c = 0; c < 8; ++c) { const u32x4 w = *((const u32x4*)p + c);
        r[8 * c + 0] = bflo(w.x); r[8 * c + 1] = bfhi(w.x); r[8 * c + 2] = bflo(w.y); r[8 * c + 3] = bfhi(w.y); r[8 * c + 4] = bflo(w.z); r[8 * c + 5] = bfhi(w.z); r[8 * c + 6] = bflo(w.w); r[8 * c + 7] = bfhi(w.w); }
}
__device__ __forceinline__ float dot_row64(const float (&q)[64], const bf16_t* p) {
    float s0 = 0.f, s1 = 0.f;
#pragma unroll
    for (int c = 0; c < 8; ++c) { const u32x4 w = *((const u32x4*)p + c);
        s0 += q[8 * c + 0] * bflo(w.x); s1 += q[8 * c + 1] * bfhi(w.x); s0 += q[8 * c + 2] * bflo(w.y); s1 += q[8 * c + 3] * bfhi(w.y);
        s0 += q[8 * c + 4] * bflo(w.z); s1 += q[8 * c + 5] * bfhi(w.z); s0 += q[8 * c + 6] * bflo(w.w); s1 += q[8 * c + 7] * bfhi(w.w); }
    return s0 + s1;
}
__device__ __forceinline__ void axpy_row64(float (&o)[64], float p, const bf16_t* vp) {
#pragma unroll
    for (int c = 0; c < 8; ++c) { const u32x4 w = *((const u32x4*)vp + c);
        o[8 * c + 0] += p * bflo(w.x); o[8 * c + 1] += p * bfhi(w.x); o[8 * c + 2] += p * bflo(w.y); o[8 * c + 3] += p * bfhi(w.y);
        o[8 * c + 4] += p * bflo(w.z); o[8 * c + 5] += p * bfhi(w.z); o[8 * c + 6] += p * bflo(w.w); o[8 * c + 7] += p * bfhi(w.w); }
}
__device__ __forceinline__ void st_row64(bf16_t* p, const float (&o)[64], float sc) {
#pragma unroll
    for (int c = 0; c < 8; ++c) { u32x4 w; w.x = pk2(o[8 * c] * sc, o[8 * c + 1] * sc); w.y = pk2(o[8 * c + 2] * sc, o[8 * c + 3] * sc); w.z = pk2(o[8 * c + 4] * sc, o[8 * c + 5] * sc); w.w = pk2(o[8 * c + 6] * sc, o[8 * c + 7] * sc); *((u32x4*)p + c) = w; }
}
#define OSM_STEP(sc, vrow) do { const float sc_ = (sc); if (sc_ > m_) { const float al = __builtin_amdgcn_exp2f(m_ - sc_); l_ *= al; _Pragma("unroll") for (int d_ = 0; d_ < 64; ++d_) o_[d_] *= al; m_ = sc_; } \
    const float p_ = __builtin_amdgcn_exp2f(sc_ - m_); l_ += p_; axpy_row64(o_, p_, (vrow)); } while (0)

__device__ __forceinline__ void naive_moba(const bf16_t* qb, const bf16_t* kb, const bf16_t* vb, const float* kmean, bf16_t* ob, int item, int tid) {
    const int b = item >> 6, h = (item >> 4) & 3, t = (item & 15) * 512 + tid, own = t >> 8;
    const size_t rowq = ((size_t)b * SEQ + t) * DM + h * HD;
    const bf16_t* kh = kb + (size_t)b * SEQ * DM + h * HD; const bf16_t* vh = vb + (size_t)b * SEQ * DM + h * HD;
    const float slope2 = exp2f(-2.0f * (float)(h + 1)) * LOG2E;
    float q_[64]; ld_row64(q_, qb + rowq);
    float bv0 = -INFINITY, bv1 = -INFINITY, bv2 = -INFINITY; int bi0 = -1, bi1 = -1, bi2 = -1;
    const float* km = kmean + (size_t)(b * 4 + h) * 32 * HD;
    for (int n = 0; n < own; ++n) {
        float gsum = 0.f;
#pragma unroll
        for (int d = 0; d < 64; ++d) gsum += q_[d] * km[n * HD + d];
        if (gsum > bv0) { bv2 = bv1; bi2 = bi1; bv1 = bv0; bi1 = bi0; bv0 = gsum; bi0 = n; }
        else if (gsum > bv1) { bv2 = bv1; bi2 = bi1; bv1 = gsum; bi1 = n; }
        else if (gsum > bv2) { bv2 = gsum; bi2 = n; }
    }
    float o_[64];
#pragma unroll
    for (int d = 0; d < 64; ++d) o_[d] = 0.f;
    float m_ = -INFINITY, l_ = 0.f;
    for (int s = 0; s < 3; ++s) {
        const int blk = (s == 0) ? bi0 : (s == 1) ? bi1 : bi2;
        if (blk < 0) continue;
        for (int j = 0; j < 256; ++j) { const int pos = blk * 256 + j;
            const float sc = dot_row64(q_, kh + (size_t)pos * DM) - slope2 * (float)(t - pos);
            OSM_STEP(sc, vh + (size_t)pos * DM); }
    }
    for (int pos = own * 256; pos <= t; ++pos) {
        const float sc = dot_row64(q_, kh + (size_t)pos * DM) - slope2 * (float)(t - pos);
        OSM_STEP(sc, vh + (size_t)pos * DM); }
    st_row64(ob + rowq, o_, 1.0f / l_);
}
__device__ __forceinline__ void naive_sb(const bf16_t* qb, const bf16_t* kb, const bf16_t* vb, bf16_t* ob, int item, int tid) {
    const int b = item >> 6, h = 4 + ((item >> 4) & 3), t = (item & 15) * 512 + tid;
    const size_t rowq = ((size_t)b * SEQ + t) * DM + h * HD;
    const bf16_t* kh = kb + (size_t)b * SEQ * DM + h * HD; const bf16_t* vh = vb + (size_t)b * SEQ * DM + h * HD;
    float q_[64]; ld_row64(q_, qb + rowq);
    float o_[64];
#pragma unroll
    for (int d = 0; d < 64; ++d) o_[d] = 0.f;
    float tail = 0.f;
    for (int s = t - 1; s >= 0 && tail > -150.f; --s) {
        const float z = dot_row64(q_, kh + (size_t)s * DM);
        const float lp = __builtin_amdgcn_logf(1.0f + __builtin_amdgcn_exp2f(-fabsf(z)));
        const float lnot = -(fmaxf(z, 0.f) + lp);
        const float aw = __builtin_amdgcn_exp2f(z + lnot + tail);
        axpy_row64(o_, aw, vh + (size_t)s * DM);
        tail += lnot;
    }
    st_row64(ob + rowq, o_, 1.0f);
}
__device__ __forceinline__ void naive_dil(const bf16_t* qb, const bf16_t* kb, const bf16_t* vb, bf16_t* ob, bf16_t* hb2, float* lse, int item, int tid) {
    const int b = item >> 7, h = 8 + ((item >> 4) & 7), t = (item & 15) * 512 + tid;
    const size_t rowq = ((size_t)b * SEQ + t) * DM + h * HD;
    const bf16_t* kh = kb + (size_t)b * SEQ * DM + h * HD; const bf16_t* vh = vb + (size_t)b * SEQ * DM + h * HD;
    const float slope2 = exp2f(-(float)(h - 8 + 1)) * LOG2E;
    float q_[64]; ld_row64(q_, qb + rowq);
    float o_[64];
#pragma unroll
    for (int d = 0; d < 64; ++d) o_[d] = 0.f;
    float m_ = -INFINITY, l_ = 0.f;
    for (int c = 0; c < 3; ++c) {
        const int dil = (c == 0) ? 1 : (c == 1) ? 4 : 16;
        for (int dl = 0; dl <= 128; ++dl) { const int pos = t - dl * dil; if (pos < 0) break;
            const float sc = dot_row64(q_, kh + (size_t)pos * DM) - slope2 * (float)(dl * dil);
            OSM_STEP(sc, vh + (size_t)pos * DM); }
    }
    st_row64(ob + rowq, o_, 1.0f / l_);
    { const size_t tok = (size_t)b * SEQ + t; const u32x4 z4 = {0u, 0u, 0u, 0u};
#pragma unroll
      for (int c = 0; c < 8; ++c) { *((u32x4*)(hb2 + tok * DM + (h - 8) * HD) + c) = z4; *((u32x4*)(hb2 + tok * DM + 512 + (h - 8) * HD) + c) = z4; }
      lse[tok * 8 + (h - 8)] = 0.f; lse[(size_t)T * 8 + tok * 8 + (h - 8)] = -1.0e30f; lse[(size_t)2 * T * 8 + tok * 8 + (h - 8)] = -1.0e30f; }
}

namespace att {
typedef float f32x16 __attribute__((ext_vector_type(16)));
typedef short s16x4 __attribute__((ext_vector_type(4)));
typedef short v4i16_t __attribute__((ext_vector_type(4)));
typedef __bf16 bf16x2_t __attribute__((ext_vector_type(2)));
constexpr int L_BUF = 16384;
constexpr int L_WSF = 2 * L_BUF;
constexpr int L_OST = L_WSF + 8 * 256;
constexpr int L_FLG = L_OST + 8 * 4096;
constexpr int L_END = L_FLG + 64;
constexpr float M_INIT = -1.0e30f;
#define ATT_MFMA(a, b, c) __builtin_amdgcn_mfma_f32_32x32x16_bf16((a), (b), (c), 0, 0, 0)

__device__ __forceinline__ unsigned cvtpk(float lo, float hi) { f32x2 v = {lo, hi}; bf16x2_t b = __builtin_convertvector(v, bf16x2_t); return __builtin_bit_cast(unsigned, b); }
__device__ __forceinline__ s16x4 vtr(LAS unsigned char* p) { return __builtin_bit_cast(s16x4, __builtin_amdgcn_ds_read_tr16_b64_v4i16((LAS v4i16_t*)p)); }

struct Wave { int lane, r32, hi, wid; LAS unsigned char* lds; LAS float* wsf; int vlo; };
__device__ __forceinline__ Wave make_wave(LAS unsigned char* lds, int tid) {
    Wave w; w.lane = tid & 63; w.r32 = w.lane & 31; w.hi = w.lane >> 5; w.wid = __builtin_amdgcn_readfirstlane(tid >> 6); w.lds = lds;
    w.wsf = (LAS float*)(lds + L_WSF) + w.wid * 64;
    w.vlo = ((w.lane >> 4) & 1) * 32 + (w.lane & 3) * 8 + (4 * w.hi + ((w.lane & 15) >> 2)) * 64;
    return w;
}
struct Stage { u32x4 k, v; };
template <class RowK, class RowV> __device__ __forceinline__ void stage_load(Stage& s, const Wave& w, const RowK& rowk, const RowV& rowv) {
    s.k = *(const u32x4*)(rowk(w.lane) + w.wid * 8);
    s.v = *(const u32x4*)(rowv(16 * (w.wid & 3) + (w.lane >> 2)) + (w.wid >> 2) * 32 + (w.lane & 3) * 8);
}
__device__ __forceinline__ void stage_write(const Stage& s, const Wave& w, int buf) {
    *(LAS u32x4*)(w.lds + buf * L_BUF + w.wid * 1024 + w.lane * 16) = s.k;
    *(LAS u32x4*)(w.lds + buf * L_BUF + 8192 + w.wid * 1024 + w.lane * 16) = s.v;
}
__device__ __forceinline__ f32x16 qk_sub(const Wave& w, int buf, int sub, const bf16x8 (&qf)[4], float init) {
    f32x16 acc;
#pragma unroll
    for (int r = 0; r < 16; ++r) acc[r] = init;
    LAS unsigned char* kp = w.lds + buf * L_BUF + w.hi * 1024 + (32 * sub + w.r32) * 16;
#pragma unroll
    for (int ks = 0; ks < 4; ++ks) { const bf16x8 kf = *(LAS bf16x8*)(kp + ks * 2048); acc = ATT_MFMA(kf, qf[ks], acc); }
    return acc;
}
__device__ __forceinline__ void pv_sub(const Wave& w, int buf, int sub, const f32x16& p, f32x16 (&o)[2]) {
    bf16x8 pk[2];
#pragma unroll
    for (int s = 0; s < 2; ++s) { u32x4 t; t.x = cvtpk(p[8 * s], p[8 * s + 1]); t.y = cvtpk(p[8 * s + 2], p[8 * s + 3]); t.z = cvtpk(p[8 * s + 4], p[8 * s + 5]); t.w = cvtpk(p[8 * s + 6], p[8 * s + 7]); pk[s] = __builtin_bit_cast(bf16x8, t); }
    LAS unsigned char* vb = w.lds + buf * L_BUF + 8192 + w.vlo;
#pragma unroll
    for (int db = 0; db < 2; ++db)
#pragma unroll
        for (int s = 0; s < 2; ++s) { LAS unsigned char* vp = vb + db * 4096 + (4 * sub + 2 * s) * 512;
            const s16x4 lo = vtr(vp), hh = vtr(vp + 512);
            const bf16x8 vf = __builtin_shufflevector(lo, hh, 0, 1, 2, 3, 4, 5, 6, 7);
            o[db] = ATT_MFMA(pk[s], vf, o[db]); }
}
__device__ __forceinline__ void scale_rows(const Wave& w, f32x16 (&o)[2], float f) {
    if (w.hi == 0) w.wsf[w.r32] = f;
#pragma unroll
    for (int g = 0; g < 4; ++g) { const f32x4 fv = *(LAS f32x4*)(w.wsf + 8 * g + 4 * w.hi);
#pragma unroll
        for (int i = 0; i < 4; ++i) { o[0][4 * g + i] *= fv[i]; o[1][4 * g + i] *= fv[i]; } }
}
__device__ __forceinline__ void softmax_sub(const Wave& w, f32x16& s, float& m, float& lsum, f32x16 (&o)[2]) {
    float tm = fmaxf(fmaxf(s[0], s[1]), fmaxf(s[2], s[3]));
#pragma unroll
    for (int r = 4; r < 16; r += 4) tm = fmaxf(tm, fmaxf(fmaxf(s[r], s[r + 1]), fmaxf(s[r + 2], s[r + 3])));
    tm = fmaxf(tm, __shfl_xor(tm, 32));
    const float mn = fmaxf(m, tm);
    if (__any(mn > m)) { const float al = __builtin_amdgcn_exp2f(m - mn); lsum *= al; scale_rows(w, o, al); m = mn; }
    float acc = 0.f;
#pragma unroll
    for (int r = 0; r < 16; ++r) { s[r] = __builtin_amdgcn_exp2f(s[r] - m); acc += s[r]; }
    lsum += acc;
}
__device__ __forceinline__ void mask_band(f32x16& s, int delta0, int W) {
#pragma unroll
    for (int r = 0; r < 16; ++r) { const int dl = delta0 - ((r & 3) + 8 * (r >> 2)); if ((unsigned)dl > (unsigned)W) s[r] = -INFINITY; }
}
template <class RowO> __device__ __forceinline__ void store_o(const Wave& w, const f32x16 (&o)[2], const RowO& rowo) {
    LAS unsigned short* stg = (LAS unsigned short*)(w.lds + L_OST + w.wid * 4096);
#pragma unroll
    for (int r = 0; r < 16; ++r) { const int q = (r & 3) + 8 * (r >> 2) + 4 * w.hi;
#pragma unroll
        for (int db = 0; db < 2; ++db) stg[q * 64 + db * 32 + w.r32] = (unsigned short)f2bf(o[db][r]); }
#pragma unroll
    for (int i = 0; i < 4; ++i) { const int row = i * 8 + (w.lane >> 3), ch = w.lane & 7; const u32x4 v = *(LAS u32x4*)((LAS unsigned char*)stg + row * 128 + ch * 16);
        *(u32x4*)(rowo(row) + ch * 8) = v; }
}
__device__ __forceinline__ void load_q(bf16x8 (&qf)[4], const bf16_t* qrow, int hi) {
#pragma unroll
    for (int ks = 0; ks < 4; ++ks) qf[ks] = *(const bf16x8*)(qrow + 16 * ks + 8 * hi);
}

__device__ __forceinline__ void moba_unit(LAS unsigned char* lds, const bf16_t* QB, const bf16_t* KB, const bf16_t* VB, const float* KMEAN, bf16_t* OB, int b, int h, int own, int tid) {
    const Wave w = make_wave(lds, tid);
    const size_t rowbase = (size_t)b * SEQ; const int q0 = own * 256, qpos = q0 + 32 * w.wid + w.r32;
    const bf16_t* kh = KB + rowbase * DM + h * HD; const bf16_t* vh = VB + rowbase * DM + h * HD;
    const float slope2 = exp2f(-2.0f * (float)(h + 1)) * LOG2E;
    bf16x8 qf[4]; load_q(qf, QB + (rowbase + qpos) * DM + h * HD, w.hi);
    int i0 = -1, i1 = -1, i2 = -1;
    if (own > 0) {
        f32x16 g;
#pragma unroll
        for (int r = 0; r < 16; ++r) g[r] = 0.f;
        const float* km = KMEAN + ((size_t)(b * 4 + h) * 32 + w.r32) * HD + 8 * w.hi;
#pragma unroll
        for (int ks = 0; ks < 4; ++ks) { const f32x4 a0 = *(const f32x4*)(km + 16 * ks), a1 = *(const f32x4*)(km + 16 * ks + 4);
            const float x[8] = {a0.x, a0.y, a0.z, a0.w, a1.x, a1.y, a1.z, a1.w}; unsigned hw[4], lw[4];
#pragma unroll
            for (int j = 0; j < 4; ++j) { const unsigned h0 = f2bf(x[2 * j]), h1 = f2bf(x[2 * j + 1]); hw[j] = h0 | (h1 << 16);
                lw[j] = pk2(x[2 * j] - __builtin_bit_cast(float, h0 << 16), x[2 * j + 1] - __builtin_bit_cast(float, h1 << 16)); }
            const u32x4 hv = {hw[0], hw[1], hw[2], hw[3]}, lv = {lw[0], lw[1], lw[2], lw[3]};
            g = ATT_MFMA(__builtin_bit_cast(bf16x8, hv), qf[ks], g); g = ATT_MFMA(__builtin_bit_cast(bf16x8, lv), qf[ks], g); }
        float v0 = -INFINITY, v1 = -INFINITY, v2 = -INFINITY;
#pragma unroll
        for (int r = 0; r < 16; ++r) { const int blk = (r & 3) + 8 * (r >> 2) + 4 * w.hi; const float val = (blk < own) ? g[r] : -INFINITY;
            if (val > v0) { v2 = v1; i2 = i1; v1 = v0; i1 = i0; v0 = val; i0 = blk; } else if (val > v1) { v2 = v1; i2 = i1; v1 = val; i1 = blk; } else if (val > v2) { v2 = val; i2 = blk; } }
        const float pv_[3] = {__shfl_xor(v0, 32), __shfl_xor(v1, 32), __shfl_xor(v2, 32)}; const int pi_[3] = {__shfl_xor(i0, 32), __shfl_xor(i1, 32), __shfl_xor(i2, 32)};
#pragma unroll
        for (int k = 0; k < 3; ++k) { const float val = pv_[k]; const int blk = pi_[k];
            if (val > v0 || (val == v0 && blk < i0)) { v2 = v1; i2 = i1; v1 = v0; i1 = i0; v0 = val; i0 = blk; }
            else if (val > v1 || (val == v1 && blk < i1)) { v2 = v1; i2 = i1; v1 = val; i1 = blk; }
            else if (val > v2 || (val == v2 && blk < i2)) { v2 = val; i2 = blk; } }
    }
    float tr_[16];
#pragma unroll
    for (int r = 0; r < 16; ++r) tr_[r] = slope2 * (float)((r & 3) + 8 * (r >> 2));
    f32x16 o[2];
#pragma unroll
    for (int r = 0; r < 16; ++r) { o[0][r] = 0.f; o[1][r] = 0.f; }
    float m = M_INIT, lsum = 0.f;
    const int nsteps = 4 * (own + 1);
    auto kpos_of = [&](int st) { return st < 4 ? q0 + (3 - st) * 64 : (own - 1 - ((st - 4) >> 2)) * 256 + (3 - ((st - 4) & 3)) * 64; };
    Stage sg;
    { const int kp = kpos_of(0); stage_load(sg, w, [&](int key) { return kh + (size_t)(kp + key) * DM; }, [&](int key) { return vh + (size_t)(kp + key) * DM; }); }
    stage_write(sg, w, 0);
    __syncthreads();
    for (int st = 0; st < nsteps; ++st) {
        const int buf = st & 1;
        if (st + 1 < nsteps) { const int kp = kpos_of(st + 1); stage_load(sg, w, [&](int key) { return kh + (size_t)(kp + key) * DM; }, [&](int key) { return vh + (size_t)(kp + key) * DM; }); }
        const int kpos0 = kpos_of(st); const bool ownblk = st < 4; const int blk = kpos0 >> 8;
        const bool selq = ownblk || blk == i0 || blk == i1 || blk == i2;
        if (__any(selq)) {
#pragma unroll
            for (int sub = 1; sub >= 0; --sub) {
                const int D = ownblk ? (w.wid - (2 * (3 - st) + sub)) : 1;
                if (D < 0) continue;
                const int delta0 = qpos - (kpos0 + 32 * sub) - 4 * w.hi;
                f32x16 s = qk_sub(w, buf, sub, qf, -slope2 * (float)delta0);
#pragma unroll
                for (int r = 0; r < 16; ++r) s[r] = selq ? s[r] + tr_[r] : -INFINITY;
                if (D == 0) mask_band(s, delta0, 0x7fffffff);
                softmax_sub(w, s, m, lsum, o);
                pv_sub(w, buf, sub, s, o);
            }
        }
        if (st + 1 < nsteps) stage_write(sg, w, buf ^ 1);
        __syncthreads();
    }
    const float l = lsum + __shfl_xor(lsum, 32);
    scale_rows(w, o, 1.0f / l);
    bf16_t* orow = OB + (rowbase + q0 + 32 * w.wid) * DM + h * HD;
    store_o(w, o, [&](int r) { return orow + (size_t)r * DM; });
}

__device__ __forceinline__ void sb_unit(LAS unsigned char* lds, const bf16_t* QB, const bf16_t* KB, const bf16_t* VB, bf16_t* OB, int b, int h, int qt, int tid) {
    const Wave w = make_wave(lds, tid);
    const size_t rowbase = (size_t)b * SEQ; const int q0 = qt * 256, qpos = q0 + 32 * w.wid + w.r32;
    const bf16_t* kh = KB + rowbase * DM + h * HD; const bf16_t* vh = VB + rowbase * DM + h * HD;
    bf16x8 qf[4]; load_q(qf, QB + (rowbase + qpos) * DM + h * HD, w.hi);
    f32x16 o[2];
#pragma unroll
    for (int r = 0; r < 16; ++r) { o[0][r] = 0.f; o[1][r] = 0.f; }
    float carry = 0.f;
    bool done = false;
    volatile LAS unsigned* flg = (volatile LAS unsigned*)(lds + L_FLG);
    const int ti0 = q0 / 64 + 3;
    Stage sg;
    { const int kp = ti0 * 64; stage_load(sg, w, [&](int key) { return kh + (size_t)(kp + key) * DM; }, [&](int key) { return vh + (size_t)(kp + key) * DM; }); }
    stage_write(sg, w, 0);
    __syncthreads();
    for (int st = 0;; ++st) {
        const int buf = st & 1, ti = ti0 - st;
        if (ti > 0) { const int kp = (ti - 1) * 64; stage_load(sg, w, [&](int key) { return kh + (size_t)(kp + key) * DM; }, [&](int key) { return vh + (size_t)(kp + key) * DM; }); }
        if (!done) {
#pragma unroll
            for (int sub = 1; sub >= 0; --sub) {
                const int D = (q0 / 32 + w.wid) - (2 * ti + sub);
                if (D < 0) continue;
                const int delta0 = qpos - (64 * ti + 32 * sub) - 4 * w.hi;
                f32x16 z = qk_sub(w, buf, sub, qf, 0.f);
                f32x16 L;
#pragma unroll
                for (int r = 0; r < 16; ++r) { const float lp = __builtin_amdgcn_logf(1.0f + __builtin_amdgcn_exp2f(-fabsf(z[r]))); L[r] = -(fmaxf(z[r], 0.f) + lp); }
                if (D == 0) {
#pragma unroll
                    for (int r = 0; r < 16; ++r) { const int dl = delta0 - ((r & 3) + 8 * (r >> 2)); if (dl < 1) { L[r] = 0.f; z[r] = -INFINITY; } }
                }
                float G[4], PG[4];
#pragma unroll
                for (int g = 0; g < 4; ++g) { G[g] = (L[4 * g] + L[4 * g + 1]) + (L[4 * g + 2] + L[4 * g + 3]); PG[g] = __shfl_xor(G[g], 32); }
                float run = carry;
#pragma unroll
                for (int g = 3; g >= 0; --g) { const float t3 = run + (w.hi == 0 ? PG[g] : 0.f), t2 = t3 + L[4 * g + 3], t1 = t2 + L[4 * g + 2], t0 = t1 + L[4 * g + 1];
                    z[4 * g + 3] = __builtin_amdgcn_exp2f(z[4 * g + 3] + L[4 * g + 3] + t3); z[4 * g + 2] = __builtin_amdgcn_exp2f(z[4 * g + 2] + L[4 * g + 2] + t2);
                    z[4 * g + 1] = __builtin_amdgcn_exp2f(z[4 * g + 1] + L[4 * g + 1] + t1); z[4 * g] = __builtin_amdgcn_exp2f(z[4 * g] + L[4 * g] + t0);
                    run += G[g] + PG[g]; }
                carry = run;
                pv_sub(w, buf, sub, z, o);
            }
            done = __all(carry < -150.f);
        }
        if (w.lane == 0) flg[buf * 8 + w.wid] = done ? 1u : 0u;
        if (ti > 0) stage_write(sg, w, buf ^ 1);
        __syncthreads();
        unsigned all = 1u;
#pragma unroll
        for (int k = 0; k < 8; ++k) all &= flg[buf * 8 + k];
        if (all || ti == 0) break;
    }
    bf16_t* orow = OB + (rowbase + q0 + 32 * w.wid) * DM + h * HD;
    store_o(w, o, [&](int r) { return orow + (size_t)r * DM; });
    __syncthreads();
}

__device__ __forceinline__ void dil_unit(LAS unsigned char* lds, const bf16_t* QB, const bf16_t* KB, const bf16_t* VB, bf16_t* PO, float* LSE, int b, int h, int dil, int res, int i2, int tid) {
    const Wave w = make_wave(lds, tid);
    const size_t rowbase = (size_t)b * SEQ; const int Q0 = 256 * i2, qj = Q0 + 32 * w.wid + w.r32;
    const bf16_t* kh = KB + (rowbase + res) * DM + h * HD; const bf16_t* vh = VB + (rowbase + res) * DM + h * HD;
    const size_t rstride = (size_t)dil * DM;
    const float slope2d = exp2f(-(float)(h - 8 + 1)) * LOG2E * (float)dil;
    bf16x8 qf[4]; load_q(qf, QB + (rowbase + res + (size_t)qj * dil) * DM + h * HD, w.hi);
    float tr_[16];
#pragma unroll
    for (int r = 0; r < 16; ++r) tr_[r] = slope2d * (float)((r & 3) + 8 * (r >> 2));
    f32x16 o[2];
#pragma unroll
    for (int r = 0; r < 16; ++r) { o[0][r] = 0.f; o[1][r] = 0.f; }
    float m = M_INIT, lsum = 0.f;
    const int ti0 = 4 * i2 + 3, nsteps = (ti0 + 1 < 6) ? ti0 + 1 : 6;
    Stage sg;
    { const int kp = ti0 * 64; stage_load(sg, w, [&](int key) { return kh + (size_t)(kp + key) * rstride; }, [&](int key) { return vh + (size_t)(kp + key) * rstride; }); }
    stage_write(sg, w, 0);
    __syncthreads();
    for (int st = 0; st < nsteps; ++st) {
        const int buf = st & 1, ti = ti0 - st;
        if (st + 1 < nsteps) { const int kp = (ti - 1) * 64; stage_load(sg, w, [&](int key) { return kh + (size_t)(kp + key) * rstride; }, [&](int key) { return vh + (size_t)(kp + key) * rstride; }); }
#pragma unroll
        for (int sub = 1; sub >= 0; --sub) {
            const int D = (8 * i2 + w.wid) - (2 * ti + sub);
            if (D < 0 || D > 4) continue;
            const int delta0 = qj - (64 * ti + 32 * sub) - 4 * w.hi;
            f32x16 s = qk_sub(w, buf, sub, qf, -slope2d * (float)delta0);
#pragma unroll
            for (int r = 0; r < 16; ++r) s[r] += tr_[r];
            if (D == 0 || D == 4) mask_band(s, delta0, 128);
            softmax_sub(w, s, m, lsum, o);
            pv_sub(w, buf, sub, s, o);
        }
        if (st + 1 < nsteps) stage_write(sg, w, buf ^ 1);
        __syncthreads();
    }
    const float l = lsum + __shfl_xor(lsum, 32);
    scale_rows(w, o, 1.0f / l);
    const size_t tok0 = rowbase + res + (size_t)(Q0 + 32 * w.wid) * dil;
    store_o(w, o, [&](int r) { return PO + (tok0 + (size_t)r * dil) * DM + (h - 8) * HD; });
    if (w.hi == 0) LSE[(tok0 + (size_t)w.r32 * dil) * 8 + (h - 8)] = m + __builtin_amdgcn_logf(l);
}

template <bool DO_MOBA, bool DO_DIL, bool DO_SB>
__device__ __forceinline__ void attn_phase(LAS unsigned char* lds, const bf16_t* QB, const bf16_t* KB, const bf16_t* VB, const float* KMEAN, bf16_t* OB, bf16_t* HB2, float* LSE, int v, int G, int tid) {
    if (DO_MOBA) for (int u = v; u < 256; u += G) { const int bh = u >> 4, p = u & 15;
        moba_unit(lds, QB, KB, VB, KMEAN, OB, bh >> 2, bh & 3, 31 - p, tid);
        moba_unit(lds, QB, KB, VB, KMEAN, OB, bh >> 2, bh & 3, p, tid); }
    if (DO_DIL) for (int u = v; u < 3072; u += G) { const int n = u & 31, bhc = u >> 5, c = bhc % 3, bh = bhc / 3, b = bh >> 3, h = 8 + (bh & 7);
        const int dil = (c == 0) ? 1 : (c == 1) ? 4 : 16, res = (c == 0) ? 0 : (c == 1) ? (n >> 3) : (n >> 1), i2 = (c == 0) ? n : (c == 1) ? (n & 7) : (n & 1);
        bf16_t* PO = (c == 0) ? OB + 512 : HB2 + (c - 1) * 512;
        dil_unit(lds, QB, KB, VB, PO, LSE + (size_t)c * T * 8, b, h, dil, res, i2, tid); }
    if (DO_SB) for (int u = v; u < 512; u += G) { const int qt = u & 31, bh = u >> 5; sb_unit(lds, QB, KB, VB, OB, bh >> 2, 4 + (bh & 3), qt, tid); }
}
}

constexpr int PH_PRO = 0, PH_L0 = 1, PH_PER_LAYER = 9, PH_FINAL = PH_L0 + DEPTH * PH_PER_LAYER, PH_COUNT = PH_FINAL + 1;
typedef const __attribute__((address_space(4))) Args* KArgP;
#define KARG() ({ KArgP p_ = (KArgP)__builtin_amdgcn_kernarg_segment_ptr(); asm volatile("" : "+s"(p_)); p_; })
#define PHASE_IDS int lane_p = lane, tid_p = tid, gw_p = gw; LAUNDER_V(lane_p); LAUNDER_V(tid_p); LAUNDER_S(gw_p)
__global__ void __launch_bounds__(NTHREADS, 2) fwd(Args a_unused) {
    extern __shared__ __attribute__((aligned(16))) unsigned char lds_raw[];
    LAS unsigned char* lds = (LAS unsigned char*)lds_raw;
    volatile LAS unsigned* MISC = (volatile LAS unsigned*)(lds + MISC_OFF);
    const int tid = threadIdx.x, lane = tid & 63, wave = __builtin_amdgcn_readfirstlane(tid >> 6);
    const int G = gridDim.x, bx = blockIdx.x;
    const int vcu = (G % 8 == 0) ? (bx % 8) * (G / 8) + bx / 8 : bx;
    const int gw = vcu * NWAVES + wave, NGW = G * NWAVES;
    for (int u = tid; u < (LDS_BYTES - LDSCTL_OFF) / 4; u += NTHREADS) ((LAS unsigned*)(lds + LDSCTL_OFF))[u] = 0u;
    __syncthreads();
    int lo, hi; XcdBarrier bar;
    { KArgP ka = KARG(); lo = ka->ph_lo; hi = ka->ph_hi; unsigned* ctl = (unsigned*)(ka->ws + WS_CTL); bar = xcd_barrier_post(ctl + CW_BAR + ka->li * XCD_BAR_WORDS, MISC + 8); }
#define IN(k) (lo <= (k) && (k) < hi)
#define SEAM(k) do { if (IN(k) && IN((k) + 1)) xcd_barrier(bar); } while (0)
#define WSP(T_, off) ((T_*)(ws + (off)))

    if (IN(PH_PRO)) { KArgP ka = KARG(); PHASE_IDS; Args a; a.ws = ka->ws; a.w_in = ka->w_in; a.w_out = ka->w_out; a.w_gate = ka->w_gate; a.w_up = ka->w_up; a.w_down = ka->w_down; phase_prologue(a, lds, gw_p, NGW, wave, lane_p); } SEAM(PH_PRO);

    for (int l = 0; l < DEPTH; ++l) {
        const int p0 = PH_L0 + l * PH_PER_LAYER;
        if (hi <= p0 || lo >= p0 + PH_PER_LAYER) continue;
        if (IN(p0 + 0)) { KArgP ka = KARG(); PHASE_IDS; unsigned char* ws = ka->ws; const float* xin = (l == 0) ? ka->x : ka->out;
            phase_norm1(xin, ka->ln1_g + (size_t)l * DM, WSP(bf16_t, WS_HB), gw_p, NGW, lane_p); } SEAM(p0 + 0);
        if (IN(p0 + 1)) { KArgP ka = KARG(); PHASE_IDS; unsigned char* ws = ka->ws;
            pg8::Gemm g{(const char*)(ws + WS_HB), (const char*)(ws + WS_WIN) + (size_t)l * NQKV * DM * 2, DM, DM, DM, (long)256 * DM * 2, (long)256 * DM * 2, (long)128 * DM * 2};
            pg8::StaticOrder S; S.init(T / 256, NQKV / 256, G, bx);
            pg8::EpiQKV E{WSP(bf16_t, WS_Q), (size_t)(WS_K - WS_Q) / 2, QSCALE};
            pg8::gemm_phase<pg8::EpiQKV, pg8::StaticOrder>(lds, g, S, E);
        } SEAM(p0 + 1);
        if (IN(p0 + 2)) { KArgP ka = KARG(); PHASE_IDS; unsigned char* ws = ka->ws; phase_kmean(WSP(bf16_t, WS_K), WSP(float, WS_KMEAN), gw_p, NGW, lane_p); } SEAM(p0 + 2);
        if (IN(p0 + 3)) { KArgP ka = KARG(); PHASE_IDS; unsigned char* ws = ka->ws;
            const bf16_t* QB = WSP(bf16_t, WS_Q); const bf16_t* KB = WSP(bf16_t, WS_K); const bf16_t* VB = WSP(bf16_t, WS_V); bf16_t* OB = WSP(bf16_t, WS_O);
            att::attn_phase<ATT_MOBA != 0, ATT_DIL != 0, ATT_SB != 0>(lds, QB, KB, VB, WSP(float, WS_KMEAN), OB, WSP(bf16_t, WS_HB), WSP(float, WS_LSE), vcu, G, tid_p);
#if !ATT_MOBA
            for (int it = vcu; it < 256; it += G) naive_moba(QB, KB, VB, WSP(float, WS_KMEAN), OB, it, tid_p);
#endif
#if !ATT_SB
            for (int it = vcu; it < 256; it += G) naive_sb(QB, KB, VB, OB, it, tid_p);
#endif
#if !ATT_DIL
            for (int it = vcu; it < 512; it += G) naive_dil(QB, KB, VB, OB, WSP(bf16_t, WS_HB), WSP(float, WS_LSE), it, tid_p);
#endif
        } SEAM(p0 + 3);
        if (IN(p0 + 4)) { KArgP ka = KARG(); PHASE_IDS; unsigned char* ws = ka->ws; phase_mixnorm(WSP(bf16_t, WS_O), WSP(bf16_t, WS_HB), WSP(float, WS_LSE), ka->mix_g + (size_t)l * DM, gw_p, NGW, lane_p); } SEAM(p0 + 4);
        if (IN(p0 + 5)) { KArgP ka = KARG(); PHASE_IDS; unsigned char* ws = ka->ws; const float* xin = (l == 0) ? ka->x : ka->out;
            pg8::Gemm g{(const char*)(ws + WS_HB), (const char*)(ws + WS_WOUT) + (size_t)l * DM * DM * 2, DM, DM, DM, (long)256 * DM * 2, (long)256 * DM * 2, (long)128 * DM * 2};
            pg8::StaticOrder S; S.init(T / 256, DM / 256, G, bx);
            pg8::EpiResAdd E{xin, ka->out};
            pg8::gemm_phase<pg8::EpiResAdd, pg8::StaticOrder>(lds, g, S, E);
        } SEAM(p0 + 5);
        if (IN(p0 + 6)) { KArgP ka = KARG(); PHASE_IDS; unsigned char* ws = ka->ws;
            phase_route(ka->out, ka->ln2_g + (size_t)l * DM, ka->w_gr + (size_t)l * DM * 4, ka->b_gr + l * 4, ka->w_er + (size_t)l * 4 * DM * 4, ka->b_er + l * 16, WSP(bf16_t, WS_HB), WSP(float, WS_COMB), gw_p, NGW, lane_p); } SEAM(p0 + 6);
        if (IN(p0 + 7)) { KArgP ka = KARG(); PHASE_IDS; unsigned char* ws = ka->ws;
            pg8::Gemm g{(const char*)(ws + WS_HB), (const char*)(ws + WS_WG) + (size_t)l * NACT * DM * 2, DM, DM, DM, (long)256 * DM * 2, (long)128 * DM * 2, (long)(WS_WU - WS_WG)};
            pg8::StaticOrder S; S.init(T / 256, 2 * NEXP, G, bx);
            pg8::EpiGateUpDense E{WSP(bf16_t, WS_ACT), WSP(float, WS_COMB)};
            pg8::gemm_phase<pg8::EpiGateUpDense, pg8::StaticOrder>(lds, g, S, E);
        } SEAM(p0 + 7);
        if (IN(p0 + 8)) { KArgP ka = KARG(); PHASE_IDS; unsigned char* ws = ka->ws;
            pg8::Gemm g{(const char*)(ws + WS_ACT), (const char*)(ws + WS_WD) + (size_t)l * DM * NACT * 2, NACT, NACT, NACT, (long)256 * NACT * 2, (long)256 * NACT * 2, (long)128 * NACT * 2};
            pg8::StaticOrder S; S.init(T / 256, DM / 256, G, bx);
            pg8::EpiResAdd E{ka->out, ka->out};
            pg8::gemm_phase<pg8::EpiResAdd, pg8::StaticOrder>(lds, g, S, E);
        } SEAM(p0 + 8);
    }
    if (IN(PH_FINAL)) { KArgP ka = KARG(); PHASE_IDS; phase_final(ka->out, ka->fin_g, gw_p, NGW, lane_p); }
#undef IN
#undef SEAM
#undef WSP
}

#ifndef N_LAUNCH_MODE
#define N_LAUNCH_MODE 1
#endif
extern "C" void kernel_launch(void* const* d_in, const int* in_sizes, int n_in, void* d_out, int out_size, void* d_ws, size_t ws_size, hipStream_t stream) {
    static int grid = 0;
    if (grid == 0) {
        if (n_in != 14 || in_sizes[0] != T * DM || out_size != T * DM || ws_size < WS_END) { fprintf(stderr, "kernel_launch: unexpected shapes (n_in %d in0 %d out %d ws %zu)\n", n_in, n_in > 0 ? in_sizes[0] : -1, out_size, ws_size); grid = -1; return; }
        int dev = 0, cus = 0, per_cu = 0;
        if (hipGetDevice(&dev) != hipSuccess || hipDeviceGetAttribute(&cus, hipDeviceAttributeMultiprocessorCount, dev) != hipSuccess) { grid = -1; return; }
        if (hipFuncSetAttribute((const void*)fwd, hipFuncAttributeMaxDynamicSharedMemorySize, LDS_BYTES) != hipSuccess) { fprintf(stderr, "kernel_launch: hipFuncSetAttribute failed\n"); grid = -1; return; }
        if (hipOccupancyMaxActiveBlocksPerMultiprocessor(&per_cu, (const void*)fwd, NTHREADS, LDS_BYTES) != hipSuccess || per_cu < 1) fprintf(stderr, "kernel_launch: occupancy query says %d\n", per_cu);
        (void)hipGetLastError();
        grid = cus;
    }
    if (grid < 0) return;
    if (hipMemsetAsync((char*)d_ws + WS_CTL, 0, CTL_ZERO_BYTES, stream) != hipSuccess) return;
    Args a{};
    a.x = (const float*)d_in[0]; a.ln1_g = (const float*)d_in[1]; a.w_in = (const float*)d_in[2]; a.mix_g = (const float*)d_in[3]; a.w_out = (const float*)d_in[4]; a.ln2_g = (const float*)d_in[5];
    a.w_gr = (const float*)d_in[6]; a.b_gr = (const float*)d_in[7]; a.w_er = (const float*)d_in[8]; a.b_er = (const float*)d_in[9]; a.w_gate = (const float*)d_in[10]; a.w_up = (const float*)d_in[11];
    a.w_down = (const float*)d_in[12]; a.fin_g = (const float*)d_in[13];
    a.out = (float*)d_out; a.ws = (unsigned char*)d_ws; a.pad = 0;
#if N_LAUNCH_MODE == 1
    a.ph_lo = 0; a.ph_hi = PH_COUNT; a.li = 0;
    hipLaunchKernelGGL(fwd, dim3(grid), dim3(NTHREADS), LDS_BYTES, stream, a);
#else
    for (int p = 0; p < PH_COUNT; ++p) { a.ph_lo = p; a.ph_hi = p + 1; a.li = p; hipLaunchKernelGGL(fwd, dim3(grid), dim3(NTHREADS), LDS_BYTES, stream, a); }
#endif
}
```

```cpp
#include <hip/hip_runtime.h>
#include <cstdio>
#include <cstdint>

#define LAS __attribute__((address_space(3)))
#define GAS __attribute__((address_space(1)))
typedef unsigned short bf16_t;
typedef short bf16x8 __attribute__((ext_vector_type(8)));
typedef float f32x4 __attribute__((ext_vector_type(4)));
typedef float f32x2 __attribute__((ext_vector_type(2)));
typedef unsigned u32x4 __attribute__((ext_vector_type(4)));
typedef unsigned u32x2 __attribute__((ext_vector_type(2)));

#ifndef MOE_SPARSE
#define MOE_SPARSE 1
#endif
#ifndef ATT_MOBA
#define ATT_MOBA 1
#endif
#ifndef ATT_SB
#define ATT_SB 1
#endif
#ifndef ATT_DIL
#define ATT_DIL 1
#endif
constexpr int BATCH = 4, SEQ = 8192, DM = 1024, DEPTH = 4, T = BATCH * SEQ, NH = 16, HD = 64;
constexpr int NQKV = 3 * DM, NEXP = 16, DEXP = 256, NACT = NEXP * DEXP;
constexpr float NORM_EPS = 1e-6f;
constexpr float LOG2E = 1.4426950408889634f;
constexpr float QSCALE = 0.125f * LOG2E;
constexpr int NWAVES = 8, NTHREADS = 512;

constexpr size_t MiB = 1u << 20;
constexpr size_t WS_CTL = 0, CTL_ZERO_BYTES = 1 * MiB;
constexpr size_t WS_WIN = 2 * MiB;
constexpr size_t WS_WOUT = 26 * MiB;
constexpr size_t WS_WG = 34 * MiB;
constexpr size_t WS_WU = 66 * MiB;
constexpr size_t WS_WD = 98 * MiB;
constexpr size_t WS_KMEAN = 130 * MiB;
constexpr size_t WS_COMB = 131 * MiB;
constexpr size_t WS_HB = 134 * MiB;
constexpr size_t WS_Q = 198 * MiB, WS_K = 262 * MiB, WS_V = 326 * MiB, WS_O = 390 * MiB;
constexpr size_t WS_ACT = WS_Q;
constexpr size_t WS_LSE = 454 * MiB;
constexpr size_t WS_LIST = 458 * MiB;
constexpr size_t WS_WLIST = 461 * MiB;
constexpr size_t WS_END = 467 * MiB;
constexpr int CW_CNT = 1024;
constexpr int CW_BAR = 4096;

constexpr int RING_BYTES = 131072;
constexpr int LDSCTL_OFF = RING_BYTES, MISC_OFF = LDSCTL_OFF + 320;
constexpr int LDS_BYTES = 147456;

__device__ __forceinline__ unsigned f2bf(float f) { unsigned u = __builtin_bit_cast(unsigned, f); return (u + 0x7fffu + ((u >> 16) & 1u)) >> 16; }
__device__ __forceinline__ unsigned pk2(float lo, float hi) { return f2bf(lo) | (f2bf(hi) << 16); }
__device__ __forceinline__ float bflo(unsigned w) { return __builtin_bit_cast(float, w << 16); }
__device__ __forceinline__ float bfhi(unsigned w) { return __builtin_bit_cast(float, w & 0xffff0000u); }
template <int M> __device__ __forceinline__ float swz_xor(float v) { return __builtin_bit_cast(float, __builtin_amdgcn_ds_swizzle(__builtin_bit_cast(int, v), 0x1f | (M << 10))); }
__device__ __forceinline__ void swap32(unsigned x, unsigned& lo_val, unsigned& hi_val) { unsigned y = x; asm volatile("" : "+v"(y)); auto rr = __builtin_amdgcn_permlane32_swap(x, y, false, false); lo_val = rr[0]; hi_val = rr[1]; }
__device__ __forceinline__ float sum_xor32(float v) { unsigned a, b; swap32(__builtin_bit_cast(unsigned, v), a, b); return __builtin_bit_cast(float, a) + __builtin_bit_cast(float, b); }
__device__ __forceinline__ float max_xor32(float v) { unsigned a, b; swap32(__builtin_bit_cast(unsigned, v), a, b); return fmaxf(__builtin_bit_cast(float, a), __builtin_bit_cast(float, b)); }
__device__ __forceinline__ float get_xor32(float v, int hi) { unsigned a, b; swap32(__builtin_bit_cast(unsigned, v), a, b); return __builtin_bit_cast(float, hi ? a : b); }
__device__ __forceinline__ int get_xor32i(int v, int hi) { unsigned a, b; swap32((unsigned)v, a, b); return (int)(hi ? a : b); }
__device__ __forceinline__ float half_sum(float v) {
    v += swz_xor<1>(v); v += swz_xor<2>(v); v += swz_xor<4>(v); v += swz_xor<8>(v); v += swz_xor<16>(v);
    return v;
}
__device__ __forceinline__ float wave_sum(float v) { return sum_xor32(half_sum(v)); }
#define LDS_WAIT() asm volatile("s_waitcnt lgkmcnt(0)" ::: "memory")
#define LAUNDER_V(x) asm volatile("" : "+v"(x))
#define LAUNDER_S(x) asm volatile("" : "+s"(x))

namespace pg8 {
constexpr int BM = 256, BK = 64, HALF = 128, HTB = HALF * BK * 2, STAGE_BYTES = 8 * HTB, NXCD = 8, WGM = 8;
__host__ __device__ __forceinline__ int lds_byte(int r, int c) { const int st = (r >> 4) * 2 + (c >> 5), rr = r & 15, cc = c & 31, ob = rr * 64 + cc * 2; return st * 1024 + (ob ^ (((ob >> 9) & 1) << 5)); }
__host__ __device__ __forceinline__ void stage_rc(int b, int& R, int& C) { const int st = b / 1024, sb = b % 1024, swz = sb ^ (((sb >> 9) & 1) << 5); R = (st >> 1) * 16 + swz / 64; C = (st & 1) * 32 + (swz % 64) / 2; }
__host__ __device__ __forceinline__ int perm32(int rho) { const int n = rho >> 4, i = rho & 15; return 8 * (i >> 2) + 4 * n + (i & 3); }

struct Unit { int pm, pn, meta;
    __device__ __forceinline__ int bk() const { return meta & 31; } __device__ __forceinline__ int tib() const { return (meta >> 5) & 255; } __device__ __forceinline__ int nb() const { return meta >> 13; } };
struct Gemm { const char* A; const char* B; int lda, ldb, K; long tstepA, tstepB, hstepB; };

struct StaticOrder {
    int nM, nN, nwg, G, c;
    __host__ __device__ void init(int nM_, int nN_, int G_, int c_) { nM = nM_; nN = nN_; nwg = nM * nN; G = G_; c = c_; }
    __host__ __device__ bool next(int i, Unit& u) const {
        const long L = (long)i * G + c; if (L >= nwg) return false;
        int wgid = (int)L; { const int q = nwg / NXCD, r = nwg % NXCD, xcd = wgid % NXCD, off = wgid / NXCD; wgid = (xcd < r ? xcd * (q + 1) : r * (q + 1) + (xcd - r) * q) + off; }
        const int nig = WGM * nN, gid = wgid / nig, fm = gid * WGM, gsz = (nM - fm) < WGM ? (nM - fm) : WGM;
        u.pm = fm + ((wgid % nig) % gsz); u.pn = (wgid % nig) / gsz; return true;
    }
};

__device__ __forceinline__ unsigned cvt_pk_bf16(float lo, float hi) { unsigned r; asm volatile("v_cvt_pk_bf16_f32 %0, %1, %2" : "=v"(r) : "v"(lo), "v"(hi)); return r; }

struct EpiQKV {
    static constexpr bool PERM = true;
    bf16_t* O; size_t split_stride; float scale0;
    __device__ __forceinline__ void operator()(const f32x4 (&acc)[2][2][4][2], const Unit& u, int wr, int wc, int fr, int fq) const {
        asm volatile("" : "+v"(fr), "+v"(fq));
        const int row0 = u.pm * BM + wr * 64 + fr; int colt = u.pn * BM;
        const int t = colt / DM; bf16_t* base = O + (size_t)t * split_stride; colt -= t * DM; const float sc = (t == 0) ? scale0 : 1.f;
        const int col0 = colt + wc * 32 + 8 * fq;
#pragma unroll
        for (int ai = 0; ai < 2; ++ai)
#pragma unroll
            for (int m = 0; m < 4; ++m) { bf16_t* rowp = base + (size_t)(row0 + ai * HALF + m * 16) * DM + col0;
#pragma unroll
                for (int bj = 0; bj < 2; ++bj) { f32x4 v0 = acc[ai][bj][m][0] * sc, v1 = acc[ai][bj][m][1] * sc;
                    u32x4 w; w.x = cvt_pk_bf16(v0[0], v0[1]); w.y = cvt_pk_bf16(v0[2], v0[3]); w.z = cvt_pk_bf16(v1[0], v1[1]); w.w = cvt_pk_bf16(v1[2], v1[3]);
                    *(u32x4*)(rowp + bj * HALF) = w; } }
    }
};
struct EpiResAdd {
    static constexpr bool PERM = false;
    const float* base; float* out;
    __device__ __forceinline__ void operator()(const f32x4 (&acc)[2][2][4][2], const Unit& u, int wr, int wc, int fr, int fq) const {
        asm volatile("" : "+v"(fr), "+v"(fq));
        const int col0 = u.pn * BM + wc * 32 + 4 * fq;
#pragma unroll
        for (int ai = 0; ai < 2; ++ai)
#pragma unroll
            for (int m = 0; m < 4; ++m) { const size_t off = (size_t)(u.pm * BM + ai * HALF + wr * 64 + m * 16 + fr) * DM + col0;
#pragma unroll
                for (int bj = 0; bj < 2; ++bj)
#pragma unroll
                    for (int n = 0; n < 2; ++n) { const f32x4 bs = *(const f32x4*)(base + off + bj * HALF + n * 16); *(f32x4*)(out + off + bj * HALF + n * 16) = bs + acc[ai][bj][m][n]; } }
    }
};
struct EpiGateUpDense {
    static constexpr bool PERM = true;
    bf16_t* act; const float* comb;
    __device__ __forceinline__ void operator()(const f32x4 (&acc)[2][2][4][2], const Unit& u, int wr, int wc, int fr, int fq) const {
        asm volatile("" : "+v"(fr), "+v"(fq));
        const int e = u.pn >> 1, c0 = (u.pn & 1) * HALF;
        const int col0 = e * DEXP + c0 + wc * 32 + 8 * fq;
#pragma unroll
        for (int ai = 0; ai < 2; ++ai)
#pragma unroll
            for (int m = 0; m < 4; ++m) { const int row = u.pm * BM + ai * HALF + wr * 64 + m * 16 + fr;
                const float cw = comb[(size_t)row * NEXP + e];
                float o[8];
#pragma unroll
                for (int n = 0; n < 2; ++n)
#pragma unroll
                    for (int j = 0; j < 4; ++j) { const float g = acc[ai][0][m][n][j], up = acc[ai][1][m][n][j];
                        const float sg = g * __builtin_amdgcn_rcpf(1.f + __builtin_amdgcn_exp2f(-g * LOG2E));
                        o[n * 4 + j] = sg * up * cw; }
                u32x4 w; w.x = cvt_pk_bf16(o[0], o[1]); w.y = cvt_pk_bf16(o[2], o[3]); w.z = cvt_pk_bf16(o[4], o[5]); w.w = cvt_pk_bf16(o[6], o[7]);
                *(u32x4*)(act + (size_t)row * NACT + col0) = w; }
    }
};

template <class Epi, class Sched>
__device__ __forceinline__ void gemm_phase(LAS unsigned char* lds, const Gemm g, const Sched& S, const Epi& E, int wave_id) {
    int lane_l = (int)__builtin_amdgcn_mbcnt_hi(~0u, __builtin_amdgcn_mbcnt_lo(~0u, 0u)); asm volatile("" : "+v"(lane_l));
    const int wid = wave_id, lane = lane_l, tid = wid * 64 + lane, wr = wid >> 2, wc = wid & 3, fr = lane & 15, fq = lane >> 4;
    const int K = g.K, nt = K / BK;
    unsigned voffA[2], voffB[2];
#pragma unroll
    for (int i = 0; i < 2; ++i) { int R, C; stage_rc(tid * 16 + i * 8192, R, C); const int Rb = Epi::PERM ? ((R & ~31) + perm32(R & 31)) : R;
        voffA[i] = (unsigned)(R * g.lda + C) * 2u; voffB[i] = (unsigned)(Rb * g.ldb + C) * 2u; }
    const size_t kstep = (size_t)(BK * 2);
    const size_t hstepA = (size_t)HALF * g.lda * 2;
    const long hstepB = g.hstepB;
    const unsigned ldsw = (unsigned)wid * 1024u;
    const int aoff = lds_byte(wr * 64 + fr, fq * 8), boff = lds_byte(wc * 32 + fr, fq * 8);
#define PG8_SA(b, h) (((b) * 2 + (h)) * HTB)
#define PG8_SB(b, h) ((4 + (b) * 2 + (h)) * HTB)
#define PG8_STAGE(bufoff, gbase, voff) do { _Pragma("unroll") for (int _i = 0; _i < 2; ++_i) \
        __builtin_amdgcn_global_load_lds((const unsigned*)((const char*)(gbase) + (voff)[_i]), (LAS unsigned*)(lds + (bufoff) + ldsw + _i * 8192), 16, 0, 0); } while (0)
#define PG8_LDA(dst, b, h) do { _Pragma("unroll") for (int m = 0; m < 4; ++m) _Pragma("unroll") for (int k = 0; k < 2; ++k) dst[m][k] = *(const LAS bf16x8*)(lds + PG8_SA(b, h) + aoff + m * 2048 + k * 1024); } while (0)
#define PG8_LDB(dst, b, h) do { _Pragma("unroll") for (int n = 0; n < 2; ++n) _Pragma("unroll") for (int k = 0; k < 2; ++k) dst[n][k] = *(const LAS bf16x8*)(lds + PG8_SB(b, h) + boff + n * 2048 + k * 1024); } while (0)
#define PG8_MMA(ai, bj, At, Bt) do { __builtin_amdgcn_s_setprio(1); _Pragma("unroll") for (int m = 0; m < 4; ++m) _Pragma("unroll") for (int n = 0; n < 2; ++n) _Pragma("unroll") for (int k = 0; k < 2; ++k) \
        acc[ai][bj][m][n] = __builtin_amdgcn_mfma_f32_16x16x32_bf16(Bt[n][k], At[m][k], acc[ai][bj][m][n], 0, 0, 0); __builtin_amdgcn_s_setprio(0); } while (0)
#define PG8_WAIT_V(n) asm volatile("s_waitcnt vmcnt(" #n ")" ::: "memory")
#define PG8_WAIT_L(n) asm volatile("s_waitcnt lgkmcnt(" #n ")" ::: "memory")
#define PG8_BAR __builtin_amdgcn_s_barrier()
#define PG8_SCHED __builtin_amdgcn_sched_barrier(0)
    Unit cur, nxt; int ui = 0;
    if (!S.next(0, cur)) return;
    f32x4 acc[2][2][4][2];
#pragma unroll
    for (int a = 0; a < 2; ++a)
#pragma unroll
        for (int b = 0; b < 2; ++b)
#pragma unroll
            for (int m = 0; m < 4; ++m)
#pragma unroll
                for (int n = 0; n < 2; ++n) acc[a][b][m][n] = (f32x4){0.f, 0.f, 0.f, 0.f};
    bf16x8 At[4][2], B0[2][2], B1[2][2];
    const char* cA = g.A + (size_t)cur.pm * g.tstepA; const char* cB = g.B + (size_t)cur.pn * g.tstepB;
    PG8_STAGE(PG8_SB(0, 0), cB, voffB); PG8_STAGE(PG8_SB(0, 1), cB + hstepB, voffB); PG8_STAGE(PG8_SA(0, 0), cA, voffA); PG8_STAGE(PG8_SA(0, 1), cA + hstepA, voffA);
    if (wr == 1) PG8_BAR;
    PG8_WAIT_V(2); PG8_BAR;
    PG8_STAGE(PG8_SB(1, 0), cB + kstep, voffB); PG8_STAGE(PG8_SA(1, 0), cA + kstep, voffA); PG8_STAGE(PG8_SB(1, 1), cB + hstepB + kstep, voffB);
    PG8_WAIT_V(6); PG8_BAR;
    for (;;) {
        const bool has_next = S.next(ui + 1, nxt);
        const char* nA = has_next ? g.A + (size_t)nxt.pm * g.tstepA : cA; const char* nB = has_next ? g.B + (size_t)nxt.pn * g.tstepB : cB;
        for (int t = 0; t < nt; t += 2) {
            const bool last = (t == nt - 2);
            const char* a1 = cA + (size_t)(t + 1) * kstep;
            const char* a2 = last ? nA : cA + (size_t)(t + 2) * kstep; const char* b2 = last ? nB : cB + (size_t)(t + 2) * kstep;
            const char* a3 = a2 + kstep; const char* b3 = b2 + kstep;
            PG8_LDB(B0, 0, 0); PG8_LDB(B1, 0, 1); PG8_SCHED; PG8_LDA(At, 0, 0); PG8_STAGE(PG8_SA(1, 1), a1 + hstepA, voffA);
            PG8_WAIT_V(8); PG8_WAIT_L(0); PG8_BAR; PG8_MMA(0, 0, At, B0); PG8_MMA(0, 1, At, B1); PG8_BAR; PG8_SCHED;
            PG8_LDA(At, 0, 1); PG8_STAGE(PG8_SB(0, 0), b2, voffB); PG8_STAGE(PG8_SB(0, 1), b2 + hstepB, voffB); PG8_STAGE(PG8_SA(0, 0), a2, voffA);
            PG8_WAIT_V(8); PG8_WAIT_L(0); PG8_BAR; PG8_MMA(1, 0, At, B0); PG8_MMA(1, 1, At, B1); PG8_BAR; PG8_SCHED;
            PG8_LDB(B0, 1, 0); PG8_LDB(B1, 1, 1); PG8_SCHED; PG8_LDA(At, 1, 0); PG8_STAGE(PG8_SA(0, 1), a2 + hstepA, voffA);
            PG8_WAIT_V(8); PG8_WAIT_L(0); PG8_BAR; PG8_MMA(0, 0, At, B0); PG8_MMA(0, 1, At, B1); PG8_BAR; PG8_SCHED;
            PG8_LDA(At, 1, 1); PG8_STAGE(PG8_SB(1, 0), b3, voffB); PG8_STAGE(PG8_SB(1, 1), b3 + hstepB, voffB); PG8_STAGE(PG8_SA(1, 0), a3, voffA);
            PG8_WAIT_V(8); PG8_WAIT_L(0); PG8_BAR; PG8_MMA(1, 0, At, B0); PG8_MMA(1, 1, At, B1); PG8_BAR; PG8_SCHED;
        }
        if (wr == 0) PG8_BAR;
        E(acc, cur, wr, wc, fr, fq);
        if (!has_next) break;
#pragma unroll
        for (int a = 0; a < 2; ++a)
#pragma unroll
            for (int b = 0; b < 2; ++b)
#pragma unroll
                for (int m = 0; m < 4; ++m)
#pragma unroll
                    for (int n = 0; n < 2; ++n) acc[a][b][m][n] = (f32x4){0.f, 0.f, 0.f, 0.f};
        cur = nxt; cA = nA; cB = nB; ++ui;
        if (wr == 1) PG8_BAR;
    }
    PG8_WAIT_V(0);
    PG8_BAR;
#undef PG8_SA
#undef PG8_SB
#undef PG8_STAGE
#undef PG8_LDA
#undef PG8_LDB
#undef PG8_MMA
#undef PG8_WAIT_V
#undef PG8_WAIT_L
#undef PG8_BAR
#undef PG8_SCHED
}
template <class Epi, class Prob>
__device__ __forceinline__ void gemm_phase_x(LAS unsigned char* lds, const Prob& P, const Epi& E, int wave_id) {
    int lane_l = (int)__builtin_amdgcn_mbcnt_hi(~0u, __builtin_amdgcn_mbcnt_lo(~0u, 0u)); asm volatile("" : "+v"(lane_l));
    const int wid = wave_id, lane = lane_l, tid = wid * 64 + lane, wr = wid >> 2, wc = wid & 3, fr = lane & 15, fq = lane >> 4;
    const int K = P.K, nt = K / BK;
    unsigned voffB[2];
#pragma unroll
    for (int i = 0; i < 2; ++i) { int R, C; stage_rc(tid * 16 + i * 8192, R, C); const int Rb = Epi::PERM ? ((R & ~31) + perm32(R & 31)) : R; voffB[i] = (unsigned)(Rb * P.ldb + C) * 2u; }
    const size_t kstep = (size_t)(BK * 2);
    const long hstepB = P.hstepB;
    const unsigned ldsw = (unsigned)wid * 1024u;
    const int aoff = lds_byte(wr * 64 + fr, fq * 8), boff = lds_byte(wc * 32 + fr, fq * 8);
    LAS u32x4* stash = (LAS u32x4*)(lds + STAGE_BYTES + 1024) + tid;
#define PG8_SA(b, h) (((b) * 2 + (h)) * HTB)
#define PG8_SB(b, h) ((4 + (b) * 2 + (h)) * HTB)
#define PG8_STAGE(bufoff, gbase, voff) do { _Pragma("unroll") for (int _i = 0; _i < 2; ++_i) \
        __builtin_amdgcn_global_load_lds((const unsigned*)((const char*)(gbase) + (voff)[_i]), (LAS unsigned*)(lds + (bufoff) + ldsw + _i * 8192), 16, 0, 0); } while (0)
#define PG8_LDA(dst, b, h) do { _Pragma("unroll") for (int m = 0; m < 4; ++m) _Pragma("unroll") for (int k = 0; k < 2; ++k) dst[m][k] = *(const LAS bf16x8*)(lds + PG8_SA(b, h) + aoff + m * 2048 + k * 1024); } while (0)
#define PG8_LDB(dst, b, h) do { _Pragma("unroll") for (int n = 0; n < 2; ++n) _Pragma("unroll") for (int k = 0; k < 2; ++k) dst[n][k] = *(const LAS bf16x8*)(lds + PG8_SB(b, h) + boff + n * 2048 + k * 1024); } while (0)
#define PG8_MMA(ai, bj, At, Bt) do { __builtin_amdgcn_s_setprio(1); _Pragma("unroll") for (int m = 0; m < 4; ++m) _Pragma("unroll") for (int n = 0; n < 2; ++n) _Pragma("unroll") for (int k = 0; k < 2; ++k) \
        acc[ai][bj][m][n] = __builtin_amdgcn_mfma_f32_16x16x32_bf16(Bt[n][k], At[m][k], acc[ai][bj][m][n], 0, 0, 0); __builtin_amdgcn_s_setprio(0); } while (0)
#define PG8_WAIT_V(n) asm volatile("s_waitcnt vmcnt(" #n ")" ::: "memory")
#define PG8_WAIT_L(n) asm volatile("s_waitcnt lgkmcnt(" #n ")" ::: "memory")
#define PG8_BAR __builtin_amdgcn_s_barrier()
#define PG8_SCHED __builtin_amdgcn_sched_barrier(0)
#define PG8_AVOFF(dst, u) do { int t2_ = tid; asm volatile("" : "+v"(t2_)); _Pragma("unroll") for (int i_ = 0; i_ < 2; ++i_) { int R_, C_; stage_rc(t2_ * 16 + i_ * 8192, R_, C_); _Pragma("unroll") for (int h_ = 0; h_ < 2; ++h_) \
        dst[h_][i_] = (Prob::GATHER ? P.arow_off(u, h_, R_) : (unsigned)((h_ * HALF + R_) * P.lda) * 2u) + (unsigned)C_ * 2u; } } while (0)
    Unit cur, nxt; int ui = 0;
    if (!P.next(0, cur)) return;
    unsigned vA[2][2];
    PG8_AVOFF(vA, cur);
    f32x4 acc[2][2][4][2];
#pragma unroll
    for (int a = 0; a < 2; ++a)
#pragma unroll
        for (int b = 0; b < 2; ++b)
#pragma unroll
            for (int m = 0; m < 4; ++m)
#pragma unroll
                for (int n = 0; n < 2; ++n) acc[a][b][m][n] = (f32x4){0.f, 0.f, 0.f, 0.f};
    bf16x8 At[4][2], B0[2][2], B1[2][2];
    const char* cA = P.a_base(cur); const char* cB = P.b_base(cur);
    long csplit = Prob::KSPLIT ? P.bsplit(cur) : 0;
    PG8_STAGE(PG8_SB(0, 0), cB, voffB); PG8_STAGE(PG8_SB(0, 1), cB + hstepB, voffB); PG8_STAGE(PG8_SA(0, 0), cA, vA[0]); PG8_STAGE(PG8_SA(0, 1), cA, vA[1]);
    if (wr == 1) PG8_BAR;
    PG8_WAIT_V(2); PG8_BAR;
    PG8_STAGE(PG8_SB(1, 0), cB + kstep, voffB); PG8_STAGE(PG8_SA(1, 0), cA + kstep, vA[0]); PG8_STAGE(PG8_SB(1, 1), cB + hstepB + kstep, voffB);
    PG8_WAIT_V(6); PG8_BAR;
    for (;;) {
        const bool has_next = P.next(ui + 1, nxt);
        const char* nA = has_next ? P.a_base(nxt) : cA; const char* nB = has_next ? P.b_base(nxt) : cB;
        if (Prob::GATHER) { unsigned vN[2][2];
            if (has_next) { PG8_AVOFF(vN, nxt); } else { vN[0][0] = vA[0][0]; vN[0][1] = vA[0][1]; vN[1][0] = vA[1][0]; vN[1][1] = vA[1][1]; }
            *stash = (u32x4){vN[0][0], vN[0][1], vN[1][0], vN[1][1]}; }
        for (int t = 0; t < nt; t += 2) {
            const bool last = (t == nt - 2);
            const char* a1 = cA + (size_t)(t + 1) * kstep;
            const char* a2 = last ? nA : cA + (size_t)(t + 2) * kstep;
            const char* b2 = last ? nB : cB + (size_t)(t + 2) * kstep + ((Prob::KSPLIT && (t + 2) >= (nt >> 1)) ? csplit : 0);
            const char* a3 = a2 + kstep; const char* b3 = b2 + kstep;
            PG8_LDB(B0, 0, 0); PG8_LDB(B1, 0, 1); PG8_SCHED; PG8_LDA(At, 0, 0); PG8_STAGE(PG8_SA(1, 1), a1, vA[1]);
            if (Prob::GATHER && last) { const u32x4 sv = *stash; vA[0][0] = sv.x; vA[0][1] = sv.y; vA[1][0] = sv.z; vA[1][1] = sv.w; }
            PG8_WAIT_V(8); PG8_WAIT_L(0); PG8_BAR; PG8_MMA(0, 0, At, B0); PG8_MMA(0, 1, At, B1); PG8_BAR; PG8_SCHED;
            PG8_LDA(At, 0, 1); PG8_STAGE(PG8_SB(0, 0), b2, voffB); PG8_STAGE(PG8_SB(0, 1), b2 + hstepB, voffB); PG8_STAGE(PG8_SA(0, 0), a2, vA[0]);
            PG8_WAIT_V(8); PG8_WAIT_L(0); PG8_BAR; PG8_MMA(1, 0, At, B0); PG8_MMA(1, 1, At, B1); PG8_BAR; PG8_SCHED;
            PG8_LDB(B0, 1, 0); PG8_LDB(B1, 1, 1); PG8_SCHED; PG8_LDA(At, 1, 0); PG8_STAGE(PG8_SA(0, 1), a2, vA[1]);
            PG8_WAIT_V(8); PG8_WAIT_L(0); PG8_BAR; PG8_MMA(0, 0, At, B0); PG8_MMA(0, 1, At, B1); PG8_BAR; PG8_SCHED;
            PG8_LDA(At, 1, 1); PG8_STAGE(PG8_SB(1, 0), b3, voffB); PG8_STAGE(PG8_SB(1, 1), b3 + hstepB, voffB); PG8_STAGE(PG8_SA(1, 0), a3, vA[0]);
            PG8_WAIT_V(8); PG8_WAIT_L(0); PG8_BAR; PG8_MMA(1, 0, At, B0); PG8_MMA(1, 1, At, B1); PG8_BAR; PG8_SCHED;
        }
        if (wr == 0) PG8_BAR;
        E(acc, cur, wr, wc, fr, fq);
        if (!has_next) break;
#pragma unroll
        for (int a = 0; a < 2; ++a)
#pragma unroll
            for (int b = 0; b < 2; ++b)
#pragma unroll
                for (int m = 0; m < 4; ++m)
#pragma unroll
                    for (int n = 0; n < 2; ++n) acc[a][b][m][n] = (f32x4){0.f, 0.f, 0.f, 0.f};
        cur = nxt; cA = nA; cB = nB; ++ui;
        if (Prob::KSPLIT) csplit = P.bsplit(cur);
        if (wr == 1) PG8_BAR;
    }
    PG8_WAIT_V(0);
    PG8_BAR;
#undef PG8_SA
#undef PG8_SB
#undef PG8_STAGE
#undef PG8_LDA
#undef PG8_LDB
#undef PG8_MMA
#undef PG8_WAIT_V
#undef PG8_WAIT_L
#undef PG8_BAR
#undef PG8_SCHED
#undef PG8_AVOFF
}

__device__ __forceinline__ int pair_a(int pi) { return pi < 3 ? 0 : (pi < 5 ? 1 : 2); }
__device__ __forceinline__ int pair_b(int pi) { return pi == 0 ? 1 : ((pi == 1 || pi == 3) ? 2 : 3); }
template <int MODE>
struct MoeProb {
    static constexpr bool GATHER = (MODE == 0), KSPLIT = (MODE == 1);
    const unsigned* cnt; const unsigned* list; const char* A; const char* B; int lda, ldb, K; long hstepB; int G, c;
    __device__ __forceinline__ bool next(int i, Unit& u) const {
        const long L = (long)i * G + c; const int tileidx = (int)(L >> 2);
        int accu = 0, bk = -1, tib = 0, nb = 0;
        for (int k = 0; k < 24; ++k) { const int n = (int)cnt[k]; const int tl = (n + 255) >> 8; if (bk < 0 && tileidx < accu + tl) { bk = k; tib = tileidx - accu; nb = n; } accu += tl; }
        if (bk < 0) return false;
        u.pm = tileidx; u.pn = (int)(L & 3); u.meta = bk | (tib << 5) | (nb << 13); return true;
    }
    __device__ __forceinline__ int expert(const Unit& u, int s) const { const int g = u.bk() / 6, pi = u.bk() % 6; return g * 4 + (s ? pair_b(pi) : pair_a(pi)); }
    __device__ __forceinline__ const char* a_base(const Unit& u) const { return MODE == 0 ? A : A + (size_t)u.pm * 256 * lda * 2; }
    __device__ __forceinline__ const char* b_base(const Unit& u) const {
        if (MODE == 0) return B + ((size_t)expert(u, u.pn >> 1) * DEXP + (size_t)(u.pn & 1) * HALF) * ldb * 2;
        return B + (size_t)u.pn * 256 * ldb * 2 + (size_t)expert(u, 0) * DEXP * 2;
    }
    __device__ __forceinline__ unsigned arow_off(const Unit& u, int h, int R) const { const int pos = u.tib() * 256 + h * HALF + R; const unsigned tok = pos < u.nb() ? list[(size_t)u.bk() * T + pos] : 0u; return tok * (unsigned)(lda * 2); }
    __device__ __forceinline__ long bsplit(const Unit& u) const { return ((long)(expert(u, 1) - expert(u, 0)) * DEXP - DEXP) * 2; }
};
struct EpiGateUpSparse {
    static constexpr bool PERM = true;
    bf16_t* act; const float* wlist;
    __device__ __forceinline__ void operator()(const f32x4 (&acc)[2][2][4][2], const Unit& u, int wr, int wc, int fr, int fq) const {
        asm volatile("" : "+v"(fr), "+v"(fq));
        const int s = u.pn >> 1, col0 = s * DEXP + (u.pn & 1) * HALF + wc * 32 + 8 * fq;
#pragma unroll
        for (int ai = 0; ai < 2; ++ai)
#pragma unroll
            for (int m = 0; m < 4; ++m) { const int r = ai * HALF + wr * 64 + m * 16 + fr, pos = u.tib() * 256 + r;
                const float cw = pos < u.nb() ? wlist[((size_t)u.bk() * T + pos) * 2 + s] : 0.f;
                float o[8];
#pragma unroll
                for (int n = 0; n < 2; ++n)
#pragma unroll
                    for (int j = 0; j < 4; ++j) { const float g = acc[ai][0][m][n][j], up = acc[ai][1][m][n][j];
                        const float sg = g * __builtin_amdgcn_rcpf(1.f + __builtin_amdgcn_exp2f(-g * LOG2E));
                        o[n * 4 + j] = sg * up * cw; }
                u32x4 w; w.x = cvt_pk_bf16(o[0], o[1]); w.y = cvt_pk_bf16(o[2], o[3]); w.z = cvt_pk_bf16(o[4], o[5]); w.w = cvt_pk_bf16(o[6], o[7]);
                *(u32x4*)(act + ((size_t)u.pm * 256 + r) * 512 + col0) = w;
                if (m & 1) asm volatile("" ::: "memory"); }
    }
};
struct EpiDownScatter {
    static constexpr bool PERM = false;
    float* x; const unsigned* list;
    __device__ __forceinline__ void operator()(const f32x4 (&acc)[2][2][4][2], const Unit& u, int wr, int wc, int fr, int fq) const {
        asm volatile("" : "+v"(fr), "+v"(fq));
        const int col0 = u.pn * BM + wc * 32 + 4 * fq;
#pragma unroll
        for (int ai = 0; ai < 2; ++ai)
#pragma unroll
            for (int m = 0; m < 4; ++m) { const int pos = u.tib() * 256 + ai * HALF + wr * 64 + m * 16 + fr;
                if (pos < u.nb()) { const size_t off = (size_t)list[(size_t)u.bk() * T + pos] * DM + col0;
#pragma unroll
                    for (int bj = 0; bj < 2; ++bj)
#pragma unroll
                        for (int n = 0; n < 2; ++n) { f32x4* p = (f32x4*)(x + off + bj * HALF + n * 16); *p = *p + acc[ai][bj][m][n]; } }
                asm volatile("" ::: "memory"); }
    }
};
}

#define XB_TMO      128
#define XB_XCNT(j)  (256  + 64 * (j))
#define XB_XSUB(j)  (1280 + 64 * (j))
#define XB_XGEN(j)  (2304 + 64 * (j))
#define XB_TOP      3328
#define XB_TOPGEN   3392
#define XCD_BAR_WORDS 3456
#define XB_SPIN_CAP (1u << 18)
__device__ __forceinline__ unsigned xb_ld(unsigned* p)              { return __hip_atomic_load(p, __ATOMIC_RELAXED, __HIP_MEMORY_SCOPE_AGENT); }
__device__ __forceinline__ unsigned xb_add(unsigned* p, unsigned v) { return __hip_atomic_fetch_add(p, v, __ATOMIC_RELAXED, __HIP_MEMORY_SCOPE_AGENT); }
__device__ __forceinline__ unsigned xb_xcc_id() { return (unsigned)__builtin_amdgcn_s_getreg((3 << 11) | 20) & 0xFu; }
#define XB_SPIN(cond, bar) do { unsigned _sp = 0; while (cond) { __builtin_amdgcn_s_sleep(1); \
    if ((++_sp & 255u) == 0u) { if (xb_ld(&(bar)[XB_TMO])) break; if (_sp > XB_SPIN_CAP) { atomicAdd(&(bar)[XB_TMO], 1u); break; } } } } while (0)
struct XcdBarrier { unsigned* bar; unsigned x; volatile LAS unsigned* st; };
__device__ __forceinline__ XcdBarrier xcd_barrier_post(unsigned* bar, volatile LAS unsigned* st) {
    XcdBarrier b; b.bar = bar; b.x = xb_xcc_id(); b.st = st;
    if (threadIdx.x == 0) (void)xb_add(&bar[XB_XCNT(b.x)], 1u);
    return b;
}
__device__ __forceinline__ void xcd_barrier_complete(unsigned* bar, unsigned x, unsigned& nloc, unsigned& nx) {
    const unsigned G = gridDim.x * gridDim.y * gridDim.z;
    unsigned sum, cnt, mine, sp = 0u;
    for (;;) {
        sum = 0u; cnt = 0u; mine = 0u;
#pragma unroll
        for (unsigned j = 0; j < 16; ++j) { const unsigned c = xb_ld(&bar[XB_XCNT(j)]); sum += c; cnt += (c > 0u) ? 1u : 0u; mine = (j == x) ? c : mine; }
        if (sum == G) break;
        __builtin_amdgcn_s_sleep(1);
        if ((++sp & 255u) == 0u) { if (xb_ld(&bar[XB_TMO])) break; if (sp > XB_SPIN_CAP) { atomicAdd(&bar[XB_TMO], 1u); break; } }
    }
    nloc = mine > 0u ? mine : 1u; nx = cnt > 0u ? cnt : 1u;
}
__device__ __forceinline__ void xcd_barrier(const XcdBarrier& b) {
    asm volatile("s_waitcnt vmcnt(0)" ::: "memory");
    __syncthreads();
    if (threadIdx.x == 0) {
        unsigned* bar = b.bar;
        __builtin_amdgcn_s_waitcnt(0);
        unsigned nloc = b.st[0], nx = b.st[1];
        if (nloc == 0u) { xcd_barrier_complete(bar, b.x, nloc, nx); b.st[0] = nloc; b.st[1] = nx; }
        const unsigned old = xb_add(&bar[XB_XSUB(b.x)], 1u);
        const unsigned gen = old / nloc;
        if (old + 1u == (gen + 1u) * nloc) {
            __builtin_amdgcn_fence(__ATOMIC_RELEASE, "agent");
            asm volatile("s_waitcnt vmcnt(0)" ::: "memory");
            const unsigned og = xb_add(&bar[XB_TOP], 1u);
            const unsigned tg = og / nx;
            if (og + 1u == (tg + 1u) * nx) xb_add(&bar[XB_TOPGEN], 1u);
            else XB_SPIN(xb_ld(&bar[XB_TOPGEN]) == tg, bar);
            __builtin_amdgcn_fence(__ATOMIC_ACQUIRE, "agent");
            xb_add(&bar[XB_XGEN(b.x)], 1u);
            asm volatile("s_waitcnt vmcnt(0)" ::: "memory");
        } else {
            XB_SPIN(xb_ld(&bar[XB_XGEN(b.x)]) == gen, bar);
            __builtin_amdgcn_fence(__ATOMIC_ACQUIRE, "agent");
            asm volatile("s_waitcnt vmcnt(0)" ::: "memory");
        }
    }
    __syncthreads();
}

struct Args {
    const float* x; const float* ln1_g; const float* w_in; const float* mix_g; const float* w_out; const float* ln2_g;
    const float* w_gr; const float* b_gr; const float* w_er; const float* b_er; const float* w_gate; const float* w_up; const float* w_down; const float* fin_g;
    float* out; unsigned char* ws; int ph_lo, ph_hi, li, pad;
};

__device__ __forceinline__ void transpose_item(const float* W, int K, int N, bf16_t* WT, int dpitch, int dcol, LAS float* scr, int item, int lane) {
    const int nblk = N / 32, kb = item / nblk, nb = item % nblk, k0 = 64 * kb, n0 = 32 * nb;
#pragma unroll 8
    for (int i = 0; i < 32; ++i) { const int kk = 2 * i + (lane >> 5); scr[kk * 33 + (lane & 31)] = W[(size_t)(k0 + kk) * N + n0 + (lane & 31)]; }
    LDS_WAIT(); asm volatile("" ::: "memory");
    const int c = lane & 7;
#pragma unroll
    for (int j = 0; j < 4; ++j) { const int n = (lane >> 3) + 8 * j; const LAS float* s = scr + (8 * c) * 33 + n;
        u32x4 o; o.x = pk2(s[0 * 33], s[1 * 33]); o.y = pk2(s[2 * 33], s[3 * 33]); o.z = pk2(s[4 * 33], s[5 * 33]); o.w = pk2(s[6 * 33], s[7 * 33]);
        *(u32x4*)(WT + (size_t)(n0 + n) * dpitch + dcol + k0 + 8 * c) = o; }
    LDS_WAIT(); asm volatile("" ::: "memory");
}
__device__ __forceinline__ void phase_prologue(const Args& a, LAS unsigned char* lds, int gw, int NGW, int wave, int lane) {
    LAS float* scr = (LAS float*)(lds + wave * 16384);
    constexpr int I_IN = (DM / 64) * (NQKV / 32);
    constexpr int I_OUT = (DM / 64) * (DM / 32);
    constexpr int I_G = (DM / 64) * (DEXP / 32);
    constexpr int I_D = (DEXP / 64) * (DM / 32);
    constexpr int N_IN = DEPTH * I_IN, N_OUT = DEPTH * I_OUT, N_G = DEPTH * NEXP * I_G, N_D = DEPTH * NEXP * I_D;
    constexpr int NITEMS = N_IN + N_OUT + 2 * N_G + N_D;
    bf16_t* WinT = (bf16_t*)(a.ws + WS_WIN); bf16_t* WoutT = (bf16_t*)(a.ws + WS_WOUT); bf16_t* WgT = (bf16_t*)(a.ws + WS_WG); bf16_t* WuT = (bf16_t*)(a.ws + WS_WU); bf16_t* WdT = (bf16_t*)(a.ws + WS_WD);
    for (int it = gw; it < NITEMS; it += NGW) {
        int r = it;
        if (r < N_IN) { const int l = r / I_IN; transpose_item(a.w_in + (size_t)l * DM * NQKV, DM, NQKV, WinT + (size_t)l * NQKV * DM, DM, 0, scr, r % I_IN, lane); continue; } r -= N_IN;
        if (r < N_OUT) { const int l = r / I_OUT; transpose_item(a.w_out + (size_t)l * DM * DM, DM, DM, WoutT + (size_t)l * DM * DM, DM, 0, scr, r % I_OUT, lane); continue; } r -= N_OUT;
        if (r < N_G) { const int le = r / I_G; transpose_item(a.w_gate + (size_t)le * DM * DEXP, DM, DEXP, WgT + (size_t)le * DEXP * DM, DM, 0, scr, r % I_G, lane); continue; } r -= N_G;
        if (r < N_G) { const int le = r / I_G; transpose_item(a.w_up + (size_t)le * DM * DEXP, DM, DEXP, WuT + (size_t)le * DEXP * DM, DM, 0, scr, r % I_G, lane); continue; } r -= N_G;
        { const int le = r / I_D, l = le / NEXP, e = le % NEXP; transpose_item(a.w_down + (size_t)le * DEXP * DM, DEXP, DM, WdT + (size_t)l * DM * NACT, NACT, e * DEXP, scr, r % I_D, lane); }
    }
}

__device__ __forceinline__ void phase_norm1(const float* x, const float* g, bf16_t* hb, int gw, int NGW, int lane) {
    f32x4 gv[4];
#pragma unroll
    for (int j = 0; j < 4; ++j) gv[j] = *((const f32x4*)g + lane + 64 * j);
    for (int m = gw; m < T; m += NGW) {
        const f32x4* xr = (const f32x4*)(x + (size_t)m * DM) + lane;
        f32x4 v[4]; float s = 0.f;
#pragma unroll
        for (int j = 0; j < 4; ++j) { v[j] = xr[64 * j]; s += (v[j].x * v[j].x + v[j].y * v[j].y) + (v[j].z * v[j].z + v[j].w * v[j].w); }
        const float rstd = 1.0f / sqrtf(wave_sum(s) * (1.f / DM) + NORM_EPS);
        u32x2* o8 = (u32x2*)(hb + (size_t)m * DM) + lane;
#pragma unroll
        for (int j = 0; j < 4; ++j) { u32x2 w; w.x = pk2(v[j].x * rstd * gv[j].x, v[j].y * rstd * gv[j].y); w.y = pk2(v[j].z * rstd * gv[j].z, v[j].w * rstd * gv[j].w); o8[64 * j] = w; }
    }
}
__device__ __forceinline__ void phase_mixnorm(const bf16_t* ob, bf16_t* hb, const float* lse, const float* g, int gw, int NGW, int lane) {
    float g0[8], g1[8];
#pragma unroll
    for (int j = 0; j < 8; ++j) { g0[j] = g[8 * lane + j]; g1[j] = g[512 + 8 * lane + j]; }
    const int hh = lane >> 3;
    for (int m = gw; m < T; m += NGW) {
        const u32x4 a = *((const u32x4*)(ob + (size_t)m * DM) + lane), c0 = *((const u32x4*)(ob + (size_t)m * DM + 512) + lane);
        const u32x4 c1 = *((const u32x4*)(hb + (size_t)m * DM) + lane), c2 = *((const u32x4*)(hb + (size_t)m * DM + 512) + lane);
        const float l0 = lse[(size_t)m * 8 + hh], l1 = lse[(size_t)T * 8 + (size_t)m * 8 + hh], l2 = lse[(size_t)2 * T * 8 + (size_t)m * 8 + hh];
        const float mx = fmaxf(l0, fmaxf(l1, l2));
        float w0 = __builtin_amdgcn_exp2f(l0 - mx), w1 = __builtin_amdgcn_exp2f(l1 - mx), w2 = __builtin_amdgcn_exp2f(l2 - mx);
        const float inv = 1.0f / (w0 + w1 + w2); w0 *= inv; w1 *= inv; w2 *= inv;
        float va[8] = {bflo(a.x), bfhi(a.x), bflo(a.y), bfhi(a.y), bflo(a.z), bfhi(a.z), bflo(a.w), bfhi(a.w)};
        const float x0[8] = {bflo(c0.x), bfhi(c0.x), bflo(c0.y), bfhi(c0.y), bflo(c0.z), bfhi(c0.z), bflo(c0.w), bfhi(c0.w)};
        const float x1[8] = {bflo(c1.x), bfhi(c1.x), bflo(c1.y), bfhi(c1.y), bflo(c1.z), bfhi(c1.z), bflo(c1.w), bfhi(c1.w)};
        const float x2[8] = {bflo(c2.x), bfhi(c2.x), bflo(c2.y), bfhi(c2.y), bflo(c2.z), bfhi(c2.z), bflo(c2.w), bfhi(c2.w)};
        float vc[8];
        float sa = 0.f, sc = 0.f;
#pragma unroll
        for (int j = 0; j < 8; ++j) { vc[j] = w0 * x0[j] + w1 * x1[j] + w2 * x2[j]; sa += va[j] * va[j]; sc += vc[j] * vc[j]; }
        sa = half_sum(sa); sc = wave_sum(sc);
        const float ra = 1.0f / sqrtf(sa * (1.f / 256.f) + NORM_EPS), rc = 1.0f / sqrtf(sc * (1.f / 512.f) + NORM_EPS);
        u32x4 oa, oc;
        oa.x = pk2(va[0] * ra * g0[0], va[1] * ra * g0[1]); oa.y = pk2(va[2] * ra * g0[2], va[3] * ra * g0[3]); oa.z = pk2(va[4] * ra * g0[4], va[5] * ra * g0[5]); oa.w = pk2(va[6] * ra * g0[6], va[7] * ra * g0[7]);
        oc.x = pk2(vc[0] * rc * g1[0], vc[1] * rc * g1[1]); oc.y = pk2(vc[2] * rc * g1[2], vc[3] * rc * g1[3]); oc.z = pk2(vc[4] * rc * g1[4], vc[5] * rc * g1[5]); oc.w = pk2(vc[6] * rc * g1[6], vc[7] * rc * g1[7]);
        *((u32x4*)(hb + (size_t)m * DM) + lane) = oa; *((u32x4*)(hb + (size_t)m * DM + 512) + lane) = oc;
    }
}
__device__ __forceinline__ void phase_route(const float* x, const float* g, const float* wgr, const float* bgr, const float* wer, const float* ber,
                                            bf16_t* hb, float* comb, unsigned* cnt, unsigned* list, float* wlist, int gw, int NGW, int lane) {
    f32x4 gv[4];
#pragma unroll
    for (int j = 0; j < 4; ++j) gv[j] = *((const f32x4*)g + lane + 64 * j);
    for (int m = gw; m < T; m += NGW) {
        const f32x4* xr = (const f32x4*)(x + (size_t)m * DM) + lane;
        f32x4 v[4]; float s = 0.f;
#pragma unroll
        for (int j = 0; j < 4; ++j) { v[j] = xr[64 * j]; s += (v[j].x * v[j].x + v[j].y * v[j].y) + (v[j].z * v[j].z + v[j].w * v[j].w); }
        const float rstd = 1.0f / sqrtf(wave_sum(s) * (1.f / DM) + NORM_EPS);
        u32x2* o8 = (u32x2*)(hb + (size_t)m * DM) + lane;
#pragma unroll
        for (int j = 0; j < 4; ++j) { v[j] = v[j] * rstd * gv[j]; u32x2 w; w.x = pk2(v[j].x, v[j].y); w.y = pk2(v[j].z, v[j].w); o8[64 * j] = w; }
        f32x4 gl = (f32x4){0.f, 0.f, 0.f, 0.f};
#pragma unroll
        for (int j = 0; j < 4; ++j) { const f32x4* wp = (const f32x4*)wgr + (size_t)(4 * lane + 256 * j);
            gl += wp[0] * v[j].x; gl += wp[1] * v[j].y; gl += wp[2] * v[j].z; gl += wp[3] * v[j].w; }
        gl.x = wave_sum(gl.x) + bgr[0]; gl.y = wave_sum(gl.y) + bgr[1]; gl.z = wave_sum(gl.z) + bgr[2]; gl.w = wave_sum(gl.w) + bgr[3];
        int gi = 0; float gm = gl.x;
        if (gl.y > gm) { gm = gl.y; gi = 1; } if (gl.z > gm) { gm = gl.z; gi = 2; } if (gl.w > gm) { gm = gl.w; gi = 3; }
        const float gden = __expf(gl.x - gm) + __expf(gl.y - gm) + __expf(gl.z - gm) + __expf(gl.w - gm);
        const float gw_ = 1.0f / gden;
        const float* we = wer + (size_t)gi * DM * 4;
        f32x4 el = (f32x4){0.f, 0.f, 0.f, 0.f};
#pragma unroll
        for (int j = 0; j < 4; ++j) { const f32x4* wp = (const f32x4*)we + (size_t)(4 * lane + 256 * j);
            el += wp[0] * v[j].x; el += wp[1] * v[j].y; el += wp[2] * v[j].z; el += wp[3] * v[j].w; }
        float e[4] = {wave_sum(el.x) + ber[gi * 4 + 0], wave_sum(el.y) + ber[gi * 4 + 1], wave_sum(el.z) + ber[gi * 4 + 2], wave_sum(el.w) + ber[gi * 4 + 3]};
        int i1 = 0; float v1 = e[0];
#pragma unroll
        for (int k = 1; k < 4; ++k) if (e[k] > v1) { v1 = e[k]; i1 = k; }
        int i2 = -1; float v2 = -INFINITY;
#pragma unroll
        for (int k = 0; k < 4; ++k) if (k != i1 && e[k] > v2) { v2 = e[k]; i2 = k; }
        const float p2 = __expf(v2 - v1), inv = 1.0f / (1.0f + p2);
        const float w1 = inv * gw_, w2 = p2 * inv * gw_;
#if MOE_SPARSE
        { const int ea = i1 < i2 ? i1 : i2, eb = i1 < i2 ? i2 : i1; const float wa = i1 < i2 ? w1 : w2, wb = i1 < i2 ? w2 : w1;
          const int pi = (ea == 0) ? (eb - 1) : (ea == 1 ? eb + 1 : 5), bk = gi * 6 + pi;
          unsigned pos = 0u; if (lane == 0) pos = __hip_atomic_fetch_add(cnt + bk, 1u, __ATOMIC_RELAXED, __HIP_MEMORY_SCOPE_AGENT);
          pos = (unsigned)__builtin_amdgcn_readfirstlane((int)pos);
          if (lane == 0) { list[(size_t)bk * T + pos] = (unsigned)m; wlist[((size_t)bk * T + pos) * 2] = wa; wlist[((size_t)bk * T + pos) * 2 + 1] = wb; } }
#else
        if (lane < 16) { const int ge = lane >> 2, ee = lane & 3; float cw = 0.f; if (ge == gi) { if (ee == i1) cw = w1; else if (ee == i2) cw = w2; } comb[(size_t)m * NEXP + lane] = cw; }
#endif
    }
}
__device__ __forceinline__ void phase_final(float* x, const float* g, int gw, int NGW, int lane) {
    f32x4 gv[4];
#pragma unroll
    for (int j = 0; j < 4; ++j) gv[j] = *((const f32x4*)g + lane + 64 * j);
    for (int m = gw; m < T; m += NGW) {
        f32x4* xr = (f32x4*)(x + (size_t)m * DM) + lane;
        f32x4 v[4]; float s = 0.f;
#pragma unroll
        for (int j = 0; j < 4; ++j) { v[j] = xr[64 * j]; s += (v[j].x * v[j].x + v[j].y * v[j].y) + (v[j].z * v[j].z + v[j].w * v[j].w); }
        const float rstd = 1.0f / sqrtf(wave_sum(s) * (1.f / DM) + NORM_EPS);
#pragma unroll
        for (int j = 0; j < 4; ++j) xr[64 * j] = v[j] * rstd * gv[j];
    }
}
__device__ __forceinline__ void phase_kmean(const bf16_t* kb, float* kmean, int gw, int NGW, int lane) {
    for (int it = gw; it < BATCH * 4 * 32; it += NGW) {
        const int b = it >> 7, h = (it >> 5) & 3, blk = it & 31;
        const bf16_t* base = kb + ((size_t)b * SEQ + (size_t)blk * 256) * DM + h * HD + (lane & 7) * 8;
        float acc[8] = {0.f, 0.f, 0.f, 0.f, 0.f, 0.f, 0.f, 0.f};
#pragma unroll 4
        for (int i = 0; i < 32; ++i) { const u32x4 w = *(const u32x4*)(base + (size_t)((lane >> 3) + 8 * i) * DM);
            acc[0] += bflo(w.x); acc[1] += bfhi(w.x); acc[2] += bflo(w.y); acc[3] += bfhi(w.y); acc[4] += bflo(w.z); acc[5] += bfhi(w.z); acc[6] += bflo(w.w); acc[7] += bfhi(w.w); }
#pragma unroll
        for (int j = 0; j < 8; ++j) { acc[j] += swz_xor<8>(acc[j]); acc[j] += swz_xor<16>(acc[j]); acc[j] = sum_xor32(acc[j]); }
        if (lane < 8) {
            float* o = kmean + (size_t)it * HD + lane * 8;
#pragma unroll
            for (int j = 0; j < 8; ++j) o[j] = acc[j] * (1.f / 256.f);
        }
    }
}

__device__ __forceinline__ void ld_row64(float (&r)[64], const bf16_t* p) {
#pragma unroll
    for (int c = 0; c < 8; ++c) { const u32x4 w = *((const u32x4*)p + c);
        r[8 * c + 0] = bflo(w.x); r[8 * c + 1] = bfhi(w.x); r[8 * c + 2] = bflo(w.y); r[8 * c + 3] = bfhi(w.y); r[8 * c + 4] = bflo(w.z); r[8 * c + 5] = bfhi(w.z); r[8 * c + 6] = bflo(w.w); r[8 * c + 7] = bfhi(w.w); }
}
__device__ __forceinline__ float dot_row64(const float (&q)[64], const bf16_t* p) {
    float s0 = 0.f, s1 = 0.f;
#pragma unroll
    for (int c = 0; c < 8; ++c) { const u32x4 w = *((const u32x4*)p + c);
        s0 += q[8 * c + 0] * bflo(w.x); s1 += q[8 * c + 1] * bfhi(w.x); s0 += q[8 * c + 2] * bflo(w.y); s1 += q[8 * c + 3] * bfhi(w.y);
        s0 += q[8 * c + 4] * bflo(w.z); s1 += q[8 * c + 5] * bfhi(w.z); s0 += q[8 * c + 6] * bflo(w.w); s1 += q[8 * c + 7] * bfhi(w.w); }
    return s0 + s1;
}
__device__ __forceinline__ void axpy_row64(float (&o)[64], float p, const bf16_t* vp) {
#pragma unroll
    for (int c = 0; c < 8; ++c) { const u32x4 w = *((const u32x4*)vp + c);
        o[8 * c + 0] += p * bflo(w.x); o[8 * c + 1] += p * bfhi(w.x); o[8 * c + 2] += p * bflo(w.y); o[8 * c + 3] += p * bfhi(w.y);
        o[8 * c + 4] += p * bflo(w.z); o[8 * c + 5] += p * bfhi(w.z); o[8 * c + 6] += p * bflo(w.w); o[8 * c + 7] += p * bfhi(w.w); }
}
__device__ __forceinline__ void st_row64(bf16_t* p, const float (&o)[64], float sc) {
#pragma unroll
    for (int c = 0; c < 8; ++c) { u32x4 w; w.x = pk2(o[8 * c] * sc, o[8 * c + 1] * sc); w.y = pk2(o[8 * c + 2] * sc, o[8 * c + 3] * sc); w.z = pk2(o[8 * c + 4] * sc, o[8 * c + 5] * sc); w.w = pk2(o[8 * c + 6] * sc, o[8 * c + 7] * sc); *((u32x4*)p + c) = w; }
}
#define OSM_STEP(sc, vrow) do { const float sc_ = (sc); if (sc_ > m_) { const float al = __builtin_amdgcn_exp2f(m_ - sc_); l_ *= al; _Pragma("unroll") for (int d_ = 0; d_ < 64; ++d_) o_[d_] *= al; m_ = sc_; } \
    const float p_ = __builtin_amdgcn_exp2f(sc_ - m_); l_ += p_; axpy_row64(o_, p_, (vrow)); } while (0)

__device__ __forceinline__ void naive_moba(const bf16_t* qb, const bf16_t* kb, const bf16_t* vb, const float* kmean, bf16_t* ob, int item, int tid) {
    const int b = item >> 6, h = (item >> 4) & 3, t = (item & 15) * 512 + tid, own = t >> 8;
    const size_t rowq = ((size_t)b * SEQ + t) * DM + h * HD;
    const bf16_t* kh = kb + (size_t)b * SEQ * DM + h * HD; const bf16_t* vh = vb + (size_t)b * SEQ * DM + h * HD;
    const float slope2 = exp2f(-2.0f * (float)(h + 1)) * LOG2E;
    float q_[64]; ld_row64(q_, qb + rowq);
    float bv0 = -INFINITY, bv1 = -INFINITY, bv2 = -INFINITY; int bi0 = -1, bi1 = -1, bi2 = -1;
    const float* km = kmean + (size_t)(b * 4 + h) * 32 * HD;
    for (int n = 0; n < own; ++n) {
        float gsum = 0.f;
#pragma unroll
        for (int d = 0; d < 64; ++d) gsum += q_[d] * km[n * HD + d];
        if (gsum > bv0) { bv2 = bv1; bi2 = bi1; bv1 = bv0; bi1 = bi0; bv0 = gsum; bi0 = n; }
        else if (gsum > bv1) { bv2 = bv1; bi2 = bi1; bv1 = gsum; bi1 = n; }
        else if (gsum > bv2) { bv2 = gsum; bi2 = n; }
    }
    float o_[64];
#pragma unroll
    for (int d = 0; d < 64; ++d) o_[d] = 0.f;
    float m_ = -INFINITY, l_ = 0.f;
    for (int s = 0; s < 3; ++s) {
        const int blk = (s == 0) ? bi0 : (s == 1) ? bi1 : bi2;
        if (blk < 0) continue;
        for (int j = 0; j < 256; ++j) { const int pos = blk * 256 + j;
            const float sc = dot_row64(q_, kh + (size_t)pos * DM) - slope2 * (float)(t - pos);
            OSM_STEP(sc, vh + (size_t)pos * DM); }
    }
    for (int pos = own * 256; pos <= t; ++pos) {
        const float sc = dot_row64(q_, kh + (size_t)pos * DM) - slope2 * (float)(t - pos);
        OSM_STEP(sc, vh + (size_t)pos * DM); }
    st_row64(ob + rowq, o_, 1.0f / l_);
}
__device__ __forceinline__ void naive_sb(const bf16_t* qb, const bf16_t* kb, const bf16_t* vb, bf16_t* ob, int item, int tid) {
    const int b = item >> 6, h = 4 + ((item >> 4) & 3), t = (item & 15) * 512 + tid;
    const size_t rowq = ((size_t)b * SEQ + t) * DM + h * HD;
    const bf16_t* kh = kb + (size_t)b * SEQ * DM + h * HD; const bf16_t* vh = vb + (size_t)b * SEQ * DM + h * HD;
    float q_[64]; ld_row64(q_, qb + rowq);
    float o_[64];
#pragma unroll
    for (int d = 0; d < 64; ++d) o_[d] = 0.f;
    float tail = 0.f;
    for (int s = t - 1; s >= 0 && tail > -150.f; --s) {
        const float z = dot_row64(q_, kh + (size_t)s * DM);
        const float lp = __builtin_amdgcn_logf(1.0f + __builtin_amdgcn_exp2f(-fabsf(z)));
        const float lnot = -(fmaxf(z, 0.f) + lp);
        const float aw = __builtin_amdgcn_exp2f(z + lnot + tail);
        axpy_row64(o_, aw, vh + (size_t)s * DM);
        tail += lnot;
    }
    st_row64(ob + rowq, o_, 1.0f);
}
__device__ __forceinline__ void naive_dil(const bf16_t* qb, const bf16_t* kb, const bf16_t* vb, bf16_t* ob, bf16_t* hb2, float* lse, int item, int tid) {
    const int b = item >> 7, h = 8 + ((item >> 4) & 7), t = (item & 15) * 512 + tid;
    const size_t rowq = ((size_t)b * SEQ + t) * DM + h * HD;
    const bf16_t* kh = kb + (size_t)b * SEQ * DM + h * HD; const bf16_t* vh = vb + (size_t)b * SEQ * DM + h * HD;
    const float slope2 = exp2f(-(float)(h - 8 + 1)) * LOG2E;
    float q_[64]; ld_row64(q_, qb + rowq);
    float o_[64];
#pragma unroll
    for (int d = 0; d < 64; ++d) o_[d] = 0.f;
    float m_ = -INFINITY, l_ = 0.f;
    for (int c = 0; c < 3; ++c) {
        const int dil = (c == 0) ? 1 : (c == 1) ? 4 : 16;
        for (int dl = 0; dl <= 128; ++dl) { const int pos = t - dl * dil; if (pos < 0) break;
            const float sc = dot_row64(q_, kh + (size_t)pos * DM) - slope2 * (float)(dl * dil);
            OSM_STEP(sc, vh + (size_t)pos * DM); }
    }
    st_row64(ob + rowq, o_, 1.0f / l_);
    { const size_t tok = (size_t)b * SEQ + t; const u32x4 z4 = {0u, 0u, 0u, 0u};
#pragma unroll
      for (int c = 0; c < 8; ++c) { *((u32x4*)(hb2 + tok * DM + (h - 8) * HD) + c) = z4; *((u32x4*)(hb2 + tok * DM + 512 + (h - 8) * HD) + c) = z4; }
      lse[tok * 8 + (h - 8)] = 0.f; lse[(size_t)T * 8 + tok * 8 + (h - 8)] = -1.0e30f; lse[(size_t)2 * T * 8 + tok * 8 + (h - 8)] = -1.0e30f; }
}

namespace att {
typedef float f32x16 __attribute__((ext_vector_type(16)));
typedef short s16x4 __attribute__((ext_vector_type(4)));
typedef short v4i16_t __attribute__((ext_vector_type(4)));
typedef __bf16 bf16x2_t __attribute__((ext_vector_type(2)));
constexpr int L_BUF = 16384;
constexpr int L_WSF = 2 * L_BUF;
constexpr int L_OST = L_WSF + 8 * 256;
constexpr int L_FLG = L_OST + 8 * 4096;
constexpr int L_END = L_FLG + 64;
constexpr float M_INIT = -1.0e30f;
#define ATT_MFMA(a, b, c) __builtin_amdgcn_mfma_f32_32x32x16_bf16((a), (b), (c), 0, 0, 0)

__device__ __forceinline__ unsigned cvtpk(float lo, float hi) { f32x2 v = {lo, hi}; bf16x2_t b = __builtin_convertvector(v, bf16x2_t); return __builtin_bit_cast(unsigned, b); }
__device__ __forceinline__ s16x4 vtr(LAS unsigned char* p) { return __builtin_bit_cast(s16x4, __builtin_amdgcn_ds_read_tr16_b64_v4i16((LAS v4i16_t*)p)); }

struct Wave { int lane, r32, hi, wid; LAS unsigned char* lds; LAS float* wsf; int vlo; };
__device__ __forceinline__ Wave make_wave(LAS unsigned char* lds, int tid) {
    Wave w; w.lane = tid & 63; w.r32 = w.lane & 31; w.hi = w.lane >> 5; w.wid = __builtin_amdgcn_readfirstlane(tid >> 6); w.lds = lds;
    w.wsf = (LAS float*)(lds + L_WSF) + w.wid * 64;
    w.vlo = ((w.lane >> 4) & 1) * 32 + (w.lane & 3) * 8 + (4 * w.hi + ((w.lane & 15) >> 2)) * 64;
    return w;
}
struct Stage { u32x4 k, v; };
template <class RowK, class RowV> __device__ __forceinline__ void stage_load(Stage& s, const Wave& w, const RowK& rowk, const RowV& rowv) {
    s.k = *(const u32x4*)(rowk(w.lane) + w.wid * 8);
    s.v = *(const u32x4*)(rowv(16 * (w.wid & 3) + (w.lane >> 2)) + (w.wid >> 2) * 32 + (w.lane & 3) * 8);
}
__device__ __forceinline__ void stage_write(const Stage& s, const Wave& w, int buf) {
    *(LAS u32x4*)(w.lds + buf * L_BUF + w.wid * 1024 + w.lane * 16) = s.k;
    *(LAS u32x4*)(w.lds + buf * L_BUF + 8192 + w.wid * 1024 + w.lane * 16) = s.v;
}
__device__ __forceinline__ f32x16 qk_sub(const Wave& w, int buf, int sub, const bf16x8 (&qf)[4], float init) {
    f32x16 acc;
#pragma unroll
    for (int r = 0; r < 16; ++r) acc[r] = init;
    LAS unsigned char* kp = w.lds + buf * L_BUF + w.hi * 1024 + (32 * sub + w.r32) * 16;
#pragma unroll
    for (int ks = 0; ks < 4; ++ks) { const bf16x8 kf = *(LAS bf16x8*)(kp + ks * 2048); acc = ATT_MFMA(kf, qf[ks], acc); }
    return acc;
}
__device__ __forceinline__ void pv_sub(const Wave& w, int buf, int sub, const f32x16& p, f32x16 (&o)[2]) {
    bf16x8 pk[2];
#pragma unroll
    for (int s = 0; s < 2; ++s) { u32x4 t; t.x = cvtpk(p[8 * s], p[8 * s + 1]); t.y = cvtpk(p[8 * s + 2], p[8 * s + 3]); t.z = cvtpk(p[8 * s + 4], p[8 * s + 5]); t.w = cvtpk(p[8 * s + 6], p[8 * s + 7]); pk[s] = __builtin_bit_cast(bf16x8, t); }
    LAS unsigned char* vb = w.lds + buf * L_BUF + 8192 + w.vlo;
#pragma unroll
    for (int db = 0; db < 2; ++db)
#pragma unroll
        for (int s = 0; s < 2; ++s) { LAS unsigned char* vp = vb + db * 4096 + (4 * sub + 2 * s) * 512;
            const s16x4 lo = vtr(vp), hh = vtr(vp + 512);
            const bf16x8 vf = __builtin_shufflevector(lo, hh, 0, 1, 2, 3, 4, 5, 6, 7);
            o[db] = ATT_MFMA(pk[s], vf, o[db]); }
}
__device__ __forceinline__ void scale_rows(const Wave& w, f32x16 (&o)[2], float f) {
    if (w.hi == 0) w.wsf[w.r32] = f;
#pragma unroll
    for (int g = 0; g < 4; ++g) { const f32x4 fv = *(LAS f32x4*)(w.wsf + 8 * g + 4 * w.hi);
#pragma unroll
        for (int i = 0; i < 4; ++i) { o[0][4 * g + i] *= fv[i]; o[1][4 * g + i] *= fv[i]; } }
}
__device__ __forceinline__ void softmax_sub(const Wave& w, f32x16& s, float& m, float& lsum, f32x16 (&o)[2]) {
    float tm = fmaxf(fmaxf(s[0], s[1]), fmaxf(s[2], s[3]));
#pragma unroll
    for (int r = 4; r < 16; r += 4) tm = fmaxf(tm, fmaxf(fmaxf(s[r], s[r + 1]), fmaxf(s[r + 2], s[r + 3])));
    tm = max_xor32(tm);
    const float mn = fmaxf(m, tm);
    if (__any(mn > m)) { const float al = __builtin_amdgcn_exp2f(m - mn); lsum *= al; scale_rows(w, o, al); m = mn; }
    float acc = 0.f;
#pragma unroll
    for (int r = 0; r < 16; ++r) { s[r] = __builtin_amdgcn_exp2f(s[r] - m); acc += s[r]; }
    lsum += acc;
}
__device__ __forceinline__ void mask_band(f32x16& s, int delta0, int W) {
#pragma unroll
    for (int r = 0; r < 16; ++r) { const int dl = delta0 - ((r & 3) + 8 * (r >> 2)); if ((unsigned)dl > (unsigned)W) s[r] = -INFINITY; }
}
template <class RowO> __device__ __forceinline__ void store_o(const Wave& w, const f32x16 (&o)[2], const RowO& rowo) {
    LAS unsigned short* stg = (LAS unsigned short*)(w.lds + L_OST + w.wid * 4096);
#pragma unroll
    for (int r = 0; r < 16; ++r) { const int q = (r & 3) + 8 * (r >> 2) + 4 * w.hi;
#pragma unroll
        for (int db = 0; db < 2; ++db) stg[q * 64 + db * 32 + w.r32] = (unsigned short)f2bf(o[db][r]); }
#pragma unroll
    for (int i = 0; i < 4; ++i) { const int row = i * 8 + (w.lane >> 3), ch = w.lane & 7; const u32x4 v = *(LAS u32x4*)((LAS unsigned char*)stg + row * 128 + ch * 16);
        *(u32x4*)(rowo(row) + ch * 8) = v; }
}
__device__ __forceinline__ void load_q(bf16x8 (&qf)[4], const bf16_t* qrow, int hi) {
#pragma unroll
    for (int ks = 0; ks < 4; ++ks) qf[ks] = *(const bf16x8*)(qrow + 16 * ks + 8 * hi);
}

__device__ __forceinline__ void moba_unit(LAS unsigned char* lds, const bf16_t* QB, const bf16_t* KB, const bf16_t* VB, const float* KMEAN, bf16_t* OB, int b, int h, int own, int tid) {
    const Wave w = make_wave(lds, tid);
    const size_t rowbase = (size_t)b * SEQ; const int q0 = own * 256, qpos = q0 + 32 * w.wid + w.r32;
    const bf16_t* kh = KB + rowbase * DM + h * HD; const bf16_t* vh = VB + rowbase * DM + h * HD;
    const float slope2 = exp2f(-2.0f * (float)(h + 1)) * LOG2E;
    bf16x8 qf[4]; load_q(qf, QB + (rowbase + qpos) * DM + h * HD, w.hi);
    int i0 = -1, i1 = -1, i2 = -1;
    if (own > 0) {
        f32x16 g;
#pragma unroll
        for (int r = 0; r < 16; ++r) g[r] = 0.f;
        const float* km = KMEAN + ((size_t)(b * 4 + h) * 32 + w.r32) * HD + 8 * w.hi;
#pragma unroll
        for (int ks = 0; ks < 4; ++ks) { const f32x4 a0 = *(const f32x4*)(km + 16 * ks), a1 = *(const f32x4*)(km + 16 * ks + 4);
            const float x[8] = {a0.x, a0.y, a0.z, a0.w, a1.x, a1.y, a1.z, a1.w}; unsigned hw[4], lw[4];
#pragma unroll
            for (int j = 0; j < 4; ++j) { const unsigned h0 = f2bf(x[2 * j]), h1 = f2bf(x[2 * j + 1]); hw[j] = h0 | (h1 << 16);
                lw[j] = pk2(x[2 * j] - __builtin_bit_cast(float, h0 << 16), x[2 * j + 1] - __builtin_bit_cast(float, h1 << 16)); }
            const u32x4 hv = {hw[0], hw[1], hw[2], hw[3]}, lv = {lw[0], lw[1], lw[2], lw[3]};
            g = ATT_MFMA(__builtin_bit_cast(bf16x8, hv), qf[ks], g); g = ATT_MFMA(__builtin_bit_cast(bf16x8, lv), qf[ks], g); }
        float v0 = -INFINITY, v1 = -INFINITY, v2 = -INFINITY;
#pragma unroll
        for (int r = 0; r < 16; ++r) { const int blk = (r & 3) + 8 * (r >> 2) + 4 * w.hi; const float val = (blk < own) ? g[r] : -INFINITY;
            if (val > v0) { v2 = v1; i2 = i1; v1 = v0; i1 = i0; v0 = val; i0 = blk; } else if (val > v1) { v2 = v1; i2 = i1; v1 = val; i1 = blk; } else if (val > v2) { v2 = val; i2 = blk; } }
        const float pv_[3] = {get_xor32(v0, w.hi), get_xor32(v1, w.hi), get_xor32(v2, w.hi)}; const int pi_[3] = {get_xor32i(i0, w.hi), get_xor32i(i1, w.hi), get_xor32i(i2, w.hi)};
#pragma unroll
        for (int k = 0; k < 3; ++k) { const float val = pv_[k]; const int blk = pi_[k];
            if (val > v0 || (val == v0 && blk < i0)) { v2 = v1; i2 = i1; v1 = v0; i1 = i0; v0 = val; i0 = blk; }
            else if (val > v1 || (val == v1 && blk < i1)) { v2 = v1; i2 = i1; v1 = val; i1 = blk; }
            else if (val > v2 || (val == v2 && blk < i2)) { v2 = val; i2 = blk; } }
    }
    float tr_[16];
#pragma unroll
    for (int r = 0; r < 16; ++r) tr_[r] = slope2 * (float)((r & 3) + 8 * (r >> 2));
    f32x16 o[2];
#pragma unroll
    for (int r = 0; r < 16; ++r) { o[0][r] = 0.f; o[1][r] = 0.f; }
    float m = M_INIT, lsum = 0.f;
    const int nsteps = 4 * (own + 1);
    auto kpos_of = [&](int st) { return st < 4 ? q0 + (3 - st) * 64 : (own - 1 - ((st - 4) >> 2)) * 256 + (3 - ((st - 4) & 3)) * 64; };
    Stage sg;
    { const int kp = kpos_of(0); stage_load(sg, w, [&](int key) { return kh + (size_t)(kp + key) * DM; }, [&](int key) { return vh + (size_t)(kp + key) * DM; }); }
    stage_write(sg, w, 0);
    __syncthreads();
    for (int st = 0; st < nsteps; ++st) {
        const int buf = st & 1;
        if (st + 1 < nsteps) { const int kp = kpos_of(st + 1); stage_load(sg, w, [&](int key) { return kh + (size_t)(kp + key) * DM; }, [&](int key) { return vh + (size_t)(kp + key) * DM; }); }
        const int kpos0 = kpos_of(st); const bool ownblk = st < 4; const int blk = kpos0 >> 8;
        const bool selq = ownblk || blk == i0 || blk == i1 || blk == i2;
        if (__any(selq)) {
#pragma unroll
            for (int sub = 1; sub >= 0; --sub) {
                const int D = ownblk ? (w.wid - (2 * (3 - st) + sub)) : 1;
                if (D < 0) continue;
                const int delta0 = qpos - (kpos0 + 32 * sub) - 4 * w.hi;
                f32x16 s = qk_sub(w, buf, sub, qf, -slope2 * (float)delta0);
#pragma unroll
                for (int r = 0; r < 16; ++r) s[r] = selq ? s[r] + tr_[r] : -INFINITY;
                if (D == 0) mask_band(s, delta0, 0x7fffffff);
                softmax_sub(w, s, m, lsum, o);
                pv_sub(w, buf, sub, s, o);
            }
        }
        if (st + 1 < nsteps) stage_write(sg, w, buf ^ 1);
        __syncthreads();
    }
    const float l = sum_xor32(lsum);
    scale_rows(w, o, 1.0f / l);
    bf16_t* orow = OB + (rowbase + q0 + 32 * w.wid) * DM + h * HD;
    store_o(w, o, [&](int r) { return orow + (size_t)r * DM; });
}

__device__ __forceinline__ void sb_unit(LAS unsigned char* lds, const bf16_t* QB, const bf16_t* KB, const bf16_t* VB, bf16_t* OB, int b, int h, int qt, int tid) {
    const Wave w = make_wave(lds, tid);
    const size_t rowbase = (size_t)b * SEQ; const int q0 = qt * 256, qpos = q0 + 32 * w.wid + w.r32;
    const bf16_t* kh = KB + rowbase * DM + h * HD; const bf16_t* vh = VB + rowbase * DM + h * HD;
    bf16x8 qf[4]; load_q(qf, QB + (rowbase + qpos) * DM + h * HD, w.hi);
    f32x16 o[2];
#pragma unroll
    for (int r = 0; r < 16; ++r) { o[0][r] = 0.f; o[1][r] = 0.f; }
    float carry = 0.f;
    bool done = false;
    volatile LAS unsigned* flg = (volatile LAS unsigned*)(lds + L_FLG);
    const int ti0 = q0 / 64 + 3;
    Stage sg;
    { const int kp = ti0 * 64; stage_load(sg, w, [&](int key) { return kh + (size_t)(kp + key) * DM; }, [&](int key) { return vh + (size_t)(kp + key) * DM; }); }
    stage_write(sg, w, 0);
    __syncthreads();
    for (int st = 0;; ++st) {
        const int buf = st & 1, ti = ti0 - st;
        if (ti > 0) { const int kp = (ti - 1) * 64; stage_load(sg, w, [&](int key) { return kh + (size_t)(kp + key) * DM; }, [&](int key) { return vh + (size_t)(kp + key) * DM; }); }
        if (!done) {
#pragma unroll
            for (int sub = 1; sub >= 0; --sub) {
                const int D = (q0 / 32 + w.wid) - (2 * ti + sub);
                if (D < 0) continue;
                const int delta0 = qpos - (64 * ti + 32 * sub) - 4 * w.hi;
                f32x16 z = qk_sub(w, buf, sub, qf, 0.f);
                f32x16 L;
#pragma unroll
                for (int r = 0; r < 16; ++r) { const float lp = __builtin_amdgcn_logf(1.0f + __builtin_amdgcn_exp2f(-fabsf(z[r]))); L[r] = -(fmaxf(z[r], 0.f) + lp); }
                if (D == 0) {
#pragma unroll
                    for (int r = 0; r < 16; ++r) { const int dl = delta0 - ((r & 3) + 8 * (r >> 2)); if (dl < 1) { L[r] = 0.f; z[r] = -INFINITY; } }
                }
                float G[4], PG[4];
#pragma unroll
                for (int g = 0; g < 4; ++g) { G[g] = (L[4 * g] + L[4 * g + 1]) + (L[4 * g + 2] + L[4 * g + 3]); PG[g] = get_xor32(G[g], w.hi); }
                float run = carry;
#pragma unroll
                for (int g = 3; g >= 0; --g) { const float t3 = run + (w.hi == 0 ? PG[g] : 0.f), t2 = t3 + L[4 * g + 3], t1 = t2 + L[4 * g + 2], t0 = t1 + L[4 * g + 1];
                    z[4 * g + 3] = __builtin_amdgcn_exp2f(z[4 * g + 3] + L[4 * g + 3] + t3); z[4 * g + 2] = __builtin_amdgcn_exp2f(z[4 * g + 2] + L[4 * g + 2] + t2);
                    z[4 * g + 1] = __builtin_amdgcn_exp2f(z[4 * g + 1] + L[4 * g + 1] + t1); z[4 * g] = __builtin_amdgcn_exp2f(z[4 * g] + L[4 * g] + t0);
                    run += G[g] + PG[g]; }
                carry = run;
                pv_sub(w, buf, sub, z, o);
            }
            done = __all(carry < -150.f);
        }
        if (w.lane == 0) flg[buf * 8 + w.wid] = done ? 1u : 0u;
        if (ti > 0) stage_write(sg, w, buf ^ 1);
        __syncthreads();
        unsigned all = 1u;
#pragma unroll
        for (int k = 0; k < 8; ++k) all &= flg[buf * 8 + k];
        if (all || ti == 0) break;
    }
    bf16_t* orow = OB + (rowbase + q0 + 32 * w.wid) * DM + h * HD;
    store_o(w, o, [&](int r) { return orow + (size_t)r * DM; });
    __syncthreads();
}

__device__ __forceinline__ void dil_unit(LAS unsigned char* lds, const bf16_t* QB, const bf16_t* KB, const bf16_t* VB, bf16_t* PO, float* LSE, int b, int h, int dil, int res, int i2, int tid) {
    const Wave w = make_wave(lds, tid);
    const size_t rowbase = (size_t)b * SEQ; const int Q0 = 256 * i2, qj = Q0 + 32 * w.wid + w.r32;
    const bf16_t* kh = KB + (rowbase + res) * DM + h * HD; const bf16_t* vh = VB + (rowbase + res) * DM + h * HD;
    const size_t rstride = (size_t)dil * DM;
    const float slope2d = exp2f(-(float)(h - 8 + 1)) * LOG2E * (float)dil;
    bf16x8 qf[4]; load_q(qf, QB + (rowbase + res + (size_t)qj * dil) * DM + h * HD, w.hi);
    float tr_[16];
#pragma unroll
    for (int r = 0; r < 16; ++r) tr_[r] = slope2d * (float)((r & 3) + 8 * (r >> 2));
    f32x16 o[2];
#pragma unroll
    for (int r = 0; r < 16; ++r) { o[0][r] = 0.f; o[1][r] = 0.f; }
    float m = M_INIT, lsum = 0.f;
    const int ti0 = 4 * i2 + 3, nsteps = (ti0 + 1 < 6) ? ti0 + 1 : 6;
    Stage sg;
    { const int kp = ti0 * 64; stage_load(sg, w, [&](int key) { return kh + (size_t)(kp + key) * rstride; }, [&](int key) { return vh + (size_t)(kp + key) * rstride; }); }
    stage_write(sg, w, 0);
    __syncthreads();
    for (int st = 0; st < nsteps; ++st) {
        const int buf = st & 1, ti = ti0 - st;
        if (st + 1 < nsteps) { const int kp = (ti - 1) * 64; stage_load(sg, w, [&](int key) { return kh + (size_t)(kp + key) * rstride; }, [&](int key) { return vh + (size_t)(kp + key) * rstride; }); }
#pragma unroll
        for (int sub = 1; sub >= 0; --sub) {
            const int D = (8 * i2 + w.wid) - (2 * ti + sub);
            if (D < 0 || D > 4) continue;
            const int delta0 = qj - (64 * ti + 32 * sub) - 4 * w.hi;
            f32x16 s = qk_sub(w, buf, sub, qf, -slope2d * (float)delta0);
#pragma unroll
            for (int r = 0; r < 16; ++r) s[r] += tr_[r];
            if (D == 0 || D == 4) mask_band(s, delta0, 128);
            softmax_sub(w, s, m, lsum, o);
            pv_sub(w, buf, sub, s, o);
        }
        if (st + 1 < nsteps) stage_write(sg, w, buf ^ 1);
        __syncthreads();
    }
    const float l = sum_xor32(lsum);
    scale_rows(w, o, 1.0f / l);
    const size_t tok0 = rowbase + res + (size_t)(Q0 + 32 * w.wid) * dil;
    store_o(w, o, [&](int r) { return PO + (tok0 + (size_t)r * dil) * DM + (h - 8) * HD; });
    if (w.hi == 0) LSE[(tok0 + (size_t)w.r32 * dil) * 8 + (h - 8)] = m + __builtin_amdgcn_logf(l);
}

template <bool DO_MOBA, bool DO_DIL, bool DO_SB>
__device__ __forceinline__ void attn_phase(LAS unsigned char* lds, const bf16_t* QB, const bf16_t* KB, const bf16_t* VB, const float* KMEAN, bf16_t* OB, bf16_t* HB2, float* LSE, int v, int G, int tid) {
    if (DO_MOBA) for (int u = v; u < 256; u += G) { const int bh = u >> 4, p = u & 15;
        moba_unit(lds, QB, KB, VB, KMEAN, OB, bh >> 2, bh & 3, 31 - p, tid);
        moba_unit(lds, QB, KB, VB, KMEAN, OB, bh >> 2, bh & 3, p, tid); }
    if (DO_DIL) for (int u = v; u < 3072; u += G) { const int n = u & 31, bhc = u >> 5, c = bhc % 3, bh = bhc / 3, b = bh >> 3, h = 8 + (bh & 7);
        const int dil = (c == 0) ? 1 : (c == 1) ? 4 : 16, res = (c == 0) ? 0 : (c == 1) ? (n >> 3) : (n >> 1), i2 = (c == 0) ? n : (c == 1) ? (n & 7) : (n & 1);
        bf16_t* PO = (c == 0) ? OB + 512 : HB2 + (c - 1) * 512;
        dil_unit(lds, QB, KB, VB, PO, LSE + (size_t)c * T * 8, b, h, dil, res, i2, tid); }
    if (DO_SB) for (int u = v; u < 512; u += G) { const int qt = u & 31, bh = u >> 5; sb_unit(lds, QB, KB, VB, OB, bh >> 2, 4 + (bh & 3), qt, tid); }
}
}

constexpr int PH_PRO = 0, PH_L0 = 1, PH_PER_LAYER = 9, PH_FINAL = PH_L0 + DEPTH * PH_PER_LAYER, PH_COUNT = PH_FINAL + 1;
typedef const __attribute__((address_space(4))) Args* KArgP;
#define KARG() ({ KArgP p_ = (KArgP)__builtin_amdgcn_kernarg_segment_ptr(); asm volatile("" : "+s"(p_)); p_; })
#define PHASE_IDS int lane_p = (int)__builtin_amdgcn_mbcnt_hi(~0u, __builtin_amdgcn_mbcnt_lo(~0u, 0u)); LAUNDER_V(lane_p); int tid_p = wave * 64 + lane_p; int gw_p = gw; LAUNDER_S(gw_p)
__global__ void __launch_bounds__(NTHREADS, 2) fwd(Args a_unused) {
    extern __shared__ __attribute__((aligned(16))) unsigned char lds_raw[];
    LAS unsigned char* lds = (LAS unsigned char*)lds_raw;
    volatile LAS unsigned* MISC = (volatile LAS unsigned*)(lds + MISC_OFF);
    const int wave = __builtin_amdgcn_readfirstlane((int)threadIdx.x >> 6);
    const int G = gridDim.x, bx = blockIdx.x;
    const int vcu = (G % 8 == 0) ? (bx % 8) * (G / 8) + bx / 8 : bx;
    const int gw = vcu * NWAVES + wave, NGW = G * NWAVES;
    for (int u = threadIdx.x; u < (LDS_BYTES - LDSCTL_OFF) / 4; u += NTHREADS) ((LAS unsigned*)(lds + LDSCTL_OFF))[u] = 0u;
    __syncthreads();
    int lo, hi; XcdBarrier bar;
    { KArgP ka = KARG(); lo = ka->ph_lo; hi = ka->ph_hi; unsigned* ctl = (unsigned*)(ka->ws + WS_CTL); bar = xcd_barrier_post(ctl + CW_BAR + ka->li * XCD_BAR_WORDS, MISC + 8); }
#define IN(k) (lo <= (k) && (k) < hi)
#define SEAM(k) do { if (IN(k) && IN((k) + 1)) xcd_barrier(bar); } while (0)
#define WSP(T_, off) ((T_*)(ws + (off)))

    if (IN(PH_PRO)) { KArgP ka = KARG(); PHASE_IDS; Args a; a.ws = ka->ws; a.w_in = ka->w_in; a.w_out = ka->w_out; a.w_gate = ka->w_gate; a.w_up = ka->w_up; a.w_down = ka->w_down; phase_prologue(a, lds, gw_p, NGW, wave, lane_p); } SEAM(PH_PRO);

    for (int l = 0; l < DEPTH; ++l) {
        const int p0 = PH_L0 + l * PH_PER_LAYER;
        if (hi <= p0 || lo >= p0 + PH_PER_LAYER) continue;
        if (IN(p0 + 0)) { KArgP ka = KARG(); PHASE_IDS; unsigned char* ws = ka->ws; const float* xin = (l == 0) ? ka->x : ka->out;
            phase_norm1(xin, ka->ln1_g + (size_t)l * DM, WSP(bf16_t, WS_HB), gw_p, NGW, lane_p); } SEAM(p0 + 0);
        if (IN(p0 + 1)) { KArgP ka = KARG(); PHASE_IDS; unsigned char* ws = ka->ws;
            pg8::Gemm g{(const char*)(ws + WS_HB), (const char*)(ws + WS_WIN) + (size_t)l * NQKV * DM * 2, DM, DM, DM, (long)256 * DM * 2, (long)256 * DM * 2, (long)128 * DM * 2};
            pg8::StaticOrder S; S.init(T / 256, NQKV / 256, G, bx);
            pg8::EpiQKV E{WSP(bf16_t, WS_Q), (size_t)(WS_K - WS_Q) / 2, QSCALE};
            pg8::gemm_phase<pg8::EpiQKV, pg8::StaticOrder>(lds, g, S, E, wave);
        } SEAM(p0 + 1);
        if (IN(p0 + 2)) { KArgP ka = KARG(); PHASE_IDS; unsigned char* ws = ka->ws; phase_kmean(WSP(bf16_t, WS_K), WSP(float, WS_KMEAN), gw_p, NGW, lane_p); } SEAM(p0 + 2);
        if (IN(p0 + 3)) { KArgP ka = KARG(); PHASE_IDS; unsigned char* ws = ka->ws;
            const bf16_t* QB = WSP(bf16_t, WS_Q); const bf16_t* KB = WSP(bf16_t, WS_K); const bf16_t* VB = WSP(bf16_t, WS_V); bf16_t* OB = WSP(bf16_t, WS_O);
            att::attn_phase<ATT_MOBA != 0, ATT_DIL != 0, ATT_SB != 0>(lds, QB, KB, VB, WSP(float, WS_KMEAN), OB, WSP(bf16_t, WS_HB), WSP(float, WS_LSE), vcu, G, tid_p);
#if !ATT_MOBA
            for (int it = vcu; it < 256; it += G) naive_moba(QB, KB, VB, WSP(float, WS_KMEAN), OB, it, tid_p);
#endif
#if !ATT_SB
            for (int it = vcu; it < 256; it += G) naive_sb(QB, KB, VB, OB, it, tid_p);
#endif
#if !ATT_DIL
            for (int it = vcu; it < 512; it += G) naive_dil(QB, KB, VB, OB, WSP(bf16_t, WS_HB), WSP(float, WS_LSE), it, tid_p);
#endif
        } SEAM(p0 + 3);
        if (IN(p0 + 4)) { KArgP ka = KARG(); PHASE_IDS; unsigned char* ws = ka->ws; phase_mixnorm(WSP(bf16_t, WS_O), WSP(bf16_t, WS_HB), WSP(float, WS_LSE), ka->mix_g + (size_t)l * DM, gw_p, NGW, lane_p); } SEAM(p0 + 4);
        if (IN(p0 + 5)) { KArgP ka = KARG(); PHASE_IDS; unsigned char* ws = ka->ws; const float* xin = (l == 0) ? ka->x : ka->out;
            pg8::Gemm g{(const char*)(ws + WS_HB), (const char*)(ws + WS_WOUT) + (size_t)l * DM * DM * 2, DM, DM, DM, (long)256 * DM * 2, (long)256 * DM * 2, (long)128 * DM * 2};
            pg8::StaticOrder S; S.init(T / 256, DM / 256, G, bx);
            pg8::EpiResAdd E{xin, ka->out};
            pg8::gemm_phase<pg8::EpiResAdd, pg8::StaticOrder>(lds, g, S, E, wave);
        } SEAM(p0 + 5);
        if (IN(p0 + 6)) { KArgP ka = KARG(); PHASE_IDS; unsigned char* ws = ka->ws;
            phase_route(ka->out, ka->ln2_g + (size_t)l * DM, ka->w_gr + (size_t)l * DM * 4, ka->b_gr + l * 4, ka->w_er + (size_t)l * 4 * DM * 4, ka->b_er + l * 16, WSP(bf16_t, WS_HB), WSP(float, WS_COMB),
                        WSP(unsigned, WS_CTL) + CW_CNT + l * 32, WSP(unsigned, WS_LIST), WSP(float, WS_WLIST), gw_p, NGW, lane_p); } SEAM(p0 + 6);
#if MOE_SPARSE
        if (IN(p0 + 7)) { KArgP ka = KARG(); PHASE_IDS; unsigned char* ws = ka->ws;
            pg8::MoeProb<0> P{WSP(unsigned, WS_CTL) + CW_CNT + l * 32, WSP(unsigned, WS_LIST), (const char*)(ws + WS_HB), (const char*)(ws + WS_WG) + (size_t)l * NACT * DM * 2, DM, DM, DM, (long)(WS_WU - WS_WG), G, vcu};
            pg8::EpiGateUpSparse E{WSP(bf16_t, WS_ACT), WSP(float, WS_WLIST)};
            pg8::gemm_phase_x<pg8::EpiGateUpSparse, pg8::MoeProb<0>>(lds, P, E, wave);
        } SEAM(p0 + 7);
        if (IN(p0 + 8)) { KArgP ka = KARG(); PHASE_IDS; unsigned char* ws = ka->ws;
            pg8::MoeProb<1> P{WSP(unsigned, WS_CTL) + CW_CNT + l * 32, WSP(unsigned, WS_LIST), (const char*)(ws + WS_ACT), (const char*)(ws + WS_WD) + (size_t)l * DM * NACT * 2, 512, NACT, 512, (long)128 * NACT * 2, G, vcu};
            pg8::EpiDownScatter E{ka->out, WSP(unsigned, WS_LIST)};
            pg8::gemm_phase_x<pg8::EpiDownScatter, pg8::MoeProb<1>>(lds, P, E, wave);
        } SEAM(p0 + 8);
#else
        if (IN(p0 + 7)) { KArgP ka = KARG(); PHASE_IDS; unsigned char* ws = ka->ws;
            pg8::Gemm g{(const char*)(ws + WS_HB), (const char*)(ws + WS_WG) + (size_t)l * NACT * DM * 2, DM, DM, DM, (long)256 * DM * 2, (long)128 * DM * 2, (long)(WS_WU - WS_WG)};
            pg8::StaticOrder S; S.init(T / 256, 2 * NEXP, G, bx);
            pg8::EpiGateUpDense E{WSP(bf16_t, WS_ACT), WSP(float, WS_COMB)};
            pg8::gemm_phase<pg8::EpiGateUpDense, pg8::StaticOrder>(lds, g, S, E, wave);
        } SEAM(p0 + 7);
        if (IN(p0 + 8)) { KArgP ka = KARG(); PHASE_IDS; unsigned char* ws = ka->ws;
            pg8::Gemm g{(const char*)(ws + WS_ACT), (const char*)(ws + WS_WD) + (size_t)l * DM * NACT * 2, NACT, NACT, NACT, (long)256 * NACT * 2, (long)256 * NACT * 2, (long)128 * NACT * 2};
            pg8::StaticOrder S; S.init(T / 256, DM / 256, G, bx);
            pg8::EpiResAdd E{ka->out, ka->out};
            pg8::gemm_phase<pg8::EpiResAdd, pg8::StaticOrder>(lds, g, S, E, wave);
        } SEAM(p0 + 8);
#endif
    }
    if (IN(PH_FINAL)) { KArgP ka = KARG(); PHASE_IDS; phase_final(ka->out, ka->fin_g, gw_p, NGW, lane_p); }
#undef IN
#undef SEAM
#undef WSP
}

#ifndef N_LAUNCH_MODE
#define N_LAUNCH_MODE 1
#endif
extern "C" void kernel_launch(void* const* d_in, const int* in_sizes, int n_in, void* d_out, int out_size, void* d_ws, size_t ws_size, hipStream_t stream) {
    static int grid = 0;
    if (grid == 0) {
        if (n_in != 14 || in_sizes[0] != T * DM || out_size != T * DM || ws_size < WS_END) { fprintf(stderr, "kernel_launch: unexpected shapes (n_in %d in0 %d out %d ws %zu)\n", n_in, n_in > 0 ? in_sizes[0] : -1, out_size, ws_size); grid = -1; return; }
        int dev = 0, cus = 0, per_cu = 0;
        if (hipGetDevice(&dev) != hipSuccess || hipDeviceGetAttribute(&cus, hipDeviceAttributeMultiprocessorCount, dev) != hipSuccess) { grid = -1; return; }
        if (hipFuncSetAttribute((const void*)fwd, hipFuncAttributeMaxDynamicSharedMemorySize, LDS_BYTES) != hipSuccess) { fprintf(stderr, "kernel_launch: hipFuncSetAttribute failed\n"); grid = -1; return; }
        if (hipOccupancyMaxActiveBlocksPerMultiprocessor(&per_cu, (const void*)fwd, NTHREADS, LDS_BYTES) != hipSuccess || per_cu < 1) fprintf(stderr, "kernel_launch: occupancy query says %d\n", per_cu);
        (void)hipGetLastError();
        grid = cus;
    }
    if (grid < 0) return;
    if (hipMemsetAsync((char*)d_ws + WS_CTL, 0, CTL_ZERO_BYTES, stream) != hipSuccess) return;
    Args a{};
    a.x = (const float*)d_in[0]; a.ln1_g = (const float*)d_in[1]; a.w_in = (const float*)d_in[2]; a.mix_g = (const float*)d_in[3]; a.w_out = (const float*)d_in[4]; a.ln2_g = (const float*)d_in[5];
    a.w_gr = (const float*)d_in[6]; a.b_gr = (const float*)d_in[7]; a.w_er = (const float*)d_in[8]; a.b_er = (const float*)d_in[9]; a.w_gate = (const float*)d_in[10]; a.w_up = (const float*)d_in[11];
    a.w_down = (const float*)d_in[12]; a.fin_g = (const float*)d_in[13];
    a.out = (float*)d_out; a.ws = (unsigned char*)d_ws; a.pad = 0;
#if N_LAUNCH_MODE == 1
    a.ph_lo = 0; a.ph_hi = PH_COUNT; a.li = 0;
    hipLaunchKernelGGL(fwd, dim3(grid), dim3(NTHREADS), LDS_BYTES, stream, a);
#else
    for (int p = 0; p < PH_COUNT; ++p) { a.ph_lo = p; a.ph_hi = p + 1; a.li = p; hipLaunchKernelGGL(fwd, dim3(grid), dim3(NTHREADS), LDS_BYTES, stream, a); }
#endif
}
```

```cpp
#include <hip/hip_runtime.h>
#include <cstdio>
#include <cstdint>

#define LAS __attribute__((address_space(3)))
#define GAS __attribute__((address_space(1)))
typedef unsigned short bf16_t;
typedef short bf16x8 __attribute__((ext_vector_type(8)));
typedef float f32x4 __attribute__((ext_vector_type(4)));
typedef float f32x2 __attribute__((ext_vector_type(2)));
typedef unsigned u32x4 __attribute__((ext_vector_type(4)));
typedef unsigned u32x2 __attribute__((ext_vector_type(2)));

#ifndef PROBE_REPEAT
#define PROBE_REPEAT 0
#endif
#define RPT(k) ((((PROBE_REPEAT) >> (k)) & 1) ? 2 : 1)
#ifndef MOE_SPARSE
#define MOE_SPARSE 1
#endif
#ifndef ATT_MOBA
#define ATT_MOBA 1
#endif
#ifndef ATT_SB
#define ATT_SB 1
#endif
#ifndef ATT_DIL
#define ATT_DIL 1
#endif
constexpr int BATCH = 4, SEQ = 8192, DM = 1024, DEPTH = 4, T = BATCH * SEQ, NH = 16, HD = 64;
constexpr int NQKV = 3 * DM, NEXP = 16, DEXP = 256, NACT = NEXP * DEXP;
constexpr float NORM_EPS = 1e-6f;
constexpr float LOG2E = 1.4426950408889634f;
constexpr float QSCALE = 0.125f * LOG2E;
constexpr int NWAVES = 8, NTHREADS = 512;

constexpr size_t MiB = 1u << 20;
constexpr size_t WS_CTL = 0, CTL_ZERO_BYTES = 1 * MiB;
constexpr size_t WS_WIN = 2 * MiB;
constexpr size_t WS_WOUT = 26 * MiB;
constexpr size_t WS_WG = 34 * MiB;
constexpr size_t WS_WU = 66 * MiB;
constexpr size_t WS_WD = 98 * MiB;
constexpr size_t WS_KMEAN = 130 * MiB;
constexpr size_t WS_COMB = 131 * MiB;
constexpr size_t WS_HB = 134 * MiB;
constexpr size_t WS_Q = 198 * MiB, WS_K = 262 * MiB, WS_V = 326 * MiB, WS_O = 390 * MiB;
constexpr size_t WS_ACT = WS_Q;
constexpr size_t WS_LSE = 454 * MiB;
constexpr size_t WS_LIST = 458 * MiB;
constexpr size_t WS_WLIST = 461 * MiB;
constexpr size_t WS_END = 467 * MiB;
constexpr int CW_CNT = 1024;
constexpr int CW_BAR = 4096;

constexpr int RING_BYTES = 131072;
constexpr int LDSCTL_OFF = RING_BYTES, MISC_OFF = LDSCTL_OFF + 320;
constexpr int LDS_BYTES = 147456;

__device__ __forceinline__ unsigned f2bf(float f) { unsigned u = __builtin_bit_cast(unsigned, f); return (u + 0x7fffu + ((u >> 16) & 1u)) >> 16; }
__device__ __forceinline__ unsigned pk2(float lo, float hi) { return f2bf(lo) | (f2bf(hi) << 16); }
__device__ __forceinline__ float bflo(unsigned w) { return __builtin_bit_cast(float, w << 16); }
__device__ __forceinline__ float bfhi(unsigned w) { return __builtin_bit_cast(float, w & 0xffff0000u); }
template <int M> __device__ __forceinline__ float swz_xor(float v) { return __builtin_bit_cast(float, __builtin_amdgcn_ds_swizzle(__builtin_bit_cast(int, v), 0x1f | (M << 10))); }
__device__ __forceinline__ void swap32(unsigned x, unsigned& lo_val, unsigned& hi_val) { unsigned y = x; asm volatile("" : "+v"(y)); auto rr = __builtin_amdgcn_permlane32_swap(x, y, false, false); lo_val = rr[0]; hi_val = rr[1]; }
__device__ __forceinline__ float sum_xor32(float v) { unsigned a, b; swap32(__builtin_bit_cast(unsigned, v), a, b); return __builtin_bit_cast(float, a) + __builtin_bit_cast(float, b); }
__device__ __forceinline__ float max_xor32(float v) { unsigned a, b; swap32(__builtin_bit_cast(unsigned, v), a, b); return fmaxf(__builtin_bit_cast(float, a), __builtin_bit_cast(float, b)); }
__device__ __forceinline__ float get_xor32(float v, int hi) { unsigned a, b; swap32(__builtin_bit_cast(unsigned, v), a, b); return __builtin_bit_cast(float, hi ? a : b); }
__device__ __forceinline__ int get_xor32i(int v, int hi) { unsigned a, b; swap32((unsigned)v, a, b); return (int)(hi ? a : b); }
__device__ __forceinline__ float half_sum(float v) {
    v += swz_xor<1>(v); v += swz_xor<2>(v); v += swz_xor<4>(v); v += swz_xor<8>(v); v += swz_xor<16>(v);
    return v;
}
__device__ __forceinline__ float wave_sum(float v) { return sum_xor32(half_sum(v)); }
#define LDS_WAIT() asm volatile("s_waitcnt lgkmcnt(0)" ::: "memory")
#define LAUNDER_V(x) asm volatile("" : "+v"(x))
#define LAUNDER_S(x) asm volatile("" : "+s"(x))

namespace pg8 {
constexpr int BM = 256, BK = 64, HALF = 128, HTB = HALF * BK * 2, STAGE_BYTES = 8 * HTB, NXCD = 8, WGM = 8;
__host__ __device__ __forceinline__ int lds_byte(int r, int c) { const int st = (r >> 4) * 2 + (c >> 5), rr = r & 15, cc = c & 31, ob = rr * 64 + cc * 2; return st * 1024 + (ob ^ (((ob >> 9) & 1) << 5)); }
__host__ __device__ __forceinline__ void stage_rc(int b, int& R, int& C) { const int st = b / 1024, sb = b % 1024, swz = sb ^ (((sb >> 9) & 1) << 5); R = (st >> 1) * 16 + swz / 64; C = (st & 1) * 32 + (swz % 64) / 2; }
__host__ __device__ __forceinline__ int perm32(int rho) { const int n = rho >> 4, i = rho & 15; return 8 * (i >> 2) + 4 * n + (i & 3); }

struct Unit { int pm, pn, meta;
    __device__ __forceinline__ int bk() const { return meta & 31; } __device__ __forceinline__ int tib() const { return (meta >> 5) & 255; } __device__ __forceinline__ int nb() const { return meta >> 13; } };
struct Gemm { const char* A; const char* B; int lda, ldb, K; long tstepA, tstepB, hstepB; };

struct StaticOrder {
    int nM, nN, nwg, G, c;
    __host__ __device__ void init(int nM_, int nN_, int G_, int c_) { nM = nM_; nN = nN_; nwg = nM * nN; G = G_; c = c_; }
    __host__ __device__ bool next(int i, Unit& u) const {
        const long L = (long)i * G + c; if (L >= nwg) return false;
        int wgid = (int)L; { const int q = nwg / NXCD, r = nwg % NXCD, xcd = wgid % NXCD, off = wgid / NXCD; wgid = (xcd < r ? xcd * (q + 1) : r * (q + 1) + (xcd - r) * q) + off; }
        const int nig = WGM * nN, gid = wgid / nig, fm = gid * WGM, gsz = (nM - fm) < WGM ? (nM - fm) : WGM;
        u.pm = fm + ((wgid % nig) % gsz); u.pn = (wgid % nig) / gsz; return true;
    }
};

__device__ __forceinline__ unsigned cvt_pk_bf16(float lo, float hi) { unsigned r; asm volatile("v_cvt_pk_bf16_f32 %0, %1, %2" : "=v"(r) : "v"(lo), "v"(hi)); return r; }

struct EpiQKV {
    static constexpr bool PERM = true;
    bf16_t* O; size_t split_stride; float scale0;
    __device__ __forceinline__ void operator()(const f32x4 (&acc)[2][2][4][2], const Unit& u, int wr, int wc, int fr, int fq) const {
        asm volatile("" : "+v"(fr), "+v"(fq));
        const int row0 = u.pm * BM + wr * 64 + fr; int colt = u.pn * BM;
        const int t = colt / DM; bf16_t* base = O + (size_t)t * split_stride; colt -= t * DM; const float sc = (t == 0) ? scale0 : 1.f;
        const int col0 = colt + wc * 32 + 8 * fq;
#pragma unroll
        for (int ai = 0; ai < 2; ++ai)
#pragma unroll
            for (int m = 0; m < 4; ++m) { bf16_t* rowp = base + (size_t)(row0 + ai * HALF + m * 16) * DM + col0;
#pragma unroll
                for (int bj = 0; bj < 2; ++bj) { f32x4 v0 = acc[ai][bj][m][0] * sc, v1 = acc[ai][bj][m][1] * sc;
                    u32x4 w; w.x = cvt_pk_bf16(v0[0], v0[1]); w.y = cvt_pk_bf16(v0[2], v0[3]); w.z = cvt_pk_bf16(v1[0], v1[1]); w.w = cvt_pk_bf16(v1[2], v1[3]);
                    *(u32x4*)(rowp + bj * HALF) = w; } }
    }
};
struct EpiResAdd {
    static constexpr bool PERM = false;
    const float* base; float* out;
    __device__ __forceinline__ void operator()(const f32x4 (&acc)[2][2][4][2], const Unit& u, int wr, int wc, int fr, int fq) const {
        asm volatile("" : "+v"(fr), "+v"(fq));
        const int col0 = u.pn * BM + wc * 32 + 4 * fq;
#pragma unroll
        for (int ai = 0; ai < 2; ++ai)
#pragma unroll
            for (int m = 0; m < 4; ++m) { const size_t off = (size_t)(u.pm * BM + ai * HALF + wr * 64 + m * 16 + fr) * DM + col0;
#pragma unroll
                for (int bj = 0; bj < 2; ++bj)
#pragma unroll
                    for (int n = 0; n < 2; ++n) { const f32x4 bs = *(const f32x4*)(base + off + bj * HALF + n * 16); *(f32x4*)(out + off + bj * HALF + n * 16) = bs + acc[ai][bj][m][n]; } }
    }
};
struct EpiGateUpDense {
    static constexpr bool PERM = true;
    bf16_t* act; const float* comb;
    __device__ __forceinline__ void operator()(const f32x4 (&acc)[2][2][4][2], const Unit& u, int wr, int wc, int fr, int fq) const {
        asm volatile("" : "+v"(fr), "+v"(fq));
        const int e = u.pn >> 1, c0 = (u.pn & 1) * HALF;
        const int col0 = e * DEXP + c0 + wc * 32 + 8 * fq;
#pragma unroll
        for (int ai = 0; ai < 2; ++ai)
#pragma unroll
            for (int m = 0; m < 4; ++m) { const int row = u.pm * BM + ai * HALF + wr * 64 + m * 16 + fr;
                const float cw = comb[(size_t)row * NEXP + e];
                float o[8];
#pragma unroll
                for (int n = 0; n < 2; ++n)
#pragma unroll
                    for (int j = 0; j < 4; ++j) { const float g = acc[ai][0][m][n][j], up = acc[ai][1][m][n][j];
                        const float sg = g * __builtin_amdgcn_rcpf(1.f + __builtin_amdgcn_exp2f(-g * LOG2E));
                        o[n * 4 + j] = sg * up * cw; }
                u32x4 w; w.x = cvt_pk_bf16(o[0], o[1]); w.y = cvt_pk_bf16(o[2], o[3]); w.z = cvt_pk_bf16(o[4], o[5]); w.w = cvt_pk_bf16(o[6], o[7]);
                *(u32x4*)(act + (size_t)row * NACT + col0) = w; }
    }
};

template <class Epi, class Sched>
__device__ __forceinline__ void gemm_phase(LAS unsigned char* lds, const Gemm g, const Sched& S, const Epi& E, int wave_id) {
    int lane_l = (int)__builtin_amdgcn_mbcnt_hi(~0u, __builtin_amdgcn_mbcnt_lo(~0u, 0u)); asm volatile("" : "+v"(lane_l));
    const int wid = wave_id, lane = lane_l, tid = wid * 64 + lane, wr = wid >> 2, wc = wid & 3, fr = lane & 15, fq = lane >> 4;
    const int K = g.K, nt = K / BK;
    unsigned voffA[2], voffB[2];
#pragma unroll
    for (int i = 0; i < 2; ++i) { int R, C; stage_rc(tid * 16 + i * 8192, R, C); const int Rb = Epi::PERM ? ((R & ~31) + perm32(R & 31)) : R;
        voffA[i] = (unsigned)(R * g.lda + C) * 2u; voffB[i] = (unsigned)(Rb * g.ldb + C) * 2u; }
    const size_t kstep = (size_t)(BK * 2);
    const size_t hstepA = (size_t)HALF * g.lda * 2;
    const long hstepB = g.hstepB;
    const unsigned ldsw = (unsigned)wid * 1024u;
    const int aoff = lds_byte(wr * 64 + fr, fq * 8), boff = lds_byte(wc * 32 + fr, fq * 8);
#define PG8_SA(b, h) (((b) * 2 + (h)) * HTB)
#define PG8_SB(b, h) ((4 + (b) * 2 + (h)) * HTB)
#define PG8_STAGE(bufoff, gbase, voff) do { _Pragma("unroll") for (int _i = 0; _i < 2; ++_i) \
        __builtin_amdgcn_global_load_lds((const unsigned*)((const char*)(gbase) + (voff)[_i]), (LAS unsigned*)(lds + (bufoff) + ldsw + _i * 8192), 16, 0, 0); } while (0)
#define PG8_LDA(dst, b, h) do { _Pragma("unroll") for (int m = 0; m < 4; ++m) _Pragma("unroll") for (int k = 0; k < 2; ++k) dst[m][k] = *(const LAS bf16x8*)(lds + PG8_SA(b, h) + aoff + m * 2048 + k * 1024); } while (0)
#define PG8_LDB(dst, b, h) do { _Pragma("unroll") for (int n = 0; n < 2; ++n) _Pragma("unroll") for (int k = 0; k < 2; ++k) dst[n][k] = *(const LAS bf16x8*)(lds + PG8_SB(b, h) + boff + n * 2048 + k * 1024); } while (0)
#define PG8_MMA(ai, bj, At, Bt) do { __builtin_amdgcn_s_setprio(1); _Pragma("unroll") for (int m = 0; m < 4; ++m) _Pragma("unroll") for (int n = 0; n < 2; ++n) _Pragma("unroll") for (int k = 0; k < 2; ++k) \
        acc[ai][bj][m][n] = __builtin_amdgcn_mfma_f32_16x16x32_bf16(Bt[n][k], At[m][k], acc[ai][bj][m][n], 0, 0, 0); __builtin_amdgcn_s_setprio(0); } while (0)
#define PG8_WAIT_V(n) asm volatile("s_waitcnt vmcnt(" #n ")" ::: "memory")
#define PG8_WAIT_L(n) asm volatile("s_waitcnt lgkmcnt(" #n ")" ::: "memory")
#define PG8_BAR __builtin_amdgcn_s_barrier()
#define PG8_SCHED __builtin_amdgcn_sched_barrier(0)
    Unit cur, nxt; int ui = 0;
    if (!S.next(0, cur)) return;
    f32x4 acc[2][2][4][2];
#pragma unroll
    for (int a = 0; a < 2; ++a)
#pragma unroll
        for (int b = 0; b < 2; ++b)
#pragma unroll
            for (int m = 0; m < 4; ++m)
#pragma unroll
                for (int n = 0; n < 2; ++n) acc[a][b][m][n] = (f32x4){0.f, 0.f, 0.f, 0.f};
    bf16x8 At[4][2], B0[2][2], B1[2][2];
    const char* cA = g.A + (size_t)cur.pm * g.tstepA; const char* cB = g.B + (size_t)cur.pn * g.tstepB;
    PG8_STAGE(PG8_SB(0, 0), cB, voffB); PG8_STAGE(PG8_SB(0, 1), cB + hstepB, voffB); PG8_STAGE(PG8_SA(0, 0), cA, voffA); PG8_STAGE(PG8_SA(0, 1), cA + hstepA, voffA);
    if (wr == 1) PG8_BAR;
    PG8_WAIT_V(2); PG8_BAR;
    PG8_STAGE(PG8_SB(1, 0), cB + kstep, voffB); PG8_STAGE(PG8_SA(1, 0), cA + kstep, voffA); PG8_STAGE(PG8_SB(1, 1), cB + hstepB + kstep, voffB);
    PG8_WAIT_V(6); PG8_BAR;
    for (;;) {
        const bool has_next = S.next(ui + 1, nxt);
        const char* nA = has_next ? g.A + (size_t)nxt.pm * g.tstepA : cA; const char* nB = has_next ? g.B + (size_t)nxt.pn * g.tstepB : cB;
        for (int t = 0; t < nt; t += 2) {
            const bool last = (t == nt - 2);
            const char* a1 = cA + (size_t)(t + 1) * kstep;
            const char* a2 = last ? nA : cA + (size_t)(t + 2) * kstep; const char* b2 = last ? nB : cB + (size_t)(t + 2) * kstep;
            const char* a3 = a2 + kstep; const char* b3 = b2 + kstep;
            PG8_LDB(B0, 0, 0); PG8_LDB(B1, 0, 1); PG8_SCHED; PG8_LDA(At, 0, 0); PG8_STAGE(PG8_SA(1, 1), a1 + hstepA, voffA);
            PG8_WAIT_V(8); PG8_WAIT_L(0); PG8_BAR; PG8_MMA(0, 0, At, B0); PG8_MMA(0, 1, At, B1); PG8_BAR; PG8_SCHED;
            PG8_LDA(At, 0, 1); PG8_STAGE(PG8_SB(0, 0), b2, voffB); PG8_STAGE(PG8_SB(0, 1), b2 + hstepB, voffB); PG8_STAGE(PG8_SA(0, 0), a2, voffA);
            PG8_WAIT_V(8); PG8_WAIT_L(0); PG8_BAR; PG8_MMA(1, 0, At, B0); PG8_MMA(1, 1, At, B1); PG8_BAR; PG8_SCHED;
            PG8_LDB(B0, 1, 0); PG8_LDB(B1, 1, 1); PG8_SCHED; PG8_LDA(At, 1, 0); PG8_STAGE(PG8_SA(0, 1), a2 + hstepA, voffA);
            PG8_WAIT_V(8); PG8_WAIT_L(0); PG8_BAR; PG8_MMA(0, 0, At, B0); PG8_MMA(0, 1, At, B1); PG8_BAR; PG8_SCHED;
            PG8_LDA(At, 1, 1); PG8_STAGE(PG8_SB(1, 0), b3, voffB); PG8_STAGE(PG8_SB(1, 1), b3 + hstepB, voffB); PG8_STAGE(PG8_SA(1, 0), a3, voffA);
            PG8_WAIT_V(8); PG8_WAIT_L(0); PG8_BAR; PG8_MMA(1, 0, At, B0); PG8_MMA(1, 1, At, B1); PG8_BAR; PG8_SCHED;
        }
        if (wr == 0) PG8_BAR;
        E(acc, cur, wr, wc, fr, fq);
        if (!has_next) break;
#pragma unroll
        for (int a = 0; a < 2; ++a)
#pragma unroll
            for (int b = 0; b < 2; ++b)
#pragma unroll
                for (int m = 0; m < 4; ++m)
#pragma unroll
                    for (int n = 0; n < 2; ++n) acc[a][b][m][n] = (f32x4){0.f, 0.f, 0.f, 0.f};
        cur = nxt; cA = nA; cB = nB; ++ui;
        if (wr == 1) PG8_BAR;
    }
    PG8_WAIT_V(0);
    PG8_BAR;
#undef PG8_SA
#undef PG8_SB
#undef PG8_STAGE
#undef PG8_LDA
#undef PG8_LDB
#undef PG8_MMA
#undef PG8_WAIT_V
#undef PG8_WAIT_L
#undef PG8_BAR
#undef PG8_SCHED
}
template <class Epi, class Prob>
__device__ __forceinline__ void gemm_phase_x(LAS unsigned char* lds, const Prob& P, const Epi& E, int wave_id) {
    int lane_l = (int)__builtin_amdgcn_mbcnt_hi(~0u, __builtin_amdgcn_mbcnt_lo(~0u, 0u)); asm volatile("" : "+v"(lane_l));
    const int wid = wave_id, lane = lane_l, tid = wid * 64 + lane, wr = wid >> 2, wc = wid & 3, fr = lane & 15, fq = lane >> 4;
    const int K = P.K, nt = K / BK;
    unsigned voffB[2];
#pragma unroll
    for (int i = 0; i < 2; ++i) { int R, C; stage_rc(tid * 16 + i * 8192, R, C); const int Rb = Epi::PERM ? ((R & ~31) + perm32(R & 31)) : R; voffB[i] = (unsigned)(Rb * P.ldb + C) * 2u; }
    const size_t kstep = (size_t)(BK * 2);
    const long hstepB = P.hstepB;
    const unsigned ldsw = (unsigned)wid * 1024u;
    const int aoff = lds_byte(wr * 64 + fr, fq * 8), boff = lds_byte(wc * 32 + fr, fq * 8);
    LAS u32x4* stash = (LAS u32x4*)(lds + STAGE_BYTES + 1024) + tid;
#define PG8_SA(b, h) (((b) * 2 + (h)) * HTB)
#define PG8_SB(b, h) ((4 + (b) * 2 + (h)) * HTB)
#define PG8_STAGE(bufoff, gbase, voff) do { _Pragma("unroll") for (int _i = 0; _i < 2; ++_i) \
        __builtin_amdgcn_global_load_lds((const unsigned*)((const char*)(gbase) + (voff)[_i]), (LAS unsigned*)(lds + (bufoff) + ldsw + _i * 8192), 16, 0, 0); } while (0)
#define PG8_LDA(dst, b, h) do { _Pragma("unroll") for (int m = 0; m < 4; ++m) _Pragma("unroll") for (int k = 0; k < 2; ++k) dst[m][k] = *(const LAS bf16x8*)(lds + PG8_SA(b, h) + aoff + m * 2048 + k * 1024); } while (0)
#define PG8_LDB(dst, b, h) do { _Pragma("unroll") for (int n = 0; n < 2; ++n) _Pragma("unroll") for (int k = 0; k < 2; ++k) dst[n][k] = *(const LAS bf16x8*)(lds + PG8_SB(b, h) + boff + n * 2048 + k * 1024); } while (0)
#define PG8_MMA(ai, bj, At, Bt) do { __builtin_amdgcn_s_setprio(1); _Pragma("unroll") for (int m = 0; m < 4; ++m) _Pragma("unroll") for (int n = 0; n < 2; ++n) _Pragma("unroll") for (int k = 0; k < 2; ++k) \
        acc[ai][bj][m][n] = __builtin_amdgcn_mfma_f32_16x16x32_bf16(Bt[n][k], At[m][k], acc[ai][bj][m][n], 0, 0, 0); __builtin_amdgcn_s_setprio(0); } while (0)
#define PG8_WAIT_V(n) asm volatile("s_waitcnt vmcnt(" #n ")" ::: "memory")
#define PG8_WAIT_L(n) asm volatile("s_waitcnt lgkmcnt(" #n ")" ::: "memory")
#define PG8_BAR __builtin_amdgcn_s_barrier()
#define PG8_SCHED __builtin_amdgcn_sched_barrier(0)
#define PG8_AVOFF(dst, u) do { int t2_ = tid; asm volatile("" : "+v"(t2_)); _Pragma("unroll") for (int i_ = 0; i_ < 2; ++i_) { int R_, C_; stage_rc(t2_ * 16 + i_ * 8192, R_, C_); _Pragma("unroll") for (int h_ = 0; h_ < 2; ++h_) \
        dst[h_][i_] = (Prob::GATHER ? P.arow_off(u, h_, R_) : (unsigned)((h_ * HALF + R_) * P.lda) * 2u) + (unsigned)C_ * 2u; } } while (0)
    Unit cur, nxt; int ui = 0;
    if (!P.next(0, cur)) return;
    unsigned vA[2][2];
    PG8_AVOFF(vA, cur);
    f32x4 acc[2][2][4][2];
#pragma unroll
    for (int a = 0; a < 2; ++a)
#pragma unroll
        for (int b = 0; b < 2; ++b)
#pragma unroll
            for (int m = 0; m < 4; ++m)
#pragma unroll
                for (int n = 0; n < 2; ++n) acc[a][b][m][n] = (f32x4){0.f, 0.f, 0.f, 0.f};
    bf16x8 At[4][2], B0[2][2], B1[2][2];
    const char* cA = P.a_base(cur); const char* cB = P.b_base(cur);
    long csplit = Prob::KSPLIT ? P.bsplit(cur) : 0;
    PG8_STAGE(PG8_SB(0, 0), cB, voffB); PG8_STAGE(PG8_SB(0, 1), cB + hstepB, voffB); PG8_STAGE(PG8_SA(0, 0), cA, vA[0]); PG8_STAGE(PG8_SA(0, 1), cA, vA[1]);
    if (wr == 1) PG8_BAR;
    PG8_WAIT_V(2); PG8_BAR;
    PG8_STAGE(PG8_SB(1, 0), cB + kstep, voffB); PG8_STAGE(PG8_SA(1, 0), cA + kstep, vA[0]); PG8_STAGE(PG8_SB(1, 1), cB + hstepB + kstep, voffB);
    PG8_WAIT_V(6); PG8_BAR;
    for (;;) {
        const bool has_next = P.next(ui + 1, nxt);
        const char* nA = has_next ? P.a_base(nxt) : cA; const char* nB = has_next ? P.b_base(nxt) : cB;
        if (Prob::GATHER) { unsigned vN[2][2];
            if (has_next) { PG8_AVOFF(vN, nxt); } else { vN[0][0] = vA[0][0]; vN[0][1] = vA[0][1]; vN[1][0] = vA[1][0]; vN[1][1] = vA[1][1]; }
            *stash = (u32x4){vN[0][0], vN[0][1], vN[1][0], vN[1][1]}; }
        for (int t = 0; t < nt; t += 2) {
            const bool last = (t == nt - 2);
            const char* a1 = cA + (size_t)(t + 1) * kstep;
            const char* a2 = last ? nA : cA + (size_t)(t + 2) * kstep;
            const char* b2 = last ? nB : cB + (size_t)(t + 2) * kstep + ((Prob::KSPLIT && (t + 2) >= (nt >> 1)) ? csplit : 0);
            const char* a3 = a2 + kstep; const char* b3 = b2 + kstep;
            PG8_LDB(B0, 0, 0); PG8_LDB(B1, 0, 1); PG8_SCHED; PG8_LDA(At, 0, 0); PG8_STAGE(PG8_SA(1, 1), a1, vA[1]);
            if (Prob::GATHER && last) { const u32x4 sv = *stash; vA[0][0] = sv.x; vA[0][1] = sv.y; vA[1][0] = sv.z; vA[1][1] = sv.w; }
            PG8_WAIT_V(8); PG8_WAIT_L(0); PG8_BAR; PG8_MMA(0, 0, At, B0); PG8_MMA(0, 1, At, B1); PG8_BAR; PG8_SCHED;
            PG8_LDA(At, 0, 1); PG8_STAGE(PG8_SB(0, 0), b2, voffB); PG8_STAGE(PG8_SB(0, 1), b2 + hstepB, voffB); PG8_STAGE(PG8_SA(0, 0), a2, vA[0]);
            PG8_WAIT_V(8); PG8_WAIT_L(0); PG8_BAR; PG8_MMA(1, 0, At, B0); PG8_MMA(1, 1, At, B1); PG8_BAR; PG8_SCHED;
            PG8_LDB(B0, 1, 0); PG8_LDB(B1, 1, 1); PG8_SCHED; PG8_LDA(At, 1, 0); PG8_STAGE(PG8_SA(0, 1), a2, vA[1]);
            PG8_WAIT_V(8); PG8_WAIT_L(0); PG8_BAR; PG8_MMA(0, 0, At, B0); PG8_MMA(0, 1, At, B1); PG8_BAR; PG8_SCHED;
            PG8_LDA(At, 1, 1); PG8_STAGE(PG8_SB(1, 0), b3, voffB); PG8_STAGE(PG8_SB(1, 1), b3 + hstepB, voffB); PG8_STAGE(PG8_SA(1, 0), a3, vA[0]);
            PG8_WAIT_V(8); PG8_WAIT_L(0); PG8_BAR; PG8_MMA(1, 0, At, B0); PG8_MMA(1, 1, At, B1); PG8_BAR; PG8_SCHED;
        }
        if (wr == 0) PG8_BAR;
        E(acc, cur, wr, wc, fr, fq);
        if (!has_next) break;
#pragma unroll
        for (int a = 0; a < 2; ++a)
#pragma unroll
            for (int b = 0; b < 2; ++b)
#pragma unroll
                for (int m = 0; m < 4; ++m)
#pragma unroll
                    for (int n = 0; n < 2; ++n) acc[a][b][m][n] = (f32x4){0.f, 0.f, 0.f, 0.f};
        cur = nxt; cA = nA; cB = nB; ++ui;
        if (Prob::KSPLIT) csplit = P.bsplit(cur);
        if (wr == 1) PG8_BAR;
    }
    PG8_WAIT_V(0);
    PG8_BAR;
#undef PG8_SA
#undef PG8_SB
#undef PG8_STAGE
#undef PG8_LDA
#undef PG8_LDB
#undef PG8_MMA
#undef PG8_WAIT_V
#undef PG8_WAIT_L
#undef PG8_BAR
#undef PG8_SCHED
#undef PG8_AVOFF
}

__device__ __forceinline__ int pair_a(int pi) { return pi < 3 ? 0 : (pi < 5 ? 1 : 2); }
__device__ __forceinline__ int pair_b(int pi) { return pi == 0 ? 1 : ((pi == 1 || pi == 3) ? 2 : 3); }
template <int MODE>
struct MoeProb {
    static constexpr bool GATHER = (MODE == 0), KSPLIT = (MODE == 1);
    const unsigned* cnt; const unsigned* list; const char* A; const char* B; int lda, ldb, K; long hstepB; int G, c;
    __device__ __forceinline__ bool next(int i, Unit& u) const {
        const long L = (long)i * G + c; const int tileidx = (int)(L >> 2);
        int accu = 0, bk = -1, tib = 0, nb = 0;
        for (int k = 0; k < 24; ++k) { const int n = (int)cnt[k]; const int tl = (n + 255) >> 8; if (bk < 0 && tileidx < accu + tl) { bk = k; tib = tileidx - accu; nb = n; } accu += tl; }
        if (bk < 0) return false;
        u.pm = tileidx; u.pn = (int)(L & 3); u.meta = bk | (tib << 5) | (nb << 13); return true;
    }
    __device__ __forceinline__ int expert(const Unit& u, int s) const { const int g = u.bk() / 6, pi = u.bk() % 6; return g * 4 + (s ? pair_b(pi) : pair_a(pi)); }
    __device__ __forceinline__ const char* a_base(const Unit& u) const { return MODE == 0 ? A : A + (size_t)u.pm * 256 * lda * 2; }
    __device__ __forceinline__ const char* b_base(const Unit& u) const {
        if (MODE == 0) return B + ((size_t)expert(u, u.pn >> 1) * DEXP + (size_t)(u.pn & 1) * HALF) * ldb * 2;
        return B + (size_t)u.pn * 256 * ldb * 2 + (size_t)expert(u, 0) * DEXP * 2;
    }
    __device__ __forceinline__ unsigned arow_off(const Unit& u, int h, int R) const { const int pos = u.tib() * 256 + h * HALF + R; const unsigned tok = pos < u.nb() ? list[(size_t)u.bk() * T + pos] : 0u; return tok * (unsigned)(lda * 2); }
    __device__ __forceinline__ long bsplit(const Unit& u) const { return ((long)(expert(u, 1) - expert(u, 0)) * DEXP - DEXP) * 2; }
};
struct EpiGateUpSparse {
    static constexpr bool PERM = true;
    bf16_t* act; const float* wlist;
    __device__ __forceinline__ void operator()(const f32x4 (&acc)[2][2][4][2], const Unit& u, int wr, int wc, int fr, int fq) const {
        asm volatile("" : "+v"(fr), "+v"(fq));
        const int s = u.pn >> 1, col0 = s * DEXP + (u.pn & 1) * HALF + wc * 32 + 8 * fq;
#pragma unroll
        for (int ai = 0; ai < 2; ++ai)
#pragma unroll
            for (int m = 0; m < 4; ++m) { const int r = ai * HALF + wr * 64 + m * 16 + fr, pos = u.tib() * 256 + r;
                const float cw = pos < u.nb() ? wlist[((size_t)u.bk() * T + pos) * 2 + s] : 0.f;
                float o[8];
#pragma unroll
                for (int n = 0; n < 2; ++n)
#pragma unroll
                    for (int j = 0; j < 4; ++j) { const float g = acc[ai][0][m][n][j], up = acc[ai][1][m][n][j];
                        const float sg = g * __builtin_amdgcn_rcpf(1.f + __builtin_amdgcn_exp2f(-g * LOG2E));
                        o[n * 4 + j] = sg * up * cw; }
                u32x4 w; w.x = cvt_pk_bf16(o[0], o[1]); w.y = cvt_pk_bf16(o[2], o[3]); w.z = cvt_pk_bf16(o[4], o[5]); w.w = cvt_pk_bf16(o[6], o[7]);
                *(u32x4*)(act + ((size_t)u.pm * 256 + r) * 512 + col0) = w;
                if (m & 1) asm volatile("" ::: "memory"); }
    }
};
struct EpiDownScatter {
    static constexpr bool PERM = false;
    float* x; const unsigned* list;
    __device__ __forceinline__ void operator()(const f32x4 (&acc)[2][2][4][2], const Unit& u, int wr, int wc, int fr, int fq) const {
        asm volatile("" : "+v"(fr), "+v"(fq));
        const int col0 = u.pn * BM + wc * 32 + 4 * fq;
#pragma unroll
        for (int ai = 0; ai < 2; ++ai)
#pragma unroll
            for (int m = 0; m < 4; ++m) { const int pos = u.tib() * 256 + ai * HALF + wr * 64 + m * 16 + fr;
                if (pos < u.nb()) { const size_t off = (size_t)list[(size_t)u.bk() * T + pos] * DM + col0;
#pragma unroll
                    for (int bj = 0; bj < 2; ++bj)
#pragma unroll
                        for (int n = 0; n < 2; ++n) { f32x4* p = (f32x4*)(x + off + bj * HALF + n * 16); *p = *p + acc[ai][bj][m][n]; } }
                asm volatile("" ::: "memory"); }
    }
};
}

#define XB_TMO      128
#define XB_XCNT(j)  (256  + 64 * (j))
#define XB_XSUB(j)  (1280 + 64 * (j))
#define XB_XGEN(j)  (2304 + 64 * (j))
#define XB_TOP      3328
#define XB_TOPGEN   3392
#define XCD_BAR_WORDS 3456
#define XB_SPIN_CAP (1u << 18)
__device__ __forceinline__ unsigned xb_ld(unsigned* p)              { return __hip_atomic_load(p, __ATOMIC_RELAXED, __HIP_MEMORY_SCOPE_AGENT); }
__device__ __forceinline__ unsigned xb_add(unsigned* p, unsigned v) { return __hip_atomic_fetch_add(p, v, __ATOMIC_RELAXED, __HIP_MEMORY_SCOPE_AGENT); }
__device__ __forceinline__ unsigned xb_xcc_id() { return (unsigned)__builtin_amdgcn_s_getreg((3 << 11) | 20) & 0xFu; }
#define XB_SPIN(cond, bar) do { unsigned _sp = 0; while (cond) { __builtin_amdgcn_s_sleep(1); \
    if ((++_sp & 255u) == 0u) { if (xb_ld(&(bar)[XB_TMO])) break; if (_sp > XB_SPIN_CAP) { atomicAdd(&(bar)[XB_TMO], 1u); break; } } } } while (0)
struct XcdBarrier { unsigned* bar; unsigned x; volatile LAS unsigned* st; };
__device__ __forceinline__ XcdBarrier xcd_barrier_post(unsigned* bar, volatile LAS unsigned* st) {
    XcdBarrier b; b.bar = bar; b.x = xb_xcc_id(); b.st = st;
    if (threadIdx.x == 0) (void)xb_add(&bar[XB_XCNT(b.x)], 1u);
    return b;
}
__device__ __forceinline__ void xcd_barrier_complete(unsigned* bar, unsigned x, unsigned& nloc, unsigned& nx) {
    const unsigned G = gridDim.x * gridDim.y * gridDim.z;
    unsigned sum, cnt, mine, sp = 0u;
    for (;;) {
        sum = 0u; cnt = 0u; mine = 0u;
#pragma unroll
        for (unsigned j = 0; j < 16; ++j) { const unsigned c = xb_ld(&bar[XB_XCNT(j)]); sum += c; cnt += (c > 0u) ? 1u : 0u; mine = (j == x) ? c : mine; }
        if (sum == G) break;
        __builtin_amdgcn_s_sleep(1);
        if ((++sp & 255u) == 0u) { if (xb_ld(&bar[XB_TMO])) break; if (sp > XB_SPIN_CAP) { atomicAdd(&bar[XB_TMO], 1u); break; } }
    }
    nloc = mine > 0u ? mine : 1u; nx = cnt > 0u ? cnt : 1u;
}
__device__ __forceinline__ void xcd_barrier(const XcdBarrier& b) {
    asm volatile("s_waitcnt vmcnt(0)" ::: "memory");
    __syncthreads();
    if (threadIdx.x == 0) {
        unsigned* bar = b.bar;
        __builtin_amdgcn_s_waitcnt(0);
        unsigned nloc = b.st[0], nx = b.st[1];
        if (nloc == 0u) { xcd_barrier_complete(bar, b.x, nloc, nx); b.st[0] = nloc; b.st[1] = nx; }
        const unsigned old = xb_add(&bar[XB_XSUB(b.x)], 1u);
        const unsigned gen = old / nloc;
        if (old + 1u == (gen + 1u) * nloc) {
            __builtin_amdgcn_fence(__ATOMIC_RELEASE, "agent");
            asm volatile("s_waitcnt vmcnt(0)" ::: "memory");
            const unsigned og = xb_add(&bar[XB_TOP], 1u);
            const unsigned tg = og / nx;
            if (og + 1u == (tg + 1u) * nx) xb_add(&bar[XB_TOPGEN], 1u);
            else XB_SPIN(xb_ld(&bar[XB_TOPGEN]) == tg, bar);
            __builtin_amdgcn_fence(__ATOMIC_ACQUIRE, "agent");
            xb_add(&bar[XB_XGEN(b.x)], 1u);
            asm volatile("s_waitcnt vmcnt(0)" ::: "memory");
        } else {
            XB_SPIN(xb_ld(&bar[XB_XGEN(b.x)]) == gen, bar);
            __builtin_amdgcn_fence(__ATOMIC_ACQUIRE, "agent");
            asm volatile("s_waitcnt vmcnt(0)" ::: "memory");
        }
    }
    __syncthreads();
}

struct Args {
    const float* x; const float* ln1_g; const float* w_in; const float* mix_g; const float* w_out; const float* ln2_g;
    const float* w_gr; const float* b_gr; const float* w_er; const float* b_er; const float* w_gate; const float* w_up; const float* w_down; const float* fin_g;
    float* out; unsigned char* ws; int ph_lo, ph_hi, li, pad;
};

__device__ __forceinline__ void transpose_item(const float* W, int K, int N, bf16_t* WT, int dpitch, int dcol, LAS float* scr, int item, int lane) {
    const int nblk = N / 32, kb = item / nblk, nb = item % nblk, k0 = 64 * kb, n0 = 32 * nb;
#pragma unroll 8
    for (int i = 0; i < 32; ++i) { const int kk = 2 * i + (lane >> 5); scr[kk * 33 + (lane & 31)] = W[(size_t)(k0 + kk) * N + n0 + (lane & 31)]; }
    LDS_WAIT(); asm volatile("" ::: "memory");
    const int c = lane & 7;
#pragma unroll
    for (int j = 0; j < 4; ++j) { const int n = (lane >> 3) + 8 * j; const LAS float* s = scr + (8 * c) * 33 + n;
        u32x4 o; o.x = pk2(s[0 * 33], s[1 * 33]); o.y = pk2(s[2 * 33], s[3 * 33]); o.z = pk2(s[4 * 33], s[5 * 33]); o.w = pk2(s[6 * 33], s[7 * 33]);
        *(u32x4*)(WT + (size_t)(n0 + n) * dpitch + dcol + k0 + 8 * c) = o; }
    LDS_WAIT(); asm volatile("" ::: "memory");
}
__device__ __forceinline__ void phase_prologue(const Args& a, LAS unsigned char* lds, int gw, int NGW, int wave, int lane) {
    LAS float* scr = (LAS float*)(lds + wave * 16384);
    constexpr int I_IN = (DM / 64) * (NQKV / 32);
    constexpr int I_OUT = (DM / 64) * (DM / 32);
    constexpr int I_G = (DM / 64) * (DEXP / 32);
    constexpr int I_D = (DEXP / 64) * (DM / 32);
    constexpr int N_IN = DEPTH * I_IN, N_OUT = DEPTH * I_OUT, N_G = DEPTH * NEXP * I_G, N_D = DEPTH * NEXP * I_D;
    constexpr int NITEMS = N_IN + N_OUT + 2 * N_G + N_D;
    bf16_t* WinT = (bf16_t*)(a.ws + WS_WIN); bf16_t* WoutT = (bf16_t*)(a.ws + WS_WOUT); bf16_t* WgT = (bf16_t*)(a.ws + WS_WG); bf16_t* WuT = (bf16_t*)(a.ws + WS_WU); bf16_t* WdT = (bf16_t*)(a.ws + WS_WD);
    for (int it = gw; it < NITEMS; it += NGW) {
        int r = it;
        if (r < N_IN) { const int l = r / I_IN; transpose_item(a.w_in + (size_t)l * DM * NQKV, DM, NQKV, WinT + (size_t)l * NQKV * DM, DM, 0, scr, r % I_IN, lane); continue; } r -= N_IN;
        if (r < N_OUT) { const int l = r / I_OUT; transpose_item(a.w_out + (size_t)l * DM * DM, DM, DM, WoutT + (size_t)l * DM * DM, DM, 0, scr, r % I_OUT, lane); continue; } r -= N_OUT;
        if (r < N_G) { const int le = r / I_G; transpose_item(a.w_gate + (size_t)le * DM * DEXP, DM, DEXP, WgT + (size_t)le * DEXP * DM, DM, 0, scr, r % I_G, lane); continue; } r -= N_G;
        if (r < N_G) { const int le = r / I_G; transpose_item(a.w_up + (size_t)le * DM * DEXP, DM, DEXP, WuT + (size_t)le * DEXP * DM, DM, 0, scr, r % I_G, lane); continue; } r -= N_G;
        { const int le = r / I_D, l = le / NEXP, e = le % NEXP; transpose_item(a.w_down + (size_t)le * DEXP * DM, DEXP, DM, WdT + (size_t)l * DM * NACT, NACT, e * DEXP, scr, r % I_D, lane); }
    }
}

__device__ __forceinline__ void phase_norm1(const float* x, const float* g, bf16_t* hb, int gw, int NGW, int lane) {
    f32x4 gv[4];
#pragma unroll
    for (int j = 0; j < 4; ++j) gv[j] = *((const f32x4*)g + lane + 64 * j);
    for (int m = gw; m < T; m += NGW) {
        const f32x4* xr = (const f32x4*)(x + (size_t)m * DM) + lane;
        f32x4 v[4]; float s = 0.f;
#pragma unroll
        for (int j = 0; j < 4; ++j) { v[j] = xr[64 * j]; s += (v[j].x * v[j].x + v[j].y * v[j].y) + (v[j].z * v[j].z + v[j].w * v[j].w); }
        const float rstd = 1.0f / sqrtf(wave_sum(s) * (1.f / DM) + NORM_EPS);
        u32x2* o8 = (u32x2*)(hb + (size_t)m * DM) + lane;
#pragma unroll
        for (int j = 0; j < 4; ++j) { u32x2 w; w.x = pk2(v[j].x * rstd * gv[j].x, v[j].y * rstd * gv[j].y); w.y = pk2(v[j].z * rstd * gv[j].z, v[j].w * rstd * gv[j].w); o8[64 * j] = w; }
    }
}
__device__ __forceinline__ void phase_mixnorm(const bf16_t* ob, bf16_t* hb, const float* lse, const float* g, int gw, int NGW, int lane) {
    float g0[8], g1[8];
#pragma unroll
    for (int j = 0; j < 8; ++j) { g0[j] = g[8 * lane + j]; g1[j] = g[512 + 8 * lane + j]; }
    const int hh = lane >> 3;
    for (int m = gw; m < T; m += NGW) {
        const u32x4 a = *((const u32x4*)(ob + (size_t)m * DM) + lane), c0 = *((const u32x4*)(ob + (size_t)m * DM + 512) + lane);
        const u32x4 c1 = *((const u32x4*)(hb + (size_t)m * DM) + lane), c2 = *((const u32x4*)(hb + (size_t)m * DM + 512) + lane);
        const float l0 = lse[(size_t)m * 8 + hh], l1 = lse[(size_t)T * 8 + (size_t)m * 8 + hh], l2 = lse[(size_t)2 * T * 8 + (size_t)m * 8 + hh];
        const float mx = fmaxf(l0, fmaxf(l1, l2));
        float w0 = __builtin_amdgcn_exp2f(l0 - mx), w1 = __builtin_amdgcn_exp2f(l1 - mx), w2 = __builtin_amdgcn_exp2f(l2 - mx);
        const float inv = 1.0f / (w0 + w1 + w2); w0 *= inv; w1 *= inv; w2 *= inv;
        float va[8] = {bflo(a.x), bfhi(a.x), bflo(a.y), bfhi(a.y), bflo(a.z), bfhi(a.z), bflo(a.w), bfhi(a.w)};
        const float x0[8] = {bflo(c0.x), bfhi(c0.x), bflo(c0.y), bfhi(c0.y), bflo(c0.z), bfhi(c0.z), bflo(c0.w), bfhi(c0.w)};
        const float x1[8] = {bflo(c1.x), bfhi(c1.x), bflo(c1.y), bfhi(c1.y), bflo(c1.z), bfhi(c1.z), bflo(c1.w), bfhi(c1.w)};
        const float x2[8] = {bflo(c2.x), bfhi(c2.x), bflo(c2.y), bfhi(c2.y), bflo(c2.z), bfhi(c2.z), bflo(c2.w), bfhi(c2.w)};
        float vc[8];
        float sa = 0.f, sc = 0.f;
#pragma unroll
        for (int j = 0; j < 8; ++j) { vc[j] = w0 * x0[j] + w1 * x1[j] + w2 * x2[j]; sa += va[j] * va[j]; sc += vc[j] * vc[j]; }
        sa = half_sum(sa); sc = wave_sum(sc);
        const float ra = 1.0f / sqrtf(sa * (1.f / 256.f) + NORM_EPS), rc = 1.0f / sqrtf(sc * (1.f / 512.f) + NORM_EPS);
        u32x4 oa, oc;
        oa.x = pk2(va[0] * ra * g0[0], va[1] * ra * g0[1]); oa.y = pk2(va[2] * ra * g0[2], va[3] * ra * g0[3]); oa.z = pk2(va[4] * ra * g0[4], va[5] * ra * g0[5]); oa.w = pk2(va[6] * ra * g0[6], va[7] * ra * g0[7]);
        oc.x = pk2(vc[0] * rc * g1[0], vc[1] * rc * g1[1]); oc.y = pk2(vc[2] * rc * g1[2], vc[3] * rc * g1[3]); oc.z = pk2(vc[4] * rc * g1[4], vc[5] * rc * g1[5]); oc.w = pk2(vc[6] * rc * g1[6], vc[7] * rc * g1[7]);
        *((u32x4*)(hb + (size_t)m * DM) + lane) = oa; *((u32x4*)(hb + (size_t)m * DM + 512) + lane) = oc;
    }
}
__device__ __forceinline__ void phase_route(const float* x, const float* g, const float* wgr, const float* bgr, const float* wer, const float* ber,
                                            bf16_t* hb, unsigned* cnt, unsigned* list, float* wlist, LAS unsigned char* lds, int v, int G, int wave, int lane) {
    const int tid = wave * 64 + lane;
    LAS f32x4* wl = (LAS f32x4*)lds;
    for (int idx = tid; idx < 5 * DM; idx += NTHREADS) { const int mtx = idx >> 10, d = idx & 1023; const float* src = (mtx == 0 ? wgr : wer + (size_t)(mtx - 1) * DM * 4) + d * 4;
        wl[mtx * 1024 + (d & 3) * 256 + (d >> 2)] = *(const f32x4*)src; }
    LAS unsigned* cl = (LAS unsigned*)(lds + 81920);
    LAS u32x2* info = (LAS u32x2*)(lds + 81920 + 256);
    LAS f32x2* infw = (LAS f32x2*)(lds + 81920 + 256 + 4096);
    if (tid < 64) cl[tid] = 0u;
    __syncthreads();
    const int rpw = (T + G - 1) / G, row0 = v * rpw;
    f32x4 gv[4];
#pragma unroll
    for (int j = 0; j < 4; ++j) gv[j] = *((const f32x4*)g + lane + 64 * j);
    const f32x4 bg = *(const f32x4*)bgr;
    for (int r = wave; r < rpw; r += NWAVES) {
        const int m = row0 + r; if (m >= T) break;
        const f32x4* xr = (const f32x4*)(x + (size_t)m * DM) + lane;
        f32x4 vv[4]; float s = 0.f;
#pragma unroll
        for (int j = 0; j < 4; ++j) { vv[j] = xr[64 * j]; s += (vv[j].x * vv[j].x + vv[j].y * vv[j].y) + (vv[j].z * vv[j].z + vv[j].w * vv[j].w); }
        const float rstd = 1.0f / sqrtf(wave_sum(s) * (1.f / DM) + NORM_EPS);
        u32x2* o8 = (u32x2*)(hb + (size_t)m * DM) + lane;
#pragma unroll
        for (int j = 0; j < 4; ++j) { vv[j] = vv[j] * rstd * gv[j]; u32x2 w; w.x = pk2(vv[j].x, vv[j].y); w.y = pk2(vv[j].z, vv[j].w); o8[64 * j] = w; }
        f32x4 gl = (f32x4){0.f, 0.f, 0.f, 0.f};
#pragma unroll
        for (int j = 0; j < 4; ++j) { LAS f32x4* wp = wl + lane + 64 * j;
            gl += wp[0] * vv[j].x; gl += wp[256] * vv[j].y; gl += wp[512] * vv[j].z; gl += wp[768] * vv[j].w; }
        gl.x = wave_sum(gl.x) + bg.x; gl.y = wave_sum(gl.y) + bg.y; gl.z = wave_sum(gl.z) + bg.z; gl.w = wave_sum(gl.w) + bg.w;
        int gi = 0; float gm = gl.x;
        if (gl.y > gm) { gm = gl.y; gi = 1; } if (gl.z > gm) { gm = gl.z; gi = 2; } if (gl.w > gm) { gm = gl.w; gi = 3; }
        const float gden = __expf(gl.x - gm) + __expf(gl.y - gm) + __expf(gl.z - gm) + __expf(gl.w - gm);
        const float gw_ = 1.0f / gden;
        gi = __builtin_amdgcn_readfirstlane(gi);
        f32x4 el = (f32x4){0.f, 0.f, 0.f, 0.f};
#pragma unroll
        for (int j = 0; j < 4; ++j) { LAS f32x4* wp = wl + (1 + gi) * 1024 + lane + 64 * j;
            el += wp[0] * vv[j].x; el += wp[256] * vv[j].y; el += wp[512] * vv[j].z; el += wp[768] * vv[j].w; }
        const f32x4 be = *(const f32x4*)(ber + gi * 4);
        float e[4] = {wave_sum(el.x) + be.x, wave_sum(el.y) + be.y, wave_sum(el.z) + be.z, wave_sum(el.w) + be.w};
        int i1 = 0; float v1 = e[0];
#pragma unroll
        for (int k = 1; k < 4; ++k) if (e[k] > v1) { v1 = e[k]; i1 = k; }
        int i2 = -1; float v2 = -INFINITY;
#pragma unroll
        for (int k = 0; k < 4; ++k) if (k != i1 && e[k] > v2) { v2 = e[k]; i2 = k; }
        const float p2 = __expf(v2 - v1), inv = 1.0f / (1.0f + p2);
        const float w1 = inv * gw_, w2 = p2 * inv * gw_;
        const int ea = i1 < i2 ? i1 : i2, eb = i1 < i2 ? i2 : i1; const float wa = i1 < i2 ? w1 : w2, wb = i1 < i2 ? w2 : w1;
        const int pi = (ea == 0) ? (eb - 1) : (ea == 1 ? eb + 1 : 5), bk = gi * 6 + pi;
        if (lane == 0) { const unsigned rank = __hip_atomic_fetch_add(cl + bk, 1u, __ATOMIC_RELAXED, __HIP_MEMORY_SCOPE_WORKGROUP);
            info[r] = (u32x2){(unsigned)bk, rank}; infw[r] = (f32x2){wa, wb}; }
    }
    __syncthreads();
    if (tid < 24) cl[32 + tid] = __hip_atomic_fetch_add(cnt + tid, cl[tid], __ATOMIC_RELAXED, __HIP_MEMORY_SCOPE_AGENT);
    __syncthreads();
    if (tid < rpw && row0 + tid < T) { const u32x2 inf = info[tid]; const f32x2 wv = infw[tid]; const size_t slot = (size_t)inf.x * T + cl[32 + inf.x] + inf.y;
        list[slot] = (unsigned)(row0 + tid); *(f32x2*)(wlist + slot * 2) = wv; }
    __syncthreads();
}
__device__ __forceinline__ void phase_final(float* x, const float* g, int gw, int NGW, int lane) {
    f32x4 gv[4];
#pragma unroll
    for (int j = 0; j < 4; ++j) gv[j] = *((const f32x4*)g + lane + 64 * j);
    for (int m = gw; m < T; m += NGW) {
        f32x4* xr = (f32x4*)(x + (size_t)m * DM) + lane;
        f32x4 v[4]; float s = 0.f;
#pragma unroll
        for (int j = 0; j < 4; ++j) { v[j] = xr[64 * j]; s += (v[j].x * v[j].x + v[j].y * v[j].y) + (v[j].z * v[j].z + v[j].w * v[j].w); }
        const float rstd = 1.0f / sqrtf(wave_sum(s) * (1.f / DM) + NORM_EPS);
#pragma unroll
        for (int j = 0; j < 4; ++j) xr[64 * j] = v[j] * rstd * gv[j];
    }
}
__device__ __forceinline__ void phase_kmean(const bf16_t* kb, float* kmean, int gw, int NGW, int lane) {
    for (int it = gw; it < BATCH * 4 * 32; it += NGW) {
        const int b = it >> 7, h = (it >> 5) & 3, blk = it & 31;
        const bf16_t* base = kb + ((size_t)b * SEQ + (size_t)blk * 256) * DM + h * HD + (lane & 7) * 8;
        float acc[8] = {0.f, 0.f, 0.f, 0.f, 0.f, 0.f, 0.f, 0.f};
#pragma unroll 4
        for (int i = 0; i < 32; ++i) { const u32x4 w = *(const u32x4*)(base + (size_t)((lane >> 3) + 8 * i) * DM);
            acc[0] += bflo(w.x); acc[1] += bfhi(w.x); acc[2] += bflo(w.y); acc[3] += bfhi(w.y); acc[4] += bflo(w.z); acc[5] += bfhi(w.z); acc[6] += bflo(w.w); acc[7] += bfhi(w.w); }
#pragma unroll
        for (int j = 0; j < 8; ++j) { acc[j] += swz_xor<8>(acc[j]); acc[j] += swz_xor<16>(acc[j]); acc[j] = sum_xor32(acc[j]); }
        if (lane < 8) {
            float* o = kmean + (size_t)it * HD + lane * 8;
#pragma unroll
            for (int j = 0; j < 8; ++j) o[j] = acc[j] * (1.f / 256.f);
        }
    }
}

__device__ __forceinline__ void ld_row64(float (&r)[64], const bf16_t* p) {
#pragma unroll
    for (int c = 0; c < 8; ++c) { const u32x4 w = *((const u32x4*)p + c);
        r[8 * c + 0] = bflo(w.x); r[8 * c + 1] = bfhi(w.x); r[8 * c + 2] = bflo(w.y); r[8 * c + 3] = bfhi(w.y); r[8 * c + 4] = bflo(w.z); r[8 * c + 5] = bfhi(w.z); r[8 * c + 6] = bflo(w.w); r[8 * c + 7] = bfhi(w.w); }
}
__device__ __forceinline__ float dot_row64(const float (&q)[64], const bf16_t* p) {
    float s0 = 0.f, s1 = 0.f;
#pragma unroll
    for (int c = 0; c < 8; ++c) { const u32x4 w = *((const u32x4*)p + c);
        s0 += q[8 * c + 0] * bflo(w.x); s1 += q[8 * c + 1] * bfhi(w.x); s0 += q[8 * c + 2] * bflo(w.y); s1 += q[8 * c + 3] * bfhi(w.y);
        s0 += q[8 * c + 4] * bflo(w.z); s1 += q[8 * c + 5] * bfhi(w.z); s0 += q[8 * c + 6] * bflo(w.w); s1 += q[8 * c + 7] * bfhi(w.w); }
    return s0 + s1;
}
__device__ __forceinline__ void axpy_row64(float (&o)[64], float p, const bf16_t* vp) {
#pragma unroll
    for (int c = 0; c < 8; ++c) { const u32x4 w = *((const u32x4*)vp + c);
        o[8 * c + 0] += p * bflo(w.x); o[8 * c + 1] += p * bfhi(w.x); o[8 * c + 2] += p * bflo(w.y); o[8 * c + 3] += p * bfhi(w.y);
        o[8 * c + 4] += p * bflo(w.z); o[8 * c + 5] += p * bfhi(w.z); o[8 * c + 6] += p * bflo(w.w); o[8 * c + 7] += p * bfhi(w.w); }
}
__device__ __forceinline__ void st_row64(bf16_t* p, const float (&o)[64], float sc) {
#pragma unroll
    for (int c = 0; c < 8; ++c) { u32x4 w; w.x = pk2(o[8 * c] * sc, o[8 * c + 1] * sc); w.y = pk2(o[8 * c + 2] * sc, o[8 * c + 3] * sc); w.z = pk2(o[8 * c + 4] * sc, o[8 * c + 5] * sc); w.w = pk2(o[8 * c + 6] * sc, o[8 * c + 7] * sc); *((u32x4*)p + c) = w; }
}
#define OSM_STEP(sc, vrow) do { const float sc_ = (sc); if (sc_ > m_) { const float al = __builtin_amdgcn_exp2f(m_ - sc_); l_ *= al; _Pragma("unroll") for (int d_ = 0; d_ < 64; ++d_) o_[d_] *= al; m_ = sc_; } \
    const float p_ = __builtin_amdgcn_exp2f(sc_ - m_); l_ += p_; axpy_row64(o_, p_, (vrow)); } while (0)

__device__ __forceinline__ void naive_moba(const bf16_t* qb, const bf16_t* kb, const bf16_t* vb, const float* kmean, bf16_t* ob, int item, int tid) {
    const int b = item >> 6, h = (item >> 4) & 3, t = (item & 15) * 512 + tid, own = t >> 8;
    const size_t rowq = ((size_t)b * SEQ + t) * DM + h * HD;
    const bf16_t* kh = kb + (size_t)b * SEQ * DM + h * HD; const bf16_t* vh = vb + (size_t)b * SEQ * DM + h * HD;
    const float slope2 = exp2f(-2.0f * (float)(h + 1)) * LOG2E;
    float q_[64]; ld_row64(q_, qb + rowq);
    float bv0 = -INFINITY, bv1 = -INFINITY, bv2 = -INFINITY; int bi0 = -1, bi1 = -1, bi2 = -1;
    const float* km = kmean + (size_t)(b * 4 + h) * 32 * HD;
    for (int n = 0; n < own; ++n) {
        float gsum = 0.f;
#pragma unroll
        for (int d = 0; d < 64; ++d) gsum += q_[d] * km[n * HD + d];
        if (gsum > bv0) { bv2 = bv1; bi2 = bi1; bv1 = bv0; bi1 = bi0; bv0 = gsum; bi0 = n; }
        else if (gsum > bv1) { bv2 = bv1; bi2 = bi1; bv1 = gsum; bi1 = n; }
        else if (gsum > bv2) { bv2 = gsum; bi2 = n; }
    }
    float o_[64];
#pragma unroll
    for (int d = 0; d < 64; ++d) o_[d] = 0.f;
    float m_ = -INFINITY, l_ = 0.f;
    for (int s = 0; s < 3; ++s) {
        const int blk = (s == 0) ? bi0 : (s == 1) ? bi1 : bi2;
        if (blk < 0) continue;
        for (int j = 0; j < 256; ++j) { const int pos = blk * 256 + j;
            const float sc = dot_row64(q_, kh + (size_t)pos * DM) - slope2 * (float)(t - pos);
            OSM_STEP(sc, vh + (size_t)pos * DM); }
    }
    for (int pos = own * 256; pos <= t; ++pos) {
        const float sc = dot_row64(q_, kh + (size_t)pos * DM) - slope2 * (float)(t - pos);
        OSM_STEP(sc, vh + (size_t)pos * DM); }
    st_row64(ob + rowq, o_, 1.0f / l_);
}
__device__ __forceinline__ void naive_sb(const bf16_t* qb, const bf16_t* kb, const bf16_t* vb, bf16_t* ob, int item, int tid) {
    const int b = item >> 6, h = 4 + ((item >> 4) & 3), t = (item & 15) * 512 + tid;
    const size_t rowq = ((size_t)b * SEQ + t) * DM + h * HD;
    const bf16_t* kh = kb + (size_t)b * SEQ * DM + h * HD; const bf16_t* vh = vb + (size_t)b * SEQ * DM + h * HD;
    float q_[64]; ld_row64(q_, qb + rowq);
    float o_[64];
#pragma unroll
    for (int d = 0; d < 64; ++d) o_[d] = 0.f;
    float tail = 0.f;
    for (int s = t - 1; s >= 0 && tail > -150.f; --s) {
        const float z = dot_row64(q_, kh + (size_t)s * DM);
        const float lp = __builtin_amdgcn_logf(1.0f + __builtin_amdgcn_exp2f(-fabsf(z)));
        const float lnot = -(fmaxf(z, 0.f) + lp);
        const float aw = __builtin_amdgcn_exp2f(z + lnot + tail);
        axpy_row64(o_, aw, vh + (size_t)s * DM);
        tail += lnot;
    }
    st_row64(ob + rowq, o_, 1.0f);
}
__device__ __forceinline__ void naive_dil(const bf16_t* qb, const bf16_t* kb, const bf16_t* vb, bf16_t* ob, bf16_t* hb2, float* lse, int item, int tid) {
    const int b = item >> 7, h = 8 + ((item >> 4) & 7), t = (item & 15) * 512 + tid;
    const size_t rowq = ((size_t)b * SEQ + t) * DM + h * HD;
    const bf16_t* kh = kb + (size_t)b * SEQ * DM + h * HD; const bf16_t* vh = vb + (size_t)b * SEQ * DM + h * HD;
    const float slope2 = exp2f(-(float)(h - 8 + 1)) * LOG2E;
    float q_[64]; ld_row64(q_, qb + rowq);
    float o_[64];
#pragma unroll
    for (int d = 0; d < 64; ++d) o_[d] = 0.f;
    float m_ = -INFINITY, l_ = 0.f;
    for (int c = 0; c < 3; ++c) {
        const int dil = (c == 0) ? 1 : (c == 1) ? 4 : 16;
        for (int dl = 0; dl <= 128; ++dl) { const int pos = t - dl * dil; if (pos < 0) break;
            const float sc = dot_row64(q_, kh + (size_t)pos * DM) - slope2 * (float)(dl * dil);
            OSM_STEP(sc, vh + (size_t)pos * DM); }
    }
    st_row64(ob + rowq, o_, 1.0f / l_);
    { const size_t tok = (size_t)b * SEQ + t; const u32x4 z4 = {0u, 0u, 0u, 0u};
#pragma unroll
      for (int c = 0; c < 8; ++c) { *((u32x4*)(hb2 + tok * DM + (h - 8) * HD) + c) = z4; *((u32x4*)(hb2 + tok * DM + 512 + (h - 8) * HD) + c) = z4; }
      lse[tok * 8 + (h - 8)] = 0.f; lse[(size_t)T * 8 + tok * 8 + (h - 8)] = -1.0e30f; lse[(size_t)2 * T * 8 + tok * 8 + (h - 8)] = -1.0e30f; }
}

namespace att {
typedef float f32x16 __attribute__((ext_vector_type(16)));
typedef short s16x4 __attribute__((ext_vector_type(4)));
typedef short v4i16_t __attribute__((ext_vector_type(4)));
typedef __bf16 bf16x2_t __attribute__((ext_vector_type(2)));
constexpr int L_BUF = 16384;
constexpr int L_WSF = 2 * L_BUF;
constexpr int L_OST = L_WSF + 8 * 256;
constexpr int L_FLG = L_OST + 8 * 4096;
constexpr int L_END = L_FLG + 64;
constexpr float M_INIT = -1.0e30f;
#define ATT_MFMA(a, b, c) __builtin_amdgcn_mfma_f32_32x32x16_bf16((a), (b), (c), 0, 0, 0)

__device__ __forceinline__ unsigned cvtpk(float lo, float hi) { f32x2 v = {lo, hi}; bf16x2_t b = __builtin_convertvector(v, bf16x2_t); return __builtin_bit_cast(unsigned, b); }
__device__ __forceinline__ s16x4 vtr(LAS unsigned char* p) { return __builtin_bit_cast(s16x4, __builtin_amdgcn_ds_read_tr16_b64_v4i16((LAS v4i16_t*)p)); }

struct Wave { int lane, r32, hi, wid; LAS unsigned char* lds; LAS float* wsf; int vlo; };
__device__ __forceinline__ Wave make_wave(LAS unsigned char* lds, int tid) {
    Wave w; w.lane = tid & 63; w.r32 = w.lane & 31; w.hi = w.lane >> 5; w.wid = __builtin_amdgcn_readfirstlane(tid >> 6); w.lds = lds;
    w.wsf = (LAS float*)(lds + L_WSF) + w.wid * 64;
    w.vlo = ((w.lane >> 4) & 1) * 32 + (w.lane & 3) * 8 + (4 * w.hi + ((w.lane & 15) >> 2)) * 64;
    return w;
}
struct Stage { u32x4 k, v; };
template <class RowK, class RowV> __device__ __forceinline__ void stage_load(Stage& s, const Wave& w, const RowK& rowk, const RowV& rowv) {
    s.k = *(const u32x4*)(rowk(w.lane) + w.wid * 8);
    s.v = *(const u32x4*)(rowv(16 * (w.wid & 3) + (w.lane >> 2)) + (w.wid >> 2) * 32 + (w.lane & 3) * 8);
}
__device__ __forceinline__ void stage_write(const Stage& s, const Wave& w, int buf) {
    *(LAS u32x4*)(w.lds + buf * L_BUF + w.wid * 1024 + w.lane * 16) = s.k;
    *(LAS u32x4*)(w.lds + buf * L_BUF + 8192 + w.wid * 1024 + w.lane * 16) = s.v;
}
__device__ __forceinline__ f32x16 qk_sub(const Wave& w, int buf, int sub, const bf16x8 (&qf)[4], float init) {
    f32x16 acc;
#pragma unroll
    for (int r = 0; r < 16; ++r) acc[r] = init;
    LAS unsigned char* kp = w.lds + buf * L_BUF + w.hi * 1024 + (32 * sub + w.r32) * 16;
#pragma unroll
    for (int ks = 0; ks < 4; ++ks) { const bf16x8 kf = *(LAS bf16x8*)(kp + ks * 2048); acc = ATT_MFMA(kf, qf[ks], acc); }
    return acc;
}
__device__ __forceinline__ void pv_sub(const Wave& w, int buf, int sub, const f32x16& p, f32x16 (&o)[2]) {
    bf16x8 pk[2];
#pragma unroll
    for (int s = 0; s < 2; ++s) { u32x4 t; t.x = cvtpk(p[8 * s], p[8 * s + 1]); t.y = cvtpk(p[8 * s + 2], p[8 * s + 3]); t.z = cvtpk(p[8 * s + 4], p[8 * s + 5]); t.w = cvtpk(p[8 * s + 6], p[8 * s + 7]); pk[s] = __builtin_bit_cast(bf16x8, t); }
    LAS unsigned char* vb = w.lds + buf * L_BUF + 8192 + w.vlo;
#pragma unroll
    for (int db = 0; db < 2; ++db)
#pragma unroll
        for (int s = 0; s < 2; ++s) { LAS unsigned char* vp = vb + db * 4096 + (4 * sub + 2 * s) * 512;
            const s16x4 lo = vtr(vp), hh = vtr(vp + 512);
            const bf16x8 vf = __builtin_shufflevector(lo, hh, 0, 1, 2, 3, 4, 5, 6, 7);
            o[db] = ATT_MFMA(pk[s], vf, o[db]); }
}
__device__ __forceinline__ void scale_rows(const Wave& w, f32x16 (&o)[2], float f) {
    if (w.hi == 0) w.wsf[w.r32] = f;
#pragma unroll
    for (int g = 0; g < 4; ++g) { const f32x4 fv = *(LAS f32x4*)(w.wsf + 8 * g + 4 * w.hi);
#pragma unroll
        for (int i = 0; i < 4; ++i) { o[0][4 * g + i] *= fv[i]; o[1][4 * g + i] *= fv[i]; } }
}
__device__ __forceinline__ void softmax_sub(const Wave& w, f32x16& s, float& m, float& lsum, f32x16 (&o)[2]) {
    float tm = fmaxf(fmaxf(s[0], s[1]), fmaxf(s[2], s[3]));
#pragma unroll
    for (int r = 4; r < 16; r += 4) tm = fmaxf(tm, fmaxf(fmaxf(s[r], s[r + 1]), fmaxf(s[r + 2], s[r + 3])));
    tm = max_xor32(tm);
    const float mn = fmaxf(m, tm);
    if (__any(mn > m)) { const float al = __builtin_amdgcn_exp2f(m - mn); lsum *= al; scale_rows(w, o, al); m = mn; }
    float acc = 0.f;
#pragma unroll
    for (int r = 0; r < 16; ++r) { s[r] = __builtin_amdgcn_exp2f(s[r] - m); acc += s[r]; }
    lsum += acc;
}
__device__ __forceinline__ void mask_band(f32x16& s, int delta0, int W) {
#pragma unroll
    for (int r = 0; r < 16; ++r) { const int dl = delta0 - ((r & 3) + 8 * (r >> 2)); if ((unsigned)dl > (unsigned)W) s[r] = -INFINITY; }
}
template <class RowO> __device__ __forceinline__ void store_o(const Wave& w, const f32x16 (&o)[2], const RowO& rowo) {
    LAS unsigned short* stg = (LAS unsigned short*)(w.lds + L_OST + w.wid * 4096);
#pragma unroll
    for (int r = 0; r < 16; ++r) { const int q = (r & 3) + 8 * (r >> 2) + 4 * w.hi;
#pragma unroll
        for (int db = 0; db < 2; ++db) stg[q * 64 + db * 32 + w.r32] = (unsigned short)f2bf(o[db][r]); }
#pragma unroll
    for (int i = 0; i < 4; ++i) { const int row = i * 8 + (w.lane >> 3), ch = w.lane & 7; const u32x4 v = *(LAS u32x4*)((LAS unsigned char*)stg + row * 128 + ch * 16);
        *(u32x4*)(rowo(row) + ch * 8) = v; }
}
__device__ __forceinline__ void load_q(bf16x8 (&qf)[4], const bf16_t* qrow, int hi) {
#pragma unroll
    for (int ks = 0; ks < 4; ++ks) qf[ks] = *(const bf16x8*)(qrow + 16 * ks + 8 * hi);
}

__device__ __forceinline__ void moba_unit(LAS unsigned char* lds, const bf16_t* QB, const bf16_t* KB, const bf16_t* VB, const float* KMEAN, bf16_t* OB, int b, int h, int own, int tid) {
    const Wave w = make_wave(lds, tid);
    const size_t rowbase = (size_t)b * SEQ; const int q0 = own * 256, qpos = q0 + 32 * w.wid + w.r32;
    const bf16_t* kh = KB + rowbase * DM + h * HD; const bf16_t* vh = VB + rowbase * DM + h * HD;
    const float slope2 = exp2f(-2.0f * (float)(h + 1)) * LOG2E;
    bf16x8 qf[4]; load_q(qf, QB + (rowbase + qpos) * DM + h * HD, w.hi);
    int i0 = -1, i1 = -1, i2 = -1;
    if (own > 0) {
        f32x16 g;
#pragma unroll
        for (int r = 0; r < 16; ++r) g[r] = 0.f;
        const float* km = KMEAN + ((size_t)(b * 4 + h) * 32 + w.r32) * HD + 8 * w.hi;
#pragma unroll
        for (int ks = 0; ks < 4; ++ks) { const f32x4 a0 = *(const f32x4*)(km + 16 * ks), a1 = *(const f32x4*)(km + 16 * ks + 4);
            const float x[8] = {a0.x, a0.y, a0.z, a0.w, a1.x, a1.y, a1.z, a1.w}; unsigned hw[4], lw[4];
#pragma unroll
            for (int j = 0; j < 4; ++j) { const unsigned h0 = f2bf(x[2 * j]), h1 = f2bf(x[2 * j + 1]); hw[j] = h0 | (h1 << 16);
                lw[j] = pk2(x[2 * j] - __builtin_bit_cast(float, h0 << 16), x[2 * j + 1] - __builtin_bit_cast(float, h1 << 16)); }
            const u32x4 hv = {hw[0], hw[1], hw[2], hw[3]}, lv = {lw[0], lw[1], lw[2], lw[3]};
            g = ATT_MFMA(__builtin_bit_cast(bf16x8, hv), qf[ks], g); g = ATT_MFMA(__builtin_bit_cast(bf16x8, lv), qf[ks], g); }
        float v0 = -INFINITY, v1 = -INFINITY, v2 = -INFINITY;
#pragma unroll
        for (int r = 0; r < 16; ++r) { const int blk = (r & 3) + 8 * (r >> 2) + 4 * w.hi; const float val = (blk < own) ? g[r] : -INFINITY;
            if (val > v0) { v2 = v1; i2 = i1; v1 = v0; i1 = i0; v0 = val; i0 = blk; } else if (val > v1) { v2 = v1; i2 = i1; v1 = val; i1 = blk; } else if (val > v2) { v2 = val; i2 = blk; } }
        const float pv_[3] = {get_xor32(v0, w.hi), get_xor32(v1, w.hi), get_xor32(v2, w.hi)}; const int pi_[3] = {get_xor32i(i0, w.hi), get_xor32i(i1, w.hi), get_xor32i(i2, w.hi)};
#pragma unroll
        for (int k = 0; k < 3; ++k) { const float val = pv_[k]; const int blk = pi_[k];
            if (val > v0 || (val == v0 && blk < i0)) { v2 = v1; i2 = i1; v1 = v0; i1 = i0; v0 = val; i0 = blk; }
            else if (val > v1 || (val == v1 && blk < i1)) { v2 = v1; i2 = i1; v1 = val; i1 = blk; }
            else if (val > v2 || (val == v2 && blk < i2)) { v2 = val; i2 = blk; } }
    }
    float tr_[16];
#pragma unroll
    for (int r = 0; r < 16; ++r) tr_[r] = slope2 * (float)((r & 3) + 8 * (r >> 2));
    f32x16 o[2];
#pragma unroll
    for (int r = 0; r < 16; ++r) { o[0][r] = 0.f; o[1][r] = 0.f; }
    float m = M_INIT, lsum = 0.f;
    const int nsteps = 4 * (own + 1);
    auto kpos_of = [&](int st) { return st < 4 ? q0 + (3 - st) * 64 : (own - 1 - ((st - 4) >> 2)) * 256 + (3 - ((st - 4) & 3)) * 64; };
    Stage sg;
    { const int kp = kpos_of(0); stage_load(sg, w, [&](int key) { return kh + (size_t)(kp + key) * DM; }, [&](int key) { return vh + (size_t)(kp + key) * DM; }); }
    stage_write(sg, w, 0);
    __syncthreads();
    for (int st = 0; st < nsteps; ++st) {
        const int buf = st & 1;
        if (st + 1 < nsteps) { const int kp = kpos_of(st + 1); stage_load(sg, w, [&](int key) { return kh + (size_t)(kp + key) * DM; }, [&](int key) { return vh + (size_t)(kp + key) * DM; }); }
        const int kpos0 = kpos_of(st); const bool ownblk = st < 4; const int blk = kpos0 >> 8;
        const bool selq = ownblk || blk == i0 || blk == i1 || blk == i2;
        if (__any(selq)) {
#pragma unroll
            for (int sub = 1; sub >= 0; --sub) {
                const int D = ownblk ? (w.wid - (2 * (3 - st) + sub)) : 1;
                if (D < 0) continue;
                const int delta0 = qpos - (kpos0 + 32 * sub) - 4 * w.hi;
                f32x16 s = qk_sub(w, buf, sub, qf, -slope2 * (float)delta0);
#pragma unroll
                for (int r = 0; r < 16; ++r) s[r] = selq ? s[r] + tr_[r] : -INFINITY;
                if (D == 0) mask_band(s, delta0, 0x7fffffff);
                softmax_sub(w, s, m, lsum, o);
                pv_sub(w, buf, sub, s, o);
            }
        }
        if (st + 1 < nsteps) stage_write(sg, w, buf ^ 1);
        __syncthreads();
    }
    const float l = sum_xor32(lsum);
    scale_rows(w, o, 1.0f / l);
    bf16_t* orow = OB + (rowbase + q0 + 32 * w.wid) * DM + h * HD;
    store_o(w, o, [&](int r) { return orow + (size_t)r * DM; });
}

__device__ __forceinline__ void sb_unit(LAS unsigned char* lds, const bf16_t* QB, const bf16_t* KB, const bf16_t* VB, bf16_t* OB, int b, int h, int qt, int tid) {
    const Wave w = make_wave(lds, tid);
    const size_t rowbase = (size_t)b * SEQ; const int q0 = qt * 256, qpos = q0 + 32 * w.wid + w.r32;
    const bf16_t* kh = KB + rowbase * DM + h * HD; const bf16_t* vh = VB + rowbase * DM + h * HD;
    bf16x8 qf[4]; load_q(qf, QB + (rowbase + qpos) * DM + h * HD, w.hi);
    f32x16 o[2];
#pragma unroll
    for (int r = 0; r < 16; ++r) { o[0][r] = 0.f; o[1][r] = 0.f; }
    float carry = 0.f;
    bool done = false;
    volatile LAS unsigned* flg = (volatile LAS unsigned*)(lds + L_FLG);
    const int ti0 = q0 / 64 + 3;
    Stage sg;
    { const int kp = ti0 * 64; stage_load(sg, w, [&](int key) { return kh + (size_t)(kp + key) * DM; }, [&](int key) { return vh + (size_t)(kp + key) * DM; }); }
    stage_write(sg, w, 0);
    __syncthreads();
    for (int st = 0;; ++st) {
        const int buf = st & 1, ti = ti0 - st;
        if (ti > 0) { const int kp = (ti - 1) * 64; stage_load(sg, w, [&](int key) { return kh + (size_t)(kp + key) * DM; }, [&](int key) { return vh + (size_t)(kp + key) * DM; }); }
        if (!done) {
#pragma unroll
            for (int sub = 1; sub >= 0; --sub) {
                const int D = (q0 / 32 + w.wid) - (2 * ti + sub);
                if (D < 0) continue;
                const int delta0 = qpos - (64 * ti + 32 * sub) - 4 * w.hi;
                f32x16 z = qk_sub(w, buf, sub, qf, 0.f);
                f32x16 L;
#pragma unroll
                for (int r = 0; r < 16; ++r) { const float lp = __builtin_amdgcn_logf(1.0f + __builtin_amdgcn_exp2f(-fabsf(z[r]))); L[r] = -(fmaxf(z[r], 0.f) + lp); }
                if (D == 0) {
#pragma unroll
                    for (int r = 0; r < 16; ++r) { const int dl = delta0 - ((r & 3) + 8 * (r >> 2)); if (dl < 1) { L[r] = 0.f; z[r] = -INFINITY; } }
                }
                float G[4], PG[4];
#pragma unroll
                for (int g = 0; g < 4; ++g) { G[g] = (L[4 * g] + L[4 * g + 1]) + (L[4 * g + 2] + L[4 * g + 3]); PG[g] = get_xor32(G[g], w.hi); }
                float run = carry;
#pragma unroll
                for (int g = 3; g >= 0; --g) { const float t3 = run + (w.hi == 0 ? PG[g] : 0.f), t2 = t3 + L[4 * g + 3], t1 = t2 + L[4 * g + 2], t0 = t1 + L[4 * g + 1];
                    z[4 * g + 3] = __builtin_amdgcn_exp2f(z[4 * g + 3] + L[4 * g + 3] + t3); z[4 * g + 2] = __builtin_amdgcn_exp2f(z[4 * g + 2] + L[4 * g + 2] + t2);
                    z[4 * g + 1] = __builtin_amdgcn_exp2f(z[4 * g + 1] + L[4 * g + 1] + t1); z[4 * g] = __builtin_amdgcn_exp2f(z[4 * g] + L[4 * g] + t0);
                    run += G[g] + PG[g]; }
                carry = run;
                pv_sub(w, buf, sub, z, o);
            }
            done = __all(carry < -150.f);
        }
        if (w.lane == 0) flg[buf * 8 + w.wid] = done ? 1u : 0u;
        if (ti > 0) stage_write(sg, w, buf ^ 1);
        __syncthreads();
        unsigned all = 1u;
#pragma unroll
        for (int k = 0; k < 8; ++k) all &= flg[buf * 8 + k];
        if (all || ti == 0) break;
    }
    bf16_t* orow = OB + (rowbase + q0 + 32 * w.wid) * DM + h * HD;
    store_o(w, o, [&](int r) { return orow + (size_t)r * DM; });
    __syncthreads();
}

__device__ __forceinline__ void dil_unit(LAS unsigned char* lds, const bf16_t* QB, const bf16_t* KB, const bf16_t* VB, bf16_t* PO, float* LSE, int b, int h, int dil, int res, int i2, int tid) {
    const Wave w = make_wave(lds, tid);
    const size_t rowbase = (size_t)b * SEQ; const int Q0 = 256 * i2, qj = Q0 + 32 * w.wid + w.r32;
    const bf16_t* kh = KB + (rowbase + res) * DM + h * HD; const bf16_t* vh = VB + (rowbase + res) * DM + h * HD;
    const size_t rstride = (size_t)dil * DM;
    const float slope2d = exp2f(-(float)(h - 8 + 1)) * LOG2E * (float)dil;
    bf16x8 qf[4]; load_q(qf, QB + (rowbase + res + (size_t)qj * dil) * DM + h * HD, w.hi);
    float tr_[16];
#pragma unroll
    for (int r = 0; r < 16; ++r) tr_[r] = slope2d * (float)((r & 3) + 8 * (r >> 2));
    f32x16 o[2];
#pragma unroll
    for (int r = 0; r < 16; ++r) { o[0][r] = 0.f; o[1][r] = 0.f; }
    float m = M_INIT, lsum = 0.f;
    const int ti0 = 4 * i2 + 3, nsteps = (ti0 + 1 < 6) ? ti0 + 1 : 6;
    Stage sg;
    { const int kp = ti0 * 64; stage_load(sg, w, [&](int key) { return kh + (size_t)(kp + key) * rstride; }, [&](int key) { return vh + (size_t)(kp + key) * rstride; }); }
    stage_write(sg, w, 0);
    __syncthreads();
    for (int st = 0; st < nsteps; ++st) {
        const int buf = st & 1, ti = ti0 - st;
        if (st + 1 < nsteps) { const int kp = (ti - 1) * 64; stage_load(sg, w, [&](int key) { return kh + (size_t)(kp + key) * rstride; }, [&](int key) { return vh + (size_t)(kp + key) * rstride; }); }
#pragma unroll
        for (int sub = 1; sub >= 0; --sub) {
            const int D = (8 * i2 + w.wid) - (2 * ti + sub);
            if (D < 0 || D > 4) continue;
            const int delta0 = qj - (64 * ti + 32 * sub) - 4 * w.hi;
            f32x16 s = qk_sub(w, buf, sub, qf, -slope2d * (float)delta0);
#pragma unroll
            for (int r = 0; r < 16; ++r) s[r] += tr_[r];
            if (D == 0 || D == 4) mask_band(s, delta0, 128);
            softmax_sub(w, s, m, lsum, o);
            pv_sub(w, buf, sub, s, o);
        }
        if (st + 1 < nsteps) stage_write(sg, w, buf ^ 1);
        __syncthreads();
    }
    const float l = sum_xor32(lsum);
    scale_rows(w, o, 1.0f / l);
    const size_t tok0 = rowbase + res + (size_t)(Q0 + 32 * w.wid) * dil;
    store_o(w, o, [&](int r) { return PO + (tok0 + (size_t)r * dil) * DM + (h - 8) * HD; });
    if (w.hi == 0) LSE[(tok0 + (size_t)w.r32 * dil) * 8 + (h - 8)] = m + __builtin_amdgcn_logf(l);
}

template <bool DO_MOBA, bool DO_DIL, bool DO_SB>
__device__ __forceinline__ void attn_phase(LAS unsigned char* lds, const bf16_t* QB, const bf16_t* KB, const bf16_t* VB, const float* KMEAN, bf16_t* OB, bf16_t* HB2, float* LSE, int v, int G, int tid) {
    if (DO_MOBA) for (int u = v; u < 256; u += G) { const int bh = u >> 4, p = u & 15;
        moba_unit(lds, QB, KB, VB, KMEAN, OB, bh >> 2, bh & 3, 31 - p, tid);
        moba_unit(lds, QB, KB, VB, KMEAN, OB, bh >> 2, bh & 3, p, tid); }
    if (DO_DIL) for (int u = v; u < 3072; u += G) { const int n = u & 31, bhc = u >> 5, c = bhc % 3, bh = bhc / 3, b = bh >> 3, h = 8 + (bh & 7);
        const int dil = (c == 0) ? 1 : (c == 1) ? 4 : 16, res = (c == 0) ? 0 : (c == 1) ? (n >> 3) : (n >> 1), i2 = (c == 0) ? n : (c == 1) ? (n & 7) : (n & 1);
        bf16_t* PO = (c == 0) ? OB + 512 : HB2 + (c - 1) * 512;
        dil_unit(lds, QB, KB, VB, PO, LSE + (size_t)c * T * 8, b, h, dil, res, i2, tid); }
    if (DO_SB) for (int u = v; u < 512; u += G) { const int qt = u & 31, bh = u >> 5; sb_unit(lds, QB, KB, VB, OB, bh >> 2, 4 + (bh & 3), qt, tid); }
}
}

constexpr int PH_PRO = 0, PH_L0 = 1, PH_PER_LAYER = 9, PH_FINAL = PH_L0 + DEPTH * PH_PER_LAYER, PH_COUNT = PH_FINAL + 1;
typedef const __attribute__((address_space(4))) Args* KArgP;
#define KARG() ({ KArgP p_ = (KArgP)__builtin_amdgcn_kernarg_segment_ptr(); asm volatile("" : "+s"(p_)); p_; })
#define PHASE_IDS int lane_p = (int)__builtin_amdgcn_mbcnt_hi(~0u, __builtin_amdgcn_mbcnt_lo(~0u, 0u)); LAUNDER_V(lane_p); int tid_p = wave * 64 + lane_p; int gw_p = gw; LAUNDER_S(gw_p)
__global__ void __launch_bounds__(NTHREADS, 2) fwd(Args a_unused) {
    extern __shared__ __attribute__((aligned(16))) unsigned char lds_raw[];
    LAS unsigned char* lds = (LAS unsigned char*)lds_raw;
    volatile LAS unsigned* MISC = (volatile LAS unsigned*)(lds + MISC_OFF);
    const int wave = __builtin_amdgcn_readfirstlane((int)threadIdx.x >> 6);
    const int G = gridDim.x, bx = blockIdx.x;
    const int vcu = (G % 8 == 0) ? (bx % 8) * (G / 8) + bx / 8 : bx;
    const int gw = vcu * NWAVES + wave, NGW = G * NWAVES;
    for (int u = threadIdx.x; u < (LDS_BYTES - LDSCTL_OFF) / 4; u += NTHREADS) ((LAS unsigned*)(lds + LDSCTL_OFF))[u] = 0u;
    __syncthreads();
    int lo, hi; XcdBarrier bar;
    { KArgP ka = KARG(); lo = ka->ph_lo; hi = ka->ph_hi; unsigned* ctl = (unsigned*)(ka->ws + WS_CTL); bar = xcd_barrier_post(ctl + CW_BAR + ka->li * XCD_BAR_WORDS, MISC + 8); }
#define IN(k) (lo <= (k) && (k) < hi)
#define SEAM(k) do { if (IN(k) && IN((k) + 1)) xcd_barrier(bar); } while (0)
#define WSP(T_, off) ((T_*)(ws + (off)))

    if (IN(PH_PRO)) { KArgP ka = KARG(); PHASE_IDS; Args a; a.ws = ka->ws; a.w_in = ka->w_in; a.w_out = ka->w_out; a.w_gate = ka->w_gate; a.w_up = ka->w_up; a.w_down = ka->w_down; phase_prologue(a, lds, gw_p, NGW, wave, lane_p); } SEAM(PH_PRO);

    for (int l = 0; l < DEPTH; ++l) {
        const int p0 = PH_L0 + l * PH_PER_LAYER;
        if (hi <= p0 || lo >= p0 + PH_PER_LAYER) continue;
        if (IN(p0 + 0)) for (int rep_ = 0; rep_ < RPT(0); ++rep_) { if (rep_) xcd_barrier(bar); KArgP ka = KARG(); PHASE_IDS; unsigned char* ws = ka->ws; const float* xin = (l == 0) ? ka->x : ka->out;
            phase_norm1(xin, ka->ln1_g + (size_t)l * DM, WSP(bf16_t, WS_HB), gw_p, NGW, lane_p); } SEAM(p0 + 0);
        if (IN(p0 + 1)) for (int rep_ = 0; rep_ < RPT(1); ++rep_) { if (rep_) xcd_barrier(bar); KArgP ka = KARG(); PHASE_IDS; unsigned char* ws = ka->ws;
            pg8::Gemm g{(const char*)(ws + WS_HB), (const char*)(ws + WS_WIN) + (size_t)l * NQKV * DM * 2, DM, DM, DM, (long)256 * DM * 2, (long)256 * DM * 2, (long)128 * DM * 2};
            pg8::StaticOrder S; S.init(T / 256, NQKV / 256, G, bx);
            pg8::EpiQKV E{WSP(bf16_t, WS_Q), (size_t)(WS_K - WS_Q) / 2, QSCALE};
            pg8::gemm_phase<pg8::EpiQKV, pg8::StaticOrder>(lds, g, S, E, wave);
        } SEAM(p0 + 1);
        if (IN(p0 + 2)) { KArgP ka = KARG(); PHASE_IDS; unsigned char* ws = ka->ws; phase_kmean(WSP(bf16_t, WS_K), WSP(float, WS_KMEAN), gw_p, NGW, lane_p); } SEAM(p0 + 2);
        if (IN(p0 + 3)) for (int rep_ = 0; rep_ < RPT(3); ++rep_) { if (rep_) xcd_barrier(bar); KArgP ka = KARG(); PHASE_IDS; unsigned char* ws = ka->ws;
            const bf16_t* QB = WSP(bf16_t, WS_Q); const bf16_t* KB = WSP(bf16_t, WS_K); const bf16_t* VB = WSP(bf16_t, WS_V); bf16_t* OB = WSP(bf16_t, WS_O);
            att::attn_phase<ATT_MOBA != 0, ATT_DIL != 0, ATT_SB != 0>(lds, QB, KB, VB, WSP(float, WS_KMEAN), OB, WSP(bf16_t, WS_HB), WSP(float, WS_LSE), vcu, G, tid_p);
#if !ATT_MOBA
            for (int it = vcu; it < 256; it += G) naive_moba(QB, KB, VB, WSP(float, WS_KMEAN), OB, it, tid_p);
#endif
#if !ATT_SB
            for (int it = vcu; it < 256; it += G) naive_sb(QB, KB, VB, OB, it, tid_p);
#endif
#if !ATT_DIL
            for (int it = vcu; it < 512; it += G) naive_dil(QB, KB, VB, OB, WSP(bf16_t, WS_HB), WSP(float, WS_LSE), it, tid_p);
#endif
        } SEAM(p0 + 3);
        if (IN(p0 + 4)) { KArgP ka = KARG(); PHASE_IDS; unsigned char* ws = ka->ws; phase_mixnorm(WSP(bf16_t, WS_O), WSP(bf16_t, WS_HB), WSP(float, WS_LSE), ka->mix_g + (size_t)l * DM, gw_p, NGW, lane_p); } SEAM(p0 + 4);
        if (IN(p0 + 5)) { KArgP ka = KARG(); PHASE_IDS; unsigned char* ws = ka->ws; const float* xin = (l == 0) ? ka->x : ka->out;
            pg8::Gemm g{(const char*)(ws + WS_HB), (const char*)(ws + WS_WOUT) + (size_t)l * DM * DM * 2, DM, DM, DM, (long)256 * DM * 2, (long)256 * DM * 2, (long)128 * DM * 2};
            pg8::StaticOrder S; S.init(T / 256, DM / 256, G, bx);
            pg8::EpiResAdd E{xin, ka->out};
            pg8::gemm_phase<pg8::EpiResAdd, pg8::StaticOrder>(lds, g, S, E, wave);
        } SEAM(p0 + 5);
        if (IN(p0 + 6)) { KArgP ka = KARG(); PHASE_IDS; unsigned char* ws = ka->ws;
            phase_route(ka->out, ka->ln2_g + (size_t)l * DM, ka->w_gr + (size_t)l * DM * 4, ka->b_gr + l * 4, ka->w_er + (size_t)l * 4 * DM * 4, ka->b_er + l * 16, WSP(bf16_t, WS_HB),
                        WSP(unsigned, WS_CTL) + CW_CNT + l * 32, WSP(unsigned, WS_LIST), WSP(float, WS_WLIST), lds, vcu, G, wave, lane_p); } SEAM(p0 + 6);
        if (IN(p0 + 7)) for (int rep_ = 0; rep_ < RPT(7); ++rep_) { if (rep_) xcd_barrier(bar); KArgP ka = KARG(); PHASE_IDS; unsigned char* ws = ka->ws;
            pg8::MoeProb<0> P{WSP(unsigned, WS_CTL) + CW_CNT + l * 32, WSP(unsigned, WS_LIST), (const char*)(ws + WS_HB), (const char*)(ws + WS_WG) + (size_t)l * NACT * DM * 2, DM, DM, DM, (long)(WS_WU - WS_WG), G, vcu};
            pg8::EpiGateUpSparse E{WSP(bf16_t, WS_ACT), WSP(float, WS_WLIST)};
            pg8::gemm_phase_x<pg8::EpiGateUpSparse, pg8::MoeProb<0>>(lds, P, E, wave);
        } SEAM(p0 + 7);
        if (IN(p0 + 8)) { KArgP ka = KARG(); PHASE_IDS; unsigned char* ws = ka->ws;
            pg8::MoeProb<1> P{WSP(unsigned, WS_CTL) + CW_CNT + l * 32, WSP(unsigned, WS_LIST), (const char*)(ws + WS_ACT), (const char*)(ws + WS_WD) + (size_t)l * DM * NACT * 2, 512, NACT, 512, (long)128 * NACT * 2, G, vcu};
            pg8::EpiDownScatter E{ka->out, WSP(unsigned, WS_LIST)};
            pg8::gemm_phase_x<pg8::EpiDownScatter, pg8::MoeProb<1>>(lds, P, E, wave);
        } SEAM(p0 + 8);
    }
    if (IN(PH_FINAL)) { KArgP ka = KARG(); PHASE_IDS; phase_final(ka->out, ka->fin_g, gw_p, NGW, lane_p); }
#undef IN
#undef SEAM
#undef WSP
}

#ifndef N_LAUNCH_MODE
#define N_LAUNCH_MODE 1
#endif
extern "C" void kernel_launch(void* const* d_in, const int* in_sizes, int n_in, void* d_out, int out_size, void* d_ws, size_t ws_size, hipStream_t stream) {
    static int grid = 0;
    if (grid == 0) {
        if (n_in != 14 || in_sizes[0] != T * DM || out_size != T * DM || ws_size < WS_END) { fprintf(stderr, "kernel_launch: unexpected shapes (n_in %d in0 %d out %d ws %zu)\n", n_in, n_in > 0 ? in_sizes[0] : -1, out_size, ws_size); grid = -1; return; }
        int dev = 0, cus = 0, per_cu = 0;
        if (hipGetDevice(&dev) != hipSuccess || hipDeviceGetAttribute(&cus, hipDeviceAttributeMultiprocessorCount, dev) != hipSuccess) { grid = -1; return; }
        if (hipFuncSetAttribute((const void*)fwd, hipFuncAttributeMaxDynamicSharedMemorySize, LDS_BYTES) != hipSuccess) { fprintf(stderr, "kernel_launch: hipFuncSetAttribute failed\n"); grid = -1; return; }
        if (hipOccupancyMaxActiveBlocksPerMultiprocessor(&per_cu, (const void*)fwd, NTHREADS, LDS_BYTES) != hipSuccess || per_cu < 1) fprintf(stderr, "kernel_launch: occupancy query says %d\n", per_cu);
        (void)hipGetLastError();
        grid = cus;
    }
    if (grid < 0) return;
    if (hipMemsetAsync((char*)d_ws + WS_CTL, 0, CTL_ZERO_BYTES, stream) != hipSuccess) return;
    Args a{};
    a.x = (const float*)d_in[0]; a.ln1_g = (const float*)d_in[1]; a.w_in = (const float*)d_in[2]; a.mix_g = (const float*)d_in[3]; a.w_out = (const float*)d_in[4]; a.ln2_g = (const float*)d_in[5];
    a.w_gr = (const float*)d_in[6]; a.b_gr = (const float*)d_in[7]; a.w_er = (const float*)d_in[8]; a.b_er = (const float*)d_in[9]; a.w_gate = (const float*)d_in[10]; a.w_up = (const float*)d_in[11];
    a.w_down = (const float*)d_in[12]; a.fin_g = (const float*)d_in[13];
    a.out = (float*)d_out; a.ws = (unsigned char*)d_ws; a.pad = 0;
#if N_LAUNCH_MODE == 1
    a.ph_lo = 0; a.ph_hi = PH_COUNT; a.li = 0;
    hipLaunchKernelGGL(fwd, dim3(grid), dim3(NTHREADS), LDS_BYTES, stream, a);
#else
    for (int p = 0; p < PH_COUNT; ++p) { a.ph_lo = p; a.ph_hi = p + 1; a.li = p; hipLaunchKernelGGL(fwd, dim3(grid), dim3(NTHREADS), LDS_BYTES, stream, a); }
#endif
}
```

```cpp
#include <hip/hip_runtime.h>
#include <cstdio>
#include <cstdint>

#define LAS __attribute__((address_space(3)))
#define GAS __attribute__((address_space(1)))
typedef unsigned short bf16_t;
typedef short bf16x8 __attribute__((ext_vector_type(8)));
typedef float f32x4 __attribute__((ext_vector_type(4)));
typedef float f32x2 __attribute__((ext_vector_type(2)));
typedef unsigned u32x4 __attribute__((ext_vector_type(4)));
typedef unsigned u32x2 __attribute__((ext_vector_type(2)));

#ifndef PROBE_REPEAT
#define PROBE_REPEAT 0
#endif
#define RPT(k) ((((PROBE_REPEAT) >> (k)) & 1) ? 2 : 1)
#ifndef MOE_SPARSE
#define MOE_SPARSE 1
#endif
#ifndef ATT_MOBA
#define ATT_MOBA 1
#endif
#ifndef ATT_SB
#define ATT_SB 1
#endif
#ifndef ATT_DIL
#define ATT_DIL 1
#endif
constexpr int BATCH = 4, SEQ = 8192, DM = 1024, DEPTH = 4, T = BATCH * SEQ, NH = 16, HD = 64;
constexpr int NQKV = 3 * DM, NEXP = 16, DEXP = 256, NACT = NEXP * DEXP;
constexpr float NORM_EPS = 1e-6f;
constexpr float LOG2E = 1.4426950408889634f;
constexpr float QSCALE = 0.125f * LOG2E;
constexpr int NWAVES = 8, NTHREADS = 512;

constexpr size_t MiB = 1u << 20;
constexpr size_t WS_CTL = 0, CTL_ZERO_BYTES = 1 * MiB;
constexpr size_t WS_WIN = 2 * MiB;
constexpr size_t WS_WOUT = 26 * MiB;
constexpr size_t WS_WG = 34 * MiB;
constexpr size_t WS_WU = 66 * MiB;
constexpr size_t WS_WD = 98 * MiB;
constexpr size_t WS_LSEM0 = 1 * MiB;
constexpr size_t WS_KMEAN = 130 * MiB;
constexpr size_t WS_HB = 131 * MiB;
constexpr size_t WS_Q = 195 * MiB, WS_K = 259 * MiB, WS_V = 323 * MiB, WS_O = 387 * MiB;
constexpr size_t WS_ACT = WS_Q;
constexpr size_t WS_LSE = 451 * MiB;
constexpr size_t WS_LIST = 454 * MiB;
constexpr size_t WS_WLIST = 457 * MiB;
constexpr size_t WS_QLIST = WS_LIST;
constexpr size_t WS_PM = 463 * MiB;
constexpr size_t WS_LSEM1 = 511 * MiB;
constexpr size_t WS_END = 512 * MiB;
constexpr int QL_PER_BH = 126976;
constexpr int CW_MCNT = 2048;
constexpr int CW_CNT = 1024;
constexpr int CW_BAR = 4096;

constexpr int RING_BYTES = 131072;
constexpr int LDSCTL_OFF = RING_BYTES, MISC_OFF = LDSCTL_OFF + 320;
constexpr int LDS_BYTES = 147456;

__device__ __forceinline__ unsigned f2bf(float f) { unsigned u = __builtin_bit_cast(unsigned, f); return (u + 0x7fffu + ((u >> 16) & 1u)) >> 16; }
__device__ __forceinline__ unsigned pk2(float lo, float hi) { return f2bf(lo) | (f2bf(hi) << 16); }
__device__ __forceinline__ float bflo(unsigned w) { return __builtin_bit_cast(float, w << 16); }
__device__ __forceinline__ float bfhi(unsigned w) { return __builtin_bit_cast(float, w & 0xffff0000u); }
template <int M> __device__ __forceinline__ float swz_xor(float v) { return __builtin_bit_cast(float, __builtin_amdgcn_ds_swizzle(__builtin_bit_cast(int, v), 0x1f | (M << 10))); }
__device__ __forceinline__ void swap32(unsigned x, unsigned& lo_val, unsigned& hi_val) { unsigned y = x; asm volatile("" : "+v"(y)); auto rr = __builtin_amdgcn_permlane32_swap(x, y, false, false); lo_val = rr[0]; hi_val = rr[1]; }
__device__ __forceinline__ float sum_xor32(float v) { unsigned a, b; swap32(__builtin_bit_cast(unsigned, v), a, b); return __builtin_bit_cast(float, a) + __builtin_bit_cast(float, b); }
__device__ __forceinline__ float max_xor32(float v) { unsigned a, b; swap32(__builtin_bit_cast(unsigned, v), a, b); return fmaxf(__builtin_bit_cast(float, a), __builtin_bit_cast(float, b)); }
__device__ __forceinline__ float get_xor32(float v, int hi) { unsigned a, b; swap32(__builtin_bit_cast(unsigned, v), a, b); return __builtin_bit_cast(float, hi ? a : b); }
__device__ __forceinline__ int get_xor32i(int v, int hi) { unsigned a, b; swap32((unsigned)v, a, b); return (int)(hi ? a : b); }
__device__ __forceinline__ float half_sum(float v) {
    v += swz_xor<1>(v); v += swz_xor<2>(v); v += swz_xor<4>(v); v += swz_xor<8>(v); v += swz_xor<16>(v);
    return v;
}
__device__ __forceinline__ float wave_sum(float v) { return sum_xor32(half_sum(v)); }
#define LDS_WAIT() asm volatile("s_waitcnt lgkmcnt(0)" ::: "memory")
#define LAUNDER_V(x) asm volatile("" : "+v"(x))
#define LAUNDER_S(x) asm volatile("" : "+s"(x))

namespace pg8 {
constexpr int BM = 256, BK = 64, HALF = 128, HTB = HALF * BK * 2, STAGE_BYTES = 8 * HTB, NXCD = 8, WGM = 8;
__host__ __device__ __forceinline__ int lds_byte(int r, int c) { const int st = (r >> 4) * 2 + (c >> 5), rr = r & 15, cc = c & 31, ob = rr * 64 + cc * 2; return st * 1024 + (ob ^ (((ob >> 9) & 1) << 5)); }
__host__ __device__ __forceinline__ void stage_rc(int b, int& R, int& C) { const int st = b / 1024, sb = b % 1024, swz = sb ^ (((sb >> 9) & 1) << 5); R = (st >> 1) * 16 + swz / 64; C = (st & 1) * 32 + (swz % 64) / 2; }
__host__ __device__ __forceinline__ int perm32(int rho) { const int n = rho >> 4, i = rho & 15; return 8 * (i >> 2) + 4 * n + (i & 3); }

struct Unit { int pm, pn, meta;
    __device__ __forceinline__ int bk() const { return meta & 31; } __device__ __forceinline__ int tib() const { return (meta >> 5) & 255; } __device__ __forceinline__ int nb() const { return meta >> 13; } };
struct Gemm { const char* A; const char* B; int lda, ldb, K; long tstepA, tstepB, hstepB; };

struct StaticOrder {
    int nM, nN, nwg, G, c;
    __host__ __device__ void init(int nM_, int nN_, int G_, int c_) { nM = nM_; nN = nN_; nwg = nM * nN; G = G_; c = c_; }
    __host__ __device__ bool next(int i, Unit& u) const {
        const long L = (long)i * G + c; if (L >= nwg) return false;
        int wgid = (int)L; { const int q = nwg / NXCD, r = nwg % NXCD, xcd = wgid % NXCD, off = wgid / NXCD; wgid = (xcd < r ? xcd * (q + 1) : r * (q + 1) + (xcd - r) * q) + off; }
        const int nig = WGM * nN, gid = wgid / nig, fm = gid * WGM, gsz = (nM - fm) < WGM ? (nM - fm) : WGM;
        u.pm = fm + ((wgid % nig) % gsz); u.pn = (wgid % nig) / gsz; return true;
    }
};

__device__ __forceinline__ unsigned cvt_pk_bf16(float lo, float hi) { unsigned r; asm volatile("v_cvt_pk_bf16_f32 %0, %1, %2" : "=v"(r) : "v"(lo), "v"(hi)); return r; }

struct EpiQKV {
    static constexpr bool PERM = true;
    bf16_t* O; size_t split_stride; float scale0;
    __device__ __forceinline__ void operator()(const f32x4 (&acc)[2][2][4][2], const Unit& u, int wr, int wc, int fr, int fq) const {
        asm volatile("" : "+v"(fr), "+v"(fq));
        const int row0 = u.pm * BM + wr * 64 + fr; int colt = u.pn * BM;
        const int t = colt / DM; bf16_t* base = O + (size_t)t * split_stride; colt -= t * DM; const float sc = (t == 0) ? scale0 : 1.f;
        const int col0 = colt + wc * 32 + 8 * fq;
#pragma unroll
        for (int ai = 0; ai < 2; ++ai)
#pragma unroll
            for (int m = 0; m < 4; ++m) { bf16_t* rowp = base + (size_t)(row0 + ai * HALF + m * 16) * DM + col0;
#pragma unroll
                for (int bj = 0; bj < 2; ++bj) { f32x4 v0 = acc[ai][bj][m][0] * sc, v1 = acc[ai][bj][m][1] * sc;
                    u32x4 w; w.x = cvt_pk_bf16(v0[0], v0[1]); w.y = cvt_pk_bf16(v0[2], v0[3]); w.z = cvt_pk_bf16(v1[0], v1[1]); w.w = cvt_pk_bf16(v1[2], v1[3]);
                    *(u32x4*)(rowp + bj * HALF) = w; } }
    }
};
struct EpiResAdd {
    static constexpr bool PERM = false;
    const float* base; float* out;
    __device__ __forceinline__ void operator()(const f32x4 (&acc)[2][2][4][2], const Unit& u, int wr, int wc, int fr, int fq) const {
        asm volatile("" : "+v"(fr), "+v"(fq));
        const int col0 = u.pn * BM + wc * 32 + 4 * fq;
#pragma unroll
        for (int ai = 0; ai < 2; ++ai)
#pragma unroll
            for (int m = 0; m < 4; ++m) { const size_t off = (size_t)(u.pm * BM + ai * HALF + wr * 64 + m * 16 + fr) * DM + col0;
#pragma unroll
                for (int bj = 0; bj < 2; ++bj)
#pragma unroll
                    for (int n = 0; n < 2; ++n) { const f32x4 bs = *(const f32x4*)(base + off + bj * HALF + n * 16); *(f32x4*)(out + off + bj * HALF + n * 16) = bs + acc[ai][bj][m][n]; } }
    }
};
struct EpiGateUpDense {
    static constexpr bool PERM = true;
    bf16_t* act; const float* comb;
    __device__ __forceinline__ void operator()(const f32x4 (&acc)[2][2][4][2], const Unit& u, int wr, int wc, int fr, int fq) const {
        asm volatile("" : "+v"(fr), "+v"(fq));
        const int e = u.pn >> 1, c0 = (u.pn & 1) * HALF;
        const int col0 = e * DEXP + c0 + wc * 32 + 8 * fq;
#pragma unroll
        for (int ai = 0; ai < 2; ++ai)
#pragma unroll
            for (int m = 0; m < 4; ++m) { const int row = u.pm * BM + ai * HALF + wr * 64 + m * 16 + fr;
                const float cw = comb[(size_t)row * NEXP + e];
                float o[8];
#pragma unroll
                for (int n = 0; n < 2; ++n)
#pragma unroll
                    for (int j = 0; j < 4; ++j) { const float g = acc[ai][0][m][n][j], up = acc[ai][1][m][n][j];
                        const float sg = g * __builtin_amdgcn_rcpf(1.f + __builtin_amdgcn_exp2f(-g * LOG2E));
                        o[n * 4 + j] = sg * up * cw; }
                u32x4 w; w.x = cvt_pk_bf16(o[0], o[1]); w.y = cvt_pk_bf16(o[2], o[3]); w.z = cvt_pk_bf16(o[4], o[5]); w.w = cvt_pk_bf16(o[6], o[7]);
                *(u32x4*)(act + (size_t)row * NACT + col0) = w; }
    }
};

template <class Epi, class Sched>
__device__ __forceinline__ void gemm_phase(LAS unsigned char* lds, const Gemm g, const Sched& S, const Epi& E, int wave_id) {
    int lane_l = (int)__builtin_amdgcn_mbcnt_hi(~0u, __builtin_amdgcn_mbcnt_lo(~0u, 0u)); asm volatile("" : "+v"(lane_l));
    const int wid = wave_id, lane = lane_l, tid = wid * 64 + lane, wr = wid >> 2, wc = wid & 3, fr = lane & 15, fq = lane >> 4;
    const int K = g.K, nt = K / BK;
    unsigned voffA[2], voffB[2];
#pragma unroll
    for (int i = 0; i < 2; ++i) { int R, C; stage_rc(tid * 16 + i * 8192, R, C); const int Rb = Epi::PERM ? ((R & ~31) + perm32(R & 31)) : R;
        voffA[i] = (unsigned)(R * g.lda + C) * 2u; voffB[i] = (unsigned)(Rb * g.ldb + C) * 2u; }
    const size_t kstep = (size_t)(BK * 2);
    const size_t hstepA = (size_t)HALF * g.lda * 2;
    const long hstepB = g.hstepB;
    const unsigned ldsw = (unsigned)wid * 1024u;
    const int aoff = lds_byte(wr * 64 + fr, fq * 8), boff = lds_byte(wc * 32 + fr, fq * 8);
#define PG8_SA(b, h) (((b) * 2 + (h)) * HTB)
#define PG8_SB(b, h) ((4 + (b) * 2 + (h)) * HTB)
#define PG8_STAGE(bufoff, gbase, voff) do { _Pragma("unroll") for (int _i = 0; _i < 2; ++_i) \
        __builtin_amdgcn_global_load_lds((const unsigned*)((const char*)(gbase) + (voff)[_i]), (LAS unsigned*)(lds + (bufoff) + ldsw + _i * 8192), 16, 0, 0); } while (0)
#define PG8_LDA(dst, b, h) do { _Pragma("unroll") for (int m = 0; m < 4; ++m) _Pragma("unroll") for (int k = 0; k < 2; ++k) dst[m][k] = *(const LAS bf16x8*)(lds + PG8_SA(b, h) + aoff + m * 2048 + k * 1024); } while (0)
#define PG8_LDB(dst, b, h) do { _Pragma("unroll") for (int n = 0; n < 2; ++n) _Pragma("unroll") for (int k = 0; k < 2; ++k) dst[n][k] = *(const LAS bf16x8*)(lds + PG8_SB(b, h) + boff + n * 2048 + k * 1024); } while (0)
#define PG8_MMA(ai, bj, At, Bt) do { __builtin_amdgcn_s_setprio(1); _Pragma("unroll") for (int m = 0; m < 4; ++m) _Pragma("unroll") for (int n = 0; n < 2; ++n) _Pragma("unroll") for (int k = 0; k < 2; ++k) \
        acc[ai][bj][m][n] = __builtin_amdgcn_mfma_f32_16x16x32_bf16(Bt[n][k], At[m][k], acc[ai][bj][m][n], 0, 0, 0); __builtin_amdgcn_s_setprio(0); } while (0)
#define PG8_WAIT_V(n) asm volatile("s_waitcnt vmcnt(" #n ")" ::: "memory")
#define PG8_WAIT_L(n) asm volatile("s_waitcnt lgkmcnt(" #n ")" ::: "memory")
#define PG8_BAR __builtin_amdgcn_s_barrier()
#define PG8_SCHED __builtin_amdgcn_sched_barrier(0)
    Unit cur, nxt; int ui = 0;
    if (!S.next(0, cur)) return;
    f32x4 acc[2][2][4][2];
#pragma unroll
    for (int a = 0; a < 2; ++a)
#pragma unroll
        for (int b = 0; b < 2; ++b)
#pragma unroll
            for (int m = 0; m < 4; ++m)
#pragma unroll
                for (int n = 0; n < 2; ++n) acc[a][b][m][n] = (f32x4){0.f, 0.f, 0.f, 0.f};
    bf16x8 At[4][2], B0[2][2], B1[2][2];
    const char* cA = g.A + (size_t)cur.pm * g.tstepA; const char* cB = g.B + (size_t)cur.pn * g.tstepB;
    PG8_STAGE(PG8_SB(0, 0), cB, voffB); PG8_STAGE(PG8_SB(0, 1), cB + hstepB, voffB); PG8_STAGE(PG8_SA(0, 0), cA, voffA); PG8_STAGE(PG8_SA(0, 1), cA + hstepA, voffA);
    if (wr == 1) PG8_BAR;
    PG8_WAIT_V(2); PG8_BAR;
    PG8_STAGE(PG8_SB(1, 0), cB + kstep, voffB); PG8_STAGE(PG8_SA(1, 0), cA + kstep, voffA); PG8_STAGE(PG8_SB(1, 1), cB + hstepB + kstep, voffB);
    PG8_WAIT_V(6); PG8_BAR;
    for (;;) {
        const bool has_next = S.next(ui + 1, nxt);
        const char* nA = has_next ? g.A + (size_t)nxt.pm * g.tstepA : cA; const char* nB = has_next ? g.B + (size_t)nxt.pn * g.tstepB : cB;
        for (int t = 0; t < nt; t += 2) {
            const bool last = (t == nt - 2);
            const char* a1 = cA + (size_t)(t + 1) * kstep;
            const char* a2 = last ? nA : cA + (size_t)(t + 2) * kstep; const char* b2 = last ? nB : cB + (size_t)(t + 2) * kstep;
            const char* a3 = a2 + kstep; const char* b3 = b2 + kstep;
            PG8_LDB(B0, 0, 0); PG8_LDB(B1, 0, 1); PG8_SCHED; PG8_LDA(At, 0, 0); PG8_STAGE(PG8_SA(1, 1), a1 + hstepA, voffA);
            PG8_WAIT_V(8); PG8_WAIT_L(0); PG8_BAR; PG8_MMA(0, 0, At, B0); PG8_MMA(0, 1, At, B1); PG8_BAR; PG8_SCHED;
            PG8_LDA(At, 0, 1); PG8_STAGE(PG8_SB(0, 0), b2, voffB); PG8_STAGE(PG8_SB(0, 1), b2 + hstepB, voffB); PG8_STAGE(PG8_SA(0, 0), a2, voffA);
            PG8_WAIT_V(8); PG8_WAIT_L(0); PG8_BAR; PG8_MMA(1, 0, At, B0); PG8_MMA(1, 1, At, B1); PG8_BAR; PG8_SCHED;
            PG8_LDB(B0, 1, 0); PG8_LDB(B1, 1, 1); PG8_SCHED; PG8_LDA(At, 1, 0); PG8_STAGE(PG8_SA(0, 1), a2 + hstepA, voffA);
            PG8_WAIT_V(8); PG8_WAIT_L(0); PG8_BAR; PG8_MMA(0, 0, At, B0); PG8_MMA(0, 1, At, B1); PG8_BAR; PG8_SCHED;
            PG8_LDA(At, 1, 1); PG8_STAGE(PG8_SB(1, 0), b3, voffB); PG8_STAGE(PG8_SB(1, 1), b3 + hstepB, voffB); PG8_STAGE(PG8_SA(1, 0), a3, voffA);
            PG8_WAIT_V(8); PG8_WAIT_L(0); PG8_BAR; PG8_MMA(1, 0, At, B0); PG8_MMA(1, 1, At, B1); PG8_BAR; PG8_SCHED;
        }
        if (wr == 0) PG8_BAR;
        E(acc, cur, wr, wc, fr, fq);
        if (!has_next) break;
#pragma unroll
        for (int a = 0; a < 2; ++a)
#pragma unroll
            for (int b = 0; b < 2; ++b)
#pragma unroll
                for (int m = 0; m < 4; ++m)
#pragma unroll
                    for (int n = 0; n < 2; ++n) acc[a][b][m][n] = (f32x4){0.f, 0.f, 0.f, 0.f};
        cur = nxt; cA = nA; cB = nB; ++ui;
        if (wr == 1) PG8_BAR;
    }
    PG8_WAIT_V(0);
    PG8_BAR;
#undef PG8_SA
#undef PG8_SB
#undef PG8_STAGE
#undef PG8_LDA
#undef PG8_LDB
#undef PG8_MMA
#undef PG8_WAIT_V
#undef PG8_WAIT_L
#undef PG8_BAR
#undef PG8_SCHED
}
template <class Epi, class Prob>
__device__ __forceinline__ void gemm_phase_x(LAS unsigned char* lds, const Prob& P, const Epi& E, int wave_id) {
    int lane_l = (int)__builtin_amdgcn_mbcnt_hi(~0u, __builtin_amdgcn_mbcnt_lo(~0u, 0u)); asm volatile("" : "+v"(lane_l));
    const int wid = wave_id, lane = lane_l, tid = wid * 64 + lane, wr = wid >> 2, wc = wid & 3, fr = lane & 15, fq = lane >> 4;
    const int K = P.K, nt = K / BK;
    unsigned voffB[2];
#pragma unroll
    for (int i = 0; i < 2; ++i) { int R, C; stage_rc(tid * 16 + i * 8192, R, C); const int Rb = Epi::PERM ? ((R & ~31) + perm32(R & 31)) : R; voffB[i] = (unsigned)(Rb * P.ldb + C) * 2u; }
    const size_t kstep = (size_t)(BK * 2);
    const long hstepB = P.hstepB;
    const unsigned ldsw = (unsigned)wid * 1024u;
    const int aoff = lds_byte(wr * 64 + fr, fq * 8), boff = lds_byte(wc * 32 + fr, fq * 8);
    LAS u32x4* stash = (LAS u32x4*)(lds + STAGE_BYTES + 1024) + tid;
#define PG8_SA(b, h) (((b) * 2 + (h)) * HTB)
#define PG8_SB(b, h) ((4 + (b) * 2 + (h)) * HTB)
#define PG8_STAGE(bufoff, gbase, voff) do { _Pragma("unroll") for (int _i = 0; _i < 2; ++_i) \
        __builtin_amdgcn_global_load_lds((const unsigned*)((const char*)(gbase) + (voff)[_i]), (LAS unsigned*)(lds + (bufoff) + ldsw + _i * 8192), 16, 0, 0); } while (0)
#define PG8_LDA(dst, b, h) do { _Pragma("unroll") for (int m = 0; m < 4; ++m) _Pragma("unroll") for (int k = 0; k < 2; ++k) dst[m][k] = *(const LAS bf16x8*)(lds + PG8_SA(b, h) + aoff + m * 2048 + k * 1024); } while (0)
#define PG8_LDB(dst, b, h) do { _Pragma("unroll") for (int n = 0; n < 2; ++n) _Pragma("unroll") for (int k = 0; k < 2; ++k) dst[n][k] = *(const LAS bf16x8*)(lds + PG8_SB(b, h) + boff + n * 2048 + k * 1024); } while (0)
#define PG8_MMA(ai, bj, At, Bt) do { __builtin_amdgcn_s_setprio(1); _Pragma("unroll") for (int m = 0; m < 4; ++m) _Pragma("unroll") for (int n = 0; n < 2; ++n) _Pragma("unroll") for (int k = 0; k < 2; ++k) \
        acc[ai][bj][m][n] = __builtin_amdgcn_mfma_f32_16x16x32_bf16(Bt[n][k], At[m][k], acc[ai][bj][m][n], 0, 0, 0); __builtin_amdgcn_s_setprio(0); } while (0)
#define PG8_WAIT_V(n) asm volatile("s_waitcnt vmcnt(" #n ")" ::: "memory")
#define PG8_WAIT_L(n) asm volatile("s_waitcnt lgkmcnt(" #n ")" ::: "memory")
#define PG8_BAR __builtin_amdgcn_s_barrier()
#define PG8_SCHED __builtin_amdgcn_sched_barrier(0)
#define PG8_AVOFF(dst, u) do { int t2_ = tid; asm volatile("" : "+v"(t2_)); _Pragma("unroll") for (int i_ = 0; i_ < 2; ++i_) { int R_, C_; stage_rc(t2_ * 16 + i_ * 8192, R_, C_); _Pragma("unroll") for (int h_ = 0; h_ < 2; ++h_) \
        dst[h_][i_] = (Prob::GATHER ? P.arow_off(u, h_, R_) : (unsigned)((h_ * HALF + R_) * P.lda) * 2u) + (unsigned)C_ * 2u; } } while (0)
    Unit cur, nxt; int ui = 0;
    if (!P.next(0, cur)) return;
    unsigned vA[2][2];
    PG8_AVOFF(vA, cur);
    f32x4 acc[2][2][4][2];
#pragma unroll
    for (int a = 0; a < 2; ++a)
#pragma unroll
        for (int b = 0; b < 2; ++b)
#pragma unroll
            for (int m = 0; m < 4; ++m)
#pragma unroll
                for (int n = 0; n < 2; ++n) acc[a][b][m][n] = (f32x4){0.f, 0.f, 0.f, 0.f};
    bf16x8 At[4][2], B0[2][2], B1[2][2];
    const char* cA = P.a_base(cur); const char* cB = P.b_base(cur);
    long csplit = Prob::KSPLIT ? P.bsplit(cur) : 0;
    PG8_STAGE(PG8_SB(0, 0), cB, voffB); PG8_STAGE(PG8_SB(0, 1), cB + hstepB, voffB); PG8_STAGE(PG8_SA(0, 0), cA, vA[0]); PG8_STAGE(PG8_SA(0, 1), cA, vA[1]);
    if (wr == 1) PG8_BAR;
    PG8_WAIT_V(2); PG8_BAR;
    PG8_STAGE(PG8_SB(1, 0), cB + kstep, voffB); PG8_STAGE(PG8_SA(1, 0), cA + kstep, vA[0]); PG8_STAGE(PG8_SB(1, 1), cB + hstepB + kstep, voffB);
    PG8_WAIT_V(6); PG8_BAR;
    for (;;) {
        const bool has_next = P.next(ui + 1, nxt);
        const char* nA = has_next ? P.a_base(nxt) : cA; const char* nB = has_next ? P.b_base(nxt) : cB;
        if (Prob::GATHER) { unsigned vN[2][2];
            if (has_next) { PG8_AVOFF(vN, nxt); } else { vN[0][0] = vA[0][0]; vN[0][1] = vA[0][1]; vN[1][0] = vA[1][0]; vN[1][1] = vA[1][1]; }
            *stash = (u32x4){vN[0][0], vN[0][1], vN[1][0], vN[1][1]}; }
        for (int t = 0; t < nt; t += 2) {
            const bool last = (t == nt - 2);
            const char* a1 = cA + (size_t)(t + 1) * kstep;
            const char* a2 = last ? nA : cA + (size_t)(t + 2) * kstep;
            const char* b2 = last ? nB : cB + (size_t)(t + 2) * kstep + ((Prob::KSPLIT && (t + 2) >= (nt >> 1)) ? csplit : 0);
            const char* a3 = a2 + kstep; const char* b3 = b2 + kstep;
            PG8_LDB(B0, 0, 0); PG8_LDB(B1, 0, 1); PG8_SCHED; PG8_LDA(At, 0, 0); PG8_STAGE(PG8_SA(1, 1), a1, vA[1]);
            if (Prob::GATHER && last) { const u32x4 sv = *stash; vA[0][0] = sv.x; vA[0][1] = sv.y; vA[1][0] = sv.z; vA[1][1] = sv.w; }
            PG8_WAIT_V(8); PG8_WAIT_L(0); PG8_BAR; PG8_MMA(0, 0, At, B0); PG8_MMA(0, 1, At, B1); PG8_BAR; PG8_SCHED;
            PG8_LDA(At, 0, 1); PG8_STAGE(PG8_SB(0, 0), b2, voffB); PG8_STAGE(PG8_SB(0, 1), b2 + hstepB, voffB); PG8_STAGE(PG8_SA(0, 0), a2, vA[0]);
            PG8_WAIT_V(8); PG8_WAIT_L(0); PG8_BAR; PG8_MMA(1, 0, At, B0); PG8_MMA(1, 1, At, B1); PG8_BAR; PG8_SCHED;
            PG8_LDB(B0, 1, 0); PG8_LDB(B1, 1, 1); PG8_SCHED; PG8_LDA(At, 1, 0); PG8_STAGE(PG8_SA(0, 1), a2, vA[1]);
            PG8_WAIT_V(8); PG8_WAIT_L(0); PG8_BAR; PG8_MMA(0, 0, At, B0); PG8_MMA(0, 1, At, B1); PG8_BAR; PG8_SCHED;
            PG8_LDA(At, 1, 1); PG8_STAGE(PG8_SB(1, 0), b3, voffB); PG8_STAGE(PG8_SB(1, 1), b3 + hstepB, voffB); PG8_STAGE(PG8_SA(1, 0), a3, vA[0]);
            PG8_WAIT_V(8); PG8_WAIT_L(0); PG8_BAR; PG8_MMA(1, 0, At, B0); PG8_MMA(1, 1, At, B1); PG8_BAR; PG8_SCHED;
        }
        if (wr == 0) PG8_BAR;
        E(acc, cur, wr, wc, fr, fq);
        if (!has_next) break;
#pragma unroll
        for (int a = 0; a < 2; ++a)
#pragma unroll
            for (int b = 0; b < 2; ++b)
#pragma unroll
                for (int m = 0; m < 4; ++m)
#pragma unroll
                    for (int n = 0; n < 2; ++n) acc[a][b][m][n] = (f32x4){0.f, 0.f, 0.f, 0.f};
        cur = nxt; cA = nA; cB = nB; ++ui;
        if (Prob::KSPLIT) csplit = P.bsplit(cur);
        if (wr == 1) PG8_BAR;
    }
    PG8_WAIT_V(0);
    PG8_BAR;
#undef PG8_SA
#undef PG8_SB
#undef PG8_STAGE
#undef PG8_LDA
#undef PG8_LDB
#undef PG8_MMA
#undef PG8_WAIT_V
#undef PG8_WAIT_L
#undef PG8_BAR
#undef PG8_SCHED
#undef PG8_AVOFF
}

__device__ __forceinline__ int pair_a(int pi) { return pi < 3 ? 0 : (pi < 5 ? 1 : 2); }
__device__ __forceinline__ int pair_b(int pi) { return pi == 0 ? 1 : ((pi == 1 || pi == 3) ? 2 : 3); }
template <int MODE>
struct MoeProb {
    static constexpr bool GATHER = (MODE == 0), KSPLIT = (MODE == 1);
    const unsigned* cnt; const unsigned* list; const char* A; const char* B; int lda, ldb, K; long hstepB; int G, c;
    __device__ __forceinline__ bool next(int i, Unit& u) const {
        const long L = (long)i * G + c; const int tileidx = (int)(L >> 2);
        int accu = 0, bk = -1, tib = 0, nb = 0;
        for (int k = 0; k < 24; ++k) { const int n = (int)cnt[k]; const int tl = (n + 255) >> 8; if (bk < 0 && tileidx < accu + tl) { bk = k; tib = tileidx - accu; nb = n; } accu += tl; }
        if (bk < 0) return false;
        u.pm = tileidx; u.pn = (int)(L & 3); u.meta = bk | (tib << 5) | (nb << 13); return true;
    }
    __device__ __forceinline__ int expert(const Unit& u, int s) const { const int g = u.bk() / 6, pi = u.bk() % 6; return g * 4 + (s ? pair_b(pi) : pair_a(pi)); }
    __device__ __forceinline__ const char* a_base(const Unit& u) const { return MODE == 0 ? A : A + (size_t)u.pm * 256 * lda * 2; }
    __device__ __forceinline__ const char* b_base(const Unit& u) const {
        if (MODE == 0) return B + ((size_t)expert(u, u.pn >> 1) * DEXP + (size_t)(u.pn & 1) * HALF) * ldb * 2;
        return B + (size_t)u.pn * 256 * ldb * 2 + (size_t)expert(u, 0) * DEXP * 2;
    }
    __device__ __forceinline__ unsigned arow_off(const Unit& u, int h, int R) const { const int pos = u.tib() * 256 + h * HALF + R; const unsigned tok = pos < u.nb() ? list[(size_t)u.bk() * T + pos] : 0u; return tok * (unsigned)(lda * 2); }
    __device__ __forceinline__ long bsplit(const Unit& u) const { return ((long)(expert(u, 1) - expert(u, 0)) * DEXP - DEXP) * 2; }
};
struct EpiGateUpSparse {
    static constexpr bool PERM = true;
    bf16_t* act; const float* wlist;
    __device__ __forceinline__ void operator()(const f32x4 (&acc)[2][2][4][2], const Unit& u, int wr, int wc, int fr, int fq) const {
        asm volatile("" : "+v"(fr), "+v"(fq));
        const int s = u.pn >> 1, col0 = s * DEXP + (u.pn & 1) * HALF + wc * 32 + 8 * fq;
#pragma unroll
        for (int ai = 0; ai < 2; ++ai)
#pragma unroll
            for (int m = 0; m < 4; ++m) { const int r = ai * HALF + wr * 64 + m * 16 + fr, pos = u.tib() * 256 + r;
                const float cw = pos < u.nb() ? wlist[((size_t)u.bk() * T + pos) * 2 + s] : 0.f;
                float o[8];
#pragma unroll
                for (int n = 0; n < 2; ++n)
#pragma unroll
                    for (int j = 0; j < 4; ++j) { const float g = acc[ai][0][m][n][j], up = acc[ai][1][m][n][j];
                        const float sg = g * __builtin_amdgcn_rcpf(1.f + __builtin_amdgcn_exp2f(-g * LOG2E));
                        o[n * 4 + j] = sg * up * cw; }
                u32x4 w; w.x = cvt_pk_bf16(o[0], o[1]); w.y = cvt_pk_bf16(o[2], o[3]); w.z = cvt_pk_bf16(o[4], o[5]); w.w = cvt_pk_bf16(o[6], o[7]);
                *(u32x4*)(act + ((size_t)u.pm * 256 + r) * 512 + col0) = w;
                if (m & 1) asm volatile("" ::: "memory"); }
    }
};
struct EpiDownScatter {
    static constexpr bool PERM = false;
    float* x; const unsigned* list;
    __device__ __forceinline__ void operator()(const f32x4 (&acc)[2][2][4][2], const Unit& u, int wr, int wc, int fr, int fq) const {
        asm volatile("" : "+v"(fr), "+v"(fq));
        const int col0 = u.pn * BM + wc * 32 + 4 * fq;
#pragma unroll
        for (int ai = 0; ai < 2; ++ai)
#pragma unroll
            for (int m = 0; m < 4; ++m) { const int pos = u.tib() * 256 + ai * HALF + wr * 64 + m * 16 + fr;
                if (pos < u.nb()) { const size_t off = (size_t)list[(size_t)u.bk() * T + pos] * DM + col0;
#pragma unroll
                    for (int bj = 0; bj < 2; ++bj)
#pragma unroll
                        for (int n = 0; n < 2; ++n) { f32x4* p = (f32x4*)(x + off + bj * HALF + n * 16); *p = *p + acc[ai][bj][m][n]; } }
                asm volatile("" ::: "memory"); }
    }
};
}

#define XB_TMO      128
#define XB_XCNT(j)  (256  + 64 * (j))
#define XB_XSUB(j)  (1280 + 64 * (j))
#define XB_XGEN(j)  (2304 + 64 * (j))
#define XB_TOP      3328
#define XB_TOPGEN   3392
#define XCD_BAR_WORDS 3456
#define XB_SPIN_CAP (1u << 18)
__device__ __forceinline__ unsigned xb_ld(unsigned* p)              { return __hip_atomic_load(p, __ATOMIC_RELAXED, __HIP_MEMORY_SCOPE_AGENT); }
__device__ __forceinline__ unsigned xb_add(unsigned* p, unsigned v) { return __hip_atomic_fetch_add(p, v, __ATOMIC_RELAXED, __HIP_MEMORY_SCOPE_AGENT); }
__device__ __forceinline__ unsigned xb_xcc_id() { return (unsigned)__builtin_amdgcn_s_getreg((3 << 11) | 20) & 0xFu; }
#define XB_SPIN(cond, bar) do { unsigned _sp = 0; while (cond) { __builtin_amdgcn_s_sleep(1); \
    if ((++_sp & 255u) == 0u) { if (xb_ld(&(bar)[XB_TMO])) break; if (_sp > XB_SPIN_CAP) { atomicAdd(&(bar)[XB_TMO], 1u); break; } } } } while (0)
struct XcdBarrier { unsigned* bar; unsigned x; volatile LAS unsigned* st; };
__device__ __forceinline__ XcdBarrier xcd_barrier_post(unsigned* bar, volatile LAS unsigned* st) {
    XcdBarrier b; b.bar = bar; b.x = xb_xcc_id(); b.st = st;
    if (threadIdx.x == 0) (void)xb_add(&bar[XB_XCNT(b.x)], 1u);
    return b;
}
__device__ __forceinline__ void xcd_barrier_complete(unsigned* bar, unsigned x, unsigned& nloc, unsigned& nx) {
    const unsigned G = gridDim.x * gridDim.y * gridDim.z;
    unsigned sum, cnt, mine, sp = 0u;
    for (;;) {
        sum = 0u; cnt = 0u; mine = 0u;
#pragma unroll
        for (unsigned j = 0; j < 16; ++j) { const unsigned c = xb_ld(&bar[XB_XCNT(j)]); sum += c; cnt += (c > 0u) ? 1u : 0u; mine = (j == x) ? c : mine; }
        if (sum == G) break;
        __builtin_amdgcn_s_sleep(1);
        if ((++sp & 255u) == 0u) { if (xb_ld(&bar[XB_TMO])) break; if (sp > XB_SPIN_CAP) { atomicAdd(&bar[XB_TMO], 1u); break; } }
    }
    nloc = mine > 0u ? mine : 1u; nx = cnt > 0u ? cnt : 1u;
}
__device__ __forceinline__ void xcd_barrier(const XcdBarrier& b) {
    asm volatile("s_waitcnt vmcnt(0)" ::: "memory");
    __syncthreads();
    if (threadIdx.x == 0) {
        unsigned* bar = b.bar;
        __builtin_amdgcn_s_waitcnt(0);
        unsigned nloc = b.st[0], nx = b.st[1];
        if (nloc == 0u) { xcd_barrier_complete(bar, b.x, nloc, nx); b.st[0] = nloc; b.st[1] = nx; }
        const unsigned old = xb_add(&bar[XB_XSUB(b.x)], 1u);
        const unsigned gen = old / nloc;
        if (old + 1u == (gen + 1u) * nloc) {
            __builtin_amdgcn_fence(__ATOMIC_RELEASE, "agent");
            asm volatile("s_waitcnt vmcnt(0)" ::: "memory");
            const unsigned og = xb_add(&bar[XB_TOP], 1u);
            const unsigned tg = og / nx;
            if (og + 1u == (tg + 1u) * nx) xb_add(&bar[XB_TOPGEN], 1u);
            else XB_SPIN(xb_ld(&bar[XB_TOPGEN]) == tg, bar);
            __builtin_amdgcn_fence(__ATOMIC_ACQUIRE, "agent");
            xb_add(&bar[XB_XGEN(b.x)], 1u);
            asm volatile("s_waitcnt vmcnt(0)" ::: "memory");
        } else {
            XB_SPIN(xb_ld(&bar[XB_XGEN(b.x)]) == gen, bar);
            __builtin_amdgcn_fence(__ATOMIC_ACQUIRE, "agent");
            asm volatile("s_waitcnt vmcnt(0)" ::: "memory");
        }
    }
    __syncthreads();
}

struct Args {
    const float* x; const float* ln1_g; const float* w_in; const float* mix_g; const float* w_out; const float* ln2_g;
    const float* w_gr; const float* b_gr; const float* w_er; const float* b_er; const float* w_gate; const float* w_up; const float* w_down; const float* fin_g;
    float* out; unsigned char* ws; int ph_lo, ph_hi, li, pad;
};

__device__ __forceinline__ void transpose_item(const float* W, int K, int N, bf16_t* WT, int dpitch, int dcol, LAS float* scr, int item, int lane) {
    const int nblk = N / 32, kb = item / nblk, nb = item % nblk, k0 = 64 * kb, n0 = 32 * nb;
#pragma unroll 8
    for (int i = 0; i < 32; ++i) { const int kk = 2 * i + (lane >> 5); scr[kk * 33 + (lane & 31)] = W[(size_t)(k0 + kk) * N + n0 + (lane & 31)]; }
    LDS_WAIT(); asm volatile("" ::: "memory");
    const int c = lane & 7;
#pragma unroll
    for (int j = 0; j < 4; ++j) { const int n = (lane >> 3) + 8 * j; const LAS float* s = scr + (8 * c) * 33 + n;
        u32x4 o; o.x = pk2(s[0 * 33], s[1 * 33]); o.y = pk2(s[2 * 33], s[3 * 33]); o.z = pk2(s[4 * 33], s[5 * 33]); o.w = pk2(s[6 * 33], s[7 * 33]);
        *(u32x4*)(WT + (size_t)(n0 + n) * dpitch + dcol + k0 + 8 * c) = o; }
    LDS_WAIT(); asm volatile("" ::: "memory");
}
__device__ __forceinline__ void phase_prologue(const Args& a, LAS unsigned char* lds, int gw, int NGW, int wave, int lane) {
    LAS float* scr = (LAS float*)(lds + wave * 16384);
    constexpr int I_IN = (DM / 64) * (NQKV / 32);
    constexpr int I_OUT = (DM / 64) * (DM / 32);
    constexpr int I_G = (DM / 64) * (DEXP / 32);
    constexpr int I_D = (DEXP / 64) * (DM / 32);
    constexpr int N_IN = DEPTH * I_IN, N_OUT = DEPTH * I_OUT, N_G = DEPTH * NEXP * I_G, N_D = DEPTH * NEXP * I_D;
    constexpr int NITEMS = N_IN + N_OUT + 2 * N_G + N_D;
    bf16_t* WinT = (bf16_t*)(a.ws + WS_WIN); bf16_t* WoutT = (bf16_t*)(a.ws + WS_WOUT); bf16_t* WgT = (bf16_t*)(a.ws + WS_WG); bf16_t* WuT = (bf16_t*)(a.ws + WS_WU); bf16_t* WdT = (bf16_t*)(a.ws + WS_WD);
    for (int it = gw; it < NITEMS; it += NGW) {
        int r = it;
        if (r < N_IN) { const int l = r / I_IN; transpose_item(a.w_in + (size_t)l * DM * NQKV, DM, NQKV, WinT + (size_t)l * NQKV * DM, DM, 0, scr, r % I_IN, lane); continue; } r -= N_IN;
        if (r < N_OUT) { const int l = r / I_OUT; transpose_item(a.w_out + (size_t)l * DM * DM, DM, DM, WoutT + (size_t)l * DM * DM, DM, 0, scr, r % I_OUT, lane); continue; } r -= N_OUT;
        if (r < N_G) { const int le = r / I_G; transpose_item(a.w_gate + (size_t)le * DM * DEXP, DM, DEXP, WgT + (size_t)le * DEXP * DM, DM, 0, scr, r % I_G, lane); continue; } r -= N_G;
        if (r < N_G) { const int le = r / I_G; transpose_item(a.w_up + (size_t)le * DM * DEXP, DM, DEXP, WuT + (size_t)le * DEXP * DM, DM, 0, scr, r % I_G, lane); continue; } r -= N_G;
        { const int le = r / I_D, l = le / NEXP, e = le % NEXP; transpose_item(a.w_down + (size_t)le * DEXP * DM, DEXP, DM, WdT + (size_t)l * DM * NACT, NACT, e * DEXP, scr, r % I_D, lane); }
    }
}

__device__ __forceinline__ void phase_norm1(const float* x, const float* g, bf16_t* hb, int gw, int NGW, int lane) {
    f32x4 gv[4];
#pragma unroll
    for (int j = 0; j < 4; ++j) gv[j] = *((const f32x4*)g + lane + 64 * j);
    for (int m = gw; m < T; m += NGW) {
        const f32x4* xr = (const f32x4*)(x + (size_t)m * DM) + lane;
        f32x4 v[4]; float s = 0.f;
#pragma unroll
        for (int j = 0; j < 4; ++j) { v[j] = xr[64 * j]; s += (v[j].x * v[j].x + v[j].y * v[j].y) + (v[j].z * v[j].z + v[j].w * v[j].w); }
        const float rstd = 1.0f / sqrtf(wave_sum(s) * (1.f / DM) + NORM_EPS);
        u32x2* o8 = (u32x2*)(hb + (size_t)m * DM) + lane;
#pragma unroll
        for (int j = 0; j < 4; ++j) { u32x2 w; w.x = pk2(v[j].x * rstd * gv[j].x, v[j].y * rstd * gv[j].y); w.y = pk2(v[j].z * rstd * gv[j].z, v[j].w * rstd * gv[j].w); o8[64 * j] = w; }
    }
}
__device__ __forceinline__ void unpack8(float (&f)[8], const u32x4 w) { f[0] = bflo(w.x); f[1] = bfhi(w.x); f[2] = bflo(w.y); f[3] = bfhi(w.y); f[4] = bflo(w.z); f[5] = bfhi(w.z); f[6] = bflo(w.w); f[7] = bfhi(w.w); }
__device__ __forceinline__ void phase_mixnorm(const bf16_t* ob, bf16_t* hb, const float* lse, const bf16_t* pm, const float* lsem0, const float* lsem1, const float* g, int gw, int NGW, int lane) {
    float g0[8], g1[8];
#pragma unroll
    for (int j = 0; j < 8; ++j) { g0[j] = g[8 * lane + j]; g1[j] = g[512 + 8 * lane + j]; }
    const int hh = lane >> 3;
    for (int m = gw; m < T; m += NGW) {
        const u32x4 a = *((const u32x4*)(ob + (size_t)m * DM) + lane), c0 = *((const u32x4*)(ob + (size_t)m * DM + 512) + lane);
        const u32x4 c1 = *((const u32x4*)(hb + (size_t)m * DM) + lane), c2 = *((const u32x4*)(hb + (size_t)m * DM + 512) + lane);
        const float l0 = lse[(size_t)m * 8 + hh], l1 = lse[(size_t)T * 8 + (size_t)m * 8 + hh], l2 = lse[(size_t)2 * T * 8 + (size_t)m * 8 + hh];
        float va[8]; unpack8(va, a);
        if (lane < 32) {
            const u32x4 p0 = *((const u32x4*)(pm + (size_t)m * 256) + lane), p1 = *((const u32x4*)(pm + ((size_t)T + m) * 256) + lane), p2 = *((const u32x4*)(pm + ((size_t)2 * T + m) * 256) + lane);
            const float e0 = lsem0[(size_t)m * 4 + hh], e1 = lsem0[(size_t)T * 4 + (size_t)m * 4 + hh], e2 = lsem1[(size_t)m * 4 + hh], e3 = lsem1[(size_t)T * 4 + (size_t)m * 4 + hh];
            const float mx = fmaxf(fmaxf(e0, e1), fmaxf(e2, e3));
            float u0 = __builtin_amdgcn_exp2f(e0 - mx), u1 = __builtin_amdgcn_exp2f(e1 - mx), u2 = __builtin_amdgcn_exp2f(e2 - mx), u3 = __builtin_amdgcn_exp2f(e3 - mx);
            const float inv = 1.0f / ((u0 + u1) + (u2 + u3)); u0 *= inv; u1 *= inv; u2 *= inv; u3 *= inv;
            float y0[8], y1[8], y2[8]; unpack8(y0, p0); unpack8(y1, p1); unpack8(y2, p2);
#pragma unroll
            for (int j = 0; j < 8; ++j) va[j] = (u0 * y0[j] + u1 * y1[j]) + (u2 * y2[j] + u3 * va[j]);
        }
        const float mx = fmaxf(l0, fmaxf(l1, l2));
        float w0 = __builtin_amdgcn_exp2f(l0 - mx), w1 = __builtin_amdgcn_exp2f(l1 - mx), w2 = __builtin_amdgcn_exp2f(l2 - mx);
        const float inv = 1.0f / (w0 + w1 + w2); w0 *= inv; w1 *= inv; w2 *= inv;
        float x0[8], x1[8], x2[8]; unpack8(x0, c0); unpack8(x1, c1); unpack8(x2, c2);
        float vc[8];
        float sa = 0.f, sc = 0.f;
#pragma unroll
        for (int j = 0; j < 8; ++j) { vc[j] = w0 * x0[j] + w1 * x1[j] + w2 * x2[j]; sa += va[j] * va[j]; sc += vc[j] * vc[j]; }
        sa = half_sum(sa); sc = wave_sum(sc);
        const float ra = 1.0f / sqrtf(sa * (1.f / 256.f) + NORM_EPS), rc = 1.0f / sqrtf(sc * (1.f / 512.f) + NORM_EPS);
        u32x4 oa, oc;
        oa.x = pk2(va[0] * ra * g0[0], va[1] * ra * g0[1]); oa.y = pk2(va[2] * ra * g0[2], va[3] * ra * g0[3]); oa.z = pk2(va[4] * ra * g0[4], va[5] * ra * g0[5]); oa.w = pk2(va[6] * ra * g0[6], va[7] * ra * g0[7]);
        oc.x = pk2(vc[0] * rc * g1[0], vc[1] * rc * g1[1]); oc.y = pk2(vc[2] * rc * g1[2], vc[3] * rc * g1[3]); oc.z = pk2(vc[4] * rc * g1[4], vc[5] * rc * g1[5]); oc.w = pk2(vc[6] * rc * g1[6], vc[7] * rc * g1[7]);
        *((u32x4*)(hb + (size_t)m * DM) + lane) = oa; *((u32x4*)(hb + (size_t)m * DM + 512) + lane) = oc;
    }
}
__device__ __forceinline__ void phase_route(const float* x, const float* g, const float* wgr, const float* bgr, const float* wer, const float* ber,
                                            bf16_t* hb, unsigned* cnt, unsigned* list, float* wlist, LAS unsigned char* lds, int v, int G, int wave, int lane) {
    const int tid = wave * 64 + lane;
    LAS f32x4* wl = (LAS f32x4*)lds;
    for (int idx = tid; idx < 5 * DM; idx += NTHREADS) { const int mtx = idx >> 10, d = idx & 1023; const float* src = (mtx == 0 ? wgr : wer + (size_t)(mtx - 1) * DM * 4) + d * 4;
        wl[mtx * 1024 + (d & 3) * 256 + (d >> 2)] = *(const f32x4*)src; }
    LAS unsigned* cl = (LAS unsigned*)(lds + 81920);
    LAS u32x2* info = (LAS u32x2*)(lds + 81920 + 256);
    LAS f32x2* infw = (LAS f32x2*)(lds + 81920 + 256 + 4096);
    if (tid < 64) cl[tid] = 0u;
    __syncthreads();
    const int rpw = (T + G - 1) / G, row0 = v * rpw;
    f32x4 gv[4];
#pragma unroll
    for (int j = 0; j < 4; ++j) gv[j] = *((const f32x4*)g + lane + 64 * j);
    const f32x4 bg = *(const f32x4*)bgr;
    for (int r = wave; r < rpw; r += NWAVES) {
        const int m = row0 + r; if (m >= T) break;
        const f32x4* xr = (const f32x4*)(x + (size_t)m * DM) + lane;
        f32x4 vv[4]; float s = 0.f;
#pragma unroll
        for (int j = 0; j < 4; ++j) { vv[j] = xr[64 * j]; s += (vv[j].x * vv[j].x + vv[j].y * vv[j].y) + (vv[j].z * vv[j].z + vv[j].w * vv[j].w); }
        const float rstd = 1.0f / sqrtf(wave_sum(s) * (1.f / DM) + NORM_EPS);
        u32x2* o8 = (u32x2*)(hb + (size_t)m * DM) + lane;
#pragma unroll
        for (int j = 0; j < 4; ++j) { vv[j] = vv[j] * rstd * gv[j]; u32x2 w; w.x = pk2(vv[j].x, vv[j].y); w.y = pk2(vv[j].z, vv[j].w); o8[64 * j] = w; }
        f32x4 gl = (f32x4){0.f, 0.f, 0.f, 0.f};
#pragma unroll
        for (int j = 0; j < 4; ++j) { LAS f32x4* wp = wl + lane + 64 * j;
            gl += wp[0] * vv[j].x; gl += wp[256] * vv[j].y; gl += wp[512] * vv[j].z; gl += wp[768] * vv[j].w; }
        gl.x = wave_sum(gl.x) + bg.x; gl.y = wave_sum(gl.y) + bg.y; gl.z = wave_sum(gl.z) + bg.z; gl.w = wave_sum(gl.w) + bg.w;
        int gi = 0; float gm = gl.x;
        if (gl.y > gm) { gm = gl.y; gi = 1; } if (gl.z > gm) { gm = gl.z; gi = 2; } if (gl.w > gm) { gm = gl.w; gi = 3; }
        const float gden = __expf(gl.x - gm) + __expf(gl.y - gm) + __expf(gl.z - gm) + __expf(gl.w - gm);
        const float gw_ = 1.0f / gden;
        gi = __builtin_amdgcn_readfirstlane(gi);
        f32x4 el = (f32x4){0.f, 0.f, 0.f, 0.f};
#pragma unroll
        for (int j = 0; j < 4; ++j) { LAS f32x4* wp = wl + (1 + gi) * 1024 + lane + 64 * j;
            el += wp[0] * vv[j].x; el += wp[256] * vv[j].y; el += wp[512] * vv[j].z; el += wp[768] * vv[j].w; }
        const f32x4 be = *(const f32x4*)(ber + gi * 4);
        float e[4] = {wave_sum(el.x) + be.x, wave_sum(el.y) + be.y, wave_sum(el.z) + be.z, wave_sum(el.w) + be.w};
        int i1 = 0; float v1 = e[0];
#pragma unroll
        for (int k = 1; k < 4; ++k) if (e[k] > v1) { v1 = e[k]; i1 = k; }
        int i2 = -1; float v2 = -INFINITY;
#pragma unroll
        for (int k = 0; k < 4; ++k) if (k != i1 && e[k] > v2) { v2 = e[k]; i2 = k; }
        const float p2 = __expf(v2 - v1), inv = 1.0f / (1.0f + p2);
        const float w1 = inv * gw_, w2 = p2 * inv * gw_;
        const int ea = i1 < i2 ? i1 : i2, eb = i1 < i2 ? i2 : i1; const float wa = i1 < i2 ? w1 : w2, wb = i1 < i2 ? w2 : w1;
        const int pi = (ea == 0) ? (eb - 1) : (ea == 1 ? eb + 1 : 5), bk = gi * 6 + pi;
        if (lane == 0) { const unsigned rank = __hip_atomic_fetch_add(cl + bk, 1u, __ATOMIC_RELAXED, __HIP_MEMORY_SCOPE_WORKGROUP);
            info[r] = (u32x2){(unsigned)bk, rank}; infw[r] = (f32x2){wa, wb}; }
    }
    __syncthreads();
    if (tid < 24) cl[32 + tid] = __hip_atomic_fetch_add(cnt + tid, cl[tid], __ATOMIC_RELAXED, __HIP_MEMORY_SCOPE_AGENT);
    __syncthreads();
    if (tid < rpw && row0 + tid < T) { const u32x2 inf = info[tid]; const f32x2 wv = infw[tid]; const size_t slot = (size_t)inf.x * T + cl[32 + inf.x] + inf.y;
        list[slot] = (unsigned)(row0 + tid); *(f32x2*)(wlist + slot * 2) = wv; }
    __syncthreads();
}
__device__ __forceinline__ void phase_final(float* x, const float* g, int gw, int NGW, int lane) {
    f32x4 gv[4];
#pragma unroll
    for (int j = 0; j < 4; ++j) gv[j] = *((const f32x4*)g + lane + 64 * j);
    for (int m = gw; m < T; m += NGW) {
        f32x4* xr = (f32x4*)(x + (size_t)m * DM) + lane;
        f32x4 v[4]; float s = 0.f;
#pragma unroll
        for (int j = 0; j < 4; ++j) { v[j] = xr[64 * j]; s += (v[j].x * v[j].x + v[j].y * v[j].y) + (v[j].z * v[j].z + v[j].w * v[j].w); }
        const float rstd = 1.0f / sqrtf(wave_sum(s) * (1.f / DM) + NORM_EPS);
#pragma unroll
        for (int j = 0; j < 4; ++j) xr[64 * j] = v[j] * rstd * gv[j];
    }
}
__device__ __forceinline__ void phase_kmean(const bf16_t* kb, float* kmean, int gw, int NGW, int lane) {
    for (int it = gw; it < BATCH * 4 * 32; it += NGW) {
        const int b = it >> 7, h = (it >> 5) & 3, blk = it & 31;
        const bf16_t* base = kb + ((size_t)b * SEQ + (size_t)blk * 256) * DM + h * HD + (lane & 7) * 8;
        float acc[8] = {0.f, 0.f, 0.f, 0.f, 0.f, 0.f, 0.f, 0.f};
#pragma unroll 4
        for (int i = 0; i < 32; ++i) { const u32x4 w = *(const u32x4*)(base + (size_t)((lane >> 3) + 8 * i) * DM);
            acc[0] += bflo(w.x); acc[1] += bfhi(w.x); acc[2] += bflo(w.y); acc[3] += bfhi(w.y); acc[4] += bflo(w.z); acc[5] += bfhi(w.z); acc[6] += bflo(w.w); acc[7] += bfhi(w.w); }
#pragma unroll
        for (int j = 0; j < 8; ++j) { acc[j] += swz_xor<8>(acc[j]); acc[j] += swz_xor<16>(acc[j]); acc[j] = sum_xor32(acc[j]); }
        if (lane < 8) {
            float* o = kmean + (size_t)it * HD + lane * 8;
#pragma unroll
            for (int j = 0; j < 8; ++j) o[j] = acc[j] * (1.f / 256.f);
        }
    }
}

__device__ __forceinline__ void ld_row64(float (&r)[64], const bf16_t* p) {
#pragma unroll
    for (int c = 0; c < 8; ++c) { const u32x4 w = *((const u32x4*)p + c);
        r[8 * c + 0] = bflo(w.x); r[8 * c + 1] = bfhi(w.x); r[8 * c + 2] = bflo(w.y); r[8 * c + 3] = bfhi(w.y); r[8 * c + 4] = bflo(w.z); r[8 * c + 5] = bfhi(w.z); r[8 * c + 6] = bflo(w.w); r[8 * c + 7] = bfhi(w.w); }
}
__device__ __forceinline__ float dot_row64(const float (&q)[64], const bf16_t* p) {
    float s0 = 0.f, s1 = 0.f;
#pragma unroll
    for (int c = 0; c < 8; ++c) { const u32x4 w = *((const u32x4*)p + c);
        s0 += q[8 * c + 0] * bflo(w.x); s1 += q[8 * c + 1] * bfhi(w.x); s0 += q[8 * c + 2] * bflo(w.y); s1 += q[8 * c + 3] * bfhi(w.y);
        s0 += q[8 * c + 4] * bflo(w.z); s1 += q[8 * c + 5] * bfhi(w.z); s0 += q[8 * c + 6] * bflo(w.w); s1 += q[8 * c + 7] * bfhi(w.w); }
    return s0 + s1;
}
__device__ __forceinline__ void axpy_row64(float (&o)[64], float p, const bf16_t* vp) {
#pragma unroll
    for (int c = 0; c < 8; ++c) { const u32x4 w = *((const u32x4*)vp + c);
        o[8 * c + 0] += p * bflo(w.x); o[8 * c + 1] += p * bfhi(w.x); o[8 * c + 2] += p * bflo(w.y); o[8 * c + 3] += p * bfhi(w.y);
        o[8 * c + 4] += p * bflo(w.z); o[8 * c + 5] += p * bfhi(w.z); o[8 * c + 6] += p * bflo(w.w); o[8 * c + 7] += p * bfhi(w.w); }
}
__device__ __forceinline__ void st_row64(bf16_t* p, const float (&o)[64], float sc) {
#pragma unroll
    for (int c = 0; c < 8; ++c) { u32x4 w; w.x = pk2(o[8 * c] * sc, o[8 * c + 1] * sc); w.y = pk2(o[8 * c + 2] * sc, o[8 * c + 3] * sc); w.z = pk2(o[8 * c + 4] * sc, o[8 * c + 5] * sc); w.w = pk2(o[8 * c + 6] * sc, o[8 * c + 7] * sc); *((u32x4*)p + c) = w; }
}
#define OSM_STEP(sc, vrow) do { const float sc_ = (sc); if (sc_ > m_) { const float al = __builtin_amdgcn_exp2f(m_ - sc_); l_ *= al; _Pragma("unroll") for (int d_ = 0; d_ < 64; ++d_) o_[d_] *= al; m_ = sc_; } \
    const float p_ = __builtin_amdgcn_exp2f(sc_ - m_); l_ += p_; axpy_row64(o_, p_, (vrow)); } while (0)

__device__ __forceinline__ void naive_moba(const bf16_t* qb, const bf16_t* kb, const bf16_t* vb, const float* kmean, bf16_t* ob, int item, int tid) {
    const int b = item >> 6, h = (item >> 4) & 3, t = (item & 15) * 512 + tid, own = t >> 8;
    const size_t rowq = ((size_t)b * SEQ + t) * DM + h * HD;
    const bf16_t* kh = kb + (size_t)b * SEQ * DM + h * HD; const bf16_t* vh = vb + (size_t)b * SEQ * DM + h * HD;
    const float slope2 = exp2f(-2.0f * (float)(h + 1)) * LOG2E;
    float q_[64]; ld_row64(q_, qb + rowq);
    float bv0 = -INFINITY, bv1 = -INFINITY, bv2 = -INFINITY; int bi0 = -1, bi1 = -1, bi2 = -1;
    const float* km = kmean + (size_t)(b * 4 + h) * 32 * HD;
    for (int n = 0; n < own; ++n) {
        float gsum = 0.f;
#pragma unroll
        for (int d = 0; d < 64; ++d) gsum += q_[d] * km[n * HD + d];
        if (gsum > bv0) { bv2 = bv1; bi2 = bi1; bv1 = bv0; bi1 = bi0; bv0 = gsum; bi0 = n; }
        else if (gsum > bv1) { bv2 = bv1; bi2 = bi1; bv1 = gsum; bi1 = n; }
        else if (gsum > bv2) { bv2 = gsum; bi2 = n; }
    }
    float o_[64];
#pragma unroll
    for (int d = 0; d < 64; ++d) o_[d] = 0.f;
    float m_ = -INFINITY, l_ = 0.f;
    for (int s = 0; s < 3; ++s) {
        const int blk = (s == 0) ? bi0 : (s == 1) ? bi1 : bi2;
        if (blk < 0) continue;
        for (int j = 0; j < 256; ++j) { const int pos = blk * 256 + j;
            const float sc = dot_row64(q_, kh + (size_t)pos * DM) - slope2 * (float)(t - pos);
            OSM_STEP(sc, vh + (size_t)pos * DM); }
    }
    for (int pos = own * 256; pos <= t; ++pos) {
        const float sc = dot_row64(q_, kh + (size_t)pos * DM) - slope2 * (float)(t - pos);
        OSM_STEP(sc, vh + (size_t)pos * DM); }
    st_row64(ob + rowq, o_, 1.0f / l_);
}
__device__ __forceinline__ void naive_sb(const bf16_t* qb, const bf16_t* kb, const bf16_t* vb, bf16_t* ob, int item, int tid) {
    const int b = item >> 6, h = 4 + ((item >> 4) & 3), t = (item & 15) * 512 + tid;
    const size_t rowq = ((size_t)b * SEQ + t) * DM + h * HD;
    const bf16_t* kh = kb + (size_t)b * SEQ * DM + h * HD; const bf16_t* vh = vb + (size_t)b * SEQ * DM + h * HD;
    float q_[64]; ld_row64(q_, qb + rowq);
    float o_[64];
#pragma unroll
    for (int d = 0; d < 64; ++d) o_[d] = 0.f;
    float tail = 0.f;
    for (int s = t - 1; s >= 0 && tail > -150.f; --s) {
        const float z = dot_row64(q_, kh + (size_t)s * DM);
        const float lp = __builtin_amdgcn_logf(1.0f + __builtin_amdgcn_exp2f(-fabsf(z)));
        const float lnot = -(fmaxf(z, 0.f) + lp);
        const float aw = __builtin_amdgcn_exp2f(z + lnot + tail);
        axpy_row64(o_, aw, vh + (size_t)s * DM);
        tail += lnot;
    }
    st_row64(ob + rowq, o_, 1.0f);
}
__device__ __forceinline__ void naive_dil(const bf16_t* qb, const bf16_t* kb, const bf16_t* vb, bf16_t* ob, bf16_t* hb2, float* lse, int item, int tid) {
    const int b = item >> 7, h = 8 + ((item >> 4) & 7), t = (item & 15) * 512 + tid;
    const size_t rowq = ((size_t)b * SEQ + t) * DM + h * HD;
    const bf16_t* kh = kb + (size_t)b * SEQ * DM + h * HD; const bf16_t* vh = vb + (size_t)b * SEQ * DM + h * HD;
    const float slope2 = exp2f(-(float)(h - 8 + 1)) * LOG2E;
    float q_[64]; ld_row64(q_, qb + rowq);
    float o_[64];
#pragma unroll
    for (int d = 0; d < 64; ++d) o_[d] = 0.f;
    float m_ = -INFINITY, l_ = 0.f;
    for (int c = 0; c < 3; ++c) {
        const int dil = (c == 0) ? 1 : (c == 1) ? 4 : 16;
        for (int dl = 0; dl <= 128; ++dl) { const int pos = t - dl * dil; if (pos < 0) break;
            const float sc = dot_row64(q_, kh + (size_t)pos * DM) - slope2 * (float)(dl * dil);
            OSM_STEP(sc, vh + (size_t)pos * DM); }
    }
    st_row64(ob + rowq, o_, 1.0f / l_);
    { const size_t tok = (size_t)b * SEQ + t; const u32x4 z4 = {0u, 0u, 0u, 0u};
#pragma unroll
      for (int c = 0; c < 8; ++c) { *((u32x4*)(hb2 + tok * DM + (h - 8) * HD) + c) = z4; *((u32x4*)(hb2 + tok * DM + 512 + (h - 8) * HD) + c) = z4; }
      lse[tok * 8 + (h - 8)] = 0.f; lse[(size_t)T * 8 + tok * 8 + (h - 8)] = -1.0e30f; lse[(size_t)2 * T * 8 + tok * 8 + (h - 8)] = -1.0e30f; }
}

namespace att {
typedef float f32x16 __attribute__((ext_vector_type(16)));
typedef short s16x4 __attribute__((ext_vector_type(4)));
typedef short v4i16_t __attribute__((ext_vector_type(4)));
typedef __bf16 bf16x2_t __attribute__((ext_vector_type(2)));
constexpr int L_BUF = 16384;
constexpr int L_WSF = 2 * L_BUF;
constexpr int L_OST = L_WSF + 8 * 256;
constexpr int L_FLG = L_OST + 8 * 4096;
constexpr int L_END = L_FLG + 64;
constexpr float M_INIT = -1.0e30f;
#define ATT_MFMA(a, b, c) __builtin_amdgcn_mfma_f32_32x32x16_bf16((a), (b), (c), 0, 0, 0)

__device__ __forceinline__ unsigned cvtpk(float lo, float hi) { f32x2 v = {lo, hi}; bf16x2_t b = __builtin_convertvector(v, bf16x2_t); return __builtin_bit_cast(unsigned, b); }
__device__ __forceinline__ s16x4 vtr(LAS unsigned char* p) { return __builtin_bit_cast(s16x4, __builtin_amdgcn_ds_read_tr16_b64_v4i16((LAS v4i16_t*)p)); }

struct Wave { int lane, r32, hi, wid; LAS unsigned char* lds; LAS float* wsf; int vlo; };
__device__ __forceinline__ Wave make_wave(LAS unsigned char* lds, int tid) {
    Wave w; w.lane = tid & 63; w.r32 = w.lane & 31; w.hi = w.lane >> 5; w.wid = __builtin_amdgcn_readfirstlane(tid >> 6); w.lds = lds;
    w.wsf = (LAS float*)(lds + L_WSF) + w.wid * 64;
    w.vlo = ((w.lane >> 4) & 1) * 32 + (w.lane & 3) * 8 + (4 * w.hi + ((w.lane & 15) >> 2)) * 64;
    return w;
}
struct Stage { u32x4 k, v; };
template <class RowK, class RowV> __device__ __forceinline__ void stage_load(Stage& s, const Wave& w, const RowK& rowk, const RowV& rowv) {
    s.k = *(const u32x4*)(rowk(w.lane) + w.wid * 8);
    s.v = *(const u32x4*)(rowv(16 * (w.wid & 3) + (w.lane >> 2)) + (w.wid >> 2) * 32 + (w.lane & 3) * 8);
}
__device__ __forceinline__ void stage_write(const Stage& s, const Wave& w, int buf) {
    *(LAS u32x4*)(w.lds + buf * L_BUF + w.wid * 1024 + w.lane * 16) = s.k;
    *(LAS u32x4*)(w.lds + buf * L_BUF + 8192 + w.wid * 1024 + w.lane * 16) = s.v;
}
__device__ __forceinline__ f32x16 qk_sub(const Wave& w, int buf, int sub, const bf16x8 (&qf)[4], float init) {
    f32x16 acc;
#pragma unroll
    for (int r = 0; r < 16; ++r) acc[r] = init;
    LAS unsigned char* kp = w.lds + buf * L_BUF + w.hi * 1024 + (32 * sub + w.r32) * 16;
#pragma unroll
    for (int ks = 0; ks < 4; ++ks) { const bf16x8 kf = *(LAS bf16x8*)(kp + ks * 2048); acc = ATT_MFMA(kf, qf[ks], acc); }
    return acc;
}
__device__ __forceinline__ void pv_sub(const Wave& w, int buf, int sub, const f32x16& p, f32x16 (&o)[2]) {
    bf16x8 pk[2];
#pragma unroll
    for (int s = 0; s < 2; ++s) { u32x4 t; t.x = cvtpk(p[8 * s], p[8 * s + 1]); t.y = cvtpk(p[8 * s + 2], p[8 * s + 3]); t.z = cvtpk(p[8 * s + 4], p[8 * s + 5]); t.w = cvtpk(p[8 * s + 6], p[8 * s + 7]); pk[s] = __builtin_bit_cast(bf16x8, t); }
    LAS unsigned char* vb = w.lds + buf * L_BUF + 8192 + w.vlo;
#pragma unroll
    for (int db = 0; db < 2; ++db)
#pragma unroll
        for (int s = 0; s < 2; ++s) { LAS unsigned char* vp = vb + db * 4096 + (4 * sub + 2 * s) * 512;
            const s16x4 lo = vtr(vp), hh = vtr(vp + 512);
            const bf16x8 vf = __builtin_shufflevector(lo, hh, 0, 1, 2, 3, 4, 5, 6, 7);
            o[db] = ATT_MFMA(pk[s], vf, o[db]); }
}
__device__ __forceinline__ void scale_rows(const Wave& w, f32x16 (&o)[2], float f) {
    if (w.hi == 0) w.wsf[w.r32] = f;
#pragma unroll
    for (int g = 0; g < 4; ++g) { const f32x4 fv = *(LAS f32x4*)(w.wsf + 8 * g + 4 * w.hi);
#pragma unroll
        for (int i = 0; i < 4; ++i) { o[0][4 * g + i] *= fv[i]; o[1][4 * g + i] *= fv[i]; } }
}
__device__ __forceinline__ void softmax_sub(const Wave& w, f32x16& s, float& m, float& lsum, f32x16 (&o)[2]) {
    float tm = fmaxf(fmaxf(s[0], s[1]), fmaxf(s[2], s[3]));
#pragma unroll
    for (int r = 4; r < 16; r += 4) tm = fmaxf(tm, fmaxf(fmaxf(s[r], s[r + 1]), fmaxf(s[r + 2], s[r + 3])));
    tm = max_xor32(tm);
    const float mn = fmaxf(m, tm);
    if (__any(mn > m)) { const float al = __builtin_amdgcn_exp2f(m - mn); lsum *= al; scale_rows(w, o, al); m = mn; }
    float acc = 0.f;
#pragma unroll
    for (int r = 0; r < 16; ++r) { s[r] = __builtin_amdgcn_exp2f(s[r] - m); acc += s[r]; }
    lsum += acc;
}
__device__ __forceinline__ void mask_band(f32x16& s, int delta0, int W) {
#pragma unroll
    for (int r = 0; r < 16; ++r) { const int dl = delta0 - ((r & 3) + 8 * (r >> 2)); if ((unsigned)dl > (unsigned)W) s[r] = -INFINITY; }
}
template <class RowO> __device__ __forceinline__ void store_o(const Wave& w, const f32x16 (&o)[2], const RowO& rowo) {
    LAS unsigned short* stg = (LAS unsigned short*)(w.lds + L_OST + w.wid * 4096);
#pragma unroll
    for (int r = 0; r < 16; ++r) { const int q = (r & 3) + 8 * (r >> 2) + 4 * w.hi;
#pragma unroll
        for (int db = 0; db < 2; ++db) stg[q * 64 + db * 32 + w.r32] = (unsigned short)f2bf(o[db][r]); }
#pragma unroll
    for (int i = 0; i < 4; ++i) { const int row = i * 8 + (w.lane >> 3), ch = w.lane & 7; const u32x4 v = *(LAS u32x4*)((LAS unsigned char*)stg + row * 128 + ch * 16);
        bf16_t* dst = rowo(row); if (dst) *(u32x4*)(dst + ch * 8) = v; }
}
__device__ __forceinline__ void load_q(bf16x8 (&qf)[4], const bf16_t* qrow, int hi) {
#pragma unroll
    for (int ks = 0; ks < 4; ++ks) qf[ks] = *(const bf16x8*)(qrow + 16 * ks + 8 * hi);
}

__device__ __forceinline__ size_t ql_off(int bh, int j) { return (size_t)bh * QL_PER_BH + (size_t)(8192 * j - 128 * j * (j + 1)); }
__device__ __forceinline__ float* lsem_ptr(float* l0, float* l1, int slot) { return (slot < 2 ? l0 : l1) + (size_t)(slot & 1) * T * 4; }
constexpr int L_GATE = 69632;

struct Top3 { int i0, i1, i2; };
__device__ __forceinline__ Top3 moba_top3(const Wave& w, const bf16x8 (&qf)[4], const float* KMEAN, int b, int h, int own) {
    int i0 = -1, i1 = -1, i2 = -1;
    if (own > 0) {
    f32x16 g;
#pragma unroll
    for (int r = 0; r < 16; ++r) g[r] = 0.f;
    const float* km = KMEAN + ((size_t)(b * 4 + h) * 32 + w.r32) * HD + 8 * w.hi;
#pragma unroll
    for (int ks = 0; ks < 4; ++ks) { const f32x4 a0 = *(const f32x4*)(km + 16 * ks), a1 = *(const f32x4*)(km + 16 * ks + 4);
        const float x[8] = {a0.x, a0.y, a0.z, a0.w, a1.x, a1.y, a1.z, a1.w}; unsigned hw[4], lw[4];
#pragma unroll
        for (int j = 0; j < 4; ++j) { const unsigned h0 = f2bf(x[2 * j]), h1 = f2bf(x[2 * j + 1]); hw[j] = h0 | (h1 << 16);
            lw[j] = pk2(x[2 * j] - __builtin_bit_cast(float, h0 << 16), x[2 * j + 1] - __builtin_bit_cast(float, h1 << 16)); }
        const u32x4 hv = {hw[0], hw[1], hw[2], hw[3]}, lv = {lw[0], lw[1], lw[2], lw[3]};
        g = ATT_MFMA(__builtin_bit_cast(bf16x8, hv), qf[ks], g); g = ATT_MFMA(__builtin_bit_cast(bf16x8, lv), qf[ks], g); }
    float v0 = -INFINITY, v1 = -INFINITY, v2 = -INFINITY;
#pragma unroll
    for (int r = 0; r < 16; ++r) { const int blk = (r & 3) + 8 * (r >> 2) + 4 * w.hi; const float val = (blk < own) ? g[r] : -INFINITY;
        if (val > v0) { v2 = v1; i2 = i1; v1 = v0; i1 = i0; v0 = val; i0 = blk; } else if (val > v1) { v2 = v1; i2 = i1; v1 = val; i1 = blk; } else if (val > v2) { v2 = val; i2 = blk; } }
    const float pv_[3] = {get_xor32(v0, w.hi), get_xor32(v1, w.hi), get_xor32(v2, w.hi)}; const int pi_[3] = {get_xor32i(i0, w.hi), get_xor32i(i1, w.hi), get_xor32i(i2, w.hi)};
#pragma unroll
    for (int k = 0; k < 3; ++k) { const float val = pv_[k]; const int blk = pi_[k];
        if (val > v0 || (val == v0 && blk < i0)) { v2 = v1; i2 = i1; v1 = v0; i1 = i0; v0 = val; i0 = blk; }
        else if (val > v1 || (val == v1 && blk < i1)) { v2 = v1; i2 = i1; v1 = val; i1 = blk; }
        else if (val > v2 || (val == v2 && blk < i2)) { v2 = val; i2 = blk; } }
    }
    Top3 t; t.i0 = i0; t.i1 = i1; t.i2 = i2; return t;
}
__device__ __forceinline__ void moba_gate_unit(LAS unsigned char* lds, const bf16_t* QB, const float* KMEAN, unsigned* mcnt, unsigned* qlist, bf16_t* PM, float* LSEM0, float* LSEM1, int b, int h, int own, int tid) {
    const Wave w = make_wave(lds, tid);
    const size_t rowbase = (size_t)b * SEQ; const int qpos = own * 256 + 32 * w.wid + w.r32, bh = b * 4 + h;
    bf16x8 qf[4]; load_q(qf, QB + (rowbase + qpos) * DM + h * HD, w.hi);
    const Top3 t3 = moba_top3(w, qf, KMEAN, b, h, own); const int s0 = t3.i0, s1 = t3.i1, s2 = t3.i2;
    LAS unsigned* cl = (LAS unsigned*)(lds + L_GATE);
    if (tid < 64) cl[tid] = 0u;
    __syncthreads();
    unsigned r0 = 0u, r1 = 0u, r2 = 0u;
    if (w.hi == 0) {
        if (s0 >= 0) r0 = __hip_atomic_fetch_add(cl + s0, 1u, __ATOMIC_RELAXED, __HIP_MEMORY_SCOPE_WORKGROUP);
        if (s1 >= 0) r1 = __hip_atomic_fetch_add(cl + s1, 1u, __ATOMIC_RELAXED, __HIP_MEMORY_SCOPE_WORKGROUP);
        if (s2 >= 0) r2 = __hip_atomic_fetch_add(cl + s2, 1u, __ATOMIC_RELAXED, __HIP_MEMORY_SCOPE_WORKGROUP);
    }
    __syncthreads();
    if (tid < 32) { const unsigned c = cl[tid]; cl[32 + tid] = c ? __hip_atomic_fetch_add(mcnt + bh * 32 + tid, c, __ATOMIC_RELAXED, __HIP_MEMORY_SCOPE_AGENT) : 0u; }
    __syncthreads();
    if (w.hi == 0) {
        const size_t tok = rowbase + qpos;
#define MOBA_EMIT(k, sk, rk) do { if (sk >= 0) qlist[ql_off(bh, sk) + cl[32 + sk] + rk] = (unsigned)qpos | ((unsigned)(k) << 13); \
            else { lsem_ptr(LSEM0, LSEM1, k)[tok * 4 + h] = -1.0e30f;          \
                u32x4* pz = (u32x4*)(PM + ((size_t)(k) * T + tok) * 256 + h * HD); const u32x4 z4 = {0u, 0u, 0u, 0u}; \
                _Pragma("unroll") for (int c = 0; c < 8; ++c) pz[c] = z4; } } while (0)
        MOBA_EMIT(0, s0, r0); MOBA_EMIT(1, s1, r1); MOBA_EMIT(2, s2, r2);
#undef MOBA_EMIT
    }
    __syncthreads();
}
__device__ __forceinline__ void moba_own_unit(LAS unsigned char* lds, const bf16_t* QB, const bf16_t* KB, const bf16_t* VB, bf16_t* OB, float* LSEM0, float* LSEM1, int b, int h, int own, int tid) {
    const Wave w = make_wave(lds, tid);
    const size_t rowbase = (size_t)b * SEQ; const int q0 = own * 256, qpos = q0 + 32 * w.wid + w.r32;
    const bf16_t* kh = KB + rowbase * DM + h * HD; const bf16_t* vh = VB + rowbase * DM + h * HD;
    const float slope2 = exp2f(-2.0f * (float)(h + 1)) * LOG2E;
    bf16x8 qf[4]; load_q(qf, QB + (rowbase + qpos) * DM + h * HD, w.hi);
    float tr_[16];
#pragma unroll
    for (int r = 0; r < 16; ++r) tr_[r] = slope2 * (float)((r & 3) + 8 * (r >> 2));
    f32x16 o[2];
#pragma unroll
    for (int r = 0; r < 16; ++r) { o[0][r] = 0.f; o[1][r] = 0.f; }
    float m = M_INIT, lsum = 0.f;
    Stage sg;
    { const int kp = q0 + 3 * 64; stage_load(sg, w, [&](int key) { return kh + (size_t)(kp + key) * DM; }, [&](int key) { return vh + (size_t)(kp + key) * DM; }); }
    stage_write(sg, w, 0);
    __syncthreads();
    for (int st = 0; st < 4; ++st) {
        const int buf = st & 1, kpos0 = q0 + (3 - st) * 64;
        if (st + 1 < 4) { const int kp = kpos0 - 64; stage_load(sg, w, [&](int key) { return kh + (size_t)(kp + key) * DM; }, [&](int key) { return vh + (size_t)(kp + key) * DM; }); }
#pragma unroll
        for (int sub = 1; sub >= 0; --sub) {
            const int D = w.wid - (2 * (3 - st) + sub);
            if (D < 0) continue;
            const int delta0 = qpos - (kpos0 + 32 * sub) - 4 * w.hi;
            f32x16 s = qk_sub(w, buf, sub, qf, -slope2 * (float)delta0);
#pragma unroll
            for (int r = 0; r < 16; ++r) s[r] += tr_[r];
            if (D == 0) mask_band(s, delta0, 0x7fffffff);
            softmax_sub(w, s, m, lsum, o);
            pv_sub(w, buf, sub, s, o);
        }
        if (st + 1 < 4) stage_write(sg, w, buf ^ 1);
        __syncthreads();
    }
    const float l = sum_xor32(lsum);
    scale_rows(w, o, 1.0f / l);
    bf16_t* orow = OB + (rowbase + q0 + 32 * w.wid) * DM + h * HD;
    store_o(w, o, [&](int r) { return orow + (size_t)r * DM; });
    if (w.hi == 0) lsem_ptr(LSEM0, LSEM1, 3)[(rowbase + qpos) * 4 + h] = m + __builtin_amdgcn_logf(l);
}
__device__ __forceinline__ void moba_gather_unit(LAS unsigned char* lds, const bf16_t* QB, const bf16_t* KB, const bf16_t* VB, const unsigned* ql, int cnt, int chunk, bf16_t* PM, float* LSEM0, float* LSEM1, int b, int h, int j, int tid) {
    const Wave w = make_wave(lds, tid);
    const size_t rowbase = (size_t)b * SEQ;
    const int idx = chunk * 256 + 32 * w.wid + w.r32; const bool valid = idx < cnt;
    const unsigned e = ql[valid ? idx : chunk * 256];
    const int qpos = (int)(e & 8191u), slot = (int)(e >> 13);
    const bf16_t* kh = KB + rowbase * DM + h * HD; const bf16_t* vh = VB + rowbase * DM + h * HD;
    const float slope2 = exp2f(-2.0f * (float)(h + 1)) * LOG2E;
    bf16x8 qf[4]; load_q(qf, QB + (rowbase + qpos) * DM + h * HD, w.hi);
    float tr_[16];
#pragma unroll
    for (int r = 0; r < 16; ++r) tr_[r] = slope2 * (float)((r & 3) + 8 * (r >> 2));
    f32x16 o[2];
#pragma unroll
    for (int r = 0; r < 16; ++r) { o[0][r] = 0.f; o[1][r] = 0.f; }
    float m = M_INIT, lsum = 0.f;
    const int k0 = j * 256;
    Stage sg;
    stage_load(sg, w, [&](int key) { return kh + (size_t)(k0 + key) * DM; }, [&](int key) { return vh + (size_t)(k0 + key) * DM; });
    stage_write(sg, w, 0);
    __syncthreads();
    for (int st = 0; st < 4; ++st) {
        const int buf = st & 1, kpos0 = k0 + st * 64;
        if (st + 1 < 4) { const int kp = kpos0 + 64; stage_load(sg, w, [&](int key) { return kh + (size_t)(kp + key) * DM; }, [&](int key) { return vh + (size_t)(kp + key) * DM; }); }
#pragma unroll
        for (int sub = 0; sub < 2; ++sub) {
            const int delta0 = qpos - (kpos0 + 32 * sub) - 4 * w.hi;
            f32x16 s = qk_sub(w, buf, sub, qf, -slope2 * (float)delta0);
#pragma unroll
            for (int r = 0; r < 16; ++r) s[r] += tr_[r];
            softmax_sub(w, s, m, lsum, o);
            pv_sub(w, buf, sub, s, o);
        }
        if (st + 1 < 4) stage_write(sg, w, buf ^ 1);
        __syncthreads();
    }
    const float l = sum_xor32(lsum);
    scale_rows(w, o, 1.0f / l);
    LAS int* code = (LAS int*)(w.wsf + 32);
    if (w.hi == 0) code[w.r32] = valid ? (int)((size_t)slot * T + rowbase + qpos) : -1;
    store_o(w, o, [&](int r) { const int c = code[r]; return c >= 0 ? PM + (size_t)c * 256 + h * HD : (bf16_t*)nullptr; });
    if (w.hi == 0 && valid) lsem_ptr(LSEM0, LSEM1, slot)[(rowbase + qpos) * 4 + h] = m + __builtin_amdgcn_logf(l);
}

__device__ __forceinline__ void sb_unit(LAS unsigned char* lds, const bf16_t* QB, const bf16_t* KB, const bf16_t* VB, bf16_t* OB, int b, int h, int qt, int tid) {
    const Wave w = make_wave(lds, tid);
    const size_t rowbase = (size_t)b * SEQ; const int q0 = qt * 256, qpos = q0 + 32 * w.wid + w.r32;
    const bf16_t* kh = KB + rowbase * DM + h * HD; const bf16_t* vh = VB + rowbase * DM + h * HD;
    bf16x8 qf[4]; load_q(qf, QB + (rowbase + qpos) * DM + h * HD, w.hi);
    f32x16 o[2];
#pragma unroll
    for (int r = 0; r < 16; ++r) { o[0][r] = 0.f; o[1][r] = 0.f; }
    float carry = 0.f;
    bool done = false;
    volatile LAS unsigned* flg = (volatile LAS unsigned*)(lds + L_FLG);
    const int ti0 = q0 / 64 + 3;
    Stage sg;
    { const int kp = ti0 * 64; stage_load(sg, w, [&](int key) { return kh + (size_t)(kp + key) * DM; }, [&](int key) { return vh + (size_t)(kp + key) * DM; }); }
    stage_write(sg, w, 0);
    __syncthreads();
    for (int st = 0;; ++st) {
        const int buf = st & 1, ti = ti0 - st;
        if (ti > 0) { const int kp = (ti - 1) * 64; stage_load(sg, w, [&](int key) { return kh + (size_t)(kp + key) * DM; }, [&](int key) { return vh + (size_t)(kp + key) * DM; }); }
        if (!done) {
#pragma unroll
            for (int sub = 1; sub >= 0; --sub) {
                const int D = (q0 / 32 + w.wid) - (2 * ti + sub);
                if (D < 0) continue;
                const int delta0 = qpos - (64 * ti + 32 * sub) - 4 * w.hi;
                f32x16 z = qk_sub(w, buf, sub, qf, 0.f);
                f32x16 L;
#pragma unroll
                for (int r = 0; r < 16; ++r) { const float lp = __builtin_amdgcn_logf(1.0f + __builtin_amdgcn_exp2f(-fabsf(z[r]))); L[r] = -(fmaxf(z[r], 0.f) + lp); }
                if (D == 0) {
#pragma unroll
                    for (int r = 0; r < 16; ++r) { const int dl = delta0 - ((r & 3) + 8 * (r >> 2)); if (dl < 1) { L[r] = 0.f; z[r] = -INFINITY; } }
                }
                float G[4], PG[4];
#pragma unroll
                for (int g = 0; g < 4; ++g) { G[g] = (L[4 * g] + L[4 * g + 1]) + (L[4 * g + 2] + L[4 * g + 3]); PG[g] = get_xor32(G[g], w.hi); }
                float run = carry;
#pragma unroll
                for (int g = 3; g >= 0; --g) { const float t3 = run + (w.hi == 0 ? PG[g] : 0.f), t2 = t3 + L[4 * g + 3], t1 = t2 + L[4 * g + 2], t0 = t1 + L[4 * g + 1];
                    z[4 * g + 3] = __builtin_amdgcn_exp2f(z[4 * g + 3] + L[4 * g + 3] + t3); z[4 * g + 2] = __builtin_amdgcn_exp2f(z[4 * g + 2] + L[4 * g + 2] + t2);
                    z[4 * g + 1] = __builtin_amdgcn_exp2f(z[4 * g + 1] + L[4 * g + 1] + t1); z[4 * g] = __builtin_amdgcn_exp2f(z[4 * g] + L[4 * g] + t0);
                    run += G[g] + PG[g]; }
                carry = run;
                pv_sub(w, buf, sub, z, o);
            }
            done = __all(carry < -150.f);
        }
        if (w.lane == 0) flg[buf * 8 + w.wid] = done ? 1u : 0u;
        if (ti > 0) stage_write(sg, w, buf ^ 1);
        __syncthreads();
        unsigned all = 1u;
#pragma unroll
        for (int k = 0; k < 8; ++k) all &= flg[buf * 8 + k];
        if (all || ti == 0) break;
    }
    bf16_t* orow = OB + (rowbase + q0 + 32 * w.wid) * DM + h * HD;
    store_o(w, o, [&](int r) { return orow + (size_t)r * DM; });
    __syncthreads();
}

__device__ __forceinline__ void dil_unit(LAS unsigned char* lds, const bf16_t* QB, const bf16_t* KB, const bf16_t* VB, bf16_t* PO, float* LSE, int b, int h, int dil, int res, int i2, int tid) {
    const Wave w = make_wave(lds, tid);
    const size_t rowbase = (size_t)b * SEQ; const int Q0 = 256 * i2, qj = Q0 + 32 * w.wid + w.r32;
    const bf16_t* kh = KB + (rowbase + res) * DM + h * HD; const bf16_t* vh = VB + (rowbase + res) * DM + h * HD;
    const size_t rstride = (size_t)dil * DM;
    const float slope2d = exp2f(-(float)(h - 8 + 1)) * LOG2E * (float)dil;
    bf16x8 qf[4]; load_q(qf, QB + (rowbase + res + (size_t)qj * dil) * DM + h * HD, w.hi);
    float tr_[16];
#pragma unroll
    for (int r = 0; r < 16; ++r) tr_[r] = slope2d * (float)((r & 3) + 8 * (r >> 2));
    f32x16 o[2];
#pragma unroll
    for (int r = 0; r < 16; ++r) { o[0][r] = 0.f; o[1][r] = 0.f; }
    float m = M_INIT, lsum = 0.f;
    const int ti0 = 4 * i2 + 3, nsteps = (ti0 + 1 < 6) ? ti0 + 1 : 6;
    Stage sg;
    { const int kp = ti0 * 64; stage_load(sg, w, [&](int key) { return kh + (size_t)(kp + key) * rstride; }, [&](int key) { return vh + (size_t)(kp + key) * rstride; }); }
    stage_write(sg, w, 0);
    __syncthreads();
    for (int st = 0; st < nsteps; ++st) {
        const int buf = st & 1, ti = ti0 - st;
        if (st + 1 < nsteps) { const int kp = (ti - 1) * 64; stage_load(sg, w, [&](int key) { return kh + (size_t)(kp + key) * rstride; }, [&](int key) { return vh + (size_t)(kp + key) * rstride; }); }
#pragma unroll
        for (int sub = 1; sub >= 0; --sub) {
            const int D = (8 * i2 + w.wid) - (2 * ti + sub);
            if (D < 0 || D > 4) continue;
            const int delta0 = qj - (64 * ti + 32 * sub) - 4 * w.hi;
            f32x16 s = qk_sub(w, buf, sub, qf, -slope2d * (float)delta0);
#pragma unroll
            for (int r = 0; r < 16; ++r) s[r] += tr_[r];
            if (D == 0 || D == 4) mask_band(s, delta0, 128);
            softmax_sub(w, s, m, lsum, o);
            pv_sub(w, buf, sub, s, o);
        }
        if (st + 1 < nsteps) stage_write(sg, w, buf ^ 1);
        __syncthreads();
    }
    const float l = sum_xor32(lsum);
    scale_rows(w, o, 1.0f / l);
    const size_t tok0 = rowbase + res + (size_t)(Q0 + 32 * w.wid) * dil;
    store_o(w, o, [&](int r) { return PO + (tok0 + (size_t)r * dil) * DM + (h - 8) * HD; });
    if (w.hi == 0) LSE[(tok0 + (size_t)w.r32 * dil) * 8 + (h - 8)] = m + __builtin_amdgcn_logf(l);
}

__device__ __forceinline__ void moba_gate_phase(LAS unsigned char* lds, const bf16_t* QB, const float* KMEAN, unsigned* mcnt, unsigned* qlist, bf16_t* PM, float* LSEM0, float* LSEM1, int v, int G, int tid) {
    for (int u = v; u < 512; u += G) { const int own = u & 31, bh = u >> 5; moba_gate_unit(lds, QB, KMEAN, mcnt, qlist, PM, LSEM0, LSEM1, bh >> 2, bh & 3, own, tid); }
}
struct AttnArgs { const bf16_t* QB; const bf16_t* KB; const bf16_t* VB; bf16_t* OB; bf16_t* HB2; float* LSE; const unsigned* mcnt; const unsigned* qlist; bf16_t* PM; float* LSEM0; float* LSEM1; };
__device__ __forceinline__ void attn_phase(LAS unsigned char* lds, const AttnArgs& A, int v, int G, int tid) {
    LAS int* cntl = (LAS int*)(lds + L_GATE); LAS int* pa = cntl + 512; LAS int* pb = pa + 512;
    const int myc = (int)A.mcnt[tid], myu = (myc + 255) >> 8;
    cntl[tid] = myc; pa[tid] = myu;
    __syncthreads();
#pragma unroll 1
    for (int d = 1; d < 512; d <<= 1) { const int x = pa[tid] + (tid >= d ? pa[tid - d] : 0); pb[tid] = x; __syncthreads(); LAS int* t_ = pa; pa = pb; pb = t_; }
    const int total = pa[511];
    for (int u = v; u < total; u += G) {
        int lo = 0, hi = 511;
        while (lo < hi) { const int mid = (lo + hi) >> 1; if (pa[mid] > u) hi = mid; else lo = mid + 1; }
        const int i = lo, c = cntl[i], chunk = u - (pa[i] - ((c + 255) >> 8)), bh = i >> 5, j = i & 31;
        moba_gather_unit(lds, A.QB, A.KB, A.VB, A.qlist + ql_off(bh, j), c, chunk, A.PM, A.LSEM0, A.LSEM1, bh >> 2, bh & 3, j, tid);
    }
    for (int u = v; u < 512; u += G) { const int own = u & 31, bh = u >> 5; moba_own_unit(lds, A.QB, A.KB, A.VB, A.OB, A.LSEM0, A.LSEM1, bh >> 2, bh & 3, own, tid); }
    for (int u = v; u < 3072; u += G) { const int n = u & 31, bhc = u >> 5, c = bhc % 3, bh = bhc / 3, b = bh >> 3, h = 8 + (bh & 7);
        const int dil = (c == 0) ? 1 : (c == 1) ? 4 : 16, res = (c == 0) ? 0 : (c == 1) ? (n >> 3) : (n >> 1), i2 = (c == 0) ? n : (c == 1) ? (n & 7) : (n & 1);
        bf16_t* PO = (c == 0) ? A.OB + 512 : A.HB2 + (c - 1) * 512;
        dil_unit(lds, A.QB, A.KB, A.VB, PO, A.LSE + (size_t)c * T * 8, b, h, dil, res, i2, tid); }
    for (int u = v; u < 512; u += G) { const int qt = u & 31, bh = u >> 5; sb_unit(lds, A.QB, A.KB, A.VB, A.OB, bh >> 2, 4 + (bh & 3), qt, tid); }
}
}

constexpr int PH_PRO = 0, PH_L0 = 1, PH_PER_LAYER = 10, PH_FINAL = PH_L0 + DEPTH * PH_PER_LAYER, PH_COUNT = PH_FINAL + 1;
typedef const __attribute__((address_space(4))) Args* KArgP;
#define KARG() ({ KArgP p_ = (KArgP)__builtin_amdgcn_kernarg_segment_ptr(); asm volatile("" : "+s"(p_)); p_; })
#define PHASE_IDS int lane_p = (int)__builtin_amdgcn_mbcnt_hi(~0u, __builtin_amdgcn_mbcnt_lo(~0u, 0u)); LAUNDER_V(lane_p); int tid_p = wave * 64 + lane_p; int gw_p = gw; LAUNDER_S(gw_p)
__global__ void __launch_bounds__(NTHREADS, 2) fwd(Args a_unused) {
    extern __shared__ __attribute__((aligned(16))) unsigned char lds_raw[];
    LAS unsigned char* lds = (LAS unsigned char*)lds_raw;
    volatile LAS unsigned* MISC = (volatile LAS unsigned*)(lds + MISC_OFF);
    const int wave = __builtin_amdgcn_readfirstlane((int)threadIdx.x >> 6);
    const int G = gridDim.x, bx = blockIdx.x;
    const int vcu = (G % 8 == 0) ? (bx % 8) * (G / 8) + bx / 8 : bx;
    const int gw = vcu * NWAVES + wave, NGW = G * NWAVES;
    for (int u = threadIdx.x; u < (LDS_BYTES - LDSCTL_OFF) / 4; u += NTHREADS) ((LAS unsigned*)(lds + LDSCTL_OFF))[u] = 0u;
    __syncthreads();
    int lo, hi; XcdBarrier bar;
    { KArgP ka = KARG(); lo = ka->ph_lo; hi = ka->ph_hi; unsigned* ctl = (unsigned*)(ka->ws + WS_CTL); bar = xcd_barrier_post(ctl + CW_BAR + ka->li * XCD_BAR_WORDS, MISC + 8); }
#define IN(k) (lo <= (k) && (k) < hi)
#define SEAM(k) do { if (IN(k) && IN((k) + 1)) xcd_barrier(bar); } while (0)
#define WSP(T_, off) ((T_*)(ws + (off)))

    if (IN(PH_PRO)) { KArgP ka = KARG(); PHASE_IDS; Args a; a.ws = ka->ws; a.w_in = ka->w_in; a.w_out = ka->w_out; a.w_gate = ka->w_gate; a.w_up = ka->w_up; a.w_down = ka->w_down; phase_prologue(a, lds, gw_p, NGW, wave, lane_p); } SEAM(PH_PRO);

    for (int l = 0; l < DEPTH; ++l) {
        const int p0 = PH_L0 + l * PH_PER_LAYER;
        if (hi <= p0 || lo >= p0 + PH_PER_LAYER) continue;
        if (IN(p0 + 0)) for (int rep_ = 0; rep_ < RPT(0); ++rep_) { if (rep_) xcd_barrier(bar); KArgP ka = KARG(); PHASE_IDS; unsigned char* ws = ka->ws; const float* xin = (l == 0) ? ka->x : ka->out;
            phase_norm1(xin, ka->ln1_g + (size_t)l * DM, WSP(bf16_t, WS_HB), gw_p, NGW, lane_p); } SEAM(p0 + 0);
        if (IN(p0 + 1)) for (int rep_ = 0; rep_ < RPT(1); ++rep_) { if (rep_) xcd_barrier(bar); KArgP ka = KARG(); PHASE_IDS; unsigned char* ws = ka->ws;
            pg8::Gemm g{(const char*)(ws + WS_HB), (const char*)(ws + WS_WIN) + (size_t)l * NQKV * DM * 2, DM, DM, DM, (long)256 * DM * 2, (long)256 * DM * 2, (long)128 * DM * 2};
            pg8::StaticOrder S; S.init(T / 256, NQKV / 256, G, bx);
            pg8::EpiQKV E{WSP(bf16_t, WS_Q), (size_t)(WS_K - WS_Q) / 2, QSCALE};
            pg8::gemm_phase<pg8::EpiQKV, pg8::StaticOrder>(lds, g, S, E, wave);
        } SEAM(p0 + 1);
        if (IN(p0 + 2)) { KArgP ka = KARG(); PHASE_IDS; unsigned char* ws = ka->ws; phase_kmean(WSP(bf16_t, WS_K), WSP(float, WS_KMEAN), gw_p, NGW, lane_p); } SEAM(p0 + 2);
        if (IN(p0 + 3)) { KArgP ka = KARG(); PHASE_IDS; unsigned char* ws = ka->ws;
            att::moba_gate_phase(lds, WSP(bf16_t, WS_Q), WSP(float, WS_KMEAN), WSP(unsigned, WS_CTL) + CW_MCNT + l * 512, WSP(unsigned, WS_QLIST), WSP(bf16_t, WS_PM), WSP(float, WS_LSEM0), WSP(float, WS_LSEM1), vcu, G, tid_p);
        } SEAM(p0 + 3);
        if (IN(p0 + 4)) for (int rep_ = 0; rep_ < RPT(4); ++rep_) { if (rep_) xcd_barrier(bar); KArgP ka = KARG(); PHASE_IDS; unsigned char* ws = ka->ws;
            const att::AttnArgs A{WSP(bf16_t, WS_Q), WSP(bf16_t, WS_K), WSP(bf16_t, WS_V), WSP(bf16_t, WS_O), WSP(bf16_t, WS_HB), WSP(float, WS_LSE), WSP(unsigned, WS_CTL) + CW_MCNT + l * 512, WSP(unsigned, WS_QLIST),
                                  WSP(bf16_t, WS_PM), WSP(float, WS_LSEM0), WSP(float, WS_LSEM1)};
            att::attn_phase(lds, A, vcu, G, tid_p);
        } SEAM(p0 + 4);
        if (IN(p0 + 5)) { KArgP ka = KARG(); PHASE_IDS; unsigned char* ws = ka->ws;
            phase_mixnorm(WSP(bf16_t, WS_O), WSP(bf16_t, WS_HB), WSP(float, WS_LSE), WSP(bf16_t, WS_PM), WSP(float, WS_LSEM0), WSP(float, WS_LSEM1), ka->mix_g + (size_t)l * DM, gw_p, NGW, lane_p); } SEAM(p0 + 5);
        if (IN(p0 + 6)) { KArgP ka = KARG(); PHASE_IDS; unsigned char* ws = ka->ws; const float* xin = (l == 0) ? ka->x : ka->out;
            pg8::Gemm g{(const char*)(ws + WS_HB), (const char*)(ws + WS_WOUT) + (size_t)l * DM * DM * 2, DM, DM, DM, (long)256 * DM * 2, (long)256 * DM * 2, (long)128 * DM * 2};
            pg8::StaticOrder S; S.init(T / 256, DM / 256, G, bx);
            pg8::EpiResAdd E{xin, ka->out};
            pg8::gemm_phase<pg8::EpiResAdd, pg8::StaticOrder>(lds, g, S, E, wave);
        } SEAM(p0 + 6);
        if (IN(p0 + 7)) { KArgP ka = KARG(); PHASE_IDS; unsigned char* ws = ka->ws;
            phase_route(ka->out, ka->ln2_g + (size_t)l * DM, ka->w_gr + (size_t)l * DM * 4, ka->b_gr + l * 4, ka->w_er + (size_t)l * 4 * DM * 4, ka->b_er + l * 16, WSP(bf16_t, WS_HB),
                        WSP(unsigned, WS_CTL) + CW_CNT + l * 32, WSP(unsigned, WS_LIST), WSP(float, WS_WLIST), lds, vcu, G, wave, lane_p); } SEAM(p0 + 7);
        if (IN(p0 + 8)) for (int rep_ = 0; rep_ < RPT(8); ++rep_) { if (rep_) xcd_barrier(bar); KArgP ka = KARG(); PHASE_IDS; unsigned char* ws = ka->ws;
            pg8::MoeProb<0> P{WSP(unsigned, WS_CTL) + CW_CNT + l * 32, WSP(unsigned, WS_LIST), (const char*)(ws + WS_HB), (const char*)(ws + WS_WG) + (size_t)l * NACT * DM * 2, DM, DM, DM, (long)(WS_WU - WS_WG), G, vcu};
            pg8::EpiGateUpSparse E{WSP(bf16_t, WS_ACT), WSP(float, WS_WLIST)};
            pg8::gemm_phase_x<pg8::EpiGateUpSparse, pg8::MoeProb<0>>(lds, P, E, wave);
        } SEAM(p0 + 8);
        if (IN(p0 + 9)) { KArgP ka = KARG(); PHASE_IDS; unsigned char* ws = ka->ws;
            pg8::MoeProb<1> P{WSP(unsigned, WS_CTL) + CW_CNT + l * 32, WSP(unsigned, WS_LIST), (const char*)(ws + WS_ACT), (const char*)(ws + WS_WD) + (size_t)l * DM * NACT * 2, 512, NACT, 512, (long)128 * NACT * 2, G, vcu};
            pg8::EpiDownScatter E{ka->out, WSP(unsigned, WS_LIST)};
            pg8::gemm_phase_x<pg8::EpiDownScatter, pg8::MoeProb<1>>(lds, P, E, wave);
        } SEAM(p0 + 9);
    }
    if (IN(PH_FINAL)) { KArgP ka = KARG(); PHASE_IDS; phase_final(ka->out, ka->fin_g, gw_p, NGW, lane_p); }
#undef IN
#undef SEAM
#undef WSP
}

#ifndef N_LAUNCH_MODE
#define N_LAUNCH_MODE 1
#endif
extern "C" void kernel_launch(void* const* d_in, const int* in_sizes, int n_in, void* d_out, int out_size, void* d_ws, size_t ws_size, hipStream_t stream) {
    static int grid = 0;
    if (grid == 0) {
        if (n_in != 14 || in_sizes[0] != T * DM || out_size != T * DM || ws_size < WS_END) { fprintf(stderr, "kernel_launch: unexpected shapes (n_in %d in0 %d out %d ws %zu)\n", n_in, n_in > 0 ? in_sizes[0] : -1, out_size, ws_size); grid = -1; return; }
        int dev = 0, cus = 0, per_cu = 0;
        if (hipGetDevice(&dev) != hipSuccess || hipDeviceGetAttribute(&cus, hipDeviceAttributeMultiprocessorCount, dev) != hipSuccess) { grid = -1; return; }
        if (hipFuncSetAttribute((const void*)fwd, hipFuncAttributeMaxDynamicSharedMemorySize, LDS_BYTES) != hipSuccess) { fprintf(stderr, "kernel_launch: hipFuncSetAttribute failed\n"); grid = -1; return; }
        if (hipOccupancyMaxActiveBlocksPerMultiprocessor(&per_cu, (const void*)fwd, NTHREADS, LDS_BYTES) != hipSuccess || per_cu < 1) fprintf(stderr, "kernel_launch: occupancy query says %d\n", per_cu);
        (void)hipGetLastError();
        grid = cus;
    }
    if (grid < 0) return;
    if (hipMemsetAsync((char*)d_ws + WS_CTL, 0, CTL_ZERO_BYTES, stream) != hipSuccess) return;
    Args a{};
    a.x = (const float*)d_in[0]; a.ln1_g = (const float*)d_in[1]; a.w_in = (const float*)d_in[2]; a.mix_g = (const float*)d_in[3]; a.w_out = (const float*)d_in[4]; a.ln2_g = (const float*)d_in[5];
    a.w_gr = (const float*)d_in[6]; a.b_gr = (const float*)d_in[7]; a.w_er = (const float*)d_in[8]; a.b_er = (const float*)d_in[9]; a.w_gate = (const float*)d_in[10]; a.w_up = (const float*)d_in[11];
    a.w_down = (const float*)d_in[12]; a.fin_g = (const float*)d_in[13];
    a.out = (float*)d_out; a.ws = (unsigned char*)d_ws; a.pad = 0;
#if N_LAUNCH_MODE == 1
    a.ph_lo = 0; a.ph_hi = PH_COUNT; a.li = 0;
    hipLaunchKernelGGL(fwd, dim3(grid), dim3(NTHREADS), LDS_BYTES, stream, a);
#else
    for (int p = 0; p < PH_COUNT; ++p) { a.ph_lo = p; a.ph_hi = p + 1; a.li = p; hipLaunchKernelGGL(fwd, dim3(grid), dim3(NTHREADS), LDS_BYTES, stream, a); }
#endif
}
```

```cpp
#include <hip/hip_runtime.h>
#include <cstdio>
#include <cstdint>

#define LAS __attribute__((address_space(3)))
#define GAS __attribute__((address_space(1)))
typedef unsigned short bf16_t;
typedef short bf16x8 __attribute__((ext_vector_type(8)));
typedef float f32x4 __attribute__((ext_vector_type(4)));
typedef float f32x2 __attribute__((ext_vector_type(2)));
typedef unsigned u32x4 __attribute__((ext_vector_type(4)));
typedef unsigned u32x2 __attribute__((ext_vector_type(2)));

#ifndef PROBE_REPEAT
#define PROBE_REPEAT 0
#endif
#define RPT(k) ((((PROBE_REPEAT) >> (k)) & 1) ? 2 : 1)
#ifndef MOE_SPARSE
#define MOE_SPARSE 1
#endif
#ifndef ATT_MOBA
#define ATT_MOBA 1
#endif
#ifndef ATT_SB
#define ATT_SB 1
#endif
#ifndef ATT_DIL
#define ATT_DIL 1
#endif
constexpr int BATCH = 4, SEQ = 8192, DM = 1024, DEPTH = 4, T = BATCH * SEQ, NH = 16, HD = 64;
constexpr int NQKV = 3 * DM, NEXP = 16, DEXP = 256, NACT = NEXP * DEXP;
constexpr float NORM_EPS = 1e-6f;
constexpr float LOG2E = 1.4426950408889634f;
constexpr float QSCALE = 0.125f * LOG2E;
constexpr int NWAVES = 8, NTHREADS = 512;

constexpr size_t MiB = 1u << 20;
constexpr size_t WS_CTL = 0, CTL_ZERO_BYTES = 1 * MiB;
constexpr size_t WS_WIN = 2 * MiB;
constexpr size_t WS_WOUT = 26 * MiB;
constexpr size_t WS_WG = 34 * MiB;
constexpr size_t WS_WU = 66 * MiB;
constexpr size_t WS_WD = 98 * MiB;
constexpr size_t WS_LSEM0 = 1 * MiB;
constexpr size_t WS_KMEAN = 130 * MiB;
constexpr size_t WS_HB = 131 * MiB;
constexpr size_t WS_Q = 195 * MiB, WS_K = 259 * MiB, WS_V = 323 * MiB, WS_O = 387 * MiB;
constexpr size_t WS_ACT = WS_Q;
constexpr size_t WS_LSE = 451 * MiB;
constexpr size_t WS_LIST = 454 * MiB;
constexpr size_t WS_WLIST = 457 * MiB;
constexpr size_t WS_QLIST = WS_LIST;
constexpr size_t WS_PM = 463 * MiB;
constexpr size_t WS_LSEM1 = 511 * MiB;
constexpr size_t WS_END = 512 * MiB;
constexpr int QL_PER_BH = 126976;
constexpr int CW_MCNT = 2048;
constexpr int CW_CNT = 1024;
constexpr int CW_BAR = 4096;

constexpr int RING_BYTES = 131072;
constexpr int LDSCTL_OFF = 147456, MISC_OFF = LDSCTL_OFF + 320;
constexpr int LDS_BYTES = 148480;

__device__ __forceinline__ unsigned f2bf(float f) { unsigned u = __builtin_bit_cast(unsigned, f); return (u + 0x7fffu + ((u >> 16) & 1u)) >> 16; }
__device__ __forceinline__ unsigned pk2(float lo, float hi) { return f2bf(lo) | (f2bf(hi) << 16); }
__device__ __forceinline__ float bflo(unsigned w) { return __builtin_bit_cast(float, w << 16); }
__device__ __forceinline__ float bfhi(unsigned w) { return __builtin_bit_cast(float, w & 0xffff0000u); }
template <int M> __device__ __forceinline__ float swz_xor(float v) { return __builtin_bit_cast(float, __builtin_amdgcn_ds_swizzle(__builtin_bit_cast(int, v), 0x1f | (M << 10))); }
__device__ __forceinline__ void swap32(unsigned x, unsigned& lo_val, unsigned& hi_val) { unsigned y = x; asm volatile("" : "+v"(y)); auto rr = __builtin_amdgcn_permlane32_swap(x, y, false, false); lo_val = rr[0]; hi_val = rr[1]; }
__device__ __forceinline__ float sum_xor32(float v) { unsigned a, b; swap32(__builtin_bit_cast(unsigned, v), a, b); return __builtin_bit_cast(float, a) + __builtin_bit_cast(float, b); }
__device__ __forceinline__ float max_xor32(float v) { unsigned a, b; swap32(__builtin_bit_cast(unsigned, v), a, b); return fmaxf(__builtin_bit_cast(float, a), __builtin_bit_cast(float, b)); }
__device__ __forceinline__ float get_xor32(float v, int hi) { unsigned a, b; swap32(__builtin_bit_cast(unsigned, v), a, b); return __builtin_bit_cast(float, hi ? a : b); }
__device__ __forceinline__ int get_xor32i(int v, int hi) { unsigned a, b; swap32((unsigned)v, a, b); return (int)(hi ? a : b); }
template <int CTRL> __device__ __forceinline__ float dpp_mov(float v) { return __builtin_bit_cast(float, __builtin_amdgcn_update_dpp(0, __builtin_bit_cast(int, v), CTRL, 0xf, 0xf, false)); }
__device__ __forceinline__ float row_sum(float v) { v += dpp_mov<0xB1>(v); v += dpp_mov<0x4E>(v); v += dpp_mov<0x141>(v); v += dpp_mov<0x140>(v); return v; }
__device__ __forceinline__ float half_sum(float v) { v = row_sum(v); v += swz_xor<16>(v); return v; }
__device__ __forceinline__ float wave_sum(float v) { return sum_xor32(half_sum(v)); }
#define LDS_WAIT() asm volatile("s_waitcnt lgkmcnt(0)" ::: "memory")
#define LAUNDER_V(x) asm volatile("" : "+v"(x))
#define LAUNDER_S(x) asm volatile("" : "+s"(x))

namespace pg8 {
constexpr int BM = 256, BK = 64, HALF = 128, HTB = HALF * BK * 2, STAGE_BYTES = 8 * HTB, NXCD = 8, WGM = 8;
__host__ __device__ __forceinline__ int lds_byte(int r, int c) { const int st = (r >> 4) * 2 + (c >> 5), rr = r & 15, cc = c & 31, ob = rr * 64 + cc * 2; return st * 1024 + (ob ^ (((ob >> 9) & 1) << 5)); }
__host__ __device__ __forceinline__ void stage_rc(int b, int& R, int& C) { const int st = b / 1024, sb = b % 1024, swz = sb ^ (((sb >> 9) & 1) << 5); R = (st >> 1) * 16 + swz / 64; C = (st & 1) * 32 + (swz % 64) / 2; }
__host__ __device__ __forceinline__ int perm32(int rho) { const int n = rho >> 4, i = rho & 15; return 8 * (i >> 2) + 4 * n + (i & 3); }

struct Unit { int pm, pn, meta;
    __device__ __forceinline__ int bk() const { return meta & 31; } __device__ __forceinline__ int tib() const { return (meta >> 5) & 255; } __device__ __forceinline__ int nb() const { return meta >> 13; } };
struct Gemm { const char* A; const char* B; int lda, ldb, K; long tstepA, tstepB, hstepB; };

struct StaticOrder {
    int nM, nN, nwg, G, c;
    __host__ __device__ void init(int nM_, int nN_, int G_, int c_) { nM = nM_; nN = nN_; nwg = nM * nN; G = G_; c = c_; }
    __host__ __device__ bool next(int i, Unit& u) const {
        const long L = (long)i * G + c; if (L >= nwg) return false;
        int wgid = (int)L; { const int q = nwg / NXCD, r = nwg % NXCD, xcd = wgid % NXCD, off = wgid / NXCD; wgid = (xcd < r ? xcd * (q + 1) : r * (q + 1) + (xcd - r) * q) + off; }
        const int nig = WGM * nN, gid = wgid / nig, fm = gid * WGM, gsz = (nM - fm) < WGM ? (nM - fm) : WGM;
        u.pm = fm + ((wgid % nig) % gsz); u.pn = (wgid % nig) / gsz; return true;
    }
};

__device__ __forceinline__ unsigned cvt_pk_bf16(float lo, float hi) { unsigned r; asm volatile("v_cvt_pk_bf16_f32 %0, %1, %2" : "=v"(r) : "v"(lo), "v"(hi)); return r; }

struct EpiQKV {
    static constexpr bool PERM = true;
    bf16_t* O; size_t split_stride; float scale0;
    __device__ __forceinline__ void operator()(const f32x4 (&acc)[2][2][4][2], const Unit& u, int wr, int wc, int fr, int fq) const {
        asm volatile("" : "+v"(fr), "+v"(fq));
        const int row0 = u.pm * BM + wr * 64 + fr; int colt = u.pn * BM;
        const int t = colt / DM; bf16_t* base = O + (size_t)t * split_stride; colt -= t * DM; const float sc = (t == 0) ? scale0 : 1.f;
        const int col0 = colt + wc * 32 + 8 * fq;
#pragma unroll
        for (int ai = 0; ai < 2; ++ai)
#pragma unroll
            for (int m = 0; m < 4; ++m) { bf16_t* rowp = base + (size_t)(row0 + ai * HALF + m * 16) * DM + col0;
#pragma unroll
                for (int bj = 0; bj < 2; ++bj) { f32x4 v0 = acc[ai][bj][m][0] * sc, v1 = acc[ai][bj][m][1] * sc;
                    u32x4 w; w.x = cvt_pk_bf16(v0[0], v0[1]); w.y = cvt_pk_bf16(v0[2], v0[3]); w.z = cvt_pk_bf16(v1[0], v1[1]); w.w = cvt_pk_bf16(v1[2], v1[3]);
                    *(u32x4*)(rowp + bj * HALF) = w; } }
    }
};
struct EpiResAdd {
    static constexpr bool PERM = false;
    const float* base; float* out;
    __device__ __forceinline__ void operator()(const f32x4 (&acc)[2][2][4][2], const Unit& u, int wr, int wc, int fr, int fq) const {
        asm volatile("" : "+v"(fr), "+v"(fq));
        const int col0 = u.pn * BM + wc * 32 + 4 * fq;
#pragma unroll
        for (int ai = 0; ai < 2; ++ai)
#pragma unroll
            for (int m = 0; m < 4; ++m) { const size_t off = (size_t)(u.pm * BM + ai * HALF + wr * 64 + m * 16 + fr) * DM + col0;
#pragma unroll
                for (int bj = 0; bj < 2; ++bj)
#pragma unroll
                    for (int n = 0; n < 2; ++n) { const f32x4 bs = *(const f32x4*)(base + off + bj * HALF + n * 16); *(f32x4*)(out + off + bj * HALF + n * 16) = bs + acc[ai][bj][m][n]; } }
    }
};
struct EpiGateUpDense {
    static constexpr bool PERM = true;
    bf16_t* act; const float* comb;
    __device__ __forceinline__ void operator()(const f32x4 (&acc)[2][2][4][2], const Unit& u, int wr, int wc, int fr, int fq) const {
        asm volatile("" : "+v"(fr), "+v"(fq));
        const int e = u.pn >> 1, c0 = (u.pn & 1) * HALF;
        const int col0 = e * DEXP + c0 + wc * 32 + 8 * fq;
#pragma unroll
        for (int ai = 0; ai < 2; ++ai)
#pragma unroll
            for (int m = 0; m < 4; ++m) { const int row = u.pm * BM + ai * HALF + wr * 64 + m * 16 + fr;
                const float cw = comb[(size_t)row * NEXP + e];
                float o[8];
#pragma unroll
                for (int n = 0; n < 2; ++n)
#pragma unroll
                    for (int j = 0; j < 4; ++j) { const float g = acc[ai][0][m][n][j], up = acc[ai][1][m][n][j];
                        const float sg = g * __builtin_amdgcn_rcpf(1.f + __builtin_amdgcn_exp2f(-g * LOG2E));
                        o[n * 4 + j] = sg * up * cw; }
                u32x4 w; w.x = cvt_pk_bf16(o[0], o[1]); w.y = cvt_pk_bf16(o[2], o[3]); w.z = cvt_pk_bf16(o[4], o[5]); w.w = cvt_pk_bf16(o[6], o[7]);
                *(u32x4*)(act + (size_t)row * NACT + col0) = w; }
    }
};

template <class Epi, class Sched>
__device__ __forceinline__ void gemm_phase(LAS unsigned char* lds, const Gemm g, const Sched& S, const Epi& E, int wave_id) {
    int lane_l = (int)__builtin_amdgcn_mbcnt_hi(~0u, __builtin_amdgcn_mbcnt_lo(~0u, 0u)); asm volatile("" : "+v"(lane_l));
    const int wid = wave_id, lane = lane_l, tid = wid * 64 + lane, wr = wid >> 2, wc = wid & 3, fr = lane & 15, fq = lane >> 4;
    const int K = g.K, nt = K / BK;
    unsigned voffA[2], voffB[2];
#pragma unroll
    for (int i = 0; i < 2; ++i) { int R, C; stage_rc(tid * 16 + i * 8192, R, C); const int Rb = Epi::PERM ? ((R & ~31) + perm32(R & 31)) : R;
        voffA[i] = (unsigned)(R * g.lda + C) * 2u; voffB[i] = (unsigned)(Rb * g.ldb + C) * 2u; }
    const size_t kstep = (size_t)(BK * 2);
    const size_t hstepA = (size_t)HALF * g.lda * 2;
    const long hstepB = g.hstepB;
    const unsigned ldsw = (unsigned)wid * 1024u;
    const int aoff = lds_byte(wr * 64 + fr, fq * 8), boff = lds_byte(wc * 32 + fr, fq * 8);
#define PG8_SA(b, h) (((b) * 2 + (h)) * HTB)
#define PG8_SB(b, h) ((4 + (b) * 2 + (h)) * HTB)
#define PG8_STAGE(bufoff, gbase, voff) do { _Pragma("unroll") for (int _i = 0; _i < 2; ++_i) \
        __builtin_amdgcn_global_load_lds((const unsigned*)((const char*)(gbase) + (voff)[_i]), (LAS unsigned*)(lds + (bufoff) + ldsw + _i * 8192), 16, 0, 0); } while (0)
#define PG8_LDA(dst, b, h) do { _Pragma("unroll") for (int m = 0; m < 4; ++m) _Pragma("unroll") for (int k = 0; k < 2; ++k) dst[m][k] = *(const LAS bf16x8*)(lds + PG8_SA(b, h) + aoff + m * 2048 + k * 1024); } while (0)
#define PG8_LDB(dst, b, h) do { _Pragma("unroll") for (int n = 0; n < 2; ++n) _Pragma("unroll") for (int k = 0; k < 2; ++k) dst[n][k] = *(const LAS bf16x8*)(lds + PG8_SB(b, h) + boff + n * 2048 + k * 1024); } while (0)
#define PG8_MMA(ai, bj, At, Bt) do { __builtin_amdgcn_s_setprio(1); _Pragma("unroll") for (int m = 0; m < 4; ++m) _Pragma("unroll") for (int n = 0; n < 2; ++n) _Pragma("unroll") for (int k = 0; k < 2; ++k) \
        acc[ai][bj][m][n] = __builtin_amdgcn_mfma_f32_16x16x32_bf16(Bt[n][k], At[m][k], acc[ai][bj][m][n], 0, 0, 0); __builtin_amdgcn_s_setprio(0); } while (0)
#define PG8_WAIT_V(n) asm volatile("s_waitcnt vmcnt(" #n ")" ::: "memory")
#define PG8_WAIT_L(n) asm volatile("s_waitcnt lgkmcnt(" #n ")" ::: "memory")
#define PG8_BAR __builtin_amdgcn_s_barrier()
#define PG8_SCHED __builtin_amdgcn_sched_barrier(0)
    Unit cur, nxt; int ui = 0;
    if (!S.next(0, cur)) return;
    f32x4 acc[2][2][4][2];
#pragma unroll
    for (int a = 0; a < 2; ++a)
#pragma unroll
        for (int b = 0; b < 2; ++b)
#pragma unroll
            for (int m = 0; m < 4; ++m)
#pragma unroll
                for (int n = 0; n < 2; ++n) acc[a][b][m][n] = (f32x4){0.f, 0.f, 0.f, 0.f};
    bf16x8 At[4][2], B0[2][2], B1[2][2];
    const char* cA = g.A + (size_t)cur.pm * g.tstepA; const char* cB = g.B + (size_t)cur.pn * g.tstepB;
    PG8_STAGE(PG8_SB(0, 0), cB, voffB); PG8_STAGE(PG8_SB(0, 1), cB + hstepB, voffB); PG8_STAGE(PG8_SA(0, 0), cA, voffA); PG8_STAGE(PG8_SA(0, 1), cA + hstepA, voffA);
    if (wr == 1) PG8_BAR;
    PG8_WAIT_V(2); PG8_BAR;
    PG8_STAGE(PG8_SB(1, 0), cB + kstep, voffB); PG8_STAGE(PG8_SA(1, 0), cA + kstep, voffA); PG8_STAGE(PG8_SB(1, 1), cB + hstepB + kstep, voffB);
    PG8_WAIT_V(6); PG8_BAR;
    for (;;) {
        const bool has_next = S.next(ui + 1, nxt);
        const char* nA = has_next ? g.A + (size_t)nxt.pm * g.tstepA : cA; const char* nB = has_next ? g.B + (size_t)nxt.pn * g.tstepB : cB;
        for (int t = 0; t < nt; t += 2) {
            const bool last = (t == nt - 2);
            const char* a1 = cA + (size_t)(t + 1) * kstep;
            const char* a2 = last ? nA : cA + (size_t)(t + 2) * kstep; const char* b2 = last ? nB : cB + (size_t)(t + 2) * kstep;
            const char* a3 = a2 + kstep; const char* b3 = b2 + kstep;
            PG8_LDB(B0, 0, 0); PG8_LDB(B1, 0, 1); PG8_SCHED; PG8_LDA(At, 0, 0); PG8_STAGE(PG8_SA(1, 1), a1 + hstepA, voffA);
            PG8_WAIT_V(8); PG8_WAIT_L(0); PG8_BAR; PG8_MMA(0, 0, At, B0); PG8_MMA(0, 1, At, B1); PG8_BAR; PG8_SCHED;
            PG8_LDA(At, 0, 1); PG8_STAGE(PG8_SB(0, 0), b2, voffB); PG8_STAGE(PG8_SB(0, 1), b2 + hstepB, voffB); PG8_STAGE(PG8_SA(0, 0), a2, voffA);
            PG8_WAIT_V(8); PG8_WAIT_L(0); PG8_BAR; PG8_MMA(1, 0, At, B0); PG8_MMA(1, 1, At, B1); PG8_BAR; PG8_SCHED;
            PG8_LDB(B0, 1, 0); PG8_LDB(B1, 1, 1); PG8_SCHED; PG8_LDA(At, 1, 0); PG8_STAGE(PG8_SA(0, 1), a2 + hstepA, voffA);
            PG8_WAIT_V(8); PG8_WAIT_L(0); PG8_BAR; PG8_MMA(0, 0, At, B0); PG8_MMA(0, 1, At, B1); PG8_BAR; PG8_SCHED;
            PG8_LDA(At, 1, 1); PG8_STAGE(PG8_SB(1, 0), b3, voffB); PG8_STAGE(PG8_SB(1, 1), b3 + hstepB, voffB); PG8_STAGE(PG8_SA(1, 0), a3, voffA);
            PG8_WAIT_V(8); PG8_WAIT_L(0); PG8_BAR; PG8_MMA(1, 0, At, B0); PG8_MMA(1, 1, At, B1); PG8_BAR; PG8_SCHED;
        }
        if (wr == 0) PG8_BAR;
        E(acc, cur, wr, wc, fr, fq);
        if (!has_next) break;
#pragma unroll
        for (int a = 0; a < 2; ++a)
#pragma unroll
            for (int b = 0; b < 2; ++b)
#pragma unroll
                for (int m = 0; m < 4; ++m)
#pragma unroll
                    for (int n = 0; n < 2; ++n) acc[a][b][m][n] = (f32x4){0.f, 0.f, 0.f, 0.f};
        cur = nxt; cA = nA; cB = nB; ++ui;
        if (wr == 1) PG8_BAR;
    }
    PG8_WAIT_V(0);
    PG8_BAR;
#undef PG8_SA
#undef PG8_SB
#undef PG8_STAGE
#undef PG8_LDA
#undef PG8_LDB
#undef PG8_MMA
#undef PG8_WAIT_V
#undef PG8_WAIT_L
#undef PG8_BAR
#undef PG8_SCHED
}
template <class Epi, class Prob>
__device__ __forceinline__ void gemm_phase_x(LAS unsigned char* lds, const Prob& P, const Epi& E, int wave_id) {
    int lane_l = (int)__builtin_amdgcn_mbcnt_hi(~0u, __builtin_amdgcn_mbcnt_lo(~0u, 0u)); asm volatile("" : "+v"(lane_l));
    const int wid = wave_id, lane = lane_l, tid = wid * 64 + lane, wr = wid >> 2, wc = wid & 3, fr = lane & 15, fq = lane >> 4;
    const int K = P.K, nt = K / BK;
    unsigned voffB[2];
#pragma unroll
    for (int i = 0; i < 2; ++i) { int R, C; stage_rc(tid * 16 + i * 8192, R, C); const int Rb = Epi::PERM ? ((R & ~31) + perm32(R & 31)) : R; voffB[i] = (unsigned)(Rb * P.ldb + C) * 2u; }
    const size_t kstep = (size_t)(BK * 2);
    const long hstepB = P.hstepB;
    const unsigned ldsw = (unsigned)wid * 1024u;
    const int aoff = lds_byte(wr * 64 + fr, fq * 8), boff = lds_byte(wc * 32 + fr, fq * 8);
    LAS u32x4* stash = (LAS u32x4*)(lds + STAGE_BYTES + 1024) + tid;
#define PG8_SA(b, h) (((b) * 2 + (h)) * HTB)
#define PG8_SB(b, h) ((4 + (b) * 2 + (h)) * HTB)
#define PG8_STAGE(bufoff, gbase, voff) do { _Pragma("unroll") for (int _i = 0; _i < 2; ++_i) \
        __builtin_amdgcn_global_load_lds((const unsigned*)((const char*)(gbase) + (voff)[_i]), (LAS unsigned*)(lds + (bufoff) + ldsw + _i * 8192), 16, 0, 0); } while (0)
#define PG8_LDA(dst, b, h) do { _Pragma("unroll") for (int m = 0; m < 4; ++m) _Pragma("unroll") for (int k = 0; k < 2; ++k) dst[m][k] = *(const LAS bf16x8*)(lds + PG8_SA(b, h) + aoff + m * 2048 + k * 1024); } while (0)
#define PG8_LDB(dst, b, h) do { _Pragma("unroll") for (int n = 0; n < 2; ++n) _Pragma("unroll") for (int k = 0; k < 2; ++k) dst[n][k] = *(const LAS bf16x8*)(lds + PG8_SB(b, h) + boff + n * 2048 + k * 1024); } while (0)
#define PG8_MMA(ai, bj, At, Bt) do { __builtin_amdgcn_s_setprio(1); _Pragma("unroll") for (int m = 0; m < 4; ++m) _Pragma("unroll") for (int n = 0; n < 2; ++n) _Pragma("unroll") for (int k = 0; k < 2; ++k) \
        acc[ai][bj][m][n] = __builtin_amdgcn_mfma_f32_16x16x32_bf16(Bt[n][k], At[m][k], acc[ai][bj][m][n], 0, 0, 0); __builtin_amdgcn_s_setprio(0); } while (0)
#define PG8_WAIT_V(n) asm volatile("s_waitcnt vmcnt(" #n ")" ::: "memory")
#define PG8_WAIT_L(n) asm volatile("s_waitcnt lgkmcnt(" #n ")" ::: "memory")
#define PG8_BAR __builtin_amdgcn_s_barrier()
#define PG8_SCHED __builtin_amdgcn_sched_barrier(0)
#define PG8_AVOFF(dst, u) do { int t2_ = tid; asm volatile("" : "+v"(t2_)); _Pragma("unroll") for (int i_ = 0; i_ < 2; ++i_) { int R_, C_; stage_rc(t2_ * 16 + i_ * 8192, R_, C_); _Pragma("unroll") for (int h_ = 0; h_ < 2; ++h_) \
        dst[h_][i_] = (Prob::GATHER ? P.arow_off(u, h_, R_) : (unsigned)((h_ * HALF + R_) * P.lda) * 2u) + (unsigned)C_ * 2u; } } while (0)
    Unit cur, nxt; int ui = 0;
    if (!P.next(0, cur)) return;
    unsigned vA[2][2];
    PG8_AVOFF(vA, cur);
    f32x4 acc[2][2][4][2];
#pragma unroll
    for (int a = 0; a < 2; ++a)
#pragma unroll
        for (int b = 0; b < 2; ++b)
#pragma unroll
            for (int m = 0; m < 4; ++m)
#pragma unroll
                for (int n = 0; n < 2; ++n) acc[a][b][m][n] = (f32x4){0.f, 0.f, 0.f, 0.f};
    bf16x8 At[4][2], B0[2][2], B1[2][2];
    const char* cA = P.a_base(cur); const char* cB = P.b_base(cur);
    long csplit = Prob::KSPLIT ? P.bsplit(cur) : 0;
    PG8_STAGE(PG8_SB(0, 0), cB, voffB); PG8_STAGE(PG8_SB(0, 1), cB + hstepB, voffB); PG8_STAGE(PG8_SA(0, 0), cA, vA[0]); PG8_STAGE(PG8_SA(0, 1), cA, vA[1]);
    if (wr == 1) PG8_BAR;
    PG8_WAIT_V(2); PG8_BAR;
    PG8_STAGE(PG8_SB(1, 0), cB + kstep, voffB); PG8_STAGE(PG8_SA(1, 0), cA + kstep, vA[0]); PG8_STAGE(PG8_SB(1, 1), cB + hstepB + kstep, voffB);
    PG8_WAIT_V(6); PG8_BAR;
    for (;;) {
        const bool has_next = P.next(ui + 1, nxt);
        const char* nA = has_next ? P.a_base(nxt) : cA; const char* nB = has_next ? P.b_base(nxt) : cB;
        if (Prob::GATHER) { unsigned vN[2][2];
            if (has_next) { PG8_AVOFF(vN, nxt); } else { vN[0][0] = vA[0][0]; vN[0][1] = vA[0][1]; vN[1][0] = vA[1][0]; vN[1][1] = vA[1][1]; }
            *stash = (u32x4){vN[0][0], vN[0][1], vN[1][0], vN[1][1]}; }
        for (int t = 0; t < nt; t += 2) {
            const bool last = (t == nt - 2);
            const char* a1 = cA + (size_t)(t + 1) * kstep;
            const char* a2 = last ? nA : cA + (size_t)(t + 2) * kstep;
            const char* b2 = last ? nB : cB + (size_t)(t + 2) * kstep + ((Prob::KSPLIT && (t + 2) >= (nt >> 1)) ? csplit : 0);
            const char* a3 = a2 + kstep; const char* b3 = b2 + kstep;
            PG8_LDB(B0, 0, 0); PG8_LDB(B1, 0, 1); PG8_SCHED; PG8_LDA(At, 0, 0); PG8_STAGE(PG8_SA(1, 1), a1, vA[1]);
            if (Prob::GATHER && last) { const u32x4 sv = *stash; vA[0][0] = sv.x; vA[0][1] = sv.y; vA[1][0] = sv.z; vA[1][1] = sv.w; }
            PG8_WAIT_V(8); PG8_WAIT_L(0); PG8_BAR; PG8_MMA(0, 0, At, B0); PG8_MMA(0, 1, At, B1); PG8_BAR; PG8_SCHED;
            PG8_LDA(At, 0, 1); PG8_STAGE(PG8_SB(0, 0), b2, voffB); PG8_STAGE(PG8_SB(0, 1), b2 + hstepB, voffB); PG8_STAGE(PG8_SA(0, 0), a2, vA[0]);
            PG8_WAIT_V(8); PG8_WAIT_L(0); PG8_BAR; PG8_MMA(1, 0, At, B0); PG8_MMA(1, 1, At, B1); PG8_BAR; PG8_SCHED;
            PG8_LDB(B0, 1, 0); PG8_LDB(B1, 1, 1); PG8_SCHED; PG8_LDA(At, 1, 0); PG8_STAGE(PG8_SA(0, 1), a2, vA[1]);
            PG8_WAIT_V(8); PG8_WAIT_L(0); PG8_BAR; PG8_MMA(0, 0, At, B0); PG8_MMA(0, 1, At, B1); PG8_BAR; PG8_SCHED;
            PG8_LDA(At, 1, 1); PG8_STAGE(PG8_SB(1, 0), b3, voffB); PG8_STAGE(PG8_SB(1, 1), b3 + hstepB, voffB); PG8_STAGE(PG8_SA(1, 0), a3, vA[0]);
            PG8_WAIT_V(8); PG8_WAIT_L(0); PG8_BAR; PG8_MMA(1, 0, At, B0); PG8_MMA(1, 1, At, B1); PG8_BAR; PG8_SCHED;
        }
        if (wr == 0) PG8_BAR;
        E(acc, cur, wr, wc, fr, fq);
        if (!has_next) break;
#pragma unroll
        for (int a = 0; a < 2; ++a)
#pragma unroll
            for (int b = 0; b < 2; ++b)
#pragma unroll
                for (int m = 0; m < 4; ++m)
#pragma unroll
                    for (int n = 0; n < 2; ++n) acc[a][b][m][n] = (f32x4){0.f, 0.f, 0.f, 0.f};
        cur = nxt; cA = nA; cB = nB; ++ui;
        if (Prob::KSPLIT) csplit = P.bsplit(cur);
        if (wr == 1) PG8_BAR;
    }
    PG8_WAIT_V(0);
    PG8_BAR;
#undef PG8_SA
#undef PG8_SB
#undef PG8_STAGE
#undef PG8_LDA
#undef PG8_LDB
#undef PG8_MMA
#undef PG8_WAIT_V
#undef PG8_WAIT_L
#undef PG8_BAR
#undef PG8_SCHED
#undef PG8_AVOFF
}

__device__ __forceinline__ int pair_a(int pi) { return pi < 3 ? 0 : (pi < 5 ? 1 : 2); }
__device__ __forceinline__ int pair_b(int pi) { return pi == 0 ? 1 : ((pi == 1 || pi == 3) ? 2 : 3); }
template <int MODE>
struct MoeProb {
    static constexpr bool GATHER = (MODE == 0), KSPLIT = (MODE == 1);
    const unsigned* cnt; const unsigned* list; const char* A; const char* B; int lda, ldb, K; long hstepB; int G, c;
    __device__ __forceinline__ bool next(int i, Unit& u) const {
        const long L = (long)i * G + c; const int tileidx = (int)(L >> 2);
        int accu = 0, bk = -1, tib = 0, nb = 0;
        for (int k = 0; k < 24; ++k) { const int n = (int)cnt[k]; const int tl = (n + 255) >> 8; if (bk < 0 && tileidx < accu + tl) { bk = k; tib = tileidx - accu; nb = n; } accu += tl; }
        if (bk < 0) return false;
        u.pm = tileidx; u.pn = (int)(L & 3); u.meta = bk | (tib << 5) | (nb << 13); return true;
    }
    __device__ __forceinline__ int expert(const Unit& u, int s) const { const int g = u.bk() / 6, pi = u.bk() % 6; return g * 4 + (s ? pair_b(pi) : pair_a(pi)); }
    __device__ __forceinline__ const char* a_base(const Unit& u) const { return MODE == 0 ? A : A + (size_t)u.pm * 256 * lda * 2; }
    __device__ __forceinline__ const char* b_base(const Unit& u) const {
        if (MODE == 0) return B + ((size_t)expert(u, u.pn >> 1) * DEXP + (size_t)(u.pn & 1) * HALF) * ldb * 2;
        return B + (size_t)u.pn * 256 * ldb * 2 + (size_t)expert(u, 0) * DEXP * 2;
    }
    __device__ __forceinline__ unsigned arow_off(const Unit& u, int h, int R) const { const int pos = u.tib() * 256 + h * HALF + R; const unsigned tok = pos < u.nb() ? list[(size_t)u.bk() * T + pos] : 0u; return tok * (unsigned)(lda * 2); }
    __device__ __forceinline__ long bsplit(const Unit& u) const { return ((long)(expert(u, 1) - expert(u, 0)) * DEXP - DEXP) * 2; }
};
struct EpiGateUpSparse {
    static constexpr bool PERM = true;
    bf16_t* act; const float* wlist;
    __device__ __forceinline__ void operator()(const f32x4 (&acc)[2][2][4][2], const Unit& u, int wr, int wc, int fr, int fq) const {
        asm volatile("" : "+v"(fr), "+v"(fq));
        const int s = u.pn >> 1, col0 = s * DEXP + (u.pn & 1) * HALF + wc * 32 + 8 * fq;
#pragma unroll
        for (int ai = 0; ai < 2; ++ai)
#pragma unroll
            for (int m = 0; m < 4; ++m) { const int r = ai * HALF + wr * 64 + m * 16 + fr, pos = u.tib() * 256 + r;
                const float cw = pos < u.nb() ? wlist[((size_t)u.bk() * T + pos) * 2 + s] : 0.f;
                float o[8];
#pragma unroll
                for (int n = 0; n < 2; ++n)
#pragma unroll
                    for (int j = 0; j < 4; ++j) { const float g = acc[ai][0][m][n][j], up = acc[ai][1][m][n][j];
                        const float sg = g * __builtin_amdgcn_rcpf(1.f + __builtin_amdgcn_exp2f(-g * LOG2E));
                        o[n * 4 + j] = sg * up * cw; }
                u32x4 w; w.x = cvt_pk_bf16(o[0], o[1]); w.y = cvt_pk_bf16(o[2], o[3]); w.z = cvt_pk_bf16(o[4], o[5]); w.w = cvt_pk_bf16(o[6], o[7]);
                *(u32x4*)(act + ((size_t)u.pm * 256 + r) * 512 + col0) = w;
                if (m & 1) asm volatile("" ::: "memory"); }
    }
};
struct EpiDownScatter {
    static constexpr bool PERM = false;
    float* x; const unsigned* list;
    __device__ __forceinline__ void operator()(const f32x4 (&acc)[2][2][4][2], const Unit& u, int wr, int wc, int fr, int fq) const {
        asm volatile("" : "+v"(fr), "+v"(fq));
        const int col0 = u.pn * BM + wc * 32 + 4 * fq;
        unsigned tok[8];
#pragma unroll
        for (int g = 0; g < 8; ++g) { const int pos = u.tib() * 256 + (g >> 2) * HALF + wr * 64 + (g & 3) * 16 + fr; tok[g] = pos < u.nb() ? list[(size_t)u.bk() * T + pos] : 0xffffffffu; }
#pragma unroll
        for (int g = 0; g < 8; ++g) { const int ai = g >> 2, m = g & 3;
            if (tok[g] != 0xffffffffu) { const size_t off = (size_t)tok[g] * DM + col0;
#pragma unroll
                for (int bj = 0; bj < 2; ++bj)
#pragma unroll
                    for (int n = 0; n < 2; ++n) { f32x4* p = (f32x4*)(x + off + bj * HALF + n * 16); *p = *p + acc[ai][bj][m][n]; } }
            if (g & 1) asm volatile("" ::: "memory"); }
    }
};
}

#define XB_TMO      128
#define XB_XCNT(j)  (256  + 64 * (j))
#define XB_XSUB(j)  (1280 + 64 * (j))
#define XB_XGEN(j)  (2304 + 64 * (j))
#define XB_TOP      3328
#define XB_TOPGEN   3392
#define XCD_BAR_WORDS 3456
#define XB_SPIN_CAP (1u << 18)
__device__ __forceinline__ unsigned xb_ld(unsigned* p)              { return __hip_atomic_load(p, __ATOMIC_RELAXED, __HIP_MEMORY_SCOPE_AGENT); }
__device__ __forceinline__ unsigned xb_add(unsigned* p, unsigned v) { return __hip_atomic_fetch_add(p, v, __ATOMIC_RELAXED, __HIP_MEMORY_SCOPE_AGENT); }
__device__ __forceinline__ unsigned xb_xcc_id() { return (unsigned)__builtin_amdgcn_s_getreg((3 << 11) | 20) & 0xFu; }
#define XB_SPIN(cond, bar) do { unsigned _sp = 0; while (cond) { __builtin_amdgcn_s_sleep(1); \
    if ((++_sp & 255u) == 0u) { if (xb_ld(&(bar)[XB_TMO])) break; if (_sp > XB_SPIN_CAP) { atomicAdd(&(bar)[XB_TMO], 1u); break; } } } } while (0)
struct XcdBarrier { unsigned* bar; unsigned x; volatile LAS unsigned* st; int wave; };
__device__ __forceinline__ bool xb_thread0(int wave) { return wave == 0 && __builtin_amdgcn_mbcnt_hi(~0u, __builtin_amdgcn_mbcnt_lo(~0u, 0u)) == 0u; }
__device__ __forceinline__ XcdBarrier xcd_barrier_post(unsigned* bar, volatile LAS unsigned* st, int wave) {
    XcdBarrier b; b.bar = bar; b.x = xb_xcc_id(); b.st = st; b.wave = wave;
    if (xb_thread0(wave)) (void)xb_add(&bar[XB_XCNT(b.x)], 1u);
    return b;
}
__device__ __forceinline__ void xcd_barrier_complete(unsigned* bar, unsigned x, unsigned& nloc, unsigned& nx) {
    const unsigned G = gridDim.x * gridDim.y * gridDim.z;
    unsigned sum, cnt, mine, sp = 0u;
    for (;;) {
        sum = 0u; cnt = 0u; mine = 0u;
#pragma unroll
        for (unsigned j = 0; j < 16; ++j) { const unsigned c = xb_ld(&bar[XB_XCNT(j)]); sum += c; cnt += (c > 0u) ? 1u : 0u; mine = (j == x) ? c : mine; }
        if (sum == G) break;
        __builtin_amdgcn_s_sleep(1);
        if ((++sp & 255u) == 0u) { if (xb_ld(&bar[XB_TMO])) break; if (sp > XB_SPIN_CAP) { atomicAdd(&bar[XB_TMO], 1u); break; } }
    }
    nloc = mine > 0u ? mine : 1u; nx = cnt > 0u ? cnt : 1u;
}
__device__ __forceinline__ void xcd_barrier(const XcdBarrier& b) {
    asm volatile("s_waitcnt vmcnt(0)" ::: "memory");
    __syncthreads();
    if (xb_thread0(b.wave)) {
        unsigned* bar = b.bar;
        __builtin_amdgcn_s_waitcnt(0);
        unsigned nloc = b.st[0], nx = b.st[1];
        if (nloc == 0u) { xcd_barrier_complete(bar, b.x, nloc, nx); b.st[0] = nloc; b.st[1] = nx; }
        const unsigned old = xb_add(&bar[XB_XSUB(b.x)], 1u);
        const unsigned gen = old / nloc;
        if (old + 1u == (gen + 1u) * nloc) {
            __builtin_amdgcn_fence(__ATOMIC_RELEASE, "agent");
            asm volatile("s_waitcnt vmcnt(0)" ::: "memory");
            const unsigned og = xb_add(&bar[XB_TOP], 1u);
            const unsigned tg = og / nx;
            if (og + 1u == (tg + 1u) * nx) xb_add(&bar[XB_TOPGEN], 1u);
            else XB_SPIN(xb_ld(&bar[XB_TOPGEN]) == tg, bar);
            __builtin_amdgcn_fence(__ATOMIC_ACQUIRE, "agent");
            xb_add(&bar[XB_XGEN(b.x)], 1u);
            asm volatile("s_waitcnt vmcnt(0)" ::: "memory");
        } else {
            XB_SPIN(xb_ld(&bar[XB_XGEN(b.x)]) == gen, bar);
            __builtin_amdgcn_fence(__ATOMIC_ACQUIRE, "agent");
            asm volatile("s_waitcnt vmcnt(0)" ::: "memory");
        }
    }
    __syncthreads();
}

struct Args {
    const float* x; const float* ln1_g; const float* w_in; const float* mix_g; const float* w_out; const float* ln2_g;
    const float* w_gr; const float* b_gr; const float* w_er; const float* b_er; const float* w_gate; const float* w_up; const float* w_down; const float* fin_g;
    float* out; unsigned char* ws; int ph_lo, ph_hi, li, pad;
};

__device__ __forceinline__ void transpose_item(const float* W, int K, int N, bf16_t* WT, int dpitch, int dcol, LAS float* scr, int item, int lane) {
    const int nblk = N / 32, kb = item / nblk, nb = item % nblk, k0 = 64 * kb, n0 = 32 * nb;
#pragma unroll 8
    for (int i = 0; i < 32; ++i) { const int kk = 2 * i + (lane >> 5); scr[kk * 33 + (lane & 31)] = W[(size_t)(k0 + kk) * N + n0 + (lane & 31)]; }
    LDS_WAIT(); asm volatile("" ::: "memory");
    const int c = lane & 7;
#pragma unroll
    for (int j = 0; j < 4; ++j) { const int n = (lane >> 3) + 8 * j; const LAS float* s = scr + (8 * c) * 33 + n;
        u32x4 o; o.x = pk2(s[0 * 33], s[1 * 33]); o.y = pk2(s[2 * 33], s[3 * 33]); o.z = pk2(s[4 * 33], s[5 * 33]); o.w = pk2(s[6 * 33], s[7 * 33]);
        *(u32x4*)(WT + (size_t)(n0 + n) * dpitch + dcol + k0 + 8 * c) = o; }
    LDS_WAIT(); asm volatile("" ::: "memory");
}
__device__ __forceinline__ void phase_prologue(const Args& a, LAS unsigned char* lds, int gw, int NGW, int wave, int lane) {
    LAS float* scr = (LAS float*)(lds + wave * 16384);
    constexpr int I_IN = (DM / 64) * (NQKV / 32);
    constexpr int I_OUT = (DM / 64) * (DM / 32);
    constexpr int I_G = (DM / 64) * (DEXP / 32);
    constexpr int I_D = (DEXP / 64) * (DM / 32);
    constexpr int N_IN = DEPTH * I_IN, N_OUT = DEPTH * I_OUT, N_G = DEPTH * NEXP * I_G, N_D = DEPTH * NEXP * I_D;
    constexpr int NITEMS = N_IN + N_OUT + 2 * N_G + N_D;
    bf16_t* WinT = (bf16_t*)(a.ws + WS_WIN); bf16_t* WoutT = (bf16_t*)(a.ws + WS_WOUT); bf16_t* WgT = (bf16_t*)(a.ws + WS_WG); bf16_t* WuT = (bf16_t*)(a.ws + WS_WU); bf16_t* WdT = (bf16_t*)(a.ws + WS_WD);
    for (int it = gw; it < NITEMS; it += NGW) {
        int r = it;
        if (r < N_IN) { const int l = r / I_IN; transpose_item(a.w_in + (size_t)l * DM * NQKV, DM, NQKV, WinT + (size_t)l * NQKV * DM, DM, 0, scr, r % I_IN, lane); continue; } r -= N_IN;
        if (r < N_OUT) { const int l = r / I_OUT; transpose_item(a.w_out + (size_t)l * DM * DM, DM, DM, WoutT + (size_t)l * DM * DM, DM, 0, scr, r % I_OUT, lane); continue; } r -= N_OUT;
        if (r < N_G) { const int le = r / I_G; transpose_item(a.w_gate + (size_t)le * DM * DEXP, DM, DEXP, WgT + (size_t)le * DEXP * DM, DM, 0, scr, r % I_G, lane); continue; } r -= N_G;
        if (r < N_G) { const int le = r / I_G; transpose_item(a.w_up + (size_t)le * DM * DEXP, DM, DEXP, WuT + (size_t)le * DEXP * DM, DM, 0, scr, r % I_G, lane); continue; } r -= N_G;
        { const int le = r / I_D, l = le / NEXP, e = le % NEXP; transpose_item(a.w_down + (size_t)le * DEXP * DM, DEXP, DM, WdT + (size_t)l * DM * NACT, NACT, e * DEXP, scr, r % I_D, lane); }
    }
}

__device__ __forceinline__ void phase_norm1(const float* x, const float* g, bf16_t* hb, int gw, int NGW, int lane) {
    f32x4 gv[4];
#pragma unroll
    for (int j = 0; j < 4; ++j) gv[j] = *((const f32x4*)g + lane + 64 * j);
    for (int m = gw; m < T; m += NGW) {
        const f32x4* xr = (const f32x4*)(x + (size_t)m * DM) + lane;
        f32x4 v[4]; float s = 0.f;
#pragma unroll
        for (int j = 0; j < 4; ++j) { v[j] = xr[64 * j]; s += (v[j].x * v[j].x + v[j].y * v[j].y) + (v[j].z * v[j].z + v[j].w * v[j].w); }
        const float rstd = 1.0f / sqrtf(wave_sum(s) * (1.f / DM) + NORM_EPS);
        u32x2* o8 = (u32x2*)(hb + (size_t)m * DM) + lane;
#pragma unroll
        for (int j = 0; j < 4; ++j) { u32x2 w; w.x = pk2(v[j].x * rstd * gv[j].x, v[j].y * rstd * gv[j].y); w.y = pk2(v[j].z * rstd * gv[j].z, v[j].w * rstd * gv[j].w); o8[64 * j] = w; }
    }
}
__device__ __forceinline__ void unpack8(float (&f)[8], const u32x4 w) { f[0] = bflo(w.x); f[1] = bfhi(w.x); f[2] = bflo(w.y); f[3] = bfhi(w.y); f[4] = bflo(w.z); f[5] = bfhi(w.z); f[6] = bflo(w.w); f[7] = bfhi(w.w); }
__device__ __forceinline__ void phase_mixnorm(const bf16_t* ob, bf16_t* hb, const float* lse, const bf16_t* pm, const float* lsem0, const float* lsem1, const float* g, int gw, int NGW, int lane) {
    float g0[8], g1[8];
#pragma unroll
    for (int j = 0; j < 8; ++j) { g0[j] = g[8 * lane + j]; g1[j] = g[512 + 8 * lane + j]; }
    const int hh = lane >> 3;
    for (int m = gw; m < T; m += NGW) {
        const u32x4 a = *((const u32x4*)(ob + (size_t)m * DM) + lane), c0 = *((const u32x4*)(ob + (size_t)m * DM + 512) + lane);
        const u32x4 c1 = *((const u32x4*)(hb + (size_t)m * DM) + lane), c2 = *((const u32x4*)(hb + (size_t)m * DM + 512) + lane);
        const float l0 = lse[(size_t)m * 8 + hh], l1 = lse[(size_t)T * 8 + (size_t)m * 8 + hh], l2 = lse[(size_t)2 * T * 8 + (size_t)m * 8 + hh];
        float va[8]; unpack8(va, a);
        if (lane < 32) {
            const u32x4 p0 = *((const u32x4*)(pm + (size_t)m * 256) + lane), p1 = *((const u32x4*)(pm + ((size_t)T + m) * 256) + lane), p2 = *((const u32x4*)(pm + ((size_t)2 * T + m) * 256) + lane);
            const float e0 = lsem0[(size_t)m * 4 + hh], e1 = lsem0[(size_t)T * 4 + (size_t)m * 4 + hh], e2 = lsem1[(size_t)m * 4 + hh], e3 = lsem1[(size_t)T * 4 + (size_t)m * 4 + hh];
            const float mx = fmaxf(fmaxf(e0, e1), fmaxf(e2, e3));
            float u0 = __builtin_amdgcn_exp2f(e0 - mx), u1 = __builtin_amdgcn_exp2f(e1 - mx), u2 = __builtin_amdgcn_exp2f(e2 - mx), u3 = __builtin_amdgcn_exp2f(e3 - mx);
            const float inv = 1.0f / ((u0 + u1) + (u2 + u3)); u0 *= inv; u1 *= inv; u2 *= inv; u3 *= inv;
            float y0[8], y1[8], y2[8]; unpack8(y0, p0); unpack8(y1, p1); unpack8(y2, p2);
#pragma unroll
            for (int j = 0; j < 8; ++j) va[j] = (u0 * y0[j] + u1 * y1[j]) + (u2 * y2[j] + u3 * va[j]);
        }
        const float mx = fmaxf(l0, fmaxf(l1, l2));
        float w0 = __builtin_amdgcn_exp2f(l0 - mx), w1 = __builtin_amdgcn_exp2f(l1 - mx), w2 = __builtin_amdgcn_exp2f(l2 - mx);
        const float inv = 1.0f / (w0 + w1 + w2); w0 *= inv; w1 *= inv; w2 *= inv;
        float x0[8], x1[8], x2[8]; unpack8(x0, c0); unpack8(x1, c1); unpack8(x2, c2);
        float vc[8];
        float sa = 0.f, sc = 0.f;
#pragma unroll
        for (int j = 0; j < 8; ++j) { vc[j] = w0 * x0[j] + w1 * x1[j] + w2 * x2[j]; sa += va[j] * va[j]; sc += vc[j] * vc[j]; }
        sa = half_sum(sa); sc = wave_sum(sc);
        const float ra = 1.0f / sqrtf(sa * (1.f / 256.f) + NORM_EPS), rc = 1.0f / sqrtf(sc * (1.f / 512.f) + NORM_EPS);
        u32x4 oa, oc;
        oa.x = pk2(va[0] * ra * g0[0], va[1] * ra * g0[1]); oa.y = pk2(va[2] * ra * g0[2], va[3] * ra * g0[3]); oa.z = pk2(va[4] * ra * g0[4], va[5] * ra * g0[5]); oa.w = pk2(va[6] * ra * g0[6], va[7] * ra * g0[7]);
        oc.x = pk2(vc[0] * rc * g1[0], vc[1] * rc * g1[1]); oc.y = pk2(vc[2] * rc * g1[2], vc[3] * rc * g1[3]); oc.z = pk2(vc[4] * rc * g1[4], vc[5] * rc * g1[5]); oc.w = pk2(vc[6] * rc * g1[6], vc[7] * rc * g1[7]);
        *((u32x4*)(hb + (size_t)m * DM) + lane) = oa; *((u32x4*)(hb + (size_t)m * DM + 512) + lane) = oc;
    }
}
__device__ __forceinline__ void phase_route(const float* x, const float* g, const float* wgr, const float* bgr, const float* wer, const float* ber,
                                            bf16_t* hb, unsigned* cnt, unsigned* list, float* wlist, LAS unsigned char* lds, int v, int G, int wave, int lane) {
    const int tid = wave * 64 + lane;
    LAS f32x4* wl = (LAS f32x4*)lds;
    for (int idx = tid; idx < 5 * DM; idx += NTHREADS) { const int mtx = idx >> 10, d = idx & 1023; const float* src = (mtx == 0 ? wgr : wer + (size_t)(mtx - 1) * DM * 4) + d * 4;
        wl[mtx * 1024 + (d & 3) * 256 + (d >> 2)] = *(const f32x4*)src; }
    LAS unsigned* cl = (LAS unsigned*)(lds + 81920);
    LAS u32x2* info = (LAS u32x2*)(lds + 81920 + 256);
    LAS f32x2* infw = (LAS f32x2*)(lds + 81920 + 256 + 4096);
    if (tid < 64) cl[tid] = 0u;
    __syncthreads();
    const int rpw = (T + G - 1) / G, row0 = v * rpw;
    f32x4 gv[4];
#pragma unroll
    for (int j = 0; j < 4; ++j) gv[j] = *((const f32x4*)g + lane + 64 * j);
    const f32x4 bg = *(const f32x4*)bgr;
    f32x4 nx[4];
    { const int m0 = row0 + wave; if (wave < rpw && m0 < T) { const f32x4* xr = (const f32x4*)(x + (size_t)m0 * DM) + lane;
#pragma unroll
        for (int j = 0; j < 4; ++j) nx[j] = xr[64 * j]; } }
    for (int r = wave; r < rpw; r += NWAVES) {
        const int m = row0 + r; if (m >= T) break;
        f32x4 vv[4]; float s = 0.f;
#pragma unroll
        for (int j = 0; j < 4; ++j) { vv[j] = nx[j]; s += (vv[j].x * vv[j].x + vv[j].y * vv[j].y) + (vv[j].z * vv[j].z + vv[j].w * vv[j].w); }
        if (r + NWAVES < rpw && m + NWAVES < T) { const f32x4* xr = (const f32x4*)(x + (size_t)(m + NWAVES) * DM) + lane;
#pragma unroll
            for (int j = 0; j < 4; ++j) nx[j] = xr[64 * j]; }
        const float rstd = 1.0f / sqrtf(wave_sum(s) * (1.f / DM) + NORM_EPS);
        u32x2* o8 = (u32x2*)(hb + (size_t)m * DM) + lane;
#pragma unroll
        for (int j = 0; j < 4; ++j) { vv[j] = vv[j] * rstd * gv[j]; u32x2 w; w.x = pk2(vv[j].x, vv[j].y); w.y = pk2(vv[j].z, vv[j].w); o8[64 * j] = w; }
        f32x4 gl = (f32x4){0.f, 0.f, 0.f, 0.f};
#pragma unroll
        for (int j = 0; j < 4; ++j) { LAS f32x4* wp = wl + lane + 64 * j;
            gl += wp[0] * vv[j].x; gl += wp[256] * vv[j].y; gl += wp[512] * vv[j].z; gl += wp[768] * vv[j].w; }
        gl.x = wave_sum(gl.x) + bg.x; gl.y = wave_sum(gl.y) + bg.y; gl.z = wave_sum(gl.z) + bg.z; gl.w = wave_sum(gl.w) + bg.w;
        int gi = 0; float gm = gl.x;
        if (gl.y > gm) { gm = gl.y; gi = 1; } if (gl.z > gm) { gm = gl.z; gi = 2; } if (gl.w > gm) { gm = gl.w; gi = 3; }
        const float gden = __expf(gl.x - gm) + __expf(gl.y - gm) + __expf(gl.z - gm) + __expf(gl.w - gm);
        const float gw_ = 1.0f / gden;
        gi = __builtin_amdgcn_readfirstlane(gi);
        f32x4 el = (f32x4){0.f, 0.f, 0.f, 0.f};
#pragma unroll
        for (int j = 0; j < 4; ++j) { LAS f32x4* wp = wl + (1 + gi) * 1024 + lane + 64 * j;
            el += wp[0] * vv[j].x; el += wp[256] * vv[j].y; el += wp[512] * vv[j].z; el += wp[768] * vv[j].w; }
        const f32x4 be = *(const f32x4*)(ber + gi * 4);
        float e[4] = {wave_sum(el.x) + be.x, wave_sum(el.y) + be.y, wave_sum(el.z) + be.z, wave_sum(el.w) + be.w};
        int i1 = 0; float v1 = e[0];
#pragma unroll
        for (int k = 1; k < 4; ++k) if (e[k] > v1) { v1 = e[k]; i1 = k; }
        int i2 = -1; float v2 = -INFINITY;
#pragma unroll
        for (int k = 0; k < 4; ++k) if (k != i1 && e[k] > v2) { v2 = e[k]; i2 = k; }
        const float p2 = __expf(v2 - v1), inv = 1.0f / (1.0f + p2);
        const float w1 = inv * gw_, w2 = p2 * inv * gw_;
        const int ea = i1 < i2 ? i1 : i2, eb = i1 < i2 ? i2 : i1; const float wa = i1 < i2 ? w1 : w2, wb = i1 < i2 ? w2 : w1;
        const int pi = (ea == 0) ? (eb - 1) : (ea == 1 ? eb + 1 : 5), bk = gi * 6 + pi;
        if (lane == 0) { const unsigned rank = __hip_atomic_fetch_add(cl + bk, 1u, __ATOMIC_RELAXED, __HIP_MEMORY_SCOPE_WORKGROUP);
            info[r] = (u32x2){(unsigned)bk, rank}; infw[r] = (f32x2){wa, wb}; }
    }
    __syncthreads();
    if (tid < 24) cl[32 + tid] = __hip_atomic_fetch_add(cnt + tid, cl[tid], __ATOMIC_RELAXED, __HIP_MEMORY_SCOPE_AGENT);
    __syncthreads();
    if (tid < rpw && row0 + tid < T) { const u32x2 inf = info[tid]; const f32x2 wv = infw[tid]; const size_t slot = (size_t)inf.x * T + cl[32 + inf.x] + inf.y;
        list[slot] = (unsigned)(row0 + tid); *(f32x2*)(wlist + slot * 2) = wv; }
    __syncthreads();
}
__device__ __forceinline__ void phase_final(float* x, const float* g, int gw, int NGW, int lane) {
    f32x4 gv[4];
#pragma unroll
    for (int j = 0; j < 4; ++j) gv[j] = *((const f32x4*)g + lane + 64 * j);
    for (int m = gw; m < T; m += NGW) {
        f32x4* xr = (f32x4*)(x + (size_t)m * DM) + lane;
        f32x4 v[4]; float s = 0.f;
#pragma unroll
        for (int j = 0; j < 4; ++j) { v[j] = xr[64 * j]; s += (v[j].x * v[j].x + v[j].y * v[j].y) + (v[j].z * v[j].z + v[j].w * v[j].w); }
        const float rstd = 1.0f / sqrtf(wave_sum(s) * (1.f / DM) + NORM_EPS);
#pragma unroll
        for (int j = 0; j < 4; ++j) xr[64 * j] = v[j] * rstd * gv[j];
    }
}
__device__ __forceinline__ void phase_kmean(const bf16_t* kb, float* kmean, int gw, int NGW, int lane) {
    for (int it = gw; it < BATCH * 4 * 32; it += NGW) {
        const int b = it >> 7, h = (it >> 5) & 3, blk = it & 31;
        const bf16_t* base = kb + ((size_t)b * SEQ + (size_t)blk * 256) * DM + h * HD + (lane & 7) * 8;
        float acc[8] = {0.f, 0.f, 0.f, 0.f, 0.f, 0.f, 0.f, 0.f};
#pragma unroll 4
        for (int i = 0; i < 32; ++i) { const u32x4 w = *(const u32x4*)(base + (size_t)((lane >> 3) + 8 * i) * DM);
            acc[0] += bflo(w.x); acc[1] += bfhi(w.x); acc[2] += bflo(w.y); acc[3] += bfhi(w.y); acc[4] += bflo(w.z); acc[5] += bfhi(w.z); acc[6] += bflo(w.w); acc[7] += bfhi(w.w); }
#pragma unroll
        for (int j = 0; j < 8; ++j) { acc[j] += swz_xor<8>(acc[j]); acc[j] += swz_xor<16>(acc[j]); acc[j] = sum_xor32(acc[j]); }
        if (lane < 8) {
            float* o = kmean + (size_t)it * HD + lane * 8;
#pragma unroll
            for (int j = 0; j < 8; ++j) o[j] = acc[j] * (1.f / 256.f);
        }
    }
}

__device__ __forceinline__ void ld_row64(float (&r)[64], const bf16_t* p) {
#pragma unroll
    for (int c = 0; c < 8; ++c) { const u32x4 w = *((const u32x4*)p + c);
        r[8 * c + 0] = bflo(w.x); r[8 * c + 1] = bfhi(w.x); r[8 * c + 2] = bflo(w.y); r[8 * c + 3] = bfhi(w.y); r[8 * c + 4] = bflo(w.z); r[8 * c + 5] = bfhi(w.z); r[8 * c + 6] = bflo(w.w); r[8 * c + 7] = bfhi(w.w); }
}
__device__ __forceinline__ float dot_row64(const float (&q)[64], const bf16_t* p) {
    float s0 = 0.f, s1 = 0.f;
#pragma unroll
    for (int c = 0; c < 8; ++c) { const u32x4 w = *((const u32x4*)p + c);
        s0 += q[8 * c + 0] * bflo(w.x); s1 += q[8 * c + 1] * bfhi(w.x); s0 += q[8 * c + 2] * bflo(w.y); s1 += q[8 * c + 3] * bfhi(w.y);
        s0 += q[8 * c + 4] * bflo(w.z); s1 += q[8 * c + 5] * bfhi(w.z); s0 += q[8 * c + 6] * bflo(w.w); s1 += q[8 * c + 7] * bfhi(w.w); }
    return s0 + s1;
}
__device__ __forceinline__ void axpy_row64(float (&o)[64], float p, const bf16_t* vp) {
#pragma unroll
    for (int c = 0; c < 8; ++c) { const u32x4 w = *((const u32x4*)vp + c);
        o[8 * c + 0] += p * bflo(w.x); o[8 * c + 1] += p * bfhi(w.x); o[8 * c + 2] += p * bflo(w.y); o[8 * c + 3] += p * bfhi(w.y);
        o[8 * c + 4] += p * bflo(w.z); o[8 * c + 5] += p * bfhi(w.z); o[8 * c + 6] += p * bflo(w.w); o[8 * c + 7] += p * bfhi(w.w); }
}
__device__ __forceinline__ void st_row64(bf16_t* p, const float (&o)[64], float sc) {
#pragma unroll
    for (int c = 0; c < 8; ++c) { u32x4 w; w.x = pk2(o[8 * c] * sc, o[8 * c + 1] * sc); w.y = pk2(o[8 * c + 2] * sc, o[8 * c + 3] * sc); w.z = pk2(o[8 * c + 4] * sc, o[8 * c + 5] * sc); w.w = pk2(o[8 * c + 6] * sc, o[8 * c + 7] * sc); *((u32x4*)p + c) = w; }
}
#define OSM_STEP(sc, vrow) do { const float sc_ = (sc); if (sc_ > m_) { const float al = __builtin_amdgcn_exp2f(m_ - sc_); l_ *= al; _Pragma("unroll") for (int d_ = 0; d_ < 64; ++d_) o_[d_] *= al; m_ = sc_; } \
    const float p_ = __builtin_amdgcn_exp2f(sc_ - m_); l_ += p_; axpy_row64(o_, p_, (vrow)); } while (0)

__device__ __forceinline__ void naive_moba(const bf16_t* qb, const bf16_t* kb, const bf16_t* vb, const float* kmean, bf16_t* ob, int item, int tid) {
    const int b = item >> 6, h = (item >> 4) & 3, t = (item & 15) * 512 + tid, own = t >> 8;
    const size_t rowq = ((size_t)b * SEQ + t) * DM + h * HD;
    const bf16_t* kh = kb + (size_t)b * SEQ * DM + h * HD; const bf16_t* vh = vb + (size_t)b * SEQ * DM + h * HD;
    const float slope2 = exp2f(-2.0f * (float)(h + 1)) * LOG2E;
    float q_[64]; ld_row64(q_, qb + rowq);
    float bv0 = -INFINITY, bv1 = -INFINITY, bv2 = -INFINITY; int bi0 = -1, bi1 = -1, bi2 = -1;
    const float* km = kmean + (size_t)(b * 4 + h) * 32 * HD;
    for (int n = 0; n < own; ++n) {
        float gsum = 0.f;
#pragma unroll
        for (int d = 0; d < 64; ++d) gsum += q_[d] * km[n * HD + d];
        if (gsum > bv0) { bv2 = bv1; bi2 = bi1; bv1 = bv0; bi1 = bi0; bv0 = gsum; bi0 = n; }
        else if (gsum > bv1) { bv2 = bv1; bi2 = bi1; bv1 = gsum; bi1 = n; }
        else if (gsum > bv2) { bv2 = gsum; bi2 = n; }
    }
    float o_[64];
#pragma unroll
    for (int d = 0; d < 64; ++d) o_[d] = 0.f;
    float m_ = -INFINITY, l_ = 0.f;
    for (int s = 0; s < 3; ++s) {
        const int blk = (s == 0) ? bi0 : (s == 1) ? bi1 : bi2;
        if (blk < 0) continue;
        for (int j = 0; j < 256; ++j) { const int pos = blk * 256 + j;
            const float sc = dot_row64(q_, kh + (size_t)pos * DM) - slope2 * (float)(t - pos);
            OSM_STEP(sc, vh + (size_t)pos * DM); }
    }
    for (int pos = own * 256; pos <= t; ++pos) {
        const float sc = dot_row64(q_, kh + (size_t)pos * DM) - slope2 * (float)(t - pos);
        OSM_STEP(sc, vh + (size_t)pos * DM); }
    st_row64(ob + rowq, o_, 1.0f / l_);
}
__device__ __forceinline__ void naive_sb(const bf16_t* qb, const bf16_t* kb, const bf16_t* vb, bf16_t* ob, int item, int tid) {
    const int b = item >> 6, h = 4 + ((item >> 4) & 3), t = (item & 15) * 512 + tid;
    const size_t rowq = ((size_t)b * SEQ + t) * DM + h * HD;
    const bf16_t* kh = kb + (size_t)b * SEQ * DM + h * HD; const bf16_t* vh = vb + (size_t)b * SEQ * DM + h * HD;
    float q_[64]; ld_row64(q_, qb + rowq);
    float o_[64];
#pragma unroll
    for (int d = 0; d < 64; ++d) o_[d] = 0.f;
    float tail = 0.f;
    for (int s = t - 1; s >= 0 && tail > -150.f; --s) {
        const float z = dot_row64(q_, kh + (size_t)s * DM);
        const float lp = __builtin_amdgcn_logf(1.0f + __builtin_amdgcn_exp2f(-fabsf(z)));
        const float lnot = -(fmaxf(z, 0.f) + lp);
        const float aw = __builtin_amdgcn_exp2f(z + lnot + tail);
        axpy_row64(o_, aw, vh + (size_t)s * DM);
        tail += lnot;
    }
    st_row64(ob + rowq, o_, 1.0f);
}
__device__ __forceinline__ void naive_dil(const bf16_t* qb, const bf16_t* kb, const bf16_t* vb, bf16_t* ob, bf16_t* hb2, float* lse, int item, int tid) {
    const int b = item >> 7, h = 8 + ((item >> 4) & 7), t = (item & 15) * 512 + tid;
    const size_t rowq = ((size_t)b * SEQ + t) * DM + h * HD;
    const bf16_t* kh = kb + (size_t)b * SEQ * DM + h * HD; const bf16_t* vh = vb + (size_t)b * SEQ * DM + h * HD;
    const float slope2 = exp2f(-(float)(h - 8 + 1)) * LOG2E;
    float q_[64]; ld_row64(q_, qb + rowq);
    float o_[64];
#pragma unroll
    for (int d = 0; d < 64; ++d) o_[d] = 0.f;
    float m_ = -INFINITY, l_ = 0.f;
    for (int c = 0; c < 3; ++c) {
        const int dil = (c == 0) ? 1 : (c == 1) ? 4 : 16;
        for (int dl = 0; dl <= 128; ++dl) { const int pos = t - dl * dil; if (pos < 0) break;
            const float sc = dot_row64(q_, kh + (size_t)pos * DM) - slope2 * (float)(dl * dil);
            OSM_STEP(sc, vh + (size_t)pos * DM); }
    }
    st_row64(ob + rowq, o_, 1.0f / l_);
    { const size_t tok = (size_t)b * SEQ + t; const u32x4 z4 = {0u, 0u, 0u, 0u};
#pragma unroll
      for (int c = 0; c < 8; ++c) { *((u32x4*)(hb2 + tok * DM + (h - 8) * HD) + c) = z4; *((u32x4*)(hb2 + tok * DM + 512 + (h - 8) * HD) + c) = z4; }
      lse[tok * 8 + (h - 8)] = 0.f; lse[(size_t)T * 8 + tok * 8 + (h - 8)] = -1.0e30f; lse[(size_t)2 * T * 8 + tok * 8 + (h - 8)] = -1.0e30f; }
}

namespace att {
typedef float f32x16 __attribute__((ext_vector_type(16)));
typedef short s16x4 __attribute__((ext_vector_type(4)));
typedef short v4i16_t __attribute__((ext_vector_type(4)));
typedef __bf16 bf16x2_t __attribute__((ext_vector_type(2)));
constexpr int L_BUF = 16384;
constexpr int L_WSF = 2 * L_BUF;
constexpr int L_OST = L_WSF + 8 * 256;
constexpr int L_FLG = L_OST + 8 * 4096;
constexpr int L_END = L_FLG + 64;
constexpr float M_INIT = -1.0e30f;
#define ATT_MFMA(a, b, c) __builtin_amdgcn_mfma_f32_32x32x16_bf16((a), (b), (c), 0, 0, 0)

__device__ __forceinline__ unsigned cvtpk(float lo, float hi) { f32x2 v = {lo, hi}; bf16x2_t b = __builtin_convertvector(v, bf16x2_t); return __builtin_bit_cast(unsigned, b); }
__device__ __forceinline__ s16x4 vtr(LAS unsigned char* p) { return __builtin_bit_cast(s16x4, __builtin_amdgcn_ds_read_tr16_b64_v4i16((LAS v4i16_t*)p)); }

struct Wave { int lane, r32, hi, wid; LAS unsigned char* lds; LAS float* wsf; LAS unsigned char* ost; int vlo; };
__device__ __forceinline__ Wave make_wave(LAS unsigned char* lds, int tid, int wsf_off = L_WSF, int ost_off = L_OST) {
    Wave w; w.lane = tid & 63; w.r32 = w.lane & 31; w.hi = w.lane >> 5; w.wid = __builtin_amdgcn_readfirstlane(tid >> 6); w.lds = lds;
    w.wsf = (LAS float*)(lds + wsf_off) + w.wid * 64; w.ost = lds + ost_off + w.wid * 4096;
    w.vlo = ((w.lane >> 4) & 1) * 32 + (w.lane & 3) * 8 + (4 * w.hi + ((w.lane & 15) >> 2)) * 64;
    return w;
}
struct Stage { u32x4 k, v; };
template <class RowK, class RowV> __device__ __forceinline__ void stage_load(Stage& s, const Wave& w, const RowK& rowk, const RowV& rowv) {
    s.k = *(const u32x4*)(rowk(w.lane) + w.wid * 8);
    s.v = *(const u32x4*)(rowv(16 * (w.wid & 3) + (w.lane >> 2)) + (w.wid >> 2) * 32 + (w.lane & 3) * 8);
}
__device__ __forceinline__ void stage_write(const Stage& s, const Wave& w, int buf) {
    *(LAS u32x4*)(w.lds + buf * L_BUF + w.wid * 1024 + w.lane * 16) = s.k;
    *(LAS u32x4*)(w.lds + buf * L_BUF + 8192 + w.wid * 1024 + w.lane * 16) = s.v;
}
__device__ __forceinline__ f32x16 qk_sub(const Wave& w, int buf, int sub, const bf16x8 (&qf)[4], float init) {
    f32x16 acc;
#pragma unroll
    for (int r = 0; r < 16; ++r) acc[r] = init;
    LAS unsigned char* kp = w.lds + buf * L_BUF + w.hi * 1024 + (32 * sub + w.r32) * 16;
#pragma unroll
    for (int ks = 0; ks < 4; ++ks) { const bf16x8 kf = *(LAS bf16x8*)(kp + ks * 2048); acc = ATT_MFMA(kf, qf[ks], acc); }
    return acc;
}
__device__ __forceinline__ void pv_sub(const Wave& w, int buf, int sub, const f32x16& p, f32x16 (&o)[2]) {
    bf16x8 pk[2];
#pragma unroll
    for (int s = 0; s < 2; ++s) { u32x4 t; t.x = cvtpk(p[8 * s], p[8 * s + 1]); t.y = cvtpk(p[8 * s + 2], p[8 * s + 3]); t.z = cvtpk(p[8 * s + 4], p[8 * s + 5]); t.w = cvtpk(p[8 * s + 6], p[8 * s + 7]); pk[s] = __builtin_bit_cast(bf16x8, t); }
    LAS unsigned char* vb = w.lds + buf * L_BUF + 8192 + w.vlo;
#pragma unroll
    for (int db = 0; db < 2; ++db)
#pragma unroll
        for (int s = 0; s < 2; ++s) { LAS unsigned char* vp = vb + db * 4096 + (4 * sub + 2 * s) * 512;
            const s16x4 lo = vtr(vp), hh = vtr(vp + 512);
            const bf16x8 vf = __builtin_shufflevector(lo, hh, 0, 1, 2, 3, 4, 5, 6, 7);
            o[db] = ATT_MFMA(pk[s], vf, o[db]); }
}
struct VFrags { s16x4 f[2][2][2]; };
__device__ __forceinline__ void load_vfrags(const Wave& w, int buf, int sub, VFrags& v) {
    LAS unsigned char* vb = w.lds + buf * L_BUF + 8192 + w.vlo;
#pragma unroll
    for (int db = 0; db < 2; ++db)
#pragma unroll
        for (int s = 0; s < 2; ++s) { LAS unsigned char* vp = vb + db * 4096 + (4 * sub + 2 * s) * 512; v.f[db][s][0] = vtr(vp); v.f[db][s][1] = vtr(vp + 512); }
}
__device__ __forceinline__ void pv_frags(const VFrags& v, const f32x16& p, f32x16 (&o)[2]) {
    bf16x8 pk[2];
#pragma unroll
    for (int s = 0; s < 2; ++s) { u32x4 t; t.x = cvtpk(p[8 * s], p[8 * s + 1]); t.y = cvtpk(p[8 * s + 2], p[8 * s + 3]); t.z = cvtpk(p[8 * s + 4], p[8 * s + 5]); t.w = cvtpk(p[8 * s + 6], p[8 * s + 7]); pk[s] = __builtin_bit_cast(bf16x8, t); }
#pragma unroll
    for (int db = 0; db < 2; ++db)
#pragma unroll
        for (int s = 0; s < 2; ++s) { const bf16x8 vf = __builtin_shufflevector(v.f[db][s][0], v.f[db][s][1], 0, 1, 2, 3, 4, 5, 6, 7); o[db] = ATT_MFMA(pk[s], vf, o[db]); }
}
__device__ __forceinline__ void scale_rows(const Wave& w, f32x16 (&o)[2], float f) {
    if (w.hi == 0) w.wsf[w.r32] = f;
#pragma unroll
    for (int g = 0; g < 4; ++g) { const f32x4 fv = *(LAS f32x4*)(w.wsf + 8 * g + 4 * w.hi);
#pragma unroll
        for (int i = 0; i < 4; ++i) { o[0][4 * g + i] *= fv[i]; o[1][4 * g + i] *= fv[i]; } }
}
__device__ __forceinline__ void softmax_sub(const Wave& w, f32x16& s, float& m, float& lsum, f32x16 (&o)[2]) {
    float tm = fmaxf(fmaxf(s[0], s[1]), fmaxf(s[2], s[3]));
#pragma unroll
    for (int r = 4; r < 16; r += 4) tm = fmaxf(tm, fmaxf(fmaxf(s[r], s[r + 1]), fmaxf(s[r + 2], s[r + 3])));
    tm = max_xor32(tm);
    const float mn = fmaxf(m, tm);
    if (__any(mn > m)) { const float al = __builtin_amdgcn_exp2f(m - mn); lsum *= al; scale_rows(w, o, al); m = mn; }
    float acc = 0.f;
#pragma unroll
    for (int r = 0; r < 16; ++r) { s[r] = __builtin_amdgcn_exp2f(s[r] - m); acc += s[r]; }
    lsum += acc;
}
__device__ __forceinline__ void mask_band(f32x16& s, int delta0, int W) {
#pragma unroll
    for (int r = 0; r < 16; ++r) { const int dl = delta0 - ((r & 3) + 8 * (r >> 2)); if ((unsigned)dl > (unsigned)W) s[r] = -INFINITY; }
}
constexpr float SM_THR = 8.0f;
struct SubDesc { bool act; int delta; int W; };
template <int NSUB>
__device__ __forceinline__ void softmax_step(const Wave& w, int buf, const bf16x8 (&qf)[4], const bf16x8& kidx, const bf16x8& slp, float slope, const SubDesc (&sd)[NSUB],
                                             float& m, float& lsum, f32x16 (&o)[2], bool& first) {
    f32x16 s[NSUB];
    bool any_act = false;
#pragma unroll
    for (int i = 0; i < NSUB; ++i) if (sd[i].act) { any_act = true; s[i] = qk_sub(w, buf, i, qf, -slope * (float)sd[i].delta - m); s[i] = ATT_MFMA(kidx, slp, s[i]); }
    if (!any_act) return;
    float tm = -INFINITY;
#pragma unroll
    for (int i = 0; i < NSUB; ++i) if (sd[i].act) {
        if (sd[i].W >= 0) mask_band(s[i], sd[i].delta - 4 * w.hi, sd[i].W);
        float t = fmaxf(fmaxf(s[i][0], s[i][1]), fmaxf(s[i][2], s[i][3]));
#pragma unroll
        for (int r = 4; r < 16; r += 4) t = fmaxf(t, fmaxf(fmaxf(s[i][r], s[i][r + 1]), fmaxf(s[i][r + 2], s[i][r + 3])));
        tm = fmaxf(tm, t); }
    tm = max_xor32(tm);
    if (first || __any(tm > SM_THR)) {
        const float d = first ? (tm > -1.0e30f ? tm : 0.f) : fmaxf(tm, 0.f);
#pragma unroll
        for (int i = 0; i < NSUB; ++i) if (sd[i].act) {
#pragma unroll
            for (int r = 0; r < 16; ++r) s[i][r] -= d; }
        if (!first) { const float al = __builtin_amdgcn_exp2f(-d); lsum *= al; scale_rows(w, o, al); }
        m += d; first = false;
    }
    VFrags vf[NSUB];
#pragma unroll
    for (int i = 0; i < NSUB; ++i) if (sd[i].act) load_vfrags(w, buf, i, vf[i]);
#pragma unroll
    for (int i = 0; i < NSUB; ++i) if (sd[i].act) { float acc = 0.f;
#pragma unroll
        for (int r = 0; r < 16; ++r) { s[i][r] = __builtin_amdgcn_exp2f(s[i][r]); acc += s[i][r]; }
        lsum += acc; }
#pragma unroll
    for (int i = 0; i < NSUB; ++i) if (sd[i].act) pv_frags(vf[i], s[i], o);
}
__device__ __forceinline__ void bias_frags(const Wave& w, float slope, bf16x8& kidx, bf16x8& slp) {
    const unsigned kb = f2bf((float)w.r32), sh = f2bf(slope), sl = f2bf(slope - __builtin_bit_cast(float, sh << 16));
    const u32x4 a = {w.hi == 0 ? (kb | (kb << 16)) : 0u, 0u, 0u, 0u}, b = {w.hi == 0 ? (sh | (sl << 16)) : 0u, 0u, 0u, 0u};
    kidx = __builtin_bit_cast(bf16x8, a); slp = __builtin_bit_cast(bf16x8, b);
}
template <class RowO> __device__ __forceinline__ void store_o(const Wave& w, const f32x16 (&o)[2], const RowO& rowo) {
    LAS unsigned short* stg = (LAS unsigned short*)w.ost;
#pragma unroll
    for (int r = 0; r < 16; ++r) { const int q = (r & 3) + 8 * (r >> 2) + 4 * w.hi;
#pragma unroll
        for (int db = 0; db < 2; ++db) stg[q * 64 + db * 32 + w.r32] = (unsigned short)f2bf(o[db][r]); }
#pragma unroll
    for (int i = 0; i < 4; ++i) { const int row = i * 8 + (w.lane >> 3), ch = w.lane & 7; const u32x4 v = *(LAS u32x4*)((LAS unsigned char*)stg + row * 128 + ch * 16);
        bf16_t* dst = rowo(row); if (dst) *(u32x4*)(dst + ch * 8) = v; }
}
__device__ __forceinline__ void load_q(bf16x8 (&qf)[4], const bf16_t* qrow, int hi) {
#pragma unroll
    for (int ks = 0; ks < 4; ++ks) qf[ks] = *(const bf16x8*)(qrow + 16 * ks + 8 * hi);
}

constexpr int W_WSF = 98304, W_OST = W_WSF + 2048, W_ENUM = W_OST + 32768;
template <int NC> struct Pref { u32x4 k[NC], v[NC]; bf16x8 q[4]; };
template <int NC, class RowF> __device__ __forceinline__ void win_issue(Pref<NC>& P, const Wave& w, const bf16_t* kbase, const bf16_t* vbase, const RowF& rowoff, const bf16_t* qrow) {
#pragma unroll
    for (int c = 0; c < NC; ++c) { P.k[c] = *(const u32x4*)(kbase + rowoff(64 * c + 8 * w.wid + (w.lane >> 3)) + (w.lane & 7) * 8);
        P.v[c] = *(const u32x4*)(vbase + rowoff(64 * c + 16 * (w.wid & 3) + (w.lane >> 2)) + (w.wid >> 2) * 32 + (w.lane & 3) * 8); }
    load_q(P.q, qrow, w.hi);
}
template <int NC> __device__ __forceinline__ void win_commit(const Pref<NC>& P, const Wave& w) {
    constexpr int NK = 64 * NC;
#pragma unroll
    for (int c = 0; c < NC; ++c) { const int key = 64 * c + 8 * w.wid + (w.lane >> 3);
        *(LAS u32x4*)(w.lds + key * 128 + ((((w.lane & 7) ^ (key >> 1)) & 7) * 16)) = P.k[c];
        *(LAS u32x4*)(w.lds + NK * 128 + (w.wid >> 2) * (NK * 64) + (8 * c + 2 * (w.wid & 3)) * 512 + w.lane * 16) = P.v[c]; }
}
template <int NK> __device__ __forceinline__ f32x16 qk_win(const Wave& w, int u, const bf16x8 (&qf)[4], float init) {
    f32x16 acc;
#pragma unroll
    for (int r = 0; r < 16; ++r) acc[r] = init;
    LAS unsigned char* kp = w.lds + (32 * u + w.r32) * 128; const int x = (w.r32 >> 1) & 7;
#pragma unroll
    for (int ks = 0; ks < 4; ++ks) { const bf16x8 kf = *(LAS bf16x8*)(kp + (((2 * ks + w.hi) ^ x) * 16)); acc = ATT_MFMA(kf, qf[ks], acc); }
    return acc;
}
template <int NK> __device__ __forceinline__ void load_vfrags_win(const Wave& w, int u, VFrags& v) {
    LAS unsigned char* vb = w.lds + NK * 128 + w.vlo;
#pragma unroll
    for (int db = 0; db < 2; ++db)
#pragma unroll
        for (int s = 0; s < 2; ++s) { LAS unsigned char* vp = vb + db * (NK * 64) + (4 * u + 2 * s) * 512; v.f[db][s][0] = vtr(vp); v.f[db][s][1] = vtr(vp + 512); }
}
struct WSub { bool act; int u; int delta; int W; };
template <int NK>
__device__ __forceinline__ void softmax_win(const Wave& w, const bf16x8 (&qf)[4], const bf16x8& kidx, const bf16x8& slp, float slope, const WSub (&sd)[2], float& m, float& lsum, f32x16 (&o)[2], bool& first) {
    f32x16 s[2];
    bool any_act = false;
#pragma unroll
    for (int i = 0; i < 2; ++i) if (sd[i].act) { any_act = true; s[i] = qk_win<NK>(w, sd[i].u, qf, -slope * (float)sd[i].delta - m); s[i] = ATT_MFMA(kidx, slp, s[i]); }
    if (!any_act) return;
    float tm = -INFINITY;
#pragma unroll
    for (int i = 0; i < 2; ++i) if (sd[i].act) {
        if (sd[i].W >= 0) mask_band(s[i], sd[i].delta - 4 * w.hi, sd[i].W);
        float t = fmaxf(fmaxf(s[i][0], s[i][1]), fmaxf(s[i][2], s[i][3]));
#pragma unroll
        for (int r = 4; r < 16; r += 4) t = fmaxf(t, fmaxf(fmaxf(s[i][r], s[i][r + 1]), fmaxf(s[i][r + 2], s[i][r + 3])));
        tm = fmaxf(tm, t); }
    tm = max_xor32(tm);
    if (first || __any(tm > SM_THR)) {
        const float d = first ? (tm > -1.0e30f ? tm : 0.f) : fmaxf(tm, 0.f);
#pragma unroll
        for (int i = 0; i < 2; ++i) if (sd[i].act) {
#pragma unroll
            for (int r = 0; r < 16; ++r) s[i][r] -= d; }
        if (!first) { const float al = __builtin_amdgcn_exp2f(-d); lsum *= al; scale_rows(w, o, al); }
        m += d; first = false;
    }
#pragma unroll
    for (int i = 0; i < 2; ++i) if (sd[i].act) { VFrags vf; load_vfrags_win<NK>(w, sd[i].u, vf);
        float acc = 0.f;
#pragma unroll
        for (int r = 0; r < 16; ++r) { s[i][r] = __builtin_amdgcn_exp2f(s[i][r]); acc += s[i][r]; }
        lsum += acc;
        pv_frags(vf, s[i], o); }
}

__device__ __forceinline__ size_t ql_off(int bh, int j) { return (size_t)bh * QL_PER_BH + (size_t)(8192 * j - 128 * j * (j + 1)); }
__device__ __forceinline__ float* lsem_ptr(float* l0, float* l1, int slot) { return (slot < 2 ? l0 : l1) + (size_t)(slot & 1) * T * 4; }

struct Top3 { int i0, i1, i2; };
__device__ __forceinline__ Top3 moba_top3(const Wave& w, const bf16x8 (&qf)[4], const float* KMEAN, int b, int h, int own) {
    int i0 = -1, i1 = -1, i2 = -1;
    if (own > 0) {
    f32x16 g;
#pragma unroll
    for (int r = 0; r < 16; ++r) g[r] = 0.f;
    const float* km = KMEAN + ((size_t)(b * 4 + h) * 32 + w.r32) * HD + 8 * w.hi;
#pragma unroll
    for (int ks = 0; ks < 4; ++ks) { const f32x4 a0 = *(const f32x4*)(km + 16 * ks), a1 = *(const f32x4*)(km + 16 * ks + 4);
        const float x[8] = {a0.x, a0.y, a0.z, a0.w, a1.x, a1.y, a1.z, a1.w}; unsigned hw[4], lw[4];
#pragma unroll
        for (int j = 0; j < 4; ++j) { const unsigned h0 = f2bf(x[2 * j]), h1 = f2bf(x[2 * j + 1]); hw[j] = h0 | (h1 << 16);
            lw[j] = pk2(x[2 * j] - __builtin_bit_cast(float, h0 << 16), x[2 * j + 1] - __builtin_bit_cast(float, h1 << 16)); }
        const u32x4 hv = {hw[0], hw[1], hw[2], hw[3]}, lv = {lw[0], lw[1], lw[2], lw[3]};
        g = ATT_MFMA(__builtin_bit_cast(bf16x8, hv), qf[ks], g); g = ATT_MFMA(__builtin_bit_cast(bf16x8, lv), qf[ks], g); }
    float v0 = -INFINITY, v1 = -INFINITY, v2 = -INFINITY;
#pragma unroll
    for (int r = 0; r < 16; ++r) { const int blk = (r & 3) + 8 * (r >> 2) + 4 * w.hi; const float val = (blk < own) ? g[r] : -INFINITY;
        if (val > v0) { v2 = v1; i2 = i1; v1 = v0; i1 = i0; v0 = val; i0 = blk; } else if (val > v1) { v2 = v1; i2 = i1; v1 = val; i1 = blk; } else if (val > v2) { v2 = val; i2 = blk; } }
    const float pv_[3] = {get_xor32(v0, w.hi), get_xor32(v1, w.hi), get_xor32(v2, w.hi)}; const int pi_[3] = {get_xor32i(i0, w.hi), get_xor32i(i1, w.hi), get_xor32i(i2, w.hi)};
#pragma unroll
    for (int k = 0; k < 3; ++k) { const float val = pv_[k]; const int blk = pi_[k];
        if (val > v0 || (val == v0 && blk < i0)) { v2 = v1; i2 = i1; v1 = v0; i1 = i0; v0 = val; i0 = blk; }
        else if (val > v1 || (val == v1 && blk < i1)) { v2 = v1; i2 = i1; v1 = val; i1 = blk; }
        else if (val > v2 || (val == v2 && blk < i2)) { v2 = val; i2 = blk; } }
    }
    Top3 t; t.i0 = i0; t.i1 = i1; t.i2 = i2; return t;
}
__device__ __forceinline__ void moba_gate_unit(LAS unsigned char* lds, const bf16_t* QB, const float* KMEAN, unsigned* mcnt, unsigned* qlist, bf16_t* PM, float* LSEM0, float* LSEM1, int b, int h, int own, int tid) {
    const Wave w = make_wave(lds, tid);
    const size_t rowbase = (size_t)b * SEQ; const int qpos = own * 256 + 32 * w.wid + w.r32, bh = b * 4 + h;
    bf16x8 qf[4]; load_q(qf, QB + (rowbase + qpos) * DM + h * HD, w.hi);
    const Top3 t3 = moba_top3(w, qf, KMEAN, b, h, own); const int s0 = t3.i0, s1 = t3.i1, s2 = t3.i2;
    LAS unsigned* cl = (LAS unsigned*)(lds + W_ENUM);
    if (tid < 64) cl[tid] = 0u;
    __syncthreads();
    unsigned r0 = 0u, r1 = 0u, r2 = 0u;
    if (w.hi == 0) {
        if (s0 >= 0) r0 = __hip_atomic_fetch_add(cl + s0, 1u, __ATOMIC_RELAXED, __HIP_MEMORY_SCOPE_WORKGROUP);
        if (s1 >= 0) r1 = __hip_atomic_fetch_add(cl + s1, 1u, __ATOMIC_RELAXED, __HIP_MEMORY_SCOPE_WORKGROUP);
        if (s2 >= 0) r2 = __hip_atomic_fetch_add(cl + s2, 1u, __ATOMIC_RELAXED, __HIP_MEMORY_SCOPE_WORKGROUP);
    }
    __syncthreads();
    if (tid < 32) { const unsigned c = cl[tid]; cl[32 + tid] = c ? __hip_atomic_fetch_add(mcnt + bh * 32 + tid, c, __ATOMIC_RELAXED, __HIP_MEMORY_SCOPE_AGENT) : 0u; }
    __syncthreads();
    if (w.hi == 0) {
        const size_t tok = rowbase + qpos;
#define MOBA_EMIT(k, sk, rk) do { if (sk >= 0) qlist[ql_off(bh, sk) + cl[32 + sk] + rk] = (unsigned)qpos | ((unsigned)(k) << 13); \
            else { lsem_ptr(LSEM0, LSEM1, k)[tok * 4 + h] = -1.0e30f;          \
                u32x4* pz = (u32x4*)(PM + ((size_t)(k) * T + tok) * 256 + h * HD); const u32x4 z4 = {0u, 0u, 0u, 0u}; \
                _Pragma("unroll") for (int c = 0; c < 8; ++c) pz[c] = z4; } } while (0)
        MOBA_EMIT(0, s0, r0); MOBA_EMIT(1, s1, r1); MOBA_EMIT(2, s2, r2);
#undef MOBA_EMIT
    }
    __syncthreads();
}
struct OwnU { int b, h, own; };
__device__ __forceinline__ void own_issue(Pref<4>& P, const Wave& w, const OwnU& u, const bf16_t* QB, const bf16_t* KB, const bf16_t* VB) {
    const size_t rowbase = (size_t)u.b * SEQ; const int q0 = u.own * 256;
    win_issue<4>(P, w, KB + (rowbase + q0) * DM + u.h * HD, VB + (rowbase + q0) * DM + u.h * HD, [&](int key) { return (size_t)key * DM; }, QB + (rowbase + q0 + 32 * w.wid + w.r32) * DM + u.h * HD);
}
__device__ __forceinline__ void own_compute(const Wave& w, const OwnU& u, const bf16x8 (&qf)[4], bf16_t* OB, float* LSEM0, float* LSEM1) {
    const size_t rowbase = (size_t)u.b * SEQ; const int q0 = u.own * 256, ql = 32 * w.wid + w.r32;
    const float slope2 = exp2f(-2.0f * (float)(u.h + 1)) * LOG2E;
    bf16x8 kidx, slp; bias_frags(w, slope2, kidx, slp);
    f32x16 o[2];
#pragma unroll
    for (int r = 0; r < 16; ++r) { o[0][r] = 0.f; o[1][r] = 0.f; }
    float m = 0.f, lsum = 0.f; bool first = true;
#pragma unroll
    for (int p = 0; p < 4; ++p) { WSub sd[2];
#pragma unroll
        for (int i = 0; i < 2; ++i) { const int su = w.wid - 2 * p - i; sd[i].act = su >= 0; sd[i].u = su; sd[i].delta = ql - 32 * su; sd[i].W = (su == w.wid) ? 0x7fffffff : -1; }
        softmax_win<256>(w, qf, kidx, slp, slope2, sd, m, lsum, o, first); }
    const float l = sum_xor32(lsum);
    scale_rows(w, o, 1.0f / l);
    bf16_t* orow = OB + (rowbase + q0 + 32 * w.wid) * DM + u.h * HD;
    store_o(w, o, [&](int r) { return orow + (size_t)r * DM; });
    if (w.hi == 0) lsem_ptr(LSEM0, LSEM1, 3)[(rowbase + q0 + ql) * 4 + u.h] = m + __builtin_amdgcn_logf(l);
}
struct GatU { int b, h, j, cnt, chunk; const unsigned* ql; };
__device__ __forceinline__ unsigned gat_entry(const Wave& w, const GatU& u, bool& valid) { const int idx = u.chunk * 256 + 32 * w.wid + w.r32; valid = idx < u.cnt; return u.ql[valid ? idx : u.chunk * 256]; }
__device__ __forceinline__ void gat_issue(Pref<4>& P, const Wave& w, const GatU& u, const bf16_t* QB, const bf16_t* KB, const bf16_t* VB) {
    const size_t rowbase = (size_t)u.b * SEQ; bool valid; const unsigned e = gat_entry(w, u, valid);
    win_issue<4>(P, w, KB + (rowbase + u.j * 256) * DM + u.h * HD, VB + (rowbase + u.j * 256) * DM + u.h * HD, [&](int key) { return (size_t)key * DM; }, QB + (rowbase + (e & 8191u)) * DM + u.h * HD);
}
__device__ __forceinline__ void gat_compute(const Wave& w, const GatU& u, const bf16x8 (&qf)[4], bf16_t* PM, float* LSEM0, float* LSEM1) {
    const size_t rowbase = (size_t)u.b * SEQ; bool valid; const unsigned e = gat_entry(w, u, valid);
    const int qpos = (int)(e & 8191u), slot = (int)(e >> 13);
    const float slope2 = exp2f(-2.0f * (float)(u.h + 1)) * LOG2E;
    bf16x8 kidx, slp; bias_frags(w, slope2, kidx, slp);
    f32x16 o[2];
#pragma unroll
    for (int r = 0; r < 16; ++r) { o[0][r] = 0.f; o[1][r] = 0.f; }
    float m = 0.f, lsum = 0.f; bool first = true;
#pragma unroll
    for (int p = 0; p < 4; ++p) { WSub sd[2];
#pragma unroll
        for (int i = 0; i < 2; ++i) { const int su = 7 - 2 * p - i; sd[i].act = true; sd[i].u = su; sd[i].delta = qpos - (u.j * 256 + 32 * su); sd[i].W = -1; }
        softmax_win<256>(w, qf, kidx, slp, slope2, sd, m, lsum, o, first); }
    const float l = sum_xor32(lsum);
    scale_rows(w, o, l > 0.f ? 1.0f / l : 0.f);
    LAS int* code = (LAS int*)(w.wsf + 32);
    if (w.hi == 0) code[w.r32] = valid ? (int)((size_t)slot * T + rowbase + qpos) : -1;
    store_o(w, o, [&](int r) { const int c = code[r]; return c >= 0 ? PM + (size_t)c * 256 + u.h * HD : (bf16_t*)nullptr; });
    if (w.hi == 0 && valid) lsem_ptr(LSEM0, LSEM1, slot)[(rowbase + qpos) * 4 + u.h] = l > 0.f ? m + __builtin_amdgcn_logf(l) : -1.0e30f;
}

__device__ __forceinline__ void sb_unit(LAS unsigned char* lds, const bf16_t* QB, const bf16_t* KB, const bf16_t* VB, bf16_t* OB, int b, int h, int qt, int tid) {
    const Wave w = make_wave(lds, tid);
    const size_t rowbase = (size_t)b * SEQ; const int q0 = qt * 256, qpos = q0 + 32 * w.wid + w.r32;
    const bf16_t* kh = KB + rowbase * DM + h * HD; const bf16_t* vh = VB + rowbase * DM + h * HD;
    bf16x8 qf[4]; load_q(qf, QB + (rowbase + qpos) * DM + h * HD, w.hi);
    f32x16 o[2];
#pragma unroll
    for (int r = 0; r < 16; ++r) { o[0][r] = 0.f; o[1][r] = 0.f; }
    float carry = 0.f;
    bool done = false;
    volatile LAS unsigned* flg = (volatile LAS unsigned*)(lds + L_FLG);
    const int ti0 = q0 / 64 + 3;
    Stage sg;
    { const int kp = ti0 * 64; stage_load(sg, w, [&](int key) { return kh + (size_t)(kp + key) * DM; }, [&](int key) { return vh + (size_t)(kp + key) * DM; }); }
    stage_write(sg, w, 0);
    __syncthreads();
    for (int st = 0;; ++st) {
        const int buf = st & 1, ti = ti0 - st;
        if (ti > 0) { const int kp = (ti - 1) * 64; stage_load(sg, w, [&](int key) { return kh + (size_t)(kp + key) * DM; }, [&](int key) { return vh + (size_t)(kp + key) * DM; }); }
        if (!done) {
#pragma unroll
            for (int sub = 1; sub >= 0; --sub) {
                const int D = (q0 / 32 + w.wid) - (2 * ti + sub);
                if (D < 0) continue;
                const int delta0 = qpos - (64 * ti + 32 * sub) - 4 * w.hi;
                f32x16 z = qk_sub(w, buf, sub, qf, 0.f);
                f32x16 L;
#pragma unroll
                for (int r = 0; r < 16; ++r) { const float lp = __builtin_amdgcn_logf(1.0f + __builtin_amdgcn_exp2f(-fabsf(z[r]))); L[r] = -(fmaxf(z[r], 0.f) + lp); }
                if (D == 0) {
#pragma unroll
                    for (int r = 0; r < 16; ++r) { const int dl = delta0 - ((r & 3) + 8 * (r >> 2)); if (dl < 1) { L[r] = 0.f; z[r] = -INFINITY; } }
                }
                float G[4], PG[4];
#pragma unroll
                for (int g = 0; g < 4; ++g) { G[g] = (L[4 * g] + L[4 * g + 1]) + (L[4 * g + 2] + L[4 * g + 3]); PG[g] = get_xor32(G[g], w.hi); }
                float run = carry;
#pragma unroll
                for (int g = 3; g >= 0; --g) { const float t3 = run + (w.hi == 0 ? PG[g] : 0.f), t2 = t3 + L[4 * g + 3], t1 = t2 + L[4 * g + 2], t0 = t1 + L[4 * g + 1];
                    z[4 * g + 3] = __builtin_amdgcn_exp2f(z[4 * g + 3] + L[4 * g + 3] + t3); z[4 * g + 2] = __builtin_amdgcn_exp2f(z[4 * g + 2] + L[4 * g + 2] + t2);
                    z[4 * g + 1] = __builtin_amdgcn_exp2f(z[4 * g + 1] + L[4 * g + 1] + t1); z[4 * g] = __builtin_amdgcn_exp2f(z[4 * g] + L[4 * g] + t0);
                    run += G[g] + PG[g]; }
                carry = run;
                pv_sub(w, buf, sub, z, o);
            }
            done = __all(carry < -150.f);
        }
        if (w.lane == 0) flg[buf * 8 + w.wid] = done ? 1u : 0u;
        if (ti > 0) stage_write(sg, w, buf ^ 1);
        __syncthreads();
        unsigned all = 1u;
#pragma unroll
        for (int k = 0; k < 8; ++k) all &= flg[buf * 8 + k];
        if (all || ti == 0) break;
    }
    bf16_t* orow = OB + (rowbase + q0 + 32 * w.wid) * DM + h * HD;
    store_o(w, o, [&](int r) { return orow + (size_t)r * DM; });
    __syncthreads();
}

struct DilU { int b, h, dil, res, i2, c; };
__device__ __forceinline__ DilU dil_decode(int u) { const int n = u & 31, bhc = u >> 5, c = bhc % 3, bh = bhc / 3; DilU d; d.b = bh >> 3; d.h = 8 + (bh & 7); d.c = c;
    d.dil = (c == 0) ? 1 : (c == 1) ? 4 : 16; d.res = (c == 0) ? 0 : (c == 1) ? (n >> 3) : (n >> 1); d.i2 = (c == 0) ? n : (c == 1) ? (n & 7) : (n & 1); return d; }
__device__ __forceinline__ void dil_issue(Pref<6>& P, const Wave& w, const DilU& u, const bf16_t* QB, const bf16_t* KB, const bf16_t* VB) {
    const size_t rowbase = (size_t)u.b * SEQ; const int Q0 = 256 * u.i2, qj = Q0 + 32 * w.wid + w.r32; const size_t rstride = (size_t)u.dil * DM;
    win_issue<6>(P, w, KB + (rowbase + u.res) * DM + u.h * HD, VB + (rowbase + u.res) * DM + u.h * HD,
                 [&](int key) { const int kj = Q0 - 128 + key; return (size_t)(kj < 0 ? 0 : kj) * rstride; },
                 QB + (rowbase + u.res + (size_t)qj * u.dil) * DM + u.h * HD);
}
__device__ __forceinline__ void dil_compute(const Wave& w, const DilU& u, const bf16x8 (&qf)[4], bf16_t* OB, bf16_t* HB2, float* LSE) {
    const size_t rowbase = (size_t)u.b * SEQ; const int Q0 = 256 * u.i2, ql = 32 * w.wid + w.r32;
    const float slope2d = exp2f(-(float)(u.h - 8 + 1)) * LOG2E * (float)u.dil;
    bf16x8 kidx, slp; bias_frags(w, slope2d, kidx, slp);
    f32x16 o[2];
#pragma unroll
    for (int r = 0; r < 16; ++r) { o[0][r] = 0.f; o[1][r] = 0.f; }
    float m = 0.f, lsum = 0.f; bool first = true;
#pragma unroll
    for (int p = 0; p < 3; ++p) { WSub sd[2];
#pragma unroll
        for (int i = 0; i < 2; ++i) { const int D = 2 * p + i, su = w.wid + 4 - D; sd[i].act = (D <= 4) && (Q0 - 128 + 32 * su >= 0); sd[i].u = su; sd[i].delta = ql + 128 - 32 * su; sd[i].W = (D == 0 || D == 4) ? 128 : -1; }
        softmax_win<384>(w, qf, kidx, slp, slope2d, sd, m, lsum, o, first); }
    const float l = sum_xor32(lsum);
    scale_rows(w, o, 1.0f / l);
    bf16_t* PO = (u.c == 0) ? OB + 512 : HB2 + (u.c - 1) * 512;
    const size_t tok0 = rowbase + u.res + (size_t)(Q0 + 32 * w.wid) * u.dil;
    store_o(w, o, [&](int r) { return PO + (tok0 + (size_t)r * u.dil) * DM + (u.h - 8) * HD; });
    if (w.hi == 0) (LSE + (size_t)u.c * T * 8)[(tok0 + (size_t)w.r32 * u.dil) * 8 + (u.h - 8)] = m + __builtin_amdgcn_logf(l);
}

__device__ __forceinline__ void moba_gate_phase(LAS unsigned char* lds, const bf16_t* QB, const float* KMEAN, unsigned* mcnt, unsigned* qlist, bf16_t* PM, float* LSEM0, float* LSEM1, int v, int G, int tid) {
    for (int u = v; u < 512; u += G) { const int own = u & 31, bh = u >> 5; moba_gate_unit(lds, QB, KMEAN, mcnt, qlist, PM, LSEM0, LSEM1, bh >> 2, bh & 3, own, tid); }
}
struct AttnArgs { const bf16_t* QB; const bf16_t* KB; const bf16_t* VB; bf16_t* OB; bf16_t* HB2; float* LSE; const unsigned* mcnt; const unsigned* qlist; bf16_t* PM; float* LSEM0; float* LSEM1; };
__device__ __forceinline__ void attn_phase(LAS unsigned char* lds, const AttnArgs& A, int v, int G, int tid) {
    const Wave w = make_wave(lds, tid, W_WSF, W_OST);
    LAS int* cntl = (LAS int*)(lds + W_ENUM); LAS int* pa = cntl + 512; LAS int* pb = pa + 512;
    const int myc = (int)A.mcnt[tid], myu = (myc + 255) >> 8;
    cntl[tid] = myc; pa[tid] = myu;
    __syncthreads();
#pragma unroll 1
    for (int d = 1; d < 512; d <<= 1) { const int x = pa[tid] + (tid >= d ? pa[tid - d] : 0); pb[tid] = x; __syncthreads(); LAS int* t_ = pa; pa = pb; pb = t_; }
    const int total = pa[511];
    auto gat_decode = [&](int u) { int lo = 0, hi = 511;
        while (lo < hi) { const int mid = (lo + hi) >> 1; if (pa[mid] > u) hi = mid; else lo = mid + 1; }
        const int i = lo, c = cntl[i], bh = i >> 5; GatU g; g.b = bh >> 2; g.h = bh & 3; g.j = i & 31; g.cnt = c; g.chunk = u - (pa[i] - ((c + 255) >> 8)); g.ql = A.qlist + ql_off(bh, g.j); return g; };
    for (int u = v; u < total; u += G) { const GatU cur = gat_decode(u);
        __syncthreads();
        bf16x8 qf[4];
        { Pref<4> P; gat_issue(P, w, cur, A.QB, A.KB, A.VB); win_commit<4>(P, w); qf[0] = P.q[0]; qf[1] = P.q[1]; qf[2] = P.q[2]; qf[3] = P.q[3]; }
        __syncthreads();
        gat_compute(w, cur, qf, A.PM, A.LSEM0, A.LSEM1); }
    for (int u = v; u < 512; u += G) { OwnU cur; { const int bh = u >> 5; cur.b = bh >> 2; cur.h = bh & 3; cur.own = u & 31; }
        __syncthreads();
        bf16x8 qf[4];
        { Pref<4> P; own_issue(P, w, cur, A.QB, A.KB, A.VB); win_commit<4>(P, w); qf[0] = P.q[0]; qf[1] = P.q[1]; qf[2] = P.q[2]; qf[3] = P.q[3]; }
        __syncthreads();
        own_compute(w, cur, qf, A.OB, A.LSEM0, A.LSEM1); }
    for (int u = v; u < 3072; u += G) { const DilU cur = dil_decode(u);
        __syncthreads();
        bf16x8 qf[4];
        { Pref<6> P; dil_issue(P, w, cur, A.QB, A.KB, A.VB); win_commit<6>(P, w); qf[0] = P.q[0]; qf[1] = P.q[1]; qf[2] = P.q[2]; qf[3] = P.q[3]; }
        __syncthreads();
        dil_compute(w, cur, qf, A.OB, A.HB2, A.LSE); }
    __syncthreads();
    for (int u = v; u < 512; u += G) { const int qt = u & 31, bh = u >> 5; sb_unit(lds, A.QB, A.KB, A.VB, A.OB, bh >> 2, 4 + (bh & 3), qt, tid); }
}
}

constexpr int PH_PRO = 0, PH_L0 = 1, PH_PER_LAYER = 10, PH_FINAL = PH_L0 + DEPTH * PH_PER_LAYER, PH_COUNT = PH_FINAL + 1;
typedef const __attribute__((address_space(4))) Args* KArgP;
#define KARG() ({ KArgP p_ = (KArgP)__builtin_amdgcn_kernarg_segment_ptr(); asm volatile("" : "+s"(p_)); p_; })
#define PHASE_IDS int lane_p = (int)__builtin_amdgcn_mbcnt_hi(~0u, __builtin_amdgcn_mbcnt_lo(~0u, 0u)); LAUNDER_V(lane_p); int tid_p = wave * 64 + lane_p; int gw_p = gw; LAUNDER_S(gw_p)
__global__ void __launch_bounds__(NTHREADS, 2) fwd(Args a_unused) {
    extern __shared__ __attribute__((aligned(16))) unsigned char lds_raw[];
    LAS unsigned char* lds = (LAS unsigned char*)lds_raw;
    volatile LAS unsigned* MISC = (volatile LAS unsigned*)(lds + MISC_OFF);
    const int wave = __builtin_amdgcn_readfirstlane((int)threadIdx.x >> 6);
    const int G = gridDim.x, bx = blockIdx.x;
    const int vcu = (G % 8 == 0) ? (bx % 8) * (G / 8) + bx / 8 : bx;
    const int gw = vcu * NWAVES + wave, NGW = G * NWAVES;
    for (int u = threadIdx.x; u < (LDS_BYTES - LDSCTL_OFF) / 4; u += NTHREADS) ((LAS unsigned*)(lds + LDSCTL_OFF))[u] = 0u;
    __syncthreads();
    int lo, hi; XcdBarrier bar;
    { KArgP ka = KARG(); lo = ka->ph_lo; hi = ka->ph_hi; unsigned* ctl = (unsigned*)(ka->ws + WS_CTL); bar = xcd_barrier_post(ctl + CW_BAR + ka->li * XCD_BAR_WORDS, MISC + 8, wave); }
#define IN(k) (lo <= (k) && (k) < hi)
#define SEAM(k) do { if (IN(k) && IN((k) + 1)) xcd_barrier(bar); } while (0)
#define WSP(T_, off) ((T_*)(ws + (off)))

    if (IN(PH_PRO)) { KArgP ka = KARG(); PHASE_IDS; Args a; a.ws = ka->ws; a.w_in = ka->w_in; a.w_out = ka->w_out; a.w_gate = ka->w_gate; a.w_up = ka->w_up; a.w_down = ka->w_down; phase_prologue(a, lds, gw_p, NGW, wave, lane_p); } SEAM(PH_PRO);

    for (int l = 0; l < DEPTH; ++l) {
        const int p0 = PH_L0 + l * PH_PER_LAYER;
        if (hi <= p0 || lo >= p0 + PH_PER_LAYER) continue;
        if (IN(p0 + 0)) for (int rep_ = 0; rep_ < RPT(0); ++rep_) { if (rep_) xcd_barrier(bar); KArgP ka = KARG(); PHASE_IDS; unsigned char* ws = ka->ws; const float* xin = (l == 0) ? ka->x : ka->out;
            phase_norm1(xin, ka->ln1_g + (size_t)l * DM, WSP(bf16_t, WS_HB), gw_p, NGW, lane_p); } SEAM(p0 + 0);
        if (IN(p0 + 1)) for (int rep_ = 0; rep_ < RPT(1); ++rep_) { if (rep_) xcd_barrier(bar); KArgP ka = KARG(); PHASE_IDS; unsigned char* ws = ka->ws;
            pg8::Gemm g{(const char*)(ws + WS_HB), (const char*)(ws + WS_WIN) + (size_t)l * NQKV * DM * 2, DM, DM, DM, (long)256 * DM * 2, (long)256 * DM * 2, (long)128 * DM * 2};
            pg8::StaticOrder S; S.init(T / 256, NQKV / 256, G, bx);
            pg8::EpiQKV E{WSP(bf16_t, WS_Q), (size_t)(WS_K - WS_Q) / 2, QSCALE};
            pg8::gemm_phase<pg8::EpiQKV, pg8::StaticOrder>(lds, g, S, E, wave);
        } SEAM(p0 + 1);
        if (IN(p0 + 2)) { KArgP ka = KARG(); PHASE_IDS; unsigned char* ws = ka->ws; phase_kmean(WSP(bf16_t, WS_K), WSP(float, WS_KMEAN), gw_p, NGW, lane_p); } SEAM(p0 + 2);
        if (IN(p0 + 3)) { KArgP ka = KARG(); PHASE_IDS; unsigned char* ws = ka->ws;
            att::moba_gate_phase(lds, WSP(bf16_t, WS_Q), WSP(float, WS_KMEAN), WSP(unsigned, WS_CTL) + CW_MCNT + l * 512, WSP(unsigned, WS_QLIST), WSP(bf16_t, WS_PM), WSP(float, WS_LSEM0), WSP(float, WS_LSEM1), vcu, G, tid_p);
        } SEAM(p0 + 3);
        if (IN(p0 + 4)) for (int rep_ = 0; rep_ < RPT(4); ++rep_) { if (rep_) xcd_barrier(bar); KArgP ka = KARG(); PHASE_IDS; unsigned char* ws = ka->ws;
            const att::AttnArgs A{WSP(bf16_t, WS_Q), WSP(bf16_t, WS_K), WSP(bf16_t, WS_V), WSP(bf16_t, WS_O), WSP(bf16_t, WS_HB), WSP(float, WS_LSE), WSP(unsigned, WS_CTL) + CW_MCNT + l * 512, WSP(unsigned, WS_QLIST),
                                  WSP(bf16_t, WS_PM), WSP(float, WS_LSEM0), WSP(float, WS_LSEM1)};
            att::attn_phase(lds, A, vcu, G, tid_p);
        } SEAM(p0 + 4);
        if (IN(p0 + 5)) { KArgP ka = KARG(); PHASE_IDS; unsigned char* ws = ka->ws;
            phase_mixnorm(WSP(bf16_t, WS_O), WSP(bf16_t, WS_HB), WSP(float, WS_LSE), WSP(bf16_t, WS_PM), WSP(float, WS_LSEM0), WSP(float, WS_LSEM1), ka->mix_g + (size_t)l * DM, gw_p, NGW, lane_p); } SEAM(p0 + 5);
        if (IN(p0 + 6)) { KArgP ka = KARG(); PHASE_IDS; unsigned char* ws = ka->ws; const float* xin = (l == 0) ? ka->x : ka->out;
            pg8::Gemm g{(const char*)(ws + WS_HB), (const char*)(ws + WS_WOUT) + (size_t)l * DM * DM * 2, DM, DM, DM, (long)256 * DM * 2, (long)256 * DM * 2, (long)128 * DM * 2};
            pg8::StaticOrder S; S.init(T / 256, DM / 256, G, bx);
            pg8::EpiResAdd E{xin, ka->out};
            pg8::gemm_phase<pg8::EpiResAdd, pg8::StaticOrder>(lds, g, S, E, wave);
        } SEAM(p0 + 6);
        if (IN(p0 + 7)) { KArgP ka = KARG(); PHASE_IDS; unsigned char* ws = ka->ws;
            phase_route(ka->out, ka->ln2_g + (size_t)l * DM, ka->w_gr + (size_t)l * DM * 4, ka->b_gr + l * 4, ka->w_er + (size_t)l * 4 * DM * 4, ka->b_er + l * 16, WSP(bf16_t, WS_HB),
                        WSP(unsigned, WS_CTL) + CW_CNT + l * 32, WSP(unsigned, WS_LIST), WSP(float, WS_WLIST), lds, vcu, G, wave, lane_p); } SEAM(p0 + 7);
        if (IN(p0 + 8)) for (int rep_ = 0; rep_ < RPT(8); ++rep_) { if (rep_) xcd_barrier(bar); KArgP ka = KARG(); PHASE_IDS; unsigned char* ws = ka->ws;
            pg8::MoeProb<0> P{WSP(unsigned, WS_CTL) + CW_CNT + l * 32, WSP(unsigned, WS_LIST), (const char*)(ws + WS_HB), (const char*)(ws + WS_WG) + (size_t)l * NACT * DM * 2, DM, DM, DM, (long)(WS_WU - WS_WG), G, vcu};
            pg8::EpiGateUpSparse E{WSP(bf16_t, WS_ACT), WSP(float, WS_WLIST)};
            pg8::gemm_phase_x<pg8::EpiGateUpSparse, pg8::MoeProb<0>>(lds, P, E, wave);
        } SEAM(p0 + 8);
        if (IN(p0 + 9)) { KArgP ka = KARG(); PHASE_IDS; unsigned char* ws = ka->ws;
            pg8::MoeProb<1> P{WSP(unsigned, WS_CTL) + CW_CNT + l * 32, WSP(unsigned, WS_LIST), (const char*)(ws + WS_ACT), (const char*)(ws + WS_WD) + (size_t)l * DM * NACT * 2, 512, NACT, 512, (long)128 * NACT * 2, G, vcu};
            pg8::EpiDownScatter E{ka->out, WSP(unsigned, WS_LIST)};
            pg8::gemm_phase_x<pg8::EpiDownScatter, pg8::MoeProb<1>>(lds, P, E, wave);
        } SEAM(p0 + 9);
    }
    if (IN(PH_FINAL)) { KArgP ka = KARG(); PHASE_IDS; phase_final(ka->out, ka->fin_g, gw_p, NGW, lane_p); }
#undef IN
#undef SEAM
#undef WSP
}

#ifndef N_LAUNCH_MODE
#define N_LAUNCH_MODE 1
#endif
extern "C" void kernel_launch(void* const* d_in, const int* in_sizes, int n_in, void* d_out, int out_size, void* d_ws, size_t ws_size, hipStream_t stream) {
    static int grid = 0;
    if (grid == 0) {
        if (n_in != 14 || in_sizes[0] != T * DM || out_size != T * DM || ws_size < WS_END) { fprintf(stderr, "kernel_launch: unexpected shapes (n_in %d in0 %d out %d ws %zu)\n", n_in, n_in > 0 ? in_sizes[0] : -1, out_size, ws_size); grid = -1; return; }
        int dev = 0, cus = 0, per_cu = 0;
        if (hipGetDevice(&dev) != hipSuccess || hipDeviceGetAttribute(&cus, hipDeviceAttributeMultiprocessorCount, dev) != hipSuccess) { grid = -1; return; }
        if (hipFuncSetAttribute((const void*)fwd, hipFuncAttributeMaxDynamicSharedMemorySize, LDS_BYTES) != hipSuccess) { fprintf(stderr, "kernel_launch: hipFuncSetAttribute failed\n"); grid = -1; return; }
        if (hipOccupancyMaxActiveBlocksPerMultiprocessor(&per_cu, (const void*)fwd, NTHREADS, LDS_BYTES) != hipSuccess || per_cu < 1) fprintf(stderr, "kernel_launch: occupancy query says %d\n", per_cu);
        (void)hipGetLastError();
        grid = cus;
    }
    if (grid < 0) return;
    if (hipMemsetAsync((char*)d_ws + WS_CTL, 0, CTL_ZERO_BYTES, stream) != hipSuccess) return;
    Args a{};
    a.x = (const float*)d_in[0]; a.ln1_g = (const float*)d_in[1]; a.w_in = (const float*)d_in[2]; a.mix_g = (const float*)d_in[3]; a.w_out = (const float*)d_in[4]; a.ln2_g = (const float*)d_in[5];
    a.w_gr = (const float*)d_in[6]; a.b_gr = (const float*)d_in[7]; a.w_er = (const float*)d_in[8]; a.b_er = (const float*)d_in[9]; a.w_gate = (const float*)d_in[10]; a.w_up = (const float*)d_in[11];
    a.w_down = (const float*)d_in[12]; a.fin_g = (const float*)d_in[13];
    a.out = (float*)d_out; a.ws = (unsigned char*)d_ws; a.pad = 0;
#if N_LAUNCH_MODE == 1
    a.ph_lo = 0; a.ph_hi = PH_COUNT; a.li = 0;
    hipLaunchKernelGGL(fwd, dim3(grid), dim3(NTHREADS), LDS_BYTES, stream, a);
#else
    for (int p = 0; p < PH_COUNT; ++p) { a.ph_lo = p; a.ph_hi = p + 1; a.li = p; hipLaunchKernelGGL(fwd, dim3(grid), dim3(NTHREADS), LDS_BYTES, stream, a); }
#endif
}
```

```cpp
#include <hip/hip_runtime.h>
#include <cstdio>
#include <cstdint>

#define LAS __attribute__((address_space(3)))
#define GAS __attribute__((address_space(1)))
typedef unsigned short bf16_t;
typedef short bf16x8 __attribute__((ext_vector_type(8)));
typedef float f32x4 __attribute__((ext_vector_type(4)));
typedef float f32x2 __attribute__((ext_vector_type(2)));
typedef unsigned u32x4 __attribute__((ext_vector_type(4)));
typedef unsigned u32x2 __attribute__((ext_vector_type(2)));

#ifndef PROBE_REPEAT
#define PROBE_REPEAT 0
#endif
#define RPT(k) ((((PROBE_REPEAT) >> (k)) & 1) ? 2 : 1)
#ifndef MOE_SPARSE
#define MOE_SPARSE 1
#endif
#ifndef ATT_MOBA
#define ATT_MOBA 1
#endif
#ifndef ATT_SB
#define ATT_SB 1
#endif
#ifndef ATT_DIL
#define ATT_DIL 1
#endif
constexpr int BATCH = 4, SEQ = 8192, DM = 1024, DEPTH = 4, T = BATCH * SEQ, NH = 16, HD = 64;
constexpr int NQKV = 3 * DM, NEXP = 16, DEXP = 256, NACT = NEXP * DEXP;
constexpr float NORM_EPS = 1e-6f;
constexpr float LOG2E = 1.4426950408889634f;
constexpr float QSCALE = 0.125f * LOG2E;
constexpr int NWAVES = 8, NTHREADS = 512;

constexpr size_t MiB = 1u << 20;
constexpr size_t WS_CTL = 0, CTL_ZERO_BYTES = 1 * MiB;
constexpr size_t WS_WIN = 2 * MiB;
constexpr size_t WS_WOUT = 26 * MiB;
constexpr size_t WS_WG = 34 * MiB;
constexpr size_t WS_WU = 66 * MiB;
constexpr size_t WS_WD = 98 * MiB;
constexpr size_t WS_LSEM0 = 1 * MiB;
constexpr size_t WS_KMEAN = 130 * MiB;
constexpr size_t WS_HB = 131 * MiB;
constexpr size_t WS_Q = 195 * MiB, WS_K = 259 * MiB, WS_V = 323 * MiB, WS_O = 387 * MiB;
constexpr size_t WS_ACT = WS_Q;
constexpr size_t WS_LSE = 451 * MiB;
constexpr size_t WS_LIST = 454 * MiB;
constexpr size_t WS_WLIST = 457 * MiB;
constexpr size_t WS_QLIST = WS_LIST;
constexpr size_t WS_PM = 463 * MiB;
constexpr size_t WS_LSEM1 = 511 * MiB;
constexpr size_t WS_END = 512 * MiB;
constexpr int QL_PER_BH = 126976;
constexpr int CW_MCNT = 2048;
constexpr int CW_CNT = 1024;
constexpr int CW_TCNT = 16384;
constexpr int CW_BAR = 4096;

constexpr int RING_BYTES = 131072;
constexpr int LDSCTL_OFF = 147456, MISC_OFF = LDSCTL_OFF + 320;
constexpr int LDS_BYTES = 148480;

__device__ __forceinline__ unsigned f2bf(float f) { unsigned u = __builtin_bit_cast(unsigned, f); return (u + 0x7fffu + ((u >> 16) & 1u)) >> 16; }
__device__ __forceinline__ unsigned pk2(float lo, float hi) { return f2bf(lo) | (f2bf(hi) << 16); }
__device__ __forceinline__ float bflo(unsigned w) { return __builtin_bit_cast(float, w << 16); }
__device__ __forceinline__ float bfhi(unsigned w) { return __builtin_bit_cast(float, w & 0xffff0000u); }
template <int M> __device__ __forceinline__ float swz_xor(float v) { return __builtin_bit_cast(float, __builtin_amdgcn_ds_swizzle(__builtin_bit_cast(int, v), 0x1f | (M << 10))); }
__device__ __forceinline__ void swap32(unsigned x, unsigned& lo_val, unsigned& hi_val) { unsigned y = x; asm volatile("" : "+v"(y)); auto rr = __builtin_amdgcn_permlane32_swap(x, y, false, false); lo_val = rr[0]; hi_val = rr[1]; }
__device__ __forceinline__ float sum_xor32(float v) { unsigned a, b; swap32(__builtin_bit_cast(unsigned, v), a, b); return __builtin_bit_cast(float, a) + __builtin_bit_cast(float, b); }
__device__ __forceinline__ float max_xor32(float v) { unsigned a, b; swap32(__builtin_bit_cast(unsigned, v), a, b); return fmaxf(__builtin_bit_cast(float, a), __builtin_bit_cast(float, b)); }
__device__ __forceinline__ float get_xor32(float v, int hi) { unsigned a, b; swap32(__builtin_bit_cast(unsigned, v), a, b); return __builtin_bit_cast(float, hi ? a : b); }
__device__ __forceinline__ int get_xor32i(int v, int hi) { unsigned a, b; swap32((unsigned)v, a, b); return (int)(hi ? a : b); }
template <int CTRL> __device__ __forceinline__ float dpp_mov(float v) { return __builtin_bit_cast(float, __builtin_amdgcn_update_dpp(0, __builtin_bit_cast(int, v), CTRL, 0xf, 0xf, false)); }
__device__ __forceinline__ float row_sum(float v) { v += dpp_mov<0xB1>(v); v += dpp_mov<0x4E>(v); v += dpp_mov<0x141>(v); v += dpp_mov<0x140>(v); return v; }
__device__ __forceinline__ float half_sum(float v) { v = row_sum(v); v += swz_xor<16>(v); return v; }
__device__ __forceinline__ float wave_sum(float v) { return sum_xor32(half_sum(v)); }
#define LDS_WAIT() asm volatile("s_waitcnt lgkmcnt(0)" ::: "memory")
#define LAUNDER_V(x) asm volatile("" : "+v"(x))
#define LAUNDER_S(x) asm volatile("" : "+s"(x))

namespace pg8 {
constexpr int BM = 256, BK = 64, HALF = 128, HTB = HALF * BK * 2, STAGE_BYTES = 8 * HTB, NXCD = 8, WGM = 8;
__host__ __device__ __forceinline__ int lds_byte(int r, int c) { const int st = (r >> 4) * 2 + (c >> 5), rr = r & 15, cc = c & 31, ob = rr * 64 + cc * 2; return st * 1024 + (ob ^ (((ob >> 9) & 1) << 5)); }
__host__ __device__ __forceinline__ void stage_rc(int b, int& R, int& C) { const int st = b / 1024, sb = b % 1024, swz = sb ^ (((sb >> 9) & 1) << 5); R = (st >> 1) * 16 + swz / 64; C = (st & 1) * 32 + (swz % 64) / 2; }
__host__ __device__ __forceinline__ int perm32(int rho) { const int n = rho >> 4, i = rho & 15; return 8 * (i >> 2) + 4 * n + (i & 3); }

struct Unit { int pm, pn, meta;
    __device__ __forceinline__ int bk() const { return meta & 31; } __device__ __forceinline__ int tib() const { return (meta >> 5) & 255; } __device__ __forceinline__ int nb() const { return meta >> 13; } };
struct Gemm { const char* A; const char* B; int lda, ldb, K; long tstepA, tstepB, hstepB; };

struct StaticOrder {
    int nM, nN, nwg, G, c;
    __host__ __device__ void init(int nM_, int nN_, int G_, int c_) { nM = nM_; nN = nN_; nwg = nM * nN; G = G_; c = c_; }
    __host__ __device__ bool next(int i, Unit& u) const {
        const long L = (long)i * G + c; if (L >= nwg) return false;
        int wgid = (int)L; { const int q = nwg / NXCD, r = nwg % NXCD, xcd = wgid % NXCD, off = wgid / NXCD; wgid = (xcd < r ? xcd * (q + 1) : r * (q + 1) + (xcd - r) * q) + off; }
        const int nig = WGM * nN, gid = wgid / nig, fm = gid * WGM, gsz = (nM - fm) < WGM ? (nM - fm) : WGM;
        u.pm = fm + ((wgid % nig) % gsz); u.pn = (wgid % nig) / gsz; return true;
    }
};

__device__ __forceinline__ unsigned cvt_pk_bf16(float lo, float hi) { unsigned r; asm volatile("v_cvt_pk_bf16_f32 %0, %1, %2" : "=v"(r) : "v"(lo), "v"(hi)); return r; }

struct EpiQKV {
    static constexpr bool PERM = true;
    bf16_t* O; size_t split_stride; float scale0;
    __device__ __forceinline__ void operator()(const f32x4 (&acc)[2][2][4][2], const Unit& u, int wr, int wc, int fr, int fq) const {
        asm volatile("" : "+v"(fr), "+v"(fq));
        const int row0 = u.pm * BM + wr * 64 + fr; int colt = u.pn * BM;
        const int t = colt / DM; bf16_t* base = O + (size_t)t * split_stride; colt -= t * DM; const float sc = (t == 0) ? scale0 : 1.f;
        const int col0 = colt + wc * 32 + 8 * fq;
#pragma unroll
        for (int ai = 0; ai < 2; ++ai)
#pragma unroll
            for (int m = 0; m < 4; ++m) { bf16_t* rowp = base + (size_t)(row0 + ai * HALF + m * 16) * DM + col0;
#pragma unroll
                for (int bj = 0; bj < 2; ++bj) { f32x4 v0 = acc[ai][bj][m][0] * sc, v1 = acc[ai][bj][m][1] * sc;
                    u32x4 w; w.x = cvt_pk_bf16(v0[0], v0[1]); w.y = cvt_pk_bf16(v0[2], v0[3]); w.z = cvt_pk_bf16(v1[0], v1[1]); w.w = cvt_pk_bf16(v1[2], v1[3]);
                    *(u32x4*)(rowp + bj * HALF) = w; } }
    }
};
struct EpiResAdd {
    static constexpr bool PERM = false;
    const float* base; float* out;
    __device__ __forceinline__ void operator()(const f32x4 (&acc)[2][2][4][2], const Unit& u, int wr, int wc, int fr, int fq) const {
        asm volatile("" : "+v"(fr), "+v"(fq));
        const int col0 = u.pn * BM + wc * 32 + 4 * fq;
#pragma unroll
        for (int ai = 0; ai < 2; ++ai)
#pragma unroll
            for (int m = 0; m < 4; ++m) { const size_t off = (size_t)(u.pm * BM + ai * HALF + wr * 64 + m * 16 + fr) * DM + col0;
#pragma unroll
                for (int bj = 0; bj < 2; ++bj)
#pragma unroll
                    for (int n = 0; n < 2; ++n) { const f32x4 bs = *(const f32x4*)(base + off + bj * HALF + n * 16); *(f32x4*)(out + off + bj * HALF + n * 16) = bs + acc[ai][bj][m][n]; } }
    }
};
struct EpiGateUpDense {
    static constexpr bool PERM = true;
    bf16_t* act; const float* comb;
    __device__ __forceinline__ void operator()(const f32x4 (&acc)[2][2][4][2], const Unit& u, int wr, int wc, int fr, int fq) const {
        asm volatile("" : "+v"(fr), "+v"(fq));
        const int e = u.pn >> 1, c0 = (u.pn & 1) * HALF;
        const int col0 = e * DEXP + c0 + wc * 32 + 8 * fq;
#pragma unroll
        for (int ai = 0; ai < 2; ++ai)
#pragma unroll
            for (int m = 0; m < 4; ++m) { const int row = u.pm * BM + ai * HALF + wr * 64 + m * 16 + fr;
                const float cw = comb[(size_t)row * NEXP + e];
                float o[8];
#pragma unroll
                for (int n = 0; n < 2; ++n)
#pragma unroll
                    for (int j = 0; j < 4; ++j) { const float g = acc[ai][0][m][n][j], up = acc[ai][1][m][n][j];
                        const float sg = g * __builtin_amdgcn_rcpf(1.f + __builtin_amdgcn_exp2f(-g * LOG2E));
                        o[n * 4 + j] = sg * up * cw; }
                u32x4 w; w.x = cvt_pk_bf16(o[0], o[1]); w.y = cvt_pk_bf16(o[2], o[3]); w.z = cvt_pk_bf16(o[4], o[5]); w.w = cvt_pk_bf16(o[6], o[7]);
                *(u32x4*)(act + (size_t)row * NACT + col0) = w; }
    }
};

template <class Epi, class Sched>
__device__ __forceinline__ void gemm_phase(LAS unsigned char* lds, const Gemm g, const Sched& S, const Epi& E, int wave_id) {
    int lane_l = (int)__builtin_amdgcn_mbcnt_hi(~0u, __builtin_amdgcn_mbcnt_lo(~0u, 0u)); asm volatile("" : "+v"(lane_l));
    const int wid = wave_id, lane = lane_l, tid = wid * 64 + lane, wr = wid >> 2, wc = wid & 3, fr = lane & 15, fq = lane >> 4;
    const int K = g.K, nt = K / BK;
    unsigned voffA[2], voffB[2];
#pragma unroll
    for (int i = 0; i < 2; ++i) { int R, C; stage_rc(tid * 16 + i * 8192, R, C); const int Rb = Epi::PERM ? ((R & ~31) + perm32(R & 31)) : R;
        voffA[i] = (unsigned)(R * g.lda + C) * 2u; voffB[i] = (unsigned)(Rb * g.ldb + C) * 2u; }
    const size_t kstep = (size_t)(BK * 2);
    const size_t hstepA = (size_t)HALF * g.lda * 2;
    const long hstepB = g.hstepB;
    const unsigned ldsw = (unsigned)wid * 1024u;
    const int aoff = lds_byte(wr * 64 + fr, fq * 8), boff = lds_byte(wc * 32 + fr, fq * 8);
#define PG8_SA(b, h) (((b) * 2 + (h)) * HTB)
#define PG8_SB(b, h) ((4 + (b) * 2 + (h)) * HTB)
#define PG8_STAGE(bufoff, gbase, voff) do { _Pragma("unroll") for (int _i = 0; _i < 2; ++_i) \
        __builtin_amdgcn_global_load_lds((const unsigned*)((const char*)(gbase) + (voff)[_i]), (LAS unsigned*)(lds + (bufoff) + ldsw + _i * 8192), 16, 0, 0); } while (0)
#define PG8_LDA(dst, b, h) do { _Pragma("unroll") for (int m = 0; m < 4; ++m) _Pragma("unroll") for (int k = 0; k < 2; ++k) dst[m][k] = *(const LAS bf16x8*)(lds + PG8_SA(b, h) + aoff + m * 2048 + k * 1024); } while (0)
#define PG8_LDB(dst, b, h) do { _Pragma("unroll") for (int n = 0; n < 2; ++n) _Pragma("unroll") for (int k = 0; k < 2; ++k) dst[n][k] = *(const LAS bf16x8*)(lds + PG8_SB(b, h) + boff + n * 2048 + k * 1024); } while (0)
#define PG8_MMA(ai, bj, At, Bt) do { __builtin_amdgcn_s_setprio(1); _Pragma("unroll") for (int m = 0; m < 4; ++m) _Pragma("unroll") for (int n = 0; n < 2; ++n) _Pragma("unroll") for (int k = 0; k < 2; ++k) \
        acc[ai][bj][m][n] = __builtin_amdgcn_mfma_f32_16x16x32_bf16(Bt[n][k], At[m][k], acc[ai][bj][m][n], 0, 0, 0); __builtin_amdgcn_s_setprio(0); } while (0)
#define PG8_WAIT_V(n) asm volatile("s_waitcnt vmcnt(" #n ")" ::: "memory")
#define PG8_WAIT_L(n) asm volatile("s_waitcnt lgkmcnt(" #n ")" ::: "memory")
#define PG8_BAR __builtin_amdgcn_s_barrier()
#define PG8_SCHED __builtin_amdgcn_sched_barrier(0)
    Unit cur, nxt; int ui = 0;
    if (!S.next(0, cur)) return;
    f32x4 acc[2][2][4][2];
#pragma unroll
    for (int a = 0; a < 2; ++a)
#pragma unroll
        for (int b = 0; b < 2; ++b)
#pragma unroll
            for (int m = 0; m < 4; ++m)
#pragma unroll
                for (int n = 0; n < 2; ++n) acc[a][b][m][n] = (f32x4){0.f, 0.f, 0.f, 0.f};
    bf16x8 At[4][2], B0[2][2], B1[2][2];
    const char* cA = g.A + (size_t)cur.pm * g.tstepA; const char* cB = g.B + (size_t)cur.pn * g.tstepB;
    PG8_STAGE(PG8_SB(0, 0), cB, voffB); PG8_STAGE(PG8_SB(0, 1), cB + hstepB, voffB); PG8_STAGE(PG8_SA(0, 0), cA, voffA); PG8_STAGE(PG8_SA(0, 1), cA + hstepA, voffA);
    if (wr == 1) PG8_BAR;
    PG8_WAIT_V(2); PG8_BAR;
    PG8_STAGE(PG8_SB(1, 0), cB + kstep, voffB); PG8_STAGE(PG8_SA(1, 0), cA + kstep, voffA); PG8_STAGE(PG8_SB(1, 1), cB + hstepB + kstep, voffB);
    PG8_WAIT_V(6); PG8_BAR;
    for (;;) {
        const bool has_next = S.next(ui + 1, nxt);
        const char* nA = has_next ? g.A + (size_t)nxt.pm * g.tstepA : cA; const char* nB = has_next ? g.B + (size_t)nxt.pn * g.tstepB : cB;
        for (int t = 0; t < nt; t += 2) {
            const bool last = (t == nt - 2);
            const char* a1 = cA + (size_t)(t + 1) * kstep;
            const char* a2 = last ? nA : cA + (size_t)(t + 2) * kstep; const char* b2 = last ? nB : cB + (size_t)(t + 2) * kstep;
            const char* a3 = a2 + kstep; const char* b3 = b2 + kstep;
            PG8_LDB(B0, 0, 0); PG8_LDB(B1, 0, 1); PG8_SCHED; PG8_LDA(At, 0, 0); PG8_STAGE(PG8_SA(1, 1), a1 + hstepA, voffA);
            PG8_WAIT_V(8); PG8_WAIT_L(0); PG8_BAR; PG8_MMA(0, 0, At, B0); PG8_MMA(0, 1, At, B1); PG8_BAR; PG8_SCHED;
            PG8_LDA(At, 0, 1); PG8_STAGE(PG8_SB(0, 0), b2, voffB); PG8_STAGE(PG8_SB(0, 1), b2 + hstepB, voffB); PG8_STAGE(PG8_SA(0, 0), a2, voffA);
            PG8_WAIT_V(8); PG8_WAIT_L(0); PG8_BAR; PG8_MMA(1, 0, At, B0); PG8_MMA(1, 1, At, B1); PG8_BAR; PG8_SCHED;
            PG8_LDB(B0, 1, 0); PG8_LDB(B1, 1, 1); PG8_SCHED; PG8_LDA(At, 1, 0); PG8_STAGE(PG8_SA(0, 1), a2 + hstepA, voffA);
            PG8_WAIT_V(8); PG8_WAIT_L(0); PG8_BAR; PG8_MMA(0, 0, At, B0); PG8_MMA(0, 1, At, B1); PG8_BAR; PG8_SCHED;
            PG8_LDA(At, 1, 1); PG8_STAGE(PG8_SB(1, 0), b3, voffB); PG8_STAGE(PG8_SB(1, 1), b3 + hstepB, voffB); PG8_STAGE(PG8_SA(1, 0), a3, voffA);
            PG8_WAIT_V(8); PG8_WAIT_L(0); PG8_BAR; PG8_MMA(1, 0, At, B0); PG8_MMA(1, 1, At, B1); PG8_BAR; PG8_SCHED;
        }
        if (wr == 0) PG8_BAR;
        E(acc, cur, wr, wc, fr, fq);
        if (!has_next) break;
#pragma unroll
        for (int a = 0; a < 2; ++a)
#pragma unroll
            for (int b = 0; b < 2; ++b)
#pragma unroll
                for (int m = 0; m < 4; ++m)
#pragma unroll
                    for (int n = 0; n < 2; ++n) acc[a][b][m][n] = (f32x4){0.f, 0.f, 0.f, 0.f};
        cur = nxt; cA = nA; cB = nB; ++ui;
        if (wr == 1) PG8_BAR;
    }
    PG8_WAIT_V(0);
    PG8_BAR;
#undef PG8_SA
#undef PG8_SB
#undef PG8_STAGE
#undef PG8_LDA
#undef PG8_LDB
#undef PG8_MMA
#undef PG8_WAIT_V
#undef PG8_WAIT_L
#undef PG8_BAR
#undef PG8_SCHED
}
template <class Epi, class Prob>
__device__ __forceinline__ void gemm_phase_x(LAS unsigned char* lds, const Prob& P, const Epi& E, int wave_id) {
    int lane_l = (int)__builtin_amdgcn_mbcnt_hi(~0u, __builtin_amdgcn_mbcnt_lo(~0u, 0u)); asm volatile("" : "+v"(lane_l));
    const int wid = wave_id, lane = lane_l, tid = wid * 64 + lane, wr = wid >> 2, wc = wid & 3, fr = lane & 15, fq = lane >> 4;
    const int K = P.K, nt = K / BK;
    unsigned voffB[2];
#pragma unroll
    for (int i = 0; i < 2; ++i) { int R, C; stage_rc(tid * 16 + i * 8192, R, C); const int Rb = Epi::PERM ? ((R & ~31) + perm32(R & 31)) : R; voffB[i] = (unsigned)(Rb * P.ldb + C) * 2u; }
    const size_t kstep = (size_t)(BK * 2);
    const long hstepB = P.hstepB;
    const unsigned ldsw = (unsigned)wid * 1024u;
    const int aoff = lds_byte(wr * 64 + fr, fq * 8), boff = lds_byte(wc * 32 + fr, fq * 8);
    LAS u32x4* stash = (LAS u32x4*)(lds + STAGE_BYTES + 1024) + tid;
#define PG8_SA(b, h) (((b) * 2 + (h)) * HTB)
#define PG8_SB(b, h) ((4 + (b) * 2 + (h)) * HTB)
#define PG8_STAGE(bufoff, gbase, voff) do { _Pragma("unroll") for (int _i = 0; _i < 2; ++_i) \
        __builtin_amdgcn_global_load_lds((const unsigned*)((const char*)(gbase) + (voff)[_i]), (LAS unsigned*)(lds + (bufoff) + ldsw + _i * 8192), 16, 0, 0); } while (0)
#define PG8_LDA(dst, b, h) do { _Pragma("unroll") for (int m = 0; m < 4; ++m) _Pragma("unroll") for (int k = 0; k < 2; ++k) dst[m][k] = *(const LAS bf16x8*)(lds + PG8_SA(b, h) + aoff + m * 2048 + k * 1024); } while (0)
#define PG8_LDB(dst, b, h) do { _Pragma("unroll") for (int n = 0; n < 2; ++n) _Pragma("unroll") for (int k = 0; k < 2; ++k) dst[n][k] = *(const LAS bf16x8*)(lds + PG8_SB(b, h) + boff + n * 2048 + k * 1024); } while (0)
#define PG8_MMA(ai, bj, At, Bt) do { __builtin_amdgcn_s_setprio(1); _Pragma("unroll") for (int m = 0; m < 4; ++m) _Pragma("unroll") for (int n = 0; n < 2; ++n) _Pragma("unroll") for (int k = 0; k < 2; ++k) \
        acc[ai][bj][m][n] = __builtin_amdgcn_mfma_f32_16x16x32_bf16(Bt[n][k], At[m][k], acc[ai][bj][m][n], 0, 0, 0); __builtin_amdgcn_s_setprio(0); } while (0)
#define PG8_WAIT_V(n) asm volatile("s_waitcnt vmcnt(" #n ")" ::: "memory")
#define PG8_WAIT_L(n) asm volatile("s_waitcnt lgkmcnt(" #n ")" ::: "memory")
#define PG8_BAR __builtin_amdgcn_s_barrier()
#define PG8_SCHED __builtin_amdgcn_sched_barrier(0)
#define PG8_AVOFF(dst, u) do { int t2_ = tid; asm volatile("" : "+v"(t2_)); _Pragma("unroll") for (int i_ = 0; i_ < 2; ++i_) { int R_, C_; stage_rc(t2_ * 16 + i_ * 8192, R_, C_); _Pragma("unroll") for (int h_ = 0; h_ < 2; ++h_) \
        dst[h_][i_] = (Prob::GATHER ? P.arow_off(u, h_, R_) : (unsigned)((h_ * HALF + R_) * P.lda) * 2u) + (unsigned)C_ * 2u; } } while (0)
    Unit cur, nxt; int ui = 0;
    if (!P.next(0, cur)) return;
    unsigned vA[2][2];
    PG8_AVOFF(vA, cur);
    f32x4 acc[2][2][4][2];
#pragma unroll
    for (int a = 0; a < 2; ++a)
#pragma unroll
        for (int b = 0; b < 2; ++b)
#pragma unroll
            for (int m = 0; m < 4; ++m)
#pragma unroll
                for (int n = 0; n < 2; ++n) acc[a][b][m][n] = (f32x4){0.f, 0.f, 0.f, 0.f};
    bf16x8 At[4][2], B0[2][2], B1[2][2];
    const char* cA = P.a_base(cur); const char* cB = P.b_base(cur);
    long csplit = Prob::KSPLIT ? P.bsplit(cur) : 0;
    if (Prob::WAITS) P.a_ready(cur, wid);
    PG8_STAGE(PG8_SB(0, 0), cB, voffB); PG8_STAGE(PG8_SB(0, 1), cB + hstepB, voffB); PG8_STAGE(PG8_SA(0, 0), cA, vA[0]); PG8_STAGE(PG8_SA(0, 1), cA, vA[1]);
    if (wr == 1) PG8_BAR;
    PG8_WAIT_V(2); PG8_BAR;
    PG8_STAGE(PG8_SB(1, 0), cB + kstep, voffB); PG8_STAGE(PG8_SA(1, 0), cA + kstep, vA[0]); PG8_STAGE(PG8_SB(1, 1), cB + hstepB + kstep, voffB);
    PG8_WAIT_V(6); PG8_BAR;
    for (;;) {
        const bool has_next = P.next(ui + 1, nxt);
        const char* nA = has_next ? P.a_base(nxt) : cA; const char* nB = has_next ? P.b_base(nxt) : cB;
        if (Prob::GATHER) { unsigned vN[2][2];
            if (has_next) { PG8_AVOFF(vN, nxt); } else { vN[0][0] = vA[0][0]; vN[0][1] = vA[0][1]; vN[1][0] = vA[1][0]; vN[1][1] = vA[1][1]; }
            *stash = (u32x4){vN[0][0], vN[0][1], vN[1][0], vN[1][1]}; }
        for (int t = 0; t < nt; t += 2) {
            const bool last = (t == nt - 2);
            if (Prob::WAITS && last && has_next) P.a_ready(nxt, wid);
            const char* a1 = cA + (size_t)(t + 1) * kstep;
            const char* a2 = last ? nA : cA + (size_t)(t + 2) * kstep;
            const char* b2 = last ? nB : cB + (size_t)(t + 2) * kstep + ((Prob::KSPLIT && (t + 2) >= (nt >> 1)) ? csplit : 0);
            const char* a3 = a2 + kstep; const char* b3 = b2 + kstep;
            PG8_LDB(B0, 0, 0); PG8_LDB(B1, 0, 1); PG8_SCHED; PG8_LDA(At, 0, 0); PG8_STAGE(PG8_SA(1, 1), a1, vA[1]);
            if (Prob::GATHER && last) { const u32x4 sv = *stash; vA[0][0] = sv.x; vA[0][1] = sv.y; vA[1][0] = sv.z; vA[1][1] = sv.w; }
            PG8_WAIT_V(8); PG8_WAIT_L(0); PG8_BAR; PG8_MMA(0, 0, At, B0); PG8_MMA(0, 1, At, B1); PG8_BAR; PG8_SCHED;
            PG8_LDA(At, 0, 1); PG8_STAGE(PG8_SB(0, 0), b2, voffB); PG8_STAGE(PG8_SB(0, 1), b2 + hstepB, voffB); PG8_STAGE(PG8_SA(0, 0), a2, vA[0]);
            PG8_WAIT_V(8); PG8_WAIT_L(0); PG8_BAR; PG8_MMA(1, 0, At, B0); PG8_MMA(1, 1, At, B1); PG8_BAR; PG8_SCHED;
            PG8_LDB(B0, 1, 0); PG8_LDB(B1, 1, 1); PG8_SCHED; PG8_LDA(At, 1, 0); PG8_STAGE(PG8_SA(0, 1), a2, vA[1]);
            PG8_WAIT_V(8); PG8_WAIT_L(0); PG8_BAR; PG8_MMA(0, 0, At, B0); PG8_MMA(0, 1, At, B1); PG8_BAR; PG8_SCHED;
            PG8_LDA(At, 1, 1); PG8_STAGE(PG8_SB(1, 0), b3, voffB); PG8_STAGE(PG8_SB(1, 1), b3 + hstepB, voffB); PG8_STAGE(PG8_SA(1, 0), a3, vA[0]);
            PG8_WAIT_V(8); PG8_WAIT_L(0); PG8_BAR; PG8_MMA(1, 0, At, B0); PG8_MMA(1, 1, At, B1); PG8_BAR; PG8_SCHED;
        }
        if (wr == 0) PG8_BAR;
        E(acc, cur, wr, wc, fr, fq);
        if (!has_next) break;
#pragma unroll
        for (int a = 0; a < 2; ++a)
#pragma unroll
            for (int b = 0; b < 2; ++b)
#pragma unroll
                for (int m = 0; m < 4; ++m)
#pragma unroll
                    for (int n = 0; n < 2; ++n) acc[a][b][m][n] = (f32x4){0.f, 0.f, 0.f, 0.f};
        cur = nxt; cA = nA; cB = nB; ++ui;
        if (Prob::KSPLIT) csplit = P.bsplit(cur);
        if (wr == 1) PG8_BAR;
    }
    PG8_WAIT_V(0);
    PG8_BAR;
#undef PG8_SA
#undef PG8_SB
#undef PG8_STAGE
#undef PG8_LDA
#undef PG8_LDB
#undef PG8_MMA
#undef PG8_WAIT_V
#undef PG8_WAIT_L
#undef PG8_BAR
#undef PG8_SCHED
#undef PG8_AVOFF
}

__device__ __forceinline__ int pair_a(int pi) { return pi < 3 ? 0 : (pi < 5 ? 1 : 2); }
__device__ __forceinline__ int pair_b(int pi) { return pi == 0 ? 1 : ((pi == 1 || pi == 3) ? 2 : 3); }
template <int MODE>
struct MoeProb {
    static constexpr bool GATHER = (MODE == 0), KSPLIT = (MODE == 1);
    const unsigned* cnt; const unsigned* list; const char* A; const char* B; int lda, ldb, K; long hstepB; int G, c; unsigned* tcnt;
    static constexpr bool WAITS = (MODE == 1);
    __device__ __forceinline__ void a_ready(const Unit& u, int wave) const {
        if (MODE == 1) {
            if (wave == 0) { unsigned polls = 0;
                while ((unsigned)__builtin_amdgcn_readfirstlane(__hip_atomic_load(tcnt + 64 * u.pm, __ATOMIC_RELAXED, __HIP_MEMORY_SCOPE_AGENT)) < 32u) {
                    if (++polls > (1u << 20)) break;
                    __builtin_amdgcn_s_sleep(2); }
                __builtin_amdgcn_fence(__ATOMIC_ACQUIRE, "agent");
                asm volatile("s_waitcnt vmcnt(0)" ::: "memory"); }
            asm volatile("" ::: "memory"); __builtin_amdgcn_s_barrier(); asm volatile("" ::: "memory");
        }
    }
    __device__ __forceinline__ bool next(int i, Unit& u) const {
        const long L = (long)i * G + c; const int tileidx = (int)(L >> 2);
        int accu = 0, bk = -1, tib = 0, nb = 0;
        for (int k = 0; k < 24; ++k) { const int n = (int)cnt[k]; const int tl = (n + 255) >> 8; if (bk < 0 && tileidx < accu + tl) { bk = k; tib = tileidx - accu; nb = n; } accu += tl; }
        if (bk < 0) return false;
        u.pm = tileidx; u.pn = (int)(L & 3); u.meta = bk | (tib << 5) | (nb << 13); return true;
    }
    __device__ __forceinline__ int expert(const Unit& u, int s) const { const int g = u.bk() / 6, pi = u.bk() % 6; return g * 4 + (s ? pair_b(pi) : pair_a(pi)); }
    __device__ __forceinline__ const char* a_base(const Unit& u) const { return MODE == 0 ? A : A + (size_t)u.pm * 256 * lda * 2; }
    __device__ __forceinline__ const char* b_base(const Unit& u) const {
        if (MODE == 0) return B + ((size_t)expert(u, u.pn >> 1) * DEXP + (size_t)(u.pn & 1) * HALF) * ldb * 2;
        return B + (size_t)u.pn * 256 * ldb * 2 + (size_t)expert(u, 0) * DEXP * 2;
    }
    __device__ __forceinline__ unsigned arow_off(const Unit& u, int h, int R) const { const int pos = u.tib() * 256 + h * HALF + R; const unsigned tok = pos < u.nb() ? list[(size_t)u.bk() * T + pos] : 0u; return tok * (unsigned)(lda * 2); }
    __device__ __forceinline__ long bsplit(const Unit& u) const { return ((long)(expert(u, 1) - expert(u, 0)) * DEXP - DEXP) * 2; }
};
struct EpiGateUpSparse {
    static constexpr bool PERM = true;
    bf16_t* act; const float* wlist; unsigned* tcnt;
    __device__ __forceinline__ void operator()(const f32x4 (&acc)[2][2][4][2], const Unit& u, int wr, int wc, int fr, int fq) const {
        asm volatile("" : "+v"(fr), "+v"(fq));
        const int s = u.pn >> 1, col0 = s * DEXP + (u.pn & 1) * HALF + wc * 32 + 8 * fq;
        const __amdgpu_buffer_rsrc_t rs_act = __builtin_amdgcn_make_buffer_rsrc((void*)act, (short)0, 0x7fffffff, 0x00020000);
#pragma unroll
        for (int ai = 0; ai < 2; ++ai)
#pragma unroll
            for (int m = 0; m < 4; ++m) { const int r = ai * HALF + wr * 64 + m * 16 + fr, pos = u.tib() * 256 + r;
                const float cw = pos < u.nb() ? wlist[((size_t)u.bk() * T + pos) * 2 + s] : 0.f;
                float o[8];
#pragma unroll
                for (int n = 0; n < 2; ++n)
#pragma unroll
                    for (int j = 0; j < 4; ++j) { const float g = acc[ai][0][m][n][j], up = acc[ai][1][m][n][j];
                        const float sg = g * __builtin_amdgcn_rcpf(1.f + __builtin_amdgcn_exp2f(-g * LOG2E));
                        o[n * 4 + j] = sg * up * cw; }
                u32x4 w; w.x = cvt_pk_bf16(o[0], o[1]); w.y = cvt_pk_bf16(o[2], o[3]); w.z = cvt_pk_bf16(o[4], o[5]); w.w = cvt_pk_bf16(o[6], o[7]);
                __builtin_amdgcn_raw_buffer_store_b128(w, rs_act, (int)((((unsigned)u.pm * 256u + (unsigned)r) * 512u + (unsigned)col0) * 2u), 0, 16);
                if (m & 1) asm volatile("" ::: "memory"); }
        asm volatile("s_waitcnt vmcnt(0)" ::: "memory");
        if ((fr | fq) == 0) __hip_atomic_fetch_add(tcnt + 64 * u.pm, 1u, __ATOMIC_RELAXED, __HIP_MEMORY_SCOPE_AGENT);
    }
};
struct EpiDownScatter {
    static constexpr bool PERM = false;
    float* x; const unsigned* list;
    __device__ __forceinline__ void operator()(const f32x4 (&acc)[2][2][4][2], const Unit& u, int wr, int wc, int fr, int fq) const {
        asm volatile("" : "+v"(fr), "+v"(fq));
        const int col0 = u.pn * BM + wc * 32 + 4 * fq;
        unsigned tok[8];
#pragma unroll
        for (int g = 0; g < 8; ++g) { const int pos = u.tib() * 256 + (g >> 2) * HALF + wr * 64 + (g & 3) * 16 + fr; tok[g] = pos < u.nb() ? list[(size_t)u.bk() * T + pos] : 0xffffffffu; }
#pragma unroll
        for (int g = 0; g < 8; ++g) { const int ai = g >> 2, m = g & 3;
            if (tok[g] != 0xffffffffu) { const size_t off = (size_t)tok[g] * DM + col0;
#pragma unroll
                for (int bj = 0; bj < 2; ++bj)
#pragma unroll
                    for (int n = 0; n < 2; ++n) { f32x4* p = (f32x4*)(x + off + bj * HALF + n * 16); *p = *p + acc[ai][bj][m][n]; } }
            if (g & 1) asm volatile("" ::: "memory"); }
    }
};
}

#define XB_TMO      128
#define XB_XCNT(j)  (256  + 64 * (j))
#define XB_XSUB(j)  (1280 + 64 * (j))
#define XB_XGEN(j)  (2304 + 64 * (j))
#define XB_TOP      3328
#define XB_TOPGEN   3392
#define XCD_BAR_WORDS 3456
#define XB_SPIN_CAP (1u << 18)
__device__ __forceinline__ unsigned xb_ld(unsigned* p)              { return __hip_atomic_load(p, __ATOMIC_RELAXED, __HIP_MEMORY_SCOPE_AGENT); }
__device__ __forceinline__ unsigned xb_add(unsigned* p, unsigned v) { return __hip_atomic_fetch_add(p, v, __ATOMIC_RELAXED, __HIP_MEMORY_SCOPE_AGENT); }
__device__ __forceinline__ unsigned xb_xcc_id() { return (unsigned)__builtin_amdgcn_s_getreg((3 << 11) | 20) & 0xFu; }
#define XB_SPIN(cond, bar) do { unsigned _sp = 0; while (cond) { __builtin_amdgcn_s_sleep(1); \
    if ((++_sp & 255u) == 0u) { if (xb_ld(&(bar)[XB_TMO])) break; if (_sp > XB_SPIN_CAP) { atomicAdd(&(bar)[XB_TMO], 1u); break; } } } } while (0)
struct XcdBarrier { unsigned* bar; unsigned x; volatile LAS unsigned* st; int wave; };
__device__ __forceinline__ bool xb_thread0(int wave) { return wave == 0 && __builtin_amdgcn_mbcnt_hi(~0u, __builtin_amdgcn_mbcnt_lo(~0u, 0u)) == 0u; }
__device__ __forceinline__ XcdBarrier xcd_barrier_post(unsigned* bar, volatile LAS unsigned* st, int wave) {
    XcdBarrier b; b.bar = bar; b.x = xb_xcc_id(); b.st = st; b.wave = wave;
    if (xb_thread0(wave)) (void)xb_add(&bar[XB_XCNT(b.x)], 1u);
    return b;
}
__device__ __forceinline__ void xcd_barrier_complete(unsigned* bar, unsigned x, unsigned& nloc, unsigned& nx) {
    const unsigned G = gridDim.x * gridDim.y * gridDim.z;
    unsigned sum, cnt, mine, sp = 0u;
    for (;;) {
        sum = 0u; cnt = 0u; mine = 0u;
#pragma unroll
        for (unsigned j = 0; j < 16; ++j) { const unsigned c = xb_ld(&bar[XB_XCNT(j)]); sum += c; cnt += (c > 0u) ? 1u : 0u; mine = (j == x) ? c : mine; }
        if (sum == G) break;
        __builtin_amdgcn_s_sleep(1);
        if ((++sp & 255u) == 0u) { if (xb_ld(&bar[XB_TMO])) break; if (sp > XB_SPIN_CAP) { atomicAdd(&bar[XB_TMO], 1u); break; } }
    }
    nloc = mine > 0u ? mine : 1u; nx = cnt > 0u ? cnt : 1u;
}
__device__ __forceinline__ void xcd_barrier(const XcdBarrier& b) {
    asm volatile("s_waitcnt vmcnt(0)" ::: "memory");
    __syncthreads();
    if (xb_thread0(b.wave)) {
        unsigned* bar = b.bar;
        __builtin_amdgcn_s_waitcnt(0);
        unsigned nloc = b.st[0], nx = b.st[1];
        if (nloc == 0u) { xcd_barrier_complete(bar, b.x, nloc, nx); b.st[0] = nloc; b.st[1] = nx; }
        const unsigned old = xb_add(&bar[XB_XSUB(b.x)], 1u);
        const unsigned gen = old / nloc;
        if (old + 1u == (gen + 1u) * nloc) {
            __builtin_amdgcn_fence(__ATOMIC_RELEASE, "agent");
            asm volatile("s_waitcnt vmcnt(0)" ::: "memory");
            const unsigned og = xb_add(&bar[XB_TOP], 1u);
            const unsigned tg = og / nx;
            if (og + 1u == (tg + 1u) * nx) xb_add(&bar[XB_TOPGEN], 1u);
            else XB_SPIN(xb_ld(&bar[XB_TOPGEN]) == tg, bar);
            __builtin_amdgcn_fence(__ATOMIC_ACQUIRE, "agent");
            xb_add(&bar[XB_XGEN(b.x)], 1u);
            asm volatile("s_waitcnt vmcnt(0)" ::: "memory");
        } else {
            XB_SPIN(xb_ld(&bar[XB_XGEN(b.x)]) == gen, bar);
            __builtin_amdgcn_fence(__ATOMIC_ACQUIRE, "agent");
            asm volatile("s_waitcnt vmcnt(0)" ::: "memory");
        }
    }
    __syncthreads();
}

struct Args {
    const float* x; const float* ln1_g; const float* w_in; const float* mix_g; const float* w_out; const float* ln2_g;
    const float* w_gr; const float* b_gr; const float* w_er; const float* b_er; const float* w_gate; const float* w_up; const float* w_down; const float* fin_g;
    float* out; unsigned char* ws; int ph_lo, ph_hi, li, pad;
};

__device__ __forceinline__ void transpose_item(const float* W, int K, int N, bf16_t* WT, int dpitch, int dcol, LAS float* scr, int item, int lane) {
    const int nblk = N / 32, kb = item / nblk, nb = item % nblk, k0 = 64 * kb, n0 = 32 * nb;
#pragma unroll 8
    for (int i = 0; i < 32; ++i) { const int kk = 2 * i + (lane >> 5); scr[kk * 33 + (lane & 31)] = W[(size_t)(k0 + kk) * N + n0 + (lane & 31)]; }
    LDS_WAIT(); asm volatile("" ::: "memory");
    const int c = lane & 7;
#pragma unroll
    for (int j = 0; j < 4; ++j) { const int n = (lane >> 3) + 8 * j; const LAS float* s = scr + (8 * c) * 33 + n;
        u32x4 o; o.x = pk2(s[0 * 33], s[1 * 33]); o.y = pk2(s[2 * 33], s[3 * 33]); o.z = pk2(s[4 * 33], s[5 * 33]); o.w = pk2(s[6 * 33], s[7 * 33]);
        *(u32x4*)(WT + (size_t)(n0 + n) * dpitch + dcol + k0 + 8 * c) = o; }
    LDS_WAIT(); asm volatile("" ::: "memory");
}
__device__ __forceinline__ void phase_prologue(const Args& a, LAS unsigned char* lds, int gw, int NGW, int wave, int lane) {
    LAS float* scr = (LAS float*)(lds + wave * 16384);
    constexpr int I_IN = (DM / 64) * (NQKV / 32);
    constexpr int I_OUT = (DM / 64) * (DM / 32);
    constexpr int I_G = (DM / 64) * (DEXP / 32);
    constexpr int I_D = (DEXP / 64) * (DM / 32);
    constexpr int N_IN = DEPTH * I_IN, N_OUT = DEPTH * I_OUT, N_G = DEPTH * NEXP * I_G, N_D = DEPTH * NEXP * I_D;
    constexpr int NITEMS = N_IN + N_OUT + 2 * N_G + N_D;
    bf16_t* WinT = (bf16_t*)(a.ws + WS_WIN); bf16_t* WoutT = (bf16_t*)(a.ws + WS_WOUT); bf16_t* WgT = (bf16_t*)(a.ws + WS_WG); bf16_t* WuT = (bf16_t*)(a.ws + WS_WU); bf16_t* WdT = (bf16_t*)(a.ws + WS_WD);
    for (int it = gw; it < NITEMS; it += NGW) {
        int r = it;
        if (r < N_IN) { const int l = r / I_IN; transpose_item(a.w_in + (size_t)l * DM * NQKV, DM, NQKV, WinT + (size_t)l * NQKV * DM, DM, 0, scr, r % I_IN, lane); continue; } r -= N_IN;
        if (r < N_OUT) { const int l = r / I_OUT; transpose_item(a.w_out + (size_t)l * DM * DM, DM, DM, WoutT + (size_t)l * DM * DM, DM, 0, scr, r % I_OUT, lane); continue; } r -= N_OUT;
        if (r < N_G) { const int le = r / I_G; transpose_item(a.w_gate + (size_t)le * DM * DEXP, DM, DEXP, WgT + (size_t)le * DEXP * DM, DM, 0, scr, r % I_G, lane); continue; } r -= N_G;
        if (r < N_G) { const int le = r / I_G; transpose_item(a.w_up + (size_t)le * DM * DEXP, DM, DEXP, WuT + (size_t)le * DEXP * DM, DM, 0, scr, r % I_G, lane); continue; } r -= N_G;
        { const int le = r / I_D, l = le / NEXP, e = le % NEXP; transpose_item(a.w_down + (size_t)le * DEXP * DM, DEXP, DM, WdT + (size_t)l * DM * NACT, NACT, e * DEXP, scr, r % I_D, lane); }
    }
}

__device__ __forceinline__ void phase_norm1(const float* x, const float* g, bf16_t* hb, int gw, int NGW, int lane) {
    f32x4 gv[4];
#pragma unroll
    for (int j = 0; j < 4; ++j) gv[j] = *((const f32x4*)g + lane + 64 * j);
    for (int m = gw; m < T; m += NGW) {
        const f32x4* xr = (const f32x4*)(x + (size_t)m * DM) + lane;
        f32x4 v[4]; float s = 0.f;
#pragma unroll
        for (int j = 0; j < 4; ++j) { v[j] = xr[64 * j]; s += (v[j].x * v[j].x + v[j].y * v[j].y) + (v[j].z * v[j].z + v[j].w * v[j].w); }
        const float rstd = 1.0f / sqrtf(wave_sum(s) * (1.f / DM) + NORM_EPS);
        u32x2* o8 = (u32x2*)(hb + (size_t)m * DM) + lane;
#pragma unroll
        for (int j = 0; j < 4; ++j) { u32x2 w; w.x = pk2(v[j].x * rstd * gv[j].x, v[j].y * rstd * gv[j].y); w.y = pk2(v[j].z * rstd * gv[j].z, v[j].w * rstd * gv[j].w); o8[64 * j] = w; }
    }
}
__device__ __forceinline__ void unpack8(float (&f)[8], const u32x4 w) { f[0] = bflo(w.x); f[1] = bfhi(w.x); f[2] = bflo(w.y); f[3] = bfhi(w.y); f[4] = bflo(w.z); f[5] = bfhi(w.z); f[6] = bflo(w.w); f[7] = bfhi(w.w); }
__device__ __forceinline__ void phase_mixnorm(const bf16_t* ob, bf16_t* hb, const float* lse, const bf16_t* pm, const float* lsem0, const float* lsem1, const float* g, int gw, int NGW, int lane) {
    float g0[8], g1[8];
#pragma unroll
    for (int j = 0; j < 8; ++j) { g0[j] = g[8 * lane + j]; g1[j] = g[512 + 8 * lane + j]; }
    const int hh = lane >> 3;
    for (int m = gw; m < T; m += NGW) {
        const u32x4 a = *((const u32x4*)(ob + (size_t)m * DM) + lane), c0 = *((const u32x4*)(ob + (size_t)m * DM + 512) + lane);
        const u32x4 c1 = *((const u32x4*)(hb + (size_t)m * DM) + lane), c2 = *((const u32x4*)(hb + (size_t)m * DM + 512) + lane);
        const float l0 = lse[(size_t)m * 8 + hh], l1 = lse[(size_t)T * 8 + (size_t)m * 8 + hh], l2 = lse[(size_t)2 * T * 8 + (size_t)m * 8 + hh];
        float va[8]; unpack8(va, a);
        if (lane < 32) {
            const u32x4 p0 = *((const u32x4*)(pm + (size_t)m * 256) + lane), p1 = *((const u32x4*)(pm + ((size_t)T + m) * 256) + lane), p2 = *((const u32x4*)(pm + ((size_t)2 * T + m) * 256) + lane);
            const float e0 = lsem0[(size_t)m * 4 + hh], e1 = lsem0[(size_t)T * 4 + (size_t)m * 4 + hh], e2 = lsem1[(size_t)m * 4 + hh], e3 = lsem1[(size_t)T * 4 + (size_t)m * 4 + hh];
            const float mx = fmaxf(fmaxf(e0, e1), fmaxf(e2, e3));
            float u0 = __builtin_amdgcn_exp2f(e0 - mx), u1 = __builtin_amdgcn_exp2f(e1 - mx), u2 = __builtin_amdgcn_exp2f(e2 - mx), u3 = __builtin_amdgcn_exp2f(e3 - mx);
            const float inv = 1.0f / ((u0 + u1) + (u2 + u3)); u0 *= inv; u1 *= inv; u2 *= inv; u3 *= inv;
            float y0[8], y1[8], y2[8]; unpack8(y0, p0); unpack8(y1, p1); unpack8(y2, p2);
#pragma unroll
            for (int j = 0; j < 8; ++j) va[j] = (u0 * y0[j] + u1 * y1[j]) + (u2 * y2[j] + u3 * va[j]);
        }
        const float mx = fmaxf(l0, fmaxf(l1, l2));
        float w0 = __builtin_amdgcn_exp2f(l0 - mx), w1 = __builtin_amdgcn_exp2f(l1 - mx), w2 = __builtin_amdgcn_exp2f(l2 - mx);
        const float inv = 1.0f / (w0 + w1 + w2); w0 *= inv; w1 *= inv; w2 *= inv;
        float x0[8], x1[8], x2[8]; unpack8(x0, c0); unpack8(x1, c1); unpack8(x2, c2);
        float vc[8];
        float sa = 0.f, sc = 0.f;
#pragma unroll
        for (int j = 0; j < 8; ++j) { vc[j] = w0 * x0[j] + w1 * x1[j] + w2 * x2[j]; sa += va[j] * va[j]; sc += vc[j] * vc[j]; }
        sa = half_sum(sa); sc = wave_sum(sc);
        const float ra = 1.0f / sqrtf(sa * (1.f / 256.f) + NORM_EPS), rc = 1.0f / sqrtf(sc * (1.f / 512.f) + NORM_EPS);
        u32x4 oa, oc;
        oa.x = pk2(va[0] * ra * g0[0], va[1] * ra * g0[1]); oa.y = pk2(va[2] * ra * g0[2], va[3] * ra * g0[3]); oa.z = pk2(va[4] * ra * g0[4], va[5] * ra * g0[5]); oa.w = pk2(va[6] * ra * g0[6], va[7] * ra * g0[7]);
        oc.x = pk2(vc[0] * rc * g1[0], vc[1] * rc * g1[1]); oc.y = pk2(vc[2] * rc * g1[2], vc[3] * rc * g1[3]); oc.z = pk2(vc[4] * rc * g1[4], vc[5] * rc * g1[5]); oc.w = pk2(vc[6] * rc * g1[6], vc[7] * rc * g1[7]);
        *((u32x4*)(hb + (size_t)m * DM) + lane) = oa; *((u32x4*)(hb + (size_t)m * DM + 512) + lane) = oc;
    }
}
__device__ __forceinline__ void phase_route(const float* x, const float* g, const float* wgr, const float* bgr, const float* wer, const float* ber,
                                            bf16_t* hb, unsigned* cnt, unsigned* list, float* wlist, LAS unsigned char* lds, int v, int G, int wave, int lane) {
    const int tid = wave * 64 + lane;
    LAS f32x4* wl = (LAS f32x4*)lds;
    for (int idx = tid; idx < 5 * DM; idx += NTHREADS) { const int mtx = idx >> 10, d = idx & 1023; const float* src = (mtx == 0 ? wgr : wer + (size_t)(mtx - 1) * DM * 4) + d * 4;
        wl[mtx * 1024 + (d & 3) * 256 + (d >> 2)] = *(const f32x4*)src; }
    LAS unsigned* cl = (LAS unsigned*)(lds + 81920);
    LAS u32x2* info = (LAS u32x2*)(lds + 81920 + 256);
    LAS f32x2* infw = (LAS f32x2*)(lds + 81920 + 256 + 4096);
    if (tid < 64) cl[tid] = 0u;
    __syncthreads();
    const int rpw = (T + G - 1) / G, row0 = v * rpw;
    f32x4 gv[4];
#pragma unroll
    for (int j = 0; j < 4; ++j) gv[j] = *((const f32x4*)g + lane + 64 * j);
    const f32x4 bg = *(const f32x4*)bgr;
    f32x4 nx[4];
    { const int m0 = row0 + wave; if (wave < rpw && m0 < T) { const f32x4* xr = (const f32x4*)(x + (size_t)m0 * DM) + lane;
#pragma unroll
        for (int j = 0; j < 4; ++j) nx[j] = xr[64 * j]; } }
    for (int r = wave; r < rpw; r += NWAVES) {
        const int m = row0 + r; if (m >= T) break;
        f32x4 vv[4]; float s = 0.f;
#pragma unroll
        for (int j = 0; j < 4; ++j) { vv[j] = nx[j]; s += (vv[j].x * vv[j].x + vv[j].y * vv[j].y) + (vv[j].z * vv[j].z + vv[j].w * vv[j].w); }
        if (r + NWAVES < rpw && m + NWAVES < T) { const f32x4* xr = (const f32x4*)(x + (size_t)(m + NWAVES) * DM) + lane;
#pragma unroll
            for (int j = 0; j < 4; ++j) nx[j] = xr[64 * j]; }
        const float rstd = 1.0f / sqrtf(wave_sum(s) * (1.f / DM) + NORM_EPS);
        u32x2* o8 = (u32x2*)(hb + (size_t)m * DM) + lane;
#pragma unroll
        for (int j = 0; j < 4; ++j) { vv[j] = vv[j] * rstd * gv[j]; u32x2 w; w.x = pk2(vv[j].x, vv[j].y); w.y = pk2(vv[j].z, vv[j].w); o8[64 * j] = w; }
        f32x4 gl = (f32x4){0.f, 0.f, 0.f, 0.f};
#pragma unroll
        for (int j = 0; j < 4; ++j) { LAS f32x4* wp = wl + lane + 64 * j;
            gl += wp[0] * vv[j].x; gl += wp[256] * vv[j].y; gl += wp[512] * vv[j].z; gl += wp[768] * vv[j].w; }
        gl.x = wave_sum(gl.x) + bg.x; gl.y = wave_sum(gl.y) + bg.y; gl.z = wave_sum(gl.z) + bg.z; gl.w = wave_sum(gl.w) + bg.w;
        int gi = 0; float gm = gl.x;
        if (gl.y > gm) { gm = gl.y; gi = 1; } if (gl.z > gm) { gm = gl.z; gi = 2; } if (gl.w > gm) { gm = gl.w; gi = 3; }
        const float gden = __expf(gl.x - gm) + __expf(gl.y - gm) + __expf(gl.z - gm) + __expf(gl.w - gm);
        const float gw_ = 1.0f / gden;
        gi = __builtin_amdgcn_readfirstlane(gi);
        f32x4 el = (f32x4){0.f, 0.f, 0.f, 0.f};
#pragma unroll
        for (int j = 0; j < 4; ++j) { LAS f32x4* wp = wl + (1 + gi) * 1024 + lane + 64 * j;
            el += wp[0] * vv[j].x; el += wp[256] * vv[j].y; el += wp[512] * vv[j].z; el += wp[768] * vv[j].w; }
        const f32x4 be = *(const f32x4*)(ber + gi * 4);
        float e[4] = {wave_sum(el.x) + be.x, wave_sum(el.y) + be.y, wave_sum(el.z) + be.z, wave_sum(el.w) + be.w};
        int i1 = 0; float v1 = e[0];
#pragma unroll
        for (int k = 1; k < 4; ++k) if (e[k] > v1) { v1 = e[k]; i1 = k; }
        int i2 = -1; float v2 = -INFINITY;
#pragma unroll
        for (int k = 0; k < 4; ++k) if (k != i1 && e[k] > v2) { v2 = e[k]; i2 = k; }
        const float p2 = __expf(v2 - v1), inv = 1.0f / (1.0f + p2);
        const float w1 = inv * gw_, w2 = p2 * inv * gw_;
        const int ea = i1 < i2 ? i1 : i2, eb = i1 < i2 ? i2 : i1; const float wa = i1 < i2 ? w1 : w2, wb = i1 < i2 ? w2 : w1;
        const int pi = (ea == 0) ? (eb - 1) : (ea == 1 ? eb + 1 : 5), bk = gi * 6 + pi;
        if (lane == 0) { const unsigned rank = __hip_atomic_fetch_add(cl + bk, 1u, __ATOMIC_RELAXED, __HIP_MEMORY_SCOPE_WORKGROUP);
            info[r] = (u32x2){(unsigned)bk, rank}; infw[r] = (f32x2){wa, wb}; }
    }
    __syncthreads();
    if (tid < 24) cl[32 + tid] = __hip_atomic_fetch_add(cnt + tid, cl[tid], __ATOMIC_RELAXED, __HIP_MEMORY_SCOPE_AGENT);
    __syncthreads();
    if (tid < rpw && row0 + tid < T) { const u32x2 inf = info[tid]; const f32x2 wv = infw[tid]; const size_t slot = (size_t)inf.x * T + cl[32 + inf.x] + inf.y;
        list[slot] = (unsigned)(row0 + tid); *(f32x2*)(wlist + slot * 2) = wv; }
    __syncthreads();
}
__device__ __forceinline__ void phase_final(float* x, const float* g, int gw, int NGW, int lane) {
    f32x4 gv[4];
#pragma unroll
    for (int j = 0; j < 4; ++j) gv[j] = *((const f32x4*)g + lane + 64 * j);
    for (int m = gw; m < T; m += NGW) {
        f32x4* xr = (f32x4*)(x + (size_t)m * DM) + lane;
        f32x4 v[4]; float s = 0.f;
#pragma unroll
        for (int j = 0; j < 4; ++j) { v[j] = xr[64 * j]; s += (v[j].x * v[j].x + v[j].y * v[j].y) + (v[j].z * v[j].z + v[j].w * v[j].w); }
        const float rstd = 1.0f / sqrtf(wave_sum(s) * (1.f / DM) + NORM_EPS);
#pragma unroll
        for (int j = 0; j < 4; ++j) xr[64 * j] = v[j] * rstd * gv[j];
    }
}
__device__ __forceinline__ void phase_kmean(const bf16_t* kb, float* kmean, int gw, int NGW, int lane) {
    for (int it = gw; it < BATCH * 4 * 32; it += NGW) {
        const int b = it >> 7, h = (it >> 5) & 3, blk = it & 31;
        const bf16_t* base = kb + ((size_t)b * SEQ + (size_t)blk * 256) * DM + h * HD + (lane & 7) * 8;
        float acc[8] = {0.f, 0.f, 0.f, 0.f, 0.f, 0.f, 0.f, 0.f};
#pragma unroll 4
        for (int i = 0; i < 32; ++i) { const u32x4 w = *(const u32x4*)(base + (size_t)((lane >> 3) + 8 * i) * DM);
            acc[0] += bflo(w.x); acc[1] += bfhi(w.x); acc[2] += bflo(w.y); acc[3] += bfhi(w.y); acc[4] += bflo(w.z); acc[5] += bfhi(w.z); acc[6] += bflo(w.w); acc[7] += bfhi(w.w); }
#pragma unroll
        for (int j = 0; j < 8; ++j) { acc[j] += swz_xor<8>(acc[j]); acc[j] += swz_xor<16>(acc[j]); acc[j] = sum_xor32(acc[j]); }
        if (lane < 8) {
            float* o = kmean + (size_t)it * HD + lane * 8;
#pragma unroll
            for (int j = 0; j < 8; ++j) o[j] = acc[j] * (1.f / 256.f);
        }
    }
}

__device__ __forceinline__ void ld_row64(float (&r)[64], const bf16_t* p) {
#pragma unroll
    for (int c = 0; c < 8; ++c) { const u32x4 w = *((const u32x4*)p + c);
        r[8 * c + 0] = bflo(w.x); r[8 * c + 1] = bfhi(w.x); r[8 * c + 2] = bflo(w.y); r[8 * c + 3] = bfhi(w.y); r[8 * c + 4] = bflo(w.z); r[8 * c + 5] = bfhi(w.z); r[8 * c + 6] = bflo(w.w); r[8 * c + 7] = bfhi(w.w); }
}
__device__ __forceinline__ float dot_row64(const float (&q)[64], const bf16_t* p) {
    float s0 = 0.f, s1 = 0.f;
#pragma unroll
    for (int c = 0; c < 8; ++c) { const u32x4 w = *((const u32x4*)p + c);
        s0 += q[8 * c + 0] * bflo(w.x); s1 += q[8 * c + 1] * bfhi(w.x); s0 += q[8 * c + 2] * bflo(w.y); s1 += q[8 * c + 3] * bfhi(w.y);
        s0 += q[8 * c + 4] * bflo(w.z); s1 += q[8 * c + 5] * bfhi(w.z); s0 += q[8 * c + 6] * bflo(w.w); s1 += q[8 * c + 7] * bfhi(w.w); }
    return s0 + s1;
}
__device__ __forceinline__ void axpy_row64(float (&o)[64], float p, const bf16_t* vp) {
#pragma unroll
    for (int c = 0; c < 8; ++c) { const u32x4 w = *((const u32x4*)vp + c);
        o[8 * c + 0] += p * bflo(w.x); o[8 * c + 1] += p * bfhi(w.x); o[8 * c + 2] += p * bflo(w.y); o[8 * c + 3] += p * bfhi(w.y);
        o[8 * c + 4] += p * bflo(w.z); o[8 * c + 5] += p * bfhi(w.z); o[8 * c + 6] += p * bflo(w.w); o[8 * c + 7] += p * bfhi(w.w); }
}
__device__ __forceinline__ void st_row64(bf16_t* p, const float (&o)[64], float sc) {
#pragma unroll
    for (int c = 0; c < 8; ++c) { u32x4 w; w.x = pk2(o[8 * c] * sc, o[8 * c + 1] * sc); w.y = pk2(o[8 * c + 2] * sc, o[8 * c + 3] * sc); w.z = pk2(o[8 * c + 4] * sc, o[8 * c + 5] * sc); w.w = pk2(o[8 * c + 6] * sc, o[8 * c + 7] * sc); *((u32x4*)p + c) = w; }
}
#define OSM_STEP(sc, vrow) do { const float sc_ = (sc); if (sc_ > m_) { const float al = __builtin_amdgcn_exp2f(m_ - sc_); l_ *= al; _Pragma("unroll") for (int d_ = 0; d_ < 64; ++d_) o_[d_] *= al; m_ = sc_; } \
    const float p_ = __builtin_amdgcn_exp2f(sc_ - m_); l_ += p_; axpy_row64(o_, p_, (vrow)); } while (0)

__device__ __forceinline__ void naive_moba(const bf16_t* qb, const bf16_t* kb, const bf16_t* vb, const float* kmean, bf16_t* ob, int item, int tid) {
    const int b = item >> 6, h = (item >> 4) & 3, t = (item & 15) * 512 + tid, own = t >> 8;
    const size_t rowq = ((size_t)b * SEQ + t) * DM + h * HD;
    const bf16_t* kh = kb + (size_t)b * SEQ * DM + h * HD; const bf16_t* vh = vb + (size_t)b * SEQ * DM + h * HD;
    const float slope2 = exp2f(-2.0f * (float)(h + 1)) * LOG2E;
    float q_[64]; ld_row64(q_, qb + rowq);
    float bv0 = -INFINITY, bv1 = -INFINITY, bv2 = -INFINITY; int bi0 = -1, bi1 = -1, bi2 = -1;
    const float* km = kmean + (size_t)(b * 4 + h) * 32 * HD;
    for (int n = 0; n < own; ++n) {
        float gsum = 0.f;
#pragma unroll
        for (int d = 0; d < 64; ++d) gsum += q_[d] * km[n * HD + d];
        if (gsum > bv0) { bv2 = bv1; bi2 = bi1; bv1 = bv0; bi1 = bi0; bv0 = gsum; bi0 = n; }
        else if (gsum > bv1) { bv2 = bv1; bi2 = bi1; bv1 = gsum; bi1 = n; }
        else if (gsum > bv2) { bv2 = gsum; bi2 = n; }
    }
    float o_[64];
#pragma unroll
    for (int d = 0; d < 64; ++d) o_[d] = 0.f;
    float m_ = -INFINITY, l_ = 0.f;
    for (int s = 0; s < 3; ++s) {
        const int blk = (s == 0) ? bi0 : (s == 1) ? bi1 : bi2;
        if (blk < 0) continue;
        for (int j = 0; j < 256; ++j) { const int pos = blk * 256 + j;
            const float sc = dot_row64(q_, kh + (size_t)pos * DM) - slope2 * (float)(t - pos);
            OSM_STEP(sc, vh + (size_t)pos * DM); }
    }
    for (int pos = own * 256; pos <= t; ++pos) {
        const float sc = dot_row64(q_, kh + (size_t)pos * DM) - slope2 * (float)(t - pos);
        OSM_STEP(sc, vh + (size_t)pos * DM); }
    st_row64(ob + rowq, o_, 1.0f / l_);
}
__device__ __forceinline__ void naive_sb(const bf16_t* qb, const bf16_t* kb, const bf16_t* vb, bf16_t* ob, int item, int tid) {
    const int b = item >> 6, h = 4 + ((item >> 4) & 3), t = (item & 15) * 512 + tid;
    const size_t rowq = ((size_t)b * SEQ + t) * DM + h * HD;
    const bf16_t* kh = kb + (size_t)b * SEQ * DM + h * HD; const bf16_t* vh = vb + (size_t)b * SEQ * DM + h * HD;
    float q_[64]; ld_row64(q_, qb + rowq);
    float o_[64];
#pragma unroll
    for (int d = 0; d < 64; ++d) o_[d] = 0.f;
    float tail = 0.f;
    for (int s = t - 1; s >= 0 && tail > -150.f; --s) {
        const float z = dot_row64(q_, kh + (size_t)s * DM);
        const float lp = __builtin_amdgcn_logf(1.0f + __builtin_amdgcn_exp2f(-fabsf(z)));
        const float lnot = -(fmaxf(z, 0.f) + lp);
        const float aw = __builtin_amdgcn_exp2f(z + lnot + tail);
        axpy_row64(o_, aw, vh + (size_t)s * DM);
        tail += lnot;
    }
    st_row64(ob + rowq, o_, 1.0f);
}
__device__ __forceinline__ void naive_dil(const bf16_t* qb, const bf16_t* kb, const bf16_t* vb, bf16_t* ob, bf16_t* hb2, float* lse, int item, int tid) {
    const int b = item >> 7, h = 8 + ((item >> 4) & 7), t = (item & 15) * 512 + tid;
    const size_t rowq = ((size_t)b * SEQ + t) * DM + h * HD;
    const bf16_t* kh = kb + (size_t)b * SEQ * DM + h * HD; const bf16_t* vh = vb + (size_t)b * SEQ * DM + h * HD;
    const float slope2 = exp2f(-(float)(h - 8 + 1)) * LOG2E;
    float q_[64]; ld_row64(q_, qb + rowq);
    float o_[64];
#pragma unroll
    for (int d = 0; d < 64; ++d) o_[d] = 0.f;
    float m_ = -INFINITY, l_ = 0.f;
    for (int c = 0; c < 3; ++c) {
        const int dil = (c == 0) ? 1 : (c == 1) ? 4 : 16;
        for (int dl = 0; dl <= 128; ++dl) { const int pos = t - dl * dil; if (pos < 0) break;
            const float sc = dot_row64(q_, kh + (size_t)pos * DM) - slope2 * (float)(dl * dil);
            OSM_STEP(sc, vh + (size_t)pos * DM); }
    }
    st_row64(ob + rowq, o_, 1.0f / l_);
    { const size_t tok = (size_t)b * SEQ + t; const u32x4 z4 = {0u, 0u, 0u, 0u};
#pragma unroll
      for (int c = 0; c < 8; ++c) { *((u32x4*)(hb2 + tok * DM + (h - 8) * HD) + c) = z4; *((u32x4*)(hb2 + tok * DM + 512 + (h - 8) * HD) + c) = z4; }
      lse[tok * 8 + (h - 8)] = 0.f; lse[(size_t)T * 8 + tok * 8 + (h - 8)] = -1.0e30f; lse[(size_t)2 * T * 8 + tok * 8 + (h - 8)] = -1.0e30f; }
}

namespace att {
typedef float f32x16 __attribute__((ext_vector_type(16)));
typedef short s16x4 __attribute__((ext_vector_type(4)));
typedef short v4i16_t __attribute__((ext_vector_type(4)));
typedef __bf16 bf16x2_t __attribute__((ext_vector_type(2)));
constexpr int L_BUF = 16384;
constexpr int L_WSF = 2 * L_BUF;
constexpr int L_OST = L_WSF + 8 * 256;
constexpr int L_FLG = L_OST + 8 * 4096;
constexpr int L_END = L_FLG + 64;
constexpr float M_INIT = -1.0e30f;
#define ATT_MFMA(a, b, c) __builtin_amdgcn_mfma_f32_32x32x16_bf16((a), (b), (c), 0, 0, 0)

__device__ __forceinline__ unsigned cvtpk(float lo, float hi) { f32x2 v = {lo, hi}; bf16x2_t b = __builtin_convertvector(v, bf16x2_t); return __builtin_bit_cast(unsigned, b); }
__device__ __forceinline__ s16x4 vtr(LAS unsigned char* p) { return __builtin_bit_cast(s16x4, __builtin_amdgcn_ds_read_tr16_b64_v4i16((LAS v4i16_t*)p)); }

struct Wave { int lane, r32, hi, wid; LAS unsigned char* lds; LAS float* wsf; LAS unsigned char* ost; int vlo; };
__device__ __forceinline__ Wave make_wave(LAS unsigned char* lds, int tid, int wsf_off = L_WSF, int ost_off = L_OST) {
    Wave w; w.lane = tid & 63; w.r32 = w.lane & 31; w.hi = w.lane >> 5; w.wid = __builtin_amdgcn_readfirstlane(tid >> 6); w.lds = lds;
    w.wsf = (LAS float*)(lds + wsf_off) + w.wid * 64; w.ost = lds + ost_off + w.wid * 4096;
    w.vlo = ((w.lane >> 4) & 1) * 32 + (w.lane & 3) * 8 + (4 * w.hi + ((w.lane & 15) >> 2)) * 64;
    return w;
}
struct Stage { u32x4 k, v; };
template <class RowK, class RowV> __device__ __forceinline__ void stage_load(Stage& s, const Wave& w, const RowK& rowk, const RowV& rowv) {
    s.k = *(const u32x4*)(rowk(w.lane) + w.wid * 8);
    s.v = *(const u32x4*)(rowv(16 * (w.wid & 3) + (w.lane >> 2)) + (w.wid >> 2) * 32 + (w.lane & 3) * 8);
}
__device__ __forceinline__ void stage_write(const Stage& s, const Wave& w, int buf) {
    *(LAS u32x4*)(w.lds + buf * L_BUF + w.wid * 1024 + w.lane * 16) = s.k;
    *(LAS u32x4*)(w.lds + buf * L_BUF + 8192 + w.wid * 1024 + w.lane * 16) = s.v;
}
__device__ __forceinline__ f32x16 qk_sub(const Wave& w, int buf, int sub, const bf16x8 (&qf)[4], float init) {
    f32x16 acc;
#pragma unroll
    for (int r = 0; r < 16; ++r) acc[r] = init;
    LAS unsigned char* kp = w.lds + buf * L_BUF + w.hi * 1024 + (32 * sub + w.r32) * 16;
#pragma unroll
    for (int ks = 0; ks < 4; ++ks) { const bf16x8 kf = *(LAS bf16x8*)(kp + ks * 2048); acc = ATT_MFMA(kf, qf[ks], acc); }
    return acc;
}
__device__ __forceinline__ void pv_sub(const Wave& w, int buf, int sub, const f32x16& p, f32x16 (&o)[2]) {
    bf16x8 pk[2];
#pragma unroll
    for (int s = 0; s < 2; ++s) { u32x4 t; t.x = cvtpk(p[8 * s], p[8 * s + 1]); t.y = cvtpk(p[8 * s + 2], p[8 * s + 3]); t.z = cvtpk(p[8 * s + 4], p[8 * s + 5]); t.w = cvtpk(p[8 * s + 6], p[8 * s + 7]); pk[s] = __builtin_bit_cast(bf16x8, t); }
    LAS unsigned char* vb = w.lds + buf * L_BUF + 8192 + w.vlo;
#pragma unroll
    for (int db = 0; db < 2; ++db)
#pragma unroll
        for (int s = 0; s < 2; ++s) { LAS unsigned char* vp = vb + db * 4096 + (4 * sub + 2 * s) * 512;
            const s16x4 lo = vtr(vp), hh = vtr(vp + 512);
            const bf16x8 vf = __builtin_shufflevector(lo, hh, 0, 1, 2, 3, 4, 5, 6, 7);
            o[db] = ATT_MFMA(pk[s], vf, o[db]); }
}
struct VFrags { s16x4 f[2][2][2]; };
__device__ __forceinline__ void load_vfrags(const Wave& w, int buf, int sub, VFrags& v) {
    LAS unsigned char* vb = w.lds + buf * L_BUF + 8192 + w.vlo;
#pragma unroll
    for (int db = 0; db < 2; ++db)
#pragma unroll
        for (int s = 0; s < 2; ++s) { LAS unsigned char* vp = vb + db * 4096 + (4 * sub + 2 * s) * 512; v.f[db][s][0] = vtr(vp); v.f[db][s][1] = vtr(vp + 512); }
}
__device__ __forceinline__ void pv_frags(const VFrags& v, const f32x16& p, f32x16 (&o)[2]) {
    bf16x8 pk[2];
#pragma unroll
    for (int s = 0; s < 2; ++s) { u32x4 t; t.x = cvtpk(p[8 * s], p[8 * s + 1]); t.y = cvtpk(p[8 * s + 2], p[8 * s + 3]); t.z = cvtpk(p[8 * s + 4], p[8 * s + 5]); t.w = cvtpk(p[8 * s + 6], p[8 * s + 7]); pk[s] = __builtin_bit_cast(bf16x8, t); }
#pragma unroll
    for (int db = 0; db < 2; ++db)
#pragma unroll
        for (int s = 0; s < 2; ++s) { const bf16x8 vf = __builtin_shufflevector(v.f[db][s][0], v.f[db][s][1], 0, 1, 2, 3, 4, 5, 6, 7); o[db] = ATT_MFMA(pk[s], vf, o[db]); }
}
__device__ __forceinline__ void scale_rows(const Wave& w, f32x16 (&o)[2], float f) {
    if (w.hi == 0) w.wsf[w.r32] = f;
#pragma unroll
    for (int g = 0; g < 4; ++g) { const f32x4 fv = *(LAS f32x4*)(w.wsf + 8 * g + 4 * w.hi);
#pragma unroll
        for (int i = 0; i < 4; ++i) { o[0][4 * g + i] *= fv[i]; o[1][4 * g + i] *= fv[i]; } }
}
__device__ __forceinline__ void softmax_sub(const Wave& w, f32x16& s, float& m, float& lsum, f32x16 (&o)[2]) {
    float tm = fmaxf(fmaxf(s[0], s[1]), fmaxf(s[2], s[3]));
#pragma unroll
    for (int r = 4; r < 16; r += 4) tm = fmaxf(tm, fmaxf(fmaxf(s[r], s[r + 1]), fmaxf(s[r + 2], s[r + 3])));
    tm = max_xor32(tm);
    const float mn = fmaxf(m, tm);
    if (__any(mn > m)) { const float al = __builtin_amdgcn_exp2f(m - mn); lsum *= al; scale_rows(w, o, al); m = mn; }
    float acc = 0.f;
#pragma unroll
    for (int r = 0; r < 16; ++r) { s[r] = __builtin_amdgcn_exp2f(s[r] - m); acc += s[r]; }
    lsum += acc;
}
__device__ __forceinline__ void mask_band(f32x16& s, int delta0, int W) {
#pragma unroll
    for (int r = 0; r < 16; ++r) { const int dl = delta0 - ((r & 3) + 8 * (r >> 2)); if ((unsigned)dl > (unsigned)W) s[r] = -INFINITY; }
}
constexpr float SM_THR = 8.0f;
struct SubDesc { bool act; int delta; int W; };
template <int NSUB>
__device__ __forceinline__ void softmax_step(const Wave& w, int buf, const bf16x8 (&qf)[4], const bf16x8& kidx, const bf16x8& slp, float slope, const SubDesc (&sd)[NSUB],
                                             float& m, float& lsum, f32x16 (&o)[2], bool& first) {
    f32x16 s[NSUB];
    bool any_act = false;
#pragma unroll
    for (int i = 0; i < NSUB; ++i) if (sd[i].act) { any_act = true; s[i] = qk_sub(w, buf, i, qf, -slope * (float)sd[i].delta - m); s[i] = ATT_MFMA(kidx, slp, s[i]); }
    if (!any_act) return;
    float tm = -INFINITY;
#pragma unroll
    for (int i = 0; i < NSUB; ++i) if (sd[i].act) {
        if (sd[i].W >= 0) mask_band(s[i], sd[i].delta - 4 * w.hi, sd[i].W);
        float t = fmaxf(fmaxf(s[i][0], s[i][1]), fmaxf(s[i][2], s[i][3]));
#pragma unroll
        for (int r = 4; r < 16; r += 4) t = fmaxf(t, fmaxf(fmaxf(s[i][r], s[i][r + 1]), fmaxf(s[i][r + 2], s[i][r + 3])));
        tm = fmaxf(tm, t); }
    tm = max_xor32(tm);
    if (first || __any(tm > SM_THR)) {
        const float d = first ? (tm > -1.0e30f ? tm : 0.f) : fmaxf(tm, 0.f);
#pragma unroll
        for (int i = 0; i < NSUB; ++i) if (sd[i].act) {
#pragma unroll
            for (int r = 0; r < 16; ++r) s[i][r] -= d; }
        if (!first) { const float al = __builtin_amdgcn_exp2f(-d); lsum *= al; scale_rows(w, o, al); }
        m += d; first = false;
    }
    VFrags vf[NSUB];
#pragma unroll
    for (int i = 0; i < NSUB; ++i) if (sd[i].act) load_vfrags(w, buf, i, vf[i]);
#pragma unroll
    for (int i = 0; i < NSUB; ++i) if (sd[i].act) { float acc = 0.f;
#pragma unroll
        for (int r = 0; r < 16; ++r) { s[i][r] = __builtin_amdgcn_exp2f(s[i][r]); acc += s[i][r]; }
        lsum += acc; }
#pragma unroll
    for (int i = 0; i < NSUB; ++i) if (sd[i].act) pv_frags(vf[i], s[i], o);
}
__device__ __forceinline__ void bias_frags(const Wave& w, float slope, bf16x8& kidx, bf16x8& slp) {
    const unsigned kb = f2bf((float)w.r32), sh = f2bf(slope), sl = f2bf(slope - __builtin_bit_cast(float, sh << 16));
    const u32x4 a = {w.hi == 0 ? (kb | (kb << 16)) : 0u, 0u, 0u, 0u}, b = {w.hi == 0 ? (sh | (sl << 16)) : 0u, 0u, 0u, 0u};
    kidx = __builtin_bit_cast(bf16x8, a); slp = __builtin_bit_cast(bf16x8, b);
}
template <class RowO> __device__ __forceinline__ void store_o(const Wave& w, const f32x16 (&o)[2], const RowO& rowo) {
    LAS unsigned short* stg = (LAS unsigned short*)w.ost;
#pragma unroll
    for (int r = 0; r < 16; ++r) { const int q = (r & 3) + 8 * (r >> 2) + 4 * w.hi;
#pragma unroll
        for (int db = 0; db < 2; ++db) stg[q * 64 + db * 32 + w.r32] = (unsigned short)f2bf(o[db][r]); }
#pragma unroll
    for (int i = 0; i < 4; ++i) { const int row = i * 8 + (w.lane >> 3), ch = w.lane & 7; const u32x4 v = *(LAS u32x4*)((LAS unsigned char*)stg + row * 128 + ch * 16);
        bf16_t* dst = rowo(row); if (dst) *(u32x4*)(dst + ch * 8) = v; }
}
__device__ __forceinline__ void load_q(bf16x8 (&qf)[4], const bf16_t* qrow, int hi) {
#pragma unroll
    for (int ks = 0; ks < 4; ++ks) qf[ks] = *(const bf16x8*)(qrow + 16 * ks + 8 * hi);
}

constexpr int W_WSF = 98304, W_OST = W_WSF + 2048, W_ENUM = W_OST + 32768;
template <int NC> struct Pref { u32x4 k[NC], v[NC]; bf16x8 q[4]; };
template <int NC, class RowF> __device__ __forceinline__ void win_issue(Pref<NC>& P, const Wave& w, const bf16_t* kbase, const bf16_t* vbase, const RowF& rowoff, const bf16_t* qrow) {
#pragma unroll
    for (int c = 0; c < NC; ++c) { P.k[c] = *(const u32x4*)(kbase + rowoff(64 * c + 8 * w.wid + (w.lane >> 3)) + (w.lane & 7) * 8);
        P.v[c] = *(const u32x4*)(vbase + rowoff(64 * c + 16 * (w.wid & 3) + (w.lane >> 2)) + (w.wid >> 2) * 32 + (w.lane & 3) * 8); }
    load_q(P.q, qrow, w.hi);
}
template <int NC> __device__ __forceinline__ void win_commit(const Pref<NC>& P, const Wave& w) {
    constexpr int NK = 64 * NC;
#pragma unroll
    for (int c = 0; c < NC; ++c) { const int key = 64 * c + 8 * w.wid + (w.lane >> 3);
        *(LAS u32x4*)(w.lds + key * 128 + ((((w.lane & 7) ^ (key >> 1)) & 7) * 16)) = P.k[c];
        *(LAS u32x4*)(w.lds + NK * 128 + (w.wid >> 2) * (NK * 64) + (8 * c + 2 * (w.wid & 3)) * 512 + w.lane * 16) = P.v[c]; }
}
template <int NK> __device__ __forceinline__ f32x16 qk_win(const Wave& w, int u, const bf16x8 (&qf)[4], float init) {
    f32x16 acc;
#pragma unroll
    for (int r = 0; r < 16; ++r) acc[r] = init;
    LAS unsigned char* kp = w.lds + (32 * u + w.r32) * 128; const int x = (w.r32 >> 1) & 7;
#pragma unroll
    for (int ks = 0; ks < 4; ++ks) { const bf16x8 kf = *(LAS bf16x8*)(kp + (((2 * ks + w.hi) ^ x) * 16)); acc = ATT_MFMA(kf, qf[ks], acc); }
    return acc;
}
template <int NK> __device__ __forceinline__ void load_vfrags_win(const Wave& w, int u, VFrags& v) {
    LAS unsigned char* vb = w.lds + NK * 128 + w.vlo;
#pragma unroll
    for (int db = 0; db < 2; ++db)
#pragma unroll
        for (int s = 0; s < 2; ++s) { LAS unsigned char* vp = vb + db * (NK * 64) + (4 * u + 2 * s) * 512; v.f[db][s][0] = vtr(vp); v.f[db][s][1] = vtr(vp + 512); }
}
struct WSub { bool act; int u; int delta; int W; };
template <int NK>
__device__ __forceinline__ void softmax_win(const Wave& w, const bf16x8 (&qf)[4], const bf16x8& kidx, const bf16x8& slp, float slope, const WSub (&sd)[2], float& m, float& lsum, f32x16 (&o)[2], bool& first) {
    f32x16 s[2];
    bool any_act = false;
#pragma unroll
    for (int i = 0; i < 2; ++i) if (sd[i].act) { any_act = true; s[i] = qk_win<NK>(w, sd[i].u, qf, -slope * (float)sd[i].delta - m); s[i] = ATT_MFMA(kidx, slp, s[i]); }
    if (!any_act) return;
    float tm = -INFINITY;
#pragma unroll
    for (int i = 0; i < 2; ++i) if (sd[i].act) {
        if (sd[i].W >= 0) mask_band(s[i], sd[i].delta - 4 * w.hi, sd[i].W);
        float t = fmaxf(fmaxf(s[i][0], s[i][1]), fmaxf(s[i][2], s[i][3]));
#pragma unroll
        for (int r = 4; r < 16; r += 4) t = fmaxf(t, fmaxf(fmaxf(s[i][r], s[i][r + 1]), fmaxf(s[i][r + 2], s[i][r + 3])));
        tm = fmaxf(tm, t); }
    tm = max_xor32(tm);
    if (first || __any(tm > SM_THR)) {
        const float d = first ? (tm > -1.0e30f ? tm : 0.f) : fmaxf(tm, 0.f);
#pragma unroll
        for (int i = 0; i < 2; ++i) if (sd[i].act) {
#pragma unroll
            for (int r = 0; r < 16; ++r) s[i][r] -= d; }
        if (!first) { const float al = __builtin_amdgcn_exp2f(-d); lsum *= al; scale_rows(w, o, al); }
        m += d; first = false;
    }
#pragma unroll
    for (int i = 0; i < 2; ++i) if (sd[i].act) { VFrags vf; load_vfrags_win<NK>(w, sd[i].u, vf);
        float acc = 0.f;
#pragma unroll
        for (int r = 0; r < 16; ++r) { s[i][r] = __builtin_amdgcn_exp2f(s[i][r]); acc += s[i][r]; }
        lsum += acc;
        pv_frags(vf, s[i], o); }
}

__device__ __forceinline__ size_t ql_off(int bh, int j) { return (size_t)bh * QL_PER_BH + (size_t)(8192 * j - 128 * j * (j + 1)); }
__device__ __forceinline__ float* lsem_ptr(float* l0, float* l1, int slot) { return (slot < 2 ? l0 : l1) + (size_t)(slot & 1) * T * 4; }

struct Top3 { int i0, i1, i2; };
__device__ __forceinline__ Top3 moba_top3(const Wave& w, const bf16x8 (&qf)[4], const float* KMEAN, int b, int h, int own) {
    int i0 = -1, i1 = -1, i2 = -1;
    if (own > 0) {
    f32x16 g;
#pragma unroll
    for (int r = 0; r < 16; ++r) g[r] = 0.f;
    const float* km = KMEAN + ((size_t)(b * 4 + h) * 32 + w.r32) * HD + 8 * w.hi;
#pragma unroll
    for (int ks = 0; ks < 4; ++ks) { const f32x4 a0 = *(const f32x4*)(km + 16 * ks), a1 = *(const f32x4*)(km + 16 * ks + 4);
        const float x[8] = {a0.x, a0.y, a0.z, a0.w, a1.x, a1.y, a1.z, a1.w}; unsigned hw[4], lw[4];
#pragma unroll
        for (int j = 0; j < 4; ++j) { const unsigned h0 = f2bf(x[2 * j]), h1 = f2bf(x[2 * j + 1]); hw[j] = h0 | (h1 << 16);
            lw[j] = pk2(x[2 * j] - __builtin_bit_cast(float, h0 << 16), x[2 * j + 1] - __builtin_bit_cast(float, h1 << 16)); }
        const u32x4 hv = {hw[0], hw[1], hw[2], hw[3]}, lv = {lw[0], lw[1], lw[2], lw[3]};
        g = ATT_MFMA(__builtin_bit_cast(bf16x8, hv), qf[ks], g); g = ATT_MFMA(__builtin_bit_cast(bf16x8, lv), qf[ks], g); }
    float v0 = -INFINITY, v1 = -INFINITY, v2 = -INFINITY;
#pragma unroll
    for (int r = 0; r < 16; ++r) { const int blk = (r & 3) + 8 * (r >> 2) + 4 * w.hi; const float val = (blk < own) ? g[r] : -INFINITY;
        if (val > v0) { v2 = v1; i2 = i1; v1 = v0; i1 = i0; v0 = val; i0 = blk; } else if (val > v1) { v2 = v1; i2 = i1; v1 = val; i1 = blk; } else if (val > v2) { v2 = val; i2 = blk; } }
    const float pv_[3] = {get_xor32(v0, w.hi), get_xor32(v1, w.hi), get_xor32(v2, w.hi)}; const int pi_[3] = {get_xor32i(i0, w.hi), get_xor32i(i1, w.hi), get_xor32i(i2, w.hi)};
#pragma unroll
    for (int k = 0; k < 3; ++k) { const float val = pv_[k]; const int blk = pi_[k];
        if (val > v0 || (val == v0 && blk < i0)) { v2 = v1; i2 = i1; v1 = v0; i1 = i0; v0 = val; i0 = blk; }
        else if (val > v1 || (val == v1 && blk < i1)) { v2 = v1; i2 = i1; v1 = val; i1 = blk; }
        else if (val > v2 || (val == v2 && blk < i2)) { v2 = val; i2 = blk; } }
    }
    Top3 t; t.i0 = i0; t.i1 = i1; t.i2 = i2; return t;
}
__device__ __forceinline__ void moba_gate_unit(LAS unsigned char* lds, const bf16_t* QB, const float* KMEAN, unsigned* mcnt, unsigned* qlist, bf16_t* PM, float* LSEM0, float* LSEM1, int b, int h, int own, int tid) {
    const Wave w = make_wave(lds, tid);
    const size_t rowbase = (size_t)b * SEQ; const int qpos = own * 256 + 32 * w.wid + w.r32, bh = b * 4 + h;
    bf16x8 qf[4]; load_q(qf, QB + (rowbase + qpos) * DM + h * HD, w.hi);
    const Top3 t3 = moba_top3(w, qf, KMEAN, b, h, own); const int s0 = t3.i0, s1 = t3.i1, s2 = t3.i2;
    LAS unsigned* cl = (LAS unsigned*)(lds + W_ENUM);
    if (tid < 64) cl[tid] = 0u;
    __syncthreads();
    unsigned r0 = 0u, r1 = 0u, r2 = 0u;
    if (w.hi == 0) {
        if (s0 >= 0) r0 = __hip_atomic_fetch_add(cl + s0, 1u, __ATOMIC_RELAXED, __HIP_MEMORY_SCOPE_WORKGROUP);
        if (s1 >= 0) r1 = __hip_atomic_fetch_add(cl + s1, 1u, __ATOMIC_RELAXED, __HIP_MEMORY_SCOPE_WORKGROUP);
        if (s2 >= 0) r2 = __hip_atomic_fetch_add(cl + s2, 1u, __ATOMIC_RELAXED, __HIP_MEMORY_SCOPE_WORKGROUP);
    }
    __syncthreads();
    if (tid < 32) { const unsigned c = cl[tid]; cl[32 + tid] = c ? __hip_atomic_fetch_add(mcnt + bh * 32 + tid, c, __ATOMIC_RELAXED, __HIP_MEMORY_SCOPE_AGENT) : 0u; }
    __syncthreads();
    if (w.hi == 0) {
        const size_t tok = rowbase + qpos;
#define MOBA_EMIT(k, sk, rk) do { if (sk >= 0) qlist[ql_off(bh, sk) + cl[32 + sk] + rk] = (unsigned)qpos | ((unsigned)(k) << 13); \
            else { lsem_ptr(LSEM0, LSEM1, k)[tok * 4 + h] = -1.0e30f;          \
                u32x4* pz = (u32x4*)(PM + ((size_t)(k) * T + tok) * 256 + h * HD); const u32x4 z4 = {0u, 0u, 0u, 0u}; \
                _Pragma("unroll") for (int c = 0; c < 8; ++c) pz[c] = z4; } } while (0)
        MOBA_EMIT(0, s0, r0); MOBA_EMIT(1, s1, r1); MOBA_EMIT(2, s2, r2);
#undef MOBA_EMIT
    }
    __syncthreads();
}
struct OwnU { int b, h, own; };
__device__ __forceinline__ void own_issue(Pref<4>& P, const Wave& w, const OwnU& u, const bf16_t* QB, const bf16_t* KB, const bf16_t* VB) {
    const size_t rowbase = (size_t)u.b * SEQ; const int q0 = u.own * 256;
    win_issue<4>(P, w, KB + (rowbase + q0) * DM + u.h * HD, VB + (rowbase + q0) * DM + u.h * HD, [&](int key) { return (size_t)key * DM; }, QB + (rowbase + q0 + 32 * w.wid + w.r32) * DM + u.h * HD);
}
__device__ __forceinline__ void own_compute(const Wave& w, const OwnU& u, const bf16x8 (&qf)[4], bf16_t* OB, float* LSEM0, float* LSEM1) {
    const size_t rowbase = (size_t)u.b * SEQ; const int q0 = u.own * 256, ql = 32 * w.wid + w.r32;
    const float slope2 = exp2f(-2.0f * (float)(u.h + 1)) * LOG2E;
    bf16x8 kidx, slp; bias_frags(w, slope2, kidx, slp);
    f32x16 o[2];
#pragma unroll
    for (int r = 0; r < 16; ++r) { o[0][r] = 0.f; o[1][r] = 0.f; }
    float m = 0.f, lsum = 0.f; bool first = true;
#pragma unroll
    for (int p = 0; p < 4; ++p) { WSub sd[2];
#pragma unroll
        for (int i = 0; i < 2; ++i) { const int su = w.wid - 2 * p - i; sd[i].act = su >= 0; sd[i].u = su; sd[i].delta = ql - 32 * su; sd[i].W = (su == w.wid) ? 0x7fffffff : -1; }
        softmax_win<256>(w, qf, kidx, slp, slope2, sd, m, lsum, o, first); }
    const float l = sum_xor32(lsum);
    scale_rows(w, o, 1.0f / l);
    bf16_t* orow = OB + (rowbase + q0 + 32 * w.wid) * DM + u.h * HD;
    store_o(w, o, [&](int r) { return orow + (size_t)r * DM; });
    if (w.hi == 0) lsem_ptr(LSEM0, LSEM1, 3)[(rowbase + q0 + ql) * 4 + u.h] = m + __builtin_amdgcn_logf(l);
}
struct GatU { int b, h, j, cnt, chunk; const unsigned* ql; };
__device__ __forceinline__ unsigned gat_entry(const Wave& w, const GatU& u, bool& valid) { const int idx = u.chunk * 256 + 32 * w.wid + w.r32; valid = idx < u.cnt; return u.ql[valid ? idx : u.chunk * 256]; }
__device__ __forceinline__ void gat_issue(Pref<4>& P, const Wave& w, const GatU& u, const bf16_t* QB, const bf16_t* KB, const bf16_t* VB) {
    const size_t rowbase = (size_t)u.b * SEQ; bool valid; const unsigned e = gat_entry(w, u, valid);
    win_issue<4>(P, w, KB + (rowbase + u.j * 256) * DM + u.h * HD, VB + (rowbase + u.j * 256) * DM + u.h * HD, [&](int key) { return (size_t)key * DM; }, QB + (rowbase + (e & 8191u)) * DM + u.h * HD);
}
__device__ __forceinline__ void gat_compute(const Wave& w, const GatU& u, const bf16x8 (&qf)[4], bf16_t* PM, float* LSEM0, float* LSEM1) {
    const size_t rowbase = (size_t)u.b * SEQ; bool valid; const unsigned e = gat_entry(w, u, valid);
    const int qpos = (int)(e & 8191u), slot = (int)(e >> 13);
    const float slope2 = exp2f(-2.0f * (float)(u.h + 1)) * LOG2E;
    bf16x8 kidx, slp; bias_frags(w, slope2, kidx, slp);
    f32x16 o[2];
#pragma unroll
    for (int r = 0; r < 16; ++r) { o[0][r] = 0.f; o[1][r] = 0.f; }
    float m = 0.f, lsum = 0.f; bool first = true;
#pragma unroll
    for (int p = 0; p < 4; ++p) { WSub sd[2];
#pragma unroll
        for (int i = 0; i < 2; ++i) { const int su = 7 - 2 * p - i; sd[i].act = true; sd[i].u = su; sd[i].delta = qpos - (u.j * 256 + 32 * su); sd[i].W = -1; }
        softmax_win<256>(w, qf, kidx, slp, slope2, sd, m, lsum, o, first); }
    const float l = sum_xor32(lsum);
    scale_rows(w, o, l > 0.f ? 1.0f / l : 0.f);
    LAS int* code = (LAS int*)(w.wsf + 32);
    if (w.hi == 0) code[w.r32] = valid ? (int)((size_t)slot * T + rowbase + qpos) : -1;
    store_o(w, o, [&](int r) { const int c = code[r]; return c >= 0 ? PM + (size_t)c * 256 + u.h * HD : (bf16_t*)nullptr; });
    if (w.hi == 0 && valid) lsem_ptr(LSEM0, LSEM1, slot)[(rowbase + qpos) * 4 + u.h] = l > 0.f ? m + __builtin_amdgcn_logf(l) : -1.0e30f;
}

__device__ __forceinline__ void sb_unit(LAS unsigned char* lds, const bf16_t* QB, const bf16_t* KB, const bf16_t* VB, bf16_t* OB, int b, int h, int qt, int tid) {
    const Wave w = make_wave(lds, tid);
    const size_t rowbase = (size_t)b * SEQ; const int q0 = qt * 256, qpos = q0 + 32 * w.wid + w.r32;
    const bf16_t* kh = KB + rowbase * DM + h * HD; const bf16_t* vh = VB + rowbase * DM + h * HD;
    bf16x8 qf[4]; load_q(qf, QB + (rowbase + qpos) * DM + h * HD, w.hi);
    f32x16 o[2];
#pragma unroll
    for (int r = 0; r < 16; ++r) { o[0][r] = 0.f; o[1][r] = 0.f; }
    float carry = 0.f;
    bool done = false;
    volatile LAS unsigned* flg = (volatile LAS unsigned*)(lds + L_FLG);
    const int ti0 = q0 / 64 + 3;
    Stage sg;
    { const int kp = ti0 * 64; stage_load(sg, w, [&](int key) { return kh + (size_t)(kp + key) * DM; }, [&](int key) { return vh + (size_t)(kp + key) * DM; }); }
    stage_write(sg, w, 0);
    __syncthreads();
    for (int st = 0;; ++st) {
        const int buf = st & 1, ti = ti0 - st;
        if (ti > 0) { const int kp = (ti - 1) * 64; stage_load(sg, w, [&](int key) { return kh + (size_t)(kp + key) * DM; }, [&](int key) { return vh + (size_t)(kp + key) * DM; }); }
        if (!done) {
#pragma unroll
            for (int sub = 1; sub >= 0; --sub) {
                const int D = (q0 / 32 + w.wid) - (2 * ti + sub);
                if (D < 0) continue;
                const int delta0 = qpos - (64 * ti + 32 * sub) - 4 * w.hi;
                f32x16 z = qk_sub(w, buf, sub, qf, 0.f);
                f32x16 L;
#pragma unroll
                for (int r = 0; r < 16; ++r) { const float lp = __builtin_amdgcn_logf(1.0f + __builtin_amdgcn_exp2f(-fabsf(z[r]))); L[r] = -(fmaxf(z[r], 0.f) + lp); }
                if (D == 0) {
#pragma unroll
                    for (int r = 0; r < 16; ++r) { const int dl = delta0 - ((r & 3) + 8 * (r >> 2)); if (dl < 1) { L[r] = 0.f; z[r] = -INFINITY; } }
                }
                float G[4], PG[4];
#pragma unroll
                for (int g = 0; g < 4; ++g) { G[g] = (L[4 * g] + L[4 * g + 1]) + (L[4 * g + 2] + L[4 * g + 3]); PG[g] = get_xor32(G[g], w.hi); }
                float run = carry;
#pragma unroll
                for (int g = 3; g >= 0; --g) { const float t3 = run + (w.hi == 0 ? PG[g] : 0.f), t2 = t3 + L[4 * g + 3], t1 = t2 + L[4 * g + 2], t0 = t1 + L[4 * g + 1];
                    z[4 * g + 3] = __builtin_amdgcn_exp2f(z[4 * g + 3] + L[4 * g + 3] + t3); z[4 * g + 2] = __builtin_amdgcn_exp2f(z[4 * g + 2] + L[4 * g + 2] + t2);
                    z[4 * g + 1] = __builtin_amdgcn_exp2f(z[4 * g + 1] + L[4 * g + 1] + t1); z[4 * g] = __builtin_amdgcn_exp2f(z[4 * g] + L[4 * g] + t0);
                    run += G[g] + PG[g]; }
                carry = run;
                pv_sub(w, buf, sub, z, o);
            }
            done = __all(carry < -150.f);
        }
        if (w.lane == 0) flg[buf * 8 + w.wid] = done ? 1u : 0u;
        if (ti > 0) stage_write(sg, w, buf ^ 1);
        __syncthreads();
        unsigned all = 1u;
#pragma unroll
        for (int k = 0; k < 8; ++k) all &= flg[buf * 8 + k];
        if (all || ti == 0) break;
    }
    bf16_t* orow = OB + (rowbase + q0 + 32 * w.wid) * DM + h * HD;
    store_o(w, o, [&](int r) { return orow + (size_t)r * DM; });
    __syncthreads();
}

struct DilU { int b, h, dil, res, i2, c; };
__device__ __forceinline__ DilU dil_decode(int u) { const int n = u & 31, bhc = u >> 5, c = bhc % 3, bh = bhc / 3; DilU d; d.b = bh >> 3; d.h = 8 + (bh & 7); d.c = c;
    d.dil = (c == 0) ? 1 : (c == 1) ? 4 : 16; d.res = (c == 0) ? 0 : (c == 1) ? (n >> 3) : (n >> 1); d.i2 = (c == 0) ? n : (c == 1) ? (n & 7) : (n & 1); return d; }
__device__ __forceinline__ void dil_issue(Pref<6>& P, const Wave& w, const DilU& u, const bf16_t* QB, const bf16_t* KB, const bf16_t* VB) {
    const size_t rowbase = (size_t)u.b * SEQ; const int Q0 = 256 * u.i2, qj = Q0 + 32 * w.wid + w.r32; const size_t rstride = (size_t)u.dil * DM;
    win_issue<6>(P, w, KB + (rowbase + u.res) * DM + u.h * HD, VB + (rowbase + u.res) * DM + u.h * HD,
                 [&](int key) { const int kj = Q0 - 128 + key; return (size_t)(kj < 0 ? 0 : kj) * rstride; },
                 QB + (rowbase + u.res + (size_t)qj * u.dil) * DM + u.h * HD);
}
__device__ __forceinline__ void dil_compute(const Wave& w, const DilU& u, const bf16x8 (&qf)[4], bf16_t* OB, bf16_t* HB2, float* LSE) {
    const size_t rowbase = (size_t)u.b * SEQ; const int Q0 = 256 * u.i2, ql = 32 * w.wid + w.r32;
    const float slope2d = exp2f(-(float)(u.h - 8 + 1)) * LOG2E * (float)u.dil;
    bf16x8 kidx, slp; bias_frags(w, slope2d, kidx, slp);
    f32x16 o[2];
#pragma unroll
    for (int r = 0; r < 16; ++r) { o[0][r] = 0.f; o[1][r] = 0.f; }
    float m = 0.f, lsum = 0.f; bool first = true;
#pragma unroll
    for (int p = 0; p < 3; ++p) { WSub sd[2];
#pragma unroll
        for (int i = 0; i < 2; ++i) { const int D = 2 * p + i, su = w.wid + 4 - D; sd[i].act = (D <= 4) && (Q0 - 128 + 32 * su >= 0); sd[i].u = su; sd[i].delta = ql + 128 - 32 * su; sd[i].W = (D == 0 || D == 4) ? 128 : -1; }
        softmax_win<384>(w, qf, kidx, slp, slope2d, sd, m, lsum, o, first); }
    const float l = sum_xor32(lsum);
    scale_rows(w, o, 1.0f / l);
    bf16_t* PO = (u.c == 0) ? OB + 512 : HB2 + (u.c - 1) * 512;
    const size_t tok0 = rowbase + u.res + (size_t)(Q0 + 32 * w.wid) * u.dil;
    store_o(w, o, [&](int r) { return PO + (tok0 + (size_t)r * u.dil) * DM + (u.h - 8) * HD; });
    if (w.hi == 0) (LSE + (size_t)u.c * T * 8)[(tok0 + (size_t)w.r32 * u.dil) * 8 + (u.h - 8)] = m + __builtin_amdgcn_logf(l);
}

__device__ __forceinline__ void moba_gate_phase(LAS unsigned char* lds, const bf16_t* QB, const float* KMEAN, unsigned* mcnt, unsigned* qlist, bf16_t* PM, float* LSEM0, float* LSEM1, int v, int G, int tid) {
    for (int u = v; u < 512; u += G) { const int own = u & 31, bh = u >> 5; moba_gate_unit(lds, QB, KMEAN, mcnt, qlist, PM, LSEM0, LSEM1, bh >> 2, bh & 3, own, tid); }
}
struct AttnArgs { const bf16_t* QB; const bf16_t* KB; const bf16_t* VB; bf16_t* OB; bf16_t* HB2; float* LSE; const unsigned* mcnt; const unsigned* qlist; bf16_t* PM; float* LSEM0; float* LSEM1; };
__device__ __forceinline__ void attn_phase(LAS unsigned char* lds, const AttnArgs& A, int v, int G, int tid) {
    const Wave w = make_wave(lds, tid, W_WSF, W_OST);
    LAS int* cntl = (LAS int*)(lds + W_ENUM); LAS int* pa = cntl + 512; LAS int* pb = pa + 512;
    const int myc = (int)A.mcnt[tid], myu = (myc + 255) >> 8;
    cntl[tid] = myc; pa[tid] = myu;
    __syncthreads();
#pragma unroll 1
    for (int d = 1; d < 512; d <<= 1) { const int x = pa[tid] + (tid >= d ? pa[tid - d] : 0); pb[tid] = x; __syncthreads(); LAS int* t_ = pa; pa = pb; pb = t_; }
    const int total = pa[511];
    auto gat_decode = [&](int u) { int lo = 0, hi = 511;
        while (lo < hi) { const int mid = (lo + hi) >> 1; if (pa[mid] > u) hi = mid; else lo = mid + 1; }
        const int i = lo, c = cntl[i], bh = i >> 5; GatU g; g.b = bh >> 2; g.h = bh & 3; g.j = i & 31; g.cnt = c; g.chunk = u - (pa[i] - ((c + 255) >> 8)); g.ql = A.qlist + ql_off(bh, g.j); return g; };
    for (int u = v; u < total; u += G) { const GatU cur = gat_decode(u);
        __syncthreads();
        bf16x8 qf[4];
        { Pref<4> P; gat_issue(P, w, cur, A.QB, A.KB, A.VB); win_commit<4>(P, w); qf[0] = P.q[0]; qf[1] = P.q[1]; qf[2] = P.q[2]; qf[3] = P.q[3]; }
        __syncthreads();
        gat_compute(w, cur, qf, A.PM, A.LSEM0, A.LSEM1); }
    for (int u = v; u < 512; u += G) { OwnU cur; { const int bh = u >> 5; cur.b = bh >> 2; cur.h = bh & 3; cur.own = u & 31; }
        __syncthreads();
        bf16x8 qf[4];
        { Pref<4> P; own_issue(P, w, cur, A.QB, A.KB, A.VB); win_commit<4>(P, w); qf[0] = P.q[0]; qf[1] = P.q[1]; qf[2] = P.q[2]; qf[3] = P.q[3]; }
        __syncthreads();
        own_compute(w, cur, qf, A.OB, A.LSEM0, A.LSEM1); }
    for (int u = v; u < 3072; u += G) { const DilU cur = dil_decode(u);
        __syncthreads();
        bf16x8 qf[4];
        { Pref<6> P; dil_issue(P, w, cur, A.QB, A.KB, A.VB); win_commit<6>(P, w); qf[0] = P.q[0]; qf[1] = P.q[1]; qf[2] = P.q[2]; qf[3] = P.q[3]; }
        __syncthreads();
        dil_compute(w, cur, qf, A.OB, A.HB2, A.LSE); }
    __syncthreads();
    for (int u = v; u < 512; u += G) { const int qt = u & 31, bh = u >> 5; sb_unit(lds, A.QB, A.KB, A.VB, A.OB, bh >> 2, 4 + (bh & 3), qt, tid); }
}
}

constexpr int PH_PRO = 0, PH_L0 = 1, PH_PER_LAYER = 10, PH_FINAL = PH_L0 + DEPTH * PH_PER_LAYER, PH_COUNT = PH_FINAL + 1;
typedef const __attribute__((address_space(4))) Args* KArgP;
#define KARG() ({ KArgP p_ = (KArgP)__builtin_amdgcn_kernarg_segment_ptr(); asm volatile("" : "+s"(p_)); p_; })
#define PHASE_IDS int lane_p = (int)__builtin_amdgcn_mbcnt_hi(~0u, __builtin_amdgcn_mbcnt_lo(~0u, 0u)); LAUNDER_V(lane_p); int tid_p = wave * 64 + lane_p; int gw_p = gw; LAUNDER_S(gw_p)
__global__ void __launch_bounds__(NTHREADS, 2) fwd(Args a_unused) {
    extern __shared__ __attribute__((aligned(16))) unsigned char lds_raw[];
    LAS unsigned char* lds = (LAS unsigned char*)lds_raw;
    volatile LAS unsigned* MISC = (volatile LAS unsigned*)(lds + MISC_OFF);
    const int wave = __builtin_amdgcn_readfirstlane((int)threadIdx.x >> 6);
    const int G = gridDim.x, bx = blockIdx.x;
    const int vcu = (G % 8 == 0) ? (bx % 8) * (G / 8) + bx / 8 : bx;
    const int gw = vcu * NWAVES + wave, NGW = G * NWAVES;
    for (int u = threadIdx.x; u < (LDS_BYTES - LDSCTL_OFF) / 4; u += NTHREADS) ((LAS unsigned*)(lds + LDSCTL_OFF))[u] = 0u;
    __syncthreads();
    int lo, hi; XcdBarrier bar;
    { KArgP ka = KARG(); lo = ka->ph_lo; hi = ka->ph_hi; unsigned* ctl = (unsigned*)(ka->ws + WS_CTL); bar = xcd_barrier_post(ctl + CW_BAR + ka->li * XCD_BAR_WORDS, MISC + 8, wave); }
#define IN(k) (lo <= (k) && (k) < hi)
#define SEAM(k) do { if (IN(k) && IN((k) + 1)) xcd_barrier(bar); } while (0)
#define WSP(T_, off) ((T_*)(ws + (off)))

    if (IN(PH_PRO)) { KArgP ka = KARG(); PHASE_IDS; Args a; a.ws = ka->ws; a.w_in = ka->w_in; a.w_out = ka->w_out; a.w_gate = ka->w_gate; a.w_up = ka->w_up; a.w_down = ka->w_down; phase_prologue(a, lds, gw_p, NGW, wave, lane_p); } SEAM(PH_PRO);

    for (int l = 0; l < DEPTH; ++l) {
        const int p0 = PH_L0 + l * PH_PER_LAYER;
        if (hi <= p0 || lo >= p0 + PH_PER_LAYER) continue;
        if (IN(p0 + 0)) for (int rep_ = 0; rep_ < RPT(0); ++rep_) { if (rep_) xcd_barrier(bar); KArgP ka = KARG(); PHASE_IDS; unsigned char* ws = ka->ws; const float* xin = (l == 0) ? ka->x : ka->out;
            phase_norm1(xin, ka->ln1_g + (size_t)l * DM, WSP(bf16_t, WS_HB), gw_p, NGW, lane_p); } SEAM(p0 + 0);
        if (IN(p0 + 1)) for (int rep_ = 0; rep_ < RPT(1); ++rep_) { if (rep_) xcd_barrier(bar); KArgP ka = KARG(); PHASE_IDS; unsigned char* ws = ka->ws;
            pg8::Gemm g{(const char*)(ws + WS_HB), (const char*)(ws + WS_WIN) + (size_t)l * NQKV * DM * 2, DM, DM, DM, (long)256 * DM * 2, (long)256 * DM * 2, (long)128 * DM * 2};
            pg8::StaticOrder S; S.init(T / 256, NQKV / 256, G, bx);
            pg8::EpiQKV E{WSP(bf16_t, WS_Q), (size_t)(WS_K - WS_Q) / 2, QSCALE};
            pg8::gemm_phase<pg8::EpiQKV, pg8::StaticOrder>(lds, g, S, E, wave);
        } SEAM(p0 + 1);
        if (IN(p0 + 2)) { KArgP ka = KARG(); PHASE_IDS; unsigned char* ws = ka->ws; phase_kmean(WSP(bf16_t, WS_K), WSP(float, WS_KMEAN), gw_p, NGW, lane_p); } SEAM(p0 + 2);
        if (IN(p0 + 3)) { KArgP ka = KARG(); PHASE_IDS; unsigned char* ws = ka->ws;
            att::moba_gate_phase(lds, WSP(bf16_t, WS_Q), WSP(float, WS_KMEAN), WSP(unsigned, WS_CTL) + CW_MCNT + l * 512, WSP(unsigned, WS_QLIST), WSP(bf16_t, WS_PM), WSP(float, WS_LSEM0), WSP(float, WS_LSEM1), vcu, G, tid_p);
        } SEAM(p0 + 3);
        if (IN(p0 + 4)) for (int rep_ = 0; rep_ < RPT(4); ++rep_) { if (rep_) xcd_barrier(bar); KArgP ka = KARG(); PHASE_IDS; unsigned char* ws = ka->ws;
            const att::AttnArgs A{WSP(bf16_t, WS_Q), WSP(bf16_t, WS_K), WSP(bf16_t, WS_V), WSP(bf16_t, WS_O), WSP(bf16_t, WS_HB), WSP(float, WS_LSE), WSP(unsigned, WS_CTL) + CW_MCNT + l * 512, WSP(unsigned, WS_QLIST),
                                  WSP(bf16_t, WS_PM), WSP(float, WS_LSEM0), WSP(float, WS_LSEM1)};
            att::attn_phase(lds, A, vcu, G, tid_p);
        } SEAM(p0 + 4);
        if (IN(p0 + 5)) { KArgP ka = KARG(); PHASE_IDS; unsigned char* ws = ka->ws;
            phase_mixnorm(WSP(bf16_t, WS_O), WSP(bf16_t, WS_HB), WSP(float, WS_LSE), WSP(bf16_t, WS_PM), WSP(float, WS_LSEM0), WSP(float, WS_LSEM1), ka->mix_g + (size_t)l * DM, gw_p, NGW, lane_p); } SEAM(p0 + 5);
        if (IN(p0 + 6)) { KArgP ka = KARG(); PHASE_IDS; unsigned char* ws = ka->ws; const float* xin = (l == 0) ? ka->x : ka->out;
            pg8::Gemm g{(const char*)(ws + WS_HB), (const char*)(ws + WS_WOUT) + (size_t)l * DM * DM * 2, DM, DM, DM, (long)256 * DM * 2, (long)256 * DM * 2, (long)128 * DM * 2};
            pg8::StaticOrder S; S.init(T / 256, DM / 256, G, bx);
            pg8::EpiResAdd E{xin, ka->out};
            pg8::gemm_phase<pg8::EpiResAdd, pg8::StaticOrder>(lds, g, S, E, wave);
        } SEAM(p0 + 6);
        if (IN(p0 + 7)) { KArgP ka = KARG(); PHASE_IDS; unsigned char* ws = ka->ws;
            phase_route(ka->out, ka->ln2_g + (size_t)l * DM, ka->w_gr + (size_t)l * DM * 4, ka->b_gr + l * 4, ka->w_er + (size_t)l * 4 * DM * 4, ka->b_er + l * 16, WSP(bf16_t, WS_HB),
                        WSP(unsigned, WS_CTL) + CW_CNT + l * 32, WSP(unsigned, WS_LIST), WSP(float, WS_WLIST), lds, vcu, G, wave, lane_p); } SEAM(p0 + 7);
        if (IN(p0 + 8)) for (int rep_ = 0; rep_ < RPT(8); ++rep_) { if (rep_) xcd_barrier(bar); KArgP ka = KARG(); PHASE_IDS; unsigned char* ws = ka->ws;
            pg8::MoeProb<0> P{WSP(unsigned, WS_CTL) + CW_CNT + l * 32, WSP(unsigned, WS_LIST), (const char*)(ws + WS_HB), (const char*)(ws + WS_WG) + (size_t)l * NACT * DM * 2, DM, DM, DM, (long)(WS_WU - WS_WG), G, vcu, WSP(unsigned, WS_CTL) + CW_TCNT + l * 16384};
            pg8::EpiGateUpSparse E{WSP(bf16_t, WS_ACT), WSP(float, WS_WLIST), WSP(unsigned, WS_CTL) + CW_TCNT + l * 16384};
            pg8::gemm_phase_x<pg8::EpiGateUpSparse, pg8::MoeProb<0>>(lds, P, E, wave);
        }
        if (IN(p0 + 9)) { KArgP ka = KARG(); PHASE_IDS; unsigned char* ws = ka->ws;
            pg8::MoeProb<1> P{WSP(unsigned, WS_CTL) + CW_CNT + l * 32, WSP(unsigned, WS_LIST), (const char*)(ws + WS_ACT), (const char*)(ws + WS_WD) + (size_t)l * DM * NACT * 2, 512, NACT, 512, (long)128 * NACT * 2, G, G - 1 - vcu, WSP(unsigned, WS_CTL) + CW_TCNT + l * 16384};
            pg8::EpiDownScatter E{ka->out, WSP(unsigned, WS_LIST)};
            pg8::gemm_phase_x<pg8::EpiDownScatter, pg8::MoeProb<1>>(lds, P, E, wave);
        } SEAM(p0 + 9);
    }
    if (IN(PH_FINAL)) { KArgP ka = KARG(); PHASE_IDS; phase_final(ka->out, ka->fin_g, gw_p, NGW, lane_p); }
#undef IN
#undef SEAM
#undef WSP
}

#ifndef N_LAUNCH_MODE
#define N_LAUNCH_MODE 1
#endif
extern "C" void kernel_launch(void* const* d_in, const int* in_sizes, int n_in, void* d_out, int out_size, void* d_ws, size_t ws_size, hipStream_t stream) {
    static int grid = 0;
    if (grid == 0) {
        if (n_in != 14 || in_sizes[0] != T * DM || out_size != T * DM || ws_size < WS_END) { fprintf(stderr, "kernel_launch: unexpected shapes (n_in %d in0 %d out %d ws %zu)\n", n_in, n_in > 0 ? in_sizes[0] : -1, out_size, ws_size); grid = -1; return; }
        int dev = 0, cus = 0, per_cu = 0;
        if (hipGetDevice(&dev) != hipSuccess || hipDeviceGetAttribute(&cus, hipDeviceAttributeMultiprocessorCount, dev) != hipSuccess) { grid = -1; return; }
        if (hipFuncSetAttribute((const void*)fwd, hipFuncAttributeMaxDynamicSharedMemorySize, LDS_BYTES) != hipSuccess) { fprintf(stderr, "kernel_launch: hipFuncSetAttribute failed\n"); grid = -1; return; }
        if (hipOccupancyMaxActiveBlocksPerMultiprocessor(&per_cu, (const void*)fwd, NTHREADS, LDS_BYTES) != hipSuccess || per_cu < 1) fprintf(stderr, "kernel_launch: occupancy query says %d\n", per_cu);
        (void)hipGetLastError();
        grid = cus;
    }
    if (grid < 0) return;
    if (hipMemsetAsync((char*)d_ws + WS_CTL, 0, CTL_ZERO_BYTES, stream) != hipSuccess) return;
    Args a{};
    a.x = (const float*)d_in[0]; a.ln1_g = (const float*)d_in[1]; a.w_in = (const float*)d_in[2]; a.mix_g = (const float*)d_in[3]; a.w_out = (const float*)d_in[4]; a.ln2_g = (const float*)d_in[5];
    a.w_gr = (const float*)d_in[6]; a.b_gr = (const float*)d_in[7]; a.w_er = (const float*)d_in[8]; a.b_er = (const float*)d_in[9]; a.w_gate = (const float*)d_in[10]; a.w_up = (const float*)d_in[11];
    a.w_down = (const float*)d_in[12]; a.fin_g = (const float*)d_in[13];
    a.out = (float*)d_out; a.ws = (unsigned char*)d_ws; a.pad = 0;
#if N_LAUNCH_MODE == 1
    a.ph_lo = 0; a.ph_hi = PH_COUNT; a.li = 0;
    hipLaunchKernelGGL(fwd, dim3(grid), dim3(NTHREADS), LDS_BYTES, stream, a);
#else
    for (int p = 0; p < PH_COUNT; ++p) { a.ph_lo = p; a.ph_hi = p + 1; a.li = p; hipLaunchKernelGGL(fwd, dim3(grid), dim3(NTHREADS), LDS_BYTES, stream, a); }
#endif
}
```

```cpp
#include <hip/hip_runtime.h>
#include <cstdio>
#include <cstdint>

#define LAS __attribute__((address_space(3)))
#define GAS __attribute__((address_space(1)))
typedef unsigned short bf16_t;
typedef short bf16x8 __attribute__((ext_vector_type(8)));
typedef float f32x4 __attribute__((ext_vector_type(4)));
typedef float f32x2 __attribute__((ext_vector_type(2)));
typedef unsigned u32x4 __attribute__((ext_vector_type(4)));
typedef unsigned u32x2 __attribute__((ext_vector_type(2)));

#ifndef PROBE_REPEAT
#define PROBE_REPEAT 0
#endif
#define RPT(k) ((((PROBE_REPEAT) >> (k)) & 1) ? 2 : 1)
#ifndef MOE_SPARSE
#define MOE_SPARSE 1
#endif
#ifndef ATT_MOBA
#define ATT_MOBA 1
#endif
#ifndef ATT_SB
#define ATT_SB 1
#endif
#ifndef ATT_DIL
#define ATT_DIL 1
#endif
constexpr int BATCH = 4, SEQ = 8192, DM = 1024, DEPTH = 4, T = BATCH * SEQ, NH = 16, HD = 64;
constexpr int NQKV = 3 * DM, NEXP = 16, DEXP = 256, NACT = NEXP * DEXP;
constexpr float NORM_EPS = 1e-6f;
constexpr float LOG2E = 1.4426950408889634f;
constexpr float QSCALE = 0.125f * LOG2E;
constexpr int NWAVES = 8, NTHREADS = 512;

constexpr size_t MiB = 1u << 20;
constexpr size_t WS_CTL = 0, CTL_ZERO_BYTES = 1 * MiB;
constexpr size_t WS_WIN = 2 * MiB;
constexpr size_t WS_WOUT = 26 * MiB;
constexpr size_t WS_WG = 34 * MiB;
constexpr size_t WS_WU = 66 * MiB;
constexpr size_t WS_WD = 98 * MiB;
constexpr size_t WS_LSEM0 = 1 * MiB;
constexpr size_t WS_KMEAN = 130 * MiB;
constexpr size_t WS_HB = 131 * MiB;
constexpr size_t WS_Q = 195 * MiB, WS_K = 259 * MiB, WS_V = 323 * MiB, WS_O = 387 * MiB;
constexpr size_t WS_ACT = WS_Q;
constexpr size_t WS_LSE = 451 * MiB;
constexpr size_t WS_LIST = 454 * MiB;
constexpr size_t WS_WLIST = 457 * MiB;
constexpr size_t WS_QLIST = WS_LIST;
constexpr size_t WS_PM = 463 * MiB;
constexpr size_t WS_LSEM1 = 511 * MiB;
constexpr size_t WS_END = 512 * MiB;
constexpr int QL_PER_BH = 126976;
constexpr int CW_MCNT = 2048;
constexpr int CW_CNT = 1024;
constexpr int CW_TCNT = 16384;
constexpr int CW_BAR = 4096;

constexpr int RING_BYTES = 131072;
constexpr int LDSCTL_OFF = 147456, MISC_OFF = LDSCTL_OFF + 320;
constexpr int LDS_BYTES = 148480;

__device__ __forceinline__ unsigned f2bf(float f) { unsigned u = __builtin_bit_cast(unsigned, f); return (u + 0x7fffu + ((u >> 16) & 1u)) >> 16; }
__device__ __forceinline__ unsigned pk2(float lo, float hi) { return f2bf(lo) | (f2bf(hi) << 16); }
__device__ __forceinline__ float bflo(unsigned w) { return __builtin_bit_cast(float, w << 16); }
__device__ __forceinline__ float bfhi(unsigned w) { return __builtin_bit_cast(float, w & 0xffff0000u); }
template <int M> __device__ __forceinline__ float swz_xor(float v) { return __builtin_bit_cast(float, __builtin_amdgcn_ds_swizzle(__builtin_bit_cast(int, v), 0x1f | (M << 10))); }
__device__ __forceinline__ void swap32(unsigned x, unsigned& lo_val, unsigned& hi_val) { unsigned y = x; asm volatile("" : "+v"(y)); auto rr = __builtin_amdgcn_permlane32_swap(x, y, false, false); lo_val = rr[0]; hi_val = rr[1]; }
__device__ __forceinline__ float sum_xor32(float v) { unsigned a, b; swap32(__builtin_bit_cast(unsigned, v), a, b); return __builtin_bit_cast(float, a) + __builtin_bit_cast(float, b); }
__device__ __forceinline__ float max_xor32(float v) { unsigned a, b; swap32(__builtin_bit_cast(unsigned, v), a, b); return fmaxf(__builtin_bit_cast(float, a), __builtin_bit_cast(float, b)); }
__device__ __forceinline__ float get_xor32(float v, int hi) { unsigned a, b; swap32(__builtin_bit_cast(unsigned, v), a, b); return __builtin_bit_cast(float, hi ? a : b); }
__device__ __forceinline__ int get_xor32i(int v, int hi) { unsigned a, b; swap32((unsigned)v, a, b); return (int)(hi ? a : b); }
template <int CTRL> __device__ __forceinline__ float dpp_mov(float v) { return __builtin_bit_cast(float, __builtin_amdgcn_update_dpp(0, __builtin_bit_cast(int, v), CTRL, 0xf, 0xf, false)); }
__device__ __forceinline__ float row_sum(float v) { v += dpp_mov<0xB1>(v); v += dpp_mov<0x4E>(v); v += dpp_mov<0x141>(v); v += dpp_mov<0x140>(v); return v; }
__device__ __forceinline__ float half_sum(float v) { v = row_sum(v); v += swz_xor<16>(v); return v; }
__device__ __forceinline__ float wave_sum(float v) { return sum_xor32(half_sum(v)); }
#define LDS_WAIT() asm volatile("s_waitcnt lgkmcnt(0)" ::: "memory")
#define LAUNDER_V(x) asm volatile("" : "+v"(x))
#define LAUNDER_S(x) asm volatile("" : "+s"(x))

namespace pg8 {
constexpr int BM = 256, BK = 64, HALF = 128, HTB = HALF * BK * 2, STAGE_BYTES = 8 * HTB, NXCD = 8, WGM = 8;
__host__ __device__ __forceinline__ int lds_byte(int r, int c) { const int st = (r >> 4) * 2 + (c >> 5), rr = r & 15, cc = c & 31, ob = rr * 64 + cc * 2; return st * 1024 + (ob ^ (((ob >> 9) & 1) << 5)); }
__host__ __device__ __forceinline__ void stage_rc(int b, int& R, int& C) { const int st = b / 1024, sb = b % 1024, swz = sb ^ (((sb >> 9) & 1) << 5); R = (st >> 1) * 16 + swz / 64; C = (st & 1) * 32 + (swz % 64) / 2; }
__host__ __device__ __forceinline__ int perm32(int rho) { const int n = rho >> 4, i = rho & 15; return 8 * (i >> 2) + 4 * n + (i & 3); }

struct Unit { int pm, pn, meta;
    __device__ __forceinline__ int bk() const { return meta & 31; } __device__ __forceinline__ int tib() const { return (meta >> 5) & 255; } __device__ __forceinline__ int nb() const { return meta >> 13; } };
struct Gemm { const char* A; const char* B; int lda, ldb, K; long tstepA, tstepB, hstepB; };

struct StaticOrder {
    int nM, nN, nwg, G, c;
    __host__ __device__ void init(int nM_, int nN_, int G_, int c_) { nM = nM_; nN = nN_; nwg = nM * nN; G = G_; c = c_; }
    __host__ __device__ bool next(int i, Unit& u) const {
        const long L = (long)i * G + c; if (L >= nwg) return false;
        int wgid = (int)L; { const int q = nwg / NXCD, r = nwg % NXCD, xcd = wgid % NXCD, off = wgid / NXCD; wgid = (xcd < r ? xcd * (q + 1) : r * (q + 1) + (xcd - r) * q) + off; }
        const int nig = WGM * nN, gid = wgid / nig, fm = gid * WGM, gsz = (nM - fm) < WGM ? (nM - fm) : WGM;
        u.pm = fm + ((wgid % nig) % gsz); u.pn = (wgid % nig) / gsz; return true;
    }
};

__device__ __forceinline__ unsigned cvt_pk_bf16(float lo, float hi) { unsigned r; asm volatile("v_cvt_pk_bf16_f32 %0, %1, %2" : "=v"(r) : "v"(lo), "v"(hi)); return r; }

struct EpiQKV {
    static constexpr bool PERM = true;
    bf16_t* O; size_t split_stride; float scale0;
    __device__ __forceinline__ void operator()(const f32x4 (&acc)[2][2][4][2], const Unit& u, int wr, int wc, int fr, int fq) const {
        asm volatile("" : "+v"(fr), "+v"(fq));
        const int row0 = u.pm * BM + wr * 64 + fr; int colt = u.pn * BM;
        const int t = colt / DM; bf16_t* base = O + (size_t)t * split_stride; colt -= t * DM; const float sc = (t == 0) ? scale0 : 1.f;
        const int col0 = colt + wc * 32 + 8 * fq;
#pragma unroll
        for (int ai = 0; ai < 2; ++ai)
#pragma unroll
            for (int m = 0; m < 4; ++m) { bf16_t* rowp = base + (size_t)(row0 + ai * HALF + m * 16) * DM + col0;
#pragma unroll
                for (int bj = 0; bj < 2; ++bj) { f32x4 v0 = acc[ai][bj][m][0] * sc, v1 = acc[ai][bj][m][1] * sc;
                    u32x4 w; w.x = cvt_pk_bf16(v0[0], v0[1]); w.y = cvt_pk_bf16(v0[2], v0[3]); w.z = cvt_pk_bf16(v1[0], v1[1]); w.w = cvt_pk_bf16(v1[2], v1[3]);
                    *(u32x4*)(rowp + bj * HALF) = w; } }
        if (u.pn == 4) {
            float* kmean = (float*)((unsigned char*)O - WS_Q + WS_KMEAN) + ((size_t)((u.pm >> 5) * 4) * 32 + (u.pm & 31)) * HD;
#pragma unroll
            for (int bj = 0; bj < 2; ++bj)
#pragma unroll
                for (int n = 0; n < 2; ++n)
#pragma unroll
                    for (int j = 0; j < 4; ++j) { float cs = 0.f;
#pragma unroll
                        for (int ai = 0; ai < 2; ++ai)
#pragma unroll
                            for (int m = 0; m < 4; ++m) cs += acc[ai][bj][m][n][j];
                        cs = row_sum(cs);
                        const int col = bj * HALF + wc * 32 + 8 * fq + 4 * n + j;
                        if (fr == 0) __hip_atomic_fetch_add(kmean + (size_t)(col >> 6) * 32 * HD + (col & 63), cs, __ATOMIC_RELAXED, __HIP_MEMORY_SCOPE_AGENT); }
        }
    }
};
struct EpiResAdd {
    static constexpr bool PERM = false;
    const float* base; float* out;
    __device__ __forceinline__ void operator()(const f32x4 (&acc)[2][2][4][2], const Unit& u, int wr, int wc, int fr, int fq) const {
        asm volatile("" : "+v"(fr), "+v"(fq));
        const int col0 = u.pn * BM + wc * 32 + 4 * fq;
#pragma unroll
        for (int ai = 0; ai < 2; ++ai)
#pragma unroll
            for (int m = 0; m < 4; ++m) { const size_t off = (size_t)(u.pm * BM + ai * HALF + wr * 64 + m * 16 + fr) * DM + col0;
#pragma unroll
                for (int bj = 0; bj < 2; ++bj)
#pragma unroll
                    for (int n = 0; n < 2; ++n) { const f32x4 bs = *(const f32x4*)(base + off + bj * HALF + n * 16); *(f32x4*)(out + off + bj * HALF + n * 16) = bs + acc[ai][bj][m][n]; } }
    }
};
struct EpiGateUpDense {
    static constexpr bool PERM = true;
    bf16_t* act; const float* comb;
    __device__ __forceinline__ void operator()(const f32x4 (&acc)[2][2][4][2], const Unit& u, int wr, int wc, int fr, int fq) const {
        asm volatile("" : "+v"(fr), "+v"(fq));
        const int e = u.pn >> 1, c0 = (u.pn & 1) * HALF;
        const int col0 = e * DEXP + c0 + wc * 32 + 8 * fq;
#pragma unroll
        for (int ai = 0; ai < 2; ++ai)
#pragma unroll
            for (int m = 0; m < 4; ++m) { const int row = u.pm * BM + ai * HALF + wr * 64 + m * 16 + fr;
                const float cw = comb[(size_t)row * NEXP + e];
                float o[8];
#pragma unroll
                for (int n = 0; n < 2; ++n)
#pragma unroll
                    for (int j = 0; j < 4; ++j) { const float g = acc[ai][0][m][n][j], up = acc[ai][1][m][n][j];
                        const float sg = g * __builtin_amdgcn_rcpf(1.f + __builtin_amdgcn_exp2f(-g * LOG2E));
                        o[n * 4 + j] = sg * up * cw; }
                u32x4 w; w.x = cvt_pk_bf16(o[0], o[1]); w.y = cvt_pk_bf16(o[2], o[3]); w.z = cvt_pk_bf16(o[4], o[5]); w.w = cvt_pk_bf16(o[6], o[7]);
                *(u32x4*)(act + (size_t)row * NACT + col0) = w; }
    }
};

template <class Epi, class Sched>
__device__ __forceinline__ void gemm_phase(LAS unsigned char* lds, const Gemm g, const Sched& S, const Epi& E, int wave_id) {
    int lane_l = (int)__builtin_amdgcn_mbcnt_hi(~0u, __builtin_amdgcn_mbcnt_lo(~0u, 0u)); asm volatile("" : "+v"(lane_l));
    const int wid = wave_id, lane = lane_l, tid = wid * 64 + lane, wr = wid >> 2, wc = wid & 3, fr = lane & 15, fq = lane >> 4;
    const int K = g.K, nt = K / BK;
    unsigned voffA[2], voffB[2];
#pragma unroll
    for (int i = 0; i < 2; ++i) { int R, C; stage_rc(tid * 16 + i * 8192, R, C); const int Rb = Epi::PERM ? ((R & ~31) + perm32(R & 31)) : R;
        voffA[i] = (unsigned)(R * g.lda + C) * 2u; voffB[i] = (unsigned)(Rb * g.ldb + C) * 2u; }
    const size_t kstep = (size_t)(BK * 2);
    const size_t hstepA = (size_t)HALF * g.lda * 2;
    const long hstepB = g.hstepB;
    const unsigned ldsw = (unsigned)wid * 1024u;
    const int aoff = lds_byte(wr * 64 + fr, fq * 8), boff = lds_byte(wc * 32 + fr, fq * 8);
#define PG8_SA(b, h) (((b) * 2 + (h)) * HTB)
#define PG8_SB(b, h) ((4 + (b) * 2 + (h)) * HTB)
#define PG8_STAGE(bufoff, gbase, voff) do { _Pragma("unroll") for (int _i = 0; _i < 2; ++_i) \
        __builtin_amdgcn_global_load_lds((const unsigned*)((const char*)(gbase) + (voff)[_i]), (LAS unsigned*)(lds + (bufoff) + ldsw + _i * 8192), 16, 0, 0); } while (0)
#define PG8_LDA(dst, b, h) do { _Pragma("unroll") for (int m = 0; m < 4; ++m) _Pragma("unroll") for (int k = 0; k < 2; ++k) dst[m][k] = *(const LAS bf16x8*)(lds + PG8_SA(b, h) + aoff + m * 2048 + k * 1024); } while (0)
#define PG8_LDB(dst, b, h) do { _Pragma("unroll") for (int n = 0; n < 2; ++n) _Pragma("unroll") for (int k = 0; k < 2; ++k) dst[n][k] = *(const LAS bf16x8*)(lds + PG8_SB(b, h) + boff + n * 2048 + k * 1024); } while (0)
#define PG8_MMA(ai, bj, At, Bt) do { __builtin_amdgcn_s_setprio(1); _Pragma("unroll") for (int m = 0; m < 4; ++m) _Pragma("unroll") for (int n = 0; n < 2; ++n) _Pragma("unroll") for (int k = 0; k < 2; ++k) \
        acc[ai][bj][m][n] = __builtin_amdgcn_mfma_f32_16x16x32_bf16(Bt[n][k], At[m][k], acc[ai][bj][m][n], 0, 0, 0); __builtin_amdgcn_s_setprio(0); } while (0)
#define PG8_WAIT_V(n) asm volatile("s_waitcnt vmcnt(" #n ")" ::: "memory")
#define PG8_WAIT_L(n) asm volatile("s_waitcnt lgkmcnt(" #n ")" ::: "memory")
#define PG8_BAR __builtin_amdgcn_s_barrier()
#define PG8_SCHED __builtin_amdgcn_sched_barrier(0)
    Unit cur, nxt; int ui = 0;
    if (!S.next(0, cur)) return;
    f32x4 acc[2][2][4][2];
#pragma unroll
    for (int a = 0; a < 2; ++a)
#pragma unroll
        for (int b = 0; b < 2; ++b)
#pragma unroll
            for (int m = 0; m < 4; ++m)
#pragma unroll
                for (int n = 0; n < 2; ++n) acc[a][b][m][n] = (f32x4){0.f, 0.f, 0.f, 0.f};
    bf16x8 At[4][2], B0[2][2], B1[2][2];
    const char* cA = g.A + (size_t)cur.pm * g.tstepA; const char* cB = g.B + (size_t)cur.pn * g.tstepB;
    PG8_STAGE(PG8_SB(0, 0), cB, voffB); PG8_STAGE(PG8_SB(0, 1), cB + hstepB, voffB); PG8_STAGE(PG8_SA(0, 0), cA, voffA); PG8_STAGE(PG8_SA(0, 1), cA + hstepA, voffA);
    if (wr == 1) PG8_BAR;
    PG8_WAIT_V(2); PG8_BAR;
    PG8_STAGE(PG8_SB(1, 0), cB + kstep, voffB); PG8_STAGE(PG8_SA(1, 0), cA + kstep, voffA); PG8_STAGE(PG8_SB(1, 1), cB + hstepB + kstep, voffB);
    PG8_WAIT_V(6); PG8_BAR;
    for (;;) {
        const bool has_next = S.next(ui + 1, nxt);
        const char* nA = has_next ? g.A + (size_t)nxt.pm * g.tstepA : cA; const char* nB = has_next ? g.B + (size_t)nxt.pn * g.tstepB : cB;
        for (int t = 0; t < nt; t += 2) {
            const bool last = (t == nt - 2);
            const char* a1 = cA + (size_t)(t + 1) * kstep;
            const char* a2 = last ? nA : cA + (size_t)(t + 2) * kstep; const char* b2 = last ? nB : cB + (size_t)(t + 2) * kstep;
            const char* a3 = a2 + kstep; const char* b3 = b2 + kstep;
            PG8_LDB(B0, 0, 0); PG8_LDB(B1, 0, 1); PG8_SCHED; PG8_LDA(At, 0, 0); PG8_STAGE(PG8_SA(1, 1), a1 + hstepA, voffA);
            PG8_WAIT_V(8); PG8_WAIT_L(0); PG8_BAR; PG8_MMA(0, 0, At, B0); PG8_MMA(0, 1, At, B1); PG8_BAR; PG8_SCHED;
            PG8_LDA(At, 0, 1); PG8_STAGE(PG8_SB(0, 0), b2, voffB); PG8_STAGE(PG8_SB(0, 1), b2 + hstepB, voffB); PG8_STAGE(PG8_SA(0, 0), a2, voffA);
            PG8_WAIT_V(8); PG8_WAIT_L(0); PG8_BAR; PG8_MMA(1, 0, At, B0); PG8_MMA(1, 1, At, B1); PG8_BAR; PG8_SCHED;
            PG8_LDB(B0, 1, 0); PG8_LDB(B1, 1, 1); PG8_SCHED; PG8_LDA(At, 1, 0); PG8_STAGE(PG8_SA(0, 1), a2 + hstepA, voffA);
            PG8_WAIT_V(8); PG8_WAIT_L(0); PG8_BAR; PG8_MMA(0, 0, At, B0); PG8_MMA(0, 1, At, B1); PG8_BAR; PG8_SCHED;
            PG8_LDA(At, 1, 1); PG8_STAGE(PG8_SB(1, 0), b3, voffB); PG8_STAGE(PG8_SB(1, 1), b3 + hstepB, voffB); PG8_STAGE(PG8_SA(1, 0), a3, voffA);
            PG8_WAIT_V(8); PG8_WAIT_L(0); PG8_BAR; PG8_MMA(1, 0, At, B0); PG8_MMA(1, 1, At, B1); PG8_BAR; PG8_SCHED;
        }
        if (wr == 0) PG8_BAR;
        E(acc, cur, wr, wc, fr, fq);
        if (!has_next) break;
#pragma unroll
        for (int a = 0; a < 2; ++a)
#pragma unroll
            for (int b = 0; b < 2; ++b)
#pragma unroll
                for (int m = 0; m < 4; ++m)
#pragma unroll
                    for (int n = 0; n < 2; ++n) acc[a][b][m][n] = (f32x4){0.f, 0.f, 0.f, 0.f};
        cur = nxt; cA = nA; cB = nB; ++ui;
        if (wr == 1) PG8_BAR;
    }
    PG8_WAIT_V(0);
    PG8_BAR;
#undef PG8_SA
#undef PG8_SB
#undef PG8_STAGE
#undef PG8_LDA
#undef PG8_LDB
#undef PG8_MMA
#undef PG8_WAIT_V
#undef PG8_WAIT_L
#undef PG8_BAR
#undef PG8_SCHED
}
template <class Epi, class Prob>
__device__ __forceinline__ void gemm_phase_x(LAS unsigned char* lds, const Prob& P, const Epi& E, int wave_id) {
    int lane_l = (int)__builtin_amdgcn_mbcnt_hi(~0u, __builtin_amdgcn_mbcnt_lo(~0u, 0u)); asm volatile("" : "+v"(lane_l));
    const int wid = wave_id, lane = lane_l, tid = wid * 64 + lane, wr = wid >> 2, wc = wid & 3, fr = lane & 15, fq = lane >> 4;
    const int K = P.K, nt = K / BK;
    unsigned voffB[2];
#pragma unroll
    for (int i = 0; i < 2; ++i) { int R, C; stage_rc(tid * 16 + i * 8192, R, C); const int Rb = Epi::PERM ? ((R & ~31) + perm32(R & 31)) : R; voffB[i] = (unsigned)(Rb * P.ldb + C) * 2u; }
    const size_t kstep = (size_t)(BK * 2);
    const long hstepB = P.hstepB;
    const unsigned ldsw = (unsigned)wid * 1024u;
    const int aoff = lds_byte(wr * 64 + fr, fq * 8), boff = lds_byte(wc * 32 + fr, fq * 8);
    LAS u32x4* stash = (LAS u32x4*)(lds + STAGE_BYTES + 1024) + tid;
#define PG8_SA(b, h) (((b) * 2 + (h)) * HTB)
#define PG8_SB(b, h) ((4 + (b) * 2 + (h)) * HTB)
#define PG8_STAGE(bufoff, gbase, voff) do { _Pragma("unroll") for (int _i = 0; _i < 2; ++_i) \
        __builtin_amdgcn_global_load_lds((const unsigned*)((const char*)(gbase) + (voff)[_i]), (LAS unsigned*)(lds + (bufoff) + ldsw + _i * 8192), 16, 0, 0); } while (0)
#define PG8_LDA(dst, b, h) do { _Pragma("unroll") for (int m = 0; m < 4; ++m) _Pragma("unroll") for (int k = 0; k < 2; ++k) dst[m][k] = *(const LAS bf16x8*)(lds + PG8_SA(b, h) + aoff + m * 2048 + k * 1024); } while (0)
#define PG8_LDB(dst, b, h) do { _Pragma("unroll") for (int n = 0; n < 2; ++n) _Pragma("unroll") for (int k = 0; k < 2; ++k) dst[n][k] = *(const LAS bf16x8*)(lds + PG8_SB(b, h) + boff + n * 2048 + k * 1024); } while (0)
#define PG8_MMA(ai, bj, At, Bt) do { __builtin_amdgcn_s_setprio(1); _Pragma("unroll") for (int m = 0; m < 4; ++m) _Pragma("unroll") for (int n = 0; n < 2; ++n) _Pragma("unroll") for (int k = 0; k < 2; ++k) \
        acc[ai][bj][m][n] = __builtin_amdgcn_mfma_f32_16x16x32_bf16(Bt[n][k], At[m][k], acc[ai][bj][m][n], 0, 0, 0); __builtin_amdgcn_s_setprio(0); } while (0)
#define PG8_WAIT_V(n) asm volatile("s_waitcnt vmcnt(" #n ")" ::: "memory")
#define PG8_WAIT_L(n) asm volatile("s_waitcnt lgkmcnt(" #n ")" ::: "memory")
#define PG8_BAR __builtin_amdgcn_s_barrier()
#define PG8_SCHED __builtin_amdgcn_sched_barrier(0)
#define PG8_AVOFF(dst, u) do { int t2_ = tid; asm volatile("" : "+v"(t2_)); _Pragma("unroll") for (int i_ = 0; i_ < 2; ++i_) { int R_, C_; stage_rc(t2_ * 16 + i_ * 8192, R_, C_); _Pragma("unroll") for (int h_ = 0; h_ < 2; ++h_) \
        dst[h_][i_] = (Prob::GATHER ? P.arow_off(u, h_, R_) : (unsigned)((h_ * HALF + R_) * P.lda) * 2u) + (unsigned)C_ * 2u; } } while (0)
    Unit cur, nxt; int ui = 0;
    if (!P.next(0, cur)) return;
    unsigned vA[2][2];
    PG8_AVOFF(vA, cur);
    f32x4 acc[2][2][4][2];
#pragma unroll
    for (int a = 0; a < 2; ++a)
#pragma unroll
        for (int b = 0; b < 2; ++b)
#pragma unroll
            for (int m = 0; m < 4; ++m)
#pragma unroll
                for (int n = 0; n < 2; ++n) acc[a][b][m][n] = (f32x4){0.f, 0.f, 0.f, 0.f};
    bf16x8 At[4][2], B0[2][2], B1[2][2];
    const char* cA = P.a_base(cur); const char* cB = P.b_base(cur);
    long csplit = Prob::KSPLIT ? P.bsplit(cur) : 0;
    if (Prob::WAITS) P.a_ready(cur, wid);
    PG8_STAGE(PG8_SB(0, 0), cB, voffB); PG8_STAGE(PG8_SB(0, 1), cB + hstepB, voffB); PG8_STAGE(PG8_SA(0, 0), cA, vA[0]); PG8_STAGE(PG8_SA(0, 1), cA, vA[1]);
    if (wr == 1) PG8_BAR;
    PG8_WAIT_V(2); PG8_BAR;
    PG8_STAGE(PG8_SB(1, 0), cB + kstep, voffB); PG8_STAGE(PG8_SA(1, 0), cA + kstep, vA[0]); PG8_STAGE(PG8_SB(1, 1), cB + hstepB + kstep, voffB);
    PG8_WAIT_V(6); PG8_BAR;
    for (;;) {
        const bool has_next = P.next(ui + 1, nxt);
        const char* nA = has_next ? P.a_base(nxt) : cA; const char* nB = has_next ? P.b_base(nxt) : cB;
        if (Prob::GATHER) { unsigned vN[2][2];
            if (has_next) { PG8_AVOFF(vN, nxt); } else { vN[0][0] = vA[0][0]; vN[0][1] = vA[0][1]; vN[1][0] = vA[1][0]; vN[1][1] = vA[1][1]; }
            *stash = (u32x4){vN[0][0], vN[0][1], vN[1][0], vN[1][1]}; }
        for (int t = 0; t < nt; t += 2) {
            const bool last = (t == nt - 2);
            if (Prob::WAITS && last && has_next) P.a_ready(nxt, wid);
            const char* a1 = cA + (size_t)(t + 1) * kstep;
            const char* a2 = last ? nA : cA + (size_t)(t + 2) * kstep;
            const char* b2 = last ? nB : cB + (size_t)(t + 2) * kstep + ((Prob::KSPLIT && (t + 2) >= (nt >> 1)) ? csplit : 0);
            const char* a3 = a2 + kstep; const char* b3 = b2 + kstep;
            PG8_LDB(B0, 0, 0); PG8_LDB(B1, 0, 1); PG8_SCHED; PG8_LDA(At, 0, 0); PG8_STAGE(PG8_SA(1, 1), a1, vA[1]);
            if (Prob::GATHER && last) { const u32x4 sv = *stash; vA[0][0] = sv.x; vA[0][1] = sv.y; vA[1][0] = sv.z; vA[1][1] = sv.w; }
            PG8_WAIT_V(8); PG8_WAIT_L(0); PG8_BAR; PG8_MMA(0, 0, At, B0); PG8_MMA(0, 1, At, B1); PG8_BAR; PG8_SCHED;
            PG8_LDA(At, 0, 1); PG8_STAGE(PG8_SB(0, 0), b2, voffB); PG8_STAGE(PG8_SB(0, 1), b2 + hstepB, voffB); PG8_STAGE(PG8_SA(0, 0), a2, vA[0]);
            PG8_WAIT_V(8); PG8_WAIT_L(0); PG8_BAR; PG8_MMA(1, 0, At, B0); PG8_MMA(1, 1, At, B1); PG8_BAR; PG8_SCHED;
            PG8_LDB(B0, 1, 0); PG8_LDB(B1, 1, 1); PG8_SCHED; PG8_LDA(At, 1, 0); PG8_STAGE(PG8_SA(0, 1), a2, vA[1]);
            PG8_WAIT_V(8); PG8_WAIT_L(0); PG8_BAR; PG8_MMA(0, 0, At, B0); PG8_MMA(0, 1, At, B1); PG8_BAR; PG8_SCHED;
            PG8_LDA(At, 1, 1); PG8_STAGE(PG8_SB(1, 0), b3, voffB); PG8_STAGE(PG8_SB(1, 1), b3 + hstepB, voffB); PG8_STAGE(PG8_SA(1, 0), a3, vA[0]);
            PG8_WAIT_V(8); PG8_WAIT_L(0); PG8_BAR; PG8_MMA(1, 0, At, B0); PG8_MMA(1, 1, At, B1); PG8_BAR; PG8_SCHED;
        }
        if (wr == 0) PG8_BAR;
        E(acc, cur, wr, wc, fr, fq);
        if (!has_next) break;
#pragma unroll
        for (int a = 0; a < 2; ++a)
#pragma unroll
            for (int b = 0; b < 2; ++b)
#pragma unroll
                for (int m = 0; m < 4; ++m)
#pragma unroll
                    for (int n = 0; n < 2; ++n) acc[a][b][m][n] = (f32x4){0.f, 0.f, 0.f, 0.f};
        cur = nxt; cA = nA; cB = nB; ++ui;
        if (Prob::KSPLIT) csplit = P.bsplit(cur);
        if (wr == 1) PG8_BAR;
    }
    PG8_WAIT_V(0);
    PG8_BAR;
#undef PG8_SA
#undef PG8_SB
#undef PG8_STAGE
#undef PG8_LDA
#undef PG8_LDB
#undef PG8_MMA
#undef PG8_WAIT_V
#undef PG8_WAIT_L
#undef PG8_BAR
#undef PG8_SCHED
#undef PG8_AVOFF
}

__device__ __forceinline__ int pair_a(int pi) { return pi < 3 ? 0 : (pi < 5 ? 1 : 2); }
__device__ __forceinline__ int pair_b(int pi) { return pi == 0 ? 1 : ((pi == 1 || pi == 3) ? 2 : 3); }
template <int MODE>
struct MoeProb {
    static constexpr bool GATHER = (MODE == 0), KSPLIT = (MODE == 1);
    const unsigned* cnt; const unsigned* list; const char* A; const char* B; int lda, ldb, K; long hstepB; int G, c; unsigned* tcnt;
    static constexpr bool WAITS = (MODE == 1);
    __device__ __forceinline__ void a_ready(const Unit& u, int wave) const {
        if (MODE == 1) {
            if (wave == 0) { unsigned polls = 0;
                while ((unsigned)__builtin_amdgcn_readfirstlane(__hip_atomic_load(tcnt + 64 * u.pm, __ATOMIC_RELAXED, __HIP_MEMORY_SCOPE_AGENT)) < 32u) {
                    if (++polls > (1u << 20)) break;
                    __builtin_amdgcn_s_sleep(2); }
                __builtin_amdgcn_fence(__ATOMIC_ACQUIRE, "agent");
                asm volatile("s_waitcnt vmcnt(0)" ::: "memory"); }
            asm volatile("" ::: "memory"); __builtin_amdgcn_s_barrier(); asm volatile("" ::: "memory");
        }
    }
    __device__ __forceinline__ bool next(int i, Unit& u) const {
        const long L = (long)i * G + c; const int tileidx = (int)(L >> 2);
        int accu = 0, bk = -1, tib = 0, nb = 0;
        for (int k = 0; k < 24; ++k) { const int n = (int)cnt[k]; const int tl = (n + 255) >> 8; if (bk < 0 && tileidx < accu + tl) { bk = k; tib = tileidx - accu; nb = n; } accu += tl; }
        if (bk < 0) return false;
        u.pm = tileidx; u.pn = (int)(L & 3); u.meta = bk | (tib << 5) | (nb << 13); return true;
    }
    __device__ __forceinline__ int expert(const Unit& u, int s) const { const int g = u.bk() / 6, pi = u.bk() % 6; return g * 4 + (s ? pair_b(pi) : pair_a(pi)); }
    __device__ __forceinline__ const char* a_base(const Unit& u) const { return MODE == 0 ? A : A + (size_t)u.pm * 256 * lda * 2; }
    __device__ __forceinline__ const char* b_base(const Unit& u) const {
        if (MODE == 0) return B + ((size_t)expert(u, u.pn >> 1) * DEXP + (size_t)(u.pn & 1) * HALF) * ldb * 2;
        return B + (size_t)u.pn * 256 * ldb * 2 + (size_t)expert(u, 0) * DEXP * 2;
    }
    __device__ __forceinline__ unsigned arow_off(const Unit& u, int h, int R) const { const int pos = u.tib() * 256 + h * HALF + R; const unsigned tok = pos < u.nb() ? list[(size_t)u.bk() * T + pos] : 0u; return tok * (unsigned)(lda * 2); }
    __device__ __forceinline__ long bsplit(const Unit& u) const { return ((long)(expert(u, 1) - expert(u, 0)) * DEXP - DEXP) * 2; }
};
struct EpiGateUpSparse {
    static constexpr bool PERM = true;
    bf16_t* act; const float* wlist; unsigned* tcnt;
    __device__ __forceinline__ void operator()(const f32x4 (&acc)[2][2][4][2], const Unit& u, int wr, int wc, int fr, int fq) const {
        asm volatile("" : "+v"(fr), "+v"(fq));
        const int s = u.pn >> 1, col0 = s * DEXP + (u.pn & 1) * HALF + wc * 32 + 8 * fq;
        const __amdgpu_buffer_rsrc_t rs_act = __builtin_amdgcn_make_buffer_rsrc((void*)act, (short)0, 0x7fffffff, 0x00020000);
#pragma unroll
        for (int ai = 0; ai < 2; ++ai)
#pragma unroll
            for (int m = 0; m < 4; ++m) { const int r = ai * HALF + wr * 64 + m * 16 + fr, pos = u.tib() * 256 + r;
                const float cw = pos < u.nb() ? wlist[((size_t)u.bk() * T + pos) * 2 + s] : 0.f;
                float o[8];
#pragma unroll
                for (int n = 0; n < 2; ++n)
#pragma unroll
                    for (int j = 0; j < 4; ++j) { const float g = acc[ai][0][m][n][j], up = acc[ai][1][m][n][j];
                        const float sg = g * __builtin_amdgcn_rcpf(1.f + __builtin_amdgcn_exp2f(-g * LOG2E));
                        o[n * 4 + j] = sg * up * cw; }
                u32x4 w; w.x = cvt_pk_bf16(o[0], o[1]); w.y = cvt_pk_bf16(o[2], o[3]); w.z = cvt_pk_bf16(o[4], o[5]); w.w = cvt_pk_bf16(o[6], o[7]);
                __builtin_amdgcn_raw_buffer_store_b128(w, rs_act, (int)((((unsigned)u.pm * 256u + (unsigned)r) * 512u + (unsigned)col0) * 2u), 0, 16);
                if (m & 1) asm volatile("" ::: "memory"); }
        asm volatile("s_waitcnt vmcnt(0)" ::: "memory");
        if ((fr | fq) == 0) __hip_atomic_fetch_add(tcnt + 64 * u.pm, 1u, __ATOMIC_RELAXED, __HIP_MEMORY_SCOPE_AGENT);
    }
};
struct EpiDownScatter {
    static constexpr bool PERM = false;
    float* x; const unsigned* list;
    __device__ __forceinline__ void operator()(const f32x4 (&acc)[2][2][4][2], const Unit& u, int wr, int wc, int fr, int fq) const {
        asm volatile("" : "+v"(fr), "+v"(fq));
        const int col0 = u.pn * BM + wc * 32 + 4 * fq;
        unsigned tok[8];
#pragma unroll
        for (int g = 0; g < 8; ++g) { const int pos = u.tib() * 256 + (g >> 2) * HALF + wr * 64 + (g & 3) * 16 + fr; tok[g] = pos < u.nb() ? list[(size_t)u.bk() * T + pos] : 0xffffffffu; }
#pragma unroll
        for (int g = 0; g < 8; ++g) { const int ai = g >> 2, m = g & 3;
            if (tok[g] != 0xffffffffu) { const size_t off = (size_t)tok[g] * DM + col0;
#pragma unroll
                for (int bj = 0; bj < 2; ++bj)
#pragma unroll
                    for (int n = 0; n < 2; ++n) { f32x4* p = (f32x4*)(x + off + bj * HALF + n * 16); *p = *p + acc[ai][bj][m][n]; } }
            if (g & 1) asm volatile("" ::: "memory"); }
    }
};
}

#define XB_TMO      128
#define XB_XCNT(j)  (256  + 64 * (j))
#define XB_XSUB(j)  (1280 + 64 * (j))
#define XB_XGEN(j)  (2304 + 64 * (j))
#define XB_TOP      3328
#define XB_TOPGEN   3392
#define XCD_BAR_WORDS 3456
#define XB_SPIN_CAP (1u << 18)
__device__ __forceinline__ unsigned xb_ld(unsigned* p)              { return __hip_atomic_load(p, __ATOMIC_RELAXED, __HIP_MEMORY_SCOPE_AGENT); }
__device__ __forceinline__ unsigned xb_add(unsigned* p, unsigned v) { return __hip_atomic_fetch_add(p, v, __ATOMIC_RELAXED, __HIP_MEMORY_SCOPE_AGENT); }
__device__ __forceinline__ unsigned xb_xcc_id() { return (unsigned)__builtin_amdgcn_s_getreg((3 << 11) | 20) & 0xFu; }
#define XB_SPIN(cond, bar) do { unsigned _sp = 0; while (cond) { __builtin_amdgcn_s_sleep(1); \
    if ((++_sp & 255u) == 0u) { if (xb_ld(&(bar)[XB_TMO])) break; if (_sp > XB_SPIN_CAP) { atomicAdd(&(bar)[XB_TMO], 1u); break; } } } } while (0)
struct XcdBarrier { unsigned* bar; unsigned x; volatile LAS unsigned* st; int wave; };
__device__ __forceinline__ bool xb_thread0(int wave) { return wave == 0 && __builtin_amdgcn_mbcnt_hi(~0u, __builtin_amdgcn_mbcnt_lo(~0u, 0u)) == 0u; }
__device__ __forceinline__ XcdBarrier xcd_barrier_post(unsigned* bar, volatile LAS unsigned* st, int wave) {
    XcdBarrier b; b.bar = bar; b.x = xb_xcc_id(); b.st = st; b.wave = wave;
    if (xb_thread0(wave)) (void)xb_add(&bar[XB_XCNT(b.x)], 1u);
    return b;
}
__device__ __forceinline__ void xcd_barrier_complete(unsigned* bar, unsigned x, unsigned& nloc, unsigned& nx) {
    const unsigned G = gridDim.x * gridDim.y * gridDim.z;
    unsigned sum, cnt, mine, sp = 0u;
    for (;;) {
        sum = 0u; cnt = 0u; mine = 0u;
#pragma unroll
        for (unsigned j = 0; j < 16; ++j) { const unsigned c = xb_ld(&bar[XB_XCNT(j)]); sum += c; cnt += (c > 0u) ? 1u : 0u; mine = (j == x) ? c : mine; }
        if (sum == G) break;
        __builtin_amdgcn_s_sleep(1);
        if ((++sp & 255u) == 0u) { if (xb_ld(&bar[XB_TMO])) break; if (sp > XB_SPIN_CAP) { atomicAdd(&bar[XB_TMO], 1u); break; } }
    }
    nloc = mine > 0u ? mine : 1u; nx = cnt > 0u ? cnt : 1u;
}
__device__ __forceinline__ void xcd_barrier(const XcdBarrier& b) {
    asm volatile("s_waitcnt vmcnt(0)" ::: "memory");
    __syncthreads();
    if (xb_thread0(b.wave)) {
        unsigned* bar = b.bar;
        __builtin_amdgcn_s_waitcnt(0);
        unsigned nloc = b.st[0], nx = b.st[1];
        if (nloc == 0u) { xcd_barrier_complete(bar, b.x, nloc, nx); b.st[0] = nloc; b.st[1] = nx; }
        const unsigned old = xb_add(&bar[XB_XSUB(b.x)], 1u);
        const unsigned gen = old / nloc;
        if (old + 1u == (gen + 1u) * nloc) {
            __builtin_amdgcn_fence(__ATOMIC_RELEASE, "agent");
            asm volatile("s_waitcnt vmcnt(0)" ::: "memory");
            const unsigned og = xb_add(&bar[XB_TOP], 1u);
            const unsigned tg = og / nx;
            if (og + 1u == (tg + 1u) * nx) xb_add(&bar[XB_TOPGEN], 1u);
            else XB_SPIN(xb_ld(&bar[XB_TOPGEN]) == tg, bar);
            __builtin_amdgcn_fence(__ATOMIC_ACQUIRE, "agent");
            xb_add(&bar[XB_XGEN(b.x)], 1u);
            asm volatile("s_waitcnt vmcnt(0)" ::: "memory");
        } else {
            XB_SPIN(xb_ld(&bar[XB_XGEN(b.x)]) == gen, bar);
            __builtin_amdgcn_fence(__ATOMIC_ACQUIRE, "agent");
            asm volatile("s_waitcnt vmcnt(0)" ::: "memory");
        }
    }
    __syncthreads();
}

struct Args {
    const float* x; const float* ln1_g; const float* w_in; const float* mix_g; const float* w_out; const float* ln2_g;
    const float* w_gr; const float* b_gr; const float* w_er; const float* b_er; const float* w_gate; const float* w_up; const float* w_down; const float* fin_g;
    float* out; unsigned char* ws; int ph_lo, ph_hi, li, pad;
};

__device__ __forceinline__ void transpose_item(const float* W, int K, int N, bf16_t* WT, int dpitch, int dcol, LAS float* scr, int item, int lane) {
    const int nblk = N / 32, kb = item / nblk, nb = item % nblk, k0 = 64 * kb, n0 = 32 * nb;
#pragma unroll 8
    for (int i = 0; i < 32; ++i) { const int kk = 2 * i + (lane >> 5); scr[kk * 33 + (lane & 31)] = W[(size_t)(k0 + kk) * N + n0 + (lane & 31)]; }
    LDS_WAIT(); asm volatile("" ::: "memory");
    const int c = lane & 7;
#pragma unroll
    for (int j = 0; j < 4; ++j) { const int n = (lane >> 3) + 8 * j; const LAS float* s = scr + (8 * c) * 33 + n;
        u32x4 o; o.x = pk2(s[0 * 33], s[1 * 33]); o.y = pk2(s[2 * 33], s[3 * 33]); o.z = pk2(s[4 * 33], s[5 * 33]); o.w = pk2(s[6 * 33], s[7 * 33]);
        *(u32x4*)(WT + (size_t)(n0 + n) * dpitch + dcol + k0 + 8 * c) = o; }
    LDS_WAIT(); asm volatile("" ::: "memory");
}
__device__ __forceinline__ void phase_prologue(const Args& a, LAS unsigned char* lds, int gw, int NGW, int wave, int lane) {
    LAS float* scr = (LAS float*)(lds + wave * 16384);
    constexpr int I_IN = (DM / 64) * (NQKV / 32);
    constexpr int I_OUT = (DM / 64) * (DM / 32);
    constexpr int I_G = (DM / 64) * (DEXP / 32);
    constexpr int I_D = (DEXP / 64) * (DM / 32);
    constexpr int N_IN = DEPTH * I_IN, N_OUT = DEPTH * I_OUT, N_G = DEPTH * NEXP * I_G, N_D = DEPTH * NEXP * I_D;
    constexpr int NITEMS = N_IN + N_OUT + 2 * N_G + N_D;
    bf16_t* WinT = (bf16_t*)(a.ws + WS_WIN); bf16_t* WoutT = (bf16_t*)(a.ws + WS_WOUT); bf16_t* WgT = (bf16_t*)(a.ws + WS_WG); bf16_t* WuT = (bf16_t*)(a.ws + WS_WU); bf16_t* WdT = (bf16_t*)(a.ws + WS_WD);
    for (int it = gw; it < NITEMS; it += NGW) {
        int r = it;
        if (r < N_IN) { const int l = r / I_IN; transpose_item(a.w_in + (size_t)l * DM * NQKV, DM, NQKV, WinT + (size_t)l * NQKV * DM, DM, 0, scr, r % I_IN, lane); continue; } r -= N_IN;
        if (r < N_OUT) { const int l = r / I_OUT; transpose_item(a.w_out + (size_t)l * DM * DM, DM, DM, WoutT + (size_t)l * DM * DM, DM, 0, scr, r % I_OUT, lane); continue; } r -= N_OUT;
        if (r < N_G) { const int le = r / I_G; transpose_item(a.w_gate + (size_t)le * DM * DEXP, DM, DEXP, WgT + (size_t)le * DEXP * DM, DM, 0, scr, r % I_G, lane); continue; } r -= N_G;
        if (r < N_G) { const int le = r / I_G; transpose_item(a.w_up + (size_t)le * DM * DEXP, DM, DEXP, WuT + (size_t)le * DEXP * DM, DM, 0, scr, r % I_G, lane); continue; } r -= N_G;
        { const int le = r / I_D, l = le / NEXP, e = le % NEXP; transpose_item(a.w_down + (size_t)le * DEXP * DM, DEXP, DM, WdT + (size_t)l * DM * NACT, NACT, e * DEXP, scr, r % I_D, lane); }
    }
}

__device__ __forceinline__ void phase_norm1(const float* x, const float* g, bf16_t* hb, int gw, int NGW, int lane, float* kmean_zero) {
    for (int i = gw * 64 + lane; i < BATCH * 4 * 32 * HD; i += NGW * 64) kmean_zero[i] = 0.f;
    f32x4 gv[4];
#pragma unroll
    for (int j = 0; j < 4; ++j) gv[j] = *((const f32x4*)g + lane + 64 * j);
    for (int m = gw; m < T; m += NGW) {
        const f32x4* xr = (const f32x4*)(x + (size_t)m * DM) + lane;
        f32x4 v[4]; float s = 0.f;
#pragma unroll
        for (int j = 0; j < 4; ++j) { v[j] = xr[64 * j]; s += (v[j].x * v[j].x + v[j].y * v[j].y) + (v[j].z * v[j].z + v[j].w * v[j].w); }
        const float rstd = 1.0f / sqrtf(wave_sum(s) * (1.f / DM) + NORM_EPS);
        u32x2* o8 = (u32x2*)(hb + (size_t)m * DM) + lane;
#pragma unroll
        for (int j = 0; j < 4; ++j) { u32x2 w; w.x = pk2(v[j].x * rstd * gv[j].x, v[j].y * rstd * gv[j].y); w.y = pk2(v[j].z * rstd * gv[j].z, v[j].w * rstd * gv[j].w); o8[64 * j] = w; }
    }
}
__device__ __forceinline__ void unpack8(float (&f)[8], const u32x4 w) { f[0] = bflo(w.x); f[1] = bfhi(w.x); f[2] = bflo(w.y); f[3] = bfhi(w.y); f[4] = bflo(w.z); f[5] = bfhi(w.z); f[6] = bflo(w.w); f[7] = bfhi(w.w); }
__device__ __forceinline__ void phase_mixnorm(const bf16_t* ob, bf16_t* hb, const float* lse, const bf16_t* pm, const float* lsem0, const float* lsem1, const float* g, int gw, int NGW, int lane) {
    float g0[8], g1[8];
#pragma unroll
    for (int j = 0; j < 8; ++j) { g0[j] = g[8 * lane + j]; g1[j] = g[512 + 8 * lane + j]; }
    const int hh = lane >> 3;
    for (int m = gw; m < T; m += NGW) {
        const u32x4 a = *((const u32x4*)(ob + (size_t)m * DM) + lane), c0 = *((const u32x4*)(ob + (size_t)m * DM + 512) + lane);
        const u32x4 c1 = *((const u32x4*)(hb + (size_t)m * DM) + lane), c2 = *((const u32x4*)(hb + (size_t)m * DM + 512) + lane);
        const float l0 = lse[(size_t)m * 8 + hh], l1 = lse[(size_t)T * 8 + (size_t)m * 8 + hh], l2 = lse[(size_t)2 * T * 8 + (size_t)m * 8 + hh];
        float va[8]; unpack8(va, a);
        if (lane < 32) {
            const u32x4 p0 = *((const u32x4*)(pm + (size_t)m * 256) + lane), p1 = *((const u32x4*)(pm + ((size_t)T + m) * 256) + lane), p2 = *((const u32x4*)(pm + ((size_t)2 * T + m) * 256) + lane);
            const float e0 = lsem0[(size_t)m * 4 + hh], e1 = lsem0[(size_t)T * 4 + (size_t)m * 4 + hh], e2 = lsem1[(size_t)m * 4 + hh], e3 = lsem1[(size_t)T * 4 + (size_t)m * 4 + hh];
            const float mx = fmaxf(fmaxf(e0, e1), fmaxf(e2, e3));
            float u0 = __builtin_amdgcn_exp2f(e0 - mx), u1 = __builtin_amdgcn_exp2f(e1 - mx), u2 = __builtin_amdgcn_exp2f(e2 - mx), u3 = __builtin_amdgcn_exp2f(e3 - mx);
            const float inv = 1.0f / ((u0 + u1) + (u2 + u3)); u0 *= inv; u1 *= inv; u2 *= inv; u3 *= inv;
            float y0[8], y1[8], y2[8]; unpack8(y0, p0); unpack8(y1, p1); unpack8(y2, p2);
#pragma unroll
            for (int j = 0; j < 8; ++j) va[j] = (u0 * y0[j] + u1 * y1[j]) + (u2 * y2[j] + u3 * va[j]);
        }
        const float mx = fmaxf(l0, fmaxf(l1, l2));
        float w0 = __builtin_amdgcn_exp2f(l0 - mx), w1 = __builtin_amdgcn_exp2f(l1 - mx), w2 = __builtin_amdgcn_exp2f(l2 - mx);
        const float inv = 1.0f / (w0 + w1 + w2); w0 *= inv; w1 *= inv; w2 *= inv;
        float x0[8], x1[8], x2[8]; unpack8(x0, c0); unpack8(x1, c1); unpack8(x2, c2);
        float vc[8];
        float sa = 0.f, sc = 0.f;
#pragma unroll
        for (int j = 0; j < 8; ++j) { vc[j] = w0 * x0[j] + w1 * x1[j] + w2 * x2[j]; sa += va[j] * va[j]; sc += vc[j] * vc[j]; }
        sa = half_sum(sa); sc = wave_sum(sc);
        const float ra = 1.0f / sqrtf(sa * (1.f / 256.f) + NORM_EPS), rc = 1.0f / sqrtf(sc * (1.f / 512.f) + NORM_EPS);
        u32x4 oa, oc;
        oa.x = pk2(va[0] * ra * g0[0], va[1] * ra * g0[1]); oa.y = pk2(va[2] * ra * g0[2], va[3] * ra * g0[3]); oa.z = pk2(va[4] * ra * g0[4], va[5] * ra * g0[5]); oa.w = pk2(va[6] * ra * g0[6], va[7] * ra * g0[7]);
        oc.x = pk2(vc[0] * rc * g1[0], vc[1] * rc * g1[1]); oc.y = pk2(vc[2] * rc * g1[2], vc[3] * rc * g1[3]); oc.z = pk2(vc[4] * rc * g1[4], vc[5] * rc * g1[5]); oc.w = pk2(vc[6] * rc * g1[6], vc[7] * rc * g1[7]);
        *((u32x4*)(hb + (size_t)m * DM) + lane) = oa; *((u32x4*)(hb + (size_t)m * DM + 512) + lane) = oc;
    }
}
__device__ __forceinline__ void phase_route(const float* x, const float* g, const float* wgr, const float* bgr, const float* wer, const float* ber,
                                            bf16_t* hb, unsigned* cnt, unsigned* list, float* wlist, LAS unsigned char* lds, int v, int G, int wave, int lane) {
    const int tid = wave * 64 + lane;
    LAS f32x4* wl = (LAS f32x4*)lds;
    for (int idx = tid; idx < 5 * DM; idx += NTHREADS) { const int mtx = idx >> 10, d = idx & 1023; const float* src = (mtx == 0 ? wgr : wer + (size_t)(mtx - 1) * DM * 4) + d * 4;
        wl[mtx * 1024 + (d & 3) * 256 + (d >> 2)] = *(const f32x4*)src; }
    LAS unsigned* cl = (LAS unsigned*)(lds + 81920);
    LAS u32x2* info = (LAS u32x2*)(lds + 81920 + 256);
    LAS f32x2* infw = (LAS f32x2*)(lds + 81920 + 256 + 4096);
    if (tid < 64) cl[tid] = 0u;
    __syncthreads();
    const int rpw = (T + G - 1) / G, row0 = v * rpw;
    f32x4 gv[4];
#pragma unroll
    for (int j = 0; j < 4; ++j) gv[j] = *((const f32x4*)g + lane + 64 * j);
    const f32x4 bg = *(const f32x4*)bgr;
    f32x4 nx[4];
    { const int m0 = row0 + wave; if (wave < rpw && m0 < T) { const f32x4* xr = (const f32x4*)(x + (size_t)m0 * DM) + lane;
#pragma unroll
        for (int j = 0; j < 4; ++j) nx[j] = xr[64 * j]; } }
    for (int r = wave; r < rpw; r += NWAVES) {
        const int m = row0 + r; if (m >= T) break;
        f32x4 vv[4]; float s = 0.f;
#pragma unroll
        for (int j = 0; j < 4; ++j) { vv[j] = nx[j]; s += (vv[j].x * vv[j].x + vv[j].y * vv[j].y) + (vv[j].z * vv[j].z + vv[j].w * vv[j].w); }
        if (r + NWAVES < rpw && m + NWAVES < T) { const f32x4* xr = (const f32x4*)(x + (size_t)(m + NWAVES) * DM) + lane;
#pragma unroll
            for (int j = 0; j < 4; ++j) nx[j] = xr[64 * j]; }
        const float rstd = 1.0f / sqrtf(wave_sum(s) * (1.f / DM) + NORM_EPS);
        u32x2* o8 = (u32x2*)(hb + (size_t)m * DM) + lane;
#pragma unroll
        for (int j = 0; j < 4; ++j) { vv[j] = vv[j] * rstd * gv[j]; u32x2 w; w.x = pk2(vv[j].x, vv[j].y); w.y = pk2(vv[j].z, vv[j].w); o8[64 * j] = w; }
        f32x4 gl = (f32x4){0.f, 0.f, 0.f, 0.f};
#pragma unroll
        for (int j = 0; j < 4; ++j) { LAS f32x4* wp = wl + lane + 64 * j;
            gl += wp[0] * vv[j].x; gl += wp[256] * vv[j].y; gl += wp[512] * vv[j].z; gl += wp[768] * vv[j].w; }
        gl.x = wave_sum(gl.x) + bg.x; gl.y = wave_sum(gl.y) + bg.y; gl.z = wave_sum(gl.z) + bg.z; gl.w = wave_sum(gl.w) + bg.w;
        int gi = 0; float gm = gl.x;
        if (gl.y > gm) { gm = gl.y; gi = 1; } if (gl.z > gm) { gm = gl.z; gi = 2; } if (gl.w > gm) { gm = gl.w; gi = 3; }
        const float gden = __expf(gl.x - gm) + __expf(gl.y - gm) + __expf(gl.z - gm) + __expf(gl.w - gm);
        const float gw_ = 1.0f / gden;
        gi = __builtin_amdgcn_readfirstlane(gi);
        f32x4 el = (f32x4){0.f, 0.f, 0.f, 0.f};
#pragma unroll
        for (int j = 0; j < 4; ++j) { LAS f32x4* wp = wl + (1 + gi) * 1024 + lane + 64 * j;
            el += wp[0] * vv[j].x; el += wp[256] * vv[j].y; el += wp[512] * vv[j].z; el += wp[768] * vv[j].w; }
        const f32x4 be = *(const f32x4*)(ber + gi * 4);
        float e[4] = {wave_sum(el.x) + be.x, wave_sum(el.y) + be.y, wave_sum(el.z) + be.z, wave_sum(el.w) + be.w};
        int i1 = 0; float v1 = e[0];
#pragma unroll
        for (int k = 1; k < 4; ++k) if (e[k] > v1) { v1 = e[k]; i1 = k; }
        int i2 = -1; float v2 = -INFINITY;
#pragma unroll
        for (int k = 0; k < 4; ++k) if (k != i1 && e[k] > v2) { v2 = e[k]; i2 = k; }
        const float p2 = __expf(v2 - v1), inv = 1.0f / (1.0f + p2);
        const float w1 = inv * gw_, w2 = p2 * inv * gw_;
        const int ea = i1 < i2 ? i1 : i2, eb = i1 < i2 ? i2 : i1; const float wa = i1 < i2 ? w1 : w2, wb = i1 < i2 ? w2 : w1;
        const int pi = (ea == 0) ? (eb - 1) : (ea == 1 ? eb + 1 : 5), bk = gi * 6 + pi;
        if (lane == 0) { const unsigned rank = __hip_atomic_fetch_add(cl + bk, 1u, __ATOMIC_RELAXED, __HIP_MEMORY_SCOPE_WORKGROUP);
            info[r] = (u32x2){(unsigned)bk, rank}; infw[r] = (f32x2){wa, wb}; }
    }
    __syncthreads();
    if (tid < 24) cl[32 + tid] = __hip_atomic_fetch_add(cnt + tid, cl[tid], __ATOMIC_RELAXED, __HIP_MEMORY_SCOPE_AGENT);
    __syncthreads();
    if (tid < rpw && row0 + tid < T) { const u32x2 inf = info[tid]; const f32x2 wv = infw[tid]; const size_t slot = (size_t)inf.x * T + cl[32 + inf.x] + inf.y;
        list[slot] = (unsigned)(row0 + tid); *(f32x2*)(wlist + slot * 2) = wv; }
    __syncthreads();
}
__device__ __forceinline__ void phase_final(float* x, const float* g, int gw, int NGW, int lane) {
    f32x4 gv[4];
#pragma unroll
    for (int j = 0; j < 4; ++j) gv[j] = *((const f32x4*)g + lane + 64 * j);
    for (int m = gw; m < T; m += NGW) {
        f32x4* xr = (f32x4*)(x + (size_t)m * DM) + lane;
        f32x4 v[4]; float s = 0.f;
#pragma unroll
        for (int j = 0; j < 4; ++j) { v[j] = xr[64 * j]; s += (v[j].x * v[j].x + v[j].y * v[j].y) + (v[j].z * v[j].z + v[j].w * v[j].w); }
        const float rstd = 1.0f / sqrtf(wave_sum(s) * (1.f / DM) + NORM_EPS);
#pragma unroll
        for (int j = 0; j < 4; ++j) xr[64 * j] = v[j] * rstd * gv[j];
    }
}
__device__ __forceinline__ void phase_kmean(const bf16_t* kb, float* kmean, int gw, int NGW, int lane) {
    for (int it = gw; it < BATCH * 4 * 32; it += NGW) {
        const int b = it >> 7, h = (it >> 5) & 3, blk = it & 31;
        const bf16_t* base = kb + ((size_t)b * SEQ + (size_t)blk * 256) * DM + h * HD + (lane & 7) * 8;
        float acc[8] = {0.f, 0.f, 0.f, 0.f, 0.f, 0.f, 0.f, 0.f};
#pragma unroll 4
        for (int i = 0; i < 32; ++i) { const u32x4 w = *(const u32x4*)(base + (size_t)((lane >> 3) + 8 * i) * DM);
            acc[0] += bflo(w.x); acc[1] += bfhi(w.x); acc[2] += bflo(w.y); acc[3] += bfhi(w.y); acc[4] += bflo(w.z); acc[5] += bfhi(w.z); acc[6] += bflo(w.w); acc[7] += bfhi(w.w); }
#pragma unroll
        for (int j = 0; j < 8; ++j) { acc[j] += swz_xor<8>(acc[j]); acc[j] += swz_xor<16>(acc[j]); acc[j] = sum_xor32(acc[j]); }
        if (lane < 8) {
            float* o = kmean + (size_t)it * HD + lane * 8;
#pragma unroll
            for (int j = 0; j < 8; ++j) o[j] = acc[j] * (1.f / 256.f);
        }
    }
}

__device__ __forceinline__ void ld_row64(float (&r)[64], const bf16_t* p) {
#pragma unroll
    for (int c = 0; c < 8; ++c) { const u32x4 w = *((const u32x4*)p + c);
        r[8 * c + 0] = bflo(w.x); r[8 * c + 1] = bfhi(w.x); r[8 * c + 2] = bflo(w.y); r[8 * c + 3] = bfhi(w.y); r[8 * c + 4] = bflo(w.z); r[8 * c + 5] = bfhi(w.z); r[8 * c + 6] = bflo(w.w); r[8 * c + 7] = bfhi(w.w); }
}
__device__ __forceinline__ float dot_row64(const float (&q)[64], const bf16_t* p) {
    float s0 = 0.f, s1 = 0.f;
#pragma unroll
    for (int c = 0; c < 8; ++c) { const u32x4 w = *((const u32x4*)p + c);
        s0 += q[8 * c + 0] * bflo(w.x); s1 += q[8 * c + 1] * bfhi(w.x); s0 += q[8 * c + 2] * bflo(w.y); s1 += q[8 * c + 3] * bfhi(w.y);
        s0 += q[8 * c + 4] * bflo(w.z); s1 += q[8 * c + 5] * bfhi(w.z); s0 += q[8 * c + 6] * bflo(w.w); s1 += q[8 * c + 7] * bfhi(w.w); }
    return s0 + s1;
}
__device__ __forceinline__ void axpy_row64(float (&o)[64], float p, const bf16_t* vp) {
#pragma unroll
    for (int c = 0; c < 8; ++c) { const u32x4 w = *((const u32x4*)vp + c);
        o[8 * c + 0] += p * bflo(w.x); o[8 * c + 1] += p * bfhi(w.x); o[8 * c + 2] += p * bflo(w.y); o[8 * c + 3] += p * bfhi(w.y);
        o[8 * c + 4] += p * bflo(w.z); o[8 * c + 5] += p * bfhi(w.z); o[8 * c + 6] += p * bflo(w.w); o[8 * c + 7] += p * bfhi(w.w); }
}
__device__ __forceinline__ void st_row64(bf16_t* p, const float (&o)[64], float sc) {
#pragma unroll
    for (int c = 0; c < 8; ++c) { u32x4 w; w.x = pk2(o[8 * c] * sc, o[8 * c + 1] * sc); w.y = pk2(o[8 * c + 2] * sc, o[8 * c + 3] * sc); w.z = pk2(o[8 * c + 4] * sc, o[8 * c + 5] * sc); w.w = pk2(o[8 * c + 6] * sc, o[8 * c + 7] * sc); *((u32x4*)p + c) = w; }
}
#define OSM_STEP(sc, vrow) do { const float sc_ = (sc); if (sc_ > m_) { const float al = __builtin_amdgcn_exp2f(m_ - sc_); l_ *= al; _Pragma("unroll") for (int d_ = 0; d_ < 64; ++d_) o_[d_] *= al; m_ = sc_; } \
    const float p_ = __builtin_amdgcn_exp2f(sc_ - m_); l_ += p_; axpy_row64(o_, p_, (vrow)); } while (0)

__device__ __forceinline__ void naive_moba(const bf16_t* qb, const bf16_t* kb, const bf16_t* vb, const float* kmean, bf16_t* ob, int item, int tid) {
    const int b = item >> 6, h = (item >> 4) & 3, t = (item & 15) * 512 + tid, own = t >> 8;
    const size_t rowq = ((size_t)b * SEQ + t) * DM + h * HD;
    const bf16_t* kh = kb + (size_t)b * SEQ * DM + h * HD; const bf16_t* vh = vb + (size_t)b * SEQ * DM + h * HD;
    const float slope2 = exp2f(-2.0f * (float)(h + 1)) * LOG2E;
    float q_[64]; ld_row64(q_, qb + rowq);
    float bv0 = -INFINITY, bv1 = -INFINITY, bv2 = -INFINITY; int bi0 = -1, bi1 = -1, bi2 = -1;
    const float* km = kmean + (size_t)(b * 4 + h) * 32 * HD;
    for (int n = 0; n < own; ++n) {
        float gsum = 0.f;
#pragma unroll
        for (int d = 0; d < 64; ++d) gsum += q_[d] * km[n * HD + d];
        if (gsum > bv0) { bv2 = bv1; bi2 = bi1; bv1 = bv0; bi1 = bi0; bv0 = gsum; bi0 = n; }
        else if (gsum > bv1) { bv2 = bv1; bi2 = bi1; bv1 = gsum; bi1 = n; }
        else if (gsum > bv2) { bv2 = gsum; bi2 = n; }
    }
    float o_[64];
#pragma unroll
    for (int d = 0; d < 64; ++d) o_[d] = 0.f;
    float m_ = -INFINITY, l_ = 0.f;
    for (int s = 0; s < 3; ++s) {
        const int blk = (s == 0) ? bi0 : (s == 1) ? bi1 : bi2;
        if (blk < 0) continue;
        for (int j = 0; j < 256; ++j) { const int pos = blk * 256 + j;
            const float sc = dot_row64(q_, kh + (size_t)pos * DM) - slope2 * (float)(t - pos);
            OSM_STEP(sc, vh + (size_t)pos * DM); }
    }
    for (int pos = own * 256; pos <= t; ++pos) {
        const float sc = dot_row64(q_, kh + (size_t)pos * DM) - slope2 * (float)(t - pos);
        OSM_STEP(sc, vh + (size_t)pos * DM); }
    st_row64(ob + rowq, o_, 1.0f / l_);
}
__device__ __forceinline__ void naive_sb(const bf16_t* qb, const bf16_t* kb, const bf16_t* vb, bf16_t* ob, int item, int tid) {
    const int b = item >> 6, h = 4 + ((item >> 4) & 3), t = (item & 15) * 512 + tid;
    const size_t rowq = ((size_t)b * SEQ + t) * DM + h * HD;
    const bf16_t* kh = kb + (size_t)b * SEQ * DM + h * HD; const bf16_t* vh = vb + (size_t)b * SEQ * DM + h * HD;
    float q_[64]; ld_row64(q_, qb + rowq);
    float o_[64];
#pragma unroll
    for (int d = 0; d < 64; ++d) o_[d] = 0.f;
    float tail = 0.f;
    for (int s = t - 1; s >= 0 && tail > -150.f; --s) {
        const float z = dot_row64(q_, kh + (size_t)s * DM);
        const float lp = __builtin_amdgcn_logf(1.0f + __builtin_amdgcn_exp2f(-fabsf(z)));
        const float lnot = -(fmaxf(z, 0.f) + lp);
        const float aw = __builtin_amdgcn_exp2f(z + lnot + tail);
        axpy_row64(o_, aw, vh + (size_t)s * DM);
        tail += lnot;
    }
    st_row64(ob + rowq, o_, 1.0f);
}
__device__ __forceinline__ void naive_dil(const bf16_t* qb, const bf16_t* kb, const bf16_t* vb, bf16_t* ob, bf16_t* hb2, float* lse, int item, int tid) {
    const int b = item >> 7, h = 8 + ((item >> 4) & 7), t = (item & 15) * 512 + tid;
    const size_t rowq = ((size_t)b * SEQ + t) * DM + h * HD;
    const bf16_t* kh = kb + (size_t)b * SEQ * DM + h * HD; const bf16_t* vh = vb + (size_t)b * SEQ * DM + h * HD;
    const float slope2 = exp2f(-(float)(h - 8 + 1)) * LOG2E;
    float q_[64]; ld_row64(q_, qb + rowq);
    float o_[64];
#pragma unroll
    for (int d = 0; d < 64; ++d) o_[d] = 0.f;
    float m_ = -INFINITY, l_ = 0.f;
    for (int c = 0; c < 3; ++c) {
        const int dil = (c == 0) ? 1 : (c == 1) ? 4 : 16;
        for (int dl = 0; dl <= 128; ++dl) { const int pos = t - dl * dil; if (pos < 0) break;
            const float sc = dot_row64(q_, kh + (size_t)pos * DM) - slope2 * (float)(dl * dil);
            OSM_STEP(sc, vh + (size_t)pos * DM); }
    }
    st_row64(ob + rowq, o_, 1.0f / l_);
    { const size_t tok = (size_t)b * SEQ + t; const u32x4 z4 = {0u, 0u, 0u, 0u};
#pragma unroll
      for (int c = 0; c < 8; ++c) { *((u32x4*)(hb2 + tok * DM + (h - 8) * HD) + c) = z4; *((u32x4*)(hb2 + tok * DM + 512 + (h - 8) * HD) + c) = z4; }
      lse[tok * 8 + (h - 8)] = 0.f; lse[(size_t)T * 8 + tok * 8 + (h - 8)] = -1.0e30f; lse[(size_t)2 * T * 8 + tok * 8 + (h - 8)] = -1.0e30f; }
}

namespace att {
typedef float f32x16 __attribute__((ext_vector_type(16)));
typedef short s16x4 __attribute__((ext_vector_type(4)));
typedef short v4i16_t __attribute__((ext_vector_type(4)));
typedef __bf16 bf16x2_t __attribute__((ext_vector_type(2)));
constexpr int L_BUF = 16384;
constexpr int L_WSF = 2 * L_BUF;
constexpr int L_OST = L_WSF + 8 * 256;
constexpr int L_FLG = L_OST + 8 * 4096;
constexpr int L_END = L_FLG + 64;
constexpr float M_INIT = -1.0e30f;
#define ATT_MFMA(a, b, c) __builtin_amdgcn_mfma_f32_32x32x16_bf16((a), (b), (c), 0, 0, 0)

__device__ __forceinline__ unsigned cvtpk(float lo, float hi) { f32x2 v = {lo, hi}; bf16x2_t b = __builtin_convertvector(v, bf16x2_t); return __builtin_bit_cast(unsigned, b); }
__device__ __forceinline__ s16x4 vtr(LAS unsigned char* p) { return __builtin_bit_cast(s16x4, __builtin_amdgcn_ds_read_tr16_b64_v4i16((LAS v4i16_t*)p)); }

struct Wave { int lane, r32, hi, wid; LAS unsigned char* lds; LAS float* wsf; LAS unsigned char* ost; int vlo; };
__device__ __forceinline__ Wave make_wave(LAS unsigned char* lds, int tid, int wsf_off = L_WSF, int ost_off = L_OST) {
    Wave w; w.lane = tid & 63; w.r32 = w.lane & 31; w.hi = w.lane >> 5; w.wid = __builtin_amdgcn_readfirstlane(tid >> 6); w.lds = lds;
    w.wsf = (LAS float*)(lds + wsf_off) + w.wid * 64; w.ost = lds + ost_off + w.wid * 4096;
    w.vlo = ((w.lane >> 4) & 1) * 32 + (w.lane & 3) * 8 + (4 * w.hi + ((w.lane & 15) >> 2)) * 64;
    return w;
}
struct Stage { u32x4 k, v; };
template <class RowK, class RowV> __device__ __forceinline__ void stage_load(Stage& s, const Wave& w, const RowK& rowk, const RowV& rowv) {
    s.k = *(const u32x4*)(rowk(w.lane) + w.wid * 8);
    s.v = *(const u32x4*)(rowv(16 * (w.wid & 3) + (w.lane >> 2)) + (w.wid >> 2) * 32 + (w.lane & 3) * 8);
}
__device__ __forceinline__ void stage_write(const Stage& s, const Wave& w, int buf) {
    *(LAS u32x4*)(w.lds + buf * L_BUF + w.wid * 1024 + w.lane * 16) = s.k;
    *(LAS u32x4*)(w.lds + buf * L_BUF + 8192 + w.wid * 1024 + w.lane * 16) = s.v;
}
__device__ __forceinline__ f32x16 qk_sub(const Wave& w, int buf, int sub, const bf16x8 (&qf)[4], float init) {
    f32x16 acc;
#pragma unroll
    for (int r = 0; r < 16; ++r) acc[r] = init;
    LAS unsigned char* kp = w.lds + buf * L_BUF + w.hi * 1024 + (32 * sub + w.r32) * 16;
#pragma unroll
    for (int ks = 0; ks < 4; ++ks) { const bf16x8 kf = *(LAS bf16x8*)(kp + ks * 2048); acc = ATT_MFMA(kf, qf[ks], acc); }
    return acc;
}
__device__ __forceinline__ void pv_sub(const Wave& w, int buf, int sub, const f32x16& p, f32x16 (&o)[2]) {
    bf16x8 pk[2];
#pragma unroll
    for (int s = 0; s < 2; ++s) { u32x4 t; t.x = cvtpk(p[8 * s], p[8 * s + 1]); t.y = cvtpk(p[8 * s + 2], p[8 * s + 3]); t.z = cvtpk(p[8 * s + 4], p[8 * s + 5]); t.w = cvtpk(p[8 * s + 6], p[8 * s + 7]); pk[s] = __builtin_bit_cast(bf16x8, t); }
    LAS unsigned char* vb = w.lds + buf * L_BUF + 8192 + w.vlo;
#pragma unroll
    for (int db = 0; db < 2; ++db)
#pragma unroll
        for (int s = 0; s < 2; ++s) { LAS unsigned char* vp = vb + db * 4096 + (4 * sub + 2 * s) * 512;
            const s16x4 lo = vtr(vp), hh = vtr(vp + 512);
            const bf16x8 vf = __builtin_shufflevector(lo, hh, 0, 1, 2, 3, 4, 5, 6, 7);
            o[db] = ATT_MFMA(pk[s], vf, o[db]); }
}
struct VFrags { s16x4 f[2][2][2]; };
__device__ __forceinline__ void load_vfrags(const Wave& w, int buf, int sub, VFrags& v) {
    LAS unsigned char* vb = w.lds + buf * L_BUF + 8192 + w.vlo;
#pragma unroll
    for (int db = 0; db < 2; ++db)
#pragma unroll
        for (int s = 0; s < 2; ++s) { LAS unsigned char* vp = vb + db * 4096 + (4 * sub + 2 * s) * 512; v.f[db][s][0] = vtr(vp); v.f[db][s][1] = vtr(vp + 512); }
}
__device__ __forceinline__ void pv_frags(const VFrags& v, const f32x16& p, f32x16 (&o)[2]) {
    bf16x8 pk[2];
#pragma unroll
    for (int s = 0; s < 2; ++s) { u32x4 t; t.x = cvtpk(p[8 * s], p[8 * s + 1]); t.y = cvtpk(p[8 * s + 2], p[8 * s + 3]); t.z = cvtpk(p[8 * s + 4], p[8 * s + 5]); t.w = cvtpk(p[8 * s + 6], p[8 * s + 7]); pk[s] = __builtin_bit_cast(bf16x8, t); }
#pragma unroll
    for (int db = 0; db < 2; ++db)
#pragma unroll
        for (int s = 0; s < 2; ++s) { const bf16x8 vf = __builtin_shufflevector(v.f[db][s][0], v.f[db][s][1], 0, 1, 2, 3, 4, 5, 6, 7); o[db] = ATT_MFMA(pk[s], vf, o[db]); }
}
__device__ __forceinline__ void scale_rows(const Wave& w, f32x16 (&o)[2], float f) {
    if (w.hi == 0) w.wsf[w.r32] = f;
#pragma unroll
    for (int g = 0; g < 4; ++g) { const f32x4 fv = *(LAS f32x4*)(w.wsf + 8 * g + 4 * w.hi);
#pragma unroll
        for (int i = 0; i < 4; ++i) { o[0][4 * g + i] *= fv[i]; o[1][4 * g + i] *= fv[i]; } }
}
__device__ __forceinline__ void softmax_sub(const Wave& w, f32x16& s, float& m, float& lsum, f32x16 (&o)[2]) {
    float tm = fmaxf(fmaxf(s[0], s[1]), fmaxf(s[2], s[3]));
#pragma unroll
    for (int r = 4; r < 16; r += 4) tm = fmaxf(tm, fmaxf(fmaxf(s[r], s[r + 1]), fmaxf(s[r + 2], s[r + 3])));
    tm = max_xor32(tm);
    const float mn = fmaxf(m, tm);
    if (__any(mn > m)) { const float al = __builtin_amdgcn_exp2f(m - mn); lsum *= al; scale_rows(w, o, al); m = mn; }
    float acc = 0.f;
#pragma unroll
    for (int r = 0; r < 16; ++r) { s[r] = __builtin_amdgcn_exp2f(s[r] - m); acc += s[r]; }
    lsum += acc;
}
__device__ __forceinline__ void mask_band(f32x16& s, int delta0, int W) {
#pragma unroll
    for (int r = 0; r < 16; ++r) { const int dl = delta0 - ((r & 3) + 8 * (r >> 2)); if ((unsigned)dl > (unsigned)W) s[r] = -INFINITY; }
}
constexpr float SM_THR = 8.0f;
struct SubDesc { bool act; int delta; int W; };
template <int NSUB>
__device__ __forceinline__ void softmax_step(const Wave& w, int buf, const bf16x8 (&qf)[4], const bf16x8& kidx, const bf16x8& slp, float slope, const SubDesc (&sd)[NSUB],
                                             float& m, float& lsum, f32x16 (&o)[2], bool& first) {
    f32x16 s[NSUB];
    bool any_act = false;
#pragma unroll
    for (int i = 0; i < NSUB; ++i) if (sd[i].act) { any_act = true; s[i] = qk_sub(w, buf, i, qf, -slope * (float)sd[i].delta - m); s[i] = ATT_MFMA(kidx, slp, s[i]); }
    if (!any_act) return;
    float tm = -INFINITY;
#pragma unroll
    for (int i = 0; i < NSUB; ++i) if (sd[i].act) {
        if (sd[i].W >= 0) mask_band(s[i], sd[i].delta - 4 * w.hi, sd[i].W);
        float t = fmaxf(fmaxf(s[i][0], s[i][1]), fmaxf(s[i][2], s[i][3]));
#pragma unroll
        for (int r = 4; r < 16; r += 4) t = fmaxf(t, fmaxf(fmaxf(s[i][r], s[i][r + 1]), fmaxf(s[i][r + 2], s[i][r + 3])));
        tm = fmaxf(tm, t); }
    tm = max_xor32(tm);
    if (first || __any(tm > SM_THR)) {
        const float d = first ? (tm > -1.0e30f ? tm : 0.f) : fmaxf(tm, 0.f);
#pragma unroll
        for (int i = 0; i < NSUB; ++i) if (sd[i].act) {
#pragma unroll
            for (int r = 0; r < 16; ++r) s[i][r] -= d; }
        if (!first) { const float al = __builtin_amdgcn_exp2f(-d); lsum *= al; scale_rows(w, o, al); }
        m += d; first = false;
    }
    VFrags vf[NSUB];
#pragma unroll
    for (int i = 0; i < NSUB; ++i) if (sd[i].act) load_vfrags(w, buf, i, vf[i]);
#pragma unroll
    for (int i = 0; i < NSUB; ++i) if (sd[i].act) { float acc = 0.f;
#pragma unroll
        for (int r = 0; r < 16; ++r) { s[i][r] = __builtin_amdgcn_exp2f(s[i][r]); acc += s[i][r]; }
        lsum += acc; }
#pragma unroll
    for (int i = 0; i < NSUB; ++i) if (sd[i].act) pv_frags(vf[i], s[i], o);
}
__device__ __forceinline__ void bias_frags(const Wave& w, float slope, bf16x8& kidx, bf16x8& slp) {
    const unsigned kb = f2bf((float)w.r32), sh = f2bf(slope), sl = f2bf(slope - __builtin_bit_cast(float, sh << 16));
    const u32x4 a = {w.hi == 0 ? (kb | (kb << 16)) : 0u, 0u, 0u, 0u}, b = {w.hi == 0 ? (sh | (sl << 16)) : 0u, 0u, 0u, 0u};
    kidx = __builtin_bit_cast(bf16x8, a); slp = __builtin_bit_cast(bf16x8, b);
}
template <class RowO> __device__ __forceinline__ void store_o(const Wave& w, const f32x16 (&o)[2], const RowO& rowo) {
    LAS unsigned short* stg = (LAS unsigned short*)w.ost;
#pragma unroll
    for (int r = 0; r < 16; ++r) { const int q = (r & 3) + 8 * (r >> 2) + 4 * w.hi;
#pragma unroll
        for (int db = 0; db < 2; ++db) stg[q * 64 + db * 32 + w.r32] = (unsigned short)f2bf(o[db][r]); }
#pragma unroll
    for (int i = 0; i < 4; ++i) { const int row = i * 8 + (w.lane >> 3), ch = w.lane & 7; const u32x4 v = *(LAS u32x4*)((LAS unsigned char*)stg + row * 128 + ch * 16);
        bf16_t* dst = rowo(row); if (dst) *(u32x4*)(dst + ch * 8) = v; }
}
__device__ __forceinline__ void load_q(bf16x8 (&qf)[4], const bf16_t* qrow, int hi) {
#pragma unroll
    for (int ks = 0; ks < 4; ++ks) qf[ks] = *(const bf16x8*)(qrow + 16 * ks + 8 * hi);
}

constexpr int W_WSF = 98304, W_OST = W_WSF + 2048, W_ENUM = W_OST + 32768;
template <int NC> struct Pref { u32x4 k[NC], v[NC]; bf16x8 q[4]; };
template <int NC, class RowF> __device__ __forceinline__ void win_issue(Pref<NC>& P, const Wave& w, const bf16_t* kbase, const bf16_t* vbase, const RowF& rowoff, const bf16_t* qrow) {
#pragma unroll
    for (int c = 0; c < NC; ++c) { P.k[c] = *(const u32x4*)(kbase + rowoff(64 * c + 8 * w.wid + (w.lane >> 3)) + (w.lane & 7) * 8);
        P.v[c] = *(const u32x4*)(vbase + rowoff(64 * c + 16 * (w.wid & 3) + (w.lane >> 2)) + (w.wid >> 2) * 32 + (w.lane & 3) * 8); }
    load_q(P.q, qrow, w.hi);
}
template <int NC> __device__ __forceinline__ void win_commit(const Pref<NC>& P, const Wave& w) {
    constexpr int NK = 64 * NC;
#pragma unroll
    for (int c = 0; c < NC; ++c) { const int key = 64 * c + 8 * w.wid + (w.lane >> 3);
        *(LAS u32x4*)(w.lds + key * 128 + ((((w.lane & 7) ^ (key >> 1)) & 7) * 16)) = P.k[c];
        *(LAS u32x4*)(w.lds + NK * 128 + (w.wid >> 2) * (NK * 64) + (8 * c + 2 * (w.wid & 3)) * 512 + w.lane * 16) = P.v[c]; }
}
template <int NK> __device__ __forceinline__ f32x16 qk_win(const Wave& w, int u, const bf16x8 (&qf)[4], float init) {
    f32x16 acc;
#pragma unroll
    for (int r = 0; r < 16; ++r) acc[r] = init;
    LAS unsigned char* kp = w.lds + (32 * u + w.r32) * 128; const int x = (w.r32 >> 1) & 7;
#pragma unroll
    for (int ks = 0; ks < 4; ++ks) { const bf16x8 kf = *(LAS bf16x8*)(kp + (((2 * ks + w.hi) ^ x) * 16)); acc = ATT_MFMA(kf, qf[ks], acc); }
    return acc;
}
template <int NK> __device__ __forceinline__ void load_vfrags_win(const Wave& w, int u, VFrags& v) {
    LAS unsigned char* vb = w.lds + NK * 128 + w.vlo;
#pragma unroll
    for (int db = 0; db < 2; ++db)
#pragma unroll
        for (int s = 0; s < 2; ++s) { LAS unsigned char* vp = vb + db * (NK * 64) + (4 * u + 2 * s) * 512; v.f[db][s][0] = vtr(vp); v.f[db][s][1] = vtr(vp + 512); }
}
struct WSub { bool act; int u; int delta; int W; };
template <int NK>
__device__ __forceinline__ void softmax_win(const Wave& w, const bf16x8 (&qf)[4], const bf16x8& kidx, const bf16x8& slp, float slope, const WSub (&sd)[2], float& m, float& lsum, f32x16 (&o)[2], bool& first) {
    f32x16 s[2];
    bool any_act = false;
#pragma unroll
    for (int i = 0; i < 2; ++i) if (sd[i].act) { any_act = true; s[i] = qk_win<NK>(w, sd[i].u, qf, -slope * (float)sd[i].delta - m); s[i] = ATT_MFMA(kidx, slp, s[i]); }
    if (!any_act) return;
    float tm = -INFINITY;
#pragma unroll
    for (int i = 0; i < 2; ++i) if (sd[i].act) {
        if (sd[i].W >= 0) mask_band(s[i], sd[i].delta - 4 * w.hi, sd[i].W);
        float t = fmaxf(fmaxf(s[i][0], s[i][1]), fmaxf(s[i][2], s[i][3]));
#pragma unroll
        for (int r = 4; r < 16; r += 4) t = fmaxf(t, fmaxf(fmaxf(s[i][r], s[i][r + 1]), fmaxf(s[i][r + 2], s[i][r + 3])));
        tm = fmaxf(tm, t); }
    tm = max_xor32(tm);
    if (first || __any(tm > SM_THR)) {
        const float d = first ? (tm > -1.0e30f ? tm : 0.f) : fmaxf(tm, 0.f);
#pragma unroll
        for (int i = 0; i < 2; ++i) if (sd[i].act) {
#pragma unroll
            for (int r = 0; r < 16; ++r) s[i][r] -= d; }
        if (!first) { const float al = __builtin_amdgcn_exp2f(-d); lsum *= al; scale_rows(w, o, al); }
        m += d; first = false;
    }
#pragma unroll
    for (int i = 0; i < 2; ++i) if (sd[i].act) { VFrags vf; load_vfrags_win<NK>(w, sd[i].u, vf);
        float acc = 0.f;
#pragma unroll
        for (int r = 0; r < 16; ++r) { s[i][r] = __builtin_amdgcn_exp2f(s[i][r]); acc += s[i][r]; }
        lsum += acc;
        pv_frags(vf, s[i], o); }
}

__device__ __forceinline__ size_t ql_off(int bh, int j) { return (size_t)bh * QL_PER_BH + (size_t)(8192 * j - 128 * j * (j + 1)); }
__device__ __forceinline__ float* lsem_ptr(float* l0, float* l1, int slot) { return (slot < 2 ? l0 : l1) + (size_t)(slot & 1) * T * 4; }

struct Top3 { int i0, i1, i2; };
__device__ __forceinline__ Top3 moba_top3(const Wave& w, const bf16x8 (&qf)[4], const float* KMEAN, int b, int h, int own) {
    int i0 = -1, i1 = -1, i2 = -1;
    if (own > 0) {
    f32x16 g;
#pragma unroll
    for (int r = 0; r < 16; ++r) g[r] = 0.f;
    const float* km = KMEAN + ((size_t)(b * 4 + h) * 32 + w.r32) * HD + 8 * w.hi;
#pragma unroll
    for (int ks = 0; ks < 4; ++ks) { const f32x4 a0 = *(const f32x4*)(km + 16 * ks), a1 = *(const f32x4*)(km + 16 * ks + 4);
        const float x[8] = {a0.x, a0.y, a0.z, a0.w, a1.x, a1.y, a1.z, a1.w}; unsigned hw[4], lw[4];
#pragma unroll
        for (int j = 0; j < 4; ++j) { const unsigned h0 = f2bf(x[2 * j]), h1 = f2bf(x[2 * j + 1]); hw[j] = h0 | (h1 << 16);
            lw[j] = pk2(x[2 * j] - __builtin_bit_cast(float, h0 << 16), x[2 * j + 1] - __builtin_bit_cast(float, h1 << 16)); }
        const u32x4 hv = {hw[0], hw[1], hw[2], hw[3]}, lv = {lw[0], lw[1], lw[2], lw[3]};
        g = ATT_MFMA(__builtin_bit_cast(bf16x8, hv), qf[ks], g); g = ATT_MFMA(__builtin_bit_cast(bf16x8, lv), qf[ks], g); }
    float v0 = -INFINITY, v1 = -INFINITY, v2 = -INFINITY;
#pragma unroll
    for (int r = 0; r < 16; ++r) { const int blk = (r & 3) + 8 * (r >> 2) + 4 * w.hi; const float val = (blk < own) ? g[r] : -INFINITY;
        if (val > v0) { v2 = v1; i2 = i1; v1 = v0; i1 = i0; v0 = val; i0 = blk; } else if (val > v1) { v2 = v1; i2 = i1; v1 = val; i1 = blk; } else if (val > v2) { v2 = val; i2 = blk; } }
    const float pv_[3] = {get_xor32(v0, w.hi), get_xor32(v1, w.hi), get_xor32(v2, w.hi)}; const int pi_[3] = {get_xor32i(i0, w.hi), get_xor32i(i1, w.hi), get_xor32i(i2, w.hi)};
#pragma unroll
    for (int k = 0; k < 3; ++k) { const float val = pv_[k]; const int blk = pi_[k];
        if (val > v0 || (val == v0 && blk < i0)) { v2 = v1; i2 = i1; v1 = v0; i1 = i0; v0 = val; i0 = blk; }
        else if (val > v1 || (val == v1 && blk < i1)) { v2 = v1; i2 = i1; v1 = val; i1 = blk; }
        else if (val > v2 || (val == v2 && blk < i2)) { v2 = val; i2 = blk; } }
    }
    Top3 t; t.i0 = i0; t.i1 = i1; t.i2 = i2; return t;
}
__device__ __forceinline__ void moba_gate_unit(LAS unsigned char* lds, const bf16_t* QB, const float* KMEAN, unsigned* mcnt, unsigned* qlist, bf16_t* PM, float* LSEM0, float* LSEM1, int b, int h, int own, int tid) {
    const Wave w = make_wave(lds, tid);
    const size_t rowbase = (size_t)b * SEQ; const int qpos = own * 256 + 32 * w.wid + w.r32, bh = b * 4 + h;
    bf16x8 qf[4]; load_q(qf, QB + (rowbase + qpos) * DM + h * HD, w.hi);
    const Top3 t3 = moba_top3(w, qf, KMEAN, b, h, own); const int s0 = t3.i0, s1 = t3.i1, s2 = t3.i2;
    LAS unsigned* cl = (LAS unsigned*)(lds + W_ENUM);
    if (tid < 64) cl[tid] = 0u;
    __syncthreads();
    unsigned r0 = 0u, r1 = 0u, r2 = 0u;
    if (w.hi == 0) {
        if (s0 >= 0) r0 = __hip_atomic_fetch_add(cl + s0, 1u, __ATOMIC_RELAXED, __HIP_MEMORY_SCOPE_WORKGROUP);
        if (s1 >= 0) r1 = __hip_atomic_fetch_add(cl + s1, 1u, __ATOMIC_RELAXED, __HIP_MEMORY_SCOPE_WORKGROUP);
        if (s2 >= 0) r2 = __hip_atomic_fetch_add(cl + s2, 1u, __ATOMIC_RELAXED, __HIP_MEMORY_SCOPE_WORKGROUP);
    }
    __syncthreads();
    if (tid < 32) { const unsigned c = cl[tid]; cl[32 + tid] = c ? __hip_atomic_fetch_add(mcnt + bh * 32 + tid, c, __ATOMIC_RELAXED, __HIP_MEMORY_SCOPE_AGENT) : 0u; }
    __syncthreads();
    if (w.hi == 0) {
        const size_t tok = rowbase + qpos;
#define MOBA_EMIT(k, sk, rk) do { if (sk >= 0) qlist[ql_off(bh, sk) + cl[32 + sk] + rk] = (unsigned)qpos | ((unsigned)(k) << 13); \
            else { lsem_ptr(LSEM0, LSEM1, k)[tok * 4 + h] = -1.0e30f;          \
                u32x4* pz = (u32x4*)(PM + ((size_t)(k) * T + tok) * 256 + h * HD); const u32x4 z4 = {0u, 0u, 0u, 0u}; \
                _Pragma("unroll") for (int c = 0; c < 8; ++c) pz[c] = z4; } } while (0)
        MOBA_EMIT(0, s0, r0); MOBA_EMIT(1, s1, r1); MOBA_EMIT(2, s2, r2);
#undef MOBA_EMIT
    }
    __syncthreads();
}
struct OwnU { int b, h, own; };
__device__ __forceinline__ void own_issue(Pref<4>& P, const Wave& w, const OwnU& u, const bf16_t* QB, const bf16_t* KB, const bf16_t* VB) {
    const size_t rowbase = (size_t)u.b * SEQ; const int q0 = u.own * 256;
    win_issue<4>(P, w, KB + (rowbase + q0) * DM + u.h * HD, VB + (rowbase + q0) * DM + u.h * HD, [&](int key) { return (size_t)key * DM; }, QB + (rowbase + q0 + 32 * w.wid + w.r32) * DM + u.h * HD);
}
__device__ __forceinline__ void own_compute(const Wave& w, const OwnU& u, const bf16x8 (&qf)[4], bf16_t* OB, float* LSEM0, float* LSEM1) {
    const size_t rowbase = (size_t)u.b * SEQ; const int q0 = u.own * 256, ql = 32 * w.wid + w.r32;
    const float slope2 = exp2f(-2.0f * (float)(u.h + 1)) * LOG2E;
    bf16x8 kidx, slp; bias_frags(w, slope2, kidx, slp);
    f32x16 o[2];
#pragma unroll
    for (int r = 0; r < 16; ++r) { o[0][r] = 0.f; o[1][r] = 0.f; }
    float m = 0.f, lsum = 0.f; bool first = true;
#pragma unroll
    for (int p = 0; p < 4; ++p) { WSub sd[2];
#pragma unroll
        for (int i = 0; i < 2; ++i) { const int su = w.wid - 2 * p - i; sd[i].act = su >= 0; sd[i].u = su; sd[i].delta = ql - 32 * su; sd[i].W = (su == w.wid) ? 0x7fffffff : -1; }
        softmax_win<256>(w, qf, kidx, slp, slope2, sd, m, lsum, o, first); }
    const float l = sum_xor32(lsum);
    scale_rows(w, o, 1.0f / l);
    bf16_t* orow = OB + (rowbase + q0 + 32 * w.wid) * DM + u.h * HD;
    store_o(w, o, [&](int r) { return orow + (size_t)r * DM; });
    if (w.hi == 0) lsem_ptr(LSEM0, LSEM1, 3)[(rowbase + q0 + ql) * 4 + u.h] = m + __builtin_amdgcn_logf(l);
}
struct GatU { int b, h, j, cnt, chunk; const unsigned* ql; };
__device__ __forceinline__ unsigned gat_entry(const Wave& w, const GatU& u, bool& valid) { const int idx = u.chunk * 256 + 32 * w.wid + w.r32; valid = idx < u.cnt; return u.ql[valid ? idx : u.chunk * 256]; }
__device__ __forceinline__ void gat_issue(Pref<4>& P, const Wave& w, const GatU& u, const bf16_t* QB, const bf16_t* KB, const bf16_t* VB) {
    const size_t rowbase = (size_t)u.b * SEQ; bool valid; const unsigned e = gat_entry(w, u, valid);
    win_issue<4>(P, w, KB + (rowbase + u.j * 256) * DM + u.h * HD, VB + (rowbase + u.j * 256) * DM + u.h * HD, [&](int key) { return (size_t)key * DM; }, QB + (rowbase + (e & 8191u)) * DM + u.h * HD);
}
__device__ __forceinline__ void gat_compute(const Wave& w, const GatU& u, const bf16x8 (&qf)[4], bf16_t* PM, float* LSEM0, float* LSEM1) {
    const size_t rowbase = (size_t)u.b * SEQ; bool valid; const unsigned e = gat_entry(w, u, valid);
    const int qpos = (int)(e & 8191u), slot = (int)(e >> 13);
    const float slope2 = exp2f(-2.0f * (float)(u.h + 1)) * LOG2E;
    bf16x8 kidx, slp; bias_frags(w, slope2, kidx, slp);
    f32x16 o[2];
#pragma unroll
    for (int r = 0; r < 16; ++r) { o[0][r] = 0.f; o[1][r] = 0.f; }
    float m = 0.f, lsum = 0.f; bool first = true;
#pragma unroll
    for (int p = 0; p < 4; ++p) { WSub sd[2];
#pragma unroll
        for (int i = 0; i < 2; ++i) { const int su = 7 - 2 * p - i; sd[i].act = true; sd[i].u = su; sd[i].delta = qpos - (u.j * 256 + 32 * su); sd[i].W = -1; }
        softmax_win<256>(w, qf, kidx, slp, slope2, sd, m, lsum, o, first); }
    const float l = sum_xor32(lsum);
    scale_rows(w, o, l > 0.f ? 1.0f / l : 0.f);
    LAS int* code = (LAS int*)(w.wsf + 32);
    if (w.hi == 0) code[w.r32] = valid ? (int)((size_t)slot * T + rowbase + qpos) : -1;
    store_o(w, o, [&](int r) { const int c = code[r]; return c >= 0 ? PM + (size_t)c * 256 + u.h * HD : (bf16_t*)nullptr; });
    if (w.hi == 0 && valid) lsem_ptr(LSEM0, LSEM1, slot)[(rowbase + qpos) * 4 + u.h] = l > 0.f ? m + __builtin_amdgcn_logf(l) : -1.0e30f;
}

__device__ __forceinline__ void sb_unit(LAS unsigned char* lds, const bf16_t* QB, const bf16_t* KB, const bf16_t* VB, bf16_t* OB, int b, int h, int qt, int tid) {
    const Wave w = make_wave(lds, tid);
    const size_t rowbase = (size_t)b * SEQ; const int q0 = qt * 256, qpos = q0 + 32 * w.wid + w.r32;
    const bf16_t* kh = KB + rowbase * DM + h * HD; const bf16_t* vh = VB + rowbase * DM + h * HD;
    bf16x8 qf[4]; load_q(qf, QB + (rowbase + qpos) * DM + h * HD, w.hi);
    f32x16 o[2];
#pragma unroll
    for (int r = 0; r < 16; ++r) { o[0][r] = 0.f; o[1][r] = 0.f; }
    float carry = 0.f;
    bool done = false;
    volatile LAS unsigned* flg = (volatile LAS unsigned*)(lds + L_FLG);
    const int ti0 = q0 / 64 + 3;
    Stage sg;
    { const int kp = ti0 * 64; stage_load(sg, w, [&](int key) { return kh + (size_t)(kp + key) * DM; }, [&](int key) { return vh + (size_t)(kp + key) * DM; }); }
    stage_write(sg, w, 0);
    __syncthreads();
    for (int st = 0;; ++st) {
        const int buf = st & 1, ti = ti0 - st;
        if (ti > 0) { const int kp = (ti - 1) * 64; stage_load(sg, w, [&](int key) { return kh + (size_t)(kp + key) * DM; }, [&](int key) { return vh + (size_t)(kp + key) * DM; }); }
        if (!done) {
#pragma unroll
            for (int sub = 1; sub >= 0; --sub) {
                const int D = (q0 / 32 + w.wid) - (2 * ti + sub);
                if (D < 0) continue;
                const int delta0 = qpos - (64 * ti + 32 * sub) - 4 * w.hi;
                f32x16 z = qk_sub(w, buf, sub, qf, 0.f);
                f32x16 L;
#pragma unroll
                for (int r = 0; r < 16; ++r) { const float lp = __builtin_amdgcn_logf(1.0f + __builtin_amdgcn_exp2f(-fabsf(z[r]))); L[r] = -(fmaxf(z[r], 0.f) + lp); }
                if (D == 0) {
#pragma unroll
                    for (int r = 0; r < 16; ++r) { const int dl = delta0 - ((r & 3) + 8 * (r >> 2)); if (dl < 1) { L[r] = 0.f; z[r] = -INFINITY; } }
                }
                float G[4], PG[4];
#pragma unroll
                for (int g = 0; g < 4; ++g) { G[g] = (L[4 * g] + L[4 * g + 1]) + (L[4 * g + 2] + L[4 * g + 3]); PG[g] = get_xor32(G[g], w.hi); }
                float run = carry;
#pragma unroll
                for (int g = 3; g >= 0; --g) { const float t3 = run + (w.hi == 0 ? PG[g] : 0.f), t2 = t3 + L[4 * g + 3], t1 = t2 + L[4 * g + 2], t0 = t1 + L[4 * g + 1];
                    z[4 * g + 3] = __builtin_amdgcn_exp2f(z[4 * g + 3] + L[4 * g + 3] + t3); z[4 * g + 2] = __builtin_amdgcn_exp2f(z[4 * g + 2] + L[4 * g + 2] + t2);
                    z[4 * g + 1] = __builtin_amdgcn_exp2f(z[4 * g + 1] + L[4 * g + 1] + t1); z[4 * g] = __builtin_amdgcn_exp2f(z[4 * g] + L[4 * g] + t0);
                    run += G[g] + PG[g]; }
                carry = run;
                pv_sub(w, buf, sub, z, o);
            }
            done = __all(carry < -150.f);
        }
        if (w.lane == 0) flg[buf * 8 + w.wid] = done ? 1u : 0u;
        if (ti > 0) stage_write(sg, w, buf ^ 1);
        __syncthreads();
        unsigned all = 1u;
#pragma unroll
        for (int k = 0; k < 8; ++k) all &= flg[buf * 8 + k];
        if (all || ti == 0) break;
    }
    bf16_t* orow = OB + (rowbase + q0 + 32 * w.wid) * DM + h * HD;
    store_o(w, o, [&](int r) { return orow + (size_t)r * DM; });
    __syncthreads();
}

struct DilU { int b, h, dil, res, i2, c; };
__device__ __forceinline__ DilU dil_decode(int u) { const int n = u & 31, bhc = u >> 5, c = bhc % 3, bh = bhc / 3; DilU d; d.b = bh >> 3; d.h = 8 + (bh & 7); d.c = c;
    d.dil = (c == 0) ? 1 : (c == 1) ? 4 : 16; d.res = (c == 0) ? 0 : (c == 1) ? (n >> 3) : (n >> 1); d.i2 = (c == 0) ? n : (c == 1) ? (n & 7) : (n & 1); return d; }
__device__ __forceinline__ void dil_issue(Pref<6>& P, const Wave& w, const DilU& u, const bf16_t* QB, const bf16_t* KB, const bf16_t* VB) {
    const size_t rowbase = (size_t)u.b * SEQ; const int Q0 = 256 * u.i2, qj = Q0 + 32 * w.wid + w.r32; const size_t rstride = (size_t)u.dil * DM;
    win_issue<6>(P, w, KB + (rowbase + u.res) * DM + u.h * HD, VB + (rowbase + u.res) * DM + u.h * HD,
                 [&](int key) { const int kj = Q0 - 128 + key; return (size_t)(kj < 0 ? 0 : kj) * rstride; },
                 QB + (rowbase + u.res + (size_t)qj * u.dil) * DM + u.h * HD);
}
__device__ __forceinline__ void dil_compute(const Wave& w, const DilU& u, const bf16x8 (&qf)[4], bf16_t* OB, bf16_t* HB2, float* LSE) {
    const size_t rowbase = (size_t)u.b * SEQ; const int Q0 = 256 * u.i2, ql = 32 * w.wid + w.r32;
    const float slope2d = exp2f(-(float)(u.h - 8 + 1)) * LOG2E * (float)u.dil;
    bf16x8 kidx, slp; bias_frags(w, slope2d, kidx, slp);
    f32x16 o[2];
#pragma unroll
    for (int r = 0; r < 16; ++r) { o[0][r] = 0.f; o[1][r] = 0.f; }
    float m = 0.f, lsum = 0.f; bool first = true;
#pragma unroll
    for (int p = 0; p < 3; ++p) { WSub sd[2];
#pragma unroll
        for (int i = 0; i < 2; ++i) { const int D = 2 * p + i, su = w.wid + 4 - D; sd[i].act = (D <= 4) && (Q0 - 128 + 32 * su >= 0); sd[i].u = su; sd[i].delta = ql + 128 - 32 * su; sd[i].W = (D == 0 || D == 4) ? 128 : -1; }
        softmax_win<384>(w, qf, kidx, slp, slope2d, sd, m, lsum, o, first); }
    const float l = sum_xor32(lsum);
    scale_rows(w, o, 1.0f / l);
    bf16_t* PO = (u.c == 0) ? OB + 512 : HB2 + (u.c - 1) * 512;
    const size_t tok0 = rowbase + u.res + (size_t)(Q0 + 32 * w.wid) * u.dil;
    store_o(w, o, [&](int r) { return PO + (tok0 + (size_t)r * u.dil) * DM + (u.h - 8) * HD; });
    if (w.hi == 0) (LSE + (size_t)u.c * T * 8)[(tok0 + (size_t)w.r32 * u.dil) * 8 + (u.h - 8)] = m + __builtin_amdgcn_logf(l);
}

__device__ __forceinline__ void moba_gate_phase(LAS unsigned char* lds, const bf16_t* QB, const float* KMEAN, unsigned* mcnt, unsigned* qlist, bf16_t* PM, float* LSEM0, float* LSEM1, int v, int G, int tid) {
    for (int u = v; u < 512; u += G) { const int own = u & 31, bh = u >> 5; moba_gate_unit(lds, QB, KMEAN, mcnt, qlist, PM, LSEM0, LSEM1, bh >> 2, bh & 3, own, tid); }
}
struct AttnArgs { const bf16_t* QB; const bf16_t* KB; const bf16_t* VB; bf16_t* OB; bf16_t* HB2; float* LSE; const unsigned* mcnt; const unsigned* qlist; bf16_t* PM; float* LSEM0; float* LSEM1; };
__device__ __forceinline__ void attn_phase(LAS unsigned char* lds, const AttnArgs& A, int v, int G, int tid) {
    const Wave w = make_wave(lds, tid, W_WSF, W_OST);
    LAS int* cntl = (LAS int*)(lds + W_ENUM); LAS int* pa = cntl + 512; LAS int* pb = pa + 512;
    const int myc = (int)A.mcnt[tid], myu = (myc + 255) >> 8;
    cntl[tid] = myc; pa[tid] = myu;
    __syncthreads();
#pragma unroll 1
    for (int d = 1; d < 512; d <<= 1) { const int x = pa[tid] + (tid >= d ? pa[tid - d] : 0); pb[tid] = x; __syncthreads(); LAS int* t_ = pa; pa = pb; pb = t_; }
    const int total = pa[511];
    auto gat_decode = [&](int u) { int lo = 0, hi = 511;
        while (lo < hi) { const int mid = (lo + hi) >> 1; if (pa[mid] > u) hi = mid; else lo = mid + 1; }
        const int i = lo, c = cntl[i], bh = i >> 5; GatU g; g.b = bh >> 2; g.h = bh & 3; g.j = i & 31; g.cnt = c; g.chunk = u - (pa[i] - ((c + 255) >> 8)); g.ql = A.qlist + ql_off(bh, g.j); return g; };
    for (int u = v; u < total; u += G) { const GatU cur = gat_decode(u);
        __syncthreads();
        bf16x8 qf[4];
        { Pref<4> P; gat_issue(P, w, cur, A.QB, A.KB, A.VB); win_commit<4>(P, w); qf[0] = P.q[0]; qf[1] = P.q[1]; qf[2] = P.q[2]; qf[3] = P.q[3]; }
        __syncthreads();
        gat_compute(w, cur, qf, A.PM, A.LSEM0, A.LSEM1); }
    for (int u = v; u < 512; u += G) { OwnU cur; { const int bh = u >> 5; cur.b = bh >> 2; cur.h = bh & 3; cur.own = u & 31; }
        __syncthreads();
        bf16x8 qf[4];
        { Pref<4> P; own_issue(P, w, cur, A.QB, A.KB, A.VB); win_commit<4>(P, w); qf[0] = P.q[0]; qf[1] = P.q[1]; qf[2] = P.q[2]; qf[3] = P.q[3]; }
        __syncthreads();
        own_compute(w, cur, qf, A.OB, A.LSEM0, A.LSEM1); }
    for (int u = v; u < 3072; u += G) { const DilU cur = dil_decode(u);
        __syncthreads();
        bf16x8 qf[4];
        { Pref<6> P; dil_issue(P, w, cur, A.QB, A.KB, A.VB); win_commit<6>(P, w); qf[0] = P.q[0]; qf[1] = P.q[1]; qf[2] = P.q[2]; qf[3] = P.q[3]; }
        __syncthreads();
        dil_compute(w, cur, qf, A.OB, A.HB2, A.LSE); }
    __syncthreads();
    for (int u = v; u < 512; u += G) { const int qt = u & 31, bh = u >> 5; sb_unit(lds, A.QB, A.KB, A.VB, A.OB, bh >> 2, 4 + (bh & 3), qt, tid); }
}
}

constexpr int PH_PRO = 0, PH_L0 = 1, PH_PER_LAYER = 10, PH_FINAL = PH_L0 + DEPTH * PH_PER_LAYER, PH_COUNT = PH_FINAL + 1;
typedef const __attribute__((address_space(4))) Args* KArgP;
#define KARG() ({ KArgP p_ = (KArgP)__builtin_amdgcn_kernarg_segment_ptr(); asm volatile("" : "+s"(p_)); p_; })
#define PHASE_IDS int lane_p = (int)__builtin_amdgcn_mbcnt_hi(~0u, __builtin_amdgcn_mbcnt_lo(~0u, 0u)); LAUNDER_V(lane_p); int tid_p = wave * 64 + lane_p; int gw_p = gw, G_p = G, NGW_p = NGW; LAUNDER_S(gw_p); LAUNDER_S(G_p); LAUNDER_S(NGW_p)
__global__ void __launch_bounds__(NTHREADS, 2) fwd(Args a_unused) {
    extern __shared__ __attribute__((aligned(16))) unsigned char lds_raw[];
    LAS unsigned char* lds = (LAS unsigned char*)lds_raw;
    volatile LAS unsigned* MISC = (volatile LAS unsigned*)(lds + MISC_OFF);
    const int wave = __builtin_amdgcn_readfirstlane((int)threadIdx.x >> 6);
    const int G = gridDim.x, bx = blockIdx.x;
    const int vcu = (G % 8 == 0) ? (bx % 8) * (G / 8) + bx / 8 : bx;
    const int gw = vcu * NWAVES + wave, NGW = G * NWAVES;
    for (int u = threadIdx.x; u < (LDS_BYTES - LDSCTL_OFF) / 4; u += NTHREADS) ((LAS unsigned*)(lds + LDSCTL_OFF))[u] = 0u;
    __syncthreads();
    int lo, hi; XcdBarrier bar;
    { KArgP ka = KARG(); lo = ka->ph_lo; hi = ka->ph_hi; unsigned* ctl = (unsigned*)(ka->ws + WS_CTL); bar = xcd_barrier_post(ctl + CW_BAR + ka->li * XCD_BAR_WORDS, MISC + 8, wave); }
#define IN(k) (lo <= (k) && (k) < hi)
#define SEAM(k) do { if (IN(k) && IN((k) + 1)) xcd_barrier(bar); } while (0)
#define WSP(T_, off) ((T_*)(ws + (off)))

    if (IN(PH_PRO)) { KArgP ka = KARG(); PHASE_IDS; Args a; a.ws = ka->ws; a.w_in = ka->w_in; a.w_out = ka->w_out; a.w_gate = ka->w_gate; a.w_up = ka->w_up; a.w_down = ka->w_down; phase_prologue(a, lds, gw_p, NGW_p, wave, lane_p); } SEAM(PH_PRO);

    for (int l = 0; l < DEPTH; ++l) {
        const int p0 = PH_L0 + l * PH_PER_LAYER;
        if (hi <= p0 || lo >= p0 + PH_PER_LAYER) continue;
        if (IN(p0 + 0)) for (int rep_ = 0; rep_ < RPT(0); ++rep_) { if (rep_) xcd_barrier(bar); KArgP ka = KARG(); PHASE_IDS; unsigned char* ws = ka->ws; const float* xin = (l == 0) ? ka->x : ka->out;
            phase_norm1(xin, ka->ln1_g + (size_t)l * DM, WSP(bf16_t, WS_HB), gw_p, NGW_p, lane_p, WSP(float, WS_KMEAN)); } SEAM(p0 + 0);
        if (IN(p0 + 1)) for (int rep_ = 0; rep_ < RPT(1); ++rep_) { if (rep_) xcd_barrier(bar); KArgP ka = KARG(); PHASE_IDS; unsigned char* ws = ka->ws;
            pg8::Gemm g{(const char*)(ws + WS_HB), (const char*)(ws + WS_WIN) + (size_t)l * NQKV * DM * 2, DM, DM, DM, (long)256 * DM * 2, (long)256 * DM * 2, (long)128 * DM * 2};
            pg8::StaticOrder S; S.init(T / 256, NQKV / 256, G_p, bx);
            pg8::EpiQKV E{WSP(bf16_t, WS_Q), (size_t)(WS_K - WS_Q) / 2, QSCALE};
            pg8::gemm_phase<pg8::EpiQKV, pg8::StaticOrder>(lds, g, S, E, wave);
        } SEAM(p0 + 1);
        if (IN(p0 + 3)) { KArgP ka = KARG(); PHASE_IDS; unsigned char* ws = ka->ws;
            att::moba_gate_phase(lds, WSP(bf16_t, WS_Q), WSP(float, WS_KMEAN), WSP(unsigned, WS_CTL) + CW_MCNT + l * 512, WSP(unsigned, WS_QLIST), WSP(bf16_t, WS_PM), WSP(float, WS_LSEM0), WSP(float, WS_LSEM1), vcu, G_p, tid_p);
        } SEAM(p0 + 3);
        if (IN(p0 + 4)) for (int rep_ = 0; rep_ < RPT(4); ++rep_) { if (rep_) xcd_barrier(bar); KArgP ka = KARG(); PHASE_IDS; unsigned char* ws = ka->ws;
            const att::AttnArgs A{WSP(bf16_t, WS_Q), WSP(bf16_t, WS_K), WSP(bf16_t, WS_V), WSP(bf16_t, WS_O), WSP(bf16_t, WS_HB), WSP(float, WS_LSE), WSP(unsigned, WS_CTL) + CW_MCNT + l * 512, WSP(unsigned, WS_QLIST),
                                  WSP(bf16_t, WS_PM), WSP(float, WS_LSEM0), WSP(float, WS_LSEM1)};
            att::attn_phase(lds, A, vcu, G_p, tid_p);
        } SEAM(p0 + 4);
        if (IN(p0 + 5)) { KArgP ka = KARG(); PHASE_IDS; unsigned char* ws = ka->ws;
            phase_mixnorm(WSP(bf16_t, WS_O), WSP(bf16_t, WS_HB), WSP(float, WS_LSE), WSP(bf16_t, WS_PM), WSP(float, WS_LSEM0), WSP(float, WS_LSEM1), ka->mix_g + (size_t)l * DM, gw_p, NGW_p, lane_p); } SEAM(p0 + 5);
        if (IN(p0 + 6)) { KArgP ka = KARG(); PHASE_IDS; unsigned char* ws = ka->ws; const float* xin = (l == 0) ? ka->x : ka->out;
            pg8::Gemm g{(const char*)(ws + WS_HB), (const char*)(ws + WS_WOUT) + (size_t)l * DM * DM * 2, DM, DM, DM, (long)256 * DM * 2, (long)256 * DM * 2, (long)128 * DM * 2};
            pg8::StaticOrder S; S.init(T / 256, DM / 256, G_p, bx);
            pg8::EpiResAdd E{xin, ka->out};
            pg8::gemm_phase<pg8::EpiResAdd, pg8::StaticOrder>(lds, g, S, E, wave);
        } SEAM(p0 + 6);
        if (IN(p0 + 7)) { KArgP ka = KARG(); PHASE_IDS; unsigned char* ws = ka->ws;
            phase_route(ka->out, ka->ln2_g + (size_t)l * DM, ka->w_gr + (size_t)l * DM * 4, ka->b_gr + l * 4, ka->w_er + (size_t)l * 4 * DM * 4, ka->b_er + l * 16, WSP(bf16_t, WS_HB),
                        WSP(unsigned, WS_CTL) + CW_CNT + l * 32, WSP(unsigned, WS_LIST), WSP(float, WS_WLIST), lds, vcu, G_p, wave, lane_p); } SEAM(p0 + 7);
        if (IN(p0 + 8)) for (int rep_ = 0; rep_ < RPT(8); ++rep_) { if (rep_) xcd_barrier(bar); KArgP ka = KARG(); PHASE_IDS; unsigned char* ws = ka->ws;
            pg8::MoeProb<0> P{WSP(unsigned, WS_CTL) + CW_CNT + l * 32, WSP(unsigned, WS_LIST), (const char*)(ws + WS_HB), (const char*)(ws + WS_WG) + (size_t)l * NACT * DM * 2, DM, DM, DM, (long)(WS_WU - WS_WG), G_p, vcu, WSP(unsigned, WS_CTL) + CW_TCNT + l * 16384};
            pg8::EpiGateUpSparse E{WSP(bf16_t, WS_ACT), WSP(float, WS_WLIST), WSP(unsigned, WS_CTL) + CW_TCNT + l * 16384};
            pg8::gemm_phase_x<pg8::EpiGateUpSparse, pg8::MoeProb<0>>(lds, P, E, wave);
        }
        if (IN(p0 + 9)) { KArgP ka = KARG(); PHASE_IDS; unsigned char* ws = ka->ws;
            pg8::MoeProb<1> P{WSP(unsigned, WS_CTL) + CW_CNT + l * 32, WSP(unsigned, WS_LIST), (const char*)(ws + WS_ACT), (const char*)(ws + WS_WD) + (size_t)l * DM * NACT * 2, 512, NACT, 512, (long)128 * NACT * 2, G_p, G_p - 1 - vcu, WSP(unsigned, WS_CTL) + CW_TCNT + l * 16384};
            pg8::EpiDownScatter E{ka->out, WSP(unsigned, WS_LIST)};
            pg8::gemm_phase_x<pg8::EpiDownScatter, pg8::MoeProb<1>>(lds, P, E, wave);
        } SEAM(p0 + 9);
    }
    if (IN(PH_FINAL)) { KArgP ka = KARG(); PHASE_IDS; phase_final(ka->out, ka->fin_g, gw_p, NGW_p, lane_p); }
#undef IN
#undef SEAM
#undef WSP
}

#ifndef N_LAUNCH_MODE
#define N_LAUNCH_MODE 1
#endif
extern "C" void kernel_launch(void* const* d_in, const int* in_sizes, int n_in, void* d_out, int out_size, void* d_ws, size_t ws_size, hipStream_t stream) {
    static int grid = 0;
    if (grid == 0) {
        if (n_in != 14 || in_sizes[0] != T * DM || out_size != T * DM || ws_size < WS_END) { fprintf(stderr, "kernel_launch: unexpected shapes (n_in %d in0 %d out %d ws %zu)\n", n_in, n_in > 0 ? in_sizes[0] : -1, out_size, ws_size); grid = -1; return; }
        int dev = 0, cus = 0, per_cu = 0;
        if (hipGetDevice(&dev) != hipSuccess || hipDeviceGetAttribute(&cus, hipDeviceAttributeMultiprocessorCount, dev) != hipSuccess) { grid = -1; return; }
        if (hipFuncSetAttribute((const void*)fwd, hipFuncAttributeMaxDynamicSharedMemorySize, LDS_BYTES) != hipSuccess) { fprintf(stderr, "kernel_launch: hipFuncSetAttribute failed\n"); grid = -1; return; }
        if (hipOccupancyMaxActiveBlocksPerMultiprocessor(&per_cu, (const void*)fwd, NTHREADS, LDS_BYTES) != hipSuccess || per_cu < 1) fprintf(stderr, "kernel_launch: occupancy query says %d\n", per_cu);
        (void)hipGetLastError();
        grid = cus;
    }
    if (grid < 0) return;
    if (hipMemsetAsync((char*)d_ws + WS_CTL, 0, CTL_ZERO_BYTES, stream) != hipSuccess) return;
    Args a{};
    a.x = (const float*)d_in[0]; a.ln1_g = (const float*)d_in[1]; a.w_in = (const float*)d_in[2]; a.mix_g = (const float*)d_in[3]; a.w_out = (const float*)d_in[4]; a.ln2_g = (const float*)d_in[5];
    a.w_gr = (const float*)d_in[6]; a.b_gr = (const float*)d_in[7]; a.w_er = (const float*)d_in[8]; a.b_er = (const float*)d_in[9]; a.w_gate = (const float*)d_in[10]; a.w_up = (const float*)d_in[11];
    a.w_down = (const float*)d_in[12]; a.fin_g = (const float*)d_in[13];
    a.out = (float*)d_out; a.ws = (unsigned char*)d_ws; a.pad = 0;
#if N_LAUNCH_MODE == 1
    a.ph_lo = 0; a.ph_hi = PH_COUNT; a.li = 0;
    hipLaunchKernelGGL(fwd, dim3(grid), dim3(NTHREADS), LDS_BYTES, stream, a);
#else
    for (int p = 0; p < PH_COUNT; ++p) { a.ph_lo = p; a.ph_hi = p + 1; a.li = p; hipLaunchKernelGGL(fwd, dim3(grid), dim3(NTHREADS), LDS_BYTES, stream, a); }
#endif
}
```

```cpp
#include <hip/hip_runtime.h>
#include <cstdio>
#include <cstdint>

#define LAS __attribute__((address_space(3)))
#define GAS __attribute__((address_space(1)))
typedef unsigned short bf16_t;
typedef short bf16x8 __attribute__((ext_vector_type(8)));
typedef float f32x4 __attribute__((ext_vector_type(4)));
typedef float f32x2 __attribute__((ext_vector_type(2)));
typedef unsigned u32x4 __attribute__((ext_vector_type(4)));
typedef unsigned u32x2 __attribute__((ext_vector_type(2)));

#ifndef PROBE_REPEAT
#define PROBE_REPEAT 0
#endif
#define RPT(k) ((((PROBE_REPEAT) >> (k)) & 1) ? 2 : 1)
#ifndef MOE_SPARSE
#define MOE_SPARSE 1
#endif
#ifndef ATT_MOBA
#define ATT_MOBA 1
#endif
#ifndef ATT_SB
#define ATT_SB 1
#endif
#ifndef ATT_DIL
#define ATT_DIL 1
#endif
constexpr int BATCH = 4, SEQ = 8192, DM = 1024, DEPTH = 4, T = BATCH * SEQ, NH = 16, HD = 64;
constexpr int NQKV = 3 * DM, NEXP = 16, DEXP = 256, NACT = NEXP * DEXP;
constexpr float NORM_EPS = 1e-6f;
constexpr float LOG2E = 1.4426950408889634f;
constexpr float QSCALE = 0.125f * LOG2E;
constexpr int NWAVES = 8, NTHREADS = 512;

constexpr size_t MiB = 1u << 20;
constexpr size_t WS_CTL = 0, CTL_ZERO_BYTES = 1 * MiB;
constexpr size_t WS_WIN = 2 * MiB;
constexpr size_t WS_WOUT = 26 * MiB;
constexpr size_t WS_WG = 34 * MiB;
constexpr size_t WS_WU = 66 * MiB;
constexpr size_t WS_WD = 98 * MiB;
constexpr size_t WS_LSEM0 = 1 * MiB;
constexpr size_t WS_KMEAN = 130 * MiB;
constexpr size_t WS_HB = 131 * MiB;
constexpr size_t WS_Q = 195 * MiB, WS_K = 259 * MiB, WS_V = 323 * MiB, WS_O = 387 * MiB;
constexpr size_t WS_ACT = WS_Q;
constexpr size_t WS_LSE = 451 * MiB;
constexpr size_t WS_LIST = 454 * MiB;
constexpr size_t WS_WLIST = 457 * MiB;
constexpr size_t WS_QLIST = WS_LIST;
constexpr size_t WS_PM = 463 * MiB;
constexpr size_t WS_LSEM1 = 511 * MiB;
constexpr size_t WS_END = 512 * MiB;
constexpr int QL_PER_BH = 126976;
constexpr int CW_MCNT = 2048;
constexpr int CW_CNT = 1024;
constexpr int CW_TCNT = 16384;
constexpr int CW_BAR = 4096;

constexpr int RING_BYTES = 131072;
constexpr int LDSCTL_OFF = 147456, MISC_OFF = LDSCTL_OFF + 320;
constexpr int LDS_BYTES = 148480;

__device__ __forceinline__ unsigned f2bf(float f) { unsigned u = __builtin_bit_cast(unsigned, f); return (u + 0x7fffu + ((u >> 16) & 1u)) >> 16; }
__device__ __forceinline__ unsigned pk2(float lo, float hi) { return f2bf(lo) | (f2bf(hi) << 16); }
__device__ __forceinline__ float bflo(unsigned w) { return __builtin_bit_cast(float, w << 16); }
__device__ __forceinline__ float bfhi(unsigned w) { return __builtin_bit_cast(float, w & 0xffff0000u); }
template <int M> __device__ __forceinline__ float swz_xor(float v) { return __builtin_bit_cast(float, __builtin_amdgcn_ds_swizzle(__builtin_bit_cast(int, v), 0x1f | (M << 10))); }
__device__ __forceinline__ void swap32(unsigned x, unsigned& lo_val, unsigned& hi_val) { unsigned y = x; asm volatile("" : "+v"(y)); auto rr = __builtin_amdgcn_permlane32_swap(x, y, false, false); lo_val = rr[0]; hi_val = rr[1]; }
__device__ __forceinline__ float sum_xor32(float v) { unsigned a, b; swap32(__builtin_bit_cast(unsigned, v), a, b); return __builtin_bit_cast(float, a) + __builtin_bit_cast(float, b); }
__device__ __forceinline__ float max_xor32(float v) { unsigned a, b; swap32(__builtin_bit_cast(unsigned, v), a, b); return fmaxf(__builtin_bit_cast(float, a), __builtin_bit_cast(float, b)); }
__device__ __forceinline__ float get_xor32(float v, int hi) { unsigned a, b; swap32(__builtin_bit_cast(unsigned, v), a, b); return __builtin_bit_cast(float, hi ? a : b); }
__device__ __forceinline__ int get_xor32i(int v, int hi) { unsigned a, b; swap32((unsigned)v, a, b); return (int)(hi ? a : b); }
template <int CTRL> __device__ __forceinline__ float dpp_mov(float v) { return __builtin_bit_cast(float, __builtin_amdgcn_update_dpp(0, __builtin_bit_cast(int, v), CTRL, 0xf, 0xf, false)); }
__device__ __forceinline__ float row_sum(float v) { v += dpp_mov<0xB1>(v); v += dpp_mov<0x4E>(v); v += dpp_mov<0x141>(v); v += dpp_mov<0x140>(v); return v; }
__device__ __forceinline__ float half_sum(float v) { v = row_sum(v); v += swz_xor<16>(v); return v; }
__device__ __forceinline__ float wave_sum(float v) { return sum_xor32(half_sum(v)); }
#define LDS_WAIT() asm volatile("s_waitcnt lgkmcnt(0)" ::: "memory")
#define LAUNDER_V(x) asm volatile("" : "+v"(x))
#define LAUNDER_S(x) asm volatile("" : "+s"(x))

namespace pg8 {
constexpr int BM = 256, BK = 64, HALF = 128, HTB = HALF * BK * 2, STAGE_BYTES = 8 * HTB, NXCD = 8, WGM = 8;
__host__ __device__ __forceinline__ int lds_byte(int r, int c) { const int st = (r >> 4) * 2 + (c >> 5), rr = r & 15, cc = c & 31, ob = rr * 64 + cc * 2; return st * 1024 + (ob ^ (((ob >> 9) & 1) << 5)); }
__host__ __device__ __forceinline__ void stage_rc(int b, int& R, int& C) { const int st = b / 1024, sb = b % 1024, swz = sb ^ (((sb >> 9) & 1) << 5); R = (st >> 1) * 16 + swz / 64; C = (st & 1) * 32 + (swz % 64) / 2; }
__host__ __device__ __forceinline__ int perm32(int rho) { const int n = rho >> 4, i = rho & 15; return 8 * (i >> 2) + 4 * n + (i & 3); }

struct Unit { int pm, pn, meta;
    __device__ __forceinline__ int bk() const { return meta & 31; } __device__ __forceinline__ int tib() const { return (meta >> 5) & 255; } __device__ __forceinline__ int nb() const { return meta >> 13; } };
struct Gemm { const char* A; const char* B; int lda, ldb, K; long tstepA, tstepB, hstepB; };

struct StaticOrder {
    int nM, nN, nwg, G, c;
    __host__ __device__ void init(int nM_, int nN_, int G_, int c_) { nM = nM_; nN = nN_; nwg = nM * nN; G = G_; c = c_; }
    __host__ __device__ bool next(int i, Unit& u) const {
        const long L = (long)i * G + c; if (L >= nwg) return false;
        int wgid = (int)L; { const int q = nwg / NXCD, r = nwg % NXCD, xcd = wgid % NXCD, off = wgid / NXCD; wgid = (xcd < r ? xcd * (q + 1) : r * (q + 1) + (xcd - r) * q) + off; }
        const int nig = WGM * nN, gid = wgid / nig, fm = gid * WGM, gsz = (nM - fm) < WGM ? (nM - fm) : WGM;
        u.pm = fm + ((wgid % nig) % gsz); u.pn = (wgid % nig) / gsz; return true;
    }
};

__device__ __forceinline__ unsigned cvt_pk_bf16(float lo, float hi) { unsigned r; asm volatile("v_cvt_pk_bf16_f32 %0, %1, %2" : "=v"(r) : "v"(lo), "v"(hi)); return r; }

struct EpiQKV {
    static constexpr bool PERM = true;
    bf16_t* O; size_t split_stride; float scale0;
    __device__ __forceinline__ void operator()(const f32x4 (&acc)[2][2][4][2], const Unit& u, int wr, int wc, int fr, int fq) const {
        asm volatile("" : "+v"(fr), "+v"(fq));
        const int row0 = u.pm * BM + wr * 64 + fr; int colt = u.pn * BM;
        const int t = colt / DM; bf16_t* base = O + (size_t)t * split_stride; colt -= t * DM; const float sc = (t == 0) ? scale0 : 1.f;
        const int col0 = colt + wc * 32 + 8 * fq;
#pragma unroll
        for (int ai = 0; ai < 2; ++ai)
#pragma unroll
            for (int m = 0; m < 4; ++m) { bf16_t* rowp = base + (size_t)(row0 + ai * HALF + m * 16) * DM + col0;
#pragma unroll
                for (int bj = 0; bj < 2; ++bj) { f32x4 v0 = acc[ai][bj][m][0] * sc, v1 = acc[ai][bj][m][1] * sc;
                    u32x4 w; w.x = cvt_pk_bf16(v0[0], v0[1]); w.y = cvt_pk_bf16(v0[2], v0[3]); w.z = cvt_pk_bf16(v1[0], v1[1]); w.w = cvt_pk_bf16(v1[2], v1[3]);
                    *(u32x4*)(rowp + bj * HALF) = w; } }
        if (u.pn == 4) {
            float* kmean = (float*)((unsigned char*)O - WS_Q + WS_KMEAN) + ((size_t)((u.pm >> 5) * 4) * 32 + (u.pm & 31)) * HD;
#pragma unroll
            for (int bj = 0; bj < 2; ++bj)
#pragma unroll
                for (int n = 0; n < 2; ++n)
#pragma unroll
                    for (int j = 0; j < 4; ++j) { float cs = 0.f;
#pragma unroll
                        for (int ai = 0; ai < 2; ++ai)
#pragma unroll
                            for (int m = 0; m < 4; ++m) cs += acc[ai][bj][m][n][j];
                        cs = row_sum(cs);
                        const int col = bj * HALF + wc * 32 + 8 * fq + 4 * n + j;
                        if (fr == 0) __hip_atomic_fetch_add(kmean + (size_t)(col >> 6) * 32 * HD + (col & 63), cs, __ATOMIC_RELAXED, __HIP_MEMORY_SCOPE_AGENT); }
        }
    }
};
struct EpiResAdd {
    static constexpr bool PERM = false;
    const float* base; float* out;
    __device__ __forceinline__ void operator()(const f32x4 (&acc)[2][2][4][2], const Unit& u, int wr, int wc, int fr, int fq) const {
        asm volatile("" : "+v"(fr), "+v"(fq));
        const int col0 = u.pn * BM + wc * 32 + 4 * fq;
#pragma unroll
        for (int ai = 0; ai < 2; ++ai)
#pragma unroll
            for (int m = 0; m < 4; ++m) { const size_t off = (size_t)(u.pm * BM + ai * HALF + wr * 64 + m * 16 + fr) * DM + col0;
#pragma unroll
                for (int bj = 0; bj < 2; ++bj)
#pragma unroll
                    for (int n = 0; n < 2; ++n) { const f32x4 bs = *(const f32x4*)(base + off + bj * HALF + n * 16); *(f32x4*)(out + off + bj * HALF + n * 16) = bs + acc[ai][bj][m][n]; } }
    }
};
struct EpiGateUpDense {
    static constexpr bool PERM = true;
    bf16_t* act; const float* comb;
    __device__ __forceinline__ void operator()(const f32x4 (&acc)[2][2][4][2], const Unit& u, int wr, int wc, int fr, int fq) const {
        asm volatile("" : "+v"(fr), "+v"(fq));
        const int e = u.pn >> 1, c0 = (u.pn & 1) * HALF;
        const int col0 = e * DEXP + c0 + wc * 32 + 8 * fq;
#pragma unroll
        for (int ai = 0; ai < 2; ++ai)
#pragma unroll
            for (int m = 0; m < 4; ++m) { const int row = u.pm * BM + ai * HALF + wr * 64 + m * 16 + fr;
                const float cw = comb[(size_t)row * NEXP + e];
                float o[8];
#pragma unroll
                for (int n = 0; n < 2; ++n)
#pragma unroll
                    for (int j = 0; j < 4; ++j) { const float g = acc[ai][0][m][n][j], up = acc[ai][1][m][n][j];
                        const float sg = g * __builtin_amdgcn_rcpf(1.f + __builtin_amdgcn_exp2f(-g * LOG2E));
                        o[n * 4 + j] = sg * up * cw; }
                u32x4 w; w.x = cvt_pk_bf16(o[0], o[1]); w.y = cvt_pk_bf16(o[2], o[3]); w.z = cvt_pk_bf16(o[4], o[5]); w.w = cvt_pk_bf16(o[6], o[7]);
                *(u32x4*)(act + (size_t)row * NACT + col0) = w; }
    }
};

template <class Epi, class Sched>
__device__ __forceinline__ void gemm_phase(LAS unsigned char* lds, const Gemm g, const Sched& S, const Epi& E, int wave_id) {
    int lane_l = (int)__builtin_amdgcn_mbcnt_hi(~0u, __builtin_amdgcn_mbcnt_lo(~0u, 0u)); asm volatile("" : "+v"(lane_l));
    const int wid = wave_id, lane = lane_l, tid = wid * 64 + lane, wr = wid >> 2, wc = wid & 3, fr = lane & 15, fq = lane >> 4;
    const int K = g.K, nt = K / BK;
    unsigned voffA[2], voffB[2];
#pragma unroll
    for (int i = 0; i < 2; ++i) { int R, C; stage_rc(tid * 16 + i * 8192, R, C); const int Rb = Epi::PERM ? ((R & ~31) + perm32(R & 31)) : R;
        voffA[i] = (unsigned)(R * g.lda + C) * 2u; voffB[i] = (unsigned)(Rb * g.ldb + C) * 2u; }
    const size_t kstep = (size_t)(BK * 2);
    const size_t hstepA = (size_t)HALF * g.lda * 2;
    const long hstepB = g.hstepB;
    const unsigned ldsw = (unsigned)wid * 1024u;
    const int aoff = lds_byte(wr * 64 + fr, fq * 8), boff = lds_byte(wc * 32 + fr, fq * 8);
#define PG8_SA(b, h) (((b) * 2 + (h)) * HTB)
#define PG8_SB(b, h) ((4 + (b) * 2 + (h)) * HTB)
#define PG8_STAGE(bufoff, gbase, voff) do { _Pragma("unroll") for (int _i = 0; _i < 2; ++_i) \
        __builtin_amdgcn_global_load_lds((const unsigned*)((const char*)(gbase) + (voff)[_i]), (LAS unsigned*)(lds + (bufoff) + ldsw + _i * 8192), 16, 0, 0); } while (0)
#define PG8_LDA(dst, b, h) do { _Pragma("unroll") for (int m = 0; m < 4; ++m) _Pragma("unroll") for (int k = 0; k < 2; ++k) dst[m][k] = *(const LAS bf16x8*)(lds + PG8_SA(b, h) + aoff + m * 2048 + k * 1024); } while (0)
#define PG8_LDB(dst, b, h) do { _Pragma("unroll") for (int n = 0; n < 2; ++n) _Pragma("unroll") for (int k = 0; k < 2; ++k) dst[n][k] = *(const LAS bf16x8*)(lds + PG8_SB(b, h) + boff + n * 2048 + k * 1024); } while (0)
#define PG8_MMA(ai, bj, At, Bt) do { __builtin_amdgcn_s_setprio(1); _Pragma("unroll") for (int m = 0; m < 4; ++m) _Pragma("unroll") for (int n = 0; n < 2; ++n) _Pragma("unroll") for (int k = 0; k < 2; ++k) \
        acc[ai][bj][m][n] = __builtin_amdgcn_mfma_f32_16x16x32_bf16(Bt[n][k], At[m][k], acc[ai][bj][m][n], 0, 0, 0); __builtin_amdgcn_s_setprio(0); } while (0)
#define PG8_WAIT_V(n) asm volatile("s_waitcnt vmcnt(" #n ")" ::: "memory")
#define PG8_WAIT_L(n) asm volatile("s_waitcnt lgkmcnt(" #n ")" ::: "memory")
#define PG8_BAR __builtin_amdgcn_s_barrier()
#define PG8_SCHED __builtin_amdgcn_sched_barrier(0)
    Unit cur, nxt; int ui = 0;
    if (!S.next(0, cur)) return;
    f32x4 acc[2][2][4][2];
#pragma unroll
    for (int a = 0; a < 2; ++a)
#pragma unroll
        for (int b = 0; b < 2; ++b)
#pragma unroll
            for (int m = 0; m < 4; ++m)
#pragma unroll
                for (int n = 0; n < 2; ++n) acc[a][b][m][n] = (f32x4){0.f, 0.f, 0.f, 0.f};
    bf16x8 At[4][2], B0[2][2], B1[2][2];
    const char* cA = g.A + (size_t)cur.pm * g.tstepA; const char* cB = g.B + (size_t)cur.pn * g.tstepB;
    PG8_STAGE(PG8_SB(0, 0), cB, voffB); PG8_STAGE(PG8_SB(0, 1), cB + hstepB, voffB); PG8_STAGE(PG8_SA(0, 0), cA, voffA); PG8_STAGE(PG8_SA(0, 1), cA + hstepA, voffA);
    if (wr == 1) PG8_BAR;
    PG8_WAIT_V(2); PG8_BAR;
    PG8_STAGE(PG8_SB(1, 0), cB + kstep, voffB); PG8_STAGE(PG8_SA(1, 0), cA + kstep, voffA); PG8_STAGE(PG8_SB(1, 1), cB + hstepB + kstep, voffB);
    PG8_WAIT_V(6); PG8_BAR;
    for (;;) {
        const bool has_next = S.next(ui + 1, nxt);
        const char* nA = has_next ? g.A + (size_t)nxt.pm * g.tstepA : cA; const char* nB = has_next ? g.B + (size_t)nxt.pn * g.tstepB : cB;
        for (int t = 0; t < nt; t += 2) {
            const bool last = (t == nt - 2);
            const char* a1 = cA + (size_t)(t + 1) * kstep;
            const char* a2 = last ? nA : cA + (size_t)(t + 2) * kstep; const char* b2 = last ? nB : cB + (size_t)(t + 2) * kstep;
            const char* a3 = a2 + kstep; const char* b3 = b2 + kstep;
            PG8_LDB(B0, 0, 0); PG8_LDB(B1, 0, 1); PG8_SCHED; PG8_LDA(At, 0, 0); PG8_STAGE(PG8_SA(1, 1), a1 + hstepA, voffA);
            PG8_WAIT_V(8); PG8_WAIT_L(0); PG8_BAR; PG8_MMA(0, 0, At, B0); PG8_MMA(0, 1, At, B1); PG8_BAR; PG8_SCHED;
            PG8_LDA(At, 0, 1); PG8_STAGE(PG8_SB(0, 0), b2, voffB); PG8_STAGE(PG8_SB(0, 1), b2 + hstepB, voffB); PG8_STAGE(PG8_SA(0, 0), a2, voffA);
            PG8_WAIT_V(8); PG8_WAIT_L(0); PG8_BAR; PG8_MMA(1, 0, At, B0); PG8_MMA(1, 1, At, B1); PG8_BAR; PG8_SCHED;
            PG8_LDB(B0, 1, 0); PG8_LDB(B1, 1, 1); PG8_SCHED; PG8_LDA(At, 1, 0); PG8_STAGE(PG8_SA(0, 1), a2 + hstepA, voffA);
            PG8_WAIT_V(8); PG8_WAIT_L(0); PG8_BAR; PG8_MMA(0, 0, At, B0); PG8_MMA(0, 1, At, B1); PG8_BAR; PG8_SCHED;
            PG8_LDA(At, 1, 1); PG8_STAGE(PG8_SB(1, 0), b3, voffB); PG8_STAGE(PG8_SB(1, 1), b3 + hstepB, voffB); PG8_STAGE(PG8_SA(1, 0), a3, voffA);
            PG8_WAIT_V(8); PG8_WAIT_L(0); PG8_BAR; PG8_MMA(1, 0, At, B0); PG8_MMA(1, 1, At, B1); PG8_BAR; PG8_SCHED;
        }
        if (wr == 0) PG8_BAR;
        E(acc, cur, wr, wc, fr, fq);
        if (!has_next) break;
#pragma unroll
        for (int a = 0; a < 2; ++a)
#pragma unroll
            for (int b = 0; b < 2; ++b)
#pragma unroll
                for (int m = 0; m < 4; ++m)
#pragma unroll
                    for (int n = 0; n < 2; ++n) acc[a][b][m][n] = (f32x4){0.f, 0.f, 0.f, 0.f};
        cur = nxt; cA = nA; cB = nB; ++ui;
        if (wr == 1) PG8_BAR;
    }
    PG8_WAIT_V(0);
    PG8_BAR;
#undef PG8_SA
#undef PG8_SB
#undef PG8_STAGE
#undef PG8_LDA
#undef PG8_LDB
#undef PG8_MMA
#undef PG8_WAIT_V
#undef PG8_WAIT_L
#undef PG8_BAR
#undef PG8_SCHED
}
template <class Epi, class Prob>
__device__ __forceinline__ void gemm_phase_x(LAS unsigned char* lds, const Prob& P, const Epi& E, int wave_id) {
    int lane_l = (int)__builtin_amdgcn_mbcnt_hi(~0u, __builtin_amdgcn_mbcnt_lo(~0u, 0u)); asm volatile("" : "+v"(lane_l));
    const int wid = wave_id, lane = lane_l, tid = wid * 64 + lane, wr = wid >> 2, wc = wid & 3, fr = lane & 15, fq = lane >> 4;
    const int K = P.K, nt = K / BK;
    unsigned voffB[2];
#pragma unroll
    for (int i = 0; i < 2; ++i) { int R, C; stage_rc(tid * 16 + i * 8192, R, C); const int Rb = Epi::PERM ? ((R & ~31) + perm32(R & 31)) : R; voffB[i] = (unsigned)(Rb * P.ldb + C) * 2u; }
    const size_t kstep = (size_t)(BK * 2);
    const long hstepB = P.hstepB;
    const unsigned ldsw = (unsigned)wid * 1024u;
    const int aoff = lds_byte(wr * 64 + fr, fq * 8), boff = lds_byte(wc * 32 + fr, fq * 8);
    LAS u32x4* stash = (LAS u32x4*)(lds + STAGE_BYTES + 1024) + tid;
#define PG8_SA(b, h) (((b) * 2 + (h)) * HTB)
#define PG8_SB(b, h) ((4 + (b) * 2 + (h)) * HTB)
#define PG8_STAGE(bufoff, gbase, voff) do { _Pragma("unroll") for (int _i = 0; _i < 2; ++_i) \
        __builtin_amdgcn_global_load_lds((const unsigned*)((const char*)(gbase) + (voff)[_i]), (LAS unsigned*)(lds + (bufoff) + ldsw + _i * 8192), 16, 0, 0); } while (0)
#define PG8_LDA(dst, b, h) do { _Pragma("unroll") for (int m = 0; m < 4; ++m) _Pragma("unroll") for (int k = 0; k < 2; ++k) dst[m][k] = *(const LAS bf16x8*)(lds + PG8_SA(b, h) + aoff + m * 2048 + k * 1024); } while (0)
#define PG8_LDB(dst, b, h) do { _Pragma("unroll") for (int n = 0; n < 2; ++n) _Pragma("unroll") for (int k = 0; k < 2; ++k) dst[n][k] = *(const LAS bf16x8*)(lds + PG8_SB(b, h) + boff + n * 2048 + k * 1024); } while (0)
#define PG8_MMA(ai, bj, At, Bt) do { __builtin_amdgcn_s_setprio(1); _Pragma("unroll") for (int m = 0; m < 4; ++m) _Pragma("unroll") for (int n = 0; n < 2; ++n) _Pragma("unroll") for (int k = 0; k < 2; ++k) \
        acc[ai][bj][m][n] = __builtin_amdgcn_mfma_f32_16x16x32_bf16(Bt[n][k], At[m][k], acc[ai][bj][m][n], 0, 0, 0); __builtin_amdgcn_s_setprio(0); } while (0)
#define PG8_WAIT_V(n) asm volatile("s_waitcnt vmcnt(" #n ")" ::: "memory")
#define PG8_WAIT_L(n) asm volatile("s_waitcnt lgkmcnt(" #n ")" ::: "memory")
#define PG8_BAR __builtin_amdgcn_s_barrier()
#define PG8_SCHED __builtin_amdgcn_sched_barrier(0)
#define PG8_AVOFF(dst, u) do { int t2_ = tid; asm volatile("" : "+v"(t2_)); _Pragma("unroll") for (int i_ = 0; i_ < 2; ++i_) { int R_, C_; stage_rc(t2_ * 16 + i_ * 8192, R_, C_); _Pragma("unroll") for (int h_ = 0; h_ < 2; ++h_) \
        dst[h_][i_] = (Prob::GATHER ? P.arow_off(u, h_, R_) : (unsigned)((h_ * HALF + R_) * P.lda) * 2u) + (unsigned)C_ * 2u; } } while (0)
    Unit cur, nxt; int ui = 0;
    if (!P.next(0, cur)) return;
    unsigned vA[2][2];
    PG8_AVOFF(vA, cur);
    f32x4 acc[2][2][4][2];
#pragma unroll
    for (int a = 0; a < 2; ++a)
#pragma unroll
        for (int b = 0; b < 2; ++b)
#pragma unroll
            for (int m = 0; m < 4; ++m)
#pragma unroll
                for (int n = 0; n < 2; ++n) acc[a][b][m][n] = (f32x4){0.f, 0.f, 0.f, 0.f};
    bf16x8 At[4][2], B0[2][2], B1[2][2];
    const char* cA = P.a_base(cur); const char* cB = P.b_base(cur);
    long csplit = Prob::KSPLIT ? P.bsplit(cur) : 0;
    if (Prob::WAITS) P.a_ready(cur, wid);
    PG8_STAGE(PG8_SB(0, 0), cB, voffB); PG8_STAGE(PG8_SB(0, 1), cB + hstepB, voffB); PG8_STAGE(PG8_SA(0, 0), cA, vA[0]); PG8_STAGE(PG8_SA(0, 1), cA, vA[1]);
    if (wr == 1) PG8_BAR;
    PG8_WAIT_V(2); PG8_BAR;
    PG8_STAGE(PG8_SB(1, 0), cB + kstep, voffB); PG8_STAGE(PG8_SA(1, 0), cA + kstep, vA[0]); PG8_STAGE(PG8_SB(1, 1), cB + hstepB + kstep, voffB);
    PG8_WAIT_V(6); PG8_BAR;
    for (;;) {
        const bool has_next = P.next(ui + 1, nxt);
        const char* nA = has_next ? P.a_base(nxt) : cA; const char* nB = has_next ? P.b_base(nxt) : cB;
        if (Prob::GATHER) { unsigned vN[2][2];
            if (has_next) { PG8_AVOFF(vN, nxt); } else { vN[0][0] = vA[0][0]; vN[0][1] = vA[0][1]; vN[1][0] = vA[1][0]; vN[1][1] = vA[1][1]; }
            *stash = (u32x4){vN[0][0], vN[0][1], vN[1][0], vN[1][1]}; }
        for (int t = 0; t < nt; t += 2) {
            const bool last = (t == nt - 2);
            if (Prob::WAITS && last && has_next) P.a_ready(nxt, wid);
            const char* a1 = cA + (size_t)(t + 1) * kstep;
            const char* a2 = last ? nA : cA + (size_t)(t + 2) * kstep;
            const char* b2 = last ? nB : cB + (size_t)(t + 2) * kstep + ((Prob::KSPLIT && (t + 2) >= (nt >> 1)) ? csplit : 0);
            const char* a3 = a2 + kstep; const char* b3 = b2 + kstep;
            PG8_LDB(B0, 0, 0); PG8_LDB(B1, 0, 1); PG8_SCHED; PG8_LDA(At, 0, 0); PG8_STAGE(PG8_SA(1, 1), a1, vA[1]);
            if (Prob::GATHER && last) { const u32x4 sv = *stash; vA[0][0] = sv.x; vA[0][1] = sv.y; vA[1][0] = sv.z; vA[1][1] = sv.w; }
            PG8_WAIT_V(8); PG8_WAIT_L(0); PG8_BAR; PG8_MMA(0, 0, At, B0); PG8_MMA(0, 1, At, B1); PG8_BAR; PG8_SCHED;
            PG8_LDA(At, 0, 1); PG8_STAGE(PG8_SB(0, 0), b2, voffB); PG8_STAGE(PG8_SB(0, 1), b2 + hstepB, voffB); PG8_STAGE(PG8_SA(0, 0), a2, vA[0]);
            PG8_WAIT_V(8); PG8_WAIT_L(0); PG8_BAR; PG8_MMA(1, 0, At, B0); PG8_MMA(1, 1, At, B1); PG8_BAR; PG8_SCHED;
            PG8_LDB(B0, 1, 0); PG8_LDB(B1, 1, 1); PG8_SCHED; PG8_LDA(At, 1, 0); PG8_STAGE(PG8_SA(0, 1), a2, vA[1]);
            PG8_WAIT_V(8); PG8_WAIT_L(0); PG8_BAR; PG8_MMA(0, 0, At, B0); PG8_MMA(0, 1, At, B1); PG8_BAR; PG8_SCHED;
            PG8_LDA(At, 1, 1); PG8_STAGE(PG8_SB(1, 0), b3, voffB); PG8_STAGE(PG8_SB(1, 1), b3 + hstepB, voffB); PG8_STAGE(PG8_SA(1, 0), a3, vA[0]);
            PG8_WAIT_V(8); PG8_WAIT_L(0); PG8_BAR; PG8_MMA(1, 0, At, B0); PG8_MMA(1, 1, At, B1); PG8_BAR; PG8_SCHED;
        }
        if (wr == 0) PG8_BAR;
        E(acc, cur, wr, wc, fr, fq);
        if (!has_next) break;
#pragma unroll
        for (int a = 0; a < 2; ++a)
#pragma unroll
            for (int b = 0; b < 2; ++b)
#pragma unroll
                for (int m = 0; m < 4; ++m)
#pragma unroll
                    for (int n = 0; n < 2; ++n) acc[a][b][m][n] = (f32x4){0.f, 0.f, 0.f, 0.f};
        cur = nxt; cA = nA; cB = nB; ++ui;
        if (Prob::KSPLIT) csplit = P.bsplit(cur);
        if (wr == 1) PG8_BAR;
    }
    PG8_WAIT_V(0);
    PG8_BAR;
#undef PG8_SA
#undef PG8_SB
#undef PG8_STAGE
#undef PG8_LDA
#undef PG8_LDB
#undef PG8_MMA
#undef PG8_WAIT_V
#undef PG8_WAIT_L
#undef PG8_BAR
#undef PG8_SCHED
#undef PG8_AVOFF
}

__device__ __forceinline__ int pair_a(int pi) { return pi < 3 ? 0 : (pi < 5 ? 1 : 2); }
__device__ __forceinline__ int pair_b(int pi) { return pi == 0 ? 1 : ((pi == 1 || pi == 3) ? 2 : 3); }
template <int MODE>
struct MoeProb {
    static constexpr bool GATHER = (MODE == 0), KSPLIT = (MODE == 1);
    const unsigned* cnt; const unsigned* list; const char* A; const char* B; int lda, ldb, K; long hstepB; int G, c; unsigned* tcnt;
    static constexpr bool WAITS = (MODE == 1);
    __device__ __forceinline__ void a_ready(const Unit& u, int wave) const {
        if (MODE == 1) {
            if (wave == 0) { unsigned polls = 0;
                while ((unsigned)__builtin_amdgcn_readfirstlane(__hip_atomic_load(tcnt + 64 * u.pm, __ATOMIC_RELAXED, __HIP_MEMORY_SCOPE_AGENT)) < 32u) {
                    if (++polls > (1u << 20)) break;
                    __builtin_amdgcn_s_sleep(2); }
                __builtin_amdgcn_fence(__ATOMIC_ACQUIRE, "agent");
                asm volatile("s_waitcnt vmcnt(0)" ::: "memory"); }
            asm volatile("" ::: "memory"); __builtin_amdgcn_s_barrier(); asm volatile("" ::: "memory");
        }
    }
    __device__ __forceinline__ bool next(int i, Unit& u) const {
        const long L = (long)i * G + c; const int tileidx = (int)(L >> 2);
        int accu = 0, bk = -1, tib = 0, nb = 0;
        for (int k = 0; k < 24; ++k) { const int n = (int)cnt[k]; const int tl = (n + 255) >> 8; if (bk < 0 && tileidx < accu + tl) { bk = k; tib = tileidx - accu; nb = n; } accu += tl; }
        if (bk < 0) return false;
        u.pm = tileidx; u.pn = (int)(L & 3); u.meta = bk | (tib << 5) | (nb << 13); return true;
    }
    __device__ __forceinline__ int expert(const Unit& u, int s) const { const int g = u.bk() / 6, pi = u.bk() % 6; return g * 4 + (s ? pair_b(pi) : pair_a(pi)); }
    __device__ __forceinline__ const char* a_base(const Unit& u) const { return MODE == 0 ? A : A + (size_t)u.pm * 256 * lda * 2; }
    __device__ __forceinline__ const char* b_base(const Unit& u) const {
        if (MODE == 0) return B + ((size_t)expert(u, u.pn >> 1) * DEXP + (size_t)(u.pn & 1) * HALF) * ldb * 2;
        return B + (size_t)u.pn * 256 * ldb * 2 + (size_t)expert(u, 0) * DEXP * 2;
    }
    __device__ __forceinline__ unsigned arow_off(const Unit& u, int h, int R) const { const int pos = u.tib() * 256 + h * HALF + R; const unsigned tok = pos < u.nb() ? list[(size_t)u.bk() * T + pos] : 0u; return tok * (unsigned)(lda * 2); }
    __device__ __forceinline__ long bsplit(const Unit& u) const { return ((long)(expert(u, 1) - expert(u, 0)) * DEXP - DEXP) * 2; }
};
struct EpiGateUpSparse {
    static constexpr bool PERM = true;
    bf16_t* act; const float* wlist; unsigned* tcnt;
    __device__ __forceinline__ void operator()(const f32x4 (&acc)[2][2][4][2], const Unit& u, int wr, int wc, int fr, int fq) const {
        asm volatile("" : "+v"(fr), "+v"(fq));
        const int s = u.pn >> 1, col0 = s * DEXP + (u.pn & 1) * HALF + wc * 32 + 8 * fq;
        const __amdgpu_buffer_rsrc_t rs_act = __builtin_amdgcn_make_buffer_rsrc((void*)act, (short)0, 0x7fffffff, 0x00020000);
#pragma unroll
        for (int ai = 0; ai < 2; ++ai)
#pragma unroll
            for (int m = 0; m < 4; ++m) { const int r = ai * HALF + wr * 64 + m * 16 + fr, pos = u.tib() * 256 + r;
                const float cw = pos < u.nb() ? wlist[((size_t)u.bk() * T + pos) * 2 + s] : 0.f;
                float o[8];
#pragma unroll
                for (int n = 0; n < 2; ++n)
#pragma unroll
                    for (int j = 0; j < 4; ++j) { const float g = acc[ai][0][m][n][j], up = acc[ai][1][m][n][j];
                        const float sg = g * __builtin_amdgcn_rcpf(1.f + __builtin_amdgcn_exp2f(-g * LOG2E));
                        o[n * 4 + j] = sg * up * cw; }
                u32x4 w; w.x = cvt_pk_bf16(o[0], o[1]); w.y = cvt_pk_bf16(o[2], o[3]); w.z = cvt_pk_bf16(o[4], o[5]); w.w = cvt_pk_bf16(o[6], o[7]);
                __builtin_amdgcn_raw_buffer_store_b128(w, rs_act, (int)((((unsigned)u.pm * 256u + (unsigned)r) * 512u + (unsigned)col0) * 2u), 0, 16);
                if (m & 1) asm volatile("" ::: "memory"); }
        asm volatile("s_waitcnt vmcnt(0)" ::: "memory");
        if ((fr | fq) == 0) __hip_atomic_fetch_add(tcnt + 64 * u.pm, 1u, __ATOMIC_RELAXED, __HIP_MEMORY_SCOPE_AGENT);
    }
};
struct EpiDownScatter {
    static constexpr bool PERM = false;
    float* x; const unsigned* list;
    __device__ __forceinline__ void operator()(const f32x4 (&acc)[2][2][4][2], const Unit& u, int wr, int wc, int fr, int fq) const {
        asm volatile("" : "+v"(fr), "+v"(fq));
        const int col0 = u.pn * BM + wc * 32 + 4 * fq;
        unsigned tok[8];
#pragma unroll
        for (int g = 0; g < 8; ++g) { const int pos = u.tib() * 256 + (g >> 2) * HALF + wr * 64 + (g & 3) * 16 + fr; tok[g] = pos < u.nb() ? list[(size_t)u.bk() * T + pos] : 0xffffffffu; }
#pragma unroll
        for (int g = 0; g < 8; ++g) { const int ai = g >> 2, m = g & 3;
            if (tok[g] != 0xffffffffu) { const size_t off = (size_t)tok[g] * DM + col0;
#pragma unroll
                for (int bj = 0; bj < 2; ++bj)
#pragma unroll
                    for (int n = 0; n < 2; ++n) { f32x4* p = (f32x4*)(x + off + bj * HALF + n * 16); *p = *p + acc[ai][bj][m][n]; } }
            if (g & 1) asm volatile("" ::: "memory"); }
    }
};
}

#define XB_TMO      128
#define XB_XCNT(j)  (256  + 64 * (j))
#define XB_XSUB(j)  (1280 + 64 * (j))
#define XB_XGEN(j)  (2304 + 64 * (j))
#define XB_TOP      3328
#define XB_TOPGEN   3392
#define XCD_BAR_WORDS 3456
#define XB_SPIN_CAP (1u << 18)
__device__ __forceinline__ unsigned xb_ld(unsigned* p)              { return __hip_atomic_load(p, __ATOMIC_RELAXED, __HIP_MEMORY_SCOPE_AGENT); }
__device__ __forceinline__ unsigned xb_add(unsigned* p, unsigned v) { return __hip_atomic_fetch_add(p, v, __ATOMIC_RELAXED, __HIP_MEMORY_SCOPE_AGENT); }
__device__ __forceinline__ unsigned xb_xcc_id() { return (unsigned)__builtin_amdgcn_s_getreg((3 << 11) | 20) & 0xFu; }
#define XB_SPIN(cond, bar) do { unsigned _sp = 0; while (cond) { __builtin_amdgcn_s_sleep(1); \
    if ((++_sp & 255u) == 0u) { if (xb_ld(&(bar)[XB_TMO])) break; if (_sp > XB_SPIN_CAP) { atomicAdd(&(bar)[XB_TMO], 1u); break; } } } } while (0)
struct XcdBarrier { unsigned* bar; unsigned x; volatile LAS unsigned* st; int wave; };
__device__ __forceinline__ bool xb_thread0(int wave) { return wave == 0 && __builtin_amdgcn_mbcnt_hi(~0u, __builtin_amdgcn_mbcnt_lo(~0u, 0u)) == 0u; }
__device__ __forceinline__ XcdBarrier xcd_barrier_post(unsigned* bar, volatile LAS unsigned* st, int wave) {
    XcdBarrier b; b.bar = bar; b.x = xb_xcc_id(); b.st = st; b.wave = wave;
    if (xb_thread0(wave)) (void)xb_add(&bar[XB_XCNT(b.x)], 1u);
    return b;
}
__device__ __forceinline__ void xcd_barrier_complete(unsigned* bar, unsigned x, unsigned& nloc, unsigned& nx) {
    const unsigned G = gridDim.x * gridDim.y * gridDim.z;
    unsigned sum, cnt, mine, sp = 0u;
    for (;;) {
        sum = 0u; cnt = 0u; mine = 0u;
#pragma unroll
        for (unsigned j = 0; j < 16; ++j) { const unsigned c = xb_ld(&bar[XB_XCNT(j)]); sum += c; cnt += (c > 0u) ? 1u : 0u; mine = (j == x) ? c : mine; }
        if (sum == G) break;
        __builtin_amdgcn_s_sleep(1);
        if ((++sp & 255u) == 0u) { if (xb_ld(&bar[XB_TMO])) break; if (sp > XB_SPIN_CAP) { atomicAdd(&bar[XB_TMO], 1u); break; } }
    }
    nloc = mine > 0u ? mine : 1u; nx = cnt > 0u ? cnt : 1u;
}
__device__ __forceinline__ void xcd_barrier(const XcdBarrier& b) {
    asm volatile("s_waitcnt vmcnt(0)" ::: "memory");
    __syncthreads();
    if (xb_thread0(b.wave)) {
        unsigned* bar = b.bar;
        __builtin_amdgcn_s_waitcnt(0);
        unsigned nloc = b.st[0], nx = b.st[1];
        if (nloc == 0u) { xcd_barrier_complete(bar, b.x, nloc, nx); b.st[0] = nloc; b.st[1] = nx; }
        const unsigned old = xb_add(&bar[XB_XSUB(b.x)], 1u);
        const unsigned gen = old / nloc;
        if (old + 1u == (gen + 1u) * nloc) {
            __builtin_amdgcn_fence(__ATOMIC_RELEASE, "agent");
            asm volatile("s_waitcnt vmcnt(0)" ::: "memory");
            const unsigned og = xb_add(&bar[XB_TOP], 1u);
            const unsigned tg = og / nx;
            if (og + 1u == (tg + 1u) * nx) xb_add(&bar[XB_TOPGEN], 1u);
            else XB_SPIN(xb_ld(&bar[XB_TOPGEN]) == tg, bar);
            __builtin_amdgcn_fence(__ATOMIC_ACQUIRE, "agent");
            xb_add(&bar[XB_XGEN(b.x)], 1u);
            asm volatile("s_waitcnt vmcnt(0)" ::: "memory");
        } else {
            XB_SPIN(xb_ld(&bar[XB_XGEN(b.x)]) == gen, bar);
            __builtin_amdgcn_fence(__ATOMIC_ACQUIRE, "agent");
            asm volatile("s_waitcnt vmcnt(0)" ::: "memory");
        }
    }
    __syncthreads();
}

struct Args {
    const float* x; const float* ln1_g; const float* w_in; const float* mix_g; const float* w_out; const float* ln2_g;
    const float* w_gr; const float* b_gr; const float* w_er; const float* b_er; const float* w_gate; const float* w_up; const float* w_down; const float* fin_g;
    float* out; unsigned char* ws; int ph_lo, ph_hi, li, pad;
};

__device__ __forceinline__ void transpose_item(const float* W, int K, int N, bf16_t* WT, int dpitch, int dcol, LAS float* scr, int item, int lane) {
    const int nblk = N / 32, kb = item / nblk, nb = item % nblk, k0 = 64 * kb, n0 = 32 * nb;
#pragma unroll 8
    for (int i = 0; i < 32; ++i) { const int kk = 2 * i + (lane >> 5); scr[kk * 33 + (lane & 31)] = W[(size_t)(k0 + kk) * N + n0 + (lane & 31)]; }
    LDS_WAIT(); asm volatile("" ::: "memory");
    const int c = lane & 7;
#pragma unroll
    for (int j = 0; j < 4; ++j) { const int n = (lane >> 3) + 8 * j; const LAS float* s = scr + (8 * c) * 33 + n;
        u32x4 o; o.x = pk2(s[0 * 33], s[1 * 33]); o.y = pk2(s[2 * 33], s[3 * 33]); o.z = pk2(s[4 * 33], s[5 * 33]); o.w = pk2(s[6 * 33], s[7 * 33]);
        *(u32x4*)(WT + (size_t)(n0 + n) * dpitch + dcol + k0 + 8 * c) = o; }
    LDS_WAIT(); asm volatile("" ::: "memory");
}
__device__ __forceinline__ void phase_prologue(const Args& a, LAS unsigned char* lds, int gw, int NGW, int wave, int lane) {
    LAS float* scr = (LAS float*)(lds + wave * 16384);
    constexpr int I_IN = (DM / 64) * (NQKV / 32);
    constexpr int I_OUT = (DM / 64) * (DM / 32);
    constexpr int I_G = (DM / 64) * (DEXP / 32);
    constexpr int I_D = (DEXP / 64) * (DM / 32);
    constexpr int N_IN = DEPTH * I_IN, N_OUT = DEPTH * I_OUT, N_G = DEPTH * NEXP * I_G, N_D = DEPTH * NEXP * I_D;
    constexpr int NITEMS = N_IN + N_OUT + 2 * N_G + N_D;
    bf16_t* WinT = (bf16_t*)(a.ws + WS_WIN); bf16_t* WoutT = (bf16_t*)(a.ws + WS_WOUT); bf16_t* WgT = (bf16_t*)(a.ws + WS_WG); bf16_t* WuT = (bf16_t*)(a.ws + WS_WU); bf16_t* WdT = (bf16_t*)(a.ws + WS_WD);
    for (int it = gw; it < NITEMS; it += NGW) {
        int r = it;
        if (r < N_IN) { const int l = r / I_IN; transpose_item(a.w_in + (size_t)l * DM * NQKV, DM, NQKV, WinT + (size_t)l * NQKV * DM, DM, 0, scr, r % I_IN, lane); continue; } r -= N_IN;
        if (r < N_OUT) { const int l = r / I_OUT; transpose_item(a.w_out + (size_t)l * DM * DM, DM, DM, WoutT + (size_t)l * DM * DM, DM, 0, scr, r % I_OUT, lane); continue; } r -= N_OUT;
        if (r < N_G) { const int le = r / I_G; transpose_item(a.w_gate + (size_t)le * DM * DEXP, DM, DEXP, WgT + (size_t)le * DEXP * DM, DM, 0, scr, r % I_G, lane); continue; } r -= N_G;
        if (r < N_G) { const int le = r / I_G; transpose_item(a.w_up + (size_t)le * DM * DEXP, DM, DEXP, WuT + (size_t)le * DEXP * DM, DM, 0, scr, r % I_G, lane); continue; } r -= N_G;
        { const int le = r / I_D, l = le / NEXP, e = le % NEXP; transpose_item(a.w_down + (size_t)le * DEXP * DM, DEXP, DM, WdT + (size_t)l * DM * NACT, NACT, e * DEXP, scr, r % I_D, lane); }
    }
}

__device__ __forceinline__ void phase_norm1(const float* x, const float* g, bf16_t* hb, int gw, int NGW, int lane, float* kmean_zero) {
    for (int i = gw * 64 + lane; i < BATCH * 4 * 32 * HD; i += NGW * 64) kmean_zero[i] = 0.f;
    f32x4 gv[4];
#pragma unroll
    for (int j = 0; j < 4; ++j) gv[j] = *((const f32x4*)g + lane + 64 * j);
    for (int m = gw; m < T; m += NGW) {
        const f32x4* xr = (const f32x4*)(x + (size_t)m * DM) + lane;
        f32x4 v[4]; float s = 0.f;
#pragma unroll
        for (int j = 0; j < 4; ++j) { v[j] = xr[64 * j]; s += (v[j].x * v[j].x + v[j].y * v[j].y) + (v[j].z * v[j].z + v[j].w * v[j].w); }
        const float rstd = 1.0f / sqrtf(wave_sum(s) * (1.f / DM) + NORM_EPS);
        u32x2* o8 = (u32x2*)(hb + (size_t)m * DM) + lane;
#pragma unroll
        for (int j = 0; j < 4; ++j) { u32x2 w; w.x = pk2(v[j].x * rstd * gv[j].x, v[j].y * rstd * gv[j].y); w.y = pk2(v[j].z * rstd * gv[j].z, v[j].w * rstd * gv[j].w); o8[64 * j] = w; }
    }
}
__device__ __forceinline__ void unpack8(float (&f)[8], const u32x4 w) { f[0] = bflo(w.x); f[1] = bfhi(w.x); f[2] = bflo(w.y); f[3] = bfhi(w.y); f[4] = bflo(w.z); f[5] = bfhi(w.z); f[6] = bflo(w.w); f[7] = bfhi(w.w); }
__device__ __forceinline__ void phase_mixnorm(const bf16_t* ob, bf16_t* hb, const float* lse, const bf16_t* pm, const float* lsem0, const float* lsem1, const float* g, int gw, int NGW, int lane) {
    float g0[8], g1[8];
#pragma unroll
    for (int j = 0; j < 8; ++j) { g0[j] = g[8 * lane + j]; g1[j] = g[512 + 8 * lane + j]; }
    const int hh = lane >> 3;
    for (int m = gw; m < T; m += NGW) {
        const u32x4 a = *((const u32x4*)(ob + (size_t)m * DM) + lane), c0 = *((const u32x4*)(ob + (size_t)m * DM + 512) + lane);
        const u32x4 c1 = *((const u32x4*)(hb + (size_t)m * DM) + lane), c2 = *((const u32x4*)(hb + (size_t)m * DM + 512) + lane);
        const float l0 = lse[(size_t)m * 8 + hh], l1 = lse[(size_t)T * 8 + (size_t)m * 8 + hh], l2 = lse[(size_t)2 * T * 8 + (size_t)m * 8 + hh];
        float va[8]; unpack8(va, a);
        if (lane < 32) {
            const u32x4 p0 = *((const u32x4*)(pm + (size_t)m * 256) + lane), p1 = *((const u32x4*)(pm + ((size_t)T + m) * 256) + lane), p2 = *((const u32x4*)(pm + ((size_t)2 * T + m) * 256) + lane);
            const float e0 = lsem0[(size_t)m * 4 + hh], e1 = lsem0[(size_t)T * 4 + (size_t)m * 4 + hh], e2 = lsem1[(size_t)m * 4 + hh], e3 = lsem1[(size_t)T * 4 + (size_t)m * 4 + hh];
            const float mx = fmaxf(fmaxf(e0, e1), fmaxf(e2, e3));
            float u0 = __builtin_amdgcn_exp2f(e0 - mx), u1 = __builtin_amdgcn_exp2f(e1 - mx), u2 = __builtin_amdgcn_exp2f(e2 - mx), u3 = __builtin_amdgcn_exp2f(e3 - mx);
            const float inv = 1.0f / ((u0 + u1) + (u2 + u3)); u0 *= inv; u1 *= inv; u2 *= inv; u3 *= inv;
            float y0[8], y1[8], y2[8]; unpack8(y0, p0); unpack8(y1, p1); unpack8(y2, p2);
#pragma unroll
            for (int j = 0; j < 8; ++j) va[j] = (u0 * y0[j] + u1 * y1[j]) + (u2 * y2[j] + u3 * va[j]);
        }
        const float mx = fmaxf(l0, fmaxf(l1, l2));
        float w0 = __builtin_amdgcn_exp2f(l0 - mx), w1 = __builtin_amdgcn_exp2f(l1 - mx), w2 = __builtin_amdgcn_exp2f(l2 - mx);
        const float inv = 1.0f / (w0 + w1 + w2); w0 *= inv; w1 *= inv; w2 *= inv;
        float x0[8], x1[8], x2[8]; unpack8(x0, c0); unpack8(x1, c1); unpack8(x2, c2);
        float vc[8];
        float sa = 0.f, sc = 0.f;
#pragma unroll
        for (int j = 0; j < 8; ++j) { vc[j] = w0 * x0[j] + w1 * x1[j] + w2 * x2[j]; sa += va[j] * va[j]; sc += vc[j] * vc[j]; }
        sa = half_sum(sa); sc = wave_sum(sc);
        const float ra = 1.0f / sqrtf(sa * (1.f / 256.f) + NORM_EPS), rc = 1.0f / sqrtf(sc * (1.f / 512.f) + NORM_EPS);
        u32x4 oa, oc;
        oa.x = pk2(va[0] * ra * g0[0], va[1] * ra * g0[1]); oa.y = pk2(va[2] * ra * g0[2], va[3] * ra * g0[3]); oa.z = pk2(va[4] * ra * g0[4], va[5] * ra * g0[5]); oa.w = pk2(va[6] * ra * g0[6], va[7] * ra * g0[7]);
        oc.x = pk2(vc[0] * rc * g1[0], vc[1] * rc * g1[1]); oc.y = pk2(vc[2] * rc * g1[2], vc[3] * rc * g1[3]); oc.z = pk2(vc[4] * rc * g1[4], vc[5] * rc * g1[5]); oc.w = pk2(vc[6] * rc * g1[6], vc[7] * rc * g1[7]);
        *((u32x4*)(hb + (size_t)m * DM) + lane) = oa; *((u32x4*)(hb + (size_t)m * DM + 512) + lane) = oc;
    }
}
__device__ __forceinline__ void phase_route(const float* x, const float* g, const float* wgr, const float* bgr, const float* wer, const float* ber,
                                            bf16_t* hb, unsigned* cnt, unsigned* list, float* wlist, LAS unsigned char* lds, int v, int G, int wave, int lane) {
    const int tid = wave * 64 + lane;
    LAS f32x4* wl = (LAS f32x4*)lds;
    for (int idx = tid; idx < 5 * DM; idx += NTHREADS) { const int mtx = idx >> 10, d = idx & 1023; const float* src = (mtx == 0 ? wgr : wer + (size_t)(mtx - 1) * DM * 4) + d * 4;
        wl[mtx * 1024 + (d & 3) * 256 + (d >> 2)] = *(const f32x4*)src; }
    LAS unsigned* cl = (LAS unsigned*)(lds + 81920);
    LAS u32x2* info = (LAS u32x2*)(lds + 81920 + 256);
    LAS f32x2* infw = (LAS f32x2*)(lds + 81920 + 256 + 4096);
    if (tid < 64) cl[tid] = 0u;
    __syncthreads();
    const int rpw = (T + G - 1) / G, row0 = v * rpw;
    f32x4 gv[4];
#pragma unroll
    for (int j = 0; j < 4; ++j) gv[j] = *((const f32x4*)g + lane + 64 * j);
    const f32x4 bg = *(const f32x4*)bgr;
    f32x4 nx[4];
    { const int m0 = row0 + wave; if (wave < rpw && m0 < T) { const f32x4* xr = (const f32x4*)(x + (size_t)m0 * DM) + lane;
#pragma unroll
        for (int j = 0; j < 4; ++j) nx[j] = xr[64 * j]; } }
    for (int r = wave; r < rpw; r += NWAVES) {
        const int m = row0 + r; if (m >= T) break;
        f32x4 vv[4]; float s = 0.f;
#pragma unroll
        for (int j = 0; j < 4; ++j) { vv[j] = nx[j]; s += (vv[j].x * vv[j].x + vv[j].y * vv[j].y) + (vv[j].z * vv[j].z + vv[j].w * vv[j].w); }
        if (r + NWAVES < rpw && m + NWAVES < T) { const f32x4* xr = (const f32x4*)(x + (size_t)(m + NWAVES) * DM) + lane;
#pragma unroll
            for (int j = 0; j < 4; ++j) nx[j] = xr[64 * j]; }
        const float rstd = 1.0f / sqrtf(wave_sum(s) * (1.f / DM) + NORM_EPS);
        u32x2* o8 = (u32x2*)(hb + (size_t)m * DM) + lane;
#pragma unroll
        for (int j = 0; j < 4; ++j) { vv[j] = vv[j] * rstd * gv[j]; u32x2 w; w.x = pk2(vv[j].x, vv[j].y); w.y = pk2(vv[j].z, vv[j].w); o8[64 * j] = w; }
        f32x4 gl = (f32x4){0.f, 0.f, 0.f, 0.f};
#pragma unroll
        for (int j = 0; j < 4; ++j) { LAS f32x4* wp = wl + lane + 64 * j;
            gl += wp[0] * vv[j].x; gl += wp[256] * vv[j].y; gl += wp[512] * vv[j].z; gl += wp[768] * vv[j].w; }
        gl.x = wave_sum(gl.x) + bg.x; gl.y = wave_sum(gl.y) + bg.y; gl.z = wave_sum(gl.z) + bg.z; gl.w = wave_sum(gl.w) + bg.w;
        int gi = 0; float gm = gl.x;
        if (gl.y > gm) { gm = gl.y; gi = 1; } if (gl.z > gm) { gm = gl.z; gi = 2; } if (gl.w > gm) { gm = gl.w; gi = 3; }
        const float gden = __expf(gl.x - gm) + __expf(gl.y - gm) + __expf(gl.z - gm) + __expf(gl.w - gm);
        const float gw_ = 1.0f / gden;
        gi = __builtin_amdgcn_readfirstlane(gi);
        f32x4 el = (f32x4){0.f, 0.f, 0.f, 0.f};
#pragma unroll
        for (int j = 0; j < 4; ++j) { LAS f32x4* wp = wl + (1 + gi) * 1024 + lane + 64 * j;
            el += wp[0] * vv[j].x; el += wp[256] * vv[j].y; el += wp[512] * vv[j].z; el += wp[768] * vv[j].w; }
        const f32x4 be = *(const f32x4*)(ber + gi * 4);
        float e[4] = {wave_sum(el.x) + be.x, wave_sum(el.y) + be.y, wave_sum(el.z) + be.z, wave_sum(el.w) + be.w};
        int i1 = 0; float v1 = e[0];
#pragma unroll
        for (int k = 1; k < 4; ++k) if (e[k] > v1) { v1 = e[k]; i1 = k; }
        int i2 = -1; float v2 = -INFINITY;
#pragma unroll
        for (int k = 0; k < 4; ++k) if (k != i1 && e[k] > v2) { v2 = e[k]; i2 = k; }
        const float p2 = __expf(v2 - v1), inv = 1.0f / (1.0f + p2);
        const float w1 = inv * gw_, w2 = p2 * inv * gw_;
        const int ea = i1 < i2 ? i1 : i2, eb = i1 < i2 ? i2 : i1; const float wa = i1 < i2 ? w1 : w2, wb = i1 < i2 ? w2 : w1;
        const int pi = (ea == 0) ? (eb - 1) : (ea == 1 ? eb + 1 : 5), bk = gi * 6 + pi;
        if (lane == 0) { const unsigned rank = __hip_atomic_fetch_add(cl + bk, 1u, __ATOMIC_RELAXED, __HIP_MEMORY_SCOPE_WORKGROUP);
            info[r] = (u32x2){(unsigned)bk, rank}; infw[r] = (f32x2){wa, wb}; }
    }
    __syncthreads();
    if (tid < 24) cl[32 + tid] = __hip_atomic_fetch_add(cnt + tid, cl[tid], __ATOMIC_RELAXED, __HIP_MEMORY_SCOPE_AGENT);
    __syncthreads();
    if (tid < rpw && row0 + tid < T) { const u32x2 inf = info[tid]; const f32x2 wv = infw[tid]; const size_t slot = (size_t)inf.x * T + cl[32 + inf.x] + inf.y;
        list[slot] = (unsigned)(row0 + tid); *(f32x2*)(wlist + slot * 2) = wv; }
    __syncthreads();
}
__device__ __forceinline__ void phase_final(float* x, const float* g, int gw, int NGW, int lane) {
    f32x4 gv[4];
#pragma unroll
    for (int j = 0; j < 4; ++j) gv[j] = *((const f32x4*)g + lane + 64 * j);
    for (int m = gw; m < T; m += NGW) {
        f32x4* xr = (f32x4*)(x + (size_t)m * DM) + lane;
        f32x4 v[4]; float s = 0.f;
#pragma unroll
        for (int j = 0; j < 4; ++j) { v[j] = xr[64 * j]; s += (v[j].x * v[j].x + v[j].y * v[j].y) + (v[j].z * v[j].z + v[j].w * v[j].w); }
        const float rstd = 1.0f / sqrtf(wave_sum(s) * (1.f / DM) + NORM_EPS);
#pragma unroll
        for (int j = 0; j < 4; ++j) xr[64 * j] = v[j] * rstd * gv[j];
    }
}
__device__ __forceinline__ void phase_kmean(const bf16_t* kb, float* kmean, int gw, int NGW, int lane) {
    for (int it = gw; it < BATCH * 4 * 32; it += NGW) {
        const int b = it >> 7, h = (it >> 5) & 3, blk = it & 31;
        const bf16_t* base = kb + ((size_t)b * SEQ + (size_t)blk * 256) * DM + h * HD + (lane & 7) * 8;
        float acc[8] = {0.f, 0.f, 0.f, 0.f, 0.f, 0.f, 0.f, 0.f};
#pragma unroll 4
        for (int i = 0; i < 32; ++i) { const u32x4 w = *(const u32x4*)(base + (size_t)((lane >> 3) + 8 * i) * DM);
            acc[0] += bflo(w.x); acc[1] += bfhi(w.x); acc[2] += bflo(w.y); acc[3] += bfhi(w.y); acc[4] += bflo(w.z); acc[5] += bfhi(w.z); acc[6] += bflo(w.w); acc[7] += bfhi(w.w); }
#pragma unroll
        for (int j = 0; j < 8; ++j) { acc[j] += swz_xor<8>(acc[j]); acc[j] += swz_xor<16>(acc[j]); acc[j] = sum_xor32(acc[j]); }
        if (lane < 8) {
            float* o = kmean + (size_t)it * HD + lane * 8;
#pragma unroll
            for (int j = 0; j < 8; ++j) o[j] = acc[j] * (1.f / 256.f);
        }
    }
}

__device__ __forceinline__ void ld_row64(float (&r)[64], const bf16_t* p) {
#pragma unroll
    for (int c = 0; c < 8; ++c) { const u32x4 w = *((const u32x4*)p + c);
        r[8 * c + 0] = bflo(w.x); r[8 * c + 1] = bfhi(w.x); r[8 * c + 2] = bflo(w.y); r[8 * c + 3] = bfhi(w.y); r[8 * c + 4] = bflo(w.z); r[8 * c + 5] = bfhi(w.z); r[8 * c + 6] = bflo(w.w); r[8 * c + 7] = bfhi(w.w); }
}
__device__ __forceinline__ float dot_row64(const float (&q)[64], const bf16_t* p) {
    float s0 = 0.f, s1 = 0.f;
#pragma unroll
    for (int c = 0; c < 8; ++c) { const u32x4 w = *((const u32x4*)p + c);
        s0 += q[8 * c + 0] * bflo(w.x); s1 += q[8 * c + 1] * bfhi(w.x); s0 += q[8 * c + 2] * bflo(w.y); s1 += q[8 * c + 3] * bfhi(w.y);
        s0 += q[8 * c + 4] * bflo(w.z); s1 += q[8 * c + 5] * bfhi(w.z); s0 += q[8 * c + 6] * bflo(w.w); s1 += q[8 * c + 7] * bfhi(w.w); }
    return s0 + s1;
}
__device__ __forceinline__ void axpy_row64(float (&o)[64], float p, const bf16_t* vp) {
#pragma unroll
    for (int c = 0; c < 8; ++c) { const u32x4 w = *((const u32x4*)vp + c);
        o[8 * c + 0] += p * bflo(w.x); o[8 * c + 1] += p * bfhi(w.x); o[8 * c + 2] += p * bflo(w.y); o[8 * c + 3] += p * bfhi(w.y);
        o[8 * c + 4] += p * bflo(w.z); o[8 * c + 5] += p * bfhi(w.z); o[8 * c + 6] += p * bflo(w.w); o[8 * c + 7] += p * bfhi(w.w); }
}
__device__ __forceinline__ void st_row64(bf16_t* p, const float (&o)[64], float sc) {
#pragma unroll
    for (int c = 0; c < 8; ++c) { u32x4 w; w.x = pk2(o[8 * c] * sc, o[8 * c + 1] * sc); w.y = pk2(o[8 * c + 2] * sc, o[8 * c + 3] * sc); w.z = pk2(o[8 * c + 4] * sc, o[8 * c + 5] * sc); w.w = pk2(o[8 * c + 6] * sc, o[8 * c + 7] * sc); *((u32x4*)p + c) = w; }
}
#define OSM_STEP(sc, vrow) do { const float sc_ = (sc); if (sc_ > m_) { const float al = __builtin_amdgcn_exp2f(m_ - sc_); l_ *= al; _Pragma("unroll") for (int d_ = 0; d_ < 64; ++d_) o_[d_] *= al; m_ = sc_; } \
    const float p_ = __builtin_amdgcn_exp2f(sc_ - m_); l_ += p_; axpy_row64(o_, p_, (vrow)); } while (0)

__device__ __forceinline__ void naive_moba(const bf16_t* qb, const bf16_t* kb, const bf16_t* vb, const float* kmean, bf16_t* ob, int item, int tid) {
    const int b = item >> 6, h = (item >> 4) & 3, t = (item & 15) * 512 + tid, own = t >> 8;
    const size_t rowq = ((size_t)b * SEQ + t) * DM + h * HD;
    const bf16_t* kh = kb + (size_t)b * SEQ * DM + h * HD; const bf16_t* vh = vb + (size_t)b * SEQ * DM + h * HD;
    const float slope2 = exp2f(-2.0f * (float)(h + 1)) * LOG2E;
    float q_[64]; ld_row64(q_, qb + rowq);
    float bv0 = -INFINITY, bv1 = -INFINITY, bv2 = -INFINITY; int bi0 = -1, bi1 = -1, bi2 = -1;
    const float* km = kmean + (size_t)(b * 4 + h) * 32 * HD;
    for (int n = 0; n < own; ++n) {
        float gsum = 0.f;
#pragma unroll
        for (int d = 0; d < 64; ++d) gsum += q_[d] * km[n * HD + d];
        if (gsum > bv0) { bv2 = bv1; bi2 = bi1; bv1 = bv0; bi1 = bi0; bv0 = gsum; bi0 = n; }
        else if (gsum > bv1) { bv2 = bv1; bi2 = bi1; bv1 = gsum; bi1 = n; }
        else if (gsum > bv2) { bv2 = gsum; bi2 = n; }
    }
    float o_[64];
#pragma unroll
    for (int d = 0; d < 64; ++d) o_[d] = 0.f;
    float m_ = -INFINITY, l_ = 0.f;
    for (int s = 0; s < 3; ++s) {
        const int blk = (s == 0) ? bi0 : (s == 1) ? bi1 : bi2;
        if (blk < 0) continue;
        for (int j = 0; j < 256; ++j) { const int pos = blk * 256 + j;
            const float sc = dot_row64(q_, kh + (size_t)pos * DM) - slope2 * (float)(t - pos);
            OSM_STEP(sc, vh + (size_t)pos * DM); }
    }
    for (int pos = own * 256; pos <= t; ++pos) {
        const float sc = dot_row64(q_, kh + (size_t)pos * DM) - slope2 * (float)(t - pos);
        OSM_STEP(sc, vh + (size_t)pos * DM); }
    st_row64(ob + rowq, o_, 1.0f / l_);
}
__device__ __forceinline__ void naive_sb(const bf16_t* qb, const bf16_t* kb, const bf16_t* vb, bf16_t* ob, int item, int tid) {
    const int b = item >> 6, h = 4 + ((item >> 4) & 3), t = (item & 15) * 512 + tid;
    const size_t rowq = ((size_t)b * SEQ + t) * DM + h * HD;
    const bf16_t* kh = kb + (size_t)b * SEQ * DM + h * HD; const bf16_t* vh = vb + (size_t)b * SEQ * DM + h * HD;
    float q_[64]; ld_row64(q_, qb + rowq);
    float o_[64];
#pragma unroll
    for (int d = 0; d < 64; ++d) o_[d] = 0.f;
    float tail = 0.f;
    for (int s = t - 1; s >= 0 && tail > -150.f; --s) {
        const float z = dot_row64(q_, kh + (size_t)s * DM);
        const float lp = __builtin_amdgcn_logf(1.0f + __builtin_amdgcn_exp2f(-fabsf(z)));
        const float lnot = -(fmaxf(z, 0.f) + lp);
        const float aw = __builtin_amdgcn_exp2f(z + lnot + tail);
        axpy_row64(o_, aw, vh + (size_t)s * DM);
        tail += lnot;
    }
    st_row64(ob + rowq, o_, 1.0f);
}
__device__ __forceinline__ void naive_dil(const bf16_t* qb, const bf16_t* kb, const bf16_t* vb, bf16_t* ob, bf16_t* hb2, float* lse, int item, int tid) {
    const int b = item >> 7, h = 8 + ((item >> 4) & 7), t = (item & 15) * 512 + tid;
    const size_t rowq = ((size_t)b * SEQ + t) * DM + h * HD;
    const bf16_t* kh = kb + (size_t)b * SEQ * DM + h * HD; const bf16_t* vh = vb + (size_t)b * SEQ * DM + h * HD;
    const float slope2 = exp2f(-(float)(h - 8 + 1)) * LOG2E;
    float q_[64]; ld_row64(q_, qb + rowq);
    float o_[64];
#pragma unroll
    for (int d = 0; d < 64; ++d) o_[d] = 0.f;
    float m_ = -INFINITY, l_ = 0.f;
    for (int c = 0; c < 3; ++c) {
        const int dil = (c == 0) ? 1 : (c == 1) ? 4 : 16;
        for (int dl = 0; dl <= 128; ++dl) { const int pos = t - dl * dil; if (pos < 0) break;
            const float sc = dot_row64(q_, kh + (size_t)pos * DM) - slope2 * (float)(dl * dil);
            OSM_STEP(sc, vh + (size_t)pos * DM); }
    }
    st_row64(ob + rowq, o_, 1.0f / l_);
    { const size_t tok = (size_t)b * SEQ + t; const u32x4 z4 = {0u, 0u, 0u, 0u};
#pragma unroll
      for (int c = 0; c < 8; ++c) { *((u32x4*)(hb2 + tok * DM + (h - 8) * HD) + c) = z4; *((u32x4*)(hb2 + tok * DM + 512 + (h - 8) * HD) + c) = z4; }
      lse[tok * 8 + (h - 8)] = 0.f; lse[(size_t)T * 8 + tok * 8 + (h - 8)] = -1.0e30f; lse[(size_t)2 * T * 8 + tok * 8 + (h - 8)] = -1.0e30f; }
}

namespace att {
typedef float f32x16 __attribute__((ext_vector_type(16)));
typedef short s16x4 __attribute__((ext_vector_type(4)));
typedef short v4i16_t __attribute__((ext_vector_type(4)));
typedef __bf16 bf16x2_t __attribute__((ext_vector_type(2)));
constexpr int L_BUF = 16384;
constexpr int L_WSF = 2 * L_BUF;
constexpr int L_OST = L_WSF + 8 * 256;
constexpr int L_FLG = L_OST + 8 * 4096;
constexpr int L_END = L_FLG + 64;
constexpr float M_INIT = -1.0e30f;
#define ATT_MFMA(a, b, c) __builtin_amdgcn_mfma_f32_32x32x16_bf16((a), (b), (c), 0, 0, 0)

__device__ __forceinline__ unsigned cvtpk(float lo, float hi) { f32x2 v = {lo, hi}; bf16x2_t b = __builtin_convertvector(v, bf16x2_t); return __builtin_bit_cast(unsigned, b); }
__device__ __forceinline__ s16x4 vtr(LAS unsigned char* p) { return __builtin_bit_cast(s16x4, __builtin_amdgcn_ds_read_tr16_b64_v4i16((LAS v4i16_t*)p)); }

struct Wave { int lane, r32, hi, wid; LAS unsigned char* lds; LAS float* wsf; LAS unsigned char* ost; int vlo; };
__device__ __forceinline__ Wave make_wave(LAS unsigned char* lds, int tid, int wsf_off = L_WSF, int ost_off = L_OST) {
    Wave w; w.lane = tid & 63; w.r32 = w.lane & 31; w.hi = w.lane >> 5; w.wid = __builtin_amdgcn_readfirstlane(tid >> 6); w.lds = lds;
    w.wsf = (LAS float*)(lds + wsf_off) + w.wid * 64; w.ost = lds + ost_off + w.wid * 4096;
    w.vlo = ((w.lane >> 4) & 1) * 32 + (w.lane & 3) * 8 + (4 * w.hi + ((w.lane & 15) >> 2)) * 64;
    return w;
}
struct Stage { u32x4 k, v; };
template <class RowK, class RowV> __device__ __forceinline__ void stage_load(Stage& s, const Wave& w, const RowK& rowk, const RowV& rowv) {
    s.k = *(const u32x4*)(rowk(w.lane) + w.wid * 8);
    s.v = *(const u32x4*)(rowv(16 * (w.wid & 3) + (w.lane >> 2)) + (w.wid >> 2) * 32 + (w.lane & 3) * 8);
}
__device__ __forceinline__ void stage_write(const Stage& s, const Wave& w, int buf) {
    *(LAS u32x4*)(w.lds + buf * L_BUF + w.wid * 1024 + w.lane * 16) = s.k;
    *(LAS u32x4*)(w.lds + buf * L_BUF + 8192 + w.wid * 1024 + w.lane * 16) = s.v;
}
__device__ __forceinline__ f32x16 qk_sub(const Wave& w, int buf, int sub, const bf16x8 (&qf)[4], float init) {
    f32x16 acc;
#pragma unroll
    for (int r = 0; r < 16; ++r) acc[r] = init;
    LAS unsigned char* kp = w.lds + buf * L_BUF + w.hi * 1024 + (32 * sub + w.r32) * 16;
#pragma unroll
    for (int ks = 0; ks < 4; ++ks) { const bf16x8 kf = *(LAS bf16x8*)(kp + ks * 2048); acc = ATT_MFMA(kf, qf[ks], acc); }
    return acc;
}
__device__ __forceinline__ void pv_sub(const Wave& w, int buf, int sub, const f32x16& p, f32x16 (&o)[2]) {
    bf16x8 pk[2];
#pragma unroll
    for (int s = 0; s < 2; ++s) { u32x4 t; t.x = cvtpk(p[8 * s], p[8 * s + 1]); t.y = cvtpk(p[8 * s + 2], p[8 * s + 3]); t.z = cvtpk(p[8 * s + 4], p[8 * s + 5]); t.w = cvtpk(p[8 * s + 6], p[8 * s + 7]); pk[s] = __builtin_bit_cast(bf16x8, t); }
    LAS unsigned char* vb = w.lds + buf * L_BUF + 8192 + w.vlo;
#pragma unroll
    for (int db = 0; db < 2; ++db)
#pragma unroll
        for (int s = 0; s < 2; ++s) { LAS unsigned char* vp = vb + db * 4096 + (4 * sub + 2 * s) * 512;
            const s16x4 lo = vtr(vp), hh = vtr(vp + 512);
            const bf16x8 vf = __builtin_shufflevector(lo, hh, 0, 1, 2, 3, 4, 5, 6, 7);
            o[db] = ATT_MFMA(pk[s], vf, o[db]); }
}
struct VFrags { s16x4 f[2][2][2]; };
__device__ __forceinline__ void load_vfrags(const Wave& w, int buf, int sub, VFrags& v) {
    LAS unsigned char* vb = w.lds + buf * L_BUF + 8192 + w.vlo;
#pragma unroll
    for (int db = 0; db < 2; ++db)
#pragma unroll
        for (int s = 0; s < 2; ++s) { LAS unsigned char* vp = vb + db * 4096 + (4 * sub + 2 * s) * 512; v.f[db][s][0] = vtr(vp); v.f[db][s][1] = vtr(vp + 512); }
}
__device__ __forceinline__ void pv_frags(const VFrags& v, const f32x16& p, f32x16 (&o)[2]) {
    bf16x8 pk[2];
#pragma unroll
    for (int s = 0; s < 2; ++s) { u32x4 t; t.x = cvtpk(p[8 * s], p[8 * s + 1]); t.y = cvtpk(p[8 * s + 2], p[8 * s + 3]); t.z = cvtpk(p[8 * s + 4], p[8 * s + 5]); t.w = cvtpk(p[8 * s + 6], p[8 * s + 7]); pk[s] = __builtin_bit_cast(bf16x8, t); }
#pragma unroll
    for (int db = 0; db < 2; ++db)
#pragma unroll
        for (int s = 0; s < 2; ++s) { const bf16x8 vf = __builtin_shufflevector(v.f[db][s][0], v.f[db][s][1], 0, 1, 2, 3, 4, 5, 6, 7); o[db] = ATT_MFMA(pk[s], vf, o[db]); }
}
__device__ __forceinline__ void scale_rows(const Wave& w, f32x16 (&o)[2], float f) {
    if (w.hi == 0) w.wsf[w.r32] = f;
#pragma unroll
    for (int g = 0; g < 4; ++g) { const f32x4 fv = *(LAS f32x4*)(w.wsf + 8 * g + 4 * w.hi);
#pragma unroll
        for (int i = 0; i < 4; ++i) { o[0][4 * g + i] *= fv[i]; o[1][4 * g + i] *= fv[i]; } }
}
__device__ __forceinline__ void softmax_sub(const Wave& w, f32x16& s, float& m, float& lsum, f32x16 (&o)[2]) {
    float tm = fmaxf(fmaxf(s[0], s[1]), fmaxf(s[2], s[3]));
#pragma unroll
    for (int r = 4; r < 16; r += 4) tm = fmaxf(tm, fmaxf(fmaxf(s[r], s[r + 1]), fmaxf(s[r + 2], s[r + 3])));
    tm = max_xor32(tm);
    const float mn = fmaxf(m, tm);
    if (__any(mn > m)) { const float al = __builtin_amdgcn_exp2f(m - mn); lsum *= al; scale_rows(w, o, al); m = mn; }
    float acc = 0.f;
#pragma unroll
    for (int r = 0; r < 16; ++r) { s[r] = __builtin_amdgcn_exp2f(s[r] - m); acc += s[r]; }
    lsum += acc;
}
__device__ __forceinline__ void mask_band(f32x16& s, int delta0, int W) {
#pragma unroll
    for (int r = 0; r < 16; ++r) { const int dl = delta0 - ((r & 3) + 8 * (r >> 2)); if ((unsigned)dl > (unsigned)W) s[r] = -INFINITY; }
}
constexpr float SM_THR = 8.0f;
struct SubDesc { bool act; int delta; int W; };
template <int NSUB>
__device__ __forceinline__ void softmax_step(const Wave& w, int buf, const bf16x8 (&qf)[4], const bf16x8& kidx, const bf16x8& slp, float slope, const SubDesc (&sd)[NSUB],
                                             float& m, float& lsum, f32x16 (&o)[2], bool& first) {
    f32x16 s[NSUB];
    bool any_act = false;
#pragma unroll
    for (int i = 0; i < NSUB; ++i) if (sd[i].act) { any_act = true; s[i] = qk_sub(w, buf, i, qf, -slope * (float)sd[i].delta - m); s[i] = ATT_MFMA(kidx, slp, s[i]); }
    if (!any_act) return;
    float tm = -INFINITY;
#pragma unroll
    for (int i = 0; i < NSUB; ++i) if (sd[i].act) {
        if (sd[i].W >= 0) mask_band(s[i], sd[i].delta - 4 * w.hi, sd[i].W);
        float t = fmaxf(fmaxf(s[i][0], s[i][1]), fmaxf(s[i][2], s[i][3]));
#pragma unroll
        for (int r = 4; r < 16; r += 4) t = fmaxf(t, fmaxf(fmaxf(s[i][r], s[i][r + 1]), fmaxf(s[i][r + 2], s[i][r + 3])));
        tm = fmaxf(tm, t); }
    tm = max_xor32(tm);
    if (first || __any(tm > SM_THR)) {
        const float d = first ? (tm > -1.0e30f ? tm : 0.f) : fmaxf(tm, 0.f);
#pragma unroll
        for (int i = 0; i < NSUB; ++i) if (sd[i].act) {
#pragma unroll
            for (int r = 0; r < 16; ++r) s[i][r] -= d; }
        if (!first) { const float al = __builtin_amdgcn_exp2f(-d); lsum *= al; scale_rows(w, o, al); }
        m += d; first = false;
    }
    VFrags vf[NSUB];
#pragma unroll
    for (int i = 0; i < NSUB; ++i) if (sd[i].act) load_vfrags(w, buf, i, vf[i]);
#pragma unroll
    for (int i = 0; i < NSUB; ++i) if (sd[i].act) { float acc = 0.f;
#pragma unroll
        for (int r = 0; r < 16; ++r) { s[i][r] = __builtin_amdgcn_exp2f(s[i][r]); acc += s[i][r]; }
        lsum += acc; }
#pragma unroll
    for (int i = 0; i < NSUB; ++i) if (sd[i].act) pv_frags(vf[i], s[i], o);
}
__device__ __forceinline__ void bias_frags(const Wave& w, float slope, bf16x8& kidx, bf16x8& slp) {
    const unsigned kb = f2bf((float)w.r32), sh = f2bf(slope), sl = f2bf(slope - __builtin_bit_cast(float, sh << 16));
    const u32x4 a = {w.hi == 0 ? (kb | (kb << 16)) : 0u, 0u, 0u, 0u}, b = {w.hi == 0 ? (sh | (sl << 16)) : 0u, 0u, 0u, 0u};
    kidx = __builtin_bit_cast(bf16x8, a); slp = __builtin_bit_cast(bf16x8, b);
}
template <class RowO> __device__ __forceinline__ void store_o(const Wave& w, const f32x16 (&o)[2], const RowO& rowo) {
    LAS unsigned short* stg = (LAS unsigned short*)w.ost;
#pragma unroll
    for (int r = 0; r < 16; ++r) { const int q = (r & 3) + 8 * (r >> 2) + 4 * w.hi;
#pragma unroll
        for (int db = 0; db < 2; ++db) stg[q * 64 + db * 32 + w.r32] = (unsigned short)f2bf(o[db][r]); }
#pragma unroll
    for (int i = 0; i < 4; ++i) { const int row = i * 8 + (w.lane >> 3), ch = w.lane & 7; const u32x4 v = *(LAS u32x4*)((LAS unsigned char*)stg + row * 128 + ch * 16);
        bf16_t* dst = rowo(row); if (dst) *(u32x4*)(dst + ch * 8) = v; }
}
__device__ __forceinline__ void load_q(bf16x8 (&qf)[4], const bf16_t* qrow, int hi) {
#pragma unroll
    for (int ks = 0; ks < 4; ++ks) qf[ks] = *(const bf16x8*)(qrow + 16 * ks + 8 * hi);
}

constexpr int W_WSF = 98304, W_OST = W_WSF + 2048, W_ENUM = W_OST + 32768;
template <int NC> struct Pref { u32x4 k[NC], v[NC]; bf16x8 q[4]; };
template <int NC, class RowF> __device__ __forceinline__ void win_issue(Pref<NC>& P, const Wave& w, const bf16_t* kbase, const bf16_t* vbase, const RowF& rowoff, const bf16_t* qrow) {
#pragma unroll
    for (int c = 0; c < NC; ++c) { P.k[c] = *(const u32x4*)(kbase + rowoff(64 * c + 8 * w.wid + (w.lane >> 3)) + (w.lane & 7) * 8);
        P.v[c] = *(const u32x4*)(vbase + rowoff(64 * c + 16 * (w.wid & 3) + (w.lane >> 2)) + (w.wid >> 2) * 32 + (w.lane & 3) * 8); }
    load_q(P.q, qrow, w.hi);
}
template <int NC> __device__ __forceinline__ void win_commit(const Pref<NC>& P, const Wave& w) {
    constexpr int NK = 64 * NC;
#pragma unroll
    for (int c = 0; c < NC; ++c) { const int key = 64 * c + 8 * w.wid + (w.lane >> 3);
        *(LAS u32x4*)(w.lds + key * 128 + ((((w.lane & 7) ^ (key >> 1)) & 7) * 16)) = P.k[c];
        *(LAS u32x4*)(w.lds + NK * 128 + (w.wid >> 2) * (NK * 64) + (8 * c + 2 * (w.wid & 3)) * 512 + w.lane * 16) = P.v[c]; }
}
template <int NK> __device__ __forceinline__ f32x16 qk_win(const Wave& w, int u, const bf16x8 (&qf)[4], float init) {
    f32x16 acc;
#pragma unroll
    for (int r = 0; r < 16; ++r) acc[r] = init;
    LAS unsigned char* kp = w.lds + (32 * u + w.r32) * 128; const int x = (w.r32 >> 1) & 7;
#pragma unroll
    for (int ks = 0; ks < 4; ++ks) { const bf16x8 kf = *(LAS bf16x8*)(kp + (((2 * ks + w.hi) ^ x) * 16)); acc = ATT_MFMA(kf, qf[ks], acc); }
    return acc;
}
template <int NK> __device__ __forceinline__ void load_vfrags_win(const Wave& w, int u, VFrags& v) {
    LAS unsigned char* vb = w.lds + NK * 128 + w.vlo;
#pragma unroll
    for (int db = 0; db < 2; ++db)
#pragma unroll
        for (int s = 0; s < 2; ++s) { LAS unsigned char* vp = vb + db * (NK * 64) + (4 * u + 2 * s) * 512; v.f[db][s][0] = vtr(vp); v.f[db][s][1] = vtr(vp + 512); }
}
struct WSub { bool act; int u; int delta; int W; };
template <int NK>
__device__ __forceinline__ void softmax_win(const Wave& w, const bf16x8 (&qf)[4], const bf16x8& kidx, const bf16x8& slp, float slope, const WSub (&sd)[2], float& m, float& lsum, f32x16 (&o)[2], bool& first) {
    f32x16 s[2];
    bool any_act = false;
#pragma unroll
    for (int i = 0; i < 2; ++i) if (sd[i].act) { any_act = true; s[i] = qk_win<NK>(w, sd[i].u, qf, -slope * (float)sd[i].delta - m); s[i] = ATT_MFMA(kidx, slp, s[i]); }
    if (!any_act) return;
    float tm = -INFINITY;
#pragma unroll
    for (int i = 0; i < 2; ++i) if (sd[i].act) {
        if (sd[i].W >= 0) mask_band(s[i], sd[i].delta - 4 * w.hi, sd[i].W);
        float t = fmaxf(fmaxf(s[i][0], s[i][1]), fmaxf(s[i][2], s[i][3]));
#pragma unroll
        for (int r = 4; r < 16; r += 4) t = fmaxf(t, fmaxf(fmaxf(s[i][r], s[i][r + 1]), fmaxf(s[i][r + 2], s[i][r + 3])));
        tm = fmaxf(tm, t); }
    tm = max_xor32(tm);
    if (first || __any(tm > SM_THR)) {
        const float d = first ? (tm > -1.0e30f ? tm : 0.f) : fmaxf(tm, 0.f);
#pragma unroll
        for (int i = 0; i < 2; ++i) if (sd[i].act) {
#pragma unroll
            for (int r = 0; r < 16; ++r) s[i][r] -= d; }
        if (!first) { const float al = __builtin_amdgcn_exp2f(-d); lsum *= al; scale_rows(w, o, al); }
        m += d; first = false;
    }
#pragma unroll
    for (int i = 0; i < 2; ++i) if (sd[i].act) { VFrags vf; load_vfrags_win<NK>(w, sd[i].u, vf);
        float acc = 0.f;
#pragma unroll
        for (int r = 0; r < 16; ++r) { s[i][r] = __builtin_amdgcn_exp2f(s[i][r]); acc += s[i][r]; }
        lsum += acc;
        pv_frags(vf, s[i], o); }
}

__device__ __forceinline__ size_t ql_off(int bh, int j) { return (size_t)bh * QL_PER_BH + (size_t)(8192 * j - 128 * j * (j + 1)); }
__device__ __forceinline__ float* lsem_ptr(float* l0, float* l1, int slot) { return (slot < 2 ? l0 : l1) + (size_t)(slot & 1) * T * 4; }

struct Top3 { int i0, i1, i2; };
__device__ __forceinline__ Top3 moba_top3(const Wave& w, const bf16x8 (&qf)[4], const float* KMEAN, int b, int h, int own) {
    int i0 = -1, i1 = -1, i2 = -1;
    if (own > 0) {
    f32x16 g;
#pragma unroll
    for (int r = 0; r < 16; ++r) g[r] = 0.f;
    const float* km = KMEAN + ((size_t)(b * 4 + h) * 32 + w.r32) * HD + 8 * w.hi;
#pragma unroll
    for (int ks = 0; ks < 4; ++ks) { const f32x4 a0 = *(const f32x4*)(km + 16 * ks), a1 = *(const f32x4*)(km + 16 * ks + 4);
        const float x[8] = {a0.x, a0.y, a0.z, a0.w, a1.x, a1.y, a1.z, a1.w}; unsigned hw[4], lw[4];
#pragma unroll
        for (int j = 0; j < 4; ++j) { const unsigned h0 = f2bf(x[2 * j]), h1 = f2bf(x[2 * j + 1]); hw[j] = h0 | (h1 << 16);
            lw[j] = pk2(x[2 * j] - __builtin_bit_cast(float, h0 << 16), x[2 * j + 1] - __builtin_bit_cast(float, h1 << 16)); }
        const u32x4 hv = {hw[0], hw[1], hw[2], hw[3]}, lv = {lw[0], lw[1], lw[2], lw[3]};
        g = ATT_MFMA(__builtin_bit_cast(bf16x8, hv), qf[ks], g); g = ATT_MFMA(__builtin_bit_cast(bf16x8, lv), qf[ks], g); }
    float v0 = -INFINITY, v1 = -INFINITY, v2 = -INFINITY;
#pragma unroll
    for (int r = 0; r < 16; ++r) { const int blk = (r & 3) + 8 * (r >> 2) + 4 * w.hi; const float val = (blk < own) ? g[r] : -INFINITY;
        if (val > v0) { v2 = v1; i2 = i1; v1 = v0; i1 = i0; v0 = val; i0 = blk; } else if (val > v1) { v2 = v1; i2 = i1; v1 = val; i1 = blk; } else if (val > v2) { v2 = val; i2 = blk; } }
    const float pv_[3] = {get_xor32(v0, w.hi), get_xor32(v1, w.hi), get_xor32(v2, w.hi)}; const int pi_[3] = {get_xor32i(i0, w.hi), get_xor32i(i1, w.hi), get_xor32i(i2, w.hi)};
#pragma unroll
    for (int k = 0; k < 3; ++k) { const float val = pv_[k]; const int blk = pi_[k];
        if (val > v0 || (val == v0 && blk < i0)) { v2 = v1; i2 = i1; v1 = v0; i1 = i0; v0 = val; i0 = blk; }
        else if (val > v1 || (val == v1 && blk < i1)) { v2 = v1; i2 = i1; v1 = val; i1 = blk; }
        else if (val > v2 || (val == v2 && blk < i2)) { v2 = val; i2 = blk; } }
    }
    Top3 t; t.i0 = i0; t.i1 = i1; t.i2 = i2; return t;
}
__device__ __forceinline__ void moba_gate_unit(LAS unsigned char* lds, const bf16_t* QB, const float* KMEAN, unsigned* mcnt, unsigned* qlist, bf16_t* PM, float* LSEM0, float* LSEM1, int b, int h, int own, int tid) {
    const Wave w = make_wave(lds, tid);
    const size_t rowbase = (size_t)b * SEQ; const int qpos = own * 256 + 32 * w.wid + w.r32, bh = b * 4 + h;
    bf16x8 qf[4]; load_q(qf, QB + (rowbase + qpos) * DM + h * HD, w.hi);
    const Top3 t3 = moba_top3(w, qf, KMEAN, b, h, own); const int s0 = t3.i0, s1 = t3.i1, s2 = t3.i2;
    LAS unsigned* cl = (LAS unsigned*)(lds + W_ENUM);
    if (tid < 64) cl[tid] = 0u;
    __syncthreads();
    unsigned r0 = 0u, r1 = 0u, r2 = 0u;
    if (w.hi == 0) {
        if (s0 >= 0) r0 = __hip_atomic_fetch_add(cl + s0, 1u, __ATOMIC_RELAXED, __HIP_MEMORY_SCOPE_WORKGROUP);
        if (s1 >= 0) r1 = __hip_atomic_fetch_add(cl + s1, 1u, __ATOMIC_RELAXED, __HIP_MEMORY_SCOPE_WORKGROUP);
        if (s2 >= 0) r2 = __hip_atomic_fetch_add(cl + s2, 1u, __ATOMIC_RELAXED, __HIP_MEMORY_SCOPE_WORKGROUP);
    }
    __syncthreads();
    if (tid < 32) { const unsigned c = cl[tid]; cl[32 + tid] = c ? __hip_atomic_fetch_add(mcnt + bh * 32 + tid, c, __ATOMIC_RELAXED, __HIP_MEMORY_SCOPE_AGENT) : 0u; }
    __syncthreads();
    if (w.hi == 0) {
        const size_t tok = rowbase + qpos;
#define MOBA_EMIT(k, sk, rk) do { if (sk >= 0) qlist[ql_off(bh, sk) + cl[32 + sk] + rk] = (unsigned)qpos | ((unsigned)(k) << 13); \
            else { lsem_ptr(LSEM0, LSEM1, k)[tok * 4 + h] = -1.0e30f;          \
                u32x4* pz = (u32x4*)(PM + ((size_t)(k) * T + tok) * 256 + h * HD); const u32x4 z4 = {0u, 0u, 0u, 0u}; \
                _Pragma("unroll") for (int c = 0; c < 8; ++c) pz[c] = z4; } } while (0)
        MOBA_EMIT(0, s0, r0); MOBA_EMIT(1, s1, r1); MOBA_EMIT(2, s2, r2);
#undef MOBA_EMIT
    }
    __syncthreads();
}
struct OwnU { int b, h, own; };
__device__ __forceinline__ void own_issue(Pref<4>& P, const Wave& w, const OwnU& u, const bf16_t* QB, const bf16_t* KB, const bf16_t* VB) {
    const size_t rowbase = (size_t)u.b * SEQ; const int q0 = u.own * 256;
    win_issue<4>(P, w, KB + (rowbase + q0) * DM + u.h * HD, VB + (rowbase + q0) * DM + u.h * HD, [&](int key) { return (size_t)key * DM; }, QB + (rowbase + q0 + 32 * w.wid + w.r32) * DM + u.h * HD);
}
template <class F> __device__ __forceinline__ void own_compute(const Wave& w, const OwnU& u, const bf16x8 (&qf)[4], bf16_t* OB, float* LSEM0, float* LSEM1, const F& between) {
    const size_t rowbase = (size_t)u.b * SEQ; const int q0 = u.own * 256, ql = 32 * w.wid + w.r32;
    const float slope2 = exp2f(-2.0f * (float)(u.h + 1)) * LOG2E;
    bf16x8 kidx, slp; bias_frags(w, slope2, kidx, slp);
    f32x16 o[2];
#pragma unroll
    for (int r = 0; r < 16; ++r) { o[0][r] = 0.f; o[1][r] = 0.f; }
    float m = 0.f, lsum = 0.f; bool first = true;
#pragma unroll
    for (int p = 0; p < 4; ++p) { WSub sd[2];
#pragma unroll
        for (int i = 0; i < 2; ++i) { const int su = w.wid - 2 * p - i; sd[i].act = su >= 0; sd[i].u = su; sd[i].delta = ql - 32 * su; sd[i].W = (su == w.wid) ? 0x7fffffff : -1; }
        softmax_win<256>(w, qf, kidx, slp, slope2, sd, m, lsum, o, first); }
    between();
    const float l = sum_xor32(lsum);
    scale_rows(w, o, 1.0f / l);
    bf16_t* orow = OB + (rowbase + q0 + 32 * w.wid) * DM + u.h * HD;
    store_o(w, o, [&](int r) { return orow + (size_t)r * DM; });
    if (w.hi == 0) lsem_ptr(LSEM0, LSEM1, 3)[(rowbase + q0 + ql) * 4 + u.h] = m + __builtin_amdgcn_logf(l);
}
struct GatU { int b, h, j, cnt, chunk; const unsigned* ql; };
__device__ __forceinline__ unsigned gat_entry(const Wave& w, const GatU& u, bool& valid) { const int idx = u.chunk * 256 + 32 * w.wid + w.r32; valid = idx < u.cnt; return u.ql[valid ? idx : u.chunk * 256]; }
__device__ __forceinline__ void gat_issue(Pref<4>& P, const Wave& w, const GatU& u, const bf16_t* QB, const bf16_t* KB, const bf16_t* VB) {
    const size_t rowbase = (size_t)u.b * SEQ; bool valid; const unsigned e = gat_entry(w, u, valid);
    win_issue<4>(P, w, KB + (rowbase + u.j * 256) * DM + u.h * HD, VB + (rowbase + u.j * 256) * DM + u.h * HD, [&](int key) { return (size_t)key * DM; }, QB + (rowbase + (e & 8191u)) * DM + u.h * HD);
}
template <class F> __device__ __forceinline__ void gat_compute(const Wave& w, const GatU& u, const bf16x8 (&qf)[4], bf16_t* PM, float* LSEM0, float* LSEM1, const F& between) {
    const size_t rowbase = (size_t)u.b * SEQ; bool valid; const unsigned e = gat_entry(w, u, valid);
    const int qpos = (int)(e & 8191u), slot = (int)(e >> 13);
    const float slope2 = exp2f(-2.0f * (float)(u.h + 1)) * LOG2E;
    bf16x8 kidx, slp; bias_frags(w, slope2, kidx, slp);
    f32x16 o[2];
#pragma unroll
    for (int r = 0; r < 16; ++r) { o[0][r] = 0.f; o[1][r] = 0.f; }
    float m = 0.f, lsum = 0.f; bool first = true;
#pragma unroll
    for (int p = 0; p < 4; ++p) { WSub sd[2];
#pragma unroll
        for (int i = 0; i < 2; ++i) { const int su = 7 - 2 * p - i; sd[i].act = true; sd[i].u = su; sd[i].delta = qpos - (u.j * 256 + 32 * su); sd[i].W = -1; }
        softmax_win<256>(w, qf, kidx, slp, slope2, sd, m, lsum, o, first); }
    between();
    const float l = sum_xor32(lsum);
    scale_rows(w, o, l > 0.f ? 1.0f / l : 0.f);
    LAS int* code = (LAS int*)(w.wsf + 32);
    if (w.hi == 0) code[w.r32] = valid ? (int)((size_t)slot * T + rowbase + qpos) : -1;
    store_o(w, o, [&](int r) { const int c = code[r]; return c >= 0 ? PM + (size_t)c * 256 + u.h * HD : (bf16_t*)nullptr; });
    if (w.hi == 0 && valid) lsem_ptr(LSEM0, LSEM1, slot)[(rowbase + qpos) * 4 + u.h] = l > 0.f ? m + __builtin_amdgcn_logf(l) : -1.0e30f;
}

__device__ __forceinline__ void sb_unit(LAS unsigned char* lds, const bf16_t* QB, const bf16_t* KB, const bf16_t* VB, bf16_t* OB, int b, int h, int qt, int tid) {
    const Wave w = make_wave(lds, tid);
    const size_t rowbase = (size_t)b * SEQ; const int q0 = qt * 256, qpos = q0 + 32 * w.wid + w.r32;
    const bf16_t* kh = KB + rowbase * DM + h * HD; const bf16_t* vh = VB + rowbase * DM + h * HD;
    bf16x8 qf[4]; load_q(qf, QB + (rowbase + qpos) * DM + h * HD, w.hi);
    f32x16 o[2];
#pragma unroll
    for (int r = 0; r < 16; ++r) { o[0][r] = 0.f; o[1][r] = 0.f; }
    float carry = 0.f;
    bool done = false;
    volatile LAS unsigned* flg = (volatile LAS unsigned*)(lds + L_FLG);
    const int ti0 = q0 / 64 + 3;
    Stage sg;
    { const int kp = ti0 * 64; stage_load(sg, w, [&](int key) { return kh + (size_t)(kp + key) * DM; }, [&](int key) { return vh + (size_t)(kp + key) * DM; }); }
    stage_write(sg, w, 0);
    __syncthreads();
    for (int st = 0;; ++st) {
        const int buf = st & 1, ti = ti0 - st;
        if (ti > 0) { const int kp = (ti - 1) * 64; stage_load(sg, w, [&](int key) { return kh + (size_t)(kp + key) * DM; }, [&](int key) { return vh + (size_t)(kp + key) * DM; }); }
        if (!done) {
#pragma unroll
            for (int sub = 1; sub >= 0; --sub) {
                const int D = (q0 / 32 + w.wid) - (2 * ti + sub);
                if (D < 0) continue;
                const int delta0 = qpos - (64 * ti + 32 * sub) - 4 * w.hi;
                f32x16 z = qk_sub(w, buf, sub, qf, 0.f);
                f32x16 L;
#pragma unroll
                for (int r = 0; r < 16; ++r) { const float lp = __builtin_amdgcn_logf(1.0f + __builtin_amdgcn_exp2f(-fabsf(z[r]))); L[r] = -(fmaxf(z[r], 0.f) + lp); }
                if (D == 0) {
#pragma unroll
                    for (int r = 0; r < 16; ++r) { const int dl = delta0 - ((r & 3) + 8 * (r >> 2)); if (dl < 1) { L[r] = 0.f; z[r] = -INFINITY; } }
                }
                float G[4], PG[4];
#pragma unroll
                for (int g = 0; g < 4; ++g) { G[g] = (L[4 * g] + L[4 * g + 1]) + (L[4 * g + 2] + L[4 * g + 3]); PG[g] = get_xor32(G[g], w.hi); }
                float run = carry;
#pragma unroll
                for (int g = 3; g >= 0; --g) { const float t3 = run + (w.hi == 0 ? PG[g] : 0.f), t2 = t3 + L[4 * g + 3], t1 = t2 + L[4 * g + 2], t0 = t1 + L[4 * g + 1];
                    z[4 * g + 3] = __builtin_amdgcn_exp2f(z[4 * g + 3] + L[4 * g + 3] + t3); z[4 * g + 2] = __builtin_amdgcn_exp2f(z[4 * g + 2] + L[4 * g + 2] + t2);
                    z[4 * g + 1] = __builtin_amdgcn_exp2f(z[4 * g + 1] + L[4 * g + 1] + t1); z[4 * g] = __builtin_amdgcn_exp2f(z[4 * g] + L[4 * g] + t0);
                    run += G[g] + PG[g]; }
                carry = run;
                pv_sub(w, buf, sub, z, o);
            }
            done = __all(carry < -150.f);
        }
        if (w.lane == 0) flg[buf * 8 + w.wid] = done ? 1u : 0u;
        if (ti > 0) stage_write(sg, w, buf ^ 1);
        __syncthreads();
        unsigned all = 1u;
#pragma unroll
        for (int k = 0; k < 8; ++k) all &= flg[buf * 8 + k];
        if (all || ti == 0) break;
    }
    bf16_t* orow = OB + (rowbase + q0 + 32 * w.wid) * DM + h * HD;
    store_o(w, o, [&](int r) { return orow + (size_t)r * DM; });
    __syncthreads();
}

struct PrefK6 { u32x4 k[6]; bf16x8 q[4]; }; struct PrefV6 { u32x4 v[6]; };
template <class RowF> __device__ __forceinline__ void win_issue_k6(PrefK6& P, const Wave& w, const bf16_t* kbase, const RowF& rowoff, const bf16_t* qrow) {
#pragma unroll
    for (int c = 0; c < 6; ++c) P.k[c] = *(const u32x4*)(kbase + rowoff(64 * c + 8 * w.wid + (w.lane >> 3)) + (w.lane & 7) * 8);
    load_q(P.q, qrow, w.hi);
}
template <class RowF> __device__ __forceinline__ void win_issue_v6(PrefV6& P, const Wave& w, const bf16_t* vbase, const RowF& rowoff) {
#pragma unroll
    for (int c = 0; c < 6; ++c) P.v[c] = *(const u32x4*)(vbase + rowoff(64 * c + 16 * (w.wid & 3) + (w.lane >> 2)) + (w.wid >> 2) * 32 + (w.lane & 3) * 8);
}
__device__ __forceinline__ void win_commit_k6(const PrefK6& P, const Wave& w) {
#pragma unroll
    for (int c = 0; c < 6; ++c) { const int key = 64 * c + 8 * w.wid + (w.lane >> 3); *(LAS u32x4*)(w.lds + key * 128 + ((((w.lane & 7) ^ (key >> 1)) & 7) * 16)) = P.k[c]; }
}
__device__ __forceinline__ void win_commit_v6(const PrefV6& P, const Wave& w) {
    constexpr int NK = 384;
#pragma unroll
    for (int c = 0; c < 6; ++c) *(LAS u32x4*)(w.lds + NK * 128 + (w.wid >> 2) * (NK * 64) + (8 * c + 2 * (w.wid & 3)) * 512 + w.lane * 16) = P.v[c];
}
struct DilU { int b, h, dil, res, i2, c; };
__device__ __forceinline__ DilU dil_decode(int u) { const int n = u & 31, bhc = u >> 5, c = bhc % 3, bh = bhc / 3; DilU d; d.b = bh >> 3; d.h = 8 + (bh & 7); d.c = c;
    d.dil = (c == 0) ? 1 : (c == 1) ? 4 : 16; d.res = (c == 0) ? 0 : (c == 1) ? (n >> 3) : (n >> 1); d.i2 = (c == 0) ? n : (c == 1) ? (n & 7) : (n & 1); return d; }
__device__ __forceinline__ void dil_issue_k(PrefK6& P, const Wave& w, const DilU& u, const bf16_t* QB, const bf16_t* KB) {
    const size_t rowbase = (size_t)u.b * SEQ; const int Q0 = 256 * u.i2, qj = Q0 + 32 * w.wid + w.r32; const size_t rstride = (size_t)u.dil * DM;
    win_issue_k6(P, w, KB + (rowbase + u.res) * DM + u.h * HD, [&](int key) { const int kj = Q0 - 128 + key; return (size_t)(kj < 0 ? 0 : kj) * rstride; },
                 QB + (rowbase + u.res + (size_t)qj * u.dil) * DM + u.h * HD);
}
__device__ __forceinline__ void dil_issue_v(PrefV6& P, const Wave& w, const DilU& u, const bf16_t* VB) {
    const size_t rowbase = (size_t)u.b * SEQ; const int Q0 = 256 * u.i2; const size_t rstride = (size_t)u.dil * DM;
    win_issue_v6(P, w, VB + (rowbase + u.res) * DM + u.h * HD, [&](int key) { const int kj = Q0 - 128 + key; return (size_t)(kj < 0 ? 0 : kj) * rstride; });
}
template <class F> __device__ __forceinline__ void dil_compute(const Wave& w, const DilU& u, const bf16x8 (&qf)[4], bf16_t* OB, bf16_t* HB2, float* LSE, const F& between) {
    const size_t rowbase = (size_t)u.b * SEQ; const int Q0 = 256 * u.i2, ql = 32 * w.wid + w.r32;
    const float slope2d = exp2f(-(float)(u.h - 8 + 1)) * LOG2E * (float)u.dil;
    bf16x8 kidx, slp; bias_frags(w, slope2d, kidx, slp);
    f32x16 o[2];
#pragma unroll
    for (int r = 0; r < 16; ++r) { o[0][r] = 0.f; o[1][r] = 0.f; }
    float m = 0.f, lsum = 0.f; bool first = true;
#pragma unroll
    for (int p = 0; p < 3; ++p) { WSub sd[2];
#pragma unroll
        for (int i = 0; i < 2; ++i) { const int D = 2 * p + i, su = w.wid + 4 - D; sd[i].act = (D <= 4) && (Q0 - 128 + 32 * su >= 0); sd[i].u = su; sd[i].delta = ql + 128 - 32 * su; sd[i].W = (D == 0 || D == 4) ? 128 : -1; }
        softmax_win<384>(w, qf, kidx, slp, slope2d, sd, m, lsum, o, first); }
    between();
    const float l = sum_xor32(lsum);
    scale_rows(w, o, 1.0f / l);
    bf16_t* PO = (u.c == 0) ? OB + 512 : HB2 + (u.c - 1) * 512;
    const size_t tok0 = rowbase + u.res + (size_t)(Q0 + 32 * w.wid) * u.dil;
    store_o(w, o, [&](int r) { return PO + (tok0 + (size_t)r * u.dil) * DM + (u.h - 8) * HD; });
    if (w.hi == 0) (LSE + (size_t)u.c * T * 8)[(tok0 + (size_t)w.r32 * u.dil) * 8 + (u.h - 8)] = m + __builtin_amdgcn_logf(l);
}

__device__ __forceinline__ void moba_gate_phase(LAS unsigned char* lds, const bf16_t* QB, const float* KMEAN, unsigned* mcnt, unsigned* qlist, bf16_t* PM, float* LSEM0, float* LSEM1, int v, int G, int tid) {
    for (int u = v; u < 512; u += G) { const int own = u & 31, bh = u >> 5; moba_gate_unit(lds, QB, KMEAN, mcnt, qlist, PM, LSEM0, LSEM1, bh >> 2, bh & 3, own, tid); }
}
struct AttnArgs { const bf16_t* QB; const bf16_t* KB; const bf16_t* VB; bf16_t* OB; bf16_t* HB2; float* LSE; const unsigned* mcnt; const unsigned* qlist; bf16_t* PM; float* LSEM0; float* LSEM1; };
__device__ __forceinline__ void attn_phase(LAS unsigned char* lds, const AttnArgs& A, int v, int G, int tid) {
    const Wave w = make_wave(lds, tid, W_WSF, W_OST);
    LAS int* cntl = (LAS int*)(lds + W_ENUM); LAS int* pa = cntl + 512; LAS int* pb = pa + 512;
    const int myc = (int)A.mcnt[tid], myu = (myc + 255) >> 8;
    cntl[tid] = myc; pa[tid] = myu;
    __syncthreads();
#pragma unroll 1
    for (int d = 1; d < 512; d <<= 1) { const int x = pa[tid] + (tid >= d ? pa[tid - d] : 0); pb[tid] = x; __syncthreads(); LAS int* t_ = pa; pa = pb; pb = t_; }
    const int total = pa[511];
    auto gat_decode = [&](int u) { int lo = 0, hi = 511;
        while (lo < hi) { const int mid = (lo + hi) >> 1; if (pa[mid] > u) hi = mid; else lo = mid + 1; }
        const int i = lo, c = cntl[i], bh = i >> 5; GatU g; g.b = bh >> 2; g.h = bh & 3; g.j = i & 31; g.cnt = c; g.chunk = u - (pa[i] - ((c + 255) >> 8)); g.ql = A.qlist + ql_off(bh, g.j); return g; };
    {   Pref<4> P; int u = v; GatU cur, nxt;
        if (u < total) { cur = gat_decode(u); gat_issue(P, w, cur, A.QB, A.KB, A.VB); }
        for (; u < total; u += G) {
            __syncthreads();
            win_commit<4>(P, w); bf16x8 qf[4] = {P.q[0], P.q[1], P.q[2], P.q[3]};
            __syncthreads();
            const bool more = u + G < total; if (more) nxt = gat_decode(u + G);
            gat_compute(w, cur, qf, A.PM, A.LSEM0, A.LSEM1, [&]() { if (more) gat_issue(P, w, nxt, A.QB, A.KB, A.VB); });
            cur = nxt; } }
    {   Pref<4> P; int u = v; OwnU cur, nxt;
        auto dec = [&](int uu) { OwnU o_; const int bh = uu >> 5; o_.b = bh >> 2; o_.h = bh & 3; o_.own = uu & 31; return o_; };
        if (u < 512) { cur = dec(u); own_issue(P, w, cur, A.QB, A.KB, A.VB); }
        for (; u < 512; u += G) {
            __syncthreads();
            win_commit<4>(P, w); bf16x8 qf[4] = {P.q[0], P.q[1], P.q[2], P.q[3]};
            __syncthreads();
            const bool more = u + G < 512; if (more) nxt = dec(u + G);
            own_compute(w, cur, qf, A.OB, A.LSEM0, A.LSEM1, [&]() { if (more) own_issue(P, w, nxt, A.QB, A.KB, A.VB); });
            cur = nxt; } }
    {   PrefK6 P; int u = v; DilU cur, nxt;
        if (u < 3072) { cur = dil_decode(u); dil_issue_k(P, w, cur, A.QB, A.KB); }
        for (; u < 3072; u += G) {
            __syncthreads();
            bf16x8 qf[4] = {P.q[0], P.q[1], P.q[2], P.q[3]};
            { PrefV6 PV; dil_issue_v(PV, w, cur, A.VB); win_commit_k6(P, w); win_commit_v6(PV, w); }
            __syncthreads();
            const bool more = u + G < 3072; if (more) nxt = dil_decode(u + G);
            dil_compute(w, cur, qf, A.OB, A.HB2, A.LSE, [&]() { if (more) dil_issue_k(P, w, nxt, A.QB, A.KB); });
            cur = nxt; } }
    __syncthreads();
    for (int u = v; u < 512; u += G) { const int qt = u & 31, bh = u >> 5; sb_unit(lds, A.QB, A.KB, A.VB, A.OB, bh >> 2, 4 + (bh & 3), qt, tid); }
}
}

constexpr int PH_PRO = 0, PH_L0 = 1, PH_PER_LAYER = 10, PH_FINAL = PH_L0 + DEPTH * PH_PER_LAYER, PH_COUNT = PH_FINAL + 1;
typedef const __attribute__((address_space(4))) Args* KArgP;
#define KARG() ({ KArgP p_ = (KArgP)__builtin_amdgcn_kernarg_segment_ptr(); asm volatile("" : "+s"(p_)); p_; })
#define PHASE_IDS int lane_p = (int)__builtin_amdgcn_mbcnt_hi(~0u, __builtin_amdgcn_mbcnt_lo(~0u, 0u)); LAUNDER_V(lane_p); int tid_p = wave * 64 + lane_p; int gw_p = gw, G_p = G, NGW_p = NGW; LAUNDER_S(gw_p); LAUNDER_S(G_p); LAUNDER_S(NGW_p)
__global__ void __launch_bounds__(NTHREADS, 2) fwd(Args a_unused) {
    extern __shared__ __attribute__((aligned(16))) unsigned char lds_raw[];
    LAS unsigned char* lds = (LAS unsigned char*)lds_raw;
    volatile LAS unsigned* MISC = (volatile LAS unsigned*)(lds + MISC_OFF);
    const int wave = __builtin_amdgcn_readfirstlane((int)threadIdx.x >> 6);
    const int G = gridDim.x, bx = blockIdx.x;
    const int vcu = (G % 8 == 0) ? (bx % 8) * (G / 8) + bx / 8 : bx;
    const int gw = vcu * NWAVES + wave, NGW = G * NWAVES;
    for (int u = threadIdx.x; u < (LDS_BYTES - LDSCTL_OFF) / 4; u += NTHREADS) ((LAS unsigned*)(lds + LDSCTL_OFF))[u] = 0u;
    __syncthreads();
    int lo, hi; XcdBarrier bar;
    { KArgP ka = KARG(); lo = ka->ph_lo; hi = ka->ph_hi; unsigned* ctl = (unsigned*)(ka->ws + WS_CTL); bar = xcd_barrier_post(ctl + CW_BAR + ka->li * XCD_BAR_WORDS, MISC + 8, wave); }
#define IN(k) (lo <= (k) && (k) < hi)
#define SEAM(k) do { if (IN(k) && IN((k) + 1)) xcd_barrier(bar); } while (0)
#define WSP(T_, off) ((T_*)(ws + (off)))

    if (IN(PH_PRO)) { KArgP ka = KARG(); PHASE_IDS; Args a; a.ws = ka->ws; a.w_in = ka->w_in; a.w_out = ka->w_out; a.w_gate = ka->w_gate; a.w_up = ka->w_up; a.w_down = ka->w_down; phase_prologue(a, lds, gw_p, NGW_p, wave, lane_p); } SEAM(PH_PRO);

    for (int l = 0; l < DEPTH; ++l) {
        const int p0 = PH_L0 + l * PH_PER_LAYER;
        if (hi <= p0 || lo >= p0 + PH_PER_LAYER) continue;
        if (IN(p0 + 0)) for (int rep_ = 0; rep_ < RPT(0); ++rep_) { if (rep_) xcd_barrier(bar); KArgP ka = KARG(); PHASE_IDS; unsigned char* ws = ka->ws; const float* xin = (l == 0) ? ka->x : ka->out;
            phase_norm1(xin, ka->ln1_g + (size_t)l * DM, WSP(bf16_t, WS_HB), gw_p, NGW_p, lane_p, WSP(float, WS_KMEAN)); } SEAM(p0 + 0);
        if (IN(p0 + 1)) for (int rep_ = 0; rep_ < RPT(1); ++rep_) { if (rep_) xcd_barrier(bar); KArgP ka = KARG(); PHASE_IDS; unsigned char* ws = ka->ws;
            pg8::Gemm g{(const char*)(ws + WS_HB), (const char*)(ws + WS_WIN) + (size_t)l * NQKV * DM * 2, DM, DM, DM, (long)256 * DM * 2, (long)256 * DM * 2, (long)128 * DM * 2};
            pg8::StaticOrder S; S.init(T / 256, NQKV / 256, G_p, bx);
            pg8::EpiQKV E{WSP(bf16_t, WS_Q), (size_t)(WS_K - WS_Q) / 2, QSCALE};
            pg8::gemm_phase<pg8::EpiQKV, pg8::StaticOrder>(lds, g, S, E, wave);
        } SEAM(p0 + 1);
        if (IN(p0 + 3)) { KArgP ka = KARG(); PHASE_IDS; unsigned char* ws = ka->ws;
            att::moba_gate_phase(lds, WSP(bf16_t, WS_Q), WSP(float, WS_KMEAN), WSP(unsigned, WS_CTL) + CW_MCNT + l * 512, WSP(unsigned, WS_QLIST), WSP(bf16_t, WS_PM), WSP(float, WS_LSEM0), WSP(float, WS_LSEM1), vcu, G_p, tid_p);
        } SEAM(p0 + 3);
        if (IN(p0 + 4)) for (int rep_ = 0; rep_ < RPT(4); ++rep_) { if (rep_) xcd_barrier(bar); KArgP ka = KARG(); PHASE_IDS; unsigned char* ws = ka->ws;
            const att::AttnArgs A{WSP(bf16_t, WS_Q), WSP(bf16_t, WS_K), WSP(bf16_t, WS_V), WSP(bf16_t, WS_O), WSP(bf16_t, WS_HB), WSP(float, WS_LSE), WSP(unsigned, WS_CTL) + CW_MCNT + l * 512, WSP(unsigned, WS_QLIST),
                                  WSP(bf16_t, WS_PM), WSP(float, WS_LSEM0), WSP(float, WS_LSEM1)};
            att::attn_phase(lds, A, vcu, G_p, tid_p);
        } SEAM(p0 + 4);
        if (IN(p0 + 5)) { KArgP ka = KARG(); PHASE_IDS; unsigned char* ws = ka->ws;
            phase_mixnorm(WSP(bf16_t, WS_O), WSP(bf16_t, WS_HB), WSP(float, WS_LSE), WSP(bf16_t, WS_PM), WSP(float, WS_LSEM0), WSP(float, WS_LSEM1), ka->mix_g + (size_t)l * DM, gw_p, NGW_p, lane_p); } SEAM(p0 + 5);
        if (IN(p0 + 6)) { KArgP ka = KARG(); PHASE_IDS; unsigned char* ws = ka->ws; const float* xin = (l == 0) ? ka->x : ka->out;
            pg8::Gemm g{(const char*)(ws + WS_HB), (const char*)(ws + WS_WOUT) + (size_t)l * DM * DM * 2, DM, DM, DM, (long)256 * DM * 2, (long)256 * DM * 2, (long)128 * DM * 2};
            pg8::StaticOrder S; S.init(T / 256, DM / 256, G_p, bx);
            pg8::EpiResAdd E{xin, ka->out};
            pg8::gemm_phase<pg8::EpiResAdd, pg8::StaticOrder>(lds, g, S, E, wave);
        } SEAM(p0 + 6);
        if (IN(p0 + 7)) { KArgP ka = KARG(); PHASE_IDS; unsigned char* ws = ka->ws;
            phase_route(ka->out, ka->ln2_g + (size_t)l * DM, ka->w_gr + (size_t)l * DM * 4, ka->b_gr + l * 4, ka->w_er + (size_t)l * 4 * DM * 4, ka->b_er + l * 16, WSP(bf16_t, WS_HB),
                        WSP(unsigned, WS_CTL) + CW_CNT + l * 32, WSP(unsigned, WS_LIST), WSP(float, WS_WLIST), lds, vcu, G_p, wave, lane_p); } SEAM(p0 + 7);
        if (IN(p0 + 8)) for (int rep_ = 0; rep_ < RPT(8); ++rep_) { if (rep_) xcd_barrier(bar); KArgP ka = KARG(); PHASE_IDS; unsigned char* ws = ka->ws;
            pg8::MoeProb<0> P{WSP(unsigned, WS_CTL) + CW_CNT + l * 32, WSP(unsigned, WS_LIST), (const char*)(ws + WS_HB), (const char*)(ws + WS_WG) + (size_t)l * NACT * DM * 2, DM, DM, DM, (long)(WS_WU - WS_WG), G_p, vcu, WSP(unsigned, WS_CTL) + CW_TCNT + l * 16384};
            pg8::EpiGateUpSparse E{WSP(bf16_t, WS_ACT), WSP(float, WS_WLIST), WSP(unsigned, WS_CTL) + CW_TCNT + l * 16384};
            pg8::gemm_phase_x<pg8::EpiGateUpSparse, pg8::MoeProb<0>>(lds, P, E, wave);
        }
        if (IN(p0 + 9)) { KArgP ka = KARG(); PHASE_IDS; unsigned char* ws = ka->ws;
            pg8::MoeProb<1> P{WSP(unsigned, WS_CTL) + CW_CNT + l * 32, WSP(unsigned, WS_LIST), (const char*)(ws + WS_ACT), (const char*)(ws + WS_WD) + (size_t)l * DM * NACT * 2, 512, NACT, 512, (long)128 * NACT * 2, G_p, G_p - 1 - vcu, WSP(unsigned, WS_CTL) + CW_TCNT + l * 16384};
            pg8::EpiDownScatter E{ka->out, WSP(unsigned, WS_LIST)};
            pg8::gemm_phase_x<pg8::EpiDownScatter, pg8::MoeProb<1>>(lds, P, E, wave);
        } SEAM(p0 + 9);
    }
    if (IN(PH_FINAL)) { KArgP ka = KARG(); PHASE_IDS; phase_final(ka->out, ka->fin_g, gw_p, NGW_p, lane_p); }
#undef IN
#undef SEAM
#undef WSP
}

#ifndef N_LAUNCH_MODE
#define N_LAUNCH_MODE 1
#endif
extern "C" void kernel_launch(void* const* d_in, const int* in_sizes, int n_in, void* d_out, int out_size, void* d_ws, size_t ws_size, hipStream_t stream) {
    static int grid = 0;
    if (grid == 0) {
        if (n_in != 14 || in_sizes[0] != T * DM || out_size != T * DM || ws_size < WS_END) { fprintf(stderr, "kernel_launch: unexpected shapes (n_in %d in0 %d out %d ws %zu)\n", n_in, n_in > 0 ? in_sizes[0] : -1, out_size, ws_size); grid = -1; return; }
        int dev = 0, cus = 0, per_cu = 0;
        if (hipGetDevice(&dev) != hipSuccess || hipDeviceGetAttribute(&cus, hipDeviceAttributeMultiprocessorCount, dev) != hipSuccess) { grid = -1; return; }
        if (hipFuncSetAttribute((const void*)fwd, hipFuncAttributeMaxDynamicSharedMemorySize, LDS_BYTES) != hipSuccess) { fprintf(stderr, "kernel_launch: hipFuncSetAttribute failed\n"); grid = -1; return; }
        if (hipOccupancyMaxActiveBlocksPerMultiprocessor(&per_cu, (const void*)fwd, NTHREADS, LDS_BYTES) != hipSuccess || per_cu < 1) fprintf(stderr, "kernel_launch: occupancy query says %d\n", per_cu);
        (void)hipGetLastError();
        grid = cus;
    }
    if (grid < 0) return;
    if (hipMemsetAsync((char*)d_ws + WS_CTL, 0, CTL_ZERO_BYTES, stream) != hipSuccess) return;
    Args a{};
    a.x = (const float*)d_in[0]; a.ln1_g = (const float*)d_in[1]; a.w_in = (const float*)d_in[2]; a.mix_g = (const float*)d_in[3]; a.w_out = (const float*)d_in[4]; a.ln2_g = (const float*)d_in[5];
    a.w_gr = (const float*)d_in[6]; a.b_gr = (const float*)d_in[7]; a.w_er = (const float*)d_in[8]; a.b_er = (const float*)d_in[9]; a.w_gate = (const float*)d_in[10]; a.w_up = (const float*)d_in[11];
    a.w_down = (const float*)d_in[12]; a.fin_g = (const float*)d_in[13];
    a.out = (float*)d_out; a.ws = (unsigned char*)d_ws; a.pad = 0;
#if N_LAUNCH_MODE == 1
    a.ph_lo = 0; a.ph_hi = PH_COUNT; a.li = 0;
    hipLaunchKernelGGL(fwd, dim3(grid), dim3(NTHREADS), LDS_BYTES, stream, a);
#else
    for (int p = 0; p < PH_COUNT; ++p) { a.ph_lo = p; a.ph_hi = p + 1; a.li = p; hipLaunchKernelGGL(fwd, dim3(grid), dim3(NTHREADS), LDS_BYTES, stream, a); }
#endif
}
```

```cpp
#include <hip/hip_runtime.h>
#include <cstdio>
#include <cstdint>

#define LAS __attribute__((address_space(3)))
#define GAS __attribute__((address_space(1)))
typedef unsigned short bf16_t;
typedef short bf16x8 __attribute__((ext_vector_type(8)));
typedef float f32x4 __attribute__((ext_vector_type(4)));
typedef float f32x2 __attribute__((ext_vector_type(2)));
typedef unsigned u32x4 __attribute__((ext_vector_type(4)));
typedef unsigned u32x2 __attribute__((ext_vector_type(2)));

#ifndef PROBE_REPEAT
#define PROBE_REPEAT 0
#endif
#define RPT(k) ((((PROBE_REPEAT) >> (k)) & 1) ? 2 : 1)
#ifndef MOE_SPARSE
#define MOE_SPARSE 1
#endif
#ifndef ATT_MOBA
#define ATT_MOBA 1
#endif
#ifndef ATT_SB
#define ATT_SB 1
#endif
#ifndef ATT_DIL
#define ATT_DIL 1
#endif
constexpr int BATCH = 4, SEQ = 8192, DM = 1024, DEPTH = 4, T = BATCH * SEQ, NH = 16, HD = 64;
constexpr int NQKV = 3 * DM, NEXP = 16, DEXP = 256, NACT = NEXP * DEXP;
constexpr float NORM_EPS = 1e-6f;
constexpr float LOG2E = 1.4426950408889634f;
constexpr float QSCALE = 0.125f * LOG2E;
constexpr int NWAVES = 8, NTHREADS = 512;

constexpr size_t MiB = 1u << 20;
constexpr size_t WS_CTL = 0, CTL_ZERO_BYTES = 1 * MiB;
constexpr size_t WS_WIN = 2 * MiB;
constexpr size_t WS_WOUT = 26 * MiB;
constexpr size_t WS_WG = 34 * MiB;
constexpr size_t WS_WU = 66 * MiB;
constexpr size_t WS_WD = 98 * MiB;
constexpr size_t WS_LSEM0 = 1 * MiB;
constexpr size_t WS_KMEAN = 130 * MiB;
constexpr size_t WS_HB = 131 * MiB;
constexpr size_t WS_Q = 195 * MiB, WS_K = 259 * MiB, WS_V = 323 * MiB, WS_O = 387 * MiB;
constexpr size_t WS_ACT = WS_Q;
constexpr size_t WS_LSE = 451 * MiB;
constexpr size_t WS_LIST = 454 * MiB;
constexpr size_t WS_WLIST = 457 * MiB;
constexpr size_t WS_QLIST = WS_LIST;
constexpr size_t WS_PM = 463 * MiB;
constexpr size_t WS_LSEM1 = 511 * MiB;
constexpr size_t WS_END = 512 * MiB;
constexpr int QL_PER_BH = 126976;
constexpr int CW_MCNT = 2048;
constexpr int CW_CNT = 1024;
constexpr int CW_TCNT = 16384;
constexpr int CW_BAR = 4096;

constexpr int RING_BYTES = 131072;
constexpr int LDSCTL_OFF = 147456, MISC_OFF = LDSCTL_OFF + 320;
constexpr int LDS_BYTES = 148480;

__device__ __forceinline__ unsigned f2bf(float f) { unsigned u = __builtin_bit_cast(unsigned, f); return (u + 0x7fffu + ((u >> 16) & 1u)) >> 16; }
__device__ __forceinline__ unsigned pk2(float lo, float hi) { return f2bf(lo) | (f2bf(hi) << 16); }
__device__ __forceinline__ float bflo(unsigned w) { return __builtin_bit_cast(float, w << 16); }
__device__ __forceinline__ float bfhi(unsigned w) { return __builtin_bit_cast(float, w & 0xffff0000u); }
template <int M> __device__ __forceinline__ float swz_xor(float v) { return __builtin_bit_cast(float, __builtin_amdgcn_ds_swizzle(__builtin_bit_cast(int, v), 0x1f | (M << 10))); }
__device__ __forceinline__ void swap32(unsigned x, unsigned& lo_val, unsigned& hi_val) { unsigned y = x; asm volatile("" : "+v"(y)); auto rr = __builtin_amdgcn_permlane32_swap(x, y, false, false); lo_val = rr[0]; hi_val = rr[1]; }
__device__ __forceinline__ float sum_xor32(float v) { unsigned a, b; swap32(__builtin_bit_cast(unsigned, v), a, b); return __builtin_bit_cast(float, a) + __builtin_bit_cast(float, b); }
__device__ __forceinline__ float max_xor32(float v) { unsigned a, b; swap32(__builtin_bit_cast(unsigned, v), a, b); return fmaxf(__builtin_bit_cast(float, a), __builtin_bit_cast(float, b)); }
__device__ __forceinline__ float get_xor32(float v, int hi) { unsigned a, b; swap32(__builtin_bit_cast(unsigned, v), a, b); return __builtin_bit_cast(float, hi ? a : b); }
__device__ __forceinline__ int get_xor32i(int v, int hi) { unsigned a, b; swap32((unsigned)v, a, b); return (int)(hi ? a : b); }
template <int CTRL> __device__ __forceinline__ float dpp_mov(float v) { return __builtin_bit_cast(float, __builtin_amdgcn_update_dpp(0, __builtin_bit_cast(int, v), CTRL, 0xf, 0xf, false)); }
__device__ __forceinline__ float row_sum(float v) { v += dpp_mov<0xB1>(v); v += dpp_mov<0x4E>(v); v += dpp_mov<0x141>(v); v += dpp_mov<0x140>(v); return v; }
__device__ __forceinline__ float half_sum(float v) { v = row_sum(v); v += swz_xor<16>(v); return v; }
__device__ __forceinline__ float wave_sum(float v) { return sum_xor32(half_sum(v)); }
#define LDS_WAIT() asm volatile("s_waitcnt lgkmcnt(0)" ::: "memory")
#define LAUNDER_V(x) asm volatile("" : "+v"(x))
#define LAUNDER_S(x) asm volatile("" : "+s"(x))

namespace pg8 {
constexpr int BM = 256, BK = 64, HALF = 128, HTB = HALF * BK * 2, STAGE_BYTES = 8 * HTB, NXCD = 8, WGM = 8;
__host__ __device__ __forceinline__ int lds_byte(int r, int c) { const int st = (r >> 4) * 2 + (c >> 5), rr = r & 15, cc = c & 31, ob = rr * 64 + cc * 2; return st * 1024 + (ob ^ (((ob >> 9) & 1) << 5)); }
__host__ __device__ __forceinline__ void stage_rc(int b, int& R, int& C) { const int st = b / 1024, sb = b % 1024, swz = sb ^ (((sb >> 9) & 1) << 5); R = (st >> 1) * 16 + swz / 64; C = (st & 1) * 32 + (swz % 64) / 2; }
__host__ __device__ __forceinline__ int perm32(int rho) { const int n = rho >> 4, i = rho & 15; return 8 * (i >> 2) + 4 * n + (i & 3); }

struct Unit { int pm, pn, meta;
    __device__ __forceinline__ int bk() const { return meta & 31; } __device__ __forceinline__ int tib() const { return (meta >> 5) & 255; } __device__ __forceinline__ int nb() const { return meta >> 13; } };
struct Gemm { const char* A; const char* B; int lda, ldb, K; long tstepA, tstepB, hstepB; };

struct StaticOrder {
    int nM, nN, nwg, G, c;
    __host__ __device__ void init(int nM_, int nN_, int G_, int c_) { nM = nM_; nN = nN_; nwg = nM * nN; G = G_; c = c_; }
    __host__ __device__ bool next(int i, Unit& u) const {
        const long L = (long)i * G + c; if (L >= nwg) return false;
        int wgid = (int)L; { const int q = nwg / NXCD, r = nwg % NXCD, xcd = wgid % NXCD, off = wgid / NXCD; wgid = (xcd < r ? xcd * (q + 1) : r * (q + 1) + (xcd - r) * q) + off; }
        const int nig = WGM * nN, gid = wgid / nig, fm = gid * WGM, gsz = (nM - fm) < WGM ? (nM - fm) : WGM;
        u.pm = fm + ((wgid % nig) % gsz); u.pn = (wgid % nig) / gsz; return true;
    }
};

__device__ __forceinline__ unsigned cvt_pk_bf16(float lo, float hi) { unsigned r; asm volatile("v_cvt_pk_bf16_f32 %0, %1, %2" : "=v"(r) : "v"(lo), "v"(hi)); return r; }

struct EpiQKV {
    static constexpr bool PERM = true;
    bf16_t* O; size_t split_stride; float scale0;
    __device__ __forceinline__ void operator()(const f32x4 (&acc)[2][2][4][2], const Unit& u, int wr, int wc, int fr, int fq) const {
        asm volatile("" : "+v"(fr), "+v"(fq));
        const int row0 = u.pm * BM + wr * 64 + fr; int colt = u.pn * BM;
        const int t = colt / DM; bf16_t* base = O + (size_t)t * split_stride; colt -= t * DM; const float sc = (t == 0) ? scale0 : 1.f;
        const int col0 = colt + wc * 32 + 8 * fq;
#pragma unroll
        for (int ai = 0; ai < 2; ++ai)
#pragma unroll
            for (int m = 0; m < 4; ++m) { bf16_t* rowp = base + (size_t)(row0 + ai * HALF + m * 16) * DM + col0;
#pragma unroll
                for (int bj = 0; bj < 2; ++bj) { f32x4 v0 = acc[ai][bj][m][0] * sc, v1 = acc[ai][bj][m][1] * sc;
                    u32x4 w; w.x = cvt_pk_bf16(v0[0], v0[1]); w.y = cvt_pk_bf16(v0[2], v0[3]); w.z = cvt_pk_bf16(v1[0], v1[1]); w.w = cvt_pk_bf16(v1[2], v1[3]);
                    *(u32x4*)(rowp + bj * HALF) = w; } }
        if (u.pn == 4) {
            float* kmean = (float*)((unsigned char*)O - WS_Q + WS_KMEAN) + ((size_t)((u.pm >> 5) * 4) * 32 + (u.pm & 31)) * HD;
#pragma unroll
            for (int bj = 0; bj < 2; ++bj)
#pragma unroll
                for (int n = 0; n < 2; ++n)
#pragma unroll
                    for (int j = 0; j < 4; ++j) { float cs = 0.f;
#pragma unroll
                        for (int ai = 0; ai < 2; ++ai)
#pragma unroll
                            for (int m = 0; m < 4; ++m) cs += acc[ai][bj][m][n][j];
                        cs = row_sum(cs);
                        const int col = bj * HALF + wc * 32 + 8 * fq + 4 * n + j;
                        if (fr == 0) __hip_atomic_fetch_add(kmean + (size_t)(col >> 6) * 32 * HD + (col & 63), cs, __ATOMIC_RELAXED, __HIP_MEMORY_SCOPE_AGENT); }
        }
    }
};
struct EpiResAdd {
    static constexpr bool PERM = false;
    const float* base; float* out;
    __device__ __forceinline__ void operator()(const f32x4 (&acc)[2][2][4][2], const Unit& u, int wr, int wc, int fr, int fq) const {
        asm volatile("" : "+v"(fr), "+v"(fq));
        const int col0 = u.pn * BM + wc * 32 + 4 * fq;
#pragma unroll
        for (int ai = 0; ai < 2; ++ai)
#pragma unroll
            for (int m = 0; m < 4; ++m) { const size_t off = (size_t)(u.pm * BM + ai * HALF + wr * 64 + m * 16 + fr) * DM + col0;
#pragma unroll
                for (int bj = 0; bj < 2; ++bj)
#pragma unroll
                    for (int n = 0; n < 2; ++n) { const f32x4 bs = *(const f32x4*)(base + off + bj * HALF + n * 16); *(f32x4*)(out + off + bj * HALF + n * 16) = bs + acc[ai][bj][m][n]; } }
    }
};
struct EpiGateUpDense {
    static constexpr bool PERM = true;
    bf16_t* act; const float* comb;
    __device__ __forceinline__ void operator()(const f32x4 (&acc)[2][2][4][2], const Unit& u, int wr, int wc, int fr, int fq) const {
        asm volatile("" : "+v"(fr), "+v"(fq));
        const int e = u.pn >> 1, c0 = (u.pn & 1) * HALF;
        const int col0 = e * DEXP + c0 + wc * 32 + 8 * fq;
#pragma unroll
        for (int ai = 0; ai < 2; ++ai)
#pragma unroll
            for (int m = 0; m < 4; ++m) { const int row = u.pm * BM + ai * HALF + wr * 64 + m * 16 + fr;
                const float cw = comb[(size_t)row * NEXP + e];
                float o[8];
#pragma unroll
                for (int n = 0; n < 2; ++n)
#pragma unroll
                    for (int j = 0; j < 4; ++j) { const float g = acc[ai][0][m][n][j], up = acc[ai][1][m][n][j];
                        const float sg = g * __builtin_amdgcn_rcpf(1.f + __builtin_amdgcn_exp2f(-g * LOG2E));
                        o[n * 4 + j] = sg * up * cw; }
                u32x4 w; w.x = cvt_pk_bf16(o[0], o[1]); w.y = cvt_pk_bf16(o[2], o[3]); w.z = cvt_pk_bf16(o[4], o[5]); w.w = cvt_pk_bf16(o[6], o[7]);
                *(u32x4*)(act + (size_t)row * NACT + col0) = w; }
    }
};

template <class Epi, class Sched>
__device__ __forceinline__ void gemm_phase(LAS unsigned char* lds, const Gemm g, const Sched& S, const Epi& E, int wave_id) {
    int lane_l = (int)__builtin_amdgcn_mbcnt_hi(~0u, __builtin_amdgcn_mbcnt_lo(~0u, 0u)); asm volatile("" : "+v"(lane_l));
    const int wid = wave_id, lane = lane_l, tid = wid * 64 + lane, wr = wid >> 2, wc = wid & 3, fr = lane & 15, fq = lane >> 4;
    const int K = g.K, nt = K / BK;
    unsigned voffA[2], voffB[2];
#pragma unroll
    for (int i = 0; i < 2; ++i) { int R, C; stage_rc(tid * 16 + i * 8192, R, C); const int Rb = Epi::PERM ? ((R & ~31) + perm32(R & 31)) : R;
        voffA[i] = (unsigned)(R * g.lda + C) * 2u; voffB[i] = (unsigned)(Rb * g.ldb + C) * 2u; }
    const size_t kstep = (size_t)(BK * 2);
    const size_t hstepA = (size_t)HALF * g.lda * 2;
    const long hstepB = g.hstepB;
    const unsigned ldsw = (unsigned)wid * 1024u;
    const int aoff = lds_byte(wr * 64 + fr, fq * 8), boff = lds_byte(wc * 32 + fr, fq * 8);
#define PG8_SA(b, h) (((b) * 2 + (h)) * HTB)
#define PG8_SB(b, h) ((4 + (b) * 2 + (h)) * HTB)
#define PG8_STAGE(bufoff, gbase, voff) do { _Pragma("unroll") for (int _i = 0; _i < 2; ++_i) \
        __builtin_amdgcn_global_load_lds((const unsigned*)((const char*)(gbase) + (voff)[_i]), (LAS unsigned*)(lds + (bufoff) + ldsw + _i * 8192), 16, 0, 0); } while (0)
#define PG8_LDA(dst, b, h) do { _Pragma("unroll") for (int m = 0; m < 4; ++m) _Pragma("unroll") for (int k = 0; k < 2; ++k) dst[m][k] = *(const LAS bf16x8*)(lds + PG8_SA(b, h) + aoff + m * 2048 + k * 1024); } while (0)
#define PG8_LDB(dst, b, h) do { _Pragma("unroll") for (int n = 0; n < 2; ++n) _Pragma("unroll") for (int k = 0; k < 2; ++k) dst[n][k] = *(const LAS bf16x8*)(lds + PG8_SB(b, h) + boff + n * 2048 + k * 1024); } while (0)
#define PG8_MMA(ai, bj, At, Bt) do { __builtin_amdgcn_s_setprio(1); _Pragma("unroll") for (int m = 0; m < 4; ++m) _Pragma("unroll") for (int n = 0; n < 2; ++n) _Pragma("unroll") for (int k = 0; k < 2; ++k) \
        acc[ai][bj][m][n] = __builtin_amdgcn_mfma_f32_16x16x32_bf16(Bt[n][k], At[m][k], acc[ai][bj][m][n], 0, 0, 0); __builtin_amdgcn_s_setprio(0); } while (0)
#define PG8_WAIT_V(n) asm volatile("s_waitcnt vmcnt(" #n ")" ::: "memory")
#define PG8_WAIT_L(n) asm volatile("s_waitcnt lgkmcnt(" #n ")" ::: "memory")
#define PG8_BAR __builtin_amdgcn_s_barrier()
#define PG8_SCHED __builtin_amdgcn_sched_barrier(0)
    Unit cur, nxt; int ui = 0;
    if (!S.next(0, cur)) return;
    f32x4 acc[2][2][4][2];
#pragma unroll
    for (int a = 0; a < 2; ++a)
#pragma unroll
        for (int b = 0; b < 2; ++b)
#pragma unroll
            for (int m = 0; m < 4; ++m)
#pragma unroll
                for (int n = 0; n < 2; ++n) acc[a][b][m][n] = (f32x4){0.f, 0.f, 0.f, 0.f};
    bf16x8 At[4][2], B0[2][2], B1[2][2];
    const char* cA = g.A + (size_t)cur.pm * g.tstepA; const char* cB = g.B + (size_t)cur.pn * g.tstepB;
    PG8_STAGE(PG8_SB(0, 0), cB, voffB); PG8_STAGE(PG8_SB(0, 1), cB + hstepB, voffB); PG8_STAGE(PG8_SA(0, 0), cA, voffA); PG8_STAGE(PG8_SA(0, 1), cA + hstepA, voffA);
    if (wr == 1) PG8_BAR;
    PG8_WAIT_V(2); PG8_BAR;
    PG8_STAGE(PG8_SB(1, 0), cB + kstep, voffB); PG8_STAGE(PG8_SA(1, 0), cA + kstep, voffA); PG8_STAGE(PG8_SB(1, 1), cB + hstepB + kstep, voffB);
    PG8_WAIT_V(6); PG8_BAR;
    for (;;) {
        const bool has_next = S.next(ui + 1, nxt);
        const char* nA = has_next ? g.A + (size_t)nxt.pm * g.tstepA : cA; const char* nB = has_next ? g.B + (size_t)nxt.pn * g.tstepB : cB;
        for (int t = 0; t < nt; t += 2) {
            const bool last = (t == nt - 2);
            const char* a1 = cA + (size_t)(t + 1) * kstep;
            const char* a2 = last ? nA : cA + (size_t)(t + 2) * kstep; const char* b2 = last ? nB : cB + (size_t)(t + 2) * kstep;
            const char* a3 = a2 + kstep; const char* b3 = b2 + kstep;
            PG8_LDB(B0, 0, 0); PG8_LDB(B1, 0, 1); PG8_SCHED; PG8_LDA(At, 0, 0); PG8_STAGE(PG8_SA(1, 1), a1 + hstepA, voffA);
            PG8_WAIT_V(8); PG8_WAIT_L(0); PG8_BAR; PG8_MMA(0, 0, At, B0); PG8_MMA(0, 1, At, B1); PG8_BAR; PG8_SCHED;
            PG8_LDA(At, 0, 1); PG8_STAGE(PG8_SB(0, 0), b2, voffB); PG8_STAGE(PG8_SB(0, 1), b2 + hstepB, voffB); PG8_STAGE(PG8_SA(0, 0), a2, voffA);
            PG8_WAIT_V(8); PG8_WAIT_L(0); PG8_BAR; PG8_MMA(1, 0, At, B0); PG8_MMA(1, 1, At, B1); PG8_BAR; PG8_SCHED;
            PG8_LDB(B0, 1, 0); PG8_LDB(B1, 1, 1); PG8_SCHED; PG8_LDA(At, 1, 0); PG8_STAGE(PG8_SA(0, 1), a2 + hstepA, voffA);
            PG8_WAIT_V(8); PG8_WAIT_L(0); PG8_BAR; PG8_MMA(0, 0, At, B0); PG8_MMA(0, 1, At, B1); PG8_BAR; PG8_SCHED;
            PG8_LDA(At, 1, 1); PG8_STAGE(PG8_SB(1, 0), b3, voffB); PG8_STAGE(PG8_SB(1, 1), b3 + hstepB, voffB); PG8_STAGE(PG8_SA(1, 0), a3, voffA);
            PG8_WAIT_V(8); PG8_WAIT_L(0); PG8_BAR; PG8_MMA(1, 0, At, B0); PG8_MMA(1, 1, At, B1); PG8_BAR; PG8_SCHED;
        }
        if (wr == 0) PG8_BAR;
        E(acc, cur, wr, wc, fr, fq);
        if (!has_next) break;
#pragma unroll
        for (int a = 0; a < 2; ++a)
#pragma unroll
            for (int b = 0; b < 2; ++b)
#pragma unroll
                for (int m = 0; m < 4; ++m)
#pragma unroll
                    for (int n = 0; n < 2; ++n) acc[a][b][m][n] = (f32x4){0.f, 0.f, 0.f, 0.f};
        cur = nxt; cA = nA; cB = nB; ++ui;
        if (wr == 1) PG8_BAR;
    }
    PG8_WAIT_V(0);
    PG8_BAR;
#undef PG8_SA
#undef PG8_SB
#undef PG8_STAGE
#undef PG8_LDA
#undef PG8_LDB
#undef PG8_MMA
#undef PG8_WAIT_V
#undef PG8_WAIT_L
#undef PG8_BAR
#undef PG8_SCHED
}
template <class Epi, class Prob>
__device__ __forceinline__ void gemm_phase_x(LAS unsigned char* lds, const Prob& P, const Epi& E, int wave_id) {
    int lane_l = (int)__builtin_amdgcn_mbcnt_hi(~0u, __builtin_amdgcn_mbcnt_lo(~0u, 0u)); asm volatile("" : "+v"(lane_l));
    const int wid = wave_id, lane = lane_l, tid = wid * 64 + lane, wr = wid >> 2, wc = wid & 3, fr = lane & 15, fq = lane >> 4;
    const int K = P.K, nt = K / BK;
    unsigned voffB[2];
#pragma unroll
    for (int i = 0; i < 2; ++i) { int R, C; stage_rc(tid * 16 + i * 8192, R, C); const int Rb = Epi::PERM ? ((R & ~31) + perm32(R & 31)) : R; voffB[i] = (unsigned)(Rb * P.ldb + C) * 2u; }
    const size_t kstep = (size_t)(BK * 2);
    const long hstepB = P.hstepB;
    const unsigned ldsw = (unsigned)wid * 1024u;
    const int aoff = lds_byte(wr * 64 + fr, fq * 8), boff = lds_byte(wc * 32 + fr, fq * 8);
    LAS u32x4* stash = (LAS u32x4*)(lds + STAGE_BYTES + 1024) + tid;
#define PG8_SA(b, h) (((b) * 2 + (h)) * HTB)
#define PG8_SB(b, h) ((4 + (b) * 2 + (h)) * HTB)
#define PG8_STAGE(bufoff, gbase, voff) do { _Pragma("unroll") for (int _i = 0; _i < 2; ++_i) \
        __builtin_amdgcn_global_load_lds((const unsigned*)((const char*)(gbase) + (voff)[_i]), (LAS unsigned*)(lds + (bufoff) + ldsw + _i * 8192), 16, 0, 0); } while (0)
#define PG8_LDA(dst, b, h) do { _Pragma("unroll") for (int m = 0; m < 4; ++m) _Pragma("unroll") for (int k = 0; k < 2; ++k) dst[m][k] = *(const LAS bf16x8*)(lds + PG8_SA(b, h) + aoff + m * 2048 + k * 1024); } while (0)
#define PG8_LDB(dst, b, h) do { _Pragma("unroll") for (int n = 0; n < 2; ++n) _Pragma("unroll") for (int k = 0; k < 2; ++k) dst[n][k] = *(const LAS bf16x8*)(lds + PG8_SB(b, h) + boff + n * 2048 + k * 1024); } while (0)
#define PG8_MMA(ai, bj, At, Bt) do { __builtin_amdgcn_s_setprio(1); _Pragma("unroll") for (int m = 0; m < 4; ++m) _Pragma("unroll") for (int n = 0; n < 2; ++n) _Pragma("unroll") for (int k = 0; k < 2; ++k) \
        acc[ai][bj][m][n] = __builtin_amdgcn_mfma_f32_16x16x32_bf16(Bt[n][k], At[m][k], acc[ai][bj][m][n], 0, 0, 0); __builtin_amdgcn_s_setprio(0); } while (0)
#define PG8_WAIT_V(n) asm volatile("s_waitcnt vmcnt(" #n ")" ::: "memory")
#define PG8_WAIT_L(n) asm volatile("s_waitcnt lgkmcnt(" #n ")" ::: "memory")
#define PG8_BAR __builtin_amdgcn_s_barrier()
#define PG8_SCHED __builtin_amdgcn_sched_barrier(0)
#define PG8_AVOFF(dst, u) do { int t2_ = tid; asm volatile("" : "+v"(t2_)); _Pragma("unroll") for (int i_ = 0; i_ < 2; ++i_) { int R_, C_; stage_rc(t2_ * 16 + i_ * 8192, R_, C_); _Pragma("unroll") for (int h_ = 0; h_ < 2; ++h_) \
        dst[h_][i_] = (Prob::GATHER ? P.arow_off(u, h_, R_) : (unsigned)((h_ * HALF + R_) * P.lda) * 2u) + (unsigned)C_ * 2u; } } while (0)
    Unit cur, nxt; int ui = 0;
    if (!P.next(0, cur)) return;
    unsigned vA[2][2];
    PG8_AVOFF(vA, cur);
    f32x4 acc[2][2][4][2];
#pragma unroll
    for (int a = 0; a < 2; ++a)
#pragma unroll
        for (int b = 0; b < 2; ++b)
#pragma unroll
            for (int m = 0; m < 4; ++m)
#pragma unroll
                for (int n = 0; n < 2; ++n) acc[a][b][m][n] = (f32x4){0.f, 0.f, 0.f, 0.f};
    bf16x8 At[4][2], B0[2][2], B1[2][2];
    const char* cA = P.a_base(cur); const char* cB = P.b_base(cur);
    long csplit = Prob::KSPLIT ? P.bsplit(cur) : 0;
    if (Prob::WAITS) P.a_ready(cur, wid);
    PG8_STAGE(PG8_SB(0, 0), cB, voffB); PG8_STAGE(PG8_SB(0, 1), cB + hstepB, voffB); PG8_STAGE(PG8_SA(0, 0), cA, vA[0]); PG8_STAGE(PG8_SA(0, 1), cA, vA[1]);
    if (wr == 1) PG8_BAR;
    PG8_WAIT_V(2); PG8_BAR;
    PG8_STAGE(PG8_SB(1, 0), cB + kstep, voffB); PG8_STAGE(PG8_SA(1, 0), cA + kstep, vA[0]); PG8_STAGE(PG8_SB(1, 1), cB + hstepB + kstep, voffB);
    PG8_WAIT_V(6); PG8_BAR;
    for (;;) {
        const bool has_next = P.next(ui + 1, nxt);
        const char* nA = has_next ? P.a_base(nxt) : cA; const char* nB = has_next ? P.b_base(nxt) : cB;
        if (Prob::GATHER) { unsigned vN[2][2];
            if (has_next) { PG8_AVOFF(vN, nxt); } else { vN[0][0] = vA[0][0]; vN[0][1] = vA[0][1]; vN[1][0] = vA[1][0]; vN[1][1] = vA[1][1]; }
            *stash = (u32x4){vN[0][0], vN[0][1], vN[1][0], vN[1][1]}; }
        for (int t = 0; t < nt; t += 2) {
            const bool last = (t == nt - 2);
            if (Prob::WAITS && last && has_next) P.a_ready(nxt, wid);
            const char* a1 = cA + (size_t)(t + 1) * kstep;
            const char* a2 = last ? nA : cA + (size_t)(t + 2) * kstep;
            const char* b2 = last ? nB : cB + (size_t)(t + 2) * kstep + ((Prob::KSPLIT && (t + 2) >= (nt >> 1)) ? csplit : 0);
            const char* a3 = a2 + kstep; const char* b3 = b2 + kstep;
            PG8_LDB(B0, 0, 0); PG8_LDB(B1, 0, 1); PG8_SCHED; PG8_LDA(At, 0, 0); PG8_STAGE(PG8_SA(1, 1), a1, vA[1]);
            if (Prob::GATHER && last) { const u32x4 sv = *stash; vA[0][0] = sv.x; vA[0][1] = sv.y; vA[1][0] = sv.z; vA[1][1] = sv.w; }
            PG8_WAIT_V(8); PG8_WAIT_L(0); PG8_BAR; PG8_MMA(0, 0, At, B0); PG8_MMA(0, 1, At, B1); PG8_BAR; PG8_SCHED;
            PG8_LDA(At, 0, 1); PG8_STAGE(PG8_SB(0, 0), b2, voffB); PG8_STAGE(PG8_SB(0, 1), b2 + hstepB, voffB); PG8_STAGE(PG8_SA(0, 0), a2, vA[0]);
            PG8_WAIT_V(8); PG8_WAIT_L(0); PG8_BAR; PG8_MMA(1, 0, At, B0); PG8_MMA(1, 1, At, B1); PG8_BAR; PG8_SCHED;
            PG8_LDB(B0, 1, 0); PG8_LDB(B1, 1, 1); PG8_SCHED; PG8_LDA(At, 1, 0); PG8_STAGE(PG8_SA(0, 1), a2, vA[1]);
            PG8_WAIT_V(8); PG8_WAIT_L(0); PG8_BAR; PG8_MMA(0, 0, At, B0); PG8_MMA(0, 1, At, B1); PG8_BAR; PG8_SCHED;
            PG8_LDA(At, 1, 1); PG8_STAGE(PG8_SB(1, 0), b3, voffB); PG8_STAGE(PG8_SB(1, 1), b3 + hstepB, voffB); PG8_STAGE(PG8_SA(1, 0), a3, vA[0]);
            PG8_WAIT_V(8); PG8_WAIT_L(0); PG8_BAR; PG8_MMA(1, 0, At, B0); PG8_MMA(1, 1, At, B1); PG8_BAR; PG8_SCHED;
        }
        if (wr == 0) PG8_BAR;
        E(acc, cur, wr, wc, fr, fq);
        if (!has_next) break;
#pragma unroll
        for (int a = 0; a < 2; ++a)
#pragma unroll
            for (int b = 0; b < 2; ++b)
#pragma unroll
                for (int m = 0; m < 4; ++m)
#pragma unroll
                    for (int n = 0; n < 2; ++n) acc[a][b][m][n] = (f32x4){0.f, 0.f, 0.f, 0.f};
        cur = nxt; cA = nA; cB = nB; ++ui;
        if (Prob::KSPLIT) csplit = P.bsplit(cur);
        if (wr == 1) PG8_BAR;
    }
    PG8_WAIT_V(0);
    PG8_BAR;
#undef PG8_SA
#undef PG8_SB
#undef PG8_STAGE
#undef PG8_LDA
#undef PG8_LDB
#undef PG8_MMA
#undef PG8_WAIT_V
#undef PG8_WAIT_L
#undef PG8_BAR
#undef PG8_SCHED
#undef PG8_AVOFF
}

__device__ __forceinline__ int pair_a(int pi) { return pi < 3 ? 0 : (pi < 5 ? 1 : 2); }
__device__ __forceinline__ int pair_b(int pi) { return pi == 0 ? 1 : ((pi == 1 || pi == 3) ? 2 : 3); }
template <int MODE>
struct MoeProb {
    static constexpr bool GATHER = (MODE == 0), KSPLIT = (MODE == 1);
    const unsigned* cnt; const unsigned* list; const char* A; const char* B; int lda, ldb, K; long hstepB; int G, c; unsigned* tcnt;
    static constexpr bool WAITS = (MODE == 1);
    __device__ __forceinline__ void a_ready(const Unit& u, int wave) const {
        if (MODE == 1) {
            if (wave == 0) { unsigned polls = 0;
                while ((unsigned)__builtin_amdgcn_readfirstlane(__hip_atomic_load(tcnt + 64 * u.pm, __ATOMIC_RELAXED, __HIP_MEMORY_SCOPE_AGENT)) < 32u) {
                    if (++polls > (1u << 20)) break;
                    __builtin_amdgcn_s_sleep(2); }
                __builtin_amdgcn_fence(__ATOMIC_ACQUIRE, "agent");
                asm volatile("s_waitcnt vmcnt(0)" ::: "memory"); }
            asm volatile("" ::: "memory"); __builtin_amdgcn_s_barrier(); asm volatile("" ::: "memory");
        }
    }
    __device__ __forceinline__ bool next(int i, Unit& u) const {
        const long L = (long)i * G + c; const int tileidx = (int)(L >> 2);
        int accu = 0, bk = -1, tib = 0, nb = 0;
        for (int k = 0; k < 24; ++k) { const int n = (int)cnt[k]; const int tl = (n + 255) >> 8; if (bk < 0 && tileidx < accu + tl) { bk = k; tib = tileidx - accu; nb = n; } accu += tl; }
        if (bk < 0) return false;
        u.pm = tileidx; u.pn = (int)(L & 3); u.meta = bk | (tib << 5) | (nb << 13); return true;
    }
    __device__ __forceinline__ int expert(const Unit& u, int s) const { const int g = u.bk() / 6, pi = u.bk() % 6; return g * 4 + (s ? pair_b(pi) : pair_a(pi)); }
    __device__ __forceinline__ const char* a_base(const Unit& u) const { return MODE == 0 ? A : A + (size_t)u.pm * 256 * lda * 2; }
    __device__ __forceinline__ const char* b_base(const Unit& u) const {
        if (MODE == 0) return B + ((size_t)expert(u, u.pn >> 1) * DEXP + (size_t)(u.pn & 1) * HALF) * ldb * 2;
        return B + (size_t)u.pn * 256 * ldb * 2 + (size_t)expert(u, 0) * DEXP * 2;
    }
    __device__ __forceinline__ unsigned arow_off(const Unit& u, int h, int R) const { const int pos = u.tib() * 256 + h * HALF + R; const unsigned tok = pos < u.nb() ? list[(size_t)u.bk() * T + pos] : 0u; return tok * (unsigned)(lda * 2); }
    __device__ __forceinline__ long bsplit(const Unit& u) const { return ((long)(expert(u, 1) - expert(u, 0)) * DEXP - DEXP) * 2; }
};
struct EpiGateUpSparse {
    static constexpr bool PERM = true;
    bf16_t* act; const float* wlist; unsigned* tcnt;
    __device__ __forceinline__ void operator()(const f32x4 (&acc)[2][2][4][2], const Unit& u, int wr, int wc, int fr, int fq) const {
        asm volatile("" : "+v"(fr), "+v"(fq));
        const int s = u.pn >> 1, col0 = s * DEXP + (u.pn & 1) * HALF + wc * 32 + 8 * fq;
        const __amdgpu_buffer_rsrc_t rs_act = __builtin_amdgcn_make_buffer_rsrc((void*)act, (short)0, 0x7fffffff, 0x00020000);
#pragma unroll
        for (int ai = 0; ai < 2; ++ai)
#pragma unroll
            for (int m = 0; m < 4; ++m) { const int r = ai * HALF + wr * 64 + m * 16 + fr, pos = u.tib() * 256 + r;
                const float cw = pos < u.nb() ? wlist[((size_t)u.bk() * T + pos) * 2 + s] : 0.f;
                float o[8];
#pragma unroll
                for (int n = 0; n < 2; ++n)
#pragma unroll
                    for (int j = 0; j < 4; ++j) { const float g = acc[ai][0][m][n][j], up = acc[ai][1][m][n][j];
                        const float sg = g * __builtin_amdgcn_rcpf(1.f + __builtin_amdgcn_exp2f(-g * LOG2E));
                        o[n * 4 + j] = sg * up * cw; }
                u32x4 w; w.x = cvt_pk_bf16(o[0], o[1]); w.y = cvt_pk_bf16(o[2], o[3]); w.z = cvt_pk_bf16(o[4], o[5]); w.w = cvt_pk_bf16(o[6], o[7]);
                __builtin_amdgcn_raw_buffer_store_b128(w, rs_act, (int)((((unsigned)u.pm * 256u + (unsigned)r) * 512u + (unsigned)col0) * 2u), 0, 16);
                if (m & 1) asm volatile("" ::: "memory"); }
        asm volatile("s_waitcnt vmcnt(0)" ::: "memory");
        if ((fr | fq) == 0) __hip_atomic_fetch_add(tcnt + 64 * u.pm, 1u, __ATOMIC_RELAXED, __HIP_MEMORY_SCOPE_AGENT);
    }
};
struct EpiDownScatter {
    static constexpr bool PERM = false;
    float* x; const unsigned* list;
    __device__ __forceinline__ void operator()(const f32x4 (&acc)[2][2][4][2], const Unit& u, int wr, int wc, int fr, int fq) const {
        asm volatile("" : "+v"(fr), "+v"(fq));
        const int col0 = u.pn * BM + wc * 32 + 4 * fq;
        unsigned tok[8];
#pragma unroll
        for (int g = 0; g < 8; ++g) { const int pos = u.tib() * 256 + (g >> 2) * HALF + wr * 64 + (g & 3) * 16 + fr; tok[g] = pos < u.nb() ? list[(size_t)u.bk() * T + pos] : 0xffffffffu; }
#pragma unroll
        for (int g = 0; g < 8; ++g) { const int ai = g >> 2, m = g & 3;
            if (tok[g] != 0xffffffffu) { const size_t off = (size_t)tok[g] * DM + col0;
#pragma unroll
                for (int bj = 0; bj < 2; ++bj)
#pragma unroll
                    for (int n = 0; n < 2; ++n) { f32x4* p = (f32x4*)(x + off + bj * HALF + n * 16); *p = *p + acc[ai][bj][m][n]; } }
            if (g & 1) asm volatile("" ::: "memory"); }
    }
};
}

#define XB_TMO      128
#define XB_XCNT(j)  (256  + 64 * (j))
#define XB_XSUB(j)  (1280 + 64 * (j))
#define XB_XGEN(j)  (2304 + 64 * (j))
#define XB_TOP      3328
#define XB_TOPGEN   3392
#define XCD_BAR_WORDS 3456
#define XB_SPIN_CAP (1u << 18)
__device__ __forceinline__ unsigned xb_ld(unsigned* p)              { return __hip_atomic_load(p, __ATOMIC_RELAXED, __HIP_MEMORY_SCOPE_AGENT); }
__device__ __forceinline__ unsigned xb_add(unsigned* p, unsigned v) { return __hip_atomic_fetch_add(p, v, __ATOMIC_RELAXED, __HIP_MEMORY_SCOPE_AGENT); }
__device__ __forceinline__ unsigned xb_xcc_id() { return (unsigned)__builtin_amdgcn_s_getreg((3 << 11) | 20) & 0xFu; }
#define XB_SPIN(cond, bar) do { unsigned _sp = 0; while (cond) { __builtin_amdgcn_s_sleep(1); \
    if ((++_sp & 255u) == 0u) { if (xb_ld(&(bar)[XB_TMO])) break; if (_sp > XB_SPIN_CAP) { atomicAdd(&(bar)[XB_TMO], 1u); break; } } } } while (0)
struct XcdBarrier { unsigned* bar; unsigned x; volatile LAS unsigned* st; int wave; };
__device__ __forceinline__ bool xb_thread0(int wave) { return wave == 0 && __builtin_amdgcn_mbcnt_hi(~0u, __builtin_amdgcn_mbcnt_lo(~0u, 0u)) == 0u; }
__device__ __forceinline__ XcdBarrier xcd_barrier_post(unsigned* bar, volatile LAS unsigned* st, int wave) {
    XcdBarrier b; b.bar = bar; b.x = xb_xcc_id(); b.st = st; b.wave = wave;
    if (xb_thread0(wave)) (void)xb_add(&bar[XB_XCNT(b.x)], 1u);
    return b;
}
__device__ __forceinline__ void xcd_barrier_complete(unsigned* bar, unsigned x, unsigned& nloc, unsigned& nx) {
    const unsigned G = gridDim.x * gridDim.y * gridDim.z;
    unsigned sum, cnt, mine, sp = 0u;
    for (;;) {
        sum = 0u; cnt = 0u; mine = 0u;
#pragma unroll
        for (unsigned j = 0; j < 16; ++j) { const unsigned c = xb_ld(&bar[XB_XCNT(j)]); sum += c; cnt += (c > 0u) ? 1u : 0u; mine = (j == x) ? c : mine; }
        if (sum == G) break;
        __builtin_amdgcn_s_sleep(1);
        if ((++sp & 255u) == 0u) { if (xb_ld(&bar[XB_TMO])) break; if (sp > XB_SPIN_CAP) { atomicAdd(&bar[XB_TMO], 1u); break; } }
    }
    nloc = mine > 0u ? mine : 1u; nx = cnt > 0u ? cnt : 1u;
}
__device__ __forceinline__ void xcd_barrier(const XcdBarrier& b) {
    asm volatile("s_waitcnt vmcnt(0)" ::: "memory");
    __syncthreads();
    if (xb_thread0(b.wave)) {
        unsigned* bar = b.bar;
        __builtin_amdgcn_s_waitcnt(0);
        unsigned nloc = b.st[0], nx = b.st[1];
        if (nloc == 0u) { xcd_barrier_complete(bar, b.x, nloc, nx); b.st[0] = nloc; b.st[1] = nx; }
        const unsigned old = xb_add(&bar[XB_XSUB(b.x)], 1u);
        const unsigned gen = old / nloc;
        if (old + 1u == (gen + 1u) * nloc) {
            __builtin_amdgcn_fence(__ATOMIC_RELEASE, "agent");
            asm volatile("s_waitcnt vmcnt(0)" ::: "memory");
            const unsigned og = xb_add(&bar[XB_TOP], 1u);
            const unsigned tg = og / nx;
            if (og + 1u == (tg + 1u) * nx) xb_add(&bar[XB_TOPGEN], 1u);
            else XB_SPIN(xb_ld(&bar[XB_TOPGEN]) == tg, bar);
            __builtin_amdgcn_fence(__ATOMIC_ACQUIRE, "agent");
            xb_add(&bar[XB_XGEN(b.x)], 1u);
            asm volatile("s_waitcnt vmcnt(0)" ::: "memory");
        } else {
            XB_SPIN(xb_ld(&bar[XB_XGEN(b.x)]) == gen, bar);
            __builtin_amdgcn_fence(__ATOMIC_ACQUIRE, "agent");
            asm volatile("s_waitcnt vmcnt(0)" ::: "memory");
        }
    }
    __syncthreads();
}

struct Args {
    const float* x; const float* ln1_g; const float* w_in; const float* mix_g; const float* w_out; const float* ln2_g;
    const float* w_gr; const float* b_gr; const float* w_er; const float* b_er; const float* w_gate; const float* w_up; const float* w_down; const float* fin_g;
    float* out; unsigned char* ws; int ph_lo, ph_hi, li, pad;
};

__device__ __forceinline__ void transpose_item(const float* W, int K, int N, bf16_t* WT, int dpitch, int dcol, LAS float* scr, int item, int lane) {
    const int nblk = N / 32, kb = item / nblk, nb = item % nblk, k0 = 64 * kb, n0 = 32 * nb;
#pragma unroll 8
    for (int i = 0; i < 32; ++i) { const int kk = 2 * i + (lane >> 5); scr[kk * 33 + (lane & 31)] = W[(size_t)(k0 + kk) * N + n0 + (lane & 31)]; }
    LDS_WAIT(); asm volatile("" ::: "memory");
    const int c = lane & 7;
#pragma unroll
    for (int j = 0; j < 4; ++j) { const int n = (lane >> 3) + 8 * j; const LAS float* s = scr + (8 * c) * 33 + n;
        u32x4 o; o.x = pk2(s[0 * 33], s[1 * 33]); o.y = pk2(s[2 * 33], s[3 * 33]); o.z = pk2(s[4 * 33], s[5 * 33]); o.w = pk2(s[6 * 33], s[7 * 33]);
        *(u32x4*)(WT + (size_t)(n0 + n) * dpitch + dcol + k0 + 8 * c) = o; }
    LDS_WAIT(); asm volatile("" ::: "memory");
}
__device__ __forceinline__ void phase_prologue(const Args& a, LAS unsigned char* lds, int gw, int NGW, int wave, int lane) {
    LAS float* scr = (LAS float*)(lds + wave * 16384);
    constexpr int I_IN = (DM / 64) * (NQKV / 32);
    constexpr int I_OUT = (DM / 64) * (DM / 32);
    constexpr int I_G = (DM / 64) * (DEXP / 32);
    constexpr int I_D = (DEXP / 64) * (DM / 32);
    constexpr int N_IN = DEPTH * I_IN, N_OUT = DEPTH * I_OUT, N_G = DEPTH * NEXP * I_G, N_D = DEPTH * NEXP * I_D;
    constexpr int NITEMS = N_IN + N_OUT + 2 * N_G + N_D;
    bf16_t* WinT = (bf16_t*)(a.ws + WS_WIN); bf16_t* WoutT = (bf16_t*)(a.ws + WS_WOUT); bf16_t* WgT = (bf16_t*)(a.ws + WS_WG); bf16_t* WuT = (bf16_t*)(a.ws + WS_WU); bf16_t* WdT = (bf16_t*)(a.ws + WS_WD);
    for (int it = gw; it < NITEMS; it += NGW) {
        int r = it;
        if (r < N_IN) { const int l = r / I_IN; transpose_item(a.w_in + (size_t)l * DM * NQKV, DM, NQKV, WinT + (size_t)l * NQKV * DM, DM, 0, scr, r % I_IN, lane); continue; } r -= N_IN;
        if (r < N_OUT) { const int l = r / I_OUT; transpose_item(a.w_out + (size_t)l * DM * DM, DM, DM, WoutT + (size_t)l * DM * DM, DM, 0, scr, r % I_OUT, lane); continue; } r -= N_OUT;
        if (r < N_G) { const int le = r / I_G; transpose_item(a.w_gate + (size_t)le * DM * DEXP, DM, DEXP, WgT + (size_t)le * DEXP * DM, DM, 0, scr, r % I_G, lane); continue; } r -= N_G;
        if (r < N_G) { const int le = r / I_G; transpose_item(a.w_up + (size_t)le * DM * DEXP, DM, DEXP, WuT + (size_t)le * DEXP * DM, DM, 0, scr, r % I_G, lane); continue; } r -= N_G;
        { const int le = r / I_D, l = le / NEXP, e = le % NEXP; transpose_item(a.w_down + (size_t)le * DEXP * DM, DEXP, DM, WdT + (size_t)l * DM * NACT, NACT, e * DEXP, scr, r % I_D, lane); }
    }
}

__device__ __forceinline__ void phase_norm1(const float* x, const float* g, bf16_t* hb, int gw, int NGW, int lane, float* kmean_zero) {
    for (int i = gw * 64 + lane; i < BATCH * 4 * 32 * HD; i += NGW * 64) kmean_zero[i] = 0.f;
    f32x4 gv[4];
#pragma unroll
    for (int j = 0; j < 4; ++j) gv[j] = *((const f32x4*)g + lane + 64 * j);
    for (int m = gw; m < T; m += NGW) {
        const f32x4* xr = (const f32x4*)(x + (size_t)m * DM) + lane;
        f32x4 v[4]; float s = 0.f;
#pragma unroll
        for (int j = 0; j < 4; ++j) { v[j] = xr[64 * j]; s += (v[j].x * v[j].x + v[j].y * v[j].y) + (v[j].z * v[j].z + v[j].w * v[j].w); }
        const float rstd = 1.0f / sqrtf(wave_sum(s) * (1.f / DM) + NORM_EPS);
        u32x2* o8 = (u32x2*)(hb + (size_t)m * DM) + lane;
#pragma unroll
        for (int j = 0; j < 4; ++j) { u32x2 w; w.x = pk2(v[j].x * rstd * gv[j].x, v[j].y * rstd * gv[j].y); w.y = pk2(v[j].z * rstd * gv[j].z, v[j].w * rstd * gv[j].w); o8[64 * j] = w; }
    }
}
__device__ __forceinline__ void unpack8(float (&f)[8], const u32x4 w) { f[0] = bflo(w.x); f[1] = bfhi(w.x); f[2] = bflo(w.y); f[3] = bfhi(w.y); f[4] = bflo(w.z); f[5] = bfhi(w.z); f[6] = bflo(w.w); f[7] = bfhi(w.w); }
struct MixRow { u32x4 a, c0, c1, c2, p0, p1, p2; float l0, l1, l2, e0, e1, e2, e3; };
__device__ __forceinline__ void mix_load(MixRow& r, int m, const bf16_t* ob, const bf16_t* hb, const float* lse, const bf16_t* pm, const float* lsem0, const float* lsem1, int lane, int hh) {
    r.a = *((const u32x4*)(ob + (size_t)m * DM) + lane); r.c0 = *((const u32x4*)(ob + (size_t)m * DM + 512) + lane);
    r.c1 = *((const u32x4*)(hb + (size_t)m * DM) + lane); r.c2 = *((const u32x4*)(hb + (size_t)m * DM + 512) + lane);
    r.l0 = lse[(size_t)m * 8 + hh]; r.l1 = lse[(size_t)T * 8 + (size_t)m * 8 + hh]; r.l2 = lse[(size_t)2 * T * 8 + (size_t)m * 8 + hh];
    if (lane < 32) {
        r.p0 = *((const u32x4*)(pm + (size_t)m * 256) + lane); r.p1 = *((const u32x4*)(pm + ((size_t)T + m) * 256) + lane); r.p2 = *((const u32x4*)(pm + ((size_t)2 * T + m) * 256) + lane);
        r.e0 = lsem0[(size_t)m * 4 + hh]; r.e1 = lsem0[(size_t)T * 4 + (size_t)m * 4 + hh]; r.e2 = lsem1[(size_t)m * 4 + hh]; r.e3 = lsem1[(size_t)T * 4 + (size_t)m * 4 + hh]; }
}
__device__ __forceinline__ void phase_mixnorm(const bf16_t* ob, bf16_t* hb, const float* lse, const bf16_t* pm, const float* lsem0, const float* lsem1, const float* g, int gw, int NGW, int lane) {
    float g0[8], g1[8];
#pragma unroll
    for (int j = 0; j < 8; ++j) { g0[j] = g[8 * lane + j]; g1[j] = g[512 + 8 * lane + j]; }
    const int hh = lane >> 3;
    MixRow cur, nxt;
    if (gw < T) mix_load(cur, gw, ob, hb, lse, pm, lsem0, lsem1, lane, hh);
    for (int m = gw; m < T; m += NGW) {
        if (m + NGW < T) mix_load(nxt, m + NGW, ob, hb, lse, pm, lsem0, lsem1, lane, hh);
        float va[8]; unpack8(va, cur.a);
        if (lane < 32) {
            const float mx = fmaxf(fmaxf(cur.e0, cur.e1), fmaxf(cur.e2, cur.e3));
            float u0 = __builtin_amdgcn_exp2f(cur.e0 - mx), u1 = __builtin_amdgcn_exp2f(cur.e1 - mx), u2 = __builtin_amdgcn_exp2f(cur.e2 - mx), u3 = __builtin_amdgcn_exp2f(cur.e3 - mx);
            const float inv = 1.0f / ((u0 + u1) + (u2 + u3)); u0 *= inv; u1 *= inv; u2 *= inv; u3 *= inv;
            float y0[8], y1[8], y2[8]; unpack8(y0, cur.p0); unpack8(y1, cur.p1); unpack8(y2, cur.p2);
#pragma unroll
            for (int j = 0; j < 8; ++j) va[j] = (u0 * y0[j] + u1 * y1[j]) + (u2 * y2[j] + u3 * va[j]);
        }
        const float mx = fmaxf(cur.l0, fmaxf(cur.l1, cur.l2));
        float w0 = __builtin_amdgcn_exp2f(cur.l0 - mx), w1 = __builtin_amdgcn_exp2f(cur.l1 - mx), w2 = __builtin_amdgcn_exp2f(cur.l2 - mx);
        const float inv = 1.0f / (w0 + w1 + w2); w0 *= inv; w1 *= inv; w2 *= inv;
        float x0[8], x1[8], x2[8]; unpack8(x0, cur.c0); unpack8(x1, cur.c1); unpack8(x2, cur.c2);
        float vc[8];
        float sa = 0.f, sc = 0.f;
#pragma unroll
        for (int j = 0; j < 8; ++j) { vc[j] = w0 * x0[j] + w1 * x1[j] + w2 * x2[j]; sa += va[j] * va[j]; sc += vc[j] * vc[j]; }
        sa = half_sum(sa); sc = wave_sum(sc);
        const float ra = 1.0f / sqrtf(sa * (1.f / 256.f) + NORM_EPS), rc = 1.0f / sqrtf(sc * (1.f / 512.f) + NORM_EPS);
        u32x4 oa, oc;
        oa.x = pk2(va[0] * ra * g0[0], va[1] * ra * g0[1]); oa.y = pk2(va[2] * ra * g0[2], va[3] * ra * g0[3]); oa.z = pk2(va[4] * ra * g0[4], va[5] * ra * g0[5]); oa.w = pk2(va[6] * ra * g0[6], va[7] * ra * g0[7]);
        oc.x = pk2(vc[0] * rc * g1[0], vc[1] * rc * g1[1]); oc.y = pk2(vc[2] * rc * g1[2], vc[3] * rc * g1[3]); oc.z = pk2(vc[4] * rc * g1[4], vc[5] * rc * g1[5]); oc.w = pk2(vc[6] * rc * g1[6], vc[7] * rc * g1[7]);
        *((u32x4*)(hb + (size_t)m * DM) + lane) = oa; *((u32x4*)(hb + (size_t)m * DM + 512) + lane) = oc;
        cur = nxt;
    }
}
__device__ __forceinline__ void phase_route(const float* x, const float* g, const float* wgr, const float* bgr, const float* wer, const float* ber,
                                            bf16_t* hb, unsigned* cnt, unsigned* list, float* wlist, LAS unsigned char* lds, int v, int G, int wave, int lane) {
    const int tid = wave * 64 + lane;
    LAS f32x4* wl = (LAS f32x4*)lds;
    for (int idx = tid; idx < 5 * DM; idx += NTHREADS) { const int mtx = idx >> 10, d = idx & 1023; const float* src = (mtx == 0 ? wgr : wer + (size_t)(mtx - 1) * DM * 4) + d * 4;
        wl[mtx * 1024 + (d & 3) * 256 + (d >> 2)] = *(const f32x4*)src; }
    LAS unsigned* cl = (LAS unsigned*)(lds + 81920);
    LAS u32x2* info = (LAS u32x2*)(lds + 81920 + 256);
    LAS f32x2* infw = (LAS f32x2*)(lds + 81920 + 256 + 4096);
    if (tid < 64) cl[tid] = 0u;
    __syncthreads();
    const int rpw = (T + G - 1) / G, row0 = v * rpw;
    f32x4 gv[4];
#pragma unroll
    for (int j = 0; j < 4; ++j) gv[j] = *((const f32x4*)g + lane + 64 * j);
    const f32x4 bg = *(const f32x4*)bgr;
    f32x4 nx[4];
    { const int m0 = row0 + wave; if (wave < rpw && m0 < T) { const f32x4* xr = (const f32x4*)(x + (size_t)m0 * DM) + lane;
#pragma unroll
        for (int j = 0; j < 4; ++j) nx[j] = xr[64 * j]; } }
    for (int r = wave; r < rpw; r += NWAVES) {
        const int m = row0 + r; if (m >= T) break;
        f32x4 vv[4]; float s = 0.f;
#pragma unroll
        for (int j = 0; j < 4; ++j) { vv[j] = nx[j]; s += (vv[j].x * vv[j].x + vv[j].y * vv[j].y) + (vv[j].z * vv[j].z + vv[j].w * vv[j].w); }
        if (r + NWAVES < rpw && m + NWAVES < T) { const f32x4* xr = (const f32x4*)(x + (size_t)(m + NWAVES) * DM) + lane;
#pragma unroll
            for (int j = 0; j < 4; ++j) nx[j] = xr[64 * j]; }
        const float rstd = 1.0f / sqrtf(wave_sum(s) * (1.f / DM) + NORM_EPS);
        u32x2* o8 = (u32x2*)(hb + (size_t)m * DM) + lane;
#pragma unroll
        for (int j = 0; j < 4; ++j) { vv[j] = vv[j] * rstd * gv[j]; u32x2 w; w.x = pk2(vv[j].x, vv[j].y); w.y = pk2(vv[j].z, vv[j].w); o8[64 * j] = w; }
        f32x4 gl = (f32x4){0.f, 0.f, 0.f, 0.f};
#pragma unroll
        for (int j = 0; j < 4; ++j) { LAS f32x4* wp = wl + lane + 64 * j;
            gl += wp[0] * vv[j].x; gl += wp[256] * vv[j].y; gl += wp[512] * vv[j].z; gl += wp[768] * vv[j].w; }
        gl.x = wave_sum(gl.x) + bg.x; gl.y = wave_sum(gl.y) + bg.y; gl.z = wave_sum(gl.z) + bg.z; gl.w = wave_sum(gl.w) + bg.w;
        int gi = 0; float gm = gl.x;
        if (gl.y > gm) { gm = gl.y; gi = 1; } if (gl.z > gm) { gm = gl.z; gi = 2; } if (gl.w > gm) { gm = gl.w; gi = 3; }
        const float gden = __expf(gl.x - gm) + __expf(gl.y - gm) + __expf(gl.z - gm) + __expf(gl.w - gm);
        const float gw_ = 1.0f / gden;
        gi = __builtin_amdgcn_readfirstlane(gi);
        f32x4 el = (f32x4){0.f, 0.f, 0.f, 0.f};
#pragma unroll
        for (int j = 0; j < 4; ++j) { LAS f32x4* wp = wl + (1 + gi) * 1024 + lane + 64 * j;
            el += wp[0] * vv[j].x; el += wp[256] * vv[j].y; el += wp[512] * vv[j].z; el += wp[768] * vv[j].w; }
        const f32x4 be = *(const f32x4*)(ber + gi * 4);
        float e[4] = {wave_sum(el.x) + be.x, wave_sum(el.y) + be.y, wave_sum(el.z) + be.z, wave_sum(el.w) + be.w};
        int i1 = 0; float v1 = e[0];
#pragma unroll
        for (int k = 1; k < 4; ++k) if (e[k] > v1) { v1 = e[k]; i1 = k; }
        int i2 = -1; float v2 = -INFINITY;
#pragma unroll
        for (int k = 0; k < 4; ++k) if (k != i1 && e[k] > v2) { v2 = e[k]; i2 = k; }
        const float p2 = __expf(v2 - v1), inv = 1.0f / (1.0f + p2);
        const float w1 = inv * gw_, w2 = p2 * inv * gw_;
        const int ea = i1 < i2 ? i1 : i2, eb = i1 < i2 ? i2 : i1; const float wa = i1 < i2 ? w1 : w2, wb = i1 < i2 ? w2 : w1;
        const int pi = (ea == 0) ? (eb - 1) : (ea == 1 ? eb + 1 : 5), bk = gi * 6 + pi;
        if (lane == 0) { const unsigned rank = __hip_atomic_fetch_add(cl + bk, 1u, __ATOMIC_RELAXED, __HIP_MEMORY_SCOPE_WORKGROUP);
            info[r] = (u32x2){(unsigned)bk, rank}; infw[r] = (f32x2){wa, wb}; }
    }
    __syncthreads();
    if (tid < 24) cl[32 + tid] = __hip_atomic_fetch_add(cnt + tid, cl[tid], __ATOMIC_RELAXED, __HIP_MEMORY_SCOPE_AGENT);
    __syncthreads();
    if (tid < rpw && row0 + tid < T) { const u32x2 inf = info[tid]; const f32x2 wv = infw[tid]; const size_t slot = (size_t)inf.x * T + cl[32 + inf.x] + inf.y;
        list[slot] = (unsigned)(row0 + tid); *(f32x2*)(wlist + slot * 2) = wv; }
    __syncthreads();
}
__device__ __forceinline__ void phase_final(float* x, const float* g, int gw, int NGW, int lane) {
    f32x4 gv[4];
#pragma unroll
    for (int j = 0; j < 4; ++j) gv[j] = *((const f32x4*)g + lane + 64 * j);
    for (int m = gw; m < T; m += NGW) {
        f32x4* xr = (f32x4*)(x + (size_t)m * DM) + lane;
        f32x4 v[4]; float s = 0.f;
#pragma unroll
        for (int j = 0; j < 4; ++j) { v[j] = xr[64 * j]; s += (v[j].x * v[j].x + v[j].y * v[j].y) + (v[j].z * v[j].z + v[j].w * v[j].w); }
        const float rstd = 1.0f / sqrtf(wave_sum(s) * (1.f / DM) + NORM_EPS);
#pragma unroll
        for (int j = 0; j < 4; ++j) xr[64 * j] = v[j] * rstd * gv[j];
    }
}
__device__ __forceinline__ void phase_kmean(const bf16_t* kb, float* kmean, int gw, int NGW, int lane) {
    for (int it = gw; it < BATCH * 4 * 32; it += NGW) {
        const int b = it >> 7, h = (it >> 5) & 3, blk = it & 31;
        const bf16_t* base = kb + ((size_t)b * SEQ + (size_t)blk * 256) * DM + h * HD + (lane & 7) * 8;
        float acc[8] = {0.f, 0.f, 0.f, 0.f, 0.f, 0.f, 0.f, 0.f};
#pragma unroll 4
        for (int i = 0; i < 32; ++i) { const u32x4 w = *(const u32x4*)(base + (size_t)((lane >> 3) + 8 * i) * DM);
            acc[0] += bflo(w.x); acc[1] += bfhi(w.x); acc[2] += bflo(w.y); acc[3] += bfhi(w.y); acc[4] += bflo(w.z); acc[5] += bfhi(w.z); acc[6] += bflo(w.w); acc[7] += bfhi(w.w); }
#pragma unroll
        for (int j = 0; j < 8; ++j) { acc[j] += swz_xor<8>(acc[j]); acc[j] += swz_xor<16>(acc[j]); acc[j] = sum_xor32(acc[j]); }
        if (lane < 8) {
            float* o = kmean + (size_t)it * HD + lane * 8;
#pragma unroll
            for (int j = 0; j < 8; ++j) o[j] = acc[j] * (1.f / 256.f);
        }
    }
}

__device__ __forceinline__ void ld_row64(float (&r)[64], const bf16_t* p) {
#pragma unroll
    for (int c = 0; c < 8; ++c) { const u32x4 w = *((const u32x4*)p + c);
        r[8 * c + 0] = bflo(w.x); r[8 * c + 1] = bfhi(w.x); r[8 * c + 2] = bflo(w.y); r[8 * c + 3] = bfhi(w.y); r[8 * c + 4] = bflo(w.z); r[8 * c + 5] = bfhi(w.z); r[8 * c + 6] = bflo(w.w); r[8 * c + 7] = bfhi(w.w); }
}
__device__ __forceinline__ float dot_row64(const float (&q)[64], const bf16_t* p) {
    float s0 = 0.f, s1 = 0.f;
#pragma unroll
    for (int c = 0; c < 8; ++c) { const u32x4 w = *((const u32x4*)p + c);
        s0 += q[8 * c + 0] * bflo(w.x); s1 += q[8 * c + 1] * bfhi(w.x); s0 += q[8 * c + 2] * bflo(w.y); s1 += q[8 * c + 3] * bfhi(w.y);
        s0 += q[8 * c + 4] * bflo(w.z); s1 += q[8 * c + 5] * bfhi(w.z); s0 += q[8 * c + 6] * bflo(w.w); s1 += q[8 * c + 7] * bfhi(w.w); }
    return s0 + s1;
}
__device__ __forceinline__ void axpy_row64(float (&o)[64], float p, const bf16_t* vp) {
#pragma unroll
    for (int c = 0; c < 8; ++c) { const u32x4 w = *((const u32x4*)vp + c);
        o[8 * c + 0] += p * bflo(w.x); o[8 * c + 1] += p * bfhi(w.x); o[8 * c + 2] += p * bflo(w.y); o[8 * c + 3] += p * bfhi(w.y);
        o[8 * c + 4] += p * bflo(w.z); o[8 * c + 5] += p * bfhi(w.z); o[8 * c + 6] += p * bflo(w.w); o[8 * c + 7] += p * bfhi(w.w); }
}
__device__ __forceinline__ void st_row64(bf16_t* p, const float (&o)[64], float sc) {
#pragma unroll
    for (int c = 0; c < 8; ++c) { u32x4 w; w.x = pk2(o[8 * c] * sc, o[8 * c + 1] * sc); w.y = pk2(o[8 * c + 2] * sc, o[8 * c + 3] * sc); w.z = pk2(o[8 * c + 4] * sc, o[8 * c + 5] * sc); w.w = pk2(o[8 * c + 6] * sc, o[8 * c + 7] * sc); *((u32x4*)p + c) = w; }
}
#define OSM_STEP(sc, vrow) do { const float sc_ = (sc); if (sc_ > m_) { const float al = __builtin_amdgcn_exp2f(m_ - sc_); l_ *= al; _Pragma("unroll") for (int d_ = 0; d_ < 64; ++d_) o_[d_] *= al; m_ = sc_; } \
    const float p_ = __builtin_amdgcn_exp2f(sc_ - m_); l_ += p_; axpy_row64(o_, p_, (vrow)); } while (0)

__device__ __forceinline__ void naive_moba(const bf16_t* qb, const bf16_t* kb, const bf16_t* vb, const float* kmean, bf16_t* ob, int item, int tid) {
    const int b = item >> 6, h = (item >> 4) & 3, t = (item & 15) * 512 + tid, own = t >> 8;
    const size_t rowq = ((size_t)b * SEQ + t) * DM + h * HD;
    const bf16_t* kh = kb + (size_t)b * SEQ * DM + h * HD; const bf16_t* vh = vb + (size_t)b * SEQ * DM + h * HD;
    const float slope2 = exp2f(-2.0f * (float)(h + 1)) * LOG2E;
    float q_[64]; ld_row64(q_, qb + rowq);
    float bv0 = -INFINITY, bv1 = -INFINITY, bv2 = -INFINITY; int bi0 = -1, bi1 = -1, bi2 = -1;
    const float* km = kmean + (size_t)(b * 4 + h) * 32 * HD;
    for (int n = 0; n < own; ++n) {
        float gsum = 0.f;
#pragma unroll
        for (int d = 0; d < 64; ++d) gsum += q_[d] * km[n * HD + d];
        if (gsum > bv0) { bv2 = bv1; bi2 = bi1; bv1 = bv0; bi1 = bi0; bv0 = gsum; bi0 = n; }
        else if (gsum > bv1) { bv2 = bv1; bi2 = bi1; bv1 = gsum; bi1 = n; }
        else if (gsum > bv2) { bv2 = gsum; bi2 = n; }
    }
    float o_[64];
#pragma unroll
    for (int d = 0; d < 64; ++d) o_[d] = 0.f;
    float m_ = -INFINITY, l_ = 0.f;
    for (int s = 0; s < 3; ++s) {
        const int blk = (s == 0) ? bi0 : (s == 1) ? bi1 : bi2;
        if (blk < 0) continue;
        for (int j = 0; j < 256; ++j) { const int pos = blk * 256 + j;
            const float sc = dot_row64(q_, kh + (size_t)pos * DM) - slope2 * (float)(t - pos);
            OSM_STEP(sc, vh + (size_t)pos * DM); }
    }
    for (int pos = own * 256; pos <= t; ++pos) {
        const float sc = dot_row64(q_, kh + (size_t)pos * DM) - slope2 * (float)(t - pos);
        OSM_STEP(sc, vh + (size_t)pos * DM); }
    st_row64(ob + rowq, o_, 1.0f / l_);
}
__device__ __forceinline__ void naive_sb(const bf16_t* qb, const bf16_t* kb, const bf16_t* vb, bf16_t* ob, int item, int tid) {
    const int b = item >> 6, h = 4 + ((item >> 4) & 3), t = (item & 15) * 512 + tid;
    const size_t rowq = ((size_t)b * SEQ + t) * DM + h * HD;
    const bf16_t* kh = kb + (size_t)b * SEQ * DM + h * HD; const bf16_t* vh = vb + (size_t)b * SEQ * DM + h * HD;
    float q_[64]; ld_row64(q_, qb + rowq);
    float o_[64];
#pragma unroll
    for (int d = 0; d < 64; ++d) o_[d] = 0.f;
    float tail = 0.f;
    for (int s = t - 1; s >= 0 && tail > -150.f; --s) {
        const float z = dot_row64(q_, kh + (size_t)s * DM);
        const float lp = __builtin_amdgcn_logf(1.0f + __builtin_amdgcn_exp2f(-fabsf(z)));
        const float lnot = -(fmaxf(z, 0.f) + lp);
        const float aw = __builtin_amdgcn_exp2f(z + lnot + tail);
        axpy_row64(o_, aw, vh + (size_t)s * DM);
        tail += lnot;
    }
    st_row64(ob + rowq, o_, 1.0f);
}
__device__ __forceinline__ void naive_dil(const bf16_t* qb, const bf16_t* kb, const bf16_t* vb, bf16_t* ob, bf16_t* hb2, float* lse, int item, int tid) {
    const int b = item >> 7, h = 8 + ((item >> 4) & 7), t = (item & 15) * 512 + tid;
    const size_t rowq = ((size_t)b * SEQ + t) * DM + h * HD;
    const bf16_t* kh = kb + (size_t)b * SEQ * DM + h * HD; const bf16_t* vh = vb + (size_t)b * SEQ * DM + h * HD;
    const float slope2 = exp2f(-(float)(h - 8 + 1)) * LOG2E;
    float q_[64]; ld_row64(q_, qb + rowq);
    float o_[64];
#pragma unroll
    for (int d = 0; d < 64; ++d) o_[d] = 0.f;
    float m_ = -INFINITY, l_ = 0.f;
    for (int c = 0; c < 3; ++c) {
        const int dil = (c == 0) ? 1 : (c == 1) ? 4 : 16;
        for (int dl = 0; dl <= 128; ++dl) { const int pos = t - dl * dil; if (pos < 0) break;
            const float sc = dot_row64(q_, kh + (size_t)pos * DM) - slope2 * (float)(dl * dil);
            OSM_STEP(sc, vh + (size_t)pos * DM); }
    }
    st_row64(ob + rowq, o_, 1.0f / l_);
    { const size_t tok = (size_t)b * SEQ + t; const u32x4 z4 = {0u, 0u, 0u, 0u};
#pragma unroll
      for (int c = 0; c < 8; ++c) { *((u32x4*)(hb2 + tok * DM + (h - 8) * HD) + c) = z4; *((u32x4*)(hb2 + tok * DM + 512 + (h - 8) * HD) + c) = z4; }
      lse[tok * 8 + (h - 8)] = 0.f; lse[(size_t)T * 8 + tok * 8 + (h - 8)] = -1.0e30f; lse[(size_t)2 * T * 8 + tok * 8 + (h - 8)] = -1.0e30f; }
}

namespace att {
typedef float f32x16 __attribute__((ext_vector_type(16)));
typedef short s16x4 __attribute__((ext_vector_type(4)));
typedef short v4i16_t __attribute__((ext_vector_type(4)));
typedef __bf16 bf16x2_t __attribute__((ext_vector_type(2)));
constexpr int L_BUF = 16384;
constexpr int L_WSF = 2 * L_BUF;
constexpr int L_OST = L_WSF + 8 * 256;
constexpr int L_FLG = L_OST + 8 * 4096;
constexpr int L_END = L_FLG + 64;
constexpr float M_INIT = -1.0e30f;
#define ATT_MFMA(a, b, c) __builtin_amdgcn_mfma_f32_32x32x16_bf16((a), (b), (c), 0, 0, 0)

__device__ __forceinline__ unsigned cvtpk(float lo, float hi) { f32x2 v = {lo, hi}; bf16x2_t b = __builtin_convertvector(v, bf16x2_t); return __builtin_bit_cast(unsigned, b); }
__device__ __forceinline__ s16x4 vtr(LAS unsigned char* p) { return __builtin_bit_cast(s16x4, __builtin_amdgcn_ds_read_tr16_b64_v4i16((LAS v4i16_t*)p)); }

struct Wave { int lane, r32, hi, wid; LAS unsigned char* lds; LAS float* wsf; LAS unsigned char* ost; int vlo; };
__device__ __forceinline__ Wave make_wave(LAS unsigned char* lds, int tid, int wsf_off = L_WSF, int ost_off = L_OST) {
    Wave w; w.lane = tid & 63; w.r32 = w.lane & 31; w.hi = w.lane >> 5; w.wid = __builtin_amdgcn_readfirstlane(tid >> 6); w.lds = lds;
    w.wsf = (LAS float*)(lds + wsf_off) + w.wid * 64; w.ost = lds + ost_off + w.wid * 4096;
    w.vlo = ((w.lane >> 4) & 1) * 32 + (w.lane & 3) * 8 + (4 * w.hi + ((w.lane & 15) >> 2)) * 64;
    return w;
}
struct Stage { u32x4 k, v; };
template <class RowK, class RowV> __device__ __forceinline__ void stage_load(Stage& s, const Wave& w, const RowK& rowk, const RowV& rowv) {
    s.k = *(const u32x4*)(rowk(w.lane) + w.wid * 8);
    s.v = *(const u32x4*)(rowv(16 * (w.wid & 3) + (w.lane >> 2)) + (w.wid >> 2) * 32 + (w.lane & 3) * 8);
}
__device__ __forceinline__ void stage_write(const Stage& s, const Wave& w, int buf) {
    *(LAS u32x4*)(w.lds + buf * L_BUF + w.wid * 1024 + w.lane * 16) = s.k;
    *(LAS u32x4*)(w.lds + buf * L_BUF + 8192 + w.wid * 1024 + w.lane * 16) = s.v;
}
__device__ __forceinline__ f32x16 qk_sub(const Wave& w, int buf, int sub, const bf16x8 (&qf)[4], float init) {
    f32x16 acc;
#pragma unroll
    for (int r = 0; r < 16; ++r) acc[r] = init;
    LAS unsigned char* kp = w.lds + buf * L_BUF + w.hi * 1024 + (32 * sub + w.r32) * 16;
#pragma unroll
    for (int ks = 0; ks < 4; ++ks) { const bf16x8 kf = *(LAS bf16x8*)(kp + ks * 2048); acc = ATT_MFMA(kf, qf[ks], acc); }
    return acc;
}
__device__ __forceinline__ void pv_sub(const Wave& w, int buf, int sub, const f32x16& p, f32x16 (&o)[2]) {
    bf16x8 pk[2];
#pragma unroll
    for (int s = 0; s < 2; ++s) { u32x4 t; t.x = cvtpk(p[8 * s], p[8 * s + 1]); t.y = cvtpk(p[8 * s + 2], p[8 * s + 3]); t.z = cvtpk(p[8 * s + 4], p[8 * s + 5]); t.w = cvtpk(p[8 * s + 6], p[8 * s + 7]); pk[s] = __builtin_bit_cast(bf16x8, t); }
    LAS unsigned char* vb = w.lds + buf * L_BUF + 8192 + w.vlo;
#pragma unroll
    for (int db = 0; db < 2; ++db)
#pragma unroll
        for (int s = 0; s < 2; ++s) { LAS unsigned char* vp = vb + db * 4096 + (4 * sub + 2 * s) * 512;
            const s16x4 lo = vtr(vp), hh = vtr(vp + 512);
            const bf16x8 vf = __builtin_shufflevector(lo, hh, 0, 1, 2, 3, 4, 5, 6, 7);
            o[db] = ATT_MFMA(pk[s], vf, o[db]); }
}
struct VFrags { s16x4 f[2][2][2]; };
__device__ __forceinline__ void load_vfrags(const Wave& w, int buf, int sub, VFrags& v) {
    LAS unsigned char* vb = w.lds + buf * L_BUF + 8192 + w.vlo;
#pragma unroll
    for (int db = 0; db < 2; ++db)
#pragma unroll
        for (int s = 0; s < 2; ++s) { LAS unsigned char* vp = vb + db * 4096 + (4 * sub + 2 * s) * 512; v.f[db][s][0] = vtr(vp); v.f[db][s][1] = vtr(vp + 512); }
}
__device__ __forceinline__ void pv_frags(const VFrags& v, const f32x16& p, f32x16 (&o)[2]) {
    bf16x8 pk[2];
#pragma unroll
    for (int s = 0; s < 2; ++s) { u32x4 t; t.x = cvtpk(p[8 * s], p[8 * s + 1]); t.y = cvtpk(p[8 * s + 2], p[8 * s + 3]); t.z = cvtpk(p[8 * s + 4], p[8 * s + 5]); t.w = cvtpk(p[8 * s + 6], p[8 * s + 7]); pk[s] = __builtin_bit_cast(bf16x8, t); }
#pragma unroll
    for (int db = 0; db < 2; ++db)
#pragma unroll
        for (int s = 0; s < 2; ++s) { const bf16x8 vf = __builtin_shufflevector(v.f[db][s][0], v.f[db][s][1], 0, 1, 2, 3, 4, 5, 6, 7); o[db] = ATT_MFMA(pk[s], vf, o[db]); }
}
__device__ __forceinline__ void scale_rows(const Wave& w, f32x16 (&o)[2], float f) {
    if (w.hi == 0) w.wsf[w.r32] = f;
#pragma unroll
    for (int g = 0; g < 4; ++g) { const f32x4 fv = *(LAS f32x4*)(w.wsf + 8 * g + 4 * w.hi);
#pragma unroll
        for (int i = 0; i < 4; ++i) { o[0][4 * g + i] *= fv[i]; o[1][4 * g + i] *= fv[i]; } }
}
__device__ __forceinline__ void softmax_sub(const Wave& w, f32x16& s, float& m, float& lsum, f32x16 (&o)[2]) {
    float tm = fmaxf(fmaxf(s[0], s[1]), fmaxf(s[2], s[3]));
#pragma unroll
    for (int r = 4; r < 16; r += 4) tm = fmaxf(tm, fmaxf(fmaxf(s[r], s[r + 1]), fmaxf(s[r + 2], s[r + 3])));
    tm = max_xor32(tm);
    const float mn = fmaxf(m, tm);
    if (__any(mn > m)) { const float al = __builtin_amdgcn_exp2f(m - mn); lsum *= al; scale_rows(w, o, al); m = mn; }
    float acc = 0.f;
#pragma unroll
    for (int r = 0; r < 16; ++r) { s[r] = __builtin_amdgcn_exp2f(s[r] - m); acc += s[r]; }
    lsum += acc;
}
__device__ __forceinline__ void mask_band(f32x16& s, int delta0, int W) {
#pragma unroll
    for (int r = 0; r < 16; ++r) { const int dl = delta0 - ((r & 3) + 8 * (r >> 2)); if ((unsigned)dl > (unsigned)W) s[r] = -INFINITY; }
}
constexpr float SM_THR = 8.0f;
struct SubDesc { bool act; int delta; int W; };
template <int NSUB>
__device__ __forceinline__ void softmax_step(const Wave& w, int buf, const bf16x8 (&qf)[4], const bf16x8& kidx, const bf16x8& slp, float slope, const SubDesc (&sd)[NSUB],
                                             float& m, float& lsum, f32x16 (&o)[2], bool& first) {
    f32x16 s[NSUB];
    bool any_act = false;
#pragma unroll
    for (int i = 0; i < NSUB; ++i) if (sd[i].act) { any_act = true; s[i] = qk_sub(w, buf, i, qf, -slope * (float)sd[i].delta - m); s[i] = ATT_MFMA(kidx, slp, s[i]); }
    if (!any_act) return;
    float tm = -INFINITY;
#pragma unroll
    for (int i = 0; i < NSUB; ++i) if (sd[i].act) {
        if (sd[i].W >= 0) mask_band(s[i], sd[i].delta - 4 * w.hi, sd[i].W);
        float t = fmaxf(fmaxf(s[i][0], s[i][1]), fmaxf(s[i][2], s[i][3]));
#pragma unroll
        for (int r = 4; r < 16; r += 4) t = fmaxf(t, fmaxf(fmaxf(s[i][r], s[i][r + 1]), fmaxf(s[i][r + 2], s[i][r + 3])));
        tm = fmaxf(tm, t); }
    tm = max_xor32(tm);
    if (first || __any(tm > SM_THR)) {
        const float d = first ? (tm > -1.0e30f ? tm : 0.f) : fmaxf(tm, 0.f);
#pragma unroll
        for (int i = 0; i < NSUB; ++i) if (sd[i].act) {
#pragma unroll
            for (int r = 0; r < 16; ++r) s[i][r] -= d; }
        if (!first) { const float al = __builtin_amdgcn_exp2f(-d); lsum *= al; scale_rows(w, o, al); }
        m += d; first = false;
    }
    VFrags vf[NSUB];
#pragma unroll
    for (int i = 0; i < NSUB; ++i) if (sd[i].act) load_vfrags(w, buf, i, vf[i]);
#pragma unroll
    for (int i = 0; i < NSUB; ++i) if (sd[i].act) { float acc = 0.f;
#pragma unroll
        for (int r = 0; r < 16; ++r) { s[i][r] = __builtin_amdgcn_exp2f(s[i][r]); acc += s[i][r]; }
        lsum += acc; }
#pragma unroll
    for (int i = 0; i < NSUB; ++i) if (sd[i].act) pv_frags(vf[i], s[i], o);
}
__device__ __forceinline__ void bias_frags(const Wave& w, float slope, bf16x8& kidx, bf16x8& slp) {
    const unsigned kb = f2bf((float)w.r32), sh = f2bf(slope), sl = f2bf(slope - __builtin_bit_cast(float, sh << 16));
    const u32x4 a = {w.hi == 0 ? (kb | (kb << 16)) : 0u, 0u, 0u, 0u}, b = {w.hi == 0 ? (sh | (sl << 16)) : 0u, 0u, 0u, 0u};
    kidx = __builtin_bit_cast(bf16x8, a); slp = __builtin_bit_cast(bf16x8, b);
}
template <class RowO> __device__ __forceinline__ void store_o(const Wave& w, const f32x16 (&o)[2], const RowO& rowo) {
    LAS unsigned short* stg = (LAS unsigned short*)w.ost;
#pragma unroll
    for (int r = 0; r < 16; ++r) { const int q = (r & 3) + 8 * (r >> 2) + 4 * w.hi;
#pragma unroll
        for (int db = 0; db < 2; ++db) stg[q * 64 + db * 32 + w.r32] = (unsigned short)f2bf(o[db][r]); }
#pragma unroll
    for (int i = 0; i < 4; ++i) { const int row = i * 8 + (w.lane >> 3), ch = w.lane & 7; const u32x4 v = *(LAS u32x4*)((LAS unsigned char*)stg + row * 128 + ch * 16);
        bf16_t* dst = rowo(row); if (dst) *(u32x4*)(dst + ch * 8) = v; }
}
__device__ __forceinline__ void load_q(bf16x8 (&qf)[4], const bf16_t* qrow, int hi) {
#pragma unroll
    for (int ks = 0; ks < 4; ++ks) qf[ks] = *(const bf16x8*)(qrow + 16 * ks + 8 * hi);
}

constexpr int W_WSF = 98304, W_OST = W_WSF + 2048, W_ENUM = W_OST + 32768;
template <int NC> struct Pref { u32x4 k[NC], v[NC]; bf16x8 q[4]; };
template <int NC, class RowF> __device__ __forceinline__ void win_issue(Pref<NC>& P, const Wave& w, const bf16_t* kbase, const bf16_t* vbase, const RowF& rowoff, const bf16_t* qrow) {
#pragma unroll
    for (int c = 0; c < NC; ++c) { P.k[c] = *(const u32x4*)(kbase + rowoff(64 * c + 8 * w.wid + (w.lane >> 3)) + (w.lane & 7) * 8);
        P.v[c] = *(const u32x4*)(vbase + rowoff(64 * c + 16 * (w.wid & 3) + (w.lane >> 2)) + (w.wid >> 2) * 32 + (w.lane & 3) * 8); }
    load_q(P.q, qrow, w.hi);
}
template <int NC> __device__ __forceinline__ void win_commit(const Pref<NC>& P, const Wave& w) {
    constexpr int NK = 64 * NC;
#pragma unroll
    for (int c = 0; c < NC; ++c) { const int key = 64 * c + 8 * w.wid + (w.lane >> 3);
        *(LAS u32x4*)(w.lds + key * 128 + ((((w.lane & 7) ^ (key >> 1)) & 7) * 16)) = P.k[c];
        *(LAS u32x4*)(w.lds + NK * 128 + (w.wid >> 2) * (NK * 64) + (8 * c + 2 * (w.wid & 3)) * 512 + w.lane * 16) = P.v[c]; }
}
template <int NK> __device__ __forceinline__ f32x16 qk_win(const Wave& w, int u, const bf16x8 (&qf)[4], float init) {
    f32x16 acc;
#pragma unroll
    for (int r = 0; r < 16; ++r) acc[r] = init;
    LAS unsigned char* kp = w.lds + (32 * u + w.r32) * 128; const int x = (w.r32 >> 1) & 7;
#pragma unroll
    for (int ks = 0; ks < 4; ++ks) { const bf16x8 kf = *(LAS bf16x8*)(kp + (((2 * ks + w.hi) ^ x) * 16)); acc = ATT_MFMA(kf, qf[ks], acc); }
    return acc;
}
template <int NK> __device__ __forceinline__ void load_vfrags_win(const Wave& w, int u, VFrags& v) {
    LAS unsigned char* vb = w.lds + NK * 128 + w.vlo;
#pragma unroll
    for (int db = 0; db < 2; ++db)
#pragma unroll
        for (int s = 0; s < 2; ++s) { LAS unsigned char* vp = vb + db * (NK * 64) + (4 * u + 2 * s) * 512; v.f[db][s][0] = vtr(vp); v.f[db][s][1] = vtr(vp + 512); }
}
struct WSub { bool act; int u; int delta; int W; };
template <int NK>
__device__ __forceinline__ void softmax_win(const Wave& w, const bf16x8 (&qf)[4], const bf16x8& kidx, const bf16x8& slp, float slope, const WSub (&sd)[2], float& m, float& lsum, f32x16 (&o)[2], bool& first) {
    f32x16 s[2];
    bool any_act = false;
#pragma unroll
    for (int i = 0; i < 2; ++i) if (sd[i].act) { any_act = true; s[i] = qk_win<NK>(w, sd[i].u, qf, -slope * (float)sd[i].delta - m); s[i] = ATT_MFMA(kidx, slp, s[i]); }
    if (!any_act) return;
    float tm = -INFINITY;
#pragma unroll
    for (int i = 0; i < 2; ++i) if (sd[i].act) {
        if (sd[i].W >= 0) mask_band(s[i], sd[i].delta - 4 * w.hi, sd[i].W);
        float t = fmaxf(fmaxf(s[i][0], s[i][1]), fmaxf(s[i][2], s[i][3]));
#pragma unroll
        for (int r = 4; r < 16; r += 4) t = fmaxf(t, fmaxf(fmaxf(s[i][r], s[i][r + 1]), fmaxf(s[i][r + 2], s[i][r + 3])));
        tm = fmaxf(tm, t); }
    tm = max_xor32(tm);
    if (first || __any(tm > SM_THR)) {
        const float d = first ? (tm > -1.0e30f ? tm : 0.f) : fmaxf(tm, 0.f);
#pragma unroll
        for (int i = 0; i < 2; ++i) if (sd[i].act) {
#pragma unroll
            for (int r = 0; r < 16; ++r) s[i][r] -= d; }
        if (!first) { const float al = __builtin_amdgcn_exp2f(-d); lsum *= al; scale_rows(w, o, al); }
        m += d; first = false;
    }
#pragma unroll
    for (int i = 0; i < 2; ++i) if (sd[i].act) { VFrags vf; load_vfrags_win<NK>(w, sd[i].u, vf);
        float acc = 0.f;
#pragma unroll
        for (int r = 0; r < 16; ++r) { s[i][r] = __builtin_amdgcn_exp2f(s[i][r]); acc += s[i][r]; }
        lsum += acc;
        pv_frags(vf, s[i], o); }
}

__device__ __forceinline__ size_t ql_off(int bh, int j) { return (size_t)bh * QL_PER_BH + (size_t)(8192 * j - 128 * j * (j + 1)); }
__device__ __forceinline__ float* lsem_ptr(float* l0, float* l1, int slot) { return (slot < 2 ? l0 : l1) + (size_t)(slot & 1) * T * 4; }

struct Top3 { int i0, i1, i2; };
__device__ __forceinline__ Top3 moba_top3(const Wave& w, const bf16x8 (&qf)[4], const float* KMEAN, int b, int h, int own) {
    int i0 = -1, i1 = -1, i2 = -1;
    if (own > 0) {
    f32x16 g;
#pragma unroll
    for (int r = 0; r < 16; ++r) g[r] = 0.f;
    const float* km = KMEAN + ((size_t)(b * 4 + h) * 32 + w.r32) * HD + 8 * w.hi;
#pragma unroll
    for (int ks = 0; ks < 4; ++ks) { const f32x4 a0 = *(const f32x4*)(km + 16 * ks), a1 = *(const f32x4*)(km + 16 * ks + 4);
        const float x[8] = {a0.x, a0.y, a0.z, a0.w, a1.x, a1.y, a1.z, a1.w}; unsigned hw[4], lw[4];
#pragma unroll
        for (int j = 0; j < 4; ++j) { const unsigned h0 = f2bf(x[2 * j]), h1 = f2bf(x[2 * j + 1]); hw[j] = h0 | (h1 << 16);
            lw[j] = pk2(x[2 * j] - __builtin_bit_cast(float, h0 << 16), x[2 * j + 1] - __builtin_bit_cast(float, h1 << 16)); }
        const u32x4 hv = {hw[0], hw[1], hw[2], hw[3]}, lv = {lw[0], lw[1], lw[2], lw[3]};
        g = ATT_MFMA(__builtin_bit_cast(bf16x8, hv), qf[ks], g); g = ATT_MFMA(__builtin_bit_cast(bf16x8, lv), qf[ks], g); }
    float v0 = -INFINITY, v1 = -INFINITY, v2 = -INFINITY;
#pragma unroll
    for (int r = 0; r < 16; ++r) { const int blk = (r & 3) + 8 * (r >> 2) + 4 * w.hi; const float val = (blk < own) ? g[r] : -INFINITY;
        if (val > v0) { v2 = v1; i2 = i1; v1 = v0; i1 = i0; v0 = val; i0 = blk; } else if (val > v1) { v2 = v1; i2 = i1; v1 = val; i1 = blk; } else if (val > v2) { v2 = val; i2 = blk; } }
    const float pv_[3] = {get_xor32(v0, w.hi), get_xor32(v1, w.hi), get_xor32(v2, w.hi)}; const int pi_[3] = {get_xor32i(i0, w.hi), get_xor32i(i1, w.hi), get_xor32i(i2, w.hi)};
#pragma unroll
    for (int k = 0; k < 3; ++k) { const float val = pv_[k]; const int blk = pi_[k];
        if (val > v0 || (val == v0 && blk < i0)) { v2 = v1; i2 = i1; v1 = v0; i1 = i0; v0 = val; i0 = blk; }
        else if (val > v1 || (val == v1 && blk < i1)) { v2 = v1; i2 = i1; v1 = val; i1 = blk; }
        else if (val > v2 || (val == v2 && blk < i2)) { v2 = val; i2 = blk; } }
    }
    Top3 t; t.i0 = i0; t.i1 = i1; t.i2 = i2; return t;
}
__device__ __forceinline__ void moba_gate_unit(LAS unsigned char* lds, const bf16_t* QB, const float* KMEAN, unsigned* mcnt, unsigned* qlist, bf16_t* PM, float* LSEM0, float* LSEM1, int b, int h, int own, int tid) {
    const Wave w = make_wave(lds, tid);
    const size_t rowbase = (size_t)b * SEQ; const int qpos = own * 256 + 32 * w.wid + w.r32, bh = b * 4 + h;
    bf16x8 qf[4]; load_q(qf, QB + (rowbase + qpos) * DM + h * HD, w.hi);
    const Top3 t3 = moba_top3(w, qf, KMEAN, b, h, own); const int s0 = t3.i0, s1 = t3.i1, s2 = t3.i2;
    LAS unsigned* cl = (LAS unsigned*)(lds + W_ENUM);
    if (tid < 64) cl[tid] = 0u;
    __syncthreads();
    unsigned r0 = 0u, r1 = 0u, r2 = 0u;
    if (w.hi == 0) {
        if (s0 >= 0) r0 = __hip_atomic_fetch_add(cl + s0, 1u, __ATOMIC_RELAXED, __HIP_MEMORY_SCOPE_WORKGROUP);
        if (s1 >= 0) r1 = __hip_atomic_fetch_add(cl + s1, 1u, __ATOMIC_RELAXED, __HIP_MEMORY_SCOPE_WORKGROUP);
        if (s2 >= 0) r2 = __hip_atomic_fetch_add(cl + s2, 1u, __ATOMIC_RELAXED, __HIP_MEMORY_SCOPE_WORKGROUP);
    }
    __syncthreads();
    if (tid < 32) { const unsigned c = cl[tid]; cl[32 + tid] = c ? __hip_atomic_fetch_add(mcnt + bh * 32 + tid, c, __ATOMIC_RELAXED, __HIP_MEMORY_SCOPE_AGENT) : 0u; }
    __syncthreads();
    if (w.hi == 0) {
        const size_t tok = rowbase + qpos;
#define MOBA_EMIT(k, sk, rk) do { if (sk >= 0) qlist[ql_off(bh, sk) + cl[32 + sk] + rk] = (unsigned)qpos | ((unsigned)(k) << 13); \
            else { lsem_ptr(LSEM0, LSEM1, k)[tok * 4 + h] = -1.0e30f;          \
                u32x4* pz = (u32x4*)(PM + ((size_t)(k) * T + tok) * 256 + h * HD); const u32x4 z4 = {0u, 0u, 0u, 0u}; \
                _Pragma("unroll") for (int c = 0; c < 8; ++c) pz[c] = z4; } } while (0)
        MOBA_EMIT(0, s0, r0); MOBA_EMIT(1, s1, r1); MOBA_EMIT(2, s2, r2);
#undef MOBA_EMIT
    }
    __syncthreads();
}
struct OwnU { int b, h, own; };
__device__ __forceinline__ void own_issue(Pref<4>& P, const Wave& w, const OwnU& u, const bf16_t* QB, const bf16_t* KB, const bf16_t* VB) {
    const size_t rowbase = (size_t)u.b * SEQ; const int q0 = u.own * 256;
    win_issue<4>(P, w, KB + (rowbase + q0) * DM + u.h * HD, VB + (rowbase + q0) * DM + u.h * HD, [&](int key) { return (size_t)key * DM; }, QB + (rowbase + q0 + 32 * w.wid + w.r32) * DM + u.h * HD);
}
template <class F> __device__ __forceinline__ void own_compute(const Wave& w, const OwnU& u, const bf16x8 (&qf)[4], bf16_t* OB, float* LSEM0, float* LSEM1, const F& between) {
    const size_t rowbase = (size_t)u.b * SEQ; const int q0 = u.own * 256, ql = 32 * w.wid + w.r32;
    const float slope2 = exp2f(-2.0f * (float)(u.h + 1)) * LOG2E;
    bf16x8 kidx, slp; bias_frags(w, slope2, kidx, slp);
    f32x16 o[2];
#pragma unroll
    for (int r = 0; r < 16; ++r) { o[0][r] = 0.f; o[1][r] = 0.f; }
    float m = 0.f, lsum = 0.f; bool first = true;
#pragma unroll
    for (int p = 0; p < 4; ++p) { WSub sd[2];
#pragma unroll
        for (int i = 0; i < 2; ++i) { const int su = w.wid - 2 * p - i; sd[i].act = su >= 0; sd[i].u = su; sd[i].delta = ql - 32 * su; sd[i].W = (su == w.wid) ? 0x7fffffff : -1; }
        softmax_win<256>(w, qf, kidx, slp, slope2, sd, m, lsum, o, first); }
    between();
    const float l = sum_xor32(lsum);
    scale_rows(w, o, 1.0f / l);
    bf16_t* orow = OB + (rowbase + q0 + 32 * w.wid) * DM + u.h * HD;
    store_o(w, o, [&](int r) { return orow + (size_t)r * DM; });
    if (w.hi == 0) lsem_ptr(LSEM0, LSEM1, 3)[(rowbase + q0 + ql) * 4 + u.h] = m + __builtin_amdgcn_logf(l);
}
struct GatU { int b, h, j, cnt, chunk; const unsigned* ql; };
__device__ __forceinline__ unsigned gat_entry(const Wave& w, const GatU& u, bool& valid) { const int idx = u.chunk * 256 + 32 * w.wid + w.r32; valid = idx < u.cnt; return u.ql[valid ? idx : u.chunk * 256]; }
__device__ __forceinline__ void gat_issue(Pref<4>& P, const Wave& w, const GatU& u, const bf16_t* QB, const bf16_t* KB, const bf16_t* VB) {
    const size_t rowbase = (size_t)u.b * SEQ; bool valid; const unsigned e = gat_entry(w, u, valid);
    win_issue<4>(P, w, KB + (rowbase + u.j * 256) * DM + u.h * HD, VB + (rowbase + u.j * 256) * DM + u.h * HD, [&](int key) { return (size_t)key * DM; }, QB + (rowbase + (e & 8191u)) * DM + u.h * HD);
}
template <class F> __device__ __forceinline__ void gat_compute(const Wave& w, const GatU& u, const bf16x8 (&qf)[4], bf16_t* PM, float* LSEM0, float* LSEM1, const F& between) {
    const size_t rowbase = (size_t)u.b * SEQ; bool valid; const unsigned e = gat_entry(w, u, valid);
    const int qpos = (int)(e & 8191u), slot = (int)(e >> 13);
    const float slope2 = exp2f(-2.0f * (float)(u.h + 1)) * LOG2E;
    bf16x8 kidx, slp; bias_frags(w, slope2, kidx, slp);
    f32x16 o[2];
#pragma unroll
    for (int r = 0; r < 16; ++r) { o[0][r] = 0.f; o[1][r] = 0.f; }
    float m = 0.f, lsum = 0.f; bool first = true;
#pragma unroll
    for (int p = 0; p < 4; ++p) { WSub sd[2];
#pragma unroll
        for (int i = 0; i < 2; ++i) { const int su = 7 - 2 * p - i; sd[i].act = true; sd[i].u = su; sd[i].delta = qpos - (u.j * 256 + 32 * su); sd[i].W = -1; }
        softmax_win<256>(w, qf, kidx, slp, slope2, sd, m, lsum, o, first); }
    between();
    const float l = sum_xor32(lsum);
    scale_rows(w, o, l > 0.f ? 1.0f / l : 0.f);
    LAS int* code = (LAS int*)(w.wsf + 32);
    if (w.hi == 0) code[w.r32] = valid ? (int)((size_t)slot * T + rowbase + qpos) : -1;
    store_o(w, o, [&](int r) { const int c = code[r]; return c >= 0 ? PM + (size_t)c * 256 + u.h * HD : (bf16_t*)nullptr; });
    if (w.hi == 0 && valid) lsem_ptr(LSEM0, LSEM1, slot)[(rowbase + qpos) * 4 + u.h] = l > 0.f ? m + __builtin_amdgcn_logf(l) : -1.0e30f;
}

__device__ __forceinline__ void sb_unit(LAS unsigned char* lds, const bf16_t* QB, const bf16_t* KB, const bf16_t* VB, bf16_t* OB, int b, int h, int qt, int tid) {
    const Wave w = make_wave(lds, tid);
    const size_t rowbase = (size_t)b * SEQ; const int q0 = qt * 256, qpos = q0 + 32 * w.wid + w.r32;
    const bf16_t* kh = KB + rowbase * DM + h * HD; const bf16_t* vh = VB + rowbase * DM + h * HD;
    bf16x8 qf[4]; load_q(qf, QB + (rowbase + qpos) * DM + h * HD, w.hi);
    f32x16 o[2];
#pragma unroll
    for (int r = 0; r < 16; ++r) { o[0][r] = 0.f; o[1][r] = 0.f; }
    float carry = 0.f;
    bool done = false;
    volatile LAS unsigned* flg = (volatile LAS unsigned*)(lds + L_FLG);
    const int ti0 = q0 / 64 + 3;
    Stage sg;
    { const int kp = ti0 * 64; stage_load(sg, w, [&](int key) { return kh + (size_t)(kp + key) * DM; }, [&](int key) { return vh + (size_t)(kp + key) * DM; }); }
    stage_write(sg, w, 0);
    __syncthreads();
    for (int st = 0;; ++st) {
        const int buf = st & 1, ti = ti0 - st;
        if (ti > 0) { const int kp = (ti - 1) * 64; stage_load(sg, w, [&](int key) { return kh + (size_t)(kp + key) * DM; }, [&](int key) { return vh + (size_t)(kp + key) * DM; }); }
        if (!done) {
#pragma unroll
            for (int sub = 1; sub >= 0; --sub) {
                const int D = (q0 / 32 + w.wid) - (2 * ti + sub);
                if (D < 0) continue;
                const int delta0 = qpos - (64 * ti + 32 * sub) - 4 * w.hi;
                f32x16 z = qk_sub(w, buf, sub, qf, 0.f);
                f32x16 L;
#pragma unroll
                for (int r = 0; r < 16; ++r) { const float lp = __builtin_amdgcn_logf(1.0f + __builtin_amdgcn_exp2f(-fabsf(z[r]))); L[r] = -(fmaxf(z[r], 0.f) + lp); }
                if (D == 0) {
#pragma unroll
                    for (int r = 0; r < 16; ++r) { const int dl = delta0 - ((r & 3) + 8 * (r >> 2)); if (dl < 1) { L[r] = 0.f; z[r] = -INFINITY; } }
                }
                float G[4], PG[4];
#pragma unroll
                for (int g = 0; g < 4; ++g) { G[g] = (L[4 * g] + L[4 * g + 1]) + (L[4 * g + 2] + L[4 * g + 3]); PG[g] = get_xor32(G[g], w.hi); }
                float run = carry;
#pragma unroll
                for (int g = 3; g >= 0; --g) { const float t3 = run + (w.hi == 0 ? PG[g] : 0.f), t2 = t3 + L[4 * g + 3], t1 = t2 + L[4 * g + 2], t0 = t1 + L[4 * g + 1];
                    z[4 * g + 3] = __builtin_amdgcn_exp2f(z[4 * g + 3] + L[4 * g + 3] + t3); z[4 * g + 2] = __builtin_amdgcn_exp2f(z[4 * g + 2] + L[4 * g + 2] + t2);
                    z[4 * g + 1] = __builtin_amdgcn_exp2f(z[4 * g + 1] + L[4 * g + 1] + t1); z[4 * g] = __builtin_amdgcn_exp2f(z[4 * g] + L[4 * g] + t0);
                    run += G[g] + PG[g]; }
                carry = run;
                pv_sub(w, buf, sub, z, o);
            }
            done = __all(carry < -150.f);
        }
        if (w.lane == 0) flg[buf * 8 + w.wid] = done ? 1u : 0u;
        if (ti > 0) stage_write(sg, w, buf ^ 1);
        __syncthreads();
        unsigned all = 1u;
#pragma unroll
        for (int k = 0; k < 8; ++k) all &= flg[buf * 8 + k];
        if (all || ti == 0) break;
    }
    bf16_t* orow = OB + (rowbase + q0 + 32 * w.wid) * DM + h * HD;
    store_o(w, o, [&](int r) { return orow + (size_t)r * DM; });
    __syncthreads();
}

struct PrefK6 { u32x4 k[6]; bf16x8 q[4]; }; struct PrefV6 { u32x4 v[6]; };
template <class RowF> __device__ __forceinline__ void win_issue_k6(PrefK6& P, const Wave& w, const bf16_t* kbase, const RowF& rowoff, const bf16_t* qrow) {
#pragma unroll
    for (int c = 0; c < 6; ++c) P.k[c] = *(const u32x4*)(kbase + rowoff(64 * c + 8 * w.wid + (w.lane >> 3)) + (w.lane & 7) * 8);
    load_q(P.q, qrow, w.hi);
}
template <class RowF> __device__ __forceinline__ void win_issue_v6(PrefV6& P, const Wave& w, const bf16_t* vbase, const RowF& rowoff) {
#pragma unroll
    for (int c = 0; c < 6; ++c) P.v[c] = *(const u32x4*)(vbase + rowoff(64 * c + 16 * (w.wid & 3) + (w.lane >> 2)) + (w.wid >> 2) * 32 + (w.lane & 3) * 8);
}
__device__ __forceinline__ void win_commit_k6(const PrefK6& P, const Wave& w) {
#pragma unroll
    for (int c = 0; c < 6; ++c) { const int key = 64 * c + 8 * w.wid + (w.lane >> 3); *(LAS u32x4*)(w.lds + key * 128 + ((((w.lane & 7) ^ (key >> 1)) & 7) * 16)) = P.k[c]; }
}
__device__ __forceinline__ void win_commit_v6(const PrefV6& P, const Wave& w) {
    constexpr int NK = 384;
#pragma unroll
    for (int c = 0; c < 6; ++c) *(LAS u32x4*)(w.lds + NK * 128 + (w.wid >> 2) * (NK * 64) + (8 * c + 2 * (w.wid & 3)) * 512 + w.lane * 16) = P.v[c];
}
struct DilU { int b, h, dil, res, i2, c; };
__device__ __forceinline__ DilU dil_decode(int u) { const int n = u & 31, bhc = u >> 5, c = bhc % 3, bh = bhc / 3; DilU d; d.b = bh >> 3; d.h = 8 + (bh & 7); d.c = c;
    d.dil = (c == 0) ? 1 : (c == 1) ? 4 : 16; d.res = (c == 0) ? 0 : (c == 1) ? (n >> 3) : (n >> 1); d.i2 = (c == 0) ? n : (c == 1) ? (n & 7) : (n & 1); return d; }
__device__ __forceinline__ void dil_issue_k(PrefK6& P, const Wave& w, const DilU& u, const bf16_t* QB, const bf16_t* KB) {
    const size_t rowbase = (size_t)u.b * SEQ; const int Q0 = 256 * u.i2, qj = Q0 + 32 * w.wid + w.r32; const size_t rstride = (size_t)u.dil * DM;
    win_issue_k6(P, w, KB + (rowbase + u.res) * DM + u.h * HD, [&](int key) { const int kj = Q0 - 128 + key; return (size_t)(kj < 0 ? 0 : kj) * rstride; },
                 QB + (rowbase + u.res + (size_t)qj * u.dil) * DM + u.h * HD);
}
__device__ __forceinline__ void dil_issue_v(PrefV6& P, const Wave& w, const DilU& u, const bf16_t* VB) {
    const size_t rowbase = (size_t)u.b * SEQ; const int Q0 = 256 * u.i2; const size_t rstride = (size_t)u.dil * DM;
    win_issue_v6(P, w, VB + (rowbase + u.res) * DM + u.h * HD, [&](int key) { const int kj = Q0 - 128 + key; return (size_t)(kj < 0 ? 0 : kj) * rstride; });
}
template <class F> __device__ __forceinline__ void dil_compute(const Wave& w, const DilU& u, const bf16x8 (&qf)[4], bf16_t* OB, bf16_t* HB2, float* LSE, const F& between) {
    const size_t rowbase = (size_t)u.b * SEQ; const int Q0 = 256 * u.i2, ql = 32 * w.wid + w.r32;
    const float slope2d = exp2f(-(float)(u.h - 8 + 1)) * LOG2E * (float)u.dil;
    bf16x8 kidx, slp; bias_frags(w, slope2d, kidx, slp);
    f32x16 o[2];
#pragma unroll
    for (int r = 0; r < 16; ++r) { o[0][r] = 0.f; o[1][r] = 0.f; }
    float m = 0.f, lsum = 0.f; bool first = true;
#pragma unroll
    for (int p = 0; p < 3; ++p) { WSub sd[2];
#pragma unroll
        for (int i = 0; i < 2; ++i) { const int D = 2 * p + i, su = w.wid + 4 - D; sd[i].act = (D <= 4) && (Q0 - 128 + 32 * su >= 0); sd[i].u = su; sd[i].delta = ql + 128 - 32 * su; sd[i].W = (D == 0 || D == 4) ? 128 : -1; }
        softmax_win<384>(w, qf, kidx, slp, slope2d, sd, m, lsum, o, first); }
    between();
    const float l = sum_xor32(lsum);
    scale_rows(w, o, 1.0f / l);
    bf16_t* PO = (u.c == 0) ? OB + 512 : HB2 + (u.c - 1) * 512;
    const size_t tok0 = rowbase + u.res + (size_t)(Q0 + 32 * w.wid) * u.dil;
    store_o(w, o, [&](int r) { return PO + (tok0 + (size_t)r * u.dil) * DM + (u.h - 8) * HD; });
    if (w.hi == 0) (LSE + (size_t)u.c * T * 8)[(tok0 + (size_t)w.r32 * u.dil) * 8 + (u.h - 8)] = m + __builtin_amdgcn_logf(l);
}

__device__ __forceinline__ void moba_gate_phase(LAS unsigned char* lds, const bf16_t* QB, const float* KMEAN, unsigned* mcnt, unsigned* qlist, bf16_t* PM, float* LSEM0, float* LSEM1, int v, int G, int tid) {
    for (int u = v; u < 512; u += G) { const int own = u & 31, bh = u >> 5; moba_gate_unit(lds, QB, KMEAN, mcnt, qlist, PM, LSEM0, LSEM1, bh >> 2, bh & 3, own, tid); }
}
struct AttnArgs { const bf16_t* QB; const bf16_t* KB; const bf16_t* VB; bf16_t* OB; bf16_t* HB2; float* LSE; const unsigned* mcnt; const unsigned* qlist; bf16_t* PM; float* LSEM0; float* LSEM1; };
__device__ __forceinline__ void attn_phase(LAS unsigned char* lds, const AttnArgs& A, int v, int G, int tid) {
    const Wave w = make_wave(lds, tid, W_WSF, W_OST);
    LAS int* cntl = (LAS int*)(lds + W_ENUM); LAS int* pa = cntl + 512; LAS int* pb = pa + 512;
    const int myc = (int)A.mcnt[tid], myu = (myc + 255) >> 8;
    cntl[tid] = myc; pa[tid] = myu;
    __syncthreads();
#pragma unroll 1
    for (int d = 1; d < 512; d <<= 1) { const int x = pa[tid] + (tid >= d ? pa[tid - d] : 0); pb[tid] = x; __syncthreads(); LAS int* t_ = pa; pa = pb; pb = t_; }
    const int total = pa[511];
    auto gat_decode = [&](int u) { int lo = 0, hi = 511;
        while (lo < hi) { const int mid = (lo + hi) >> 1; if (pa[mid] > u) hi = mid; else lo = mid + 1; }
        const int i = lo, c = cntl[i], bh = i >> 5; GatU g; g.b = bh >> 2; g.h = bh & 3; g.j = i & 31; g.cnt = c; g.chunk = u - (pa[i] - ((c + 255) >> 8)); g.ql = A.qlist + ql_off(bh, g.j); return g; };
    {   Pref<4> P; int u = v; GatU cur, nxt;
        if (u < total) { cur = gat_decode(u); gat_issue(P, w, cur, A.QB, A.KB, A.VB); }
        for (; u < total; u += G) {
            __syncthreads();
            win_commit<4>(P, w); bf16x8 qf[4] = {P.q[0], P.q[1], P.q[2], P.q[3]};
            __syncthreads();
            const bool more = u + G < total; if (more) nxt = gat_decode(u + G);
            gat_compute(w, cur, qf, A.PM, A.LSEM0, A.LSEM1, [&]() { if (more) gat_issue(P, w, nxt, A.QB, A.KB, A.VB); });
            cur = nxt; } }
    {   Pref<4> P; int u = v; OwnU cur, nxt;
        auto dec = [&](int uu) { OwnU o_; const int bh = uu >> 5; o_.b = bh >> 2; o_.h = bh & 3; o_.own = uu & 31; return o_; };
        if (u < 512) { cur = dec(u); own_issue(P, w, cur, A.QB, A.KB, A.VB); }
        for (; u < 512; u += G) {
            __syncthreads();
            win_commit<4>(P, w); bf16x8 qf[4] = {P.q[0], P.q[1], P.q[2], P.q[3]};
            __syncthreads();
            const bool more = u + G < 512; if (more) nxt = dec(u + G);
            own_compute(w, cur, qf, A.OB, A.LSEM0, A.LSEM1, [&]() { if (more) own_issue(P, w, nxt, A.QB, A.KB, A.VB); });
            cur = nxt; } }
    {   PrefK6 P; int u = v; DilU cur, nxt;
        if (u < 3072) { cur = dil_decode(u); dil_issue_k(P, w, cur, A.QB, A.KB); }
        for (; u < 3072; u += G) {
            __syncthreads();
            bf16x8 qf[4] = {P.q[0], P.q[1], P.q[2], P.q[3]};
            { PrefV6 PV; dil_issue_v(PV, w, cur, A.VB); win_commit_k6(P, w); win_commit_v6(PV, w); }
            __syncthreads();
            const bool more = u + G < 3072; if (more) nxt = dil_decode(u + G);
            dil_compute(w, cur, qf, A.OB, A.HB2, A.LSE, [&]() { if (more) dil_issue_k(P, w, nxt, A.QB, A.KB); });
            cur = nxt; } }
    __syncthreads();
    for (int u = v; u < 512; u += G) { const int qt = u & 31, bh = u >> 5; sb_unit(lds, A.QB, A.KB, A.VB, A.OB, bh >> 2, 4 + (bh & 3), qt, tid); }
}
}

constexpr int PH_PRO = 0, PH_L0 = 1, PH_PER_LAYER = 10, PH_FINAL = PH_L0 + DEPTH * PH_PER_LAYER, PH_COUNT = PH_FINAL + 1;
typedef const __attribute__((address_space(4))) Args* KArgP;
#define KARG() ({ KArgP p_ = (KArgP)__builtin_amdgcn_kernarg_segment_ptr(); asm volatile("" : "+s"(p_)); p_; })
#define PHASE_IDS int lane_p = (int)__builtin_amdgcn_mbcnt_hi(~0u, __builtin_amdgcn_mbcnt_lo(~0u, 0u)); LAUNDER_V(lane_p); int tid_p = wave * 64 + lane_p; int gw_p = gw, G_p = G, NGW_p = NGW; LAUNDER_S(gw_p); LAUNDER_S(G_p); LAUNDER_S(NGW_p)
__global__ void __launch_bounds__(NTHREADS, 2) fwd(Args a_unused) {
    extern __shared__ __attribute__((aligned(16))) unsigned char lds_raw[];
    LAS unsigned char* lds = (LAS unsigned char*)lds_raw;
    volatile LAS unsigned* MISC = (volatile LAS unsigned*)(lds + MISC_OFF);
    const int wave = __builtin_amdgcn_readfirstlane((int)threadIdx.x >> 6);
    const int G = gridDim.x, bx = blockIdx.x;
    const int vcu = (G % 8 == 0) ? (bx % 8) * (G / 8) + bx / 8 : bx;
    const int gw = vcu * NWAVES + wave, NGW = G * NWAVES;
    for (int u = threadIdx.x; u < (LDS_BYTES - LDSCTL_OFF) / 4; u += NTHREADS) ((LAS unsigned*)(lds + LDSCTL_OFF))[u] = 0u;
    __syncthreads();
    int lo, hi; XcdBarrier bar;
    { KArgP ka = KARG(); lo = ka->ph_lo; hi = ka->ph_hi; unsigned* ctl = (unsigned*)(ka->ws + WS_CTL); bar = xcd_barrier_post(ctl + CW_BAR + ka->li * XCD_BAR_WORDS, MISC + 8, wave); }
#define IN(k) (lo <= (k) && (k) < hi)
#define SEAM(k) do { if (IN(k) && IN((k) + 1)) xcd_barrier(bar); } while (0)
#define WSP(T_, off) ((T_*)(ws + (off)))

    if (IN(PH_PRO)) { KArgP ka = KARG(); PHASE_IDS; Args a; a.ws = ka->ws; a.w_in = ka->w_in; a.w_out = ka->w_out; a.w_gate = ka->w_gate; a.w_up = ka->w_up; a.w_down = ka->w_down; phase_prologue(a, lds, gw_p, NGW_p, wave, lane_p); } SEAM(PH_PRO);

    for (int l = 0; l < DEPTH; ++l) {
        const int p0 = PH_L0 + l * PH_PER_LAYER;
        if (hi <= p0 || lo >= p0 + PH_PER_LAYER) continue;
        if (IN(p0 + 0)) for (int rep_ = 0; rep_ < RPT(0); ++rep_) { if (rep_) xcd_barrier(bar); KArgP ka = KARG(); PHASE_IDS; unsigned char* ws = ka->ws; const float* xin = (l == 0) ? ka->x : ka->out;
            phase_norm1(xin, ka->ln1_g + (size_t)l * DM, WSP(bf16_t, WS_HB), gw_p, NGW_p, lane_p, WSP(float, WS_KMEAN)); } SEAM(p0 + 0);
        if (IN(p0 + 1)) for (int rep_ = 0; rep_ < RPT(1); ++rep_) { if (rep_) xcd_barrier(bar); KArgP ka = KARG(); PHASE_IDS; unsigned char* ws = ka->ws;
            pg8::Gemm g{(const char*)(ws + WS_HB), (const char*)(ws + WS_WIN) + (size_t)l * NQKV * DM * 2, DM, DM, DM, (long)256 * DM * 2, (long)256 * DM * 2, (long)128 * DM * 2};
            pg8::StaticOrder S; S.init(T / 256, NQKV / 256, G_p, bx);
            pg8::EpiQKV E{WSP(bf16_t, WS_Q), (size_t)(WS_K - WS_Q) / 2, QSCALE};
            pg8::gemm_phase<pg8::EpiQKV, pg8::StaticOrder>(lds, g, S, E, wave);
        } SEAM(p0 + 1);
        if (IN(p0 + 3)) { KArgP ka = KARG(); PHASE_IDS; unsigned char* ws = ka->ws;
            att::moba_gate_phase(lds, WSP(bf16_t, WS_Q), WSP(float, WS_KMEAN), WSP(unsigned, WS_CTL) + CW_MCNT + l * 512, WSP(unsigned, WS_QLIST), WSP(bf16_t, WS_PM), WSP(float, WS_LSEM0), WSP(float, WS_LSEM1), vcu, G_p, tid_p);
        } SEAM(p0 + 3);
        if (IN(p0 + 4)) for (int rep_ = 0; rep_ < RPT(4); ++rep_) { if (rep_) xcd_barrier(bar); KArgP ka = KARG(); PHASE_IDS; unsigned char* ws = ka->ws;
            const att::AttnArgs A{WSP(bf16_t, WS_Q), WSP(bf16_t, WS_K), WSP(bf16_t, WS_V), WSP(bf16_t, WS_O), WSP(bf16_t, WS_HB), WSP(float, WS_LSE), WSP(unsigned, WS_CTL) + CW_MCNT + l * 512, WSP(unsigned, WS_QLIST),
                                  WSP(bf16_t, WS_PM), WSP(float, WS_LSEM0), WSP(float, WS_LSEM1)};
            att::attn_phase(lds, A, vcu, G_p, tid_p);
        } SEAM(p0 + 4);
        if (IN(p0 + 5)) { KArgP ka = KARG(); PHASE_IDS; unsigned char* ws = ka->ws;
            phase_mixnorm(WSP(bf16_t, WS_O), WSP(bf16_t, WS_HB), WSP(float, WS_LSE), WSP(bf16_t, WS_PM), WSP(float, WS_LSEM0), WSP(float, WS_LSEM1), ka->mix_g + (size_t)l * DM, gw_p, NGW_p, lane_p); } SEAM(p0 + 5);
        if (IN(p0 + 6)) { KArgP ka = KARG(); PHASE_IDS; unsigned char* ws = ka->ws; const float* xin = (l == 0) ? ka->x : ka->out;
            pg8::Gemm g{(const char*)(ws + WS_HB), (const char*)(ws + WS_WOUT) + (size_t)l * DM * DM * 2, DM, DM, DM, (long)256 * DM * 2, (long)256 * DM * 2, (long)128 * DM * 2};
            pg8::StaticOrder S; S.init(T / 256, DM / 256, G_p, bx);
            pg8::EpiResAdd E{xin, ka->out};
            pg8::gemm_phase<pg8::EpiResAdd, pg8::StaticOrder>(lds, g, S, E, wave);
        } SEAM(p0 + 6);
        if (IN(p0 + 7)) { KArgP ka = KARG(); PHASE_IDS; unsigned char* ws = ka->ws;
            phase_route(ka->out, ka->ln2_g + (size_t)l * DM, ka->w_gr + (size_t)l * DM * 4, ka->b_gr + l * 4, ka->w_er + (size_t)l * 4 * DM * 4, ka->b_er + l * 16, WSP(bf16_t, WS_HB),
                        WSP(unsigned, WS_CTL) + CW_CNT + l * 32, WSP(unsigned, WS_LIST), WSP(float, WS_WLIST), lds, vcu, G_p, wave, lane_p); } SEAM(p0 + 7);
        if (IN(p0 + 8)) for (int rep_ = 0; rep_ < RPT(8); ++rep_) { if (rep_) xcd_barrier(bar); KArgP ka = KARG(); PHASE_IDS; unsigned char* ws = ka->ws;
            pg8::MoeProb<0> P{WSP(unsigned, WS_CTL) + CW_CNT + l * 32, WSP(unsigned, WS_LIST), (const char*)(ws + WS_HB), (const char*)(ws + WS_WG) + (size_t)l * NACT * DM * 2, DM, DM, DM, (long)(WS_WU - WS_WG), G_p, vcu, WSP(unsigned, WS_CTL) + CW_TCNT + l * 16384};
            pg8::EpiGateUpSparse E{WSP(bf16_t, WS_ACT), WSP(float, WS_WLIST), WSP(unsigned, WS_CTL) + CW_TCNT + l * 16384};
            pg8::gemm_phase_x<pg8::EpiGateUpSparse, pg8::MoeProb<0>>(lds, P, E, wave);
        }
        if (IN(p0 + 9)) { KArgP ka = KARG(); PHASE_IDS; unsigned char* ws = ka->ws;
            pg8::MoeProb<1> P{WSP(unsigned, WS_CTL) + CW_CNT + l * 32, WSP(unsigned, WS_LIST), (const char*)(ws + WS_ACT), (const char*)(ws + WS_WD) + (size_t)l * DM * NACT * 2, 512, NACT, 512, (long)128 * NACT * 2, G_p, G_p - 1 - vcu, WSP(unsigned, WS_CTL) + CW_TCNT + l * 16384};
            pg8::EpiDownScatter E{ka->out, WSP(unsigned, WS_LIST)};
            pg8::gemm_phase_x<pg8::EpiDownScatter, pg8::MoeProb<1>>(lds, P, E, wave);
        } SEAM(p0 + 9);
    }
    if (IN(PH_FINAL)) { KArgP ka = KARG(); PHASE_IDS; phase_final(ka->out, ka->fin_g, gw_p, NGW_p, lane_p); }
#undef IN
#undef SEAM
#undef WSP
}

#ifndef N_LAUNCH_MODE
#define N_LAUNCH_MODE 1
#endif
extern "C" void kernel_launch(void* const* d_in, const int* in_sizes, int n_in, void* d_out, int out_size, void* d_ws, size_t ws_size, hipStream_t stream) {
    static int grid = 0;
    if (grid == 0) {
        if (n_in != 14 || in_sizes[0] != T * DM || out_size != T * DM || ws_size < WS_END) { fprintf(stderr, "kernel_launch: unexpected shapes (n_in %d in0 %d out %d ws %zu)\n", n_in, n_in > 0 ? in_sizes[0] : -1, out_size, ws_size); grid = -1; return; }
        int dev = 0, cus = 0, per_cu = 0;
        if (hipGetDevice(&dev) != hipSuccess || hipDeviceGetAttribute(&cus, hipDeviceAttributeMultiprocessorCount, dev) != hipSuccess) { grid = -1; return; }
        if (hipFuncSetAttribute((const void*)fwd, hipFuncAttributeMaxDynamicSharedMemorySize, LDS_BYTES) != hipSuccess) { fprintf(stderr, "kernel_launch: hipFuncSetAttribute failed\n"); grid = -1; return; }
        if (hipOccupancyMaxActiveBlocksPerMultiprocessor(&per_cu, (const void*)fwd, NTHREADS, LDS_BYTES) != hipSuccess || per_cu < 1) fprintf(stderr, "kernel_launch: occupancy query says %d\n", per_cu);
        (void)hipGetLastError();
        grid = cus;
    }
    if (grid < 0) return;
    if (hipMemsetAsync((char*)d_ws + WS_CTL, 0, CTL_ZERO_BYTES, stream) != hipSuccess) return;
    Args a{};
    a.x = (const float*)d_in[0]; a.ln1_g = (const float*)d_in[1]; a.w_in = (const float*)d_in[2]; a.mix_g = (const float*)d_in[3]; a.w_out = (const float*)d_in[4]; a.ln2_g = (const float*)d_in[5];
    a.w_gr = (const float*)d_in[6]; a.b_gr = (const float*)d_in[7]; a.w_er = (const float*)d_in[8]; a.b_er = (const float*)d_in[9]; a.w_gate = (const float*)d_in[10]; a.w_up = (const float*)d_in[11];
    a.w_down = (const float*)d_in[12]; a.fin_g = (const float*)d_in[13];
    a.out = (float*)d_out; a.ws = (unsigned char*)d_ws; a.pad = 0;
#if N_LAUNCH_MODE == 1
    a.ph_lo = 0; a.ph_hi = PH_COUNT; a.li = 0;
    hipLaunchKernelGGL(fwd, dim3(grid), dim3(NTHREADS), LDS_BYTES, stream, a);
#else
    for (int p = 0; p < PH_COUNT; ++p) { a.ph_lo = p; a.ph_hi = p + 1; a.li = p; hipLaunchKernelGGL(fwd, dim3(grid), dim3(NTHREADS), LDS_BYTES, stream, a); }
#endif
}
```

```cpp
#include <hip/hip_runtime.h>
#include <cstdio>
#include <cstdint>

#define LAS __attribute__((address_space(3)))
#define GAS __attribute__((address_space(1)))
typedef unsigned short bf16_t;
typedef short bf16x8 __attribute__((ext_vector_type(8)));
typedef float f32x4 __attribute__((ext_vector_type(4)));
typedef float f32x2 __attribute__((ext_vector_type(2)));
typedef unsigned u32x4 __attribute__((ext_vector_type(4)));
typedef unsigned u32x2 __attribute__((ext_vector_type(2)));

#ifndef PROBE_REPEAT
#define PROBE_REPEAT 0
#endif
#define RPT(k) ((((PROBE_REPEAT) >> (k)) & 1) ? 2 : 1)
#ifndef MOE_SPARSE
#define MOE_SPARSE 1
#endif
#ifndef ATT_MOBA
#define ATT_MOBA 1
#endif
#ifndef ATT_SB
#define ATT_SB 1
#endif
#ifndef ATT_DIL
#define ATT_DIL 1
#endif
constexpr int BATCH = 4, SEQ = 8192, DM = 1024, DEPTH = 4, T = BATCH * SEQ, NH = 16, HD = 64;
constexpr int NQKV = 3 * DM, NEXP = 16, DEXP = 256, NACT = NEXP * DEXP;
constexpr float NORM_EPS = 1e-6f;
constexpr float LOG2E = 1.4426950408889634f;
constexpr float QSCALE = 0.125f * LOG2E;
constexpr int NWAVES = 8, NTHREADS = 512;

constexpr size_t MiB = 1u << 20;
constexpr size_t WS_CTL = 0, CTL_ZERO_BYTES = 1 * MiB;
constexpr size_t WS_WIN = 2 * MiB;
constexpr size_t WS_WOUT = 26 * MiB;
constexpr size_t WS_WG = 34 * MiB;
constexpr size_t WS_WU = 66 * MiB;
constexpr size_t WS_WD = 98 * MiB;
constexpr size_t WS_LSEM0 = 1 * MiB;
constexpr size_t WS_KMEAN = 130 * MiB;
constexpr size_t WS_HB = 131 * MiB;
constexpr size_t WS_Q = 195 * MiB, WS_K = 259 * MiB, WS_V = 323 * MiB, WS_O = 387 * MiB;
constexpr size_t WS_ACT = WS_Q;
constexpr size_t WS_LSE = 451 * MiB;
constexpr size_t WS_LIST = 454 * MiB;
constexpr size_t WS_WLIST = 457 * MiB;
constexpr size_t WS_QLIST = WS_LIST;
constexpr size_t WS_PM = 463 * MiB;
constexpr size_t WS_LSEM1 = 511 * MiB;
constexpr size_t WS_END = 512 * MiB;
constexpr int QL_PER_BH = 126976;
constexpr int CW_GDONE = 1536;
constexpr int CW_MCNT = 2048;
constexpr int CW_CNT = 1024;
constexpr int CW_TCNT = 16384;
constexpr int CW_BAR = 4096;

constexpr int RING_BYTES = 131072;
constexpr int LDSCTL_OFF = 147456, MISC_OFF = LDSCTL_OFF + 320;
constexpr int LDS_BYTES = 148480;

__device__ __forceinline__ unsigned f2bf(float f) { unsigned u = __builtin_bit_cast(unsigned, f); return (u + 0x7fffu + ((u >> 16) & 1u)) >> 16; }
__device__ __forceinline__ unsigned pk2(float lo, float hi) { return f2bf(lo) | (f2bf(hi) << 16); }
__device__ __forceinline__ float bflo(unsigned w) { return __builtin_bit_cast(float, w << 16); }
__device__ __forceinline__ float bfhi(unsigned w) { return __builtin_bit_cast(float, w & 0xffff0000u); }
template <int M> __device__ __forceinline__ float swz_xor(float v) { return __builtin_bit_cast(float, __builtin_amdgcn_ds_swizzle(__builtin_bit_cast(int, v), 0x1f | (M << 10))); }
__device__ __forceinline__ void swap32(unsigned x, unsigned& lo_val, unsigned& hi_val) { unsigned y = x; asm volatile("" : "+v"(y)); auto rr = __builtin_amdgcn_permlane32_swap(x, y, false, false); lo_val = rr[0]; hi_val = rr[1]; }
__device__ __forceinline__ float sum_xor32(float v) { unsigned a, b; swap32(__builtin_bit_cast(unsigned, v), a, b); return __builtin_bit_cast(float, a) + __builtin_bit_cast(float, b); }
__device__ __forceinline__ float max_xor32(float v) { unsigned a, b; swap32(__builtin_bit_cast(unsigned, v), a, b); return fmaxf(__builtin_bit_cast(float, a), __builtin_bit_cast(float, b)); }
__device__ __forceinline__ float get_xor32(float v, int hi) { unsigned a, b; swap32(__builtin_bit_cast(unsigned, v), a, b); return __builtin_bit_cast(float, hi ? a : b); }
__device__ __forceinline__ int get_xor32i(int v, int hi) { unsigned a, b; swap32((unsigned)v, a, b); return (int)(hi ? a : b); }
template <int CTRL> __device__ __forceinline__ float dpp_mov(float v) { return __builtin_bit_cast(float, __builtin_amdgcn_update_dpp(0, __builtin_bit_cast(int, v), CTRL, 0xf, 0xf, false)); }
__device__ __forceinline__ float row_sum(float v) { v += dpp_mov<0xB1>(v); v += dpp_mov<0x4E>(v); v += dpp_mov<0x141>(v); v += dpp_mov<0x140>(v); return v; }
__device__ __forceinline__ float half_sum(float v) { v = row_sum(v); v += swz_xor<16>(v); return v; }
__device__ __forceinline__ float wave_sum(float v) { return sum_xor32(half_sum(v)); }
#define LDS_WAIT() asm volatile("s_waitcnt lgkmcnt(0)" ::: "memory")
#define LAUNDER_V(x) asm volatile("" : "+v"(x))
#define LAUNDER_S(x) asm volatile("" : "+s"(x))

namespace pg8 {
constexpr int BM = 256, BK = 64, HALF = 128, HTB = HALF * BK * 2, STAGE_BYTES = 8 * HTB, NXCD = 8, WGM = 8;
__host__ __device__ __forceinline__ int lds_byte(int r, int c) { const int st = (r >> 4) * 2 + (c >> 5), rr = r & 15, cc = c & 31, ob = rr * 64 + cc * 2; return st * 1024 + (ob ^ (((ob >> 9) & 1) << 5)); }
__host__ __device__ __forceinline__ void stage_rc(int b, int& R, int& C) { const int st = b / 1024, sb = b % 1024, swz = sb ^ (((sb >> 9) & 1) << 5); R = (st >> 1) * 16 + swz / 64; C = (st & 1) * 32 + (swz % 64) / 2; }
__host__ __device__ __forceinline__ int perm32(int rho) { const int n = rho >> 4, i = rho & 15; return 8 * (i >> 2) + 4 * n + (i & 3); }

struct Unit { int pm, pn, meta;
    __device__ __forceinline__ int bk() const { return meta & 31; } __device__ __forceinline__ int tib() const { return (meta >> 5) & 255; } __device__ __forceinline__ int nb() const { return meta >> 13; } };
struct Gemm { const char* A; const char* B; int lda, ldb, K; long tstepA, tstepB, hstepB; };

struct StaticOrder {
    int nM, nN, nwg, G, c;
    __host__ __device__ void init(int nM_, int nN_, int G_, int c_) { nM = nM_; nN = nN_; nwg = nM * nN; G = G_; c = c_; }
    __host__ __device__ bool next(int i, Unit& u) const {
        const long L = (long)i * G + c; if (L >= nwg) return false;
        int wgid = (int)L; { const int q = nwg / NXCD, r = nwg % NXCD, xcd = wgid % NXCD, off = wgid / NXCD; wgid = (xcd < r ? xcd * (q + 1) : r * (q + 1) + (xcd - r) * q) + off; }
        const int nig = WGM * nN, gid = wgid / nig, fm = gid * WGM, gsz = (nM - fm) < WGM ? (nM - fm) : WGM;
        u.pm = fm + ((wgid % nig) % gsz); u.pn = (wgid % nig) / gsz; return true;
    }
};

__device__ __forceinline__ unsigned cvt_pk_bf16(float lo, float hi) { unsigned r; asm volatile("v_cvt_pk_bf16_f32 %0, %1, %2" : "=v"(r) : "v"(lo), "v"(hi)); return r; }

struct EpiQKV {
    static constexpr bool PERM = true;
    bf16_t* O; size_t split_stride; float scale0;
    __device__ __forceinline__ void operator()(const f32x4 (&acc)[2][2][4][2], const Unit& u, int wr, int wc, int fr, int fq) const {
        asm volatile("" : "+v"(fr), "+v"(fq));
        const int row0 = u.pm * BM + wr * 64 + fr; int colt = u.pn * BM;
        const int t = colt / DM; bf16_t* base = O + (size_t)t * split_stride; colt -= t * DM; const float sc = (t == 0) ? scale0 : 1.f;
        const int col0 = colt + wc * 32 + 8 * fq;
#pragma unroll
        for (int ai = 0; ai < 2; ++ai)
#pragma unroll
            for (int m = 0; m < 4; ++m) { bf16_t* rowp = base + (size_t)(row0 + ai * HALF + m * 16) * DM + col0;
#pragma unroll
                for (int bj = 0; bj < 2; ++bj) { f32x4 v0 = acc[ai][bj][m][0] * sc, v1 = acc[ai][bj][m][1] * sc;
                    u32x4 w; w.x = cvt_pk_bf16(v0[0], v0[1]); w.y = cvt_pk_bf16(v0[2], v0[3]); w.z = cvt_pk_bf16(v1[0], v1[1]); w.w = cvt_pk_bf16(v1[2], v1[3]);
                    *(u32x4*)(rowp + bj * HALF) = w; } }
        if (u.pn == 4) {
            float* kmean = (float*)((unsigned char*)O - WS_Q + WS_KMEAN) + ((size_t)((u.pm >> 5) * 4) * 32 + (u.pm & 31)) * HD;
#pragma unroll
            for (int bj = 0; bj < 2; ++bj)
#pragma unroll
                for (int n = 0; n < 2; ++n)
#pragma unroll
                    for (int j = 0; j < 4; ++j) { float cs = 0.f;
#pragma unroll
                        for (int ai = 0; ai < 2; ++ai)
#pragma unroll
                            for (int m = 0; m < 4; ++m) cs += acc[ai][bj][m][n][j];
                        cs = row_sum(cs);
                        const int col = bj * HALF + wc * 32 + 8 * fq + 4 * n + j;
                        if (fr == 0) __hip_atomic_fetch_add(kmean + (size_t)(col >> 6) * 32 * HD + (col & 63), cs, __ATOMIC_RELAXED, __HIP_MEMORY_SCOPE_AGENT); }
        }
    }
};
struct EpiResAdd {
    static constexpr bool PERM = false;
    const float* base; float* out;
    __device__ __forceinline__ void operator()(const f32x4 (&acc)[2][2][4][2], const Unit& u, int wr, int wc, int fr, int fq) const {
        asm volatile("" : "+v"(fr), "+v"(fq));
        const int col0 = u.pn * BM + wc * 32 + 4 * fq;
#pragma unroll
        for (int ai = 0; ai < 2; ++ai)
#pragma unroll
            for (int m = 0; m < 4; ++m) { const size_t off = (size_t)(u.pm * BM + ai * HALF + wr * 64 + m * 16 + fr) * DM + col0;
#pragma unroll
                for (int bj = 0; bj < 2; ++bj)
#pragma unroll
                    for (int n = 0; n < 2; ++n) { const f32x4 bs = *(const f32x4*)(base + off + bj * HALF + n * 16); *(f32x4*)(out + off + bj * HALF + n * 16) = bs + acc[ai][bj][m][n]; } }
    }
};
struct EpiGateUpDense {
    static constexpr bool PERM = true;
    bf16_t* act; const float* comb;
    __device__ __forceinline__ void operator()(const f32x4 (&acc)[2][2][4][2], const Unit& u, int wr, int wc, int fr, int fq) const {
        asm volatile("" : "+v"(fr), "+v"(fq));
        const int e = u.pn >> 1, c0 = (u.pn & 1) * HALF;
        const int col0 = e * DEXP + c0 + wc * 32 + 8 * fq;
#pragma unroll
        for (int ai = 0; ai < 2; ++ai)
#pragma unroll
            for (int m = 0; m < 4; ++m) { const int row = u.pm * BM + ai * HALF + wr * 64 + m * 16 + fr;
                const float cw = comb[(size_t)row * NEXP + e];
                float o[8];
#pragma unroll
                for (int n = 0; n < 2; ++n)
#pragma unroll
                    for (int j = 0; j < 4; ++j) { const float g = acc[ai][0][m][n][j], up = acc[ai][1][m][n][j];
                        const float sg = g * __builtin_amdgcn_rcpf(1.f + __builtin_amdgcn_exp2f(-g * LOG2E));
                        o[n * 4 + j] = sg * up * cw; }
                u32x4 w; w.x = cvt_pk_bf16(o[0], o[1]); w.y = cvt_pk_bf16(o[2], o[3]); w.z = cvt_pk_bf16(o[4], o[5]); w.w = cvt_pk_bf16(o[6], o[7]);
                *(u32x4*)(act + (size_t)row * NACT + col0) = w; }
    }
};

template <class Epi, class Sched>
__device__ __forceinline__ void gemm_phase(LAS unsigned char* lds, const Gemm g, const Sched& S, const Epi& E, int wave_id) {
    int lane_l = (int)__builtin_amdgcn_mbcnt_hi(~0u, __builtin_amdgcn_mbcnt_lo(~0u, 0u)); asm volatile("" : "+v"(lane_l));
    const int wid = wave_id, lane = lane_l, tid = wid * 64 + lane, wr = wid >> 2, wc = wid & 3, fr = lane & 15, fq = lane >> 4;
    const int K = g.K, nt = K / BK;
    unsigned voffA[2], voffB[2];
#pragma unroll
    for (int i = 0; i < 2; ++i) { int R, C; stage_rc(tid * 16 + i * 8192, R, C); const int Rb = Epi::PERM ? ((R & ~31) + perm32(R & 31)) : R;
        voffA[i] = (unsigned)(R * g.lda + C) * 2u; voffB[i] = (unsigned)(Rb * g.ldb + C) * 2u; }
    const size_t kstep = (size_t)(BK * 2);
    const size_t hstepA = (size_t)HALF * g.lda * 2;
    const long hstepB = g.hstepB;
    const unsigned ldsw = (unsigned)wid * 1024u;
    const int aoff = lds_byte(wr * 64 + fr, fq * 8), boff = lds_byte(wc * 32 + fr, fq * 8);
#define PG8_SA(b, h) (((b) * 2 + (h)) * HTB)
#define PG8_SB(b, h) ((4 + (b) * 2 + (h)) * HTB)
#define PG8_STAGE(bufoff, gbase, voff) do { _Pragma("unroll") for (int _i = 0; _i < 2; ++_i) \
        __builtin_amdgcn_global_load_lds((const unsigned*)((const char*)(gbase) + (voff)[_i]), (LAS unsigned*)(lds + (bufoff) + ldsw + _i * 8192), 16, 0, 0); } while (0)
#define PG8_LDA(dst, b, h) do { _Pragma("unroll") for (int m = 0; m < 4; ++m) _Pragma("unroll") for (int k = 0; k < 2; ++k) dst[m][k] = *(const LAS bf16x8*)(lds + PG8_SA(b, h) + aoff + m * 2048 + k * 1024); } while (0)
#define PG8_LDB(dst, b, h) do { _Pragma("unroll") for (int n = 0; n < 2; ++n) _Pragma("unroll") for (int k = 0; k < 2; ++k) dst[n][k] = *(const LAS bf16x8*)(lds + PG8_SB(b, h) + boff + n * 2048 + k * 1024); } while (0)
#define PG8_MMA(ai, bj, At, Bt) do { __builtin_amdgcn_s_setprio(1); _Pragma("unroll") for (int m = 0; m < 4; ++m) _Pragma("unroll") for (int n = 0; n < 2; ++n) _Pragma("unroll") for (int k = 0; k < 2; ++k) \
        acc[ai][bj][m][n] = __builtin_amdgcn_mfma_f32_16x16x32_bf16(Bt[n][k], At[m][k], acc[ai][bj][m][n], 0, 0, 0); __builtin_amdgcn_s_setprio(0); } while (0)
#define PG8_WAIT_V(n) asm volatile("s_waitcnt vmcnt(" #n ")" ::: "memory")
#define PG8_WAIT_L(n) asm volatile("s_waitcnt lgkmcnt(" #n ")" ::: "memory")
#define PG8_BAR __builtin_amdgcn_s_barrier()
#define PG8_SCHED __builtin_amdgcn_sched_barrier(0)
    Unit cur, nxt; int ui = 0;
    if (!S.next(0, cur)) return;
    f32x4 acc[2][2][4][2];
#pragma unroll
    for (int a = 0; a < 2; ++a)
#pragma unroll
        for (int b = 0; b < 2; ++b)
#pragma unroll
            for (int m = 0; m < 4; ++m)
#pragma unroll
                for (int n = 0; n < 2; ++n) acc[a][b][m][n] = (f32x4){0.f, 0.f, 0.f, 0.f};
    bf16x8 At[4][2], B0[2][2], B1[2][2];
    const char* cA = g.A + (size_t)cur.pm * g.tstepA; const char* cB = g.B + (size_t)cur.pn * g.tstepB;
    PG8_STAGE(PG8_SB(0, 0), cB, voffB); PG8_STAGE(PG8_SB(0, 1), cB + hstepB, voffB); PG8_STAGE(PG8_SA(0, 0), cA, voffA); PG8_STAGE(PG8_SA(0, 1), cA + hstepA, voffA);
    if (wr == 1) PG8_BAR;
    PG8_WAIT_V(2); PG8_BAR;
    PG8_STAGE(PG8_SB(1, 0), cB + kstep, voffB); PG8_STAGE(PG8_SA(1, 0), cA + kstep, voffA); PG8_STAGE(PG8_SB(1, 1), cB + hstepB + kstep, voffB);
    PG8_WAIT_V(6); PG8_BAR;
    for (;;) {
        const bool has_next = S.next(ui + 1, nxt);
        const char* nA = has_next ? g.A + (size_t)nxt.pm * g.tstepA : cA; const char* nB = has_next ? g.B + (size_t)nxt.pn * g.tstepB : cB;
        for (int t = 0; t < nt; t += 2) {
            const bool last = (t == nt - 2);
            const char* a1 = cA + (size_t)(t + 1) * kstep;
            const char* a2 = last ? nA : cA + (size_t)(t + 2) * kstep; const char* b2 = last ? nB : cB + (size_t)(t + 2) * kstep;
            const char* a3 = a2 + kstep; const char* b3 = b2 + kstep;
            PG8_LDB(B0, 0, 0); PG8_LDB(B1, 0, 1); PG8_SCHED; PG8_LDA(At, 0, 0); PG8_STAGE(PG8_SA(1, 1), a1 + hstepA, voffA);
            PG8_WAIT_V(8); PG8_WAIT_L(0); PG8_BAR; PG8_MMA(0, 0, At, B0); PG8_MMA(0, 1, At, B1); PG8_BAR; PG8_SCHED;
            PG8_LDA(At, 0, 1); PG8_STAGE(PG8_SB(0, 0), b2, voffB); PG8_STAGE(PG8_SB(0, 1), b2 + hstepB, voffB); PG8_STAGE(PG8_SA(0, 0), a2, voffA);
            PG8_WAIT_V(8); PG8_WAIT_L(0); PG8_BAR; PG8_MMA(1, 0, At, B0); PG8_MMA(1, 1, At, B1); PG8_BAR; PG8_SCHED;
            PG8_LDB(B0, 1, 0); PG8_LDB(B1, 1, 1); PG8_SCHED; PG8_LDA(At, 1, 0); PG8_STAGE(PG8_SA(0, 1), a2 + hstepA, voffA);
            PG8_WAIT_V(8); PG8_WAIT_L(0); PG8_BAR; PG8_MMA(0, 0, At, B0); PG8_MMA(0, 1, At, B1); PG8_BAR; PG8_SCHED;
            PG8_LDA(At, 1, 1); PG8_STAGE(PG8_SB(1, 0), b3, voffB); PG8_STAGE(PG8_SB(1, 1), b3 + hstepB, voffB); PG8_STAGE(PG8_SA(1, 0), a3, voffA);
            PG8_WAIT_V(8); PG8_WAIT_L(0); PG8_BAR; PG8_MMA(1, 0, At, B0); PG8_MMA(1, 1, At, B1); PG8_BAR; PG8_SCHED;
        }
        if (wr == 0) PG8_BAR;
        E(acc, cur, wr, wc, fr, fq);
        if (!has_next) break;
#pragma unroll
        for (int a = 0; a < 2; ++a)
#pragma unroll
            for (int b = 0; b < 2; ++b)
#pragma unroll
                for (int m = 0; m < 4; ++m)
#pragma unroll
                    for (int n = 0; n < 2; ++n) acc[a][b][m][n] = (f32x4){0.f, 0.f, 0.f, 0.f};
        cur = nxt; cA = nA; cB = nB; ++ui;
        if (wr == 1) PG8_BAR;
    }
    PG8_WAIT_V(0);
    PG8_BAR;
#undef PG8_SA
#undef PG8_SB
#undef PG8_STAGE
#undef PG8_LDA
#undef PG8_LDB
#undef PG8_MMA
#undef PG8_WAIT_V
#undef PG8_WAIT_L
#undef PG8_BAR
#undef PG8_SCHED
}
template <class Epi, class Prob>
__device__ __forceinline__ void gemm_phase_x(LAS unsigned char* lds, const Prob& P, const Epi& E, int wave_id) {
    int lane_l = (int)__builtin_amdgcn_mbcnt_hi(~0u, __builtin_amdgcn_mbcnt_lo(~0u, 0u)); asm volatile("" : "+v"(lane_l));
    const int wid = wave_id, lane = lane_l, tid = wid * 64 + lane, wr = wid >> 2, wc = wid & 3, fr = lane & 15, fq = lane >> 4;
    const int K = P.K, nt = K / BK;
    unsigned voffB[2];
#pragma unroll
    for (int i = 0; i < 2; ++i) { int R, C; stage_rc(tid * 16 + i * 8192, R, C); const int Rb = Epi::PERM ? ((R & ~31) + perm32(R & 31)) : R; voffB[i] = (unsigned)(Rb * P.ldb + C) * 2u; }
    const size_t kstep = (size_t)(BK * 2);
    const long hstepB = P.hstepB;
    const unsigned ldsw = (unsigned)wid * 1024u;
    const int aoff = lds_byte(wr * 64 + fr, fq * 8), boff = lds_byte(wc * 32 + fr, fq * 8);
    LAS u32x4* stash = (LAS u32x4*)(lds + STAGE_BYTES + 1024) + tid;
#define PG8_SA(b, h) (((b) * 2 + (h)) * HTB)
#define PG8_SB(b, h) ((4 + (b) * 2 + (h)) * HTB)
#define PG8_STAGE(bufoff, gbase, voff) do { _Pragma("unroll") for (int _i = 0; _i < 2; ++_i) \
        __builtin_amdgcn_global_load_lds((const unsigned*)((const char*)(gbase) + (voff)[_i]), (LAS unsigned*)(lds + (bufoff) + ldsw + _i * 8192), 16, 0, 0); } while (0)
#define PG8_LDA(dst, b, h) do { _Pragma("unroll") for (int m = 0; m < 4; ++m) _Pragma("unroll") for (int k = 0; k < 2; ++k) dst[m][k] = *(const LAS bf16x8*)(lds + PG8_SA(b, h) + aoff + m * 2048 + k * 1024); } while (0)
#define PG8_LDB(dst, b, h) do { _Pragma("unroll") for (int n = 0; n < 2; ++n) _Pragma("unroll") for (int k = 0; k < 2; ++k) dst[n][k] = *(const LAS bf16x8*)(lds + PG8_SB(b, h) + boff + n * 2048 + k * 1024); } while (0)
#define PG8_MMA(ai, bj, At, Bt) do { __builtin_amdgcn_s_setprio(1); _Pragma("unroll") for (int m = 0; m < 4; ++m) _Pragma("unroll") for (int n = 0; n < 2; ++n) _Pragma("unroll") for (int k = 0; k < 2; ++k) \
        acc[ai][bj][m][n] = __builtin_amdgcn_mfma_f32_16x16x32_bf16(Bt[n][k], At[m][k], acc[ai][bj][m][n], 0, 0, 0); __builtin_amdgcn_s_setprio(0); } while (0)
#define PG8_WAIT_V(n) asm volatile("s_waitcnt vmcnt(" #n ")" ::: "memory")
#define PG8_WAIT_L(n) asm volatile("s_waitcnt lgkmcnt(" #n ")" ::: "memory")
#define PG8_BAR __builtin_amdgcn_s_barrier()
#define PG8_SCHED __builtin_amdgcn_sched_barrier(0)
#define PG8_AVOFF(dst, u) do { int t2_ = tid; asm volatile("" : "+v"(t2_)); _Pragma("unroll") for (int i_ = 0; i_ < 2; ++i_) { int R_, C_; stage_rc(t2_ * 16 + i_ * 8192, R_, C_); _Pragma("unroll") for (int h_ = 0; h_ < 2; ++h_) \
        dst[h_][i_] = (Prob::GATHER ? P.arow_off(u, h_, R_) : (unsigned)((h_ * HALF + R_) * P.lda) * 2u) + (unsigned)C_ * 2u; } } while (0)
    Unit cur, nxt; int ui = 0;
    if (!P.next(0, cur)) return;
    unsigned vA[2][2];
    PG8_AVOFF(vA, cur);
    f32x4 acc[2][2][4][2];
#pragma unroll
    for (int a = 0; a < 2; ++a)
#pragma unroll
        for (int b = 0; b < 2; ++b)
#pragma unroll
            for (int m = 0; m < 4; ++m)
#pragma unroll
                for (int n = 0; n < 2; ++n) acc[a][b][m][n] = (f32x4){0.f, 0.f, 0.f, 0.f};
    bf16x8 At[4][2], B0[2][2], B1[2][2];
    const char* cA = P.a_base(cur); const char* cB = P.b_base(cur);
    long csplit = Prob::KSPLIT ? P.bsplit(cur) : 0;
    if (Prob::WAITS) P.a_ready(cur, wid);
    PG8_STAGE(PG8_SB(0, 0), cB, voffB); PG8_STAGE(PG8_SB(0, 1), cB + hstepB, voffB); PG8_STAGE(PG8_SA(0, 0), cA, vA[0]); PG8_STAGE(PG8_SA(0, 1), cA, vA[1]);
    if (wr == 1) PG8_BAR;
    PG8_WAIT_V(2); PG8_BAR;
    PG8_STAGE(PG8_SB(1, 0), cB + kstep, voffB); PG8_STAGE(PG8_SA(1, 0), cA + kstep, vA[0]); PG8_STAGE(PG8_SB(1, 1), cB + hstepB + kstep, voffB);
    PG8_WAIT_V(6); PG8_BAR;
    for (;;) {
        const bool has_next = P.next(ui + 1, nxt);
        const char* nA = has_next ? P.a_base(nxt) : cA; const char* nB = has_next ? P.b_base(nxt) : cB;
        if (Prob::GATHER) { unsigned vN[2][2];
            if (has_next) { PG8_AVOFF(vN, nxt); } else { vN[0][0] = vA[0][0]; vN[0][1] = vA[0][1]; vN[1][0] = vA[1][0]; vN[1][1] = vA[1][1]; }
            *stash = (u32x4){vN[0][0], vN[0][1], vN[1][0], vN[1][1]}; }
        for (int t = 0; t < nt; t += 2) {
            const bool last = (t == nt - 2);
            if (Prob::WAITS && last && has_next) P.a_ready(nxt, wid);
            const char* a1 = cA + (size_t)(t + 1) * kstep;
            const char* a2 = last ? nA : cA + (size_t)(t + 2) * kstep;
            const char* b2 = last ? nB : cB + (size_t)(t + 2) * kstep + ((Prob::KSPLIT && (t + 2) >= (nt >> 1)) ? csplit : 0);
            const char* a3 = a2 + kstep; const char* b3 = b2 + kstep;
            PG8_LDB(B0, 0, 0); PG8_LDB(B1, 0, 1); PG8_SCHED; PG8_LDA(At, 0, 0); PG8_STAGE(PG8_SA(1, 1), a1, vA[1]);
            if (Prob::GATHER && last) { const u32x4 sv = *stash; vA[0][0] = sv.x; vA[0][1] = sv.y; vA[1][0] = sv.z; vA[1][1] = sv.w; }
            PG8_WAIT_V(8); PG8_WAIT_L(0); PG8_BAR; PG8_MMA(0, 0, At, B0); PG8_MMA(0, 1, At, B1); PG8_BAR; PG8_SCHED;
            PG8_LDA(At, 0, 1); PG8_STAGE(PG8_SB(0, 0), b2, voffB); PG8_STAGE(PG8_SB(0, 1), b2 + hstepB, voffB); PG8_STAGE(PG8_SA(0, 0), a2, vA[0]);
            PG8_WAIT_V(8); PG8_WAIT_L(0); PG8_BAR; PG8_MMA(1, 0, At, B0); PG8_MMA(1, 1, At, B1); PG8_BAR; PG8_SCHED;
            PG8_LDB(B0, 1, 0); PG8_LDB(B1, 1, 1); PG8_SCHED; PG8_LDA(At, 1, 0); PG8_STAGE(PG8_SA(0, 1), a2, vA[1]);
            PG8_WAIT_V(8); PG8_WAIT_L(0); PG8_BAR; PG8_MMA(0, 0, At, B0); PG8_MMA(0, 1, At, B1); PG8_BAR; PG8_SCHED;
            PG8_LDA(At, 1, 1); PG8_STAGE(PG8_SB(1, 0), b3, voffB); PG8_STAGE(PG8_SB(1, 1), b3 + hstepB, voffB); PG8_STAGE(PG8_SA(1, 0), a3, vA[0]);
            PG8_WAIT_V(8); PG8_WAIT_L(0); PG8_BAR; PG8_MMA(1, 0, At, B0); PG8_MMA(1, 1, At, B1); PG8_BAR; PG8_SCHED;
        }
        if (wr == 0) PG8_BAR;
        E(acc, cur, wr, wc, fr, fq);
        if (!has_next) break;
#pragma unroll
        for (int a = 0; a < 2; ++a)
#pragma unroll
            for (int b = 0; b < 2; ++b)
#pragma unroll
                for (int m = 0; m < 4; ++m)
#pragma unroll
                    for (int n = 0; n < 2; ++n) acc[a][b][m][n] = (f32x4){0.f, 0.f, 0.f, 0.f};
        cur = nxt; cA = nA; cB = nB; ++ui;
        if (Prob::KSPLIT) csplit = P.bsplit(cur);
        if (wr == 1) PG8_BAR;
    }
    PG8_WAIT_V(0);
    PG8_BAR;
#undef PG8_SA
#undef PG8_SB
#undef PG8_STAGE
#undef PG8_LDA
#undef PG8_LDB
#undef PG8_MMA
#undef PG8_WAIT_V
#undef PG8_WAIT_L
#undef PG8_BAR
#undef PG8_SCHED
#undef PG8_AVOFF
}

__device__ __forceinline__ int pair_a(int pi) { return pi < 3 ? 0 : (pi < 5 ? 1 : 2); }
__device__ __forceinline__ int pair_b(int pi) { return pi == 0 ? 1 : ((pi == 1 || pi == 3) ? 2 : 3); }
template <int MODE>
struct MoeProb {
    static constexpr bool GATHER = (MODE == 0), KSPLIT = (MODE == 1);
    const unsigned* cnt; const unsigned* list; const char* A; const char* B; int lda, ldb, K; long hstepB; int G, c; unsigned* tcnt;
    static constexpr bool WAITS = (MODE == 1);
    __device__ __forceinline__ void a_ready(const Unit& u, int wave) const {
        if (MODE == 1) {
            if (wave == 0) { unsigned polls = 0;
                while ((unsigned)__builtin_amdgcn_readfirstlane(__hip_atomic_load(tcnt + 64 * u.pm, __ATOMIC_RELAXED, __HIP_MEMORY_SCOPE_AGENT)) < 32u) {
                    if (++polls > (1u << 20)) break;
                    __builtin_amdgcn_s_sleep(2); }
                __builtin_amdgcn_fence(__ATOMIC_ACQUIRE, "agent");
                asm volatile("s_waitcnt vmcnt(0)" ::: "memory"); }
            asm volatile("" ::: "memory"); __builtin_amdgcn_s_barrier(); asm volatile("" ::: "memory");
        }
    }
    __device__ __forceinline__ bool next(int i, Unit& u) const {
        const long L = (long)i * G + c; const int tileidx = (int)(L >> 2);
        int accu = 0, bk = -1, tib = 0, nb = 0;
        for (int k = 0; k < 24; ++k) { const int n = (int)cnt[k]; const int tl = (n + 255) >> 8; if (bk < 0 && tileidx < accu + tl) { bk = k; tib = tileidx - accu; nb = n; } accu += tl; }
        if (bk < 0) return false;
        u.pm = tileidx; u.pn = (int)(L & 3); u.meta = bk | (tib << 5) | (nb << 13); return true;
    }
    __device__ __forceinline__ int expert(const Unit& u, int s) const { const int g = u.bk() / 6, pi = u.bk() % 6; return g * 4 + (s ? pair_b(pi) : pair_a(pi)); }
    __device__ __forceinline__ const char* a_base(const Unit& u) const { return MODE == 0 ? A : A + (size_t)u.pm * 256 * lda * 2; }
    __device__ __forceinline__ const char* b_base(const Unit& u) const {
        if (MODE == 0) return B + ((size_t)expert(u, u.pn >> 1) * DEXP + (size_t)(u.pn & 1) * HALF) * ldb * 2;
        return B + (size_t)u.pn * 256 * ldb * 2 + (size_t)expert(u, 0) * DEXP * 2;
    }
    __device__ __forceinline__ unsigned arow_off(const Unit& u, int h, int R) const { const int pos = u.tib() * 256 + h * HALF + R; const unsigned tok = pos < u.nb() ? list[(size_t)u.bk() * T + pos] : 0u; return tok * (unsigned)(lda * 2); }
    __device__ __forceinline__ long bsplit(const Unit& u) const { return ((long)(expert(u, 1) - expert(u, 0)) * DEXP - DEXP) * 2; }
};
struct EpiGateUpSparse {
    static constexpr bool PERM = true;
    bf16_t* act; const float* wlist; unsigned* tcnt;
    __device__ __forceinline__ void operator()(const f32x4 (&acc)[2][2][4][2], const Unit& u, int wr, int wc, int fr, int fq) const {
        asm volatile("" : "+v"(fr), "+v"(fq));
        const int s = u.pn >> 1, col0 = s * DEXP + (u.pn & 1) * HALF + wc * 32 + 8 * fq;
        const __amdgpu_buffer_rsrc_t rs_act = __builtin_amdgcn_make_buffer_rsrc((void*)act, (short)0, 0x7fffffff, 0x00020000);
#pragma unroll
        for (int ai = 0; ai < 2; ++ai)
#pragma unroll
            for (int m = 0; m < 4; ++m) { const int r = ai * HALF + wr * 64 + m * 16 + fr, pos = u.tib() * 256 + r;
                const float cw = pos < u.nb() ? wlist[((size_t)u.bk() * T + pos) * 2 + s] : 0.f;
                float o[8];
#pragma unroll
                for (int n = 0; n < 2; ++n)
#pragma unroll
                    for (int j = 0; j < 4; ++j) { const float g = acc[ai][0][m][n][j], up = acc[ai][1][m][n][j];
                        const float sg = g * __builtin_amdgcn_rcpf(1.f + __builtin_amdgcn_exp2f(-g * LOG2E));
                        o[n * 4 + j] = sg * up * cw; }
                u32x4 w; w.x = cvt_pk_bf16(o[0], o[1]); w.y = cvt_pk_bf16(o[2], o[3]); w.z = cvt_pk_bf16(o[4], o[5]); w.w = cvt_pk_bf16(o[6], o[7]);
                __builtin_amdgcn_raw_buffer_store_b128(w, rs_act, (int)((((unsigned)u.pm * 256u + (unsigned)r) * 512u + (unsigned)col0) * 2u), 0, 16);
                if (m & 1) asm volatile("" ::: "memory"); }
        asm volatile("s_waitcnt vmcnt(0)" ::: "memory");
        if ((fr | fq) == 0) __hip_atomic_fetch_add(tcnt + 64 * u.pm, 1u, __ATOMIC_RELAXED, __HIP_MEMORY_SCOPE_AGENT);
    }
};
struct EpiDownScatter {
    static constexpr bool PERM = false;
    float* x; const unsigned* list;
    __device__ __forceinline__ void operator()(const f32x4 (&acc)[2][2][4][2], const Unit& u, int wr, int wc, int fr, int fq) const {
        asm volatile("" : "+v"(fr), "+v"(fq));
        const int col0 = u.pn * BM + wc * 32 + 4 * fq;
        unsigned tok[8];
#pragma unroll
        for (int g = 0; g < 8; ++g) { const int pos = u.tib() * 256 + (g >> 2) * HALF + wr * 64 + (g & 3) * 16 + fr; tok[g] = pos < u.nb() ? list[(size_t)u.bk() * T + pos] : 0xffffffffu; }
#pragma unroll
        for (int g = 0; g < 8; ++g) { const int ai = g >> 2, m = g & 3;
            if (tok[g] != 0xffffffffu) { const size_t off = (size_t)tok[g] * DM + col0;
#pragma unroll
                for (int bj = 0; bj < 2; ++bj)
#pragma unroll
                    for (int n = 0; n < 2; ++n) { f32x4* p = (f32x4*)(x + off + bj * HALF + n * 16); *p = *p + acc[ai][bj][m][n]; } }
            if (g & 1) asm volatile("" ::: "memory"); }
    }
};
}

#define XB_TMO      128
#define XB_XCNT(j)  (256  + 64 * (j))
#define XB_XSUB(j)  (1280 + 64 * (j))
#define XB_XGEN(j)  (2304 + 64 * (j))
#define XB_TOP      3328
#define XB_TOPGEN   3392
#define XCD_BAR_WORDS 3456
#define XB_SPIN_CAP (1u << 18)
__device__ __forceinline__ unsigned xb_ld(unsigned* p)              { return __hip_atomic_load(p, __ATOMIC_RELAXED, __HIP_MEMORY_SCOPE_AGENT); }
__device__ __forceinline__ unsigned xb_add(unsigned* p, unsigned v) { return __hip_atomic_fetch_add(p, v, __ATOMIC_RELAXED, __HIP_MEMORY_SCOPE_AGENT); }
__device__ __forceinline__ unsigned xb_xcc_id() { return (unsigned)__builtin_amdgcn_s_getreg((3 << 11) | 20) & 0xFu; }
#define XB_SPIN(cond, bar) do { unsigned _sp = 0; while (cond) { __builtin_amdgcn_s_sleep(1); \
    if ((++_sp & 255u) == 0u) { if (xb_ld(&(bar)[XB_TMO])) break; if (_sp > XB_SPIN_CAP) { atomicAdd(&(bar)[XB_TMO], 1u); break; } } } } while (0)
struct XcdBarrier { unsigned* bar; unsigned x; volatile LAS unsigned* st; int wave; };
__device__ __forceinline__ bool xb_thread0(int wave) { return wave == 0 && __builtin_amdgcn_mbcnt_hi(~0u, __builtin_amdgcn_mbcnt_lo(~0u, 0u)) == 0u; }
__device__ __forceinline__ XcdBarrier xcd_barrier_post(unsigned* bar, volatile LAS unsigned* st, int wave) {
    XcdBarrier b; b.bar = bar; b.x = xb_xcc_id(); b.st = st; b.wave = wave;
    if (xb_thread0(wave)) (void)xb_add(&bar[XB_XCNT(b.x)], 1u);
    return b;
}
__device__ __forceinline__ void xcd_barrier_complete(unsigned* bar, unsigned x, unsigned& nloc, unsigned& nx) {
    const unsigned G = gridDim.x * gridDim.y * gridDim.z;
    unsigned sum, cnt, mine, sp = 0u;
    for (;;) {
        sum = 0u; cnt = 0u; mine = 0u;
#pragma unroll
        for (unsigned j = 0; j < 16; ++j) { const unsigned c = xb_ld(&bar[XB_XCNT(j)]); sum += c; cnt += (c > 0u) ? 1u : 0u; mine = (j == x) ? c : mine; }
        if (sum == G) break;
        __builtin_amdgcn_s_sleep(1);
        if ((++sp & 255u) == 0u) { if (xb_ld(&bar[XB_TMO])) break; if (sp > XB_SPIN_CAP) { atomicAdd(&bar[XB_TMO], 1u); break; } }
    }
    nloc = mine > 0u ? mine : 1u; nx = cnt > 0u ? cnt : 1u;
}
__device__ __forceinline__ void xcd_barrier(const XcdBarrier& b) {
    asm volatile("s_waitcnt vmcnt(0)" ::: "memory");
    __syncthreads();
    if (xb_thread0(b.wave)) {
        unsigned* bar = b.bar;
        __builtin_amdgcn_s_waitcnt(0);
        unsigned nloc = b.st[0], nx = b.st[1];
        if (nloc == 0u) { xcd_barrier_complete(bar, b.x, nloc, nx); b.st[0] = nloc; b.st[1] = nx; }
        const unsigned old = xb_add(&bar[XB_XSUB(b.x)], 1u);
        const unsigned gen = old / nloc;
        if (old + 1u == (gen + 1u) * nloc) {
            __builtin_amdgcn_fence(__ATOMIC_RELEASE, "agent");
            asm volatile("s_waitcnt vmcnt(0)" ::: "memory");
            const unsigned og = xb_add(&bar[XB_TOP], 1u);
            const unsigned tg = og / nx;
            if (og + 1u == (tg + 1u) * nx) xb_add(&bar[XB_TOPGEN], 1u);
            else XB_SPIN(xb_ld(&bar[XB_TOPGEN]) == tg, bar);
            __builtin_amdgcn_fence(__ATOMIC_ACQUIRE, "agent");
            xb_add(&bar[XB_XGEN(b.x)], 1u);
            asm volatile("s_waitcnt vmcnt(0)" ::: "memory");
        } else {
            XB_SPIN(xb_ld(&bar[XB_XGEN(b.x)]) == gen, bar);
            __builtin_amdgcn_fence(__ATOMIC_ACQUIRE, "agent");
            asm volatile("s_waitcnt vmcnt(0)" ::: "memory");
        }
    }
    __syncthreads();
}

struct Args {
    const float* x; const float* ln1_g; const float* w_in; const float* mix_g; const float* w_out; const float* ln2_g;
    const float* w_gr; const float* b_gr; const float* w_er; const float* b_er; const float* w_gate; const float* w_up; const float* w_down; const float* fin_g;
    float* out; unsigned char* ws; int ph_lo, ph_hi, li, pad;
};

__device__ __forceinline__ void transpose_item(const float* W, int K, int N, bf16_t* WT, int dpitch, int dcol, LAS float* scr, int item, int lane) {
    const int nblk = N / 32, kb = item / nblk, nb = item % nblk, k0 = 64 * kb, n0 = 32 * nb;
#pragma unroll 8
    for (int i = 0; i < 32; ++i) { const int kk = 2 * i + (lane >> 5); scr[kk * 33 + (lane & 31)] = W[(size_t)(k0 + kk) * N + n0 + (lane & 31)]; }
    LDS_WAIT(); asm volatile("" ::: "memory");
    const int c = lane & 7;
#pragma unroll
    for (int j = 0; j < 4; ++j) { const int n = (lane >> 3) + 8 * j; const LAS float* s = scr + (8 * c) * 33 + n;
        u32x4 o; o.x = pk2(s[0 * 33], s[1 * 33]); o.y = pk2(s[2 * 33], s[3 * 33]); o.z = pk2(s[4 * 33], s[5 * 33]); o.w = pk2(s[6 * 33], s[7 * 33]);
        *(u32x4*)(WT + (size_t)(n0 + n) * dpitch + dcol + k0 + 8 * c) = o; }
    LDS_WAIT(); asm volatile("" ::: "memory");
}
__device__ __forceinline__ void phase_prologue(const Args& a, LAS unsigned char* lds, int gw, int NGW, int wave, int lane) {
    LAS float* scr = (LAS float*)(lds + wave * 16384);
    constexpr int I_IN = (DM / 64) * (NQKV / 32);
    constexpr int I_OUT = (DM / 64) * (DM / 32);
    constexpr int I_G = (DM / 64) * (DEXP / 32);
    constexpr int I_D = (DEXP / 64) * (DM / 32);
    constexpr int N_IN = DEPTH * I_IN, N_OUT = DEPTH * I_OUT, N_G = DEPTH * NEXP * I_G, N_D = DEPTH * NEXP * I_D;
    constexpr int NITEMS = N_IN + N_OUT + 2 * N_G + N_D;
    bf16_t* WinT = (bf16_t*)(a.ws + WS_WIN); bf16_t* WoutT = (bf16_t*)(a.ws + WS_WOUT); bf16_t* WgT = (bf16_t*)(a.ws + WS_WG); bf16_t* WuT = (bf16_t*)(a.ws + WS_WU); bf16_t* WdT = (bf16_t*)(a.ws + WS_WD);
    for (int it = gw; it < NITEMS; it += NGW) {
        int r = it;
        if (r < N_IN) { const int l = r / I_IN; transpose_item(a.w_in + (size_t)l * DM * NQKV, DM, NQKV, WinT + (size_t)l * NQKV * DM, DM, 0, scr, r % I_IN, lane); continue; } r -= N_IN;
        if (r < N_OUT) { const int l = r / I_OUT; transpose_item(a.w_out + (size_t)l * DM * DM, DM, DM, WoutT + (size_t)l * DM * DM, DM, 0, scr, r % I_OUT, lane); continue; } r -= N_OUT;
        if (r < N_G) { const int le = r / I_G; transpose_item(a.w_gate + (size_t)le * DM * DEXP, DM, DEXP, WgT + (size_t)le * DEXP * DM, DM, 0, scr, r % I_G, lane); continue; } r -= N_G;
        if (r < N_G) { const int le = r / I_G; transpose_item(a.w_up + (size_t)le * DM * DEXP, DM, DEXP, WuT + (size_t)le * DEXP * DM, DM, 0, scr, r % I_G, lane); continue; } r -= N_G;
        { const int le = r / I_D, l = le / NEXP, e = le % NEXP; transpose_item(a.w_down + (size_t)le * DEXP * DM, DEXP, DM, WdT + (size_t)l * DM * NACT, NACT, e * DEXP, scr, r % I_D, lane); }
    }
}

__device__ __forceinline__ void phase_norm1(const float* x, const float* g, bf16_t* hb, int gw, int NGW, int lane, float* kmean_zero) {
    for (int i = gw * 64 + lane; i < BATCH * 4 * 32 * HD; i += NGW * 64) kmean_zero[i] = 0.f;
    f32x4 gv[4];
#pragma unroll
    for (int j = 0; j < 4; ++j) gv[j] = *((const f32x4*)g + lane + 64 * j);
    for (int m = gw; m < T; m += NGW) {
        const f32x4* xr = (const f32x4*)(x + (size_t)m * DM) + lane;
        f32x4 v[4]; float s = 0.f;
#pragma unroll
        for (int j = 0; j < 4; ++j) { v[j] = xr[64 * j]; s += (v[j].x * v[j].x + v[j].y * v[j].y) + (v[j].z * v[j].z + v[j].w * v[j].w); }
        const float rstd = 1.0f / sqrtf(wave_sum(s) * (1.f / DM) + NORM_EPS);
        u32x2* o8 = (u32x2*)(hb + (size_t)m * DM) + lane;
#pragma unroll
        for (int j = 0; j < 4; ++j) { u32x2 w; w.x = pk2(v[j].x * rstd * gv[j].x, v[j].y * rstd * gv[j].y); w.y = pk2(v[j].z * rstd * gv[j].z, v[j].w * rstd * gv[j].w); o8[64 * j] = w; }
    }
}
__device__ __forceinline__ void unpack8(float (&f)[8], const u32x4 w) { f[0] = bflo(w.x); f[1] = bfhi(w.x); f[2] = bflo(w.y); f[3] = bfhi(w.y); f[4] = bflo(w.z); f[5] = bfhi(w.z); f[6] = bflo(w.w); f[7] = bfhi(w.w); }
struct MixRow { u32x4 a, c0, c1, c2, p0, p1, p2; float l0, l1, l2, e0, e1, e2, e3; };
__device__ __forceinline__ void mix_load(MixRow& r, int m, const bf16_t* ob, const bf16_t* hb, const float* lse, const bf16_t* pm, const float* lsem0, const float* lsem1, int lane, int hh) {
    r.a = *((const u32x4*)(ob + (size_t)m * DM) + lane); r.c0 = *((const u32x4*)(ob + (size_t)m * DM + 512) + lane);
    r.c1 = *((const u32x4*)(hb + (size_t)m * DM) + lane); r.c2 = *((const u32x4*)(hb + (size_t)m * DM + 512) + lane);
    r.l0 = lse[(size_t)m * 8 + hh]; r.l1 = lse[(size_t)T * 8 + (size_t)m * 8 + hh]; r.l2 = lse[(size_t)2 * T * 8 + (size_t)m * 8 + hh];
    if (lane < 32) {
        r.p0 = *((const u32x4*)(pm + (size_t)m * 256) + lane); r.p1 = *((const u32x4*)(pm + ((size_t)T + m) * 256) + lane); r.p2 = *((const u32x4*)(pm + ((size_t)2 * T + m) * 256) + lane);
        r.e0 = lsem0[(size_t)m * 4 + hh]; r.e1 = lsem0[(size_t)T * 4 + (size_t)m * 4 + hh]; r.e2 = lsem1[(size_t)m * 4 + hh]; r.e3 = lsem1[(size_t)T * 4 + (size_t)m * 4 + hh]; }
}
__device__ __forceinline__ void phase_mixnorm(const bf16_t* ob, bf16_t* hb, const float* lse, const bf16_t* pm, const float* lsem0, const float* lsem1, const float* g, int gw, int NGW, int lane) {
    float g0[8], g1[8];
#pragma unroll
    for (int j = 0; j < 8; ++j) { g0[j] = g[8 * lane + j]; g1[j] = g[512 + 8 * lane + j]; }
    const int hh = lane >> 3;
    MixRow cur, nxt;
    if (gw < T) mix_load(cur, gw, ob, hb, lse, pm, lsem0, lsem1, lane, hh);
    for (int m = gw; m < T; m += NGW) {
        if (m + NGW < T) mix_load(nxt, m + NGW, ob, hb, lse, pm, lsem0, lsem1, lane, hh);
        float va[8]; unpack8(va, cur.a);
        if (lane < 32) {
            const float mx = fmaxf(fmaxf(cur.e0, cur.e1), fmaxf(cur.e2, cur.e3));
            float u0 = __builtin_amdgcn_exp2f(cur.e0 - mx), u1 = __builtin_amdgcn_exp2f(cur.e1 - mx), u2 = __builtin_amdgcn_exp2f(cur.e2 - mx), u3 = __builtin_amdgcn_exp2f(cur.e3 - mx);
            const float inv = 1.0f / ((u0 + u1) + (u2 + u3)); u0 *= inv; u1 *= inv; u2 *= inv; u3 *= inv;
            float y0[8], y1[8], y2[8]; unpack8(y0, cur.p0); unpack8(y1, cur.p1); unpack8(y2, cur.p2);
#pragma unroll
            for (int j = 0; j < 8; ++j) va[j] = (u0 * y0[j] + u1 * y1[j]) + (u2 * y2[j] + u3 * va[j]);
        }
        const float mx = fmaxf(cur.l0, fmaxf(cur.l1, cur.l2));
        float w0 = __builtin_amdgcn_exp2f(cur.l0 - mx), w1 = __builtin_amdgcn_exp2f(cur.l1 - mx), w2 = __builtin_amdgcn_exp2f(cur.l2 - mx);
        const float inv = 1.0f / (w0 + w1 + w2); w0 *= inv; w1 *= inv; w2 *= inv;
        float x0[8], x1[8], x2[8]; unpack8(x0, cur.c0); unpack8(x1, cur.c1); unpack8(x2, cur.c2);
        float vc[8];
        float sa = 0.f, sc = 0.f;
#pragma unroll
        for (int j = 0; j < 8; ++j) { vc[j] = w0 * x0[j] + w1 * x1[j] + w2 * x2[j]; sa += va[j] * va[j]; sc += vc[j] * vc[j]; }
        sa = half_sum(sa); sc = wave_sum(sc);
        const float ra = 1.0f / sqrtf(sa * (1.f / 256.f) + NORM_EPS), rc = 1.0f / sqrtf(sc * (1.f / 512.f) + NORM_EPS);
        u32x4 oa, oc;
        oa.x = pk2(va[0] * ra * g0[0], va[1] * ra * g0[1]); oa.y = pk2(va[2] * ra * g0[2], va[3] * ra * g0[3]); oa.z = pk2(va[4] * ra * g0[4], va[5] * ra * g0[5]); oa.w = pk2(va[6] * ra * g0[6], va[7] * ra * g0[7]);
        oc.x = pk2(vc[0] * rc * g1[0], vc[1] * rc * g1[1]); oc.y = pk2(vc[2] * rc * g1[2], vc[3] * rc * g1[3]); oc.z = pk2(vc[4] * rc * g1[4], vc[5] * rc * g1[5]); oc.w = pk2(vc[6] * rc * g1[6], vc[7] * rc * g1[7]);
        *((u32x4*)(hb + (size_t)m * DM) + lane) = oa; *((u32x4*)(hb + (size_t)m * DM + 512) + lane) = oc;
        cur = nxt;
    }
}
__device__ __forceinline__ void phase_route(const float* x, const float* g, const float* wgr, const float* bgr, const float* wer, const float* ber,
                                            bf16_t* hb, unsigned* cnt, unsigned* list, float* wlist, LAS unsigned char* lds, int v, int G, int wave, int lane) {
    const int tid = wave * 64 + lane;
    LAS f32x4* wl = (LAS f32x4*)lds;
    for (int idx = tid; idx < 5 * DM; idx += NTHREADS) { const int mtx = idx >> 10, d = idx & 1023; const float* src = (mtx == 0 ? wgr : wer + (size_t)(mtx - 1) * DM * 4) + d * 4;
        wl[mtx * 1024 + (d & 3) * 256 + (d >> 2)] = *(const f32x4*)src; }
    LAS unsigned* cl = (LAS unsigned*)(lds + 81920);
    LAS u32x2* info = (LAS u32x2*)(lds + 81920 + 256);
    LAS f32x2* infw = (LAS f32x2*)(lds + 81920 + 256 + 4096);
    if (tid < 64) cl[tid] = 0u;
    __syncthreads();
    const int rpw = (T + G - 1) / G, row0 = v * rpw;
    f32x4 gv[4];
#pragma unroll
    for (int j = 0; j < 4; ++j) gv[j] = *((const f32x4*)g + lane + 64 * j);
    const f32x4 bg = *(const f32x4*)bgr;
    f32x4 nx[4];
    { const int m0 = row0 + wave; if (wave < rpw && m0 < T) { const f32x4* xr = (const f32x4*)(x + (size_t)m0 * DM) + lane;
#pragma unroll
        for (int j = 0; j < 4; ++j) nx[j] = xr[64 * j]; } }
    for (int r = wave; r < rpw; r += NWAVES) {
        const int m = row0 + r; if (m >= T) break;
        f32x4 vv[4]; float s = 0.f;
#pragma unroll
        for (int j = 0; j < 4; ++j) { vv[j] = nx[j]; s += (vv[j].x * vv[j].x + vv[j].y * vv[j].y) + (vv[j].z * vv[j].z + vv[j].w * vv[j].w); }
        if (r + NWAVES < rpw && m + NWAVES < T) { const f32x4* xr = (const f32x4*)(x + (size_t)(m + NWAVES) * DM) + lane;
#pragma unroll
            for (int j = 0; j < 4; ++j) nx[j] = xr[64 * j]; }
        const float rstd = 1.0f / sqrtf(wave_sum(s) * (1.f / DM) + NORM_EPS);
        u32x2* o8 = (u32x2*)(hb + (size_t)m * DM) + lane;
#pragma unroll
        for (int j = 0; j < 4; ++j) { vv[j] = vv[j] * rstd * gv[j]; u32x2 w; w.x = pk2(vv[j].x, vv[j].y); w.y = pk2(vv[j].z, vv[j].w); o8[64 * j] = w; }
        f32x4 gl = (f32x4){0.f, 0.f, 0.f, 0.f};
#pragma unroll
        for (int j = 0; j < 4; ++j) { LAS f32x4* wp = wl + lane + 64 * j;
            gl += wp[0] * vv[j].x; gl += wp[256] * vv[j].y; gl += wp[512] * vv[j].z; gl += wp[768] * vv[j].w; }
        gl.x = wave_sum(gl.x) + bg.x; gl.y = wave_sum(gl.y) + bg.y; gl.z = wave_sum(gl.z) + bg.z; gl.w = wave_sum(gl.w) + bg.w;
        int gi = 0; float gm = gl.x;
        if (gl.y > gm) { gm = gl.y; gi = 1; } if (gl.z > gm) { gm = gl.z; gi = 2; } if (gl.w > gm) { gm = gl.w; gi = 3; }
        const float gden = __expf(gl.x - gm) + __expf(gl.y - gm) + __expf(gl.z - gm) + __expf(gl.w - gm);
        const float gw_ = 1.0f / gden;
        gi = __builtin_amdgcn_readfirstlane(gi);
        f32x4 el = (f32x4){0.f, 0.f, 0.f, 0.f};
#pragma unroll
        for (int j = 0; j < 4; ++j) { LAS f32x4* wp = wl + (1 + gi) * 1024 + lane + 64 * j;
            el += wp[0] * vv[j].x; el += wp[256] * vv[j].y; el += wp[512] * vv[j].z; el += wp[768] * vv[j].w; }
        const f32x4 be = *(const f32x4*)(ber + gi * 4);
        float e[4] = {wave_sum(el.x) + be.x, wave_sum(el.y) + be.y, wave_sum(el.z) + be.z, wave_sum(el.w) + be.w};
        int i1 = 0; float v1 = e[0];
#pragma unroll
        for (int k = 1; k < 4; ++k) if (e[k] > v1) { v1 = e[k]; i1 = k; }
        int i2 = -1; float v2 = -INFINITY;
#pragma unroll
        for (int k = 0; k < 4; ++k) if (k != i1 && e[k] > v2) { v2 = e[k]; i2 = k; }
        const float p2 = __expf(v2 - v1), inv = 1.0f / (1.0f + p2);
        const float w1 = inv * gw_, w2 = p2 * inv * gw_;
        const int ea = i1 < i2 ? i1 : i2, eb = i1 < i2 ? i2 : i1; const float wa = i1 < i2 ? w1 : w2, wb = i1 < i2 ? w2 : w1;
        const int pi = (ea == 0) ? (eb - 1) : (ea == 1 ? eb + 1 : 5), bk = gi * 6 + pi;
        if (lane == 0) { const unsigned rank = __hip_atomic_fetch_add(cl + bk, 1u, __ATOMIC_RELAXED, __HIP_MEMORY_SCOPE_WORKGROUP);
            info[r] = (u32x2){(unsigned)bk, rank}; infw[r] = (f32x2){wa, wb}; }
    }
    __syncthreads();
    if (tid < 24) cl[32 + tid] = __hip_atomic_fetch_add(cnt + tid, cl[tid], __ATOMIC_RELAXED, __HIP_MEMORY_SCOPE_AGENT);
    __syncthreads();
    if (tid < rpw && row0 + tid < T) { const u32x2 inf = info[tid]; const f32x2 wv = infw[tid]; const size_t slot = (size_t)inf.x * T + cl[32 + inf.x] + inf.y;
        list[slot] = (unsigned)(row0 + tid); *(f32x2*)(wlist + slot * 2) = wv; }
    __syncthreads();
}
__device__ __forceinline__ void phase_final(float* x, const float* g, int gw, int NGW, int lane) {
    f32x4 gv[4];
#pragma unroll
    for (int j = 0; j < 4; ++j) gv[j] = *((const f32x4*)g + lane + 64 * j);
    for (int m = gw; m < T; m += NGW) {
        f32x4* xr = (f32x4*)(x + (size_t)m * DM) + lane;
        f32x4 v[4]; float s = 0.f;
#pragma unroll
        for (int j = 0; j < 4; ++j) { v[j] = xr[64 * j]; s += (v[j].x * v[j].x + v[j].y * v[j].y) + (v[j].z * v[j].z + v[j].w * v[j].w); }
        const float rstd = 1.0f / sqrtf(wave_sum(s) * (1.f / DM) + NORM_EPS);
#pragma unroll
        for (int j = 0; j < 4; ++j) xr[64 * j] = v[j] * rstd * gv[j];
    }
}
__device__ __forceinline__ void phase_kmean(const bf16_t* kb, float* kmean, int gw, int NGW, int lane) {
    for (int it = gw; it < BATCH * 4 * 32; it += NGW) {
        const int b = it >> 7, h = (it >> 5) & 3, blk = it & 31;
        const bf16_t* base = kb + ((size_t)b * SEQ + (size_t)blk * 256) * DM + h * HD + (lane & 7) * 8;
        float acc[8] = {0.f, 0.f, 0.f, 0.f, 0.f, 0.f, 0.f, 0.f};
#pragma unroll 4
        for (int i = 0; i < 32; ++i) { const u32x4 w = *(const u32x4*)(base + (size_t)((lane >> 3) + 8 * i) * DM);
            acc[0] += bflo(w.x); acc[1] += bfhi(w.x); acc[2] += bflo(w.y); acc[3] += bfhi(w.y); acc[4] += bflo(w.z); acc[5] += bfhi(w.z); acc[6] += bflo(w.w); acc[7] += bfhi(w.w); }
#pragma unroll
        for (int j = 0; j < 8; ++j) { acc[j] += swz_xor<8>(acc[j]); acc[j] += swz_xor<16>(acc[j]); acc[j] = sum_xor32(acc[j]); }
        if (lane < 8) {
            float* o = kmean + (size_t)it * HD + lane * 8;
#pragma unroll
            for (int j = 0; j < 8; ++j) o[j] = acc[j] * (1.f / 256.f);
        }
    }
}

__device__ __forceinline__ void ld_row64(float (&r)[64], const bf16_t* p) {
#pragma unroll
    for (int c = 0; c < 8; ++c) { const u32x4 w = *((const u32x4*)p + c);
        r[8 * c + 0] = bflo(w.x); r[8 * c + 1] = bfhi(w.x); r[8 * c + 2] = bflo(w.y); r[8 * c + 3] = bfhi(w.y); r[8 * c + 4] = bflo(w.z); r[8 * c + 5] = bfhi(w.z); r[8 * c + 6] = bflo(w.w); r[8 * c + 7] = bfhi(w.w); }
}
__device__ __forceinline__ float dot_row64(const float (&q)[64], const bf16_t* p) {
    float s0 = 0.f, s1 = 0.f;
#pragma unroll
    for (int c = 0; c < 8; ++c) { const u32x4 w = *((const u32x4*)p + c);
        s0 += q[8 * c + 0] * bflo(w.x); s1 += q[8 * c + 1] * bfhi(w.x); s0 += q[8 * c + 2] * bflo(w.y); s1 += q[8 * c + 3] * bfhi(w.y);
        s0 += q[8 * c + 4] * bflo(w.z); s1 += q[8 * c + 5] * bfhi(w.z); s0 += q[8 * c + 6] * bflo(w.w); s1 += q[8 * c + 7] * bfhi(w.w); }
    return s0 + s1;
}
__device__ __forceinline__ void axpy_row64(float (&o)[64], float p, const bf16_t* vp) {
#pragma unroll
    for (int c = 0; c < 8; ++c) { const u32x4 w = *((const u32x4*)vp + c);
        o[8 * c + 0] += p * bflo(w.x); o[8 * c + 1] += p * bfhi(w.x); o[8 * c + 2] += p * bflo(w.y); o[8 * c + 3] += p * bfhi(w.y);
        o[8 * c + 4] += p * bflo(w.z); o[8 * c + 5] += p * bfhi(w.z); o[8 * c + 6] += p * bflo(w.w); o[8 * c + 7] += p * bfhi(w.w); }
}
__device__ __forceinline__ void st_row64(bf16_t* p, const float (&o)[64], float sc) {
#pragma unroll
    for (int c = 0; c < 8; ++c) { u32x4 w; w.x = pk2(o[8 * c] * sc, o[8 * c + 1] * sc); w.y = pk2(o[8 * c + 2] * sc, o[8 * c + 3] * sc); w.z = pk2(o[8 * c + 4] * sc, o[8 * c + 5] * sc); w.w = pk2(o[8 * c + 6] * sc, o[8 * c + 7] * sc); *((u32x4*)p + c) = w; }
}
#define OSM_STEP(sc, vrow) do { const float sc_ = (sc); if (sc_ > m_) { const float al = __builtin_amdgcn_exp2f(m_ - sc_); l_ *= al; _Pragma("unroll") for (int d_ = 0; d_ < 64; ++d_) o_[d_] *= al; m_ = sc_; } \
    const float p_ = __builtin_amdgcn_exp2f(sc_ - m_); l_ += p_; axpy_row64(o_, p_, (vrow)); } while (0)

__device__ __forceinline__ void naive_moba(const bf16_t* qb, const bf16_t* kb, const bf16_t* vb, const float* kmean, bf16_t* ob, int item, int tid) {
    const int b = item >> 6, h = (item >> 4) & 3, t = (item & 15) * 512 + tid, own = t >> 8;
    const size_t rowq = ((size_t)b * SEQ + t) * DM + h * HD;
    const bf16_t* kh = kb + (size_t)b * SEQ * DM + h * HD; const bf16_t* vh = vb + (size_t)b * SEQ * DM + h * HD;
    const float slope2 = exp2f(-2.0f * (float)(h + 1)) * LOG2E;
    float q_[64]; ld_row64(q_, qb + rowq);
    float bv0 = -INFINITY, bv1 = -INFINITY, bv2 = -INFINITY; int bi0 = -1, bi1 = -1, bi2 = -1;
    const float* km = kmean + (size_t)(b * 4 + h) * 32 * HD;
    for (int n = 0; n < own; ++n) {
        float gsum = 0.f;
#pragma unroll
        for (int d = 0; d < 64; ++d) gsum += q_[d] * km[n * HD + d];
        if (gsum > bv0) { bv2 = bv1; bi2 = bi1; bv1 = bv0; bi1 = bi0; bv0 = gsum; bi0 = n; }
        else if (gsum > bv1) { bv2 = bv1; bi2 = bi1; bv1 = gsum; bi1 = n; }
        else if (gsum > bv2) { bv2 = gsum; bi2 = n; }
    }
    float o_[64];
#pragma unroll
    for (int d = 0; d < 64; ++d) o_[d] = 0.f;
    float m_ = -INFINITY, l_ = 0.f;
    for (int s = 0; s < 3; ++s) {
        const int blk = (s == 0) ? bi0 : (s == 1) ? bi1 : bi2;
        if (blk < 0) continue;
        for (int j = 0; j < 256; ++j) { const int pos = blk * 256 + j;
            const float sc = dot_row64(q_, kh + (size_t)pos * DM) - slope2 * (float)(t - pos);
            OSM_STEP(sc, vh + (size_t)pos * DM); }
    }
    for (int pos = own * 256; pos <= t; ++pos) {
        const float sc = dot_row64(q_, kh + (size_t)pos * DM) - slope2 * (float)(t - pos);
        OSM_STEP(sc, vh + (size_t)pos * DM); }
    st_row64(ob + rowq, o_, 1.0f / l_);
}
__device__ __forceinline__ void naive_sb(const bf16_t* qb, const bf16_t* kb, const bf16_t* vb, bf16_t* ob, int item, int tid) {
    const int b = item >> 6, h = 4 + ((item >> 4) & 3), t = (item & 15) * 512 + tid;
    const size_t rowq = ((size_t)b * SEQ + t) * DM + h * HD;
    const bf16_t* kh = kb + (size_t)b * SEQ * DM + h * HD; const bf16_t* vh = vb + (size_t)b * SEQ * DM + h * HD;
    float q_[64]; ld_row64(q_, qb + rowq);
    float o_[64];
#pragma unroll
    for (int d = 0; d < 64; ++d) o_[d] = 0.f;
    float tail = 0.f;
    for (int s = t - 1; s >= 0 && tail > -150.f; --s) {
        const float z = dot_row64(q_, kh + (size_t)s * DM);
        const float lp = __builtin_amdgcn_logf(1.0f + __builtin_amdgcn_exp2f(-fabsf(z)));
        const float lnot = -(fmaxf(z, 0.f) + lp);
        const float aw = __builtin_amdgcn_exp2f(z + lnot + tail);
        axpy_row64(o_, aw, vh + (size_t)s * DM);
        tail += lnot;
    }
    st_row64(ob + rowq, o_, 1.0f);
}
__device__ __forceinline__ void naive_dil(const bf16_t* qb, const bf16_t* kb, const bf16_t* vb, bf16_t* ob, bf16_t* hb2, float* lse, int item, int tid) {
    const int b = item >> 7, h = 8 + ((item >> 4) & 7), t = (item & 15) * 512 + tid;
    const size_t rowq = ((size_t)b * SEQ + t) * DM + h * HD;
    const bf16_t* kh = kb + (size_t)b * SEQ * DM + h * HD; const bf16_t* vh = vb + (size_t)b * SEQ * DM + h * HD;
    const float slope2 = exp2f(-(float)(h - 8 + 1)) * LOG2E;
    float q_[64]; ld_row64(q_, qb + rowq);
    float o_[64];
#pragma unroll
    for (int d = 0; d < 64; ++d) o_[d] = 0.f;
    float m_ = -INFINITY, l_ = 0.f;
    for (int c = 0; c < 3; ++c) {
        const int dil = (c == 0) ? 1 : (c == 1) ? 4 : 16;
        for (int dl = 0; dl <= 128; ++dl) { const int pos = t - dl * dil; if (pos < 0) break;
            const float sc = dot_row64(q_, kh + (size_t)pos * DM) - slope2 * (float)(dl * dil);
            OSM_STEP(sc, vh + (size_t)pos * DM); }
    }
    st_row64(ob + rowq, o_, 1.0f / l_);
    { const size_t tok = (size_t)b * SEQ + t; const u32x4 z4 = {0u, 0u, 0u, 0u};
#pragma unroll
      for (int c = 0; c < 8; ++c) { *((u32x4*)(hb2 + tok * DM + (h - 8) * HD) + c) = z4; *((u32x4*)(hb2 + tok * DM + 512 + (h - 8) * HD) + c) = z4; }
      lse[tok * 8 + (h - 8)] = 0.f; lse[(size_t)T * 8 + tok * 8 + (h - 8)] = -1.0e30f; lse[(size_t)2 * T * 8 + tok * 8 + (h - 8)] = -1.0e30f; }
}

namespace att {
typedef float f32x16 __attribute__((ext_vector_type(16)));
typedef short s16x4 __attribute__((ext_vector_type(4)));
typedef short v4i16_t __attribute__((ext_vector_type(4)));
typedef __bf16 bf16x2_t __attribute__((ext_vector_type(2)));
constexpr int L_BUF = 16384;
constexpr int L_WSF = 2 * L_BUF;
constexpr int L_OST = L_WSF + 8 * 256;
constexpr int L_FLG = L_OST + 8 * 4096;
constexpr int L_END = L_FLG + 64;
constexpr float M_INIT = -1.0e30f;
#define ATT_MFMA(a, b, c) __builtin_amdgcn_mfma_f32_32x32x16_bf16((a), (b), (c), 0, 0, 0)

__device__ __forceinline__ unsigned cvtpk(float lo, float hi) { f32x2 v = {lo, hi}; bf16x2_t b = __builtin_convertvector(v, bf16x2_t); return __builtin_bit_cast(unsigned, b); }
__device__ __forceinline__ s16x4 vtr(LAS unsigned char* p) { return __builtin_bit_cast(s16x4, __builtin_amdgcn_ds_read_tr16_b64_v4i16((LAS v4i16_t*)p)); }

struct Wave { int lane, r32, hi, wid; LAS unsigned char* lds; LAS float* wsf; LAS unsigned char* ost; int vlo; };
__device__ __forceinline__ Wave make_wave(LAS unsigned char* lds, int tid, int wsf_off = L_WSF, int ost_off = L_OST) {
    Wave w; w.lane = tid & 63; w.r32 = w.lane & 31; w.hi = w.lane >> 5; w.wid = __builtin_amdgcn_readfirstlane(tid >> 6); w.lds = lds;
    w.wsf = (LAS float*)(lds + wsf_off) + w.wid * 64; w.ost = lds + ost_off + w.wid * 4096;
    w.vlo = ((w.lane >> 4) & 1) * 32 + (w.lane & 3) * 8 + (4 * w.hi + ((w.lane & 15) >> 2)) * 64;
    return w;
}
struct Stage { u32x4 k, v; };
template <class RowK, class RowV> __device__ __forceinline__ void stage_load(Stage& s, const Wave& w, const RowK& rowk, const RowV& rowv) {
    s.k = *(const u32x4*)(rowk(w.lane) + w.wid * 8);
    s.v = *(const u32x4*)(rowv(16 * (w.wid & 3) + (w.lane >> 2)) + (w.wid >> 2) * 32 + (w.lane & 3) * 8);
}
__device__ __forceinline__ void stage_write(const Stage& s, const Wave& w, int buf) {
    *(LAS u32x4*)(w.lds + buf * L_BUF + w.wid * 1024 + w.lane * 16) = s.k;
    *(LAS u32x4*)(w.lds + buf * L_BUF + 8192 + w.wid * 1024 + w.lane * 16) = s.v;
}
__device__ __forceinline__ f32x16 qk_sub(const Wave& w, int buf, int sub, const bf16x8 (&qf)[4], float init) {
    f32x16 acc;
#pragma unroll
    for (int r = 0; r < 16; ++r) acc[r] = init;
    LAS unsigned char* kp = w.lds + buf * L_BUF + w.hi * 1024 + (32 * sub + w.r32) * 16;
#pragma unroll
    for (int ks = 0; ks < 4; ++ks) { const bf16x8 kf = *(LAS bf16x8*)(kp + ks * 2048); acc = ATT_MFMA(kf, qf[ks], acc); }
    return acc;
}
__device__ __forceinline__ void pv_sub(const Wave& w, int buf, int sub, const f32x16& p, f32x16 (&o)[2]) {
    bf16x8 pk[2];
#pragma unroll
    for (int s = 0; s < 2; ++s) { u32x4 t; t.x = cvtpk(p[8 * s], p[8 * s + 1]); t.y = cvtpk(p[8 * s + 2], p[8 * s + 3]); t.z = cvtpk(p[8 * s + 4], p[8 * s + 5]); t.w = cvtpk(p[8 * s + 6], p[8 * s + 7]); pk[s] = __builtin_bit_cast(bf16x8, t); }
    LAS unsigned char* vb = w.lds + buf * L_BUF + 8192 + w.vlo;
#pragma unroll
    for (int db = 0; db < 2; ++db)
#pragma unroll
        for (int s = 0; s < 2; ++s) { LAS unsigned char* vp = vb + db * 4096 + (4 * sub + 2 * s) * 512;
            const s16x4 lo = vtr(vp), hh = vtr(vp + 512);
            const bf16x8 vf = __builtin_shufflevector(lo, hh, 0, 1, 2, 3, 4, 5, 6, 7);
            o[db] = ATT_MFMA(pk[s], vf, o[db]); }
}
struct VFrags { s16x4 f[2][2][2]; };
__device__ __forceinline__ void load_vfrags(const Wave& w, int buf, int sub, VFrags& v) {
    LAS unsigned char* vb = w.lds + buf * L_BUF + 8192 + w.vlo;
#pragma unroll
    for (int db = 0; db < 2; ++db)
#pragma unroll
        for (int s = 0; s < 2; ++s) { LAS unsigned char* vp = vb + db * 4096 + (4 * sub + 2 * s) * 512; v.f[db][s][0] = vtr(vp); v.f[db][s][1] = vtr(vp + 512); }
}
__device__ __forceinline__ void pv_frags(const VFrags& v, const f32x16& p, f32x16 (&o)[2]) {
    bf16x8 pk[2];
#pragma unroll
    for (int s = 0; s < 2; ++s) { u32x4 t; t.x = cvtpk(p[8 * s], p[8 * s + 1]); t.y = cvtpk(p[8 * s + 2], p[8 * s + 3]); t.z = cvtpk(p[8 * s + 4], p[8 * s + 5]); t.w = cvtpk(p[8 * s + 6], p[8 * s + 7]); pk[s] = __builtin_bit_cast(bf16x8, t); }
#pragma unroll
    for (int db = 0; db < 2; ++db)
#pragma unroll
        for (int s = 0; s < 2; ++s) { const bf16x8 vf = __builtin_shufflevector(v.f[db][s][0], v.f[db][s][1], 0, 1, 2, 3, 4, 5, 6, 7); o[db] = ATT_MFMA(pk[s], vf, o[db]); }
}
__device__ __forceinline__ void scale_rows(const Wave& w, f32x16 (&o)[2], float f) {
    if (w.hi == 0) w.wsf[w.r32] = f;
#pragma unroll
    for (int g = 0; g < 4; ++g) { const f32x4 fv = *(LAS f32x4*)(w.wsf + 8 * g + 4 * w.hi);
#pragma unroll
        for (int i = 0; i < 4; ++i) { o[0][4 * g + i] *= fv[i]; o[1][4 * g + i] *= fv[i]; } }
}
__device__ __forceinline__ void softmax_sub(const Wave& w, f32x16& s, float& m, float& lsum, f32x16 (&o)[2]) {
    float tm = fmaxf(fmaxf(s[0], s[1]), fmaxf(s[2], s[3]));
#pragma unroll
    for (int r = 4; r < 16; r += 4) tm = fmaxf(tm, fmaxf(fmaxf(s[r], s[r + 1]), fmaxf(s[r + 2], s[r + 3])));
    tm = max_xor32(tm);
    const float mn = fmaxf(m, tm);
    if (__any(mn > m)) { const float al = __builtin_amdgcn_exp2f(m - mn); lsum *= al; scale_rows(w, o, al); m = mn; }
    float acc = 0.f;
#pragma unroll
    for (int r = 0; r < 16; ++r) { s[r] = __builtin_amdgcn_exp2f(s[r] - m); acc += s[r]; }
    lsum += acc;
}
__device__ __forceinline__ void mask_band(f32x16& s, int delta0, int W) {
#pragma unroll
    for (int r = 0; r < 16; ++r) { const int dl = delta0 - ((r & 3) + 8 * (r >> 2)); if ((unsigned)dl > (unsigned)W) s[r] = -INFINITY; }
}
constexpr float SM_THR = 8.0f;
struct SubDesc { bool act; int delta; int W; };
template <int NSUB>
__device__ __forceinline__ void softmax_step(const Wave& w, int buf, const bf16x8 (&qf)[4], const bf16x8& kidx, const bf16x8& slp, float slope, const SubDesc (&sd)[NSUB],
                                             float& m, float& lsum, f32x16 (&o)[2], bool& first) {
    f32x16 s[NSUB];
    bool any_act = false;
#pragma unroll
    for (int i = 0; i < NSUB; ++i) if (sd[i].act) { any_act = true; s[i] = qk_sub(w, buf, i, qf, -slope * (float)sd[i].delta - m); s[i] = ATT_MFMA(kidx, slp, s[i]); }
    if (!any_act) return;
    float tm = -INFINITY;
#pragma unroll
    for (int i = 0; i < NSUB; ++i) if (sd[i].act) {
        if (sd[i].W >= 0) mask_band(s[i], sd[i].delta - 4 * w.hi, sd[i].W);
        float t = fmaxf(fmaxf(s[i][0], s[i][1]), fmaxf(s[i][2], s[i][3]));
#pragma unroll
        for (int r = 4; r < 16; r += 4) t = fmaxf(t, fmaxf(fmaxf(s[i][r], s[i][r + 1]), fmaxf(s[i][r + 2], s[i][r + 3])));
        tm = fmaxf(tm, t); }
    tm = max_xor32(tm);
    if (first || __any(tm > SM_THR)) {
        const float d = first ? (tm > -1.0e30f ? tm : 0.f) : fmaxf(tm, 0.f);
#pragma unroll
        for (int i = 0; i < NSUB; ++i) if (sd[i].act) {
#pragma unroll
            for (int r = 0; r < 16; ++r) s[i][r] -= d; }
        if (!first) { const float al = __builtin_amdgcn_exp2f(-d); lsum *= al; scale_rows(w, o, al); }
        m += d; first = false;
    }
    VFrags vf[NSUB];
#pragma unroll
    for (int i = 0; i < NSUB; ++i) if (sd[i].act) load_vfrags(w, buf, i, vf[i]);
#pragma unroll
    for (int i = 0; i < NSUB; ++i) if (sd[i].act) { float acc = 0.f;
#pragma unroll
        for (int r = 0; r < 16; ++r) { s[i][r] = __builtin_amdgcn_exp2f(s[i][r]); acc += s[i][r]; }
        lsum += acc; }
#pragma unroll
    for (int i = 0; i < NSUB; ++i) if (sd[i].act) pv_frags(vf[i], s[i], o);
}
__device__ __forceinline__ void bias_frags(const Wave& w, float slope, bf16x8& kidx, bf16x8& slp) {
    const unsigned kb = f2bf((float)w.r32), sh = f2bf(slope), sl = f2bf(slope - __builtin_bit_cast(float, sh << 16));
    const u32x4 a = {w.hi == 0 ? (kb | (kb << 16)) : 0u, 0u, 0u, 0u}, b = {w.hi == 0 ? (sh | (sl << 16)) : 0u, 0u, 0u, 0u};
    kidx = __builtin_bit_cast(bf16x8, a); slp = __builtin_bit_cast(bf16x8, b);
}
template <class RowO> __device__ __forceinline__ void store_o(const Wave& w, const f32x16 (&o)[2], const RowO& rowo) {
    LAS unsigned short* stg = (LAS unsigned short*)w.ost;
#pragma unroll
    for (int r = 0; r < 16; ++r) { const int q = (r & 3) + 8 * (r >> 2) + 4 * w.hi;
#pragma unroll
        for (int db = 0; db < 2; ++db) stg[q * 64 + db * 32 + w.r32] = (unsigned short)f2bf(o[db][r]); }
#pragma unroll
    for (int i = 0; i < 4; ++i) { const int row = i * 8 + (w.lane >> 3), ch = w.lane & 7; const u32x4 v = *(LAS u32x4*)((LAS unsigned char*)stg + row * 128 + ch * 16);
        bf16_t* dst = rowo(row); if (dst) *(u32x4*)(dst + ch * 8) = v; }
}
__device__ __forceinline__ void load_q(bf16x8 (&qf)[4], const bf16_t* qrow, int hi) {
#pragma unroll
    for (int ks = 0; ks < 4; ++ks) qf[ks] = *(const bf16x8*)(qrow + 16 * ks + 8 * hi);
}

constexpr int W_WSF = 98304, W_OST = W_WSF + 2048, W_ENUM = W_OST + 32768;
template <int NC> struct Pref { u32x4 k[NC], v[NC]; bf16x8 q[4]; };
template <int NC, class RowF> __device__ __forceinline__ void win_issue(Pref<NC>& P, const Wave& w, const bf16_t* kbase, const bf16_t* vbase, const RowF& rowoff, const bf16_t* qrow) {
#pragma unroll
    for (int c = 0; c < NC; ++c) { P.k[c] = *(const u32x4*)(kbase + rowoff(64 * c + 8 * w.wid + (w.lane >> 3)) + (w.lane & 7) * 8);
        P.v[c] = *(const u32x4*)(vbase + rowoff(64 * c + 16 * (w.wid & 3) + (w.lane >> 2)) + (w.wid >> 2) * 32 + (w.lane & 3) * 8); }
    load_q(P.q, qrow, w.hi);
}
template <int NC> __device__ __forceinline__ void win_commit(const Pref<NC>& P, const Wave& w) {
    constexpr int NK = 64 * NC;
#pragma unroll
    for (int c = 0; c < NC; ++c) { const int key = 64 * c + 8 * w.wid + (w.lane >> 3);
        *(LAS u32x4*)(w.lds + key * 128 + ((((w.lane & 7) ^ (key >> 1)) & 7) * 16)) = P.k[c];
        *(LAS u32x4*)(w.lds + NK * 128 + (w.wid >> 2) * (NK * 64) + (8 * c + 2 * (w.wid & 3)) * 512 + w.lane * 16) = P.v[c]; }
}
template <int NK> __device__ __forceinline__ f32x16 qk_win(const Wave& w, int u, const bf16x8 (&qf)[4], float init) {
    f32x16 acc;
#pragma unroll
    for (int r = 0; r < 16; ++r) acc[r] = init;
    LAS unsigned char* kp = w.lds + (32 * u + w.r32) * 128; const int x = (w.r32 >> 1) & 7;
#pragma unroll
    for (int ks = 0; ks < 4; ++ks) { const bf16x8 kf = *(LAS bf16x8*)(kp + (((2 * ks + w.hi) ^ x) * 16)); acc = ATT_MFMA(kf, qf[ks], acc); }
    return acc;
}
template <int NK> __device__ __forceinline__ void load_vfrags_win(const Wave& w, int u, VFrags& v) {
    LAS unsigned char* vb = w.lds + NK * 128 + w.vlo;
#pragma unroll
    for (int db = 0; db < 2; ++db)
#pragma unroll
        for (int s = 0; s < 2; ++s) { LAS unsigned char* vp = vb + db * (NK * 64) + (4 * u + 2 * s) * 512; v.f[db][s][0] = vtr(vp); v.f[db][s][1] = vtr(vp + 512); }
}
struct WSub { bool act; int u; int delta; int W; };
template <int NK>
__device__ __forceinline__ void softmax_win(const Wave& w, const bf16x8 (&qf)[4], const bf16x8& kidx, const bf16x8& slp, float slope, const WSub (&sd)[2], float& m, float& lsum, f32x16 (&o)[2], bool& first) {
    f32x16 s[2];
    bool any_act = false;
#pragma unroll
    for (int i = 0; i < 2; ++i) if (sd[i].act) { any_act = true; s[i] = qk_win<NK>(w, sd[i].u, qf, -slope * (float)sd[i].delta - m); s[i] = ATT_MFMA(kidx, slp, s[i]); }
    if (!any_act) return;
    float tm = -INFINITY;
#pragma unroll
    for (int i = 0; i < 2; ++i) if (sd[i].act) {
        if (sd[i].W >= 0) mask_band(s[i], sd[i].delta - 4 * w.hi, sd[i].W);
        float t = fmaxf(fmaxf(s[i][0], s[i][1]), fmaxf(s[i][2], s[i][3]));
#pragma unroll
        for (int r = 4; r < 16; r += 4) t = fmaxf(t, fmaxf(fmaxf(s[i][r], s[i][r + 1]), fmaxf(s[i][r + 2], s[i][r + 3])));
        tm = fmaxf(tm, t); }
    tm = max_xor32(tm);
    if (first || __any(tm > SM_THR)) {
        const float d = first ? (tm > -1.0e30f ? tm : 0.f) : fmaxf(tm, 0.f);
#pragma unroll
        for (int i = 0; i < 2; ++i) if (sd[i].act) {
#pragma unroll
            for (int r = 0; r < 16; ++r) s[i][r] -= d; }
        if (!first) { const float al = __builtin_amdgcn_exp2f(-d); lsum *= al; scale_rows(w, o, al); }
        m += d; first = false;
    }
#pragma unroll
    for (int i = 0; i < 2; ++i) if (sd[i].act) { VFrags vf; load_vfrags_win<NK>(w, sd[i].u, vf);
        float acc = 0.f;
#pragma unroll
        for (int r = 0; r < 16; ++r) { s[i][r] = __builtin_amdgcn_exp2f(s[i][r]); acc += s[i][r]; }
        lsum += acc;
        pv_frags(vf, s[i], o); }
}

__device__ __forceinline__ size_t ql_off(int bh, int j) { return (size_t)bh * QL_PER_BH + (size_t)(8192 * j - 128 * j * (j + 1)); }
__device__ __forceinline__ float* lsem_ptr(float* l0, float* l1, int slot) { return (slot < 2 ? l0 : l1) + (size_t)(slot & 1) * T * 4; }

struct Top3 { int i0, i1, i2; };
__device__ __forceinline__ Top3 moba_top3(const Wave& w, const bf16x8 (&qf)[4], const float* KMEAN, int b, int h, int own) {
    int i0 = -1, i1 = -1, i2 = -1;
    if (own > 0) {
    f32x16 g;
#pragma unroll
    for (int r = 0; r < 16; ++r) g[r] = 0.f;
    const float* km = KMEAN + ((size_t)(b * 4 + h) * 32 + w.r32) * HD + 8 * w.hi;
#pragma unroll
    for (int ks = 0; ks < 4; ++ks) { const f32x4 a0 = *(const f32x4*)(km + 16 * ks), a1 = *(const f32x4*)(km + 16 * ks + 4);
        const float x[8] = {a0.x, a0.y, a0.z, a0.w, a1.x, a1.y, a1.z, a1.w}; unsigned hw[4], lw[4];
#pragma unroll
        for (int j = 0; j < 4; ++j) { const unsigned h0 = f2bf(x[2 * j]), h1 = f2bf(x[2 * j + 1]); hw[j] = h0 | (h1 << 16);
            lw[j] = pk2(x[2 * j] - __builtin_bit_cast(float, h0 << 16), x[2 * j + 1] - __builtin_bit_cast(float, h1 << 16)); }
        const u32x4 hv = {hw[0], hw[1], hw[2], hw[3]}, lv = {lw[0], lw[1], lw[2], lw[3]};
        g = ATT_MFMA(__builtin_bit_cast(bf16x8, hv), qf[ks], g); g = ATT_MFMA(__builtin_bit_cast(bf16x8, lv), qf[ks], g); }
    float v0 = -INFINITY, v1 = -INFINITY, v2 = -INFINITY;
#pragma unroll
    for (int r = 0; r < 16; ++r) { const int blk = (r & 3) + 8 * (r >> 2) + 4 * w.hi; const float val = (blk < own) ? g[r] : -INFINITY;
        if (val > v0) { v2 = v1; i2 = i1; v1 = v0; i1 = i0; v0 = val; i0 = blk; } else if (val > v1) { v2 = v1; i2 = i1; v1 = val; i1 = blk; } else if (val > v2) { v2 = val; i2 = blk; } }
    const float pv_[3] = {get_xor32(v0, w.hi), get_xor32(v1, w.hi), get_xor32(v2, w.hi)}; const int pi_[3] = {get_xor32i(i0, w.hi), get_xor32i(i1, w.hi), get_xor32i(i2, w.hi)};
#pragma unroll
    for (int k = 0; k < 3; ++k) { const float val = pv_[k]; const int blk = pi_[k];
        if (val > v0 || (val == v0 && blk < i0)) { v2 = v1; i2 = i1; v1 = v0; i1 = i0; v0 = val; i0 = blk; }
        else if (val > v1 || (val == v1 && blk < i1)) { v2 = v1; i2 = i1; v1 = val; i1 = blk; }
        else if (val > v2 || (val == v2 && blk < i2)) { v2 = val; i2 = blk; } }
    }
    Top3 t; t.i0 = i0; t.i1 = i1; t.i2 = i2; return t;
}
__device__ __forceinline__ void moba_gate_unit(LAS unsigned char* lds, const bf16_t* QB, const float* KMEAN, unsigned* mcnt, unsigned* qlist, bf16_t* PM, float* LSEM0, float* LSEM1, int b, int h, int own, int tid) {
    const Wave w = make_wave(lds, tid);
    const size_t rowbase = (size_t)b * SEQ; const int qpos = own * 256 + 32 * w.wid + w.r32, bh = b * 4 + h;
    bf16x8 qf[4]; load_q(qf, QB + (rowbase + qpos) * DM + h * HD, w.hi);
    const Top3 t3 = moba_top3(w, qf, KMEAN, b, h, own); const int s0 = t3.i0, s1 = t3.i1, s2 = t3.i2;
    LAS unsigned* cl = (LAS unsigned*)(lds + W_ENUM);
    if (tid < 64) cl[tid] = 0u;
    __syncthreads();
    unsigned r0 = 0u, r1 = 0u, r2 = 0u;
    if (w.hi == 0) {
        if (s0 >= 0) r0 = __hip_atomic_fetch_add(cl + s0, 1u, __ATOMIC_RELAXED, __HIP_MEMORY_SCOPE_WORKGROUP);
        if (s1 >= 0) r1 = __hip_atomic_fetch_add(cl + s1, 1u, __ATOMIC_RELAXED, __HIP_MEMORY_SCOPE_WORKGROUP);
        if (s2 >= 0) r2 = __hip_atomic_fetch_add(cl + s2, 1u, __ATOMIC_RELAXED, __HIP_MEMORY_SCOPE_WORKGROUP);
    }
    __syncthreads();
    if (tid < 32) { const unsigned c = cl[tid]; cl[32 + tid] = c ? __hip_atomic_fetch_add(mcnt + bh * 32 + tid, c, __ATOMIC_RELAXED, __HIP_MEMORY_SCOPE_AGENT) : 0u; }
    __syncthreads();
    if (w.hi == 0) {
        const size_t tok = rowbase + qpos;
#define MOBA_EMIT(k, sk, rk) do { if (sk >= 0) qlist[ql_off(bh, sk) + cl[32 + sk] + rk] = (unsigned)qpos | ((unsigned)(k) << 13); \
            else { lsem_ptr(LSEM0, LSEM1, k)[tok * 4 + h] = -1.0e30f;          \
                u32x4* pz = (u32x4*)(PM + ((size_t)(k) * T + tok) * 256 + h * HD); const u32x4 z4 = {0u, 0u, 0u, 0u}; \
                _Pragma("unroll") for (int c = 0; c < 8; ++c) pz[c] = z4; } } while (0)
        MOBA_EMIT(0, s0, r0); MOBA_EMIT(1, s1, r1); MOBA_EMIT(2, s2, r2);
#undef MOBA_EMIT
    }
    __syncthreads();
}
struct OwnU { int b, h, own; };
__device__ __forceinline__ void own_issue(Pref<4>& P, const Wave& w, const OwnU& u, const bf16_t* QB, const bf16_t* KB, const bf16_t* VB) {
    const size_t rowbase = (size_t)u.b * SEQ; const int q0 = u.own * 256;
    win_issue<4>(P, w, KB + (rowbase + q0) * DM + u.h * HD, VB + (rowbase + q0) * DM + u.h * HD, [&](int key) { return (size_t)key * DM; }, QB + (rowbase + q0 + 32 * w.wid + w.r32) * DM + u.h * HD);
}
template <class F> __device__ __forceinline__ void own_compute(const Wave& w, const OwnU& u, const bf16x8 (&qf)[4], bf16_t* OB, float* LSEM0, float* LSEM1, const F& between) {
    const size_t rowbase = (size_t)u.b * SEQ; const int q0 = u.own * 256, ql = 32 * w.wid + w.r32;
    const float slope2 = exp2f(-2.0f * (float)(u.h + 1)) * LOG2E;
    bf16x8 kidx, slp; bias_frags(w, slope2, kidx, slp);
    f32x16 o[2];
#pragma unroll
    for (int r = 0; r < 16; ++r) { o[0][r] = 0.f; o[1][r] = 0.f; }
    float m = 0.f, lsum = 0.f; bool first = true;
#pragma unroll
    for (int p = 0; p < 4; ++p) { WSub sd[2];
#pragma unroll
        for (int i = 0; i < 2; ++i) { const int su = w.wid - 2 * p - i; sd[i].act = su >= 0; sd[i].u = su; sd[i].delta = ql - 32 * su; sd[i].W = (su == w.wid) ? 0x7fffffff : -1; }
        softmax_win<256>(w, qf, kidx, slp, slope2, sd, m, lsum, o, first); }
    between();
    const float l = sum_xor32(lsum);
    scale_rows(w, o, 1.0f / l);
    bf16_t* orow = OB + (rowbase + q0 + 32 * w.wid) * DM + u.h * HD;
    store_o(w, o, [&](int r) { return orow + (size_t)r * DM; });
    if (w.hi == 0) lsem_ptr(LSEM0, LSEM1, 3)[(rowbase + q0 + ql) * 4 + u.h] = m + __builtin_amdgcn_logf(l);
}
struct GatU { int b, h, j, cnt, chunk; const unsigned* ql; };
__device__ __forceinline__ unsigned gat_entry(const Wave& w, const GatU& u, bool& valid) { const int idx = u.chunk * 256 + 32 * w.wid + w.r32; valid = idx < u.cnt; return u.ql[valid ? idx : u.chunk * 256]; }
__device__ __forceinline__ void gat_issue(Pref<4>& P, const Wave& w, const GatU& u, const bf16_t* QB, const bf16_t* KB, const bf16_t* VB) {
    const size_t rowbase = (size_t)u.b * SEQ; bool valid; const unsigned e = gat_entry(w, u, valid);
    win_issue<4>(P, w, KB + (rowbase + u.j * 256) * DM + u.h * HD, VB + (rowbase + u.j * 256) * DM + u.h * HD, [&](int key) { return (size_t)key * DM; }, QB + (rowbase + (e & 8191u)) * DM + u.h * HD);
}
template <class F> __device__ __forceinline__ void gat_compute(const Wave& w, const GatU& u, const bf16x8 (&qf)[4], bf16_t* PM, float* LSEM0, float* LSEM1, const F& between) {
    const size_t rowbase = (size_t)u.b * SEQ; bool valid; const unsigned e = gat_entry(w, u, valid);
    const int qpos = (int)(e & 8191u), slot = (int)(e >> 13);
    const float slope2 = exp2f(-2.0f * (float)(u.h + 1)) * LOG2E;
    bf16x8 kidx, slp; bias_frags(w, slope2, kidx, slp);
    f32x16 o[2];
#pragma unroll
    for (int r = 0; r < 16; ++r) { o[0][r] = 0.f; o[1][r] = 0.f; }
    float m = 0.f, lsum = 0.f; bool first = true;
#pragma unroll
    for (int p = 0; p < 4; ++p) { WSub sd[2];
#pragma unroll
        for (int i = 0; i < 2; ++i) { const int su = 7 - 2 * p - i; sd[i].act = true; sd[i].u = su; sd[i].delta = qpos - (u.j * 256 + 32 * su); sd[i].W = -1; }
        softmax_win<256>(w, qf, kidx, slp, slope2, sd, m, lsum, o, first); }
    between();
    const float l = sum_xor32(lsum);
    scale_rows(w, o, l > 0.f ? 1.0f / l : 0.f);
    LAS int* code = (LAS int*)(w.wsf + 32);
    if (w.hi == 0) code[w.r32] = valid ? (int)((size_t)slot * T + rowbase + qpos) : -1;
    store_o(w, o, [&](int r) { const int c = code[r]; return c >= 0 ? PM + (size_t)c * 256 + u.h * HD : (bf16_t*)nullptr; });
    if (w.hi == 0 && valid) lsem_ptr(LSEM0, LSEM1, slot)[(rowbase + qpos) * 4 + u.h] = l > 0.f ? m + __builtin_amdgcn_logf(l) : -1.0e30f;
}

__device__ __forceinline__ void sb_unit(LAS unsigned char* lds, const bf16_t* QB, const bf16_t* KB, const bf16_t* VB, bf16_t* OB, int b, int h, int qt, int tid) {
    const Wave w = make_wave(lds, tid);
    const size_t rowbase = (size_t)b * SEQ; const int q0 = qt * 256, qpos = q0 + 32 * w.wid + w.r32;
    const bf16_t* kh = KB + rowbase * DM + h * HD; const bf16_t* vh = VB + rowbase * DM + h * HD;
    bf16x8 qf[4]; load_q(qf, QB + (rowbase + qpos) * DM + h * HD, w.hi);
    f32x16 o[2];
#pragma unroll
    for (int r = 0; r < 16; ++r) { o[0][r] = 0.f; o[1][r] = 0.f; }
    float carry = 0.f;
    bool done = false;
    volatile LAS unsigned* flg = (volatile LAS unsigned*)(lds + L_FLG);
    const int ti0 = q0 / 64 + 3;
    Stage sg;
    { const int kp = ti0 * 64; stage_load(sg, w, [&](int key) { return kh + (size_t)(kp + key) * DM; }, [&](int key) { return vh + (size_t)(kp + key) * DM; }); }
    stage_write(sg, w, 0);
    __syncthreads();
    for (int st = 0;; ++st) {
        const int buf = st & 1, ti = ti0 - st;
        if (ti > 0) { const int kp = (ti - 1) * 64; stage_load(sg, w, [&](int key) { return kh + (size_t)(kp + key) * DM; }, [&](int key) { return vh + (size_t)(kp + key) * DM; }); }
        if (!done) {
#pragma unroll
            for (int sub = 1; sub >= 0; --sub) {
                const int D = (q0 / 32 + w.wid) - (2 * ti + sub);
                if (D < 0) continue;
                const int delta0 = qpos - (64 * ti + 32 * sub) - 4 * w.hi;
                f32x16 z = qk_sub(w, buf, sub, qf, 0.f);
                f32x16 L;
#pragma unroll
                for (int r = 0; r < 16; ++r) { const float lp = __builtin_amdgcn_logf(1.0f + __builtin_amdgcn_exp2f(-fabsf(z[r]))); L[r] = -(fmaxf(z[r], 0.f) + lp); }
                if (D == 0) {
#pragma unroll
                    for (int r = 0; r < 16; ++r) { const int dl = delta0 - ((r & 3) + 8 * (r >> 2)); if (dl < 1) { L[r] = 0.f; z[r] = -INFINITY; } }
                }
                float G[4], PG[4];
#pragma unroll
                for (int g = 0; g < 4; ++g) { G[g] = (L[4 * g] + L[4 * g + 1]) + (L[4 * g + 2] + L[4 * g + 3]); PG[g] = get_xor32(G[g], w.hi); }
                float run = carry;
#pragma unroll
                for (int g = 3; g >= 0; --g) { const float t3 = run + (w.hi == 0 ? PG[g] : 0.f), t2 = t3 + L[4 * g + 3], t1 = t2 + L[4 * g + 2], t0 = t1 + L[4 * g + 1];
                    z[4 * g + 3] = __builtin_amdgcn_exp2f(z[4 * g + 3] + L[4 * g + 3] + t3); z[4 * g + 2] = __builtin_amdgcn_exp2f(z[4 * g + 2] + L[4 * g + 2] + t2);
                    z[4 * g + 1] = __builtin_amdgcn_exp2f(z[4 * g + 1] + L[4 * g + 1] + t1); z[4 * g] = __builtin_amdgcn_exp2f(z[4 * g] + L[4 * g] + t0);
                    run += G[g] + PG[g]; }
                carry = run;
                pv_sub(w, buf, sub, z, o);
            }
            done = __all(carry < -150.f);
        }
        if (w.lane == 0) flg[buf * 8 + w.wid] = done ? 1u : 0u;
        if (ti > 0) stage_write(sg, w, buf ^ 1);
        __syncthreads();
        unsigned all = 1u;
#pragma unroll
        for (int k = 0; k < 8; ++k) all &= flg[buf * 8 + k];
        if (all || ti == 0) break;
    }
    bf16_t* orow = OB + (rowbase + q0 + 32 * w.wid) * DM + h * HD;
    store_o(w, o, [&](int r) { return orow + (size_t)r * DM; });
    __syncthreads();
}

struct PrefK6 { u32x4 k[6]; bf16x8 q[4]; }; struct PrefV6 { u32x4 v[6]; };
template <class RowF> __device__ __forceinline__ void win_issue_k6(PrefK6& P, const Wave& w, const bf16_t* kbase, const RowF& rowoff, const bf16_t* qrow) {
#pragma unroll
    for (int c = 0; c < 6; ++c) P.k[c] = *(const u32x4*)(kbase + rowoff(64 * c + 8 * w.wid + (w.lane >> 3)) + (w.lane & 7) * 8);
    load_q(P.q, qrow, w.hi);
}
template <class RowF> __device__ __forceinline__ void win_issue_v6(PrefV6& P, const Wave& w, const bf16_t* vbase, const RowF& rowoff) {
#pragma unroll
    for (int c = 0; c < 6; ++c) P.v[c] = *(const u32x4*)(vbase + rowoff(64 * c + 16 * (w.wid & 3) + (w.lane >> 2)) + (w.wid >> 2) * 32 + (w.lane & 3) * 8);
}
__device__ __forceinline__ void win_commit_k6(const PrefK6& P, const Wave& w) {
#pragma unroll
    for (int c = 0; c < 6; ++c) { const int key = 64 * c + 8 * w.wid + (w.lane >> 3); *(LAS u32x4*)(w.lds + key * 128 + ((((w.lane & 7) ^ (key >> 1)) & 7) * 16)) = P.k[c]; }
}
__device__ __forceinline__ void win_commit_v6(const PrefV6& P, const Wave& w) {
    constexpr int NK = 384;
#pragma unroll
    for (int c = 0; c < 6; ++c) *(LAS u32x4*)(w.lds + NK * 128 + (w.wid >> 2) * (NK * 64) + (8 * c + 2 * (w.wid & 3)) * 512 + w.lane * 16) = P.v[c];
}
struct DilU { int b, h, dil, res, i2, c; };
__device__ __forceinline__ DilU dil_decode(int u) { const int n = u & 31, bhc = u >> 5, c = bhc % 3, bh = bhc / 3; DilU d; d.b = bh >> 3; d.h = 8 + (bh & 7); d.c = c;
    d.dil = (c == 0) ? 1 : (c == 1) ? 4 : 16; d.res = (c == 0) ? 0 : (c == 1) ? (n >> 3) : (n >> 1); d.i2 = (c == 0) ? n : (c == 1) ? (n & 7) : (n & 1); return d; }
__device__ __forceinline__ void dil_issue_k(PrefK6& P, const Wave& w, const DilU& u, const bf16_t* QB, const bf16_t* KB) {
    const size_t rowbase = (size_t)u.b * SEQ; const int Q0 = 256 * u.i2, qj = Q0 + 32 * w.wid + w.r32; const size_t rstride = (size_t)u.dil * DM;
    win_issue_k6(P, w, KB + (rowbase + u.res) * DM + u.h * HD, [&](int key) { const int kj = Q0 - 128 + key; return (size_t)(kj < 0 ? 0 : kj) * rstride; },
                 QB + (rowbase + u.res + (size_t)qj * u.dil) * DM + u.h * HD);
}
__device__ __forceinline__ void dil_issue_v(PrefV6& P, const Wave& w, const DilU& u, const bf16_t* VB) {
    const size_t rowbase = (size_t)u.b * SEQ; const int Q0 = 256 * u.i2; const size_t rstride = (size_t)u.dil * DM;
    win_issue_v6(P, w, VB + (rowbase + u.res) * DM + u.h * HD, [&](int key) { const int kj = Q0 - 128 + key; return (size_t)(kj < 0 ? 0 : kj) * rstride; });
}
template <class F> __device__ __forceinline__ void dil_compute(const Wave& w, const DilU& u, const bf16x8 (&qf)[4], bf16_t* OB, bf16_t* HB2, float* LSE, const F& between) {
    const size_t rowbase = (size_t)u.b * SEQ; const int Q0 = 256 * u.i2, ql = 32 * w.wid + w.r32;
    const float slope2d = exp2f(-(float)(u.h - 8 + 1)) * LOG2E * (float)u.dil;
    bf16x8 kidx, slp; bias_frags(w, slope2d, kidx, slp);
    f32x16 o[2];
#pragma unroll
    for (int r = 0; r < 16; ++r) { o[0][r] = 0.f; o[1][r] = 0.f; }
    float m = 0.f, lsum = 0.f; bool first = true;
#pragma unroll
    for (int p = 0; p < 3; ++p) { WSub sd[2];
#pragma unroll
        for (int i = 0; i < 2; ++i) { const int D = 2 * p + i, su = w.wid + 4 - D; sd[i].act = (D <= 4) && (Q0 - 128 + 32 * su >= 0); sd[i].u = su; sd[i].delta = ql + 128 - 32 * su; sd[i].W = (D == 0 || D == 4) ? 128 : -1; }
        softmax_win<384>(w, qf, kidx, slp, slope2d, sd, m, lsum, o, first); }
    between();
    const float l = sum_xor32(lsum);
    scale_rows(w, o, 1.0f / l);
    bf16_t* PO = (u.c == 0) ? OB + 512 : HB2 + (u.c - 1) * 512;
    const size_t tok0 = rowbase + u.res + (size_t)(Q0 + 32 * w.wid) * u.dil;
    store_o(w, o, [&](int r) { return PO + (tok0 + (size_t)r * u.dil) * DM + (u.h - 8) * HD; });
    if (w.hi == 0) (LSE + (size_t)u.c * T * 8)[(tok0 + (size_t)w.r32 * u.dil) * 8 + (u.h - 8)] = m + __builtin_amdgcn_logf(l);
}

__device__ __forceinline__ void moba_gate_phase(LAS unsigned char* lds, const bf16_t* QB, const float* KMEAN, unsigned* mcnt, unsigned* qlist, bf16_t* PM, float* LSEM0, float* LSEM1, int v, int G, int tid) {
    for (int u = v; u < 512; u += G) { const int own = u & 31, bh = u >> 5; moba_gate_unit(lds, QB, KMEAN, mcnt, qlist, PM, LSEM0, LSEM1, bh >> 2, bh & 3, own, tid); }
}
struct AttnArgs { const bf16_t* QB; const bf16_t* KB; const bf16_t* VB; bf16_t* OB; bf16_t* HB2; float* LSE; unsigned* mcnt; unsigned* qlist; bf16_t* PM; float* LSEM0; float* LSEM1; const float* KMEAN; unsigned* gdone; };
__device__ __forceinline__ void attn_phase(LAS unsigned char* lds, const AttnArgs& A, int v, int G, int tid) {
    moba_gate_phase(lds, A.QB, A.KMEAN, A.mcnt, A.qlist, A.PM, A.LSEM0, A.LSEM1, v, G, tid);
    asm volatile("s_waitcnt vmcnt(0)" ::: "memory");
    __syncthreads();
    if (tid == 0) { __builtin_amdgcn_fence(__ATOMIC_RELEASE, "agent"); asm volatile("s_waitcnt vmcnt(0)" ::: "memory"); __hip_atomic_fetch_add(A.gdone, 1u, __ATOMIC_RELAXED, __HIP_MEMORY_SCOPE_AGENT); }
    const Wave w = make_wave(lds, tid, W_WSF, W_OST);
    {   Pref<4> P; int u = v; OwnU cur, nxt;
        auto dec = [&](int uu) { OwnU o_; const int bh = uu >> 5; o_.b = bh >> 2; o_.h = bh & 3; o_.own = uu & 31; return o_; };
        if (u < 512) { cur = dec(u); own_issue(P, w, cur, A.QB, A.KB, A.VB); }
        for (; u < 512; u += G) {
            __syncthreads();
            win_commit<4>(P, w); bf16x8 qf[4] = {P.q[0], P.q[1], P.q[2], P.q[3]};
            __syncthreads();
            const bool more = u + G < 512; if (more) nxt = dec(u + G);
            own_compute(w, cur, qf, A.OB, A.LSEM0, A.LSEM1, [&]() { if (more) own_issue(P, w, nxt, A.QB, A.KB, A.VB); });
            cur = nxt; } }
    {   PrefK6 P; int u = v; DilU cur, nxt;
        if (u < 3072) { cur = dil_decode(u); dil_issue_k(P, w, cur, A.QB, A.KB); }
        for (; u < 3072; u += G) {
            __syncthreads();
            bf16x8 qf[4] = {P.q[0], P.q[1], P.q[2], P.q[3]};
            { PrefV6 PV; dil_issue_v(PV, w, cur, A.VB); win_commit_k6(P, w); win_commit_v6(PV, w); }
            __syncthreads();
            const bool more = u + G < 3072; if (more) nxt = dil_decode(u + G);
            dil_compute(w, cur, qf, A.OB, A.HB2, A.LSE, [&]() { if (more) dil_issue_k(P, w, nxt, A.QB, A.KB); });
            cur = nxt; } }
    __syncthreads();
    for (int u = v; u < 512; u += G) { const int qt = u & 31, bh = u >> 5; sb_unit(lds, A.QB, A.KB, A.VB, A.OB, bh >> 2, 4 + (bh & 3), qt, tid); }
    if (tid == 0) { unsigned polls = 0;
        while (__hip_atomic_load(A.gdone, __ATOMIC_RELAXED, __HIP_MEMORY_SCOPE_AGENT) < (unsigned)G) { if (++polls > (1u << 20)) break; __builtin_amdgcn_s_sleep(2); }
        __builtin_amdgcn_fence(__ATOMIC_ACQUIRE, "agent"); asm volatile("s_waitcnt vmcnt(0)" ::: "memory"); }
    __syncthreads();
    LAS int* cntl = (LAS int*)(lds + W_ENUM); LAS int* pa = cntl + 512; LAS int* pb = pa + 512;
    const int myc = (int)A.mcnt[tid], myu = (myc + 255) >> 8;
    cntl[tid] = myc; pa[tid] = myu;
    __syncthreads();
#pragma unroll 1
    for (int d = 1; d < 512; d <<= 1) { const int x = pa[tid] + (tid >= d ? pa[tid - d] : 0); pb[tid] = x; __syncthreads(); LAS int* t_ = pa; pa = pb; pb = t_; }
    const int total = pa[511];
    auto gat_decode = [&](int u) { int lo = 0, hi = 511;
        while (lo < hi) { const int mid = (lo + hi) >> 1; if (pa[mid] > u) hi = mid; else lo = mid + 1; }
        const int i = lo, c = cntl[i], bh = i >> 5; GatU g; g.b = bh >> 2; g.h = bh & 3; g.j = i & 31; g.cnt = c; g.chunk = u - (pa[i] - ((c + 255) >> 8)); g.ql = A.qlist + ql_off(bh, g.j); return g; };
    {   Pref<4> P; int u = v; GatU cur, nxt;
        if (u < total) { cur = gat_decode(u); gat_issue(P, w, cur, A.QB, A.KB, A.VB); }
        for (; u < total; u += G) {
            __syncthreads();
            win_commit<4>(P, w); bf16x8 qf[4] = {P.q[0], P.q[1], P.q[2], P.q[3]};
            __syncthreads();
            const bool more = u + G < total; if (more) nxt = gat_decode(u + G);
            gat_compute(w, cur, qf, A.PM, A.LSEM0, A.LSEM1, [&]() { if (more) gat_issue(P, w, nxt, A.QB, A.KB, A.VB); });
            cur = nxt; } }
}
}

constexpr int PH_PRO = 0, PH_L0 = 1, PH_PER_LAYER = 10, PH_FINAL = PH_L0 + DEPTH * PH_PER_LAYER, PH_COUNT = PH_FINAL + 1;
typedef const __attribute__((address_space(4))) Args* KArgP;
#define KARG() ({ KArgP p_ = (KArgP)__builtin_amdgcn_kernarg_segment_ptr(); asm volatile("" : "+s"(p_)); p_; })
#define PHASE_IDS int lane_p = (int)__builtin_amdgcn_mbcnt_hi(~0u, __builtin_amdgcn_mbcnt_lo(~0u, 0u)); LAUNDER_V(lane_p); int tid_p = wave * 64 + lane_p; int gw_p = gw, G_p = G, NGW_p = NGW; LAUNDER_S(gw_p); LAUNDER_S(G_p); LAUNDER_S(NGW_p)
__global__ void __launch_bounds__(NTHREADS, 2) fwd(Args a_unused) {
    extern __shared__ __attribute__((aligned(16))) unsigned char lds_raw[];
    LAS unsigned char* lds = (LAS unsigned char*)lds_raw;
    volatile LAS unsigned* MISC = (volatile LAS unsigned*)(lds + MISC_OFF);
    const int wave = __builtin_amdgcn_readfirstlane((int)threadIdx.x >> 6);
    const int G = gridDim.x, bx = blockIdx.x;
    const int vcu = (G % 8 == 0) ? (bx % 8) * (G / 8) + bx / 8 : bx;
    const int gw = vcu * NWAVES + wave, NGW = G * NWAVES;
    for (int u = threadIdx.x; u < (LDS_BYTES - LDSCTL_OFF) / 4; u += NTHREADS) ((LAS unsigned*)(lds + LDSCTL_OFF))[u] = 0u;
    __syncthreads();
    int lo, hi; XcdBarrier bar;
    { KArgP ka = KARG(); lo = ka->ph_lo; hi = ka->ph_hi; unsigned* ctl = (unsigned*)(ka->ws + WS_CTL); bar = xcd_barrier_post(ctl + CW_BAR + ka->li * XCD_BAR_WORDS, MISC + 8, wave); }
#define IN(k) (lo <= (k) && (k) < hi)
#define SEAM(k) do { if (IN(k) && IN((k) + 1)) xcd_barrier(bar); } while (0)
#define WSP(T_, off) ((T_*)(ws + (off)))

    if (IN(PH_PRO)) { KArgP ka = KARG(); PHASE_IDS; Args a; a.ws = ka->ws; a.w_in = ka->w_in; a.w_out = ka->w_out; a.w_gate = ka->w_gate; a.w_up = ka->w_up; a.w_down = ka->w_down; phase_prologue(a, lds, gw_p, NGW_p, wave, lane_p); } SEAM(PH_PRO);

    for (int l = 0; l < DEPTH; ++l) {
        const int p0 = PH_L0 + l * PH_PER_LAYER;
        if (hi <= p0 || lo >= p0 + PH_PER_LAYER) continue;
        if (IN(p0 + 0)) for (int rep_ = 0; rep_ < RPT(0); ++rep_) { if (rep_) xcd_barrier(bar); KArgP ka = KARG(); PHASE_IDS; unsigned char* ws = ka->ws; const float* xin = (l == 0) ? ka->x : ka->out;
            phase_norm1(xin, ka->ln1_g + (size_t)l * DM, WSP(bf16_t, WS_HB), gw_p, NGW_p, lane_p, WSP(float, WS_KMEAN)); } SEAM(p0 + 0);
        if (IN(p0 + 1)) for (int rep_ = 0; rep_ < RPT(1); ++rep_) { if (rep_) xcd_barrier(bar); KArgP ka = KARG(); PHASE_IDS; unsigned char* ws = ka->ws;
            pg8::Gemm g{(const char*)(ws + WS_HB), (const char*)(ws + WS_WIN) + (size_t)l * NQKV * DM * 2, DM, DM, DM, (long)256 * DM * 2, (long)256 * DM * 2, (long)128 * DM * 2};
            pg8::StaticOrder S; S.init(T / 256, NQKV / 256, G_p, bx);
            pg8::EpiQKV E{WSP(bf16_t, WS_Q), (size_t)(WS_K - WS_Q) / 2, QSCALE};
            pg8::gemm_phase<pg8::EpiQKV, pg8::StaticOrder>(lds, g, S, E, wave);
        } SEAM(p0 + 1);
        if (IN(p0 + 4)) for (int rep_ = 0; rep_ < RPT(4); ++rep_) { if (rep_) xcd_barrier(bar); KArgP ka = KARG(); PHASE_IDS; unsigned char* ws = ka->ws;
            const att::AttnArgs A{WSP(bf16_t, WS_Q), WSP(bf16_t, WS_K), WSP(bf16_t, WS_V), WSP(bf16_t, WS_O), WSP(bf16_t, WS_HB), WSP(float, WS_LSE), WSP(unsigned, WS_CTL) + CW_MCNT + l * 512, WSP(unsigned, WS_QLIST),
                                  WSP(bf16_t, WS_PM), WSP(float, WS_LSEM0), WSP(float, WS_LSEM1), WSP(float, WS_KMEAN), WSP(unsigned, WS_CTL) + CW_GDONE + l * 64};
            att::attn_phase(lds, A, vcu, G_p, tid_p);
        } SEAM(p0 + 4);
        if (IN(p0 + 5)) { KArgP ka = KARG(); PHASE_IDS; unsigned char* ws = ka->ws;
            phase_mixnorm(WSP(bf16_t, WS_O), WSP(bf16_t, WS_HB), WSP(float, WS_LSE), WSP(bf16_t, WS_PM), WSP(float, WS_LSEM0), WSP(float, WS_LSEM1), ka->mix_g + (size_t)l * DM, gw_p, NGW_p, lane_p); } SEAM(p0 + 5);
        if (IN(p0 + 6)) { KArgP ka = KARG(); PHASE_IDS; unsigned char* ws = ka->ws; const float* xin = (l == 0) ? ka->x : ka->out;
            pg8::Gemm g{(const char*)(ws + WS_HB), (const char*)(ws + WS_WOUT) + (size_t)l * DM * DM * 2, DM, DM, DM, (long)256 * DM * 2, (long)256 * DM * 2, (long)128 * DM * 2};
            pg8::StaticOrder S; S.init(T / 256, DM / 256, G_p, bx);
            pg8::EpiResAdd E{xin, ka->out};
            pg8::gemm_phase<pg8::EpiResAdd, pg8::StaticOrder>(lds, g, S, E, wave);
        } SEAM(p0 + 6);
        if (IN(p0 + 7)) { KArgP ka = KARG(); PHASE_IDS; unsigned char* ws = ka->ws;
            phase_route(ka->out, ka->ln2_g + (size_t)l * DM, ka->w_gr + (size_t)l * DM * 4, ka->b_gr + l * 4, ka->w_er + (size_t)l * 4 * DM * 4, ka->b_er + l * 16, WSP(bf16_t, WS_HB),
                        WSP(unsigned, WS_CTL) + CW_CNT + l * 32, WSP(unsigned, WS_LIST), WSP(float, WS_WLIST), lds, vcu, G_p, wave, lane_p); } SEAM(p0 + 7);
        if (IN(p0 + 8)) for (int rep_ = 0; rep_ < RPT(8); ++rep_) { if (rep_) xcd_barrier(bar); KArgP ka = KARG(); PHASE_IDS; unsigned char* ws = ka->ws;
            pg8::MoeProb<0> P{WSP(unsigned, WS_CTL) + CW_CNT + l * 32, WSP(unsigned, WS_LIST), (const char*)(ws + WS_HB), (const char*)(ws + WS_WG) + (size_t)l * NACT * DM * 2, DM, DM, DM, (long)(WS_WU - WS_WG), G_p, vcu, WSP(unsigned, WS_CTL) + CW_TCNT + l * 16384};
            pg8::EpiGateUpSparse E{WSP(bf16_t, WS_ACT), WSP(float, WS_WLIST), WSP(unsigned, WS_CTL) + CW_TCNT + l * 16384};
            pg8::gemm_phase_x<pg8::EpiGateUpSparse, pg8::MoeProb<0>>(lds, P, E, wave);
        }
        if (IN(p0 + 9)) { KArgP ka = KARG(); PHASE_IDS; unsigned char* ws = ka->ws;
            pg8::MoeProb<1> P{WSP(unsigned, WS_CTL) + CW_CNT + l * 32, WSP(unsigned, WS_LIST), (const char*)(ws + WS_ACT), (const char*)(ws + WS_WD) + (size_t)l * DM * NACT * 2, 512, NACT, 512, (long)128 * NACT * 2, G_p, G_p - 1 - vcu, WSP(unsigned, WS_CTL) + CW_TCNT + l * 16384};
            pg8::EpiDownScatter E{ka->out, WSP(unsigned, WS_LIST)};
            pg8::gemm_phase_x<pg8::EpiDownScatter, pg8::MoeProb<1>>(lds, P, E, wave);
        } SEAM(p0 + 9);
    }
    if (IN(PH_FINAL)) { KArgP ka = KARG(); PHASE_IDS; phase_final(ka->out, ka->fin_g, gw_p, NGW_p, lane_p); }
#undef IN
#undef SEAM
#undef WSP
}

#ifndef N_LAUNCH_MODE
#define N_LAUNCH_MODE 1
#endif
extern "C" void kernel_launch(void* const* d_in, const int* in_sizes, int n_in, void* d_out, int out_size, void* d_ws, size_t ws_size, hipStream_t stream) {
    static int grid = 0;
    if (grid == 0) {
        if (n_in != 14 || in_sizes[0] != T * DM || out_size != T * DM || ws_size < WS_END) { fprintf(stderr, "kernel_launch: unexpected shapes (n_in %d in0 %d out %d ws %zu)\n", n_in, n_in > 0 ? in_sizes[0] : -1, out_size, ws_size); grid = -1; return; }
        int dev = 0, cus = 0, per_cu = 0;
        if (hipGetDevice(&dev) != hipSuccess || hipDeviceGetAttribute(&cus, hipDeviceAttributeMultiprocessorCount, dev) != hipSuccess) { grid = -1; return; }
        if (hipFuncSetAttribute((const void*)fwd, hipFuncAttributeMaxDynamicSharedMemorySize, LDS_BYTES) != hipSuccess) { fprintf(stderr, "kernel_launch: hipFuncSetAttribute failed\n"); grid = -1; return; }
        if (hipOccupancyMaxActiveBlocksPerMultiprocessor(&per_cu, (const void*)fwd, NTHREADS, LDS_BYTES) != hipSuccess || per_cu < 1) fprintf(stderr, "kernel_launch: occupancy query says %d\n", per_cu);
        (void)hipGetLastError();
        grid = cus;
    }
    if (grid < 0) return;
    if (hipMemsetAsync((char*)d_ws + WS_CTL, 0, CTL_ZERO_BYTES, stream) != hipSuccess) return;
    Args a{};
    a.x = (const float*)d_in[0]; a.ln1_g = (const float*)d_in[1]; a.w_in = (const float*)d_in[2]; a.mix_g = (const float*)d_in[3]; a.w_out = (const float*)d_in[4]; a.ln2_g = (const float*)d_in[5];
    a.w_gr = (const float*)d_in[6]; a.b_gr = (const float*)d_in[7]; a.w_er = (const float*)d_in[8]; a.b_er = (const float*)d_in[9]; a.w_gate = (const float*)d_in[10]; a.w_up = (const float*)d_in[11];
    a.w_down = (const float*)d_in[12]; a.fin_g = (const float*)d_in[13];
    a.out = (float*)d_out; a.ws = (unsigned char*)d_ws; a.pad = 0;
#if N_LAUNCH_MODE == 1
    a.ph_lo = 0; a.ph_hi = PH_COUNT; a.li = 0;
    hipLaunchKernelGGL(fwd, dim3(grid), dim3(NTHREADS), LDS_BYTES, stream, a);
#else
    for (int p = 0; p < PH_COUNT; ++p) { a.ph_lo = p; a.ph_hi = p + 1; a.li = p; hipLaunchKernelGGL(fwd, dim3(grid), dim3(NTHREADS), LDS_BYTES, stream, a); }
#endif
}
```

```cpp
#include <hip/hip_runtime.h>
#include <cstdio>
#include <cstdint>

#define LAS __attribute__((address_space(3)))
#define GAS __attribute__((address_space(1)))
typedef unsigned short bf16_t;
typedef short bf16x8 __attribute__((ext_vector_type(8)));
typedef float f32x4 __attribute__((ext_vector_type(4)));
typedef float f32x2 __attribute__((ext_vector_type(2)));
typedef unsigned u32x4 __attribute__((ext_vector_type(4)));
typedef unsigned u32x2 __attribute__((ext_vector_type(2)));

#ifndef PROBE_REPEAT
#define PROBE_REPEAT 0
#endif
#define RPT(k) ((((PROBE_REPEAT) >> (k)) & 1) ? 2 : 1)
#ifndef MOE_SPARSE
#define MOE_SPARSE 1
#endif
#ifndef ATT_MOBA
#define ATT_MOBA 1
#endif
#ifndef ATT_SB
#define ATT_SB 1
#endif
#ifndef ATT_DIL
#define ATT_DIL 1
#endif
constexpr int BATCH = 4, SEQ = 8192, DM = 1024, DEPTH = 4, T = BATCH * SEQ, NH = 16, HD = 64;
constexpr int NQKV = 3 * DM, NEXP = 16, DEXP = 256, NACT = NEXP * DEXP;
constexpr float NORM_EPS = 1e-6f;
constexpr float LOG2E = 1.4426950408889634f;
constexpr float QSCALE = 0.125f * LOG2E;
constexpr int NWAVES = 8, NTHREADS = 512;

constexpr size_t MiB = 1u << 20;
constexpr size_t WS_CTL = 0, CTL_ZERO_BYTES = 1 * MiB;
constexpr size_t WS_WIN = 2 * MiB;
constexpr size_t WS_WOUT = 26 * MiB;
constexpr size_t WS_WG = 34 * MiB;
constexpr size_t WS_WU = 66 * MiB;
constexpr size_t WS_WD = 98 * MiB;
constexpr size_t WS_LSEM0 = 1 * MiB;
constexpr size_t WS_KMEAN = 130 * MiB;
constexpr size_t WS_HB = 131 * MiB;
constexpr size_t WS_Q = 195 * MiB, WS_K = 259 * MiB, WS_V = 323 * MiB, WS_XB = 387 * MiB;
constexpr size_t WS_ACT = WS_Q;
constexpr size_t WS_LSE = 451 * MiB;
constexpr size_t WS_LIST = 454 * MiB;
constexpr size_t WS_WLIST = 457 * MiB;
constexpr size_t WS_QLIST = WS_LIST;
constexpr size_t WS_PM = 463 * MiB;
constexpr size_t WS_LSEM1 = 511 * MiB;
constexpr size_t WS_END = 512 * MiB;
constexpr int QL_PER_BH = 126976;
constexpr int CW_GDONE = 1536;
constexpr int CW_MCNT = 2048;
constexpr int CW_CNT = 1024;
constexpr int CW_TCNT = 16384;
constexpr int CW_BAR = 4096;

constexpr int RING_BYTES = 131072;
constexpr int LDSCTL_OFF = 147456, MISC_OFF = LDSCTL_OFF + 320;
constexpr int LDS_BYTES = 148480;

__device__ __forceinline__ unsigned f2bf(float f) { unsigned u = __builtin_bit_cast(unsigned, f); return (u + 0x7fffu + ((u >> 16) & 1u)) >> 16; }
__device__ __forceinline__ unsigned pk2(float lo, float hi) { return f2bf(lo) | (f2bf(hi) << 16); }
__device__ __forceinline__ float bflo(unsigned w) { return __builtin_bit_cast(float, w << 16); }
__device__ __forceinline__ float bfhi(unsigned w) { return __builtin_bit_cast(float, w & 0xffff0000u); }
template <int M> __device__ __forceinline__ float swz_xor(float v) { return __builtin_bit_cast(float, __builtin_amdgcn_ds_swizzle(__builtin_bit_cast(int, v), 0x1f | (M << 10))); }
__device__ __forceinline__ void swap32(unsigned x, unsigned& lo_val, unsigned& hi_val) { unsigned y = x; asm volatile("" : "+v"(y)); auto rr = __builtin_amdgcn_permlane32_swap(x, y, false, false); lo_val = rr[0]; hi_val = rr[1]; }
__device__ __forceinline__ float sum_xor32(float v) { unsigned a, b; swap32(__builtin_bit_cast(unsigned, v), a, b); return __builtin_bit_cast(float, a) + __builtin_bit_cast(float, b); }
__device__ __forceinline__ float max_xor32(float v) { unsigned a, b; swap32(__builtin_bit_cast(unsigned, v), a, b); return fmaxf(__builtin_bit_cast(float, a), __builtin_bit_cast(float, b)); }
__device__ __forceinline__ float get_xor32(float v, int hi) { unsigned a, b; swap32(__builtin_bit_cast(unsigned, v), a, b); return __builtin_bit_cast(float, hi ? a : b); }
__device__ __forceinline__ int get_xor32i(int v, int hi) { unsigned a, b; swap32((unsigned)v, a, b); return (int)(hi ? a : b); }
template <int CTRL> __device__ __forceinline__ float dpp_mov(float v) { return __builtin_bit_cast(float, __builtin_amdgcn_update_dpp(0, __builtin_bit_cast(int, v), CTRL, 0xf, 0xf, false)); }
__device__ __forceinline__ float row_sum(float v) { v += dpp_mov<0xB1>(v); v += dpp_mov<0x4E>(v); v += dpp_mov<0x141>(v); v += dpp_mov<0x140>(v); return v; }
__device__ __forceinline__ float half_sum(float v) { v = row_sum(v); v += swz_xor<16>(v); return v; }
__device__ __forceinline__ float wave_sum(float v) { return sum_xor32(half_sum(v)); }
#define LDS_WAIT() asm volatile("s_waitcnt lgkmcnt(0)" ::: "memory")
#define LAUNDER_V(x) asm volatile("" : "+v"(x))
#define LAUNDER_S(x) asm volatile("" : "+s"(x))

namespace pg8 {
constexpr int BM = 256, BK = 64, HALF = 128, HTB = HALF * BK * 2, STAGE_BYTES = 8 * HTB, NXCD = 8, WGM = 8;
__host__ __device__ __forceinline__ int lds_byte(int r, int c) { const int st = (r >> 4) * 2 + (c >> 5), rr = r & 15, cc = c & 31, ob = rr * 64 + cc * 2; return st * 1024 + (ob ^ (((ob >> 9) & 1) << 5)); }
__host__ __device__ __forceinline__ void stage_rc(int b, int& R, int& C) { const int st = b / 1024, sb = b % 1024, swz = sb ^ (((sb >> 9) & 1) << 5); R = (st >> 1) * 16 + swz / 64; C = (st & 1) * 32 + (swz % 64) / 2; }
__host__ __device__ __forceinline__ int perm32(int rho) { const int n = rho >> 4, i = rho & 15; return 8 * (i >> 2) + 4 * n + (i & 3); }

struct Unit { int pm, pn, meta;
    __device__ __forceinline__ int bk() const { return meta & 31; } __device__ __forceinline__ int tib() const { return (meta >> 5) & 255; } __device__ __forceinline__ int nb() const { return meta >> 13; } };
struct Gemm { const char* A; const char* B; int lda, ldb, K; long tstepA, tstepB, hstepB; };

struct StaticOrder {
    int nM, nN, nwg, G, c;
    __host__ __device__ void init(int nM_, int nN_, int G_, int c_) { nM = nM_; nN = nN_; nwg = nM * nN; G = G_; c = c_; }
    __host__ __device__ bool next(int i, Unit& u) const {
        const long L = (long)i * G + c; if (L >= nwg) return false;
        int wgid = (int)L; { const int q = nwg / NXCD, r = nwg % NXCD, xcd = wgid % NXCD, off = wgid / NXCD; wgid = (xcd < r ? xcd * (q + 1) : r * (q + 1) + (xcd - r) * q) + off; }
        const int nig = WGM * nN, gid = wgid / nig, fm = gid * WGM, gsz = (nM - fm) < WGM ? (nM - fm) : WGM;
        u.pm = fm + ((wgid % nig) % gsz); u.pn = (wgid % nig) / gsz; return true;
    }
};

__device__ __forceinline__ unsigned cvt_pk_bf16(float lo, float hi) { unsigned r; asm volatile("v_cvt_pk_bf16_f32 %0, %1, %2" : "=v"(r) : "v"(lo), "v"(hi)); return r; }

struct EpiQKV {
    static constexpr bool PERM = true;
    bf16_t* O; size_t split_stride; float scale0;
    __device__ __forceinline__ void operator()(const f32x4 (&acc)[2][2][4][2], const Unit& u, int wr, int wc, int fr, int fq) const {
        asm volatile("" : "+v"(fr), "+v"(fq));
        const int row0 = u.pm * BM + wr * 64 + fr; int colt = u.pn * BM;
        const int t = colt / DM; bf16_t* base = O + (size_t)t * split_stride; colt -= t * DM; const float sc = (t == 0) ? scale0 : 1.f;
        const int col0 = colt + wc * 32 + 8 * fq;
#pragma unroll
        for (int ai = 0; ai < 2; ++ai)
#pragma unroll
            for (int m = 0; m < 4; ++m) { bf16_t* rowp = base + (size_t)(row0 + ai * HALF + m * 16) * DM + col0;
#pragma unroll
                for (int bj = 0; bj < 2; ++bj) { f32x4 v0 = acc[ai][bj][m][0] * sc, v1 = acc[ai][bj][m][1] * sc;
                    u32x4 w; w.x = cvt_pk_bf16(v0[0], v0[1]); w.y = cvt_pk_bf16(v0[2], v0[3]); w.z = cvt_pk_bf16(v1[0], v1[1]); w.w = cvt_pk_bf16(v1[2], v1[3]);
                    *(u32x4*)(rowp + bj * HALF) = w; } }
        if (u.pn == 4) {
            float* kmean = (float*)((unsigned char*)O - WS_Q + WS_KMEAN) + ((size_t)((u.pm >> 5) * 4) * 32 + (u.pm & 31)) * HD;
#pragma unroll
            for (int bj = 0; bj < 2; ++bj)
#pragma unroll
                for (int n = 0; n < 2; ++n)
#pragma unroll
                    for (int j = 0; j < 4; ++j) { float cs = 0.f;
#pragma unroll
                        for (int ai = 0; ai < 2; ++ai)
#pragma unroll
                            for (int m = 0; m < 4; ++m) cs += acc[ai][bj][m][n][j];
                        cs = row_sum(cs);
                        const int col = bj * HALF + wc * 32 + 8 * fq + 4 * n + j;
                        if (fr == 0) __hip_atomic_fetch_add(kmean + (size_t)(col >> 6) * 32 * HD + (col & 63), cs, __ATOMIC_RELAXED, __HIP_MEMORY_SCOPE_AGENT); }
        }
    }
};
struct EpiResAdd {
    static constexpr bool PERM = true;
    bf16_t* xb;
    __device__ __forceinline__ void operator()(const f32x4 (&acc)[2][2][4][2], const Unit& u, int wr, int wc, int fr, int fq) const {
        asm volatile("" : "+v"(fr), "+v"(fq));
        const int col0 = u.pn * BM + wc * 32 + 8 * fq;
#pragma unroll
        for (int ai = 0; ai < 2; ++ai) { u32x4 r[4][2];
#pragma unroll
            for (int m = 0; m < 4; ++m) { const bf16_t* rowp = xb + (size_t)(u.pm * BM + ai * HALF + wr * 64 + m * 16 + fr) * DM + col0;
#pragma unroll
                for (int bj = 0; bj < 2; ++bj) r[m][bj] = *(const u32x4*)(rowp + bj * HALF); }
#pragma unroll
            for (int m = 0; m < 4; ++m) { bf16_t* rowp = xb + (size_t)(u.pm * BM + ai * HALF + wr * 64 + m * 16 + fr) * DM + col0;
#pragma unroll
                for (int bj = 0; bj < 2; ++bj) { const f32x4 v0 = acc[ai][bj][m][0], v1 = acc[ai][bj][m][1]; const u32x4 q = r[m][bj];
                    u32x4 w; w.x = cvt_pk_bf16(bflo(q.x) + v0[0], bfhi(q.x) + v0[1]); w.y = cvt_pk_bf16(bflo(q.y) + v0[2], bfhi(q.y) + v0[3]);
                    w.z = cvt_pk_bf16(bflo(q.z) + v1[0], bfhi(q.z) + v1[1]); w.w = cvt_pk_bf16(bflo(q.w) + v1[2], bfhi(q.w) + v1[3]);
                    *(u32x4*)(rowp + bj * HALF) = w; } } }
    }
};
struct EpiGateUpDense {
    static constexpr bool PERM = true;
    bf16_t* act; const float* comb;
    __device__ __forceinline__ void operator()(const f32x4 (&acc)[2][2][4][2], const Unit& u, int wr, int wc, int fr, int fq) const {
        asm volatile("" : "+v"(fr), "+v"(fq));
        const int e = u.pn >> 1, c0 = (u.pn & 1) * HALF;
        const int col0 = e * DEXP + c0 + wc * 32 + 8 * fq;
#pragma unroll
        for (int ai = 0; ai < 2; ++ai)
#pragma unroll
            for (int m = 0; m < 4; ++m) { const int row = u.pm * BM + ai * HALF + wr * 64 + m * 16 + fr;
                const float cw = comb[(size_t)row * NEXP + e];
                float o[8];
#pragma unroll
                for (int n = 0; n < 2; ++n)
#pragma unroll
                    for (int j = 0; j < 4; ++j) { const float g = acc[ai][0][m][n][j], up = acc[ai][1][m][n][j];
                        const float sg = g * __builtin_amdgcn_rcpf(1.f + __builtin_amdgcn_exp2f(-g * LOG2E));
                        o[n * 4 + j] = sg * up * cw; }
                u32x4 w; w.x = cvt_pk_bf16(o[0], o[1]); w.y = cvt_pk_bf16(o[2], o[3]); w.z = cvt_pk_bf16(o[4], o[5]); w.w = cvt_pk_bf16(o[6], o[7]);
                *(u32x4*)(act + (size_t)row * NACT + col0) = w; }
    }
};

template <class Epi, class Sched>
__device__ __forceinline__ void gemm_phase(LAS unsigned char* lds, const Gemm g, const Sched& S, const Epi& E, int wave_id) {
    int lane_l = (int)__builtin_amdgcn_mbcnt_hi(~0u, __builtin_amdgcn_mbcnt_lo(~0u, 0u)); asm volatile("" : "+v"(lane_l));
    const int wid = wave_id, lane = lane_l, tid = wid * 64 + lane, wr = wid >> 2, wc = wid & 3, fr = lane & 15, fq = lane >> 4;
    const int K = g.K, nt = K / BK;
    unsigned voffA[2], voffB[2];
#pragma unroll
    for (int i = 0; i < 2; ++i) { int R, C; stage_rc(tid * 16 + i * 8192, R, C); const int Rb = Epi::PERM ? ((R & ~31) + perm32(R & 31)) : R;
        voffA[i] = (unsigned)(R * g.lda + C) * 2u; voffB[i] = (unsigned)(Rb * g.ldb + C) * 2u; }
    const size_t kstep = (size_t)(BK * 2);
    const size_t hstepA = (size_t)HALF * g.lda * 2;
    const long hstepB = g.hstepB;
    const unsigned ldsw = (unsigned)wid * 1024u;
    const int aoff = lds_byte(wr * 64 + fr, fq * 8), boff = lds_byte(wc * 32 + fr, fq * 8);
#define PG8_SA(b, h) (((b) * 2 + (h)) * HTB)
#define PG8_SB(b, h) ((4 + (b) * 2 + (h)) * HTB)
#define PG8_STAGE(bufoff, gbase, voff) do { _Pragma("unroll") for (int _i = 0; _i < 2; ++_i) \
        __builtin_amdgcn_global_load_lds((const unsigned*)((const char*)(gbase) + (voff)[_i]), (LAS unsigned*)(lds + (bufoff) + ldsw + _i * 8192), 16, 0, 0); } while (0)
#define PG8_LDA(dst, b, h) do { _Pragma("unroll") for (int m = 0; m < 4; ++m) _Pragma("unroll") for (int k = 0; k < 2; ++k) dst[m][k] = *(const LAS bf16x8*)(lds + PG8_SA(b, h) + aoff + m * 2048 + k * 1024); } while (0)
#define PG8_LDB(dst, b, h) do { _Pragma("unroll") for (int n = 0; n < 2; ++n) _Pragma("unroll") for (int k = 0; k < 2; ++k) dst[n][k] = *(const LAS bf16x8*)(lds + PG8_SB(b, h) + boff + n * 2048 + k * 1024); } while (0)
#define PG8_MMA(ai, bj, At, Bt) do { __builtin_amdgcn_s_setprio(1); _Pragma("unroll") for (int m = 0; m < 4; ++m) _Pragma("unroll") for (int n = 0; n < 2; ++n) _Pragma("unroll") for (int k = 0; k < 2; ++k) \
        acc[ai][bj][m][n] = __builtin_amdgcn_mfma_f32_16x16x32_bf16(Bt[n][k], At[m][k], acc[ai][bj][m][n], 0, 0, 0); __builtin_amdgcn_s_setprio(0); } while (0)
#define PG8_WAIT_V(n) asm volatile("s_waitcnt vmcnt(" #n ")" ::: "memory")
#define PG8_WAIT_L(n) asm volatile("s_waitcnt lgkmcnt(" #n ")" ::: "memory")
#define PG8_BAR __builtin_amdgcn_s_barrier()
#define PG8_SCHED __builtin_amdgcn_sched_barrier(0)
    Unit cur, nxt; int ui = 0;
    if (!S.next(0, cur)) return;
    f32x4 acc[2][2][4][2];
#pragma unroll
    for (int a = 0; a < 2; ++a)
#pragma unroll
        for (int b = 0; b < 2; ++b)
#pragma unroll
            for (int m = 0; m < 4; ++m)
#pragma unroll
                for (int n = 0; n < 2; ++n) acc[a][b][m][n] = (f32x4){0.f, 0.f, 0.f, 0.f};
    bf16x8 At[4][2], B0[2][2], B1[2][2];
    const char* cA = g.A + (size_t)cur.pm * g.tstepA; const char* cB = g.B + (size_t)cur.pn * g.tstepB;
    PG8_STAGE(PG8_SB(0, 0), cB, voffB); PG8_STAGE(PG8_SB(0, 1), cB + hstepB, voffB); PG8_STAGE(PG8_SA(0, 0), cA, voffA); PG8_STAGE(PG8_SA(0, 1), cA + hstepA, voffA);
    if (wr == 1) PG8_BAR;
    PG8_WAIT_V(2); PG8_BAR;
    PG8_STAGE(PG8_SB(1, 0), cB + kstep, voffB); PG8_STAGE(PG8_SA(1, 0), cA + kstep, voffA); PG8_STAGE(PG8_SB(1, 1), cB + hstepB + kstep, voffB);
    PG8_WAIT_V(6); PG8_BAR;
    for (;;) {
        const bool has_next = S.next(ui + 1, nxt);
        const char* nA = has_next ? g.A + (size_t)nxt.pm * g.tstepA : cA; const char* nB = has_next ? g.B + (size_t)nxt.pn * g.tstepB : cB;
        for (int t = 0; t < nt; t += 2) {
            const bool last = (t == nt - 2);
            const char* a1 = cA + (size_t)(t + 1) * kstep;
            const char* a2 = last ? nA : cA + (size_t)(t + 2) * kstep; const char* b2 = last ? nB : cB + (size_t)(t + 2) * kstep;
            const char* a3 = a2 + kstep; const char* b3 = b2 + kstep;
            PG8_LDB(B0, 0, 0); PG8_LDB(B1, 0, 1); PG8_SCHED; PG8_LDA(At, 0, 0); PG8_STAGE(PG8_SA(1, 1), a1 + hstepA, voffA);
            PG8_WAIT_V(8); PG8_WAIT_L(0); PG8_BAR; PG8_MMA(0, 0, At, B0); PG8_MMA(0, 1, At, B1); PG8_BAR; PG8_SCHED;
            PG8_LDA(At, 0, 1); PG8_STAGE(PG8_SB(0, 0), b2, voffB); PG8_STAGE(PG8_SB(0, 1), b2 + hstepB, voffB); PG8_STAGE(PG8_SA(0, 0), a2, voffA);
            PG8_WAIT_V(8); PG8_WAIT_L(0); PG8_BAR; PG8_MMA(1, 0, At, B0); PG8_MMA(1, 1, At, B1); PG8_BAR; PG8_SCHED;
            PG8_LDB(B0, 1, 0); PG8_LDB(B1, 1, 1); PG8_SCHED; PG8_LDA(At, 1, 0); PG8_STAGE(PG8_SA(0, 1), a2 + hstepA, voffA);
            PG8_WAIT_V(8); PG8_WAIT_L(0); PG8_BAR; PG8_MMA(0, 0, At, B0); PG8_MMA(0, 1, At, B1); PG8_BAR; PG8_SCHED;
            PG8_LDA(At, 1, 1); PG8_STAGE(PG8_SB(1, 0), b3, voffB); PG8_STAGE(PG8_SB(1, 1), b3 + hstepB, voffB); PG8_STAGE(PG8_SA(1, 0), a3, voffA);
            PG8_WAIT_V(8); PG8_WAIT_L(0); PG8_BAR; PG8_MMA(1, 0, At, B0); PG8_MMA(1, 1, At, B1); PG8_BAR; PG8_SCHED;
        }
        if (wr == 0) PG8_BAR;
        E(acc, cur, wr, wc, fr, fq);
        if (!has_next) break;
#pragma unroll
        for (int a = 0; a < 2; ++a)
#pragma unroll
            for (int b = 0; b < 2; ++b)
#pragma unroll
                for (int m = 0; m < 4; ++m)
#pragma unroll
                    for (int n = 0; n < 2; ++n) acc[a][b][m][n] = (f32x4){0.f, 0.f, 0.f, 0.f};
        cur = nxt; cA = nA; cB = nB; ++ui;
        if (wr == 1) PG8_BAR;
    }
    PG8_WAIT_V(0);
    PG8_BAR;
#undef PG8_SA
#undef PG8_SB
#undef PG8_STAGE
#undef PG8_LDA
#undef PG8_LDB
#undef PG8_MMA
#undef PG8_WAIT_V
#undef PG8_WAIT_L
#undef PG8_BAR
#undef PG8_SCHED
}
template <class Epi, class Prob>
__device__ __forceinline__ void gemm_phase_x(LAS unsigned char* lds, const Prob& P, const Epi& E, int wave_id) {
    int lane_l = (int)__builtin_amdgcn_mbcnt_hi(~0u, __builtin_amdgcn_mbcnt_lo(~0u, 0u)); asm volatile("" : "+v"(lane_l));
    const int wid = wave_id, lane = lane_l, tid = wid * 64 + lane, wr = wid >> 2, wc = wid & 3, fr = lane & 15, fq = lane >> 4;
    const int K = P.K, nt = K / BK;
    unsigned voffB[2];
#pragma unroll
    for (int i = 0; i < 2; ++i) { int R, C; stage_rc(tid * 16 + i * 8192, R, C); const int Rb = Epi::PERM ? ((R & ~31) + perm32(R & 31)) : R; voffB[i] = (unsigned)(Rb * P.ldb + C) * 2u; }
    const size_t kstep = (size_t)(BK * 2);
    const long hstepB = P.hstepB;
    const unsigned ldsw = (unsigned)wid * 1024u;
    const int aoff = lds_byte(wr * 64 + fr, fq * 8), boff = lds_byte(wc * 32 + fr, fq * 8);
    LAS u32x4* stash = (LAS u32x4*)(lds + STAGE_BYTES + 1024) + tid;
#define PG8_SA(b, h) (((b) * 2 + (h)) * HTB)
#define PG8_SB(b, h) ((4 + (b) * 2 + (h)) * HTB)
#define PG8_STAGE(bufoff, gbase, voff) do { _Pragma("unroll") for (int _i = 0; _i < 2; ++_i) \
        __builtin_amdgcn_global_load_lds((const unsigned*)((const char*)(gbase) + (voff)[_i]), (LAS unsigned*)(lds + (bufoff) + ldsw + _i * 8192), 16, 0, 0); } while (0)
#define PG8_LDA(dst, b, h) do { _Pragma("unroll") for (int m = 0; m < 4; ++m) _Pragma("unroll") for (int k = 0; k < 2; ++k) dst[m][k] = *(const LAS bf16x8*)(lds + PG8_SA(b, h) + aoff + m * 2048 + k * 1024); } while (0)
#define PG8_LDB(dst, b, h) do { _Pragma("unroll") for (int n = 0; n < 2; ++n) _Pragma("unroll") for (int k = 0; k < 2; ++k) dst[n][k] = *(const LAS bf16x8*)(lds + PG8_SB(b, h) + boff + n * 2048 + k * 1024); } while (0)
#define PG8_MMA(ai, bj, At, Bt) do { __builtin_amdgcn_s_setprio(1); _Pragma("unroll") for (int m = 0; m < 4; ++m) _Pragma("unroll") for (int n = 0; n < 2; ++n) _Pragma("unroll") for (int k = 0; k < 2; ++k) \
        acc[ai][bj][m][n] = __builtin_amdgcn_mfma_f32_16x16x32_bf16(Bt[n][k], At[m][k], acc[ai][bj][m][n], 0, 0, 0); __builtin_amdgcn_s_setprio(0); } while (0)
#define PG8_WAIT_V(n) asm volatile("s_waitcnt vmcnt(" #n ")" ::: "memory")
#define PG8_WAIT_L(n) asm volatile("s_waitcnt lgkmcnt(" #n ")" ::: "memory")
#define PG8_BAR __builtin_amdgcn_s_barrier()
#define PG8_SCHED __builtin_amdgcn_sched_barrier(0)
#define PG8_AVOFF(dst, u) do { int t2_ = tid; asm volatile("" : "+v"(t2_)); _Pragma("unroll") for (int i_ = 0; i_ < 2; ++i_) { int R_, C_; stage_rc(t2_ * 16 + i_ * 8192, R_, C_); _Pragma("unroll") for (int h_ = 0; h_ < 2; ++h_) \
        dst[h_][i_] = (Prob::GATHER ? P.arow_off(u, h_, R_) : (unsigned)((h_ * HALF + R_) * P.lda) * 2u) + (unsigned)C_ * 2u; } } while (0)
    Unit cur, nxt; int ui = 0;
    if (!P.next(0, cur)) return;
    unsigned vA[2][2];
    PG8_AVOFF(vA, cur);
    f32x4 acc[2][2][4][2];
#pragma unroll
    for (int a = 0; a < 2; ++a)
#pragma unroll
        for (int b = 0; b < 2; ++b)
#pragma unroll
            for (int m = 0; m < 4; ++m)
#pragma unroll
                for (int n = 0; n < 2; ++n) acc[a][b][m][n] = (f32x4){0.f, 0.f, 0.f, 0.f};
    bf16x8 At[4][2], B0[2][2], B1[2][2];
    const char* cA = P.a_base(cur); const char* cB = P.b_base(cur);
    long csplit = Prob::KSPLIT ? P.bsplit(cur) : 0;
    if (Prob::WAITS) P.a_ready(cur, wid);
    PG8_STAGE(PG8_SB(0, 0), cB, voffB); PG8_STAGE(PG8_SB(0, 1), cB + hstepB, voffB); PG8_STAGE(PG8_SA(0, 0), cA, vA[0]); PG8_STAGE(PG8_SA(0, 1), cA, vA[1]);
    if (wr == 1) PG8_BAR;
    PG8_WAIT_V(2); PG8_BAR;
    PG8_STAGE(PG8_SB(1, 0), cB + kstep, voffB); PG8_STAGE(PG8_SA(1, 0), cA + kstep, vA[0]); PG8_STAGE(PG8_SB(1, 1), cB + hstepB + kstep, voffB);
    PG8_WAIT_V(6); PG8_BAR;
    for (;;) {
        const bool has_next = P.next(ui + 1, nxt);
        const char* nA = has_next ? P.a_base(nxt) : cA; const char* nB = has_next ? P.b_base(nxt) : cB;
        if (Prob::GATHER) { unsigned vN[2][2];
            if (has_next) { PG8_AVOFF(vN, nxt); } else { vN[0][0] = vA[0][0]; vN[0][1] = vA[0][1]; vN[1][0] = vA[1][0]; vN[1][1] = vA[1][1]; }
            *stash = (u32x4){vN[0][0], vN[0][1], vN[1][0], vN[1][1]}; }
        for (int t = 0; t < nt; t += 2) {
            const bool last = (t == nt - 2);
            if (Prob::WAITS && last && has_next) P.a_ready(nxt, wid);
            const char* a1 = cA + (size_t)(t + 1) * kstep;
            const char* a2 = last ? nA : cA + (size_t)(t + 2) * kstep;
            const char* b2 = last ? nB : cB + (size_t)(t + 2) * kstep + ((Prob::KSPLIT && (t + 2) >= (nt >> 1)) ? csplit : 0);
            const char* a3 = a2 + kstep; const char* b3 = b2 + kstep;
            PG8_LDB(B0, 0, 0); PG8_LDB(B1, 0, 1); PG8_SCHED; PG8_LDA(At, 0, 0); PG8_STAGE(PG8_SA(1, 1), a1, vA[1]);
            if (Prob::GATHER && last) { const u32x4 sv = *stash; vA[0][0] = sv.x; vA[0][1] = sv.y; vA[1][0] = sv.z; vA[1][1] = sv.w; }
            PG8_WAIT_V(8); PG8_WAIT_L(0); PG8_BAR; PG8_MMA(0, 0, At, B0); PG8_MMA(0, 1, At, B1); PG8_BAR; PG8_SCHED;
            PG8_LDA(At, 0, 1); PG8_STAGE(PG8_SB(0, 0), b2, voffB); PG8_STAGE(PG8_SB(0, 1), b2 + hstepB, voffB); PG8_STAGE(PG8_SA(0, 0), a2, vA[0]);
            PG8_WAIT_V(8); PG8_WAIT_L(0); PG8_BAR; PG8_MMA(1, 0, At, B0); PG8_MMA(1, 1, At, B1); PG8_BAR; PG8_SCHED;
            PG8_LDB(B0, 1, 0); PG8_LDB(B1, 1, 1); PG8_SCHED; PG8_LDA(At, 1, 0); PG8_STAGE(PG8_SA(0, 1), a2, vA[1]);
            PG8_WAIT_V(8); PG8_WAIT_L(0); PG8_BAR; PG8_MMA(0, 0, At, B0); PG8_MMA(0, 1, At, B1); PG8_BAR; PG8_SCHED;
            PG8_LDA(At, 1, 1); PG8_STAGE(PG8_SB(1, 0), b3, voffB); PG8_STAGE(PG8_SB(1, 1), b3 + hstepB, voffB); PG8_STAGE(PG8_SA(1, 0), a3, vA[0]);
            PG8_WAIT_V(8); PG8_WAIT_L(0); PG8_BAR; PG8_MMA(1, 0, At, B0); PG8_MMA(1, 1, At, B1); PG8_BAR; PG8_SCHED;
        }
        if (wr == 0) PG8_BAR;
        E(acc, cur, wr, wc, fr, fq);
        if (!has_next) break;
#pragma unroll
        for (int a = 0; a < 2; ++a)
#pragma unroll
            for (int b = 0; b < 2; ++b)
#pragma unroll
                for (int m = 0; m < 4; ++m)
#pragma unroll
                    for (int n = 0; n < 2; ++n) acc[a][b][m][n] = (f32x4){0.f, 0.f, 0.f, 0.f};
        cur = nxt; cA = nA; cB = nB; ++ui;
        if (Prob::KSPLIT) csplit = P.bsplit(cur);
        if (wr == 1) PG8_BAR;
    }
    PG8_WAIT_V(0);
    PG8_BAR;
#undef PG8_SA
#undef PG8_SB
#undef PG8_STAGE
#undef PG8_LDA
#undef PG8_LDB
#undef PG8_MMA
#undef PG8_WAIT_V
#undef PG8_WAIT_L
#undef PG8_BAR
#undef PG8_SCHED
#undef PG8_AVOFF
}

__device__ __forceinline__ int pair_a(int pi) { return pi < 3 ? 0 : (pi < 5 ? 1 : 2); }
__device__ __forceinline__ int pair_b(int pi) { return pi == 0 ? 1 : ((pi == 1 || pi == 3) ? 2 : 3); }
template <int MODE>
struct MoeProb {
    static constexpr bool GATHER = (MODE == 0), KSPLIT = (MODE == 1);
    const unsigned* cnt; const unsigned* list; const char* A; const char* B; int lda, ldb, K; long hstepB; int G, c; unsigned* tcnt;
    static constexpr bool WAITS = (MODE == 1);
    __device__ __forceinline__ void a_ready(const Unit& u, int wave) const {
        if (MODE == 1) {
            if (wave == 0) { unsigned polls = 0;
                while ((unsigned)__builtin_amdgcn_readfirstlane(__hip_atomic_load(tcnt + 64 * u.pm, __ATOMIC_RELAXED, __HIP_MEMORY_SCOPE_AGENT)) < 32u) {
                    if (++polls > (1u << 20)) break;
                    __builtin_amdgcn_s_sleep(2); }
                __builtin_amdgcn_fence(__ATOMIC_ACQUIRE, "agent");
                asm volatile("s_waitcnt vmcnt(0)" ::: "memory"); }
            asm volatile("" ::: "memory"); __builtin_amdgcn_s_barrier(); asm volatile("" ::: "memory");
        }
    }
    __device__ __forceinline__ bool next(int i, Unit& u) const {
        const long L = (long)i * G + c; const int tileidx = (int)(L >> 2);
        int accu = 0, bk = -1, tib = 0, nb = 0;
        for (int k = 0; k < 24; ++k) { const int n = (int)cnt[k]; const int tl = (n + 255) >> 8; if (bk < 0 && tileidx < accu + tl) { bk = k; tib = tileidx - accu; nb = n; } accu += tl; }
        if (bk < 0) return false;
        u.pm = tileidx; u.pn = (int)(L & 3); u.meta = bk | (tib << 5) | (nb << 13); return true;
    }
    __device__ __forceinline__ int expert(const Unit& u, int s) const { const int g = u.bk() / 6, pi = u.bk() % 6; return g * 4 + (s ? pair_b(pi) : pair_a(pi)); }
    __device__ __forceinline__ const char* a_base(const Unit& u) const { return MODE == 0 ? A : A + (size_t)u.pm * 256 * lda * 2; }
    __device__ __forceinline__ const char* b_base(const Unit& u) const {
        if (MODE == 0) return B + ((size_t)expert(u, u.pn >> 1) * DEXP + (size_t)(u.pn & 1) * HALF) * ldb * 2;
        return B + (size_t)u.pn * 256 * ldb * 2 + (size_t)expert(u, 0) * DEXP * 2;
    }
    __device__ __forceinline__ unsigned arow_off(const Unit& u, int h, int R) const { const int pos = u.tib() * 256 + h * HALF + R; const unsigned tok = pos < u.nb() ? list[(size_t)u.bk() * T + pos] : 0u; return tok * (unsigned)(lda * 2); }
    __device__ __forceinline__ long bsplit(const Unit& u) const { return ((long)(expert(u, 1) - expert(u, 0)) * DEXP - DEXP) * 2; }
};
struct EpiGateUpSparse {
    static constexpr bool PERM = true;
    bf16_t* act; const float* wlist; unsigned* tcnt;
    __device__ __forceinline__ void operator()(const f32x4 (&acc)[2][2][4][2], const Unit& u, int wr, int wc, int fr, int fq) const {
        asm volatile("" : "+v"(fr), "+v"(fq));
        const int s = u.pn >> 1, col0 = s * DEXP + (u.pn & 1) * HALF + wc * 32 + 8 * fq;
        const __amdgpu_buffer_rsrc_t rs_act = __builtin_amdgcn_make_buffer_rsrc((void*)act, (short)0, 0x7fffffff, 0x00020000);
#pragma unroll
        for (int ai = 0; ai < 2; ++ai)
#pragma unroll
            for (int m = 0; m < 4; ++m) { const int r = ai * HALF + wr * 64 + m * 16 + fr, pos = u.tib() * 256 + r;
                const float cw = pos < u.nb() ? wlist[((size_t)u.bk() * T + pos) * 2 + s] : 0.f;
                float o[8];
#pragma unroll
                for (int n = 0; n < 2; ++n)
#pragma unroll
                    for (int j = 0; j < 4; ++j) { const float g = acc[ai][0][m][n][j], up = acc[ai][1][m][n][j];
                        const float sg = g * __builtin_amdgcn_rcpf(1.f + __builtin_amdgcn_exp2f(-g * LOG2E));
                        o[n * 4 + j] = sg * up * cw; }
                u32x4 w; w.x = cvt_pk_bf16(o[0], o[1]); w.y = cvt_pk_bf16(o[2], o[3]); w.z = cvt_pk_bf16(o[4], o[5]); w.w = cvt_pk_bf16(o[6], o[7]);
                __builtin_amdgcn_raw_buffer_store_b128(w, rs_act, (int)((((unsigned)u.pm * 256u + (unsigned)r) * 512u + (unsigned)col0) * 2u), 0, 16);
                if (m & 1) asm volatile("" ::: "memory"); }
        asm volatile("s_waitcnt vmcnt(0)" ::: "memory");
        if ((fr | fq) == 0) __hip_atomic_fetch_add(tcnt + 64 * u.pm, 1u, __ATOMIC_RELAXED, __HIP_MEMORY_SCOPE_AGENT);
    }
};
struct EpiDownScatter {
    static constexpr bool PERM = true;
    bf16_t* xb; const unsigned* list;
    __device__ __forceinline__ void operator()(const f32x4 (&acc)[2][2][4][2], const Unit& u, int wr, int wc, int fr, int fq) const {
        asm volatile("" : "+v"(fr), "+v"(fq));
        const int col0 = u.pn * BM + wc * 32 + 8 * fq;
        unsigned tok[8];
#pragma unroll
        for (int g = 0; g < 8; ++g) { const int pos = u.tib() * 256 + (g >> 2) * HALF + wr * 64 + (g & 3) * 16 + fr; tok[g] = pos < u.nb() ? list[(size_t)u.bk() * T + pos] : 0xffffffffu; }
#pragma unroll
        for (int ai = 0; ai < 2; ++ai) { u32x4 r[4][2];
#pragma unroll
            for (int m = 0; m < 4; ++m) { const unsigned tk = tok[ai * 4 + m]; const bf16_t* rowp = xb + (size_t)(tk != 0xffffffffu ? tk : 0u) * DM + col0;
#pragma unroll
                for (int bj = 0; bj < 2; ++bj) r[m][bj] = *(const u32x4*)(rowp + bj * HALF); }
#pragma unroll
            for (int m = 0; m < 4; ++m) { const unsigned tk = tok[ai * 4 + m];
                if (tk != 0xffffffffu) { bf16_t* rowp = xb + (size_t)tk * DM + col0;
#pragma unroll
                    for (int bj = 0; bj < 2; ++bj) { const f32x4 v0 = acc[ai][bj][m][0], v1 = acc[ai][bj][m][1]; const u32x4 q = r[m][bj];
                        u32x4 w; w.x = cvt_pk_bf16(bflo(q.x) + v0[0], bfhi(q.x) + v0[1]); w.y = cvt_pk_bf16(bflo(q.y) + v0[2], bfhi(q.y) + v0[3]);
                        w.z = cvt_pk_bf16(bflo(q.z) + v1[0], bfhi(q.z) + v1[1]); w.w = cvt_pk_bf16(bflo(q.w) + v1[2], bfhi(q.w) + v1[3]);
                        *(u32x4*)(rowp + bj * HALF) = w; } } } }
    }
};
}

#define XB_TMO      128
#define XB_XCNT(j)  (256  + 64 * (j))
#define XB_XSUB(j)  (1280 + 64 * (j))
#define XB_XGEN(j)  (2304 + 64 * (j))
#define XB_TOP      3328
#define XB_TOPGEN   3392
#define XCD_BAR_WORDS 3456
#define XB_SPIN_CAP (1u << 18)
__device__ __forceinline__ unsigned xb_ld(unsigned* p)              { return __hip_atomic_load(p, __ATOMIC_RELAXED, __HIP_MEMORY_SCOPE_AGENT); }
__device__ __forceinline__ unsigned xb_add(unsigned* p, unsigned v) { return __hip_atomic_fetch_add(p, v, __ATOMIC_RELAXED, __HIP_MEMORY_SCOPE_AGENT); }
__device__ __forceinline__ unsigned xb_xcc_id() { return (unsigned)__builtin_amdgcn_s_getreg((3 << 11) | 20) & 0xFu; }
#define XB_SPIN(cond, bar) do { unsigned _sp = 0; while (cond) { __builtin_amdgcn_s_sleep(1); \
    if ((++_sp & 255u) == 0u) { if (xb_ld(&(bar)[XB_TMO])) break; if (_sp > XB_SPIN_CAP) { atomicAdd(&(bar)[XB_TMO], 1u); break; } } } } while (0)
struct XcdBarrier { unsigned* bar; unsigned x; volatile LAS unsigned* st; int wave; };
__device__ __forceinline__ bool xb_thread0(int wave) { return wave == 0 && __builtin_amdgcn_mbcnt_hi(~0u, __builtin_amdgcn_mbcnt_lo(~0u, 0u)) == 0u; }
__device__ __forceinline__ XcdBarrier xcd_barrier_post(unsigned* bar, volatile LAS unsigned* st, int wave) {
    XcdBarrier b; b.bar = bar; b.x = xb_xcc_id(); b.st = st; b.wave = wave;
    if (xb_thread0(wave)) (void)xb_add(&bar[XB_XCNT(b.x)], 1u);
    return b;
}
__device__ __forceinline__ void xcd_barrier_complete(unsigned* bar, unsigned x, unsigned& nloc, unsigned& nx) {
    const unsigned G = gridDim.x * gridDim.y * gridDim.z;
    unsigned sum, cnt, mine, sp = 0u;
    for (;;) {
        sum = 0u; cnt = 0u; mine = 0u;
#pragma unroll
        for (unsigned j = 0; j < 16; ++j) { const unsigned c = xb_ld(&bar[XB_XCNT(j)]); sum += c; cnt += (c > 0u) ? 1u : 0u; mine = (j == x) ? c : mine; }
        if (sum == G) break;
        __builtin_amdgcn_s_sleep(1);
        if ((++sp & 255u) == 0u) { if (xb_ld(&bar[XB_TMO])) break; if (sp > XB_SPIN_CAP) { atomicAdd(&bar[XB_TMO], 1u); break; } }
    }
    nloc = mine > 0u ? mine : 1u; nx = cnt > 0u ? cnt : 1u;
}
__device__ __forceinline__ void xcd_barrier(const XcdBarrier& b) {
    asm volatile("s_waitcnt vmcnt(0)" ::: "memory");
    __syncthreads();
    if (xb_thread0(b.wave)) {
        unsigned* bar = b.bar;
        __builtin_amdgcn_s_waitcnt(0);
        unsigned nloc = b.st[0], nx = b.st[1];
        if (nloc == 0u) { xcd_barrier_complete(bar, b.x, nloc, nx); b.st[0] = nloc; b.st[1] = nx; }
        const unsigned old = xb_add(&bar[XB_XSUB(b.x)], 1u);
        const unsigned gen = old / nloc;
        if (old + 1u == (gen + 1u) * nloc) {
            __builtin_amdgcn_fence(__ATOMIC_RELEASE, "agent");
            asm volatile("s_waitcnt vmcnt(0)" ::: "memory");
            const unsigned og = xb_add(&bar[XB_TOP], 1u);
            const unsigned tg = og / nx;
            if (og + 1u == (tg + 1u) * nx) xb_add(&bar[XB_TOPGEN], 1u);
            else XB_SPIN(xb_ld(&bar[XB_TOPGEN]) == tg, bar);
            __builtin_amdgcn_fence(__ATOMIC_ACQUIRE, "agent");
            xb_add(&bar[XB_XGEN(b.x)], 1u);
            asm volatile("s_waitcnt vmcnt(0)" ::: "memory");
        } else {
            XB_SPIN(xb_ld(&bar[XB_XGEN(b.x)]) == gen, bar);
            __builtin_amdgcn_fence(__ATOMIC_ACQUIRE, "agent");
            asm volatile("s_waitcnt vmcnt(0)" ::: "memory");
        }
    }
    __syncthreads();
}

struct Args {
    const float* x; const float* ln1_g; const float* w_in; const float* mix_g; const float* w_out; const float* ln2_g;
    const float* w_gr; const float* b_gr; const float* w_er; const float* b_er; const float* w_gate; const float* w_up; const float* w_down; const float* fin_g;
    float* out; unsigned char* ws; int ph_lo, ph_hi, li, pad;
};

__device__ __forceinline__ void transpose_item(const float* W, int K, int N, bf16_t* WT, int dpitch, int dcol, LAS float* scr, int item, int lane) {
    const int nblk = N / 32, kb = item / nblk, nb = item % nblk, k0 = 64 * kb, n0 = 32 * nb;
#pragma unroll 8
    for (int i = 0; i < 32; ++i) { const int kk = 2 * i + (lane >> 5); scr[kk * 33 + (lane & 31)] = W[(size_t)(k0 + kk) * N + n0 + (lane & 31)]; }
    LDS_WAIT(); asm volatile("" ::: "memory");
    const int c = lane & 7;
#pragma unroll
    for (int j = 0; j < 4; ++j) { const int n = (lane >> 3) + 8 * j; const LAS float* s = scr + (8 * c) * 33 + n;
        u32x4 o; o.x = pk2(s[0 * 33], s[1 * 33]); o.y = pk2(s[2 * 33], s[3 * 33]); o.z = pk2(s[4 * 33], s[5 * 33]); o.w = pk2(s[6 * 33], s[7 * 33]);
        *(u32x4*)(WT + (size_t)(n0 + n) * dpitch + dcol + k0 + 8 * c) = o; }
    LDS_WAIT(); asm volatile("" ::: "memory");
}
__device__ __forceinline__ void phase_prologue(const Args& a, LAS unsigned char* lds, int gw, int NGW, int wave, int lane) {
    LAS float* scr = (LAS float*)(lds + wave * 16384);
    constexpr int I_IN = (DM / 64) * (NQKV / 32);
    constexpr int I_OUT = (DM / 64) * (DM / 32);
    constexpr int I_G = (DM / 64) * (DEXP / 32);
    constexpr int I_D = (DEXP / 64) * (DM / 32);
    constexpr int N_IN = DEPTH * I_IN, N_OUT = DEPTH * I_OUT, N_G = DEPTH * NEXP * I_G, N_D = DEPTH * NEXP * I_D;
    constexpr int NITEMS = N_IN + N_OUT + 2 * N_G + N_D;
    bf16_t* WinT = (bf16_t*)(a.ws + WS_WIN); bf16_t* WoutT = (bf16_t*)(a.ws + WS_WOUT); bf16_t* WgT = (bf16_t*)(a.ws + WS_WG); bf16_t* WuT = (bf16_t*)(a.ws + WS_WU); bf16_t* WdT = (bf16_t*)(a.ws + WS_WD);
    for (int it = gw; it < NITEMS; it += NGW) {
        int r = it;
        if (r < N_IN) { const int l = r / I_IN; transpose_item(a.w_in + (size_t)l * DM * NQKV, DM, NQKV, WinT + (size_t)l * NQKV * DM, DM, 0, scr, r % I_IN, lane); continue; } r -= N_IN;
        if (r < N_OUT) { const int l = r / I_OUT; transpose_item(a.w_out + (size_t)l * DM * DM, DM, DM, WoutT + (size_t)l * DM * DM, DM, 0, scr, r % I_OUT, lane); continue; } r -= N_OUT;
        if (r < N_G) { const int le = r / I_G; transpose_item(a.w_gate + (size_t)le * DM * DEXP, DM, DEXP, WgT + (size_t)le * DEXP * DM, DM, 0, scr, r % I_G, lane); continue; } r -= N_G;
        if (r < N_G) { const int le = r / I_G; transpose_item(a.w_up + (size_t)le * DM * DEXP, DM, DEXP, WuT + (size_t)le * DEXP * DM, DM, 0, scr, r % I_G, lane); continue; } r -= N_G;
        { const int le = r / I_D, l = le / NEXP, e = le % NEXP; transpose_item(a.w_down + (size_t)le * DEXP * DM, DEXP, DM, WdT + (size_t)l * DM * NACT, NACT, e * DEXP, scr, r % I_D, lane); }
    }
}

__device__ __forceinline__ void phase_norm1(const float* x, const float* g, bf16_t* hb, int gw, int NGW, int lane, float* kmean_zero, bf16_t* xb) {
    for (int i = gw * 64 + lane; i < BATCH * 4 * 32 * HD; i += NGW * 64) kmean_zero[i] = 0.f;
    f32x4 gv[4];
#pragma unroll
    for (int j = 0; j < 4; ++j) gv[j] = *((const f32x4*)g + lane + 64 * j);
    for (int m = gw; m < T; m += NGW) {
        const f32x4* xr = (const f32x4*)(x + (size_t)m * DM) + lane;
        f32x4 v[4]; float s = 0.f;
#pragma unroll
        for (int j = 0; j < 4; ++j) { v[j] = xr[64 * j]; s += (v[j].x * v[j].x + v[j].y * v[j].y) + (v[j].z * v[j].z + v[j].w * v[j].w); }
        const float rstd = 1.0f / sqrtf(wave_sum(s) * (1.f / DM) + NORM_EPS);
        u32x2* o8 = (u32x2*)(hb + (size_t)m * DM) + lane; u32x2* x8 = (u32x2*)(xb + (size_t)m * DM) + lane;
#pragma unroll
        for (int j = 0; j < 4; ++j) { u32x2 w; w.x = pk2(v[j].x * rstd * gv[j].x, v[j].y * rstd * gv[j].y); w.y = pk2(v[j].z * rstd * gv[j].z, v[j].w * rstd * gv[j].w); o8[64 * j] = w;
            u32x2 c; c.x = pk2(v[j].x, v[j].y); c.y = pk2(v[j].z, v[j].w); x8[64 * j] = c; }
    }
}
__device__ __forceinline__ void phase_norm1_b(const bf16_t* xb, const float* g, bf16_t* hb, int gw, int NGW, int lane, float* kmean_zero) {
    for (int i = gw * 64 + lane; i < BATCH * 4 * 32 * HD; i += NGW * 64) kmean_zero[i] = 0.f;
    f32x4 gv[4];
#pragma unroll
    for (int j = 0; j < 2; ++j) { gv[2 * j] = *((const f32x4*)g + 2 * lane + 128 * j); gv[2 * j + 1] = *((const f32x4*)g + 2 * lane + 128 * j + 1); }
    for (int m = gw; m < T; m += NGW) {
        const u32x4* xr = (const u32x4*)(xb + (size_t)m * DM) + lane;
        u32x4 r[2]; float s = 0.f;
#pragma unroll
        for (int j = 0; j < 2; ++j) r[j] = xr[64 * j];
        f32x4 v[4];
#pragma unroll
        for (int j = 0; j < 2; ++j) { v[2 * j] = (f32x4){bflo(r[j].x), bfhi(r[j].x), bflo(r[j].y), bfhi(r[j].y)}; v[2 * j + 1] = (f32x4){bflo(r[j].z), bfhi(r[j].z), bflo(r[j].w), bfhi(r[j].w)}; }
#pragma unroll
        for (int j = 0; j < 4; ++j) s += (v[j].x * v[j].x + v[j].y * v[j].y) + (v[j].z * v[j].z + v[j].w * v[j].w);
        const float rstd = 1.0f / sqrtf(wave_sum(s) * (1.f / DM) + NORM_EPS);
        u32x4* o16 = (u32x4*)(hb + (size_t)m * DM) + lane;
#pragma unroll
        for (int j = 0; j < 2; ++j) { const f32x4 a = v[2 * j] * rstd * gv[2 * j], b = v[2 * j + 1] * rstd * gv[2 * j + 1];
            u32x4 w; w.x = pk2(a.x, a.y); w.y = pk2(a.z, a.w); w.z = pk2(b.x, b.y); w.w = pk2(b.z, b.w); o16[64 * j] = w; }
    }
}
__device__ __forceinline__ void unpack8(float (&f)[8], const u32x4 w) { f[0] = bflo(w.x); f[1] = bfhi(w.x); f[2] = bflo(w.y); f[3] = bfhi(w.y); f[4] = bflo(w.z); f[5] = bfhi(w.z); f[6] = bflo(w.w); f[7] = bfhi(w.w); }
struct MixRow { u32x4 a, c0, c1, c2, p0, p1, p2; float l0, l1, l2, e0, e1, e2, e3; };
__device__ __forceinline__ void mix_load(MixRow& r, int m, const bf16_t* ob, const bf16_t* hb, const float* lse, const bf16_t* pm, const float* lsem0, const float* lsem1, int lane, int hh) {
    r.a = *((const u32x4*)(ob + (size_t)m * DM) + lane); r.c0 = *((const u32x4*)(ob + (size_t)m * DM + 512) + lane);
    r.c1 = *((const u32x4*)(hb + (size_t)m * DM) + lane); r.c2 = *((const u32x4*)(hb + (size_t)m * DM + 512) + lane);
    r.l0 = lse[(size_t)m * 8 + hh]; r.l1 = lse[(size_t)T * 8 + (size_t)m * 8 + hh]; r.l2 = lse[(size_t)2 * T * 8 + (size_t)m * 8 + hh];
    if (lane < 32) {
        r.p0 = *((const u32x4*)(pm + (size_t)m * 256) + lane); r.p1 = *((const u32x4*)(pm + ((size_t)T + m) * 256) + lane); r.p2 = *((const u32x4*)(pm + ((size_t)2 * T + m) * 256) + lane);
        r.e0 = lsem0[(size_t)m * 4 + hh]; r.e1 = lsem0[(size_t)T * 4 + (size_t)m * 4 + hh]; r.e2 = lsem1[(size_t)m * 4 + hh]; r.e3 = lsem1[(size_t)T * 4 + (size_t)m * 4 + hh]; }
}
__device__ __forceinline__ void phase_mixnorm(const bf16_t* ob, bf16_t* hb, const float* lse, const bf16_t* pm, const float* lsem0, const float* lsem1, const float* g, int gw, int NGW, int lane) {
    float g0[8], g1[8];
#pragma unroll
    for (int j = 0; j < 8; ++j) { g0[j] = g[8 * lane + j]; g1[j] = g[512 + 8 * lane + j]; }
    const int hh = lane >> 3;
    MixRow cur, nxt;
    if (gw < T) mix_load(cur, gw, ob, hb, lse, pm, lsem0, lsem1, lane, hh);
    for (int m = gw; m < T; m += NGW) {
        if (m + NGW < T) mix_load(nxt, m + NGW, ob, hb, lse, pm, lsem0, lsem1, lane, hh);
        float va[8]; unpack8(va, cur.a);
        if (lane < 32) {
            const float mx = fmaxf(fmaxf(cur.e0, cur.e1), fmaxf(cur.e2, cur.e3));
            float u0 = __builtin_amdgcn_exp2f(cur.e0 - mx), u1 = __builtin_amdgcn_exp2f(cur.e1 - mx), u2 = __builtin_amdgcn_exp2f(cur.e2 - mx), u3 = __builtin_amdgcn_exp2f(cur.e3 - mx);
            const float inv = 1.0f / ((u0 + u1) + (u2 + u3)); u0 *= inv; u1 *= inv; u2 *= inv; u3 *= inv;
            float y0[8], y1[8], y2[8]; unpack8(y0, cur.p0); unpack8(y1, cur.p1); unpack8(y2, cur.p2);
#pragma unroll
            for (int j = 0; j < 8; ++j) va[j] = (u0 * y0[j] + u1 * y1[j]) + (u2 * y2[j] + u3 * va[j]);
        }
        const float mx = fmaxf(cur.l0, fmaxf(cur.l1, cur.l2));
        float w0 = __builtin_amdgcn_exp2f(cur.l0 - mx), w1 = __builtin_amdgcn_exp2f(cur.l1 - mx), w2 = __builtin_amdgcn_exp2f(cur.l2 - mx);
        const float inv = 1.0f / (w0 + w1 + w2); w0 *= inv; w1 *= inv; w2 *= inv;
        float x0[8], x1[8], x2[8]; unpack8(x0, cur.c0); unpack8(x1, cur.c1); unpack8(x2, cur.c2);
        float vc[8];
        float sa = 0.f, sc = 0.f;
#pragma unroll
        for (int j = 0; j < 8; ++j) { vc[j] = w0 * x0[j] + w1 * x1[j] + w2 * x2[j]; sa += va[j] * va[j]; sc += vc[j] * vc[j]; }
        sa = half_sum(sa); sc = wave_sum(sc);
        const float ra = 1.0f / sqrtf(sa * (1.f / 256.f) + NORM_EPS), rc = 1.0f / sqrtf(sc * (1.f / 512.f) + NORM_EPS);
        u32x4 oa, oc;
        oa.x = pk2(va[0] * ra * g0[0], va[1] * ra * g0[1]); oa.y = pk2(va[2] * ra * g0[2], va[3] * ra * g0[3]); oa.z = pk2(va[4] * ra * g0[4], va[5] * ra * g0[5]); oa.w = pk2(va[6] * ra * g0[6], va[7] * ra * g0[7]);
        oc.x = pk2(vc[0] * rc * g1[0], vc[1] * rc * g1[1]); oc.y = pk2(vc[2] * rc * g1[2], vc[3] * rc * g1[3]); oc.z = pk2(vc[4] * rc * g1[4], vc[5] * rc * g1[5]); oc.w = pk2(vc[6] * rc * g1[6], vc[7] * rc * g1[7]);
        *((u32x4*)(hb + (size_t)m * DM) + lane) = oa; *((u32x4*)(hb + (size_t)m * DM + 512) + lane) = oc;
        cur = nxt;
    }
}
__device__ __forceinline__ void phase_route(const bf16_t* x, const float* g, const float* wgr, const float* bgr, const float* wer, const float* ber,
                                            bf16_t* hb, unsigned* cnt, unsigned* list, float* wlist, LAS unsigned char* lds, int v, int G, int wave, int lane) {
    const int tid = wave * 64 + lane;
    LAS f32x4* wl = (LAS f32x4*)lds;
    for (int idx = tid; idx < 5 * DM; idx += NTHREADS) { const int mtx = idx >> 10, d = idx & 1023; const float* src = (mtx == 0 ? wgr : wer + (size_t)(mtx - 1) * DM * 4) + d * 4;
        wl[mtx * 1024 + (d & 3) * 256 + (d >> 2)] = *(const f32x4*)src; }
    LAS unsigned* cl = (LAS unsigned*)(lds + 81920);
    LAS u32x2* info = (LAS u32x2*)(lds + 81920 + 256);
    LAS f32x2* infw = (LAS f32x2*)(lds + 81920 + 256 + 4096);
    if (tid < 64) cl[tid] = 0u;
    __syncthreads();
    const int rpw = (T + G - 1) / G, row0 = v * rpw;
    f32x4 gv[4];
#pragma unroll
    for (int j = 0; j < 4; ++j) gv[j] = *((const f32x4*)g + lane + 64 * j);
    const f32x4 bg = *(const f32x4*)bgr;
    u32x2 nx[4];
    { const int m0 = row0 + wave; if (wave < rpw && m0 < T) { const u32x2* xr = (const u32x2*)(x + (size_t)m0 * DM) + lane;
#pragma unroll
        for (int j = 0; j < 4; ++j) nx[j] = xr[64 * j]; } }
    for (int r = wave; r < rpw; r += NWAVES) {
        const int m = row0 + r; if (m >= T) break;
        f32x4 vv[4]; float s = 0.f;
#pragma unroll
        for (int j = 0; j < 4; ++j) { vv[j] = (f32x4){bflo(nx[j].x), bfhi(nx[j].x), bflo(nx[j].y), bfhi(nx[j].y)}; s += (vv[j].x * vv[j].x + vv[j].y * vv[j].y) + (vv[j].z * vv[j].z + vv[j].w * vv[j].w); }
        if (r + NWAVES < rpw && m + NWAVES < T) { const u32x2* xr = (const u32x2*)(x + (size_t)(m + NWAVES) * DM) + lane;
#pragma unroll
            for (int j = 0; j < 4; ++j) nx[j] = xr[64 * j]; }
        const float rstd = 1.0f / sqrtf(wave_sum(s) * (1.f / DM) + NORM_EPS);
        u32x2* o8 = (u32x2*)(hb + (size_t)m * DM) + lane;
#pragma unroll
        for (int j = 0; j < 4; ++j) { vv[j] = vv[j] * rstd * gv[j]; u32x2 w; w.x = pk2(vv[j].x, vv[j].y); w.y = pk2(vv[j].z, vv[j].w); o8[64 * j] = w; }
        f32x4 gl = (f32x4){0.f, 0.f, 0.f, 0.f};
#pragma unroll
        for (int j = 0; j < 4; ++j) { LAS f32x4* wp = wl + lane + 64 * j;
            gl += wp[0] * vv[j].x; gl += wp[256] * vv[j].y; gl += wp[512] * vv[j].z; gl += wp[768] * vv[j].w; }
        gl.x = wave_sum(gl.x) + bg.x; gl.y = wave_sum(gl.y) + bg.y; gl.z = wave_sum(gl.z) + bg.z; gl.w = wave_sum(gl.w) + bg.w;
        int gi = 0; float gm = gl.x;
        if (gl.y > gm) { gm = gl.y; gi = 1; } if (gl.z > gm) { gm = gl.z; gi = 2; } if (gl.w > gm) { gm = gl.w; gi = 3; }
        const float gden = __expf(gl.x - gm) + __expf(gl.y - gm) + __expf(gl.z - gm) + __expf(gl.w - gm);
        const float gw_ = 1.0f / gden;
        gi = __builtin_amdgcn_readfirstlane(gi);
        f32x4 el = (f32x4){0.f, 0.f, 0.f, 0.f};
#pragma unroll
        for (int j = 0; j < 4; ++j) { LAS f32x4* wp = wl + (1 + gi) * 1024 + lane + 64 * j;
            el += wp[0] * vv[j].x; el += wp[256] * vv[j].y; el += wp[512] * vv[j].z; el += wp[768] * vv[j].w; }
        const f32x4 be = *(const f32x4*)(ber + gi * 4);
        float e[4] = {wave_sum(el.x) + be.x, wave_sum(el.y) + be.y, wave_sum(el.z) + be.z, wave_sum(el.w) + be.w};
        int i1 = 0; float v1 = e[0];
#pragma unroll
        for (int k = 1; k < 4; ++k) if (e[k] > v1) { v1 = e[k]; i1 = k; }
        int i2 = -1; float v2 = -INFINITY;
#pragma unroll
        for (int k = 0; k < 4; ++k) if (k != i1 && e[k] > v2) { v2 = e[k]; i2 = k; }
        const float p2 = __expf(v2 - v1), inv = 1.0f / (1.0f + p2);
        const float w1 = inv * gw_, w2 = p2 * inv * gw_;
        const int ea = i1 < i2 ? i1 : i2, eb = i1 < i2 ? i2 : i1; const float wa = i1 < i2 ? w1 : w2, wb = i1 < i2 ? w2 : w1;
        const int pi = (ea == 0) ? (eb - 1) : (ea == 1 ? eb + 1 : 5), bk = gi * 6 + pi;
        if (lane == 0) { const unsigned rank = __hip_atomic_fetch_add(cl + bk, 1u, __ATOMIC_RELAXED, __HIP_MEMORY_SCOPE_WORKGROUP);
            info[r] = (u32x2){(unsigned)bk, rank}; infw[r] = (f32x2){wa, wb}; }
    }
    __syncthreads();
    if (tid < 24) cl[32 + tid] = __hip_atomic_fetch_add(cnt + tid, cl[tid], __ATOMIC_RELAXED, __HIP_MEMORY_SCOPE_AGENT);
    __syncthreads();
    if (tid < rpw && row0 + tid < T) { const u32x2 inf = info[tid]; const f32x2 wv = infw[tid]; const size_t slot = (size_t)inf.x * T + cl[32 + inf.x] + inf.y;
        list[slot] = (unsigned)(row0 + tid); *(f32x2*)(wlist + slot * 2) = wv; }
    __syncthreads();
}
__device__ __forceinline__ void phase_final(const bf16_t* xb, const float* g, float* out, int gw, int NGW, int lane) {
    f32x4 gv[4];
#pragma unroll
    for (int j = 0; j < 2; ++j) { gv[2 * j] = *((const f32x4*)g + 2 * lane + 128 * j); gv[2 * j + 1] = *((const f32x4*)g + 2 * lane + 128 * j + 1); }
    for (int m = gw; m < T; m += NGW) {
        const u32x4* xr = (const u32x4*)(xb + (size_t)m * DM) + lane;
        u32x4 r[2]; float s = 0.f;
#pragma unroll
        for (int j = 0; j < 2; ++j) r[j] = xr[64 * j];
        f32x4 v[4];
#pragma unroll
        for (int j = 0; j < 2; ++j) { v[2 * j] = (f32x4){bflo(r[j].x), bfhi(r[j].x), bflo(r[j].y), bfhi(r[j].y)}; v[2 * j + 1] = (f32x4){bflo(r[j].z), bfhi(r[j].z), bflo(r[j].w), bfhi(r[j].w)}; }
#pragma unroll
        for (int j = 0; j < 4; ++j) s += (v[j].x * v[j].x + v[j].y * v[j].y) + (v[j].z * v[j].z + v[j].w * v[j].w);
        const float rstd = 1.0f / sqrtf(wave_sum(s) * (1.f / DM) + NORM_EPS);
        f32x4* orow = (f32x4*)(out + (size_t)m * DM) + 2 * lane;
#pragma unroll
        for (int j = 0; j < 2; ++j) { orow[128 * j] = v[2 * j] * rstd * gv[2 * j]; orow[128 * j + 1] = v[2 * j + 1] * rstd * gv[2 * j + 1]; }
    }
}
__device__ __forceinline__ void phase_kmean(const bf16_t* kb, float* kmean, int gw, int NGW, int lane) {
    for (int it = gw; it < BATCH * 4 * 32; it += NGW) {
        const int b = it >> 7, h = (it >> 5) & 3, blk = it & 31;
        const bf16_t* base = kb + ((size_t)b * SEQ + (size_t)blk * 256) * DM + h * HD + (lane & 7) * 8;
        float acc[8] = {0.f, 0.f, 0.f, 0.f, 0.f, 0.f, 0.f, 0.f};
#pragma unroll 4
        for (int i = 0; i < 32; ++i) { const u32x4 w = *(const u32x4*)(base + (size_t)((lane >> 3) + 8 * i) * DM);
            acc[0] += bflo(w.x); acc[1] += bfhi(w.x); acc[2] += bflo(w.y); acc[3] += bfhi(w.y); acc[4] += bflo(w.z); acc[5] += bfhi(w.z); acc[6] += bflo(w.w); acc[7] += bfhi(w.w); }
#pragma unroll
        for (int j = 0; j < 8; ++j) { acc[j] += swz_xor<8>(acc[j]); acc[j] += swz_xor<16>(acc[j]); acc[j] = sum_xor32(acc[j]); }
        if (lane < 8) {
            float* o = kmean + (size_t)it * HD + lane * 8;
#pragma unroll
            for (int j = 0; j < 8; ++j) o[j] = acc[j] * (1.f / 256.f);
        }
    }
}

__device__ __forceinline__ void ld_row64(float (&r)[64], const bf16_t* p) {
#pragma unroll
    for (int c = 0; c < 8; ++c) { const u32x4 w = *((const u32x4*)p + c);
        r[8 * c + 0] = bflo(w.x); r[8 * c + 1] = bfhi(w.x); r[8 * c + 2] = bflo(w.y); r[8 * c + 3] = bfhi(w.y); r[8 * c + 4] = bflo(w.z); r[8 * c + 5] = bfhi(w.z); r[8 * c + 6] = bflo(w.w); r[8 * c + 7] = bfhi(w.w); }
}
__device__ __forceinline__ float dot_row64(const float (&q)[64], const bf16_t* p) {
    float s0 = 0.f, s1 = 0.f;
#pragma unroll
    for (int c = 0; c < 8; ++c) { const u32x4 w = *((const u32x4*)p + c);
        s0 += q[8 * c + 0] * bflo(w.x); s1 += q[8 * c + 1] * bfhi(w.x); s0 += q[8 * c + 2] * bflo(w.y); s1 += q[8 * c + 3] * bfhi(w.y);
        s0 += q[8 * c + 4] * bflo(w.z); s1 += q[8 * c + 5] * bfhi(w.z); s0 += q[8 * c + 6] * bflo(w.w); s1 += q[8 * c + 7] * bfhi(w.w); }
    return s0 + s1;
}
__device__ __forceinline__ void axpy_row64(float (&o)[64], float p, const bf16_t* vp) {
#pragma unroll
    for (int c = 0; c < 8; ++c) { const u32x4 w = *((const u32x4*)vp + c);
        o[8 * c + 0] += p * bflo(w.x); o[8 * c + 1] += p * bfhi(w.x); o[8 * c + 2] += p * bflo(w.y); o[8 * c + 3] += p * bfhi(w.y);
        o[8 * c + 4] += p * bflo(w.z); o[8 * c + 5] += p * bfhi(w.z); o[8 * c + 6] += p * bflo(w.w); o[8 * c + 7] += p * bfhi(w.w); }
}
__device__ __forceinline__ void st_row64(bf16_t* p, const float (&o)[64], float sc) {
#pragma unroll
    for (int c = 0; c < 8; ++c) { u32x4 w; w.x = pk2(o[8 * c] * sc, o[8 * c + 1] * sc); w.y = pk2(o[8 * c + 2] * sc, o[8 * c + 3] * sc); w.z = pk2(o[8 * c + 4] * sc, o[8 * c + 5] * sc); w.w = pk2(o[8 * c + 6] * sc, o[8 * c + 7] * sc); *((u32x4*)p + c) = w; }
}
#define OSM_STEP(sc, vrow) do { const float sc_ = (sc); if (sc_ > m_) { const float al = __builtin_amdgcn_exp2f(m_ - sc_); l_ *= al; _Pragma("unroll") for (int d_ = 0; d_ < 64; ++d_) o_[d_] *= al; m_ = sc_; } \
    const float p_ = __builtin_amdgcn_exp2f(sc_ - m_); l_ += p_; axpy_row64(o_, p_, (vrow)); } while (0)

__device__ __forceinline__ void naive_moba(const bf16_t* qb, const bf16_t* kb, const bf16_t* vb, const float* kmean, bf16_t* ob, int item, int tid) {
    const int b = item >> 6, h = (item >> 4) & 3, t = (item & 15) * 512 + tid, own = t >> 8;
    const size_t rowq = ((size_t)b * SEQ + t) * DM + h * HD;
    const bf16_t* kh = kb + (size_t)b * SEQ * DM + h * HD; const bf16_t* vh = vb + (size_t)b * SEQ * DM + h * HD;
    const float slope2 = exp2f(-2.0f * (float)(h + 1)) * LOG2E;
    float q_[64]; ld_row64(q_, qb + rowq);
    float bv0 = -INFINITY, bv1 = -INFINITY, bv2 = -INFINITY; int bi0 = -1, bi1 = -1, bi2 = -1;
    const float* km = kmean + (size_t)(b * 4 + h) * 32 * HD;
    for (int n = 0; n < own; ++n) {
        float gsum = 0.f;
#pragma unroll
        for (int d = 0; d < 64; ++d) gsum += q_[d] * km[n * HD + d];
        if (gsum > bv0) { bv2 = bv1; bi2 = bi1; bv1 = bv0; bi1 = bi0; bv0 = gsum; bi0 = n; }
        else if (gsum > bv1) { bv2 = bv1; bi2 = bi1; bv1 = gsum; bi1 = n; }
        else if (gsum > bv2) { bv2 = gsum; bi2 = n; }
    }
    float o_[64];
#pragma unroll
    for (int d = 0; d < 64; ++d) o_[d] = 0.f;
    float m_ = -INFINITY, l_ = 0.f;
    for (int s = 0; s < 3; ++s) {
        const int blk = (s == 0) ? bi0 : (s == 1) ? bi1 : bi2;
        if (blk < 0) continue;
        for (int j = 0; j < 256; ++j) { const int pos = blk * 256 + j;
            const float sc = dot_row64(q_, kh + (size_t)pos * DM) - slope2 * (float)(t - pos);
            OSM_STEP(sc, vh + (size_t)pos * DM); }
    }
    for (int pos = own * 256; pos <= t; ++pos) {
        const float sc = dot_row64(q_, kh + (size_t)pos * DM) - slope2 * (float)(t - pos);
        OSM_STEP(sc, vh + (size_t)pos * DM); }
    st_row64(ob + rowq, o_, 1.0f / l_);
}
__device__ __forceinline__ void naive_sb(const bf16_t* qb, const bf16_t* kb, const bf16_t* vb, bf16_t* ob, int item, int tid) {
    const int b = item >> 6, h = 4 + ((item >> 4) & 3), t = (item & 15) * 512 + tid;
    const size_t rowq = ((size_t)b * SEQ + t) * DM + h * HD;
    const bf16_t* kh = kb + (size_t)b * SEQ * DM + h * HD; const bf16_t* vh = vb + (size_t)b * SEQ * DM + h * HD;
    float q_[64]; ld_row64(q_, qb + rowq);
    float o_[64];
#pragma unroll
    for (int d = 0; d < 64; ++d) o_[d] = 0.f;
    float tail = 0.f;
    for (int s = t - 1; s >= 0 && tail > -150.f; --s) {
        const float z = dot_row64(q_, kh + (size_t)s * DM);
        const float lp = __builtin_amdgcn_logf(1.0f + __builtin_amdgcn_exp2f(-fabsf(z)));
        const float lnot = -(fmaxf(z, 0.f) + lp);
        const float aw = __builtin_amdgcn_exp2f(z + lnot + tail);
        axpy_row64(o_, aw, vh + (size_t)s * DM);
        tail += lnot;
    }
    st_row64(ob + rowq, o_, 1.0f);
}
__device__ __forceinline__ void naive_dil(const bf16_t* qb, const bf16_t* kb, const bf16_t* vb, bf16_t* ob, bf16_t* hb2, float* lse, int item, int tid) {
    const int b = item >> 7, h = 8 + ((item >> 4) & 7), t = (item & 15) * 512 + tid;
    const size_t rowq = ((size_t)b * SEQ + t) * DM + h * HD;
    const bf16_t* kh = kb + (size_t)b * SEQ * DM + h * HD; const bf16_t* vh = vb + (size_t)b * SEQ * DM + h * HD;
    const float slope2 = exp2f(-(float)(h - 8 + 1)) * LOG2E;
    float q_[64]; ld_row64(q_, qb + rowq);
    float o_[64];
#pragma unroll
    for (int d = 0; d < 64; ++d) o_[d] = 0.f;
    float m_ = -INFINITY, l_ = 0.f;
    for (int c = 0; c < 3; ++c) {
        const int dil = (c == 0) ? 1 : (c == 1) ? 4 : 16;
        for (int dl = 0; dl <= 128; ++dl) { const int pos = t - dl * dil; if (pos < 0) break;
            const float sc = dot_row64(q_, kh + (size_t)pos * DM) - slope2 * (float)(dl * dil);
            OSM_STEP(sc, vh + (size_t)pos * DM); }
    }
    st_row64(ob + rowq, o_, 1.0f / l_);
    { const size_t tok = (size_t)b * SEQ + t; const u32x4 z4 = {0u, 0u, 0u, 0u};
#pragma unroll
      for (int c = 0; c < 8; ++c) { *((u32x4*)(hb2 + tok * DM + (h - 8) * HD) + c) = z4; *((u32x4*)(hb2 + tok * DM + 512 + (h - 8) * HD) + c) = z4; }
      lse[tok * 8 + (h - 8)] = 0.f; lse[(size_t)T * 8 + tok * 8 + (h - 8)] = -1.0e30f; lse[(size_t)2 * T * 8 + tok * 8 + (h - 8)] = -1.0e30f; }
}

namespace att {
typedef float f32x16 __attribute__((ext_vector_type(16)));
typedef short s16x4 __attribute__((ext_vector_type(4)));
typedef short v4i16_t __attribute__((ext_vector_type(4)));
typedef __bf16 bf16x2_t __attribute__((ext_vector_type(2)));
constexpr int L_BUF = 16384;
constexpr int L_WSF = 2 * L_BUF;
constexpr int L_OST = L_WSF + 8 * 256;
constexpr int L_FLG = L_OST + 8 * 4096;
constexpr int L_END = L_FLG + 64;
constexpr float M_INIT = -1.0e30f;
#define ATT_MFMA(a, b, c) __builtin_amdgcn_mfma_f32_32x32x16_bf16((a), (b), (c), 0, 0, 0)

__device__ __forceinline__ unsigned cvtpk(float lo, float hi) { f32x2 v = {lo, hi}; bf16x2_t b = __builtin_convertvector(v, bf16x2_t); return __builtin_bit_cast(unsigned, b); }
__device__ __forceinline__ s16x4 vtr(LAS unsigned char* p) { return __builtin_bit_cast(s16x4, __builtin_amdgcn_ds_read_tr16_b64_v4i16((LAS v4i16_t*)p)); }

struct Wave { int lane, r32, hi, wid; LAS unsigned char* lds; LAS float* wsf; LAS unsigned char* ost; int vlo; };
__device__ __forceinline__ Wave make_wave(LAS unsigned char* lds, int tid, int wsf_off = L_WSF, int ost_off = L_OST) {
    Wave w; w.lane = tid & 63; w.r32 = w.lane & 31; w.hi = w.lane >> 5; w.wid = __builtin_amdgcn_readfirstlane(tid >> 6); w.lds = lds;
    w.wsf = (LAS float*)(lds + wsf_off) + w.wid * 64; w.ost = lds + ost_off + w.wid * 4096;
    w.vlo = ((w.lane >> 4) & 1) * 32 + (w.lane & 3) * 8 + (4 * w.hi + ((w.lane & 15) >> 2)) * 64;
    return w;
}
struct Stage { u32x4 k, v; };
template <class RowK, class RowV> __device__ __forceinline__ void stage_load(Stage& s, const Wave& w, const RowK& rowk, const RowV& rowv) {
    s.k = *(const u32x4*)(rowk(w.lane) + w.wid * 8);
    s.v = *(const u32x4*)(rowv(16 * (w.wid & 3) + (w.lane >> 2)) + (w.wid >> 2) * 32 + (w.lane & 3) * 8);
}
__device__ __forceinline__ void stage_write(const Stage& s, const Wave& w, int buf) {
    *(LAS u32x4*)(w.lds + buf * L_BUF + w.wid * 1024 + w.lane * 16) = s.k;
    *(LAS u32x4*)(w.lds + buf * L_BUF + 8192 + w.wid * 1024 + w.lane * 16) = s.v;
}
__device__ __forceinline__ f32x16 qk_sub(const Wave& w, int buf, int sub, const bf16x8 (&qf)[4], float init) {
    f32x16 acc;
#pragma unroll
    for (int r = 0; r < 16; ++r) acc[r] = init;
    LAS unsigned char* kp = w.lds + buf * L_BUF + w.hi * 1024 + (32 * sub + w.r32) * 16;
#pragma unroll
    for (int ks = 0; ks < 4; ++ks) { const bf16x8 kf = *(LAS bf16x8*)(kp + ks * 2048); acc = ATT_MFMA(kf, qf[ks], acc); }
    return acc;
}
__device__ __forceinline__ void pv_sub(const Wave& w, int buf, int sub, const f32x16& p, f32x16 (&o)[2]) {
    bf16x8 pk[2];
#pragma unroll
    for (int s = 0; s < 2; ++s) { u32x4 t; t.x = cvtpk(p[8 * s], p[8 * s + 1]); t.y = cvtpk(p[8 * s + 2], p[8 * s + 3]); t.z = cvtpk(p[8 * s + 4], p[8 * s + 5]); t.w = cvtpk(p[8 * s + 6], p[8 * s + 7]); pk[s] = __builtin_bit_cast(bf16x8, t); }
    LAS unsigned char* vb = w.lds + buf * L_BUF + 8192 + w.vlo;
#pragma unroll
    for (int db = 0; db < 2; ++db)
#pragma unroll
        for (int s = 0; s < 2; ++s) { LAS unsigned char* vp = vb + db * 4096 + (4 * sub + 2 * s) * 512;
            const s16x4 lo = vtr(vp), hh = vtr(vp + 512);
            const bf16x8 vf = __builtin_shufflevector(lo, hh, 0, 1, 2, 3, 4, 5, 6, 7);
            o[db] = ATT_MFMA(pk[s], vf, o[db]); }
}
struct VFrags { s16x4 f[2][2][2]; };
__device__ __forceinline__ void load_vfrags(const Wave& w, int buf, int sub, VFrags& v) {
    LAS unsigned char* vb = w.lds + buf * L_BUF + 8192 + w.vlo;
#pragma unroll
    for (int db = 0; db < 2; ++db)
#pragma unroll
        for (int s = 0; s < 2; ++s) { LAS unsigned char* vp = vb + db * 4096 + (4 * sub + 2 * s) * 512; v.f[db][s][0] = vtr(vp); v.f[db][s][1] = vtr(vp + 512); }
}
__device__ __forceinline__ void pv_frags(const VFrags& v, const f32x16& p, f32x16 (&o)[2]) {
    bf16x8 pk[2];
#pragma unroll
    for (int s = 0; s < 2; ++s) { u32x4 t; t.x = cvtpk(p[8 * s], p[8 * s + 1]); t.y = cvtpk(p[8 * s + 2], p[8 * s + 3]); t.z = cvtpk(p[8 * s + 4], p[8 * s + 5]); t.w = cvtpk(p[8 * s + 6], p[8 * s + 7]); pk[s] = __builtin_bit_cast(bf16x8, t); }
#pragma unroll
    for (int db = 0; db < 2; ++db)
#pragma unroll
        for (int s = 0; s < 2; ++s) { const bf16x8 vf = __builtin_shufflevector(v.f[db][s][0], v.f[db][s][1], 0, 1, 2, 3, 4, 5, 6, 7); o[db] = ATT_MFMA(pk[s], vf, o[db]); }
}
__device__ __forceinline__ void scale_rows(const Wave& w, f32x16 (&o)[2], float f) {
    if (w.hi == 0) w.wsf[w.r32] = f;
#pragma unroll
    for (int g = 0; g < 4; ++g) { const f32x4 fv = *(LAS f32x4*)(w.wsf + 8 * g + 4 * w.hi);
#pragma unroll
        for (int i = 0; i < 4; ++i) { o[0][4 * g + i] *= fv[i]; o[1][4 * g + i] *= fv[i]; } }
}
__device__ __forceinline__ void softmax_sub(const Wave& w, f32x16& s, float& m, float& lsum, f32x16 (&o)[2]) {
    float tm = fmaxf(fmaxf(s[0], s[1]), fmaxf(s[2], s[3]));
#pragma unroll
    for (int r = 4; r < 16; r += 4) tm = fmaxf(tm, fmaxf(fmaxf(s[r], s[r + 1]), fmaxf(s[r + 2], s[r + 3])));
    tm = max_xor32(tm);
    const float mn = fmaxf(m, tm);
    if (__any(mn > m)) { const float al = __builtin_amdgcn_exp2f(m - mn); lsum *= al; scale_rows(w, o, al); m = mn; }
    float acc = 0.f;
#pragma unroll
    for (int r = 0; r < 16; ++r) { s[r] = __builtin_amdgcn_exp2f(s[r] - m); acc += s[r]; }
    lsum += acc;
}
__device__ __forceinline__ void mask_band(f32x16& s, int delta0, int W) {
#pragma unroll
    for (int r = 0; r < 16; ++r) { const int dl = delta0 - ((r & 3) + 8 * (r >> 2)); if ((unsigned)dl > (unsigned)W) s[r] = -INFINITY; }
}
constexpr float SM_THR = 8.0f;
struct SubDesc { bool act; int delta; int W; };
template <int NSUB>
__device__ __forceinline__ void softmax_step(const Wave& w, int buf, const bf16x8 (&qf)[4], const bf16x8& kidx, const bf16x8& slp, float slope, const SubDesc (&sd)[NSUB],
                                             float& m, float& lsum, f32x16 (&o)[2], bool& first) {
    f32x16 s[NSUB];
    bool any_act = false;
#pragma unroll
    for (int i = 0; i < NSUB; ++i) if (sd[i].act) { any_act = true; s[i] = qk_sub(w, buf, i, qf, -slope * (float)sd[i].delta - m); s[i] = ATT_MFMA(kidx, slp, s[i]); }
    if (!any_act) return;
    float tm = -INFINITY;
#pragma unroll
    for (int i = 0; i < NSUB; ++i) if (sd[i].act) {
        if (sd[i].W >= 0) mask_band(s[i], sd[i].delta - 4 * w.hi, sd[i].W);
        float t = fmaxf(fmaxf(s[i][0], s[i][1]), fmaxf(s[i][2], s[i][3]));
#pragma unroll
        for (int r = 4; r < 16; r += 4) t = fmaxf(t, fmaxf(fmaxf(s[i][r], s[i][r + 1]), fmaxf(s[i][r + 2], s[i][r + 3])));
        tm = fmaxf(tm, t); }
    tm = max_xor32(tm);
    if (first || __any(tm > SM_THR)) {
        const float d = first ? (tm > -1.0e30f ? tm : 0.f) : fmaxf(tm, 0.f);
#pragma unroll
        for (int i = 0; i < NSUB; ++i) if (sd[i].act) {
#pragma unroll
            for (int r = 0; r < 16; ++r) s[i][r] -= d; }
        if (!first) { const float al = __builtin_amdgcn_exp2f(-d); lsum *= al; scale_rows(w, o, al); }
        m += d; first = false;
    }
    VFrags vf[NSUB];
#pragma unroll
    for (int i = 0; i < NSUB; ++i) if (sd[i].act) load_vfrags(w, buf, i, vf[i]);
#pragma unroll
    for (int i = 0; i < NSUB; ++i) if (sd[i].act) { float acc = 0.f;
#pragma unroll
        for (int r = 0; r < 16; ++r) { s[i][r] = __builtin_amdgcn_exp2f(s[i][r]); acc += s[i][r]; }
        lsum += acc; }
#pragma unroll
    for (int i = 0; i < NSUB; ++i) if (sd[i].act) pv_frags(vf[i], s[i], o);
}
__device__ __forceinline__ void bias_frags(const Wave& w, float slope, bf16x8& kidx, bf16x8& slp) {
    const unsigned kb = f2bf((float)w.r32), sh = f2bf(slope), sl = f2bf(slope - __builtin_bit_cast(float, sh << 16));
    const u32x4 a = {w.hi == 0 ? (kb | (kb << 16)) : 0u, 0u, 0u, 0u}, b = {w.hi == 0 ? (sh | (sl << 16)) : 0u, 0u, 0u, 0u};
    kidx = __builtin_bit_cast(bf16x8, a); slp = __builtin_bit_cast(bf16x8, b);
}
template <class RowO> __device__ __forceinline__ void store_o(const Wave& w, const f32x16 (&o)[2], const RowO& rowo) {
    LAS unsigned short* stg = (LAS unsigned short*)w.ost;
#pragma unroll
    for (int r = 0; r < 16; ++r) { const int q = (r & 3) + 8 * (r >> 2) + 4 * w.hi;
#pragma unroll
        for (int db = 0; db < 2; ++db) stg[q * 64 + db * 32 + w.r32] = (unsigned short)f2bf(o[db][r]); }
#pragma unroll
    for (int i = 0; i < 4; ++i) { const int row = i * 8 + (w.lane >> 3), ch = w.lane & 7; const u32x4 v = *(LAS u32x4*)((LAS unsigned char*)stg + row * 128 + ch * 16);
        bf16_t* dst = rowo(row); if (dst) *(u32x4*)(dst + ch * 8) = v; }
}
__device__ __forceinline__ void load_q(bf16x8 (&qf)[4], const bf16_t* qrow, int hi) {
#pragma unroll
    for (int ks = 0; ks < 4; ++ks) qf[ks] = *(const bf16x8*)(qrow + 16 * ks + 8 * hi);
}

constexpr int W_WSF = 98304, W_OST = W_WSF + 2048, W_ENUM = W_OST + 32768;
template <int NC> struct Pref { u32x4 k[NC], v[NC]; bf16x8 q[4]; };
template <int NC, class RowF> __device__ __forceinline__ void win_issue(Pref<NC>& P, const Wave& w, const bf16_t* kbase, const bf16_t* vbase, const RowF& rowoff, const bf16_t* qrow) {
#pragma unroll
    for (int c = 0; c < NC; ++c) { P.k[c] = *(const u32x4*)(kbase + rowoff(64 * c + 8 * w.wid + (w.lane >> 3)) + (w.lane & 7) * 8);
        P.v[c] = *(const u32x4*)(vbase + rowoff(64 * c + 16 * (w.wid & 3) + (w.lane >> 2)) + (w.wid >> 2) * 32 + (w.lane & 3) * 8); }
    load_q(P.q, qrow, w.hi);
}
template <int NC> __device__ __forceinline__ void win_commit(const Pref<NC>& P, const Wave& w) {
    constexpr int NK = 64 * NC;
#pragma unroll
    for (int c = 0; c < NC; ++c) { const int key = 64 * c + 8 * w.wid + (w.lane >> 3);
        *(LAS u32x4*)(w.lds + key * 128 + ((((w.lane & 7) ^ (key >> 1)) & 7) * 16)) = P.k[c];
        *(LAS u32x4*)(w.lds + NK * 128 + (w.wid >> 2) * (NK * 64) + (8 * c + 2 * (w.wid & 3)) * 512 + w.lane * 16) = P.v[c]; }
}
template <int NK> __device__ __forceinline__ f32x16 qk_win(const Wave& w, int u, const bf16x8 (&qf)[4], float init) {
    f32x16 acc;
#pragma unroll
    for (int r = 0; r < 16; ++r) acc[r] = init;
    LAS unsigned char* kp = w.lds + (32 * u + w.r32) * 128; const int x = (w.r32 >> 1) & 7;
#pragma unroll
    for (int ks = 0; ks < 4; ++ks) { const bf16x8 kf = *(LAS bf16x8*)(kp + (((2 * ks + w.hi) ^ x) * 16)); acc = ATT_MFMA(kf, qf[ks], acc); }
    return acc;
}
template <int NK> __device__ __forceinline__ void load_vfrags_win(const Wave& w, int u, VFrags& v) {
    LAS unsigned char* vb = w.lds + NK * 128 + w.vlo;
#pragma unroll
    for (int db = 0; db < 2; ++db)
#pragma unroll
        for (int s = 0; s < 2; ++s) { LAS unsigned char* vp = vb + db * (NK * 64) + (4 * u + 2 * s) * 512; v.f[db][s][0] = vtr(vp); v.f[db][s][1] = vtr(vp + 512); }
}
struct WSub { bool act; int u; int delta; int W; };
template <int NK>
__device__ __forceinline__ void softmax_win(const Wave& w, const bf16x8 (&qf)[4], const bf16x8& kidx, const bf16x8& slp, float slope, const WSub (&sd)[2], float& m, float& lsum, f32x16 (&o)[2], bool& first) {
    f32x16 s[2];
    bool any_act = false;
#pragma unroll
    for (int i = 0; i < 2; ++i) if (sd[i].act) { any_act = true; s[i] = qk_win<NK>(w, sd[i].u, qf, -slope * (float)sd[i].delta - m); s[i] = ATT_MFMA(kidx, slp, s[i]); }
    if (!any_act) return;
    float tm = -INFINITY;
#pragma unroll
    for (int i = 0; i < 2; ++i) if (sd[i].act) {
        if (sd[i].W >= 0) mask_band(s[i], sd[i].delta - 4 * w.hi, sd[i].W);
        float t = fmaxf(fmaxf(s[i][0], s[i][1]), fmaxf(s[i][2], s[i][3]));
#pragma unroll
        for (int r = 4; r < 16; r += 4) t = fmaxf(t, fmaxf(fmaxf(s[i][r], s[i][r + 1]), fmaxf(s[i][r + 2], s[i][r + 3])));
        tm = fmaxf(tm, t); }
    tm = max_xor32(tm);
    if (first || __any(tm > SM_THR)) {
        const float d = first ? (tm > -1.0e30f ? tm : 0.f) : fmaxf(tm, 0.f);
#pragma unroll
        for (int i = 0; i < 2; ++i) if (sd[i].act) {
#pragma unroll
            for (int r = 0; r < 16; ++r) s[i][r] -= d; }
        if (!first) { const float al = __builtin_amdgcn_exp2f(-d); lsum *= al; scale_rows(w, o, al); }
        m += d; first = false;
    }
#pragma unroll
    for (int i = 0; i < 2; ++i) if (sd[i].act) { VFrags vf; load_vfrags_win<NK>(w, sd[i].u, vf);
        float acc = 0.f;
#pragma unroll
        for (int r = 0; r < 16; ++r) { s[i][r] = __builtin_amdgcn_exp2f(s[i][r]); acc += s[i][r]; }
        lsum += acc;
        pv_frags(vf, s[i], o); }
}

__device__ __forceinline__ size_t ql_off(int bh, int j) { return (size_t)bh * QL_PER_BH + (size_t)(8192 * j - 128 * j * (j + 1)); }
__device__ __forceinline__ float* lsem_ptr(float* l0, float* l1, int slot) { return (slot < 2 ? l0 : l1) + (size_t)(slot & 1) * T * 4; }

struct Top3 { int i0, i1, i2; };
__device__ __forceinline__ Top3 moba_top3(const Wave& w, const bf16x8 (&qf)[4], const float* KMEAN, int b, int h, int own) {
    int i0 = -1, i1 = -1, i2 = -1;
    if (own > 0) {
    f32x16 g;
#pragma unroll
    for (int r = 0; r < 16; ++r) g[r] = 0.f;
    const float* km = KMEAN + ((size_t)(b * 4 + h) * 32 + w.r32) * HD + 8 * w.hi;
#pragma unroll
    for (int ks = 0; ks < 4; ++ks) { const f32x4 a0 = *(const f32x4*)(km + 16 * ks), a1 = *(const f32x4*)(km + 16 * ks + 4);
        const float x[8] = {a0.x, a0.y, a0.z, a0.w, a1.x, a1.y, a1.z, a1.w}; unsigned hw[4], lw[4];
#pragma unroll
        for (int j = 0; j < 4; ++j) { const unsigned h0 = f2bf(x[2 * j]), h1 = f2bf(x[2 * j + 1]); hw[j] = h0 | (h1 << 16);
            lw[j] = pk2(x[2 * j] - __builtin_bit_cast(float, h0 << 16), x[2 * j + 1] - __builtin_bit_cast(float, h1 << 16)); }
        const u32x4 hv = {hw[0], hw[1], hw[2], hw[3]}, lv = {lw[0], lw[1], lw[2], lw[3]};
        g = ATT_MFMA(__builtin_bit_cast(bf16x8, hv), qf[ks], g); g = ATT_MFMA(__builtin_bit_cast(bf16x8, lv), qf[ks], g); }
    float v0 = -INFINITY, v1 = -INFINITY, v2 = -INFINITY;
#pragma unroll
    for (int r = 0; r < 16; ++r) { const int blk = (r & 3) + 8 * (r >> 2) + 4 * w.hi; const float val = (blk < own) ? g[r] : -INFINITY;
        if (val > v0) { v2 = v1; i2 = i1; v1 = v0; i1 = i0; v0 = val; i0 = blk; } else if (val > v1) { v2 = v1; i2 = i1; v1 = val; i1 = blk; } else if (val > v2) { v2 = val; i2 = blk; } }
    const float pv_[3] = {get_xor32(v0, w.hi), get_xor32(v1, w.hi), get_xor32(v2, w.hi)}; const int pi_[3] = {get_xor32i(i0, w.hi), get_xor32i(i1, w.hi), get_xor32i(i2, w.hi)};
#pragma unroll
    for (int k = 0; k < 3; ++k) { const float val = pv_[k]; const int blk = pi_[k];
        if (val > v0 || (val == v0 && blk < i0)) { v2 = v1; i2 = i1; v1 = v0; i1 = i0; v0 = val; i0 = blk; }
        else if (val > v1 || (val == v1 && blk < i1)) { v2 = v1; i2 = i1; v1 = val; i1 = blk; }
        else if (val > v2 || (val == v2 && blk < i2)) { v2 = val; i2 = blk; } }
    }
    Top3 t; t.i0 = i0; t.i1 = i1; t.i2 = i2; return t;
}
__device__ __forceinline__ void moba_gate_unit(LAS unsigned char* lds, const bf16_t* QB, const float* KMEAN, unsigned* mcnt, unsigned* qlist, bf16_t* PM, float* LSEM0, float* LSEM1, int b, int h, int own, int tid) {
    const Wave w = make_wave(lds, tid);
    const size_t rowbase = (size_t)b * SEQ; const int qpos = own * 256 + 32 * w.wid + w.r32, bh = b * 4 + h;
    bf16x8 qf[4]; load_q(qf, QB + (rowbase + qpos) * DM + h * HD, w.hi);
    const Top3 t3 = moba_top3(w, qf, KMEAN, b, h, own); const int s0 = t3.i0, s1 = t3.i1, s2 = t3.i2;
    LAS unsigned* cl = (LAS unsigned*)(lds + W_ENUM);
    if (tid < 64) cl[tid] = 0u;
    __syncthreads();
    unsigned r0 = 0u, r1 = 0u, r2 = 0u;
    if (w.hi == 0) {
        if (s0 >= 0) r0 = __hip_atomic_fetch_add(cl + s0, 1u, __ATOMIC_RELAXED, __HIP_MEMORY_SCOPE_WORKGROUP);
        if (s1 >= 0) r1 = __hip_atomic_fetch_add(cl + s1, 1u, __ATOMIC_RELAXED, __HIP_MEMORY_SCOPE_WORKGROUP);
        if (s2 >= 0) r2 = __hip_atomic_fetch_add(cl + s2, 1u, __ATOMIC_RELAXED, __HIP_MEMORY_SCOPE_WORKGROUP);
    }
    __syncthreads();
    if (tid < 32) { const unsigned c = cl[tid]; cl[32 + tid] = c ? __hip_atomic_fetch_add(mcnt + bh * 32 + tid, c, __ATOMIC_RELAXED, __HIP_MEMORY_SCOPE_AGENT) : 0u; }
    __syncthreads();
    if (w.hi == 0) {
        const size_t tok = rowbase + qpos;
#define MOBA_EMIT(k, sk, rk) do { if (sk >= 0) qlist[ql_off(bh, sk) + cl[32 + sk] + rk] = (unsigned)qpos | ((unsigned)(k) << 13); \
            else { lsem_ptr(LSEM0, LSEM1, k)[tok * 4 + h] = -1.0e30f;          \
                u32x4* pz = (u32x4*)(PM + ((size_t)(k) * T + tok) * 256 + h * HD); const u32x4 z4 = {0u, 0u, 0u, 0u}; \
                _Pragma("unroll") for (int c = 0; c < 8; ++c) pz[c] = z4; } } while (0)
        MOBA_EMIT(0, s0, r0); MOBA_EMIT(1, s1, r1); MOBA_EMIT(2, s2, r2);
#undef MOBA_EMIT
    }
    __syncthreads();
}
struct OwnU { int b, h, own; };
__device__ __forceinline__ void own_issue(Pref<4>& P, const Wave& w, const OwnU& u, const bf16_t* QB, const bf16_t* KB, const bf16_t* VB) {
    const size_t rowbase = (size_t)u.b * SEQ; const int q0 = u.own * 256;
    win_issue<4>(P, w, KB + (rowbase + q0) * DM + u.h * HD, VB + (rowbase + q0) * DM + u.h * HD, [&](int key) { return (size_t)key * DM; }, QB + (rowbase + q0 + 32 * w.wid + w.r32) * DM + u.h * HD);
}
template <class F> __device__ __forceinline__ void own_compute(const Wave& w, const OwnU& u, const bf16x8 (&qf)[4], bf16_t* OB, float* LSEM0, float* LSEM1, const F& between) {
    const size_t rowbase = (size_t)u.b * SEQ; const int q0 = u.own * 256, ql = 32 * w.wid + w.r32;
    const float slope2 = exp2f(-2.0f * (float)(u.h + 1)) * LOG2E;
    bf16x8 kidx, slp; bias_frags(w, slope2, kidx, slp);
    f32x16 o[2];
#pragma unroll
    for (int r = 0; r < 16; ++r) { o[0][r] = 0.f; o[1][r] = 0.f; }
    float m = 0.f, lsum = 0.f; bool first = true;
#pragma unroll
    for (int p = 0; p < 4; ++p) { WSub sd[2];
#pragma unroll
        for (int i = 0; i < 2; ++i) { const int su = w.wid - 2 * p - i; sd[i].act = su >= 0; sd[i].u = su; sd[i].delta = ql - 32 * su; sd[i].W = (su == w.wid) ? 0x7fffffff : -1; }
        softmax_win<256>(w, qf, kidx, slp, slope2, sd, m, lsum, o, first); }
    between();
    const float l = sum_xor32(lsum);
    scale_rows(w, o, 1.0f / l);
    bf16_t* orow = OB + (rowbase + q0 + 32 * w.wid) * DM + u.h * HD;
    store_o(w, o, [&](int r) { return orow + (size_t)r * DM; });
    if (w.hi == 0) lsem_ptr(LSEM0, LSEM1, 3)[(rowbase + q0 + ql) * 4 + u.h] = m + __builtin_amdgcn_logf(l);
}
struct GatU { int b, h, j, cnt, chunk; const unsigned* ql; };
__device__ __forceinline__ unsigned gat_entry(const Wave& w, const GatU& u, bool& valid) { const int idx = u.chunk * 256 + 32 * w.wid + w.r32; valid = idx < u.cnt; return u.ql[valid ? idx : u.chunk * 256]; }
__device__ __forceinline__ void gat_issue(Pref<4>& P, const Wave& w, const GatU& u, const bf16_t* QB, const bf16_t* KB, const bf16_t* VB) {
    const size_t rowbase = (size_t)u.b * SEQ; bool valid; const unsigned e = gat_entry(w, u, valid);
    win_issue<4>(P, w, KB + (rowbase + u.j * 256) * DM + u.h * HD, VB + (rowbase + u.j * 256) * DM + u.h * HD, [&](int key) { return (size_t)key * DM; }, QB + (rowbase + (e & 8191u)) * DM + u.h * HD);
}
template <class F> __device__ __forceinline__ void gat_compute(const Wave& w, const GatU& u, const bf16x8 (&qf)[4], bf16_t* PM, float* LSEM0, float* LSEM1, const F& between) {
    const size_t rowbase = (size_t)u.b * SEQ; bool valid; const unsigned e = gat_entry(w, u, valid);
    const int qpos = (int)(e & 8191u), slot = (int)(e >> 13);
    const float slope2 = exp2f(-2.0f * (float)(u.h + 1)) * LOG2E;
    bf16x8 kidx, slp; bias_frags(w, slope2, kidx, slp);
    f32x16 o[2];
#pragma unroll
    for (int r = 0; r < 16; ++r) { o[0][r] = 0.f; o[1][r] = 0.f; }
    float m = 0.f, lsum = 0.f; bool first = true;
#pragma unroll
    for (int p = 0; p < 4; ++p) { WSub sd[2];
#pragma unroll
        for (int i = 0; i < 2; ++i) { const int su = 7 - 2 * p - i; sd[i].act = true; sd[i].u = su; sd[i].delta = qpos - (u.j * 256 + 32 * su); sd[i].W = -1; }
        softmax_win<256>(w, qf, kidx, slp, slope2, sd, m, lsum, o, first); }
    between();
    const float l = sum_xor32(lsum);
    scale_rows(w, o, l > 0.f ? 1.0f / l : 0.f);
    LAS int* code = (LAS int*)(w.wsf + 32);
    if (w.hi == 0) code[w.r32] = valid ? (int)((size_t)slot * T + rowbase + qpos) : -1;
    store_o(w, o, [&](int r) { const int c = code[r]; return c >= 0 ? PM + (size_t)c * 256 + u.h * HD : (bf16_t*)nullptr; });
    if (w.hi == 0 && valid) lsem_ptr(LSEM0, LSEM1, slot)[(rowbase + qpos) * 4 + u.h] = l > 0.f ? m + __builtin_amdgcn_logf(l) : -1.0e30f;
}

__device__ __forceinline__ void sb_unit(LAS unsigned char* lds, const bf16_t* QB, const bf16_t* KB, const bf16_t* VB, bf16_t* OB, int b, int h, int qt, int tid) {
    const Wave w = make_wave(lds, tid);
    const size_t rowbase = (size_t)b * SEQ; const int q0 = qt * 256, qpos = q0 + 32 * w.wid + w.r32;
    const bf16_t* kh = KB + rowbase * DM + h * HD; const bf16_t* vh = VB + rowbase * DM + h * HD;
    bf16x8 qf[4]; load_q(qf, QB + (rowbase + qpos) * DM + h * HD, w.hi);
    f32x16 o[2];
#pragma unroll
    for (int r = 0; r < 16; ++r) { o[0][r] = 0.f; o[1][r] = 0.f; }
    float carry = 0.f;
    bool done = false;
    volatile LAS unsigned* flg = (volatile LAS unsigned*)(lds + L_FLG);
    const int ti0 = q0 / 64 + 3;
    Stage sg;
    { const int kp = ti0 * 64; stage_load(sg, w, [&](int key) { return kh + (size_t)(kp + key) * DM; }, [&](int key) { return vh + (size_t)(kp + key) * DM; }); }
    stage_write(sg, w, 0);
    __syncthreads();
    for (int st = 0;; ++st) {
        const int buf = st & 1, ti = ti0 - st;
        if (ti > 0) { const int kp = (ti - 1) * 64; stage_load(sg, w, [&](int key) { return kh + (size_t)(kp + key) * DM; }, [&](int key) { return vh + (size_t)(kp + key) * DM; }); }
        if (!done) {
#pragma unroll
            for (int sub = 1; sub >= 0; --sub) {
                const int D = (q0 / 32 + w.wid) - (2 * ti + sub);
                if (D < 0) continue;
                const int delta0 = qpos - (64 * ti + 32 * sub) - 4 * w.hi;
                f32x16 z = qk_sub(w, buf, sub, qf, 0.f);
                f32x16 dd;
#pragma unroll
                for (int r = 0; r < 16; ++r) { z[r] = __builtin_amdgcn_exp2f(fminf(z[r], 30.f)); }
                if (D == 0) {
#pragma unroll
                    for (int r = 0; r < 16; ++r) { const int dl = delta0 - ((r & 3) + 8 * (r >> 2)); if (dl < 1) z[r] = 0.f; }
                }
#pragma unroll
                for (int r = 0; r < 16; ++r) dd[r] = 1.f + z[r];
                float G[4], PG[4];
#pragma unroll
                for (int g = 0; g < 4; ++g) { G[g] = (dd[4 * g] * dd[4 * g + 1]) * (dd[4 * g + 2] * dd[4 * g + 3]); PG[g] = get_xor32(G[g], w.hi); }
                const float cin = __builtin_amdgcn_exp2f(carry);
                float run = 1.f;
#pragma unroll
                for (int g = 3; g >= 0; --g) { const float x3 = run * (w.hi == 0 ? PG[g] : 1.f);
                    const float p0 = x3 * G[g];
                    const float r0 = __builtin_amdgcn_rcpf(p0) * cin, r1 = r0 * dd[4 * g], r2 = r1 * dd[4 * g + 1], r3 = r2 * dd[4 * g + 2];
                    z[4 * g] *= r0; z[4 * g + 1] *= r1; z[4 * g + 2] *= r2; z[4 * g + 3] *= r3;
                    run *= G[g] * PG[g]; }
                carry -= __builtin_amdgcn_logf(run);
                pv_sub(w, buf, sub, z, o);
            }
            done = __all(carry < -150.f);
        }
        if (w.lane == 0) flg[buf * 8 + w.wid] = done ? 1u : 0u;
        if (ti > 0) stage_write(sg, w, buf ^ 1);
        __syncthreads();
        unsigned all = 1u;
#pragma unroll
        for (int k = 0; k < 8; ++k) all &= flg[buf * 8 + k];
        if (all || ti == 0) break;
    }
    bf16_t* orow = OB + (rowbase + q0 + 32 * w.wid) * DM + h * HD;
    store_o(w, o, [&](int r) { return orow + (size_t)r * DM; });
    __syncthreads();
}

struct PrefK6 { u32x4 k[6]; bf16x8 q[4]; }; struct PrefV6 { u32x4 v[6]; };
template <class RowF> __device__ __forceinline__ void win_issue_k6(PrefK6& P, const Wave& w, const bf16_t* kbase, const RowF& rowoff, const bf16_t* qrow) {
#pragma unroll
    for (int c = 0; c < 6; ++c) P.k[c] = *(const u32x4*)(kbase + rowoff(64 * c + 8 * w.wid + (w.lane >> 3)) + (w.lane & 7) * 8);
    load_q(P.q, qrow, w.hi);
}
template <class RowF> __device__ __forceinline__ void win_issue_v6(PrefV6& P, const Wave& w, const bf16_t* vbase, const RowF& rowoff) {
#pragma unroll
    for (int c = 0; c < 6; ++c) P.v[c] = *(const u32x4*)(vbase + rowoff(64 * c + 16 * (w.wid & 3) + (w.lane >> 2)) + (w.wid >> 2) * 32 + (w.lane & 3) * 8);
}
__device__ __forceinline__ void win_commit_k6(const PrefK6& P, const Wave& w) {
#pragma unroll
    for (int c = 0; c < 6; ++c) { const int key = 64 * c + 8 * w.wid + (w.lane >> 3); *(LAS u32x4*)(w.lds + key * 128 + ((((w.lane & 7) ^ (key >> 1)) & 7) * 16)) = P.k[c]; }
}
__device__ __forceinline__ void win_commit_v6(const PrefV6& P, const Wave& w) {
    constexpr int NK = 384;
#pragma unroll
    for (int c = 0; c < 6; ++c) *(LAS u32x4*)(w.lds + NK * 128 + (w.wid >> 2) * (NK * 64) + (8 * c + 2 * (w.wid & 3)) * 512 + w.lane * 16) = P.v[c];
}
struct DilU { int b, h, dil, res, i2, c; };
__device__ __forceinline__ DilU dil_decode(int u) { const int n = ((u & 31) + (u >> 8)) & 31, bhc = u >> 5,
    c = bhc % 3, bh = bhc / 3; DilU d; d.b = bh >> 3; d.h = 8 + (bh & 7); d.c = c;
    d.dil = (c == 0) ? 1 : (c == 1) ? 4 : 16; d.res = (c == 0) ? 0 : (c == 1) ? (n >> 3) : (n >> 1); d.i2 = (c == 0) ? n : (c == 1) ? (n & 7) : (n & 1); return d; }
__device__ __forceinline__ void dil_issue_k(PrefK6& P, const Wave& w, const DilU& u, const bf16_t* QB, const bf16_t* KB) {
    const size_t rowbase = (size_t)u.b * SEQ; const int Q0 = 256 * u.i2, qj = Q0 + 32 * w.wid + w.r32; const size_t rstride = (size_t)u.dil * DM;
    win_issue_k6(P, w, KB + (rowbase + u.res) * DM + u.h * HD, [&](int key) { const int kj = Q0 - 128 + key; return (size_t)(kj < 0 ? 0 : kj) * rstride; },
                 QB + (rowbase + u.res + (size_t)qj * u.dil) * DM + u.h * HD);
}
__device__ __forceinline__ void dil_issue_v(PrefV6& P, const Wave& w, const DilU& u, const bf16_t* VB) {
    const size_t rowbase = (size_t)u.b * SEQ; const int Q0 = 256 * u.i2; const size_t rstride = (size_t)u.dil * DM;
    win_issue_v6(P, w, VB + (rowbase + u.res) * DM + u.h * HD, [&](int key) { const int kj = Q0 - 128 + key; return (size_t)(kj < 0 ? 0 : kj) * rstride; });
}
template <class F> __device__ __forceinline__ void dil_compute(const Wave& w, const DilU& u, const bf16x8 (&qf)[4], bf16_t* OB, bf16_t* HB2, float* LSE, const F& between) {
    const size_t rowbase = (size_t)u.b * SEQ; const int Q0 = 256 * u.i2, ql = 32 * w.wid + w.r32;
    const float slope2d = exp2f(-(float)(u.h - 8 + 1)) * LOG2E * (float)u.dil;
    bf16x8 kidx, slp; bias_frags(w, slope2d, kidx, slp);
    f32x16 o[2];
#pragma unroll
    for (int r = 0; r < 16; ++r) { o[0][r] = 0.f; o[1][r] = 0.f; }
    float m = 0.f, lsum = 0.f; bool first = true;
#pragma unroll
    for (int p = 0; p < 3; ++p) { WSub sd[2];
#pragma unroll
        for (int i = 0; i < 2; ++i) { const int D = 2 * p + i, su = w.wid + 4 - D; sd[i].act = (D <= 4) && (Q0 - 128 + 32 * su >= 0); sd[i].u = su; sd[i].delta = ql + 128 - 32 * su; sd[i].W = (D == 0 || D == 4) ? 128 : -1; }
        softmax_win<384>(w, qf, kidx, slp, slope2d, sd, m, lsum, o, first); }
    between();
    const float l = sum_xor32(lsum);
    scale_rows(w, o, 1.0f / l);
    bf16_t* PO = (u.c == 0) ? OB + 512 : HB2 + (u.c - 1) * 512;
    const size_t tok0 = rowbase + u.res + (size_t)(Q0 + 32 * w.wid) * u.dil;
    store_o(w, o, [&](int r) { return PO + (tok0 + (size_t)r * u.dil) * DM + (u.h - 8) * HD; });
    if (w.hi == 0) (LSE + (size_t)u.c * T * 8)[(tok0 + (size_t)w.r32 * u.dil) * 8 + (u.h - 8)] = m + __builtin_amdgcn_logf(l);
}

__device__ __forceinline__ void moba_gate_phase(LAS unsigned char* lds, const bf16_t* QB, const float* KMEAN, unsigned* mcnt, unsigned* qlist, bf16_t* PM, float* LSEM0, float* LSEM1, int v, int G, int tid) {
    for (int u = v; u < 512; u += G) { const int own = u & 31, bh = u >> 5; moba_gate_unit(lds, QB, KMEAN, mcnt, qlist, PM, LSEM0, LSEM1, bh >> 2, bh & 3, own, tid); }
}
struct AttnArgs { const bf16_t* QB; const bf16_t* KB; const bf16_t* VB; bf16_t* OB; bf16_t* HB2; float* LSE; unsigned* mcnt; unsigned* qlist; bf16_t* PM; float* LSEM0; float* LSEM1; const float* KMEAN; unsigned* gdone; };
__device__ __forceinline__ void attn_phase(LAS unsigned char* lds, const AttnArgs& A, int v, int G, int tid) {
    moba_gate_phase(lds, A.QB, A.KMEAN, A.mcnt, A.qlist, A.PM, A.LSEM0, A.LSEM1, v, G, tid);
    asm volatile("s_waitcnt vmcnt(0)" ::: "memory");
    __syncthreads();
    if (tid == 0) { __builtin_amdgcn_fence(__ATOMIC_RELEASE, "agent"); asm volatile("s_waitcnt vmcnt(0)" ::: "memory"); __hip_atomic_fetch_add(A.gdone, 1u, __ATOMIC_RELAXED, __HIP_MEMORY_SCOPE_AGENT); }
    const Wave w = make_wave(lds, tid, W_WSF, W_OST);
    {   Pref<4> P; int u = v; OwnU cur, nxt;
        auto dec = [&](int uu) { OwnU o_; const int bh = uu >> 5; o_.b = bh >> 2; o_.h = bh & 3; o_.own = uu & 31; return o_; };
        if (u < 512) { cur = dec(u); own_issue(P, w, cur, A.QB, A.KB, A.VB); }
        for (; u < 512; u += G) {
            __syncthreads();
            win_commit<4>(P, w); bf16x8 qf[4] = {P.q[0], P.q[1], P.q[2], P.q[3]};
            __syncthreads();
            const bool more = u + G < 512; if (more) nxt = dec(u + G);
            own_compute(w, cur, qf, A.OB, A.LSEM0, A.LSEM1, [&]() { if (more) own_issue(P, w, nxt, A.QB, A.KB, A.VB); });
            cur = nxt; } }
    {   PrefK6 P; int u = v; DilU cur, nxt;
        if (u < 3072) { cur = dil_decode(u); dil_issue_k(P, w, cur, A.QB, A.KB); }
        for (; u < 3072; u += G) {
            __syncthreads();
            bf16x8 qf[4] = {P.q[0], P.q[1], P.q[2], P.q[3]};
            { PrefV6 PV; dil_issue_v(PV, w, cur, A.VB); win_commit_k6(P, w); win_commit_v6(PV, w); }
            __syncthreads();
            const bool more = u + G < 3072; if (more) nxt = dil_decode(u + G);
            dil_compute(w, cur, qf, A.OB, A.HB2, A.LSE, [&]() { if (more) dil_issue_k(P, w, nxt, A.QB, A.KB); });
            cur = nxt; } }
    __syncthreads();
    for (int u = v; u < 512; u += G) { const int qt = ((u & 31) + (u >> 8)) & 31, bh = u >> 5; sb_unit(lds, A.QB, A.KB, A.VB, A.OB, bh >> 2, 4 + (bh & 3), qt, tid); }
    if (tid == 0) { unsigned polls = 0;
        while (__hip_atomic_load(A.gdone, __ATOMIC_RELAXED, __HIP_MEMORY_SCOPE_AGENT) < (unsigned)G) { if (++polls > (1u << 20)) break; __builtin_amdgcn_s_sleep(2); }
        __builtin_amdgcn_fence(__ATOMIC_ACQUIRE, "agent"); asm volatile("s_waitcnt vmcnt(0)" ::: "memory"); }
    __syncthreads();
    LAS int* cntl = (LAS int*)(lds + W_ENUM); LAS int* pa = cntl + 512; LAS int* pb = pa + 512;
    const int myc = (int)A.mcnt[tid], myu = (myc + 255) >> 8;
    cntl[tid] = myc; pa[tid] = myu;
    __syncthreads();
#pragma unroll 1
    for (int d = 1; d < 512; d <<= 1) { const int x = pa[tid] + (tid >= d ? pa[tid - d] : 0); pb[tid] = x; __syncthreads(); LAS int* t_ = pa; pa = pb; pb = t_; }
    const int total = pa[511];
    auto gat_decode = [&](int u) { int lo = 0, hi = 511;
        while (lo < hi) { const int mid = (lo + hi) >> 1; if (pa[mid] > u) hi = mid; else lo = mid + 1; }
        const int i = lo, c = cntl[i], bh = i >> 5; GatU g; g.b = bh >> 2; g.h = bh & 3; g.j = i & 31; g.cnt = c; g.chunk = u - (pa[i] - ((c + 255) >> 8)); g.ql = A.qlist + ql_off(bh, g.j); return g; };
    {   Pref<4> P; int u = v; GatU cur, nxt;
        if (u < total) { cur = gat_decode(u); gat_issue(P, w, cur, A.QB, A.KB, A.VB); }
        for (; u < total; u += G) {
            __syncthreads();
            win_commit<4>(P, w); bf16x8 qf[4] = {P.q[0], P.q[1], P.q[2], P.q[3]};
            __syncthreads();
            const bool more = u + G < total; if (more) nxt = gat_decode(u + G);
            gat_compute(w, cur, qf, A.PM, A.LSEM0, A.LSEM1, [&]() { if (more) gat_issue(P, w, nxt, A.QB, A.KB, A.VB); });
            cur = nxt; } }
}
}

constexpr int PH_PRO = 0, PH_L0 = 1, PH_PER_LAYER = 10, PH_FINAL = PH_L0 + DEPTH * PH_PER_LAYER, PH_COUNT = PH_FINAL + 1;
typedef const __attribute__((address_space(4))) Args* KArgP;
#define KARG() ({ KArgP p_ = (KArgP)__builtin_amdgcn_kernarg_segment_ptr(); asm volatile("" : "+s"(p_)); p_; })
#define PHASE_IDS int lane_p = (int)__builtin_amdgcn_mbcnt_hi(~0u, __builtin_amdgcn_mbcnt_lo(~0u, 0u)); LAUNDER_V(lane_p); int tid_p = wave * 64 + lane_p; int gw_p = gw, G_p = G, NGW_p = NGW; LAUNDER_S(gw_p); LAUNDER_S(G_p); LAUNDER_S(NGW_p)
__global__ void __launch_bounds__(NTHREADS, 2) fwd(Args a_unused) {
    extern __shared__ __attribute__((aligned(16))) unsigned char lds_raw[];
    LAS unsigned char* lds = (LAS unsigned char*)lds_raw;
    volatile LAS unsigned* MISC = (volatile LAS unsigned*)(lds + MISC_OFF);
    const int wave = __builtin_amdgcn_readfirstlane((int)threadIdx.x >> 6);
    const int G = gridDim.x, bx = blockIdx.x;
    const int vcu = (G % 8 == 0) ? (bx % 8) * (G / 8) + bx / 8 : bx;
    const int gw = vcu * NWAVES + wave, NGW = G * NWAVES;
    for (int u = threadIdx.x; u < (LDS_BYTES - LDSCTL_OFF) / 4; u += NTHREADS) ((LAS unsigned*)(lds + LDSCTL_OFF))[u] = 0u;
    __syncthreads();
    int lo, hi; XcdBarrier bar;
    { KArgP ka = KARG(); lo = ka->ph_lo; hi = ka->ph_hi; unsigned* ctl = (unsigned*)(ka->ws + WS_CTL); bar = xcd_barrier_post(ctl + CW_BAR + ka->li * XCD_BAR_WORDS, MISC + 8, wave); }
#define IN(k) (lo <= (k) && (k) < hi)
#define SEAM(k) do { if (IN(k) && IN((k) + 1)) xcd_barrier(bar); } while (0)
#define WSP(T_, off) ((T_*)(ws + (off)))

    if (IN(PH_PRO)) { KArgP ka = KARG(); PHASE_IDS; Args a; a.ws = ka->ws; a.w_in = ka->w_in; a.w_out = ka->w_out; a.w_gate = ka->w_gate; a.w_up = ka->w_up; a.w_down = ka->w_down; phase_prologue(a, lds, gw_p, NGW_p, wave, lane_p); } SEAM(PH_PRO);

    for (int l = 0; l < DEPTH; ++l) {
        const int p0 = PH_L0 + l * PH_PER_LAYER;
        if (hi <= p0 || lo >= p0 + PH_PER_LAYER) continue;
        if (IN(p0 + 0)) for (int rep_ = 0; rep_ < RPT(0); ++rep_) { if (rep_) xcd_barrier(bar); KArgP ka = KARG(); PHASE_IDS; unsigned char* ws = ka->ws;
            if (l == 0) phase_norm1(ka->x, ka->ln1_g, WSP(bf16_t, WS_HB), gw_p, NGW_p, lane_p, WSP(float, WS_KMEAN), WSP(bf16_t, WS_XB));
            else phase_norm1_b(WSP(bf16_t, WS_XB), ka->ln1_g + (size_t)l * DM, WSP(bf16_t, WS_HB), gw_p, NGW_p, lane_p, WSP(float, WS_KMEAN)); } SEAM(p0 + 0);
        if (IN(p0 + 1)) for (int rep_ = 0; rep_ < RPT(1); ++rep_) { if (rep_) xcd_barrier(bar); KArgP ka = KARG(); PHASE_IDS; unsigned char* ws = ka->ws;
            pg8::Gemm g{(const char*)(ws + WS_HB), (const char*)(ws + WS_WIN) + (size_t)l * NQKV * DM * 2, DM, DM, DM, (long)256 * DM * 2, (long)256 * DM * 2, (long)128 * DM * 2};
            pg8::StaticOrder S; S.init(T / 256, NQKV / 256, G_p, bx);
            pg8::EpiQKV E{WSP(bf16_t, WS_Q), (size_t)(WS_K - WS_Q) / 2, QSCALE};
            pg8::gemm_phase<pg8::EpiQKV, pg8::StaticOrder>(lds, g, S, E, wave);
        } SEAM(p0 + 1);
        if (IN(p0 + 4)) for (int rep_ = 0; rep_ < RPT(4); ++rep_) { if (rep_) xcd_barrier(bar); KArgP ka = KARG(); PHASE_IDS; unsigned char* ws = ka->ws;
            const att::AttnArgs A{WSP(bf16_t, WS_Q), WSP(bf16_t, WS_K), WSP(bf16_t, WS_V), (bf16_t*)ka->out, WSP(bf16_t, WS_HB), WSP(float, WS_LSE), WSP(unsigned, WS_CTL) + CW_MCNT + l * 512, WSP(unsigned, WS_QLIST),
                                  WSP(bf16_t, WS_PM), WSP(float, WS_LSEM0), WSP(float, WS_LSEM1), WSP(float, WS_KMEAN), WSP(unsigned, WS_CTL) + CW_GDONE + l * 64};
            att::attn_phase(lds, A, vcu, G_p, tid_p);
        } SEAM(p0 + 4);
        if (IN(p0 + 5)) { KArgP ka = KARG(); PHASE_IDS; unsigned char* ws = ka->ws;
            phase_mixnorm((const bf16_t*)ka->out, WSP(bf16_t, WS_HB), WSP(float, WS_LSE), WSP(bf16_t, WS_PM), WSP(float, WS_LSEM0), WSP(float, WS_LSEM1), ka->mix_g + (size_t)l * DM, gw_p, NGW_p, lane_p); } SEAM(p0 + 5);
        if (IN(p0 + 6)) { KArgP ka = KARG(); PHASE_IDS; unsigned char* ws = ka->ws;
            pg8::Gemm g{(const char*)(ws + WS_HB), (const char*)(ws + WS_WOUT) + (size_t)l * DM * DM * 2, DM, DM, DM, (long)256 * DM * 2, (long)256 * DM * 2, (long)128 * DM * 2};
            pg8::StaticOrder S; S.init(T / 256, DM / 256, G_p, bx);
            pg8::EpiResAdd E{WSP(bf16_t, WS_XB)};
            pg8::gemm_phase<pg8::EpiResAdd, pg8::StaticOrder>(lds, g, S, E, wave);
        } SEAM(p0 + 6);
        if (IN(p0 + 7)) { KArgP ka = KARG(); PHASE_IDS; unsigned char* ws = ka->ws;
            phase_route(WSP(bf16_t, WS_XB), ka->ln2_g + (size_t)l * DM, ka->w_gr + (size_t)l * DM * 4, ka->b_gr + l * 4, ka->w_er + (size_t)l * 4 * DM * 4, ka->b_er + l * 16, WSP(bf16_t, WS_HB),
                        WSP(unsigned, WS_CTL) + CW_CNT + l * 32, WSP(unsigned, WS_LIST), WSP(float, WS_WLIST), lds, vcu, G_p, wave, lane_p); } SEAM(p0 + 7);
        if (IN(p0 + 8)) for (int rep_ = 0; rep_ < RPT(8); ++rep_) { if (rep_) xcd_barrier(bar); KArgP ka = KARG(); PHASE_IDS; unsigned char* ws = ka->ws;
            pg8::MoeProb<0> P{WSP(unsigned, WS_CTL) + CW_CNT + l * 32, WSP(unsigned, WS_LIST), (const char*)(ws + WS_HB), (const char*)(ws + WS_WG) + (size_t)l * NACT * DM * 2, DM, DM, DM, (long)(WS_WU - WS_WG), G_p, vcu, WSP(unsigned, WS_CTL) + CW_TCNT + l * 16384};
            pg8::EpiGateUpSparse E{WSP(bf16_t, WS_ACT), WSP(float, WS_WLIST), WSP(unsigned, WS_CTL) + CW_TCNT + l * 16384};
            pg8::gemm_phase_x<pg8::EpiGateUpSparse, pg8::MoeProb<0>>(lds, P, E, wave);
        }
        if (IN(p0 + 9)) { KArgP ka = KARG(); PHASE_IDS; unsigned char* ws = ka->ws;
            pg8::MoeProb<1> P{WSP(unsigned, WS_CTL) + CW_CNT + l * 32, WSP(unsigned, WS_LIST), (const char*)(ws + WS_ACT), (const char*)(ws + WS_WD) + (size_t)l * DM * NACT * 2, 512, NACT, 512, (long)128 * NACT * 2, G_p, G_p - 1 - vcu, WSP(unsigned, WS_CTL) + CW_TCNT + l * 16384};
            pg8::EpiDownScatter E{WSP(bf16_t, WS_XB), WSP(unsigned, WS_LIST)};
            pg8::gemm_phase_x<pg8::EpiDownScatter, pg8::MoeProb<1>>(lds, P, E, wave);
        } SEAM(p0 + 9);
    }
    if (IN(PH_FINAL)) { KArgP ka = KARG(); PHASE_IDS; phase_final((const bf16_t*)(ka->ws + WS_XB), ka->fin_g, ka->out, gw_p, NGW_p, lane_p); }
#undef IN
#undef SEAM
#undef WSP
}

#ifndef N_LAUNCH_MODE
#define N_LAUNCH_MODE 1
#endif
extern "C" void kernel_launch(void* const* d_in, const int* in_sizes, int n_in, void* d_out, int out_size, void* d_ws, size_t ws_size, hipStream_t stream) {
    static int grid = 0;
    if (grid == 0) {
        if (n_in != 14 || in_sizes[0] != T * DM || out_size != T * DM || ws_size < WS_END) { fprintf(stderr, "kernel_launch: unexpected shapes (n_in %d in0 %d out %d ws %zu)\n", n_in, n_in > 0 ? in_sizes[0] : -1, out_size, ws_size); grid = -1; return; }
        int dev = 0, cus = 0, per_cu = 0;
        if (hipGetDevice(&dev) != hipSuccess || hipDeviceGetAttribute(&cus, hipDeviceAttributeMultiprocessorCount, dev) != hipSuccess) { grid = -1; return; }
        if (hipFuncSetAttribute((const void*)fwd, hipFuncAttributeMaxDynamicSharedMemorySize, LDS_BYTES) != hipSuccess) { fprintf(stderr, "kernel_launch: hipFuncSetAttribute failed\n"); grid = -1; return; }
        if (hipOccupancyMaxActiveBlocksPerMultiprocessor(&per_cu, (const void*)fwd, NTHREADS, LDS_BYTES) != hipSuccess || per_cu < 1) fprintf(stderr, "kernel_launch: occupancy query says %d\n", per_cu);
        (void)hipGetLastError();
        grid = cus;
    }
    if (grid < 0) return;
    if (hipMemsetAsync((char*)d_ws + WS_CTL, 0, CTL_ZERO_BYTES, stream) != hipSuccess) return;
    Args a{};
    a.x = (const float*)d_in[0]; a.ln1_g = (const float*)d_in[1]; a.w_in = (const float*)d_in[2]; a.mix_g = (const float*)d_in[3]; a.w_out = (const float*)d_in[4]; a.ln2_g = (const float*)d_in[5];
    a.w_gr = (const float*)d_in[6]; a.b_gr = (const float*)d_in[7]; a.w_er = (const float*)d_in[8]; a.b_er = (const float*)d_in[9]; a.w_gate = (const float*)d_in[10]; a.w_up = (const float*)d_in[11];
    a.w_down = (const float*)d_in[12]; a.fin_g = (const float*)d_in[13];
    a.out = (float*)d_out; a.ws = (unsigned char*)d_ws; a.pad = 0;
#if N_LAUNCH_MODE == 1
    a.ph_lo = 0; a.ph_hi = PH_COUNT; a.li = 0;
    hipLaunchKernelGGL(fwd, dim3(grid), dim3(NTHREADS), LDS_BYTES, stream, a);
#else
    for (int p = 0; p < PH_COUNT; ++p) { a.ph_lo = p; a.ph_hi = p + 1; a.li = p; hipLaunchKernelGGL(fwd, dim3(grid), dim3(NTHREADS), LDS_BYTES, stream, a); }
#endif
}
```

```cpp
#include <hip/hip_runtime.h>
#include <cstdio>
#include <cstdint>

#define LAS __attribute__((address_space(3)))
#define GAS __attribute__((address_space(1)))
typedef unsigned short bf16_t;
typedef short bf16x8 __attribute__((ext_vector_type(8)));
typedef float f32x4 __attribute__((ext_vector_type(4)));
typedef float f32x2 __attribute__((ext_vector_type(2)));
typedef unsigned u32x4 __attribute__((ext_vector_type(4)));
typedef unsigned u32x2 __attribute__((ext_vector_type(2)));

#ifndef PROBE_REPEAT
#define PROBE_REPEAT 0
#endif
#define RPT(k) ((((PROBE_REPEAT) >> (k)) & 1) ? 2 : 1)
#ifndef MOE_SPARSE
#define MOE_SPARSE 1
#endif
#ifndef ATT_MOBA
#define ATT_MOBA 1
#endif
#ifndef ATT_SB
#define ATT_SB 1
#endif
#ifndef ATT_DIL
#define ATT_DIL 1
#endif
constexpr int BATCH = 4, SEQ = 8192, DM = 1024, DEPTH = 4, T = BATCH * SEQ, NH = 16, HD = 64;
constexpr int NQKV = 3 * DM, NEXP = 16, DEXP = 256, NACT = NEXP * DEXP;
constexpr float NORM_EPS = 1e-6f;
constexpr float LOG2E = 1.4426950408889634f;
constexpr float QSCALE = 0.125f * LOG2E;
constexpr int NWAVES = 8, NTHREADS = 512;

constexpr size_t MiB = 1u << 20;
constexpr size_t WS_CTL = 0, CTL_ZERO_BYTES = 1 * MiB;
constexpr size_t WS_WIN = 2 * MiB;
constexpr size_t WS_WOUT = 26 * MiB;
constexpr size_t WS_WG = 34 * MiB;
constexpr size_t WS_WU = 66 * MiB;
constexpr size_t WS_WD = 98 * MiB;
constexpr size_t WS_LSEM0 = 1 * MiB;
constexpr size_t WS_KMEAN = 130 * MiB;
constexpr size_t WS_HB = 131 * MiB;
constexpr size_t WS_Q = 195 * MiB, WS_K = 259 * MiB, WS_V = 323 * MiB, WS_XB = 387 * MiB;
constexpr size_t WS_ACT = WS_Q;
constexpr size_t WS_LSE = 451 * MiB;
constexpr size_t WS_LIST = 454 * MiB;
constexpr size_t WS_WLIST = 457 * MiB;
constexpr size_t WS_QLIST = WS_LIST;
constexpr size_t WS_PM = 463 * MiB;
constexpr size_t WS_LSEM1 = 511 * MiB;
constexpr size_t WS_END = 512 * MiB;
constexpr int QL_PER_BH = 126976;
constexpr int CW_GDONE = 1536;
constexpr int CW_MCNT = 2048;
constexpr int CW_CNT = 1024;
constexpr int CW_TCNT = 16384;
constexpr int CW_BAR = 4096;

constexpr int RING_BYTES = 131072;
constexpr int LDSCTL_OFF = 147456, MISC_OFF = LDSCTL_OFF + 320;
constexpr int LDS_BYTES = 148480;

__device__ __forceinline__ unsigned f2bf(float f) { unsigned u = __builtin_bit_cast(unsigned, f); return (u + 0x7fffu + ((u >> 16) & 1u)) >> 16; }
__device__ __forceinline__ unsigned pk2(float lo, float hi) { return f2bf(lo) | (f2bf(hi) << 16); }
__device__ __forceinline__ float bflo(unsigned w) { return __builtin_bit_cast(float, w << 16); }
__device__ __forceinline__ float bfhi(unsigned w) { return __builtin_bit_cast(float, w & 0xffff0000u); }
template <int M> __device__ __forceinline__ float swz_xor(float v) { return __builtin_bit_cast(float, __builtin_amdgcn_ds_swizzle(__builtin_bit_cast(int, v), 0x1f | (M << 10))); }
__device__ __forceinline__ void swap32(unsigned x, unsigned& lo_val, unsigned& hi_val) { unsigned y = x; asm volatile("" : "+v"(y)); auto rr = __builtin_amdgcn_permlane32_swap(x, y, false, false); lo_val = rr[0]; hi_val = rr[1]; }
__device__ __forceinline__ float sum_xor32(float v) { unsigned a, b; swap32(__builtin_bit_cast(unsigned, v), a, b); return __builtin_bit_cast(float, a) + __builtin_bit_cast(float, b); }
__device__ __forceinline__ float max_xor32(float v) { unsigned a, b; swap32(__builtin_bit_cast(unsigned, v), a, b); return fmaxf(__builtin_bit_cast(float, a), __builtin_bit_cast(float, b)); }
__device__ __forceinline__ float get_xor32(float v, int hi) { unsigned a, b; swap32(__builtin_bit_cast(unsigned, v), a, b); return __builtin_bit_cast(float, hi ? a : b); }
__device__ __forceinline__ int get_xor32i(int v, int hi) { unsigned a, b; swap32((unsigned)v, a, b); return (int)(hi ? a : b); }
template <int CTRL> __device__ __forceinline__ float dpp_mov(float v) { return __builtin_bit_cast(float, __builtin_amdgcn_update_dpp(0, __builtin_bit_cast(int, v), CTRL, 0xf, 0xf, false)); }
__device__ __forceinline__ float row_sum(float v) { v += dpp_mov<0xB1>(v); v += dpp_mov<0x4E>(v); v += dpp_mov<0x141>(v); v += dpp_mov<0x140>(v); return v; }
__device__ __forceinline__ float half_sum(float v) { v = row_sum(v); v += swz_xor<16>(v); return v; }
__device__ __forceinline__ float wave_sum(float v) { return sum_xor32(half_sum(v)); }
#define LDS_WAIT() asm volatile("s_waitcnt lgkmcnt(0)" ::: "memory")
#define LAUNDER_V(x) asm volatile("" : "+v"(x))
#define LAUNDER_S(x) asm volatile("" : "+s"(x))

namespace pg8 {
constexpr int BM = 256, BK = 64, HALF = 128, HTB = HALF * BK * 2, STAGE_BYTES = 8 * HTB, NXCD = 8, WGM = 8;
__host__ __device__ __forceinline__ int lds_byte(int r, int c) { const int st = (r >> 4) * 2 + (c >> 5), rr = r & 15, cc = c & 31, ob = rr * 64 + cc * 2; return st * 1024 + (ob ^ (((ob >> 9) & 1) << 5)); }
__host__ __device__ __forceinline__ void stage_rc(int b, int& R, int& C) { const int st = b / 1024, sb = b % 1024, swz = sb ^ (((sb >> 9) & 1) << 5); R = (st >> 1) * 16 + swz / 64; C = (st & 1) * 32 + (swz % 64) / 2; }
__host__ __device__ __forceinline__ int perm32(int rho) { const int n = rho >> 4, i = rho & 15; return 8 * (i >> 2) + 4 * n + (i & 3); }

struct Unit { int pm, pn, meta;
    __device__ __forceinline__ int bk() const { return meta & 31; } __device__ __forceinline__ int tib() const { return (meta >> 5) & 255; } __device__ __forceinline__ int nb() const { return meta >> 13; } };
struct Gemm { const char* A; const char* B; int lda, ldb, K; long tstepA, tstepB, hstepB; };

struct StaticOrder {
    int nM, nN, nwg, G, c;
    __host__ __device__ void init(int nM_, int nN_, int G_, int c_) { nM = nM_; nN = nN_; nwg = nM * nN; G = G_; c = c_; }
    __host__ __device__ bool next(int i, Unit& u) const {
        const long L = (long)i * G + c; if (L >= nwg) return false;
        int wgid = (int)L; { const int q = nwg / NXCD, r = nwg % NXCD, xcd = wgid % NXCD, off = wgid / NXCD; wgid = (xcd < r ? xcd * (q + 1) : r * (q + 1) + (xcd - r) * q) + off; }
        const int nig = WGM * nN, gid = wgid / nig, fm = gid * WGM, gsz = (nM - fm) < WGM ? (nM - fm) : WGM;
        u.pm = fm + ((wgid % nig) % gsz); u.pn = (wgid % nig) / gsz; return true;
    }
};

__device__ __forceinline__ unsigned cvt_pk_bf16(float lo, float hi) { unsigned r; asm volatile("v_cvt_pk_bf16_f32 %0, %1, %2" : "=v"(r) : "v"(lo), "v"(hi)); return r; }

struct EpiQKV {
    static constexpr bool PERM = true;
    bf16_t* O; size_t split_stride; float scale0;
    __device__ __forceinline__ void operator()(const f32x4 (&acc)[2][2][4][2], const Unit& u, int wr, int wc, int fr, int fq) const {
        asm volatile("" : "+v"(fr), "+v"(fq));
        const int row0 = u.pm * BM + wr * 64 + fr; int colt = u.pn * BM;
        const int t = colt / DM; bf16_t* base = O + (size_t)t * split_stride; colt -= t * DM; const float sc = (t == 0) ? scale0 : 1.f;
        const int col0 = colt + wc * 32 + 8 * fq;
#pragma unroll
        for (int ai = 0; ai < 2; ++ai)
#pragma unroll
            for (int m = 0; m < 4; ++m) { bf16_t* rowp = base + (size_t)(row0 + ai * HALF + m * 16) * DM + col0;
#pragma unroll
                for (int bj = 0; bj < 2; ++bj) { f32x4 v0 = acc[ai][bj][m][0] * sc, v1 = acc[ai][bj][m][1] * sc;
                    u32x4 w; w.x = cvt_pk_bf16(v0[0], v0[1]); w.y = cvt_pk_bf16(v0[2], v0[3]); w.z = cvt_pk_bf16(v1[0], v1[1]); w.w = cvt_pk_bf16(v1[2], v1[3]);
                    *(u32x4*)(rowp + bj * HALF) = w; } }
        if (u.pn == 4) {
            float* kmean = (float*)((unsigned char*)O - WS_Q + WS_KMEAN) + ((size_t)((u.pm >> 5) * 4) * 32 + (u.pm & 31)) * HD;
#pragma unroll
            for (int bj = 0; bj < 2; ++bj)
#pragma unroll
                for (int n = 0; n < 2; ++n)
#pragma unroll
                    for (int j = 0; j < 4; ++j) { float cs = 0.f;
#pragma unroll
                        for (int ai = 0; ai < 2; ++ai)
#pragma unroll
                            for (int m = 0; m < 4; ++m) cs += acc[ai][bj][m][n][j];
                        cs = row_sum(cs);
                        const int col = bj * HALF + wc * 32 + 8 * fq + 4 * n + j;
                        if (fr == 0) __hip_atomic_fetch_add(kmean + (size_t)(col >> 6) * 32 * HD + (col & 63), cs, __ATOMIC_RELAXED, __HIP_MEMORY_SCOPE_AGENT); }
        }
    }
};
struct EpiResAdd {
    static constexpr bool PERM = true;
    bf16_t* xb;
    __device__ __forceinline__ void operator()(const f32x4 (&acc)[2][2][4][2], const Unit& u, int wr, int wc, int fr, int fq) const {
        asm volatile("" : "+v"(fr), "+v"(fq));
        const int col0 = u.pn * BM + wc * 32 + 8 * fq;
#pragma unroll
        for (int ai = 0; ai < 2; ++ai) { u32x4 r[4][2];
#pragma unroll
            for (int m = 0; m < 4; ++m) { const bf16_t* rowp = xb + (size_t)(u.pm * BM + ai * HALF + wr * 64 + m * 16 + fr) * DM + col0;
#pragma unroll
                for (int bj = 0; bj < 2; ++bj) r[m][bj] = *(const u32x4*)(rowp + bj * HALF); }
#pragma unroll
            for (int m = 0; m < 4; ++m) { bf16_t* rowp = xb + (size_t)(u.pm * BM + ai * HALF + wr * 64 + m * 16 + fr) * DM + col0;
#pragma unroll
                for (int bj = 0; bj < 2; ++bj) { const f32x4 v0 = acc[ai][bj][m][0], v1 = acc[ai][bj][m][1]; const u32x4 q = r[m][bj];
                    u32x4 w; w.x = cvt_pk_bf16(bflo(q.x) + v0[0], bfhi(q.x) + v0[1]); w.y = cvt_pk_bf16(bflo(q.y) + v0[2], bfhi(q.y) + v0[3]);
                    w.z = cvt_pk_bf16(bflo(q.z) + v1[0], bfhi(q.z) + v1[1]); w.w = cvt_pk_bf16(bflo(q.w) + v1[2], bfhi(q.w) + v1[3]);
                    *(u32x4*)(rowp + bj * HALF) = w; } } }
    }
};
struct EpiGateUpDense {
    static constexpr bool PERM = true;
    bf16_t* act; const float* comb;
    __device__ __forceinline__ void operator()(const f32x4 (&acc)[2][2][4][2], const Unit& u, int wr, int wc, int fr, int fq) const {
        asm volatile("" : "+v"(fr), "+v"(fq));
        const int e = u.pn >> 1, c0 = (u.pn & 1) * HALF;
        const int col0 = e * DEXP + c0 + wc * 32 + 8 * fq;
#pragma unroll
        for (int ai = 0; ai < 2; ++ai)
#pragma unroll
            for (int m = 0; m < 4; ++m) { const int row = u.pm * BM + ai * HALF + wr * 64 + m * 16 + fr;
                const float cw = comb[(size_t)row * NEXP + e];
                float o[8];
#pragma unroll
                for (int n = 0; n < 2; ++n)
#pragma unroll
                    for (int j = 0; j < 4; ++j) { const float g = acc[ai][0][m][n][j], up = acc[ai][1][m][n][j];
                        const float sg = g * __builtin_amdgcn_rcpf(1.f + __builtin_amdgcn_exp2f(-g * LOG2E));
                        o[n * 4 + j] = sg * up * cw; }
                u32x4 w; w.x = cvt_pk_bf16(o[0], o[1]); w.y = cvt_pk_bf16(o[2], o[3]); w.z = cvt_pk_bf16(o[4], o[5]); w.w = cvt_pk_bf16(o[6], o[7]);
                *(u32x4*)(act + (size_t)row * NACT + col0) = w; }
    }
};

template <class Epi, class Sched>
__device__ __forceinline__ void gemm_phase(LAS unsigned char* lds, const Gemm g, const Sched& S, const Epi& E, int wave_id) {
    int lane_l = (int)__builtin_amdgcn_mbcnt_hi(~0u, __builtin_amdgcn_mbcnt_lo(~0u, 0u)); asm volatile("" : "+v"(lane_l));
    const int wid = wave_id, lane = lane_l, tid = wid * 64 + lane, wr = wid >> 2, wc = wid & 3, fr = lane & 15, fq = lane >> 4;
    const int K = g.K, nt = K / BK;
    unsigned voffA[2], voffB[2];
#pragma unroll
    for (int i = 0; i < 2; ++i) { int R, C; stage_rc(tid * 16 + i * 8192, R, C); const int Rb = Epi::PERM ? ((R & ~31) + perm32(R & 31)) : R;
        voffA[i] = (unsigned)(R * g.lda + C) * 2u; voffB[i] = (unsigned)(Rb * g.ldb + C) * 2u; }
    const size_t kstep = (size_t)(BK * 2);
    const size_t hstepA = (size_t)HALF * g.lda * 2;
    const long hstepB = g.hstepB;
    const unsigned ldsw = (unsigned)wid * 1024u;
    const int aoff = lds_byte(wr * 64 + fr, fq * 8), boff = lds_byte(wc * 32 + fr, fq * 8);
#define PG8_SA(b, h) (((b) * 2 + (h)) * HTB)
#define PG8_SB(b, h) ((4 + (b) * 2 + (h)) * HTB)
#define PG8_STAGE(bufoff, gbase, voff) do { _Pragma("unroll") for (int _i = 0; _i < 2; ++_i) \
        __builtin_amdgcn_global_load_lds((const unsigned*)((const char*)(gbase) + (voff)[_i]), (LAS unsigned*)(lds + (bufoff) + ldsw + _i * 8192), 16, 0, 0); } while (0)
#define PG8_LDA(dst, b, h) do { _Pragma("unroll") for (int m = 0; m < 4; ++m) _Pragma("unroll") for (int k = 0; k < 2; ++k) dst[m][k] = *(const LAS bf16x8*)(lds + PG8_SA(b, h) + aoff + m * 2048 + k * 1024); } while (0)
#define PG8_LDB(dst, b, h) do { _Pragma("unroll") for (int n = 0; n < 2; ++n) _Pragma("unroll") for (int k = 0; k < 2; ++k) dst[n][k] = *(const LAS bf16x8*)(lds + PG8_SB(b, h) + boff + n * 2048 + k * 1024); } while (0)
#define PG8_MMA(ai, bj, At, Bt) do { __builtin_amdgcn_s_setprio(1); _Pragma("unroll") for (int m = 0; m < 4; ++m) _Pragma("unroll") for (int n = 0; n < 2; ++n) _Pragma("unroll") for (int k = 0; k < 2; ++k) \
        acc[ai][bj][m][n] = __builtin_amdgcn_mfma_f32_16x16x32_bf16(Bt[n][k], At[m][k], acc[ai][bj][m][n], 0, 0, 0); __builtin_amdgcn_s_setprio(0); } while (0)
#define PG8_WAIT_V(n) asm volatile("s_waitcnt vmcnt(" #n ")" ::: "memory")
#define PG8_WAIT_L(n) asm volatile("s_waitcnt lgkmcnt(" #n ")" ::: "memory")
#define PG8_BAR __builtin_amdgcn_s_barrier()
#define PG8_SCHED __builtin_amdgcn_sched_barrier(0)
    Unit cur, nxt; int ui = 0;
    if (!S.next(0, cur)) return;
    f32x4 acc[2][2][4][2];
#pragma unroll
    for (int a = 0; a < 2; ++a)
#pragma unroll
        for (int b = 0; b < 2; ++b)
#pragma unroll
            for (int m = 0; m < 4; ++m)
#pragma unroll
                for (int n = 0; n < 2; ++n) acc[a][b][m][n] = (f32x4){0.f, 0.f, 0.f, 0.f};
    bf16x8 At[4][2], B0[2][2], B1[2][2];
    const char* cA = g.A + (size_t)cur.pm * g.tstepA; const char* cB = g.B + (size_t)cur.pn * g.tstepB;
    PG8_STAGE(PG8_SB(0, 0), cB, voffB); PG8_STAGE(PG8_SB(0, 1), cB + hstepB, voffB); PG8_STAGE(PG8_SA(0, 0), cA, voffA); PG8_STAGE(PG8_SA(0, 1), cA + hstepA, voffA);
    if (wr == 1) PG8_BAR;
    PG8_WAIT_V(2); PG8_BAR;
    PG8_STAGE(PG8_SB(1, 0), cB + kstep, voffB); PG8_STAGE(PG8_SA(1, 0), cA + kstep, voffA); PG8_STAGE(PG8_SB(1, 1), cB + hstepB + kstep, voffB);
    PG8_WAIT_V(6); PG8_BAR;
    for (;;) {
        const bool has_next = S.next(ui + 1, nxt);
        const char* nA = has_next ? g.A + (size_t)nxt.pm * g.tstepA : cA; const char* nB = has_next ? g.B + (size_t)nxt.pn * g.tstepB : cB;
        for (int t = 0; t < nt; t += 2) {
            const bool last = (t == nt - 2);
            const char* a1 = cA + (size_t)(t + 1) * kstep;
            const char* a2 = last ? nA : cA + (size_t)(t + 2) * kstep; const char* b2 = last ? nB : cB + (size_t)(t + 2) * kstep;
            const char* a3 = a2 + kstep; const char* b3 = b2 + kstep;
            PG8_LDB(B0, 0, 0); PG8_LDB(B1, 0, 1); PG8_SCHED; PG8_LDA(At, 0, 0); PG8_STAGE(PG8_SA(1, 1), a1 + hstepA, voffA);
            PG8_WAIT_V(8); PG8_WAIT_L(0); PG8_BAR; PG8_MMA(0, 0, At, B0); PG8_MMA(0, 1, At, B1); PG8_BAR; PG8_SCHED;
            PG8_LDA(At, 0, 1); PG8_STAGE(PG8_SB(0, 0), b2, voffB); PG8_STAGE(PG8_SB(0, 1), b2 + hstepB, voffB); PG8_STAGE(PG8_SA(0, 0), a2, voffA);
            PG8_WAIT_V(8); PG8_WAIT_L(0); PG8_BAR; PG8_MMA(1, 0, At, B0); PG8_MMA(1, 1, At, B1); PG8_BAR; PG8_SCHED;
            PG8_LDB(B0, 1, 0); PG8_LDB(B1, 1, 1); PG8_SCHED; PG8_LDA(At, 1, 0); PG8_STAGE(PG8_SA(0, 1), a2 + hstepA, voffA);
            PG8_WAIT_V(8); PG8_WAIT_L(0); PG8_BAR; PG8_MMA(0, 0, At, B0); PG8_MMA(0, 1, At, B1); PG8_BAR; PG8_SCHED;
            PG8_LDA(At, 1, 1); PG8_STAGE(PG8_SB(1, 0), b3, voffB); PG8_STAGE(PG8_SB(1, 1), b3 + hstepB, voffB); PG8_STAGE(PG8_SA(1, 0), a3, voffA);
            PG8_WAIT_V(8); PG8_WAIT_L(0); PG8_BAR; PG8_MMA(1, 0, At, B0); PG8_MMA(1, 1, At, B1); PG8_BAR; PG8_SCHED;
        }
        if (wr == 0) PG8_BAR;
        E(acc, cur, wr, wc, fr, fq);
        if (!has_next) break;
#pragma unroll
        for (int a = 0; a < 2; ++a)
#pragma unroll
            for (int b = 0; b < 2; ++b)
#pragma unroll
                for (int m = 0; m < 4; ++m)
#pragma unroll
                    for (int n = 0; n < 2; ++n) acc[a][b][m][n] = (f32x4){0.f, 0.f, 0.f, 0.f};
        cur = nxt; cA = nA; cB = nB; ++ui;
        if (wr == 1) PG8_BAR;
    }
    PG8_WAIT_V(0);
    PG8_BAR;
#undef PG8_SA
#undef PG8_SB
#undef PG8_STAGE
#undef PG8_LDA
#undef PG8_LDB
#undef PG8_MMA
#undef PG8_WAIT_V
#undef PG8_WAIT_L
#undef PG8_BAR
#undef PG8_SCHED
}
template <class Epi, class Prob>
__device__ __forceinline__ void gemm_phase_x(LAS unsigned char* lds, const Prob& P, const Epi& E, int wave_id) {
    int lane_l = (int)__builtin_amdgcn_mbcnt_hi(~0u, __builtin_amdgcn_mbcnt_lo(~0u, 0u)); asm volatile("" : "+v"(lane_l));
    const int wid = wave_id, lane = lane_l, tid = wid * 64 + lane, wr = wid >> 2, wc = wid & 3, fr = lane & 15, fq = lane >> 4;
    const int K = P.K, nt = K / BK;
    unsigned voffB[2];
#pragma unroll
    for (int i = 0; i < 2; ++i) { int R, C; stage_rc(tid * 16 + i * 8192, R, C); const int Rb = Epi::PERM ? ((R & ~31) + perm32(R & 31)) : R; voffB[i] = (unsigned)(Rb * P.ldb + C) * 2u; }
    const size_t kstep = (size_t)(BK * 2);
    const long hstepB = P.hstepB;
    const unsigned ldsw = (unsigned)wid * 1024u;
    const int aoff = lds_byte(wr * 64 + fr, fq * 8), boff = lds_byte(wc * 32 + fr, fq * 8);
    LAS u32x4* stash = (LAS u32x4*)(lds + STAGE_BYTES + 1024) + tid;
#define PG8_SA(b, h) (((b) * 2 + (h)) * HTB)
#define PG8_SB(b, h) ((4 + (b) * 2 + (h)) * HTB)
#define PG8_STAGE(bufoff, gbase, voff) do { _Pragma("unroll") for (int _i = 0; _i < 2; ++_i) \
        __builtin_amdgcn_global_load_lds((const unsigned*)((const char*)(gbase) + (voff)[_i]), (LAS unsigned*)(lds + (bufoff) + ldsw + _i * 8192), 16, 0, 0); } while (0)
#define PG8_LDA(dst, b, h) do { _Pragma("unroll") for (int m = 0; m < 4; ++m) _Pragma("unroll") for (int k = 0; k < 2; ++k) dst[m][k] = *(const LAS bf16x8*)(lds + PG8_SA(b, h) + aoff + m * 2048 + k * 1024); } while (0)
#define PG8_LDB(dst, b, h) do { _Pragma("unroll") for (int n = 0; n < 2; ++n) _Pragma("unroll") for (int k = 0; k < 2; ++k) dst[n][k] = *(const LAS bf16x8*)(lds + PG8_SB(b, h) + boff + n * 2048 + k * 1024); } while (0)
#define PG8_MMA(ai, bj, At, Bt) do { __builtin_amdgcn_s_setprio(1); _Pragma("unroll") for (int m = 0; m < 4; ++m) _Pragma("unroll") for (int n = 0; n < 2; ++n) _Pragma("unroll") for (int k = 0; k < 2; ++k) \
        acc[ai][bj][m][n] = __builtin_amdgcn_mfma_f32_16x16x32_bf16(Bt[n][k], At[m][k], acc[ai][bj][m][n], 0, 0, 0); __builtin_amdgcn_s_setprio(0); } while (0)
#define PG8_WAIT_V(n) asm volatile("s_waitcnt vmcnt(" #n ")" ::: "memory")
#define PG8_WAIT_L(n) asm volatile("s_waitcnt lgkmcnt(" #n ")" ::: "memory")
#define PG8_BAR __builtin_amdgcn_s_barrier()
#define PG8_SCHED __builtin_amdgcn_sched_barrier(0)
#define PG8_AVOFF(dst, u) do { int t2_ = tid; asm volatile("" : "+v"(t2_)); _Pragma("unroll") for (int i_ = 0; i_ < 2; ++i_) { int R_, C_; stage_rc(t2_ * 16 + i_ * 8192, R_, C_); _Pragma("unroll") for (int h_ = 0; h_ < 2; ++h_) \
        dst[h_][i_] = (Prob::GATHER ? P.arow_off(u, h_, R_) : (unsigned)((h_ * HALF + R_) * P.lda) * 2u) + (unsigned)C_ * 2u; } } while (0)
    Unit cur, nxt; int ui = 0;
    if (!P.next(0, cur)) return;
    unsigned vA[2][2];
    PG8_AVOFF(vA, cur);
    f32x4 acc[2][2][4][2];
#pragma unroll
    for (int a = 0; a < 2; ++a)
#pragma unroll
        for (int b = 0; b < 2; ++b)
#pragma unroll
            for (int m = 0; m < 4; ++m)
#pragma unroll
                for (int n = 0; n < 2; ++n) acc[a][b][m][n] = (f32x4){0.f, 0.f, 0.f, 0.f};
    bf16x8 At[4][2], B0[2][2], B1[2][2];
    const char* cA = P.a_base(cur); const char* cB = P.b_base(cur);
    long csplit = Prob::KSPLIT ? P.bsplit(cur) : 0;
    if (Prob::WAITS) P.a_ready(cur, wid);
    PG8_STAGE(PG8_SB(0, 0), cB, voffB); PG8_STAGE(PG8_SB(0, 1), cB + hstepB, voffB); PG8_STAGE(PG8_SA(0, 0), cA, vA[0]); PG8_STAGE(PG8_SA(0, 1), cA, vA[1]);
    if (wr == 1) PG8_BAR;
    PG8_WAIT_V(2); PG8_BAR;
    PG8_STAGE(PG8_SB(1, 0), cB + kstep, voffB); PG8_STAGE(PG8_SA(1, 0), cA + kstep, vA[0]); PG8_STAGE(PG8_SB(1, 1), cB + hstepB + kstep, voffB);
    PG8_WAIT_V(6); PG8_BAR;
    for (;;) {
        const bool has_next = P.next(ui + 1, nxt);
        const char* nA = has_next ? P.a_base(nxt) : cA; const char* nB = has_next ? P.b_base(nxt) : cB;
        if (Prob::GATHER) { unsigned vN[2][2];
            if (has_next) { PG8_AVOFF(vN, nxt); } else { vN[0][0] = vA[0][0]; vN[0][1] = vA[0][1]; vN[1][0] = vA[1][0]; vN[1][1] = vA[1][1]; }
            *stash = (u32x4){vN[0][0], vN[0][1], vN[1][0], vN[1][1]}; }
        for (int t = 0; t < nt; t += 2) {
            const bool last = (t == nt - 2);
            if (Prob::WAITS && last && has_next) P.a_ready(nxt, wid);
            const char* a1 = cA + (size_t)(t + 1) * kstep;
            const char* a2 = last ? nA : cA + (size_t)(t + 2) * kstep;
            const char* b2 = last ? nB : cB + (size_t)(t + 2) * kstep + ((Prob::KSPLIT && (t + 2) >= (nt >> 1)) ? csplit : 0);
            const char* a3 = a2 + kstep; const char* b3 = b2 + kstep;
            PG8_LDB(B0, 0, 0); PG8_LDB(B1, 0, 1); PG8_SCHED; PG8_LDA(At, 0, 0); PG8_STAGE(PG8_SA(1, 1), a1, vA[1]);
            if (Prob::GATHER && last) { const u32x4 sv = *stash; vA[0][0] = sv.x; vA[0][1] = sv.y; vA[1][0] = sv.z; vA[1][1] = sv.w; }
            PG8_WAIT_V(8); PG8_WAIT_L(0); PG8_BAR; PG8_MMA(0, 0, At, B0); PG8_MMA(0, 1, At, B1); PG8_BAR; PG8_SCHED;
            PG8_LDA(At, 0, 1); PG8_STAGE(PG8_SB(0, 0), b2, voffB); PG8_STAGE(PG8_SB(0, 1), b2 + hstepB, voffB); PG8_STAGE(PG8_SA(0, 0), a2, vA[0]);
            PG8_WAIT_V(8); PG8_WAIT_L(0); PG8_BAR; PG8_MMA(1, 0, At, B0); PG8_MMA(1, 1, At, B1); PG8_BAR; PG8_SCHED;
            PG8_LDB(B0, 1, 0); PG8_LDB(B1, 1, 1); PG8_SCHED; PG8_LDA(At, 1, 0); PG8_STAGE(PG8_SA(0, 1), a2, vA[1]);
            PG8_WAIT_V(8); PG8_WAIT_L(0); PG8_BAR; PG8_MMA(0, 0, At, B0); PG8_MMA(0, 1, At, B1); PG8_BAR; PG8_SCHED;
            PG8_LDA(At, 1, 1); PG8_STAGE(PG8_SB(1, 0), b3, voffB); PG8_STAGE(PG8_SB(1, 1), b3 + hstepB, voffB); PG8_STAGE(PG8_SA(1, 0), a3, vA[0]);
            PG8_WAIT_V(8); PG8_WAIT_L(0); PG8_BAR; PG8_MMA(1, 0, At, B0); PG8_MMA(1, 1, At, B1); PG8_BAR; PG8_SCHED;
        }
        if (wr == 0) PG8_BAR;
        E(acc, cur, wr, wc, fr, fq);
        if (!has_next) break;
#pragma unroll
        for (int a = 0; a < 2; ++a)
#pragma unroll
            for (int b = 0; b < 2; ++b)
#pragma unroll
                for (int m = 0; m < 4; ++m)
#pragma unroll
                    for (int n = 0; n < 2; ++n) acc[a][b][m][n] = (f32x4){0.f, 0.f, 0.f, 0.f};
        cur = nxt; cA = nA; cB = nB; ++ui;
        if (Prob::KSPLIT) csplit = P.bsplit(cur);
        if (wr == 1) PG8_BAR;
    }
    PG8_WAIT_V(0);
    PG8_BAR;
#undef PG8_SA
#undef PG8_SB
#undef PG8_STAGE
#undef PG8_LDA
#undef PG8_LDB
#undef PG8_MMA
#undef PG8_WAIT_V
#undef PG8_WAIT_L
#undef PG8_BAR
#undef PG8_SCHED
#undef PG8_AVOFF
}

__device__ __forceinline__ int pair_a(int pi) { return pi < 3 ? 0 : (pi < 5 ? 1 : 2); }
__device__ __forceinline__ int pair_b(int pi) { return pi == 0 ? 1 : ((pi == 1 || pi == 3) ? 2 : 3); }
template <int MODE>
struct MoeProb {
    static constexpr bool GATHER = (MODE == 0), KSPLIT = (MODE == 1);
    const unsigned* cnt; const unsigned* list; const char* A; const char* B; int lda, ldb, K; long hstepB; int G, c; unsigned* tcnt;
    static constexpr bool WAITS = (MODE == 1);
    __device__ __forceinline__ void a_ready(const Unit& u, int wave) const {
        if (MODE == 1) {
            if (wave == 0) { unsigned polls = 0;
                while ((unsigned)__builtin_amdgcn_readfirstlane(__hip_atomic_load(tcnt + 64 * u.pm, __ATOMIC_RELAXED, __HIP_MEMORY_SCOPE_AGENT)) < 32u) {
                    if (++polls > (1u << 20)) break;
                    __builtin_amdgcn_s_sleep(2); }
                __builtin_amdgcn_fence(__ATOMIC_ACQUIRE, "agent");
                asm volatile("s_waitcnt vmcnt(0)" ::: "memory"); }
            asm volatile("" ::: "memory"); __builtin_amdgcn_s_barrier(); asm volatile("" ::: "memory");
        }
    }
    __device__ __forceinline__ bool next(int i, Unit& u) const {
        long L = (long)i * G + c;
        if (MODE == 1) {
            int tot = 0;
            for (int k = 0; k < 24; ++k) tot += ((int)cnt[k] + 255) >> 8;
            const int N = 4 * tot, R = N - 2 * G;
            if (R > 0 && R < G) { if (c < R) { if (i > 0) return false; L = c; } else L = (i == 0) ? c : (long)G + (c - R) + (long)(i - 1) * (G - R); }
            else L = (long)i * G + (G - 1 - c);
        }
        const int tileidx = (int)(L >> 2);
        int accu = 0, bk = -1, tib = 0, nb = 0;
        for (int k = 0; k < 24; ++k) { const int n = (int)cnt[k]; const int tl = (n + 255) >> 8; if (bk < 0 && tileidx < accu + tl) { bk = k; tib = tileidx - accu; nb = n; } accu += tl; }
        if (bk < 0) return false;
        u.pm = tileidx; u.pn = (int)(L & 3); u.meta = bk | (tib << 5) | (nb << 13); return true;
    }
    __device__ __forceinline__ int expert(const Unit& u, int s) const { const int g = u.bk() / 6, pi = u.bk() % 6; return g * 4 + (s ? pair_b(pi) : pair_a(pi)); }
    __device__ __forceinline__ const char* a_base(const Unit& u) const { return MODE == 0 ? A : A + (size_t)u.pm * 256 * lda * 2; }
    __device__ __forceinline__ const char* b_base(const Unit& u) const {
        if (MODE == 0) return B + ((size_t)expert(u, u.pn >> 1) * DEXP + (size_t)(u.pn & 1) * HALF) * ldb * 2;
        return B + (size_t)u.pn * 256 * ldb * 2 + (size_t)expert(u, 0) * DEXP * 2;
    }
    __device__ __forceinline__ unsigned arow_off(const Unit& u, int h, int R) const { const int pos = u.tib() * 256 + h * HALF + R; const unsigned tok = pos < u.nb() ? list[(size_t)u.bk() * T + pos] : 0u; return tok * (unsigned)(lda * 2); }
    __device__ __forceinline__ long bsplit(const Unit& u) const { return ((long)(expert(u, 1) - expert(u, 0)) * DEXP - DEXP) * 2; }
};
struct EpiGateUpSparse {
    static constexpr bool PERM = true;
    bf16_t* act; const float* wlist; unsigned* tcnt;
    __device__ __forceinline__ void operator()(const f32x4 (&acc)[2][2][4][2], const Unit& u, int wr, int wc, int fr, int fq) const {
        asm volatile("" : "+v"(fr), "+v"(fq));
        const int s = u.pn >> 1, col0 = s * DEXP + (u.pn & 1) * HALF + wc * 32 + 8 * fq;
        const __amdgpu_buffer_rsrc_t rs_act = __builtin_amdgcn_make_buffer_rsrc((void*)act, (short)0, 0x7fffffff, 0x00020000);
#pragma unroll
        for (int ai = 0; ai < 2; ++ai)
#pragma unroll
            for (int m = 0; m < 4; ++m) { const int r = ai * HALF + wr * 64 + m * 16 + fr, pos = u.tib() * 256 + r;
                const float cw = pos < u.nb() ? wlist[((size_t)u.bk() * T + pos) * 2 + s] : 0.f;
                float o[8];
#pragma unroll
                for (int n = 0; n < 2; ++n)
#pragma unroll
                    for (int j = 0; j < 4; ++j) { const float g = acc[ai][0][m][n][j], up = acc[ai][1][m][n][j];
                        const float sg = g * __builtin_amdgcn_rcpf(1.f + __builtin_amdgcn_exp2f(-g * LOG2E));
                        o[n * 4 + j] = sg * up * cw; }
                u32x4 w; w.x = cvt_pk_bf16(o[0], o[1]); w.y = cvt_pk_bf16(o[2], o[3]); w.z = cvt_pk_bf16(o[4], o[5]); w.w = cvt_pk_bf16(o[6], o[7]);
                __builtin_amdgcn_raw_buffer_store_b128(w, rs_act, (int)((((unsigned)u.pm * 256u + (unsigned)r) * 512u + (unsigned)col0) * 2u), 0, 16);
                if (m & 1) asm volatile("" ::: "memory"); }
        asm volatile("s_waitcnt vmcnt(0)" ::: "memory");
        if ((fr | fq) == 0) __hip_atomic_fetch_add(tcnt + 64 * u.pm, 1u, __ATOMIC_RELAXED, __HIP_MEMORY_SCOPE_AGENT);
    }
};
struct EpiDownScatter {
    static constexpr bool PERM = true;
    bf16_t* xb; const unsigned* list;
    __device__ __forceinline__ void operator()(const f32x4 (&acc)[2][2][4][2], const Unit& u, int wr, int wc, int fr, int fq) const {
        asm volatile("" : "+v"(fr), "+v"(fq));
        const int col0 = u.pn * BM + wc * 32 + 8 * fq;
        unsigned tok[8];
#pragma unroll
        for (int g = 0; g < 8; ++g) { const int pos = u.tib() * 256 + (g >> 2) * HALF + wr * 64 + (g & 3) * 16 + fr; tok[g] = pos < u.nb() ? list[(size_t)u.bk() * T + pos] : 0xffffffffu; }
#pragma unroll
        for (int ai = 0; ai < 2; ++ai) { u32x4 r[4][2];
#pragma unroll
            for (int m = 0; m < 4; ++m) { const unsigned tk = tok[ai * 4 + m]; const bf16_t* rowp = xb + (size_t)(tk != 0xffffffffu ? tk : 0u) * DM + col0;
#pragma unroll
                for (int bj = 0; bj < 2; ++bj) r[m][bj] = *(const u32x4*)(rowp + bj * HALF); }
#pragma unroll
            for (int m = 0; m < 4; ++m) { const unsigned tk = tok[ai * 4 + m];
                if (tk != 0xffffffffu) { bf16_t* rowp = xb + (size_t)tk * DM + col0;
#pragma unroll
                    for (int bj = 0; bj < 2; ++bj) { const f32x4 v0 = acc[ai][bj][m][0], v1 = acc[ai][bj][m][1]; const u32x4 q = r[m][bj];
                        u32x4 w; w.x = cvt_pk_bf16(bflo(q.x) + v0[0], bfhi(q.x) + v0[1]); w.y = cvt_pk_bf16(bflo(q.y) + v0[2], bfhi(q.y) + v0[3]);
                        w.z = cvt_pk_bf16(bflo(q.z) + v1[0], bfhi(q.z) + v1[1]); w.w = cvt_pk_bf16(bflo(q.w) + v1[2], bfhi(q.w) + v1[3]);
                        *(u32x4*)(rowp + bj * HALF) = w; } } } }
    }
};
}

#define XB_TMO      128
#define XB_XCNT(j)  (256  + 64 * (j))
#define XB_XSUB(j)  (1280 + 64 * (j))
#define XB_XGEN(j)  (2304 + 64 * (j))
#define XB_TOP      3328
#define XB_TOPGEN   3392
#define XCD_BAR_WORDS 3456
#define XB_SPIN_CAP (1u << 18)
__device__ __forceinline__ unsigned xb_ld(unsigned* p)              { return __hip_atomic_load(p, __ATOMIC_RELAXED, __HIP_MEMORY_SCOPE_AGENT); }
__device__ __forceinline__ unsigned xb_add(unsigned* p, unsigned v) { return __hip_atomic_fetch_add(p, v, __ATOMIC_RELAXED, __HIP_MEMORY_SCOPE_AGENT); }
__device__ __forceinline__ unsigned xb_xcc_id() { return (unsigned)__builtin_amdgcn_s_getreg((3 << 11) | 20) & 0xFu; }
#define XB_SPIN(cond, bar) do { unsigned _sp = 0; while (cond) { __builtin_amdgcn_s_sleep(1); \
    if ((++_sp & 255u) == 0u) { if (xb_ld(&(bar)[XB_TMO])) break; if (_sp > XB_SPIN_CAP) { atomicAdd(&(bar)[XB_TMO], 1u); break; } } } } while (0)
struct XcdBarrier { unsigned* bar; unsigned x; volatile LAS unsigned* st; int wave; };
__device__ __forceinline__ bool xb_thread0(int wave) { return wave == 0 && __builtin_amdgcn_mbcnt_hi(~0u, __builtin_amdgcn_mbcnt_lo(~0u, 0u)) == 0u; }
__device__ __forceinline__ XcdBarrier xcd_barrier_post(unsigned* bar, volatile LAS unsigned* st, int wave) {
    XcdBarrier b; b.bar = bar; b.x = xb_xcc_id(); b.st = st; b.wave = wave;
    if (xb_thread0(wave)) (void)xb_add(&bar[XB_XCNT(b.x)], 1u);
    return b;
}
__device__ __forceinline__ void xcd_barrier_complete(unsigned* bar, unsigned x, unsigned& nloc, unsigned& nx) {
    const unsigned G = gridDim.x * gridDim.y * gridDim.z;
    unsigned sum, cnt, mine, sp = 0u;
    for (;;) {
        sum = 0u; cnt = 0u; mine = 0u;
#pragma unroll
        for (unsigned j = 0; j < 16; ++j) { const unsigned c = xb_ld(&bar[XB_XCNT(j)]); sum += c; cnt += (c > 0u) ? 1u : 0u; mine = (j == x) ? c : mine; }
        if (sum == G) break;
        __builtin_amdgcn_s_sleep(1);
        if ((++sp & 255u) == 0u) { if (xb_ld(&bar[XB_TMO])) break; if (sp > XB_SPIN_CAP) { atomicAdd(&bar[XB_TMO], 1u); break; } }
    }
    nloc = mine > 0u ? mine : 1u; nx = cnt > 0u ? cnt : 1u;
}
__device__ __forceinline__ void xcd_barrier(const XcdBarrier& b) {
    asm volatile("s_waitcnt vmcnt(0)" ::: "memory");
    __syncthreads();
    if (xb_thread0(b.wave)) {
        unsigned* bar = b.bar;
        __builtin_amdgcn_s_waitcnt(0);
        unsigned nloc = b.st[0], nx = b.st[1];
        if (nloc == 0u) { xcd_barrier_complete(bar, b.x, nloc, nx); b.st[0] = nloc; b.st[1] = nx; }
        const unsigned old = xb_add(&bar[XB_XSUB(b.x)], 1u);
        const unsigned gen = old / nloc;
        if (old + 1u == (gen + 1u) * nloc) {
            __builtin_amdgcn_fence(__ATOMIC_RELEASE, "agent");
            asm volatile("s_waitcnt vmcnt(0)" ::: "memory");
            const unsigned og = xb_add(&bar[XB_TOP], 1u);
            const unsigned tg = og / nx;
            if (og + 1u == (tg + 1u) * nx) xb_add(&bar[XB_TOPGEN], 1u);
            else XB_SPIN(xb_ld(&bar[XB_TOPGEN]) == tg, bar);
            __builtin_amdgcn_fence(__ATOMIC_ACQUIRE, "agent");
            xb_add(&bar[XB_XGEN(b.x)], 1u);
            asm volatile("s_waitcnt vmcnt(0)" ::: "memory");
        } else {
            XB_SPIN(xb_ld(&bar[XB_XGEN(b.x)]) == gen, bar);
            __builtin_amdgcn_fence(__ATOMIC_ACQUIRE, "agent");
            asm volatile("s_waitcnt vmcnt(0)" ::: "memory");
        }
    }
    __syncthreads();
}

struct Args {
    const float* x; const float* ln1_g; const float* w_in; const float* mix_g; const float* w_out; const float* ln2_g;
    const float* w_gr; const float* b_gr; const float* w_er; const float* b_er; const float* w_gate; const float* w_up; const float* w_down; const float* fin_g;
    float* out; unsigned char* ws; int ph_lo, ph_hi, li, pad;
};

__device__ __forceinline__ void transpose_item(const float* W, int K, int N, bf16_t* WT, int dpitch, int dcol, LAS float* scr, int item, int lane) {
    const int nblk = N / 32, kb = item / nblk, nb = item % nblk, k0 = 64 * kb, n0 = 32 * nb;
#pragma unroll 8
    for (int i = 0; i < 32; ++i) { const int kk = 2 * i + (lane >> 5); scr[kk * 33 + (lane & 31)] = W[(size_t)(k0 + kk) * N + n0 + (lane & 31)]; }
    LDS_WAIT(); asm volatile("" ::: "memory");
    const int c = lane & 7;
#pragma unroll
    for (int j = 0; j < 4; ++j) { const int n = (lane >> 3) + 8 * j; const LAS float* s = scr + (8 * c) * 33 + n;
        u32x4 o; o.x = pk2(s[0 * 33], s[1 * 33]); o.y = pk2(s[2 * 33], s[3 * 33]); o.z = pk2(s[4 * 33], s[5 * 33]); o.w = pk2(s[6 * 33], s[7 * 33]);
        *(u32x4*)(WT + (size_t)(n0 + n) * dpitch + dcol + k0 + 8 * c) = o; }
    LDS_WAIT(); asm volatile("" ::: "memory");
}
__device__ __forceinline__ void phase_prologue(const Args& a, LAS unsigned char* lds, int gw, int NGW, int wave, int lane) {
    LAS float* scr = (LAS float*)(lds + wave * 16384);
    constexpr int I_IN = (DM / 64) * (NQKV / 32);
    constexpr int I_OUT = (DM / 64) * (DM / 32);
    constexpr int I_G = (DM / 64) * (DEXP / 32);
    constexpr int I_D = (DEXP / 64) * (DM / 32);
    constexpr int N_IN = DEPTH * I_IN, N_OUT = DEPTH * I_OUT, N_G = DEPTH * NEXP * I_G, N_D = DEPTH * NEXP * I_D;
    constexpr int NITEMS = N_IN + N_OUT + 2 * N_G + N_D;
    bf16_t* WinT = (bf16_t*)(a.ws + WS_WIN); bf16_t* WoutT = (bf16_t*)(a.ws + WS_WOUT); bf16_t* WgT = (bf16_t*)(a.ws + WS_WG); bf16_t* WuT = (bf16_t*)(a.ws + WS_WU); bf16_t* WdT = (bf16_t*)(a.ws + WS_WD);
    for (int it = gw; it < NITEMS; it += NGW) {
        int r = it;
        if (r < N_IN) { const int l = r / I_IN; transpose_item(a.w_in + (size_t)l * DM * NQKV, DM, NQKV, WinT + (size_t)l * NQKV * DM, DM, 0, scr, r % I_IN, lane); continue; } r -= N_IN;
        if (r < N_OUT) { const int l = r / I_OUT; transpose_item(a.w_out + (size_t)l * DM * DM, DM, DM, WoutT + (size_t)l * DM * DM, DM, 0, scr, r % I_OUT, lane); continue; } r -= N_OUT;
        if (r < N_G) { const int le = r / I_G; transpose_item(a.w_gate + (size_t)le * DM * DEXP, DM, DEXP, WgT + (size_t)le * DEXP * DM, DM, 0, scr, r % I_G, lane); continue; } r -= N_G;
        if (r < N_G) { const int le = r / I_G; transpose_item(a.w_up + (size_t)le * DM * DEXP, DM, DEXP, WuT + (size_t)le * DEXP * DM, DM, 0, scr, r % I_G, lane); continue; } r -= N_G;
        { const int le = r / I_D, l = le / NEXP, e = le % NEXP; transpose_item(a.w_down + (size_t)le * DEXP * DM, DEXP, DM, WdT + (size_t)l * DM * NACT, NACT, e * DEXP, scr, r % I_D, lane); }
    }
}

__device__ __forceinline__ void phase_norm1(const float* x, const float* g, bf16_t* hb, int gw, int NGW, int lane, float* kmean_zero, bf16_t* xb) {
    for (int i = gw * 64 + lane; i < BATCH * 4 * 32 * HD; i += NGW * 64) kmean_zero[i] = 0.f;
    f32x4 gv[4];
#pragma unroll
    for (int j = 0; j < 4; ++j) gv[j] = *((const f32x4*)g + lane + 64 * j);
    for (int m = gw; m < T; m += NGW) {
        const f32x4* xr = (const f32x4*)(x + (size_t)m * DM) + lane;
        f32x4 v[4]; float s = 0.f;
#pragma unroll
        for (int j = 0; j < 4; ++j) { v[j] = xr[64 * j]; s += (v[j].x * v[j].x + v[j].y * v[j].y) + (v[j].z * v[j].z + v[j].w * v[j].w); }
        const float rstd = 1.0f / sqrtf(wave_sum(s) * (1.f / DM) + NORM_EPS);
        u32x2* o8 = (u32x2*)(hb + (size_t)m * DM) + lane; u32x2* x8 = (u32x2*)(xb + (size_t)m * DM) + lane;
#pragma unroll
        for (int j = 0; j < 4; ++j) { u32x2 w; w.x = pk2(v[j].x * rstd * gv[j].x, v[j].y * rstd * gv[j].y); w.y = pk2(v[j].z * rstd * gv[j].z, v[j].w * rstd * gv[j].w); o8[64 * j] = w;
            u32x2 c; c.x = pk2(v[j].x, v[j].y); c.y = pk2(v[j].z, v[j].w); x8[64 * j] = c; }
    }
}
__device__ __forceinline__ void phase_norm1_b(const bf16_t* xb, const float* g, bf16_t* hb, int gw, int NGW, int lane, float* kmean_zero) {
    for (int i = gw * 64 + lane; i < BATCH * 4 * 32 * HD; i += NGW * 64) kmean_zero[i] = 0.f;
    f32x4 gv[4];
#pragma unroll
    for (int j = 0; j < 2; ++j) { gv[2 * j] = *((const f32x4*)g + 2 * lane + 128 * j); gv[2 * j + 1] = *((const f32x4*)g + 2 * lane + 128 * j + 1); }
    for (int m = gw; m < T; m += NGW) {
        const u32x4* xr = (const u32x4*)(xb + (size_t)m * DM) + lane;
        u32x4 r[2]; float s = 0.f;
#pragma unroll
        for (int j = 0; j < 2; ++j) r[j] = xr[64 * j];
        f32x4 v[4];
#pragma unroll
        for (int j = 0; j < 2; ++j) { v[2 * j] = (f32x4){bflo(r[j].x), bfhi(r[j].x), bflo(r[j].y), bfhi(r[j].y)}; v[2 * j + 1] = (f32x4){bflo(r[j].z), bfhi(r[j].z), bflo(r[j].w), bfhi(r[j].w)}; }
#pragma unroll
        for (int j = 0; j < 4; ++j) s += (v[j].x * v[j].x + v[j].y * v[j].y) + (v[j].z * v[j].z + v[j].w * v[j].w);
        const float rstd = 1.0f / sqrtf(wave_sum(s) * (1.f / DM) + NORM_EPS);
        u32x4* o16 = (u32x4*)(hb + (size_t)m * DM) + lane;
#pragma unroll
        for (int j = 0; j < 2; ++j) { const f32x4 a = v[2 * j] * rstd * gv[2 * j], b = v[2 * j + 1] * rstd * gv[2 * j + 1];
            u32x4 w; w.x = pk2(a.x, a.y); w.y = pk2(a.z, a.w); w.z = pk2(b.x, b.y); w.w = pk2(b.z, b.w); o16[64 * j] = w; }
    }
}
__device__ __forceinline__ void unpack8(float (&f)[8], const u32x4 w) { f[0] = bflo(w.x); f[1] = bfhi(w.x); f[2] = bflo(w.y); f[3] = bfhi(w.y); f[4] = bflo(w.z); f[5] = bfhi(w.z); f[6] = bflo(w.w); f[7] = bfhi(w.w); }
struct MixRow { u32x4 a, c0, c1, c2, p0, p1, p2; float l0, l1, l2, e0, e1, e2, e3; };
__device__ __forceinline__ void mix_load(MixRow& r, int m, const bf16_t* ob, const bf16_t* hb, const float* lse, const bf16_t* pm, const float* lsem0, const float* lsem1, int lane, int hh) {
    r.a = *((const u32x4*)(ob + (size_t)m * DM) + lane); r.c0 = *((const u32x4*)(ob + (size_t)m * DM + 512) + lane);
    r.c1 = *((const u32x4*)(hb + (size_t)m * DM) + lane); r.c2 = *((const u32x4*)(hb + (size_t)m * DM + 512) + lane);
    r.l0 = lse[(size_t)m * 8 + hh]; r.l1 = lse[(size_t)T * 8 + (size_t)m * 8 + hh]; r.l2 = lse[(size_t)2 * T * 8 + (size_t)m * 8 + hh];
    if (lane < 32) {
        r.p0 = *((const u32x4*)(pm + (size_t)m * 256) + lane); r.p1 = *((const u32x4*)(pm + ((size_t)T + m) * 256) + lane); r.p2 = *((const u32x4*)(pm + ((size_t)2 * T + m) * 256) + lane);
        r.e0 = lsem0[(size_t)m * 4 + hh]; r.e1 = lsem0[(size_t)T * 4 + (size_t)m * 4 + hh]; r.e2 = lsem1[(size_t)m * 4 + hh]; r.e3 = lsem1[(size_t)T * 4 + (size_t)m * 4 + hh]; }
}
__device__ __forceinline__ void phase_mixnorm(const bf16_t* ob, bf16_t* hb, const float* lse, const bf16_t* pm, const float* lsem0, const float* lsem1, const float* g, int gw, int NGW, int lane) {
    float g0[8], g1[8];
#pragma unroll
    for (int j = 0; j < 8; ++j) { g0[j] = g[8 * lane + j]; g1[j] = g[512 + 8 * lane + j]; }
    const int hh = lane >> 3;
    MixRow cur, nxt;
    if (gw < T) mix_load(cur, gw, ob, hb, lse, pm, lsem0, lsem1, lane, hh);
    for (int m = gw; m < T; m += NGW) {
        if (m + NGW < T) mix_load(nxt, m + NGW, ob, hb, lse, pm, lsem0, lsem1, lane, hh);
        float va[8]; unpack8(va, cur.a);
        if (lane < 32) {
            const float mx = fmaxf(fmaxf(cur.e0, cur.e1), fmaxf(cur.e2, cur.e3));
            float u0 = __builtin_amdgcn_exp2f(cur.e0 - mx), u1 = __builtin_amdgcn_exp2f(cur.e1 - mx), u2 = __builtin_amdgcn_exp2f(cur.e2 - mx), u3 = __builtin_amdgcn_exp2f(cur.e3 - mx);
            const float inv = 1.0f / ((u0 + u1) + (u2 + u3)); u0 *= inv; u1 *= inv; u2 *= inv; u3 *= inv;
            float y0[8], y1[8], y2[8]; unpack8(y0, cur.p0); unpack8(y1, cur.p1); unpack8(y2, cur.p2);
#pragma unroll
            for (int j = 0; j < 8; ++j) va[j] = (u0 * y0[j] + u1 * y1[j]) + (u2 * y2[j] + u3 * va[j]);
        }
        const float mx = fmaxf(cur.l0, fmaxf(cur.l1, cur.l2));
        float w0 = __builtin_amdgcn_exp2f(cur.l0 - mx), w1 = __builtin_amdgcn_exp2f(cur.l1 - mx), w2 = __builtin_amdgcn_exp2f(cur.l2 - mx);
        const float inv = 1.0f / (w0 + w1 + w2); w0 *= inv; w1 *= inv; w2 *= inv;
        float x0[8], x1[8], x2[8]; unpack8(x0, cur.c0); unpack8(x1, cur.c1); unpack8(x2, cur.c2);
        float vc[8];
        float sa = 0.f, sc = 0.f;
#pragma unroll
        for (int j = 0; j < 8; ++j) { vc[j] = w0 * x0[j] + w1 * x1[j] + w2 * x2[j]; sa += va[j] * va[j]; sc += vc[j] * vc[j]; }
        sa = half_sum(sa); sc = wave_sum(sc);
        const float ra = 1.0f / sqrtf(sa * (1.f / 256.f) + NORM_EPS), rc = 1.0f / sqrtf(sc * (1.f / 512.f) + NORM_EPS);
        u32x4 oa, oc;
        oa.x = pk2(va[0] * ra * g0[0], va[1] * ra * g0[1]); oa.y = pk2(va[2] * ra * g0[2], va[3] * ra * g0[3]); oa.z = pk2(va[4] * ra * g0[4], va[5] * ra * g0[5]); oa.w = pk2(va[6] * ra * g0[6], va[7] * ra * g0[7]);
        oc.x = pk2(vc[0] * rc * g1[0], vc[1] * rc * g1[1]); oc.y = pk2(vc[2] * rc * g1[2], vc[3] * rc * g1[3]); oc.z = pk2(vc[4] * rc * g1[4], vc[5] * rc * g1[5]); oc.w = pk2(vc[6] * rc * g1[6], vc[7] * rc * g1[7]);
        *((u32x4*)(hb + (size_t)m * DM) + lane) = oa; *((u32x4*)(hb + (size_t)m * DM + 512) + lane) = oc;
        cur = nxt;
    }
}
__device__ __forceinline__ void phase_route(const bf16_t* x, const float* g, const float* wgr, const float* bgr, const float* wer, const float* ber,
                                            bf16_t* hb, unsigned* cnt, unsigned* list, float* wlist, LAS unsigned char* lds, int v, int G, int wave, int lane) {
    const int tid = wave * 64 + lane;
    LAS f32x4* wl = (LAS f32x4*)lds;
    for (int idx = tid; idx < 5 * DM; idx += NTHREADS) { const int mtx = idx >> 10, d = idx & 1023; const float* src = (mtx == 0 ? wgr : wer + (size_t)(mtx - 1) * DM * 4) + d * 4;
        wl[mtx * 1024 + (d & 3) * 256 + (d >> 2)] = *(const f32x4*)src; }
    LAS unsigned* cl = (LAS unsigned*)(lds + 81920);
    LAS u32x2* info = (LAS u32x2*)(lds + 81920 + 256);
    LAS f32x2* infw = (LAS f32x2*)(lds + 81920 + 256 + 4096);
    if (tid < 64) cl[tid] = 0u;
    __syncthreads();
    const int rpw = (T + G - 1) / G, row0 = v * rpw;
    f32x4 gv[4];
#pragma unroll
    for (int j = 0; j < 4; ++j) gv[j] = *((const f32x4*)g + lane + 64 * j);
    const f32x4 bg = *(const f32x4*)bgr;
    u32x2 nx[4];
    { const int m0 = row0 + wave; if (wave < rpw && m0 < T) { const u32x2* xr = (const u32x2*)(x + (size_t)m0 * DM) + lane;
#pragma unroll
        for (int j = 0; j < 4; ++j) nx[j] = xr[64 * j]; } }
    for (int r = wave; r < rpw; r += NWAVES) {
        const int m = row0 + r; if (m >= T) break;
        f32x4 vv[4]; float s = 0.f;
#pragma unroll
        for (int j = 0; j < 4; ++j) { vv[j] = (f32x4){bflo(nx[j].x), bfhi(nx[j].x), bflo(nx[j].y), bfhi(nx[j].y)}; s += (vv[j].x * vv[j].x + vv[j].y * vv[j].y) + (vv[j].z * vv[j].z + vv[j].w * vv[j].w); }
        if (r + NWAVES < rpw && m + NWAVES < T) { const u32x2* xr = (const u32x2*)(x + (size_t)(m + NWAVES) * DM) + lane;
#pragma unroll
            for (int j = 0; j < 4; ++j) nx[j] = xr[64 * j]; }
        const float rstd = 1.0f / sqrtf(wave_sum(s) * (1.f / DM) + NORM_EPS);
        u32x2* o8 = (u32x2*)(hb + (size_t)m * DM) + lane;
#pragma unroll
        for (int j = 0; j < 4; ++j) { vv[j] = vv[j] * rstd * gv[j]; u32x2 w; w.x = pk2(vv[j].x, vv[j].y); w.y = pk2(vv[j].z, vv[j].w); o8[64 * j] = w; }
        f32x4 gl = (f32x4){0.f, 0.f, 0.f, 0.f};
#pragma unroll
        for (int j = 0; j < 4; ++j) { LAS f32x4* wp = wl + lane + 64 * j;
            gl += wp[0] * vv[j].x; gl += wp[256] * vv[j].y; gl += wp[512] * vv[j].z; gl += wp[768] * vv[j].w; }
        gl.x = wave_sum(gl.x) + bg.x; gl.y = wave_sum(gl.y) + bg.y; gl.z = wave_sum(gl.z) + bg.z; gl.w = wave_sum(gl.w) + bg.w;
        int gi = 0; float gm = gl.x;
        if (gl.y > gm) { gm = gl.y; gi = 1; } if (gl.z > gm) { gm = gl.z; gi = 2; } if (gl.w > gm) { gm = gl.w; gi = 3; }
        const float gden = __expf(gl.x - gm) + __expf(gl.y - gm) + __expf(gl.z - gm) + __expf(gl.w - gm);
        const float gw_ = 1.0f / gden;
        gi = __builtin_amdgcn_readfirstlane(gi);
        f32x4 el = (f32x4){0.f, 0.f, 0.f, 0.f};
#pragma unroll
        for (int j = 0; j < 4; ++j) { LAS f32x4* wp = wl + (1 + gi) * 1024 + lane + 64 * j;
            el += wp[0] * vv[j].x; el += wp[256] * vv[j].y; el += wp[512] * vv[j].z; el += wp[768] * vv[j].w; }
        const f32x4 be = *(const f32x4*)(ber + gi * 4);
        float e[4] = {wave_sum(el.x) + be.x, wave_sum(el.y) + be.y, wave_sum(el.z) + be.z, wave_sum(el.w) + be.w};
        int i1 = 0; float v1 = e[0];
#pragma unroll
        for (int k = 1; k < 4; ++k) if (e[k] > v1) { v1 = e[k]; i1 = k; }
        int i2 = -1; float v2 = -INFINITY;
#pragma unroll
        for (int k = 0; k < 4; ++k) if (k != i1 && e[k] > v2) { v2 = e[k]; i2 = k; }
        const float p2 = __expf(v2 - v1), inv = 1.0f / (1.0f + p2);
        const float w1 = inv * gw_, w2 = p2 * inv * gw_;
        const int ea = i1 < i2 ? i1 : i2, eb = i1 < i2 ? i2 : i1; const float wa = i1 < i2 ? w1 : w2, wb = i1 < i2 ? w2 : w1;
        const int pi = (ea == 0) ? (eb - 1) : (ea == 1 ? eb + 1 : 5), bk = gi * 6 + pi;
        if (lane == 0) { const unsigned rank = __hip_atomic_fetch_add(cl + bk, 1u, __ATOMIC_RELAXED, __HIP_MEMORY_SCOPE_WORKGROUP);
            info[r] = (u32x2){(unsigned)bk, rank}; infw[r] = (f32x2){wa, wb}; }
    }
    __syncthreads();
    if (tid < 24) cl[32 + tid] = __hip_atomic_fetch_add(cnt + tid, cl[tid], __ATOMIC_RELAXED, __HIP_MEMORY_SCOPE_AGENT);
    __syncthreads();
    if (tid < rpw && row0 + tid < T) { const u32x2 inf = info[tid]; const f32x2 wv = infw[tid]; const size_t slot = (size_t)inf.x * T + cl[32 + inf.x] + inf.y;
        list[slot] = (unsigned)(row0 + tid); *(f32x2*)(wlist + slot * 2) = wv; }
    __syncthreads();
}
__device__ __forceinline__ void phase_final(const bf16_t* xb, const float* g, float* out, int gw, int NGW, int lane) {
    f32x4 gv[4];
#pragma unroll
    for (int j = 0; j < 2; ++j) { gv[2 * j] = *((const f32x4*)g + 2 * lane + 128 * j); gv[2 * j + 1] = *((const f32x4*)g + 2 * lane + 128 * j + 1); }
    for (int m = gw; m < T; m += NGW) {
        const u32x4* xr = (const u32x4*)(xb + (size_t)m * DM) + lane;
        u32x4 r[2]; float s = 0.f;
#pragma unroll
        for (int j = 0; j < 2; ++j) r[j] = xr[64 * j];
        f32x4 v[4];
#pragma unroll
        for (int j = 0; j < 2; ++j) { v[2 * j] = (f32x4){bflo(r[j].x), bfhi(r[j].x), bflo(r[j].y), bfhi(r[j].y)}; v[2 * j + 1] = (f32x4){bflo(r[j].z), bfhi(r[j].z), bflo(r[j].w), bfhi(r[j].w)}; }
#pragma unroll
        for (int j = 0; j < 4; ++j) s += (v[j].x * v[j].x + v[j].y * v[j].y) + (v[j].z * v[j].z + v[j].w * v[j].w);
        const float rstd = 1.0f / sqrtf(wave_sum(s) * (1.f / DM) + NORM_EPS);
        f32x4* orow = (f32x4*)(out + (size_t)m * DM) + 2 * lane;
#pragma unroll
        for (int j = 0; j < 2; ++j) { orow[128 * j] = v[2 * j] * rstd * gv[2 * j]; orow[128 * j + 1] = v[2 * j + 1] * rstd * gv[2 * j + 1]; }
    }
}
__device__ __forceinline__ void phase_kmean(const bf16_t* kb, float* kmean, int gw, int NGW, int lane) {
    for (int it = gw; it < BATCH * 4 * 32; it += NGW) {
        const int b = it >> 7, h = (it >> 5) & 3, blk = it & 31;
        const bf16_t* base = kb + ((size_t)b * SEQ + (size_t)blk * 256) * DM + h * HD + (lane & 7) * 8;
        float acc[8] = {0.f, 0.f, 0.f, 0.f, 0.f, 0.f, 0.f, 0.f};
#pragma unroll 4
        for (int i = 0; i < 32; ++i) { const u32x4 w = *(const u32x4*)(base + (size_t)((lane >> 3) + 8 * i) * DM);
            acc[0] += bflo(w.x); acc[1] += bfhi(w.x); acc[2] += bflo(w.y); acc[3] += bfhi(w.y); acc[4] += bflo(w.z); acc[5] += bfhi(w.z); acc[6] += bflo(w.w); acc[7] += bfhi(w.w); }
#pragma unroll
        for (int j = 0; j < 8; ++j) { acc[j] += swz_xor<8>(acc[j]); acc[j] += swz_xor<16>(acc[j]); acc[j] = sum_xor32(acc[j]); }
        if (lane < 8) {
            float* o = kmean + (size_t)it * HD + lane * 8;
#pragma unroll
            for (int j = 0; j < 8; ++j) o[j] = acc[j] * (1.f / 256.f);
        }
    }
}

__device__ __forceinline__ void ld_row64(float (&r)[64], const bf16_t* p) {
#pragma unroll
    for (int c = 0; c < 8; ++c) { const u32x4 w = *((const u32x4*)p + c);
        r[8 * c + 0] = bflo(w.x); r[8 * c + 1] = bfhi(w.x); r[8 * c + 2] = bflo(w.y); r[8 * c + 3] = bfhi(w.y); r[8 * c + 4] = bflo(w.z); r[8 * c + 5] = bfhi(w.z); r[8 * c + 6] = bflo(w.w); r[8 * c + 7] = bfhi(w.w); }
}
__device__ __forceinline__ float dot_row64(const float (&q)[64], const bf16_t* p) {
    float s0 = 0.f, s1 = 0.f;
#pragma unroll
    for (int c = 0; c < 8; ++c) { const u32x4 w = *((const u32x4*)p + c);
        s0 += q[8 * c + 0] * bflo(w.x); s1 += q[8 * c + 1] * bfhi(w.x); s0 += q[8 * c + 2] * bflo(w.y); s1 += q[8 * c + 3] * bfhi(w.y);
        s0 += q[8 * c + 4] * bflo(w.z); s1 += q[8 * c + 5] * bfhi(w.z); s0 += q[8 * c + 6] * bflo(w.w); s1 += q[8 * c + 7] * bfhi(w.w); }
    return s0 + s1;
}
__device__ __forceinline__ void axpy_row64(float (&o)[64], float p, const bf16_t* vp) {
#pragma unroll
    for (int c = 0; c < 8; ++c) { const u32x4 w = *((const u32x4*)vp + c);
        o[8 * c + 0] += p * bflo(w.x); o[8 * c + 1] += p * bfhi(w.x); o[8 * c + 2] += p * bflo(w.y); o[8 * c + 3] += p * bfhi(w.y);
        o[8 * c + 4] += p * bflo(w.z); o[8 * c + 5] += p * bfhi(w.z); o[8 * c + 6] += p * bflo(w.w); o[8 * c + 7] += p * bfhi(w.w); }
}
__device__ __forceinline__ void st_row64(bf16_t* p, const float (&o)[64], float sc) {
#pragma unroll
    for (int c = 0; c < 8; ++c) { u32x4 w; w.x = pk2(o[8 * c] * sc, o[8 * c + 1] * sc); w.y = pk2(o[8 * c + 2] * sc, o[8 * c + 3] * sc); w.z = pk2(o[8 * c + 4] * sc, o[8 * c + 5] * sc); w.w = pk2(o[8 * c + 6] * sc, o[8 * c + 7] * sc); *((u32x4*)p + c) = w; }
}
#define OSM_STEP(sc, vrow) do { const float sc_ = (sc); if (sc_ > m_) { const float al = __builtin_amdgcn_exp2f(m_ - sc_); l_ *= al; _Pragma("unroll") for (int d_ = 0; d_ < 64; ++d_) o_[d_] *= al; m_ = sc_; } \
    const float p_ = __builtin_amdgcn_exp2f(sc_ - m_); l_ += p_; axpy_row64(o_, p_, (vrow)); } while (0)

__device__ __forceinline__ void naive_moba(const bf16_t* qb, const bf16_t* kb, const bf16_t* vb, const float* kmean, bf16_t* ob, int item, int tid) {
    const int b = item >> 6, h = (item >> 4) & 3, t = (item & 15) * 512 + tid, own = t >> 8;
    const size_t rowq = ((size_t)b * SEQ + t) * DM + h * HD;
    const bf16_t* kh = kb + (size_t)b * SEQ * DM + h * HD; const bf16_t* vh = vb + (size_t)b * SEQ * DM + h * HD;
    const float slope2 = exp2f(-2.0f * (float)(h + 1)) * LOG2E;
    float q_[64]; ld_row64(q_, qb + rowq);
    float bv0 = -INFINITY, bv1 = -INFINITY, bv2 = -INFINITY; int bi0 = -1, bi1 = -1, bi2 = -1;
    const float* km = kmean + (size_t)(b * 4 + h) * 32 * HD;
    for (int n = 0; n < own; ++n) {
        float gsum = 0.f;
#pragma unroll
        for (int d = 0; d < 64; ++d) gsum += q_[d] * km[n * HD + d];
        if (gsum > bv0) { bv2 = bv1; bi2 = bi1; bv1 = bv0; bi1 = bi0; bv0 = gsum; bi0 = n; }
        else if (gsum > bv1) { bv2 = bv1; bi2 = bi1; bv1 = gsum; bi1 = n; }
        else if (gsum > bv2) { bv2 = gsum; bi2 = n; }
    }
    float o_[64];
#pragma unroll
    for (int d = 0; d < 64; ++d) o_[d] = 0.f;
    float m_ = -INFINITY, l_ = 0.f;
    for (int s = 0; s < 3; ++s) {
        const int blk = (s == 0) ? bi0 : (s == 1) ? bi1 : bi2;
        if (blk < 0) continue;
        for (int j = 0; j < 256; ++j) { const int pos = blk * 256 + j;
            const float sc = dot_row64(q_, kh + (size_t)pos * DM) - slope2 * (float)(t - pos);
            OSM_STEP(sc, vh + (size_t)pos * DM); }
    }
    for (int pos = own * 256; pos <= t; ++pos) {
        const float sc = dot_row64(q_, kh + (size_t)pos * DM) - slope2 * (float)(t - pos);
        OSM_STEP(sc, vh + (size_t)pos * DM); }
    st_row64(ob + rowq, o_, 1.0f / l_);
}
__device__ __forceinline__ void naive_sb(const bf16_t* qb, const bf16_t* kb, const bf16_t* vb, bf16_t* ob, int item, int tid) {
    const int b = item >> 6, h = 4 + ((item >> 4) & 3), t = (item & 15) * 512 + tid;
    const size_t rowq = ((size_t)b * SEQ + t) * DM + h * HD;
    const bf16_t* kh = kb + (size_t)b * SEQ * DM + h * HD; const bf16_t* vh = vb + (size_t)b * SEQ * DM + h * HD;
    float q_[64]; ld_row64(q_, qb + rowq);
    float o_[64];
#pragma unroll
    for (int d = 0; d < 64; ++d) o_[d] = 0.f;
    float tail = 0.f;
    for (int s = t - 1; s >= 0 && tail > -150.f; --s) {
        const float z = dot_row64(q_, kh + (size_t)s * DM);
        const float lp = __builtin_amdgcn_logf(1.0f + __builtin_amdgcn_exp2f(-fabsf(z)));
        const float lnot = -(fmaxf(z, 0.f) + lp);
        const float aw = __builtin_amdgcn_exp2f(z + lnot + tail);
        axpy_row64(o_, aw, vh + (size_t)s * DM);
        tail += lnot;
    }
    st_row64(ob + rowq, o_, 1.0f);
}
__device__ __forceinline__ void naive_dil(const bf16_t* qb, const bf16_t* kb, const bf16_t* vb, bf16_t* ob, bf16_t* hb2, float* lse, int item, int tid) {
    const int b = item >> 7, h = 8 + ((item >> 4) & 7), t = (item & 15) * 512 + tid;
    const size_t rowq = ((size_t)b * SEQ + t) * DM + h * HD;
    const bf16_t* kh = kb + (size_t)b * SEQ * DM + h * HD; const bf16_t* vh = vb + (size_t)b * SEQ * DM + h * HD;
    const float slope2 = exp2f(-(float)(h - 8 + 1)) * LOG2E;
    float q_[64]; ld_row64(q_, qb + rowq);
    float o_[64];
#pragma unroll
    for (int d = 0; d < 64; ++d) o_[d] = 0.f;
    float m_ = -INFINITY, l_ = 0.f;
    for (int c = 0; c < 3; ++c) {
        const int dil = (c == 0) ? 1 : (c == 1) ? 4 : 16;
        for (int dl = 0; dl <= 128; ++dl) { const int pos = t - dl * dil; if (pos < 0) break;
            const float sc = dot_row64(q_, kh + (size_t)pos * DM) - slope2 * (float)(dl * dil);
            OSM_STEP(sc, vh + (size_t)pos * DM); }
    }
    st_row64(ob + rowq, o_, 1.0f / l_);
    { const size_t tok = (size_t)b * SEQ + t; const u32x4 z4 = {0u, 0u, 0u, 0u};
#pragma unroll
      for (int c = 0; c < 8; ++c) { *((u32x4*)(hb2 + tok * DM + (h - 8) * HD) + c) = z4; *((u32x4*)(hb2 + tok * DM + 512 + (h - 8) * HD) + c) = z4; }
      lse[tok * 8 + (h - 8)] = 0.f; lse[(size_t)T * 8 + tok * 8 + (h - 8)] = -1.0e30f; lse[(size_t)2 * T * 8 + tok * 8 + (h - 8)] = -1.0e30f; }
}

namespace att {
typedef float f32x16 __attribute__((ext_vector_type(16)));
typedef short s16x4 __attribute__((ext_vector_type(4)));
typedef short v4i16_t __attribute__((ext_vector_type(4)));
typedef __bf16 bf16x2_t __attribute__((ext_vector_type(2)));
constexpr int L_BUF = 16384;
constexpr int L_WSF = 2 * L_BUF;
constexpr int L_OST = L_WSF + 8 * 256;
constexpr int L_FLG = L_OST + 8 * 4096;
constexpr int L_END = L_FLG + 64;
constexpr float M_INIT = -1.0e30f;
#define ATT_MFMA(a, b, c) __builtin_amdgcn_mfma_f32_32x32x16_bf16((a), (b), (c), 0, 0, 0)

__device__ __forceinline__ unsigned cvtpk(float lo, float hi) { f32x2 v = {lo, hi}; bf16x2_t b = __builtin_convertvector(v, bf16x2_t); return __builtin_bit_cast(unsigned, b); }
__device__ __forceinline__ s16x4 vtr(LAS unsigned char* p) { return __builtin_bit_cast(s16x4, __builtin_amdgcn_ds_read_tr16_b64_v4i16((LAS v4i16_t*)p)); }

struct Wave { int lane, r32, hi, wid; LAS unsigned char* lds; LAS float* wsf; LAS unsigned char* ost; int vlo; };
__device__ __forceinline__ Wave make_wave(LAS unsigned char* lds, int tid, int wsf_off = L_WSF, int ost_off = L_OST) {
    Wave w; w.lane = tid & 63; w.r32 = w.lane & 31; w.hi = w.lane >> 5; w.wid = __builtin_amdgcn_readfirstlane(tid >> 6); w.lds = lds;
    w.wsf = (LAS float*)(lds + wsf_off) + w.wid * 64; w.ost = lds + ost_off + w.wid * 4096;
    w.vlo = ((w.lane >> 4) & 1) * 32 + (w.lane & 3) * 8 + (4 * w.hi + ((w.lane & 15) >> 2)) * 64;
    return w;
}
struct Stage { u32x4 k, v; };
template <class RowK, class RowV> __device__ __forceinline__ void stage_load(Stage& s, const Wave& w, const RowK& rowk, const RowV& rowv) {
    s.k = *(const u32x4*)(rowk(w.lane) + w.wid * 8);
    s.v = *(const u32x4*)(rowv(16 * (w.wid & 3) + (w.lane >> 2)) + (w.wid >> 2) * 32 + (w.lane & 3) * 8);
}
__device__ __forceinline__ void stage_write(const Stage& s, const Wave& w, int buf) {
    *(LAS u32x4*)(w.lds + buf * L_BUF + w.wid * 1024 + w.lane * 16) = s.k;
    *(LAS u32x4*)(w.lds + buf * L_BUF + 8192 + w.wid * 1024 + w.lane * 16) = s.v;
}
__device__ __forceinline__ f32x16 qk_sub(const Wave& w, int buf, int sub, const bf16x8 (&qf)[4], float init) {
    f32x16 acc;
#pragma unroll
    for (int r = 0; r < 16; ++r) acc[r] = init;
    LAS unsigned char* kp = w.lds + buf * L_BUF + w.hi * 1024 + (32 * sub + w.r32) * 16;
#pragma unroll
    for (int ks = 0; ks < 4; ++ks) { const bf16x8 kf = *(LAS bf16x8*)(kp + ks * 2048); acc = ATT_MFMA(kf, qf[ks], acc); }
    return acc;
}
__device__ __forceinline__ void pv_sub(const Wave& w, int buf, int sub, const f32x16& p, f32x16 (&o)[2]) {
    bf16x8 pk[2];
#pragma unroll
    for (int s = 0; s < 2; ++s) { u32x4 t; t.x = cvtpk(p[8 * s], p[8 * s + 1]); t.y = cvtpk(p[8 * s + 2], p[8 * s + 3]); t.z = cvtpk(p[8 * s + 4], p[8 * s + 5]); t.w = cvtpk(p[8 * s + 6], p[8 * s + 7]); pk[s] = __builtin_bit_cast(bf16x8, t); }
    LAS unsigned char* vb = w.lds + buf * L_BUF + 8192 + w.vlo;
#pragma unroll
    for (int db = 0; db < 2; ++db)
#pragma unroll
        for (int s = 0; s < 2; ++s) { LAS unsigned char* vp = vb + db * 4096 + (4 * sub + 2 * s) * 512;
            const s16x4 lo = vtr(vp), hh = vtr(vp + 512);
            const bf16x8 vf = __builtin_shufflevector(lo, hh, 0, 1, 2, 3, 4, 5, 6, 7);
            o[db] = ATT_MFMA(pk[s], vf, o[db]); }
}
struct VFrags { s16x4 f[2][2][2]; };
__device__ __forceinline__ void load_vfrags(const Wave& w, int buf, int sub, VFrags& v) {
    LAS unsigned char* vb = w.lds + buf * L_BUF + 8192 + w.vlo;
#pragma unroll
    for (int db = 0; db < 2; ++db)
#pragma unroll
        for (int s = 0; s < 2; ++s) { LAS unsigned char* vp = vb + db * 4096 + (4 * sub + 2 * s) * 512; v.f[db][s][0] = vtr(vp); v.f[db][s][1] = vtr(vp + 512); }
}
__device__ __forceinline__ void pv_frags(const VFrags& v, const f32x16& p, f32x16 (&o)[2]) {
    bf16x8 pk[2];
#pragma unroll
    for (int s = 0; s < 2; ++s) { u32x4 t; t.x = cvtpk(p[8 * s], p[8 * s + 1]); t.y = cvtpk(p[8 * s + 2], p[8 * s + 3]); t.z = cvtpk(p[8 * s + 4], p[8 * s + 5]); t.w = cvtpk(p[8 * s + 6], p[8 * s + 7]); pk[s] = __builtin_bit_cast(bf16x8, t); }
#pragma unroll
    for (int db = 0; db < 2; ++db)
#pragma unroll
        for (int s = 0; s < 2; ++s) { const bf16x8 vf = __builtin_shufflevector(v.f[db][s][0], v.f[db][s][1], 0, 1, 2, 3, 4, 5, 6, 7); o[db] = ATT_MFMA(pk[s], vf, o[db]); }
}
__device__ __forceinline__ void scale_rows(const Wave& w, f32x16 (&o)[2], float f) {
    if (w.hi == 0) w.wsf[w.r32] = f;
#pragma unroll
    for (int g = 0; g < 4; ++g) { const f32x4 fv = *(LAS f32x4*)(w.wsf + 8 * g + 4 * w.hi);
#pragma unroll
        for (int i = 0; i < 4; ++i) { o[0][4 * g + i] *= fv[i]; o[1][4 * g + i] *= fv[i]; } }
}
__device__ __forceinline__ void softmax_sub(const Wave& w, f32x16& s, float& m, float& lsum, f32x16 (&o)[2]) {
    float tm = fmaxf(fmaxf(s[0], s[1]), fmaxf(s[2], s[3]));
#pragma unroll
    for (int r = 4; r < 16; r += 4) tm = fmaxf(tm, fmaxf(fmaxf(s[r], s[r + 1]), fmaxf(s[r + 2], s[r + 3])));
    tm = max_xor32(tm);
    const float mn = fmaxf(m, tm);
    if (__any(mn > m)) { const float al = __builtin_amdgcn_exp2f(m - mn); lsum *= al; scale_rows(w, o, al); m = mn; }
    float acc = 0.f;
#pragma unroll
    for (int r = 0; r < 16; ++r) { s[r] = __builtin_amdgcn_exp2f(s[r] - m); acc += s[r]; }
    lsum += acc;
}
__device__ __forceinline__ void mask_band(f32x16& s, int delta0, int W) {
#pragma unroll
    for (int r = 0; r < 16; ++r) { const int dl = delta0 - ((r & 3) + 8 * (r >> 2)); if ((unsigned)dl > (unsigned)W) s[r] = -INFINITY; }
}
constexpr float SM_THR = 8.0f;
struct SubDesc { bool act; int delta; int W; };
template <int NSUB>
__device__ __forceinline__ void softmax_step(const Wave& w, int buf, const bf16x8 (&qf)[4], const bf16x8& kidx, const bf16x8& slp, float slope, const SubDesc (&sd)[NSUB],
                                             float& m, float& lsum, f32x16 (&o)[2], bool& first) {
    f32x16 s[NSUB];
    bool any_act = false;
#pragma unroll
    for (int i = 0; i < NSUB; ++i) if (sd[i].act) { any_act = true; s[i] = qk_sub(w, buf, i, qf, -slope * (float)sd[i].delta - m); s[i] = ATT_MFMA(kidx, slp, s[i]); }
    if (!any_act) return;
    float tm = -INFINITY;
#pragma unroll
    for (int i = 0; i < NSUB; ++i) if (sd[i].act) {
        if (sd[i].W >= 0) mask_band(s[i], sd[i].delta - 4 * w.hi, sd[i].W);
        float t = fmaxf(fmaxf(s[i][0], s[i][1]), fmaxf(s[i][2], s[i][3]));
#pragma unroll
        for (int r = 4; r < 16; r += 4) t = fmaxf(t, fmaxf(fmaxf(s[i][r], s[i][r + 1]), fmaxf(s[i][r + 2], s[i][r + 3])));
        tm = fmaxf(tm, t); }
    tm = max_xor32(tm);
    if (first || __any(tm > SM_THR)) {
        const float d = first ? (tm > -1.0e30f ? tm : 0.f) : fmaxf(tm, 0.f);
#pragma unroll
        for (int i = 0; i < NSUB; ++i) if (sd[i].act) {
#pragma unroll
            for (int r = 0; r < 16; ++r) s[i][r] -= d; }
        if (!first) { const float al = __builtin_amdgcn_exp2f(-d); lsum *= al; scale_rows(w, o, al); }
        m += d; first = false;
    }
    VFrags vf[NSUB];
#pragma unroll
    for (int i = 0; i < NSUB; ++i) if (sd[i].act) load_vfrags(w, buf, i, vf[i]);
#pragma unroll
    for (int i = 0; i < NSUB; ++i) if (sd[i].act) { float acc = 0.f;
#pragma unroll
        for (int r = 0; r < 16; ++r) { s[i][r] = __builtin_amdgcn_exp2f(s[i][r]); acc += s[i][r]; }
        lsum += acc; }
#pragma unroll
    for (int i = 0; i < NSUB; ++i) if (sd[i].act) pv_frags(vf[i], s[i], o);
}
__device__ __forceinline__ void bias_frags(const Wave& w, float slope, bf16x8& kidx, bf16x8& slp) {
    const unsigned kb = f2bf((float)w.r32), sh = f2bf(slope), sl = f2bf(slope - __builtin_bit_cast(float, sh << 16));
    const u32x4 a = {w.hi == 0 ? (kb | (kb << 16)) : 0u, 0u, 0u, 0u}, b = {w.hi == 0 ? (sh | (sl << 16)) : 0u, 0u, 0u, 0u};
    kidx = __builtin_bit_cast(bf16x8, a); slp = __builtin_bit_cast(bf16x8, b);
}
template <class RowO> __device__ __forceinline__ void store_o(const Wave& w, const f32x16 (&o)[2], const RowO& rowo) {
    LAS unsigned short* stg = (LAS unsigned short*)w.ost;
#pragma unroll
    for (int r = 0; r < 16; ++r) { const int q = (r & 3) + 8 * (r >> 2) + 4 * w.hi;
#pragma unroll
        for (int db = 0; db < 2; ++db) stg[q * 64 + db * 32 + w.r32] = (unsigned short)f2bf(o[db][r]); }
#pragma unroll
    for (int i = 0; i < 4; ++i) { const int row = i * 8 + (w.lane >> 3), ch = w.lane & 7; const u32x4 v = *(LAS u32x4*)((LAS unsigned char*)stg + row * 128 + ch * 16);
        bf16_t* dst = rowo(row); if (dst) *(u32x4*)(dst + ch * 8) = v; }
}
__device__ __forceinline__ void load_q(bf16x8 (&qf)[4], const bf16_t* qrow, int hi) {
#pragma unroll
    for (int ks = 0; ks < 4; ++ks) qf[ks] = *(const bf16x8*)(qrow + 16 * ks + 8 * hi);
}

constexpr int W_WSF = 98304, W_OST = W_WSF + 2048, W_ENUM = W_OST + 32768;
template <int NC> struct Pref { u32x4 k[NC], v[NC]; bf16x8 q[4]; };
template <int NC, class RowF> __device__ __forceinline__ void win_issue(Pref<NC>& P, const Wave& w, const bf16_t* kbase, const bf16_t* vbase, const RowF& rowoff, const bf16_t* qrow) {
#pragma unroll
    for (int c = 0; c < NC; ++c) { P.k[c] = *(const u32x4*)(kbase + rowoff(64 * c + 8 * w.wid + (w.lane >> 3)) + (w.lane & 7) * 8);
        P.v[c] = *(const u32x4*)(vbase + rowoff(64 * c + 16 * (w.wid & 3) + (w.lane >> 2)) + (w.wid >> 2) * 32 + (w.lane & 3) * 8); }
    load_q(P.q, qrow, w.hi);
}
template <int NC> __device__ __forceinline__ void win_commit(const Pref<NC>& P, const Wave& w) {
    constexpr int NK = 64 * NC;
#pragma unroll
    for (int c = 0; c < NC; ++c) { const int key = 64 * c + 8 * w.wid + (w.lane >> 3);
        *(LAS u32x4*)(w.lds + key * 128 + ((((w.lane & 7) ^ (key >> 1)) & 7) * 16)) = P.k[c];
        *(LAS u32x4*)(w.lds + NK * 128 + (w.wid >> 2) * (NK * 64) + (8 * c + 2 * (w.wid & 3)) * 512 + w.lane * 16) = P.v[c]; }
}
template <int NK> __device__ __forceinline__ f32x16 qk_win(const Wave& w, int u, const bf16x8 (&qf)[4], float init) {
    f32x16 acc;
#pragma unroll
    for (int r = 0; r < 16; ++r) acc[r] = init;
    LAS unsigned char* kp = w.lds + (32 * u + w.r32) * 128; const int x = (w.r32 >> 1) & 7;
#pragma unroll
    for (int ks = 0; ks < 4; ++ks) { const bf16x8 kf = *(LAS bf16x8*)(kp + (((2 * ks + w.hi) ^ x) * 16)); acc = ATT_MFMA(kf, qf[ks], acc); }
    return acc;
}
template <int NK> __device__ __forceinline__ void load_vfrags_win(const Wave& w, int u, VFrags& v) {
    LAS unsigned char* vb = w.lds + NK * 128 + w.vlo;
#pragma unroll
    for (int db = 0; db < 2; ++db)
#pragma unroll
        for (int s = 0; s < 2; ++s) { LAS unsigned char* vp = vb + db * (NK * 64) + (4 * u + 2 * s) * 512; v.f[db][s][0] = vtr(vp); v.f[db][s][1] = vtr(vp + 512); }
}
struct WSub { bool act; int u; int delta; int W; };
template <int NK>
__device__ __forceinline__ void softmax_win(const Wave& w, const bf16x8 (&qf)[4], const bf16x8& kidx, const bf16x8& slp, float slope, const WSub (&sd)[2], float& m, float& lsum, f32x16 (&o)[2], bool& first) {
    f32x16 s[2];
    bool any_act = false;
#pragma unroll
    for (int i = 0; i < 2; ++i) if (sd[i].act) { any_act = true; s[i] = qk_win<NK>(w, sd[i].u, qf, -slope * (float)sd[i].delta - m); s[i] = ATT_MFMA(kidx, slp, s[i]); }
    if (!any_act) return;
    float tm = -INFINITY;
#pragma unroll
    for (int i = 0; i < 2; ++i) if (sd[i].act) {
        if (sd[i].W >= 0) mask_band(s[i], sd[i].delta - 4 * w.hi, sd[i].W);
        float t = fmaxf(fmaxf(s[i][0], s[i][1]), fmaxf(s[i][2], s[i][3]));
#pragma unroll
        for (int r = 4; r < 16; r += 4) t = fmaxf(t, fmaxf(fmaxf(s[i][r], s[i][r + 1]), fmaxf(s[i][r + 2], s[i][r + 3])));
        tm = fmaxf(tm, t); }
    tm = max_xor32(tm);
    if (first || __any(tm > SM_THR)) {
        const float d = first ? (tm > -1.0e30f ? tm : 0.f) : fmaxf(tm, 0.f);
#pragma unroll
        for (int i = 0; i < 2; ++i) if (sd[i].act) {
#pragma unroll
            for (int r = 0; r < 16; ++r) s[i][r] -= d; }
        if (!first) { const float al = __builtin_amdgcn_exp2f(-d); lsum *= al; scale_rows(w, o, al); }
        m += d; first = false;
    }
#pragma unroll
    for (int i = 0; i < 2; ++i) if (sd[i].act) { VFrags vf; load_vfrags_win<NK>(w, sd[i].u, vf);
        float acc = 0.f;
#pragma unroll
        for (int r = 0; r < 16; ++r) { s[i][r] = __builtin_amdgcn_exp2f(s[i][r]); acc += s[i][r]; }
        lsum += acc;
        pv_frags(vf, s[i], o); }
}

__device__ __forceinline__ size_t ql_off(int bh, int j) { return (size_t)bh * QL_PER_BH + (size_t)(8192 * j - 128 * j * (j + 1)); }
__device__ __forceinline__ float* lsem_ptr(float* l0, float* l1, int slot) { return (slot < 2 ? l0 : l1) + (size_t)(slot & 1) * T * 4; }

struct Top3 { int i0, i1, i2; };
__device__ __forceinline__ Top3 moba_top3(const Wave& w, const bf16x8 (&qf)[4], const float* KMEAN, int b, int h, int own) {
    int i0 = -1, i1 = -1, i2 = -1;
    if (own > 0) {
    f32x16 g;
#pragma unroll
    for (int r = 0; r < 16; ++r) g[r] = 0.f;
    const float* km = KMEAN + ((size_t)(b * 4 + h) * 32 + w.r32) * HD + 8 * w.hi;
#pragma unroll
    for (int ks = 0; ks < 4; ++ks) { const f32x4 a0 = *(const f32x4*)(km + 16 * ks), a1 = *(const f32x4*)(km + 16 * ks + 4);
        const float x[8] = {a0.x, a0.y, a0.z, a0.w, a1.x, a1.y, a1.z, a1.w}; unsigned hw[4], lw[4];
#pragma unroll
        for (int j = 0; j < 4; ++j) { const unsigned h0 = f2bf(x[2 * j]), h1 = f2bf(x[2 * j + 1]); hw[j] = h0 | (h1 << 16);
            lw[j] = pk2(x[2 * j] - __builtin_bit_cast(float, h0 << 16), x[2 * j + 1] - __builtin_bit_cast(float, h1 << 16)); }
        const u32x4 hv = {hw[0], hw[1], hw[2], hw[3]}, lv = {lw[0], lw[1], lw[2], lw[3]};
        g = ATT_MFMA(__builtin_bit_cast(bf16x8, hv), qf[ks], g); g = ATT_MFMA(__builtin_bit_cast(bf16x8, lv), qf[ks], g); }
    float v0 = -INFINITY, v1 = -INFINITY, v2 = -INFINITY;
#pragma unroll
    for (int r = 0; r < 16; ++r) { const int blk = (r & 3) + 8 * (r >> 2) + 4 * w.hi; const float val = (blk < own) ? g[r] : -INFINITY;
        if (val > v0) { v2 = v1; i2 = i1; v1 = v0; i1 = i0; v0 = val; i0 = blk; } else if (val > v1) { v2 = v1; i2 = i1; v1 = val; i1 = blk; } else if (val > v2) { v2 = val; i2 = blk; } }
    const float pv_[3] = {get_xor32(v0, w.hi), get_xor32(v1, w.hi), get_xor32(v2, w.hi)}; const int pi_[3] = {get_xor32i(i0, w.hi), get_xor32i(i1, w.hi), get_xor32i(i2, w.hi)};
#pragma unroll
    for (int k = 0; k < 3; ++k) { const float val = pv_[k]; const int blk = pi_[k];
        if (val > v0 || (val == v0 && blk < i0)) { v2 = v1; i2 = i1; v1 = v0; i1 = i0; v0 = val; i0 = blk; }
        else if (val > v1 || (val == v1 && blk < i1)) { v2 = v1; i2 = i1; v1 = val; i1 = blk; }
        else if (val > v2 || (val == v2 && blk < i2)) { v2 = val; i2 = blk; } }
    }
    Top3 t; t.i0 = i0; t.i1 = i1; t.i2 = i2; return t;
}
__device__ __forceinline__ void moba_gate_unit(LAS unsigned char* lds, const bf16_t* QB, const float* KMEAN, unsigned* mcnt, unsigned* qlist, bf16_t* PM, float* LSEM0, float* LSEM1, int b, int h, int own, int tid) {
    const Wave w = make_wave(lds, tid);
    const size_t rowbase = (size_t)b * SEQ; const int qpos = own * 256 + 32 * w.wid + w.r32, bh = b * 4 + h;
    bf16x8 qf[4]; load_q(qf, QB + (rowbase + qpos) * DM + h * HD, w.hi);
    const Top3 t3 = moba_top3(w, qf, KMEAN, b, h, own); const int s0 = t3.i0, s1 = t3.i1, s2 = t3.i2;
    LAS unsigned* cl = (LAS unsigned*)(lds + W_ENUM);
    if (tid < 64) cl[tid] = 0u;
    __syncthreads();
    unsigned r0 = 0u, r1 = 0u, r2 = 0u;
    if (w.hi == 0) {
        if (s0 >= 0) r0 = __hip_atomic_fetch_add(cl + s0, 1u, __ATOMIC_RELAXED, __HIP_MEMORY_SCOPE_WORKGROUP);
        if (s1 >= 0) r1 = __hip_atomic_fetch_add(cl + s1, 1u, __ATOMIC_RELAXED, __HIP_MEMORY_SCOPE_WORKGROUP);
        if (s2 >= 0) r2 = __hip_atomic_fetch_add(cl + s2, 1u, __ATOMIC_RELAXED, __HIP_MEMORY_SCOPE_WORKGROUP);
    }
    __syncthreads();
    if (tid < 32) { const unsigned c = cl[tid]; cl[32 + tid] = c ? __hip_atomic_fetch_add(mcnt + bh * 32 + tid, c, __ATOMIC_RELAXED, __HIP_MEMORY_SCOPE_AGENT) : 0u; }
    __syncthreads();
    if (w.hi == 0) {
        const size_t tok = rowbase + qpos;
#define MOBA_EMIT(k, sk, rk) do { if (sk >= 0) qlist[ql_off(bh, sk) + cl[32 + sk] + rk] = (unsigned)qpos | ((unsigned)(k) << 13); \
            else { lsem_ptr(LSEM0, LSEM1, k)[tok * 4 + h] = -1.0e30f;          \
                u32x4* pz = (u32x4*)(PM + ((size_t)(k) * T + tok) * 256 + h * HD); const u32x4 z4 = {0u, 0u, 0u, 0u}; \
                _Pragma("unroll") for (int c = 0; c < 8; ++c) pz[c] = z4; } } while (0)
        MOBA_EMIT(0, s0, r0); MOBA_EMIT(1, s1, r1); MOBA_EMIT(2, s2, r2);
#undef MOBA_EMIT
    }
    __syncthreads();
}
struct OwnU { int b, h, own; };
__device__ __forceinline__ void own_issue(Pref<4>& P, const Wave& w, const OwnU& u, const bf16_t* QB, const bf16_t* KB, const bf16_t* VB) {
    const size_t rowbase = (size_t)u.b * SEQ; const int q0 = u.own * 256;
    win_issue<4>(P, w, KB + (rowbase + q0) * DM + u.h * HD, VB + (rowbase + q0) * DM + u.h * HD, [&](int key) { return (size_t)key * DM; }, QB + (rowbase + q0 + 32 * w.wid + w.r32) * DM + u.h * HD);
}
template <class F> __device__ __forceinline__ void own_compute(const Wave& w, const OwnU& u, const bf16x8 (&qf)[4], bf16_t* OB, float* LSEM0, float* LSEM1, const F& between) {
    const size_t rowbase = (size_t)u.b * SEQ; const int q0 = u.own * 256, ql = 32 * w.wid + w.r32;
    const float slope2 = exp2f(-2.0f * (float)(u.h + 1)) * LOG2E;
    bf16x8 kidx, slp; bias_frags(w, slope2, kidx, slp);
    f32x16 o[2];
#pragma unroll
    for (int r = 0; r < 16; ++r) { o[0][r] = 0.f; o[1][r] = 0.f; }
    float m = 0.f, lsum = 0.f; bool first = true;
#pragma unroll
    for (int p = 0; p < 4; ++p) { WSub sd[2];
#pragma unroll
        for (int i = 0; i < 2; ++i) { const int su = w.wid - 2 * p - i; sd[i].act = su >= 0; sd[i].u = su; sd[i].delta = ql - 32 * su; sd[i].W = (su == w.wid) ? 0x7fffffff : -1; }
        softmax_win<256>(w, qf, kidx, slp, slope2, sd, m, lsum, o, first); }
    between();
    const float l = sum_xor32(lsum);
    scale_rows(w, o, 1.0f / l);
    bf16_t* orow = OB + (rowbase + q0 + 32 * w.wid) * DM + u.h * HD;
    store_o(w, o, [&](int r) { return orow + (size_t)r * DM; });
    if (w.hi == 0) lsem_ptr(LSEM0, LSEM1, 3)[(rowbase + q0 + ql) * 4 + u.h] = m + __builtin_amdgcn_logf(l);
}
struct GatU { int b, h, j, cnt, chunk; const unsigned* ql; };
__device__ __forceinline__ unsigned gat_entry(const Wave& w, const GatU& u, bool& valid) { const int idx = u.chunk * 256 + 32 * w.wid + w.r32; valid = idx < u.cnt; return u.ql[valid ? idx : u.chunk * 256]; }
__device__ __forceinline__ void gat_issue(Pref<4>& P, const Wave& w, const GatU& u, const bf16_t* QB, const bf16_t* KB, const bf16_t* VB) {
    const size_t rowbase = (size_t)u.b * SEQ; bool valid; const unsigned e = gat_entry(w, u, valid);
    win_issue<4>(P, w, KB + (rowbase + u.j * 256) * DM + u.h * HD, VB + (rowbase + u.j * 256) * DM + u.h * HD, [&](int key) { return (size_t)key * DM; }, QB + (rowbase + (e & 8191u)) * DM + u.h * HD);
}
template <class F> __device__ __forceinline__ void gat_compute(const Wave& w, const GatU& u, const bf16x8 (&qf)[4], bf16_t* PM, float* LSEM0, float* LSEM1, const F& between) {
    const size_t rowbase = (size_t)u.b * SEQ; bool valid; const unsigned e = gat_entry(w, u, valid);
    const int qpos = (int)(e & 8191u), slot = (int)(e >> 13);
    const float slope2 = exp2f(-2.0f * (float)(u.h + 1)) * LOG2E;
    bf16x8 kidx, slp; bias_frags(w, slope2, kidx, slp);
    f32x16 o[2];
#pragma unroll
    for (int r = 0; r < 16; ++r) { o[0][r] = 0.f; o[1][r] = 0.f; }
    float m = 0.f, lsum = 0.f; bool first = true;
#pragma unroll
    for (int p = 0; p < 4; ++p) { WSub sd[2];
#pragma unroll
        for (int i = 0; i < 2; ++i) { const int su = 7 - 2 * p - i; sd[i].act = true; sd[i].u = su; sd[i].delta = qpos - (u.j * 256 + 32 * su); sd[i].W = -1; }
        softmax_win<256>(w, qf, kidx, slp, slope2, sd, m, lsum, o, first); }
    between();
    const float l = sum_xor32(lsum);
    scale_rows(w, o, l > 0.f ? 1.0f / l : 0.f);
    LAS int* code = (LAS int*)(w.wsf + 32);
    if (w.hi == 0) code[w.r32] = valid ? (int)((size_t)slot * T + rowbase + qpos) : -1;
    store_o(w, o, [&](int r) { const int c = code[r]; return c >= 0 ? PM + (size_t)c * 256 + u.h * HD : (bf16_t*)nullptr; });
    if (w.hi == 0 && valid) lsem_ptr(LSEM0, LSEM1, slot)[(rowbase + qpos) * 4 + u.h] = l > 0.f ? m + __builtin_amdgcn_logf(l) : -1.0e30f;
}

__device__ __forceinline__ void sb_unit(LAS unsigned char* lds, const bf16_t* QB, const bf16_t* KB, const bf16_t* VB, bf16_t* OB, int b, int h, int qt, int tid) {
    const Wave w = make_wave(lds, tid);
    const size_t rowbase = (size_t)b * SEQ; const int q0 = qt * 256, qpos = q0 + 32 * w.wid + w.r32;
    const bf16_t* kh = KB + rowbase * DM + h * HD; const bf16_t* vh = VB + rowbase * DM + h * HD;
    bf16x8 qf[4]; load_q(qf, QB + (rowbase + qpos) * DM + h * HD, w.hi);
    f32x16 o[2];
#pragma unroll
    for (int r = 0; r < 16; ++r) { o[0][r] = 0.f; o[1][r] = 0.f; }
    float carry = 0.f;
    bool done = false;
    volatile LAS unsigned* flg = (volatile LAS unsigned*)(lds + L_FLG);
    const int ti0 = q0 / 64 + 3;
    Stage sg;
    { const int kp = ti0 * 64; stage_load(sg, w, [&](int key) { return kh + (size_t)(kp + key) * DM; }, [&](int key) { return vh + (size_t)(kp + key) * DM; }); }
    stage_write(sg, w, 0);
    __syncthreads();
    for (int st = 0;; ++st) {
        const int buf = st & 1, ti = ti0 - st;
        if (ti > 0) { const int kp = (ti - 1) * 64; stage_load(sg, w, [&](int key) { return kh + (size_t)(kp + key) * DM; }, [&](int key) { return vh + (size_t)(kp + key) * DM; }); }
        if (!done) {
#pragma unroll
            for (int sub = 1; sub >= 0; --sub) {
                const int D = (q0 / 32 + w.wid) - (2 * ti + sub);
                if (D < 0) continue;
                const int delta0 = qpos - (64 * ti + 32 * sub) - 4 * w.hi;
                f32x16 z = qk_sub(w, buf, sub, qf, 0.f);
                f32x16 dd;
#pragma unroll
                for (int r = 0; r < 16; ++r) { z[r] = __builtin_amdgcn_exp2f(fminf(z[r], 30.f)); }
                if (D == 0) {
#pragma unroll
                    for (int r = 0; r < 16; ++r) { const int dl = delta0 - ((r & 3) + 8 * (r >> 2)); if (dl < 1) z[r] = 0.f; }
                }
#pragma unroll
                for (int r = 0; r < 16; ++r) dd[r] = 1.f + z[r];
                float G[4], PG[4];
#pragma unroll
                for (int g = 0; g < 4; ++g) { G[g] = (dd[4 * g] * dd[4 * g + 1]) * (dd[4 * g + 2] * dd[4 * g + 3]); PG[g] = get_xor32(G[g], w.hi); }
                const float cin = __builtin_amdgcn_exp2f(carry);
                float run = 1.f;
#pragma unroll
                for (int g = 3; g >= 0; --g) { const float x3 = run * (w.hi == 0 ? PG[g] : 1.f);
                    const float p0 = x3 * G[g];
                    const float r0 = __builtin_amdgcn_rcpf(p0) * cin, r1 = r0 * dd[4 * g], r2 = r1 * dd[4 * g + 1], r3 = r2 * dd[4 * g + 2];
                    z[4 * g] *= r0; z[4 * g + 1] *= r1; z[4 * g + 2] *= r2; z[4 * g + 3] *= r3;
                    run *= G[g] * PG[g]; }
                carry -= __builtin_amdgcn_logf(run);
                pv_sub(w, buf, sub, z, o);
            }
            done = __all(carry < -150.f);
        }
        if (w.lane == 0) flg[buf * 8 + w.wid] = done ? 1u : 0u;
        if (ti > 0) stage_write(sg, w, buf ^ 1);
        __syncthreads();
        unsigned all = 1u;
#pragma unroll
        for (int k = 0; k < 8; ++k) all &= flg[buf * 8 + k];
        if (all || ti == 0) break;
    }
    bf16_t* orow = OB + (rowbase + q0 + 32 * w.wid) * DM + h * HD;
    store_o(w, o, [&](int r) { return orow + (size_t)r * DM; });
    __syncthreads();
}

struct PrefK6 { u32x4 k[6]; bf16x8 q[4]; }; struct PrefV6 { u32x4 v[6]; };
template <class RowF> __device__ __forceinline__ void win_issue_k6(PrefK6& P, const Wave& w, const bf16_t* kbase, const RowF& rowoff, const bf16_t* qrow) {
#pragma unroll
    for (int c = 0; c < 6; ++c) P.k[c] = *(const u32x4*)(kbase + rowoff(64 * c + 8 * w.wid + (w.lane >> 3)) + (w.lane & 7) * 8);
    load_q(P.q, qrow, w.hi);
}
template <class RowF> __device__ __forceinline__ void win_issue_v6(PrefV6& P, const Wave& w, const bf16_t* vbase, const RowF& rowoff) {
#pragma unroll
    for (int c = 0; c < 6; ++c) P.v[c] = *(const u32x4*)(vbase + rowoff(64 * c + 16 * (w.wid & 3) + (w.lane >> 2)) + (w.wid >> 2) * 32 + (w.lane & 3) * 8);
}
__device__ __forceinline__ void win_commit_k6(const PrefK6& P, const Wave& w) {
#pragma unroll
    for (int c = 0; c < 6; ++c) { const int key = 64 * c + 8 * w.wid + (w.lane >> 3); *(LAS u32x4*)(w.lds + key * 128 + ((((w.lane & 7) ^ (key >> 1)) & 7) * 16)) = P.k[c]; }
}
__device__ __forceinline__ void win_commit_v6(const PrefV6& P, const Wave& w) {
    constexpr int NK = 384;
#pragma unroll
    for (int c = 0; c < 6; ++c) *(LAS u32x4*)(w.lds + NK * 128 + (w.wid >> 2) * (NK * 64) + (8 * c + 2 * (w.wid & 3)) * 512 + w.lane * 16) = P.v[c];
}
struct DilU { int b, h, dil, res, i2, c; };
__device__ __forceinline__ DilU dil_decode(int u) { const int n = ((u & 31) + (u >> 8)) & 31, bhc = u >> 5,
    c = bhc % 3, bh = bhc / 3; DilU d; d.b = bh >> 3; d.h = 8 + (bh & 7); d.c = c;
    d.dil = (c == 0) ? 1 : (c == 1) ? 4 : 16; d.res = (c == 0) ? 0 : (c == 1) ? (n >> 3) : (n >> 1); d.i2 = (c == 0) ? n : (c == 1) ? (n & 7) : (n & 1); return d; }
__device__ __forceinline__ void dil_issue_k(PrefK6& P, const Wave& w, const DilU& u, const bf16_t* QB, const bf16_t* KB) {
    const size_t rowbase = (size_t)u.b * SEQ; const int Q0 = 256 * u.i2, qj = Q0 + 32 * w.wid + w.r32; const size_t rstride = (size_t)u.dil * DM;
    win_issue_k6(P, w, KB + (rowbase + u.res) * DM + u.h * HD, [&](int key) { const int kj = Q0 - 128 + key; return (size_t)(kj < 0 ? 0 : kj) * rstride; },
                 QB + (rowbase + u.res + (size_t)qj * u.dil) * DM + u.h * HD);
}
__device__ __forceinline__ void dil_issue_v(PrefV6& P, const Wave& w, const DilU& u, const bf16_t* VB) {
    const size_t rowbase = (size_t)u.b * SEQ; const int Q0 = 256 * u.i2; const size_t rstride = (size_t)u.dil * DM;
    win_issue_v6(P, w, VB + (rowbase + u.res) * DM + u.h * HD, [&](int key) { const int kj = Q0 - 128 + key; return (size_t)(kj < 0 ? 0 : kj) * rstride; });
}
template <class F> __device__ __forceinline__ void dil_compute(const Wave& w, const DilU& u, const bf16x8 (&qf)[4], bf16_t* OB, bf16_t* HB2, float* LSE, const F& between) {
    const size_t rowbase = (size_t)u.b * SEQ; const int Q0 = 256 * u.i2, ql = 32 * w.wid + w.r32;
    const float slope2d = exp2f(-(float)(u.h - 8 + 1)) * LOG2E * (float)u.dil;
    bf16x8 kidx, slp; bias_frags(w, slope2d, kidx, slp);
    f32x16 o[2];
#pragma unroll
    for (int r = 0; r < 16; ++r) { o[0][r] = 0.f; o[1][r] = 0.f; }
    float m = 0.f, lsum = 0.f; bool first = true;
#pragma unroll
    for (int p = 0; p < 3; ++p) { WSub sd[2];
#pragma unroll
        for (int i = 0; i < 2; ++i) { const int D = 2 * p + i, su = w.wid + 4 - D; sd[i].act = (D <= 4) && (Q0 - 128 + 32 * su >= 0); sd[i].u = su; sd[i].delta = ql + 128 - 32 * su; sd[i].W = (D == 0 || D == 4) ? 128 : -1; }
        softmax_win<384>(w, qf, kidx, slp, slope2d, sd, m, lsum, o, first); }
    between();
    const float l = sum_xor32(lsum);
    scale_rows(w, o, 1.0f / l);
    bf16_t* PO = (u.c == 0) ? OB + 512 : HB2 + (u.c - 1) * 512;
    const size_t tok0 = rowbase + u.res + (size_t)(Q0 + 32 * w.wid) * u.dil;
    store_o(w, o, [&](int r) { return PO + (tok0 + (size_t)r * u.dil) * DM + (u.h - 8) * HD; });
    if (w.hi == 0) (LSE + (size_t)u.c * T * 8)[(tok0 + (size_t)w.r32 * u.dil) * 8 + (u.h - 8)] = m + __builtin_amdgcn_logf(l);
}

__device__ __forceinline__ void moba_gate_phase(LAS unsigned char* lds, const bf16_t* QB, const float* KMEAN, unsigned* mcnt, unsigned* qlist, bf16_t* PM, float* LSEM0, float* LSEM1, int v, int G, int tid) {
    for (int u = v; u < 512; u += G) { const int own = u & 31, bh = u >> 5; moba_gate_unit(lds, QB, KMEAN, mcnt, qlist, PM, LSEM0, LSEM1, bh >> 2, bh & 3, own, tid); }
}
struct AttnArgs { const bf16_t* QB; const bf16_t* KB; const bf16_t* VB; bf16_t* OB; bf16_t* HB2; float* LSE; unsigned* mcnt; unsigned* qlist; bf16_t* PM; float* LSEM0; float* LSEM1; const float* KMEAN; unsigned* gdone; };
__device__ __forceinline__ void attn_phase(LAS unsigned char* lds, const AttnArgs& A, int v, int G, int tid) {
    moba_gate_phase(lds, A.QB, A.KMEAN, A.mcnt, A.qlist, A.PM, A.LSEM0, A.LSEM1, v, G, tid);
    asm volatile("s_waitcnt vmcnt(0)" ::: "memory");
    __syncthreads();
    if (tid == 0) { __builtin_amdgcn_fence(__ATOMIC_RELEASE, "agent"); asm volatile("s_waitcnt vmcnt(0)" ::: "memory"); __hip_atomic_fetch_add(A.gdone, 1u, __ATOMIC_RELAXED, __HIP_MEMORY_SCOPE_AGENT); }
    const Wave w = make_wave(lds, tid, W_WSF, W_OST);
    {   Pref<4> P; int u = v; OwnU cur, nxt;
        auto dec = [&](int uu) { OwnU o_; const int bh = uu >> 5; o_.b = bh >> 2; o_.h = bh & 3; o_.own = uu & 31; return o_; };
        if (u < 512) { cur = dec(u); own_issue(P, w, cur, A.QB, A.KB, A.VB); }
        for (; u < 512; u += G) {
            __syncthreads();
            win_commit<4>(P, w); bf16x8 qf[4] = {P.q[0], P.q[1], P.q[2], P.q[3]};
            __syncthreads();
            const bool more = u + G < 512; if (more) nxt = dec(u + G);
            own_compute(w, cur, qf, A.OB, A.LSEM0, A.LSEM1, [&]() { if (more) own_issue(P, w, nxt, A.QB, A.KB, A.VB); });
            cur = nxt; } }
    {   PrefK6 P; int u = v; DilU cur, nxt;
        if (u < 3072) { cur = dil_decode(u); dil_issue_k(P, w, cur, A.QB, A.KB); }
        for (; u < 3072; u += G) {
            __syncthreads();
            bf16x8 qf[4] = {P.q[0], P.q[1], P.q[2], P.q[3]};
            { PrefV6 PV; dil_issue_v(PV, w, cur, A.VB); win_commit_k6(P, w); win_commit_v6(PV, w); }
            __syncthreads();
            const bool more = u + G < 3072; if (more) nxt = dil_decode(u + G);
            dil_compute(w, cur, qf, A.OB, A.HB2, A.LSE, [&]() { if (more) dil_issue_k(P, w, nxt, A.QB, A.KB); });
            cur = nxt; } }
    __syncthreads();
    for (int u = v; u < 512; u += G) { const int qt = ((u & 31) + (u >> 8)) & 31, bh = u >> 5; sb_unit(lds, A.QB, A.KB, A.VB, A.OB, bh >> 2, 4 + (bh & 3), qt, tid); }
    if (tid == 0) { unsigned polls = 0;
        while (__hip_atomic_load(A.gdone, __ATOMIC_RELAXED, __HIP_MEMORY_SCOPE_AGENT) < (unsigned)G) { if (++polls > (1u << 20)) break; __builtin_amdgcn_s_sleep(2); }
        __builtin_amdgcn_fence(__ATOMIC_ACQUIRE, "agent"); asm volatile("s_waitcnt vmcnt(0)" ::: "memory"); }
    __syncthreads();
    LAS int* cntl = (LAS int*)(lds + W_ENUM); LAS int* pa = cntl + 512; LAS int* pb = pa + 512;
    const int myc = (int)A.mcnt[tid], myu = (myc + 255) >> 8;
    cntl[tid] = myc; pa[tid] = myu;
    __syncthreads();
#pragma unroll 1
    for (int d = 1; d < 512; d <<= 1) { const int x = pa[tid] + (tid >= d ? pa[tid - d] : 0); pb[tid] = x; __syncthreads(); LAS int* t_ = pa; pa = pb; pb = t_; }
    const int total = pa[511];
    auto gat_decode = [&](int u) { int lo = 0, hi = 511;
        while (lo < hi) { const int mid = (lo + hi) >> 1; if (pa[mid] > u) hi = mid; else lo = mid + 1; }
        const int i = lo, c = cntl[i], bh = i >> 5; GatU g; g.b = bh >> 2; g.h = bh & 3; g.j = i & 31; g.cnt = c; g.chunk = u - (pa[i] - ((c + 255) >> 8)); g.ql = A.qlist + ql_off(bh, g.j); return g; };
    {   Pref<4> P; int u = v; GatU cur, nxt;
        if (u < total) { cur = gat_decode(u); gat_issue(P, w, cur, A.QB, A.KB, A.VB); }
        for (; u < total; u += G) {
            __syncthreads();
            win_commit<4>(P, w); bf16x8 qf[4] = {P.q[0], P.q[1], P.q[2], P.q[3]};
            __syncthreads();
            const bool more = u + G < total; if (more) nxt = gat_decode(u + G);
            gat_compute(w, cur, qf, A.PM, A.LSEM0, A.LSEM1, [&]() { if (more) gat_issue(P, w, nxt, A.QB, A.KB, A.VB); });
            cur = nxt; } }
}
}

constexpr int PH_PRO = 0, PH_L0 = 1, PH_PER_LAYER = 10, PH_FINAL = PH_L0 + DEPTH * PH_PER_LAYER, PH_COUNT = PH_FINAL + 1;
typedef const __attribute__((address_space(4))) Args* KArgP;
#define KARG() ({ KArgP p_ = (KArgP)__builtin_amdgcn_kernarg_segment_ptr(); asm volatile("" : "+s"(p_)); p_; })
#define PHASE_IDS int lane_p = (int)__builtin_amdgcn_mbcnt_hi(~0u, __builtin_amdgcn_mbcnt_lo(~0u, 0u)); LAUNDER_V(lane_p); int tid_p = wave * 64 + lane_p; int gw_p = gw, G_p = G, NGW_p = NGW; LAUNDER_S(gw_p); LAUNDER_S(G_p); LAUNDER_S(NGW_p)
__global__ void __launch_bounds__(NTHREADS, 2) fwd(Args a_unused) {
    extern __shared__ __attribute__((aligned(16))) unsigned char lds_raw[];
    LAS unsigned char* lds = (LAS unsigned char*)lds_raw;
    volatile LAS unsigned* MISC = (volatile LAS unsigned*)(lds + MISC_OFF);
    const int wave = __builtin_amdgcn_readfirstlane((int)threadIdx.x >> 6);
    const int G = gridDim.x, bx = blockIdx.x;
    const int vcu = (G % 8 == 0) ? (bx % 8) * (G / 8) + bx / 8 : bx;
    const int gw = vcu * NWAVES + wave, NGW = G * NWAVES;
    for (int u = threadIdx.x; u < (LDS_BYTES - LDSCTL_OFF) / 4; u += NTHREADS) ((LAS unsigned*)(lds + LDSCTL_OFF))[u] = 0u;
    __syncthreads();
    int lo, hi; XcdBarrier bar;
    { KArgP ka = KARG(); lo = ka->ph_lo; hi = ka->ph_hi; unsigned* ctl = (unsigned*)(ka->ws + WS_CTL); bar = xcd_barrier_post(ctl + CW_BAR + ka->li * XCD_BAR_WORDS, MISC + 8, wave); }
#define IN(k) (lo <= (k) && (k) < hi)
#define SEAM(k) do { if (IN(k) && IN((k) + 1)) xcd_barrier(bar); } while (0)
#define WSP(T_, off) ((T_*)(ws + (off)))

    if (IN(PH_PRO)) { KArgP ka = KARG(); PHASE_IDS; Args a; a.ws = ka->ws; a.w_in = ka->w_in; a.w_out = ka->w_out; a.w_gate = ka->w_gate; a.w_up = ka->w_up; a.w_down = ka->w_down; phase_prologue(a, lds, gw_p, NGW_p, wave, lane_p); } SEAM(PH_PRO);

    for (int l = 0; l < DEPTH; ++l) {
        const int p0 = PH_L0 + l * PH_PER_LAYER;
        if (hi <= p0 || lo >= p0 + PH_PER_LAYER) continue;
        if (IN(p0 + 0)) for (int rep_ = 0; rep_ < RPT(0); ++rep_) { if (rep_) xcd_barrier(bar); KArgP ka = KARG(); PHASE_IDS; unsigned char* ws = ka->ws;
            if (l == 0) phase_norm1(ka->x, ka->ln1_g, WSP(bf16_t, WS_HB), gw_p, NGW_p, lane_p, WSP(float, WS_KMEAN), WSP(bf16_t, WS_XB));
            else phase_norm1_b(WSP(bf16_t, WS_XB), ka->ln1_g + (size_t)l * DM, WSP(bf16_t, WS_HB), gw_p, NGW_p, lane_p, WSP(float, WS_KMEAN)); } SEAM(p0 + 0);
        if (IN(p0 + 1)) for (int rep_ = 0; rep_ < RPT(1); ++rep_) { if (rep_) xcd_barrier(bar); KArgP ka = KARG(); PHASE_IDS; unsigned char* ws = ka->ws;
            pg8::Gemm g{(const char*)(ws + WS_HB), (const char*)(ws + WS_WIN) + (size_t)l * NQKV * DM * 2, DM, DM, DM, (long)256 * DM * 2, (long)256 * DM * 2, (long)128 * DM * 2};
            pg8::StaticOrder S; S.init(T / 256, NQKV / 256, G_p, bx);
            pg8::EpiQKV E{WSP(bf16_t, WS_Q), (size_t)(WS_K - WS_Q) / 2, QSCALE};
            pg8::gemm_phase<pg8::EpiQKV, pg8::StaticOrder>(lds, g, S, E, wave);
        } SEAM(p0 + 1);
        if (IN(p0 + 4)) for (int rep_ = 0; rep_ < RPT(4); ++rep_) { if (rep_) xcd_barrier(bar); KArgP ka = KARG(); PHASE_IDS; unsigned char* ws = ka->ws;
            const att::AttnArgs A{WSP(bf16_t, WS_Q), WSP(bf16_t, WS_K), WSP(bf16_t, WS_V), (bf16_t*)ka->out, WSP(bf16_t, WS_HB), WSP(float, WS_LSE), WSP(unsigned, WS_CTL) + CW_MCNT + l * 512, WSP(unsigned, WS_QLIST),
                                  WSP(bf16_t, WS_PM), WSP(float, WS_LSEM0), WSP(float, WS_LSEM1), WSP(float, WS_KMEAN), WSP(unsigned, WS_CTL) + CW_GDONE + l * 64};
            att::attn_phase(lds, A, vcu, G_p, tid_p);
        } SEAM(p0 + 4);
        if (IN(p0 + 5)) { KArgP ka = KARG(); PHASE_IDS; unsigned char* ws = ka->ws;
            phase_mixnorm((const bf16_t*)ka->out, WSP(bf16_t, WS_HB), WSP(float, WS_LSE), WSP(bf16_t, WS_PM), WSP(float, WS_LSEM0), WSP(float, WS_LSEM1), ka->mix_g + (size_t)l * DM, gw_p, NGW_p, lane_p); } SEAM(p0 + 5);
        if (IN(p0 + 6)) { KArgP ka = KARG(); PHASE_IDS; unsigned char* ws = ka->ws;
            pg8::Gemm g{(const char*)(ws + WS_HB), (const char*)(ws + WS_WOUT) + (size_t)l * DM * DM * 2, DM, DM, DM, (long)256 * DM * 2, (long)256 * DM * 2, (long)128 * DM * 2};
            pg8::StaticOrder S; S.init(T / 256, DM / 256, G_p, bx);
            pg8::EpiResAdd E{WSP(bf16_t, WS_XB)};
            pg8::gemm_phase<pg8::EpiResAdd, pg8::StaticOrder>(lds, g, S, E, wave);
        } SEAM(p0 + 6);
        if (IN(p0 + 7)) { KArgP ka = KARG(); PHASE_IDS; unsigned char* ws = ka->ws;
            phase_route(WSP(bf16_t, WS_XB), ka->ln2_g + (size_t)l * DM, ka->w_gr + (size_t)l * DM * 4, ka->b_gr + l * 4, ka->w_er + (size_t)l * 4 * DM * 4, ka->b_er + l * 16, WSP(bf16_t, WS_HB),
                        WSP(unsigned, WS_CTL) + CW_CNT + l * 32, WSP(unsigned, WS_LIST), WSP(float, WS_WLIST), lds, vcu, G_p, wave, lane_p); } SEAM(p0 + 7);
        if (IN(p0 + 8)) for (int rep_ = 0; rep_ < RPT(8); ++rep_) { if (rep_) xcd_barrier(bar); KArgP ka = KARG(); PHASE_IDS; unsigned char* ws = ka->ws;
            pg8::MoeProb<0> P{WSP(unsigned, WS_CTL) + CW_CNT + l * 32, WSP(unsigned, WS_LIST), (const char*)(ws + WS_HB), (const char*)(ws + WS_WG) + (size_t)l * NACT * DM * 2, DM, DM, DM, (long)(WS_WU - WS_WG), G_p, vcu, WSP(unsigned, WS_CTL) + CW_TCNT + l * 16384};
            pg8::EpiGateUpSparse E{WSP(bf16_t, WS_ACT), WSP(float, WS_WLIST), WSP(unsigned, WS_CTL) + CW_TCNT + l * 16384};
            pg8::gemm_phase_x<pg8::EpiGateUpSparse, pg8::MoeProb<0>>(lds, P, E, wave);
        }
        if (IN(p0 + 9)) { KArgP ka = KARG(); PHASE_IDS; unsigned char* ws = ka->ws;
            pg8::MoeProb<1> P{WSP(unsigned, WS_CTL) + CW_CNT + l * 32, WSP(unsigned, WS_LIST), (const char*)(ws + WS_ACT), (const char*)(ws + WS_WD) + (size_t)l * DM * NACT * 2, 512, NACT, 512, (long)128 * NACT * 2, G_p, vcu, WSP(unsigned, WS_CTL) + CW_TCNT + l * 16384};
            pg8::EpiDownScatter E{WSP(bf16_t, WS_XB), WSP(unsigned, WS_LIST)};
            pg8::gemm_phase_x<pg8::EpiDownScatter, pg8::MoeProb<1>>(lds, P, E, wave);
        } SEAM(p0 + 9);
    }
    if (IN(PH_FINAL)) { KArgP ka = KARG(); PHASE_IDS; phase_final((const bf16_t*)(ka->ws + WS_XB), ka->fin_g, ka->out, gw_p, NGW_p, lane_p); }
#undef IN
#undef SEAM
#undef WSP
}

#ifndef N_LAUNCH_MODE
#define N_LAUNCH_MODE 1
#endif
extern "C" void kernel_launch(void* const* d_in, const int* in_sizes, int n_in, void* d_out, int out_size, void* d_ws, size_t ws_size, hipStream_t stream) {
    static int grid = 0;
    if (grid == 0) {
        if (n_in != 14 || in_sizes[0] != T * DM || out_size != T * DM || ws_size < WS_END) { fprintf(stderr, "kernel_launch: unexpected shapes (n_in %d in0 %d out %d ws %zu)\n", n_in, n_in > 0 ? in_sizes[0] : -1, out_size, ws_size); grid = -1; return; }
        int dev = 0, cus = 0, per_cu = 0;
        if (hipGetDevice(&dev) != hipSuccess || hipDeviceGetAttribute(&cus, hipDeviceAttributeMultiprocessorCount, dev) != hipSuccess) { grid = -1; return; }
        if (hipFuncSetAttribute((const void*)fwd, hipFuncAttributeMaxDynamicSharedMemorySize, LDS_BYTES) != hipSuccess) { fprintf(stderr, "kernel_launch: hipFuncSetAttribute failed\n"); grid = -1; return; }
        if (hipOccupancyMaxActiveBlocksPerMultiprocessor(&per_cu, (const void*)fwd, NTHREADS, LDS_BYTES) != hipSuccess || per_cu < 1) fprintf(stderr, "kernel_launch: occupancy query says %d\n", per_cu);
        (void)hipGetLastError();
        grid = cus;
    }
    if (grid < 0) return;
    if (hipMemsetAsync((char*)d_ws + WS_CTL, 0, CTL_ZERO_BYTES, stream) != hipSuccess) return;
    Args a{};
    a.x = (const float*)d_in[0]; a.ln1_g = (const float*)d_in[1]; a.w_in = (const float*)d_in[2]; a.mix_g = (const float*)d_in[3]; a.w_out = (const float*)d_in[4]; a.ln2_g = (const float*)d_in[5];
    a.w_gr = (const float*)d_in[6]; a.b_gr = (const float*)d_in[7]; a.w_er = (const float*)d_in[8]; a.b_er = (const float*)d_in[9]; a.w_gate = (const float*)d_in[10]; a.w_up = (const float*)d_in[11];
    a.w_down = (const float*)d_in[12]; a.fin_g = (const float*)d_in[13];
    a.out = (float*)d_out; a.ws = (unsigned char*)d_ws; a.pad = 0;
#if N_LAUNCH_MODE == 1
    a.ph_lo = 0; a.ph_hi = PH_COUNT; a.li = 0;
    hipLaunchKernelGGL(fwd, dim3(grid), dim3(NTHREADS), LDS_BYTES, stream, a);
#else
    for (int p = 0; p < PH_COUNT; ++p) { a.ph_lo = p; a.ph_hi = p + 1; a.li = p; hipLaunchKernelGGL(fwd, dim3(grid), dim3(NTHREADS), LDS_BYTES, stream, a); }
#endif
}
```

```cpp
#include <hip/hip_runtime.h>
#include <cstdio>
#include <cstdint>

#define LAS __attribute__((address_space(3)))
#define GAS __attribute__((address_space(1)))
typedef unsigned short bf16_t;
typedef short bf16x8 __attribute__((ext_vector_type(8)));
typedef float f32x4 __attribute__((ext_vector_type(4)));
typedef float f32x2 __attribute__((ext_vector_type(2)));
typedef unsigned u32x4 __attribute__((ext_vector_type(4)));
typedef unsigned u32x2 __attribute__((ext_vector_type(2)));

#ifndef PROBE_REPEAT
#define PROBE_REPEAT 0
#endif
#define RPT(k) ((((PROBE_REPEAT) >> (k)) & 1) ? 2 : 1)
#ifndef MOE_SPARSE
#define MOE_SPARSE 1
#endif
#ifndef ATT_MOBA
#define ATT_MOBA 1
#endif
#ifndef ATT_SB
#define ATT_SB 1
#endif
#ifndef ATT_DIL
#define ATT_DIL 1
#endif
constexpr int BATCH = 4, SEQ = 8192, DM = 1024, DEPTH = 4, T = BATCH * SEQ, NH = 16, HD = 64;
constexpr int NQKV = 3 * DM, NEXP = 16, DEXP = 256, NACT = NEXP * DEXP;
constexpr float NORM_EPS = 1e-6f;
constexpr float LOG2E = 1.4426950408889634f;
constexpr float QSCALE = 0.125f * LOG2E;
constexpr int NWAVES = 8, NTHREADS = 512;

constexpr size_t MiB = 1u << 20;
constexpr size_t WS_CTL = 0, CTL_ZERO_BYTES = 1 * MiB;
constexpr size_t WS_WIN = 2 * MiB;
constexpr size_t WS_WOUT = 26 * MiB;
constexpr size_t WS_WG = 34 * MiB;
constexpr size_t WS_WU = 66 * MiB;
constexpr size_t WS_WD = 98 * MiB;
constexpr size_t WS_LSEM0 = 1 * MiB;
constexpr size_t WS_KMEAN = 130 * MiB;
constexpr size_t WS_HB = 131 * MiB;
constexpr size_t WS_Q = 195 * MiB, WS_K = 259 * MiB, WS_V = 323 * MiB, WS_XB = 387 * MiB;
constexpr size_t WS_ACT = WS_Q;
constexpr size_t WS_LSE = 451 * MiB;
constexpr size_t WS_LIST = 454 * MiB;
constexpr size_t WS_WLIST = 457 * MiB;
constexpr size_t WS_QLIST = WS_LIST;
constexpr size_t WS_PM = 463 * MiB;
constexpr size_t WS_LSEM1 = 511 * MiB;
constexpr size_t WS_END = 512 * MiB;
constexpr int QL_PER_BH = 126976;
constexpr int CW_GDONE = 1536;
constexpr int CW_MCNT = 2048;
constexpr int CW_CNT = 1024;
constexpr int CW_TCNT = 16384;
constexpr int CW_BAR = 4096;

constexpr int RING_BYTES = 131072;
constexpr int LDSCTL_OFF = 147456, MISC_OFF = LDSCTL_OFF + 320;
constexpr int LDS_BYTES = 148480;

__device__ __forceinline__ unsigned f2bf(float f) { unsigned u = __builtin_bit_cast(unsigned, f); return (u + 0x7fffu + ((u >> 16) & 1u)) >> 16; }
__device__ __forceinline__ unsigned pk2(float lo, float hi) { return f2bf(lo) | (f2bf(hi) << 16); }
__device__ __forceinline__ float bflo(unsigned w) { return __builtin_bit_cast(float, w << 16); }
__device__ __forceinline__ float bfhi(unsigned w) { return __builtin_bit_cast(float, w & 0xffff0000u); }
template <int M> __device__ __forceinline__ float swz_xor(float v) { return __builtin_bit_cast(float, __builtin_amdgcn_ds_swizzle(__builtin_bit_cast(int, v), 0x1f | (M << 10))); }
__device__ __forceinline__ void swap32(unsigned x, unsigned& lo_val, unsigned& hi_val) { unsigned y = x; asm volatile("" : "+v"(y)); auto rr = __builtin_amdgcn_permlane32_swap(x, y, false, false); lo_val = rr[0]; hi_val = rr[1]; }
__device__ __forceinline__ float sum_xor32(float v) { unsigned a, b; swap32(__builtin_bit_cast(unsigned, v), a, b); return __builtin_bit_cast(float, a) + __builtin_bit_cast(float, b); }
__device__ __forceinline__ float max_xor32(float v) { unsigned a, b; swap32(__builtin_bit_cast(unsigned, v), a, b); return fmaxf(__builtin_bit_cast(float, a), __builtin_bit_cast(float, b)); }
__device__ __forceinline__ float get_xor32(float v, int hi) { unsigned a, b; swap32(__builtin_bit_cast(unsigned, v), a, b); return __builtin_bit_cast(float, hi ? a : b); }
__device__ __forceinline__ int get_xor32i(int v, int hi) { unsigned a, b; swap32((unsigned)v, a, b); return (int)(hi ? a : b); }
template <int CTRL> __device__ __forceinline__ float dpp_mov(float v) { return __builtin_bit_cast(float, __builtin_amdgcn_update_dpp(0, __builtin_bit_cast(int, v), CTRL, 0xf, 0xf, false)); }
__device__ __forceinline__ float row_sum(float v) { v += dpp_mov<0xB1>(v); v += dpp_mov<0x4E>(v); v += dpp_mov<0x141>(v); v += dpp_mov<0x140>(v); return v; }
__device__ __forceinline__ float half_sum(float v) { v = row_sum(v); v += swz_xor<16>(v); return v; }
__device__ __forceinline__ float wave_sum(float v) { return sum_xor32(half_sum(v)); }
#define LDS_WAIT() asm volatile("s_waitcnt lgkmcnt(0)" ::: "memory")
#define LAUNDER_V(x) asm volatile("" : "+v"(x))
#define LAUNDER_S(x) asm volatile("" : "+s"(x))

namespace pg8 {
constexpr int BM = 256, BK = 64, HALF = 128, HTB = HALF * BK * 2, STAGE_BYTES = 8 * HTB, NXCD = 8, WGM = 8;
__host__ __device__ __forceinline__ int lds_byte(int r, int c) { const int st = (r >> 4) * 2 + (c >> 5), rr = r & 15, cc = c & 31, ob = rr * 64 + cc * 2; return st * 1024 + (ob ^ (((ob >> 9) & 1) << 5)); }
__host__ __device__ __forceinline__ void stage_rc(int b, int& R, int& C) { const int st = b / 1024, sb = b % 1024, swz = sb ^ (((sb >> 9) & 1) << 5); R = (st >> 1) * 16 + swz / 64; C = (st & 1) * 32 + (swz % 64) / 2; }
__host__ __device__ __forceinline__ int perm32(int rho) { const int n = rho >> 4, i = rho & 15; return 8 * (i >> 2) + 4 * n + (i & 3); }

struct Unit { int pm, pn, meta;
    __device__ __forceinline__ int bk() const { return meta & 31; } __device__ __forceinline__ int tib() const { return (meta >> 5) & 255; } __device__ __forceinline__ int nb() const { return meta >> 13; } };
struct Gemm { const char* A; const char* B; int lda, ldb, K; long tstepA, tstepB, hstepB; };

struct StaticOrder {
    int nM, nN, nwg, G, c;
    __host__ __device__ void init(int nM_, int nN_, int G_, int c_) { nM = nM_; nN = nN_; nwg = nM * nN; G = G_; c = c_; }
    __host__ __device__ bool next(int i, Unit& u) const {
        const long L = (long)i * G + c; if (L >= nwg) return false;
        int wgid = (int)L; { const int q = nwg / NXCD, r = nwg % NXCD, xcd = wgid % NXCD, off = wgid / NXCD; wgid = (xcd < r ? xcd * (q + 1) : r * (q + 1) + (xcd - r) * q) + off; }
        const int nig = WGM * nN, gid = wgid / nig, fm = gid * WGM, gsz = (nM - fm) < WGM ? (nM - fm) : WGM;
        u.pm = fm + ((wgid % nig) % gsz); u.pn = (wgid % nig) / gsz; return true;
    }
};

__device__ __forceinline__ unsigned cvt_pk_bf16(float lo, float hi) { unsigned r; asm volatile("v_cvt_pk_bf16_f32 %0, %1, %2" : "=v"(r) : "v"(lo), "v"(hi)); return r; }

struct EpiQKV {
    static constexpr bool PERM = true;
    bf16_t* O; size_t split_stride; float scale0;
    __device__ __forceinline__ void operator()(const f32x4 (&acc)[2][2][4][2], const Unit& u, int wr, int wc, int fr, int fq) const {
        asm volatile("" : "+v"(fr), "+v"(fq));
        const int row0 = u.pm * BM + wr * 64 + fr; int colt = u.pn * BM;
        const int t = colt / DM; bf16_t* base = O + (size_t)t * split_stride; colt -= t * DM; const float sc = (t == 0) ? scale0 : 1.f;
        const int col0 = colt + wc * 32 + 8 * fq;
#pragma unroll
        for (int ai = 0; ai < 2; ++ai)
#pragma unroll
            for (int m = 0; m < 4; ++m) { bf16_t* rowp = base + (size_t)(row0 + ai * HALF + m * 16) * DM + col0;
#pragma unroll
                for (int bj = 0; bj < 2; ++bj) { f32x4 v0 = acc[ai][bj][m][0] * sc, v1 = acc[ai][bj][m][1] * sc;
                    u32x4 w; w.x = cvt_pk_bf16(v0[0], v0[1]); w.y = cvt_pk_bf16(v0[2], v0[3]); w.z = cvt_pk_bf16(v1[0], v1[1]); w.w = cvt_pk_bf16(v1[2], v1[3]);
                    *(u32x4*)(rowp + bj * HALF) = w; } }
        if (u.pn == 4) {
            float* kmean = (float*)((unsigned char*)O - WS_Q + WS_KMEAN) + ((size_t)((u.pm >> 5) * 4) * 32 + (u.pm & 31)) * HD;
#pragma unroll
            for (int bj = 0; bj < 2; ++bj)
#pragma unroll
                for (int n = 0; n < 2; ++n)
#pragma unroll
                    for (int j = 0; j < 4; ++j) { float cs = 0.f;
#pragma unroll
                        for (int ai = 0; ai < 2; ++ai)
#pragma unroll
                            for (int m = 0; m < 4; ++m) cs += acc[ai][bj][m][n][j];
                        cs = row_sum(cs);
                        const int col = bj * HALF + wc * 32 + 8 * fq + 4 * n + j;
                        if (fr == 0) __hip_atomic_fetch_add(kmean + (size_t)(col >> 6) * 32 * HD + (col & 63), cs, __ATOMIC_RELAXED, __HIP_MEMORY_SCOPE_AGENT); }
        }
    }
};
struct EpiResAdd {
    static constexpr bool PERM = true;
    bf16_t* xb;
    __device__ __forceinline__ void operator()(const f32x4 (&acc)[2][2][4][2], const Unit& u, int wr, int wc, int fr, int fq) const {
        asm volatile("" : "+v"(fr), "+v"(fq));
        const int col0 = u.pn * BM + wc * 32 + 8 * fq;
#pragma unroll
        for (int ai = 0; ai < 2; ++ai) { u32x4 r[4][2];
#pragma unroll
            for (int m = 0; m < 4; ++m) { const bf16_t* rowp = xb + (size_t)(u.pm * BM + ai * HALF + wr * 64 + m * 16 + fr) * DM + col0;
#pragma unroll
                for (int bj = 0; bj < 2; ++bj) r[m][bj] = *(const u32x4*)(rowp + bj * HALF); }
#pragma unroll
            for (int m = 0; m < 4; ++m) { bf16_t* rowp = xb + (size_t)(u.pm * BM + ai * HALF + wr * 64 + m * 16 + fr) * DM + col0;
#pragma unroll
                for (int bj = 0; bj < 2; ++bj) { const f32x4 v0 = acc[ai][bj][m][0], v1 = acc[ai][bj][m][1]; const u32x4 q = r[m][bj];
                    u32x4 w; w.x = cvt_pk_bf16(bflo(q.x) + v0[0], bfhi(q.x) + v0[1]); w.y = cvt_pk_bf16(bflo(q.y) + v0[2], bfhi(q.y) + v0[3]);
                    w.z = cvt_pk_bf16(bflo(q.z) + v1[0], bfhi(q.z) + v1[1]); w.w = cvt_pk_bf16(bflo(q.w) + v1[2], bfhi(q.w) + v1[3]);
                    *(u32x4*)(rowp + bj * HALF) = w; } } }
    }
};
struct EpiGateUpDense {
    static constexpr bool PERM = true;
    bf16_t* act; const float* comb;
    __device__ __forceinline__ void operator()(const f32x4 (&acc)[2][2][4][2], const Unit& u, int wr, int wc, int fr, int fq) const {
        asm volatile("" : "+v"(fr), "+v"(fq));
        const int e = u.pn >> 1, c0 = (u.pn & 1) * HALF;
        const int col0 = e * DEXP + c0 + wc * 32 + 8 * fq;
#pragma unroll
        for (int ai = 0; ai < 2; ++ai)
#pragma unroll
            for (int m = 0; m < 4; ++m) { const int row = u.pm * BM + ai * HALF + wr * 64 + m * 16 + fr;
                const float cw = comb[(size_t)row * NEXP + e];
                float o[8];
#pragma unroll
                for (int n = 0; n < 2; ++n)
#pragma unroll
                    for (int j = 0; j < 4; ++j) { const float g = acc[ai][0][m][n][j], up = acc[ai][1][m][n][j];
                        const float sg = g * __builtin_amdgcn_rcpf(1.f + __builtin_amdgcn_exp2f(-g * LOG2E));
                        o[n * 4 + j] = sg * up * cw; }
                u32x4 w; w.x = cvt_pk_bf16(o[0], o[1]); w.y = cvt_pk_bf16(o[2], o[3]); w.z = cvt_pk_bf16(o[4], o[5]); w.w = cvt_pk_bf16(o[6], o[7]);
                *(u32x4*)(act + (size_t)row * NACT + col0) = w; }
    }
};

template <class Epi, class Sched>
__device__ __forceinline__ void gemm_phase(LAS unsigned char* lds, const Gemm g, const Sched& S, const Epi& E, int wave_id) {
    int lane_l = (int)__builtin_amdgcn_mbcnt_hi(~0u, __builtin_amdgcn_mbcnt_lo(~0u, 0u)); asm volatile("" : "+v"(lane_l));
    const int wid = wave_id, lane = lane_l, tid = wid * 64 + lane, wr = wid >> 2, wc = wid & 3, fr = lane & 15, fq = lane >> 4;
    const int K = g.K, nt = K / BK;
    unsigned voffA[2], voffB[2];
#pragma unroll
    for (int i = 0; i < 2; ++i) { int R, C; stage_rc(tid * 16 + i * 8192, R, C); const int Rb = Epi::PERM ? ((R & ~31) + perm32(R & 31)) : R;
        voffA[i] = (unsigned)(R * g.lda + C) * 2u; voffB[i] = (unsigned)(Rb * g.ldb + C) * 2u; }
    const size_t kstep = (size_t)(BK * 2);
    const size_t hstepA = (size_t)HALF * g.lda * 2;
    const long hstepB = g.hstepB;
    const unsigned ldsw = (unsigned)wid * 1024u;
    const int aoff = lds_byte(wr * 64 + fr, fq * 8), boff = lds_byte(wc * 32 + fr, fq * 8);
#define PG8_SA(b, h) (((b) * 2 + (h)) * HTB)
#define PG8_SB(b, h) ((4 + (b) * 2 + (h)) * HTB)
#define PG8_STAGE(bufoff, gbase, voff) do { _Pragma("unroll") for (int _i = 0; _i < 2; ++_i) \
        __builtin_amdgcn_global_load_lds((const unsigned*)((const char*)(gbase) + (voff)[_i]), (LAS unsigned*)(lds + (bufoff) + ldsw + _i * 8192), 16, 0, 0); } while (0)
#define PG8_LDA(dst, b, h) do { _Pragma("unroll") for (int m = 0; m < 4; ++m) _Pragma("unroll") for (int k = 0; k < 2; ++k) dst[m][k] = *(const LAS bf16x8*)(lds + PG8_SA(b, h) + aoff + m * 2048 + k * 1024); } while (0)
#define PG8_LDB(dst, b, h) do { _Pragma("unroll") for (int n = 0; n < 2; ++n) _Pragma("unroll") for (int k = 0; k < 2; ++k) dst[n][k] = *(const LAS bf16x8*)(lds + PG8_SB(b, h) + boff + n * 2048 + k * 1024); } while (0)
#define PG8_MMA(ai, bj, At, Bt) do { __builtin_amdgcn_s_setprio(1); _Pragma("unroll") for (int m = 0; m < 4; ++m) _Pragma("unroll") for (int n = 0; n < 2; ++n) _Pragma("unroll") for (int k = 0; k < 2; ++k) \
        acc[ai][bj][m][n] = __builtin_amdgcn_mfma_f32_16x16x32_bf16(Bt[n][k], At[m][k], acc[ai][bj][m][n], 0, 0, 0); __builtin_amdgcn_s_setprio(0); } while (0)
#define PG8_WAIT_V(n) asm volatile("s_waitcnt vmcnt(" #n ")" ::: "memory")
#define PG8_WAIT_L(n) asm volatile("s_waitcnt lgkmcnt(" #n ")" ::: "memory")
#define PG8_BAR __builtin_amdgcn_s_barrier()
#define PG8_SCHED __builtin_amdgcn_sched_barrier(0)
    Unit cur, nxt; int ui = 0;
    if (!S.next(0, cur)) return;
    f32x4 acc[2][2][4][2];
#pragma unroll
    for (int a = 0; a < 2; ++a)
#pragma unroll
        for (int b = 0; b < 2; ++b)
#pragma unroll
            for (int m = 0; m < 4; ++m)
#pragma unroll
                for (int n = 0; n < 2; ++n) acc[a][b][m][n] = (f32x4){0.f, 0.f, 0.f, 0.f};
    bf16x8 At[4][2], B0[2][2], B1[2][2];
    const char* cA = g.A + (size_t)cur.pm * g.tstepA; const char* cB = g.B + (size_t)cur.pn * g.tstepB;
    PG8_STAGE(PG8_SB(0, 0), cB, voffB); PG8_STAGE(PG8_SB(0, 1), cB + hstepB, voffB); PG8_STAGE(PG8_SA(0, 0), cA, voffA); PG8_STAGE(PG8_SA(0, 1), cA + hstepA, voffA);
    if (wr == 1) PG8_BAR;
    PG8_WAIT_V(2); PG8_BAR;
    PG8_STAGE(PG8_SB(1, 0), cB + kstep, voffB); PG8_STAGE(PG8_SA(1, 0), cA + kstep, voffA); PG8_STAGE(PG8_SB(1, 1), cB + hstepB + kstep, voffB);
    PG8_WAIT_V(6); PG8_BAR;
    for (;;) {
        const bool has_next = S.next(ui + 1, nxt);
        const char* nA = has_next ? g.A + (size_t)nxt.pm * g.tstepA : cA; const char* nB = has_next ? g.B + (size_t)nxt.pn * g.tstepB : cB;
        for (int t = 0; t < nt; t += 2) {
            const bool last = (t == nt - 2);
            const char* a1 = cA + (size_t)(t + 1) * kstep;
            const char* a2 = last ? nA : cA + (size_t)(t + 2) * kstep; const char* b2 = last ? nB : cB + (size_t)(t + 2) * kstep;
            const char* a3 = a2 + kstep; const char* b3 = b2 + kstep;
            PG8_LDB(B0, 0, 0); PG8_LDB(B1, 0, 1); PG8_SCHED; PG8_LDA(At, 0, 0); PG8_STAGE(PG8_SA(1, 1), a1 + hstepA, voffA);
            PG8_WAIT_V(8); PG8_WAIT_L(0); PG8_BAR; PG8_MMA(0, 0, At, B0); PG8_MMA(0, 1, At, B1); PG8_BAR; PG8_SCHED;
            PG8_LDA(At, 0, 1); PG8_STAGE(PG8_SB(0, 0), b2, voffB); PG8_STAGE(PG8_SB(0, 1), b2 + hstepB, voffB); PG8_STAGE(PG8_SA(0, 0), a2, voffA);
            PG8_WAIT_V(8); PG8_WAIT_L(0); PG8_BAR; PG8_MMA(1, 0, At, B0); PG8_MMA(1, 1, At, B1); PG8_BAR; PG8_SCHED;
            PG8_LDB(B0, 1, 0); PG8_LDB(B1, 1, 1); PG8_SCHED; PG8_LDA(At, 1, 0); PG8_STAGE(PG8_SA(0, 1), a2 + hstepA, voffA);
            PG8_WAIT_V(8); PG8_WAIT_L(0); PG8_BAR; PG8_MMA(0, 0, At, B0); PG8_MMA(0, 1, At, B1); PG8_BAR; PG8_SCHED;
            PG8_LDA(At, 1, 1); PG8_STAGE(PG8_SB(1, 0), b3, voffB); PG8_STAGE(PG8_SB(1, 1), b3 + hstepB, voffB); PG8_STAGE(PG8_SA(1, 0), a3, voffA);
            PG8_WAIT_V(8); PG8_WAIT_L(0); PG8_BAR; PG8_MMA(1, 0, At, B0); PG8_MMA(1, 1, At, B1); PG8_BAR; PG8_SCHED;
        }
        if (wr == 0) PG8_BAR;
        E(acc, cur, wr, wc, fr, fq);
        if (!has_next) break;
#pragma unroll
        for (int a = 0; a < 2; ++a)
#pragma unroll
            for (int b = 0; b < 2; ++b)
#pragma unroll
                for (int m = 0; m < 4; ++m)
#pragma unroll
                    for (int n = 0; n < 2; ++n) acc[a][b][m][n] = (f32x4){0.f, 0.f, 0.f, 0.f};
        cur = nxt; cA = nA; cB = nB; ++ui;
        if (wr == 1) PG8_BAR;
    }
    PG8_WAIT_V(0);
    PG8_BAR;
#undef PG8_SA
#undef PG8_SB
#undef PG8_STAGE
#undef PG8_LDA
#undef PG8_LDB
#undef PG8_MMA
#undef PG8_WAIT_V
#undef PG8_WAIT_L
#undef PG8_BAR
#undef PG8_SCHED
}
template <class Epi, class Prob>
__device__ __forceinline__ void gemm_phase_x(LAS unsigned char* lds, const Prob& P, const Epi& E, int wave_id) {
    int lane_l = (int)__builtin_amdgcn_mbcnt_hi(~0u, __builtin_amdgcn_mbcnt_lo(~0u, 0u)); asm volatile("" : "+v"(lane_l));
    const int wid = wave_id, lane = lane_l, tid = wid * 64 + lane, wr = wid >> 2, wc = wid & 3, fr = lane & 15, fq = lane >> 4;
    const int K = P.K, nt = K / BK;
    unsigned voffB[2];
#pragma unroll
    for (int i = 0; i < 2; ++i) { int R, C; stage_rc(tid * 16 + i * 8192, R, C); const int Rb = Epi::PERM ? ((R & ~31) + perm32(R & 31)) : R; voffB[i] = (unsigned)(Rb * P.ldb + C) * 2u; }
    const size_t kstep = (size_t)(BK * 2);
    const long hstepB = P.hstepB;
    const unsigned ldsw = (unsigned)wid * 1024u;
    const int aoff = lds_byte(wr * 64 + fr, fq * 8), boff = lds_byte(wc * 32 + fr, fq * 8);
    LAS u32x4* stash = (LAS u32x4*)(lds + STAGE_BYTES + 1024) + tid;
#define PG8_SA(b, h) (((b) * 2 + (h)) * HTB)
#define PG8_SB(b, h) ((4 + (b) * 2 + (h)) * HTB)
#define PG8_STAGE(bufoff, gbase, voff) do { _Pragma("unroll") for (int _i = 0; _i < 2; ++_i) \
        __builtin_amdgcn_global_load_lds((const unsigned*)((const char*)(gbase) + (voff)[_i]), (LAS unsigned*)(lds + (bufoff) + ldsw + _i * 8192), 16, 0, 0); } while (0)
#define PG8_LDA(dst, b, h) do { _Pragma("unroll") for (int m = 0; m < 4; ++m) _Pragma("unroll") for (int k = 0; k < 2; ++k) dst[m][k] = *(const LAS bf16x8*)(lds + PG8_SA(b, h) + aoff + m * 2048 + k * 1024); } while (0)
#define PG8_LDB(dst, b, h) do { _Pragma("unroll") for (int n = 0; n < 2; ++n) _Pragma("unroll") for (int k = 0; k < 2; ++k) dst[n][k] = *(const LAS bf16x8*)(lds + PG8_SB(b, h) + boff + n * 2048 + k * 1024); } while (0)
#define PG8_MMA(ai, bj, At, Bt) do { __builtin_amdgcn_s_setprio(1); _Pragma("unroll") for (int m = 0; m < 4; ++m) _Pragma("unroll") for (int n = 0; n < 2; ++n) _Pragma("unroll") for (int k = 0; k < 2; ++k) \
        acc[ai][bj][m][n] = __builtin_amdgcn_mfma_f32_16x16x32_bf16(Bt[n][k], At[m][k], acc[ai][bj][m][n], 0, 0, 0); __builtin_amdgcn_s_setprio(0); } while (0)
#define PG8_WAIT_V(n) asm volatile("s_waitcnt vmcnt(" #n ")" ::: "memory")
#define PG8_WAIT_L(n) asm volatile("s_waitcnt lgkmcnt(" #n ")" ::: "memory")
#define PG8_BAR __builtin_amdgcn_s_barrier()
#define PG8_SCHED __builtin_amdgcn_sched_barrier(0)
#define PG8_AVOFF(dst, u) do { int t2_ = tid; asm volatile("" : "+v"(t2_)); _Pragma("unroll") for (int i_ = 0; i_ < 2; ++i_) { int R_, C_; stage_rc(t2_ * 16 + i_ * 8192, R_, C_); _Pragma("unroll") for (int h_ = 0; h_ < 2; ++h_) \
        dst[h_][i_] = (Prob::GATHER ? P.arow_off(u, h_, R_) : (unsigned)((h_ * HALF + R_) * P.lda) * 2u) + (unsigned)C_ * 2u; } } while (0)
    Unit cur, nxt; int ui = 0;
    if (!P.next(0, cur)) return;
    unsigned vA[2][2];
    PG8_AVOFF(vA, cur);
    f32x4 acc[2][2][4][2];
#pragma unroll
    for (int a = 0; a < 2; ++a)
#pragma unroll
        for (int b = 0; b < 2; ++b)
#pragma unroll
            for (int m = 0; m < 4; ++m)
#pragma unroll
                for (int n = 0; n < 2; ++n) acc[a][b][m][n] = (f32x4){0.f, 0.f, 0.f, 0.f};
    bf16x8 At[4][2], B0[2][2], B1[2][2];
    const char* cA = P.a_base(cur); const char* cB = P.b_base(cur);
    long csplit = Prob::KSPLIT ? P.bsplit(cur) : 0;
    if (Prob::WAITS) P.a_ready(cur, wid);
    PG8_STAGE(PG8_SB(0, 0), cB, voffB); PG8_STAGE(PG8_SB(0, 1), cB + hstepB, voffB); PG8_STAGE(PG8_SA(0, 0), cA, vA[0]); PG8_STAGE(PG8_SA(0, 1), cA, vA[1]);
    if (wr == 1) PG8_BAR;
    PG8_WAIT_V(2); PG8_BAR;
    PG8_STAGE(PG8_SB(1, 0), cB + kstep, voffB); PG8_STAGE(PG8_SA(1, 0), cA + kstep, vA[0]); PG8_STAGE(PG8_SB(1, 1), cB + hstepB + kstep, voffB);
    PG8_WAIT_V(6); PG8_BAR;
    for (;;) {
        const bool has_next = P.next(ui + 1, nxt);
        const char* nA = has_next ? P.a_base(nxt) : cA; const char* nB = has_next ? P.b_base(nxt) : cB;
        if (Prob::GATHER) { unsigned vN[2][2];
            if (has_next) { PG8_AVOFF(vN, nxt); } else { vN[0][0] = vA[0][0]; vN[0][1] = vA[0][1]; vN[1][0] = vA[1][0]; vN[1][1] = vA[1][1]; }
            *stash = (u32x4){vN[0][0], vN[0][1], vN[1][0], vN[1][1]}; }
        for (int t = 0; t < nt; t += 2) {
            const bool last = (t == nt - 2);
            if (Prob::WAITS && last && has_next) P.a_ready(nxt, wid);
            const char* a1 = cA + (size_t)(t + 1) * kstep;
            const char* a2 = last ? nA : cA + (size_t)(t + 2) * kstep;
            const char* b2 = last ? nB : cB + (size_t)(t + 2) * kstep + ((Prob::KSPLIT && (t + 2) >= (nt >> 1)) ? csplit : 0);
            const char* a3 = a2 + kstep; const char* b3 = b2 + kstep;
            PG8_LDB(B0, 0, 0); PG8_LDB(B1, 0, 1); PG8_SCHED; PG8_LDA(At, 0, 0); PG8_STAGE(PG8_SA(1, 1), a1, vA[1]);
            if (Prob::GATHER && last) { const u32x4 sv = *stash; vA[0][0] = sv.x; vA[0][1] = sv.y; vA[1][0] = sv.z; vA[1][1] = sv.w; }
            PG8_WAIT_V(8); PG8_WAIT_L(0); PG8_BAR; PG8_MMA(0, 0, At, B0); PG8_MMA(0, 1, At, B1); PG8_BAR; PG8_SCHED;
            PG8_LDA(At, 0, 1); PG8_STAGE(PG8_SB(0, 0), b2, voffB); PG8_STAGE(PG8_SB(0, 1), b2 + hstepB, voffB); PG8_STAGE(PG8_SA(0, 0), a2, vA[0]);
            PG8_WAIT_V(8); PG8_WAIT_L(0); PG8_BAR; PG8_MMA(1, 0, At, B0); PG8_MMA(1, 1, At, B1); PG8_BAR; PG8_SCHED;
            PG8_LDB(B0, 1, 0); PG8_LDB(B1, 1, 1); PG8_SCHED; PG8_LDA(At, 1, 0); PG8_STAGE(PG8_SA(0, 1), a2, vA[1]);
            PG8_WAIT_V(8); PG8_WAIT_L(0); PG8_BAR; PG8_MMA(0, 0, At, B0); PG8_MMA(0, 1, At, B1); PG8_BAR; PG8_SCHED;
            PG8_LDA(At, 1, 1); PG8_STAGE(PG8_SB(1, 0), b3, voffB); PG8_STAGE(PG8_SB(1, 1), b3 + hstepB, voffB); PG8_STAGE(PG8_SA(1, 0), a3, vA[0]);
            PG8_WAIT_V(8); PG8_WAIT_L(0); PG8_BAR; PG8_MMA(1, 0, At, B0); PG8_MMA(1, 1, At, B1); PG8_BAR; PG8_SCHED;
        }
        if (wr == 0) PG8_BAR;
        E(acc, cur, wr, wc, fr, fq);
        if (!has_next) break;
#pragma unroll
        for (int a = 0; a < 2; ++a)
#pragma unroll
            for (int b = 0; b < 2; ++b)
#pragma unroll
                for (int m = 0; m < 4; ++m)
#pragma unroll
                    for (int n = 0; n < 2; ++n) acc[a][b][m][n] = (f32x4){0.f, 0.f, 0.f, 0.f};
        cur = nxt; cA = nA; cB = nB; ++ui;
        if (Prob::KSPLIT) csplit = P.bsplit(cur);
        if (wr == 1) PG8_BAR;
    }
    PG8_WAIT_V(0);
    PG8_BAR;
#undef PG8_SA
#undef PG8_SB
#undef PG8_STAGE
#undef PG8_LDA
#undef PG8_LDB
#undef PG8_MMA
#undef PG8_WAIT_V
#undef PG8_WAIT_L
#undef PG8_BAR
#undef PG8_SCHED
#undef PG8_AVOFF
}

__device__ __forceinline__ int pair_a(int pi) { return pi < 3 ? 0 : (pi < 5 ? 1 : 2); }
__device__ __forceinline__ int pair_b(int pi) { return pi == 0 ? 1 : ((pi == 1 || pi == 3) ? 2 : 3); }
template <int MODE>
struct MoeProb {
    static constexpr bool GATHER = (MODE == 0), KSPLIT = (MODE == 1);
    const unsigned* cnt; const unsigned* list; const char* A; const char* B; int lda, ldb, K; long hstepB; int G, c; unsigned* tcnt;
    static constexpr bool WAITS = (MODE == 1);
    __device__ __forceinline__ void a_ready(const Unit& u, int wave) const {
        if (MODE == 1) {
            if (wave == 0) { unsigned polls = 0;
                while ((unsigned)__builtin_amdgcn_readfirstlane(__hip_atomic_load(tcnt + 64 * u.pm, __ATOMIC_RELAXED, __HIP_MEMORY_SCOPE_AGENT)) < 32u) {
                    if (++polls > (1u << 20)) break;
                    __builtin_amdgcn_s_sleep(2); }
                __builtin_amdgcn_fence(__ATOMIC_ACQUIRE, "agent");
                asm volatile("s_waitcnt vmcnt(0)" ::: "memory"); }
            asm volatile("" ::: "memory"); __builtin_amdgcn_s_barrier(); asm volatile("" ::: "memory");
        }
    }
    __device__ __forceinline__ bool next(int i, Unit& u) const {
        long L = (long)i * G + c;
        if (MODE == 1) {
            int tot = 0;
            for (int k = 0; k < 24; ++k) tot += ((int)cnt[k] + 255) >> 8;
            const int N = 4 * tot, R = N - 2 * G;
            if (R > 0 && R < G) { if (c < R) { if (i > 0) return false; L = c; } else L = (i == 0) ? c : (long)G + (c - R) + (long)(i - 1) * (G - R); }
            else L = (long)i * G + (G - 1 - c);
        }
        const int tileidx = (int)(L >> 2);
        int accu = 0, bk = -1, tib = 0, nb = 0;
        for (int k = 0; k < 24; ++k) { const int n = (int)cnt[k]; const int tl = (n + 255) >> 8; if (bk < 0 && tileidx < accu + tl) { bk = k; tib = tileidx - accu; nb = n; } accu += tl; }
        if (bk < 0) return false;
        u.pm = tileidx; u.pn = (int)(L & 3); u.meta = bk | (tib << 5) | (nb << 13); return true;
    }
    __device__ __forceinline__ int expert(const Unit& u, int s) const { const int g = u.bk() / 6, pi = u.bk() % 6; return g * 4 + (s ? pair_b(pi) : pair_a(pi)); }
    __device__ __forceinline__ const char* a_base(const Unit& u) const { return MODE == 0 ? A : A + (size_t)u.pm * 256 * lda * 2; }
    __device__ __forceinline__ const char* b_base(const Unit& u) const {
        if (MODE == 0) return B + ((size_t)expert(u, u.pn >> 1) * DEXP + (size_t)(u.pn & 1) * HALF) * ldb * 2;
        return B + (size_t)u.pn * 256 * ldb * 2 + (size_t)expert(u, 0) * DEXP * 2;
    }
    __device__ __forceinline__ unsigned arow_off(const Unit& u, int h, int R) const { const int pos = u.tib() * 256 + h * HALF + R; const unsigned tok = pos < u.nb() ? list[(size_t)u.bk() * T + pos] : 0u; return tok * (unsigned)(lda * 2); }
    __device__ __forceinline__ long bsplit(const Unit& u) const { return ((long)(expert(u, 1) - expert(u, 0)) * DEXP - DEXP) * 2; }
};
struct EpiGateUpSparse {
    static constexpr bool PERM = true;
    bf16_t* act; const float* wlist; const float* rlist; unsigned* tcnt;
    __device__ __forceinline__ void operator()(const f32x4 (&acc)[2][2][4][2], const Unit& u, int wr, int wc, int fr, int fq) const {
        asm volatile("" : "+v"(fr), "+v"(fq));
        const int s = u.pn >> 1, col0 = s * DEXP + (u.pn & 1) * HALF + wc * 32 + 8 * fq;
        const __amdgpu_buffer_rsrc_t rs_act = __builtin_amdgcn_make_buffer_rsrc((void*)act, (short)0, 0x7fffffff, 0x00020000);
#pragma unroll
        for (int ai = 0; ai < 2; ++ai)
#pragma unroll
            for (int m = 0; m < 4; ++m) { const int r = ai * HALF + wr * 64 + m * 16 + fr, pos = u.tib() * 256 + r;
                const float cw = pos < u.nb() ? wlist[((size_t)u.bk() * T + pos) * 2 + s] : 0.f; const float rs = pos < u.nb() ? rlist[(size_t)u.bk() * T + pos] : 0.f;
                float o[8];
#pragma unroll
                for (int n = 0; n < 2; ++n)
#pragma unroll
                    for (int j = 0; j < 4; ++j) { const float g = acc[ai][0][m][n][j] * rs, up = acc[ai][1][m][n][j] * rs;
                        const float sg = g * __builtin_amdgcn_rcpf(1.f + __builtin_amdgcn_exp2f(-g * LOG2E));
                        o[n * 4 + j] = sg * up * cw; }
                u32x4 w; w.x = cvt_pk_bf16(o[0], o[1]); w.y = cvt_pk_bf16(o[2], o[3]); w.z = cvt_pk_bf16(o[4], o[5]); w.w = cvt_pk_bf16(o[6], o[7]);
                __builtin_amdgcn_raw_buffer_store_b128(w, rs_act, (int)((((unsigned)u.pm * 256u + (unsigned)r) * 512u + (unsigned)col0) * 2u), 0, 16);
                if (m & 1) asm volatile("" ::: "memory"); }
        asm volatile("s_waitcnt vmcnt(0)" ::: "memory");
        if ((fr | fq) == 0) __hip_atomic_fetch_add(tcnt + 64 * u.pm, 1u, __ATOMIC_RELAXED, __HIP_MEMORY_SCOPE_AGENT);
    }
};
struct EpiDownScatter {
    static constexpr bool PERM = true;
    bf16_t* xb; const unsigned* list;
    __device__ __forceinline__ void operator()(const f32x4 (&acc)[2][2][4][2], const Unit& u, int wr, int wc, int fr, int fq) const {
        asm volatile("" : "+v"(fr), "+v"(fq));
        const int col0 = u.pn * BM + wc * 32 + 8 * fq;
        unsigned tok[8];
#pragma unroll
        for (int g = 0; g < 8; ++g) { const int pos = u.tib() * 256 + (g >> 2) * HALF + wr * 64 + (g & 3) * 16 + fr; tok[g] = pos < u.nb() ? list[(size_t)u.bk() * T + pos] : 0xffffffffu; }
#pragma unroll
        for (int ai = 0; ai < 2; ++ai) { u32x4 r[4][2];
#pragma unroll
            for (int m = 0; m < 4; ++m) { const unsigned tk = tok[ai * 4 + m]; const bf16_t* rowp = xb + (size_t)(tk != 0xffffffffu ? tk : 0u) * DM + col0;
#pragma unroll
                for (int bj = 0; bj < 2; ++bj) r[m][bj] = *(const u32x4*)(rowp + bj * HALF); }
#pragma unroll
            for (int m = 0; m < 4; ++m) { const unsigned tk = tok[ai * 4 + m];
                if (tk != 0xffffffffu) { bf16_t* rowp = xb + (size_t)tk * DM + col0;
#pragma unroll
                    for (int bj = 0; bj < 2; ++bj) { const f32x4 v0 = acc[ai][bj][m][0], v1 = acc[ai][bj][m][1]; const u32x4 q = r[m][bj];
                        u32x4 w; w.x = cvt_pk_bf16(bflo(q.x) + v0[0], bfhi(q.x) + v0[1]); w.y = cvt_pk_bf16(bflo(q.y) + v0[2], bfhi(q.y) + v0[3]);
                        w.z = cvt_pk_bf16(bflo(q.z) + v1[0], bfhi(q.z) + v1[1]); w.w = cvt_pk_bf16(bflo(q.w) + v1[2], bfhi(q.w) + v1[3]);
                        *(u32x4*)(rowp + bj * HALF) = w; } } } }
    }
};
}

#define XB_TMO      128
#define XB_XCNT(j)  (256  + 64 * (j))
#define XB_XSUB(j)  (1280 + 64 * (j))
#define XB_XGEN(j)  (2304 + 64 * (j))
#define XB_TOP      3328
#define XB_TOPGEN   3392
#define XCD_BAR_WORDS 3456
#define XB_SPIN_CAP (1u << 18)
__device__ __forceinline__ unsigned xb_ld(unsigned* p)              { return __hip_atomic_load(p, __ATOMIC_RELAXED, __HIP_MEMORY_SCOPE_AGENT); }
__device__ __forceinline__ unsigned xb_add(unsigned* p, unsigned v) { return __hip_atomic_fetch_add(p, v, __ATOMIC_RELAXED, __HIP_MEMORY_SCOPE_AGENT); }
__device__ __forceinline__ unsigned xb_xcc_id() { return (unsigned)__builtin_amdgcn_s_getreg((3 << 11) | 20) & 0xFu; }
#define XB_SPIN(cond, bar) do { unsigned _sp = 0; while (cond) { __builtin_amdgcn_s_sleep(1); \
    if ((++_sp & 255u) == 0u) { if (xb_ld(&(bar)[XB_TMO])) break; if (_sp > XB_SPIN_CAP) { atomicAdd(&(bar)[XB_TMO], 1u); break; } } } } while (0)
struct XcdBarrier { unsigned* bar; unsigned x; volatile LAS unsigned* st; int wave; };
__device__ __forceinline__ bool xb_thread0(int wave) { return wave == 0 && __builtin_amdgcn_mbcnt_hi(~0u, __builtin_amdgcn_mbcnt_lo(~0u, 0u)) == 0u; }
__device__ __forceinline__ XcdBarrier xcd_barrier_post(unsigned* bar, volatile LAS unsigned* st, int wave) {
    XcdBarrier b; b.bar = bar; b.x = xb_xcc_id(); b.st = st; b.wave = wave;
    if (xb_thread0(wave)) (void)xb_add(&bar[XB_XCNT(b.x)], 1u);
    return b;
}
__device__ __forceinline__ void xcd_barrier_complete(unsigned* bar, unsigned x, unsigned& nloc, unsigned& nx) {
    const unsigned G = gridDim.x * gridDim.y * gridDim.z;
    unsigned sum, cnt, mine, sp = 0u;
    for (;;) {
        sum = 0u; cnt = 0u; mine = 0u;
#pragma unroll
        for (unsigned j = 0; j < 16; ++j) { const unsigned c = xb_ld(&bar[XB_XCNT(j)]); sum += c; cnt += (c > 0u) ? 1u : 0u; mine = (j == x) ? c : mine; }
        if (sum == G) break;
        __builtin_amdgcn_s_sleep(1);
        if ((++sp & 255u) == 0u) { if (xb_ld(&bar[XB_TMO])) break; if (sp > XB_SPIN_CAP) { atomicAdd(&bar[XB_TMO], 1u); break; } }
    }
    nloc = mine > 0u ? mine : 1u; nx = cnt > 0u ? cnt : 1u;
}
__device__ __forceinline__ void xcd_barrier(const XcdBarrier& b) {
    asm volatile("s_waitcnt vmcnt(0)" ::: "memory");
    __syncthreads();
    if (xb_thread0(b.wave)) {
        unsigned* bar = b.bar;
        __builtin_amdgcn_s_waitcnt(0);
        unsigned nloc = b.st[0], nx = b.st[1];
        if (nloc == 0u) { xcd_barrier_complete(bar, b.x, nloc, nx); b.st[0] = nloc; b.st[1] = nx; }
        const unsigned old = xb_add(&bar[XB_XSUB(b.x)], 1u);
        const unsigned gen = old / nloc;
        if (old + 1u == (gen + 1u) * nloc) {
            __builtin_amdgcn_fence(__ATOMIC_RELEASE, "agent");
            asm volatile("s_waitcnt vmcnt(0)" ::: "memory");
            const unsigned og = xb_add(&bar[XB_TOP], 1u);
            const unsigned tg = og / nx;
            if (og + 1u == (tg + 1u) * nx) xb_add(&bar[XB_TOPGEN], 1u);
            else XB_SPIN(xb_ld(&bar[XB_TOPGEN]) == tg, bar);
            __builtin_amdgcn_fence(__ATOMIC_ACQUIRE, "agent");
            xb_add(&bar[XB_XGEN(b.x)], 1u);
            asm volatile("s_waitcnt vmcnt(0)" ::: "memory");
        } else {
            XB_SPIN(xb_ld(&bar[XB_XGEN(b.x)]) == gen, bar);
            __builtin_amdgcn_fence(__ATOMIC_ACQUIRE, "agent");
            asm volatile("s_waitcnt vmcnt(0)" ::: "memory");
        }
    }
    __syncthreads();
}

struct Args {
    const float* x; const float* ln1_g; const float* w_in; const float* mix_g; const float* w_out; const float* ln2_g;
    const float* w_gr; const float* b_gr; const float* w_er; const float* b_er; const float* w_gate; const float* w_up; const float* w_down; const float* fin_g;
    float* out; unsigned char* ws; int ph_lo, ph_hi, li, pad;
};

template <bool SC = false>
__device__ __forceinline__ void transpose_item(const float* W, int K, int N, bf16_t* WT, int dpitch, int dcol, LAS float* scr, int item, int lane, const float* ks = nullptr) {
    const int nblk = N / 32, kb = item / nblk, nb = item % nblk, k0 = 64 * kb, n0 = 32 * nb;
#pragma unroll 8
    for (int i = 0; i < 32; ++i) { const int kk = 2 * i + (lane >> 5); scr[kk * 33 + (lane & 31)] = W[(size_t)(k0 + kk) * N + n0 + (lane & 31)]; }
    LDS_WAIT(); asm volatile("" ::: "memory");
    const int c = lane & 7;
    f32x4 ga = (f32x4){1.f, 1.f, 1.f, 1.f}, gb = ga;
    if (SC) { ga = *(const f32x4*)(ks + k0 + 8 * c); gb = *(const f32x4*)(ks + k0 + 8 * c + 4); }
#pragma unroll
    for (int j = 0; j < 4; ++j) { const int n = (lane >> 3) + 8 * j; const LAS float* s = scr + (8 * c) * 33 + n;
        u32x4 o; o.x = pk2(s[0 * 33] * ga.x, s[1 * 33] * ga.y); o.y = pk2(s[2 * 33] * ga.z, s[3 * 33] * ga.w); o.z = pk2(s[4 * 33] * gb.x, s[5 * 33] * gb.y); o.w = pk2(s[6 * 33] * gb.z, s[7 * 33] * gb.w);
        *(u32x4*)(WT + (size_t)(n0 + n) * dpitch + dcol + k0 + 8 * c) = o; }
    LDS_WAIT(); asm volatile("" ::: "memory");
}
__device__ __forceinline__ void phase_prologue(const Args& a, LAS unsigned char* lds, int gw, int NGW, int wave, int lane) {
    LAS float* scr = (LAS float*)(lds + wave * 16384);
    constexpr int I_IN = (DM / 64) * (NQKV / 32);
    constexpr int I_OUT = (DM / 64) * (DM / 32);
    constexpr int I_G = (DM / 64) * (DEXP / 32);
    constexpr int I_D = (DEXP / 64) * (DM / 32);
    constexpr int N_IN = DEPTH * I_IN, N_OUT = DEPTH * I_OUT, N_G = DEPTH * NEXP * I_G, N_D = DEPTH * NEXP * I_D;
    constexpr int NITEMS = N_IN + N_OUT + 2 * N_G + N_D;
    bf16_t* WinT = (bf16_t*)(a.ws + WS_WIN); bf16_t* WoutT = (bf16_t*)(a.ws + WS_WOUT); bf16_t* WgT = (bf16_t*)(a.ws + WS_WG); bf16_t* WuT = (bf16_t*)(a.ws + WS_WU); bf16_t* WdT = (bf16_t*)(a.ws + WS_WD);
    for (int it = gw; it < NITEMS; it += NGW) {
        int r = it;
        if (r < N_IN) { const int l = r / I_IN; transpose_item(a.w_in + (size_t)l * DM * NQKV, DM, NQKV, WinT + (size_t)l * NQKV * DM, DM, 0, scr, r % I_IN, lane); continue; } r -= N_IN;
        if (r < N_OUT) { const int l = r / I_OUT; transpose_item(a.w_out + (size_t)l * DM * DM, DM, DM, WoutT + (size_t)l * DM * DM, DM, 0, scr, r % I_OUT, lane); continue; } r -= N_OUT;
        if (r < N_G) { const int le = r / I_G; transpose_item<true>(a.w_gate + (size_t)le * DM * DEXP, DM, DEXP, WgT + (size_t)le * DEXP * DM, DM, 0, scr, r % I_G, lane, a.ln2_g + (size_t)(le / NEXP) * DM); continue; } r -= N_G;
        if (r < N_G) { const int le = r / I_G; transpose_item<true>(a.w_up + (size_t)le * DM * DEXP, DM, DEXP, WuT + (size_t)le * DEXP * DM, DM, 0, scr, r % I_G, lane, a.ln2_g + (size_t)(le / NEXP) * DM); continue; } r -= N_G;
        { const int le = r / I_D, l = le / NEXP, e = le % NEXP; transpose_item(a.w_down + (size_t)le * DEXP * DM, DEXP, DM, WdT + (size_t)l * DM * NACT, NACT, e * DEXP, scr, r % I_D, lane); }
    }
}

__device__ __forceinline__ void phase_norm1(const float* x, const float* g, bf16_t* hb, int gw, int NGW, int lane, float* kmean_zero, bf16_t* xb) {
    for (int i = gw * 64 + lane; i < BATCH * 4 * 32 * HD; i += NGW * 64) kmean_zero[i] = 0.f;
    f32x4 gv[4];
#pragma unroll
    for (int j = 0; j < 4; ++j) gv[j] = *((const f32x4*)g + lane + 64 * j);
    for (int m = gw; m < T; m += NGW) {
        const f32x4* xr = (const f32x4*)(x + (size_t)m * DM) + lane;
        f32x4 v[4]; float s = 0.f;
#pragma unroll
        for (int j = 0; j < 4; ++j) { v[j] = xr[64 * j]; s += (v[j].x * v[j].x + v[j].y * v[j].y) + (v[j].z * v[j].z + v[j].w * v[j].w); }
        const float rstd = 1.0f / sqrtf(wave_sum(s) * (1.f / DM) + NORM_EPS);
        u32x2* o8 = (u32x2*)(hb + (size_t)m * DM) + lane; u32x2* x8 = (u32x2*)(xb + (size_t)m * DM) + lane;
#pragma unroll
        for (int j = 0; j < 4; ++j) { u32x2 w; w.x = pk2(v[j].x * rstd * gv[j].x, v[j].y * rstd * gv[j].y); w.y = pk2(v[j].z * rstd * gv[j].z, v[j].w * rstd * gv[j].w); o8[64 * j] = w;
            u32x2 c; c.x = pk2(v[j].x, v[j].y); c.y = pk2(v[j].z, v[j].w); x8[64 * j] = c; }
    }
}
__device__ __forceinline__ void phase_norm1_b(const bf16_t* xb, const float* g, bf16_t* hb, int gw, int NGW, int lane, float* kmean_zero) {
    for (int i = gw * 64 + lane; i < BATCH * 4 * 32 * HD; i += NGW * 64) kmean_zero[i] = 0.f;
    f32x4 gv[4];
#pragma unroll
    for (int j = 0; j < 2; ++j) { gv[2 * j] = *((const f32x4*)g + 2 * lane + 128 * j); gv[2 * j + 1] = *((const f32x4*)g + 2 * lane + 128 * j + 1); }
    for (int m = gw; m < T; m += NGW) {
        const u32x4* xr = (const u32x4*)(xb + (size_t)m * DM) + lane;
        u32x4 r[2]; float s = 0.f;
#pragma unroll
        for (int j = 0; j < 2; ++j) r[j] = xr[64 * j];
        f32x4 v[4];
#pragma unroll
        for (int j = 0; j < 2; ++j) { v[2 * j] = (f32x4){bflo(r[j].x), bfhi(r[j].x), bflo(r[j].y), bfhi(r[j].y)}; v[2 * j + 1] = (f32x4){bflo(r[j].z), bfhi(r[j].z), bflo(r[j].w), bfhi(r[j].w)}; }
#pragma unroll
        for (int j = 0; j < 4; ++j) s += (v[j].x * v[j].x + v[j].y * v[j].y) + (v[j].z * v[j].z + v[j].w * v[j].w);
        const float rstd = 1.0f / sqrtf(wave_sum(s) * (1.f / DM) + NORM_EPS);
        u32x4* o16 = (u32x4*)(hb + (size_t)m * DM) + lane;
#pragma unroll
        for (int j = 0; j < 2; ++j) { const f32x4 a = v[2 * j] * rstd * gv[2 * j], b = v[2 * j + 1] * rstd * gv[2 * j + 1];
            u32x4 w; w.x = pk2(a.x, a.y); w.y = pk2(a.z, a.w); w.z = pk2(b.x, b.y); w.w = pk2(b.z, b.w); o16[64 * j] = w; }
    }
}
__device__ __forceinline__ void unpack8(float (&f)[8], const u32x4 w) { f[0] = bflo(w.x); f[1] = bfhi(w.x); f[2] = bflo(w.y); f[3] = bfhi(w.y); f[4] = bflo(w.z); f[5] = bfhi(w.z); f[6] = bflo(w.w); f[7] = bfhi(w.w); }
struct MixRow { u32x4 a, c0, c1, c2, p0, p1, p2; float l0, l1, l2, e0, e1, e2, e3; };
__device__ __forceinline__ void mix_load(MixRow& r, int m, const bf16_t* ob, const bf16_t* hb, const float* lse, const bf16_t* pm, const float* lsem0, const float* lsem1, int lane, int hh) {
    r.a = *((const u32x4*)(ob + (size_t)m * DM) + lane); r.c0 = *((const u32x4*)(ob + (size_t)m * DM + 512) + lane);
    r.c1 = *((const u32x4*)(hb + (size_t)m * DM) + lane); r.c2 = *((const u32x4*)(hb + (size_t)m * DM + 512) + lane);
    r.l0 = lse[(size_t)m * 8 + hh]; r.l1 = lse[(size_t)T * 8 + (size_t)m * 8 + hh]; r.l2 = lse[(size_t)2 * T * 8 + (size_t)m * 8 + hh];
    if (lane < 32) {
        r.p0 = *((const u32x4*)(pm + (size_t)m * 256) + lane); r.p1 = *((const u32x4*)(pm + ((size_t)T + m) * 256) + lane); r.p2 = *((const u32x4*)(pm + ((size_t)2 * T + m) * 256) + lane);
        r.e0 = lsem0[(size_t)m * 4 + hh]; r.e1 = lsem0[(size_t)T * 4 + (size_t)m * 4 + hh]; r.e2 = lsem1[(size_t)m * 4 + hh]; r.e3 = lsem1[(size_t)T * 4 + (size_t)m * 4 + hh]; }
}
__device__ __forceinline__ void phase_mixnorm(const bf16_t* ob, bf16_t* hb, const float* lse, const bf16_t* pm, const float* lsem0, const float* lsem1, const float* g, int gw, int NGW, int lane) {
    float g0[8], g1[8];
#pragma unroll
    for (int j = 0; j < 8; ++j) { g0[j] = g[8 * lane + j]; g1[j] = g[512 + 8 * lane + j]; }
    const int hh = lane >> 3;
    MixRow cur, nxt;
    if (gw < T) mix_load(cur, gw, ob, hb, lse, pm, lsem0, lsem1, lane, hh);
    for (int m = gw; m < T; m += NGW) {
        if (m + NGW < T) mix_load(nxt, m + NGW, ob, hb, lse, pm, lsem0, lsem1, lane, hh);
        float va[8]; unpack8(va, cur.a);
        if (lane < 32) {
            const float mx = fmaxf(fmaxf(cur.e0, cur.e1), fmaxf(cur.e2, cur.e3));
            float u0 = __builtin_amdgcn_exp2f(cur.e0 - mx), u1 = __builtin_amdgcn_exp2f(cur.e1 - mx), u2 = __builtin_amdgcn_exp2f(cur.e2 - mx), u3 = __builtin_amdgcn_exp2f(cur.e3 - mx);
            const float inv = 1.0f / ((u0 + u1) + (u2 + u3)); u0 *= inv; u1 *= inv; u2 *= inv; u3 *= inv;
            float y0[8], y1[8], y2[8]; unpack8(y0, cur.p0); unpack8(y1, cur.p1); unpack8(y2, cur.p2);
#pragma unroll
            for (int j = 0; j < 8; ++j) va[j] = (u0 * y0[j] + u1 * y1[j]) + (u2 * y2[j] + u3 * va[j]);
        }
        const float mx = fmaxf(cur.l0, fmaxf(cur.l1, cur.l2));
        float w0 = __builtin_amdgcn_exp2f(cur.l0 - mx), w1 = __builtin_amdgcn_exp2f(cur.l1 - mx), w2 = __builtin_amdgcn_exp2f(cur.l2 - mx);
        const float inv = 1.0f / (w0 + w1 + w2); w0 *= inv; w1 *= inv; w2 *= inv;
        float x0[8], x1[8], x2[8]; unpack8(x0, cur.c0); unpack8(x1, cur.c1); unpack8(x2, cur.c2);
        float vc[8];
        float sa = 0.f, sc = 0.f;
#pragma unroll
        for (int j = 0; j < 8; ++j) { vc[j] = w0 * x0[j] + w1 * x1[j] + w2 * x2[j]; sa += va[j] * va[j]; sc += vc[j] * vc[j]; }
        sa = half_sum(sa); sc = wave_sum(sc);
        const float ra = 1.0f / sqrtf(sa * (1.f / 256.f) + NORM_EPS), rc = 1.0f / sqrtf(sc * (1.f / 512.f) + NORM_EPS);
        u32x4 oa, oc;
        oa.x = pk2(va[0] * ra * g0[0], va[1] * ra * g0[1]); oa.y = pk2(va[2] * ra * g0[2], va[3] * ra * g0[3]); oa.z = pk2(va[4] * ra * g0[4], va[5] * ra * g0[5]); oa.w = pk2(va[6] * ra * g0[6], va[7] * ra * g0[7]);
        oc.x = pk2(vc[0] * rc * g1[0], vc[1] * rc * g1[1]); oc.y = pk2(vc[2] * rc * g1[2], vc[3] * rc * g1[3]); oc.z = pk2(vc[4] * rc * g1[4], vc[5] * rc * g1[5]); oc.w = pk2(vc[6] * rc * g1[6], vc[7] * rc * g1[7]);
        *((u32x4*)(hb + (size_t)m * DM) + lane) = oa; *((u32x4*)(hb + (size_t)m * DM + 512) + lane) = oc;
        cur = nxt;
    }
}
__device__ __forceinline__ void phase_route(const bf16_t* x, const float* g, const float* wgr, const float* bgr, const float* wer, const float* ber,
                                            float* rlist, unsigned* cnt, unsigned* list, float* wlist, LAS unsigned char* lds, int v, int G, int wave, int lane) {
    const int tid = wave * 64 + lane;
    LAS f32x4* wl = (LAS f32x4*)lds;
    for (int idx = tid; idx < 5 * DM; idx += NTHREADS) { const int mtx = idx >> 10, d = idx & 1023; const float* src = (mtx == 0 ? wgr : wer + (size_t)(mtx - 1) * DM * 4) + d * 4;
        wl[mtx * 1024 + (d & 3) * 256 + (d >> 2)] = *(const f32x4*)src * g[d]; }
    LAS unsigned* cl = (LAS unsigned*)(lds + 81920);
    LAS u32x2* info = (LAS u32x2*)(lds + 81920 + 256);
    LAS f32x2* infw = (LAS f32x2*)(lds + 81920 + 256 + 4096);
    LAS float* infr = (LAS float*)(lds + 81920 + 256 + 8192);
    if (tid < 64) cl[tid] = 0u;
    __syncthreads();
    const int rpw = (T + G - 1) / G, row0 = v * rpw;
    const f32x4 bg = *(const f32x4*)bgr;
    u32x2 nx[4];
    { const int m0 = row0 + wave; if (wave < rpw && m0 < T) { const u32x2* xr = (const u32x2*)(x + (size_t)m0 * DM) + lane;
#pragma unroll
        for (int j = 0; j < 4; ++j) nx[j] = xr[64 * j]; } }
    for (int r = wave; r < rpw; r += NWAVES) {
        const int m = row0 + r; if (m >= T) break;
        f32x4 vv[4]; float s = 0.f;
#pragma unroll
        for (int j = 0; j < 4; ++j) { vv[j] = (f32x4){bflo(nx[j].x), bfhi(nx[j].x), bflo(nx[j].y), bfhi(nx[j].y)}; s += (vv[j].x * vv[j].x + vv[j].y * vv[j].y) + (vv[j].z * vv[j].z + vv[j].w * vv[j].w); }
        if (r + NWAVES < rpw && m + NWAVES < T) { const u32x2* xr = (const u32x2*)(x + (size_t)(m + NWAVES) * DM) + lane;
#pragma unroll
            for (int j = 0; j < 4; ++j) nx[j] = xr[64 * j]; }
        const float rstd = 1.0f / sqrtf(wave_sum(s) * (1.f / DM) + NORM_EPS);
        f32x4 gl = (f32x4){0.f, 0.f, 0.f, 0.f};
#pragma unroll
        for (int j = 0; j < 4; ++j) { LAS f32x4* wp = wl + lane + 64 * j;
            gl += wp[0] * vv[j].x; gl += wp[256] * vv[j].y; gl += wp[512] * vv[j].z; gl += wp[768] * vv[j].w; }
        gl.x = wave_sum(gl.x) * rstd + bg.x; gl.y = wave_sum(gl.y) * rstd + bg.y; gl.z = wave_sum(gl.z) * rstd + bg.z; gl.w = wave_sum(gl.w) * rstd + bg.w;
        int gi = 0; float gm = gl.x;
        if (gl.y > gm) { gm = gl.y; gi = 1; } if (gl.z > gm) { gm = gl.z; gi = 2; } if (gl.w > gm) { gm = gl.w; gi = 3; }
        const float gden = __expf(gl.x - gm) + __expf(gl.y - gm) + __expf(gl.z - gm) + __expf(gl.w - gm);
        const float gw_ = 1.0f / gden;
        gi = __builtin_amdgcn_readfirstlane(gi);
        f32x4 el = (f32x4){0.f, 0.f, 0.f, 0.f};
#pragma unroll
        for (int j = 0; j < 4; ++j) { LAS f32x4* wp = wl + (1 + gi) * 1024 + lane + 64 * j;
            el += wp[0] * vv[j].x; el += wp[256] * vv[j].y; el += wp[512] * vv[j].z; el += wp[768] * vv[j].w; }
        const f32x4 be = *(const f32x4*)(ber + gi * 4);
        float e[4] = {wave_sum(el.x) * rstd + be.x, wave_sum(el.y) * rstd + be.y, wave_sum(el.z) * rstd + be.z, wave_sum(el.w) * rstd + be.w};
        int i1 = 0; float v1 = e[0];
#pragma unroll
        for (int k = 1; k < 4; ++k) if (e[k] > v1) { v1 = e[k]; i1 = k; }
        int i2 = -1; float v2 = -INFINITY;
#pragma unroll
        for (int k = 0; k < 4; ++k) if (k != i1 && e[k] > v2) { v2 = e[k]; i2 = k; }
        const float p2 = __expf(v2 - v1), inv = 1.0f / (1.0f + p2);
        const float w1 = inv * gw_, w2 = p2 * inv * gw_;
        const int ea = i1 < i2 ? i1 : i2, eb = i1 < i2 ? i2 : i1; const float wa = i1 < i2 ? w1 : w2, wb = i1 < i2 ? w2 : w1;
        const int pi = (ea == 0) ? (eb - 1) : (ea == 1 ? eb + 1 : 5), bk = gi * 6 + pi;
        if (lane == 0) { const unsigned rank = __hip_atomic_fetch_add(cl + bk, 1u, __ATOMIC_RELAXED, __HIP_MEMORY_SCOPE_WORKGROUP);
            info[r] = (u32x2){(unsigned)bk, rank}; infw[r] = (f32x2){wa, wb}; infr[r] = rstd; }
    }
    __syncthreads();
    if (tid < 24) cl[32 + tid] = __hip_atomic_fetch_add(cnt + tid, cl[tid], __ATOMIC_RELAXED, __HIP_MEMORY_SCOPE_AGENT);
    __syncthreads();
    if (tid < rpw && row0 + tid < T) { const u32x2 inf = info[tid]; const f32x2 wv = infw[tid]; const size_t slot = (size_t)inf.x * T + cl[32 + inf.x] + inf.y;
        list[slot] = (unsigned)(row0 + tid); *(f32x2*)(wlist + slot * 2) = wv; rlist[slot] = infr[tid]; }
    __syncthreads();
}
__device__ __forceinline__ void phase_final(const bf16_t* xb, const float* g, float* out, int gw, int NGW, int lane) {
    f32x4 gv[4];
#pragma unroll
    for (int j = 0; j < 2; ++j) { gv[2 * j] = *((const f32x4*)g + 2 * lane + 128 * j); gv[2 * j + 1] = *((const f32x4*)g + 2 * lane + 128 * j + 1); }
    for (int m = gw; m < T; m += NGW) {
        const u32x4* xr = (const u32x4*)(xb + (size_t)m * DM) + lane;
        u32x4 r[2]; float s = 0.f;
#pragma unroll
        for (int j = 0; j < 2; ++j) r[j] = xr[64 * j];
        f32x4 v[4];
#pragma unroll
        for (int j = 0; j < 2; ++j) { v[2 * j] = (f32x4){bflo(r[j].x), bfhi(r[j].x), bflo(r[j].y), bfhi(r[j].y)}; v[2 * j + 1] = (f32x4){bflo(r[j].z), bfhi(r[j].z), bflo(r[j].w), bfhi(r[j].w)}; }
#pragma unroll
        for (int j = 0; j < 4; ++j) s += (v[j].x * v[j].x + v[j].y * v[j].y) + (v[j].z * v[j].z + v[j].w * v[j].w);
        const float rstd = 1.0f / sqrtf(wave_sum(s) * (1.f / DM) + NORM_EPS);
        f32x4* orow = (f32x4*)(out + (size_t)m * DM) + 2 * lane;
#pragma unroll
        for (int j = 0; j < 2; ++j) { orow[128 * j] = v[2 * j] * rstd * gv[2 * j]; orow[128 * j + 1] = v[2 * j + 1] * rstd * gv[2 * j + 1]; }
    }
}
__device__ __forceinline__ void phase_kmean(const bf16_t* kb, float* kmean, int gw, int NGW, int lane) {
    for (int it = gw; it < BATCH * 4 * 32; it += NGW) {
        const int b = it >> 7, h = (it >> 5) & 3, blk = it & 31;
        const bf16_t* base = kb + ((size_t)b * SEQ + (size_t)blk * 256) * DM + h * HD + (lane & 7) * 8;
        float acc[8] = {0.f, 0.f, 0.f, 0.f, 0.f, 0.f, 0.f, 0.f};
#pragma unroll 4
        for (int i = 0; i < 32; ++i) { const u32x4 w = *(const u32x4*)(base + (size_t)((lane >> 3) + 8 * i) * DM);
            acc[0] += bflo(w.x); acc[1] += bfhi(w.x); acc[2] += bflo(w.y); acc[3] += bfhi(w.y); acc[4] += bflo(w.z); acc[5] += bfhi(w.z); acc[6] += bflo(w.w); acc[7] += bfhi(w.w); }
#pragma unroll
        for (int j = 0; j < 8; ++j) { acc[j] += swz_xor<8>(acc[j]); acc[j] += swz_xor<16>(acc[j]); acc[j] = sum_xor32(acc[j]); }
        if (lane < 8) {
            float* o = kmean + (size_t)it * HD + lane * 8;
#pragma unroll
            for (int j = 0; j < 8; ++j) o[j] = acc[j] * (1.f / 256.f);
        }
    }
}

__device__ __forceinline__ void ld_row64(float (&r)[64], const bf16_t* p) {
#pragma unroll
    for (int c = 0; c < 8; ++c) { const u32x4 w = *((const u32x4*)p + c);
        r[8 * c + 0] = bflo(w.x); r[8 * c + 1] = bfhi(w.x); r[8 * c + 2] = bflo(w.y); r[8 * c + 3] = bfhi(w.y); r[8 * c + 4] = bflo(w.z); r[8 * c + 5] = bfhi(w.z); r[8 * c + 6] = bflo(w.w); r[8 * c + 7] = bfhi(w.w); }
}
__device__ __forceinline__ float dot_row64(const float (&q)[64], const bf16_t* p) {
    float s0 = 0.f, s1 = 0.f;
#pragma unroll
    for (int c = 0; c < 8; ++c) { const u32x4 w = *((const u32x4*)p + c);
        s0 += q[8 * c + 0] * bflo(w.x); s1 += q[8 * c + 1] * bfhi(w.x); s0 += q[8 * c + 2] * bflo(w.y); s1 += q[8 * c + 3] * bfhi(w.y);
        s0 += q[8 * c + 4] * bflo(w.z); s1 += q[8 * c + 5] * bfhi(w.z); s0 += q[8 * c + 6] * bflo(w.w); s1 += q[8 * c + 7] * bfhi(w.w); }
    return s0 + s1;
}
__device__ __forceinline__ void axpy_row64(float (&o)[64], float p, const bf16_t* vp) {
#pragma unroll
    for (int c = 0; c < 8; ++c) { const u32x4 w = *((const u32x4*)vp + c);
        o[8 * c + 0] += p * bflo(w.x); o[8 * c + 1] += p * bfhi(w.x); o[8 * c + 2] += p * bflo(w.y); o[8 * c + 3] += p * bfhi(w.y);
        o[8 * c + 4] += p * bflo(w.z); o[8 * c + 5] += p * bfhi(w.z); o[8 * c + 6] += p * bflo(w.w); o[8 * c + 7] += p * bfhi(w.w); }
}
__device__ __forceinline__ void st_row64(bf16_t* p, const float (&o)[64], float sc) {
#pragma unroll
    for (int c = 0; c < 8; ++c) { u32x4 w; w.x = pk2(o[8 * c] * sc, o[8 * c + 1] * sc); w.y = pk2(o[8 * c + 2] * sc, o[8 * c + 3] * sc); w.z = pk2(o[8 * c + 4] * sc, o[8 * c + 5] * sc); w.w = pk2(o[8 * c + 6] * sc, o[8 * c + 7] * sc); *((u32x4*)p + c) = w; }
}
#define OSM_STEP(sc, vrow) do { const float sc_ = (sc); if (sc_ > m_) { const float al = __builtin_amdgcn_exp2f(m_ - sc_); l_ *= al; _Pragma("unroll") for (int d_ = 0; d_ < 64; ++d_) o_[d_] *= al; m_ = sc_; } \
    const float p_ = __builtin_amdgcn_exp2f(sc_ - m_); l_ += p_; axpy_row64(o_, p_, (vrow)); } while (0)

__device__ __forceinline__ void naive_moba(const bf16_t* qb, const bf16_t* kb, const bf16_t* vb, const float* kmean, bf16_t* ob, int item, int tid) {
    const int b = item >> 6, h = (item >> 4) & 3, t = (item & 15) * 512 + tid, own = t >> 8;
    const size_t rowq = ((size_t)b * SEQ + t) * DM + h * HD;
    const bf16_t* kh = kb + (size_t)b * SEQ * DM + h * HD; const bf16_t* vh = vb + (size_t)b * SEQ * DM + h * HD;
    const float slope2 = exp2f(-2.0f * (float)(h + 1)) * LOG2E;
    float q_[64]; ld_row64(q_, qb + rowq);
    float bv0 = -INFINITY, bv1 = -INFINITY, bv2 = -INFINITY; int bi0 = -1, bi1 = -1, bi2 = -1;
    const float* km = kmean + (size_t)(b * 4 + h) * 32 * HD;
    for (int n = 0; n < own; ++n) {
        float gsum = 0.f;
#pragma unroll
        for (int d = 0; d < 64; ++d) gsum += q_[d] * km[n * HD + d];
        if (gsum > bv0) { bv2 = bv1; bi2 = bi1; bv1 = bv0; bi1 = bi0; bv0 = gsum; bi0 = n; }
        else if (gsum > bv1) { bv2 = bv1; bi2 = bi1; bv1 = gsum; bi1 = n; }
        else if (gsum > bv2) { bv2 = gsum; bi2 = n; }
    }
    float o_[64];
#pragma unroll
    for (int d = 0; d < 64; ++d) o_[d] = 0.f;
    float m_ = -INFINITY, l_ = 0.f;
    for (int s = 0; s < 3; ++s) {
        const int blk = (s == 0) ? bi0 : (s == 1) ? bi1 : bi2;
        if (blk < 0) continue;
        for (int j = 0; j < 256; ++j) { const int pos = blk * 256 + j;
            const float sc = dot_row64(q_, kh + (size_t)pos * DM) - slope2 * (float)(t - pos);
            OSM_STEP(sc, vh + (size_t)pos * DM); }
    }
    for (int pos = own * 256; pos <= t; ++pos) {
        const float sc = dot_row64(q_, kh + (size_t)pos * DM) - slope2 * (float)(t - pos);
        OSM_STEP(sc, vh + (size_t)pos * DM); }
    st_row64(ob + rowq, o_, 1.0f / l_);
}
__device__ __forceinline__ void naive_sb(const bf16_t* qb, const bf16_t* kb, const bf16_t* vb, bf16_t* ob, int item, int tid) {
    const int b = item >> 6, h = 4 + ((item >> 4) & 3), t = (item & 15) * 512 + tid;
    const size_t rowq = ((size_t)b * SEQ + t) * DM + h * HD;
    const bf16_t* kh = kb + (size_t)b * SEQ * DM + h * HD; const bf16_t* vh = vb + (size_t)b * SEQ * DM + h * HD;
    float q_[64]; ld_row64(q_, qb + rowq);
    float o_[64];
#pragma unroll
    for (int d = 0; d < 64; ++d) o_[d] = 0.f;
    float tail = 0.f;
    for (int s = t - 1; s >= 0 && tail > -150.f; --s) {
        const float z = dot_row64(q_, kh + (size_t)s * DM);
        const float lp = __builtin_amdgcn_logf(1.0f + __builtin_amdgcn_exp2f(-fabsf(z)));
        const float lnot = -(fmaxf(z, 0.f) + lp);
        const float aw = __builtin_amdgcn_exp2f(z + lnot + tail);
        axpy_row64(o_, aw, vh + (size_t)s * DM);
        tail += lnot;
    }
    st_row64(ob + rowq, o_, 1.0f);
}
__device__ __forceinline__ void naive_dil(const bf16_t* qb, const bf16_t* kb, const bf16_t* vb, bf16_t* ob, bf16_t* hb2, float* lse, int item, int tid) {
    const int b = item >> 7, h = 8 + ((item >> 4) & 7), t = (item & 15) * 512 + tid;
    const size_t rowq = ((size_t)b * SEQ + t) * DM + h * HD;
    const bf16_t* kh = kb + (size_t)b * SEQ * DM + h * HD; const bf16_t* vh = vb + (size_t)b * SEQ * DM + h * HD;
    const float slope2 = exp2f(-(float)(h - 8 + 1)) * LOG2E;
    float q_[64]; ld_row64(q_, qb + rowq);
    float o_[64];
#pragma unroll
    for (int d = 0; d < 64; ++d) o_[d] = 0.f;
    float m_ = -INFINITY, l_ = 0.f;
    for (int c = 0; c < 3; ++c) {
        const int dil = (c == 0) ? 1 : (c == 1) ? 4 : 16;
        for (int dl = 0; dl <= 128; ++dl) { const int pos = t - dl * dil; if (pos < 0) break;
            const float sc = dot_row64(q_, kh + (size_t)pos * DM) - slope2 * (float)(dl * dil);
            OSM_STEP(sc, vh + (size_t)pos * DM); }
    }
    st_row64(ob + rowq, o_, 1.0f / l_);
    { const size_t tok = (size_t)b * SEQ + t; const u32x4 z4 = {0u, 0u, 0u, 0u};
#pragma unroll
      for (int c = 0; c < 8; ++c) { *((u32x4*)(hb2 + tok * DM + (h - 8) * HD) + c) = z4; *((u32x4*)(hb2 + tok * DM + 512 + (h - 8) * HD) + c) = z4; }
      lse[tok * 8 + (h - 8)] = 0.f; lse[(size_t)T * 8 + tok * 8 + (h - 8)] = -1.0e30f; lse[(size_t)2 * T * 8 + tok * 8 + (h - 8)] = -1.0e30f; }
}

namespace att {
typedef float f32x16 __attribute__((ext_vector_type(16)));
typedef short s16x4 __attribute__((ext_vector_type(4)));
typedef short v4i16_t __attribute__((ext_vector_type(4)));
typedef __bf16 bf16x2_t __attribute__((ext_vector_type(2)));
constexpr int L_BUF = 16384;
constexpr int L_WSF = 2 * L_BUF;
constexpr int L_OST = L_WSF + 8 * 256;
constexpr int L_FLG = L_OST + 8 * 4096;
constexpr int L_END = L_FLG + 64;
constexpr float M_INIT = -1.0e30f;
#define ATT_MFMA(a, b, c) __builtin_amdgcn_mfma_f32_32x32x16_bf16((a), (b), (c), 0, 0, 0)

__device__ __forceinline__ unsigned cvtpk(float lo, float hi) { f32x2 v = {lo, hi}; bf16x2_t b = __builtin_convertvector(v, bf16x2_t); return __builtin_bit_cast(unsigned, b); }
__device__ __forceinline__ s16x4 vtr(LAS unsigned char* p) { return __builtin_bit_cast(s16x4, __builtin_amdgcn_ds_read_tr16_b64_v4i16((LAS v4i16_t*)p)); }

struct Wave { int lane, r32, hi, wid; LAS unsigned char* lds; LAS float* wsf; LAS unsigned char* ost; int vlo; };
__device__ __forceinline__ Wave make_wave(LAS unsigned char* lds, int tid, int wsf_off = L_WSF, int ost_off = L_OST) {
    Wave w; w.lane = tid & 63; w.r32 = w.lane & 31; w.hi = w.lane >> 5; w.wid = __builtin_amdgcn_readfirstlane(tid >> 6); w.lds = lds;
    w.wsf = (LAS float*)(lds + wsf_off) + w.wid * 64; w.ost = lds + ost_off + w.wid * 4096;
    w.vlo = ((w.lane >> 4) & 1) * 32 + (w.lane & 3) * 8 + (4 * w.hi + ((w.lane & 15) >> 2)) * 64;
    return w;
}
struct Stage { u32x4 k, v; };
template <class RowK, class RowV> __device__ __forceinline__ void stage_load(Stage& s, const Wave& w, const RowK& rowk, const RowV& rowv) {
    s.k = *(const u32x4*)(rowk(w.lane) + w.wid * 8);
    s.v = *(const u32x4*)(rowv(16 * (w.wid & 3) + (w.lane >> 2)) + (w.wid >> 2) * 32 + (w.lane & 3) * 8);
}
__device__ __forceinline__ void stage_write(const Stage& s, const Wave& w, int buf) {
    *(LAS u32x4*)(w.lds + buf * L_BUF + w.wid * 1024 + w.lane * 16) = s.k;
    *(LAS u32x4*)(w.lds + buf * L_BUF + 8192 + w.wid * 1024 + w.lane * 16) = s.v;
}
__device__ __forceinline__ f32x16 qk_sub(const Wave& w, int buf, int sub, const bf16x8 (&qf)[4], float init) {
    f32x16 acc;
#pragma unroll
    for (int r = 0; r < 16; ++r) acc[r] = init;
    LAS unsigned char* kp = w.lds + buf * L_BUF + w.hi * 1024 + (32 * sub + w.r32) * 16;
#pragma unroll
    for (int ks = 0; ks < 4; ++ks) { const bf16x8 kf = *(LAS bf16x8*)(kp + ks * 2048); acc = ATT_MFMA(kf, qf[ks], acc); }
    return acc;
}
__device__ __forceinline__ void pv_sub(const Wave& w, int buf, int sub, const f32x16& p, f32x16 (&o)[2]) {
    bf16x8 pk[2];
#pragma unroll
    for (int s = 0; s < 2; ++s) { u32x4 t; t.x = cvtpk(p[8 * s], p[8 * s + 1]); t.y = cvtpk(p[8 * s + 2], p[8 * s + 3]); t.z = cvtpk(p[8 * s + 4], p[8 * s + 5]); t.w = cvtpk(p[8 * s + 6], p[8 * s + 7]); pk[s] = __builtin_bit_cast(bf16x8, t); }
    LAS unsigned char* vb = w.lds + buf * L_BUF + 8192 + w.vlo;
#pragma unroll
    for (int db = 0; db < 2; ++db)
#pragma unroll
        for (int s = 0; s < 2; ++s) { LAS unsigned char* vp = vb + db * 4096 + (4 * sub + 2 * s) * 512;
            const s16x4 lo = vtr(vp), hh = vtr(vp + 512);
            const bf16x8 vf = __builtin_shufflevector(lo, hh, 0, 1, 2, 3, 4, 5, 6, 7);
            o[db] = ATT_MFMA(pk[s], vf, o[db]); }
}
struct VFrags { s16x4 f[2][2][2]; };
__device__ __forceinline__ void load_vfrags(const Wave& w, int buf, int sub, VFrags& v) {
    LAS unsigned char* vb = w.lds + buf * L_BUF + 8192 + w.vlo;
#pragma unroll
    for (int db = 0; db < 2; ++db)
#pragma unroll
        for (int s = 0; s < 2; ++s) { LAS unsigned char* vp = vb + db * 4096 + (4 * sub + 2 * s) * 512; v.f[db][s][0] = vtr(vp); v.f[db][s][1] = vtr(vp + 512); }
}
__device__ __forceinline__ void pv_frags(const VFrags& v, const f32x16& p, f32x16 (&o)[2]) {
    bf16x8 pk[2];
#pragma unroll
    for (int s = 0; s < 2; ++s) { u32x4 t; t.x = cvtpk(p[8 * s], p[8 * s + 1]); t.y = cvtpk(p[8 * s + 2], p[8 * s + 3]); t.z = cvtpk(p[8 * s + 4], p[8 * s + 5]); t.w = cvtpk(p[8 * s + 6], p[8 * s + 7]); pk[s] = __builtin_bit_cast(bf16x8, t); }
#pragma unroll
    for (int db = 0; db < 2; ++db)
#pragma unroll
        for (int s = 0; s < 2; ++s) { const bf16x8 vf = __builtin_shufflevector(v.f[db][s][0], v.f[db][s][1], 0, 1, 2, 3, 4, 5, 6, 7); o[db] = ATT_MFMA(pk[s], vf, o[db]); }
}
__device__ __forceinline__ void scale_rows(const Wave& w, f32x16 (&o)[2], float f) {
    if (w.hi == 0) w.wsf[w.r32] = f;
#pragma unroll
    for (int g = 0; g < 4; ++g) { const f32x4 fv = *(LAS f32x4*)(w.wsf + 8 * g + 4 * w.hi);
#pragma unroll
        for (int i = 0; i < 4; ++i) { o[0][4 * g + i] *= fv[i]; o[1][4 * g + i] *= fv[i]; } }
}
__device__ __forceinline__ void softmax_sub(const Wave& w, f32x16& s, float& m, float& lsum, f32x16 (&o)[2]) {
    float tm = fmaxf(fmaxf(s[0], s[1]), fmaxf(s[2], s[3]));
#pragma unroll
    for (int r = 4; r < 16; r += 4) tm = fmaxf(tm, fmaxf(fmaxf(s[r], s[r + 1]), fmaxf(s[r + 2], s[r + 3])));
    tm = max_xor32(tm);
    const float mn = fmaxf(m, tm);
    if (__any(mn > m)) { const float al = __builtin_amdgcn_exp2f(m - mn); lsum *= al; scale_rows(w, o, al); m = mn; }
    float acc = 0.f;
#pragma unroll
    for (int r = 0; r < 16; ++r) { s[r] = __builtin_amdgcn_exp2f(s[r] - m); acc += s[r]; }
    lsum += acc;
}
__device__ __forceinline__ void mask_band(f32x16& s, int delta0, int W) {
#pragma unroll
    for (int r = 0; r < 16; ++r) { const int dl = delta0 - ((r & 3) + 8 * (r >> 2)); if ((unsigned)dl > (unsigned)W) s[r] = -INFINITY; }
}
constexpr float SM_THR = 8.0f;
struct SubDesc { bool act; int delta; int W; };
template <int NSUB>
__device__ __forceinline__ void softmax_step(const Wave& w, int buf, const bf16x8 (&qf)[4], const bf16x8& kidx, const bf16x8& slp, float slope, const SubDesc (&sd)[NSUB],
                                             float& m, float& lsum, f32x16 (&o)[2], bool& first) {
    f32x16 s[NSUB];
    bool any_act = false;
#pragma unroll
    for (int i = 0; i < NSUB; ++i) if (sd[i].act) { any_act = true; s[i] = qk_sub(w, buf, i, qf, -slope * (float)sd[i].delta - m); s[i] = ATT_MFMA(kidx, slp, s[i]); }
    if (!any_act) return;
    float tm = -INFINITY;
#pragma unroll
    for (int i = 0; i < NSUB; ++i) if (sd[i].act) {
        if (sd[i].W >= 0) mask_band(s[i], sd[i].delta - 4 * w.hi, sd[i].W);
        float t = fmaxf(fmaxf(s[i][0], s[i][1]), fmaxf(s[i][2], s[i][3]));
#pragma unroll
        for (int r = 4; r < 16; r += 4) t = fmaxf(t, fmaxf(fmaxf(s[i][r], s[i][r + 1]), fmaxf(s[i][r + 2], s[i][r + 3])));
        tm = fmaxf(tm, t); }
    tm = max_xor32(tm);
    if (first || __any(tm > SM_THR)) {
        const float d = first ? (tm > -1.0e30f ? tm : 0.f) : fmaxf(tm, 0.f);
#pragma unroll
        for (int i = 0; i < NSUB; ++i) if (sd[i].act) {
#pragma unroll
            for (int r = 0; r < 16; ++r) s[i][r] -= d; }
        if (!first) { const float al = __builtin_amdgcn_exp2f(-d); lsum *= al; scale_rows(w, o, al); }
        m += d; first = false;
    }
    VFrags vf[NSUB];
#pragma unroll
    for (int i = 0; i < NSUB; ++i) if (sd[i].act) load_vfrags(w, buf, i, vf[i]);
#pragma unroll
    for (int i = 0; i < NSUB; ++i) if (sd[i].act) { float acc = 0.f;
#pragma unroll
        for (int r = 0; r < 16; ++r) { s[i][r] = __builtin_amdgcn_exp2f(s[i][r]); acc += s[i][r]; }
        lsum += acc; }
#pragma unroll
    for (int i = 0; i < NSUB; ++i) if (sd[i].act) pv_frags(vf[i], s[i], o);
}
__device__ __forceinline__ void bias_frags(const Wave& w, float slope, bf16x8& kidx, bf16x8& slp) {
    const unsigned kb = f2bf((float)w.r32), sh = f2bf(slope), sl = f2bf(slope - __builtin_bit_cast(float, sh << 16));
    const u32x4 a = {w.hi == 0 ? (kb | (kb << 16)) : 0u, 0u, 0u, 0u}, b = {w.hi == 0 ? (sh | (sl << 16)) : 0u, 0u, 0u, 0u};
    kidx = __builtin_bit_cast(bf16x8, a); slp = __builtin_bit_cast(bf16x8, b);
}
template <class RowO> __device__ __forceinline__ void store_o(const Wave& w, const f32x16 (&o)[2], const RowO& rowo) {
    LAS unsigned short* stg = (LAS unsigned short*)w.ost;
#pragma unroll
    for (int r = 0; r < 16; ++r) { const int q = (r & 3) + 8 * (r >> 2) + 4 * w.hi;
#pragma unroll
        for (int db = 0; db < 2; ++db) stg[q * 64 + db * 32 + w.r32] = (unsigned short)f2bf(o[db][r]); }
#pragma unroll
    for (int i = 0; i < 4; ++i) { const int row = i * 8 + (w.lane >> 3), ch = w.lane & 7; const u32x4 v = *(LAS u32x4*)((LAS unsigned char*)stg + row * 128 + ch * 16);
        bf16_t* dst = rowo(row); if (dst) *(u32x4*)(dst + ch * 8) = v; }
}
__device__ __forceinline__ void load_q(bf16x8 (&qf)[4], const bf16_t* qrow, int hi) {
#pragma unroll
    for (int ks = 0; ks < 4; ++ks) qf[ks] = *(const bf16x8*)(qrow + 16 * ks + 8 * hi);
}

constexpr int W_WSF = 98304, W_OST = W_WSF + 2048, W_ENUM = W_OST + 32768;
template <int NC> struct Pref { u32x4 k[NC], v[NC]; bf16x8 q[4]; };
template <int NC, class RowF> __device__ __forceinline__ void win_issue(Pref<NC>& P, const Wave& w, const bf16_t* kbase, const bf16_t* vbase, const RowF& rowoff, const bf16_t* qrow) {
#pragma unroll
    for (int c = 0; c < NC; ++c) { P.k[c] = *(const u32x4*)(kbase + rowoff(64 * c + 8 * w.wid + (w.lane >> 3)) + (w.lane & 7) * 8);
        P.v[c] = *(const u32x4*)(vbase + rowoff(64 * c + 16 * (w.wid & 3) + (w.lane >> 2)) + (w.wid >> 2) * 32 + (w.lane & 3) * 8); }
    load_q(P.q, qrow, w.hi);
}
template <int NC> __device__ __forceinline__ void win_commit(const Pref<NC>& P, const Wave& w) {
    constexpr int NK = 64 * NC;
#pragma unroll
    for (int c = 0; c < NC; ++c) { const int key = 64 * c + 8 * w.wid + (w.lane >> 3);
        *(LAS u32x4*)(w.lds + key * 128 + ((((w.lane & 7) ^ (key >> 1)) & 7) * 16)) = P.k[c];
        *(LAS u32x4*)(w.lds + NK * 128 + (w.wid >> 2) * (NK * 64) + (8 * c + 2 * (w.wid & 3)) * 512 + w.lane * 16) = P.v[c]; }
}
template <int NK> __device__ __forceinline__ f32x16 qk_win(const Wave& w, int u, const bf16x8 (&qf)[4], float init) {
    f32x16 acc;
#pragma unroll
    for (int r = 0; r < 16; ++r) acc[r] = init;
    LAS unsigned char* kp = w.lds + (32 * u + w.r32) * 128; const int x = (w.r32 >> 1) & 7;
#pragma unroll
    for (int ks = 0; ks < 4; ++ks) { const bf16x8 kf = *(LAS bf16x8*)(kp + (((2 * ks + w.hi) ^ x) * 16)); acc = ATT_MFMA(kf, qf[ks], acc); }
    return acc;
}
template <int NK> __device__ __forceinline__ void load_vfrags_win(const Wave& w, int u, VFrags& v) {
    LAS unsigned char* vb = w.lds + NK * 128 + w.vlo;
#pragma unroll
    for (int db = 0; db < 2; ++db)
#pragma unroll
        for (int s = 0; s < 2; ++s) { LAS unsigned char* vp = vb + db * (NK * 64) + (4 * u + 2 * s) * 512; v.f[db][s][0] = vtr(vp); v.f[db][s][1] = vtr(vp + 512); }
}
struct WSub { bool act; int u; int delta; int W; };
template <int NK>
__device__ __forceinline__ void softmax_win(const Wave& w, const bf16x8 (&qf)[4], const bf16x8& kidx, const bf16x8& slp, float slope, const WSub (&sd)[2], float& m, float& lsum, f32x16 (&o)[2], bool& first) {
    f32x16 s[2];
    bool any_act = false;
#pragma unroll
    for (int i = 0; i < 2; ++i) if (sd[i].act) { any_act = true; s[i] = qk_win<NK>(w, sd[i].u, qf, -slope * (float)sd[i].delta - m); s[i] = ATT_MFMA(kidx, slp, s[i]); }
    if (!any_act) return;
    float tm = -INFINITY;
#pragma unroll
    for (int i = 0; i < 2; ++i) if (sd[i].act) {
        if (sd[i].W >= 0) mask_band(s[i], sd[i].delta - 4 * w.hi, sd[i].W);
        float t = fmaxf(fmaxf(s[i][0], s[i][1]), fmaxf(s[i][2], s[i][3]));
#pragma unroll
        for (int r = 4; r < 16; r += 4) t = fmaxf(t, fmaxf(fmaxf(s[i][r], s[i][r + 1]), fmaxf(s[i][r + 2], s[i][r + 3])));
        tm = fmaxf(tm, t); }
    tm = max_xor32(tm);
    if (first || __any(tm > SM_THR)) {
        const float d = first ? (tm > -1.0e30f ? tm : 0.f) : fmaxf(tm, 0.f);
#pragma unroll
        for (int i = 0; i < 2; ++i) if (sd[i].act) {
#pragma unroll
            for (int r = 0; r < 16; ++r) s[i][r] -= d; }
        if (!first) { const float al = __builtin_amdgcn_exp2f(-d); lsum *= al; scale_rows(w, o, al); }
        m += d; first = false;
    }
#pragma unroll
    for (int i = 0; i < 2; ++i) if (sd[i].act) { VFrags vf; load_vfrags_win<NK>(w, sd[i].u, vf);
        float acc = 0.f;
#pragma unroll
        for (int r = 0; r < 16; ++r) { s[i][r] = __builtin_amdgcn_exp2f(s[i][r]); acc += s[i][r]; }
        lsum += acc;
        pv_frags(vf, s[i], o); }
}

__device__ __forceinline__ size_t ql_off(int bh, int j) { return (size_t)bh * QL_PER_BH + (size_t)(8192 * j - 128 * j * (j + 1)); }
__device__ __forceinline__ float* lsem_ptr(float* l0, float* l1, int slot) { return (slot < 2 ? l0 : l1) + (size_t)(slot & 1) * T * 4; }

struct Top3 { int i0, i1, i2; };
__device__ __forceinline__ Top3 moba_top3(const Wave& w, const bf16x8 (&qf)[4], const float* KMEAN, int b, int h, int own) {
    int i0 = -1, i1 = -1, i2 = -1;
    if (own > 0) {
    f32x16 g;
#pragma unroll
    for (int r = 0; r < 16; ++r) g[r] = 0.f;
    const float* km = KMEAN + ((size_t)(b * 4 + h) * 32 + w.r32) * HD + 8 * w.hi;
#pragma unroll
    for (int ks = 0; ks < 4; ++ks) { const f32x4 a0 = *(const f32x4*)(km + 16 * ks), a1 = *(const f32x4*)(km + 16 * ks + 4);
        const float x[8] = {a0.x, a0.y, a0.z, a0.w, a1.x, a1.y, a1.z, a1.w}; unsigned hw[4], lw[4];
#pragma unroll
        for (int j = 0; j < 4; ++j) { const unsigned h0 = f2bf(x[2 * j]), h1 = f2bf(x[2 * j + 1]); hw[j] = h0 | (h1 << 16);
            lw[j] = pk2(x[2 * j] - __builtin_bit_cast(float, h0 << 16), x[2 * j + 1] - __builtin_bit_cast(float, h1 << 16)); }
        const u32x4 hv = {hw[0], hw[1], hw[2], hw[3]}, lv = {lw[0], lw[1], lw[2], lw[3]};
        g = ATT_MFMA(__builtin_bit_cast(bf16x8, hv), qf[ks], g); g = ATT_MFMA(__builtin_bit_cast(bf16x8, lv), qf[ks], g); }
    float v0 = -INFINITY, v1 = -INFINITY, v2 = -INFINITY;
#pragma unroll
    for (int r = 0; r < 16; ++r) { const int blk = (r & 3) + 8 * (r >> 2) + 4 * w.hi; const float val = (blk < own) ? g[r] : -INFINITY;
        if (val > v0) { v2 = v1; i2 = i1; v1 = v0; i1 = i0; v0 = val; i0 = blk; } else if (val > v1) { v2 = v1; i2 = i1; v1 = val; i1 = blk; } else if (val > v2) { v2 = val; i2 = blk; } }
    const float pv_[3] = {get_xor32(v0, w.hi), get_xor32(v1, w.hi), get_xor32(v2, w.hi)}; const int pi_[3] = {get_xor32i(i0, w.hi), get_xor32i(i1, w.hi), get_xor32i(i2, w.hi)};
#pragma unroll
    for (int k = 0; k < 3; ++k) { const float val = pv_[k]; const int blk = pi_[k];
        if (val > v0 || (val == v0 && blk < i0)) { v2 = v1; i2 = i1; v1 = v0; i1 = i0; v0 = val; i0 = blk; }
        else if (val > v1 || (val == v1 && blk < i1)) { v2 = v1; i2 = i1; v1 = val; i1 = blk; }
        else if (val > v2 || (val == v2 && blk < i2)) { v2 = val; i2 = blk; } }
    }
    Top3 t; t.i0 = i0; t.i1 = i1; t.i2 = i2; return t;
}
__device__ __forceinline__ void moba_gate_unit(LAS unsigned char* lds, const bf16_t* QB, const float* KMEAN, unsigned* mcnt, unsigned* qlist, bf16_t* PM, float* LSEM0, float* LSEM1, int b, int h, int own, int tid) {
    const Wave w = make_wave(lds, tid);
    const size_t rowbase = (size_t)b * SEQ; const int qpos = own * 256 + 32 * w.wid + w.r32, bh = b * 4 + h;
    bf16x8 qf[4]; load_q(qf, QB + (rowbase + qpos) * DM + h * HD, w.hi);
    const Top3 t3 = moba_top3(w, qf, KMEAN, b, h, own); const int s0 = t3.i0, s1 = t3.i1, s2 = t3.i2;
    LAS unsigned* cl = (LAS unsigned*)(lds + W_ENUM);
    if (tid < 64) cl[tid] = 0u;
    __syncthreads();
    unsigned r0 = 0u, r1 = 0u, r2 = 0u;
    if (w.hi == 0) {
        if (s0 >= 0) r0 = __hip_atomic_fetch_add(cl + s0, 1u, __ATOMIC_RELAXED, __HIP_MEMORY_SCOPE_WORKGROUP);
        if (s1 >= 0) r1 = __hip_atomic_fetch_add(cl + s1, 1u, __ATOMIC_RELAXED, __HIP_MEMORY_SCOPE_WORKGROUP);
        if (s2 >= 0) r2 = __hip_atomic_fetch_add(cl + s2, 1u, __ATOMIC_RELAXED, __HIP_MEMORY_SCOPE_WORKGROUP);
    }
    __syncthreads();
    if (tid < 32) { const unsigned c = cl[tid]; cl[32 + tid] = c ? __hip_atomic_fetch_add(mcnt + bh * 32 + tid, c, __ATOMIC_RELAXED, __HIP_MEMORY_SCOPE_AGENT) : 0u; }
    __syncthreads();
    if (w.hi == 0) {
        const size_t tok = rowbase + qpos;
#define MOBA_EMIT(k, sk, rk) do { if (sk >= 0) qlist[ql_off(bh, sk) + cl[32 + sk] + rk] = (unsigned)qpos | ((unsigned)(k) << 13); \
            else { lsem_ptr(LSEM0, LSEM1, k)[tok * 4 + h] = -1.0e30f;          \
                u32x4* pz = (u32x4*)(PM + ((size_t)(k) * T + tok) * 256 + h * HD); const u32x4 z4 = {0u, 0u, 0u, 0u}; \
                _Pragma("unroll") for (int c = 0; c < 8; ++c) pz[c] = z4; } } while (0)
        MOBA_EMIT(0, s0, r0); MOBA_EMIT(1, s1, r1); MOBA_EMIT(2, s2, r2);
#undef MOBA_EMIT
    }
    __syncthreads();
}
struct OwnU { int b, h, own; };
__device__ __forceinline__ void own_issue(Pref<4>& P, const Wave& w, const OwnU& u, const bf16_t* QB, const bf16_t* KB, const bf16_t* VB) {
    const size_t rowbase = (size_t)u.b * SEQ; const int q0 = u.own * 256;
    win_issue<4>(P, w, KB + (rowbase + q0) * DM + u.h * HD, VB + (rowbase + q0) * DM + u.h * HD, [&](int key) { return (size_t)key * DM; }, QB + (rowbase + q0 + 32 * w.wid + w.r32) * DM + u.h * HD);
}
template <class F> __device__ __forceinline__ void own_compute(const Wave& w, const OwnU& u, const bf16x8 (&qf)[4], bf16_t* OB, float* LSEM0, float* LSEM1, const F& between) {
    const size_t rowbase = (size_t)u.b * SEQ; const int q0 = u.own * 256, ql = 32 * w.wid + w.r32;
    const float slope2 = exp2f(-2.0f * (float)(u.h + 1)) * LOG2E;
    bf16x8 kidx, slp; bias_frags(w, slope2, kidx, slp);
    f32x16 o[2];
#pragma unroll
    for (int r = 0; r < 16; ++r) { o[0][r] = 0.f; o[1][r] = 0.f; }
    float m = 0.f, lsum = 0.f; bool first = true;
#pragma unroll
    for (int p = 0; p < 4; ++p) { WSub sd[2];
#pragma unroll
        for (int i = 0; i < 2; ++i) { const int su = w.wid - 2 * p - i; sd[i].act = su >= 0; sd[i].u = su; sd[i].delta = ql - 32 * su; sd[i].W = (su == w.wid) ? 0x7fffffff : -1; }
        softmax_win<256>(w, qf, kidx, slp, slope2, sd, m, lsum, o, first); }
    between();
    const float l = sum_xor32(lsum);
    scale_rows(w, o, 1.0f / l);
    bf16_t* orow = OB + (rowbase + q0 + 32 * w.wid) * DM + u.h * HD;
    store_o(w, o, [&](int r) { return orow + (size_t)r * DM; });
    if (w.hi == 0) lsem_ptr(LSEM0, LSEM1, 3)[(rowbase + q0 + ql) * 4 + u.h] = m + __builtin_amdgcn_logf(l);
}
struct GatU { int b, h, j, cnt, chunk; const unsigned* ql; };
__device__ __forceinline__ unsigned gat_entry(const Wave& w, const GatU& u, bool& valid) { const int idx = u.chunk * 256 + 32 * w.wid + w.r32; valid = idx < u.cnt; return u.ql[valid ? idx : u.chunk * 256]; }
__device__ __forceinline__ void gat_issue(Pref<4>& P, const Wave& w, const GatU& u, const bf16_t* QB, const bf16_t* KB, const bf16_t* VB) {
    const size_t rowbase = (size_t)u.b * SEQ; bool valid; const unsigned e = gat_entry(w, u, valid);
    win_issue<4>(P, w, KB + (rowbase + u.j * 256) * DM + u.h * HD, VB + (rowbase + u.j * 256) * DM + u.h * HD, [&](int key) { return (size_t)key * DM; }, QB + (rowbase + (e & 8191u)) * DM + u.h * HD);
}
template <class F> __device__ __forceinline__ void gat_compute(const Wave& w, const GatU& u, const bf16x8 (&qf)[4], bf16_t* PM, float* LSEM0, float* LSEM1, const F& between) {
    const size_t rowbase = (size_t)u.b * SEQ; bool valid; const unsigned e = gat_entry(w, u, valid);
    const int qpos = (int)(e & 8191u), slot = (int)(e >> 13);
    const float slope2 = exp2f(-2.0f * (float)(u.h + 1)) * LOG2E;
    bf16x8 kidx, slp; bias_frags(w, slope2, kidx, slp);
    f32x16 o[2];
#pragma unroll
    for (int r = 0; r < 16; ++r) { o[0][r] = 0.f; o[1][r] = 0.f; }
    float m = 0.f, lsum = 0.f; bool first = true;
#pragma unroll
    for (int p = 0; p < 4; ++p) { WSub sd[2];
#pragma unroll
        for (int i = 0; i < 2; ++i) { const int su = 7 - 2 * p - i; sd[i].act = true; sd[i].u = su; sd[i].delta = qpos - (u.j * 256 + 32 * su); sd[i].W = -1; }
        softmax_win<256>(w, qf, kidx, slp, slope2, sd, m, lsum, o, first); }
    between();
    const float l = sum_xor32(lsum);
    scale_rows(w, o, l > 0.f ? 1.0f / l : 0.f);
    LAS int* code = (LAS int*)(w.wsf + 32);
    if (w.hi == 0) code[w.r32] = valid ? (int)((size_t)slot * T + rowbase + qpos) : -1;
    store_o(w, o, [&](int r) { const int c = code[r]; return c >= 0 ? PM + (size_t)c * 256 + u.h * HD : (bf16_t*)nullptr; });
    if (w.hi == 0 && valid) lsem_ptr(LSEM0, LSEM1, slot)[(rowbase + qpos) * 4 + u.h] = l > 0.f ? m + __builtin_amdgcn_logf(l) : -1.0e30f;
}

__device__ __forceinline__ void sb_unit(LAS unsigned char* lds, const bf16_t* QB, const bf16_t* KB, const bf16_t* VB, bf16_t* OB, int b, int h, int qt, int tid) {
    const Wave w = make_wave(lds, tid);
    const size_t rowbase = (size_t)b * SEQ; const int q0 = qt * 256, qpos = q0 + 32 * w.wid + w.r32;
    const bf16_t* kh = KB + rowbase * DM + h * HD; const bf16_t* vh = VB + rowbase * DM + h * HD;
    bf16x8 qf[4]; load_q(qf, QB + (rowbase + qpos) * DM + h * HD, w.hi);
    f32x16 o[2];
#pragma unroll
    for (int r = 0; r < 16; ++r) { o[0][r] = 0.f; o[1][r] = 0.f; }
    float carry = 0.f;
    bool done = false;
    volatile LAS unsigned* flg = (volatile LAS unsigned*)(lds + L_FLG);
    const int ti0 = q0 / 64 + 3;
    Stage sg;
    { const int kp = ti0 * 64; stage_load(sg, w, [&](int key) { return kh + (size_t)(kp + key) * DM; }, [&](int key) { return vh + (size_t)(kp + key) * DM; }); }
    stage_write(sg, w, 0);
    __syncthreads();
    for (int st = 0;; ++st) {
        const int buf = st & 1, ti = ti0 - st;
        if (ti > 0) { const int kp = (ti - 1) * 64; stage_load(sg, w, [&](int key) { return kh + (size_t)(kp + key) * DM; }, [&](int key) { return vh + (size_t)(kp + key) * DM; }); }
        if (!done) {
#pragma unroll
            for (int sub = 1; sub >= 0; --sub) {
                const int D = (q0 / 32 + w.wid) - (2 * ti + sub);
                if (D < 0) continue;
                const int delta0 = qpos - (64 * ti + 32 * sub) - 4 * w.hi;
                f32x16 z = qk_sub(w, buf, sub, qf, 0.f);
                f32x16 dd;
#pragma unroll
                for (int r = 0; r < 16; ++r) { z[r] = __builtin_amdgcn_exp2f(fminf(z[r], 30.f)); }
                if (D == 0) {
#pragma unroll
                    for (int r = 0; r < 16; ++r) { const int dl = delta0 - ((r & 3) + 8 * (r >> 2)); if (dl < 1) z[r] = 0.f; }
                }
#pragma unroll
                for (int r = 0; r < 16; ++r) dd[r] = 1.f + z[r];
                float G[4], PG[4];
#pragma unroll
                for (int g = 0; g < 4; ++g) { G[g] = (dd[4 * g] * dd[4 * g + 1]) * (dd[4 * g + 2] * dd[4 * g + 3]); PG[g] = get_xor32(G[g], w.hi); }
                const float cin = __builtin_amdgcn_exp2f(carry);
                float run = 1.f;
#pragma unroll
                for (int g = 3; g >= 0; --g) { const float x3 = run * (w.hi == 0 ? PG[g] : 1.f);
                    const float p0 = x3 * G[g];
                    const float r0 = __builtin_amdgcn_rcpf(p0) * cin, r1 = r0 * dd[4 * g], r2 = r1 * dd[4 * g + 1], r3 = r2 * dd[4 * g + 2];
                    z[4 * g] *= r0; z[4 * g + 1] *= r1; z[4 * g + 2] *= r2; z[4 * g + 3] *= r3;
                    run *= G[g] * PG[g]; }
                carry -= __builtin_amdgcn_logf(run);
                pv_sub(w, buf, sub, z, o);
            }
            done = __all(carry < -150.f);
        }
        if (w.lane == 0) flg[buf * 8 + w.wid] = done ? 1u : 0u;
        if (ti > 0) stage_write(sg, w, buf ^ 1);
        __syncthreads();
        unsigned all = 1u;
#pragma unroll
        for (int k = 0; k < 8; ++k) all &= flg[buf * 8 + k];
        if (all || ti == 0) break;
    }
    bf16_t* orow = OB + (rowbase + q0 + 32 * w.wid) * DM + h * HD;
    store_o(w, o, [&](int r) { return orow + (size_t)r * DM; });
    __syncthreads();
}

struct PrefK6 { u32x4 k[6]; bf16x8 q[4]; }; struct PrefV6 { u32x4 v[6]; };
template <class RowF> __device__ __forceinline__ void win_issue_k6(PrefK6& P, const Wave& w, const bf16_t* kbase, const RowF& rowoff, const bf16_t* qrow) {
#pragma unroll
    for (int c = 0; c < 6; ++c) P.k[c] = *(const u32x4*)(kbase + rowoff(64 * c + 8 * w.wid + (w.lane >> 3)) + (w.lane & 7) * 8);
    load_q(P.q, qrow, w.hi);
}
template <class RowF> __device__ __forceinline__ void win_issue_v6(PrefV6& P, const Wave& w, const bf16_t* vbase, const RowF& rowoff) {
#pragma unroll
    for (int c = 0; c < 6; ++c) P.v[c] = *(const u32x4*)(vbase + rowoff(64 * c + 16 * (w.wid & 3) + (w.lane >> 2)) + (w.wid >> 2) * 32 + (w.lane & 3) * 8);
}
__device__ __forceinline__ void win_commit_k6(const PrefK6& P, const Wave& w) {
#pragma unroll
    for (int c = 0; c < 6; ++c) { const int key = 64 * c + 8 * w.wid + (w.lane >> 3); *(LAS u32x4*)(w.lds + key * 128 + ((((w.lane & 7) ^ (key >> 1)) & 7) * 16)) = P.k[c]; }
}
__device__ __forceinline__ void win_commit_v6(const PrefV6& P, const Wave& w) {
    constexpr int NK = 384;
#pragma unroll
    for (int c = 0; c < 6; ++c) *(LAS u32x4*)(w.lds + NK * 128 + (w.wid >> 2) * (NK * 64) + (8 * c + 2 * (w.wid & 3)) * 512 + w.lane * 16) = P.v[c];
}
struct DilU { int b, h, dil, res, i2, c; };
__device__ __forceinline__ DilU dil_decode(int u) { const int n = ((u & 31) + (u >> 8)) & 31, bhc = u >> 5,
    c = bhc % 3, bh = bhc / 3; DilU d; d.b = bh >> 3; d.h = 8 + (bh & 7); d.c = c;
    d.dil = (c == 0) ? 1 : (c == 1) ? 4 : 16; d.res = (c == 0) ? 0 : (c == 1) ? (n >> 3) : (n >> 1); d.i2 = (c == 0) ? n : (c == 1) ? (n & 7) : (n & 1); return d; }
__device__ __forceinline__ void dil_issue_k(PrefK6& P, const Wave& w, const DilU& u, const bf16_t* QB, const bf16_t* KB) {
    const size_t rowbase = (size_t)u.b * SEQ; const int Q0 = 256 * u.i2, qj = Q0 + 32 * w.wid + w.r32; const size_t rstride = (size_t)u.dil * DM;
    win_issue_k6(P, w, KB + (rowbase + u.res) * DM + u.h * HD, [&](int key) { const int kj = Q0 - 128 + key; return (size_t)(kj < 0 ? 0 : kj) * rstride; },
                 QB + (rowbase + u.res + (size_t)qj * u.dil) * DM + u.h * HD);
}
__device__ __forceinline__ void dil_issue_v(PrefV6& P, const Wave& w, const DilU& u, const bf16_t* VB) {
    const size_t rowbase = (size_t)u.b * SEQ; const int Q0 = 256 * u.i2; const size_t rstride = (size_t)u.dil * DM;
    win_issue_v6(P, w, VB + (rowbase + u.res) * DM + u.h * HD, [&](int key) { const int kj = Q0 - 128 + key; return (size_t)(kj < 0 ? 0 : kj) * rstride; });
}
template <class F> __device__ __forceinline__ void dil_compute(const Wave& w, const DilU& u, const bf16x8 (&qf)[4], bf16_t* OB, bf16_t* HB2, float* LSE, const F& between) {
    const size_t rowbase = (size_t)u.b * SEQ; const int Q0 = 256 * u.i2, ql = 32 * w.wid + w.r32;
    const float slope2d = exp2f(-(float)(u.h - 8 + 1)) * LOG2E * (float)u.dil;
    bf16x8 kidx, slp; bias_frags(w, slope2d, kidx, slp);
    f32x16 o[2];
#pragma unroll
    for (int r = 0; r < 16; ++r) { o[0][r] = 0.f; o[1][r] = 0.f; }
    float m = 0.f, lsum = 0.f; bool first = true;
#pragma unroll
    for (int p = 0; p < 3; ++p) { WSub sd[2];
#pragma unroll
        for (int i = 0; i < 2; ++i) { const int D = 2 * p + i, su = w.wid + 4 - D; sd[i].act = (D <= 4) && (Q0 - 128 + 32 * su >= 0); sd[i].u = su; sd[i].delta = ql + 128 - 32 * su; sd[i].W = (D == 0 || D == 4) ? 128 : -1; }
        softmax_win<384>(w, qf, kidx, slp, slope2d, sd, m, lsum, o, first); }
    between();
    const float l = sum_xor32(lsum);
    scale_rows(w, o, 1.0f / l);
    bf16_t* PO = (u.c == 0) ? OB + 512 : HB2 + (u.c - 1) * 512;
    const size_t tok0 = rowbase + u.res + (size_t)(Q0 + 32 * w.wid) * u.dil;
    store_o(w, o, [&](int r) { return PO + (tok0 + (size_t)r * u.dil) * DM + (u.h - 8) * HD; });
    if (w.hi == 0) (LSE + (size_t)u.c * T * 8)[(tok0 + (size_t)w.r32 * u.dil) * 8 + (u.h - 8)] = m + __builtin_amdgcn_logf(l);
}

__device__ __forceinline__ void moba_gate_phase(LAS unsigned char* lds, const bf16_t* QB, const float* KMEAN, unsigned* mcnt, unsigned* qlist, bf16_t* PM, float* LSEM0, float* LSEM1, int v, int G, int tid) {
    for (int u = v; u < 512; u += G) { const int own = u & 31, bh = u >> 5; moba_gate_unit(lds, QB, KMEAN, mcnt, qlist, PM, LSEM0, LSEM1, bh >> 2, bh & 3, own, tid); }
}
struct AttnArgs { const bf16_t* QB; const bf16_t* KB; const bf16_t* VB; bf16_t* OB; bf16_t* HB2; float* LSE; unsigned* mcnt; unsigned* qlist; bf16_t* PM; float* LSEM0; float* LSEM1; const float* KMEAN; unsigned* gdone; };
__device__ __forceinline__ void attn_phase(LAS unsigned char* lds, const AttnArgs& A, int v, int G, int tid) {
    moba_gate_phase(lds, A.QB, A.KMEAN, A.mcnt, A.qlist, A.PM, A.LSEM0, A.LSEM1, v, G, tid);
    asm volatile("s_waitcnt vmcnt(0)" ::: "memory");
    __syncthreads();
    if (tid == 0) { __builtin_amdgcn_fence(__ATOMIC_RELEASE, "agent"); asm volatile("s_waitcnt vmcnt(0)" ::: "memory"); __hip_atomic_fetch_add(A.gdone, 1u, __ATOMIC_RELAXED, __HIP_MEMORY_SCOPE_AGENT); }
    const Wave w = make_wave(lds, tid, W_WSF, W_OST);
    {   Pref<4> P; int u = v; OwnU cur, nxt;
        auto dec = [&](int uu) { OwnU o_; const int bh = uu >> 5; o_.b = bh >> 2; o_.h = bh & 3; o_.own = uu & 31; return o_; };
        if (u < 512) { cur = dec(u); own_issue(P, w, cur, A.QB, A.KB, A.VB); }
        for (; u < 512; u += G) {
            __syncthreads();
            win_commit<4>(P, w); bf16x8 qf[4] = {P.q[0], P.q[1], P.q[2], P.q[3]};
            __syncthreads();
            const bool more = u + G < 512; if (more) nxt = dec(u + G);
            own_compute(w, cur, qf, A.OB, A.LSEM0, A.LSEM1, [&]() { if (more) own_issue(P, w, nxt, A.QB, A.KB, A.VB); });
            cur = nxt; } }
    {   PrefK6 P; int u = v; DilU cur, nxt;
        if (u < 3072) { cur = dil_decode(u); dil_issue_k(P, w, cur, A.QB, A.KB); }
        for (; u < 3072; u += G) {
            __syncthreads();
            bf16x8 qf[4] = {P.q[0], P.q[1], P.q[2], P.q[3]};
            { PrefV6 PV; dil_issue_v(PV, w, cur, A.VB); win_commit_k6(P, w); win_commit_v6(PV, w); }
            __syncthreads();
            const bool more = u + G < 3072; if (more) nxt = dil_decode(u + G);
            dil_compute(w, cur, qf, A.OB, A.HB2, A.LSE, [&]() { if (more) dil_issue_k(P, w, nxt, A.QB, A.KB); });
            cur = nxt; } }
    __syncthreads();
    for (int u = v; u < 512; u += G) { const int qt = ((u & 31) + (u >> 8)) & 31, bh = u >> 5; sb_unit(lds, A.QB, A.KB, A.VB, A.OB, bh >> 2, 4 + (bh & 3), qt, tid); }
    if (tid == 0) { unsigned polls = 0;
        while (__hip_atomic_load(A.gdone, __ATOMIC_RELAXED, __HIP_MEMORY_SCOPE_AGENT) < (unsigned)G) { if (++polls > (1u << 20)) break; __builtin_amdgcn_s_sleep(2); }
        __builtin_amdgcn_fence(__ATOMIC_ACQUIRE, "agent"); asm volatile("s_waitcnt vmcnt(0)" ::: "memory"); }
    __syncthreads();
    LAS int* cntl = (LAS int*)(lds + W_ENUM); LAS int* pa = cntl + 512; LAS int* pb = pa + 512;
    const int myc = (int)A.mcnt[tid], myu = (myc + 255) >> 8;
    cntl[tid] = myc; pa[tid] = myu;
    __syncthreads();
#pragma unroll 1
    for (int d = 1; d < 512; d <<= 1) { const int x = pa[tid] + (tid >= d ? pa[tid - d] : 0); pb[tid] = x; __syncthreads(); LAS int* t_ = pa; pa = pb; pb = t_; }
    const int total = pa[511];
    auto gat_decode = [&](int u) { int lo = 0, hi = 511;
        while (lo < hi) { const int mid = (lo + hi) >> 1; if (pa[mid] > u) hi = mid; else lo = mid + 1; }
        const int i = lo, c = cntl[i], bh = i >> 5; GatU g; g.b = bh >> 2; g.h = bh & 3; g.j = i & 31; g.cnt = c; g.chunk = u - (pa[i] - ((c + 255) >> 8)); g.ql = A.qlist + ql_off(bh, g.j); return g; };
    {   Pref<4> P; int u = v; GatU cur, nxt;
        if (u < total) { cur = gat_decode(u); gat_issue(P, w, cur, A.QB, A.KB, A.VB); }
        for (; u < total; u += G) {
            __syncthreads();
            win_commit<4>(P, w); bf16x8 qf[4] = {P.q[0], P.q[1], P.q[2], P.q[3]};
            __syncthreads();
            const bool more = u + G < total; if (more) nxt = gat_decode(u + G);
            gat_compute(w, cur, qf, A.PM, A.LSEM0, A.LSEM1, [&]() { if (more) gat_issue(P, w, nxt, A.QB, A.KB, A.VB); });
            cur = nxt; } }
}
}

constexpr int PH_PRO = 0, PH_L0 = 1, PH_PER_LAYER = 10, PH_FINAL = PH_L0 + DEPTH * PH_PER_LAYER, PH_COUNT = PH_FINAL + 1;
typedef const __attribute__((address_space(4))) Args* KArgP;
#define KARG() ({ KArgP p_ = (KArgP)__builtin_amdgcn_kernarg_segment_ptr(); asm volatile("" : "+s"(p_)); p_; })
#define PHASE_IDS int lane_p = (int)__builtin_amdgcn_mbcnt_hi(~0u, __builtin_amdgcn_mbcnt_lo(~0u, 0u)); LAUNDER_V(lane_p); int tid_p = wave * 64 + lane_p; int gw_p = gw, G_p = G, NGW_p = NGW; LAUNDER_S(gw_p); LAUNDER_S(G_p); LAUNDER_S(NGW_p)
__global__ void __launch_bounds__(NTHREADS, 2) fwd(Args a_unused) {
    extern __shared__ __attribute__((aligned(16))) unsigned char lds_raw[];
    LAS unsigned char* lds = (LAS unsigned char*)lds_raw;
    volatile LAS unsigned* MISC = (volatile LAS unsigned*)(lds + MISC_OFF);
    const int wave = __builtin_amdgcn_readfirstlane((int)threadIdx.x >> 6);
    const int G = gridDim.x, bx = blockIdx.x;
    const int vcu = (G % 8 == 0) ? (bx % 8) * (G / 8) + bx / 8 : bx;
    const int gw = vcu * NWAVES + wave, NGW = G * NWAVES;
    for (int u = threadIdx.x; u < (LDS_BYTES - LDSCTL_OFF) / 4; u += NTHREADS) ((LAS unsigned*)(lds + LDSCTL_OFF))[u] = 0u;
    __syncthreads();
    int lo, hi; XcdBarrier bar;
    { KArgP ka = KARG(); lo = ka->ph_lo; hi = ka->ph_hi; unsigned* ctl = (unsigned*)(ka->ws + WS_CTL); bar = xcd_barrier_post(ctl + CW_BAR + ka->li * XCD_BAR_WORDS, MISC + 8, wave); }
#define IN(k) (lo <= (k) && (k) < hi)
#define SEAM(k) do { if (IN(k) && IN((k) + 1)) xcd_barrier(bar); } while (0)
#define WSP(T_, off) ((T_*)(ws + (off)))

    if (IN(PH_PRO)) { KArgP ka = KARG(); PHASE_IDS; Args a; a.ws = ka->ws; a.w_in = ka->w_in; a.w_out = ka->w_out; a.w_gate = ka->w_gate; a.w_up = ka->w_up; a.w_down = ka->w_down; a.ln2_g = ka->ln2_g; phase_prologue(a, lds, gw_p, NGW_p, wave, lane_p); } SEAM(PH_PRO);

    for (int l = 0; l < DEPTH; ++l) {
        const int p0 = PH_L0 + l * PH_PER_LAYER;
        if (hi <= p0 || lo >= p0 + PH_PER_LAYER) continue;
        if (IN(p0 + 0)) for (int rep_ = 0; rep_ < RPT(0); ++rep_) { if (rep_) xcd_barrier(bar); KArgP ka = KARG(); PHASE_IDS; unsigned char* ws = ka->ws;
            if (l == 0) phase_norm1(ka->x, ka->ln1_g, WSP(bf16_t, WS_HB), gw_p, NGW_p, lane_p, WSP(float, WS_KMEAN), WSP(bf16_t, WS_XB));
            else phase_norm1_b(WSP(bf16_t, WS_XB), ka->ln1_g + (size_t)l * DM, WSP(bf16_t, WS_HB), gw_p, NGW_p, lane_p, WSP(float, WS_KMEAN)); } SEAM(p0 + 0);
        if (IN(p0 + 1)) for (int rep_ = 0; rep_ < RPT(1); ++rep_) { if (rep_) xcd_barrier(bar); KArgP ka = KARG(); PHASE_IDS; unsigned char* ws = ka->ws;
            pg8::Gemm g{(const char*)(ws + WS_HB), (const char*)(ws + WS_WIN) + (size_t)l * NQKV * DM * 2, DM, DM, DM, (long)256 * DM * 2, (long)256 * DM * 2, (long)128 * DM * 2};
            pg8::StaticOrder S; S.init(T / 256, NQKV / 256, G_p, bx);
            pg8::EpiQKV E{WSP(bf16_t, WS_Q), (size_t)(WS_K - WS_Q) / 2, QSCALE};
            pg8::gemm_phase<pg8::EpiQKV, pg8::StaticOrder>(lds, g, S, E, wave);
        } SEAM(p0 + 1);
        if (IN(p0 + 4)) for (int rep_ = 0; rep_ < RPT(4); ++rep_) { if (rep_) xcd_barrier(bar); KArgP ka = KARG(); PHASE_IDS; unsigned char* ws = ka->ws;
            const att::AttnArgs A{WSP(bf16_t, WS_Q), WSP(bf16_t, WS_K), WSP(bf16_t, WS_V), (bf16_t*)ka->out, WSP(bf16_t, WS_HB), WSP(float, WS_LSE), WSP(unsigned, WS_CTL) + CW_MCNT + l * 512, WSP(unsigned, WS_QLIST),
                                  WSP(bf16_t, WS_PM), WSP(float, WS_LSEM0), WSP(float, WS_LSEM1), WSP(float, WS_KMEAN), WSP(unsigned, WS_CTL) + CW_GDONE + l * 64};
            att::attn_phase(lds, A, vcu, G_p, tid_p);
        } SEAM(p0 + 4);
        if (IN(p0 + 5)) { KArgP ka = KARG(); PHASE_IDS; unsigned char* ws = ka->ws;
            phase_mixnorm((const bf16_t*)ka->out, WSP(bf16_t, WS_HB), WSP(float, WS_LSE), WSP(bf16_t, WS_PM), WSP(float, WS_LSEM0), WSP(float, WS_LSEM1), ka->mix_g + (size_t)l * DM, gw_p, NGW_p, lane_p); } SEAM(p0 + 5);
        if (IN(p0 + 6)) { KArgP ka = KARG(); PHASE_IDS; unsigned char* ws = ka->ws;
            pg8::Gemm g{(const char*)(ws + WS_HB), (const char*)(ws + WS_WOUT) + (size_t)l * DM * DM * 2, DM, DM, DM, (long)256 * DM * 2, (long)256 * DM * 2, (long)128 * DM * 2};
            pg8::StaticOrder S; S.init(T / 256, DM / 256, G_p, bx);
            pg8::EpiResAdd E{WSP(bf16_t, WS_XB)};
            pg8::gemm_phase<pg8::EpiResAdd, pg8::StaticOrder>(lds, g, S, E, wave);
        } SEAM(p0 + 6);
        if (IN(p0 + 7)) { KArgP ka = KARG(); PHASE_IDS; unsigned char* ws = ka->ws;
            phase_route(WSP(bf16_t, WS_XB), ka->ln2_g + (size_t)l * DM, ka->w_gr + (size_t)l * DM * 4, ka->b_gr + l * 4, ka->w_er + (size_t)l * 4 * DM * 4, ka->b_er + l * 16, WSP(float, WS_LSE),
                        WSP(unsigned, WS_CTL) + CW_CNT + l * 32, WSP(unsigned, WS_LIST), WSP(float, WS_WLIST), lds, vcu, G_p, wave, lane_p); } SEAM(p0 + 7);
        if (IN(p0 + 8)) for (int rep_ = 0; rep_ < RPT(8); ++rep_) { if (rep_) xcd_barrier(bar); KArgP ka = KARG(); PHASE_IDS; unsigned char* ws = ka->ws;
            pg8::MoeProb<0> P{WSP(unsigned, WS_CTL) + CW_CNT + l * 32, WSP(unsigned, WS_LIST), (const char*)(ws + WS_XB), (const char*)(ws + WS_WG) + (size_t)l * NACT * DM * 2, DM, DM, DM, (long)(WS_WU - WS_WG), G_p, vcu, WSP(unsigned, WS_CTL) + CW_TCNT + l * 16384};
            pg8::EpiGateUpSparse E{WSP(bf16_t, WS_ACT), WSP(float, WS_WLIST), WSP(float, WS_LSE), WSP(unsigned, WS_CTL) + CW_TCNT + l * 16384};
            pg8::gemm_phase_x<pg8::EpiGateUpSparse, pg8::MoeProb<0>>(lds, P, E, wave);
        }
        if (IN(p0 + 9)) { KArgP ka = KARG(); PHASE_IDS; unsigned char* ws = ka->ws;
            pg8::MoeProb<1> P{WSP(unsigned, WS_CTL) + CW_CNT + l * 32, WSP(unsigned, WS_LIST), (const char*)(ws + WS_ACT), (const char*)(ws + WS_WD) + (size_t)l * DM * NACT * 2, 512, NACT, 512, (long)128 * NACT * 2, G_p, vcu, WSP(unsigned, WS_CTL) + CW_TCNT + l * 16384};
            pg8::EpiDownScatter E{WSP(bf16_t, WS_XB), WSP(unsigned, WS_LIST)};
            pg8::gemm_phase_x<pg8::EpiDownScatter, pg8::MoeProb<1>>(lds, P, E, wave);
        } SEAM(p0 + 9);
    }
    if (IN(PH_FINAL)) { KArgP ka = KARG(); PHASE_IDS; phase_final((const bf16_t*)(ka->ws + WS_XB), ka->fin_g, ka->out, gw_p, NGW_p, lane_p); }
#undef IN
#undef SEAM
#undef WSP
}

#ifndef N_LAUNCH_MODE
#define N_LAUNCH_MODE 1
#endif
extern "C" void kernel_launch(void* const* d_in, const int* in_sizes, int n_in, void* d_out, int out_size, void* d_ws, size_t ws_size, hipStream_t stream) {
    static int grid = 0;
    if (grid == 0) {
        if (n_in != 14 || in_sizes[0] != T * DM || out_size != T * DM || ws_size < WS_END) { fprintf(stderr, "kernel_launch: unexpected shapes (n_in %d in0 %d out %d ws %zu)\n", n_in, n_in > 0 ? in_sizes[0] : -1, out_size, ws_size); grid = -1; return; }
        int dev = 0, cus = 0, per_cu = 0;
        if (hipGetDevice(&dev) != hipSuccess || hipDeviceGetAttribute(&cus, hipDeviceAttributeMultiprocessorCount, dev) != hipSuccess) { grid = -1; return; }
        if (hipFuncSetAttribute((const void*)fwd, hipFuncAttributeMaxDynamicSharedMemorySize, LDS_BYTES) != hipSuccess) { fprintf(stderr, "kernel_launch: hipFuncSetAttribute failed\n"); grid = -1; return; }
        if (hipOccupancyMaxActiveBlocksPerMultiprocessor(&per_cu, (const void*)fwd, NTHREADS, LDS_BYTES) != hipSuccess || per_cu < 1) fprintf(stderr, "kernel_launch: occupancy query says %d\n", per_cu);
        (void)hipGetLastError();
        grid = cus;
    }
    if (grid < 0) return;
    if (hipMemsetAsync((char*)d_ws + WS_CTL, 0, CTL_ZERO_BYTES, stream) != hipSuccess) return;
    Args a{};
    a.x = (const float*)d_in[0]; a.ln1_g = (const float*)d_in[1]; a.w_in = (const float*)d_in[2]; a.mix_g = (const float*)d_in[3]; a.w_out = (const float*)d_in[4]; a.ln2_g = (const float*)d_in[5];
    a.w_gr = (const float*)d_in[6]; a.b_gr = (const float*)d_in[7]; a.w_er = (const float*)d_in[8]; a.b_er = (const float*)d_in[9]; a.w_gate = (const float*)d_in[10]; a.w_up = (const float*)d_in[11];
    a.w_down = (const float*)d_in[12]; a.fin_g = (const float*)d_in[13];
    a.out = (float*)d_out; a.ws = (unsigned char*)d_ws; a.pad = 0;
#if N_LAUNCH_MODE == 1
    a.ph_lo = 0; a.ph_hi = PH_COUNT; a.li = 0;
    hipLaunchKernelGGL(fwd, dim3(grid), dim3(NTHREADS), LDS_BYTES, stream, a);
#else
    for (int p = 0; p < PH_COUNT; ++p) { a.ph_lo = p; a.ph_hi = p + 1; a.li = p; hipLaunchKernelGGL(fwd, dim3(grid), dim3(NTHREADS), LDS_BYTES, stream, a); }
#endif
}
```

```cpp
#include <hip/hip_runtime.h>
#include <cstdio>
#include <cstdint>

#define LAS __attribute__((address_space(3)))
#define GAS __attribute__((address_space(1)))
typedef unsigned short bf16_t;
typedef short bf16x8 __attribute__((ext_vector_type(8)));
typedef float f32x4 __attribute__((ext_vector_type(4)));
typedef float f32x2 __attribute__((ext_vector_type(2)));
typedef unsigned u32x4 __attribute__((ext_vector_type(4)));
typedef unsigned u32x2 __attribute__((ext_vector_type(2)));

#ifndef PROBE_REPEAT
#define PROBE_REPEAT 0
#endif
#define RPT(k) ((((PROBE_REPEAT) >> (k)) & 1) ? 2 : 1)
#ifndef MOE_SPARSE
#define MOE_SPARSE 1
#endif
#ifndef ATT_MOBA
#define ATT_MOBA 1
#endif
#ifndef ATT_SB
#define ATT_SB 1
#endif
#ifndef ATT_DIL
#define ATT_DIL 1
#endif
constexpr int BATCH = 4, SEQ = 8192, DM = 1024, DEPTH = 4, T = BATCH * SEQ, NH = 16, HD = 64;
constexpr int NQKV = 3 * DM, NEXP = 16, DEXP = 256, NACT = NEXP * DEXP;
constexpr float NORM_EPS = 1e-6f;
constexpr float LOG2E = 1.4426950408889634f;
constexpr float QSCALE = 0.125f * LOG2E;
constexpr int NWAVES = 8, NTHREADS = 512;

constexpr size_t MiB = 1u << 20;
constexpr size_t WS_CTL = 0, CTL_ZERO_BYTES = 1 * MiB;
constexpr size_t WS_WIN = 2 * MiB;
constexpr size_t WS_WOUT = 26 * MiB;
constexpr size_t WS_WG = 34 * MiB;
constexpr size_t WS_WU = 66 * MiB;
constexpr size_t WS_WD = 98 * MiB;
constexpr size_t WS_LSEM0 = 1 * MiB;
constexpr size_t WS_KMEAN = 130 * MiB;
constexpr size_t WS_HB = 131 * MiB;
constexpr size_t WS_Q = 195 * MiB, WS_K = 259 * MiB, WS_V = 323 * MiB, WS_XB = 387 * MiB;
constexpr size_t WS_ACT = WS_Q;
constexpr size_t WS_RSTD = 130 * MiB + 512 * 1024;
constexpr size_t WS_LSE = 451 * MiB;
constexpr size_t WS_LIST = 454 * MiB;
constexpr size_t WS_WLIST = 457 * MiB;
constexpr size_t WS_QLIST = WS_LIST;
constexpr size_t WS_PM = 463 * MiB;
constexpr size_t WS_LSEM1 = 511 * MiB;
constexpr size_t WS_END = 512 * MiB;
constexpr int QL_PER_BH = 126976;
constexpr int CW_GDONE = 1536;
constexpr int CW_MCNT = 2048;
constexpr int CW_CNT = 1024;
constexpr int CW_TCNT = 16384;
constexpr int CW_BAR = 4096;

constexpr int RING_BYTES = 131072;
constexpr int LDSCTL_OFF = 147456, MISC_OFF = LDSCTL_OFF + 320;
constexpr int LDS_BYTES = 148480;

__device__ __forceinline__ unsigned f2bf(float f) { unsigned u = __builtin_bit_cast(unsigned, f); return (u + 0x7fffu + ((u >> 16) & 1u)) >> 16; }
__device__ __forceinline__ unsigned pk2(float lo, float hi) { return f2bf(lo) | (f2bf(hi) << 16); }
__device__ __forceinline__ float bflo(unsigned w) { return __builtin_bit_cast(float, w << 16); }
__device__ __forceinline__ float bfhi(unsigned w) { return __builtin_bit_cast(float, w & 0xffff0000u); }
template <int M> __device__ __forceinline__ float swz_xor(float v) { return __builtin_bit_cast(float, __builtin_amdgcn_ds_swizzle(__builtin_bit_cast(int, v), 0x1f | (M << 10))); }
__device__ __forceinline__ void swap32(unsigned x, unsigned& lo_val, unsigned& hi_val) { unsigned y = x; asm volatile("" : "+v"(y)); auto rr = __builtin_amdgcn_permlane32_swap(x, y, false, false); lo_val = rr[0]; hi_val = rr[1]; }
__device__ __forceinline__ float sum_xor32(float v) { unsigned a, b; swap32(__builtin_bit_cast(unsigned, v), a, b); return __builtin_bit_cast(float, a) + __builtin_bit_cast(float, b); }
__device__ __forceinline__ float max_xor32(float v) { unsigned a, b; swap32(__builtin_bit_cast(unsigned, v), a, b); return fmaxf(__builtin_bit_cast(float, a), __builtin_bit_cast(float, b)); }
__device__ __forceinline__ float get_xor32(float v, int hi) { unsigned a, b; swap32(__builtin_bit_cast(unsigned, v), a, b); return __builtin_bit_cast(float, hi ? a : b); }
__device__ __forceinline__ int get_xor32i(int v, int hi) { unsigned a, b; swap32((unsigned)v, a, b); return (int)(hi ? a : b); }
template <int CTRL> __device__ __forceinline__ float dpp_mov(float v) { return __builtin_bit_cast(float, __builtin_amdgcn_update_dpp(0, __builtin_bit_cast(int, v), CTRL, 0xf, 0xf, false)); }
__device__ __forceinline__ float row_sum(float v) { v += dpp_mov<0xB1>(v); v += dpp_mov<0x4E>(v); v += dpp_mov<0x141>(v); v += dpp_mov<0x140>(v); return v; }
__device__ __forceinline__ float half_sum(float v) { v = row_sum(v); v += swz_xor<16>(v); return v; }
__device__ __forceinline__ float wave_sum(float v) { return sum_xor32(half_sum(v)); }
#define LDS_WAIT() asm volatile("s_waitcnt lgkmcnt(0)" ::: "memory")
#define LAUNDER_V(x) asm volatile("" : "+v"(x))
#define LAUNDER_S(x) asm volatile("" : "+s"(x))

namespace pg8 {
constexpr int BM = 256, BK = 64, HALF = 128, HTB = HALF * BK * 2, STAGE_BYTES = 8 * HTB, NXCD = 8, WGM = 8;
__host__ __device__ __forceinline__ int lds_byte(int r, int c) { const int st = (r >> 4) * 2 + (c >> 5), rr = r & 15, cc = c & 31, ob = rr * 64 + cc * 2; return st * 1024 + (ob ^ (((ob >> 9) & 1) << 5)); }
__host__ __device__ __forceinline__ void stage_rc(int b, int& R, int& C) { const int st = b / 1024, sb = b % 1024, swz = sb ^ (((sb >> 9) & 1) << 5); R = (st >> 1) * 16 + swz / 64; C = (st & 1) * 32 + (swz % 64) / 2; }
__host__ __device__ __forceinline__ int perm32(int rho) { const int n = rho >> 4, i = rho & 15; return 8 * (i >> 2) + 4 * n + (i & 3); }

struct Unit { int pm, pn, meta;
    __device__ __forceinline__ int bk() const { return meta & 31; } __device__ __forceinline__ int tib() const { return (meta >> 5) & 255; } __device__ __forceinline__ int nb() const { return meta >> 13; } };
struct Gemm { const char* A; const char* B; int lda, ldb, K; long tstepA, tstepB, hstepB; const float* rowvec; };
constexpr int RV_OFF = 140288;

struct StaticOrder {
    int nM, nN, nwg, G, c;
    __host__ __device__ void init(int nM_, int nN_, int G_, int c_) { nM = nM_; nN = nN_; nwg = nM * nN; G = G_; c = c_; }
    __host__ __device__ bool next(int i, Unit& u) const {
        const long L = (long)i * G + c; if (L >= nwg) return false;
        int wgid = (int)L; { const int q = nwg / NXCD, r = nwg % NXCD, xcd = wgid % NXCD, off = wgid / NXCD; wgid = (xcd < r ? xcd * (q + 1) : r * (q + 1) + (xcd - r) * q) + off; }
        const int nig = WGM * nN, gid = wgid / nig, fm = gid * WGM, gsz = (nM - fm) < WGM ? (nM - fm) : WGM;
        u.pm = fm + ((wgid % nig) % gsz); u.pn = (wgid % nig) / gsz; return true;
    }
};

__device__ __forceinline__ unsigned cvt_pk_bf16(float lo, float hi) { unsigned r; asm volatile("v_cvt_pk_bf16_f32 %0, %1, %2" : "=v"(r) : "v"(lo), "v"(hi)); return r; }

struct EpiQKV {
    static constexpr bool PERM = true, ROWVEC = true;
    bf16_t* O; size_t split_stride; float scale0;
    __device__ __forceinline__ void operator()(const f32x4 (&acc)[2][2][4][2], const Unit& u, int wr, int wc, int fr, int fq, const LAS float* rv) const {
        asm volatile("" : "+v"(fr), "+v"(fq));
        float rs[2][4];
#pragma unroll
        for (int ai = 0; ai < 2; ++ai)
#pragma unroll
            for (int m = 0; m < 4; ++m) rs[ai][m] = rv[ai * HALF + wr * 64 + m * 16 + fr];
        const int row0 = u.pm * BM + wr * 64 + fr; int colt = u.pn * BM;
        const int t = colt / DM; bf16_t* base = O + (size_t)t * split_stride; colt -= t * DM; const float sc = (t == 0) ? scale0 : 1.f;
        const int col0 = colt + wc * 32 + 8 * fq;
#pragma unroll
        for (int ai = 0; ai < 2; ++ai)
#pragma unroll
            for (int m = 0; m < 4; ++m) { bf16_t* rowp = base + (size_t)(row0 + ai * HALF + m * 16) * DM + col0;
#pragma unroll
                for (int bj = 0; bj < 2; ++bj) { const float sr = sc * rs[ai][m]; f32x4 v0 = acc[ai][bj][m][0] * sr, v1 = acc[ai][bj][m][1] * sr;
                    u32x4 w; w.x = cvt_pk_bf16(v0[0], v0[1]); w.y = cvt_pk_bf16(v0[2], v0[3]); w.z = cvt_pk_bf16(v1[0], v1[1]); w.w = cvt_pk_bf16(v1[2], v1[3]);
                    *(u32x4*)(rowp + bj * HALF) = w; } }
        if (u.pn == 4) {
            float* kmean = (float*)((unsigned char*)O - WS_Q + WS_KMEAN) + ((size_t)((u.pm >> 5) * 4) * 32 + (u.pm & 31)) * HD;
#pragma unroll
            for (int bj = 0; bj < 2; ++bj)
#pragma unroll
                for (int n = 0; n < 2; ++n)
#pragma unroll
                    for (int j = 0; j < 4; ++j) { float cs = 0.f;
#pragma unroll
                        for (int ai = 0; ai < 2; ++ai)
#pragma unroll
                            for (int m = 0; m < 4; ++m) cs += acc[ai][bj][m][n][j] * rs[ai][m];
                        cs = row_sum(cs);
                        const int col = bj * HALF + wc * 32 + 8 * fq + 4 * n + j;
                        if (fr == 0) __hip_atomic_fetch_add(kmean + (size_t)(col >> 6) * 32 * HD + (col & 63), cs, __ATOMIC_RELAXED, __HIP_MEMORY_SCOPE_AGENT); }
        }
    }
};
struct EpiResAdd {
    static constexpr bool PERM = true, ROWVEC = false;
    bf16_t* xb;
    __device__ __forceinline__ void operator()(const f32x4 (&acc)[2][2][4][2], const Unit& u, int wr, int wc, int fr, int fq, const LAS float*) const {
        asm volatile("" : "+v"(fr), "+v"(fq));
        const int col0 = u.pn * BM + wc * 32 + 8 * fq;
#pragma unroll
        for (int ai = 0; ai < 2; ++ai) { u32x4 r[4][2];
#pragma unroll
            for (int m = 0; m < 4; ++m) { const bf16_t* rowp = xb + (size_t)(u.pm * BM + ai * HALF + wr * 64 + m * 16 + fr) * DM + col0;
#pragma unroll
                for (int bj = 0; bj < 2; ++bj) r[m][bj] = *(const u32x4*)(rowp + bj * HALF); }
#pragma unroll
            for (int m = 0; m < 4; ++m) { bf16_t* rowp = xb + (size_t)(u.pm * BM + ai * HALF + wr * 64 + m * 16 + fr) * DM + col0;
#pragma unroll
                for (int bj = 0; bj < 2; ++bj) { const f32x4 v0 = acc[ai][bj][m][0], v1 = acc[ai][bj][m][1]; const u32x4 q = r[m][bj];
                    u32x4 w; w.x = cvt_pk_bf16(bflo(q.x) + v0[0], bfhi(q.x) + v0[1]); w.y = cvt_pk_bf16(bflo(q.y) + v0[2], bfhi(q.y) + v0[3]);
                    w.z = cvt_pk_bf16(bflo(q.z) + v1[0], bfhi(q.z) + v1[1]); w.w = cvt_pk_bf16(bflo(q.w) + v1[2], bfhi(q.w) + v1[3]);
                    *(u32x4*)(rowp + bj * HALF) = w; } } }
    }
};
struct EpiGateUpDense {
    static constexpr bool PERM = true;
    bf16_t* act; const float* comb;
    __device__ __forceinline__ void operator()(const f32x4 (&acc)[2][2][4][2], const Unit& u, int wr, int wc, int fr, int fq) const {
        asm volatile("" : "+v"(fr), "+v"(fq));
        const int e = u.pn >> 1, c0 = (u.pn & 1) * HALF;
        const int col0 = e * DEXP + c0 + wc * 32 + 8 * fq;
#pragma unroll
        for (int ai = 0; ai < 2; ++ai)
#pragma unroll
            for (int m = 0; m < 4; ++m) { const int row = u.pm * BM + ai * HALF + wr * 64 + m * 16 + fr;
                const float cw = comb[(size_t)row * NEXP + e];
                float o[8];
#pragma unroll
                for (int n = 0; n < 2; ++n)
#pragma unroll
                    for (int j = 0; j < 4; ++j) { const float g = acc[ai][0][m][n][j], up = acc[ai][1][m][n][j];
                        const float sg = g * __builtin_amdgcn_rcpf(1.f + __builtin_amdgcn_exp2f(-g * LOG2E));
                        o[n * 4 + j] = sg * up * cw; }
                u32x4 w; w.x = cvt_pk_bf16(o[0], o[1]); w.y = cvt_pk_bf16(o[2], o[3]); w.z = cvt_pk_bf16(o[4], o[5]); w.w = cvt_pk_bf16(o[6], o[7]);
                *(u32x4*)(act + (size_t)row * NACT + col0) = w; }
    }
};

template <class Epi, class Sched>
__device__ __forceinline__ void gemm_phase(LAS unsigned char* lds, const Gemm g, const Sched& S, const Epi& E, int wave_id) {
    int lane_l = (int)__builtin_amdgcn_mbcnt_hi(~0u, __builtin_amdgcn_mbcnt_lo(~0u, 0u)); asm volatile("" : "+v"(lane_l));
    const int wid = wave_id, lane = lane_l, tid = wid * 64 + lane, wr = wid >> 2, wc = wid & 3, fr = lane & 15, fq = lane >> 4;
    const int K = g.K, nt = K / BK;
    unsigned voffA[2], voffB[2];
#pragma unroll
    for (int i = 0; i < 2; ++i) { int R, C; stage_rc(tid * 16 + i * 8192, R, C); const int Rb = Epi::PERM ? ((R & ~31) + perm32(R & 31)) : R;
        voffA[i] = (unsigned)(R * g.lda + C) * 2u; voffB[i] = (unsigned)(Rb * g.ldb + C) * 2u; }
    const size_t kstep = (size_t)(BK * 2);
    const size_t hstepA = (size_t)HALF * g.lda * 2;
    const long hstepB = g.hstepB;
    const unsigned ldsw = (unsigned)wid * 1024u;
    const int aoff = lds_byte(wr * 64 + fr, fq * 8), boff = lds_byte(wc * 32 + fr, fq * 8);
#define PG8_SA(b, h) (((b) * 2 + (h)) * HTB)
#define PG8_SB(b, h) ((4 + (b) * 2 + (h)) * HTB)
#define PG8_STAGE(bufoff, gbase, voff) do { _Pragma("unroll") for (int _i = 0; _i < 2; ++_i) \
        __builtin_amdgcn_global_load_lds((const unsigned*)((const char*)(gbase) + (voff)[_i]), (LAS unsigned*)(lds + (bufoff) + ldsw + _i * 8192), 16, 0, 0); } while (0)
#define PG8_LDA(dst, b, h) do { _Pragma("unroll") for (int m = 0; m < 4; ++m) _Pragma("unroll") for (int k = 0; k < 2; ++k) dst[m][k] = *(const LAS bf16x8*)(lds + PG8_SA(b, h) + aoff + m * 2048 + k * 1024); } while (0)
#define PG8_LDB(dst, b, h) do { _Pragma("unroll") for (int n = 0; n < 2; ++n) _Pragma("unroll") for (int k = 0; k < 2; ++k) dst[n][k] = *(const LAS bf16x8*)(lds + PG8_SB(b, h) + boff + n * 2048 + k * 1024); } while (0)
#define PG8_MMA(ai, bj, At, Bt) do { __builtin_amdgcn_s_setprio(1); _Pragma("unroll") for (int m = 0; m < 4; ++m) _Pragma("unroll") for (int n = 0; n < 2; ++n) _Pragma("unroll") for (int k = 0; k < 2; ++k) \
        acc[ai][bj][m][n] = __builtin_amdgcn_mfma_f32_16x16x32_bf16(Bt[n][k], At[m][k], acc[ai][bj][m][n], 0, 0, 0); __builtin_amdgcn_s_setprio(0); } while (0)
#define PG8_WAIT_V(n) asm volatile("s_waitcnt vmcnt(" #n ")" ::: "memory")
#define PG8_WAIT_L(n) asm volatile("s_waitcnt lgkmcnt(" #n ")" ::: "memory")
#define PG8_BAR __builtin_amdgcn_s_barrier()
#define PG8_SCHED __builtin_amdgcn_sched_barrier(0)
    Unit cur, nxt; int ui = 0;
    if (!S.next(0, cur)) return;
#define PG8_RV(u_, b_) do { if (Epi::ROWVEC && wid < 4) __builtin_amdgcn_global_load_lds((const unsigned*)(g.rowvec + (size_t)(u_).pm * BM + wid * 64 + lane), (LAS unsigned*)(lds + RV_OFF + (b_) * 1024 + wid * 256), 4, 0, 0); } while (0)
    PG8_RV(cur, 0);
    f32x4 acc[2][2][4][2];
#pragma unroll
    for (int a = 0; a < 2; ++a)
#pragma unroll
        for (int b = 0; b < 2; ++b)
#pragma unroll
            for (int m = 0; m < 4; ++m)
#pragma unroll
                for (int n = 0; n < 2; ++n) acc[a][b][m][n] = (f32x4){0.f, 0.f, 0.f, 0.f};
    bf16x8 At[4][2], B0[2][2], B1[2][2];
    const char* cA = g.A + (size_t)cur.pm * g.tstepA; const char* cB = g.B + (size_t)cur.pn * g.tstepB;
    PG8_STAGE(PG8_SB(0, 0), cB, voffB); PG8_STAGE(PG8_SB(0, 1), cB + hstepB, voffB); PG8_STAGE(PG8_SA(0, 0), cA, voffA); PG8_STAGE(PG8_SA(0, 1), cA + hstepA, voffA);
    if (wr == 1) PG8_BAR;
    PG8_WAIT_V(2); PG8_BAR;
    PG8_STAGE(PG8_SB(1, 0), cB + kstep, voffB); PG8_STAGE(PG8_SA(1, 0), cA + kstep, voffA); PG8_STAGE(PG8_SB(1, 1), cB + hstepB + kstep, voffB);
    PG8_WAIT_V(6); PG8_BAR;
    for (;;) {
        const bool has_next = S.next(ui + 1, nxt);
        const char* nA = has_next ? g.A + (size_t)nxt.pm * g.tstepA : cA; const char* nB = has_next ? g.B + (size_t)nxt.pn * g.tstepB : cB;
        for (int t = 0; t < nt; t += 2) {
            const bool last = (t == nt - 2);
            const char* a1 = cA + (size_t)(t + 1) * kstep;
            const char* a2 = last ? nA : cA + (size_t)(t + 2) * kstep; const char* b2 = last ? nB : cB + (size_t)(t + 2) * kstep;
            const char* a3 = a2 + kstep; const char* b3 = b2 + kstep;
            PG8_LDB(B0, 0, 0); PG8_LDB(B1, 0, 1); PG8_SCHED; PG8_LDA(At, 0, 0); PG8_STAGE(PG8_SA(1, 1), a1 + hstepA, voffA);
            PG8_WAIT_V(8); PG8_WAIT_L(0); PG8_BAR; PG8_MMA(0, 0, At, B0); PG8_MMA(0, 1, At, B1); PG8_BAR; PG8_SCHED;
            PG8_LDA(At, 0, 1); PG8_STAGE(PG8_SB(0, 0), b2, voffB); PG8_STAGE(PG8_SB(0, 1), b2 + hstepB, voffB); PG8_STAGE(PG8_SA(0, 0), a2, voffA);
            PG8_WAIT_V(8); PG8_WAIT_L(0); PG8_BAR; PG8_MMA(1, 0, At, B0); PG8_MMA(1, 1, At, B1); PG8_BAR; PG8_SCHED;
            PG8_LDB(B0, 1, 0); PG8_LDB(B1, 1, 1); PG8_SCHED; PG8_LDA(At, 1, 0); PG8_STAGE(PG8_SA(0, 1), a2 + hstepA, voffA);
            PG8_WAIT_V(8); PG8_WAIT_L(0); PG8_BAR; PG8_MMA(0, 0, At, B0); PG8_MMA(0, 1, At, B1); PG8_BAR; PG8_SCHED;
            PG8_LDA(At, 1, 1); PG8_STAGE(PG8_SB(1, 0), b3, voffB); PG8_STAGE(PG8_SB(1, 1), b3 + hstepB, voffB); PG8_STAGE(PG8_SA(1, 0), a3, voffA);
            PG8_WAIT_V(8); PG8_WAIT_L(0); PG8_BAR; PG8_MMA(1, 0, At, B0); PG8_MMA(1, 1, At, B1); PG8_BAR; PG8_SCHED;
        }
        if (wr == 0) PG8_BAR;
        E(acc, cur, wr, wc, fr, fq, (const LAS float*)(lds + RV_OFF + (ui & 1) * 1024));
        if (!has_next) break;
#pragma unroll
        for (int a = 0; a < 2; ++a)
#pragma unroll
            for (int b = 0; b < 2; ++b)
#pragma unroll
                for (int m = 0; m < 4; ++m)
#pragma unroll
                    for (int n = 0; n < 2; ++n) acc[a][b][m][n] = (f32x4){0.f, 0.f, 0.f, 0.f};
        cur = nxt; cA = nA; cB = nB; ++ui;
        PG8_RV(cur, ui & 1);
        if (wr == 1) PG8_BAR;
    }
    PG8_WAIT_V(0);
    PG8_BAR;
#undef PG8_SA
#undef PG8_SB
#undef PG8_STAGE
#undef PG8_LDA
#undef PG8_LDB
#undef PG8_MMA
#undef PG8_WAIT_V
#undef PG8_WAIT_L
#undef PG8_BAR
#undef PG8_SCHED
#undef PG8_RV
}
template <class Epi, class Prob>
__device__ __forceinline__ void gemm_phase_x(LAS unsigned char* lds, const Prob& P, const Epi& E, int wave_id) {
    int lane_l = (int)__builtin_amdgcn_mbcnt_hi(~0u, __builtin_amdgcn_mbcnt_lo(~0u, 0u)); asm volatile("" : "+v"(lane_l));
    const int wid = wave_id, lane = lane_l, tid = wid * 64 + lane, wr = wid >> 2, wc = wid & 3, fr = lane & 15, fq = lane >> 4;
    const int K = P.K, nt = K / BK;
    unsigned voffB[2];
#pragma unroll
    for (int i = 0; i < 2; ++i) { int R, C; stage_rc(tid * 16 + i * 8192, R, C); const int Rb = Epi::PERM ? ((R & ~31) + perm32(R & 31)) : R; voffB[i] = (unsigned)(Rb * P.ldb + C) * 2u; }
    const size_t kstep = (size_t)(BK * 2);
    const long hstepB = P.hstepB;
    const unsigned ldsw = (unsigned)wid * 1024u;
    const int aoff = lds_byte(wr * 64 + fr, fq * 8), boff = lds_byte(wc * 32 + fr, fq * 8);
    LAS u32x4* stash = (LAS u32x4*)(lds + STAGE_BYTES + 1024) + tid;
#define PG8_SA(b, h) (((b) * 2 + (h)) * HTB)
#define PG8_SB(b, h) ((4 + (b) * 2 + (h)) * HTB)
#define PG8_STAGE(bufoff, gbase, voff) do { _Pragma("unroll") for (int _i = 0; _i < 2; ++_i) \
        __builtin_amdgcn_global_load_lds((const unsigned*)((const char*)(gbase) + (voff)[_i]), (LAS unsigned*)(lds + (bufoff) + ldsw + _i * 8192), 16, 0, 0); } while (0)
#define PG8_LDA(dst, b, h) do { _Pragma("unroll") for (int m = 0; m < 4; ++m) _Pragma("unroll") for (int k = 0; k < 2; ++k) dst[m][k] = *(const LAS bf16x8*)(lds + PG8_SA(b, h) + aoff + m * 2048 + k * 1024); } while (0)
#define PG8_LDB(dst, b, h) do { _Pragma("unroll") for (int n = 0; n < 2; ++n) _Pragma("unroll") for (int k = 0; k < 2; ++k) dst[n][k] = *(const LAS bf16x8*)(lds + PG8_SB(b, h) + boff + n * 2048 + k * 1024); } while (0)
#define PG8_MMA(ai, bj, At, Bt) do { __builtin_amdgcn_s_setprio(1); _Pragma("unroll") for (int m = 0; m < 4; ++m) _Pragma("unroll") for (int n = 0; n < 2; ++n) _Pragma("unroll") for (int k = 0; k < 2; ++k) \
        acc[ai][bj][m][n] = __builtin_amdgcn_mfma_f32_16x16x32_bf16(Bt[n][k], At[m][k], acc[ai][bj][m][n], 0, 0, 0); __builtin_amdgcn_s_setprio(0); } while (0)
#define PG8_WAIT_V(n) asm volatile("s_waitcnt vmcnt(" #n ")" ::: "memory")
#define PG8_WAIT_L(n) asm volatile("s_waitcnt lgkmcnt(" #n ")" ::: "memory")
#define PG8_BAR __builtin_amdgcn_s_barrier()
#define PG8_SCHED __builtin_amdgcn_sched_barrier(0)
#define PG8_AVOFF(dst, u) do { int t2_ = tid; asm volatile("" : "+v"(t2_)); _Pragma("unroll") for (int i_ = 0; i_ < 2; ++i_) { int R_, C_; stage_rc(t2_ * 16 + i_ * 8192, R_, C_); _Pragma("unroll") for (int h_ = 0; h_ < 2; ++h_) \
        dst[h_][i_] = (Prob::GATHER ? P.arow_off(u, h_, R_) : (unsigned)((h_ * HALF + R_) * P.lda) * 2u) + (unsigned)C_ * 2u; } } while (0)
    Unit cur, nxt; int ui = 0;
    if (!P.next(0, cur)) return;
    unsigned vA[2][2];
    PG8_AVOFF(vA, cur);
    f32x4 acc[2][2][4][2];
#pragma unroll
    for (int a = 0; a < 2; ++a)
#pragma unroll
        for (int b = 0; b < 2; ++b)
#pragma unroll
            for (int m = 0; m < 4; ++m)
#pragma unroll
                for (int n = 0; n < 2; ++n) acc[a][b][m][n] = (f32x4){0.f, 0.f, 0.f, 0.f};
    bf16x8 At[4][2], B0[2][2], B1[2][2];
    const char* cA = P.a_base(cur); const char* cB = P.b_base(cur);
    long csplit = Prob::KSPLIT ? P.bsplit(cur) : 0;
    if (Prob::WAITS) P.a_ready(cur, wid);
    PG8_STAGE(PG8_SB(0, 0), cB, voffB); PG8_STAGE(PG8_SB(0, 1), cB + hstepB, voffB); PG8_STAGE(PG8_SA(0, 0), cA, vA[0]); PG8_STAGE(PG8_SA(0, 1), cA, vA[1]);
    if (wr == 1) PG8_BAR;
    PG8_WAIT_V(2); PG8_BAR;
    PG8_STAGE(PG8_SB(1, 0), cB + kstep, voffB); PG8_STAGE(PG8_SA(1, 0), cA + kstep, vA[0]); PG8_STAGE(PG8_SB(1, 1), cB + hstepB + kstep, voffB);
    PG8_WAIT_V(6); PG8_BAR;
    for (;;) {
        const bool has_next = P.next(ui + 1, nxt);
        const char* nA = has_next ? P.a_base(nxt) : cA; const char* nB = has_next ? P.b_base(nxt) : cB;
        if (Prob::GATHER) { unsigned vN[2][2];
            if (has_next) { PG8_AVOFF(vN, nxt); } else { vN[0][0] = vA[0][0]; vN[0][1] = vA[0][1]; vN[1][0] = vA[1][0]; vN[1][1] = vA[1][1]; }
            *stash = (u32x4){vN[0][0], vN[0][1], vN[1][0], vN[1][1]}; }
        for (int t = 0; t < nt; t += 2) {
            const bool last = (t == nt - 2);
            if (Prob::WAITS && last && has_next) P.a_ready(nxt, wid);
            const char* a1 = cA + (size_t)(t + 1) * kstep;
            const char* a2 = last ? nA : cA + (size_t)(t + 2) * kstep;
            const char* b2 = last ? nB : cB + (size_t)(t + 2) * kstep + ((Prob::KSPLIT && (t + 2) >= (nt >> 1)) ? csplit : 0);
            const char* a3 = a2 + kstep; const char* b3 = b2 + kstep;
            PG8_LDB(B0, 0, 0); PG8_LDB(B1, 0, 1); PG8_SCHED; PG8_LDA(At, 0, 0); PG8_STAGE(PG8_SA(1, 1), a1, vA[1]);
            if (Prob::GATHER && last) { const u32x4 sv = *stash; vA[0][0] = sv.x; vA[0][1] = sv.y; vA[1][0] = sv.z; vA[1][1] = sv.w; }
            PG8_WAIT_V(8); PG8_WAIT_L(0); PG8_BAR; PG8_MMA(0, 0, At, B0); PG8_MMA(0, 1, At, B1); PG8_BAR; PG8_SCHED;
            PG8_LDA(At, 0, 1); PG8_STAGE(PG8_SB(0, 0), b2, voffB); PG8_STAGE(PG8_SB(0, 1), b2 + hstepB, voffB); PG8_STAGE(PG8_SA(0, 0), a2, vA[0]);
            PG8_WAIT_V(8); PG8_WAIT_L(0); PG8_BAR; PG8_MMA(1, 0, At, B0); PG8_MMA(1, 1, At, B1); PG8_BAR; PG8_SCHED;
            PG8_LDB(B0, 1, 0); PG8_LDB(B1, 1, 1); PG8_SCHED; PG8_LDA(At, 1, 0); PG8_STAGE(PG8_SA(0, 1), a2, vA[1]);
            PG8_WAIT_V(8); PG8_WAIT_L(0); PG8_BAR; PG8_MMA(0, 0, At, B0); PG8_MMA(0, 1, At, B1); PG8_BAR; PG8_SCHED;
            PG8_LDA(At, 1, 1); PG8_STAGE(PG8_SB(1, 0), b3, voffB); PG8_STAGE(PG8_SB(1, 1), b3 + hstepB, voffB); PG8_STAGE(PG8_SA(1, 0), a3, vA[0]);
            PG8_WAIT_V(8); PG8_WAIT_L(0); PG8_BAR; PG8_MMA(1, 0, At, B0); PG8_MMA(1, 1, At, B1); PG8_BAR; PG8_SCHED;
        }
        if (wr == 0) PG8_BAR;
        E(acc, cur, wr, wc, fr, fq);
        if (!has_next) break;
#pragma unroll
        for (int a = 0; a < 2; ++a)
#pragma unroll
            for (int b = 0; b < 2; ++b)
#pragma unroll
                for (int m = 0; m < 4; ++m)
#pragma unroll
                    for (int n = 0; n < 2; ++n) acc[a][b][m][n] = (f32x4){0.f, 0.f, 0.f, 0.f};
        cur = nxt; cA = nA; cB = nB; ++ui;
        if (Prob::KSPLIT) csplit = P.bsplit(cur);
        if (wr == 1) PG8_BAR;
    }
    PG8_WAIT_V(0);
    PG8_BAR;
#undef PG8_SA
#undef PG8_SB
#undef PG8_STAGE
#undef PG8_LDA
#undef PG8_LDB
#undef PG8_MMA
#undef PG8_WAIT_V
#undef PG8_WAIT_L
#undef PG8_BAR
#undef PG8_SCHED
#undef PG8_AVOFF
}

__device__ __forceinline__ int pair_a(int pi) { return pi < 3 ? 0 : (pi < 5 ? 1 : 2); }
__device__ __forceinline__ int pair_b(int pi) { return pi == 0 ? 1 : ((pi == 1 || pi == 3) ? 2 : 3); }
template <int MODE>
struct MoeProb {
    static constexpr bool GATHER = (MODE == 0), KSPLIT = (MODE == 1);
    const unsigned* cnt; const unsigned* list; const char* A; const char* B; int lda, ldb, K; long hstepB; int G, c; unsigned* tcnt;
    static constexpr bool WAITS = (MODE == 1);
    __device__ __forceinline__ void a_ready(const Unit& u, int wave) const {
        if (MODE == 1) {
            if (wave == 0) { unsigned polls = 0;
                while ((unsigned)__builtin_amdgcn_readfirstlane(__hip_atomic_load(tcnt + 64 * u.pm, __ATOMIC_RELAXED, __HIP_MEMORY_SCOPE_AGENT)) < 32u) {
                    if (++polls > (1u << 20)) break;
                    __builtin_amdgcn_s_sleep(2); }
                __builtin_amdgcn_fence(__ATOMIC_ACQUIRE, "agent");
                asm volatile("s_waitcnt vmcnt(0)" ::: "memory"); }
            asm volatile("" ::: "memory"); __builtin_amdgcn_s_barrier(); asm volatile("" ::: "memory");
        }
    }
    __device__ __forceinline__ bool next(int i, Unit& u) const {
        long L = (long)i * G + c;
        if (MODE == 1) {
            int tot = 0;
            for (int k = 0; k < 24; ++k) tot += ((int)cnt[k] + 255) >> 8;
            const int N = 4 * tot, R = N - 2 * G;
            if (R > 0 && R < G) { if (c < R) { if (i > 0) return false; L = c; } else L = (i == 0) ? c : (long)G + (c - R) + (long)(i - 1) * (G - R); }
            else L = (long)i * G + (G - 1 - c);
        }
        const int tileidx = (int)(L >> 2);
        int accu = 0, bk = -1, tib = 0, nb = 0;
        for (int k = 0; k < 24; ++k) { const int n = (int)cnt[k]; const int tl = (n + 255) >> 8; if (bk < 0 && tileidx < accu + tl) { bk = k; tib = tileidx - accu; nb = n; } accu += tl; }
        if (bk < 0) return false;
        u.pm = tileidx; u.pn = (int)(L & 3); u.meta = bk | (tib << 5) | (nb << 13); return true;
    }
    __device__ __forceinline__ int expert(const Unit& u, int s) const { const int g = u.bk() / 6, pi = u.bk() % 6; return g * 4 + (s ? pair_b(pi) : pair_a(pi)); }
    __device__ __forceinline__ const char* a_base(const Unit& u) const { return MODE == 0 ? A : A + (size_t)u.pm * 256 * lda * 2; }
    __device__ __forceinline__ const char* b_base(const Unit& u) const {
        if (MODE == 0) return B + ((size_t)expert(u, u.pn >> 1) * DEXP + (size_t)(u.pn & 1) * HALF) * ldb * 2;
        return B + (size_t)u.pn * 256 * ldb * 2 + (size_t)expert(u, 0) * DEXP * 2;
    }
    __device__ __forceinline__ unsigned arow_off(const Unit& u, int h, int R) const { const int pos = u.tib() * 256 + h * HALF + R; const unsigned tok = pos < u.nb() ? list[(size_t)u.bk() * T + pos] : 0u; return tok * (unsigned)(lda * 2); }
    __device__ __forceinline__ long bsplit(const Unit& u) const { return ((long)(expert(u, 1) - expert(u, 0)) * DEXP - DEXP) * 2; }
};
struct EpiGateUpSparse {
    static constexpr bool PERM = true;
    bf16_t* act; const float* wlist; const float* rlist; unsigned* tcnt;
    __device__ __forceinline__ void operator()(const f32x4 (&acc)[2][2][4][2], const Unit& u, int wr, int wc, int fr, int fq) const {
        asm volatile("" : "+v"(fr), "+v"(fq));
        const int s = u.pn >> 1, col0 = s * DEXP + (u.pn & 1) * HALF + wc * 32 + 8 * fq;
        const __amdgpu_buffer_rsrc_t rs_act = __builtin_amdgcn_make_buffer_rsrc((void*)act, (short)0, 0x7fffffff, 0x00020000);
#pragma unroll
        for (int ai = 0; ai < 2; ++ai)
#pragma unroll
            for (int m = 0; m < 4; ++m) { const int r = ai * HALF + wr * 64 + m * 16 + fr, pos = u.tib() * 256 + r;
                const float cw = pos < u.nb() ? wlist[((size_t)u.bk() * T + pos) * 2 + s] : 0.f; const float rs = pos < u.nb() ? rlist[(size_t)u.bk() * T + pos] : 0.f;
                float o[8];
#pragma unroll
                for (int n = 0; n < 2; ++n)
#pragma unroll
                    for (int j = 0; j < 4; ++j) { const float g = acc[ai][0][m][n][j] * rs, up = acc[ai][1][m][n][j] * rs;
                        const float sg = g * __builtin_amdgcn_rcpf(1.f + __builtin_amdgcn_exp2f(-g * LOG2E));
                        o[n * 4 + j] = sg * up * cw; }
                u32x4 w; w.x = cvt_pk_bf16(o[0], o[1]); w.y = cvt_pk_bf16(o[2], o[3]); w.z = cvt_pk_bf16(o[4], o[5]); w.w = cvt_pk_bf16(o[6], o[7]);
                __builtin_amdgcn_raw_buffer_store_b128(w, rs_act, (int)((((unsigned)u.pm * 256u + (unsigned)r) * 512u + (unsigned)col0) * 2u), 0, 16);
                if (m & 1) asm volatile("" ::: "memory"); }
        asm volatile("s_waitcnt vmcnt(0)" ::: "memory");
        if ((fr | fq) == 0) __hip_atomic_fetch_add(tcnt + 64 * u.pm, 1u, __ATOMIC_RELAXED, __HIP_MEMORY_SCOPE_AGENT);
    }
};
struct EpiDownScatter {
    static constexpr bool PERM = true;
    bf16_t* xb; const unsigned* list;
    __device__ __forceinline__ void operator()(const f32x4 (&acc)[2][2][4][2], const Unit& u, int wr, int wc, int fr, int fq) const {
        asm volatile("" : "+v"(fr), "+v"(fq));
        const int col0 = u.pn * BM + wc * 32 + 8 * fq;
        unsigned tok[8];
#pragma unroll
        for (int g = 0; g < 8; ++g) { const int pos = u.tib() * 256 + (g >> 2) * HALF + wr * 64 + (g & 3) * 16 + fr; tok[g] = pos < u.nb() ? list[(size_t)u.bk() * T + pos] : 0xffffffffu; }
#pragma unroll
        for (int ai = 0; ai < 2; ++ai) { u32x4 r[4][2];
#pragma unroll
            for (int m = 0; m < 4; ++m) { const unsigned tk = tok[ai * 4 + m]; const bf16_t* rowp = xb + (size_t)(tk != 0xffffffffu ? tk : 0u) * DM + col0;
#pragma unroll
                for (int bj = 0; bj < 2; ++bj) r[m][bj] = *(const u32x4*)(rowp + bj * HALF); }
#pragma unroll
            for (int m = 0; m < 4; ++m) { const unsigned tk = tok[ai * 4 + m];
                if (tk != 0xffffffffu) { bf16_t* rowp = xb + (size_t)tk * DM + col0;
#pragma unroll
                    for (int bj = 0; bj < 2; ++bj) { const f32x4 v0 = acc[ai][bj][m][0], v1 = acc[ai][bj][m][1]; const u32x4 q = r[m][bj];
                        u32x4 w; w.x = cvt_pk_bf16(bflo(q.x) + v0[0], bfhi(q.x) + v0[1]); w.y = cvt_pk_bf16(bflo(q.y) + v0[2], bfhi(q.y) + v0[3]);
                        w.z = cvt_pk_bf16(bflo(q.z) + v1[0], bfhi(q.z) + v1[1]); w.w = cvt_pk_bf16(bflo(q.w) + v1[2], bfhi(q.w) + v1[3]);
                        *(u32x4*)(rowp + bj * HALF) = w; } } } }
    }
};
}

#define XB_TMO      128
#define XB_XCNT(j)  (256  + 64 * (j))
#define XB_XSUB(j)  (1280 + 64 * (j))
#define XB_XGEN(j)  (2304 + 64 * (j))
#define XB_TOP      3328
#define XB_TOPGEN   3392
#define XCD_BAR_WORDS 3456
#define XB_SPIN_CAP (1u << 18)
__device__ __forceinline__ unsigned xb_ld(unsigned* p)              { return __hip_atomic_load(p, __ATOMIC_RELAXED, __HIP_MEMORY_SCOPE_AGENT); }
__device__ __forceinline__ unsigned xb_add(unsigned* p, unsigned v) { return __hip_atomic_fetch_add(p, v, __ATOMIC_RELAXED, __HIP_MEMORY_SCOPE_AGENT); }
__device__ __forceinline__ unsigned xb_xcc_id() { return (unsigned)__builtin_amdgcn_s_getreg((3 << 11) | 20) & 0xFu; }
#define XB_SPIN(cond, bar) do { unsigned _sp = 0; while (cond) { __builtin_amdgcn_s_sleep(1); \
    if ((++_sp & 255u) == 0u) { if (xb_ld(&(bar)[XB_TMO])) break; if (_sp > XB_SPIN_CAP) { atomicAdd(&(bar)[XB_TMO], 1u); break; } } } } while (0)
struct XcdBarrier { unsigned* bar; unsigned x; volatile LAS unsigned* st; int wave; };
__device__ __forceinline__ bool xb_thread0(int wave) { return wave == 0 && __builtin_amdgcn_mbcnt_hi(~0u, __builtin_amdgcn_mbcnt_lo(~0u, 0u)) == 0u; }
__device__ __forceinline__ XcdBarrier xcd_barrier_post(unsigned* bar, volatile LAS unsigned* st, int wave) {
    XcdBarrier b; b.bar = bar; b.x = xb_xcc_id(); b.st = st; b.wave = wave;
    if (xb_thread0(wave)) (void)xb_add(&bar[XB_XCNT(b.x)], 1u);
    return b;
}
__device__ __forceinline__ void xcd_barrier_complete(unsigned* bar, unsigned x, unsigned& nloc, unsigned& nx) {
    const unsigned G = gridDim.x * gridDim.y * gridDim.z;
    unsigned sum, cnt, mine, sp = 0u;
    for (;;) {
        sum = 0u; cnt = 0u; mine = 0u;
#pragma unroll
        for (unsigned j = 0; j < 16; ++j) { const unsigned c = xb_ld(&bar[XB_XCNT(j)]); sum += c; cnt += (c > 0u) ? 1u : 0u; mine = (j == x) ? c : mine; }
        if (sum == G) break;
        __builtin_amdgcn_s_sleep(1);
        if ((++sp & 255u) == 0u) { if (xb_ld(&bar[XB_TMO])) break; if (sp > XB_SPIN_CAP) { atomicAdd(&bar[XB_TMO], 1u); break; } }
    }
    nloc = mine > 0u ? mine : 1u; nx = cnt > 0u ? cnt : 1u;
}
__device__ __forceinline__ void xcd_barrier(const XcdBarrier& b) {
    asm volatile("s_waitcnt vmcnt(0)" ::: "memory");
    __syncthreads();
    if (xb_thread0(b.wave)) {
        unsigned* bar = b.bar;
        __builtin_amdgcn_s_waitcnt(0);
        unsigned nloc = b.st[0], nx = b.st[1];
        if (nloc == 0u) { xcd_barrier_complete(bar, b.x, nloc, nx); b.st[0] = nloc; b.st[1] = nx; }
        const unsigned old = xb_add(&bar[XB_XSUB(b.x)], 1u);
        const unsigned gen = old / nloc;
        if (old + 1u == (gen + 1u) * nloc) {
            __builtin_amdgcn_fence(__ATOMIC_RELEASE, "agent");
            asm volatile("s_waitcnt vmcnt(0)" ::: "memory");
            const unsigned og = xb_add(&bar[XB_TOP], 1u);
            const unsigned tg = og / nx;
            if (og + 1u == (tg + 1u) * nx) xb_add(&bar[XB_TOPGEN], 1u);
            else XB_SPIN(xb_ld(&bar[XB_TOPGEN]) == tg, bar);
            __builtin_amdgcn_fence(__ATOMIC_ACQUIRE, "agent");
            xb_add(&bar[XB_XGEN(b.x)], 1u);
            asm volatile("s_waitcnt vmcnt(0)" ::: "memory");
        } else {
            XB_SPIN(xb_ld(&bar[XB_XGEN(b.x)]) == gen, bar);
            __builtin_amdgcn_fence(__ATOMIC_ACQUIRE, "agent");
            asm volatile("s_waitcnt vmcnt(0)" ::: "memory");
        }
    }
    __syncthreads();
}

struct Args {
    const float* x; const float* ln1_g; const float* w_in; const float* mix_g; const float* w_out; const float* ln2_g;
    const float* w_gr; const float* b_gr; const float* w_er; const float* b_er; const float* w_gate; const float* w_up; const float* w_down; const float* fin_g;
    float* out; unsigned char* ws; int ph_lo, ph_hi, li, pad;
};

template <bool SC = false>
__device__ __forceinline__ void transpose_item(const float* W, int K, int N, bf16_t* WT, int dpitch, int dcol, LAS float* scr, int item, int lane, const float* ks = nullptr) {
    const int nblk = N / 32, kb = item / nblk, nb = item % nblk, k0 = 64 * kb, n0 = 32 * nb;
#pragma unroll 8
    for (int i = 0; i < 32; ++i) { const int kk = 2 * i + (lane >> 5); scr[kk * 33 + (lane & 31)] = W[(size_t)(k0 + kk) * N + n0 + (lane & 31)]; }
    LDS_WAIT(); asm volatile("" ::: "memory");
    const int c = lane & 7;
    f32x4 ga = (f32x4){1.f, 1.f, 1.f, 1.f}, gb = ga;
    if (SC) { ga = *(const f32x4*)(ks + k0 + 8 * c); gb = *(const f32x4*)(ks + k0 + 8 * c + 4); }
#pragma unroll
    for (int j = 0; j < 4; ++j) { const int n = (lane >> 3) + 8 * j; const LAS float* s = scr + (8 * c) * 33 + n;
        u32x4 o; o.x = pk2(s[0 * 33] * ga.x, s[1 * 33] * ga.y); o.y = pk2(s[2 * 33] * ga.z, s[3 * 33] * ga.w); o.z = pk2(s[4 * 33] * gb.x, s[5 * 33] * gb.y); o.w = pk2(s[6 * 33] * gb.z, s[7 * 33] * gb.w);
        *(u32x4*)(WT + (size_t)(n0 + n) * dpitch + dcol + k0 + 8 * c) = o; }
    LDS_WAIT(); asm volatile("" ::: "memory");
}
__device__ __forceinline__ void phase_prologue(const Args& a, LAS unsigned char* lds, int gw, int NGW, int wave, int lane) {
    LAS float* scr = (LAS float*)(lds + wave * 16384);
    constexpr int I_IN = (DM / 64) * (NQKV / 32);
    constexpr int I_OUT = (DM / 64) * (DM / 32);
    constexpr int I_G = (DM / 64) * (DEXP / 32);
    constexpr int I_D = (DEXP / 64) * (DM / 32);
    constexpr int N_IN = DEPTH * I_IN, N_OUT = DEPTH * I_OUT, N_G = DEPTH * NEXP * I_G, N_D = DEPTH * NEXP * I_D;
    constexpr int NITEMS = N_IN + N_OUT + 2 * N_G + N_D;
    bf16_t* WinT = (bf16_t*)(a.ws + WS_WIN); bf16_t* WoutT = (bf16_t*)(a.ws + WS_WOUT); bf16_t* WgT = (bf16_t*)(a.ws + WS_WG); bf16_t* WuT = (bf16_t*)(a.ws + WS_WU); bf16_t* WdT = (bf16_t*)(a.ws + WS_WD);
    for (int it = gw; it < NITEMS; it += NGW) {
        int r = it;
        if (r < N_IN) { const int l = r / I_IN; transpose_item<true>(a.w_in + (size_t)l * DM * NQKV, DM, NQKV, WinT + (size_t)l * NQKV * DM, DM, 0, scr, r % I_IN, lane, a.ln1_g + (size_t)l * DM); continue; } r -= N_IN;
        if (r < N_OUT) { const int l = r / I_OUT; transpose_item(a.w_out + (size_t)l * DM * DM, DM, DM, WoutT + (size_t)l * DM * DM, DM, 0, scr, r % I_OUT, lane); continue; } r -= N_OUT;
        if (r < N_G) { const int le = r / I_G; transpose_item<true>(a.w_gate + (size_t)le * DM * DEXP, DM, DEXP, WgT + (size_t)le * DEXP * DM, DM, 0, scr, r % I_G, lane, a.ln2_g + (size_t)(le / NEXP) * DM); continue; } r -= N_G;
        if (r < N_G) { const int le = r / I_G; transpose_item<true>(a.w_up + (size_t)le * DM * DEXP, DM, DEXP, WuT + (size_t)le * DEXP * DM, DM, 0, scr, r % I_G, lane, a.ln2_g + (size_t)(le / NEXP) * DM); continue; } r -= N_G;
        { const int le = r / I_D, l = le / NEXP, e = le % NEXP; transpose_item(a.w_down + (size_t)le * DEXP * DM, DEXP, DM, WdT + (size_t)l * DM * NACT, NACT, e * DEXP, scr, r % I_D, lane); }
    }
}

__device__ __forceinline__ void phase_norm1(const float* x, int gw, int NGW, int lane, float* kmean_zero, bf16_t* xb, float* rstd_out) {
    for (int i = gw * 64 + lane; i < BATCH * 4 * 32 * HD; i += NGW * 64) kmean_zero[i] = 0.f;
    for (int m = gw; m < T; m += NGW) {
        const f32x4* xr = (const f32x4*)(x + (size_t)m * DM) + lane;
        f32x4 v[4]; float s = 0.f;
#pragma unroll
        for (int j = 0; j < 4; ++j) { v[j] = xr[64 * j]; s += (v[j].x * v[j].x + v[j].y * v[j].y) + (v[j].z * v[j].z + v[j].w * v[j].w); }
        const float rstd = 1.0f / sqrtf(wave_sum(s) * (1.f / DM) + NORM_EPS);
        u32x2* x8 = (u32x2*)(xb + (size_t)m * DM) + lane;
#pragma unroll
        for (int j = 0; j < 4; ++j) { u32x2 c; c.x = pk2(v[j].x, v[j].y); c.y = pk2(v[j].z, v[j].w); x8[64 * j] = c; }
        if (lane == 0) rstd_out[m] = rstd;
    }
}
__device__ __forceinline__ void phase_norm1_b(const bf16_t* xb, int gw, int NGW, int lane, float* kmean_zero, float* rstd_out) {
    for (int i = gw * 64 + lane; i < BATCH * 4 * 32 * HD; i += NGW * 64) kmean_zero[i] = 0.f;
    for (int m = gw; m < T; m += 2 * NGW) {
        const int m2 = m + NGW;
        const u32x4* xr = (const u32x4*)(xb + (size_t)m * DM) + lane; const u32x4* xr2 = (const u32x4*)(xb + (size_t)(m2 < T ? m2 : m) * DM) + lane;
        u32x4 r[2], q[2];
#pragma unroll
        for (int j = 0; j < 2; ++j) { r[j] = xr[64 * j]; q[j] = xr2[64 * j]; }
        float s = 0.f, s2 = 0.f;
#pragma unroll
        for (int j = 0; j < 2; ++j) {
            const float a0 = bflo(r[j].x), a1 = bfhi(r[j].x), a2 = bflo(r[j].y), a3 = bfhi(r[j].y), a4 = bflo(r[j].z), a5 = bfhi(r[j].z), a6 = bflo(r[j].w), a7 = bfhi(r[j].w);
            s += ((a0 * a0 + a1 * a1) + (a2 * a2 + a3 * a3)) + ((a4 * a4 + a5 * a5) + (a6 * a6 + a7 * a7));
            const float b0 = bflo(q[j].x), b1 = bfhi(q[j].x), b2 = bflo(q[j].y), b3 = bfhi(q[j].y), b4 = bflo(q[j].z), b5 = bfhi(q[j].z), b6 = bflo(q[j].w), b7 = bfhi(q[j].w);
            s2 += ((b0 * b0 + b1 * b1) + (b2 * b2 + b3 * b3)) + ((b4 * b4 + b5 * b5) + (b6 * b6 + b7 * b7)); }
        const float rstd = 1.0f / sqrtf(wave_sum(s) * (1.f / DM) + NORM_EPS), rstd2 = 1.0f / sqrtf(wave_sum(s2) * (1.f / DM) + NORM_EPS);
        if (lane == 0) { rstd_out[m] = rstd; if (m2 < T) rstd_out[m2] = rstd2; }
    }
}
__device__ __forceinline__ void unpack8(float (&f)[8], const u32x4 w) { f[0] = bflo(w.x); f[1] = bfhi(w.x); f[2] = bflo(w.y); f[3] = bfhi(w.y); f[4] = bflo(w.z); f[5] = bfhi(w.z); f[6] = bflo(w.w); f[7] = bfhi(w.w); }
struct MixRow { u32x4 a, c0, c1, c2, p0, p1, p2; float l0, l1, l2, e0, e1, e2, e3; };
__device__ __forceinline__ void mix_load(MixRow& r, int m, const bf16_t* ob, const bf16_t* hb, const float* lse, const bf16_t* pm, const float* lsem0, const float* lsem1, int lane, int hh) {
    r.a = *((const u32x4*)(ob + (size_t)m * DM) + lane); r.c0 = *((const u32x4*)(ob + (size_t)m * DM + 512) + lane);
    r.c1 = *((const u32x4*)(hb + (size_t)m * DM) + lane); r.c2 = *((const u32x4*)(hb + (size_t)m * DM + 512) + lane);
    r.l0 = lse[(size_t)m * 8 + hh]; r.l1 = lse[(size_t)T * 8 + (size_t)m * 8 + hh]; r.l2 = lse[(size_t)2 * T * 8 + (size_t)m * 8 + hh];
    if (lane < 32) {
        r.p0 = *((const u32x4*)(pm + (size_t)m * 256) + lane); r.p1 = *((const u32x4*)(pm + ((size_t)T + m) * 256) + lane); r.p2 = *((const u32x4*)(pm + ((size_t)2 * T + m) * 256) + lane);
        r.e0 = lsem0[(size_t)m * 4 + hh]; r.e1 = lsem0[(size_t)T * 4 + (size_t)m * 4 + hh]; r.e2 = lsem1[(size_t)m * 4 + hh]; r.e3 = lsem1[(size_t)T * 4 + (size_t)m * 4 + hh]; }
}
__device__ __forceinline__ void phase_mixnorm(const bf16_t* ob, bf16_t* hb, const float* lse, const bf16_t* pm, const float* lsem0, const float* lsem1, const float* g, int gw, int NGW, int lane) {
    float g0[8], g1[8];
#pragma unroll
    for (int j = 0; j < 8; ++j) { g0[j] = g[8 * lane + j]; g1[j] = g[512 + 8 * lane + j]; }
    const int hh = lane >> 3;
    MixRow cur, nxt;
    if (gw < T) mix_load(cur, gw, ob, hb, lse, pm, lsem0, lsem1, lane, hh);
    for (int m = gw; m < T; m += NGW) {
        if (m + NGW < T) mix_load(nxt, m + NGW, ob, hb, lse, pm, lsem0, lsem1, lane, hh);
        float va[8]; unpack8(va, cur.a);
        if (lane < 32) {
            const float mx = fmaxf(fmaxf(cur.e0, cur.e1), fmaxf(cur.e2, cur.e3));
            float u0 = __builtin_amdgcn_exp2f(cur.e0 - mx), u1 = __builtin_amdgcn_exp2f(cur.e1 - mx), u2 = __builtin_amdgcn_exp2f(cur.e2 - mx), u3 = __builtin_amdgcn_exp2f(cur.e3 - mx);
            const float inv = 1.0f / ((u0 + u1) + (u2 + u3)); u0 *= inv; u1 *= inv; u2 *= inv; u3 *= inv;
            float y0[8], y1[8], y2[8]; unpack8(y0, cur.p0); unpack8(y1, cur.p1); unpack8(y2, cur.p2);
#pragma unroll
            for (int j = 0; j < 8; ++j) va[j] = (u0 * y0[j] + u1 * y1[j]) + (u2 * y2[j] + u3 * va[j]);
        }
        const float mx = fmaxf(cur.l0, fmaxf(cur.l1, cur.l2));
        float w0 = __builtin_amdgcn_exp2f(cur.l0 - mx), w1 = __builtin_amdgcn_exp2f(cur.l1 - mx), w2 = __builtin_amdgcn_exp2f(cur.l2 - mx);
        const float inv = 1.0f / (w0 + w1 + w2); w0 *= inv; w1 *= inv; w2 *= inv;
        float x0[8], x1[8], x2[8]; unpack8(x0, cur.c0); unpack8(x1, cur.c1); unpack8(x2, cur.c2);
        float vc[8];
        float sa = 0.f, sc = 0.f;
#pragma unroll
        for (int j = 0; j < 8; ++j) { vc[j] = w0 * x0[j] + w1 * x1[j] + w2 * x2[j]; sa += va[j] * va[j]; sc += vc[j] * vc[j]; }
        sa = half_sum(sa); sc = wave_sum(sc);
        const float ra = 1.0f / sqrtf(sa * (1.f / 256.f) + NORM_EPS), rc = 1.0f / sqrtf(sc * (1.f / 512.f) + NORM_EPS);
        u32x4 oa, oc;
        oa.x = pk2(va[0] * ra * g0[0], va[1] * ra * g0[1]); oa.y = pk2(va[2] * ra * g0[2], va[3] * ra * g0[3]); oa.z = pk2(va[4] * ra * g0[4], va[5] * ra * g0[5]); oa.w = pk2(va[6] * ra * g0[6], va[7] * ra * g0[7]);
        oc.x = pk2(vc[0] * rc * g1[0], vc[1] * rc * g1[1]); oc.y = pk2(vc[2] * rc * g1[2], vc[3] * rc * g1[3]); oc.z = pk2(vc[4] * rc * g1[4], vc[5] * rc * g1[5]); oc.w = pk2(vc[6] * rc * g1[6], vc[7] * rc * g1[7]);
        *((u32x4*)(hb + (size_t)m * DM) + lane) = oa; *((u32x4*)(hb + (size_t)m * DM + 512) + lane) = oc;
        cur = nxt;
    }
}
__device__ __forceinline__ void phase_route(const bf16_t* x, const float* g, const float* wgr, const float* bgr, const float* wer, const float* ber,
                                            float* rlist, unsigned* cnt, unsigned* list, float* wlist, LAS unsigned char* lds, int v, int G, int wave, int lane) {
    const int tid = wave * 64 + lane;
    LAS f32x4* wl = (LAS f32x4*)lds;
    for (int idx = tid; idx < 5 * DM; idx += NTHREADS) { const int mtx = idx >> 10, d = idx & 1023; const float* src = (mtx == 0 ? wgr : wer + (size_t)(mtx - 1) * DM * 4) + d * 4;
        wl[mtx * 1024 + (d & 3) * 256 + (d >> 2)] = *(const f32x4*)src * g[d]; }
    LAS unsigned* cl = (LAS unsigned*)(lds + 81920);
    LAS u32x2* info = (LAS u32x2*)(lds + 81920 + 256);
    LAS f32x2* infw = (LAS f32x2*)(lds + 81920 + 256 + 4096);
    LAS float* infr = (LAS float*)(lds + 81920 + 256 + 8192);
    if (tid < 64) cl[tid] = 0u;
    __syncthreads();
    const int rpw = (T + G - 1) / G, row0 = v * rpw;
    const f32x4 bg = *(const f32x4*)bgr;
    u32x2 nx[4];
    { const int m0 = row0 + wave; if (wave < rpw && m0 < T) { const u32x2* xr = (const u32x2*)(x + (size_t)m0 * DM) + lane;
#pragma unroll
        for (int j = 0; j < 4; ++j) nx[j] = xr[64 * j]; } }
    for (int r = wave; r < rpw; r += NWAVES) {
        const int m = row0 + r; if (m >= T) break;
        f32x4 vv[4]; float s = 0.f;
#pragma unroll
        for (int j = 0; j < 4; ++j) { vv[j] = (f32x4){bflo(nx[j].x), bfhi(nx[j].x), bflo(nx[j].y), bfhi(nx[j].y)}; s += (vv[j].x * vv[j].x + vv[j].y * vv[j].y) + (vv[j].z * vv[j].z + vv[j].w * vv[j].w); }
        if (r + NWAVES < rpw && m + NWAVES < T) { const u32x2* xr = (const u32x2*)(x + (size_t)(m + NWAVES) * DM) + lane;
#pragma unroll
            for (int j = 0; j < 4; ++j) nx[j] = xr[64 * j]; }
        const float rstd = 1.0f / sqrtf(wave_sum(s) * (1.f / DM) + NORM_EPS);
        f32x4 gl = (f32x4){0.f, 0.f, 0.f, 0.f};
#pragma unroll
        for (int j = 0; j < 4; ++j) { LAS f32x4* wp = wl + lane + 64 * j;
            gl += wp[0] * vv[j].x; gl += wp[256] * vv[j].y; gl += wp[512] * vv[j].z; gl += wp[768] * vv[j].w; }
        gl.x = wave_sum(gl.x) * rstd + bg.x; gl.y = wave_sum(gl.y) * rstd + bg.y; gl.z = wave_sum(gl.z) * rstd + bg.z; gl.w = wave_sum(gl.w) * rstd + bg.w;
        int gi = 0; float gm = gl.x;
        if (gl.y > gm) { gm = gl.y; gi = 1; } if (gl.z > gm) { gm = gl.z; gi = 2; } if (gl.w > gm) { gm = gl.w; gi = 3; }
        const float gden = __expf(gl.x - gm) + __expf(gl.y - gm) + __expf(gl.z - gm) + __expf(gl.w - gm);
        const float gw_ = 1.0f / gden;
        gi = __builtin_amdgcn_readfirstlane(gi);
        f32x4 el = (f32x4){0.f, 0.f, 0.f, 0.f};
#pragma unroll
        for (int j = 0; j < 4; ++j) { LAS f32x4* wp = wl + (1 + gi) * 1024 + lane + 64 * j;
            el += wp[0] * vv[j].x; el += wp[256] * vv[j].y; el += wp[512] * vv[j].z; el += wp[768] * vv[j].w; }
        const f32x4 be = *(const f32x4*)(ber + gi * 4);
        float e[4] = {wave_sum(el.x) * rstd + be.x, wave_sum(el.y) * rstd + be.y, wave_sum(el.z) * rstd + be.z, wave_sum(el.w) * rstd + be.w};
        int i1 = 0; float v1 = e[0];
#pragma unroll
        for (int k = 1; k < 4; ++k) if (e[k] > v1) { v1 = e[k]; i1 = k; }
        int i2 = -1; float v2 = -INFINITY;
#pragma unroll
        for (int k = 0; k < 4; ++k) if (k != i1 && e[k] > v2) { v2 = e[k]; i2 = k; }
        const float p2 = __expf(v2 - v1), inv = 1.0f / (1.0f + p2);
        const float w1 = inv * gw_, w2 = p2 * inv * gw_;
        const int ea = i1 < i2 ? i1 : i2, eb = i1 < i2 ? i2 : i1; const float wa = i1 < i2 ? w1 : w2, wb = i1 < i2 ? w2 : w1;
        const int pi = (ea == 0) ? (eb - 1) : (ea == 1 ? eb + 1 : 5), bk = gi * 6 + pi;
        if (lane == 0) { const unsigned rank = __hip_atomic_fetch_add(cl + bk, 1u, __ATOMIC_RELAXED, __HIP_MEMORY_SCOPE_WORKGROUP);
            info[r] = (u32x2){(unsigned)bk, rank}; infw[r] = (f32x2){wa, wb}; infr[r] = rstd; }
    }
    __syncthreads();
    if (tid < 24) cl[32 + tid] = __hip_atomic_fetch_add(cnt + tid, cl[tid], __ATOMIC_RELAXED, __HIP_MEMORY_SCOPE_AGENT);
    __syncthreads();
    if (tid < rpw && row0 + tid < T) { const u32x2 inf = info[tid]; const f32x2 wv = infw[tid]; const size_t slot = (size_t)inf.x * T + cl[32 + inf.x] + inf.y;
        list[slot] = (unsigned)(row0 + tid); *(f32x2*)(wlist + slot * 2) = wv; rlist[slot] = infr[tid]; }
    __syncthreads();
}
__device__ __forceinline__ void phase_final(const bf16_t* xb, const float* g, float* out, int gw, int NGW, int lane) {
    f32x4 gv[4];
#pragma unroll
    for (int j = 0; j < 2; ++j) { gv[2 * j] = *((const f32x4*)g + 2 * lane + 128 * j); gv[2 * j + 1] = *((const f32x4*)g + 2 * lane + 128 * j + 1); }
    for (int m = gw; m < T; m += NGW) {
        const u32x4* xr = (const u32x4*)(xb + (size_t)m * DM) + lane;
        u32x4 r[2]; float s = 0.f;
#pragma unroll
        for (int j = 0; j < 2; ++j) r[j] = xr[64 * j];
        f32x4 v[4];
#pragma unroll
        for (int j = 0; j < 2; ++j) { v[2 * j] = (f32x4){bflo(r[j].x), bfhi(r[j].x), bflo(r[j].y), bfhi(r[j].y)}; v[2 * j + 1] = (f32x4){bflo(r[j].z), bfhi(r[j].z), bflo(r[j].w), bfhi(r[j].w)}; }
#pragma unroll
        for (int j = 0; j < 4; ++j) s += (v[j].x * v[j].x + v[j].y * v[j].y) + (v[j].z * v[j].z + v[j].w * v[j].w);
        const float rstd = 1.0f / sqrtf(wave_sum(s) * (1.f / DM) + NORM_EPS);
        f32x4* orow = (f32x4*)(out + (size_t)m * DM) + 2 * lane;
#pragma unroll
        for (int j = 0; j < 2; ++j) { orow[128 * j] = v[2 * j] * rstd * gv[2 * j]; orow[128 * j + 1] = v[2 * j + 1] * rstd * gv[2 * j + 1]; }
    }
}
__device__ __forceinline__ void phase_kmean(const bf16_t* kb, float* kmean, int gw, int NGW, int lane) {
    for (int it = gw; it < BATCH * 4 * 32; it += NGW) {
        const int b = it >> 7, h = (it >> 5) & 3, blk = it & 31;
        const bf16_t* base = kb + ((size_t)b * SEQ + (size_t)blk * 256) * DM + h * HD + (lane & 7) * 8;
        float acc[8] = {0.f, 0.f, 0.f, 0.f, 0.f, 0.f, 0.f, 0.f};
#pragma unroll 4
        for (int i = 0; i < 32; ++i) { const u32x4 w = *(const u32x4*)(base + (size_t)((lane >> 3) + 8 * i) * DM);
            acc[0] += bflo(w.x); acc[1] += bfhi(w.x); acc[2] += bflo(w.y); acc[3] += bfhi(w.y); acc[4] += bflo(w.z); acc[5] += bfhi(w.z); acc[6] += bflo(w.w); acc[7] += bfhi(w.w); }
#pragma unroll
        for (int j = 0; j < 8; ++j) { acc[j] += swz_xor<8>(acc[j]); acc[j] += swz_xor<16>(acc[j]); acc[j] = sum_xor32(acc[j]); }
        if (lane < 8) {
            float* o = kmean + (size_t)it * HD + lane * 8;
#pragma unroll
            for (int j = 0; j < 8; ++j) o[j] = acc[j] * (1.f / 256.f);
        }
    }
}

__device__ __forceinline__ void ld_row64(float (&r)[64], const bf16_t* p) {
#pragma unroll
    for (int c = 0; c < 8; ++c) { const u32x4 w = *((const u32x4*)p + c);
        r[8 * c + 0] = bflo(w.x); r[8 * c + 1] = bfhi(w.x); r[8 * c + 2] = bflo(w.y); r[8 * c + 3] = bfhi(w.y); r[8 * c + 4] = bflo(w.z); r[8 * c + 5] = bfhi(w.z); r[8 * c + 6] = bflo(w.w); r[8 * c + 7] = bfhi(w.w); }
}
__device__ __forceinline__ float dot_row64(const float (&q)[64], const bf16_t* p) {
    float s0 = 0.f, s1 = 0.f;
#pragma unroll
    for (int c = 0; c < 8; ++c) { const u32x4 w = *((const u32x4*)p + c);
        s0 += q[8 * c + 0] * bflo(w.x); s1 += q[8 * c + 1] * bfhi(w.x); s0 += q[8 * c + 2] * bflo(w.y); s1 += q[8 * c + 3] * bfhi(w.y);
        s0 += q[8 * c + 4] * bflo(w.z); s1 += q[8 * c + 5] * bfhi(w.z); s0 += q[8 * c + 6] * bflo(w.w); s1 += q[8 * c + 7] * bfhi(w.w); }
    return s0 + s1;
}
__device__ __forceinline__ void axpy_row64(float (&o)[64], float p, const bf16_t* vp) {
#pragma unroll
    for (int c = 0; c < 8; ++c) { const u32x4 w = *((const u32x4*)vp + c);
        o[8 * c + 0] += p * bflo(w.x); o[8 * c + 1] += p * bfhi(w.x); o[8 * c + 2] += p * bflo(w.y); o[8 * c + 3] += p * bfhi(w.y);
        o[8 * c + 4] += p * bflo(w.z); o[8 * c + 5] += p * bfhi(w.z); o[8 * c + 6] += p * bflo(w.w); o[8 * c + 7] += p * bfhi(w.w); }
}
__device__ __forceinline__ void st_row64(bf16_t* p, const float (&o)[64], float sc) {
#pragma unroll
    for (int c = 0; c < 8; ++c) { u32x4 w; w.x = pk2(o[8 * c] * sc, o[8 * c + 1] * sc); w.y = pk2(o[8 * c + 2] * sc, o[8 * c + 3] * sc); w.z = pk2(o[8 * c + 4] * sc, o[8 * c + 5] * sc); w.w = pk2(o[8 * c + 6] * sc, o[8 * c + 7] * sc); *((u32x4*)p + c) = w; }
}
#define OSM_STEP(sc, vrow) do { const float sc_ = (sc); if (sc_ > m_) { const float al = __builtin_amdgcn_exp2f(m_ - sc_); l_ *= al; _Pragma("unroll") for (int d_ = 0; d_ < 64; ++d_) o_[d_] *= al; m_ = sc_; } \
    const float p_ = __builtin_amdgcn_exp2f(sc_ - m_); l_ += p_; axpy_row64(o_, p_, (vrow)); } while (0)

__device__ __forceinline__ void naive_moba(const bf16_t* qb, const bf16_t* kb, const bf16_t* vb, const float* kmean, bf16_t* ob, int item, int tid) {
    const int b = item >> 6, h = (item >> 4) & 3, t = (item & 15) * 512 + tid, own = t >> 8;
    const size_t rowq = ((size_t)b * SEQ + t) * DM + h * HD;
    const bf16_t* kh = kb + (size_t)b * SEQ * DM + h * HD; const bf16_t* vh = vb + (size_t)b * SEQ * DM + h * HD;
    const float slope2 = exp2f(-2.0f * (float)(h + 1)) * LOG2E;
    float q_[64]; ld_row64(q_, qb + rowq);
    float bv0 = -INFINITY, bv1 = -INFINITY, bv2 = -INFINITY; int bi0 = -1, bi1 = -1, bi2 = -1;
    const float* km = kmean + (size_t)(b * 4 + h) * 32 * HD;
    for (int n = 0; n < own; ++n) {
        float gsum = 0.f;
#pragma unroll
        for (int d = 0; d < 64; ++d) gsum += q_[d] * km[n * HD + d];
        if (gsum > bv0) { bv2 = bv1; bi2 = bi1; bv1 = bv0; bi1 = bi0; bv0 = gsum; bi0 = n; }
        else if (gsum > bv1) { bv2 = bv1; bi2 = bi1; bv1 = gsum; bi1 = n; }
        else if (gsum > bv2) { bv2 = gsum; bi2 = n; }
    }
    float o_[64];
#pragma unroll
    for (int d = 0; d < 64; ++d) o_[d] = 0.f;
    float m_ = -INFINITY, l_ = 0.f;
    for (int s = 0; s < 3; ++s) {
        const int blk = (s == 0) ? bi0 : (s == 1) ? bi1 : bi2;
        if (blk < 0) continue;
        for (int j = 0; j < 256; ++j) { const int pos = blk * 256 + j;
            const float sc = dot_row64(q_, kh + (size_t)pos * DM) - slope2 * (float)(t - pos);
            OSM_STEP(sc, vh + (size_t)pos * DM); }
    }
    for (int pos = own * 256; pos <= t; ++pos) {
        const float sc = dot_row64(q_, kh + (size_t)pos * DM) - slope2 * (float)(t - pos);
        OSM_STEP(sc, vh + (size_t)pos * DM); }
    st_row64(ob + rowq, o_, 1.0f / l_);
}
__device__ __forceinline__ void naive_sb(const bf16_t* qb, const bf16_t* kb, const bf16_t* vb, bf16_t* ob, int item, int tid) {
    const int b = item >> 6, h = 4 + ((item >> 4) & 3), t = (item & 15) * 512 + tid;
    const size_t rowq = ((size_t)b * SEQ + t) * DM + h * HD;
    const bf16_t* kh = kb + (size_t)b * SEQ * DM + h * HD; const bf16_t* vh = vb + (size_t)b * SEQ * DM + h * HD;
    float q_[64]; ld_row64(q_, qb + rowq);
    float o_[64];
#pragma unroll
    for (int d = 0; d < 64; ++d) o_[d] = 0.f;
    float tail = 0.f;
    for (int s = t - 1; s >= 0 && tail > -150.f; --s) {
        const float z = dot_row64(q_, kh + (size_t)s * DM);
        const float lp = __builtin_amdgcn_logf(1.0f + __builtin_amdgcn_exp2f(-fabsf(z)));
        const float lnot = -(fmaxf(z, 0.f) + lp);
        const float aw = __builtin_amdgcn_exp2f(z + lnot + tail);
        axpy_row64(o_, aw, vh + (size_t)s * DM);
        tail += lnot;
    }
    st_row64(ob + rowq, o_, 1.0f);
}
__device__ __forceinline__ void naive_dil(const bf16_t* qb, const bf16_t* kb, const bf16_t* vb, bf16_t* ob, bf16_t* hb2, float* lse, int item, int tid) {
    const int b = item >> 7, h = 8 + ((item >> 4) & 7), t = (item & 15) * 512 + tid;
    const size_t rowq = ((size_t)b * SEQ + t) * DM + h * HD;
    const bf16_t* kh = kb + (size_t)b * SEQ * DM + h * HD; const bf16_t* vh = vb + (size_t)b * SEQ * DM + h * HD;
    const float slope2 = exp2f(-(float)(h - 8 + 1)) * LOG2E;
    float q_[64]; ld_row64(q_, qb + rowq);
    float o_[64];
#pragma unroll
    for (int d = 0; d < 64; ++d) o_[d] = 0.f;
    float m_ = -INFINITY, l_ = 0.f;
    for (int c = 0; c < 3; ++c) {
        const int dil = (c == 0) ? 1 : (c == 1) ? 4 : 16;
        for (int dl = 0; dl <= 128; ++dl) { const int pos = t - dl * dil; if (pos < 0) break;
            const float sc = dot_row64(q_, kh + (size_t)pos * DM) - slope2 * (float)(dl * dil);
            OSM_STEP(sc, vh + (size_t)pos * DM); }
    }
    st_row64(ob + rowq, o_, 1.0f / l_);
    { const size_t tok = (size_t)b * SEQ + t; const u32x4 z4 = {0u, 0u, 0u, 0u};
#pragma unroll
      for (int c = 0; c < 8; ++c) { *((u32x4*)(hb2 + tok * DM + (h - 8) * HD) + c) = z4; *((u32x4*)(hb2 + tok * DM + 512 + (h - 8) * HD) + c) = z4; }
      lse[tok * 8 + (h - 8)] = 0.f; lse[(size_t)T * 8 + tok * 8 + (h - 8)] = -1.0e30f; lse[(size_t)2 * T * 8 + tok * 8 + (h - 8)] = -1.0e30f; }
}

namespace att {
typedef float f32x16 __attribute__((ext_vector_type(16)));
typedef short s16x4 __attribute__((ext_vector_type(4)));
typedef short v4i16_t __attribute__((ext_vector_type(4)));
typedef __bf16 bf16x2_t __attribute__((ext_vector_type(2)));
constexpr int L_BUF = 16384;
constexpr int L_WSF = 2 * L_BUF;
constexpr int L_OST = L_WSF + 8 * 256;
constexpr int L_FLG = L_OST + 8 * 4096;
constexpr int L_END = L_FLG + 64;
constexpr float M_INIT = -1.0e30f;
#define ATT_MFMA(a, b, c) __builtin_amdgcn_mfma_f32_32x32x16_bf16((a), (b), (c), 0, 0, 0)

__device__ __forceinline__ unsigned cvtpk(float lo, float hi) { f32x2 v = {lo, hi}; bf16x2_t b = __builtin_convertvector(v, bf16x2_t); return __builtin_bit_cast(unsigned, b); }
__device__ __forceinline__ s16x4 vtr(LAS unsigned char* p) { return __builtin_bit_cast(s16x4, __builtin_amdgcn_ds_read_tr16_b64_v4i16((LAS v4i16_t*)p)); }

struct Wave { int lane, r32, hi, wid; LAS unsigned char* lds; LAS float* wsf; LAS unsigned char* ost; int vlo; };
__device__ __forceinline__ Wave make_wave(LAS unsigned char* lds, int tid, int wsf_off = L_WSF, int ost_off = L_OST) {
    Wave w; w.lane = tid & 63; w.r32 = w.lane & 31; w.hi = w.lane >> 5; w.wid = __builtin_amdgcn_readfirstlane(tid >> 6); w.lds = lds;
    w.wsf = (LAS float*)(lds + wsf_off) + w.wid * 64; w.ost = lds + ost_off + w.wid * 4096;
    w.vlo = ((w.lane >> 4) & 1) * 32 + (w.lane & 3) * 8 + (4 * w.hi + ((w.lane & 15) >> 2)) * 64;
    return w;
}
struct Stage { u32x4 k, v; };
template <class RowK, class RowV> __device__ __forceinline__ void stage_load(Stage& s, const Wave& w, const RowK& rowk, const RowV& rowv) {
    s.k = *(const u32x4*)(rowk(w.lane) + w.wid * 8);
    s.v = *(const u32x4*)(rowv(16 * (w.wid & 3) + (w.lane >> 2)) + (w.wid >> 2) * 32 + (w.lane & 3) * 8);
}
__device__ __forceinline__ void stage_write(const Stage& s, const Wave& w, int buf) {
    *(LAS u32x4*)(w.lds + buf * L_BUF + w.wid * 1024 + w.lane * 16) = s.k;
    *(LAS u32x4*)(w.lds + buf * L_BUF + 8192 + w.wid * 1024 + w.lane * 16) = s.v;
}
__device__ __forceinline__ f32x16 qk_sub(const Wave& w, int buf, int sub, const bf16x8 (&qf)[4], float init) {
    f32x16 acc;
#pragma unroll
    for (int r = 0; r < 16; ++r) acc[r] = init;
    LAS unsigned char* kp = w.lds + buf * L_BUF + w.hi * 1024 + (32 * sub + w.r32) * 16;
#pragma unroll
    for (int ks = 0; ks < 4; ++ks) { const bf16x8 kf = *(LAS bf16x8*)(kp + ks * 2048); acc = ATT_MFMA(kf, qf[ks], acc); }
    return acc;
}
__device__ __forceinline__ void pv_sub(const Wave& w, int buf, int sub, const f32x16& p, f32x16 (&o)[2]) {
    bf16x8 pk[2];
#pragma unroll
    for (int s = 0; s < 2; ++s) { u32x4 t; t.x = cvtpk(p[8 * s], p[8 * s + 1]); t.y = cvtpk(p[8 * s + 2], p[8 * s + 3]); t.z = cvtpk(p[8 * s + 4], p[8 * s + 5]); t.w = cvtpk(p[8 * s + 6], p[8 * s + 7]); pk[s] = __builtin_bit_cast(bf16x8, t); }
    LAS unsigned char* vb = w.lds + buf * L_BUF + 8192 + w.vlo;
#pragma unroll
    for (int db = 0; db < 2; ++db)
#pragma unroll
        for (int s = 0; s < 2; ++s) { LAS unsigned char* vp = vb + db * 4096 + (4 * sub + 2 * s) * 512;
            const s16x4 lo = vtr(vp), hh = vtr(vp + 512);
            const bf16x8 vf = __builtin_shufflevector(lo, hh, 0, 1, 2, 3, 4, 5, 6, 7);
            o[db] = ATT_MFMA(pk[s], vf, o[db]); }
}
struct VFrags { s16x4 f[2][2][2]; };
__device__ __forceinline__ void load_vfrags(const Wave& w, int buf, int sub, VFrags& v) {
    LAS unsigned char* vb = w.lds + buf * L_BUF + 8192 + w.vlo;
#pragma unroll
    for (int db = 0; db < 2; ++db)
#pragma unroll
        for (int s = 0; s < 2; ++s) { LAS unsigned char* vp = vb + db * 4096 + (4 * sub + 2 * s) * 512; v.f[db][s][0] = vtr(vp); v.f[db][s][1] = vtr(vp + 512); }
}
__device__ __forceinline__ void pv_frags(const VFrags& v, const f32x16& p, f32x16 (&o)[2]) {
    bf16x8 pk[2];
#pragma unroll
    for (int s = 0; s < 2; ++s) { u32x4 t; t.x = cvtpk(p[8 * s], p[8 * s + 1]); t.y = cvtpk(p[8 * s + 2], p[8 * s + 3]); t.z = cvtpk(p[8 * s + 4], p[8 * s + 5]); t.w = cvtpk(p[8 * s + 6], p[8 * s + 7]); pk[s] = __builtin_bit_cast(bf16x8, t); }
#pragma unroll
    for (int db = 0; db < 2; ++db)
#pragma unroll
        for (int s = 0; s < 2; ++s) { const bf16x8 vf = __builtin_shufflevector(v.f[db][s][0], v.f[db][s][1], 0, 1, 2, 3, 4, 5, 6, 7); o[db] = ATT_MFMA(pk[s], vf, o[db]); }
}
__device__ __forceinline__ void scale_rows(const Wave& w, f32x16 (&o)[2], float f) {
    if (w.hi == 0) w.wsf[w.r32] = f;
#pragma unroll
    for (int g = 0; g < 4; ++g) { const f32x4 fv = *(LAS f32x4*)(w.wsf + 8 * g + 4 * w.hi);
#pragma unroll
        for (int i = 0; i < 4; ++i) { o[0][4 * g + i] *= fv[i]; o[1][4 * g + i] *= fv[i]; } }
}
__device__ __forceinline__ void softmax_sub(const Wave& w, f32x16& s, float& m, float& lsum, f32x16 (&o)[2]) {
    float tm = fmaxf(fmaxf(s[0], s[1]), fmaxf(s[2], s[3]));
#pragma unroll
    for (int r = 4; r < 16; r += 4) tm = fmaxf(tm, fmaxf(fmaxf(s[r], s[r + 1]), fmaxf(s[r + 2], s[r + 3])));
    tm = max_xor32(tm);
    const float mn = fmaxf(m, tm);
    if (__any(mn > m)) { const float al = __builtin_amdgcn_exp2f(m - mn); lsum *= al; scale_rows(w, o, al); m = mn; }
    float acc = 0.f;
#pragma unroll
    for (int r = 0; r < 16; ++r) { s[r] = __builtin_amdgcn_exp2f(s[r] - m); acc += s[r]; }
    lsum += acc;
}
__device__ __forceinline__ void mask_band(f32x16& s, int delta0, int W) {
#pragma unroll
    for (int r = 0; r < 16; ++r) { const int dl = delta0 - ((r & 3) + 8 * (r >> 2)); if ((unsigned)dl > (unsigned)W) s[r] = -INFINITY; }
}
constexpr float SM_THR = 8.0f;
struct SubDesc { bool act; int delta; int W; };
template <int NSUB>
__device__ __forceinline__ void softmax_step(const Wave& w, int buf, const bf16x8 (&qf)[4], const bf16x8& kidx, const bf16x8& slp, float slope, const SubDesc (&sd)[NSUB],
                                             float& m, float& lsum, f32x16 (&o)[2], bool& first) {
    f32x16 s[NSUB];
    bool any_act = false;
#pragma unroll
    for (int i = 0; i < NSUB; ++i) if (sd[i].act) { any_act = true; s[i] = qk_sub(w, buf, i, qf, -slope * (float)sd[i].delta - m); s[i] = ATT_MFMA(kidx, slp, s[i]); }
    if (!any_act) return;
    float tm = -INFINITY;
#pragma unroll
    for (int i = 0; i < NSUB; ++i) if (sd[i].act) {
        if (sd[i].W >= 0) mask_band(s[i], sd[i].delta - 4 * w.hi, sd[i].W);
        float t = fmaxf(fmaxf(s[i][0], s[i][1]), fmaxf(s[i][2], s[i][3]));
#pragma unroll
        for (int r = 4; r < 16; r += 4) t = fmaxf(t, fmaxf(fmaxf(s[i][r], s[i][r + 1]), fmaxf(s[i][r + 2], s[i][r + 3])));
        tm = fmaxf(tm, t); }
    tm = max_xor32(tm);
    if (first || __any(tm > SM_THR)) {
        const float d = first ? (tm > -1.0e30f ? tm : 0.f) : fmaxf(tm, 0.f);
#pragma unroll
        for (int i = 0; i < NSUB; ++i) if (sd[i].act) {
#pragma unroll
            for (int r = 0; r < 16; ++r) s[i][r] -= d; }
        if (!first) { const float al = __builtin_amdgcn_exp2f(-d); lsum *= al; scale_rows(w, o, al); }
        m += d; first = false;
    }
    VFrags vf[NSUB];
#pragma unroll
    for (int i = 0; i < NSUB; ++i) if (sd[i].act) load_vfrags(w, buf, i, vf[i]);
#pragma unroll
    for (int i = 0; i < NSUB; ++i) if (sd[i].act) { float acc = 0.f;
#pragma unroll
        for (int r = 0; r < 16; ++r) { s[i][r] = __builtin_amdgcn_exp2f(s[i][r]); acc += s[i][r]; }
        lsum += acc; }
#pragma unroll
    for (int i = 0; i < NSUB; ++i) if (sd[i].act) pv_frags(vf[i], s[i], o);
}
__device__ __forceinline__ void bias_frags(const Wave& w, float slope, bf16x8& kidx, bf16x8& slp) {
    const unsigned kb = f2bf((float)w.r32), sh = f2bf(slope), sl = f2bf(slope - __builtin_bit_cast(float, sh << 16));
    const u32x4 a = {w.hi == 0 ? (kb | (kb << 16)) : 0u, 0u, 0u, 0u}, b = {w.hi == 0 ? (sh | (sl << 16)) : 0u, 0u, 0u, 0u};
    kidx = __builtin_bit_cast(bf16x8, a); slp = __builtin_bit_cast(bf16x8, b);
}
template <class RowO> __device__ __forceinline__ void store_o(const Wave& w, const f32x16 (&o)[2], const RowO& rowo) {
    LAS unsigned short* stg = (LAS unsigned short*)w.ost;
#pragma unroll
    for (int r = 0; r < 16; ++r) { const int q = (r & 3) + 8 * (r >> 2) + 4 * w.hi;
#pragma unroll
        for (int db = 0; db < 2; ++db) stg[q * 64 + db * 32 + w.r32] = (unsigned short)f2bf(o[db][r]); }
#pragma unroll
    for (int i = 0; i < 4; ++i) { const int row = i * 8 + (w.lane >> 3), ch = w.lane & 7; const u32x4 v = *(LAS u32x4*)((LAS unsigned char*)stg + row * 128 + ch * 16);
        bf16_t* dst = rowo(row); if (dst) *(u32x4*)(dst + ch * 8) = v; }
}
__device__ __forceinline__ void load_q(bf16x8 (&qf)[4], const bf16_t* qrow, int hi) {
#pragma unroll
    for (int ks = 0; ks < 4; ++ks) qf[ks] = *(const bf16x8*)(qrow + 16 * ks + 8 * hi);
}

constexpr int W_WSF = 98304, W_OST = W_WSF + 2048, W_ENUM = W_OST + 32768;
template <int NC> struct Pref { u32x4 k[NC], v[NC]; bf16x8 q[4]; };
template <int NC, class RowF> __device__ __forceinline__ void win_issue(Pref<NC>& P, const Wave& w, const bf16_t* kbase, const bf16_t* vbase, const RowF& rowoff, const bf16_t* qrow) {
#pragma unroll
    for (int c = 0; c < NC; ++c) { P.k[c] = *(const u32x4*)(kbase + rowoff(64 * c + 8 * w.wid + (w.lane >> 3)) + (w.lane & 7) * 8);
        P.v[c] = *(const u32x4*)(vbase + rowoff(64 * c + 16 * (w.wid & 3) + (w.lane >> 2)) + (w.wid >> 2) * 32 + (w.lane & 3) * 8); }
    load_q(P.q, qrow, w.hi);
}
template <int NC> __device__ __forceinline__ void win_commit(const Pref<NC>& P, const Wave& w) {
    constexpr int NK = 64 * NC;
#pragma unroll
    for (int c = 0; c < NC; ++c) { const int key = 64 * c + 8 * w.wid + (w.lane >> 3);
        *(LAS u32x4*)(w.lds + key * 128 + ((((w.lane & 7) ^ (key >> 1)) & 7) * 16)) = P.k[c];
        *(LAS u32x4*)(w.lds + NK * 128 + (w.wid >> 2) * (NK * 64) + (8 * c + 2 * (w.wid & 3)) * 512 + w.lane * 16) = P.v[c]; }
}
template <int NK> __device__ __forceinline__ f32x16 qk_win(const Wave& w, int u, const bf16x8 (&qf)[4], float init) {
    f32x16 acc;
#pragma unroll
    for (int r = 0; r < 16; ++r) acc[r] = init;
    LAS unsigned char* kp = w.lds + (32 * u + w.r32) * 128; const int x = (w.r32 >> 1) & 7;
#pragma unroll
    for (int ks = 0; ks < 4; ++ks) { const bf16x8 kf = *(LAS bf16x8*)(kp + (((2 * ks + w.hi) ^ x) * 16)); acc = ATT_MFMA(kf, qf[ks], acc); }
    return acc;
}
template <int NK> __device__ __forceinline__ void load_vfrags_win(const Wave& w, int u, VFrags& v) {
    LAS unsigned char* vb = w.lds + NK * 128 + w.vlo;
#pragma unroll
    for (int db = 0; db < 2; ++db)
#pragma unroll
        for (int s = 0; s < 2; ++s) { LAS unsigned char* vp = vb + db * (NK * 64) + (4 * u + 2 * s) * 512; v.f[db][s][0] = vtr(vp); v.f[db][s][1] = vtr(vp + 512); }
}
struct WSub { bool act; int u; int delta; int W; };
template <int NK>
__device__ __forceinline__ void softmax_win(const Wave& w, const bf16x8 (&qf)[4], const bf16x8& kidx, const bf16x8& slp, float slope, const WSub (&sd)[2], float& m, float& lsum, f32x16 (&o)[2], bool& first) {
    f32x16 s[2];
    bool any_act = false;
#pragma unroll
    for (int i = 0; i < 2; ++i) if (sd[i].act) { any_act = true; s[i] = qk_win<NK>(w, sd[i].u, qf, -slope * (float)sd[i].delta - m); s[i] = ATT_MFMA(kidx, slp, s[i]); }
    if (!any_act) return;
    float tm = -INFINITY;
#pragma unroll
    for (int i = 0; i < 2; ++i) if (sd[i].act) {
        if (sd[i].W >= 0) mask_band(s[i], sd[i].delta - 4 * w.hi, sd[i].W);
        float t = fmaxf(fmaxf(s[i][0], s[i][1]), fmaxf(s[i][2], s[i][3]));
#pragma unroll
        for (int r = 4; r < 16; r += 4) t = fmaxf(t, fmaxf(fmaxf(s[i][r], s[i][r + 1]), fmaxf(s[i][r + 2], s[i][r + 3])));
        tm = fmaxf(tm, t); }
    tm = max_xor32(tm);
    if (first || __any(tm > SM_THR)) {
        const float d = first ? (tm > -1.0e30f ? tm : 0.f) : fmaxf(tm, 0.f);
#pragma unroll
        for (int i = 0; i < 2; ++i) if (sd[i].act) {
#pragma unroll
            for (int r = 0; r < 16; ++r) s[i][r] -= d; }
        if (!first) { const float al = __builtin_amdgcn_exp2f(-d); lsum *= al; scale_rows(w, o, al); }
        m += d; first = false;
    }
#pragma unroll
    for (int i = 0; i < 2; ++i) if (sd[i].act) { VFrags vf; load_vfrags_win<NK>(w, sd[i].u, vf);
        float acc = 0.f;
#pragma unroll
        for (int r = 0; r < 16; ++r) { s[i][r] = __builtin_amdgcn_exp2f(s[i][r]); acc += s[i][r]; }
        lsum += acc;
        pv_frags(vf, s[i], o); }
}

__device__ __forceinline__ size_t ql_off(int bh, int j) { return (size_t)bh * QL_PER_BH + (size_t)(8192 * j - 128 * j * (j + 1)); }
__device__ __forceinline__ float* lsem_ptr(float* l0, float* l1, int slot) { return (slot < 2 ? l0 : l1) + (size_t)(slot & 1) * T * 4; }

struct Top3 { int i0, i1, i2; };
__device__ __forceinline__ Top3 moba_top3(const Wave& w, const bf16x8 (&qf)[4], const float* KMEAN, int b, int h, int own) {
    int i0 = -1, i1 = -1, i2 = -1;
    if (own > 0) {
    f32x16 g;
#pragma unroll
    for (int r = 0; r < 16; ++r) g[r] = 0.f;
    const float* km = KMEAN + ((size_t)(b * 4 + h) * 32 + w.r32) * HD + 8 * w.hi;
#pragma unroll
    for (int ks = 0; ks < 4; ++ks) { const f32x4 a0 = *(const f32x4*)(km + 16 * ks), a1 = *(const f32x4*)(km + 16 * ks + 4);
        const float x[8] = {a0.x, a0.y, a0.z, a0.w, a1.x, a1.y, a1.z, a1.w}; unsigned hw[4], lw[4];
#pragma unroll
        for (int j = 0; j < 4; ++j) { const unsigned h0 = f2bf(x[2 * j]), h1 = f2bf(x[2 * j + 1]); hw[j] = h0 | (h1 << 16);
            lw[j] = pk2(x[2 * j] - __builtin_bit_cast(float, h0 << 16), x[2 * j + 1] - __builtin_bit_cast(float, h1 << 16)); }
        const u32x4 hv = {hw[0], hw[1], hw[2], hw[3]}, lv = {lw[0], lw[1], lw[2], lw[3]};
        g = ATT_MFMA(__builtin_bit_cast(bf16x8, hv), qf[ks], g); g = ATT_MFMA(__builtin_bit_cast(bf16x8, lv), qf[ks], g); }
    float v0 = -INFINITY, v1 = -INFINITY, v2 = -INFINITY;
#pragma unroll
    for (int r = 0; r < 16; ++r) { const int blk = (r & 3) + 8 * (r >> 2) + 4 * w.hi; const float val = (blk < own) ? g[r] : -INFINITY;
        if (val > v0) { v2 = v1; i2 = i1; v1 = v0; i1 = i0; v0 = val; i0 = blk; } else if (val > v1) { v2 = v1; i2 = i1; v1 = val; i1 = blk; } else if (val > v2) { v2 = val; i2 = blk; } }
    const float pv_[3] = {get_xor32(v0, w.hi), get_xor32(v1, w.hi), get_xor32(v2, w.hi)}; const int pi_[3] = {get_xor32i(i0, w.hi), get_xor32i(i1, w.hi), get_xor32i(i2, w.hi)};
#pragma unroll
    for (int k = 0; k < 3; ++k) { const float val = pv_[k]; const int blk = pi_[k];
        if (val > v0 || (val == v0 && blk < i0)) { v2 = v1; i2 = i1; v1 = v0; i1 = i0; v0 = val; i0 = blk; }
        else if (val > v1 || (val == v1 && blk < i1)) { v2 = v1; i2 = i1; v1 = val; i1 = blk; }
        else if (val > v2 || (val == v2 && blk < i2)) { v2 = val; i2 = blk; } }
    }
    Top3 t; t.i0 = i0; t.i1 = i1; t.i2 = i2; return t;
}
__device__ __forceinline__ void moba_gate_unit(LAS unsigned char* lds, const bf16_t* QB, const float* KMEAN, unsigned* mcnt, unsigned* qlist, bf16_t* PM, float* LSEM0, float* LSEM1, int b, int h, int own, int tid) {
    const Wave w = make_wave(lds, tid);
    const size_t rowbase = (size_t)b * SEQ; const int qpos = own * 256 + 32 * w.wid + w.r32, bh = b * 4 + h;
    bf16x8 qf[4]; load_q(qf, QB + (rowbase + qpos) * DM + h * HD, w.hi);
    const Top3 t3 = moba_top3(w, qf, KMEAN, b, h, own); const int s0 = t3.i0, s1 = t3.i1, s2 = t3.i2;
    LAS unsigned* cl = (LAS unsigned*)(lds + W_ENUM);
    if (tid < 64) cl[tid] = 0u;
    __syncthreads();
    unsigned r0 = 0u, r1 = 0u, r2 = 0u;
    if (w.hi == 0) {
        if (s0 >= 0) r0 = __hip_atomic_fetch_add(cl + s0, 1u, __ATOMIC_RELAXED, __HIP_MEMORY_SCOPE_WORKGROUP);
        if (s1 >= 0) r1 = __hip_atomic_fetch_add(cl + s1, 1u, __ATOMIC_RELAXED, __HIP_MEMORY_SCOPE_WORKGROUP);
        if (s2 >= 0) r2 = __hip_atomic_fetch_add(cl + s2, 1u, __ATOMIC_RELAXED, __HIP_MEMORY_SCOPE_WORKGROUP);
    }
    __syncthreads();
    if (tid < 32) { const unsigned c = cl[tid]; cl[32 + tid] = c ? __hip_atomic_fetch_add(mcnt + bh * 32 + tid, c, __ATOMIC_RELAXED, __HIP_MEMORY_SCOPE_AGENT) : 0u; }
    __syncthreads();
    if (w.hi == 0) {
        const size_t tok = rowbase + qpos;
#define MOBA_EMIT(k, sk, rk) do { if (sk >= 0) qlist[ql_off(bh, sk) + cl[32 + sk] + rk] = (unsigned)qpos | ((unsigned)(k) << 13); \
            else { lsem_ptr(LSEM0, LSEM1, k)[tok * 4 + h] = -1.0e30f;          \
                u32x4* pz = (u32x4*)(PM + ((size_t)(k) * T + tok) * 256 + h * HD); const u32x4 z4 = {0u, 0u, 0u, 0u}; \
                _Pragma("unroll") for (int c = 0; c < 8; ++c) pz[c] = z4; } } while (0)
        MOBA_EMIT(0, s0, r0); MOBA_EMIT(1, s1, r1); MOBA_EMIT(2, s2, r2);
#undef MOBA_EMIT
    }
    __syncthreads();
}
struct OwnU { int b, h, own; };
__device__ __forceinline__ void own_issue(Pref<4>& P, const Wave& w, const OwnU& u, const bf16_t* QB, const bf16_t* KB, const bf16_t* VB) {
    const size_t rowbase = (size_t)u.b * SEQ; const int q0 = u.own * 256;
    win_issue<4>(P, w, KB + (rowbase + q0) * DM + u.h * HD, VB + (rowbase + q0) * DM + u.h * HD, [&](int key) { return (size_t)key * DM; }, QB + (rowbase + q0 + 32 * w.wid + w.r32) * DM + u.h * HD);
}
template <class F> __device__ __forceinline__ void own_compute(const Wave& w, const OwnU& u, const bf16x8 (&qf)[4], bf16_t* OB, float* LSEM0, float* LSEM1, const F& between) {
    const size_t rowbase = (size_t)u.b * SEQ; const int q0 = u.own * 256, ql = 32 * w.wid + w.r32;
    const float slope2 = exp2f(-2.0f * (float)(u.h + 1)) * LOG2E;
    bf16x8 kidx, slp; bias_frags(w, slope2, kidx, slp);
    f32x16 o[2];
#pragma unroll
    for (int r = 0; r < 16; ++r) { o[0][r] = 0.f; o[1][r] = 0.f; }
    float m = 0.f, lsum = 0.f; bool first = true;
#pragma unroll
    for (int p = 0; p < 4; ++p) { WSub sd[2];
#pragma unroll
        for (int i = 0; i < 2; ++i) { const int su = w.wid - 2 * p - i; sd[i].act = su >= 0; sd[i].u = su; sd[i].delta = ql - 32 * su; sd[i].W = (su == w.wid) ? 0x7fffffff : -1; }
        softmax_win<256>(w, qf, kidx, slp, slope2, sd, m, lsum, o, first); }
    between();
    const float l = sum_xor32(lsum);
    scale_rows(w, o, 1.0f / l);
    bf16_t* orow = OB + (rowbase + q0 + 32 * w.wid) * DM + u.h * HD;
    store_o(w, o, [&](int r) { return orow + (size_t)r * DM; });
    if (w.hi == 0) lsem_ptr(LSEM0, LSEM1, 3)[(rowbase + q0 + ql) * 4 + u.h] = m + __builtin_amdgcn_logf(l);
}
struct GatU { int b, h, j, cnt, chunk; const unsigned* ql; };
__device__ __forceinline__ unsigned gat_entry(const Wave& w, const GatU& u, bool& valid) { const int idx = u.chunk * 256 + 32 * w.wid + w.r32; valid = idx < u.cnt; return u.ql[valid ? idx : u.chunk * 256]; }
__device__ __forceinline__ void gat_issue(Pref<4>& P, const Wave& w, const GatU& u, const bf16_t* QB, const bf16_t* KB, const bf16_t* VB) {
    const size_t rowbase = (size_t)u.b * SEQ; bool valid; const unsigned e = gat_entry(w, u, valid);
    win_issue<4>(P, w, KB + (rowbase + u.j * 256) * DM + u.h * HD, VB + (rowbase + u.j * 256) * DM + u.h * HD, [&](int key) { return (size_t)key * DM; }, QB + (rowbase + (e & 8191u)) * DM + u.h * HD);
}
template <class F> __device__ __forceinline__ void gat_compute(const Wave& w, const GatU& u, const bf16x8 (&qf)[4], bf16_t* PM, float* LSEM0, float* LSEM1, const F& between) {
    const size_t rowbase = (size_t)u.b * SEQ; bool valid; const unsigned e = gat_entry(w, u, valid);
    const int qpos = (int)(e & 8191u), slot = (int)(e >> 13);
    const float slope2 = exp2f(-2.0f * (float)(u.h + 1)) * LOG2E;
    bf16x8 kidx, slp; bias_frags(w, slope2, kidx, slp);
    f32x16 o[2];
#pragma unroll
    for (int r = 0; r < 16; ++r) { o[0][r] = 0.f; o[1][r] = 0.f; }
    float m = 0.f, lsum = 0.f; bool first = true;
#pragma unroll
    for (int p = 0; p < 4; ++p) { WSub sd[2];
#pragma unroll
        for (int i = 0; i < 2; ++i) { const int su = 7 - 2 * p - i; sd[i].act = true; sd[i].u = su; sd[i].delta = qpos - (u.j * 256 + 32 * su); sd[i].W = -1; }
        softmax_win<256>(w, qf, kidx, slp, slope2, sd, m, lsum, o, first); }
    between();
    const float l = sum_xor32(lsum);
    scale_rows(w, o, l > 0.f ? 1.0f / l : 0.f);
    LAS int* code = (LAS int*)(w.wsf + 32);
    if (w.hi == 0) code[w.r32] = valid ? (int)((size_t)slot * T + rowbase + qpos) : -1;
    store_o(w, o, [&](int r) { const int c = code[r]; return c >= 0 ? PM + (size_t)c * 256 + u.h * HD : (bf16_t*)nullptr; });
    if (w.hi == 0 && valid) lsem_ptr(LSEM0, LSEM1, slot)[(rowbase + qpos) * 4 + u.h] = l > 0.f ? m + __builtin_amdgcn_logf(l) : -1.0e30f;
}

__device__ __forceinline__ void sb_unit(LAS unsigned char* lds, const bf16_t* QB, const bf16_t* KB, const bf16_t* VB, bf16_t* OB, int b, int h, int qt, int tid) {
    const Wave w = make_wave(lds, tid);
    const size_t rowbase = (size_t)b * SEQ; const int q0 = qt * 256, qpos = q0 + 32 * w.wid + w.r32;
    const bf16_t* kh = KB + rowbase * DM + h * HD; const bf16_t* vh = VB + rowbase * DM + h * HD;
    bf16x8 qf[4]; load_q(qf, QB + (rowbase + qpos) * DM + h * HD, w.hi);
    f32x16 o[2];
#pragma unroll
    for (int r = 0; r < 16; ++r) { o[0][r] = 0.f; o[1][r] = 0.f; }
    float carry = 0.f;
    bool done = false;
    volatile LAS unsigned* flg = (volatile LAS unsigned*)(lds + L_FLG);
    const int ti0 = q0 / 64 + 3;
    Stage sg;
    { const int kp = ti0 * 64; stage_load(sg, w, [&](int key) { return kh + (size_t)(kp + key) * DM; }, [&](int key) { return vh + (size_t)(kp + key) * DM; }); }
    stage_write(sg, w, 0);
    __syncthreads();
    for (int st = 0;; ++st) {
        const int buf = st & 1, ti = ti0 - st;
        if (ti > 0) { const int kp = (ti - 1) * 64; stage_load(sg, w, [&](int key) { return kh + (size_t)(kp + key) * DM; }, [&](int key) { return vh + (size_t)(kp + key) * DM; }); }
        if (!done) {
#pragma unroll
            for (int sub = 1; sub >= 0; --sub) {
                const int D = (q0 / 32 + w.wid) - (2 * ti + sub);
                if (D < 0) continue;
                const int delta0 = qpos - (64 * ti + 32 * sub) - 4 * w.hi;
                f32x16 z = qk_sub(w, buf, sub, qf, 0.f);
                f32x16 dd;
#pragma unroll
                for (int r = 0; r < 16; ++r) { z[r] = __builtin_amdgcn_exp2f(fminf(z[r], 30.f)); }
                if (D == 0) {
#pragma unroll
                    for (int r = 0; r < 16; ++r) { const int dl = delta0 - ((r & 3) + 8 * (r >> 2)); if (dl < 1) z[r] = 0.f; }
                }
#pragma unroll
                for (int r = 0; r < 16; ++r) dd[r] = 1.f + z[r];
                float G[4], PG[4];
#pragma unroll
                for (int g = 0; g < 4; ++g) { G[g] = (dd[4 * g] * dd[4 * g + 1]) * (dd[4 * g + 2] * dd[4 * g + 3]); PG[g] = get_xor32(G[g], w.hi); }
                const float cin = __builtin_amdgcn_exp2f(carry);
                float run = 1.f;
#pragma unroll
                for (int g = 3; g >= 0; --g) { const float x3 = run * (w.hi == 0 ? PG[g] : 1.f);
                    const float p0 = x3 * G[g];
                    const float r0 = __builtin_amdgcn_rcpf(p0) * cin, r1 = r0 * dd[4 * g], r2 = r1 * dd[4 * g + 1], r3 = r2 * dd[4 * g + 2];
                    z[4 * g] *= r0; z[4 * g + 1] *= r1; z[4 * g + 2] *= r2; z[4 * g + 3] *= r3;
                    run *= G[g] * PG[g]; }
                carry -= __builtin_amdgcn_logf(run);
                pv_sub(w, buf, sub, z, o);
            }
            done = __all(carry < -150.f);
        }
        if (w.lane == 0) flg[buf * 8 + w.wid] = done ? 1u : 0u;
        if (ti > 0) stage_write(sg, w, buf ^ 1);
        __syncthreads();
        unsigned all = 1u;
#pragma unroll
        for (int k = 0; k < 8; ++k) all &= flg[buf * 8 + k];
        if (all || ti == 0) break;
    }
    bf16_t* orow = OB + (rowbase + q0 + 32 * w.wid) * DM + h * HD;
    store_o(w, o, [&](int r) { return orow + (size_t)r * DM; });
    __syncthreads();
}

struct PrefK6 { u32x4 k[6]; bf16x8 q[4]; }; struct PrefV6 { u32x4 v[6]; };
template <class RowF> __device__ __forceinline__ void win_issue_k6(PrefK6& P, const Wave& w, const bf16_t* kbase, const RowF& rowoff, const bf16_t* qrow) {
#pragma unroll
    for (int c = 0; c < 6; ++c) P.k[c] = *(const u32x4*)(kbase + rowoff(64 * c + 8 * w.wid + (w.lane >> 3)) + (w.lane & 7) * 8);
    load_q(P.q, qrow, w.hi);
}
template <class RowF> __device__ __forceinline__ void win_issue_v6(PrefV6& P, const Wave& w, const bf16_t* vbase, const RowF& rowoff) {
#pragma unroll
    for (int c = 0; c < 6; ++c) P.v[c] = *(const u32x4*)(vbase + rowoff(64 * c + 16 * (w.wid & 3) + (w.lane >> 2)) + (w.wid >> 2) * 32 + (w.lane & 3) * 8);
}
__device__ __forceinline__ void win_commit_k6(const PrefK6& P, const Wave& w) {
#pragma unroll
    for (int c = 0; c < 6; ++c) { const int key = 64 * c + 8 * w.wid + (w.lane >> 3); *(LAS u32x4*)(w.lds + key * 128 + ((((w.lane & 7) ^ (key >> 1)) & 7) * 16)) = P.k[c]; }
}
__device__ __forceinline__ void win_commit_v6(const PrefV6& P, const Wave& w) {
    constexpr int NK = 384;
#pragma unroll
    for (int c = 0; c < 6; ++c) *(LAS u32x4*)(w.lds + NK * 128 + (w.wid >> 2) * (NK * 64) + (8 * c + 2 * (w.wid & 3)) * 512 + w.lane * 16) = P.v[c];
}
struct DilU { int b, h, dil, res, i2, c; };
__device__ __forceinline__ DilU dil_decode(int u) { const int n = ((u & 31) + (u >> 8)) & 31, bhc = u >> 5,
    c = bhc % 3, bh = bhc / 3; DilU d; d.b = bh >> 3; d.h = 8 + (bh & 7); d.c = c;
    d.dil = (c == 0) ? 1 : (c == 1) ? 4 : 16; d.res = (c == 0) ? 0 : (c == 1) ? (n >> 3) : (n >> 1); d.i2 = (c == 0) ? n : (c == 1) ? (n & 7) : (n & 1); return d; }
__device__ __forceinline__ void dil_issue_k(PrefK6& P, const Wave& w, const DilU& u, const bf16_t* QB, const bf16_t* KB) {
    const size_t rowbase = (size_t)u.b * SEQ; const int Q0 = 256 * u.i2, qj = Q0 + 32 * w.wid + w.r32; const size_t rstride = (size_t)u.dil * DM;
    win_issue_k6(P, w, KB + (rowbase + u.res) * DM + u.h * HD, [&](int key) { const int kj = Q0 - 128 + key; return (size_t)(kj < 0 ? 0 : kj) * rstride; },
                 QB + (rowbase + u.res + (size_t)qj * u.dil) * DM + u.h * HD);
}
__device__ __forceinline__ void dil_issue_v(PrefV6& P, const Wave& w, const DilU& u, const bf16_t* VB) {
    const size_t rowbase = (size_t)u.b * SEQ; const int Q0 = 256 * u.i2; const size_t rstride = (size_t)u.dil * DM;
    win_issue_v6(P, w, VB + (rowbase + u.res) * DM + u.h * HD, [&](int key) { const int kj = Q0 - 128 + key; return (size_t)(kj < 0 ? 0 : kj) * rstride; });
}
template <class F> __device__ __forceinline__ void dil_compute(const Wave& w, const DilU& u, const bf16x8 (&qf)[4], bf16_t* OB, bf16_t* HB2, float* LSE, const F& between) {
    const size_t rowbase = (size_t)u.b * SEQ; const int Q0 = 256 * u.i2, ql = 32 * w.wid + w.r32;
    const float slope2d = exp2f(-(float)(u.h - 8 + 1)) * LOG2E * (float)u.dil;
    bf16x8 kidx, slp; bias_frags(w, slope2d, kidx, slp);
    f32x16 o[2];
#pragma unroll
    for (int r = 0; r < 16; ++r) { o[0][r] = 0.f; o[1][r] = 0.f; }
    float m = 0.f, lsum = 0.f; bool first = true;
#pragma unroll
    for (int p = 0; p < 3; ++p) { WSub sd[2];
#pragma unroll
        for (int i = 0; i < 2; ++i) { const int D = 2 * p + i, su = w.wid + 4 - D; sd[i].act = (D <= 4) && (Q0 - 128 + 32 * su >= 0); sd[i].u = su; sd[i].delta = ql + 128 - 32 * su; sd[i].W = (D == 0 || D == 4) ? 128 : -1; }
        softmax_win<384>(w, qf, kidx, slp, slope2d, sd, m, lsum, o, first); }
    between();
    const float l = sum_xor32(lsum);
    scale_rows(w, o, 1.0f / l);
    bf16_t* PO = (u.c == 0) ? OB + 512 : HB2 + (u.c - 1) * 512;
    const size_t tok0 = rowbase + u.res + (size_t)(Q0 + 32 * w.wid) * u.dil;
    store_o(w, o, [&](int r) { return PO + (tok0 + (size_t)r * u.dil) * DM + (u.h - 8) * HD; });
    if (w.hi == 0) (LSE + (size_t)u.c * T * 8)[(tok0 + (size_t)w.r32 * u.dil) * 8 + (u.h - 8)] = m + __builtin_amdgcn_logf(l);
}

__device__ __forceinline__ void moba_gate_phase(LAS unsigned char* lds, const bf16_t* QB, const float* KMEAN, unsigned* mcnt, unsigned* qlist, bf16_t* PM, float* LSEM0, float* LSEM1, int v, int G, int tid) {
    for (int u = v; u < 512; u += G) { const int own = u & 31, bh = u >> 5; moba_gate_unit(lds, QB, KMEAN, mcnt, qlist, PM, LSEM0, LSEM1, bh >> 2, bh & 3, own, tid); }
}
struct AttnArgs { const bf16_t* QB; const bf16_t* KB; const bf16_t* VB; bf16_t* OB; bf16_t* HB2; float* LSE; unsigned* mcnt; unsigned* qlist; bf16_t* PM; float* LSEM0; float* LSEM1; const float* KMEAN; unsigned* gdone; };
__device__ __forceinline__ void attn_phase(LAS unsigned char* lds, const AttnArgs& A, int v, int G, int tid) {
    moba_gate_phase(lds, A.QB, A.KMEAN, A.mcnt, A.qlist, A.PM, A.LSEM0, A.LSEM1, v, G, tid);
    asm volatile("s_waitcnt vmcnt(0)" ::: "memory");
    __syncthreads();
    if (tid == 0) { __builtin_amdgcn_fence(__ATOMIC_RELEASE, "agent"); asm volatile("s_waitcnt vmcnt(0)" ::: "memory"); __hip_atomic_fetch_add(A.gdone, 1u, __ATOMIC_RELAXED, __HIP_MEMORY_SCOPE_AGENT); }
    const Wave w = make_wave(lds, tid, W_WSF, W_OST);
    {   Pref<4> P; int u = v; OwnU cur, nxt;
        auto dec = [&](int uu) { OwnU o_; const int bh = uu >> 5; o_.b = bh >> 2; o_.h = bh & 3; o_.own = uu & 31; return o_; };
        if (u < 512) { cur = dec(u); own_issue(P, w, cur, A.QB, A.KB, A.VB); }
        for (; u < 512; u += G) {
            __syncthreads();
            win_commit<4>(P, w); bf16x8 qf[4] = {P.q[0], P.q[1], P.q[2], P.q[3]};
            __syncthreads();
            const bool more = u + G < 512; if (more) nxt = dec(u + G);
            own_compute(w, cur, qf, A.OB, A.LSEM0, A.LSEM1, [&]() { if (more) own_issue(P, w, nxt, A.QB, A.KB, A.VB); });
            cur = nxt; } }
    {   PrefK6 P; int u = v; DilU cur, nxt;
        if (u < 3072) { cur = dil_decode(u); dil_issue_k(P, w, cur, A.QB, A.KB); }
        for (; u < 3072; u += G) {
            __syncthreads();
            bf16x8 qf[4] = {P.q[0], P.q[1], P.q[2], P.q[3]};
            { PrefV6 PV; dil_issue_v(PV, w, cur, A.VB); win_commit_k6(P, w); win_commit_v6(PV, w); }
            __syncthreads();
            const bool more = u + G < 3072; if (more) nxt = dil_decode(u + G);
            dil_compute(w, cur, qf, A.OB, A.HB2, A.LSE, [&]() { if (more) dil_issue_k(P, w, nxt, A.QB, A.KB); });
            cur = nxt; } }
    __syncthreads();
    for (int u = v; u < 512; u += G) { const int qt = ((u & 31) + (u >> 8)) & 31, bh = u >> 5; sb_unit(lds, A.QB, A.KB, A.VB, A.OB, bh >> 2, 4 + (bh & 3), qt, tid); }
    if (tid == 0) { unsigned polls = 0;
        while (__hip_atomic_load(A.gdone, __ATOMIC_RELAXED, __HIP_MEMORY_SCOPE_AGENT) < (unsigned)G) { if (++polls > (1u << 20)) break; __builtin_amdgcn_s_sleep(2); }
        __builtin_amdgcn_fence(__ATOMIC_ACQUIRE, "agent"); asm volatile("s_waitcnt vmcnt(0)" ::: "memory"); }
    __syncthreads();
    LAS int* cntl = (LAS int*)(lds + W_ENUM); LAS int* pa = cntl + 512; LAS int* pb = pa + 512;
    const int myc = (int)A.mcnt[tid], myu = (myc + 255) >> 8;
    cntl[tid] = myc; pa[tid] = myu;
    __syncthreads();
#pragma unroll 1
    for (int d = 1; d < 512; d <<= 1) { const int x = pa[tid] + (tid >= d ? pa[tid - d] : 0); pb[tid] = x; __syncthreads(); LAS int* t_ = pa; pa = pb; pb = t_; }
    const int total = pa[511];
    auto gat_decode = [&](int u) { int lo = 0, hi = 511;
        while (lo < hi) { const int mid = (lo + hi) >> 1; if (pa[mid] > u) hi = mid; else lo = mid + 1; }
        const int i = lo, c = cntl[i], bh = i >> 5; GatU g; g.b = bh >> 2; g.h = bh & 3; g.j = i & 31; g.cnt = c; g.chunk = u - (pa[i] - ((c + 255) >> 8)); g.ql = A.qlist + ql_off(bh, g.j); return g; };
    {   Pref<4> P; int u = v; GatU cur, nxt;
        if (u < total) { cur = gat_decode(u); gat_issue(P, w, cur, A.QB, A.KB, A.VB); }
        for (; u < total; u += G) {
            __syncthreads();
            win_commit<4>(P, w); bf16x8 qf[4] = {P.q[0], P.q[1], P.q[2], P.q[3]};
            __syncthreads();
            const bool more = u + G < total; if (more) nxt = gat_decode(u + G);
            gat_compute(w, cur, qf, A.PM, A.LSEM0, A.LSEM1, [&]() { if (more) gat_issue(P, w, nxt, A.QB, A.KB, A.VB); });
            cur = nxt; } }
}
}

constexpr int PH_PRO = 0, PH_L0 = 1, PH_PER_LAYER = 10, PH_FINAL = PH_L0 + DEPTH * PH_PER_LAYER, PH_COUNT = PH_FINAL + 1;
typedef const __attribute__((address_space(4))) Args* KArgP;
#define KARG() ({ KArgP p_ = (KArgP)__builtin_amdgcn_kernarg_segment_ptr(); asm volatile("" : "+s"(p_)); p_; })
#define PHASE_IDS int lane_p = (int)__builtin_amdgcn_mbcnt_hi(~0u, __builtin_amdgcn_mbcnt_lo(~0u, 0u)); LAUNDER_V(lane_p); int tid_p = wave * 64 + lane_p; int gw_p = gw, G_p = G, NGW_p = NGW; LAUNDER_S(gw_p); LAUNDER_S(G_p); LAUNDER_S(NGW_p)
__global__ void __launch_bounds__(NTHREADS, 2) fwd(Args a_unused) {
    extern __shared__ __attribute__((aligned(16))) unsigned char lds_raw[];
    LAS unsigned char* lds = (LAS unsigned char*)lds_raw;
    volatile LAS unsigned* MISC = (volatile LAS unsigned*)(lds + MISC_OFF);
    const int wave = __builtin_amdgcn_readfirstlane((int)threadIdx.x >> 6);
    const int G = gridDim.x, bx = blockIdx.x;
    const int vcu = (G % 8 == 0) ? (bx % 8) * (G / 8) + bx / 8 : bx;
    const int gw = vcu * NWAVES + wave, NGW = G * NWAVES;
    for (int u = threadIdx.x; u < (LDS_BYTES - LDSCTL_OFF) / 4; u += NTHREADS) ((LAS unsigned*)(lds + LDSCTL_OFF))[u] = 0u;
    __syncthreads();
    int lo, hi; XcdBarrier bar;
    { KArgP ka = KARG(); lo = ka->ph_lo; hi = ka->ph_hi; unsigned* ctl = (unsigned*)(ka->ws + WS_CTL); bar = xcd_barrier_post(ctl + CW_BAR + ka->li * XCD_BAR_WORDS, MISC + 8, wave); }
#define IN(k) (lo <= (k) && (k) < hi)
#define SEAM(k) do { if (IN(k) && IN((k) + 1)) xcd_barrier(bar); } while (0)
#define WSP(T_, off) ((T_*)(ws + (off)))

    if (IN(PH_PRO)) { KArgP ka = KARG(); PHASE_IDS; Args a; a.ws = ka->ws; a.w_in = ka->w_in; a.w_out = ka->w_out; a.w_gate = ka->w_gate; a.w_up = ka->w_up; a.w_down = ka->w_down; a.ln2_g = ka->ln2_g; a.ln1_g = ka->ln1_g; phase_prologue(a, lds, gw_p, NGW_p, wave, lane_p); } SEAM(PH_PRO);

    for (int l = 0; l < DEPTH; ++l) {
        const int p0 = PH_L0 + l * PH_PER_LAYER;
        if (hi <= p0 || lo >= p0 + PH_PER_LAYER) continue;
        if (IN(p0 + 0)) for (int rep_ = 0; rep_ < RPT(0); ++rep_) { if (rep_) xcd_barrier(bar); KArgP ka = KARG(); PHASE_IDS; unsigned char* ws = ka->ws;
            if (l == 0) phase_norm1(ka->x, gw_p, NGW_p, lane_p, WSP(float, WS_KMEAN), WSP(bf16_t, WS_XB), WSP(float, WS_RSTD));
            else phase_norm1_b(WSP(bf16_t, WS_XB), gw_p, NGW_p, lane_p, WSP(float, WS_KMEAN), WSP(float, WS_RSTD)); } SEAM(p0 + 0);
        if (IN(p0 + 1)) for (int rep_ = 0; rep_ < RPT(1); ++rep_) { if (rep_) xcd_barrier(bar); KArgP ka = KARG(); PHASE_IDS; unsigned char* ws = ka->ws;
            pg8::Gemm g{(const char*)(ws + WS_XB), (const char*)(ws + WS_WIN) + (size_t)l * NQKV * DM * 2, DM, DM, DM, (long)256 * DM * 2, (long)256 * DM * 2, (long)128 * DM * 2, WSP(float, WS_RSTD)};
            pg8::StaticOrder S; S.init(T / 256, NQKV / 256, G_p, bx);
            pg8::EpiQKV E{WSP(bf16_t, WS_Q), (size_t)(WS_K - WS_Q) / 2, QSCALE};
            pg8::gemm_phase<pg8::EpiQKV, pg8::StaticOrder>(lds, g, S, E, wave);
        } SEAM(p0 + 1);
        if (IN(p0 + 4)) for (int rep_ = 0; rep_ < RPT(4); ++rep_) { if (rep_) xcd_barrier(bar); KArgP ka = KARG(); PHASE_IDS; unsigned char* ws = ka->ws;
            const att::AttnArgs A{WSP(bf16_t, WS_Q), WSP(bf16_t, WS_K), WSP(bf16_t, WS_V), (bf16_t*)ka->out, WSP(bf16_t, WS_HB), WSP(float, WS_LSE), WSP(unsigned, WS_CTL) + CW_MCNT + l * 512, WSP(unsigned, WS_QLIST),
                                  WSP(bf16_t, WS_PM), WSP(float, WS_LSEM0), WSP(float, WS_LSEM1), WSP(float, WS_KMEAN), WSP(unsigned, WS_CTL) + CW_GDONE + l * 64};
            att::attn_phase(lds, A, vcu, G_p, tid_p);
        } SEAM(p0 + 4);
        if (IN(p0 + 5)) { KArgP ka = KARG(); PHASE_IDS; unsigned char* ws = ka->ws;
            phase_mixnorm((const bf16_t*)ka->out, WSP(bf16_t, WS_HB), WSP(float, WS_LSE), WSP(bf16_t, WS_PM), WSP(float, WS_LSEM0), WSP(float, WS_LSEM1), ka->mix_g + (size_t)l * DM, gw_p, NGW_p, lane_p); } SEAM(p0 + 5);
        if (IN(p0 + 6)) { KArgP ka = KARG(); PHASE_IDS; unsigned char* ws = ka->ws;
            pg8::Gemm g{(const char*)(ws + WS_HB), (const char*)(ws + WS_WOUT) + (size_t)l * DM * DM * 2, DM, DM, DM, (long)256 * DM * 2, (long)256 * DM * 2, (long)128 * DM * 2, nullptr};
            pg8::StaticOrder S; S.init(T / 256, DM / 256, G_p, bx);
            pg8::EpiResAdd E{WSP(bf16_t, WS_XB)};
            pg8::gemm_phase<pg8::EpiResAdd, pg8::StaticOrder>(lds, g, S, E, wave);
        } SEAM(p0 + 6);
        if (IN(p0 + 7)) { KArgP ka = KARG(); PHASE_IDS; unsigned char* ws = ka->ws;
            phase_route(WSP(bf16_t, WS_XB), ka->ln2_g + (size_t)l * DM, ka->w_gr + (size_t)l * DM * 4, ka->b_gr + l * 4, ka->w_er + (size_t)l * 4 * DM * 4, ka->b_er + l * 16, WSP(float, WS_LSE),
                        WSP(unsigned, WS_CTL) + CW_CNT + l * 32, WSP(unsigned, WS_LIST), WSP(float, WS_WLIST), lds, vcu, G_p, wave, lane_p); } SEAM(p0 + 7);
        if (IN(p0 + 8)) for (int rep_ = 0; rep_ < RPT(8); ++rep_) { if (rep_) xcd_barrier(bar); KArgP ka = KARG(); PHASE_IDS; unsigned char* ws = ka->ws;
            pg8::MoeProb<0> P{WSP(unsigned, WS_CTL) + CW_CNT + l * 32, WSP(unsigned, WS_LIST), (const char*)(ws + WS_XB), (const char*)(ws + WS_WG) + (size_t)l * NACT * DM * 2, DM, DM, DM, (long)(WS_WU - WS_WG), G_p, vcu, WSP(unsigned, WS_CTL) + CW_TCNT + l * 16384};
            pg8::EpiGateUpSparse E{WSP(bf16_t, WS_ACT), WSP(float, WS_WLIST), WSP(float, WS_LSE), WSP(unsigned, WS_CTL) + CW_TCNT + l * 16384};
            pg8::gemm_phase_x<pg8::EpiGateUpSparse, pg8::MoeProb<0>>(lds, P, E, wave);
        }
        if (IN(p0 + 9)) { KArgP ka = KARG(); PHASE_IDS; unsigned char* ws = ka->ws;
            pg8::MoeProb<1> P{WSP(unsigned, WS_CTL) + CW_CNT + l * 32, WSP(unsigned, WS_LIST), (const char*)(ws + WS_ACT), (const char*)(ws + WS_WD) + (size_t)l * DM * NACT * 2, 512, NACT, 512, (long)128 * NACT * 2, G_p, vcu, WSP(unsigned, WS_CTL) + CW_TCNT + l * 16384};
            pg8::EpiDownScatter E{WSP(bf16_t, WS_XB), WSP(unsigned, WS_LIST)};
            pg8::gemm_phase_x<pg8::EpiDownScatter, pg8::MoeProb<1>>(lds, P, E, wave);
        } SEAM(p0 + 9);
    }
    if (IN(PH_FINAL)) { KArgP ka = KARG(); PHASE_IDS; phase_final((const bf16_t*)(ka->ws + WS_XB), ka->fin_g, ka->out, gw_p, NGW_p, lane_p); }
#undef IN
#undef SEAM
#undef WSP
}

#ifndef N_LAUNCH_MODE
#define N_LAUNCH_MODE 1
#endif
extern "C" void kernel_launch(void* const* d_in, const int* in_sizes, int n_in, void* d_out, int out_size, void* d_ws, size_t ws_size, hipStream_t stream) {
    static int grid = 0;
    if (grid == 0) {
        if (n_in != 14 || in_sizes[0] != T * DM || out_size != T * DM || ws_size < WS_END) { fprintf(stderr, "kernel_launch: unexpected shapes (n_in %d in0 %d out %d ws %zu)\n", n_in, n_in > 0 ? in_sizes[0] : -1, out_size, ws_size); grid = -1; return; }
        int dev = 0, cus = 0, per_cu = 0;
        if (hipGetDevice(&dev) != hipSuccess || hipDeviceGetAttribute(&cus, hipDeviceAttributeMultiprocessorCount, dev) != hipSuccess) { grid = -1; return; }
        if (hipFuncSetAttribute((const void*)fwd, hipFuncAttributeMaxDynamicSharedMemorySize, LDS_BYTES) != hipSuccess) { fprintf(stderr, "kernel_launch: hipFuncSetAttribute failed\n"); grid = -1; return; }
        if (hipOccupancyMaxActiveBlocksPerMultiprocessor(&per_cu, (const void*)fwd, NTHREADS, LDS_BYTES) != hipSuccess || per_cu < 1) fprintf(stderr, "kernel_launch: occupancy query says %d\n", per_cu);
        (void)hipGetLastError();
        grid = cus;
    }
    if (grid < 0) return;
    if (hipMemsetAsync((char*)d_ws + WS_CTL, 0, CTL_ZERO_BYTES, stream) != hipSuccess) return;
    Args a{};
    a.x = (const float*)d_in[0]; a.ln1_g = (const float*)d_in[1]; a.w_in = (const float*)d_in[2]; a.mix_g = (const float*)d_in[3]; a.w_out = (const float*)d_in[4]; a.ln2_g = (const float*)d_in[5];
    a.w_gr = (const float*)d_in[6]; a.b_gr = (const float*)d_in[7]; a.w_er = (const float*)d_in[8]; a.b_er = (const float*)d_in[9]; a.w_gate = (const float*)d_in[10]; a.w_up = (const float*)d_in[11];
    a.w_down = (const float*)d_in[12]; a.fin_g = (const float*)d_in[13];
    a.out = (float*)d_out; a.ws = (unsigned char*)d_ws; a.pad = 0;
#if N_LAUNCH_MODE == 1
    a.ph_lo = 0; a.ph_hi = PH_COUNT; a.li = 0;
    hipLaunchKernelGGL(fwd, dim3(grid), dim3(NTHREADS), LDS_BYTES, stream, a);
#else
    for (int p = 0; p < PH_COUNT; ++p) { a.ph_lo = p; a.ph_hi = p + 1; a.li = p; hipLaunchKernelGGL(fwd, dim3(grid), dim3(NTHREADS), LDS_BYTES, stream, a); }
#endif
}
```

```cpp
#include <hip/hip_runtime.h>
#include <cstdio>
#include <cstdint>

#define LAS __attribute__((address_space(3)))
#define GAS __attribute__((address_space(1)))
typedef unsigned short bf16_t;
typedef short bf16x8 __attribute__((ext_vector_type(8)));
typedef float f32x4 __attribute__((ext_vector_type(4)));
typedef float f32x2 __attribute__((ext_vector_type(2)));
typedef unsigned u32x4 __attribute__((ext_vector_type(4)));
typedef unsigned u32x2 __attribute__((ext_vector_type(2)));

#ifndef PROBE_REPEAT
#define PROBE_REPEAT 0
#endif
#define RPT(k) ((((PROBE_REPEAT) >> (k)) & 1) ? 2 : 1)
#ifndef MOE_SPARSE
#define MOE_SPARSE 1
#endif
#ifndef ATT_MOBA
#define ATT_MOBA 1
#endif
#ifndef ATT_SB
#define ATT_SB 1
#endif
#ifndef ATT_DIL
#define ATT_DIL 1
#endif
constexpr int BATCH = 4, SEQ = 8192, DM = 1024, DEPTH = 4, T = BATCH * SEQ, NH = 16, HD = 64;
constexpr int NQKV = 3 * DM, NEXP = 16, DEXP = 256, NACT = NEXP * DEXP;
constexpr float NORM_EPS = 1e-6f;
constexpr float LOG2E = 1.4426950408889634f;
constexpr float QSCALE = 0.125f * LOG2E;
constexpr int NWAVES = 8, NTHREADS = 512;

constexpr size_t MiB = 1u << 20;
constexpr size_t WS_CTL = 0, CTL_ZERO_BYTES = 1 * MiB;
constexpr size_t WS_WIN = 2 * MiB;
constexpr size_t WS_WOUT = 26 * MiB;
constexpr size_t WS_WG = 34 * MiB;
constexpr size_t WS_WU = 66 * MiB;
constexpr size_t WS_WD = 98 * MiB;
constexpr size_t WS_LSEM0 = 1 * MiB;
constexpr size_t WS_KMEAN = 130 * MiB;
constexpr size_t WS_HB = 131 * MiB;
constexpr size_t WS_Q = 195 * MiB, WS_K = 259 * MiB, WS_V = 323 * MiB, WS_XB = 387 * MiB;
constexpr size_t WS_ACT = WS_Q;
constexpr size_t WS_RSTD = 130 * MiB + 512 * 1024;
constexpr size_t WS_LSE = 451 * MiB;
constexpr size_t WS_LIST = 454 * MiB;
constexpr size_t WS_WLIST = 457 * MiB;
constexpr size_t WS_QLIST = WS_LIST;
constexpr size_t WS_PM = 463 * MiB;
constexpr size_t WS_LSEM1 = 511 * MiB;
constexpr size_t WS_END = 512 * MiB;
constexpr int QL_PER_BH = 126976;
constexpr int CW_GDONE = 1536;
constexpr int CW_MCNT = 2048;
constexpr int CW_CNT = 1024;
constexpr int CW_TCNT = 16384;
constexpr int CW_BAR = 4096;

constexpr int RING_BYTES = 131072;
constexpr int LDSCTL_OFF = 147456, MISC_OFF = LDSCTL_OFF + 320;
constexpr int LDS_BYTES = 148480;

__device__ __forceinline__ unsigned f2bf(float f) { unsigned u = __builtin_bit_cast(unsigned, f); return (u + 0x7fffu + ((u >> 16) & 1u)) >> 16; }
__device__ __forceinline__ unsigned pk2(float lo, float hi) { return f2bf(lo) | (f2bf(hi) << 16); }
__device__ __forceinline__ float bflo(unsigned w) { return __builtin_bit_cast(float, w << 16); }
__device__ __forceinline__ float bfhi(unsigned w) { return __builtin_bit_cast(float, w & 0xffff0000u); }
template <int M> __device__ __forceinline__ float swz_xor(float v) { return __builtin_bit_cast(float, __builtin_amdgcn_ds_swizzle(__builtin_bit_cast(int, v), 0x1f | (M << 10))); }
__device__ __forceinline__ void swap32(unsigned x, unsigned& lo_val, unsigned& hi_val) { unsigned y = x; asm volatile("" : "+v"(y)); auto rr = __builtin_amdgcn_permlane32_swap(x, y, false, false); lo_val = rr[0]; hi_val = rr[1]; }
__device__ __forceinline__ float sum_xor32(float v) { unsigned a, b; swap32(__builtin_bit_cast(unsigned, v), a, b); return __builtin_bit_cast(float, a) + __builtin_bit_cast(float, b); }
__device__ __forceinline__ float max_xor32(float v) { unsigned a, b; swap32(__builtin_bit_cast(unsigned, v), a, b); return fmaxf(__builtin_bit_cast(float, a), __builtin_bit_cast(float, b)); }
__device__ __forceinline__ float get_xor32(float v, int hi) { unsigned a, b; swap32(__builtin_bit_cast(unsigned, v), a, b); return __builtin_bit_cast(float, hi ? a : b); }
__device__ __forceinline__ int get_xor32i(int v, int hi) { unsigned a, b; swap32((unsigned)v, a, b); return (int)(hi ? a : b); }
template <int CTRL> __device__ __forceinline__ float dpp_mov(float v) { return __builtin_bit_cast(float, __builtin_amdgcn_update_dpp(0, __builtin_bit_cast(int, v), CTRL, 0xf, 0xf, false)); }
__device__ __forceinline__ float row_sum(float v) { v += dpp_mov<0xB1>(v); v += dpp_mov<0x4E>(v); v += dpp_mov<0x141>(v); v += dpp_mov<0x140>(v); return v; }
__device__ __forceinline__ float half_sum(float v) { v = row_sum(v); v += swz_xor<16>(v); return v; }
__device__ __forceinline__ float wave_sum(float v) { return sum_xor32(half_sum(v)); }
#define LDS_WAIT() asm volatile("s_waitcnt lgkmcnt(0)" ::: "memory")
#define LAUNDER_V(x) asm volatile("" : "+v"(x))
#define LAUNDER_S(x) asm volatile("" : "+s"(x))

namespace pg8 {
constexpr int BM = 256, BK = 64, HALF = 128, HTB = HALF * BK * 2, STAGE_BYTES = 8 * HTB, NXCD = 8, WGM = 8;
__host__ __device__ __forceinline__ int lds_byte(int r, int c) { const int st = (r >> 4) * 2 + (c >> 5), rr = r & 15, cc = c & 31, ob = rr * 64 + cc * 2; return st * 1024 + (ob ^ (((ob >> 9) & 1) << 5)); }
__host__ __device__ __forceinline__ void stage_rc(int b, int& R, int& C) { const int st = b / 1024, sb = b % 1024, swz = sb ^ (((sb >> 9) & 1) << 5); R = (st >> 1) * 16 + swz / 64; C = (st & 1) * 32 + (swz % 64) / 2; }
__host__ __device__ __forceinline__ int perm32(int rho) { const int n = rho >> 4, i = rho & 15; return 8 * (i >> 2) + 4 * n + (i & 3); }

struct Unit { int pm, pn, meta;
    __device__ __forceinline__ int bk() const { return meta & 31; } __device__ __forceinline__ int tib() const { return (meta >> 5) & 255; } __device__ __forceinline__ int nb() const { return meta >> 13; } };
struct Gemm { const char* A; const char* B; int lda, ldb, K; long tstepA, tstepB, hstepB; const float* rowvec; };
constexpr int RV_OFF = 140288;

struct StaticOrder {
    int nM, nN, nwg, G, c;
    __host__ __device__ void init(int nM_, int nN_, int G_, int c_) { nM = nM_; nN = nN_; nwg = nM * nN; G = G_; c = c_; }
    __host__ __device__ bool next(int i, Unit& u) const {
        const long L = (long)i * G + c; if (L >= nwg) return false;
        int wgid = (int)L; { const int q = nwg / NXCD, r = nwg % NXCD, xcd = wgid % NXCD, off = wgid / NXCD; wgid = (xcd < r ? xcd * (q + 1) : r * (q + 1) + (xcd - r) * q) + off; }
        const int nig = WGM * nN, gid = wgid / nig, fm = gid * WGM, gsz = (nM - fm) < WGM ? (nM - fm) : WGM;
        u.pm = fm + ((wgid % nig) % gsz); u.pn = (wgid % nig) / gsz; return true;
    }
};

__device__ __forceinline__ unsigned cvt_pk_bf16(float lo, float hi) { unsigned r; asm volatile("v_cvt_pk_bf16_f32 %0, %1, %2" : "=v"(r) : "v"(lo), "v"(hi)); return r; }

struct EpiQKV {
    static constexpr bool PERM = true, ROWVEC = true;
    bf16_t* O; size_t split_stride; float scale0;
    __device__ __forceinline__ void operator()(const f32x4 (&acc)[2][2][4][2], const Unit& u, int wr, int wc, int fr, int fq, const LAS float* rv) const {
        asm volatile("" : "+v"(fr), "+v"(fq));
        float rs[2][4];
#pragma unroll
        for (int ai = 0; ai < 2; ++ai)
#pragma unroll
            for (int m = 0; m < 4; ++m) rs[ai][m] = rv[ai * HALF + wr * 64 + m * 16 + fr];
        const int row0 = u.pm * BM + wr * 64 + fr; int colt = u.pn * BM;
        const int t = colt / DM; bf16_t* base = O + (size_t)t * split_stride; colt -= t * DM; const float sc = (t == 0) ? scale0 : 1.f;
        const int col0 = colt + wc * 32 + 8 * fq;
#pragma unroll
        for (int ai = 0; ai < 2; ++ai)
#pragma unroll
            for (int m = 0; m < 4; ++m) { bf16_t* rowp = base + (size_t)(row0 + ai * HALF + m * 16) * DM + col0;
#pragma unroll
                for (int bj = 0; bj < 2; ++bj) { const float sr = sc * rs[ai][m]; f32x4 v0 = acc[ai][bj][m][0] * sr, v1 = acc[ai][bj][m][1] * sr;
                    u32x4 w; w.x = cvt_pk_bf16(v0[0], v0[1]); w.y = cvt_pk_bf16(v0[2], v0[3]); w.z = cvt_pk_bf16(v1[0], v1[1]); w.w = cvt_pk_bf16(v1[2], v1[3]);
                    *(u32x4*)(rowp + bj * HALF) = w; } }
        if (u.pn == 4) {
            float* kmean = (float*)((unsigned char*)O - WS_Q + WS_KMEAN) + ((size_t)((u.pm >> 5) * 4) * 32 + (u.pm & 31)) * HD;
#pragma unroll
            for (int bj = 0; bj < 2; ++bj)
#pragma unroll
                for (int n = 0; n < 2; ++n)
#pragma unroll
                    for (int j = 0; j < 4; ++j) { float cs = 0.f;
#pragma unroll
                        for (int ai = 0; ai < 2; ++ai)
#pragma unroll
                            for (int m = 0; m < 4; ++m) cs += acc[ai][bj][m][n][j] * rs[ai][m];
                        cs = row_sum(cs);
                        const int col = bj * HALF + wc * 32 + 8 * fq + 4 * n + j;
                        if (fr == 0) __hip_atomic_fetch_add(kmean + (size_t)(col >> 6) * 32 * HD + (col & 63), cs, __ATOMIC_RELAXED, __HIP_MEMORY_SCOPE_AGENT); }
        }
    }
};
struct EpiResAdd {
    static constexpr bool PERM = true, ROWVEC = false;
    bf16_t* xb;
    __device__ __forceinline__ void operator()(const f32x4 (&acc)[2][2][4][2], const Unit& u, int wr, int wc, int fr, int fq, const LAS float*) const {
        asm volatile("" : "+v"(fr), "+v"(fq));
        const int col0 = u.pn * BM + wc * 32 + 8 * fq;
#pragma unroll
        for (int ai = 0; ai < 2; ++ai) { u32x4 r[4][2];
#pragma unroll
            for (int m = 0; m < 4; ++m) { const bf16_t* rowp = xb + (size_t)(u.pm * BM + ai * HALF + wr * 64 + m * 16 + fr) * DM + col0;
#pragma unroll
                for (int bj = 0; bj < 2; ++bj) r[m][bj] = *(const u32x4*)(rowp + bj * HALF); }
#pragma unroll
            for (int m = 0; m < 4; ++m) { bf16_t* rowp = xb + (size_t)(u.pm * BM + ai * HALF + wr * 64 + m * 16 + fr) * DM + col0;
#pragma unroll
                for (int bj = 0; bj < 2; ++bj) { const f32x4 v0 = acc[ai][bj][m][0], v1 = acc[ai][bj][m][1]; const u32x4 q = r[m][bj];
                    u32x4 w; w.x = cvt_pk_bf16(bflo(q.x) + v0[0], bfhi(q.x) + v0[1]); w.y = cvt_pk_bf16(bflo(q.y) + v0[2], bfhi(q.y) + v0[3]);
                    w.z = cvt_pk_bf16(bflo(q.z) + v1[0], bfhi(q.z) + v1[1]); w.w = cvt_pk_bf16(bflo(q.w) + v1[2], bfhi(q.w) + v1[3]);
                    *(u32x4*)(rowp + bj * HALF) = w; } } }
    }
};
struct EpiGateUpDense {
    static constexpr bool PERM = true;
    bf16_t* act; const float* comb;
    __device__ __forceinline__ void operator()(const f32x4 (&acc)[2][2][4][2], const Unit& u, int wr, int wc, int fr, int fq) const {
        asm volatile("" : "+v"(fr), "+v"(fq));
        const int e = u.pn >> 1, c0 = (u.pn & 1) * HALF;
        const int col0 = e * DEXP + c0 + wc * 32 + 8 * fq;
#pragma unroll
        for (int ai = 0; ai < 2; ++ai)
#pragma unroll
            for (int m = 0; m < 4; ++m) { const int row = u.pm * BM + ai * HALF + wr * 64 + m * 16 + fr;
                const float cw = comb[(size_t)row * NEXP + e];
                float o[8];
#pragma unroll
                for (int n = 0; n < 2; ++n)
#pragma unroll
                    for (int j = 0; j < 4; ++j) { const float g = acc[ai][0][m][n][j], up = acc[ai][1][m][n][j];
                        const float sg = g * __builtin_amdgcn_rcpf(1.f + __builtin_amdgcn_exp2f(-g * LOG2E));
                        o[n * 4 + j] = sg * up * cw; }
                u32x4 w; w.x = cvt_pk_bf16(o[0], o[1]); w.y = cvt_pk_bf16(o[2], o[3]); w.z = cvt_pk_bf16(o[4], o[5]); w.w = cvt_pk_bf16(o[6], o[7]);
                *(u32x4*)(act + (size_t)row * NACT + col0) = w; }
    }
};

template <class Epi, class Sched>
__device__ __forceinline__ void gemm_phase(LAS unsigned char* lds, const Gemm g, const Sched& S, const Epi& E, int wave_id) {
    int lane_l = (int)__builtin_amdgcn_mbcnt_hi(~0u, __builtin_amdgcn_mbcnt_lo(~0u, 0u)); asm volatile("" : "+v"(lane_l));
    const int wid = wave_id, lane = lane_l, tid = wid * 64 + lane, wr = wid >> 2, wc = wid & 3, fr = lane & 15, fq = lane >> 4;
    const int K = g.K, nt = K / BK;
    unsigned voffA[2], voffB[2];
#pragma unroll
    for (int i = 0; i < 2; ++i) { int R, C; stage_rc(tid * 16 + i * 8192, R, C); const int Rb = Epi::PERM ? ((R & ~31) + perm32(R & 31)) : R;
        voffA[i] = (unsigned)(R * g.lda + C) * 2u; voffB[i] = (unsigned)(Rb * g.ldb + C) * 2u; }
    const size_t kstep = (size_t)(BK * 2);
    const size_t hstepA = (size_t)HALF * g.lda * 2;
    const long hstepB = g.hstepB;
    const unsigned ldsw = (unsigned)wid * 1024u;
    const int aoff = lds_byte(wr * 64 + fr, fq * 8), boff = lds_byte(wc * 32 + fr, fq * 8);
#define PG8_SA(b, h) (((b) * 2 + (h)) * HTB)
#define PG8_SB(b, h) ((4 + (b) * 2 + (h)) * HTB)
#define PG8_STAGE(bufoff, gbase, voff) do { _Pragma("unroll") for (int _i = 0; _i < 2; ++_i) \
        __builtin_amdgcn_global_load_lds((const unsigned*)((const char*)(gbase) + (voff)[_i]), (LAS unsigned*)(lds + (bufoff) + ldsw + _i * 8192), 16, 0, 0); } while (0)
#define PG8_LDA(dst, b, h) do { _Pragma("unroll") for (int m = 0; m < 4; ++m) _Pragma("unroll") for (int k = 0; k < 2; ++k) dst[m][k] = *(const LAS bf16x8*)(lds + PG8_SA(b, h) + aoff + m * 2048 + k * 1024); } while (0)
#define PG8_LDB(dst, b, h) do { _Pragma("unroll") for (int n = 0; n < 2; ++n) _Pragma("unroll") for (int k = 0; k < 2; ++k) dst[n][k] = *(const LAS bf16x8*)(lds + PG8_SB(b, h) + boff + n * 2048 + k * 1024); } while (0)
#define PG8_MMA(ai, bj, At, Bt) do { __builtin_amdgcn_s_setprio(1); _Pragma("unroll") for (int m = 0; m < 4; ++m) _Pragma("unroll") for (int n = 0; n < 2; ++n) _Pragma("unroll") for (int k = 0; k < 2; ++k) \
        acc[ai][bj][m][n] = __builtin_amdgcn_mfma_f32_16x16x32_bf16(Bt[n][k], At[m][k], acc[ai][bj][m][n], 0, 0, 0); __builtin_amdgcn_s_setprio(0); } while (0)
#define PG8_WAIT_V(n) asm volatile("s_waitcnt vmcnt(" #n ")" ::: "memory")
#define PG8_WAIT_L(n) asm volatile("s_waitcnt lgkmcnt(" #n ")" ::: "memory")
#define PG8_BAR __builtin_amdgcn_s_barrier()
#define PG8_SCHED __builtin_amdgcn_sched_barrier(0)
    Unit cur, nxt; int ui = 0;
    if (!S.next(0, cur)) return;
#define PG8_RV(u_, b_) do { if (Epi::ROWVEC && wid < 4) __builtin_amdgcn_global_load_lds((const unsigned*)(g.rowvec + (size_t)(u_).pm * BM + wid * 64 + lane), (LAS unsigned*)(lds + RV_OFF + (b_) * 1024 + wid * 256), 4, 0, 0); } while (0)
    PG8_RV(cur, 0);
    f32x4 acc[2][2][4][2];
#pragma unroll
    for (int a = 0; a < 2; ++a)
#pragma unroll
        for (int b = 0; b < 2; ++b)
#pragma unroll
            for (int m = 0; m < 4; ++m)
#pragma unroll
                for (int n = 0; n < 2; ++n) acc[a][b][m][n] = (f32x4){0.f, 0.f, 0.f, 0.f};
    bf16x8 At[4][2], B0[2][2], B1[2][2];
    const char* cA = g.A + (size_t)cur.pm * g.tstepA; const char* cB = g.B + (size_t)cur.pn * g.tstepB;
    PG8_STAGE(PG8_SB(0, 0), cB, voffB); PG8_STAGE(PG8_SB(0, 1), cB + hstepB, voffB); PG8_STAGE(PG8_SA(0, 0), cA, voffA); PG8_STAGE(PG8_SA(0, 1), cA + hstepA, voffA);
    if (wr == 1) PG8_BAR;
    PG8_WAIT_V(2); PG8_BAR;
    PG8_STAGE(PG8_SB(1, 0), cB + kstep, voffB); PG8_STAGE(PG8_SA(1, 0), cA + kstep, voffA); PG8_STAGE(PG8_SB(1, 1), cB + hstepB + kstep, voffB);
    PG8_WAIT_V(6); PG8_BAR;
    for (;;) {
        const bool has_next = S.next(ui + 1, nxt);
        const char* nA = has_next ? g.A + (size_t)nxt.pm * g.tstepA : cA; const char* nB = has_next ? g.B + (size_t)nxt.pn * g.tstepB : cB;
        for (int t = 0; t < nt; t += 2) {
            const bool last = (t == nt - 2);
            const char* a1 = cA + (size_t)(t + 1) * kstep;
            const char* a2 = last ? nA : cA + (size_t)(t + 2) * kstep; const char* b2 = last ? nB : cB + (size_t)(t + 2) * kstep;
            const char* a3 = a2 + kstep; const char* b3 = b2 + kstep;
            PG8_LDB(B0, 0, 0); PG8_LDB(B1, 0, 1); PG8_SCHED; PG8_LDA(At, 0, 0); PG8_STAGE(PG8_SA(1, 1), a1 + hstepA, voffA);
            PG8_WAIT_V(8); PG8_WAIT_L(0); PG8_BAR; PG8_MMA(0, 0, At, B0); PG8_MMA(0, 1, At, B1); PG8_BAR; PG8_SCHED;
            PG8_LDA(At, 0, 1); PG8_STAGE(PG8_SB(0, 0), b2, voffB); PG8_STAGE(PG8_SB(0, 1), b2 + hstepB, voffB); PG8_STAGE(PG8_SA(0, 0), a2, voffA);
            PG8_WAIT_V(8); PG8_WAIT_L(0); PG8_BAR; PG8_MMA(1, 0, At, B0); PG8_MMA(1, 1, At, B1); PG8_BAR; PG8_SCHED;
            PG8_LDB(B0, 1, 0); PG8_LDB(B1, 1, 1); PG8_SCHED; PG8_LDA(At, 1, 0); PG8_STAGE(PG8_SA(0, 1), a2 + hstepA, voffA);
            PG8_WAIT_V(8); PG8_WAIT_L(0); PG8_BAR; PG8_MMA(0, 0, At, B0); PG8_MMA(0, 1, At, B1); PG8_BAR; PG8_SCHED;
            PG8_LDA(At, 1, 1); PG8_STAGE(PG8_SB(1, 0), b3, voffB); PG8_STAGE(PG8_SB(1, 1), b3 + hstepB, voffB); PG8_STAGE(PG8_SA(1, 0), a3, voffA);
            PG8_WAIT_V(8); PG8_WAIT_L(0); PG8_BAR; PG8_MMA(1, 0, At, B0); PG8_MMA(1, 1, At, B1); PG8_BAR; PG8_SCHED;
        }
        if (wr == 0) PG8_BAR;
        E(acc, cur, wr, wc, fr, fq, (const LAS float*)(lds + RV_OFF + (ui & 1) * 1024));
        if (!has_next) break;
#pragma unroll
        for (int a = 0; a < 2; ++a)
#pragma unroll
            for (int b = 0; b < 2; ++b)
#pragma unroll
                for (int m = 0; m < 4; ++m)
#pragma unroll
                    for (int n = 0; n < 2; ++n) acc[a][b][m][n] = (f32x4){0.f, 0.f, 0.f, 0.f};
        cur = nxt; cA = nA; cB = nB; ++ui;
        PG8_RV(cur, ui & 1);
        if (wr == 1) PG8_BAR;
    }
    PG8_WAIT_V(0);
    PG8_BAR;
#undef PG8_SA
#undef PG8_SB
#undef PG8_STAGE
#undef PG8_LDA
#undef PG8_LDB
#undef PG8_MMA
#undef PG8_WAIT_V
#undef PG8_WAIT_L
#undef PG8_BAR
#undef PG8_SCHED
#undef PG8_RV
}
template <class Epi, class Prob>
__device__ __forceinline__ void gemm_phase_x(LAS unsigned char* lds, const Prob& P, const Epi& E, int wave_id) {
    int lane_l = (int)__builtin_amdgcn_mbcnt_hi(~0u, __builtin_amdgcn_mbcnt_lo(~0u, 0u)); asm volatile("" : "+v"(lane_l));
    const int wid = wave_id, lane = lane_l, tid = wid * 64 + lane, wr = wid >> 2, wc = wid & 3, fr = lane & 15, fq = lane >> 4;
    const int K = P.K, nt = K / BK;
    unsigned voffB[2];
#pragma unroll
    for (int i = 0; i < 2; ++i) { int R, C; stage_rc(tid * 16 + i * 8192, R, C); const int Rb = Epi::PERM ? ((R & ~31) + perm32(R & 31)) : R; voffB[i] = (unsigned)(Rb * P.ldb + C) * 2u; }
    const size_t kstep = (size_t)(BK * 2);
    const long hstepB = P.hstepB;
    const unsigned ldsw = (unsigned)wid * 1024u;
    const int aoff = lds_byte(wr * 64 + fr, fq * 8), boff = lds_byte(wc * 32 + fr, fq * 8);
    LAS u32x4* stash = (LAS u32x4*)(lds + STAGE_BYTES + 1024) + tid;
#define PG8_SA(b, h) (((b) * 2 + (h)) * HTB)
#define PG8_SB(b, h) ((4 + (b) * 2 + (h)) * HTB)
#define PG8_STAGE(bufoff, gbase, voff) do { _Pragma("unroll") for (int _i = 0; _i < 2; ++_i) \
        __builtin_amdgcn_global_load_lds((const unsigned*)((const char*)(gbase) + (voff)[_i]), (LAS unsigned*)(lds + (bufoff) + ldsw + _i * 8192), 16, 0, 0); } while (0)
#define PG8_LDA(dst, b, h) do { _Pragma("unroll") for (int m = 0; m < 4; ++m) _Pragma("unroll") for (int k = 0; k < 2; ++k) dst[m][k] = *(const LAS bf16x8*)(lds + PG8_SA(b, h) + aoff + m * 2048 + k * 1024); } while (0)
#define PG8_LDB(dst, b, h) do { _Pragma("unroll") for (int n = 0; n < 2; ++n) _Pragma("unroll") for (int k = 0; k < 2; ++k) dst[n][k] = *(const LAS bf16x8*)(lds + PG8_SB(b, h) + boff + n * 2048 + k * 1024); } while (0)
#define PG8_MMA(ai, bj, At, Bt) do { __builtin_amdgcn_s_setprio(1); _Pragma("unroll") for (int m = 0; m < 4; ++m) _Pragma("unroll") for (int n = 0; n < 2; ++n) _Pragma("unroll") for (int k = 0; k < 2; ++k) \
        acc[ai][bj][m][n] = __builtin_amdgcn_mfma_f32_16x16x32_bf16(Bt[n][k], At[m][k], acc[ai][bj][m][n], 0, 0, 0); __builtin_amdgcn_s_setprio(0); } while (0)
#define PG8_WAIT_V(n) asm volatile("s_waitcnt vmcnt(" #n ")" ::: "memory")
#define PG8_WAIT_L(n) asm volatile("s_waitcnt lgkmcnt(" #n ")" ::: "memory")
#define PG8_BAR __builtin_amdgcn_s_barrier()
#define PG8_SCHED __builtin_amdgcn_sched_barrier(0)
#define PG8_AVOFF(dst, u) do { int t2_ = tid; asm volatile("" : "+v"(t2_)); _Pragma("unroll") for (int i_ = 0; i_ < 2; ++i_) { int R_, C_; stage_rc(t2_ * 16 + i_ * 8192, R_, C_); _Pragma("unroll") for (int h_ = 0; h_ < 2; ++h_) \
        dst[h_][i_] = (Prob::GATHER ? P.arow_off(u, h_, R_) : (unsigned)((h_ * HALF + R_) * P.lda) * 2u) + (unsigned)C_ * 2u; } } while (0)
    Unit cur, nxt; int ui = 0;
    if (!P.next(0, cur)) return;
    unsigned vA[2][2];
    PG8_AVOFF(vA, cur);
    f32x4 acc[2][2][4][2];
#pragma unroll
    for (int a = 0; a < 2; ++a)
#pragma unroll
        for (int b = 0; b < 2; ++b)
#pragma unroll
            for (int m = 0; m < 4; ++m)
#pragma unroll
                for (int n = 0; n < 2; ++n) acc[a][b][m][n] = (f32x4){0.f, 0.f, 0.f, 0.f};
    bf16x8 At[4][2], B0[2][2], B1[2][2];
    const char* cA = P.a_base(cur); const char* cB = P.b_base(cur);
    long csplit = Prob::KSPLIT ? P.bsplit(cur) : 0;
    if (Prob::WAITS) P.a_ready(cur, wid);
    PG8_STAGE(PG8_SB(0, 0), cB, voffB); PG8_STAGE(PG8_SB(0, 1), cB + hstepB, voffB); PG8_STAGE(PG8_SA(0, 0), cA, vA[0]); PG8_STAGE(PG8_SA(0, 1), cA, vA[1]);
    if (wr == 1) PG8_BAR;
    PG8_WAIT_V(2); PG8_BAR;
    PG8_STAGE(PG8_SB(1, 0), cB + kstep, voffB); PG8_STAGE(PG8_SA(1, 0), cA + kstep, vA[0]); PG8_STAGE(PG8_SB(1, 1), cB + hstepB + kstep, voffB);
    PG8_WAIT_V(6); PG8_BAR;
    for (;;) {
        const bool has_next = P.next(ui + 1, nxt);
        const char* nA = has_next ? P.a_base(nxt) : cA; const char* nB = has_next ? P.b_base(nxt) : cB;
        if (Prob::GATHER) { unsigned vN[2][2];
            if (has_next) { PG8_AVOFF(vN, nxt); } else { vN[0][0] = vA[0][0]; vN[0][1] = vA[0][1]; vN[1][0] = vA[1][0]; vN[1][1] = vA[1][1]; }
            *stash = (u32x4){vN[0][0], vN[0][1], vN[1][0], vN[1][1]}; }
        for (int t = 0; t < nt; t += 2) {
            const bool last = (t == nt - 2);
            if (Prob::WAITS && last && has_next) P.a_ready(nxt, wid);
            const char* a1 = cA + (size_t)(t + 1) * kstep;
            const char* a2 = last ? nA : cA + (size_t)(t + 2) * kstep;
            const char* b2 = last ? nB : cB + (size_t)(t + 2) * kstep + ((Prob::KSPLIT && (t + 2) >= (nt >> 1)) ? csplit : 0);
            const char* a3 = a2 + kstep; const char* b3 = b2 + kstep;
            PG8_LDB(B0, 0, 0); PG8_LDB(B1, 0, 1); PG8_SCHED; PG8_LDA(At, 0, 0); PG8_STAGE(PG8_SA(1, 1), a1, vA[1]);
            if (Prob::GATHER && last) { const u32x4 sv = *stash; vA[0][0] = sv.x; vA[0][1] = sv.y; vA[1][0] = sv.z; vA[1][1] = sv.w; }
            PG8_WAIT_V(8); PG8_WAIT_L(0); PG8_BAR; PG8_MMA(0, 0, At, B0); PG8_MMA(0, 1, At, B1); PG8_BAR; PG8_SCHED;
            PG8_LDA(At, 0, 1); PG8_STAGE(PG8_SB(0, 0), b2, voffB); PG8_STAGE(PG8_SB(0, 1), b2 + hstepB, voffB); PG8_STAGE(PG8_SA(0, 0), a2, vA[0]);
            PG8_WAIT_V(8); PG8_WAIT_L(0); PG8_BAR; PG8_MMA(1, 0, At, B0); PG8_MMA(1, 1, At, B1); PG8_BAR; PG8_SCHED;
            PG8_LDB(B0, 1, 0); PG8_LDB(B1, 1, 1); PG8_SCHED; PG8_LDA(At, 1, 0); PG8_STAGE(PG8_SA(0, 1), a2, vA[1]);
            PG8_WAIT_V(8); PG8_WAIT_L(0); PG8_BAR; PG8_MMA(0, 0, At, B0); PG8_MMA(0, 1, At, B1); PG8_BAR; PG8_SCHED;
            PG8_LDA(At, 1, 1); PG8_STAGE(PG8_SB(1, 0), b3, voffB); PG8_STAGE(PG8_SB(1, 1), b3 + hstepB, voffB); PG8_STAGE(PG8_SA(1, 0), a3, vA[0]);
            PG8_WAIT_V(8); PG8_WAIT_L(0); PG8_BAR; PG8_MMA(1, 0, At, B0); PG8_MMA(1, 1, At, B1); PG8_BAR; PG8_SCHED;
        }
        if (wr == 0) PG8_BAR;
        E(acc, cur, wr, wc, fr, fq);
        if (!has_next) break;
#pragma unroll
        for (int a = 0; a < 2; ++a)
#pragma unroll
            for (int b = 0; b < 2; ++b)
#pragma unroll
                for (int m = 0; m < 4; ++m)
#pragma unroll
                    for (int n = 0; n < 2; ++n) acc[a][b][m][n] = (f32x4){0.f, 0.f, 0.f, 0.f};
        cur = nxt; cA = nA; cB = nB; ++ui;
        if (Prob::KSPLIT) csplit = P.bsplit(cur);
        if (wr == 1) PG8_BAR;
    }
    PG8_WAIT_V(0);
    PG8_BAR;
#undef PG8_SA
#undef PG8_SB
#undef PG8_STAGE
#undef PG8_LDA
#undef PG8_LDB
#undef PG8_MMA
#undef PG8_WAIT_V
#undef PG8_WAIT_L
#undef PG8_BAR
#undef PG8_SCHED
#undef PG8_AVOFF
}

__device__ __forceinline__ int pair_a(int pi) { return pi < 3 ? 0 : (pi < 5 ? 1 : 2); }
__device__ __forceinline__ int pair_b(int pi) { return pi == 0 ? 1 : ((pi == 1 || pi == 3) ? 2 : 3); }
template <int MODE>
struct MoeProb {
    static constexpr bool GATHER = (MODE == 0), KSPLIT = (MODE == 1);
    const unsigned* cnt; const unsigned* list; const char* A; const char* B; int lda, ldb, K; long hstepB; int G, c; unsigned* tcnt;
    static constexpr bool WAITS = (MODE == 1);
    __device__ __forceinline__ void a_ready(const Unit& u, int wave) const {
        if (MODE == 1) {
            if (wave == 0) { unsigned polls = 0;
                while ((unsigned)__builtin_amdgcn_readfirstlane(__hip_atomic_load(tcnt + 64 * u.pm, __ATOMIC_RELAXED, __HIP_MEMORY_SCOPE_AGENT)) < 32u) {
                    if (++polls > (1u << 20)) break;
                    __builtin_amdgcn_s_sleep(2); }
                __builtin_amdgcn_fence(__ATOMIC_ACQUIRE, "agent");
                asm volatile("s_waitcnt vmcnt(0)" ::: "memory"); }
            asm volatile("" ::: "memory"); __builtin_amdgcn_s_barrier(); asm volatile("" ::: "memory");
        }
    }
    __device__ __forceinline__ bool next(int i, Unit& u) const {
        long L = (long)i * G + c;
        if (MODE == 1) {
            int tot = 0;
            for (int k = 0; k < 24; ++k) tot += ((int)cnt[k] + 255) >> 8;
            const int N = 4 * tot, R = N - 2 * G;
            if (R > 0 && R < G) { if (c < R) { if (i > 0) return false; L = c; } else L = (i == 0) ? c : (long)G + (c - R) + (long)(i - 1) * (G - R); }
            else L = (long)i * G + (G - 1 - c);
        }
        const int tileidx = (int)(L >> 2);
        int accu = 0, bk = -1, tib = 0, nb = 0;
        for (int k = 0; k < 24; ++k) { const int n = (int)cnt[k]; const int tl = (n + 255) >> 8; if (bk < 0 && tileidx < accu + tl) { bk = k; tib = tileidx - accu; nb = n; } accu += tl; }
        if (bk < 0) return false;
        u.pm = tileidx; u.pn = (int)(L & 3); u.meta = bk | (tib << 5) | (nb << 13); return true;
    }
    __device__ __forceinline__ int expert(const Unit& u, int s) const { const int g = u.bk() / 6, pi = u.bk() % 6; return g * 4 + (s ? pair_b(pi) : pair_a(pi)); }
    __device__ __forceinline__ const char* a_base(const Unit& u) const { return MODE == 0 ? A : A + (size_t)u.pm * 256 * lda * 2; }
    __device__ __forceinline__ const char* b_base(const Unit& u) const {
        if (MODE == 0) return B + ((size_t)expert(u, u.pn >> 1) * DEXP + (size_t)(u.pn & 1) * HALF) * ldb * 2;
        return B + (size_t)u.pn * 256 * ldb * 2 + (size_t)expert(u, 0) * DEXP * 2;
    }
    __device__ __forceinline__ unsigned arow_off(const Unit& u, int h, int R) const { const int pos = u.tib() * 256 + h * HALF + R; const unsigned tok = pos < u.nb() ? list[(size_t)u.bk() * T + pos] : 0u; return tok * (unsigned)(lda * 2); }
    __device__ __forceinline__ long bsplit(const Unit& u) const { return ((long)(expert(u, 1) - expert(u, 0)) * DEXP - DEXP) * 2; }
};
struct EpiGateUpSparse {
    static constexpr bool PERM = true;
    bf16_t* act; const float* wlist; const float* rlist; unsigned* tcnt;
    __device__ __forceinline__ void operator()(const f32x4 (&acc)[2][2][4][2], const Unit& u, int wr, int wc, int fr, int fq) const {
        asm volatile("" : "+v"(fr), "+v"(fq));
        const int s = u.pn >> 1, col0 = s * DEXP + (u.pn & 1) * HALF + wc * 32 + 8 * fq;
        const __amdgpu_buffer_rsrc_t rs_act = __builtin_amdgcn_make_buffer_rsrc((void*)act, (short)0, 0x7fffffff, 0x00020000);
#pragma unroll
        for (int ai = 0; ai < 2; ++ai)
#pragma unroll
            for (int m = 0; m < 4; ++m) { const int r = ai * HALF + wr * 64 + m * 16 + fr, pos = u.tib() * 256 + r;
                const float cw = pos < u.nb() ? wlist[((size_t)u.bk() * T + pos) * 2 + s] : 0.f; const float rs = pos < u.nb() ? rlist[(size_t)u.bk() * T + pos] : 0.f;
                float o[8];
#pragma unroll
                for (int n = 0; n < 2; ++n)
#pragma unroll
                    for (int j = 0; j < 4; ++j) { const float g = acc[ai][0][m][n][j] * rs, up = acc[ai][1][m][n][j] * rs;
                        const float sg = g * __builtin_amdgcn_rcpf(1.f + __builtin_amdgcn_exp2f(-g * LOG2E));
                        o[n * 4 + j] = sg * up * cw; }
                u32x4 w; w.x = cvt_pk_bf16(o[0], o[1]); w.y = cvt_pk_bf16(o[2], o[3]); w.z = cvt_pk_bf16(o[4], o[5]); w.w = cvt_pk_bf16(o[6], o[7]);
                __builtin_amdgcn_raw_buffer_store_b128(w, rs_act, (int)((((unsigned)u.pm * 256u + (unsigned)r) * 512u + (unsigned)col0) * 2u), 0, 16);
                if (m & 1) asm volatile("" ::: "memory"); }
        asm volatile("s_waitcnt vmcnt(0)" ::: "memory");
        if ((fr | fq) == 0) __hip_atomic_fetch_add(tcnt + 64 * u.pm, 1u, __ATOMIC_RELAXED, __HIP_MEMORY_SCOPE_AGENT);
    }
};
struct EpiDownScatter {
    static constexpr bool PERM = true;
    bf16_t* xb; const unsigned* list;
    __device__ __forceinline__ void operator()(const f32x4 (&acc)[2][2][4][2], const Unit& u, int wr, int wc, int fr, int fq) const {
        asm volatile("" : "+v"(fr), "+v"(fq));
        const int col0 = u.pn * BM + wc * 32 + 8 * fq;
        unsigned tok[8];
#pragma unroll
        for (int g = 0; g < 8; ++g) { const int pos = u.tib() * 256 + (g >> 2) * HALF + wr * 64 + (g & 3) * 16 + fr; tok[g] = pos < u.nb() ? list[(size_t)u.bk() * T + pos] : 0xffffffffu; }
#pragma unroll
        for (int ai = 0; ai < 2; ++ai) { u32x4 r[4][2];
#pragma unroll
            for (int m = 0; m < 4; ++m) { const unsigned tk = tok[ai * 4 + m]; const bf16_t* rowp = xb + (size_t)(tk != 0xffffffffu ? tk : 0u) * DM + col0;
#pragma unroll
                for (int bj = 0; bj < 2; ++bj) r[m][bj] = *(const u32x4*)(rowp + bj * HALF); }
#pragma unroll
            for (int m = 0; m < 4; ++m) { const unsigned tk = tok[ai * 4 + m];
                if (tk != 0xffffffffu) { bf16_t* rowp = xb + (size_t)tk * DM + col0;
#pragma unroll
                    for (int bj = 0; bj < 2; ++bj) { const f32x4 v0 = acc[ai][bj][m][0], v1 = acc[ai][bj][m][1]; const u32x4 q = r[m][bj];
                        u32x4 w; w.x = cvt_pk_bf16(bflo(q.x) + v0[0], bfhi(q.x) + v0[1]); w.y = cvt_pk_bf16(bflo(q.y) + v0[2], bfhi(q.y) + v0[3]);
                        w.z = cvt_pk_bf16(bflo(q.z) + v1[0], bfhi(q.z) + v1[1]); w.w = cvt_pk_bf16(bflo(q.w) + v1[2], bfhi(q.w) + v1[3]);
                        *(u32x4*)(rowp + bj * HALF) = w; } } } }
    }
};
}

#define XB_TMO      128
#define XB_XCNT(j)  (256  + 64 * (j))
#define XB_XSUB(j)  (1280 + 64 * (j))
#define XB_XGEN(j)  (2304 + 64 * (j))
#define XB_TOP      3328
#define XB_TOPGEN   3392
#define XCD_BAR_WORDS 3456
#define XB_SPIN_CAP (1u << 18)
__device__ __forceinline__ unsigned xb_ld(unsigned* p)              { return __hip_atomic_load(p, __ATOMIC_RELAXED, __HIP_MEMORY_SCOPE_AGENT); }
__device__ __forceinline__ unsigned xb_add(unsigned* p, unsigned v) { return __hip_atomic_fetch_add(p, v, __ATOMIC_RELAXED, __HIP_MEMORY_SCOPE_AGENT); }
__device__ __forceinline__ unsigned xb_xcc_id() { return (unsigned)__builtin_amdgcn_s_getreg((3 << 11) | 20) & 0xFu; }
#define XB_SPIN(cond, bar) do { unsigned _sp = 0; while (cond) { __builtin_amdgcn_s_sleep(1); \
    if ((++_sp & 255u) == 0u) { if (xb_ld(&(bar)[XB_TMO])) break; if (_sp > XB_SPIN_CAP) { atomicAdd(&(bar)[XB_TMO], 1u); break; } } } } while (0)
struct XcdBarrier { unsigned* bar; unsigned x; volatile LAS unsigned* st; int wave; };
__device__ __forceinline__ bool xb_thread0(int wave) { return wave == 0 && __builtin_amdgcn_mbcnt_hi(~0u, __builtin_amdgcn_mbcnt_lo(~0u, 0u)) == 0u; }
__device__ __forceinline__ XcdBarrier xcd_barrier_post(unsigned* bar, volatile LAS unsigned* st, int wave) {
    XcdBarrier b; b.bar = bar; b.x = xb_xcc_id(); b.st = st; b.wave = wave;
    if (xb_thread0(wave)) (void)xb_add(&bar[XB_XCNT(b.x)], 1u);
    return b;
}
__device__ __forceinline__ void xcd_barrier_complete(unsigned* bar, unsigned x, unsigned& nloc, unsigned& nx) {
    const unsigned G = gridDim.x * gridDim.y * gridDim.z;
    unsigned sum, cnt, mine, sp = 0u;
    for (;;) {
        sum = 0u; cnt = 0u; mine = 0u;
#pragma unroll
        for (unsigned j = 0; j < 16; ++j) { const unsigned c = xb_ld(&bar[XB_XCNT(j)]); sum += c; cnt += (c > 0u) ? 1u : 0u; mine = (j == x) ? c : mine; }
        if (sum == G) break;
        __builtin_amdgcn_s_sleep(1);
        if ((++sp & 255u) == 0u) { if (xb_ld(&bar[XB_TMO])) break; if (sp > XB_SPIN_CAP) { atomicAdd(&bar[XB_TMO], 1u); break; } }
    }
    nloc = mine > 0u ? mine : 1u; nx = cnt > 0u ? cnt : 1u;
}
__device__ __forceinline__ void xcd_barrier(const XcdBarrier& b) {
    asm volatile("s_waitcnt vmcnt(0)" ::: "memory");
    __syncthreads();
    if (xb_thread0(b.wave)) {
        unsigned* bar = b.bar;
        __builtin_amdgcn_s_waitcnt(0);
        unsigned nloc = b.st[0], nx = b.st[1];
        if (nloc == 0u) { xcd_barrier_complete(bar, b.x, nloc, nx); b.st[0] = nloc; b.st[1] = nx; }
        const unsigned old = xb_add(&bar[XB_XSUB(b.x)], 1u);
        const unsigned gen = old / nloc;
        if (old + 1u == (gen + 1u) * nloc) {
            __builtin_amdgcn_fence(__ATOMIC_RELEASE, "agent");
            asm volatile("s_waitcnt vmcnt(0)" ::: "memory");
            const unsigned og = xb_add(&bar[XB_TOP], 1u);
            const unsigned tg = og / nx;
            if (og + 1u == (tg + 1u) * nx) xb_add(&bar[XB_TOPGEN], 1u);
            else XB_SPIN(xb_ld(&bar[XB_TOPGEN]) == tg, bar);
            __builtin_amdgcn_fence(__ATOMIC_ACQUIRE, "agent");
            xb_add(&bar[XB_XGEN(b.x)], 1u);
            asm volatile("s_waitcnt vmcnt(0)" ::: "memory");
        } else {
            XB_SPIN(xb_ld(&bar[XB_XGEN(b.x)]) == gen, bar);
            __builtin_amdgcn_fence(__ATOMIC_ACQUIRE, "agent");
            asm volatile("s_waitcnt vmcnt(0)" ::: "memory");
        }
    }
    __syncthreads();
}

struct Args {
    const float* x; const float* ln1_g; const float* w_in; const float* mix_g; const float* w_out; const float* ln2_g;
    const float* w_gr; const float* b_gr; const float* w_er; const float* b_er; const float* w_gate; const float* w_up; const float* w_down; const float* fin_g;
    float* out; unsigned char* ws; int ph_lo, ph_hi, li, pad;
};

template <bool SC = false>
__device__ __forceinline__ void transpose_item(const float* W, int K, int N, bf16_t* WT, int dpitch, int dcol, LAS float* scr, int item, int lane, const float* ks = nullptr) {
    const int nblk = N / 32, kb = item / nblk, nb = item % nblk, k0 = 64 * kb, n0 = 32 * nb;
#pragma unroll 8
    for (int i = 0; i < 32; ++i) { const int kk = 2 * i + (lane >> 5); scr[kk * 33 + (lane & 31)] = W[(size_t)(k0 + kk) * N + n0 + (lane & 31)]; }
    LDS_WAIT(); asm volatile("" ::: "memory");
    const int c = lane & 7;
    f32x4 ga = (f32x4){1.f, 1.f, 1.f, 1.f}, gb = ga;
    if (SC) { ga = *(const f32x4*)(ks + k0 + 8 * c); gb = *(const f32x4*)(ks + k0 + 8 * c + 4); }
#pragma unroll
    for (int j = 0; j < 4; ++j) { const int n = (lane >> 3) + 8 * j; const LAS float* s = scr + (8 * c) * 33 + n;
        u32x4 o; o.x = pk2(s[0 * 33] * ga.x, s[1 * 33] * ga.y); o.y = pk2(s[2 * 33] * ga.z, s[3 * 33] * ga.w); o.z = pk2(s[4 * 33] * gb.x, s[5 * 33] * gb.y); o.w = pk2(s[6 * 33] * gb.z, s[7 * 33] * gb.w);
        *(u32x4*)(WT + (size_t)(n0 + n) * dpitch + dcol + k0 + 8 * c) = o; }
    LDS_WAIT(); asm volatile("" ::: "memory");
}
__device__ __forceinline__ void phase_prologue(const Args& a, LAS unsigned char* lds, int gw, int NGW, int wave, int lane) {
    LAS float* scr = (LAS float*)(lds + wave * 16384);
    constexpr int I_IN = (DM / 64) * (NQKV / 32);
    constexpr int I_OUT = (DM / 64) * (DM / 32);
    constexpr int I_G = (DM / 64) * (DEXP / 32);
    constexpr int I_D = (DEXP / 64) * (DM / 32);
    constexpr int N_IN = DEPTH * I_IN, N_OUT = DEPTH * I_OUT, N_G = DEPTH * NEXP * I_G, N_D = DEPTH * NEXP * I_D;
    constexpr int NITEMS = N_IN + N_OUT + 2 * N_G + N_D;
    bf16_t* WinT = (bf16_t*)(a.ws + WS_WIN); bf16_t* WoutT = (bf16_t*)(a.ws + WS_WOUT); bf16_t* WgT = (bf16_t*)(a.ws + WS_WG); bf16_t* WuT = (bf16_t*)(a.ws + WS_WU); bf16_t* WdT = (bf16_t*)(a.ws + WS_WD);
    for (int it = gw; it < NITEMS; it += NGW) {
        int r = it;
        if (r < N_IN) { const int l = r / I_IN; transpose_item<true>(a.w_in + (size_t)l * DM * NQKV, DM, NQKV, WinT + (size_t)l * NQKV * DM, DM, 0, scr, r % I_IN, lane, a.ln1_g + (size_t)l * DM); continue; } r -= N_IN;
        if (r < N_OUT) { const int l = r / I_OUT; transpose_item(a.w_out + (size_t)l * DM * DM, DM, DM, WoutT + (size_t)l * DM * DM, DM, 0, scr, r % I_OUT, lane); continue; } r -= N_OUT;
        if (r < N_G) { const int le = r / I_G; transpose_item<true>(a.w_gate + (size_t)le * DM * DEXP, DM, DEXP, WgT + (size_t)le * DEXP * DM, DM, 0, scr, r % I_G, lane, a.ln2_g + (size_t)(le / NEXP) * DM); continue; } r -= N_G;
        if (r < N_G) { const int le = r / I_G; transpose_item<true>(a.w_up + (size_t)le * DM * DEXP, DM, DEXP, WuT + (size_t)le * DEXP * DM, DM, 0, scr, r % I_G, lane, a.ln2_g + (size_t)(le / NEXP) * DM); continue; } r -= N_G;
        { const int le = r / I_D, l = le / NEXP, e = le % NEXP; transpose_item(a.w_down + (size_t)le * DEXP * DM, DEXP, DM, WdT + (size_t)l * DM * NACT, NACT, e * DEXP, scr, r % I_D, lane); }
    }
}

__device__ __forceinline__ void phase_norm1(const float* x, int gw, int NGW, int lane, float* kmean_zero, bf16_t* xb, float* rstd_out) {
    for (int i = gw * 64 + lane; i < BATCH * 4 * 32 * HD; i += NGW * 64) kmean_zero[i] = 0.f;
    for (int m = gw; m < T; m += NGW) {
        const f32x4* xr = (const f32x4*)(x + (size_t)m * DM) + lane;
        f32x4 v[4]; float s = 0.f;
#pragma unroll
        for (int j = 0; j < 4; ++j) { v[j] = xr[64 * j]; s += (v[j].x * v[j].x + v[j].y * v[j].y) + (v[j].z * v[j].z + v[j].w * v[j].w); }
        const float rstd = 1.0f / sqrtf(wave_sum(s) * (1.f / DM) + NORM_EPS);
        u32x2* x8 = (u32x2*)(xb + (size_t)m * DM) + lane;
#pragma unroll
        for (int j = 0; j < 4; ++j) { u32x2 c; c.x = pk2(v[j].x, v[j].y); c.y = pk2(v[j].z, v[j].w); x8[64 * j] = c; }
        if (lane == 0) rstd_out[m] = rstd;
    }
}
__device__ __forceinline__ void phase_norm1_b(const bf16_t* xb, int gw, int NGW, int lane, float* kmean_zero, float* rstd_out) {
    for (int i = gw * 64 + lane; i < BATCH * 4 * 32 * HD; i += NGW * 64) kmean_zero[i] = 0.f;
    for (int m = gw; m < T; m += 2 * NGW) {
        const int m2 = m + NGW;
        const u32x4* xr = (const u32x4*)(xb + (size_t)m * DM) + lane; const u32x4* xr2 = (const u32x4*)(xb + (size_t)(m2 < T ? m2 : m) * DM) + lane;
        u32x4 r[2], q[2];
#pragma unroll
        for (int j = 0; j < 2; ++j) { r[j] = xr[64 * j]; q[j] = xr2[64 * j]; }
        float s = 0.f, s2 = 0.f;
#pragma unroll
        for (int j = 0; j < 2; ++j) {
            const float a0 = bflo(r[j].x), a1 = bfhi(r[j].x), a2 = bflo(r[j].y), a3 = bfhi(r[j].y), a4 = bflo(r[j].z), a5 = bfhi(r[j].z), a6 = bflo(r[j].w), a7 = bfhi(r[j].w);
            s += ((a0 * a0 + a1 * a1) + (a2 * a2 + a3 * a3)) + ((a4 * a4 + a5 * a5) + (a6 * a6 + a7 * a7));
            const float b0 = bflo(q[j].x), b1 = bfhi(q[j].x), b2 = bflo(q[j].y), b3 = bfhi(q[j].y), b4 = bflo(q[j].z), b5 = bfhi(q[j].z), b6 = bflo(q[j].w), b7 = bfhi(q[j].w);
            s2 += ((b0 * b0 + b1 * b1) + (b2 * b2 + b3 * b3)) + ((b4 * b4 + b5 * b5) + (b6 * b6 + b7 * b7)); }
        const float rstd = 1.0f / sqrtf(wave_sum(s) * (1.f / DM) + NORM_EPS), rstd2 = 1.0f / sqrtf(wave_sum(s2) * (1.f / DM) + NORM_EPS);
        if (lane == 0) { rstd_out[m] = rstd; if (m2 < T) rstd_out[m2] = rstd2; }
    }
}
__device__ __forceinline__ void unpack8(float (&f)[8], const u32x4 w) { f[0] = bflo(w.x); f[1] = bfhi(w.x); f[2] = bflo(w.y); f[3] = bfhi(w.y); f[4] = bflo(w.z); f[5] = bfhi(w.z); f[6] = bflo(w.w); f[7] = bfhi(w.w); }
struct MixRow { u32x4 a, c0, c1, c2, p0, p1, p2; float l0, l1, l2, e0, e1, e2, e3; };
__device__ __forceinline__ void mix_load(MixRow& r, int m, const bf16_t* ob, const bf16_t* hb, const float* lse, const bf16_t* pm, const float* lsem0, const float* lsem1, int lane, int hh) {
    r.a = *((const u32x4*)(ob + (size_t)m * DM) + lane); r.c0 = *((const u32x4*)(ob + (size_t)m * DM + 512) + lane);
    r.c1 = *((const u32x4*)(hb + (size_t)m * DM) + lane); r.c2 = *((const u32x4*)(hb + (size_t)m * DM + 512) + lane);
    r.l0 = lse[(size_t)m * 8 + hh]; r.l1 = lse[(size_t)T * 8 + (size_t)m * 8 + hh]; r.l2 = lse[(size_t)2 * T * 8 + (size_t)m * 8 + hh];
    if (lane < 32) {
        r.p0 = *((const u32x4*)(pm + (size_t)m * 256) + lane); r.p1 = *((const u32x4*)(pm + ((size_t)T + m) * 256) + lane); r.p2 = *((const u32x4*)(pm + ((size_t)2 * T + m) * 256) + lane);
        r.e0 = lsem0[(size_t)m * 4 + hh]; r.e1 = lsem0[(size_t)T * 4 + (size_t)m * 4 + hh]; r.e2 = lsem1[(size_t)m * 4 + hh]; r.e3 = lsem1[(size_t)T * 4 + (size_t)m * 4 + hh]; }
}
__device__ __forceinline__ void phase_mixnorm(const bf16_t* ob, bf16_t* hb, const float* lse, const bf16_t* pm, const float* lsem0, const float* lsem1, const float* g, int gw, int NGW, int lane) {
    float g0[8], g1[8];
#pragma unroll
    for (int j = 0; j < 8; ++j) { g0[j] = g[8 * lane + j]; g1[j] = g[512 + 8 * lane + j]; }
    const int hh = lane >> 3;
    MixRow cur, nxt;
    if (gw < T) mix_load(cur, gw, ob, hb, lse, pm, lsem0, lsem1, lane, hh);
    for (int m = gw; m < T; m += NGW) {
        if (m + NGW < T) mix_load(nxt, m + NGW, ob, hb, lse, pm, lsem0, lsem1, lane, hh);
        float va[8]; unpack8(va, cur.a);
        if (lane < 32) {
            const float mx = fmaxf(fmaxf(cur.e0, cur.e1), fmaxf(cur.e2, cur.e3));
            float u0 = __builtin_amdgcn_exp2f(cur.e0 - mx), u1 = __builtin_amdgcn_exp2f(cur.e1 - mx), u2 = __builtin_amdgcn_exp2f(cur.e2 - mx), u3 = __builtin_amdgcn_exp2f(cur.e3 - mx);
            const float inv = 1.0f / ((u0 + u1) + (u2 + u3)); u0 *= inv; u1 *= inv; u2 *= inv; u3 *= inv;
            float y0[8], y1[8], y2[8]; unpack8(y0, cur.p0); unpack8(y1, cur.p1); unpack8(y2, cur.p2);
#pragma unroll
            for (int j = 0; j < 8; ++j) va[j] = (u0 * y0[j] + u1 * y1[j]) + (u2 * y2[j] + u3 * va[j]);
        }
        const float mx = fmaxf(cur.l0, fmaxf(cur.l1, cur.l2));
        float w0 = __builtin_amdgcn_exp2f(cur.l0 - mx), w1 = __builtin_amdgcn_exp2f(cur.l1 - mx), w2 = __builtin_amdgcn_exp2f(cur.l2 - mx);
        const float inv = 1.0f / (w0 + w1 + w2); w0 *= inv; w1 *= inv; w2 *= inv;
        float x0[8], x1[8], x2[8]; unpack8(x0, cur.c0); unpack8(x1, cur.c1); unpack8(x2, cur.c2);
        float vc[8];
        float sa = 0.f, sc = 0.f;
#pragma unroll
        for (int j = 0; j < 8; ++j) { vc[j] = w0 * x0[j] + w1 * x1[j] + w2 * x2[j]; sa += va[j] * va[j]; sc += vc[j] * vc[j]; }
        sa = half_sum(sa); sc = wave_sum(sc);
        const float ra = 1.0f / sqrtf(sa * (1.f / 256.f) + NORM_EPS), rc = 1.0f / sqrtf(sc * (1.f / 512.f) + NORM_EPS);
        u32x4 oa, oc;
        oa.x = pk2(va[0] * ra * g0[0], va[1] * ra * g0[1]); oa.y = pk2(va[2] * ra * g0[2], va[3] * ra * g0[3]); oa.z = pk2(va[4] * ra * g0[4], va[5] * ra * g0[5]); oa.w = pk2(va[6] * ra * g0[6], va[7] * ra * g0[7]);
        oc.x = pk2(vc[0] * rc * g1[0], vc[1] * rc * g1[1]); oc.y = pk2(vc[2] * rc * g1[2], vc[3] * rc * g1[3]); oc.z = pk2(vc[4] * rc * g1[4], vc[5] * rc * g1[5]); oc.w = pk2(vc[6] * rc * g1[6], vc[7] * rc * g1[7]);
        *((u32x4*)(hb + (size_t)m * DM) + lane) = oa; *((u32x4*)(hb + (size_t)m * DM + 512) + lane) = oc;
        cur = nxt;
    }
}
__device__ __forceinline__ void phase_route(const bf16_t* x, const float* g, const float* wgr, const float* bgr, const float* wer, const float* ber,
                                            float* rlist, unsigned* cnt, unsigned* list, float* wlist, LAS unsigned char* lds, int v, int G, int wave, int lane) {
    const int tid = wave * 64 + lane;
    constexpr int RP = 2064;
    LAS unsigned char* WH = lds; LAS unsigned char* WL = lds + 20 * RP;
    LAS unsigned* cl = (LAS unsigned*)(lds + 86016);
    LAS u32x2* info = (LAS u32x2*)(lds + 86016 + 256);
    LAS f32x2* infw = (LAS f32x2*)(lds + 86016 + 256 + 4096);
    LAS float* infr = (LAS float*)(lds + 86016 + 256 + 8192);
    for (int idx = tid; idx < 5 * DM; idx += NTHREADS) { const int mtx = idx >> 10, d = idx & 1023; const f32x4 wv = *(const f32x4*)((mtx == 0 ? wgr : wer + (size_t)(mtx - 1) * DM * 4) + d * 4) * g[d];
#pragma unroll
        for (int e = 0; e < 4; ++e) { const float w = wv[e]; const unsigned short hi = (unsigned short)f2bf(w); const float rem = w - __builtin_bit_cast(float, (unsigned)hi << 16);
            *(LAS unsigned short*)(WH + (mtx * 4 + e) * RP + d * 2) = hi; *(LAS unsigned short*)(WL + (mtx * 4 + e) * RP + d * 2) = (unsigned short)f2bf(rem); } }
    if (tid < 64) cl[tid] = 0u;
    __syncthreads();
    const int rpw = (T + G - 1) / G, row0 = v * rpw;
    const int m16 = lane & 15, q = lane >> 4;
    const f32x4 bg = *(const f32x4*)bgr;
    for (int t0 = wave * 16; t0 < rpw; t0 += NWAVES * 16) {
        const int r = t0 + m16; const bool valid = r < rpw && row0 + r < T;
        const u32x4* xp = (const u32x4*)(x + (size_t)(valid ? row0 + r : row0) * DM) + q;
        f32x4 a0 = (f32x4){0.f, 0.f, 0.f, 0.f}, a1 = a0; float ss = 0.f;
        LAS unsigned char* wh0 = WH + m16 * RP + q * 16; LAS unsigned char* wh1 = WH + (16 + (lane & 3)) * RP + q * 16;
#pragma unroll 1
        for (int sb = 0; sb < 32; sb += 8) { u32x4 xv[8];
#pragma unroll
            for (int s = 0; s < 8; ++s) xv[s] = xp[4 * (sb + s)];
#pragma unroll
            for (int s = 0; s < 8; ++s) { const int ko = (sb + s) * 64; const bf16x8 xf = __builtin_bit_cast(bf16x8, xv[s]);
                a0 = __builtin_amdgcn_mfma_f32_16x16x32_bf16(*(LAS bf16x8*)(wh0 + ko), xf, a0, 0, 0, 0);
                a0 = __builtin_amdgcn_mfma_f32_16x16x32_bf16(*(LAS bf16x8*)(wh0 + 20 * RP + ko), xf, a0, 0, 0, 0);
                a1 = __builtin_amdgcn_mfma_f32_16x16x32_bf16(*(LAS bf16x8*)(wh1 + ko), xf, a1, 0, 0, 0);
                a1 = __builtin_amdgcn_mfma_f32_16x16x32_bf16(*(LAS bf16x8*)(wh1 + 20 * RP + ko), xf, a1, 0, 0, 0);
                const float x0 = bflo(xv[s].x), x1 = bfhi(xv[s].x), x2 = bflo(xv[s].y), x3 = bfhi(xv[s].y), x4 = bflo(xv[s].z), x5 = bfhi(xv[s].z), x6 = bflo(xv[s].w), x7 = bfhi(xv[s].w);
                ss += ((x0 * x0 + x1 * x1) + (x2 * x2 + x3 * x3)) + ((x4 * x4 + x5 * x5) + (x6 * x6 + x7 * x7)); } }
        ss += swz_xor<16>(ss); ss = sum_xor32(ss);
        const float rstd = 1.0f / sqrtf(ss * (1.f / DM) + NORM_EPS);
        const int gc = (q == 0) ? 3 : q - 1;
        const f32x4 be = *(const f32x4*)(ber + gc * 4);
        const f32x4 ev = (q == 0) ? a1 : a0;
        const float e[4] = {ev.x * rstd + be.x, ev.y * rstd + be.y, ev.z * rstd + be.z, ev.w * rstd + be.w};
        int i1 = 0; float v1 = e[0];
#pragma unroll
        for (int k = 1; k < 4; ++k) if (e[k] > v1) { v1 = e[k]; i1 = k; }
        int i2 = -1; float v2 = -INFINITY;
#pragma unroll
        for (int k = 0; k < 4; ++k) if (k != i1 && e[k] > v2) { v2 = e[k]; i2 = k; }
        const float p2 = __expf(v2 - v1), inv = 1.0f / (1.0f + p2);
        const float w1 = inv, w2 = p2 * inv;
        const int ea = i1 < i2 ? i1 : i2, eb = i1 < i2 ? i2 : i1; const float wa0 = i1 < i2 ? w1 : w2, wb0 = i1 < i2 ? w2 : w1;
        const int pi0 = (ea == 0) ? (eb - 1) : (ea == 1 ? eb + 1 : 5);
        const f32x4 gl = (f32x4){a0.x * rstd + bg.x, a0.y * rstd + bg.y, a0.z * rstd + bg.z, a0.w * rstd + bg.w};
        int gi = 0; float gm = gl.x;
        if (gl.y > gm) { gm = gl.y; gi = 1; } if (gl.z > gm) { gm = gl.z; gi = 2; } if (gl.w > gm) { gm = gl.w; gi = 3; }
        const float gden = __expf(gl.x - gm) + __expf(gl.y - gm) + __expf(gl.z - gm) + __expf(gl.w - gm);
        const float gw_ = 1.0f / gden;
        const int src = (m16 + 16 * ((gi == 3) ? 0 : gi + 1)) * 4;
        const int pi = __builtin_amdgcn_ds_bpermute(src, pi0);
        const float wa = __builtin_bit_cast(float, __builtin_amdgcn_ds_bpermute(src, __builtin_bit_cast(int, wa0))) * gw_, wb = __builtin_bit_cast(float, __builtin_amdgcn_ds_bpermute(src, __builtin_bit_cast(int, wb0))) * gw_;
        if (q == 0 && valid) { int bk = gi * 6 + pi; bk = bk < 0 ? 0 : (bk > 23 ? 23 : bk);
            const unsigned rank = __hip_atomic_fetch_add(cl + bk, 1u, __ATOMIC_RELAXED, __HIP_MEMORY_SCOPE_WORKGROUP);
            info[r] = (u32x2){(unsigned)bk, rank}; infw[r] = (f32x2){wa, wb}; infr[r] = rstd; }
    }
    __syncthreads();
    if (tid < 24) cl[32 + tid] = __hip_atomic_fetch_add(cnt + tid, cl[tid], __ATOMIC_RELAXED, __HIP_MEMORY_SCOPE_AGENT);
    __syncthreads();
    if (tid < rpw && row0 + tid < T) { const u32x2 inf = info[tid]; const f32x2 wv = infw[tid]; const size_t slot = (size_t)inf.x * T + cl[32 + inf.x] + inf.y;
        list[slot] = (unsigned)(row0 + tid); *(f32x2*)(wlist + slot * 2) = wv; rlist[slot] = infr[tid]; }
    __syncthreads();
}
__device__ __forceinline__ void phase_final(const bf16_t* xb, const float* g, float* out, int gw, int NGW, int lane) {
    f32x4 gv[4];
#pragma unroll
    for (int j = 0; j < 2; ++j) { gv[2 * j] = *((const f32x4*)g + 2 * lane + 128 * j); gv[2 * j + 1] = *((const f32x4*)g + 2 * lane + 128 * j + 1); }
    for (int m = gw; m < T; m += NGW) {
        const u32x4* xr = (const u32x4*)(xb + (size_t)m * DM) + lane;
        u32x4 r[2]; float s = 0.f;
#pragma unroll
        for (int j = 0; j < 2; ++j) r[j] = xr[64 * j];
        f32x4 v[4];
#pragma unroll
        for (int j = 0; j < 2; ++j) { v[2 * j] = (f32x4){bflo(r[j].x), bfhi(r[j].x), bflo(r[j].y), bfhi(r[j].y)}; v[2 * j + 1] = (f32x4){bflo(r[j].z), bfhi(r[j].z), bflo(r[j].w), bfhi(r[j].w)}; }
#pragma unroll
        for (int j = 0; j < 4; ++j) s += (v[j].x * v[j].x + v[j].y * v[j].y) + (v[j].z * v[j].z + v[j].w * v[j].w);
        const float rstd = 1.0f / sqrtf(wave_sum(s) * (1.f / DM) + NORM_EPS);
        f32x4* orow = (f32x4*)(out + (size_t)m * DM) + 2 * lane;
#pragma unroll
        for (int j = 0; j < 2; ++j) { orow[128 * j] = v[2 * j] * rstd * gv[2 * j]; orow[128 * j + 1] = v[2 * j + 1] * rstd * gv[2 * j + 1]; }
    }
}
__device__ __forceinline__ void phase_kmean(const bf16_t* kb, float* kmean, int gw, int NGW, int lane) {
    for (int it = gw; it < BATCH * 4 * 32; it += NGW) {
        const int b = it >> 7, h = (it >> 5) & 3, blk = it & 31;
        const bf16_t* base = kb + ((size_t)b * SEQ + (size_t)blk * 256) * DM + h * HD + (lane & 7) * 8;
        float acc[8] = {0.f, 0.f, 0.f, 0.f, 0.f, 0.f, 0.f, 0.f};
#pragma unroll 4
        for (int i = 0; i < 32; ++i) { const u32x4 w = *(const u32x4*)(base + (size_t)((lane >> 3) + 8 * i) * DM);
            acc[0] += bflo(w.x); acc[1] += bfhi(w.x); acc[2] += bflo(w.y); acc[3] += bfhi(w.y); acc[4] += bflo(w.z); acc[5] += bfhi(w.z); acc[6] += bflo(w.w); acc[7] += bfhi(w.w); }
#pragma unroll
        for (int j = 0; j < 8; ++j) { acc[j] += swz_xor<8>(acc[j]); acc[j] += swz_xor<16>(acc[j]); acc[j] = sum_xor32(acc[j]); }
        if (lane < 8) {
            float* o = kmean + (size_t)it * HD + lane * 8;
#pragma unroll
            for (int j = 0; j < 8; ++j) o[j] = acc[j] * (1.f / 256.f);
        }
    }
}

__device__ __forceinline__ void ld_row64(float (&r)[64], const bf16_t* p) {
#pragma unroll
    for (int c = 0; c < 8; ++c) { const u32x4 w = *((const u32x4*)p + c);
        r[8 * c + 0] = bflo(w.x); r[8 * c + 1] = bfhi(w.x); r[8 * c + 2] = bflo(w.y); r[8 * c + 3] = bfhi(w.y); r[8 * c + 4] = bflo(w.z); r[8 * c + 5] = bfhi(w.z); r[8 * c + 6] = bflo(w.w); r[8 * c + 7] = bfhi(w.w); }
}
__device__ __forceinline__ float dot_row64(const float (&q)[64], const bf16_t* p) {
    float s0 = 0.f, s1 = 0.f;
#pragma unroll
    for (int c = 0; c < 8; ++c) { const u32x4 w = *((const u32x4*)p + c);
        s0 += q[8 * c + 0] * bflo(w.x); s1 += q[8 * c + 1] * bfhi(w.x); s0 += q[8 * c + 2] * bflo(w.y); s1 += q[8 * c + 3] * bfhi(w.y);
        s0 += q[8 * c + 4] * bflo(w.z); s1 += q[8 * c + 5] * bfhi(w.z); s0 += q[8 * c + 6] * bflo(w.w); s1 += q[8 * c + 7] * bfhi(w.w); }
    return s0 + s1;
}
__device__ __forceinline__ void axpy_row64(float (&o)[64], float p, const bf16_t* vp) {
#pragma unroll
    for (int c = 0; c < 8; ++c) { const u32x4 w = *((const u32x4*)vp + c);
        o[8 * c + 0] += p * bflo(w.x); o[8 * c + 1] += p * bfhi(w.x); o[8 * c + 2] += p * bflo(w.y); o[8 * c + 3] += p * bfhi(w.y);
        o[8 * c + 4] += p * bflo(w.z); o[8 * c + 5] += p * bfhi(w.z); o[8 * c + 6] += p * bflo(w.w); o[8 * c + 7] += p * bfhi(w.w); }
}
__device__ __forceinline__ void st_row64(bf16_t* p, const float (&o)[64], float sc) {
#pragma unroll
    for (int c = 0; c < 8; ++c) { u32x4 w; w.x = pk2(o[8 * c] * sc, o[8 * c + 1] * sc); w.y = pk2(o[8 * c + 2] * sc, o[8 * c + 3] * sc); w.z = pk2(o[8 * c + 4] * sc, o[8 * c + 5] * sc); w.w = pk2(o[8 * c + 6] * sc, o[8 * c + 7] * sc); *((u32x4*)p + c) = w; }
}
#define OSM_STEP(sc, vrow) do { const float sc_ = (sc); if (sc_ > m_) { const float al = __builtin_amdgcn_exp2f(m_ - sc_); l_ *= al; _Pragma("unroll") for (int d_ = 0; d_ < 64; ++d_) o_[d_] *= al; m_ = sc_; } \
    const float p_ = __builtin_amdgcn_exp2f(sc_ - m_); l_ += p_; axpy_row64(o_, p_, (vrow)); } while (0)

__device__ __forceinline__ void naive_moba(const bf16_t* qb, const bf16_t* kb, const bf16_t* vb, const float* kmean, bf16_t* ob, int item, int tid) {
    const int b = item >> 6, h = (item >> 4) & 3, t = (item & 15) * 512 + tid, own = t >> 8;
    const size_t rowq = ((size_t)b * SEQ + t) * DM + h * HD;
    const bf16_t* kh = kb + (size_t)b * SEQ * DM + h * HD; const bf16_t* vh = vb + (size_t)b * SEQ * DM + h * HD;
    const float slope2 = exp2f(-2.0f * (float)(h + 1)) * LOG2E;
    float q_[64]; ld_row64(q_, qb + rowq);
    float bv0 = -INFINITY, bv1 = -INFINITY, bv2 = -INFINITY; int bi0 = -1, bi1 = -1, bi2 = -1;
    const float* km = kmean + (size_t)(b * 4 + h) * 32 * HD;
    for (int n = 0; n < own; ++n) {
        float gsum = 0.f;
#pragma unroll
        for (int d = 0; d < 64; ++d) gsum += q_[d] * km[n * HD + d];
        if (gsum > bv0) { bv2 = bv1; bi2 = bi1; bv1 = bv0; bi1 = bi0; bv0 = gsum; bi0 = n; }
        else if (gsum > bv1) { bv2 = bv1; bi2 = bi1; bv1 = gsum; bi1 = n; }
        else if (gsum > bv2) { bv2 = gsum; bi2 = n; }
    }
    float o_[64];
#pragma unroll
    for (int d = 0; d < 64; ++d) o_[d] = 0.f;
    float m_ = -INFINITY, l_ = 0.f;
    for (int s = 0; s < 3; ++s) {
        const int blk = (s == 0) ? bi0 : (s == 1) ? bi1 : bi2;
        if (blk < 0) continue;
        for (int j = 0; j < 256; ++j) { const int pos = blk * 256 + j;
            const float sc = dot_row64(q_, kh + (size_t)pos * DM) - slope2 * (float)(t - pos);
            OSM_STEP(sc, vh + (size_t)pos * DM); }
    }
    for (int pos = own * 256; pos <= t; ++pos) {
        const float sc = dot_row64(q_, kh + (size_t)pos * DM) - slope2 * (float)(t - pos);
        OSM_STEP(sc, vh + (size_t)pos * DM); }
    st_row64(ob + rowq, o_, 1.0f / l_);
}
__device__ __forceinline__ void naive_sb(const bf16_t* qb, const bf16_t* kb, const bf16_t* vb, bf16_t* ob, int item, int tid) {
    const int b = item >> 6, h = 4 + ((item >> 4) & 3), t = (item & 15) * 512 + tid;
    const size_t rowq = ((size_t)b * SEQ + t) * DM + h * HD;
    const bf16_t* kh = kb + (size_t)b * SEQ * DM + h * HD; const bf16_t* vh = vb + (size_t)b * SEQ * DM + h * HD;
    float q_[64]; ld_row64(q_, qb + rowq);
    float o_[64];
#pragma unroll
    for (int d = 0; d < 64; ++d) o_[d] = 0.f;
    float tail = 0.f;
    for (int s = t - 1; s >= 0 && tail > -150.f; --s) {
        const float z = dot_row64(q_, kh + (size_t)s * DM);
        const float lp = __builtin_amdgcn_logf(1.0f + __builtin_amdgcn_exp2f(-fabsf(z)));
        const float lnot = -(fmaxf(z, 0.f) + lp);
        const float aw = __builtin_amdgcn_exp2f(z + lnot + tail);
        axpy_row64(o_, aw, vh + (size_t)s * DM);
        tail += lnot;
    }
    st_row64(ob + rowq, o_, 1.0f);
}
__device__ __forceinline__ void naive_dil(const bf16_t* qb, const bf16_t* kb, const bf16_t* vb, bf16_t* ob, bf16_t* hb2, float* lse, int item, int tid) {
    const int b = item >> 7, h = 8 + ((item >> 4) & 7), t = (item & 15) * 512 + tid;
    const size_t rowq = ((size_t)b * SEQ + t) * DM + h * HD;
    const bf16_t* kh = kb + (size_t)b * SEQ * DM + h * HD; const bf16_t* vh = vb + (size_t)b * SEQ * DM + h * HD;
    const float slope2 = exp2f(-(float)(h - 8 + 1)) * LOG2E;
    float q_[64]; ld_row64(q_, qb + rowq);
    float o_[64];
#pragma unroll
    for (int d = 0; d < 64; ++d) o_[d] = 0.f;
    float m_ = -INFINITY, l_ = 0.f;
    for (int c = 0; c < 3; ++c) {
        const int dil = (c == 0) ? 1 : (c == 1) ? 4 : 16;
        for (int dl = 0; dl <= 128; ++dl) { const int pos = t - dl * dil; if (pos < 0) break;
            const float sc = dot_row64(q_, kh + (size_t)pos * DM) - slope2 * (float)(dl * dil);
            OSM_STEP(sc, vh + (size_t)pos * DM); }
    }
    st_row64(ob + rowq, o_, 1.0f / l_);
    { const size_t tok = (size_t)b * SEQ + t; const u32x4 z4 = {0u, 0u, 0u, 0u};
#pragma unroll
      for (int c = 0; c < 8; ++c) { *((u32x4*)(hb2 + tok * DM + (h - 8) * HD) + c) = z4; *((u32x4*)(hb2 + tok * DM + 512 + (h - 8) * HD) + c) = z4; }
      lse[tok * 8 + (h - 8)] = 0.f; lse[(size_t)T * 8 + tok * 8 + (h - 8)] = -1.0e30f; lse[(size_t)2 * T * 8 + tok * 8 + (h - 8)] = -1.0e30f; }
}

namespace att {
typedef float f32x16 __attribute__((ext_vector_type(16)));
typedef short s16x4 __attribute__((ext_vector_type(4)));
typedef short v4i16_t __attribute__((ext_vector_type(4)));
typedef __bf16 bf16x2_t __attribute__((ext_vector_type(2)));
constexpr int L_BUF = 16384;
constexpr int L_WSF = 2 * L_BUF;
constexpr int L_OST = L_WSF + 8 * 256;
constexpr int L_FLG = L_OST + 8 * 4096;
constexpr int L_END = L_FLG + 64;
constexpr float M_INIT = -1.0e30f;
#define ATT_MFMA(a, b, c) __builtin_amdgcn_mfma_f32_32x32x16_bf16((a), (b), (c), 0, 0, 0)

__device__ __forceinline__ unsigned cvtpk(float lo, float hi) { f32x2 v = {lo, hi}; bf16x2_t b = __builtin_convertvector(v, bf16x2_t); return __builtin_bit_cast(unsigned, b); }
__device__ __forceinline__ s16x4 vtr(LAS unsigned char* p) { return __builtin_bit_cast(s16x4, __builtin_amdgcn_ds_read_tr16_b64_v4i16((LAS v4i16_t*)p)); }

struct Wave { int lane, r32, hi, wid; LAS unsigned char* lds; LAS float* wsf; LAS unsigned char* ost; int vlo; };
__device__ __forceinline__ Wave make_wave(LAS unsigned char* lds, int tid, int wsf_off = L_WSF, int ost_off = L_OST) {
    Wave w; w.lane = tid & 63; w.r32 = w.lane & 31; w.hi = w.lane >> 5; w.wid = __builtin_amdgcn_readfirstlane(tid >> 6); w.lds = lds;
    w.wsf = (LAS float*)(lds + wsf_off) + w.wid * 64; w.ost = lds + ost_off + w.wid * 4096;
    w.vlo = ((w.lane >> 4) & 1) * 32 + (w.lane & 3) * 8 + (4 * w.hi + ((w.lane & 15) >> 2)) * 64;
    return w;
}
struct Stage { u32x4 k, v; };
template <class RowK, class RowV> __device__ __forceinline__ void stage_load(Stage& s, const Wave& w, const RowK& rowk, const RowV& rowv) {
    s.k = *(const u32x4*)(rowk(w.lane) + w.wid * 8);
    s.v = *(const u32x4*)(rowv(16 * (w.wid & 3) + (w.lane >> 2)) + (w.wid >> 2) * 32 + (w.lane & 3) * 8);
}
__device__ __forceinline__ void stage_write(const Stage& s, const Wave& w, int buf) {
    *(LAS u32x4*)(w.lds + buf * L_BUF + w.wid * 1024 + w.lane * 16) = s.k;
    *(LAS u32x4*)(w.lds + buf * L_BUF + 8192 + w.wid * 1024 + w.lane * 16) = s.v;
}
__device__ __forceinline__ f32x16 qk_sub(const Wave& w, int buf, int sub, const bf16x8 (&qf)[4], float init) {
    f32x16 acc;
#pragma unroll
    for (int r = 0; r < 16; ++r) acc[r] = init;
    LAS unsigned char* kp = w.lds + buf * L_BUF + w.hi * 1024 + (32 * sub + w.r32) * 16;
#pragma unroll
    for (int ks = 0; ks < 4; ++ks) { const bf16x8 kf = *(LAS bf16x8*)(kp + ks * 2048); acc = ATT_MFMA(kf, qf[ks], acc); }
    return acc;
}
__device__ __forceinline__ void pv_sub(const Wave& w, int buf, int sub, const f32x16& p, f32x16 (&o)[2]) {
    bf16x8 pk[2];
#pragma unroll
    for (int s = 0; s < 2; ++s) { u32x4 t; t.x = cvtpk(p[8 * s], p[8 * s + 1]); t.y = cvtpk(p[8 * s + 2], p[8 * s + 3]); t.z = cvtpk(p[8 * s + 4], p[8 * s + 5]); t.w = cvtpk(p[8 * s + 6], p[8 * s + 7]); pk[s] = __builtin_bit_cast(bf16x8, t); }
    LAS unsigned char* vb = w.lds + buf * L_BUF + 8192 + w.vlo;
#pragma unroll
    for (int db = 0; db < 2; ++db)
#pragma unroll
        for (int s = 0; s < 2; ++s) { LAS unsigned char* vp = vb + db * 4096 + (4 * sub + 2 * s) * 512;
            const s16x4 lo = vtr(vp), hh = vtr(vp + 512);
            const bf16x8 vf = __builtin_shufflevector(lo, hh, 0, 1, 2, 3, 4, 5, 6, 7);
            o[db] = ATT_MFMA(pk[s], vf, o[db]); }
}
struct VFrags { s16x4 f[2][2][2]; };
__device__ __forceinline__ void load_vfrags(const Wave& w, int buf, int sub, VFrags& v) {
    LAS unsigned char* vb = w.lds + buf * L_BUF + 8192 + w.vlo;
#pragma unroll
    for (int db = 0; db < 2; ++db)
#pragma unroll
        for (int s = 0; s < 2; ++s) { LAS unsigned char* vp = vb + db * 4096 + (4 * sub + 2 * s) * 512; v.f[db][s][0] = vtr(vp); v.f[db][s][1] = vtr(vp + 512); }
}
__device__ __forceinline__ void pv_frags(const VFrags& v, const f32x16& p, f32x16 (&o)[2]) {
    bf16x8 pk[2];
#pragma unroll
    for (int s = 0; s < 2; ++s) { u32x4 t; t.x = cvtpk(p[8 * s], p[8 * s + 1]); t.y = cvtpk(p[8 * s + 2], p[8 * s + 3]); t.z = cvtpk(p[8 * s + 4], p[8 * s + 5]); t.w = cvtpk(p[8 * s + 6], p[8 * s + 7]); pk[s] = __builtin_bit_cast(bf16x8, t); }
#pragma unroll
    for (int db = 0; db < 2; ++db)
#pragma unroll
        for (int s = 0; s < 2; ++s) { const bf16x8 vf = __builtin_shufflevector(v.f[db][s][0], v.f[db][s][1], 0, 1, 2, 3, 4, 5, 6, 7); o[db] = ATT_MFMA(pk[s], vf, o[db]); }
}
__device__ __forceinline__ void scale_rows(const Wave& w, f32x16 (&o)[2], float f) {
    if (w.hi == 0) w.wsf[w.r32] = f;
#pragma unroll
    for (int g = 0; g < 4; ++g) { const f32x4 fv = *(LAS f32x4*)(w.wsf + 8 * g + 4 * w.hi);
#pragma unroll
        for (int i = 0; i < 4; ++i) { o[0][4 * g + i] *= fv[i]; o[1][4 * g + i] *= fv[i]; } }
}
__device__ __forceinline__ void softmax_sub(const Wave& w, f32x16& s, float& m, float& lsum, f32x16 (&o)[2]) {
    float tm = fmaxf(fmaxf(s[0], s[1]), fmaxf(s[2], s[3]));
#pragma unroll
    for (int r = 4; r < 16; r += 4) tm = fmaxf(tm, fmaxf(fmaxf(s[r], s[r + 1]), fmaxf(s[r + 2], s[r + 3])));
    tm = max_xor32(tm);
    const float mn = fmaxf(m, tm);
    if (__any(mn > m)) { const float al = __builtin_amdgcn_exp2f(m - mn); lsum *= al; scale_rows(w, o, al); m = mn; }
    float acc = 0.f;
#pragma unroll
    for (int r = 0; r < 16; ++r) { s[r] = __builtin_amdgcn_exp2f(s[r] - m); acc += s[r]; }
    lsum += acc;
}
__device__ __forceinline__ void mask_band(f32x16& s, int delta0, int W) {
#pragma unroll
    for (int r = 0; r < 16; ++r) { const int dl = delta0 - ((r & 3) + 8 * (r >> 2)); if ((unsigned)dl > (unsigned)W) s[r] = -INFINITY; }
}
constexpr float SM_THR = 8.0f;
struct SubDesc { bool act; int delta; int W; };
template <int NSUB>
__device__ __forceinline__ void softmax_step(const Wave& w, int buf, const bf16x8 (&qf)[4], const bf16x8& kidx, const bf16x8& slp, float slope, const SubDesc (&sd)[NSUB],
                                             float& m, float& lsum, f32x16 (&o)[2], bool& first) {
    f32x16 s[NSUB];
    bool any_act = false;
#pragma unroll
    for (int i = 0; i < NSUB; ++i) if (sd[i].act) { any_act = true; s[i] = qk_sub(w, buf, i, qf, -slope * (float)sd[i].delta - m); s[i] = ATT_MFMA(kidx, slp, s[i]); }
    if (!any_act) return;
    float tm = -INFINITY;
#pragma unroll
    for (int i = 0; i < NSUB; ++i) if (sd[i].act) {
        if (sd[i].W >= 0) mask_band(s[i], sd[i].delta - 4 * w.hi, sd[i].W);
        float t = fmaxf(fmaxf(s[i][0], s[i][1]), fmaxf(s[i][2], s[i][3]));
#pragma unroll
        for (int r = 4; r < 16; r += 4) t = fmaxf(t, fmaxf(fmaxf(s[i][r], s[i][r + 1]), fmaxf(s[i][r + 2], s[i][r + 3])));
        tm = fmaxf(tm, t); }
    tm = max_xor32(tm);
    if (first || __any(tm > SM_THR)) {
        const float d = first ? (tm > -1.0e30f ? tm : 0.f) : fmaxf(tm, 0.f);
#pragma unroll
        for (int i = 0; i < NSUB; ++i) if (sd[i].act) {
#pragma unroll
            for (int r = 0; r < 16; ++r) s[i][r] -= d; }
        if (!first) { const float al = __builtin_amdgcn_exp2f(-d); lsum *= al; scale_rows(w, o, al); }
        m += d; first = false;
    }
    VFrags vf[NSUB];
#pragma unroll
    for (int i = 0; i < NSUB; ++i) if (sd[i].act) load_vfrags(w, buf, i, vf[i]);
#pragma unroll
    for (int i = 0; i < NSUB; ++i) if (sd[i].act) { float acc = 0.f;
#pragma unroll
        for (int r = 0; r < 16; ++r) { s[i][r] = __builtin_amdgcn_exp2f(s[i][r]); acc += s[i][r]; }
        lsum += acc; }
#pragma unroll
    for (int i = 0; i < NSUB; ++i) if (sd[i].act) pv_frags(vf[i], s[i], o);
}
__device__ __forceinline__ void bias_frags(const Wave& w, float slope, bf16x8& kidx, bf16x8& slp) {
    const unsigned kb = f2bf((float)w.r32), sh = f2bf(slope), sl = f2bf(slope - __builtin_bit_cast(float, sh << 16));
    const u32x4 a = {w.hi == 0 ? (kb | (kb << 16)) : 0u, 0u, 0u, 0u}, b = {w.hi == 0 ? (sh | (sl << 16)) : 0u, 0u, 0u, 0u};
    kidx = __builtin_bit_cast(bf16x8, a); slp = __builtin_bit_cast(bf16x8, b);
}
template <class RowO> __device__ __forceinline__ void store_o(const Wave& w, const f32x16 (&o)[2], const RowO& rowo) {
    LAS unsigned short* stg = (LAS unsigned short*)w.ost;
#pragma unroll
    for (int r = 0; r < 16; ++r) { const int q = (r & 3) + 8 * (r >> 2) + 4 * w.hi;
#pragma unroll
        for (int db = 0; db < 2; ++db) stg[q * 64 + db * 32 + w.r32] = (unsigned short)f2bf(o[db][r]); }
#pragma unroll
    for (int i = 0; i < 4; ++i) { const int row = i * 8 + (w.lane >> 3), ch = w.lane & 7; const u32x4 v = *(LAS u32x4*)((LAS unsigned char*)stg + row * 128 + ch * 16);
        bf16_t* dst = rowo(row); if (dst) *(u32x4*)(dst + ch * 8) = v; }
}
__device__ __forceinline__ void load_q(bf16x8 (&qf)[4], const bf16_t* qrow, int hi) {
#pragma unroll
    for (int ks = 0; ks < 4; ++ks) qf[ks] = *(const bf16x8*)(qrow + 16 * ks + 8 * hi);
}

constexpr int W_WSF = 98304, W_OST = W_WSF + 2048, W_ENUM = W_OST + 32768;
template <int NC> struct Pref { u32x4 k[NC], v[NC]; bf16x8 q[4]; };
template <int NC, class RowF> __device__ __forceinline__ void win_issue(Pref<NC>& P, const Wave& w, const bf16_t* kbase, const bf16_t* vbase, const RowF& rowoff, const bf16_t* qrow) {
#pragma unroll
    for (int c = 0; c < NC; ++c) { P.k[c] = *(const u32x4*)(kbase + rowoff(64 * c + 8 * w.wid + (w.lane >> 3)) + (w.lane & 7) * 8);
        P.v[c] = *(const u32x4*)(vbase + rowoff(64 * c + 16 * (w.wid & 3) + (w.lane >> 2)) + (w.wid >> 2) * 32 + (w.lane & 3) * 8); }
    load_q(P.q, qrow, w.hi);
}
template <int NC> __device__ __forceinline__ void win_commit(const Pref<NC>& P, const Wave& w) {
    constexpr int NK = 64 * NC;
#pragma unroll
    for (int c = 0; c < NC; ++c) { const int key = 64 * c + 8 * w.wid + (w.lane >> 3);
        *(LAS u32x4*)(w.lds + key * 128 + ((((w.lane & 7) ^ (key >> 1)) & 7) * 16)) = P.k[c];
        *(LAS u32x4*)(w.lds + NK * 128 + (w.wid >> 2) * (NK * 64) + (8 * c + 2 * (w.wid & 3)) * 512 + w.lane * 16) = P.v[c]; }
}
template <int NK> __device__ __forceinline__ f32x16 qk_win(const Wave& w, int u, const bf16x8 (&qf)[4], float init) {
    f32x16 acc;
#pragma unroll
    for (int r = 0; r < 16; ++r) acc[r] = init;
    LAS unsigned char* kp = w.lds + (32 * u + w.r32) * 128; const int x = (w.r32 >> 1) & 7;
#pragma unroll
    for (int ks = 0; ks < 4; ++ks) { const bf16x8 kf = *(LAS bf16x8*)(kp + (((2 * ks + w.hi) ^ x) * 16)); acc = ATT_MFMA(kf, qf[ks], acc); }
    return acc;
}
template <int NK> __device__ __forceinline__ void load_vfrags_win(const Wave& w, int u, VFrags& v) {
    LAS unsigned char* vb = w.lds + NK * 128 + w.vlo;
#pragma unroll
    for (int db = 0; db < 2; ++db)
#pragma unroll
        for (int s = 0; s < 2; ++s) { LAS unsigned char* vp = vb + db * (NK * 64) + (4 * u + 2 * s) * 512; v.f[db][s][0] = vtr(vp); v.f[db][s][1] = vtr(vp + 512); }
}
struct WSub { bool act; int u; int delta; int W; };
template <int NK>
__device__ __forceinline__ void softmax_win(const Wave& w, const bf16x8 (&qf)[4], const bf16x8& kidx, const bf16x8& slp, float slope, const WSub (&sd)[2], float& m, float& lsum, f32x16 (&o)[2], bool& first) {
    f32x16 s[2];
    bool any_act = false;
#pragma unroll
    for (int i = 0; i < 2; ++i) if (sd[i].act) { any_act = true; s[i] = qk_win<NK>(w, sd[i].u, qf, -slope * (float)sd[i].delta - m); s[i] = ATT_MFMA(kidx, slp, s[i]); }
    if (!any_act) return;
    float tm = -INFINITY;
#pragma unroll
    for (int i = 0; i < 2; ++i) if (sd[i].act) {
        if (sd[i].W >= 0) mask_band(s[i], sd[i].delta - 4 * w.hi, sd[i].W);
        float t = fmaxf(fmaxf(s[i][0], s[i][1]), fmaxf(s[i][2], s[i][3]));
#pragma unroll
        for (int r = 4; r < 16; r += 4) t = fmaxf(t, fmaxf(fmaxf(s[i][r], s[i][r + 1]), fmaxf(s[i][r + 2], s[i][r + 3])));
        tm = fmaxf(tm, t); }
    tm = max_xor32(tm);
    if (first || __any(tm > SM_THR)) {
        const float d = first ? (tm > -1.0e30f ? tm : 0.f) : fmaxf(tm, 0.f);
#pragma unroll
        for (int i = 0; i < 2; ++i) if (sd[i].act) {
#pragma unroll
            for (int r = 0; r < 16; ++r) s[i][r] -= d; }
        if (!first) { const float al = __builtin_amdgcn_exp2f(-d); lsum *= al; scale_rows(w, o, al); }
        m += d; first = false;
    }
#pragma unroll
    for (int i = 0; i < 2; ++i) if (sd[i].act) { VFrags vf; load_vfrags_win<NK>(w, sd[i].u, vf);
        float acc = 0.f;
#pragma unroll
        for (int r = 0; r < 16; ++r) { s[i][r] = __builtin_amdgcn_exp2f(s[i][r]); acc += s[i][r]; }
        lsum += acc;
        pv_frags(vf, s[i], o); }
}

__device__ __forceinline__ size_t ql_off(int bh, int j) { return (size_t)bh * QL_PER_BH + (size_t)(8192 * j - 128 * j * (j + 1)); }
__device__ __forceinline__ float* lsem_ptr(float* l0, float* l1, int slot) { return (slot < 2 ? l0 : l1) + (size_t)(slot & 1) * T * 4; }

struct Top3 { int i0, i1, i2; };
__device__ __forceinline__ Top3 moba_top3(const Wave& w, const bf16x8 (&qf)[4], const float* KMEAN, int b, int h, int own) {
    int i0 = -1, i1 = -1, i2 = -1;
    if (own > 0) {
    f32x16 g;
#pragma unroll
    for (int r = 0; r < 16; ++r) g[r] = 0.f;
    const float* km = KMEAN + ((size_t)(b * 4 + h) * 32 + w.r32) * HD + 8 * w.hi;
#pragma unroll
    for (int ks = 0; ks < 4; ++ks) { const f32x4 a0 = *(const f32x4*)(km + 16 * ks), a1 = *(const f32x4*)(km + 16 * ks + 4);
        const float x[8] = {a0.x, a0.y, a0.z, a0.w, a1.x, a1.y, a1.z, a1.w}; unsigned hw[4], lw[4];
#pragma unroll
        for (int j = 0; j < 4; ++j) { const unsigned h0 = f2bf(x[2 * j]), h1 = f2bf(x[2 * j + 1]); hw[j] = h0 | (h1 << 16);
            lw[j] = pk2(x[2 * j] - __builtin_bit_cast(float, h0 << 16), x[2 * j + 1] - __builtin_bit_cast(float, h1 << 16)); }
        const u32x4 hv = {hw[0], hw[1], hw[2], hw[3]}, lv = {lw[0], lw[1], lw[2], lw[3]};
        g = ATT_MFMA(__builtin_bit_cast(bf16x8, hv), qf[ks], g); g = ATT_MFMA(__builtin_bit_cast(bf16x8, lv), qf[ks], g); }
    float v0 = -INFINITY, v1 = -INFINITY, v2 = -INFINITY;
#pragma unroll
    for (int r = 0; r < 16; ++r) { const int blk = (r & 3) + 8 * (r >> 2) + 4 * w.hi; const float val = (blk < own) ? g[r] : -INFINITY;
        if (val > v0) { v2 = v1; i2 = i1; v1 = v0; i1 = i0; v0 = val; i0 = blk; } else if (val > v1) { v2 = v1; i2 = i1; v1 = val; i1 = blk; } else if (val > v2) { v2 = val; i2 = blk; } }
    const float pv_[3] = {get_xor32(v0, w.hi), get_xor32(v1, w.hi), get_xor32(v2, w.hi)}; const int pi_[3] = {get_xor32i(i0, w.hi), get_xor32i(i1, w.hi), get_xor32i(i2, w.hi)};
#pragma unroll
    for (int k = 0; k < 3; ++k) { const float val = pv_[k]; const int blk = pi_[k];
        if (val > v0 || (val == v0 && blk < i0)) { v2 = v1; i2 = i1; v1 = v0; i1 = i0; v0 = val; i0 = blk; }
        else if (val > v1 || (val == v1 && blk < i1)) { v2 = v1; i2 = i1; v1 = val; i1 = blk; }
        else if (val > v2 || (val == v2 && blk < i2)) { v2 = val; i2 = blk; } }
    }
    Top3 t; t.i0 = i0; t.i1 = i1; t.i2 = i2; return t;
}
__device__ __forceinline__ void moba_gate_unit(LAS unsigned char* lds, const bf16_t* QB, const float* KMEAN, unsigned* mcnt, unsigned* qlist, bf16_t* PM, float* LSEM0, float* LSEM1, int b, int h, int own, int tid) {
    const Wave w = make_wave(lds, tid);
    const size_t rowbase = (size_t)b * SEQ; const int qpos = own * 256 + 32 * w.wid + w.r32, bh = b * 4 + h;
    bf16x8 qf[4]; load_q(qf, QB + (rowbase + qpos) * DM + h * HD, w.hi);
    const Top3 t3 = moba_top3(w, qf, KMEAN, b, h, own); const int s0 = t3.i0, s1 = t3.i1, s2 = t3.i2;
    LAS unsigned* cl = (LAS unsigned*)(lds + W_ENUM);
    if (tid < 64) cl[tid] = 0u;
    __syncthreads();
    unsigned r0 = 0u, r1 = 0u, r2 = 0u;
    if (w.hi == 0) {
        if (s0 >= 0) r0 = __hip_atomic_fetch_add(cl + s0, 1u, __ATOMIC_RELAXED, __HIP_MEMORY_SCOPE_WORKGROUP);
        if (s1 >= 0) r1 = __hip_atomic_fetch_add(cl + s1, 1u, __ATOMIC_RELAXED, __HIP_MEMORY_SCOPE_WORKGROUP);
        if (s2 >= 0) r2 = __hip_atomic_fetch_add(cl + s2, 1u, __ATOMIC_RELAXED, __HIP_MEMORY_SCOPE_WORKGROUP);
    }
    __syncthreads();
    if (tid < 32) { const unsigned c = cl[tid]; cl[32 + tid] = c ? __hip_atomic_fetch_add(mcnt + bh * 32 + tid, c, __ATOMIC_RELAXED, __HIP_MEMORY_SCOPE_AGENT) : 0u; }
    __syncthreads();
    if (w.hi == 0) {
        const size_t tok = rowbase + qpos;
#define MOBA_EMIT(k, sk, rk) do { if (sk >= 0) qlist[ql_off(bh, sk) + cl[32 + sk] + rk] = (unsigned)qpos | ((unsigned)(k) << 13); \
            else { lsem_ptr(LSEM0, LSEM1, k)[tok * 4 + h] = -1.0e30f;          \
                u32x4* pz = (u32x4*)(PM + ((size_t)(k) * T + tok) * 256 + h * HD); const u32x4 z4 = {0u, 0u, 0u, 0u}; \
                _Pragma("unroll") for (int c = 0; c < 8; ++c) pz[c] = z4; } } while (0)
        MOBA_EMIT(0, s0, r0); MOBA_EMIT(1, s1, r1); MOBA_EMIT(2, s2, r2);
#undef MOBA_EMIT
    }
    __syncthreads();
}
struct OwnU { int b, h, own; };
__device__ __forceinline__ void own_issue(Pref<4>& P, const Wave& w, const OwnU& u, const bf16_t* QB, const bf16_t* KB, const bf16_t* VB) {
    const size_t rowbase = (size_t)u.b * SEQ; const int q0 = u.own * 256;
    win_issue<4>(P, w, KB + (rowbase + q0) * DM + u.h * HD, VB + (rowbase + q0) * DM + u.h * HD, [&](int key) { return (size_t)key * DM; }, QB + (rowbase + q0 + 32 * w.wid + w.r32) * DM + u.h * HD);
}
template <class F> __device__ __forceinline__ void own_compute(const Wave& w, const OwnU& u, const bf16x8 (&qf)[4], bf16_t* OB, float* LSEM0, float* LSEM1, const F& between) {
    const size_t rowbase = (size_t)u.b * SEQ; const int q0 = u.own * 256, ql = 32 * w.wid + w.r32;
    const float slope2 = exp2f(-2.0f * (float)(u.h + 1)) * LOG2E;
    bf16x8 kidx, slp; bias_frags(w, slope2, kidx, slp);
    f32x16 o[2];
#pragma unroll
    for (int r = 0; r < 16; ++r) { o[0][r] = 0.f; o[1][r] = 0.f; }
    float m = 0.f, lsum = 0.f; bool first = true;
#pragma unroll
    for (int p = 0; p < 4; ++p) { WSub sd[2];
#pragma unroll
        for (int i = 0; i < 2; ++i) { const int su = w.wid - 2 * p - i; sd[i].act = su >= 0; sd[i].u = su; sd[i].delta = ql - 32 * su; sd[i].W = (su == w.wid) ? 0x7fffffff : -1; }
        softmax_win<256>(w, qf, kidx, slp, slope2, sd, m, lsum, o, first); }
    between();
    const float l = sum_xor32(lsum);
    scale_rows(w, o, 1.0f / l);
    bf16_t* orow = OB + (rowbase + q0 + 32 * w.wid) * DM + u.h * HD;
    store_o(w, o, [&](int r) { return orow + (size_t)r * DM; });
    if (w.hi == 0) lsem_ptr(LSEM0, LSEM1, 3)[(rowbase + q0 + ql) * 4 + u.h] = m + __builtin_amdgcn_logf(l);
}
struct GatU { int b, h, j, cnt, chunk; const unsigned* ql; };
__device__ __forceinline__ unsigned gat_entry(const Wave& w, const GatU& u, bool& valid) { const int idx = u.chunk * 256 + 32 * w.wid + w.r32; valid = idx < u.cnt; return u.ql[valid ? idx : u.chunk * 256]; }
__device__ __forceinline__ void gat_issue(Pref<4>& P, const Wave& w, const GatU& u, const bf16_t* QB, const bf16_t* KB, const bf16_t* VB) {
    const size_t rowbase = (size_t)u.b * SEQ; bool valid; const unsigned e = gat_entry(w, u, valid);
    win_issue<4>(P, w, KB + (rowbase + u.j * 256) * DM + u.h * HD, VB + (rowbase + u.j * 256) * DM + u.h * HD, [&](int key) { return (size_t)key * DM; }, QB + (rowbase + (e & 8191u)) * DM + u.h * HD);
}
template <class F> __device__ __forceinline__ void gat_compute(const Wave& w, const GatU& u, const bf16x8 (&qf)[4], bf16_t* PM, float* LSEM0, float* LSEM1, const F& between) {
    const size_t rowbase = (size_t)u.b * SEQ; bool valid; const unsigned e = gat_entry(w, u, valid);
    const int qpos = (int)(e & 8191u), slot = (int)(e >> 13);
    const float slope2 = exp2f(-2.0f * (float)(u.h + 1)) * LOG2E;
    bf16x8 kidx, slp; bias_frags(w, slope2, kidx, slp);
    f32x16 o[2];
#pragma unroll
    for (int r = 0; r < 16; ++r) { o[0][r] = 0.f; o[1][r] = 0.f; }
    float m = 0.f, lsum = 0.f; bool first = true;
#pragma unroll
    for (int p = 0; p < 4; ++p) { WSub sd[2];
#pragma unroll
        for (int i = 0; i < 2; ++i) { const int su = 7 - 2 * p - i; sd[i].act = true; sd[i].u = su; sd[i].delta = qpos - (u.j * 256 + 32 * su); sd[i].W = -1; }
        softmax_win<256>(w, qf, kidx, slp, slope2, sd, m, lsum, o, first); }
    between();
    const float l = sum_xor32(lsum);
    scale_rows(w, o, l > 0.f ? 1.0f / l : 0.f);
    LAS int* code = (LAS int*)(w.wsf + 32);
    if (w.hi == 0) code[w.r32] = valid ? (int)((size_t)slot * T + rowbase + qpos) : -1;
    store_o(w, o, [&](int r) { const int c = code[r]; return c >= 0 ? PM + (size_t)c * 256 + u.h * HD : (bf16_t*)nullptr; });
    if (w.hi == 0 && valid) lsem_ptr(LSEM0, LSEM1, slot)[(rowbase + qpos) * 4 + u.h] = l > 0.f ? m + __builtin_amdgcn_logf(l) : -1.0e30f;
}

__device__ __forceinline__ void sb_unit(LAS unsigned char* lds, const bf16_t* QB, const bf16_t* KB, const bf16_t* VB, bf16_t* OB, int b, int h, int qt, int tid) {
    const Wave w = make_wave(lds, tid);
    const size_t rowbase = (size_t)b * SEQ; const int q0 = qt * 256, qpos = q0 + 32 * w.wid + w.r32;
    const bf16_t* kh = KB + rowbase * DM + h * HD; const bf16_t* vh = VB + rowbase * DM + h * HD;
    bf16x8 qf[4]; load_q(qf, QB + (rowbase + qpos) * DM + h * HD, w.hi);
    f32x16 o[2];
#pragma unroll
    for (int r = 0; r < 16; ++r) { o[0][r] = 0.f; o[1][r] = 0.f; }
    float carry = 0.f;
    bool done = false;
    volatile LAS unsigned* flg = (volatile LAS unsigned*)(lds + L_FLG);
    const int ti0 = q0 / 64 + 3;
    Stage sg;
    { const int kp = ti0 * 64; stage_load(sg, w, [&](int key) { return kh + (size_t)(kp + key) * DM; }, [&](int key) { return vh + (size_t)(kp + key) * DM; }); }
    stage_write(sg, w, 0);
    __syncthreads();
    for (int st = 0;; ++st) {
        const int buf = st & 1, ti = ti0 - st;
        if (ti > 0) { const int kp = (ti - 1) * 64; stage_load(sg, w, [&](int key) { return kh + (size_t)(kp + key) * DM; }, [&](int key) { return vh + (size_t)(kp + key) * DM; }); }
        if (!done) {
#pragma unroll
            for (int sub = 1; sub >= 0; --sub) {
                const int D = (q0 / 32 + w.wid) - (2 * ti + sub);
                if (D < 0) continue;
                const int delta0 = qpos - (64 * ti + 32 * sub) - 4 * w.hi;
                f32x16 z = qk_sub(w, buf, sub, qf, 0.f);
                f32x16 dd;
#pragma unroll
                for (int r = 0; r < 16; ++r) { z[r] = __builtin_amdgcn_exp2f(fminf(z[r], 30.f)); }
                if (D == 0) {
#pragma unroll
                    for (int r = 0; r < 16; ++r) { const int dl = delta0 - ((r & 3) + 8 * (r >> 2)); if (dl < 1) z[r] = 0.f; }
                }
#pragma unroll
                for (int r = 0; r < 16; ++r) dd[r] = 1.f + z[r];
                float G[4], PG[4];
#pragma unroll
                for (int g = 0; g < 4; ++g) { G[g] = (dd[4 * g] * dd[4 * g + 1]) * (dd[4 * g + 2] * dd[4 * g + 3]); PG[g] = get_xor32(G[g], w.hi); }
                const float cin = __builtin_amdgcn_exp2f(carry);
                float run = 1.f;
#pragma unroll
                for (int g = 3; g >= 0; --g) { const float x3 = run * (w.hi == 0 ? PG[g] : 1.f);
                    const float p0 = x3 * G[g];
                    const float r0 = __builtin_amdgcn_rcpf(p0) * cin, r1 = r0 * dd[4 * g], r2 = r1 * dd[4 * g + 1], r3 = r2 * dd[4 * g + 2];
                    z[4 * g] *= r0; z[4 * g + 1] *= r1; z[4 * g + 2] *= r2; z[4 * g + 3] *= r3;
                    run *= G[g] * PG[g]; }
                carry -= __builtin_amdgcn_logf(run);
                pv_sub(w, buf, sub, z, o);
            }
            done = __all(carry < -150.f);
        }
        if (w.lane == 0) flg[buf * 8 + w.wid] = done ? 1u : 0u;
        if (ti > 0) stage_write(sg, w, buf ^ 1);
        __syncthreads();
        unsigned all = 1u;
#pragma unroll
        for (int k = 0; k < 8; ++k) all &= flg[buf * 8 + k];
        if (all || ti == 0) break;
    }
    bf16_t* orow = OB + (rowbase + q0 + 32 * w.wid) * DM + h * HD;
    store_o(w, o, [&](int r) { return orow + (size_t)r * DM; });
    __syncthreads();
}

struct PrefK6 { u32x4 k[6]; bf16x8 q[4]; }; struct PrefV6 { u32x4 v[6]; };
template <class RowF> __device__ __forceinline__ void win_issue_k6(PrefK6& P, const Wave& w, const bf16_t* kbase, const RowF& rowoff, const bf16_t* qrow) {
#pragma unroll
    for (int c = 0; c < 6; ++c) P.k[c] = *(const u32x4*)(kbase + rowoff(64 * c + 8 * w.wid + (w.lane >> 3)) + (w.lane & 7) * 8);
    load_q(P.q, qrow, w.hi);
}
template <class RowF> __device__ __forceinline__ void win_issue_v6(PrefV6& P, const Wave& w, const bf16_t* vbase, const RowF& rowoff) {
#pragma unroll
    for (int c = 0; c < 6; ++c) P.v[c] = *(const u32x4*)(vbase + rowoff(64 * c + 16 * (w.wid & 3) + (w.lane >> 2)) + (w.wid >> 2) * 32 + (w.lane & 3) * 8);
}
__device__ __forceinline__ void win_commit_k6(const PrefK6& P, const Wave& w) {
#pragma unroll
    for (int c = 0; c < 6; ++c) { const int key = 64 * c + 8 * w.wid + (w.lane >> 3); *(LAS u32x4*)(w.lds + key * 128 + ((((w.lane & 7) ^ (key >> 1)) & 7) * 16)) = P.k[c]; }
}
__device__ __forceinline__ void win_commit_v6(const PrefV6& P, const Wave& w) {
    constexpr int NK = 384;
#pragma unroll
    for (int c = 0; c < 6; ++c) *(LAS u32x4*)(w.lds + NK * 128 + (w.wid >> 2) * (NK * 64) + (8 * c + 2 * (w.wid & 3)) * 512 + w.lane * 16) = P.v[c];
}
struct DilU { int b, h, dil, res, i2, c; };
__device__ __forceinline__ DilU dil_decode(int u) { const int n = ((u & 31) + (u >> 8)) & 31, bhc = u >> 5,
    c = bhc % 3, bh = bhc / 3; DilU d; d.b = bh >> 3; d.h = 8 + (bh & 7); d.c = c;
    d.dil = (c == 0) ? 1 : (c == 1) ? 4 : 16; d.res = (c == 0) ? 0 : (c == 1) ? (n >> 3) : (n >> 1); d.i2 = (c == 0) ? n : (c == 1) ? (n & 7) : (n & 1); return d; }
__device__ __forceinline__ void dil_issue_k(PrefK6& P, const Wave& w, const DilU& u, const bf16_t* QB, const bf16_t* KB) {
    const size_t rowbase = (size_t)u.b * SEQ; const int Q0 = 256 * u.i2, qj = Q0 + 32 * w.wid + w.r32; const size_t rstride = (size_t)u.dil * DM;
    win_issue_k6(P, w, KB + (rowbase + u.res) * DM + u.h * HD, [&](int key) { const int kj = Q0 - 128 + key; return (size_t)(kj < 0 ? 0 : kj) * rstride; },
                 QB + (rowbase + u.res + (size_t)qj * u.dil) * DM + u.h * HD);
}
__device__ __forceinline__ void dil_issue_v(PrefV6& P, const Wave& w, const DilU& u, const bf16_t* VB) {
    const size_t rowbase = (size_t)u.b * SEQ; const int Q0 = 256 * u.i2; const size_t rstride = (size_t)u.dil * DM;
    win_issue_v6(P, w, VB + (rowbase + u.res) * DM + u.h * HD, [&](int key) { const int kj = Q0 - 128 + key; return (size_t)(kj < 0 ? 0 : kj) * rstride; });
}
template <class F> __device__ __forceinline__ void dil_compute(const Wave& w, const DilU& u, const bf16x8 (&qf)[4], bf16_t* OB, bf16_t* HB2, float* LSE, const F& between) {
    const size_t rowbase = (size_t)u.b * SEQ; const int Q0 = 256 * u.i2, ql = 32 * w.wid + w.r32;
    const float slope2d = exp2f(-(float)(u.h - 8 + 1)) * LOG2E * (float)u.dil;
    bf16x8 kidx, slp; bias_frags(w, slope2d, kidx, slp);
    f32x16 o[2];
#pragma unroll
    for (int r = 0; r < 16; ++r) { o[0][r] = 0.f; o[1][r] = 0.f; }
    float m = 0.f, lsum = 0.f; bool first = true;
#pragma unroll
    for (int p = 0; p < 3; ++p) { WSub sd[2];
#pragma unroll
        for (int i = 0; i < 2; ++i) { const int D = 2 * p + i, su = w.wid + 4 - D; sd[i].act = (D <= 4) && (Q0 - 128 + 32 * su >= 0); sd[i].u = su; sd[i].delta = ql + 128 - 32 * su; sd[i].W = (D == 0 || D == 4) ? 128 : -1; }
        softmax_win<384>(w, qf, kidx, slp, slope2d, sd, m, lsum, o, first); }
    between();
    const float l = sum_xor32(lsum);
    scale_rows(w, o, 1.0f / l);
    bf16_t* PO = (u.c == 0) ? OB + 512 : HB2 + (u.c - 1) * 512;
    const size_t tok0 = rowbase + u.res + (size_t)(Q0 + 32 * w.wid) * u.dil;
    store_o(w, o, [&](int r) { return PO + (tok0 + (size_t)r * u.dil) * DM + (u.h - 8) * HD; });
    if (w.hi == 0) (LSE + (size_t)u.c * T * 8)[(tok0 + (size_t)w.r32 * u.dil) * 8 + (u.h - 8)] = m + __builtin_amdgcn_logf(l);
}

__device__ __forceinline__ void moba_gate_phase(LAS unsigned char* lds, const bf16_t* QB, const float* KMEAN, unsigned* mcnt, unsigned* qlist, bf16_t* PM, float* LSEM0, float* LSEM1, int v, int G, int tid) {
    for (int u = v; u < 512; u += G) { const int own = u & 31, bh = u >> 5; moba_gate_unit(lds, QB, KMEAN, mcnt, qlist, PM, LSEM0, LSEM1, bh >> 2, bh & 3, own, tid); }
}
struct AttnArgs { const bf16_t* QB; const bf16_t* KB; const bf16_t* VB; bf16_t* OB; bf16_t* HB2; float* LSE; unsigned* mcnt; unsigned* qlist; bf16_t* PM; float* LSEM0; float* LSEM1; const float* KMEAN; unsigned* gdone; };
__device__ __forceinline__ void attn_phase(LAS unsigned char* lds, const AttnArgs& A, int v, int G, int tid) {
    moba_gate_phase(lds, A.QB, A.KMEAN, A.mcnt, A.qlist, A.PM, A.LSEM0, A.LSEM1, v, G, tid);
    asm volatile("s_waitcnt vmcnt(0)" ::: "memory");
    __syncthreads();
    if (tid == 0) { __builtin_amdgcn_fence(__ATOMIC_RELEASE, "agent"); asm volatile("s_waitcnt vmcnt(0)" ::: "memory"); __hip_atomic_fetch_add(A.gdone, 1u, __ATOMIC_RELAXED, __HIP_MEMORY_SCOPE_AGENT); }
    const Wave w = make_wave(lds, tid, W_WSF, W_OST);
    {   Pref<4> P; int u = v; OwnU cur, nxt;
        auto dec = [&](int uu) { OwnU o_; const int bh = uu >> 5; o_.b = bh >> 2; o_.h = bh & 3; o_.own = uu & 31; return o_; };
        if (u < 512) { cur = dec(u); own_issue(P, w, cur, A.QB, A.KB, A.VB); }
        for (; u < 512; u += G) {
            __syncthreads();
            win_commit<4>(P, w); bf16x8 qf[4] = {P.q[0], P.q[1], P.q[2], P.q[3]};
            __syncthreads();
            const bool more = u + G < 512; if (more) nxt = dec(u + G);
            own_compute(w, cur, qf, A.OB, A.LSEM0, A.LSEM1, [&]() { if (more) own_issue(P, w, nxt, A.QB, A.KB, A.VB); });
            cur = nxt; } }
    {   PrefK6 P; int u = v; DilU cur, nxt;
        if (u < 3072) { cur = dil_decode(u); dil_issue_k(P, w, cur, A.QB, A.KB); }
        for (; u < 3072; u += G) {
            __syncthreads();
            bf16x8 qf[4] = {P.q[0], P.q[1], P.q[2], P.q[3]};
            { PrefV6 PV; dil_issue_v(PV, w, cur, A.VB); win_commit_k6(P, w); win_commit_v6(PV, w); }
            __syncthreads();
            const bool more = u + G < 3072; if (more) nxt = dil_decode(u + G);
            dil_compute(w, cur, qf, A.OB, A.HB2, A.LSE, [&]() { if (more) dil_issue_k(P, w, nxt, A.QB, A.KB); });
            cur = nxt; } }
    __syncthreads();
    for (int u = v; u < 512; u += G) { const int qt = ((u & 31) + (u >> 8)) & 31, bh = u >> 5; sb_unit(lds, A.QB, A.KB, A.VB, A.OB, bh >> 2, 4 + (bh & 3), qt, tid); }
    if (tid == 0) { unsigned polls = 0;
        while (__hip_atomic_load(A.gdone, __ATOMIC_RELAXED, __HIP_MEMORY_SCOPE_AGENT) < (unsigned)G) { if (++polls > (1u << 20)) break; __builtin_amdgcn_s_sleep(2); }
        __builtin_amdgcn_fence(__ATOMIC_ACQUIRE, "agent"); asm volatile("s_waitcnt vmcnt(0)" ::: "memory"); }
    __syncthreads();
    LAS int* cntl = (LAS int*)(lds + W_ENUM); LAS int* pa = cntl + 512; LAS int* pb = pa + 512;
    const int myc = (int)A.mcnt[tid], myu = (myc + 255) >> 8;
    cntl[tid] = myc; pa[tid] = myu;
    __syncthreads();
#pragma unroll 1
    for (int d = 1; d < 512; d <<= 1) { const int x = pa[tid] + (tid >= d ? pa[tid - d] : 0); pb[tid] = x; __syncthreads(); LAS int* t_ = pa; pa = pb; pb = t_; }
    const int total = pa[511];
    auto gat_decode = [&](int u) { int lo = 0, hi = 511;
        while (lo < hi) { const int mid = (lo + hi) >> 1; if (pa[mid] > u) hi = mid; else lo = mid + 1; }
        const int i = lo, c = cntl[i], bh = i >> 5; GatU g; g.b = bh >> 2; g.h = bh & 3; g.j = i & 31; g.cnt = c; g.chunk = u - (pa[i] - ((c + 255) >> 8)); g.ql = A.qlist + ql_off(bh, g.j); return g; };
    {   Pref<4> P; int u = v; GatU cur, nxt;
        if (u < total) { cur = gat_decode(u); gat_issue(P, w, cur, A.QB, A.KB, A.VB); }
        for (; u < total; u += G) {
            __syncthreads();
            win_commit<4>(P, w); bf16x8 qf[4] = {P.q[0], P.q[1], P.q[2], P.q[3]};
            __syncthreads();
            const bool more = u + G < total; if (more) nxt = gat_decode(u + G);
            gat_compute(w, cur, qf, A.PM, A.LSEM0, A.LSEM1, [&]() { if (more) gat_issue(P, w, nxt, A.QB, A.KB, A.VB); });
            cur = nxt; } }
}
}

constexpr int PH_PRO = 0, PH_L0 = 1, PH_PER_LAYER = 10, PH_FINAL = PH_L0 + DEPTH * PH_PER_LAYER, PH_COUNT = PH_FINAL + 1;
typedef const __attribute__((address_space(4))) Args* KArgP;
#define KARG() ({ KArgP p_ = (KArgP)__builtin_amdgcn_kernarg_segment_ptr(); asm volatile("" : "+s"(p_)); p_; })
#define PHASE_IDS int lane_p = (int)__builtin_amdgcn_mbcnt_hi(~0u, __builtin_amdgcn_mbcnt_lo(~0u, 0u)); LAUNDER_V(lane_p); int tid_p = wave * 64 + lane_p; int gw_p = gw, G_p = G, NGW_p = NGW; LAUNDER_S(gw_p); LAUNDER_S(G_p); LAUNDER_S(NGW_p)
__global__ void __launch_bounds__(NTHREADS, 2) fwd(Args a_unused) {
    extern __shared__ __attribute__((aligned(16))) unsigned char lds_raw[];
    LAS unsigned char* lds = (LAS unsigned char*)lds_raw;
    volatile LAS unsigned* MISC = (volatile LAS unsigned*)(lds + MISC_OFF);
    const int wave = __builtin_amdgcn_readfirstlane((int)threadIdx.x >> 6);
    const int G = gridDim.x, bx = blockIdx.x;
    const int vcu = (G % 8 == 0) ? (bx % 8) * (G / 8) + bx / 8 : bx;
    const int gw = vcu * NWAVES + wave, NGW = G * NWAVES;
    for (int u = threadIdx.x; u < (LDS_BYTES - LDSCTL_OFF) / 4; u += NTHREADS) ((LAS unsigned*)(lds + LDSCTL_OFF))[u] = 0u;
    __syncthreads();
    int lo, hi; XcdBarrier bar;
    { KArgP ka = KARG(); lo = ka->ph_lo; hi = ka->ph_hi; unsigned* ctl = (unsigned*)(ka->ws + WS_CTL); bar = xcd_barrier_post(ctl + CW_BAR + ka->li * XCD_BAR_WORDS, MISC + 8, wave); }
#define IN(k) (lo <= (k) && (k) < hi)
#define SEAM(k) do { if (IN(k) && IN((k) + 1)) xcd_barrier(bar); } while (0)
#define WSP(T_, off) ((T_*)(ws + (off)))

    if (IN(PH_PRO)) { KArgP ka = KARG(); PHASE_IDS; Args a; a.ws = ka->ws; a.w_in = ka->w_in; a.w_out = ka->w_out; a.w_gate = ka->w_gate; a.w_up = ka->w_up; a.w_down = ka->w_down; a.ln2_g = ka->ln2_g; a.ln1_g = ka->ln1_g; phase_prologue(a, lds, gw_p, NGW_p, wave, lane_p); } SEAM(PH_PRO);

    for (int l = 0; l < DEPTH; ++l) {
        const int p0 = PH_L0 + l * PH_PER_LAYER;
        if (hi <= p0 || lo >= p0 + PH_PER_LAYER) continue;
        if (IN(p0 + 0)) for (int rep_ = 0; rep_ < RPT(0); ++rep_) { if (rep_) xcd_barrier(bar); KArgP ka = KARG(); PHASE_IDS; unsigned char* ws = ka->ws;
            if (l == 0) phase_norm1(ka->x, gw_p, NGW_p, lane_p, WSP(float, WS_KMEAN), WSP(bf16_t, WS_XB), WSP(float, WS_RSTD));
            else phase_norm1_b(WSP(bf16_t, WS_XB), gw_p, NGW_p, lane_p, WSP(float, WS_KMEAN), WSP(float, WS_RSTD)); } SEAM(p0 + 0);
        if (IN(p0 + 1)) for (int rep_ = 0; rep_ < RPT(1); ++rep_) { if (rep_) xcd_barrier(bar); KArgP ka = KARG(); PHASE_IDS; unsigned char* ws = ka->ws;
            pg8::Gemm g{(const char*)(ws + WS_XB), (const char*)(ws + WS_WIN) + (size_t)l * NQKV * DM * 2, DM, DM, DM, (long)256 * DM * 2, (long)256 * DM * 2, (long)128 * DM * 2, WSP(float, WS_RSTD)};
            pg8::StaticOrder S; S.init(T / 256, NQKV / 256, G_p, bx);
            pg8::EpiQKV E{WSP(bf16_t, WS_Q), (size_t)(WS_K - WS_Q) / 2, QSCALE};
            pg8::gemm_phase<pg8::EpiQKV, pg8::StaticOrder>(lds, g, S, E, wave);
        } SEAM(p0 + 1);
        if (IN(p0 + 4)) for (int rep_ = 0; rep_ < RPT(4); ++rep_) { if (rep_) xcd_barrier(bar); KArgP ka = KARG(); PHASE_IDS; unsigned char* ws = ka->ws;
            const att::AttnArgs A{WSP(bf16_t, WS_Q), WSP(bf16_t, WS_K), WSP(bf16_t, WS_V), (bf16_t*)ka->out, WSP(bf16_t, WS_HB), WSP(float, WS_LSE), WSP(unsigned, WS_CTL) + CW_MCNT + l * 512, WSP(unsigned, WS_QLIST),
                                  WSP(bf16_t, WS_PM), WSP(float, WS_LSEM0), WSP(float, WS_LSEM1), WSP(float, WS_KMEAN), WSP(unsigned, WS_CTL) + CW_GDONE + l * 64};
            att::attn_phase(lds, A, vcu, G_p, tid_p);
        } SEAM(p0 + 4);
        if (IN(p0 + 5)) { KArgP ka = KARG(); PHASE_IDS; unsigned char* ws = ka->ws;
            phase_mixnorm((const bf16_t*)ka->out, WSP(bf16_t, WS_HB), WSP(float, WS_LSE), WSP(bf16_t, WS_PM), WSP(float, WS_LSEM0), WSP(float, WS_LSEM1), ka->mix_g + (size_t)l * DM, gw_p, NGW_p, lane_p); } SEAM(p0 + 5);
        if (IN(p0 + 6)) { KArgP ka = KARG(); PHASE_IDS; unsigned char* ws = ka->ws;
            pg8::Gemm g{(const char*)(ws + WS_HB), (const char*)(ws + WS_WOUT) + (size_t)l * DM * DM * 2, DM, DM, DM, (long)256 * DM * 2, (long)256 * DM * 2, (long)128 * DM * 2, nullptr};
            pg8::StaticOrder S; S.init(T / 256, DM / 256, G_p, bx);
            pg8::EpiResAdd E{WSP(bf16_t, WS_XB)};
            pg8::gemm_phase<pg8::EpiResAdd, pg8::StaticOrder>(lds, g, S, E, wave);
        } SEAM(p0 + 6);
        if (IN(p0 + 7)) { KArgP ka = KARG(); PHASE_IDS; unsigned char* ws = ka->ws;
            phase_route(WSP(bf16_t, WS_XB), ka->ln2_g + (size_t)l * DM, ka->w_gr + (size_t)l * DM * 4, ka->b_gr + l * 4, ka->w_er + (size_t)l * 4 * DM * 4, ka->b_er + l * 16, WSP(float, WS_LSE),
                        WSP(unsigned, WS_CTL) + CW_CNT + l * 32, WSP(unsigned, WS_LIST), WSP(float, WS_WLIST), lds, vcu, G_p, wave, lane_p); } SEAM(p0 + 7);
        if (IN(p0 + 8)) for (int rep_ = 0; rep_ < RPT(8); ++rep_) { if (rep_) xcd_barrier(bar); KArgP ka = KARG(); PHASE_IDS; unsigned char* ws = ka->ws;
            pg8::MoeProb<0> P{WSP(unsigned, WS_CTL) + CW_CNT + l * 32, WSP(unsigned, WS_LIST), (const char*)(ws + WS_XB), (const char*)(ws + WS_WG) + (size_t)l * NACT * DM * 2, DM, DM, DM, (long)(WS_WU - WS_WG), G_p, vcu, WSP(unsigned, WS_CTL) + CW_TCNT + l * 16384};
            pg8::EpiGateUpSparse E{WSP(bf16_t, WS_ACT), WSP(float, WS_WLIST), WSP(float, WS_LSE), WSP(unsigned, WS_CTL) + CW_TCNT + l * 16384};
            pg8::gemm_phase_x<pg8::EpiGateUpSparse, pg8::MoeProb<0>>(lds, P, E, wave);
        }
        if (IN(p0 + 9)) { KArgP ka = KARG(); PHASE_IDS; unsigned char* ws = ka->ws;
            pg8::MoeProb<1> P{WSP(unsigned, WS_CTL) + CW_CNT + l * 32, WSP(unsigned, WS_LIST), (const char*)(ws + WS_ACT), (const char*)(ws + WS_WD) + (size_t)l * DM * NACT * 2, 512, NACT, 512, (long)128 * NACT * 2, G_p, vcu, WSP(unsigned, WS_CTL) + CW_TCNT + l * 16384};
            pg8::EpiDownScatter E{WSP(bf16_t, WS_XB), WSP(unsigned, WS_LIST)};
            pg8::gemm_phase_x<pg8::EpiDownScatter, pg8::MoeProb<1>>(lds, P, E, wave);
        } SEAM(p0 + 9);
    }
    if (IN(PH_FINAL)) { KArgP ka = KARG(); PHASE_IDS; phase_final((const bf16_t*)(ka->ws + WS_XB), ka->fin_g, ka->out, gw_p, NGW_p, lane_p); }
#undef IN
#undef SEAM
#undef WSP
}

#ifndef N_LAUNCH_MODE
#define N_LAUNCH_MODE 1
#endif
extern "C" void kernel_launch(void* const* d_in, const int* in_sizes, int n_in, void* d_out, int out_size, void* d_ws, size_t ws_size, hipStream_t stream) {
    static int grid = 0;
    if (grid == 0) {
        if (n_in != 14 || in_sizes[0] != T * DM || out_size != T * DM || ws_size < WS_END) { fprintf(stderr, "kernel_launch: unexpected shapes (n_in %d in0 %d out %d ws %zu)\n", n_in, n_in > 0 ? in_sizes[0] : -1, out_size, ws_size); grid = -1; return; }
        int dev = 0, cus = 0, per_cu = 0;
        if (hipGetDevice(&dev) != hipSuccess || hipDeviceGetAttribute(&cus, hipDeviceAttributeMultiprocessorCount, dev) != hipSuccess) { grid = -1; return; }
        if (hipFuncSetAttribute((const void*)fwd, hipFuncAttributeMaxDynamicSharedMemorySize, LDS_BYTES) != hipSuccess) { fprintf(stderr, "kernel_launch: hipFuncSetAttribute failed\n"); grid = -1; return; }
        if (hipOccupancyMaxActiveBlocksPerMultiprocessor(&per_cu, (const void*)fwd, NTHREADS, LDS_BYTES) != hipSuccess || per_cu < 1) fprintf(stderr, "kernel_launch: occupancy query says %d\n", per_cu);
        (void)hipGetLastError();
        grid = cus;
    }
    if (grid < 0) return;
    if (hipMemsetAsync((char*)d_ws + WS_CTL, 0, CTL_ZERO_BYTES, stream) != hipSuccess) return;
    Args a{};
    a.x = (const float*)d_in[0]; a.ln1_g = (const float*)d_in[1]; a.w_in = (const float*)d_in[2]; a.mix_g = (const float*)d_in[3]; a.w_out = (const float*)d_in[4]; a.ln2_g = (const float*)d_in[5];
    a.w_gr = (const float*)d_in[6]; a.b_gr = (const float*)d_in[7]; a.w_er = (const float*)d_in[8]; a.b_er = (const float*)d_in[9]; a.w_gate = (const float*)d_in[10]; a.w_up = (const float*)d_in[11];
    a.w_down = (const float*)d_in[12]; a.fin_g = (const float*)d_in[13];
    a.out = (float*)d_out; a.ws = (unsigned char*)d_ws; a.pad = 0;
#if N_LAUNCH_MODE == 1
    a.ph_lo = 0; a.ph_hi = PH_COUNT; a.li = 0;
    hipLaunchKernelGGL(fwd, dim3(grid), dim3(NTHREADS), LDS_BYTES, stream, a);
#else
    for (int p = 0; p < PH_COUNT; ++p) { a.ph_lo = p; a.ph_hi = p + 1; a.li = p; hipLaunchKernelGGL(fwd, dim3(grid), dim3(NTHREADS), LDS_BYTES, stream, a); }
#endif
}
```

```cpp
#include <hip/hip_runtime.h>
#include <cstdio>
#include <cstdint>

#define LAS __attribute__((address_space(3)))
#define GAS __attribute__((address_space(1)))
typedef unsigned short bf16_t;
typedef short bf16x8 __attribute__((ext_vector_type(8)));
typedef float f32x4 __attribute__((ext_vector_type(4)));
typedef float f32x2 __attribute__((ext_vector_type(2)));
typedef unsigned u32x4 __attribute__((ext_vector_type(4)));
typedef unsigned u32x2 __attribute__((ext_vector_type(2)));

#ifndef PROBE_REPEAT
#define PROBE_REPEAT 0
#endif
#define RPT(k) ((((PROBE_REPEAT) >> (k)) & 1) ? 2 : 1)
#ifndef MOE_SPARSE
#define MOE_SPARSE 1
#endif
#ifndef ATT_MOBA
#define ATT_MOBA 1
#endif
#ifndef ATT_SB
#define ATT_SB 1
#endif
#ifndef ATT_DIL
#define ATT_DIL 1
#endif
constexpr int BATCH = 4, SEQ = 8192, DM = 1024, DEPTH = 4, T = BATCH * SEQ, NH = 16, HD = 64;
constexpr int NQKV = 3 * DM, NEXP = 16, DEXP = 256, NACT = NEXP * DEXP;
constexpr float NORM_EPS = 1e-6f;
constexpr float LOG2E = 1.4426950408889634f;
constexpr float QSCALE = 0.125f * LOG2E;
constexpr int NWAVES = 8, NTHREADS = 512;

constexpr size_t MiB = 1u << 20;
constexpr size_t WS_CTL = 0, CTL_ZERO_BYTES = 1 * MiB;
constexpr size_t WS_WIN = 2 * MiB;
constexpr size_t WS_WOUT = 26 * MiB;
constexpr size_t WS_WG = 34 * MiB;
constexpr size_t WS_WU = 66 * MiB;
constexpr size_t WS_WD = 98 * MiB;
constexpr size_t WS_LSEM0 = 1 * MiB;
constexpr size_t WS_KMEAN = 130 * MiB;
constexpr size_t WS_HB = 131 * MiB;
constexpr size_t WS_Q = 195 * MiB, WS_K = 259 * MiB, WS_V = 323 * MiB, WS_XB = 387 * MiB;
constexpr size_t WS_ACT = WS_Q;
constexpr size_t WS_SSQ = 130 * MiB + 512 * 1024;
constexpr size_t WS_LSE = 451 * MiB;
constexpr size_t WS_LIST = 454 * MiB;
constexpr size_t WS_WLIST = 457 * MiB;
constexpr size_t WS_QLIST = WS_LIST;
constexpr size_t WS_PM = 463 * MiB;
constexpr size_t WS_LSEM1 = 511 * MiB;
constexpr size_t WS_END = 512 * MiB;
constexpr int QL_PER_BH = 126976;
constexpr int CW_GDONE = 1536;
constexpr int CW_MCNT = 2048;
constexpr int CW_CNT = 1024;
constexpr int CW_TCNT = 16384;
constexpr int CW_BAR = 4096;

constexpr int RING_BYTES = 131072;
constexpr int LDSCTL_OFF = 147456, MISC_OFF = LDSCTL_OFF + 320;
constexpr int LDS_BYTES = 148480;

__device__ __forceinline__ unsigned f2bf(float f) { unsigned u = __builtin_bit_cast(unsigned, f); return (u + 0x7fffu + ((u >> 16) & 1u)) >> 16; }
__device__ __forceinline__ unsigned pk2(float lo, float hi) { return f2bf(lo) | (f2bf(hi) << 16); }
__device__ __forceinline__ float bflo(unsigned w) { return __builtin_bit_cast(float, w << 16); }
__device__ __forceinline__ float bfhi(unsigned w) { return __builtin_bit_cast(float, w & 0xffff0000u); }
template <int M> __device__ __forceinline__ float swz_xor(float v) { return __builtin_bit_cast(float, __builtin_amdgcn_ds_swizzle(__builtin_bit_cast(int, v), 0x1f | (M << 10))); }
__device__ __forceinline__ void swap32(unsigned x, unsigned& lo_val, unsigned& hi_val) { unsigned y = x; asm volatile("" : "+v"(y)); auto rr = __builtin_amdgcn_permlane32_swap(x, y, false, false); lo_val = rr[0]; hi_val = rr[1]; }
__device__ __forceinline__ float sum_xor32(float v) { unsigned a, b; swap32(__builtin_bit_cast(unsigned, v), a, b); return __builtin_bit_cast(float, a) + __builtin_bit_cast(float, b); }
__device__ __forceinline__ float max_xor32(float v) { unsigned a, b; swap32(__builtin_bit_cast(unsigned, v), a, b); return fmaxf(__builtin_bit_cast(float, a), __builtin_bit_cast(float, b)); }
__device__ __forceinline__ float get_xor32(float v, int hi) { unsigned a, b; swap32(__builtin_bit_cast(unsigned, v), a, b); return __builtin_bit_cast(float, hi ? a : b); }
__device__ __forceinline__ int get_xor32i(int v, int hi) { unsigned a, b; swap32((unsigned)v, a, b); return (int)(hi ? a : b); }
template <int CTRL> __device__ __forceinline__ float dpp_mov(float v) { return __builtin_bit_cast(float, __builtin_amdgcn_update_dpp(0, __builtin_bit_cast(int, v), CTRL, 0xf, 0xf, false)); }
__device__ __forceinline__ float row_sum(float v) { v += dpp_mov<0xB1>(v); v += dpp_mov<0x4E>(v); v += dpp_mov<0x141>(v); v += dpp_mov<0x140>(v); return v; }
__device__ __forceinline__ float half_sum(float v) { v = row_sum(v); v += swz_xor<16>(v); return v; }
__device__ __forceinline__ float wave_sum(float v) { return sum_xor32(half_sum(v)); }
#define LDS_WAIT() asm volatile("s_waitcnt lgkmcnt(0)" ::: "memory")
#define LAUNDER_V(x) asm volatile("" : "+v"(x))
#define LAUNDER_S(x) asm volatile("" : "+s"(x))

namespace pg8 {
constexpr int BM = 256, BK = 64, HALF = 128, HTB = HALF * BK * 2, STAGE_BYTES = 8 * HTB, NXCD = 8, WGM = 8;
__host__ __device__ __forceinline__ int lds_byte(int r, int c) { const int st = (r >> 4) * 2 + (c >> 5), rr = r & 15, cc = c & 31, ob = rr * 64 + cc * 2; return st * 1024 + (ob ^ (((ob >> 9) & 1) << 5)); }
__host__ __device__ __forceinline__ void stage_rc(int b, int& R, int& C) { const int st = b / 1024, sb = b % 1024, swz = sb ^ (((sb >> 9) & 1) << 5); R = (st >> 1) * 16 + swz / 64; C = (st & 1) * 32 + (swz % 64) / 2; }
__host__ __device__ __forceinline__ int perm32(int rho) { const int n = rho >> 4, i = rho & 15; return 8 * (i >> 2) + 4 * n + (i & 3); }

struct Unit { int pm, pn, meta;
    __device__ __forceinline__ int bk() const { return meta & 31; } __device__ __forceinline__ int tib() const { return (meta >> 5) & 255; } __device__ __forceinline__ int nb() const { return meta >> 13; } };
struct Gemm { const char* A; const char* B; int lda, ldb, K; long tstepA, tstepB, hstepB; const float* rowvec; };
constexpr int RV_OFF = STAGE_BYTES + 1024;
constexpr int RED_OFF = 140288;

struct StaticOrder {
    int nM, nN, nwg, G, c;
    __host__ __device__ void init(int nM_, int nN_, int G_, int c_) { nM = nM_; nN = nN_; nwg = nM * nN; G = G_; c = c_; }
    __host__ __device__ bool next(int i, Unit& u) const {
        const long L = (long)i * G + c; if (L >= nwg) return false;
        int wgid = (int)L; { const int q = nwg / NXCD, r = nwg % NXCD, xcd = wgid % NXCD, off = wgid / NXCD; wgid = (xcd < r ? xcd * (q + 1) : r * (q + 1) + (xcd - r) * q) + off; }
        const int nig = WGM * nN, gid = wgid / nig, fm = gid * WGM, gsz = (nM - fm) < WGM ? (nM - fm) : WGM;
        u.pm = fm + ((wgid % nig) % gsz); u.pn = (wgid % nig) / gsz; return true;
    }
};

__device__ __forceinline__ unsigned cvt_pk_bf16(float lo, float hi) { unsigned r; asm volatile("v_cvt_pk_bf16_f32 %0, %1, %2" : "=v"(r) : "v"(lo), "v"(hi)); return r; }

struct EpiQKV {
    static constexpr bool PERM = true, ROWVEC = true;
    bf16_t* O; size_t split_stride; float scale0;
    __device__ __forceinline__ void operator()(const f32x4 (&acc)[2][2][4][2], const Unit& u, int wr, int wc, int fr, int fq, const LAS float* rv) const {
        asm volatile("" : "+v"(fr), "+v"(fq));
        float rs[2][4];
#pragma unroll
        for (int ai = 0; ai < 2; ++ai)
#pragma unroll
            for (int m = 0; m < 4; ++m) { const int ri = ai * HALF + wr * 64 + m * 16 + fr; const f32x4 p4 = *(const LAS f32x4*)(rv + 4 * ri); const float ss = (p4.x + p4.y) + (p4.z + p4.w);
                rs[ai][m] = 1.0f / sqrtf(ss * (1.f / DM) + NORM_EPS); }
        const int row0 = u.pm * BM + wr * 64 + fr; int colt = u.pn * BM;
        const int t = colt / DM; bf16_t* base = O + (size_t)t * split_stride; colt -= t * DM; const float sc = (t == 0) ? scale0 : 1.f;
        const int col0 = colt + wc * 32 + 8 * fq;
#pragma unroll
        for (int ai = 0; ai < 2; ++ai)
#pragma unroll
            for (int m = 0; m < 4; ++m) { bf16_t* rowp = base + (size_t)(row0 + ai * HALF + m * 16) * DM + col0;
#pragma unroll
                for (int bj = 0; bj < 2; ++bj) { const float sr = sc * rs[ai][m]; f32x4 v0 = acc[ai][bj][m][0] * sr, v1 = acc[ai][bj][m][1] * sr;
                    u32x4 w; w.x = cvt_pk_bf16(v0[0], v0[1]); w.y = cvt_pk_bf16(v0[2], v0[3]); w.z = cvt_pk_bf16(v1[0], v1[1]); w.w = cvt_pk_bf16(v1[2], v1[3]);
                    *(u32x4*)(rowp + bj * HALF) = w; } }
        if (u.pn == 4) {
            float* kmean = (float*)((unsigned char*)O - WS_Q + WS_KMEAN) + ((size_t)((u.pm >> 5) * 4) * 32 + (u.pm & 31)) * HD;
#pragma unroll
            for (int bj = 0; bj < 2; ++bj)
#pragma unroll
                for (int n = 0; n < 2; ++n)
#pragma unroll
                    for (int j = 0; j < 4; ++j) { float cs = 0.f;
#pragma unroll
                        for (int ai = 0; ai < 2; ++ai)
#pragma unroll
                            for (int m = 0; m < 4; ++m) cs += acc[ai][bj][m][n][j] * rs[ai][m];
                        cs = row_sum(cs);
                        const int col = bj * HALF + wc * 32 + 8 * fq + 4 * n + j;
                        if (fr == 0) __hip_atomic_fetch_add(kmean + (size_t)(col >> 6) * 32 * HD + (col & 63), cs, __ATOMIC_RELAXED, __HIP_MEMORY_SCOPE_AGENT); }
        }
    }
};
struct EpiResAdd {
    static constexpr bool PERM = true, ROWVEC = false;
    bf16_t* xb;
    __device__ __forceinline__ void operator()(const f32x4 (&acc)[2][2][4][2], const Unit& u, int wr, int wc, int fr, int fq, const LAS float*) const {
        asm volatile("" : "+v"(fr), "+v"(fq));
        const int col0 = u.pn * BM + wc * 32 + 8 * fq;
#pragma unroll
        for (int ai = 0; ai < 2; ++ai) { u32x4 r[4][2];
#pragma unroll
            for (int m = 0; m < 4; ++m) { const bf16_t* rowp = xb + (size_t)(u.pm * BM + ai * HALF + wr * 64 + m * 16 + fr) * DM + col0;
#pragma unroll
                for (int bj = 0; bj < 2; ++bj) r[m][bj] = *(const u32x4*)(rowp + bj * HALF); }
#pragma unroll
            for (int m = 0; m < 4; ++m) { bf16_t* rowp = xb + (size_t)(u.pm * BM + ai * HALF + wr * 64 + m * 16 + fr) * DM + col0;
#pragma unroll
                for (int bj = 0; bj < 2; ++bj) { const f32x4 v0 = acc[ai][bj][m][0], v1 = acc[ai][bj][m][1]; const u32x4 q = r[m][bj];
                    u32x4 w; w.x = cvt_pk_bf16(bflo(q.x) + v0[0], bfhi(q.x) + v0[1]); w.y = cvt_pk_bf16(bflo(q.y) + v0[2], bfhi(q.y) + v0[3]);
                    w.z = cvt_pk_bf16(bflo(q.z) + v1[0], bfhi(q.z) + v1[1]); w.w = cvt_pk_bf16(bflo(q.w) + v1[2], bfhi(q.w) + v1[3]);
                    *(u32x4*)(rowp + bj * HALF) = w; } } }
    }
};
struct EpiGateUpDense {
    static constexpr bool PERM = true;
    bf16_t* act; const float* comb;
    __device__ __forceinline__ void operator()(const f32x4 (&acc)[2][2][4][2], const Unit& u, int wr, int wc, int fr, int fq) const {
        asm volatile("" : "+v"(fr), "+v"(fq));
        const int e = u.pn >> 1, c0 = (u.pn & 1) * HALF;
        const int col0 = e * DEXP + c0 + wc * 32 + 8 * fq;
#pragma unroll
        for (int ai = 0; ai < 2; ++ai)
#pragma unroll
            for (int m = 0; m < 4; ++m) { const int row = u.pm * BM + ai * HALF + wr * 64 + m * 16 + fr;
                const float cw = comb[(size_t)row * NEXP + e];
                float o[8];
#pragma unroll
                for (int n = 0; n < 2; ++n)
#pragma unroll
                    for (int j = 0; j < 4; ++j) { const float g = acc[ai][0][m][n][j], up = acc[ai][1][m][n][j];
                        const float sg = g * __builtin_amdgcn_rcpf(1.f + __builtin_amdgcn_exp2f(-g * LOG2E));
                        o[n * 4 + j] = sg * up * cw; }
                u32x4 w; w.x = cvt_pk_bf16(o[0], o[1]); w.y = cvt_pk_bf16(o[2], o[3]); w.z = cvt_pk_bf16(o[4], o[5]); w.w = cvt_pk_bf16(o[6], o[7]);
                *(u32x4*)(act + (size_t)row * NACT + col0) = w; }
    }
};

template <class Epi, class Sched>
__device__ __forceinline__ void gemm_phase(LAS unsigned char* lds, const Gemm g, const Sched& S, const Epi& E, int wave_id) {
    int lane_l = (int)__builtin_amdgcn_mbcnt_hi(~0u, __builtin_amdgcn_mbcnt_lo(~0u, 0u)); asm volatile("" : "+v"(lane_l));
    const int wid = wave_id, lane = lane_l, tid = wid * 64 + lane, wr = wid >> 2, wc = wid & 3, fr = lane & 15, fq = lane >> 4;
    const int K = g.K, nt = K / BK;
    unsigned voffA[2], voffB[2];
#pragma unroll
    for (int i = 0; i < 2; ++i) { int R, C; stage_rc(tid * 16 + i * 8192, R, C); const int Rb = Epi::PERM ? ((R & ~31) + perm32(R & 31)) : R;
        voffA[i] = (unsigned)(R * g.lda + C) * 2u; voffB[i] = (unsigned)(Rb * g.ldb + C) * 2u; }
    const size_t kstep = (size_t)(BK * 2);
    const size_t hstepA = (size_t)HALF * g.lda * 2;
    const long hstepB = g.hstepB;
    const unsigned ldsw = (unsigned)wid * 1024u;
    const int aoff = lds_byte(wr * 64 + fr, fq * 8), boff = lds_byte(wc * 32 + fr, fq * 8);
#define PG8_SA(b, h) (((b) * 2 + (h)) * HTB)
#define PG8_SB(b, h) ((4 + (b) * 2 + (h)) * HTB)
#define PG8_STAGE(bufoff, gbase, voff) do { _Pragma("unroll") for (int _i = 0; _i < 2; ++_i) \
        __builtin_amdgcn_global_load_lds((const unsigned*)((const char*)(gbase) + (voff)[_i]), (LAS unsigned*)(lds + (bufoff) + ldsw + _i * 8192), 16, 0, 0); } while (0)
#define PG8_LDA(dst, b, h) do { _Pragma("unroll") for (int m = 0; m < 4; ++m) _Pragma("unroll") for (int k = 0; k < 2; ++k) dst[m][k] = *(const LAS bf16x8*)(lds + PG8_SA(b, h) + aoff + m * 2048 + k * 1024); } while (0)
#define PG8_LDB(dst, b, h) do { _Pragma("unroll") for (int n = 0; n < 2; ++n) _Pragma("unroll") for (int k = 0; k < 2; ++k) dst[n][k] = *(const LAS bf16x8*)(lds + PG8_SB(b, h) + boff + n * 2048 + k * 1024); } while (0)
#define PG8_MMA(ai, bj, At, Bt) do { __builtin_amdgcn_s_setprio(1); _Pragma("unroll") for (int m = 0; m < 4; ++m) _Pragma("unroll") for (int n = 0; n < 2; ++n) _Pragma("unroll") for (int k = 0; k < 2; ++k) \
        acc[ai][bj][m][n] = __builtin_amdgcn_mfma_f32_16x16x32_bf16(Bt[n][k], At[m][k], acc[ai][bj][m][n], 0, 0, 0); __builtin_amdgcn_s_setprio(0); } while (0)
#define PG8_WAIT_V(n) asm volatile("s_waitcnt vmcnt(" #n ")" ::: "memory")
#define PG8_WAIT_L(n) asm volatile("s_waitcnt lgkmcnt(" #n ")" ::: "memory")
#define PG8_BAR __builtin_amdgcn_s_barrier()
#define PG8_SCHED __builtin_amdgcn_sched_barrier(0)
    Unit cur, nxt; int ui = 0;
    if (!S.next(0, cur)) return;
#define PG8_RV(u_, b_) do { if (Epi::ROWVEC && wid < 4) __builtin_amdgcn_global_load_lds((const unsigned*)(g.rowvec + 4 * ((size_t)(u_).pm * BM + wid * 64 + lane)), (LAS unsigned*)(lds + RV_OFF + (b_) * 4096 + wid * 1024), 16, 0, 0); } while (0)
    PG8_RV(cur, 0);
    f32x4 acc[2][2][4][2];
#pragma unroll
    for (int a = 0; a < 2; ++a)
#pragma unroll
        for (int b = 0; b < 2; ++b)
#pragma unroll
            for (int m = 0; m < 4; ++m)
#pragma unroll
                for (int n = 0; n < 2; ++n) acc[a][b][m][n] = (f32x4){0.f, 0.f, 0.f, 0.f};
    bf16x8 At[4][2], B0[2][2], B1[2][2];
    const char* cA = g.A + (size_t)cur.pm * g.tstepA; const char* cB = g.B + (size_t)cur.pn * g.tstepB;
    PG8_STAGE(PG8_SB(0, 0), cB, voffB); PG8_STAGE(PG8_SB(0, 1), cB + hstepB, voffB); PG8_STAGE(PG8_SA(0, 0), cA, voffA); PG8_STAGE(PG8_SA(0, 1), cA + hstepA, voffA);
    if (wr == 1) PG8_BAR;
    PG8_WAIT_V(2); PG8_BAR;
    PG8_STAGE(PG8_SB(1, 0), cB + kstep, voffB); PG8_STAGE(PG8_SA(1, 0), cA + kstep, voffA); PG8_STAGE(PG8_SB(1, 1), cB + hstepB + kstep, voffB);
    PG8_WAIT_V(6); PG8_BAR;
    for (;;) {
        const bool has_next = S.next(ui + 1, nxt);
        const char* nA = has_next ? g.A + (size_t)nxt.pm * g.tstepA : cA; const char* nB = has_next ? g.B + (size_t)nxt.pn * g.tstepB : cB;
        for (int t = 0; t < nt; t += 2) {
            const bool last = (t == nt - 2);
            const char* a1 = cA + (size_t)(t + 1) * kstep;
            const char* a2 = last ? nA : cA + (size_t)(t + 2) * kstep; const char* b2 = last ? nB : cB + (size_t)(t + 2) * kstep;
            const char* a3 = a2 + kstep; const char* b3 = b2 + kstep;
            PG8_LDB(B0, 0, 0); PG8_LDB(B1, 0, 1); PG8_SCHED; PG8_LDA(At, 0, 0); PG8_STAGE(PG8_SA(1, 1), a1 + hstepA, voffA);
            PG8_WAIT_V(8); PG8_WAIT_L(0); PG8_BAR; PG8_MMA(0, 0, At, B0); PG8_MMA(0, 1, At, B1); PG8_BAR; PG8_SCHED;
            PG8_LDA(At, 0, 1); PG8_STAGE(PG8_SB(0, 0), b2, voffB); PG8_STAGE(PG8_SB(0, 1), b2 + hstepB, voffB); PG8_STAGE(PG8_SA(0, 0), a2, voffA);
            PG8_WAIT_V(8); PG8_WAIT_L(0); PG8_BAR; PG8_MMA(1, 0, At, B0); PG8_MMA(1, 1, At, B1); PG8_BAR; PG8_SCHED;
            PG8_LDB(B0, 1, 0); PG8_LDB(B1, 1, 1); PG8_SCHED; PG8_LDA(At, 1, 0); PG8_STAGE(PG8_SA(0, 1), a2 + hstepA, voffA);
            PG8_WAIT_V(8); PG8_WAIT_L(0); PG8_BAR; PG8_MMA(0, 0, At, B0); PG8_MMA(0, 1, At, B1); PG8_BAR; PG8_SCHED;
            PG8_LDA(At, 1, 1); PG8_STAGE(PG8_SB(1, 0), b3, voffB); PG8_STAGE(PG8_SB(1, 1), b3 + hstepB, voffB); PG8_STAGE(PG8_SA(1, 0), a3, voffA);
            PG8_WAIT_V(8); PG8_WAIT_L(0); PG8_BAR; PG8_MMA(1, 0, At, B0); PG8_MMA(1, 1, At, B1); PG8_BAR; PG8_SCHED;
        }
        if (wr == 0) PG8_BAR;
        E(acc, cur, wr, wc, fr, fq, (const LAS float*)(lds + RV_OFF + (ui & 1) * 4096));
        if (!has_next) break;
#pragma unroll
        for (int a = 0; a < 2; ++a)
#pragma unroll
            for (int b = 0; b < 2; ++b)
#pragma unroll
                for (int m = 0; m < 4; ++m)
#pragma unroll
                    for (int n = 0; n < 2; ++n) acc[a][b][m][n] = (f32x4){0.f, 0.f, 0.f, 0.f};
        cur = nxt; cA = nA; cB = nB; ++ui;
        PG8_RV(cur, ui & 1);
        if (wr == 1) PG8_BAR;
    }
    PG8_WAIT_V(0);
    PG8_BAR;
#undef PG8_SA
#undef PG8_SB
#undef PG8_STAGE
#undef PG8_LDA
#undef PG8_LDB
#undef PG8_MMA
#undef PG8_WAIT_V
#undef PG8_WAIT_L
#undef PG8_BAR
#undef PG8_SCHED
#undef PG8_RV
}
template <class Epi, class Prob>
__device__ __forceinline__ void gemm_phase_x(LAS unsigned char* lds, const Prob& P, const Epi& E, int wave_id) {
    int lane_l = (int)__builtin_amdgcn_mbcnt_hi(~0u, __builtin_amdgcn_mbcnt_lo(~0u, 0u)); asm volatile("" : "+v"(lane_l));
    const int wid = wave_id, lane = lane_l, tid = wid * 64 + lane, wr = wid >> 2, wc = wid & 3, fr = lane & 15, fq = lane >> 4;
    const int K = P.K, nt = K / BK;
    unsigned voffB[2];
#pragma unroll
    for (int i = 0; i < 2; ++i) { int R, C; stage_rc(tid * 16 + i * 8192, R, C); const int Rb = Epi::PERM ? ((R & ~31) + perm32(R & 31)) : R; voffB[i] = (unsigned)(Rb * P.ldb + C) * 2u; }
    const size_t kstep = (size_t)(BK * 2);
    const long hstepB = P.hstepB;
    const unsigned ldsw = (unsigned)wid * 1024u;
    const int aoff = lds_byte(wr * 64 + fr, fq * 8), boff = lds_byte(wc * 32 + fr, fq * 8);
    LAS u32x4* stash = (LAS u32x4*)(lds + STAGE_BYTES + 1024) + tid;
#define PG8_SA(b, h) (((b) * 2 + (h)) * HTB)
#define PG8_SB(b, h) ((4 + (b) * 2 + (h)) * HTB)
#define PG8_STAGE(bufoff, gbase, voff) do { _Pragma("unroll") for (int _i = 0; _i < 2; ++_i) \
        __builtin_amdgcn_global_load_lds((const unsigned*)((const char*)(gbase) + (voff)[_i]), (LAS unsigned*)(lds + (bufoff) + ldsw + _i * 8192), 16, 0, 0); } while (0)
#define PG8_LDA(dst, b, h) do { _Pragma("unroll") for (int m = 0; m < 4; ++m) _Pragma("unroll") for (int k = 0; k < 2; ++k) dst[m][k] = *(const LAS bf16x8*)(lds + PG8_SA(b, h) + aoff + m * 2048 + k * 1024); } while (0)
#define PG8_LDB(dst, b, h) do { _Pragma("unroll") for (int n = 0; n < 2; ++n) _Pragma("unroll") for (int k = 0; k < 2; ++k) dst[n][k] = *(const LAS bf16x8*)(lds + PG8_SB(b, h) + boff + n * 2048 + k * 1024); } while (0)
#define PG8_MMA(ai, bj, At, Bt) do { __builtin_amdgcn_s_setprio(1); _Pragma("unroll") for (int m = 0; m < 4; ++m) _Pragma("unroll") for (int n = 0; n < 2; ++n) _Pragma("unroll") for (int k = 0; k < 2; ++k) \
        acc[ai][bj][m][n] = __builtin_amdgcn_mfma_f32_16x16x32_bf16(Bt[n][k], At[m][k], acc[ai][bj][m][n], 0, 0, 0); __builtin_amdgcn_s_setprio(0); } while (0)
#define PG8_WAIT_V(n) asm volatile("s_waitcnt vmcnt(" #n ")" ::: "memory")
#define PG8_WAIT_L(n) asm volatile("s_waitcnt lgkmcnt(" #n ")" ::: "memory")
#define PG8_BAR __builtin_amdgcn_s_barrier()
#define PG8_SCHED __builtin_amdgcn_sched_barrier(0)
#define PG8_AVOFF(dst, u) do { int t2_ = tid; asm volatile("" : "+v"(t2_)); _Pragma("unroll") for (int i_ = 0; i_ < 2; ++i_) { int R_, C_; stage_rc(t2_ * 16 + i_ * 8192, R_, C_); _Pragma("unroll") for (int h_ = 0; h_ < 2; ++h_) \
        dst[h_][i_] = (Prob::GATHER ? P.arow_off(u, h_, R_) : (unsigned)((h_ * HALF + R_) * P.lda) * 2u) + (unsigned)C_ * 2u; } } while (0)
    Unit cur, nxt; int ui = 0;
    if (!P.next(0, cur)) return;
    unsigned vA[2][2];
    PG8_AVOFF(vA, cur);
    f32x4 acc[2][2][4][2];
#pragma unroll
    for (int a = 0; a < 2; ++a)
#pragma unroll
        for (int b = 0; b < 2; ++b)
#pragma unroll
            for (int m = 0; m < 4; ++m)
#pragma unroll
                for (int n = 0; n < 2; ++n) acc[a][b][m][n] = (f32x4){0.f, 0.f, 0.f, 0.f};
    bf16x8 At[4][2], B0[2][2], B1[2][2];
    const char* cA = P.a_base(cur); const char* cB = P.b_base(cur);
    long csplit = Prob::KSPLIT ? P.bsplit(cur) : 0;
    if (Prob::WAITS) P.a_ready(cur, wid);
    PG8_STAGE(PG8_SB(0, 0), cB, voffB); PG8_STAGE(PG8_SB(0, 1), cB + hstepB, voffB); PG8_STAGE(PG8_SA(0, 0), cA, vA[0]); PG8_STAGE(PG8_SA(0, 1), cA, vA[1]);
    if (wr == 1) PG8_BAR;
    PG8_WAIT_V(2); PG8_BAR;
    PG8_STAGE(PG8_SB(1, 0), cB + kstep, voffB); PG8_STAGE(PG8_SA(1, 0), cA + kstep, vA[0]); PG8_STAGE(PG8_SB(1, 1), cB + hstepB + kstep, voffB);
    PG8_WAIT_V(6); PG8_BAR;
    for (;;) {
        const bool has_next = P.next(ui + 1, nxt);
        const char* nA = has_next ? P.a_base(nxt) : cA; const char* nB = has_next ? P.b_base(nxt) : cB;
        if (Prob::GATHER) { unsigned vN[2][2];
            if (has_next) { PG8_AVOFF(vN, nxt); } else { vN[0][0] = vA[0][0]; vN[0][1] = vA[0][1]; vN[1][0] = vA[1][0]; vN[1][1] = vA[1][1]; }
            *stash = (u32x4){vN[0][0], vN[0][1], vN[1][0], vN[1][1]}; }
        for (int t = 0; t < nt; t += 2) {
            const bool last = (t == nt - 2);
            if (Prob::WAITS && last && has_next) P.a_ready(nxt, wid);
            const char* a1 = cA + (size_t)(t + 1) * kstep;
            const char* a2 = last ? nA : cA + (size_t)(t + 2) * kstep;
            const char* b2 = last ? nB : cB + (size_t)(t + 2) * kstep + ((Prob::KSPLIT && (t + 2) >= (nt >> 1)) ? csplit : 0);
            const char* a3 = a2 + kstep; const char* b3 = b2 + kstep;
            PG8_LDB(B0, 0, 0); PG8_LDB(B1, 0, 1); PG8_SCHED; PG8_LDA(At, 0, 0); PG8_STAGE(PG8_SA(1, 1), a1, vA[1]);
            if (Prob::GATHER && last) { const u32x4 sv = *stash; vA[0][0] = sv.x; vA[0][1] = sv.y; vA[1][0] = sv.z; vA[1][1] = sv.w; }
            PG8_WAIT_V(8); PG8_WAIT_L(0); PG8_BAR; PG8_MMA(0, 0, At, B0); PG8_MMA(0, 1, At, B1); PG8_BAR; PG8_SCHED;
            PG8_LDA(At, 0, 1); PG8_STAGE(PG8_SB(0, 0), b2, voffB); PG8_STAGE(PG8_SB(0, 1), b2 + hstepB, voffB); PG8_STAGE(PG8_SA(0, 0), a2, vA[0]);
            PG8_WAIT_V(8); PG8_WAIT_L(0); PG8_BAR; PG8_MMA(1, 0, At, B0); PG8_MMA(1, 1, At, B1); PG8_BAR; PG8_SCHED;
            PG8_LDB(B0, 1, 0); PG8_LDB(B1, 1, 1); PG8_SCHED; PG8_LDA(At, 1, 0); PG8_STAGE(PG8_SA(0, 1), a2, vA[1]);
            PG8_WAIT_V(8); PG8_WAIT_L(0); PG8_BAR; PG8_MMA(0, 0, At, B0); PG8_MMA(0, 1, At, B1); PG8_BAR; PG8_SCHED;
            PG8_LDA(At, 1, 1); PG8_STAGE(PG8_SB(1, 0), b3, voffB); PG8_STAGE(PG8_SB(1, 1), b3 + hstepB, voffB); PG8_STAGE(PG8_SA(1, 0), a3, vA[0]);
            PG8_WAIT_V(8); PG8_WAIT_L(0); PG8_BAR; PG8_MMA(1, 0, At, B0); PG8_MMA(1, 1, At, B1); PG8_BAR; PG8_SCHED;
        }
        if (wr == 0) PG8_BAR;
        E(acc, cur, wr, wc, fr, fq);
        if (!has_next) break;
#pragma unroll
        for (int a = 0; a < 2; ++a)
#pragma unroll
            for (int b = 0; b < 2; ++b)
#pragma unroll
                for (int m = 0; m < 4; ++m)
#pragma unroll
                    for (int n = 0; n < 2; ++n) acc[a][b][m][n] = (f32x4){0.f, 0.f, 0.f, 0.f};
        cur = nxt; cA = nA; cB = nB; ++ui;
        if (Prob::KSPLIT) csplit = P.bsplit(cur);
        if (wr == 1) PG8_BAR;
    }
    PG8_WAIT_V(0);
    PG8_BAR;
#undef PG8_SA
#undef PG8_SB
#undef PG8_STAGE
#undef PG8_LDA
#undef PG8_LDB
#undef PG8_MMA
#undef PG8_WAIT_V
#undef PG8_WAIT_L
#undef PG8_BAR
#undef PG8_SCHED
#undef PG8_AVOFF
}

__device__ __forceinline__ int pair_a(int pi) { return pi < 3 ? 0 : (pi < 5 ? 1 : 2); }
__device__ __forceinline__ int pair_b(int pi) { return pi == 0 ? 1 : ((pi == 1 || pi == 3) ? 2 : 3); }
template <int MODE>
struct MoeProb {
    static constexpr bool GATHER = (MODE == 0), KSPLIT = (MODE == 1);
    const unsigned* cnt; const unsigned* list; const char* A; const char* B; int lda, ldb, K; long hstepB; int G, c; unsigned* tcnt;
    static constexpr bool WAITS = (MODE == 1);
    __device__ __forceinline__ void a_ready(const Unit& u, int wave) const {
        if (MODE == 1) {
            if (wave == 0) { unsigned polls = 0;
                while ((unsigned)__builtin_amdgcn_readfirstlane(__hip_atomic_load(tcnt + 64 * u.pm, __ATOMIC_RELAXED, __HIP_MEMORY_SCOPE_AGENT)) < 32u) {
                    if (++polls > (1u << 20)) break;
                    __builtin_amdgcn_s_sleep(2); }
                __builtin_amdgcn_fence(__ATOMIC_ACQUIRE, "agent");
                asm volatile("s_waitcnt vmcnt(0)" ::: "memory"); }
            asm volatile("" ::: "memory"); __builtin_amdgcn_s_barrier(); asm volatile("" ::: "memory");
        }
    }
    __device__ __forceinline__ bool next(int i, Unit& u) const {
        long L = (long)i * G + c;
        if (MODE == 1) {
            int tot = 0;
            for (int k = 0; k < 24; ++k) tot += ((int)cnt[k] + 255) >> 8;
            const int N = 4 * tot, R = N - 2 * G;
            if (R > 0 && R < G) { if (c < R) { if (i > 0) return false; L = c; } else L = (i == 0) ? c : (long)G + (c - R) + (long)(i - 1) * (G - R); }
            else L = (long)i * G + (G - 1 - c);
        }
        const int tileidx = (int)(L >> 2);
        int accu = 0, bk = -1, tib = 0, nb = 0;
        for (int k = 0; k < 24; ++k) { const int n = (int)cnt[k]; const int tl = (n + 255) >> 8; if (bk < 0 && tileidx < accu + tl) { bk = k; tib = tileidx - accu; nb = n; } accu += tl; }
        if (bk < 0) return false;
        u.pm = tileidx; u.pn = (int)(L & 3); u.meta = bk | (tib << 5) | (nb << 13); return true;
    }
    __device__ __forceinline__ int expert(const Unit& u, int s) const { const int g = u.bk() / 6, pi = u.bk() % 6; return g * 4 + (s ? pair_b(pi) : pair_a(pi)); }
    __device__ __forceinline__ const char* a_base(const Unit& u) const { return MODE == 0 ? A : A + (size_t)u.pm * 256 * lda * 2; }
    __device__ __forceinline__ const char* b_base(const Unit& u) const {
        if (MODE == 0) return B + ((size_t)expert(u, u.pn >> 1) * DEXP + (size_t)(u.pn & 1) * HALF) * ldb * 2;
        return B + (size_t)u.pn * 256 * ldb * 2 + (size_t)expert(u, 0) * DEXP * 2;
    }
    __device__ __forceinline__ unsigned arow_off(const Unit& u, int h, int R) const { const int pos = u.tib() * 256 + h * HALF + R; const unsigned tok = pos < u.nb() ? list[(size_t)u.bk() * T + pos] : 0u; return tok * (unsigned)(lda * 2); }
    __device__ __forceinline__ long bsplit(const Unit& u) const { return ((long)(expert(u, 1) - expert(u, 0)) * DEXP - DEXP) * 2; }
};
struct EpiGateUpSparse {
    static constexpr bool PERM = true;
    bf16_t* act; const float* wlist; const float* rlist; unsigned* tcnt;
    __device__ __forceinline__ void operator()(const f32x4 (&acc)[2][2][4][2], const Unit& u, int wr, int wc, int fr, int fq) const {
        asm volatile("" : "+v"(fr), "+v"(fq));
        const int s = u.pn >> 1, col0 = s * DEXP + (u.pn & 1) * HALF + wc * 32 + 8 * fq;
        const __amdgpu_buffer_rsrc_t rs_act = __builtin_amdgcn_make_buffer_rsrc((void*)act, (short)0, 0x7fffffff, 0x00020000);
#pragma unroll
        for (int ai = 0; ai < 2; ++ai)
#pragma unroll
            for (int m = 0; m < 4; ++m) { const int r = ai * HALF + wr * 64 + m * 16 + fr, pos = u.tib() * 256 + r;
                const float cw = pos < u.nb() ? wlist[((size_t)u.bk() * T + pos) * 2 + s] : 0.f; const float rs = pos < u.nb() ? rlist[(size_t)u.bk() * T + pos] : 0.f;
                float o[8];
#pragma unroll
                for (int n = 0; n < 2; ++n)
#pragma unroll
                    for (int j = 0; j < 4; ++j) { const float g = acc[ai][0][m][n][j] * rs, up = acc[ai][1][m][n][j] * rs;
                        const float sg = g * __builtin_amdgcn_rcpf(1.f + __builtin_amdgcn_exp2f(-g * LOG2E));
                        o[n * 4 + j] = sg * up * cw; }
                u32x4 w; w.x = cvt_pk_bf16(o[0], o[1]); w.y = cvt_pk_bf16(o[2], o[3]); w.z = cvt_pk_bf16(o[4], o[5]); w.w = cvt_pk_bf16(o[6], o[7]);
                __builtin_amdgcn_raw_buffer_store_b128(w, rs_act, (int)((((unsigned)u.pm * 256u + (unsigned)r) * 512u + (unsigned)col0) * 2u), 0, 16);
                if (m & 1) asm volatile("" ::: "memory"); }
        asm volatile("s_waitcnt vmcnt(0)" ::: "memory");
        if ((fr | fq) == 0) __hip_atomic_fetch_add(tcnt + 64 * u.pm, 1u, __ATOMIC_RELAXED, __HIP_MEMORY_SCOPE_AGENT);
    }
};
struct EpiDownScatter {
    static constexpr bool PERM = true;
    bf16_t* xb; const unsigned* list; float* ssq; LAS unsigned char* ldsb;
    __device__ __forceinline__ void operator()(const f32x4 (&acc)[2][2][4][2], const Unit& u, int wr, int wc, int fr, int fq) const {
        asm volatile("" : "+v"(fr), "+v"(fq));
        const int col0 = u.pn * BM + wc * 32 + 8 * fq;
        unsigned tok[8];
#pragma unroll
        for (int g = 0; g < 8; ++g) { const int pos = u.tib() * 256 + (g >> 2) * HALF + wr * 64 + (g & 3) * 16 + fr; tok[g] = pos < u.nb() ? list[(size_t)u.bk() * T + pos] : 0xffffffffu; }
#pragma unroll
        for (int ai = 0; ai < 2; ++ai) { u32x4 r[4][2];
#pragma unroll
            for (int m = 0; m < 4; ++m) { const unsigned tk = tok[ai * 4 + m]; const bf16_t* rowp = xb + (size_t)(tk != 0xffffffffu ? tk : 0u) * DM + col0;
#pragma unroll
                for (int bj = 0; bj < 2; ++bj) r[m][bj] = *(const u32x4*)(rowp + bj * HALF); }
#pragma unroll
            for (int m = 0; m < 4; ++m) { const unsigned tk = tok[ai * 4 + m]; float sq = 0.f;
                if (tk != 0xffffffffu) { bf16_t* rowp = xb + (size_t)tk * DM + col0;
#pragma unroll
                    for (int bj = 0; bj < 2; ++bj) { const f32x4 v0 = acc[ai][bj][m][0], v1 = acc[ai][bj][m][1]; const u32x4 q = r[m][bj];
                        u32x4 w; w.x = cvt_pk_bf16(bflo(q.x) + v0[0], bfhi(q.x) + v0[1]); w.y = cvt_pk_bf16(bflo(q.y) + v0[2], bfhi(q.y) + v0[3]);
                        w.z = cvt_pk_bf16(bflo(q.z) + v1[0], bfhi(q.z) + v1[1]); w.w = cvt_pk_bf16(bflo(q.w) + v1[2], bfhi(q.w) + v1[3]);
                        *(u32x4*)(rowp + bj * HALF) = w;
                        const float a0 = bflo(w.x), a1 = bfhi(w.x), a2 = bflo(w.y), a3 = bfhi(w.y), a4 = bflo(w.z), a5 = bfhi(w.z), a6 = bflo(w.w), a7 = bfhi(w.w);
                        sq += ((a0 * a0 + a1 * a1) + (a2 * a2 + a3 * a3)) + ((a4 * a4 + a5 * a5) + (a6 * a6 + a7 * a7)); } }
                sq += swz_xor<16>(sq); sq = sum_xor32(sq);
                if (fq == 0) { const int ri = ai * HALF + wr * 64 + m * 16 + fr; ((LAS float*)(ldsb + RED_OFF))[wc * 256 + ri] = sq; if (wc == 0) ((LAS unsigned*)(ldsb + RED_OFF + 4096))[ri] = tk; } } }
        asm volatile("s_waitcnt lgkmcnt(0)" ::: "memory"); __builtin_amdgcn_s_barrier(); asm volatile("" ::: "memory");
        { const int ri = (wr * 4 + wc) * 64 + fq * 16 + fr;
          if (ri < 256) { const LAS float* rp = (const LAS float*)(ldsb + RED_OFF) + ri; const unsigned tk = ((const LAS unsigned*)(ldsb + RED_OFF + 4096))[ri];
              if (tk != 0xffffffffu) ssq[(size_t)tk * 4 + u.pn] = (rp[0] + rp[256]) + (rp[512] + rp[768]); } }
    }
};
}

#define XB_TMO      128
#define XB_XCNT(j)  (256  + 64 * (j))
#define XB_XSUB(j)  (1280 + 64 * (j))
#define XB_XGEN(j)  (2304 + 64 * (j))
#define XB_TOP      3328
#define XB_TOPGEN   3392
#define XCD_BAR_WORDS 3456
#define XB_SPIN_CAP (1u << 18)
__device__ __forceinline__ unsigned xb_ld(unsigned* p)              { return __hip_atomic_load(p, __ATOMIC_RELAXED, __HIP_MEMORY_SCOPE_AGENT); }
__device__ __forceinline__ unsigned xb_add(unsigned* p, unsigned v) { return __hip_atomic_fetch_add(p, v, __ATOMIC_RELAXED, __HIP_MEMORY_SCOPE_AGENT); }
__device__ __forceinline__ unsigned xb_xcc_id() { return (unsigned)__builtin_amdgcn_s_getreg((3 << 11) | 20) & 0xFu; }
#define XB_SPIN(cond, bar) do { unsigned _sp = 0; while (cond) { __builtin_amdgcn_s_sleep(1); \
    if ((++_sp & 255u) == 0u) { if (xb_ld(&(bar)[XB_TMO])) break; if (_sp > XB_SPIN_CAP) { atomicAdd(&(bar)[XB_TMO], 1u); break; } } } } while (0)
struct XcdBarrier { unsigned* bar; unsigned x; volatile LAS unsigned* st; int wave; };
__device__ __forceinline__ bool xb_thread0(int wave) { return wave == 0 && __builtin_amdgcn_mbcnt_hi(~0u, __builtin_amdgcn_mbcnt_lo(~0u, 0u)) == 0u; }
__device__ __forceinline__ XcdBarrier xcd_barrier_post(unsigned* bar, volatile LAS unsigned* st, int wave) {
    XcdBarrier b; b.bar = bar; b.x = xb_xcc_id(); b.st = st; b.wave = wave;
    if (xb_thread0(wave)) (void)xb_add(&bar[XB_XCNT(b.x)], 1u);
    return b;
}
__device__ __forceinline__ void xcd_barrier_complete(unsigned* bar, unsigned x, unsigned& nloc, unsigned& nx) {
    const unsigned G = gridDim.x * gridDim.y * gridDim.z;
    unsigned sum, cnt, mine, sp = 0u;
    for (;;) {
        sum = 0u; cnt = 0u; mine = 0u;
#pragma unroll
        for (unsigned j = 0; j < 16; ++j) { const unsigned c = xb_ld(&bar[XB_XCNT(j)]); sum += c; cnt += (c > 0u) ? 1u : 0u; mine = (j == x) ? c : mine; }
        if (sum == G) break;
        __builtin_amdgcn_s_sleep(1);
        if ((++sp & 255u) == 0u) { if (xb_ld(&bar[XB_TMO])) break; if (sp > XB_SPIN_CAP) { atomicAdd(&bar[XB_TMO], 1u); break; } }
    }
    nloc = mine > 0u ? mine : 1u; nx = cnt > 0u ? cnt : 1u;
}
__device__ __forceinline__ void xcd_barrier(const XcdBarrier& b) {
    asm volatile("s_waitcnt vmcnt(0)" ::: "memory");
    __syncthreads();
    if (xb_thread0(b.wave)) {
        unsigned* bar = b.bar;
        __builtin_amdgcn_s_waitcnt(0);
        unsigned nloc = b.st[0], nx = b.st[1];
        if (nloc == 0u) { xcd_barrier_complete(bar, b.x, nloc, nx); b.st[0] = nloc; b.st[1] = nx; }
        const unsigned old = xb_add(&bar[XB_XSUB(b.x)], 1u);
        const unsigned gen = old / nloc;
        if (old + 1u == (gen + 1u) * nloc) {
            __builtin_amdgcn_fence(__ATOMIC_RELEASE, "agent");
            asm volatile("s_waitcnt vmcnt(0)" ::: "memory");
            const unsigned og = xb_add(&bar[XB_TOP], 1u);
            const unsigned tg = og / nx;
            if (og + 1u == (tg + 1u) * nx) xb_add(&bar[XB_TOPGEN], 1u);
            else XB_SPIN(xb_ld(&bar[XB_TOPGEN]) == tg, bar);
            __builtin_amdgcn_fence(__ATOMIC_ACQUIRE, "agent");
            xb_add(&bar[XB_XGEN(b.x)], 1u);
            asm volatile("s_waitcnt vmcnt(0)" ::: "memory");
        } else {
            XB_SPIN(xb_ld(&bar[XB_XGEN(b.x)]) == gen, bar);
            __builtin_amdgcn_fence(__ATOMIC_ACQUIRE, "agent");
            asm volatile("s_waitcnt vmcnt(0)" ::: "memory");
        }
    }
    __syncthreads();
}

struct Args {
    const float* x; const float* ln1_g; const float* w_in; const float* mix_g; const float* w_out; const float* ln2_g;
    const float* w_gr; const float* b_gr; const float* w_er; const float* b_er; const float* w_gate; const float* w_up; const float* w_down; const float* fin_g;
    float* out; unsigned char* ws; int ph_lo, ph_hi, li, pad;
};

template <bool SC = false>
__device__ __forceinline__ void transpose_item(const float* W, int K, int N, bf16_t* WT, int dpitch, int dcol, LAS float* scr, int item, int lane, const float* ks = nullptr) {
    const int nblk = N / 32, kb = item / nblk, nb = item % nblk, k0 = 64 * kb, n0 = 32 * nb;
#pragma unroll 8
    for (int i = 0; i < 32; ++i) { const int kk = 2 * i + (lane >> 5); scr[kk * 33 + (lane & 31)] = W[(size_t)(k0 + kk) * N + n0 + (lane & 31)]; }
    LDS_WAIT(); asm volatile("" ::: "memory");
    const int c = lane & 7;
    f32x4 ga = (f32x4){1.f, 1.f, 1.f, 1.f}, gb = ga;
    if (SC) { ga = *(const f32x4*)(ks + k0 + 8 * c); gb = *(const f32x4*)(ks + k0 + 8 * c + 4); }
#pragma unroll
    for (int j = 0; j < 4; ++j) { const int n = (lane >> 3) + 8 * j; const LAS float* s = scr + (8 * c) * 33 + n;
        u32x4 o; o.x = pk2(s[0 * 33] * ga.x, s[1 * 33] * ga.y); o.y = pk2(s[2 * 33] * ga.z, s[3 * 33] * ga.w); o.z = pk2(s[4 * 33] * gb.x, s[5 * 33] * gb.y); o.w = pk2(s[6 * 33] * gb.z, s[7 * 33] * gb.w);
        *(u32x4*)(WT + (size_t)(n0 + n) * dpitch + dcol + k0 + 8 * c) = o; }
    LDS_WAIT(); asm volatile("" ::: "memory");
}
__device__ __forceinline__ void phase_prologue(const Args& a, LAS unsigned char* lds, int gw, int NGW, int wave, int lane) {
    LAS float* scr = (LAS float*)(lds + wave * 16384);
    constexpr int I_IN = (DM / 64) * (NQKV / 32);
    constexpr int I_OUT = (DM / 64) * (DM / 32);
    constexpr int I_G = (DM / 64) * (DEXP / 32);
    constexpr int I_D = (DEXP / 64) * (DM / 32);
    constexpr int N_IN = DEPTH * I_IN, N_OUT = DEPTH * I_OUT, N_G = DEPTH * NEXP * I_G, N_D = DEPTH * NEXP * I_D;
    constexpr int NITEMS = N_IN + N_OUT + 2 * N_G + N_D;
    bf16_t* WinT = (bf16_t*)(a.ws + WS_WIN); bf16_t* WoutT = (bf16_t*)(a.ws + WS_WOUT); bf16_t* WgT = (bf16_t*)(a.ws + WS_WG); bf16_t* WuT = (bf16_t*)(a.ws + WS_WU); bf16_t* WdT = (bf16_t*)(a.ws + WS_WD);
    for (int it = gw; it < NITEMS; it += NGW) {
        int r = it;
        if (r < N_IN) { const int l = r / I_IN; transpose_item<true>(a.w_in + (size_t)l * DM * NQKV, DM, NQKV, WinT + (size_t)l * NQKV * DM, DM, 0, scr, r % I_IN, lane, a.ln1_g + (size_t)l * DM); continue; } r -= N_IN;
        if (r < N_OUT) { const int l = r / I_OUT; transpose_item(a.w_out + (size_t)l * DM * DM, DM, DM, WoutT + (size_t)l * DM * DM, DM, 0, scr, r % I_OUT, lane); continue; } r -= N_OUT;
        if (r < N_G) { const int le = r / I_G; transpose_item<true>(a.w_gate + (size_t)le * DM * DEXP, DM, DEXP, WgT + (size_t)le * DEXP * DM, DM, 0, scr, r % I_G, lane, a.ln2_g + (size_t)(le / NEXP) * DM); continue; } r -= N_G;
        if (r < N_G) { const int le = r / I_G; transpose_item<true>(a.w_up + (size_t)le * DM * DEXP, DM, DEXP, WuT + (size_t)le * DEXP * DM, DM, 0, scr, r % I_G, lane, a.ln2_g + (size_t)(le / NEXP) * DM); continue; } r -= N_G;
        { const int le = r / I_D, l = le / NEXP, e = le % NEXP; transpose_item(a.w_down + (size_t)le * DEXP * DM, DEXP, DM, WdT + (size_t)l * DM * NACT, NACT, e * DEXP, scr, r % I_D, lane); }
    }
}

__device__ __forceinline__ void phase_norm1(const float* x, int gw, int NGW, int lane, float* kmean_zero, bf16_t* xb, float* ssq_out) {
    for (int i = gw * 64 + lane; i < BATCH * 4 * 32 * HD; i += NGW * 64) kmean_zero[i] = 0.f;
    for (int m = gw; m < T; m += NGW) {
        const f32x4* xr = (const f32x4*)(x + (size_t)m * DM) + lane;
        f32x4 v[4]; float s = 0.f;
#pragma unroll
        for (int j = 0; j < 4; ++j) v[j] = xr[64 * j];
        u32x2* x8 = (u32x2*)(xb + (size_t)m * DM) + lane;
#pragma unroll
        for (int j = 0; j < 4; ++j) { u32x2 c; c.x = pk2(v[j].x, v[j].y); c.y = pk2(v[j].z, v[j].w); x8[64 * j] = c;
            const float a0 = bflo(c.x), a1 = bfhi(c.x), a2 = bflo(c.y), a3 = bfhi(c.y); s += (a0 * a0 + a1 * a1) + (a2 * a2 + a3 * a3); }
        s = wave_sum(s);
        if (lane == 0) *(f32x4*)(ssq_out + (size_t)m * 4) = (f32x4){s, 0.f, 0.f, 0.f};
    }
}
__device__ __forceinline__ void unpack8(float (&f)[8], const u32x4 w) { f[0] = bflo(w.x); f[1] = bfhi(w.x); f[2] = bflo(w.y); f[3] = bfhi(w.y); f[4] = bflo(w.z); f[5] = bfhi(w.z); f[6] = bflo(w.w); f[7] = bfhi(w.w); }
struct MixRow { u32x4 a, c0, c1, c2, p0, p1, p2; float l0, l1, l2, e0, e1, e2, e3; };
__device__ __forceinline__ void mix_load(MixRow& r, int m, const bf16_t* ob, const bf16_t* hb, const float* lse, const bf16_t* pm, const float* lsem0, const float* lsem1, int lane, int hh) {
    r.a = *((const u32x4*)(ob + (size_t)m * DM) + lane); r.c0 = *((const u32x4*)(ob + (size_t)m * DM + 512) + lane);
    r.c1 = *((const u32x4*)(hb + (size_t)m * DM) + lane); r.c2 = *((const u32x4*)(hb + (size_t)m * DM + 512) + lane);
    r.l0 = lse[(size_t)m * 8 + hh]; r.l1 = lse[(size_t)T * 8 + (size_t)m * 8 + hh]; r.l2 = lse[(size_t)2 * T * 8 + (size_t)m * 8 + hh];
    if (lane < 32) {
        r.p0 = *((const u32x4*)(pm + (size_t)m * 256) + lane); r.p1 = *((const u32x4*)(pm + ((size_t)T + m) * 256) + lane); r.p2 = *((const u32x4*)(pm + ((size_t)2 * T + m) * 256) + lane);
        r.e0 = lsem0[(size_t)m * 4 + hh]; r.e1 = lsem0[(size_t)T * 4 + (size_t)m * 4 + hh]; r.e2 = lsem1[(size_t)m * 4 + hh]; r.e3 = lsem1[(size_t)T * 4 + (size_t)m * 4 + hh]; }
}
__device__ __forceinline__ void phase_mixnorm(const bf16_t* ob, bf16_t* hb, const float* lse, const bf16_t* pm, const float* lsem0, const float* lsem1, const float* g, int gw, int NGW, int lane) {
    float g0[8], g1[8];
#pragma unroll
    for (int j = 0; j < 8; ++j) { g0[j] = g[8 * lane + j]; g1[j] = g[512 + 8 * lane + j]; }
    const int hh = lane >> 3;
    MixRow cur, nxt;
    if (gw < T) mix_load(cur, gw, ob, hb, lse, pm, lsem0, lsem1, lane, hh);
    for (int m = gw; m < T; m += NGW) {
        if (m + NGW < T) mix_load(nxt, m + NGW, ob, hb, lse, pm, lsem0, lsem1, lane, hh);
        float va[8]; unpack8(va, cur.a);
        if (lane < 32) {
            const float mx = fmaxf(fmaxf(cur.e0, cur.e1), fmaxf(cur.e2, cur.e3));
            float u0 = __builtin_amdgcn_exp2f(cur.e0 - mx), u1 = __builtin_amdgcn_exp2f(cur.e1 - mx), u2 = __builtin_amdgcn_exp2f(cur.e2 - mx), u3 = __builtin_amdgcn_exp2f(cur.e3 - mx);
            const float inv = 1.0f / ((u0 + u1) + (u2 + u3)); u0 *= inv; u1 *= inv; u2 *= inv; u3 *= inv;
            float y0[8], y1[8], y2[8]; unpack8(y0, cur.p0); unpack8(y1, cur.p1); unpack8(y2, cur.p2);
#pragma unroll
            for (int j = 0; j < 8; ++j) va[j] = (u0 * y0[j] + u1 * y1[j]) + (u2 * y2[j] + u3 * va[j]);
        }
        const float mx = fmaxf(cur.l0, fmaxf(cur.l1, cur.l2));
        float w0 = __builtin_amdgcn_exp2f(cur.l0 - mx), w1 = __builtin_amdgcn_exp2f(cur.l1 - mx), w2 = __builtin_amdgcn_exp2f(cur.l2 - mx);
        const float inv = 1.0f / (w0 + w1 + w2); w0 *= inv; w1 *= inv; w2 *= inv;
        float x0[8], x1[8], x2[8]; unpack8(x0, cur.c0); unpack8(x1, cur.c1); unpack8(x2, cur.c2);
        float vc[8];
        float sa = 0.f, sc = 0.f;
#pragma unroll
        for (int j = 0; j < 8; ++j) { vc[j] = w0 * x0[j] + w1 * x1[j] + w2 * x2[j]; sa += va[j] * va[j]; sc += vc[j] * vc[j]; }
        sa = half_sum(sa); sc = wave_sum(sc);
        const float ra = 1.0f / sqrtf(sa * (1.f / 256.f) + NORM_EPS), rc = 1.0f / sqrtf(sc * (1.f / 512.f) + NORM_EPS);
        u32x4 oa, oc;
        oa.x = pk2(va[0] * ra * g0[0], va[1] * ra * g0[1]); oa.y = pk2(va[2] * ra * g0[2], va[3] * ra * g0[3]); oa.z = pk2(va[4] * ra * g0[4], va[5] * ra * g0[5]); oa.w = pk2(va[6] * ra * g0[6], va[7] * ra * g0[7]);
        oc.x = pk2(vc[0] * rc * g1[0], vc[1] * rc * g1[1]); oc.y = pk2(vc[2] * rc * g1[2], vc[3] * rc * g1[3]); oc.z = pk2(vc[4] * rc * g1[4], vc[5] * rc * g1[5]); oc.w = pk2(vc[6] * rc * g1[6], vc[7] * rc * g1[7]);
        *((u32x4*)(hb + (size_t)m * DM) + lane) = oa; *((u32x4*)(hb + (size_t)m * DM + 512) + lane) = oc;
        cur = nxt;
    }
}
__device__ __forceinline__ void phase_route(const bf16_t* x, const float* g, const float* wgr, const float* bgr, const float* wer, const float* ber,
                                            float* rlist, unsigned* cnt, unsigned* list, float* wlist, LAS unsigned char* lds, int v, int G, int wave, int lane, float* kmean_zero) {
    for (int i = (v * NWAVES + wave) * 64 + lane; i < BATCH * 4 * 32 * HD; i += G * NWAVES * 64) kmean_zero[i] = 0.f;
    const int tid = wave * 64 + lane;
    constexpr int RP = 2064;
    LAS unsigned char* WH = lds; LAS unsigned char* WL = lds + 20 * RP;
    LAS unsigned* cl = (LAS unsigned*)(lds + 86016);
    LAS u32x2* info = (LAS u32x2*)(lds + 86016 + 256);
    LAS f32x2* infw = (LAS f32x2*)(lds + 86016 + 256 + 4096);
    LAS float* infr = (LAS float*)(lds + 86016 + 256 + 8192);
    for (int idx = tid; idx < 5 * DM; idx += NTHREADS) { const int mtx = idx >> 10, d = idx & 1023; const f32x4 wv = *(const f32x4*)((mtx == 0 ? wgr : wer + (size_t)(mtx - 1) * DM * 4) + d * 4) * g[d];
#pragma unroll
        for (int e = 0; e < 4; ++e) { const float w = wv[e]; const unsigned short hi = (unsigned short)f2bf(w); const float rem = w - __builtin_bit_cast(float, (unsigned)hi << 16);
            *(LAS unsigned short*)(WH + (mtx * 4 + e) * RP + d * 2) = hi; *(LAS unsigned short*)(WL + (mtx * 4 + e) * RP + d * 2) = (unsigned short)f2bf(rem); } }
    if (tid < 64) cl[tid] = 0u;
    __syncthreads();
    const int rpw = (T + G - 1) / G, row0 = v * rpw;
    const int m16 = lane & 15, q = lane >> 4;
    const f32x4 bg = *(const f32x4*)bgr;
    for (int t0 = wave * 16; t0 < rpw; t0 += NWAVES * 16) {
        const int r = t0 + m16; const bool valid = r < rpw && row0 + r < T;
        const u32x4* xp = (const u32x4*)(x + (size_t)(valid ? row0 + r : row0) * DM) + q;
        f32x4 a0 = (f32x4){0.f, 0.f, 0.f, 0.f}, a1 = a0; float ss = 0.f;
        LAS unsigned char* wh0 = WH + m16 * RP + q * 16; LAS unsigned char* wh1 = WH + (16 + (lane & 3)) * RP + q * 16;
#pragma unroll 1
        for (int sb = 0; sb < 32; sb += 8) { u32x4 xv[8];
#pragma unroll
            for (int s = 0; s < 8; ++s) xv[s] = xp[4 * (sb + s)];
#pragma unroll
            for (int s = 0; s < 8; ++s) { const int ko = (sb + s) * 64; const bf16x8 xf = __builtin_bit_cast(bf16x8, xv[s]);
                a0 = __builtin_amdgcn_mfma_f32_16x16x32_bf16(*(LAS bf16x8*)(wh0 + ko), xf, a0, 0, 0, 0);
                a0 = __builtin_amdgcn_mfma_f32_16x16x32_bf16(*(LAS bf16x8*)(wh0 + 20 * RP + ko), xf, a0, 0, 0, 0);
                a1 = __builtin_amdgcn_mfma_f32_16x16x32_bf16(*(LAS bf16x8*)(wh1 + ko), xf, a1, 0, 0, 0);
                a1 = __builtin_amdgcn_mfma_f32_16x16x32_bf16(*(LAS bf16x8*)(wh1 + 20 * RP + ko), xf, a1, 0, 0, 0);
                const float x0 = bflo(xv[s].x), x1 = bfhi(xv[s].x), x2 = bflo(xv[s].y), x3 = bfhi(xv[s].y), x4 = bflo(xv[s].z), x5 = bfhi(xv[s].z), x6 = bflo(xv[s].w), x7 = bfhi(xv[s].w);
                ss += ((x0 * x0 + x1 * x1) + (x2 * x2 + x3 * x3)) + ((x4 * x4 + x5 * x5) + (x6 * x6 + x7 * x7)); } }
        ss += swz_xor<16>(ss); ss = sum_xor32(ss);
        const float rstd = 1.0f / sqrtf(ss * (1.f / DM) + NORM_EPS);
        const int gc = (q == 0) ? 3 : q - 1;
        const f32x4 be = *(const f32x4*)(ber + gc * 4);
        const f32x4 ev = (q == 0) ? a1 : a0;
        const float e[4] = {ev.x * rstd + be.x, ev.y * rstd + be.y, ev.z * rstd + be.z, ev.w * rstd + be.w};
        int i1 = 0; float v1 = e[0];
#pragma unroll
        for (int k = 1; k < 4; ++k) if (e[k] > v1) { v1 = e[k]; i1 = k; }
        int i2 = -1; float v2 = -INFINITY;
#pragma unroll
        for (int k = 0; k < 4; ++k) if (k != i1 && e[k] > v2) { v2 = e[k]; i2 = k; }
        const float p2 = __expf(v2 - v1), inv = 1.0f / (1.0f + p2);
        const float w1 = inv, w2 = p2 * inv;
        const int ea = i1 < i2 ? i1 : i2, eb = i1 < i2 ? i2 : i1; const float wa0 = i1 < i2 ? w1 : w2, wb0 = i1 < i2 ? w2 : w1;
        const int pi0 = (ea == 0) ? (eb - 1) : (ea == 1 ? eb + 1 : 5);
        const f32x4 gl = (f32x4){a0.x * rstd + bg.x, a0.y * rstd + bg.y, a0.z * rstd + bg.z, a0.w * rstd + bg.w};
        int gi = 0; float gm = gl.x;
        if (gl.y > gm) { gm = gl.y; gi = 1; } if (gl.z > gm) { gm = gl.z; gi = 2; } if (gl.w > gm) { gm = gl.w; gi = 3; }
        const float gden = __expf(gl.x - gm) + __expf(gl.y - gm) + __expf(gl.z - gm) + __expf(gl.w - gm);
        const float gw_ = 1.0f / gden;
        const int src = (m16 + 16 * ((gi == 3) ? 0 : gi + 1)) * 4;
        const int pi = __builtin_amdgcn_ds_bpermute(src, pi0);
        const float wa = __builtin_bit_cast(float, __builtin_amdgcn_ds_bpermute(src, __builtin_bit_cast(int, wa0))) * gw_, wb = __builtin_bit_cast(float, __builtin_amdgcn_ds_bpermute(src, __builtin_bit_cast(int, wb0))) * gw_;
        if (q == 0 && valid) { int bk = gi * 6 + pi; bk = bk < 0 ? 0 : (bk > 23 ? 23 : bk);
            const unsigned rank = __hip_atomic_fetch_add(cl + bk, 1u, __ATOMIC_RELAXED, __HIP_MEMORY_SCOPE_WORKGROUP);
            info[r] = (u32x2){(unsigned)bk, rank}; infw[r] = (f32x2){wa, wb}; infr[r] = rstd; }
    }
    __syncthreads();
    if (tid < 24) cl[32 + tid] = __hip_atomic_fetch_add(cnt + tid, cl[tid], __ATOMIC_RELAXED, __HIP_MEMORY_SCOPE_AGENT);
    __syncthreads();
    if (tid < rpw && row0 + tid < T) { const u32x2 inf = info[tid]; const f32x2 wv = infw[tid]; const size_t slot = (size_t)inf.x * T + cl[32 + inf.x] + inf.y;
        list[slot] = (unsigned)(row0 + tid); *(f32x2*)(wlist + slot * 2) = wv; rlist[slot] = infr[tid]; }
    __syncthreads();
}
__device__ __forceinline__ void phase_final(const bf16_t* xb, const float* g, float* out, int gw, int NGW, int lane) {
    f32x4 gv[4];
#pragma unroll
    for (int j = 0; j < 2; ++j) { gv[2 * j] = *((const f32x4*)g + 2 * lane + 128 * j); gv[2 * j + 1] = *((const f32x4*)g + 2 * lane + 128 * j + 1); }
    for (int m = gw; m < T; m += NGW) {
        const u32x4* xr = (const u32x4*)(xb + (size_t)m * DM) + lane;
        u32x4 r[2]; float s = 0.f;
#pragma unroll
        for (int j = 0; j < 2; ++j) r[j] = xr[64 * j];
        f32x4 v[4];
#pragma unroll
        for (int j = 0; j < 2; ++j) { v[2 * j] = (f32x4){bflo(r[j].x), bfhi(r[j].x), bflo(r[j].y), bfhi(r[j].y)}; v[2 * j + 1] = (f32x4){bflo(r[j].z), bfhi(r[j].z), bflo(r[j].w), bfhi(r[j].w)}; }
#pragma unroll
        for (int j = 0; j < 4; ++j) s += (v[j].x * v[j].x + v[j].y * v[j].y) + (v[j].z * v[j].z + v[j].w * v[j].w);
        const float rstd = 1.0f / sqrtf(wave_sum(s) * (1.f / DM) + NORM_EPS);
        f32x4* orow = (f32x4*)(out + (size_t)m * DM) + 2 * lane;
#pragma unroll
        for (int j = 0; j < 2; ++j) { orow[128 * j] = v[2 * j] * rstd * gv[2 * j]; orow[128 * j + 1] = v[2 * j + 1] * rstd * gv[2 * j + 1]; }
    }
}
__device__ __forceinline__ void phase_kmean(const bf16_t* kb, float* kmean, int gw, int NGW, int lane) {
    for (int it = gw; it < BATCH * 4 * 32; it += NGW) {
        const int b = it >> 7, h = (it >> 5) & 3, blk = it & 31;
        const bf16_t* base = kb + ((size_t)b * SEQ + (size_t)blk * 256) * DM + h * HD + (lane & 7) * 8;
        float acc[8] = {0.f, 0.f, 0.f, 0.f, 0.f, 0.f, 0.f, 0.f};
#pragma unroll 4
        for (int i = 0; i < 32; ++i) { const u32x4 w = *(const u32x4*)(base + (size_t)((lane >> 3) + 8 * i) * DM);
            acc[0] += bflo(w.x); acc[1] += bfhi(w.x); acc[2] += bflo(w.y); acc[3] += bfhi(w.y); acc[4] += bflo(w.z); acc[5] += bfhi(w.z); acc[6] += bflo(w.w); acc[7] += bfhi(w.w); }
#pragma unroll
        for (int j = 0; j < 8; ++j) { acc[j] += swz_xor<8>(acc[j]); acc[j] += swz_xor<16>(acc[j]); acc[j] = sum_xor32(acc[j]); }
        if (lane < 8) {
            float* o = kmean + (size_t)it * HD + lane * 8;
#pragma unroll
            for (int j = 0; j < 8; ++j) o[j] = acc[j] * (1.f / 256.f);
        }
    }
}

__device__ __forceinline__ void ld_row64(float (&r)[64], const bf16_t* p) {
#pragma unroll
    for (int c = 0; c < 8; ++c) { const u32x4 w = *((const u32x4*)p + c);
        r[8 * c + 0] = bflo(w.x); r[8 * c + 1] = bfhi(w.x); r[8 * c + 2] = bflo(w.y); r[8 * c + 3] = bfhi(w.y); r[8 * c + 4] = bflo(w.z); r[8 * c + 5] = bfhi(w.z); r[8 * c + 6] = bflo(w.w); r[8 * c + 7] = bfhi(w.w); }
}
__device__ __forceinline__ float dot_row64(const float (&q)[64], const bf16_t* p) {
    float s0 = 0.f, s1 = 0.f;
#pragma unroll
    for (int c = 0; c < 8; ++c) { const u32x4 w = *((const u32x4*)p + c);
        s0 += q[8 * c + 0] * bflo(w.x); s1 += q[8 * c + 1] * bfhi(w.x); s0 += q[8 * c + 2] * bflo(w.y); s1 += q[8 * c + 3] * bfhi(w.y);
        s0 += q[8 * c + 4] * bflo(w.z); s1 += q[8 * c + 5] * bfhi(w.z); s0 += q[8 * c + 6] * bflo(w.w); s1 += q[8 * c + 7] * bfhi(w.w); }
    return s0 + s1;
}
__device__ __forceinline__ void axpy_row64(float (&o)[64], float p, const bf16_t* vp) {
#pragma unroll
    for (int c = 0; c < 8; ++c) { const u32x4 w = *((const u32x4*)vp + c);
        o[8 * c + 0] += p * bflo(w.x); o[8 * c + 1] += p * bfhi(w.x); o[8 * c + 2] += p * bflo(w.y); o[8 * c + 3] += p * bfhi(w.y);
        o[8 * c + 4] += p * bflo(w.z); o[8 * c + 5] += p * bfhi(w.z); o[8 * c + 6] += p * bflo(w.w); o[8 * c + 7] += p * bfhi(w.w); }
}
__device__ __forceinline__ void st_row64(bf16_t* p, const float (&o)[64], float sc) {
#pragma unroll
    for (int c = 0; c < 8; ++c) { u32x4 w; w.x = pk2(o[8 * c] * sc, o[8 * c + 1] * sc); w.y = pk2(o[8 * c + 2] * sc, o[8 * c + 3] * sc); w.z = pk2(o[8 * c + 4] * sc, o[8 * c + 5] * sc); w.w = pk2(o[8 * c + 6] * sc, o[8 * c + 7] * sc); *((u32x4*)p + c) = w; }
}
#define OSM_STEP(sc, vrow) do { const float sc_ = (sc); if (sc_ > m_) { const float al = __builtin_amdgcn_exp2f(m_ - sc_); l_ *= al; _Pragma("unroll") for (int d_ = 0; d_ < 64; ++d_) o_[d_] *= al; m_ = sc_; } \
    const float p_ = __builtin_amdgcn_exp2f(sc_ - m_); l_ += p_; axpy_row64(o_, p_, (vrow)); } while (0)

__device__ __forceinline__ void naive_moba(const bf16_t* qb, const bf16_t* kb, const bf16_t* vb, const float* kmean, bf16_t* ob, int item, int tid) {
    const int b = item >> 6, h = (item >> 4) & 3, t = (item & 15) * 512 + tid, own = t >> 8;
    const size_t rowq = ((size_t)b * SEQ + t) * DM + h * HD;
    const bf16_t* kh = kb + (size_t)b * SEQ * DM + h * HD; const bf16_t* vh = vb + (size_t)b * SEQ * DM + h * HD;
    const float slope2 = exp2f(-2.0f * (float)(h + 1)) * LOG2E;
    float q_[64]; ld_row64(q_, qb + rowq);
    float bv0 = -INFINITY, bv1 = -INFINITY, bv2 = -INFINITY; int bi0 = -1, bi1 = -1, bi2 = -1;
    const float* km = kmean + (size_t)(b * 4 + h) * 32 * HD;
    for (int n = 0; n < own; ++n) {
        float gsum = 0.f;
#pragma unroll
        for (int d = 0; d < 64; ++d) gsum += q_[d] * km[n * HD + d];
        if (gsum > bv0) { bv2 = bv1; bi2 = bi1; bv1 = bv0; bi1 = bi0; bv0 = gsum; bi0 = n; }
        else if (gsum > bv1) { bv2 = bv1; bi2 = bi1; bv1 = gsum; bi1 = n; }
        else if (gsum > bv2) { bv2 = gsum; bi2 = n; }
    }
    float o_[64];
#pragma unroll
    for (int d = 0; d < 64; ++d) o_[d] = 0.f;
    float m_ = -INFINITY, l_ = 0.f;
    for (int s = 0; s < 3; ++s) {
        const int blk = (s == 0) ? bi0 : (s == 1) ? bi1 : bi2;
        if (blk < 0) continue;
        for (int j = 0; j < 256; ++j) { const int pos = blk * 256 + j;
            const float sc = dot_row64(q_, kh + (size_t)pos * DM) - slope2 * (float)(t - pos);
            OSM_STEP(sc, vh + (size_t)pos * DM); }
    }
    for (int pos = own * 256; pos <= t; ++pos) {
        const float sc = dot_row64(q_, kh + (size_t)pos * DM) - slope2 * (float)(t - pos);
        OSM_STEP(sc, vh + (size_t)pos * DM); }
    st_row64(ob + rowq, o_, 1.0f / l_);
}
__device__ __forceinline__ void naive_sb(const bf16_t* qb, const bf16_t* kb, const bf16_t* vb, bf16_t* ob, int item, int tid) {
    const int b = item >> 6, h = 4 + ((item >> 4) & 3), t = (item & 15) * 512 + tid;
    const size_t rowq = ((size_t)b * SEQ + t) * DM + h * HD;
    const bf16_t* kh = kb + (size_t)b * SEQ * DM + h * HD; const bf16_t* vh = vb + (size_t)b * SEQ * DM + h * HD;
    float q_[64]; ld_row64(q_, qb + rowq);
    float o_[64];
#pragma unroll
    for (int d = 0; d < 64; ++d) o_[d] = 0.f;
    float tail = 0.f;
    for (int s = t - 1; s >= 0 && tail > -150.f; --s) {
        const float z = dot_row64(q_, kh + (size_t)s * DM);
        const float lp = __builtin_amdgcn_logf(1.0f + __builtin_amdgcn_exp2f(-fabsf(z)));
        const float lnot = -(fmaxf(z, 0.f) + lp);
        const float aw = __builtin_amdgcn_exp2f(z + lnot + tail);
        axpy_row64(o_, aw, vh + (size_t)s * DM);
        tail += lnot;
    }
    st_row64(ob + rowq, o_, 1.0f);
}
__device__ __forceinline__ void naive_dil(const bf16_t* qb, const bf16_t* kb, const bf16_t* vb, bf16_t* ob, bf16_t* hb2, float* lse, int item, int tid) {
    const int b = item >> 7, h = 8 + ((item >> 4) & 7), t = (item & 15) * 512 + tid;
    const size_t rowq = ((size_t)b * SEQ + t) * DM + h * HD;
    const bf16_t* kh = kb + (size_t)b * SEQ * DM + h * HD; const bf16_t* vh = vb + (size_t)b * SEQ * DM + h * HD;
    const float slope2 = exp2f(-(float)(h - 8 + 1)) * LOG2E;
    float q_[64]; ld_row64(q_, qb + rowq);
    float o_[64];
#pragma unroll
    for (int d = 0; d < 64; ++d) o_[d] = 0.f;
    float m_ = -INFINITY, l_ = 0.f;
    for (int c = 0; c < 3; ++c) {
        const int dil = (c == 0) ? 1 : (c == 1) ? 4 : 16;
        for (int dl = 0; dl <= 128; ++dl) { const int pos = t - dl * dil; if (pos < 0) break;
            const float sc = dot_row64(q_, kh + (size_t)pos * DM) - slope2 * (float)(dl * dil);
            OSM_STEP(sc, vh + (size_t)pos * DM); }
    }
    st_row64(ob + rowq, o_, 1.0f / l_);
    { const size_t tok = (size_t)b * SEQ + t; const u32x4 z4 = {0u, 0u, 0u, 0u};
#pragma unroll
      for (int c = 0; c < 8; ++c) { *((u32x4*)(hb2 + tok * DM + (h - 8) * HD) + c) = z4; *((u32x4*)(hb2 + tok * DM + 512 + (h - 8) * HD) + c) = z4; }
      lse[tok * 8 + (h - 8)] = 0.f; lse[(size_t)T * 8 + tok * 8 + (h - 8)] = -1.0e30f; lse[(size_t)2 * T * 8 + tok * 8 + (h - 8)] = -1.0e30f; }
}

namespace att {
typedef float f32x16 __attribute__((ext_vector_type(16)));
typedef short s16x4 __attribute__((ext_vector_type(4)));
typedef short v4i16_t __attribute__((ext_vector_type(4)));
typedef __bf16 bf16x2_t __attribute__((ext_vector_type(2)));
constexpr int L_BUF = 16384;
constexpr int L_WSF = 2 * L_BUF;
constexpr int L_OST = L_WSF + 8 * 256;
constexpr int L_FLG = L_OST + 8 * 4096;
constexpr int L_END = L_FLG + 64;
constexpr float M_INIT = -1.0e30f;
#define ATT_MFMA(a, b, c) __builtin_amdgcn_mfma_f32_32x32x16_bf16((a), (b), (c), 0, 0, 0)

__device__ __forceinline__ unsigned cvtpk(float lo, float hi) { f32x2 v = {lo, hi}; bf16x2_t b = __builtin_convertvector(v, bf16x2_t); return __builtin_bit_cast(unsigned, b); }
__device__ __forceinline__ s16x4 vtr(LAS unsigned char* p) { return __builtin_bit_cast(s16x4, __builtin_amdgcn_ds_read_tr16_b64_v4i16((LAS v4i16_t*)p)); }

struct Wave { int lane, r32, hi, wid; LAS unsigned char* lds; LAS float* wsf; LAS unsigned char* ost; int vlo; };
__device__ __forceinline__ Wave make_wave(LAS unsigned char* lds, int tid, int wsf_off = L_WSF, int ost_off = L_OST) {
    Wave w; w.lane = tid & 63; w.r32 = w.lane & 31; w.hi = w.lane >> 5; w.wid = __builtin_amdgcn_readfirstlane(tid >> 6); w.lds = lds;
    w.wsf = (LAS float*)(lds + wsf_off) + w.wid * 64; w.ost = lds + ost_off + w.wid * 4096;
    w.vlo = ((w.lane >> 4) & 1) * 32 + (w.lane & 3) * 8 + (4 * w.hi + ((w.lane & 15) >> 2)) * 64;
    return w;
}
struct Stage { u32x4 k, v; };
template <class RowK, class RowV> __device__ __forceinline__ void stage_load(Stage& s, const Wave& w, const RowK& rowk, const RowV& rowv) {
    s.k = *(const u32x4*)(rowk(w.lane) + w.wid * 8);
    s.v = *(const u32x4*)(rowv(16 * (w.wid & 3) + (w.lane >> 2)) + (w.wid >> 2) * 32 + (w.lane & 3) * 8);
}
__device__ __forceinline__ void stage_write(const Stage& s, const Wave& w, int buf) {
    *(LAS u32x4*)(w.lds + buf * L_BUF + w.wid * 1024 + w.lane * 16) = s.k;
    *(LAS u32x4*)(w.lds + buf * L_BUF + 8192 + w.wid * 1024 + w.lane * 16) = s.v;
}
__device__ __forceinline__ f32x16 qk_sub(const Wave& w, int buf, int sub, const bf16x8 (&qf)[4], float init) {
    f32x16 acc;
#pragma unroll
    for (int r = 0; r < 16; ++r) acc[r] = init;
    LAS unsigned char* kp = w.lds + buf * L_BUF + w.hi * 1024 + (32 * sub + w.r32) * 16;
#pragma unroll
    for (int ks = 0; ks < 4; ++ks) { const bf16x8 kf = *(LAS bf16x8*)(kp + ks * 2048); acc = ATT_MFMA(kf, qf[ks], acc); }
    return acc;
}
__device__ __forceinline__ void pv_sub(const Wave& w, int buf, int sub, const f32x16& p, f32x16 (&o)[2]) {
    bf16x8 pk[2];
#pragma unroll
    for (int s = 0; s < 2; ++s) { u32x4 t; t.x = cvtpk(p[8 * s], p[8 * s + 1]); t.y = cvtpk(p[8 * s + 2], p[8 * s + 3]); t.z = cvtpk(p[8 * s + 4], p[8 * s + 5]); t.w = cvtpk(p[8 * s + 6], p[8 * s + 7]); pk[s] = __builtin_bit_cast(bf16x8, t); }
    LAS unsigned char* vb = w.lds + buf * L_BUF + 8192 + w.vlo;
#pragma unroll
    for (int db = 0; db < 2; ++db)
#pragma unroll
        for (int s = 0; s < 2; ++s) { LAS unsigned char* vp = vb + db * 4096 + (4 * sub + 2 * s) * 512;
            const s16x4 lo = vtr(vp), hh = vtr(vp + 512);
            const bf16x8 vf = __builtin_shufflevector(lo, hh, 0, 1, 2, 3, 4, 5, 6, 7);
            o[db] = ATT_MFMA(pk[s], vf, o[db]); }
}
struct VFrags { s16x4 f[2][2][2]; };
__device__ __forceinline__ void load_vfrags(const Wave& w, int buf, int sub, VFrags& v) {
    LAS unsigned char* vb = w.lds + buf * L_BUF + 8192 + w.vlo;
#pragma unroll
    for (int db = 0; db < 2; ++db)
#pragma unroll
        for (int s = 0; s < 2; ++s) { LAS unsigned char* vp = vb + db * 4096 + (4 * sub + 2 * s) * 512; v.f[db][s][0] = vtr(vp); v.f[db][s][1] = vtr(vp + 512); }
}
__device__ __forceinline__ void pv_frags(const VFrags& v, const f32x16& p, f32x16 (&o)[2]) {
    bf16x8 pk[2];
#pragma unroll
    for (int s = 0; s < 2; ++s) { u32x4 t; t.x = cvtpk(p[8 * s], p[8 * s + 1]); t.y = cvtpk(p[8 * s + 2], p[8 * s + 3]); t.z = cvtpk(p[8 * s + 4], p[8 * s + 5]); t.w = cvtpk(p[8 * s + 6], p[8 * s + 7]); pk[s] = __builtin_bit_cast(bf16x8, t); }
#pragma unroll
    for (int db = 0; db < 2; ++db)
#pragma unroll
        for (int s = 0; s < 2; ++s) { const bf16x8 vf = __builtin_shufflevector(v.f[db][s][0], v.f[db][s][1], 0, 1, 2, 3, 4, 5, 6, 7); o[db] = ATT_MFMA(pk[s], vf, o[db]); }
}
__device__ __forceinline__ void scale_rows(const Wave& w, f32x16 (&o)[2], float f) {
    if (w.hi == 0) w.wsf[w.r32] = f;
#pragma unroll
    for (int g = 0; g < 4; ++g) { const f32x4 fv = *(LAS f32x4*)(w.wsf + 8 * g + 4 * w.hi);
#pragma unroll
        for (int i = 0; i < 4; ++i) { o[0][4 * g + i] *= fv[i]; o[1][4 * g + i] *= fv[i]; } }
}
__device__ __forceinline__ void softmax_sub(const Wave& w, f32x16& s, float& m, float& lsum, f32x16 (&o)[2]) {
    float tm = fmaxf(fmaxf(s[0], s[1]), fmaxf(s[2], s[3]));
#pragma unroll
    for (int r = 4; r < 16; r += 4) tm = fmaxf(tm, fmaxf(fmaxf(s[r], s[r + 1]), fmaxf(s[r + 2], s[r + 3])));
    tm = max_xor32(tm);
    const float mn = fmaxf(m, tm);
    if (__any(mn > m)) { const float al = __builtin_amdgcn_exp2f(m - mn); lsum *= al; scale_rows(w, o, al); m = mn; }
    float acc = 0.f;
#pragma unroll
    for (int r = 0; r < 16; ++r) { s[r] = __builtin_amdgcn_exp2f(s[r] - m); acc += s[r]; }
    lsum += acc;
}
__device__ __forceinline__ void mask_band(f32x16& s, int delta0, int W) {
#pragma unroll
    for (int r = 0; r < 16; ++r) { const int dl = delta0 - ((r & 3) + 8 * (r >> 2)); if ((unsigned)dl > (unsigned)W) s[r] = -INFINITY; }
}
constexpr float SM_THR = 8.0f;
struct SubDesc { bool act; int delta; int W; };
template <int NSUB>
__device__ __forceinline__ void softmax_step(const Wave& w, int buf, const bf16x8 (&qf)[4], const bf16x8& kidx, const bf16x8& slp, float slope, const SubDesc (&sd)[NSUB],
                                             float& m, float& lsum, f32x16 (&o)[2], bool& first) {
    f32x16 s[NSUB];
    bool any_act = false;
#pragma unroll
    for (int i = 0; i < NSUB; ++i) if (sd[i].act) { any_act = true; s[i] = qk_sub(w, buf, i, qf, -slope * (float)sd[i].delta - m); s[i] = ATT_MFMA(kidx, slp, s[i]); }
    if (!any_act) return;
    float tm = -INFINITY;
#pragma unroll
    for (int i = 0; i < NSUB; ++i) if (sd[i].act) {
        if (sd[i].W >= 0) mask_band(s[i], sd[i].delta - 4 * w.hi, sd[i].W);
        float t = fmaxf(fmaxf(s[i][0], s[i][1]), fmaxf(s[i][2], s[i][3]));
#pragma unroll
        for (int r = 4; r < 16; r += 4) t = fmaxf(t, fmaxf(fmaxf(s[i][r], s[i][r + 1]), fmaxf(s[i][r + 2], s[i][r + 3])));
        tm = fmaxf(tm, t); }
    tm = max_xor32(tm);
    if (first || __any(tm > SM_THR)) {
        const float d = first ? (tm > -1.0e30f ? tm : 0.f) : fmaxf(tm, 0.f);
#pragma unroll
        for (int i = 0; i < NSUB; ++i) if (sd[i].act) {
#pragma unroll
            for (int r = 0; r < 16; ++r) s[i][r] -= d; }
        if (!first) { const float al = __builtin_amdgcn_exp2f(-d); lsum *= al; scale_rows(w, o, al); }
        m += d; first = false;
    }
    VFrags vf[NSUB];
#pragma unroll
    for (int i = 0; i < NSUB; ++i) if (sd[i].act) load_vfrags(w, buf, i, vf[i]);
#pragma unroll
    for (int i = 0; i < NSUB; ++i) if (sd[i].act) { float acc = 0.f;
#pragma unroll
        for (int r = 0; r < 16; ++r) { s[i][r] = __builtin_amdgcn_exp2f(s[i][r]); acc += s[i][r]; }
        lsum += acc; }
#pragma unroll
    for (int i = 0; i < NSUB; ++i) if (sd[i].act) pv_frags(vf[i], s[i], o);
}
__device__ __forceinline__ void bias_frags(const Wave& w, float slope, bf16x8& kidx, bf16x8& slp) {
    const unsigned kb = f2bf((float)w.r32), sh = f2bf(slope), sl = f2bf(slope - __builtin_bit_cast(float, sh << 16));
    const u32x4 a = {w.hi == 0 ? (kb | (kb << 16)) : 0u, 0u, 0u, 0u}, b = {w.hi == 0 ? (sh | (sl << 16)) : 0u, 0u, 0u, 0u};
    kidx = __builtin_bit_cast(bf16x8, a); slp = __builtin_bit_cast(bf16x8, b);
}
template <class RowO> __device__ __forceinline__ void store_o(const Wave& w, const f32x16 (&o)[2], const RowO& rowo) {
    LAS unsigned short* stg = (LAS unsigned short*)w.ost;
#pragma unroll
    for (int r = 0; r < 16; ++r) { const int q = (r & 3) + 8 * (r >> 2) + 4 * w.hi;
#pragma unroll
        for (int db = 0; db < 2; ++db) stg[q * 64 + db * 32 + w.r32] = (unsigned short)f2bf(o[db][r]); }
#pragma unroll
    for (int i = 0; i < 4; ++i) { const int row = i * 8 + (w.lane >> 3), ch = w.lane & 7; const u32x4 v = *(LAS u32x4*)((LAS unsigned char*)stg + row * 128 + ch * 16);
        bf16_t* dst = rowo(row); if (dst) *(u32x4*)(dst + ch * 8) = v; }
}
__device__ __forceinline__ void load_q(bf16x8 (&qf)[4], const bf16_t* qrow, int hi) {
#pragma unroll
    for (int ks = 0; ks < 4; ++ks) qf[ks] = *(const bf16x8*)(qrow + 16 * ks + 8 * hi);
}

constexpr int W_WSF = 98304, W_OST = W_WSF + 2048, W_ENUM = W_OST + 32768;
template <int NC> struct Pref { u32x4 k[NC], v[NC]; bf16x8 q[4]; };
template <int NC, class RowF> __device__ __forceinline__ void win_issue(Pref<NC>& P, const Wave& w, const bf16_t* kbase, const bf16_t* vbase, const RowF& rowoff, const bf16_t* qrow) {
#pragma unroll
    for (int c = 0; c < NC; ++c) { P.k[c] = *(const u32x4*)(kbase + rowoff(64 * c + 8 * w.wid + (w.lane >> 3)) + (w.lane & 7) * 8);
        P.v[c] = *(const u32x4*)(vbase + rowoff(64 * c + 16 * (w.wid & 3) + (w.lane >> 2)) + (w.wid >> 2) * 32 + (w.lane & 3) * 8); }
    load_q(P.q, qrow, w.hi);
}
template <int NC> __device__ __forceinline__ void win_commit(const Pref<NC>& P, const Wave& w) {
    constexpr int NK = 64 * NC;
#pragma unroll
    for (int c = 0; c < NC; ++c) { const int key = 64 * c + 8 * w.wid + (w.lane >> 3);
        *(LAS u32x4*)(w.lds + key * 128 + ((((w.lane & 7) ^ (key >> 1)) & 7) * 16)) = P.k[c];
        *(LAS u32x4*)(w.lds + NK * 128 + (w.wid >> 2) * (NK * 64) + (8 * c + 2 * (w.wid & 3)) * 512 + w.lane * 16) = P.v[c]; }
}
template <int NK> __device__ __forceinline__ f32x16 qk_win(const Wave& w, int u, const bf16x8 (&qf)[4], float init) {
    f32x16 acc;
#pragma unroll
    for (int r = 0; r < 16; ++r) acc[r] = init;
    LAS unsigned char* kp = w.lds + (32 * u + w.r32) * 128; const int x = (w.r32 >> 1) & 7;
#pragma unroll
    for (int ks = 0; ks < 4; ++ks) { const bf16x8 kf = *(LAS bf16x8*)(kp + (((2 * ks + w.hi) ^ x) * 16)); acc = ATT_MFMA(kf, qf[ks], acc); }
    return acc;
}
template <int NK> __device__ __forceinline__ void load_vfrags_win(const Wave& w, int u, VFrags& v) {
    LAS unsigned char* vb = w.lds + NK * 128 + w.vlo;
#pragma unroll
    for (int db = 0; db < 2; ++db)
#pragma unroll
        for (int s = 0; s < 2; ++s) { LAS unsigned char* vp = vb + db * (NK * 64) + (4 * u + 2 * s) * 512; v.f[db][s][0] = vtr(vp); v.f[db][s][1] = vtr(vp + 512); }
}
struct WSub { bool act; int u; int delta; int W; };
template <int NK>
__device__ __forceinline__ void softmax_win(const Wave& w, const bf16x8 (&qf)[4], const bf16x8& kidx, const bf16x8& slp, float slope, const WSub (&sd)[2], float& m, float& lsum, f32x16 (&o)[2], bool& first) {
    f32x16 s[2];
    bool any_act = false;
#pragma unroll
    for (int i = 0; i < 2; ++i) if (sd[i].act) { any_act = true; s[i] = qk_win<NK>(w, sd[i].u, qf, -slope * (float)sd[i].delta - m); s[i] = ATT_MFMA(kidx, slp, s[i]); }
    if (!any_act) return;
    float tm = -INFINITY;
#pragma unroll
    for (int i = 0; i < 2; ++i) if (sd[i].act) {
        if (sd[i].W >= 0) mask_band(s[i], sd[i].delta - 4 * w.hi, sd[i].W);
        float t = fmaxf(fmaxf(s[i][0], s[i][1]), fmaxf(s[i][2], s[i][3]));
#pragma unroll
        for (int r = 4; r < 16; r += 4) t = fmaxf(t, fmaxf(fmaxf(s[i][r], s[i][r + 1]), fmaxf(s[i][r + 2], s[i][r + 3])));
        tm = fmaxf(tm, t); }
    tm = max_xor32(tm);
    if (first || __any(tm > SM_THR)) {
        const float d = first ? (tm > -1.0e30f ? tm : 0.f) : fmaxf(tm, 0.f);
#pragma unroll
        for (int i = 0; i < 2; ++i) if (sd[i].act) {
#pragma unroll
            for (int r = 0; r < 16; ++r) s[i][r] -= d; }
        if (!first) { const float al = __builtin_amdgcn_exp2f(-d); lsum *= al; scale_rows(w, o, al); }
        m += d; first = false;
    }
#pragma unroll
    for (int i = 0; i < 2; ++i) if (sd[i].act) { VFrags vf; load_vfrags_win<NK>(w, sd[i].u, vf);
        float acc = 0.f;
#pragma unroll
        for (int r = 0; r < 16; ++r) { s[i][r] = __builtin_amdgcn_exp2f(s[i][r]); acc += s[i][r]; }
        lsum += acc;
        pv_frags(vf, s[i], o); }
}

__device__ __forceinline__ size_t ql_off(int bh, int j) { return (size_t)bh * QL_PER_BH + (size_t)(8192 * j - 128 * j * (j + 1)); }
__device__ __forceinline__ float* lsem_ptr(float* l0, float* l1, int slot) { return (slot < 2 ? l0 : l1) + (size_t)(slot & 1) * T * 4; }

struct Top3 { int i0, i1, i2; };
__device__ __forceinline__ Top3 moba_top3(const Wave& w, const bf16x8 (&qf)[4], const float* KMEAN, int b, int h, int own) {
    int i0 = -1, i1 = -1, i2 = -1;
    if (own > 0) {
    f32x16 g;
#pragma unroll
    for (int r = 0; r < 16; ++r) g[r] = 0.f;
    const float* km = KMEAN + ((size_t)(b * 4 + h) * 32 + w.r32) * HD + 8 * w.hi;
#pragma unroll
    for (int ks = 0; ks < 4; ++ks) { const f32x4 a0 = *(const f32x4*)(km + 16 * ks), a1 = *(const f32x4*)(km + 16 * ks + 4);
        const float x[8] = {a0.x, a0.y, a0.z, a0.w, a1.x, a1.y, a1.z, a1.w}; unsigned hw[4], lw[4];
#pragma unroll
        for (int j = 0; j < 4; ++j) { const unsigned h0 = f2bf(x[2 * j]), h1 = f2bf(x[2 * j + 1]); hw[j] = h0 | (h1 << 16);
            lw[j] = pk2(x[2 * j] - __builtin_bit_cast(float, h0 << 16), x[2 * j + 1] - __builtin_bit_cast(float, h1 << 16)); }
        const u32x4 hv = {hw[0], hw[1], hw[2], hw[3]}, lv = {lw[0], lw[1], lw[2], lw[3]};
        g = ATT_MFMA(__builtin_bit_cast(bf16x8, hv), qf[ks], g); g = ATT_MFMA(__builtin_bit_cast(bf16x8, lv), qf[ks], g); }
    float v0 = -INFINITY, v1 = -INFINITY, v2 = -INFINITY;
#pragma unroll
    for (int r = 0; r < 16; ++r) { const int blk = (r & 3) + 8 * (r >> 2) + 4 * w.hi; const float val = (blk < own) ? g[r] : -INFINITY;
        if (val > v0) { v2 = v1; i2 = i1; v1 = v0; i1 = i0; v0 = val; i0 = blk; } else if (val > v1) { v2 = v1; i2 = i1; v1 = val; i1 = blk; } else if (val > v2) { v2 = val; i2 = blk; } }
    const float pv_[3] = {get_xor32(v0, w.hi), get_xor32(v1, w.hi), get_xor32(v2, w.hi)}; const int pi_[3] = {get_xor32i(i0, w.hi), get_xor32i(i1, w.hi), get_xor32i(i2, w.hi)};
#pragma unroll
    for (int k = 0; k < 3; ++k) { const float val = pv_[k]; const int blk = pi_[k];
        if (val > v0 || (val == v0 && blk < i0)) { v2 = v1; i2 = i1; v1 = v0; i1 = i0; v0 = val; i0 = blk; }
        else if (val > v1 || (val == v1 && blk < i1)) { v2 = v1; i2 = i1; v1 = val; i1 = blk; }
        else if (val > v2 || (val == v2 && blk < i2)) { v2 = val; i2 = blk; } }
    }
    Top3 t; t.i0 = i0; t.i1 = i1; t.i2 = i2; return t;
}
__device__ __forceinline__ void moba_gate_unit(LAS unsigned char* lds, const bf16_t* QB, const float* KMEAN, unsigned* mcnt, unsigned* qlist, bf16_t* PM, float* LSEM0, float* LSEM1, int b, int h, int own, int tid) {
    const Wave w = make_wave(lds, tid);
    const size_t rowbase = (size_t)b * SEQ; const int qpos = own * 256 + 32 * w.wid + w.r32, bh = b * 4 + h;
    bf16x8 qf[4]; load_q(qf, QB + (rowbase + qpos) * DM + h * HD, w.hi);
    const Top3 t3 = moba_top3(w, qf, KMEAN, b, h, own); const int s0 = t3.i0, s1 = t3.i1, s2 = t3.i2;
    LAS unsigned* cl = (LAS unsigned*)(lds + W_ENUM);
    if (tid < 64) cl[tid] = 0u;
    __syncthreads();
    unsigned r0 = 0u, r1 = 0u, r2 = 0u;
    if (w.hi == 0) {
        if (s0 >= 0) r0 = __hip_atomic_fetch_add(cl + s0, 1u, __ATOMIC_RELAXED, __HIP_MEMORY_SCOPE_WORKGROUP);
        if (s1 >= 0) r1 = __hip_atomic_fetch_add(cl + s1, 1u, __ATOMIC_RELAXED, __HIP_MEMORY_SCOPE_WORKGROUP);
        if (s2 >= 0) r2 = __hip_atomic_fetch_add(cl + s2, 1u, __ATOMIC_RELAXED, __HIP_MEMORY_SCOPE_WORKGROUP);
    }
    __syncthreads();
    if (tid < 32) { const unsigned c = cl[tid]; cl[32 + tid] = c ? __hip_atomic_fetch_add(mcnt + bh * 32 + tid, c, __ATOMIC_RELAXED, __HIP_MEMORY_SCOPE_AGENT) : 0u; }
    __syncthreads();
    if (w.hi == 0) {
        const size_t tok = rowbase + qpos;
#define MOBA_EMIT(k, sk, rk) do { if (sk >= 0) qlist[ql_off(bh, sk) + cl[32 + sk] + rk] = (unsigned)qpos | ((unsigned)(k) << 13); \
            else { lsem_ptr(LSEM0, LSEM1, k)[tok * 4 + h] = -1.0e30f;          \
                u32x4* pz = (u32x4*)(PM + ((size_t)(k) * T + tok) * 256 + h * HD); const u32x4 z4 = {0u, 0u, 0u, 0u}; \
                _Pragma("unroll") for (int c = 0; c < 8; ++c) pz[c] = z4; } } while (0)
        MOBA_EMIT(0, s0, r0); MOBA_EMIT(1, s1, r1); MOBA_EMIT(2, s2, r2);
#undef MOBA_EMIT
    }
    __syncthreads();
}
struct OwnU { int b, h, own; };
__device__ __forceinline__ void own_issue(Pref<4>& P, const Wave& w, const OwnU& u, const bf16_t* QB, const bf16_t* KB, const bf16_t* VB) {
    const size_t rowbase = (size_t)u.b * SEQ; const int q0 = u.own * 256;
    win_issue<4>(P, w, KB + (rowbase + q0) * DM + u.h * HD, VB + (rowbase + q0) * DM + u.h * HD, [&](int key) { return (size_t)key * DM; }, QB + (rowbase + q0 + 32 * w.wid + w.r32) * DM + u.h * HD);
}
template <class F> __device__ __forceinline__ void own_compute(const Wave& w, const OwnU& u, const bf16x8 (&qf)[4], bf16_t* OB, float* LSEM0, float* LSEM1, const F& between) {
    const size_t rowbase = (size_t)u.b * SEQ; const int q0 = u.own * 256, ql = 32 * w.wid + w.r32;
    const float slope2 = exp2f(-2.0f * (float)(u.h + 1)) * LOG2E;
    bf16x8 kidx, slp; bias_frags(w, slope2, kidx, slp);
    f32x16 o[2];
#pragma unroll
    for (int r = 0; r < 16; ++r) { o[0][r] = 0.f; o[1][r] = 0.f; }
    float m = 0.f, lsum = 0.f; bool first = true;
#pragma unroll
    for (int p = 0; p < 4; ++p) { WSub sd[2];
#pragma unroll
        for (int i = 0; i < 2; ++i) { const int su = w.wid - 2 * p - i; sd[i].act = su >= 0; sd[i].u = su; sd[i].delta = ql - 32 * su; sd[i].W = (su == w.wid) ? 0x7fffffff : -1; }
        softmax_win<256>(w, qf, kidx, slp, slope2, sd, m, lsum, o, first); }
    between();
    const float l = sum_xor32(lsum);
    scale_rows(w, o, 1.0f / l);
    bf16_t* orow = OB + (rowbase + q0 + 32 * w.wid) * DM + u.h * HD;
    store_o(w, o, [&](int r) { return orow + (size_t)r * DM; });
    if (w.hi == 0) lsem_ptr(LSEM0, LSEM1, 3)[(rowbase + q0 + ql) * 4 + u.h] = m + __builtin_amdgcn_logf(l);
}
struct GatU { int b, h, j, cnt, chunk; const unsigned* ql; };
__device__ __forceinline__ unsigned gat_entry(const Wave& w, const GatU& u, bool& valid) { const int idx = u.chunk * 256 + 32 * w.wid + w.r32; valid = idx < u.cnt; return u.ql[valid ? idx : u.chunk * 256]; }
__device__ __forceinline__ void gat_issue(Pref<4>& P, const Wave& w, const GatU& u, const bf16_t* QB, const bf16_t* KB, const bf16_t* VB) {
    const size_t rowbase = (size_t)u.b * SEQ; bool valid; const unsigned e = gat_entry(w, u, valid);
    win_issue<4>(P, w, KB + (rowbase + u.j * 256) * DM + u.h * HD, VB + (rowbase + u.j * 256) * DM + u.h * HD, [&](int key) { return (size_t)key * DM; }, QB + (rowbase + (e & 8191u)) * DM + u.h * HD);
}
template <class F> __device__ __forceinline__ void gat_compute(const Wave& w, const GatU& u, const bf16x8 (&qf)[4], bf16_t* PM, float* LSEM0, float* LSEM1, const F& between) {
    const size_t rowbase = (size_t)u.b * SEQ; bool valid; const unsigned e = gat_entry(w, u, valid);
    const int qpos = (int)(e & 8191u), slot = (int)(e >> 13);
    const float slope2 = exp2f(-2.0f * (float)(u.h + 1)) * LOG2E;
    bf16x8 kidx, slp; bias_frags(w, slope2, kidx, slp);
    f32x16 o[2];
#pragma unroll
    for (int r = 0; r < 16; ++r) { o[0][r] = 0.f; o[1][r] = 0.f; }
    float m = 0.f, lsum = 0.f; bool first = true;
#pragma unroll
    for (int p = 0; p < 4; ++p) { WSub sd[2];
#pragma unroll
        for (int i = 0; i < 2; ++i) { const int su = 7 - 2 * p - i; sd[i].act = true; sd[i].u = su; sd[i].delta = qpos - (u.j * 256 + 32 * su); sd[i].W = -1; }
        softmax_win<256>(w, qf, kidx, slp, slope2, sd, m, lsum, o, first); }
    between();
    const float l = sum_xor32(lsum);
    scale_rows(w, o, l > 0.f ? 1.0f / l : 0.f);
    LAS int* code = (LAS int*)(w.wsf + 32);
    if (w.hi == 0) code[w.r32] = valid ? (int)((size_t)slot * T + rowbase + qpos) : -1;
    store_o(w, o, [&](int r) { const int c = code[r]; return c >= 0 ? PM + (size_t)c * 256 + u.h * HD : (bf16_t*)nullptr; });
    if (w.hi == 0 && valid) lsem_ptr(LSEM0, LSEM1, slot)[(rowbase + qpos) * 4 + u.h] = l > 0.f ? m + __builtin_amdgcn_logf(l) : -1.0e30f;
}

__device__ __forceinline__ void sb_unit(LAS unsigned char* lds, const bf16_t* QB, const bf16_t* KB, const bf16_t* VB, bf16_t* OB, int b, int h, int qt, int tid) {
    const Wave w = make_wave(lds, tid);
    const size_t rowbase = (size_t)b * SEQ; const int q0 = qt * 256, qpos = q0 + 32 * w.wid + w.r32;
    const bf16_t* kh = KB + rowbase * DM + h * HD; const bf16_t* vh = VB + rowbase * DM + h * HD;
    bf16x8 qf[4]; load_q(qf, QB + (rowbase + qpos) * DM + h * HD, w.hi);
    f32x16 o[2];
#pragma unroll
    for (int r = 0; r < 16; ++r) { o[0][r] = 0.f; o[1][r] = 0.f; }
    float carry = 0.f;
    bool done = false;
    volatile LAS unsigned* flg = (volatile LAS unsigned*)(lds + L_FLG);
    const int ti0 = q0 / 64 + 3;
    Stage sg;
    { const int kp = ti0 * 64; stage_load(sg, w, [&](int key) { return kh + (size_t)(kp + key) * DM; }, [&](int key) { return vh + (size_t)(kp + key) * DM; }); }
    stage_write(sg, w, 0);
    __syncthreads();
    for (int st = 0;; ++st) {
        const int buf = st & 1, ti = ti0 - st;
        if (ti > 0) { const int kp = (ti - 1) * 64; stage_load(sg, w, [&](int key) { return kh + (size_t)(kp + key) * DM; }, [&](int key) { return vh + (size_t)(kp + key) * DM; }); }
        if (!done) {
#pragma unroll
            for (int sub = 1; sub >= 0; --sub) {
                const int D = (q0 / 32 + w.wid) - (2 * ti + sub);
                if (D < 0) continue;
                const int delta0 = qpos - (64 * ti + 32 * sub) - 4 * w.hi;
                f32x16 z = qk_sub(w, buf, sub, qf, 0.f);
                f32x16 dd;
#pragma unroll
                for (int r = 0; r < 16; ++r) { z[r] = __builtin_amdgcn_exp2f(fminf(z[r], 30.f)); }
                if (D == 0) {
#pragma unroll
                    for (int r = 0; r < 16; ++r) { const int dl = delta0 - ((r & 3) + 8 * (r >> 2)); if (dl < 1) z[r] = 0.f; }
                }
#pragma unroll
                for (int r = 0; r < 16; ++r) dd[r] = 1.f + z[r];
                float G[4], PG[4];
#pragma unroll
                for (int g = 0; g < 4; ++g) { G[g] = (dd[4 * g] * dd[4 * g + 1]) * (dd[4 * g + 2] * dd[4 * g + 3]); PG[g] = get_xor32(G[g], w.hi); }
                const float cin = __builtin_amdgcn_exp2f(carry);
                float run = 1.f;
#pragma unroll
                for (int g = 3; g >= 0; --g) { const float x3 = run * (w.hi == 0 ? PG[g] : 1.f);
                    const float p0 = x3 * G[g];
                    const float r0 = __builtin_amdgcn_rcpf(p0) * cin, r1 = r0 * dd[4 * g], r2 = r1 * dd[4 * g + 1], r3 = r2 * dd[4 * g + 2];
                    z[4 * g] *= r0; z[4 * g + 1] *= r1; z[4 * g + 2] *= r2; z[4 * g + 3] *= r3;
                    run *= G[g] * PG[g]; }
                carry -= __builtin_amdgcn_logf(run);
                pv_sub(w, buf, sub, z, o);
            }
            done = __all(carry < -150.f);
        }
        if (w.lane == 0) flg[buf * 8 + w.wid] = done ? 1u : 0u;
        if (ti > 0) stage_write(sg, w, buf ^ 1);
        __syncthreads();
        unsigned all = 1u;
#pragma unroll
        for (int k = 0; k < 8; ++k) all &= flg[buf * 8 + k];
        if (all || ti == 0) break;
    }
    bf16_t* orow = OB + (rowbase + q0 + 32 * w.wid) * DM + h * HD;
    store_o(w, o, [&](int r) { return orow + (size_t)r * DM; });
    __syncthreads();
}

struct PrefK6 { u32x4 k[6]; bf16x8 q[4]; }; struct PrefV6 { u32x4 v[6]; };
template <class RowF> __device__ __forceinline__ void win_issue_k6(PrefK6& P, const Wave& w, const bf16_t* kbase, const RowF& rowoff, const bf16_t* qrow) {
#pragma unroll
    for (int c = 0; c < 6; ++c) P.k[c] = *(const u32x4*)(kbase + rowoff(64 * c + 8 * w.wid + (w.lane >> 3)) + (w.lane & 7) * 8);
    load_q(P.q, qrow, w.hi);
}
template <class RowF> __device__ __forceinline__ void win_issue_v6(PrefV6& P, const Wave& w, const bf16_t* vbase, const RowF& rowoff) {
#pragma unroll
    for (int c = 0; c < 6; ++c) P.v[c] = *(const u32x4*)(vbase + rowoff(64 * c + 16 * (w.wid & 3) + (w.lane >> 2)) + (w.wid >> 2) * 32 + (w.lane & 3) * 8);
}
__device__ __forceinline__ void win_commit_k6(const PrefK6& P, const Wave& w) {
#pragma unroll
    for (int c = 0; c < 6; ++c) { const int key = 64 * c + 8 * w.wid + (w.lane >> 3); *(LAS u32x4*)(w.lds + key * 128 + ((((w.lane & 7) ^ (key >> 1)) & 7) * 16)) = P.k[c]; }
}
__device__ __forceinline__ void win_commit_v6(const PrefV6& P, const Wave& w) {
    constexpr int NK = 384;
#pragma unroll
    for (int c = 0; c < 6; ++c) *(LAS u32x4*)(w.lds + NK * 128 + (w.wid >> 2) * (NK * 64) + (8 * c + 2 * (w.wid & 3)) * 512 + w.lane * 16) = P.v[c];
}
struct DilU { int b, h, dil, res, i2, c; };
__device__ __forceinline__ DilU dil_decode(int u) { const int n = ((u & 31) + (u >> 8)) & 31, bhc = u >> 5,
    c = bhc % 3, bh = bhc / 3; DilU d; d.b = bh >> 3; d.h = 8 + (bh & 7); d.c = c;
    d.dil = (c == 0) ? 1 : (c == 1) ? 4 : 16; d.res = (c == 0) ? 0 : (c == 1) ? (n >> 3) : (n >> 1); d.i2 = (c == 0) ? n : (c == 1) ? (n & 7) : (n & 1); return d; }
__device__ __forceinline__ void dil_issue_k(PrefK6& P, const Wave& w, const DilU& u, const bf16_t* QB, const bf16_t* KB) {
    const size_t rowbase = (size_t)u.b * SEQ; const int Q0 = 256 * u.i2, qj = Q0 + 32 * w.wid + w.r32; const size_t rstride = (size_t)u.dil * DM;
    win_issue_k6(P, w, KB + (rowbase + u.res) * DM + u.h * HD, [&](int key) { const int kj = Q0 - 128 + key; return (size_t)(kj < 0 ? 0 : kj) * rstride; },
                 QB + (rowbase + u.res + (size_t)qj * u.dil) * DM + u.h * HD);
}
__device__ __forceinline__ void dil_issue_v(PrefV6& P, const Wave& w, const DilU& u, const bf16_t* VB) {
    const size_t rowbase = (size_t)u.b * SEQ; const int Q0 = 256 * u.i2; const size_t rstride = (size_t)u.dil * DM;
    win_issue_v6(P, w, VB + (rowbase + u.res) * DM + u.h * HD, [&](int key) { const int kj = Q0 - 128 + key; return (size_t)(kj < 0 ? 0 : kj) * rstride; });
}
template <class F> __device__ __forceinline__ void dil_compute(const Wave& w, const DilU& u, const bf16x8 (&qf)[4], bf16_t* OB, bf16_t* HB2, float* LSE, const F& between) {
    const size_t rowbase = (size_t)u.b * SEQ; const int Q0 = 256 * u.i2, ql = 32 * w.wid + w.r32;
    const float slope2d = exp2f(-(float)(u.h - 8 + 1)) * LOG2E * (float)u.dil;
    bf16x8 kidx, slp; bias_frags(w, slope2d, kidx, slp);
    f32x16 o[2];
#pragma unroll
    for (int r = 0; r < 16; ++r) { o[0][r] = 0.f; o[1][r] = 0.f; }
    float m = 0.f, lsum = 0.f; bool first = true;
#pragma unroll
    for (int p = 0; p < 3; ++p) { WSub sd[2];
#pragma unroll
        for (int i = 0; i < 2; ++i) { const int D = 2 * p + i, su = w.wid + 4 - D; sd[i].act = (D <= 4) && (Q0 - 128 + 32 * su >= 0); sd[i].u = su; sd[i].delta = ql + 128 - 32 * su; sd[i].W = (D == 0 || D == 4) ? 128 : -1; }
        softmax_win<384>(w, qf, kidx, slp, slope2d, sd, m, lsum, o, first); }
    between();
    const float l = sum_xor32(lsum);
    scale_rows(w, o, 1.0f / l);
    bf16_t* PO = (u.c == 0) ? OB + 512 : HB2 + (u.c - 1) * 512;
    const size_t tok0 = rowbase + u.res + (size_t)(Q0 + 32 * w.wid) * u.dil;
    store_o(w, o, [&](int r) { return PO + (tok0 + (size_t)r * u.dil) * DM + (u.h - 8) * HD; });
    if (w.hi == 0) (LSE + (size_t)u.c * T * 8)[(tok0 + (size_t)w.r32 * u.dil) * 8 + (u.h - 8)] = m + __builtin_amdgcn_logf(l);
}

__device__ __forceinline__ void moba_gate_phase(LAS unsigned char* lds, const bf16_t* QB, const float* KMEAN, unsigned* mcnt, unsigned* qlist, bf16_t* PM, float* LSEM0, float* LSEM1, int v, int G, int tid) {
    for (int u = v; u < 512; u += G) { const int own = u & 31, bh = u >> 5; moba_gate_unit(lds, QB, KMEAN, mcnt, qlist, PM, LSEM0, LSEM1, bh >> 2, bh & 3, own, tid); }
}
struct AttnArgs { const bf16_t* QB; const bf16_t* KB; const bf16_t* VB; bf16_t* OB; bf16_t* HB2; float* LSE; unsigned* mcnt; unsigned* qlist; bf16_t* PM; float* LSEM0; float* LSEM1; const float* KMEAN; unsigned* gdone; };
__device__ __forceinline__ void attn_phase(LAS unsigned char* lds, const AttnArgs& A, int v, int G, int tid) {
    moba_gate_phase(lds, A.QB, A.KMEAN, A.mcnt, A.qlist, A.PM, A.LSEM0, A.LSEM1, v, G, tid);
    asm volatile("s_waitcnt vmcnt(0)" ::: "memory");
    __syncthreads();
    if (tid == 0) { __builtin_amdgcn_fence(__ATOMIC_RELEASE, "agent"); asm volatile("s_waitcnt vmcnt(0)" ::: "memory"); __hip_atomic_fetch_add(A.gdone, 1u, __ATOMIC_RELAXED, __HIP_MEMORY_SCOPE_AGENT); }
    const Wave w = make_wave(lds, tid, W_WSF, W_OST);
    {   Pref<4> P; int u = v; OwnU cur, nxt;
        auto dec = [&](int uu) { OwnU o_; const int bh = uu >> 5; o_.b = bh >> 2; o_.h = bh & 3; o_.own = uu & 31; return o_; };
        if (u < 512) { cur = dec(u); own_issue(P, w, cur, A.QB, A.KB, A.VB); }
        for (; u < 512; u += G) {
            __syncthreads();
            win_commit<4>(P, w); bf16x8 qf[4] = {P.q[0], P.q[1], P.q[2], P.q[3]};
            __syncthreads();
            const bool more = u + G < 512; if (more) nxt = dec(u + G);
            own_compute(w, cur, qf, A.OB, A.LSEM0, A.LSEM1, [&]() { if (more) own_issue(P, w, nxt, A.QB, A.KB, A.VB); });
            cur = nxt; } }
    {   PrefK6 P; int u = v; DilU cur, nxt;
        if (u < 3072) { cur = dil_decode(u); dil_issue_k(P, w, cur, A.QB, A.KB); }
        for (; u < 3072; u += G) {
            __syncthreads();
            bf16x8 qf[4] = {P.q[0], P.q[1], P.q[2], P.q[3]};
            { PrefV6 PV; dil_issue_v(PV, w, cur, A.VB); win_commit_k6(P, w); win_commit_v6(PV, w); }
            __syncthreads();
            const bool more = u + G < 3072; if (more) nxt = dil_decode(u + G);
            dil_compute(w, cur, qf, A.OB, A.HB2, A.LSE, [&]() { if (more) dil_issue_k(P, w, nxt, A.QB, A.KB); });
            cur = nxt; } }
    __syncthreads();
    for (int u = v; u < 512; u += G) { const int qt = ((u & 31) + (u >> 8)) & 31, bh = u >> 5; sb_unit(lds, A.QB, A.KB, A.VB, A.OB, bh >> 2, 4 + (bh & 3), qt, tid); }
    if (tid == 0) { unsigned polls = 0;
        while (__hip_atomic_load(A.gdone, __ATOMIC_RELAXED, __HIP_MEMORY_SCOPE_AGENT) < (unsigned)G) { if (++polls > (1u << 20)) break; __builtin_amdgcn_s_sleep(2); }
        __builtin_amdgcn_fence(__ATOMIC_ACQUIRE, "agent"); asm volatile("s_waitcnt vmcnt(0)" ::: "memory"); }
    __syncthreads();
    LAS int* cntl = (LAS int*)(lds + W_ENUM); LAS int* pa = cntl + 512; LAS int* pb = pa + 512;
    const int myc = (int)A.mcnt[tid], myu = (myc + 255) >> 8;
    cntl[tid] = myc; pa[tid] = myu;
    __syncthreads();
#pragma unroll 1
    for (int d = 1; d < 512; d <<= 1) { const int x = pa[tid] + (tid >= d ? pa[tid - d] : 0); pb[tid] = x; __syncthreads(); LAS int* t_ = pa; pa = pb; pb = t_; }
    const int total = pa[511];
    auto gat_decode = [&](int u) { int lo = 0, hi = 511;
        while (lo < hi) { const int mid = (lo + hi) >> 1; if (pa[mid] > u) hi = mid; else lo = mid + 1; }
        const int i = lo, c = cntl[i], bh = i >> 5; GatU g; g.b = bh >> 2; g.h = bh & 3; g.j = i & 31; g.cnt = c; g.chunk = u - (pa[i] - ((c + 255) >> 8)); g.ql = A.qlist + ql_off(bh, g.j); return g; };
    {   Pref<4> P; int u = v; GatU cur, nxt;
        if (u < total) { cur = gat_decode(u); gat_issue(P, w, cur, A.QB, A.KB, A.VB); }
        for (; u < total; u += G) {
            __syncthreads();
            win_commit<4>(P, w); bf16x8 qf[4] = {P.q[0], P.q[1], P.q[2], P.q[3]};
            __syncthreads();
            const bool more = u + G < total; if (more) nxt = gat_decode(u + G);
            gat_compute(w, cur, qf, A.PM, A.LSEM0, A.LSEM1, [&]() { if (more) gat_issue(P, w, nxt, A.QB, A.KB, A.VB); });
            cur = nxt; } }
}
}

constexpr int PH_PRO = 0, PH_L0 = 1, PH_PER_LAYER = 10, PH_FINAL = PH_L0 + DEPTH * PH_PER_LAYER, PH_COUNT = PH_FINAL + 1;
typedef const __attribute__((address_space(4))) Args* KArgP;
#define KARG() ({ KArgP p_ = (KArgP)__builtin_amdgcn_kernarg_segment_ptr(); asm volatile("" : "+s"(p_)); p_; })
#define PHASE_IDS int lane_p = (int)__builtin_amdgcn_mbcnt_hi(~0u, __builtin_amdgcn_mbcnt_lo(~0u, 0u)); LAUNDER_V(lane_p); int tid_p = wave * 64 + lane_p; int gw_p = gw, G_p = G, NGW_p = NGW; LAUNDER_S(gw_p); LAUNDER_S(G_p); LAUNDER_S(NGW_p)
__global__ void __launch_bounds__(NTHREADS, 2) fwd(Args a_unused) {
    extern __shared__ __attribute__((aligned(16))) unsigned char lds_raw[];
    LAS unsigned char* lds = (LAS unsigned char*)lds_raw;
    volatile LAS unsigned* MISC = (volatile LAS unsigned*)(lds + MISC_OFF);
    const int wave = __builtin_amdgcn_readfirstlane((int)threadIdx.x >> 6);
    const int G = gridDim.x, bx = blockIdx.x;
    const int vcu = (G % 8 == 0) ? (bx % 8) * (G / 8) + bx / 8 : bx;
    const int gw = vcu * NWAVES + wave, NGW = G * NWAVES;
    for (int u = threadIdx.x; u < (LDS_BYTES - LDSCTL_OFF) / 4; u += NTHREADS) ((LAS unsigned*)(lds + LDSCTL_OFF))[u] = 0u;
    __syncthreads();
    int lo, hi; XcdBarrier bar;
    { KArgP ka = KARG(); lo = ka->ph_lo; hi = ka->ph_hi; unsigned* ctl = (unsigned*)(ka->ws + WS_CTL); bar = xcd_barrier_post(ctl + CW_BAR + ka->li * XCD_BAR_WORDS, MISC + 8, wave); }
#define IN(k) (lo <= (k) && (k) < hi)
#define SEAM(k) do { if (IN(k) && IN((k) + 1)) xcd_barrier(bar); } while (0)
#define WSP(T_, off) ((T_*)(ws + (off)))

    if (IN(PH_PRO)) { KArgP ka = KARG(); PHASE_IDS; Args a; a.ws = ka->ws; a.w_in = ka->w_in; a.w_out = ka->w_out; a.w_gate = ka->w_gate; a.w_up = ka->w_up; a.w_down = ka->w_down; a.ln2_g = ka->ln2_g; a.ln1_g = ka->ln1_g; phase_prologue(a, lds, gw_p, NGW_p, wave, lane_p); } SEAM(PH_PRO);

    for (int l = 0; l < DEPTH; ++l) {
        const int p0 = PH_L0 + l * PH_PER_LAYER;
        if (hi <= p0 || lo >= p0 + PH_PER_LAYER) continue;
        if (l == 0) { if (IN(p0 + 0)) { KArgP ka = KARG(); PHASE_IDS; unsigned char* ws = ka->ws;
            phase_norm1(ka->x, gw_p, NGW_p, lane_p, WSP(float, WS_KMEAN), WSP(bf16_t, WS_XB), WSP(float, WS_SSQ)); } SEAM(p0 + 0); }
        if (IN(p0 + 1)) for (int rep_ = 0; rep_ < RPT(1); ++rep_) { if (rep_) xcd_barrier(bar); KArgP ka = KARG(); PHASE_IDS; unsigned char* ws = ka->ws;
            pg8::Gemm g{(const char*)(ws + WS_XB), (const char*)(ws + WS_WIN) + (size_t)l * NQKV * DM * 2, DM, DM, DM, (long)256 * DM * 2, (long)256 * DM * 2, (long)128 * DM * 2, WSP(float, WS_SSQ)};
            pg8::StaticOrder S; S.init(T / 256, NQKV / 256, G_p, bx);
            pg8::EpiQKV E{WSP(bf16_t, WS_Q), (size_t)(WS_K - WS_Q) / 2, QSCALE};
            pg8::gemm_phase<pg8::EpiQKV, pg8::StaticOrder>(lds, g, S, E, wave);
        } SEAM(p0 + 1);
        if (IN(p0 + 4)) for (int rep_ = 0; rep_ < RPT(4); ++rep_) { if (rep_) xcd_barrier(bar); KArgP ka = KARG(); PHASE_IDS; unsigned char* ws = ka->ws;
            const att::AttnArgs A{WSP(bf16_t, WS_Q), WSP(bf16_t, WS_K), WSP(bf16_t, WS_V), (bf16_t*)ka->out, WSP(bf16_t, WS_HB), WSP(float, WS_LSE), WSP(unsigned, WS_CTL) + CW_MCNT + l * 512, WSP(unsigned, WS_QLIST),
                                  WSP(bf16_t, WS_PM), WSP(float, WS_LSEM0), WSP(float, WS_LSEM1), WSP(float, WS_KMEAN), WSP(unsigned, WS_CTL) + CW_GDONE + l * 64};
            att::attn_phase(lds, A, vcu, G_p, tid_p);
        } SEAM(p0 + 4);
        if (IN(p0 + 5)) { KArgP ka = KARG(); PHASE_IDS; unsigned char* ws = ka->ws;
            phase_mixnorm((const bf16_t*)ka->out, WSP(bf16_t, WS_HB), WSP(float, WS_LSE), WSP(bf16_t, WS_PM), WSP(float, WS_LSEM0), WSP(float, WS_LSEM1), ka->mix_g + (size_t)l * DM, gw_p, NGW_p, lane_p); } SEAM(p0 + 5);
        if (IN(p0 + 6)) { KArgP ka = KARG(); PHASE_IDS; unsigned char* ws = ka->ws;
            pg8::Gemm g{(const char*)(ws + WS_HB), (const char*)(ws + WS_WOUT) + (size_t)l * DM * DM * 2, DM, DM, DM, (long)256 * DM * 2, (long)256 * DM * 2, (long)128 * DM * 2, nullptr};
            pg8::StaticOrder S; S.init(T / 256, DM / 256, G_p, bx);
            pg8::EpiResAdd E{WSP(bf16_t, WS_XB)};
            pg8::gemm_phase<pg8::EpiResAdd, pg8::StaticOrder>(lds, g, S, E, wave);
        } SEAM(p0 + 6);
        if (IN(p0 + 7)) { KArgP ka = KARG(); PHASE_IDS; unsigned char* ws = ka->ws;
            phase_route(WSP(bf16_t, WS_XB), ka->ln2_g + (size_t)l * DM, ka->w_gr + (size_t)l * DM * 4, ka->b_gr + l * 4, ka->w_er + (size_t)l * 4 * DM * 4, ka->b_er + l * 16, WSP(float, WS_LSE),
                        WSP(unsigned, WS_CTL) + CW_CNT + l * 32, WSP(unsigned, WS_LIST), WSP(float, WS_WLIST), lds, vcu, G_p, wave, lane_p, WSP(float, WS_KMEAN)); } SEAM(p0 + 7);
        if (IN(p0 + 8)) for (int rep_ = 0; rep_ < RPT(8); ++rep_) { if (rep_) xcd_barrier(bar); KArgP ka = KARG(); PHASE_IDS; unsigned char* ws = ka->ws;
            pg8::MoeProb<0> P{WSP(unsigned, WS_CTL) + CW_CNT + l * 32, WSP(unsigned, WS_LIST), (const char*)(ws + WS_XB), (const char*)(ws + WS_WG) + (size_t)l * NACT * DM * 2, DM, DM, DM, (long)(WS_WU - WS_WG), G_p, vcu, WSP(unsigned, WS_CTL) + CW_TCNT + l * 16384};
            pg8::EpiGateUpSparse E{WSP(bf16_t, WS_ACT), WSP(float, WS_WLIST), WSP(float, WS_LSE), WSP(unsigned, WS_CTL) + CW_TCNT + l * 16384};
            pg8::gemm_phase_x<pg8::EpiGateUpSparse, pg8::MoeProb<0>>(lds, P, E, wave);
        }
        if (IN(p0 + 9)) { KArgP ka = KARG(); PHASE_IDS; unsigned char* ws = ka->ws;
            pg8::MoeProb<1> P{WSP(unsigned, WS_CTL) + CW_CNT + l * 32, WSP(unsigned, WS_LIST), (const char*)(ws + WS_ACT), (const char*)(ws + WS_WD) + (size_t)l * DM * NACT * 2, 512, NACT, 512, (long)128 * NACT * 2, G_p, vcu, WSP(unsigned, WS_CTL) + CW_TCNT + l * 16384};
            pg8::EpiDownScatter E{WSP(bf16_t, WS_XB), WSP(unsigned, WS_LIST), WSP(float, WS_SSQ), lds};
            pg8::gemm_phase_x<pg8::EpiDownScatter, pg8::MoeProb<1>>(lds, P, E, wave);
        } SEAM(p0 + 9);
    }
    if (IN(PH_FINAL)) { KArgP ka = KARG(); PHASE_IDS; phase_final((const bf16_t*)(ka->ws + WS_XB), ka->fin_g, ka->out, gw_p, NGW_p, lane_p); }
#undef IN
#undef SEAM
#undef WSP
}

#ifndef N_LAUNCH_MODE
#define N_LAUNCH_MODE 1
#endif
extern "C" void kernel_launch(void* const* d_in, const int* in_sizes, int n_in, void* d_out, int out_size, void* d_ws, size_t ws_size, hipStream_t stream) {
    static int grid = 0;
    if (grid == 0) {
        if (n_in != 14 || in_sizes[0] != T * DM || out_size != T * DM || ws_size < WS_END) { fprintf(stderr, "kernel_launch: unexpected shapes (n_in %d in0 %d out %d ws %zu)\n", n_in, n_in > 0 ? in_sizes[0] : -1, out_size, ws_size); grid = -1; return; }
        int dev = 0, cus = 0, per_cu = 0;
        if (hipGetDevice(&dev) != hipSuccess || hipDeviceGetAttribute(&cus, hipDeviceAttributeMultiprocessorCount, dev) != hipSuccess) { grid = -1; return; }
        if (hipFuncSetAttribute((const void*)fwd, hipFuncAttributeMaxDynamicSharedMemorySize, LDS_BYTES) != hipSuccess) { fprintf(stderr, "kernel_launch: hipFuncSetAttribute failed\n"); grid = -1; return; }
        if (hipOccupancyMaxActiveBlocksPerMultiprocessor(&per_cu, (const void*)fwd, NTHREADS, LDS_BYTES) != hipSuccess || per_cu < 1) fprintf(stderr, "kernel_launch: occupancy query says %d\n", per_cu);
        (void)hipGetLastError();
        grid = cus;
    }
    if (grid < 0) return;
    if (hipMemsetAsync((char*)d_ws + WS_CTL, 0, CTL_ZERO_BYTES, stream) != hipSuccess) return;
    Args a{};
    a.x = (const float*)d_in[0]; a.ln1_g = (const float*)d_in[1]; a.w_in = (const float*)d_in[2]; a.mix_g = (const float*)d_in[3]; a.w_out = (const float*)d_in[4]; a.ln2_g = (const float*)d_in[5];
    a.w_gr = (const float*)d_in[6]; a.b_gr = (const float*)d_in[7]; a.w_er = (const float*)d_in[8]; a.b_er = (const float*)d_in[9]; a.w_gate = (const float*)d_in[10]; a.w_up = (const float*)d_in[11];
    a.w_down = (const float*)d_in[12]; a.fin_g = (const float*)d_in[13];
    a.out = (float*)d_out; a.ws = (unsigned char*)d_ws; a.pad = 0;
#if N_LAUNCH_MODE == 1
    a.ph_lo = 0; a.ph_hi = PH_COUNT; a.li = 0;
    hipLaunchKernelGGL(fwd, dim3(grid), dim3(NTHREADS), LDS_BYTES, stream, a);
#else
    for (int p = 0; p < PH_COUNT; ++p) { a.ph_lo = p; a.ph_hi = p + 1; a.li = p; hipLaunchKernelGGL(fwd, dim3(grid), dim3(NTHREADS), LDS_BYTES, stream, a); }
#endif
}
```

```cpp
#include <hip/hip_runtime.h>
#include <cstdio>
#include <cstdint>

#define LAS __attribute__((address_space(3)))
#define GAS __attribute__((address_space(1)))
typedef unsigned short bf16_t;
typedef short bf16x8 __attribute__((ext_vector_type(8)));
typedef float f32x4 __attribute__((ext_vector_type(4)));
typedef float f32x2 __attribute__((ext_vector_type(2)));
typedef unsigned u32x4 __attribute__((ext_vector_type(4)));
typedef unsigned u32x2 __attribute__((ext_vector_type(2)));

#ifndef PROBE_REPEAT
#define PROBE_REPEAT 0
#endif
#define RPT(k) ((((PROBE_REPEAT) >> (k)) & 1) ? 2 : 1)
#ifndef MOE_SPARSE
#define MOE_SPARSE 1
#endif
#ifndef ATT_MOBA
#define ATT_MOBA 1
#endif
#ifndef ATT_SB
#define ATT_SB 1
#endif
#ifndef ATT_DIL
#define ATT_DIL 1
#endif
constexpr int BATCH = 4, SEQ = 8192, DM = 1024, DEPTH = 4, T = BATCH * SEQ, NH = 16, HD = 64;
constexpr int NQKV = 3 * DM, NEXP = 16, DEXP = 256, NACT = NEXP * DEXP;
constexpr float NORM_EPS = 1e-6f;
constexpr float LOG2E = 1.4426950408889634f;
constexpr float QSCALE = 0.125f * LOG2E;
constexpr int NWAVES = 8, NTHREADS = 512;

constexpr size_t MiB = 1u << 20;
constexpr size_t WS_CTL = 0, CTL_ZERO_BYTES = 1 * MiB;
constexpr size_t WS_WIN = 2 * MiB;
constexpr size_t WS_WOUT = 26 * MiB;
constexpr size_t WS_WG = 34 * MiB;
constexpr size_t WS_WU = 66 * MiB;
constexpr size_t WS_WD = 98 * MiB;
constexpr size_t WS_LSEM0 = 1 * MiB;
constexpr size_t WS_KMEAN = 130 * MiB;
constexpr size_t WS_HB = 131 * MiB;
constexpr size_t WS_Q = 195 * MiB, WS_K = 259 * MiB, WS_V = 323 * MiB, WS_XB = 387 * MiB;
constexpr size_t WS_ACT = WS_Q;
constexpr size_t WS_SSQ = 130 * MiB + 512 * 1024;
constexpr size_t WS_LSE = 451 * MiB;
constexpr size_t WS_LIST = 454 * MiB;
constexpr size_t WS_WLIST = 457 * MiB;
constexpr size_t WS_QLIST = WS_LIST;
constexpr size_t WS_PM = 463 * MiB;
constexpr size_t WS_LSEM1 = 511 * MiB;
constexpr size_t WS_END = 512 * MiB;
constexpr int QL_PER_BH = 126976;
constexpr int CW_GDONE = 1536;
constexpr int CW_MCNT = 2048;
constexpr int CW_CNT = 1024;
constexpr int CW_TCNT = 16384;
constexpr int CW_BAR = 4096;

constexpr int RING_BYTES = 131072;
constexpr int LDSCTL_OFF = 147456, MISC_OFF = LDSCTL_OFF + 320;
constexpr int LDS_BYTES = 148480;

__device__ __forceinline__ unsigned f2bf(float f) { unsigned u = __builtin_bit_cast(unsigned, f); return (u + 0x7fffu + ((u >> 16) & 1u)) >> 16; }
__device__ __forceinline__ unsigned pk2(float lo, float hi) { return f2bf(lo) | (f2bf(hi) << 16); }
__device__ __forceinline__ float bflo(unsigned w) { return __builtin_bit_cast(float, w << 16); }
__device__ __forceinline__ float bfhi(unsigned w) { return __builtin_bit_cast(float, w & 0xffff0000u); }
template <int M> __device__ __forceinline__ float swz_xor(float v) { return __builtin_bit_cast(float, __builtin_amdgcn_ds_swizzle(__builtin_bit_cast(int, v), 0x1f | (M << 10))); }
__device__ __forceinline__ void swap32(unsigned x, unsigned& lo_val, unsigned& hi_val) { unsigned y = x; asm volatile("" : "+v"(y)); auto rr = __builtin_amdgcn_permlane32_swap(x, y, false, false); lo_val = rr[0]; hi_val = rr[1]; }
__device__ __forceinline__ float sum_xor32(float v) { unsigned a, b; swap32(__builtin_bit_cast(unsigned, v), a, b); return __builtin_bit_cast(float, a) + __builtin_bit_cast(float, b); }
__device__ __forceinline__ float max_xor32(float v) { unsigned a, b; swap32(__builtin_bit_cast(unsigned, v), a, b); return fmaxf(__builtin_bit_cast(float, a), __builtin_bit_cast(float, b)); }
__device__ __forceinline__ float get_xor32(float v, int hi) { unsigned a, b; swap32(__builtin_bit_cast(unsigned, v), a, b); return __builtin_bit_cast(float, hi ? a : b); }
__device__ __forceinline__ int get_xor32i(int v, int hi) { unsigned a, b; swap32((unsigned)v, a, b); return (int)(hi ? a : b); }
template <int CTRL> __device__ __forceinline__ float dpp_mov(float v) { return __builtin_bit_cast(float, __builtin_amdgcn_update_dpp(0, __builtin_bit_cast(int, v), CTRL, 0xf, 0xf, false)); }
__device__ __forceinline__ float row_sum(float v) { v += dpp_mov<0xB1>(v); v += dpp_mov<0x4E>(v); v += dpp_mov<0x141>(v); v += dpp_mov<0x140>(v); return v; }
__device__ __forceinline__ float half_sum(float v) { v = row_sum(v); v += swz_xor<16>(v); return v; }
__device__ __forceinline__ float wave_sum(float v) { return sum_xor32(half_sum(v)); }
#define LDS_WAIT() asm volatile("s_waitcnt lgkmcnt(0)" ::: "memory")
#define LAUNDER_V(x) asm volatile("" : "+v"(x))
#define LAUNDER_S(x) asm volatile("" : "+s"(x))

namespace pg8 {
constexpr int BM = 256, BK = 64, HALF = 128, HTB = HALF * BK * 2, STAGE_BYTES = 8 * HTB, NXCD = 8, WGM = 8;
__host__ __device__ __forceinline__ int lds_byte(int r, int c) { const int st = (r >> 4) * 2 + (c >> 5), rr = r & 15, cc = c & 31, ob = rr * 64 + cc * 2; return st * 1024 + (ob ^ (((ob >> 9) & 1) << 5)); }
__host__ __device__ __forceinline__ void stage_rc(int b, int& R, int& C) { const int st = b / 1024, sb = b % 1024, swz = sb ^ (((sb >> 9) & 1) << 5); R = (st >> 1) * 16 + swz / 64; C = (st & 1) * 32 + (swz % 64) / 2; }
__host__ __device__ __forceinline__ int perm32(int rho) { const int n = rho >> 4, i = rho & 15; return 8 * (i >> 2) + 4 * n + (i & 3); }

struct Unit { int pm, pn, meta;
    __device__ __forceinline__ int bk() const { return meta & 31; } __device__ __forceinline__ int tib() const { return (meta >> 5) & 255; } __device__ __forceinline__ int nb() const { return meta >> 13; } };
struct Gemm { const char* A; const char* B; int lda, ldb, K; long tstepA, tstepB, hstepB; const float* rowvec; };
constexpr int RV_OFF = STAGE_BYTES + 1024;
constexpr int RED_OFF = 140288;

struct StaticOrder {
    int nM, nN, nwg, G, c;
    __host__ __device__ void init(int nM_, int nN_, int G_, int c_) { nM = nM_; nN = nN_; nwg = nM * nN; G = G_; c = c_; }
    __host__ __device__ bool next(int i, Unit& u) const {
        const long L = (long)i * G + c; if (L >= nwg) return false;
        int wgid = (int)L; { const int q = nwg / NXCD, r = nwg % NXCD, xcd = wgid % NXCD, off = wgid / NXCD; wgid = (xcd < r ? xcd * (q + 1) : r * (q + 1) + (xcd - r) * q) + off; }
        const int nig = WGM * nN, gid = wgid / nig, fm = gid * WGM, gsz = (nM - fm) < WGM ? (nM - fm) : WGM;
        u.pm = fm + ((wgid % nig) % gsz); u.pn = (wgid % nig) / gsz; return true;
    }
};

__device__ __forceinline__ unsigned cvt_pk_bf16(float lo, float hi) { unsigned r; asm volatile("v_cvt_pk_bf16_f32 %0, %1, %2" : "=v"(r) : "v"(lo), "v"(hi)); return r; }

struct EpiQKV {
    static constexpr bool PERM = true, ROWVEC = true;
    bf16_t* O; size_t split_stride; float scale0;
    __device__ __forceinline__ void operator()(const f32x4 (&acc)[2][2][4][2], const Unit& u, int wr, int wc, int fr, int fq, const LAS float* rv) const {
        asm volatile("" : "+v"(fr), "+v"(fq));
        float rs[2][4];
#pragma unroll
        for (int ai = 0; ai < 2; ++ai)
#pragma unroll
            for (int m = 0; m < 4; ++m) { const int ri = ai * HALF + wr * 64 + m * 16 + fr; const f32x4 p4 = *(const LAS f32x4*)(rv + 4 * ri); const float ss = (p4.x + p4.y) + (p4.z + p4.w);
                rs[ai][m] = 1.0f / sqrtf(ss * (1.f / DM) + NORM_EPS); }
        const int row0 = u.pm * BM + wr * 64 + fr; int colt = u.pn * BM;
        const int t = colt / DM; bf16_t* base = O + (size_t)t * split_stride; colt -= t * DM; const float sc = (t == 0) ? scale0 : 1.f;
        const int col0 = colt + wc * 32 + 8 * fq;
#pragma unroll
        for (int ai = 0; ai < 2; ++ai)
#pragma unroll
            for (int m = 0; m < 4; ++m) { bf16_t* rowp = base + (size_t)(row0 + ai * HALF + m * 16) * DM + col0;
#pragma unroll
                for (int bj = 0; bj < 2; ++bj) { const float sr = sc * rs[ai][m]; f32x4 v0 = acc[ai][bj][m][0] * sr, v1 = acc[ai][bj][m][1] * sr;
                    u32x4 w; w.x = cvt_pk_bf16(v0[0], v0[1]); w.y = cvt_pk_bf16(v0[2], v0[3]); w.z = cvt_pk_bf16(v1[0], v1[1]); w.w = cvt_pk_bf16(v1[2], v1[3]);
                    *(u32x4*)(rowp + bj * HALF) = w; } }
        if (u.pn == 4) {
            float* kmean = (float*)((unsigned char*)O - WS_Q + WS_KMEAN) + ((size_t)((u.pm >> 5) * 4) * 32 + (u.pm & 31)) * HD;
#pragma unroll
            for (int bj = 0; bj < 2; ++bj)
#pragma unroll
                for (int n = 0; n < 2; ++n)
#pragma unroll
                    for (int j = 0; j < 4; ++j) { float cs = 0.f;
#pragma unroll
                        for (int ai = 0; ai < 2; ++ai)
#pragma unroll
                            for (int m = 0; m < 4; ++m) cs += acc[ai][bj][m][n][j] * rs[ai][m];
                        cs = row_sum(cs);
                        const int col = bj * HALF + wc * 32 + 8 * fq + 4 * n + j;
                        if (fr == 0) __hip_atomic_fetch_add(kmean + (size_t)(col >> 6) * 32 * HD + (col & 63), cs, __ATOMIC_RELAXED, __HIP_MEMORY_SCOPE_AGENT); }
        }
    }
};
struct EpiResAdd {
    static constexpr bool PERM = true, ROWVEC = false;
    bf16_t* xb;
    __device__ __forceinline__ void operator()(const f32x4 (&acc)[2][2][4][2], const Unit& u, int wr, int wc, int fr, int fq, const LAS float*) const {
        asm volatile("" : "+v"(fr), "+v"(fq));
        const int col0 = u.pn * BM + wc * 32 + 8 * fq;
#pragma unroll
        for (int ai = 0; ai < 2; ++ai) { u32x4 r[4][2];
#pragma unroll
            for (int m = 0; m < 4; ++m) { const bf16_t* rowp = xb + (size_t)(u.pm * BM + ai * HALF + wr * 64 + m * 16 + fr) * DM + col0;
#pragma unroll
                for (int bj = 0; bj < 2; ++bj) r[m][bj] = *(const u32x4*)(rowp + bj * HALF); }
#pragma unroll
            for (int m = 0; m < 4; ++m) { bf16_t* rowp = xb + (size_t)(u.pm * BM + ai * HALF + wr * 64 + m * 16 + fr) * DM + col0;
#pragma unroll
                for (int bj = 0; bj < 2; ++bj) { const f32x4 v0 = acc[ai][bj][m][0], v1 = acc[ai][bj][m][1]; const u32x4 q = r[m][bj];
                    u32x4 w; w.x = cvt_pk_bf16(bflo(q.x) + v0[0], bfhi(q.x) + v0[1]); w.y = cvt_pk_bf16(bflo(q.y) + v0[2], bfhi(q.y) + v0[3]);
                    w.z = cvt_pk_bf16(bflo(q.z) + v1[0], bfhi(q.z) + v1[1]); w.w = cvt_pk_bf16(bflo(q.w) + v1[2], bfhi(q.w) + v1[3]);
                    *(u32x4*)(rowp + bj * HALF) = w; } } }
    }
};
struct EpiGateUpDense {
    static constexpr bool PERM = true;
    bf16_t* act; const float* comb;
    __device__ __forceinline__ void operator()(const f32x4 (&acc)[2][2][4][2], const Unit& u, int wr, int wc, int fr, int fq) const {
        asm volatile("" : "+v"(fr), "+v"(fq));
        const int e = u.pn >> 1, c0 = (u.pn & 1) * HALF;
        const int col0 = e * DEXP + c0 + wc * 32 + 8 * fq;
#pragma unroll
        for (int ai = 0; ai < 2; ++ai)
#pragma unroll
            for (int m = 0; m < 4; ++m) { const int row = u.pm * BM + ai * HALF + wr * 64 + m * 16 + fr;
                const float cw = comb[(size_t)row * NEXP + e];
                float o[8];
#pragma unroll
                for (int n = 0; n < 2; ++n)
#pragma unroll
                    for (int j = 0; j < 4; ++j) { const float g = acc[ai][0][m][n][j], up = acc[ai][1][m][n][j];
                        const float sg = g * __builtin_amdgcn_rcpf(1.f + __builtin_amdgcn_exp2f(-g * LOG2E));
                        o[n * 4 + j] = sg * up * cw; }
                u32x4 w; w.x = cvt_pk_bf16(o[0], o[1]); w.y = cvt_pk_bf16(o[2], o[3]); w.z = cvt_pk_bf16(o[4], o[5]); w.w = cvt_pk_bf16(o[6], o[7]);
                *(u32x4*)(act + (size_t)row * NACT + col0) = w; }
    }
};

template <class Epi, class Sched>
__device__ __forceinline__ void gemm_phase(LAS unsigned char* lds, const Gemm g, const Sched& S, const Epi& E, int wave_id) {
    int lane_l = (int)__builtin_amdgcn_mbcnt_hi(~0u, __builtin_amdgcn_mbcnt_lo(~0u, 0u)); asm volatile("" : "+v"(lane_l));
    const int wid = wave_id, lane = lane_l, tid = wid * 64 + lane, wr = wid >> 2, wc = wid & 3, fr = lane & 15, fq = lane >> 4;
    const int K = g.K, nt = K / BK;
    unsigned voffA[2], voffB[2];
#pragma unroll
    for (int i = 0; i < 2; ++i) { int R, C; stage_rc(tid * 16 + i * 8192, R, C); const int Rb = Epi::PERM ? ((R & ~31) + perm32(R & 31)) : R;
        voffA[i] = (unsigned)(R * g.lda + C) * 2u; voffB[i] = (unsigned)(Rb * g.ldb + C) * 2u; }
    const size_t kstep = (size_t)(BK * 2);
    const size_t hstepA = (size_t)HALF * g.lda * 2;
    const long hstepB = g.hstepB;
    const unsigned ldsw = (unsigned)wid * 1024u;
    const int aoff = lds_byte(wr * 64 + fr, fq * 8), boff = lds_byte(wc * 32 + fr, fq * 8);
#define PG8_SA(b, h) (((b) * 2 + (h)) * HTB)
#define PG8_SB(b, h) ((4 + (b) * 2 + (h)) * HTB)
#define PG8_STAGE(bufoff, gbase, voff) do { _Pragma("unroll") for (int _i = 0; _i < 2; ++_i) \
        __builtin_amdgcn_global_load_lds((const unsigned*)((const char*)(gbase) + (voff)[_i]), (LAS unsigned*)(lds + (bufoff) + ldsw + _i * 8192), 16, 0, 0); } while (0)
#define PG8_LDA(dst, b, h) do { _Pragma("unroll") for (int m = 0; m < 4; ++m) _Pragma("unroll") for (int k = 0; k < 2; ++k) dst[m][k] = *(const LAS bf16x8*)(lds + PG8_SA(b, h) + aoff + m * 2048 + k * 1024); } while (0)
#define PG8_LDB(dst, b, h) do { _Pragma("unroll") for (int n = 0; n < 2; ++n) _Pragma("unroll") for (int k = 0; k < 2; ++k) dst[n][k] = *(const LAS bf16x8*)(lds + PG8_SB(b, h) + boff + n * 2048 + k * 1024); } while (0)
#define PG8_MMA(ai, bj, At, Bt) do { __builtin_amdgcn_s_setprio(1); _Pragma("unroll") for (int m = 0; m < 4; ++m) _Pragma("unroll") for (int n = 0; n < 2; ++n) _Pragma("unroll") for (int k = 0; k < 2; ++k) \
        acc[ai][bj][m][n] = __builtin_amdgcn_mfma_f32_16x16x32_bf16(Bt[n][k], At[m][k], acc[ai][bj][m][n], 0, 0, 0); __builtin_amdgcn_s_setprio(0); } while (0)
#define PG8_WAIT_V(n) asm volatile("s_waitcnt vmcnt(" #n ")" ::: "memory")
#define PG8_WAIT_L(n) asm volatile("s_waitcnt lgkmcnt(" #n ")" ::: "memory")
#define PG8_BAR __builtin_amdgcn_s_barrier()
#define PG8_SCHED __builtin_amdgcn_sched_barrier(0)
    Unit cur, nxt; int ui = 0;
    if (!S.next(0, cur)) return;
#define PG8_RV(u_, b_) do { if (Epi::ROWVEC && wid < 4) __builtin_amdgcn_global_load_lds((const unsigned*)(g.rowvec + 4 * ((size_t)(u_).pm * BM + wid * 64 + lane)), (LAS unsigned*)(lds + RV_OFF + (b_) * 4096 + wid * 1024), 16, 0, 0); } while (0)
    PG8_RV(cur, 0);
    f32x4 acc[2][2][4][2];
#pragma unroll
    for (int a = 0; a < 2; ++a)
#pragma unroll
        for (int b = 0; b < 2; ++b)
#pragma unroll
            for (int m = 0; m < 4; ++m)
#pragma unroll
                for (int n = 0; n < 2; ++n) acc[a][b][m][n] = (f32x4){0.f, 0.f, 0.f, 0.f};
    bf16x8 At[4][2], B0[2][2], B1[2][2];
    const char* cA = g.A + (size_t)cur.pm * g.tstepA; const char* cB = g.B + (size_t)cur.pn * g.tstepB;
    PG8_STAGE(PG8_SB(0, 0), cB, voffB); PG8_STAGE(PG8_SB(0, 1), cB + hstepB, voffB); PG8_STAGE(PG8_SA(0, 0), cA, voffA); PG8_STAGE(PG8_SA(0, 1), cA + hstepA, voffA);
    if (wr == 1) PG8_BAR;
    PG8_WAIT_V(2); PG8_BAR;
    PG8_STAGE(PG8_SB(1, 0), cB + kstep, voffB); PG8_STAGE(PG8_SA(1, 0), cA + kstep, voffA); PG8_STAGE(PG8_SB(1, 1), cB + hstepB + kstep, voffB);
    PG8_WAIT_V(6); PG8_BAR;
    for (;;) {
        const bool has_next = S.next(ui + 1, nxt);
        const char* nA = has_next ? g.A + (size_t)nxt.pm * g.tstepA : cA; const char* nB = has_next ? g.B + (size_t)nxt.pn * g.tstepB : cB;
        for (int t = 0; t < nt; t += 2) {
            const bool last = (t == nt - 2);
            const char* a1 = cA + (size_t)(t + 1) * kstep;
            const char* a2 = last ? nA : cA + (size_t)(t + 2) * kstep; const char* b2 = last ? nB : cB + (size_t)(t + 2) * kstep;
            const char* a3 = a2 + kstep; const char* b3 = b2 + kstep;
            PG8_LDB(B0, 0, 0); PG8_LDB(B1, 0, 1); PG8_SCHED; PG8_LDA(At, 0, 0); PG8_STAGE(PG8_SA(1, 1), a1 + hstepA, voffA);
            PG8_WAIT_V(8); PG8_WAIT_L(0); PG8_BAR; PG8_MMA(0, 0, At, B0); PG8_MMA(0, 1, At, B1); PG8_BAR; PG8_SCHED;
            PG8_LDA(At, 0, 1); PG8_STAGE(PG8_SB(0, 0), b2, voffB); PG8_STAGE(PG8_SB(0, 1), b2 + hstepB, voffB); PG8_STAGE(PG8_SA(0, 0), a2, voffA);
            PG8_WAIT_V(8); PG8_WAIT_L(0); PG8_BAR; PG8_MMA(1, 0, At, B0); PG8_MMA(1, 1, At, B1); PG8_BAR; PG8_SCHED;
            PG8_LDB(B0, 1, 0); PG8_LDB(B1, 1, 1); PG8_SCHED; PG8_LDA(At, 1, 0); PG8_STAGE(PG8_SA(0, 1), a2 + hstepA, voffA);
            PG8_WAIT_V(8); PG8_WAIT_L(0); PG8_BAR; PG8_MMA(0, 0, At, B0); PG8_MMA(0, 1, At, B1); PG8_BAR; PG8_SCHED;
            PG8_LDA(At, 1, 1); PG8_STAGE(PG8_SB(1, 0), b3, voffB); PG8_STAGE(PG8_SB(1, 1), b3 + hstepB, voffB); PG8_STAGE(PG8_SA(1, 0), a3, voffA);
            PG8_WAIT_V(8); PG8_WAIT_L(0); PG8_BAR; PG8_MMA(1, 0, At, B0); PG8_MMA(1, 1, At, B1); PG8_BAR; PG8_SCHED;
        }
        if (wr == 0) PG8_BAR;
        E(acc, cur, wr, wc, fr, fq, (const LAS float*)(lds + RV_OFF + (ui & 1) * 4096));
        if (!has_next) break;
#pragma unroll
        for (int a = 0; a < 2; ++a)
#pragma unroll
            for (int b = 0; b < 2; ++b)
#pragma unroll
                for (int m = 0; m < 4; ++m)
#pragma unroll
                    for (int n = 0; n < 2; ++n) acc[a][b][m][n] = (f32x4){0.f, 0.f, 0.f, 0.f};
        cur = nxt; cA = nA; cB = nB; ++ui;
        PG8_RV(cur, ui & 1);
        if (wr == 1) PG8_BAR;
    }
    PG8_WAIT_V(0);
    PG8_BAR;
#undef PG8_SA
#undef PG8_SB
#undef PG8_STAGE
#undef PG8_LDA
#undef PG8_LDB
#undef PG8_MMA
#undef PG8_WAIT_V
#undef PG8_WAIT_L
#undef PG8_BAR
#undef PG8_SCHED
#undef PG8_RV
}
template <class Epi, class Prob>
__device__ __forceinline__ void gemm_phase_x(LAS unsigned char* lds, const Prob& P, const Epi& E, int wave_id) {
    int lane_l = (int)__builtin_amdgcn_mbcnt_hi(~0u, __builtin_amdgcn_mbcnt_lo(~0u, 0u)); asm volatile("" : "+v"(lane_l));
    const int wid = wave_id, lane = lane_l, tid = wid * 64 + lane, wr = wid >> 2, wc = wid & 3, fr = lane & 15, fq = lane >> 4;
    const int K = P.K, nt = K / BK;
    unsigned voffB[2];
#pragma unroll
    for (int i = 0; i < 2; ++i) { int R, C; stage_rc(tid * 16 + i * 8192, R, C); const int Rb = Epi::PERM ? ((R & ~31) + perm32(R & 31)) : R; voffB[i] = (unsigned)(Rb * P.ldb + C) * 2u; }
    const size_t kstep = (size_t)(BK * 2);
    const long hstepB = P.hstepB;
    const unsigned ldsw = (unsigned)wid * 1024u;
    const int aoff = lds_byte(wr * 64 + fr, fq * 8), boff = lds_byte(wc * 32 + fr, fq * 8);
    LAS u32x4* stash = (LAS u32x4*)(lds + STAGE_BYTES + 1024) + tid;
#define PG8_SA(b, h) (((b) * 2 + (h)) * HTB)
#define PG8_SB(b, h) ((4 + (b) * 2 + (h)) * HTB)
#define PG8_STAGE(bufoff, gbase, voff) do { _Pragma("unroll") for (int _i = 0; _i < 2; ++_i) \
        __builtin_amdgcn_global_load_lds((const unsigned*)((const char*)(gbase) + (voff)[_i]), (LAS unsigned*)(lds + (bufoff) + ldsw + _i * 8192), 16, 0, 0); } while (0)
#define PG8_LDA(dst, b, h) do { _Pragma("unroll") for (int m = 0; m < 4; ++m) _Pragma("unroll") for (int k = 0; k < 2; ++k) dst[m][k] = *(const LAS bf16x8*)(lds + PG8_SA(b, h) + aoff + m * 2048 + k * 1024); } while (0)
#define PG8_LDB(dst, b, h) do { _Pragma("unroll") for (int n = 0; n < 2; ++n) _Pragma("unroll") for (int k = 0; k < 2; ++k) dst[n][k] = *(const LAS bf16x8*)(lds + PG8_SB(b, h) + boff + n * 2048 + k * 1024); } while (0)
#define PG8_MMA(ai, bj, At, Bt) do { __builtin_amdgcn_s_setprio(1); _Pragma("unroll") for (int m = 0; m < 4; ++m) _Pragma("unroll") for (int n = 0; n < 2; ++n) _Pragma("unroll") for (int k = 0; k < 2; ++k) \
        acc[ai][bj][m][n] = __builtin_amdgcn_mfma_f32_16x16x32_bf16(Bt[n][k], At[m][k], acc[ai][bj][m][n], 0, 0, 0); __builtin_amdgcn_s_setprio(0); } while (0)
#define PG8_WAIT_V(n) asm volatile("s_waitcnt vmcnt(" #n ")" ::: "memory")
#define PG8_WAIT_L(n) asm volatile("s_waitcnt lgkmcnt(" #n ")" ::: "memory")
#define PG8_BAR __builtin_amdgcn_s_barrier()
#define PG8_SCHED __builtin_amdgcn_sched_barrier(0)
#define PG8_AVOFF(dst, u) do { int t2_ = tid; asm volatile("" : "+v"(t2_)); _Pragma("unroll") for (int i_ = 0; i_ < 2; ++i_) { int R_, C_; stage_rc(t2_ * 16 + i_ * 8192, R_, C_); _Pragma("unroll") for (int h_ = 0; h_ < 2; ++h_) \
        dst[h_][i_] = (Prob::GATHER ? P.arow_off(u, h_, R_) : (unsigned)((h_ * HALF + R_) * P.lda) * 2u) + (unsigned)C_ * 2u; } } while (0)
    Unit cur, nxt; int ui = 0;
    if (!P.next(0, cur)) return;
    unsigned vA[2][2];
    PG8_AVOFF(vA, cur);
    f32x4 acc[2][2][4][2];
#pragma unroll
    for (int a = 0; a < 2; ++a)
#pragma unroll
        for (int b = 0; b < 2; ++b)
#pragma unroll
            for (int m = 0; m < 4; ++m)
#pragma unroll
                for (int n = 0; n < 2; ++n) acc[a][b][m][n] = (f32x4){0.f, 0.f, 0.f, 0.f};
    bf16x8 At[4][2], B0[2][2], B1[2][2];
    const char* cA = P.a_base(cur); const char* cB = P.b_base(cur);
    long csplit = Prob::KSPLIT ? P.bsplit(cur) : 0;
    if (Prob::WAITS) P.a_ready(cur, wid);
    PG8_STAGE(PG8_SB(0, 0), cB, voffB); PG8_STAGE(PG8_SB(0, 1), cB + hstepB, voffB); PG8_STAGE(PG8_SA(0, 0), cA, vA[0]); PG8_STAGE(PG8_SA(0, 1), cA, vA[1]);
    if (wr == 1) PG8_BAR;
    PG8_WAIT_V(2); PG8_BAR;
    PG8_STAGE(PG8_SB(1, 0), cB + kstep, voffB); PG8_STAGE(PG8_SA(1, 0), cA + kstep, vA[0]); PG8_STAGE(PG8_SB(1, 1), cB + hstepB + kstep, voffB);
    PG8_WAIT_V(6); PG8_BAR;
    for (;;) {
        const bool has_next = P.next(ui + 1, nxt);
        const char* nA = has_next ? P.a_base(nxt) : cA; const char* nB = has_next ? P.b_base(nxt) : cB;
        if (Prob::GATHER) { unsigned vN[2][2];
            if (has_next) { PG8_AVOFF(vN, nxt); } else { vN[0][0] = vA[0][0]; vN[0][1] = vA[0][1]; vN[1][0] = vA[1][0]; vN[1][1] = vA[1][1]; }
            *stash = (u32x4){vN[0][0], vN[0][1], vN[1][0], vN[1][1]}; }
        for (int t = 0; t < nt; t += 2) {
            const bool last = (t == nt - 2);
            if (Prob::WAITS && last && has_next) P.a_ready(nxt, wid);
            const char* a1 = cA + (size_t)(t + 1) * kstep;
            const char* a2 = last ? nA : cA + (size_t)(t + 2) * kstep;
            const char* b2 = last ? nB : cB + (size_t)(t + 2) * kstep + ((Prob::KSPLIT && (t + 2) >= (nt >> 1)) ? csplit : 0);
            const char* a3 = a2 + kstep; const char* b3 = b2 + kstep;
            PG8_LDB(B0, 0, 0); PG8_LDB(B1, 0, 1); PG8_SCHED; PG8_LDA(At, 0, 0); PG8_STAGE(PG8_SA(1, 1), a1, vA[1]);
            if (Prob::GATHER && last) { const u32x4 sv = *stash; vA[0][0] = sv.x; vA[0][1] = sv.y; vA[1][0] = sv.z; vA[1][1] = sv.w; }
            PG8_WAIT_V(8); PG8_WAIT_L(0); PG8_BAR; PG8_MMA(0, 0, At, B0); PG8_MMA(0, 1, At, B1); PG8_BAR; PG8_SCHED;
            PG8_LDA(At, 0, 1); PG8_STAGE(PG8_SB(0, 0), b2, voffB); PG8_STAGE(PG8_SB(0, 1), b2 + hstepB, voffB); PG8_STAGE(PG8_SA(0, 0), a2, vA[0]);
            PG8_WAIT_V(8); PG8_WAIT_L(0); PG8_BAR; PG8_MMA(1, 0, At, B0); PG8_MMA(1, 1, At, B1); PG8_BAR; PG8_SCHED;
            PG8_LDB(B0, 1, 0); PG8_LDB(B1, 1, 1); PG8_SCHED; PG8_LDA(At, 1, 0); PG8_STAGE(PG8_SA(0, 1), a2, vA[1]);
            PG8_WAIT_V(8); PG8_WAIT_L(0); PG8_BAR; PG8_MMA(0, 0, At, B0); PG8_MMA(0, 1, At, B1); PG8_BAR; PG8_SCHED;
            PG8_LDA(At, 1, 1); PG8_STAGE(PG8_SB(1, 0), b3, voffB); PG8_STAGE(PG8_SB(1, 1), b3 + hstepB, voffB); PG8_STAGE(PG8_SA(1, 0), a3, vA[0]);
            PG8_WAIT_V(8); PG8_WAIT_L(0); PG8_BAR; PG8_MMA(1, 0, At, B0); PG8_MMA(1, 1, At, B1); PG8_BAR; PG8_SCHED;
        }
        if (wr == 0) PG8_BAR;
        E(acc, cur, wr, wc, fr, fq);
        if (!has_next) break;
#pragma unroll
        for (int a = 0; a < 2; ++a)
#pragma unroll
            for (int b = 0; b < 2; ++b)
#pragma unroll
                for (int m = 0; m < 4; ++m)
#pragma unroll
                    for (int n = 0; n < 2; ++n) acc[a][b][m][n] = (f32x4){0.f, 0.f, 0.f, 0.f};
        cur = nxt; cA = nA; cB = nB; ++ui;
        if (Prob::KSPLIT) csplit = P.bsplit(cur);
        if (wr == 1) PG8_BAR;
    }
    PG8_WAIT_V(0);
    PG8_BAR;
#undef PG8_SA
#undef PG8_SB
#undef PG8_STAGE
#undef PG8_LDA
#undef PG8_LDB
#undef PG8_MMA
#undef PG8_WAIT_V
#undef PG8_WAIT_L
#undef PG8_BAR
#undef PG8_SCHED
#undef PG8_AVOFF
}

__device__ __forceinline__ int pair_a(int pi) { return pi < 3 ? 0 : (pi < 5 ? 1 : 2); }
__device__ __forceinline__ int pair_b(int pi) { return pi == 0 ? 1 : ((pi == 1 || pi == 3) ? 2 : 3); }
template <int MODE>
struct MoeProb {
    static constexpr bool GATHER = (MODE == 0), KSPLIT = (MODE == 1);
    const unsigned* cnt; const unsigned* list; const char* A; const char* B; int lda, ldb, K; long hstepB; int G, c; unsigned* tcnt;
    static constexpr bool WAITS = (MODE == 1);
    __device__ __forceinline__ void a_ready(const Unit& u, int wave) const {
        if (MODE == 1) {
            if (wave == 0) { unsigned polls = 0;
                while ((unsigned)__builtin_amdgcn_readfirstlane(__hip_atomic_load(tcnt + 64 * u.pm, __ATOMIC_RELAXED, __HIP_MEMORY_SCOPE_AGENT)) < 32u) {
                    if (++polls > (1u << 20)) break;
                    __builtin_amdgcn_s_sleep(2); }
                __builtin_amdgcn_fence(__ATOMIC_ACQUIRE, "agent");
                asm volatile("s_waitcnt vmcnt(0)" ::: "memory"); }
            asm volatile("" ::: "memory"); __builtin_amdgcn_s_barrier(); asm volatile("" ::: "memory");
        }
    }
    __device__ __forceinline__ bool next(int i, Unit& u) const {
        long L = (long)i * G + c;
        if (MODE == 1) {
            int tot = 0;
            for (int k = 0; k < 24; ++k) tot += ((int)cnt[k] + 255) >> 8;
            const int N = 4 * tot, R = N - 2 * G;
            if (R > 0 && R < G) { if (c < R) { if (i > 0) return false; L = c; } else L = (i == 0) ? c : (long)G + (c - R) + (long)(i - 1) * (G - R); }
            else L = (long)i * G + (G - 1 - c);
        }
        const int tileidx = (int)(L >> 2);
        int accu = 0, bk = -1, tib = 0, nb = 0;
        for (int k = 0; k < 24; ++k) { const int n = (int)cnt[k]; const int tl = (n + 255) >> 8; if (bk < 0 && tileidx < accu + tl) { bk = k; tib = tileidx - accu; nb = n; } accu += tl; }
        if (bk < 0) return false;
        u.pm = tileidx; u.pn = (int)(L & 3); u.meta = bk | (tib << 5) | (nb << 13); return true;
    }
    __device__ __forceinline__ int expert(const Unit& u, int s) const { const int g = u.bk() / 6, pi = u.bk() % 6; return g * 4 + (s ? pair_b(pi) : pair_a(pi)); }
    __device__ __forceinline__ const char* a_base(const Unit& u) const { return MODE == 0 ? A : A + (size_t)u.pm * 256 * lda * 2; }
    __device__ __forceinline__ const char* b_base(const Unit& u) const {
        if (MODE == 0) return B + ((size_t)expert(u, u.pn >> 1) * DEXP + (size_t)(u.pn & 1) * HALF) * ldb * 2;
        return B + (size_t)u.pn * 256 * ldb * 2 + (size_t)expert(u, 0) * DEXP * 2;
    }
    __device__ __forceinline__ unsigned arow_off(const Unit& u, int h, int R) const { const int pos = u.tib() * 256 + h * HALF + R; const unsigned tok = pos < u.nb() ? list[(size_t)u.bk() * T + pos] : 0u; return tok * (unsigned)(lda * 2); }
    __device__ __forceinline__ long bsplit(const Unit& u) const { return ((long)(expert(u, 1) - expert(u, 0)) * DEXP - DEXP) * 2; }
};
struct EpiGateUpSparse {
    static constexpr bool PERM = true;
    bf16_t* act; const float* wlist; const float* rlist; unsigned* tcnt;
    __device__ __forceinline__ void operator()(const f32x4 (&acc)[2][2][4][2], const Unit& u, int wr, int wc, int fr, int fq) const {
        asm volatile("" : "+v"(fr), "+v"(fq));
        const int s = u.pn >> 1, col0 = s * DEXP + (u.pn & 1) * HALF + wc * 32 + 8 * fq;
        const __amdgpu_buffer_rsrc_t rs_act = __builtin_amdgcn_make_buffer_rsrc((void*)act, (short)0, 0x7fffffff, 0x00020000);
#pragma unroll
        for (int ai = 0; ai < 2; ++ai)
#pragma unroll
            for (int m = 0; m < 4; ++m) { const int r = ai * HALF + wr * 64 + m * 16 + fr, pos = u.tib() * 256 + r;
                const float cw = pos < u.nb() ? wlist[((size_t)u.bk() * T + pos) * 2 + s] : 0.f; const float rs = pos < u.nb() ? rlist[(size_t)u.bk() * T + pos] : 0.f;
                float o[8];
#pragma unroll
                for (int n = 0; n < 2; ++n)
#pragma unroll
                    for (int j = 0; j < 4; ++j) { const float g = acc[ai][0][m][n][j] * rs, up = acc[ai][1][m][n][j] * rs;
                        const float sg = g * __builtin_amdgcn_rcpf(1.f + __builtin_amdgcn_exp2f(-g * LOG2E));
                        o[n * 4 + j] = sg * up * cw; }
                u32x4 w; w.x = cvt_pk_bf16(o[0], o[1]); w.y = cvt_pk_bf16(o[2], o[3]); w.z = cvt_pk_bf16(o[4], o[5]); w.w = cvt_pk_bf16(o[6], o[7]);
                __builtin_amdgcn_raw_buffer_store_b128(w, rs_act, (int)((((unsigned)u.pm * 256u + (unsigned)r) * 512u + (unsigned)col0) * 2u), 0, 16);
                if (m & 1) asm volatile("" ::: "memory"); }
        asm volatile("s_waitcnt vmcnt(0)" ::: "memory");
        if ((fr | fq) == 0) __hip_atomic_fetch_add(tcnt + 64 * u.pm, 1u, __ATOMIC_RELAXED, __HIP_MEMORY_SCOPE_AGENT);
    }
};
struct EpiDownScatter {
    static constexpr bool PERM = true;
    bf16_t* xb; const unsigned* list; float* ssq; LAS unsigned char* ldsb;
    __device__ __forceinline__ void operator()(const f32x4 (&acc)[2][2][4][2], const Unit& u, int wr, int wc, int fr, int fq) const {
        asm volatile("" : "+v"(fr), "+v"(fq));
        const int col0 = u.pn * BM + wc * 32 + 8 * fq;
        unsigned tok[8];
#pragma unroll
        for (int g = 0; g < 8; ++g) { const int pos = u.tib() * 256 + (g >> 2) * HALF + wr * 64 + (g & 3) * 16 + fr; tok[g] = pos < u.nb() ? list[(size_t)u.bk() * T + pos] : 0xffffffffu; }
#pragma unroll
        for (int ai = 0; ai < 2; ++ai) { u32x4 r[4][2];
#pragma unroll
            for (int m = 0; m < 4; ++m) { const unsigned tk = tok[ai * 4 + m]; const bf16_t* rowp = xb + (size_t)(tk != 0xffffffffu ? tk : 0u) * DM + col0;
#pragma unroll
                for (int bj = 0; bj < 2; ++bj) r[m][bj] = *(const u32x4*)(rowp + bj * HALF); }
#pragma unroll
            for (int m = 0; m < 4; ++m) { const unsigned tk = tok[ai * 4 + m]; float sq = 0.f;
                if (tk != 0xffffffffu) { bf16_t* rowp = xb + (size_t)tk * DM + col0;
#pragma unroll
                    for (int bj = 0; bj < 2; ++bj) { const f32x4 v0 = acc[ai][bj][m][0], v1 = acc[ai][bj][m][1]; const u32x4 q = r[m][bj];
                        u32x4 w; w.x = cvt_pk_bf16(bflo(q.x) + v0[0], bfhi(q.x) + v0[1]); w.y = cvt_pk_bf16(bflo(q.y) + v0[2], bfhi(q.y) + v0[3]);
                        w.z = cvt_pk_bf16(bflo(q.z) + v1[0], bfhi(q.z) + v1[1]); w.w = cvt_pk_bf16(bflo(q.w) + v1[2], bfhi(q.w) + v1[3]);
                        *(u32x4*)(rowp + bj * HALF) = w;
                        const float a0 = bflo(w.x), a1 = bfhi(w.x), a2 = bflo(w.y), a3 = bfhi(w.y), a4 = bflo(w.z), a5 = bfhi(w.z), a6 = bflo(w.w), a7 = bfhi(w.w);
                        sq += ((a0 * a0 + a1 * a1) + (a2 * a2 + a3 * a3)) + ((a4 * a4 + a5 * a5) + (a6 * a6 + a7 * a7)); } }
                sq += swz_xor<16>(sq); sq = sum_xor32(sq);
                if (fq == 0) { const int ri = ai * HALF + wr * 64 + m * 16 + fr; ((LAS float*)(ldsb + RED_OFF))[wc * 256 + ri] = sq; if (wc == 0) ((LAS unsigned*)(ldsb + RED_OFF + 4096))[ri] = tk; } } }
        asm volatile("s_waitcnt lgkmcnt(0)" ::: "memory"); __builtin_amdgcn_s_barrier(); asm volatile("" ::: "memory");
        { const int ri = (wr * 4 + wc) * 64 + fq * 16 + fr;
          if (ri < 256) { const LAS float* rp = (const LAS float*)(ldsb + RED_OFF) + ri; const unsigned tk = ((const LAS unsigned*)(ldsb + RED_OFF + 4096))[ri];
              if (tk != 0xffffffffu) ssq[(size_t)tk * 4 + u.pn] = (rp[0] + rp[256]) + (rp[512] + rp[768]); } }
    }
};
}

#define XB_TMO      128
#define XB_XCNT(j)  (256  + 64 * (j))
#define XB_XSUB(j)  (1280 + 64 * (j))
#define XB_XGEN(j)  (2304 + 64 * (j))
#define XB_TOP      3328
#define XB_TOPGEN   3392
#define XCD_BAR_WORDS 3456
#define XB_SPIN_CAP (1u << 18)
__device__ __forceinline__ unsigned xb_ld(unsigned* p)              { return __hip_atomic_load(p, __ATOMIC_RELAXED, __HIP_MEMORY_SCOPE_AGENT); }
__device__ __forceinline__ unsigned xb_add(unsigned* p, unsigned v) { return __hip_atomic_fetch_add(p, v, __ATOMIC_RELAXED, __HIP_MEMORY_SCOPE_AGENT); }
__device__ __forceinline__ unsigned xb_xcc_id() { return (unsigned)__builtin_amdgcn_s_getreg((3 << 11) | 20) & 0xFu; }
#define XB_SPIN(cond, bar) do { unsigned _sp = 0; while (cond) { __builtin_amdgcn_s_sleep(1); \
    if ((++_sp & 255u) == 0u) { if (xb_ld(&(bar)[XB_TMO])) break; if (_sp > XB_SPIN_CAP) { atomicAdd(&(bar)[XB_TMO], 1u); break; } } } } while (0)
struct XcdBarrier { unsigned* bar; unsigned x; volatile LAS unsigned* st; int wave; };
__device__ __forceinline__ bool xb_thread0(int wave) { return wave == 0 && __builtin_amdgcn_mbcnt_hi(~0u, __builtin_amdgcn_mbcnt_lo(~0u, 0u)) == 0u; }
__device__ __forceinline__ XcdBarrier xcd_barrier_post(unsigned* bar, volatile LAS unsigned* st, int wave) {
    XcdBarrier b; b.bar = bar; b.x = xb_xcc_id(); b.st = st; b.wave = wave;
    if (xb_thread0(wave)) (void)xb_add(&bar[XB_XCNT(b.x)], 1u);
    return b;
}
__device__ __forceinline__ void xcd_barrier_complete(unsigned* bar, unsigned x, unsigned& nloc, unsigned& nx) {
    const unsigned G = gridDim.x * gridDim.y * gridDim.z;
    unsigned sum, cnt, mine, sp = 0u;
    for (;;) {
        sum = 0u; cnt = 0u; mine = 0u;
#pragma unroll
        for (unsigned j = 0; j < 16; ++j) { const unsigned c = xb_ld(&bar[XB_XCNT(j)]); sum += c; cnt += (c > 0u) ? 1u : 0u; mine = (j == x) ? c : mine; }
        if (sum == G) break;
        __builtin_amdgcn_s_sleep(1);
        if ((++sp & 255u) == 0u) { if (xb_ld(&bar[XB_TMO])) break; if (sp > XB_SPIN_CAP) { atomicAdd(&bar[XB_TMO], 1u); break; } }
    }
    nloc = mine > 0u ? mine : 1u; nx = cnt > 0u ? cnt : 1u;
}
__device__ __forceinline__ void xcd_barrier(const XcdBarrier& b) {
    asm volatile("s_waitcnt vmcnt(0)" ::: "memory");
    __syncthreads();
    if (xb_thread0(b.wave)) {
        unsigned* bar = b.bar;
        __builtin_amdgcn_s_waitcnt(0);
        unsigned nloc = b.st[0], nx = b.st[1];
        if (nloc == 0u) { xcd_barrier_complete(bar, b.x, nloc, nx); b.st[0] = nloc; b.st[1] = nx; }
        const unsigned old = xb_add(&bar[XB_XSUB(b.x)], 1u);
        const unsigned gen = old / nloc;
        if (old + 1u == (gen + 1u) * nloc) {
            __builtin_amdgcn_fence(__ATOMIC_RELEASE, "agent");
            asm volatile("s_waitcnt vmcnt(0)" ::: "memory");
            const unsigned og = xb_add(&bar[XB_TOP], 1u);
            const unsigned tg = og / nx;
            if (og + 1u == (tg + 1u) * nx) xb_add(&bar[XB_TOPGEN], 1u);
            else XB_SPIN(xb_ld(&bar[XB_TOPGEN]) == tg, bar);
            __builtin_amdgcn_fence(__ATOMIC_ACQUIRE, "agent");
            xb_add(&bar[XB_XGEN(b.x)], 1u);
            asm volatile("s_waitcnt vmcnt(0)" ::: "memory");
        } else {
            XB_SPIN(xb_ld(&bar[XB_XGEN(b.x)]) == gen, bar);
            __builtin_amdgcn_fence(__ATOMIC_ACQUIRE, "agent");
            asm volatile("s_waitcnt vmcnt(0)" ::: "memory");
        }
    }
    __syncthreads();
}

struct Args {
    const float* x; const float* ln1_g; const float* w_in; const float* mix_g; const float* w_out; const float* ln2_g;
    const float* w_gr; const float* b_gr; const float* w_er; const float* b_er; const float* w_gate; const float* w_up; const float* w_down; const float* fin_g;
    float* out; unsigned char* ws; int ph_lo, ph_hi, li, pad;
};

__device__ __forceinline__ void transpose_item(const float* W, int K, int N, bf16_t* WT, int dpitch, int dcol, int item, int lane, const float* ks) {
    const int nblk = N / 64, kb = item / nblk, nb = item % nblk, k0 = 64 * kb, n0 = 64 * nb;
    const int i = lane & 15, q = lane >> 4, ar = 8 * (i >> 2) + (i & 3);
    f32x4 v[2][2][2][2];
#pragma unroll
    for (int kh = 0; kh < 2; ++kh)
#pragma unroll
        for (int t = 0; t < 2; ++t)
#pragma unroll
            for (int c = 0; c < 2; ++c)
#pragma unroll
                for (int e2 = 0; e2 < 2; ++e2) v[kh][t][c][e2] = *(const f32x4*)(W + (size_t)(k0 + 32 * kh + ar + 4 * t) * N + n0 + 32 * c + 16 * e2 + 4 * q);
    float gk[2][2] = {{1.f, 1.f}, {1.f, 1.f}};
    if (ks) {
#pragma unroll
        for (int kh = 0; kh < 2; ++kh)
#pragma unroll
            for (int t = 0; t < 2; ++t) gk[kh][t] = ks[k0 + 32 * kh + ar + 4 * t]; }
    u32x4 s0 = {0u, 0u, 0u, 0u}, s1 = s0;
    if ((i >> 2) == q) { const unsigned one = (i & 1) ? 0x3f800000u : 0x00003f80u;
        if (i & 2) { s0.y = one; s1.w = one; } else { s0.x = one; s1.z = one; } }
    const bf16x8 sel0 = __builtin_bit_cast(bf16x8, s0), sel1 = __builtin_bit_cast(bf16x8, s1);
    const f32x4 z4 = {0.f, 0.f, 0.f, 0.f};
#pragma unroll
    for (int c = 0; c < 2; ++c) {
        bf16x8 A[2][2];
#pragma unroll
        for (int kh = 0; kh < 2; ++kh)
#pragma unroll
            for (int t = 0; t < 2; ++t) { const f32x4 lo = v[kh][t][c][0] * gk[kh][t], hi = v[kh][t][c][1] * gk[kh][t];
                u32x4 p; p.x = pk2(lo.x, lo.y); p.y = pk2(lo.z, lo.w); p.z = pk2(hi.x, hi.y); p.w = pk2(hi.z, hi.w); A[kh][t] = __builtin_bit_cast(bf16x8, p); }
#pragma unroll
        for (int h = 0; h < 2; ++h) { bf16_t* orow = WT + (size_t)(n0 + 32 * c + 16 * h + i) * dpitch + dcol + k0 + 8 * q;
#pragma unroll
            for (int kh = 0; kh < 2; ++kh) { const f32x4 d0 = __builtin_amdgcn_mfma_f32_16x16x32_bf16(A[kh][0], h ? sel1 : sel0, z4, 0, 0, 0), d1 = __builtin_amdgcn_mfma_f32_16x16x32_bf16(A[kh][1], h ? sel1 : sel0, z4, 0, 0, 0);
                const float e0 = d0.x, e1 = d0.y, e2 = d0.z, e3 = d0.w, e4 = d1.x, e5 = d1.y, e6 = d1.z, e7 = d1.w;
#define TP_PK(lo_, hi_) ((__builtin_bit_cast(unsigned, lo_) >> 16) | (__builtin_bit_cast(unsigned, hi_) & 0xffff0000u))
                u32x4 o; o.x = TP_PK(e0, e1); o.y = TP_PK(e2, e3); o.z = TP_PK(e4, e5); o.w = TP_PK(e6, e7);
#undef TP_PK
                *(u32x4*)(orow + 32 * kh) = o; } } }
}
__device__ __forceinline__ void phase_prologue(const Args& a, LAS unsigned char* lds, int gw, int NGW, int wave, int lane) {
    constexpr int I_IN = (DM / 64) * (NQKV / 64);
    constexpr int I_OUT = (DM / 64) * (DM / 64);
    constexpr int I_G = (DM / 64) * (DEXP / 64);
    constexpr int I_D = (DEXP / 64) * (DM / 64);
    constexpr int N_IN = DEPTH * I_IN, N_OUT = DEPTH * I_OUT, N_G = DEPTH * NEXP * I_G, N_D = DEPTH * NEXP * I_D;
    constexpr int NITEMS = N_IN + N_OUT + 2 * N_G + N_D;
    bf16_t* WinT = (bf16_t*)(a.ws + WS_WIN); bf16_t* WoutT = (bf16_t*)(a.ws + WS_WOUT); bf16_t* WgT = (bf16_t*)(a.ws + WS_WG); bf16_t* WuT = (bf16_t*)(a.ws + WS_WU); bf16_t* WdT = (bf16_t*)(a.ws + WS_WD);
    for (int it = gw; it < NITEMS; it += NGW) {
        int r = it;
        if (r < N_IN) { const int l = r / I_IN; transpose_item(a.w_in + (size_t)l * DM * NQKV, DM, NQKV, WinT + (size_t)l * NQKV * DM, DM, 0, r % I_IN, lane, a.ln1_g + (size_t)l * DM); continue; } r -= N_IN;
        if (r < N_OUT) { const int l = r / I_OUT; transpose_item(a.w_out + (size_t)l * DM * DM, DM, DM, WoutT + (size_t)l * DM * DM, DM, 0, r % I_OUT, lane, nullptr); continue; } r -= N_OUT;
        if (r < N_G) { const int le = r / I_G; transpose_item(a.w_gate + (size_t)le * DM * DEXP, DM, DEXP, WgT + (size_t)le * DEXP * DM, DM, 0, r % I_G, lane, a.ln2_g + (size_t)(le / NEXP) * DM); continue; } r -= N_G;
        if (r < N_G) { const int le = r / I_G; transpose_item(a.w_up + (size_t)le * DM * DEXP, DM, DEXP, WuT + (size_t)le * DEXP * DM, DM, 0, r % I_G, lane, a.ln2_g + (size_t)(le / NEXP) * DM); continue; } r -= N_G;
        { const int le = r / I_D, l = le / NEXP, e = le % NEXP; transpose_item(a.w_down + (size_t)le * DEXP * DM, DEXP, DM, WdT + (size_t)l * DM * NACT, NACT, e * DEXP, r % I_D, lane, nullptr); }
    }
}

__device__ __forceinline__ void phase_norm1(const float* x, int gw, int NGW, int lane, float* kmean_zero, bf16_t* xb, float* ssq_out) {
    for (int i = gw * 64 + lane; i < BATCH * 4 * 32 * HD; i += NGW * 64) kmean_zero[i] = 0.f;
    for (int m = gw; m < T; m += NGW) {
        const f32x4* xr = (const f32x4*)(x + (size_t)m * DM) + lane;
        f32x4 v[4]; float s = 0.f;
#pragma unroll
        for (int j = 0; j < 4; ++j) v[j] = xr[64 * j];
        u32x2* x8 = (u32x2*)(xb + (size_t)m * DM) + lane;
#pragma unroll
        for (int j = 0; j < 4; ++j) { u32x2 c; c.x = pk2(v[j].x, v[j].y); c.y = pk2(v[j].z, v[j].w); x8[64 * j] = c;
            const float a0 = bflo(c.x), a1 = bfhi(c.x), a2 = bflo(c.y), a3 = bfhi(c.y); s += (a0 * a0 + a1 * a1) + (a2 * a2 + a3 * a3); }
        s = wave_sum(s);
        if (lane == 0) *(f32x4*)(ssq_out + (size_t)m * 4) = (f32x4){s, 0.f, 0.f, 0.f};
    }
}
__device__ __forceinline__ void unpack8(float (&f)[8], const u32x4 w) { f[0] = bflo(w.x); f[1] = bfhi(w.x); f[2] = bflo(w.y); f[3] = bfhi(w.y); f[4] = bflo(w.z); f[5] = bfhi(w.z); f[6] = bflo(w.w); f[7] = bfhi(w.w); }
struct MixRow { u32x4 a, c0, c1, c2, p0, p1, p2; float l0, l1, l2, e0, e1, e2, e3; };
__device__ __forceinline__ void mix_load(MixRow& r, int m, const bf16_t* ob, const bf16_t* hb, const float* lse, const bf16_t* pm, const float* lsem0, const float* lsem1, int lane, int hh) {
    r.a = *((const u32x4*)(ob + (size_t)m * DM) + lane); r.c0 = *((const u32x4*)(ob + (size_t)m * DM + 512) + lane);
    r.c1 = *((const u32x4*)(hb + (size_t)m * DM) + lane); r.c2 = *((const u32x4*)(hb + (size_t)m * DM + 512) + lane);
    r.l0 = lse[(size_t)m * 8 + hh]; r.l1 = lse[(size_t)T * 8 + (size_t)m * 8 + hh]; r.l2 = lse[(size_t)2 * T * 8 + (size_t)m * 8 + hh];
    if (lane < 32) {
        r.p0 = *((const u32x4*)(pm + (size_t)m * 256) + lane); r.p1 = *((const u32x4*)(pm + ((size_t)T + m) * 256) + lane); r.p2 = *((const u32x4*)(pm + ((size_t)2 * T + m) * 256) + lane);
        r.e0 = lsem0[(size_t)m * 4 + hh]; r.e1 = lsem0[(size_t)T * 4 + (size_t)m * 4 + hh]; r.e2 = lsem1[(size_t)m * 4 + hh]; r.e3 = lsem1[(size_t)T * 4 + (size_t)m * 4 + hh]; }
}
__device__ __forceinline__ void phase_mixnorm(const bf16_t* ob, bf16_t* hb, const float* lse, const bf16_t* pm, const float* lsem0, const float* lsem1, const float* g, int gw, int NGW, int lane) {
    float g0[8], g1[8];
#pragma unroll
    for (int j = 0; j < 8; ++j) { g0[j] = g[8 * lane + j]; g1[j] = g[512 + 8 * lane + j]; }
    const int hh = lane >> 3;
    MixRow cur, nxt;
    if (gw < T) mix_load(cur, gw, ob, hb, lse, pm, lsem0, lsem1, lane, hh);
    for (int m = gw; m < T; m += NGW) {
        if (m + NGW < T) mix_load(nxt, m + NGW, ob, hb, lse, pm, lsem0, lsem1, lane, hh);
        float va[8]; unpack8(va, cur.a);
        if (lane < 32) {
            const float mx = fmaxf(fmaxf(cur.e0, cur.e1), fmaxf(cur.e2, cur.e3));
            float u0 = __builtin_amdgcn_exp2f(cur.e0 - mx), u1 = __builtin_amdgcn_exp2f(cur.e1 - mx), u2 = __builtin_amdgcn_exp2f(cur.e2 - mx), u3 = __builtin_amdgcn_exp2f(cur.e3 - mx);
            const float inv = 1.0f / ((u0 + u1) + (u2 + u3)); u0 *= inv; u1 *= inv; u2 *= inv; u3 *= inv;
            float y0[8], y1[8], y2[8]; unpack8(y0, cur.p0); unpack8(y1, cur.p1); unpack8(y2, cur.p2);
#pragma unroll
            for (int j = 0; j < 8; ++j) va[j] = (u0 * y0[j] + u1 * y1[j]) + (u2 * y2[j] + u3 * va[j]);
        }
        const float mx = fmaxf(cur.l0, fmaxf(cur.l1, cur.l2));
        float w0 = __builtin_amdgcn_exp2f(cur.l0 - mx), w1 = __builtin_amdgcn_exp2f(cur.l1 - mx), w2 = __builtin_amdgcn_exp2f(cur.l2 - mx);
        const float inv = 1.0f / (w0 + w1 + w2); w0 *= inv; w1 *= inv; w2 *= inv;
        float x0[8], x1[8], x2[8]; unpack8(x0, cur.c0); unpack8(x1, cur.c1); unpack8(x2, cur.c2);
        float vc[8];
        float sa = 0.f, sc = 0.f;
#pragma unroll
        for (int j = 0; j < 8; ++j) { vc[j] = w0 * x0[j] + w1 * x1[j] + w2 * x2[j]; sa += va[j] * va[j]; sc += vc[j] * vc[j]; }
        sa = half_sum(sa); sc = wave_sum(sc);
        const float ra = 1.0f / sqrtf(sa * (1.f / 256.f) + NORM_EPS), rc = 1.0f / sqrtf(sc * (1.f / 512.f) + NORM_EPS);
        u32x4 oa, oc;
        oa.x = pk2(va[0] * ra * g0[0], va[1] * ra * g0[1]); oa.y = pk2(va[2] * ra * g0[2], va[3] * ra * g0[3]); oa.z = pk2(va[4] * ra * g0[4], va[5] * ra * g0[5]); oa.w = pk2(va[6] * ra * g0[6], va[7] * ra * g0[7]);
        oc.x = pk2(vc[0] * rc * g1[0], vc[1] * rc * g1[1]); oc.y = pk2(vc[2] * rc * g1[2], vc[3] * rc * g1[3]); oc.z = pk2(vc[4] * rc * g1[4], vc[5] * rc * g1[5]); oc.w = pk2(vc[6] * rc * g1[6], vc[7] * rc * g1[7]);
        *((u32x4*)(hb + (size_t)m * DM) + lane) = oa; *((u32x4*)(hb + (size_t)m * DM + 512) + lane) = oc;
        cur = nxt;
    }
}
__device__ __forceinline__ void phase_route(const bf16_t* x, const float* g, const float* wgr, const float* bgr, const float* wer, const float* ber,
                                            float* rlist, unsigned* cnt, unsigned* list, float* wlist, LAS unsigned char* lds, int v, int G, int wave, int lane, float* kmean_zero) {
    for (int i = (v * NWAVES + wave) * 64 + lane; i < BATCH * 4 * 32 * HD; i += G * NWAVES * 64) kmean_zero[i] = 0.f;
    const int tid = wave * 64 + lane;
    constexpr int RP = 2064;
    LAS unsigned char* WH = lds; LAS unsigned char* WL = lds + 20 * RP;
    LAS unsigned* cl = (LAS unsigned*)(lds + 86016);
    LAS u32x2* info = (LAS u32x2*)(lds + 86016 + 256);
    LAS f32x2* infw = (LAS f32x2*)(lds + 86016 + 256 + 4096);
    LAS float* infr = (LAS float*)(lds + 86016 + 256 + 8192);
    for (int idx = tid; idx < 5 * DM; idx += NTHREADS) { const int mtx = idx >> 10, d = idx & 1023; const f32x4 wv = *(const f32x4*)((mtx == 0 ? wgr : wer + (size_t)(mtx - 1) * DM * 4) + d * 4) * g[d];
#pragma unroll
        for (int e = 0; e < 4; ++e) { const float w = wv[e]; const unsigned short hi = (unsigned short)f2bf(w); const float rem = w - __builtin_bit_cast(float, (unsigned)hi << 16);
            *(LAS unsigned short*)(WH + (mtx * 4 + e) * RP + d * 2) = hi; *(LAS unsigned short*)(WL + (mtx * 4 + e) * RP + d * 2) = (unsigned short)f2bf(rem); } }
    if (tid < 64) cl[tid] = 0u;
    __syncthreads();
    const int rpw = (T + G - 1) / G, row0 = v * rpw;
    const int m16 = lane & 15, q = lane >> 4;
    const f32x4 bg = *(const f32x4*)bgr;
    for (int t0 = wave * 16; t0 < rpw; t0 += NWAVES * 16) {
        const int r = t0 + m16; const bool valid = r < rpw && row0 + r < T;
        const u32x4* xp = (const u32x4*)(x + (size_t)(valid ? row0 + r : row0) * DM) + q;
        f32x4 a0 = (f32x4){0.f, 0.f, 0.f, 0.f}, a1 = a0; float ss = 0.f;
        LAS unsigned char* wh0 = WH + m16 * RP + q * 16; LAS unsigned char* wh1 = WH + (16 + (lane & 3)) * RP + q * 16;
#pragma unroll 1
        for (int sb = 0; sb < 32; sb += 8) { u32x4 xv[8];
#pragma unroll
            for (int s = 0; s < 8; ++s) xv[s] = xp[4 * (sb + s)];
#pragma unroll
            for (int s = 0; s < 8; ++s) { const int ko = (sb + s) * 64; const bf16x8 xf = __builtin_bit_cast(bf16x8, xv[s]);
                a0 = __builtin_amdgcn_mfma_f32_16x16x32_bf16(*(LAS bf16x8*)(wh0 + ko), xf, a0, 0, 0, 0);
                a0 = __builtin_amdgcn_mfma_f32_16x16x32_bf16(*(LAS bf16x8*)(wh0 + 20 * RP + ko), xf, a0, 0, 0, 0);
                a1 = __builtin_amdgcn_mfma_f32_16x16x32_bf16(*(LAS bf16x8*)(wh1 + ko), xf, a1, 0, 0, 0);
                a1 = __builtin_amdgcn_mfma_f32_16x16x32_bf16(*(LAS bf16x8*)(wh1 + 20 * RP + ko), xf, a1, 0, 0, 0);
                const float x0 = bflo(xv[s].x), x1 = bfhi(xv[s].x), x2 = bflo(xv[s].y), x3 = bfhi(xv[s].y), x4 = bflo(xv[s].z), x5 = bfhi(xv[s].z), x6 = bflo(xv[s].w), x7 = bfhi(xv[s].w);
                ss += ((x0 * x0 + x1 * x1) + (x2 * x2 + x3 * x3)) + ((x4 * x4 + x5 * x5) + (x6 * x6 + x7 * x7)); } }
        ss += swz_xor<16>(ss); ss = sum_xor32(ss);
        const float rstd = 1.0f / sqrtf(ss * (1.f / DM) + NORM_EPS);
        const int gc = (q == 0) ? 3 : q - 1;
        const f32x4 be = *(const f32x4*)(ber + gc * 4);
        const f32x4 ev = (q == 0) ? a1 : a0;
        const float e[4] = {ev.x * rstd + be.x, ev.y * rstd + be.y, ev.z * rstd + be.z, ev.w * rstd + be.w};
        int i1 = 0; float v1 = e[0];
#pragma unroll
        for (int k = 1; k < 4; ++k) if (e[k] > v1) { v1 = e[k]; i1 = k; }
        int i2 = -1; float v2 = -INFINITY;
#pragma unroll
        for (int k = 0; k < 4; ++k) if (k != i1 && e[k] > v2) { v2 = e[k]; i2 = k; }
        const float p2 = __expf(v2 - v1), inv = 1.0f / (1.0f + p2);
        const float w1 = inv, w2 = p2 * inv;
        const int ea = i1 < i2 ? i1 : i2, eb = i1 < i2 ? i2 : i1; const float wa0 = i1 < i2 ? w1 : w2, wb0 = i1 < i2 ? w2 : w1;
        const int pi0 = (ea == 0) ? (eb - 1) : (ea == 1 ? eb + 1 : 5);
        const f32x4 gl = (f32x4){a0.x * rstd + bg.x, a0.y * rstd + bg.y, a0.z * rstd + bg.z, a0.w * rstd + bg.w};
        int gi = 0; float gm = gl.x;
        if (gl.y > gm) { gm = gl.y; gi = 1; } if (gl.z > gm) { gm = gl.z; gi = 2; } if (gl.w > gm) { gm = gl.w; gi = 3; }
        const float gden = __expf(gl.x - gm) + __expf(gl.y - gm) + __expf(gl.z - gm) + __expf(gl.w - gm);
        const float gw_ = 1.0f / gden;
        const int src = (m16 + 16 * ((gi == 3) ? 0 : gi + 1)) * 4;
        const int pi = __builtin_amdgcn_ds_bpermute(src, pi0);
        const float wa = __builtin_bit_cast(float, __builtin_amdgcn_ds_bpermute(src, __builtin_bit_cast(int, wa0))) * gw_, wb = __builtin_bit_cast(float, __builtin_amdgcn_ds_bpermute(src, __builtin_bit_cast(int, wb0))) * gw_;
        if (q == 0 && valid) { int bk = gi * 6 + pi; bk = bk < 0 ? 0 : (bk > 23 ? 23 : bk);
            const unsigned rank = __hip_atomic_fetch_add(cl + bk, 1u, __ATOMIC_RELAXED, __HIP_MEMORY_SCOPE_WORKGROUP);
            info[r] = (u32x2){(unsigned)bk, rank}; infw[r] = (f32x2){wa, wb}; infr[r] = rstd; }
    }
    __syncthreads();
    if (tid < 24) cl[32 + tid] = __hip_atomic_fetch_add(cnt + tid, cl[tid], __ATOMIC_RELAXED, __HIP_MEMORY_SCOPE_AGENT);
    __syncthreads();
    if (tid < rpw && row0 + tid < T) { const u32x2 inf = info[tid]; const f32x2 wv = infw[tid]; const size_t slot = (size_t)inf.x * T + cl[32 + inf.x] + inf.y;
        list[slot] = (unsigned)(row0 + tid); *(f32x2*)(wlist + slot * 2) = wv; rlist[slot] = infr[tid]; }
    __syncthreads();
}
__device__ __forceinline__ void phase_final(const bf16_t* xb, const float* g, float* out, int gw, int NGW, int lane) {
    f32x4 gv[4];
#pragma unroll
    for (int j = 0; j < 2; ++j) { gv[2 * j] = *((const f32x4*)g + 2 * lane + 128 * j); gv[2 * j + 1] = *((const f32x4*)g + 2 * lane + 128 * j + 1); }
    for (int m = gw; m < T; m += NGW) {
        const u32x4* xr = (const u32x4*)(xb + (size_t)m * DM) + lane;
        u32x4 r[2]; float s = 0.f;
#pragma unroll
        for (int j = 0; j < 2; ++j) r[j] = xr[64 * j];
        f32x4 v[4];
#pragma unroll
        for (int j = 0; j < 2; ++j) { v[2 * j] = (f32x4){bflo(r[j].x), bfhi(r[j].x), bflo(r[j].y), bfhi(r[j].y)}; v[2 * j + 1] = (f32x4){bflo(r[j].z), bfhi(r[j].z), bflo(r[j].w), bfhi(r[j].w)}; }
#pragma unroll
        for (int j = 0; j < 4; ++j) s += (v[j].x * v[j].x + v[j].y * v[j].y) + (v[j].z * v[j].z + v[j].w * v[j].w);
        const float rstd = 1.0f / sqrtf(wave_sum(s) * (1.f / DM) + NORM_EPS);
        f32x4* orow = (f32x4*)(out + (size_t)m * DM) + 2 * lane;
#pragma unroll
        for (int j = 0; j < 2; ++j) { orow[128 * j] = v[2 * j] * rstd * gv[2 * j]; orow[128 * j + 1] = v[2 * j + 1] * rstd * gv[2 * j + 1]; }
    }
}
__device__ __forceinline__ void phase_kmean(const bf16_t* kb, float* kmean, int gw, int NGW, int lane) {
    for (int it = gw; it < BATCH * 4 * 32; it += NGW) {
        const int b = it >> 7, h = (it >> 5) & 3, blk = it & 31;
        const bf16_t* base = kb + ((size_t)b * SEQ + (size_t)blk * 256) * DM + h * HD + (lane & 7) * 8;
        float acc[8] = {0.f, 0.f, 0.f, 0.f, 0.f, 0.f, 0.f, 0.f};
#pragma unroll 4
        for (int i = 0; i < 32; ++i) { const u32x4 w = *(const u32x4*)(base + (size_t)((lane >> 3) + 8 * i) * DM);
            acc[0] += bflo(w.x); acc[1] += bfhi(w.x); acc[2] += bflo(w.y); acc[3] += bfhi(w.y); acc[4] += bflo(w.z); acc[5] += bfhi(w.z); acc[6] += bflo(w.w); acc[7] += bfhi(w.w); }
#pragma unroll
        for (int j = 0; j < 8; ++j) { acc[j] += swz_xor<8>(acc[j]); acc[j] += swz_xor<16>(acc[j]); acc[j] = sum_xor32(acc[j]); }
        if (lane < 8) {
            float* o = kmean + (size_t)it * HD + lane * 8;
#pragma unroll
            for (int j = 0; j < 8; ++j) o[j] = acc[j] * (1.f / 256.f);
        }
    }
}

__device__ __forceinline__ void ld_row64(float (&r)[64], const bf16_t* p) {
#pragma unroll
    for (int c = 0; c < 8; ++c) { const u32x4 w = *((const u32x4*)p + c);
        r[8 * c + 0] = bflo(w.x); r[8 * c + 1] = bfhi(w.x); r[8 * c + 2] = bflo(w.y); r[8 * c + 3] = bfhi(w.y); r[8 * c + 4] = bflo(w.z); r[8 * c + 5] = bfhi(w.z); r[8 * c + 6] = bflo(w.w); r[8 * c + 7] = bfhi(w.w); }
}
__device__ __forceinline__ float dot_row64(const float (&q)[64], const bf16_t* p) {
    float s0 = 0.f, s1 = 0.f;
#pragma unroll
    for (int c = 0; c < 8; ++c) { const u32x4 w = *((const u32x4*)p + c);
        s0 += q[8 * c + 0] * bflo(w.x); s1 += q[8 * c + 1] * bfhi(w.x); s0 += q[8 * c + 2] * bflo(w.y); s1 += q[8 * c + 3] * bfhi(w.y);
        s0 += q[8 * c + 4] * bflo(w.z); s1 += q[8 * c + 5] * bfhi(w.z); s0 += q[8 * c + 6] * bflo(w.w); s1 += q[8 * c + 7] * bfhi(w.w); }
    return s0 + s1;
}
__device__ __forceinline__ void axpy_row64(float (&o)[64], float p, const bf16_t* vp) {
#pragma unroll
    for (int c = 0; c < 8; ++c) { const u32x4 w = *((const u32x4*)vp + c);
        o[8 * c + 0] += p * bflo(w.x); o[8 * c + 1] += p * bfhi(w.x); o[8 * c + 2] += p * bflo(w.y); o[8 * c + 3] += p * bfhi(w.y);
        o[8 * c + 4] += p * bflo(w.z); o[8 * c + 5] += p * bfhi(w.z); o[8 * c + 6] += p * bflo(w.w); o[8 * c + 7] += p * bfhi(w.w); }
}
__device__ __forceinline__ void st_row64(bf16_t* p, const float (&o)[64], float sc) {
#pragma unroll
    for (int c = 0; c < 8; ++c) { u32x4 w; w.x = pk2(o[8 * c] * sc, o[8 * c + 1] * sc); w.y = pk2(o[8 * c + 2] * sc, o[8 * c + 3] * sc); w.z = pk2(o[8 * c + 4] * sc, o[8 * c + 5] * sc); w.w = pk2(o[8 * c + 6] * sc, o[8 * c + 7] * sc); *((u32x4*)p + c) = w; }
}
#define OSM_STEP(sc, vrow) do { const float sc_ = (sc); if (sc_ > m_) { const float al = __builtin_amdgcn_exp2f(m_ - sc_); l_ *= al; _Pragma("unroll") for (int d_ = 0; d_ < 64; ++d_) o_[d_] *= al; m_ = sc_; } \
    const float p_ = __builtin_amdgcn_exp2f(sc_ - m_); l_ += p_; axpy_row64(o_, p_, (vrow)); } while (0)

__device__ __forceinline__ void naive_moba(const bf16_t* qb, const bf16_t* kb, const bf16_t* vb, const float* kmean, bf16_t* ob, int item, int tid) {
    const int b = item >> 6, h = (item >> 4) & 3, t = (item & 15) * 512 + tid, own = t >> 8;
    const size_t rowq = ((size_t)b * SEQ + t) * DM + h * HD;
    const bf16_t* kh = kb + (size_t)b * SEQ * DM + h * HD; const bf16_t* vh = vb + (size_t)b * SEQ * DM + h * HD;
    const float slope2 = exp2f(-2.0f * (float)(h + 1)) * LOG2E;
    float q_[64]; ld_row64(q_, qb + rowq);
    float bv0 = -INFINITY, bv1 = -INFINITY, bv2 = -INFINITY; int bi0 = -1, bi1 = -1, bi2 = -1;
    const float* km = kmean + (size_t)(b * 4 + h) * 32 * HD;
    for (int n = 0; n < own; ++n) {
        float gsum = 0.f;
#pragma unroll
        for (int d = 0; d < 64; ++d) gsum += q_[d] * km[n * HD + d];
        if (gsum > bv0) { bv2 = bv1; bi2 = bi1; bv1 = bv0; bi1 = bi0; bv0 = gsum; bi0 = n; }
        else if (gsum > bv1) { bv2 = bv1; bi2 = bi1; bv1 = gsum; bi1 = n; }
        else if (gsum > bv2) { bv2 = gsum; bi2 = n; }
    }
    float o_[64];
#pragma unroll
    for (int d = 0; d < 64; ++d) o_[d] = 0.f;
    float m_ = -INFINITY, l_ = 0.f;
    for (int s = 0; s < 3; ++s) {
        const int blk = (s == 0) ? bi0 : (s == 1) ? bi1 : bi2;
        if (blk < 0) continue;
        for (int j = 0; j < 256; ++j) { const int pos = blk * 256 + j;
            const float sc = dot_row64(q_, kh + (size_t)pos * DM) - slope2 * (float)(t - pos);
            OSM_STEP(sc, vh + (size_t)pos * DM); }
    }
    for (int pos = own * 256; pos <= t; ++pos) {
        const float sc = dot_row64(q_, kh + (size_t)pos * DM) - slope2 * (float)(t - pos);
        OSM_STEP(sc, vh + (size_t)pos * DM); }
    st_row64(ob + rowq, o_, 1.0f / l_);
}
__device__ __forceinline__ void naive_sb(const bf16_t* qb, const bf16_t* kb, const bf16_t* vb, bf16_t* ob, int item, int tid) {
    const int b = item >> 6, h = 4 + ((item >> 4) & 3), t = (item & 15) * 512 + tid;
    const size_t rowq = ((size_t)b * SEQ + t) * DM + h * HD;
    const bf16_t* kh = kb + (size_t)b * SEQ * DM + h * HD; const bf16_t* vh = vb + (size_t)b * SEQ * DM + h * HD;
    float q_[64]; ld_row64(q_, qb + rowq);
    float o_[64];
#pragma unroll
    for (int d = 0; d < 64; ++d) o_[d] = 0.f;
    float tail = 0.f;
    for (int s = t - 1; s >= 0 && tail > -150.f; --s) {
        const float z = dot_row64(q_, kh + (size_t)s * DM);
        const float lp = __builtin_amdgcn_logf(1.0f + __builtin_amdgcn_exp2f(-fabsf(z)));
        const float lnot = -(fmaxf(z, 0.f) + lp);
        const float aw = __builtin_amdgcn_exp2f(z + lnot + tail);
        axpy_row64(o_, aw, vh + (size_t)s * DM);
        tail += lnot;
    }
    st_row64(ob + rowq, o_, 1.0f);
}
__device__ __forceinline__ void naive_dil(const bf16_t* qb, const bf16_t* kb, const bf16_t* vb, bf16_t* ob, bf16_t* hb2, float* lse, int item, int tid) {
    const int b = item >> 7, h = 8 + ((item >> 4) & 7), t = (item & 15) * 512 + tid;
    const size_t rowq = ((size_t)b * SEQ + t) * DM + h * HD;
    const bf16_t* kh = kb + (size_t)b * SEQ * DM + h * HD; const bf16_t* vh = vb + (size_t)b * SEQ * DM + h * HD;
    const float slope2 = exp2f(-(float)(h - 8 + 1)) * LOG2E;
    float q_[64]; ld_row64(q_, qb + rowq);
    float o_[64];
#pragma unroll
    for (int d = 0; d < 64; ++d) o_[d] = 0.f;
    float m_ = -INFINITY, l_ = 0.f;
    for (int c = 0; c < 3; ++c) {
        const int dil = (c == 0) ? 1 : (c == 1) ? 4 : 16;
        for (int dl = 0; dl <= 128; ++dl) { const int pos = t - dl * dil; if (pos < 0) break;
            const float sc = dot_row64(q_, kh + (size_t)pos * DM) - slope2 * (float)(dl * dil);
            OSM_STEP(sc, vh + (size_t)pos * DM); }
    }
    st_row64(ob + rowq, o_, 1.0f / l_);
    { const size_t tok = (size_t)b * SEQ + t; const u32x4 z4 = {0u, 0u, 0u, 0u};
#pragma unroll
      for (int c = 0; c < 8; ++c) { *((u32x4*)(hb2 + tok * DM + (h - 8) * HD) + c) = z4; *((u32x4*)(hb2 + tok * DM + 512 + (h - 8) * HD) + c) = z4; }
      lse[tok * 8 + (h - 8)] = 0.f; lse[(size_t)T * 8 + tok * 8 + (h - 8)] = -1.0e30f; lse[(size_t)2 * T * 8 + tok * 8 + (h - 8)] = -1.0e30f; }
}

namespace att {
typedef float f32x16 __attribute__((ext_vector_type(16)));
typedef short s16x4 __attribute__((ext_vector_type(4)));
typedef short v4i16_t __attribute__((ext_vector_type(4)));
typedef __bf16 bf16x2_t __attribute__((ext_vector_type(2)));
constexpr int L_BUF = 16384;
constexpr int L_WSF = 2 * L_BUF;
constexpr int L_OST = L_WSF + 8 * 256;
constexpr int L_FLG = L_OST + 8 * 4096;
constexpr int L_END = L_FLG + 64;
constexpr float M_INIT = -1.0e30f;
#define ATT_MFMA(a, b, c) __builtin_amdgcn_mfma_f32_32x32x16_bf16((a), (b), (c), 0, 0, 0)

__device__ __forceinline__ unsigned cvtpk(float lo, float hi) { f32x2 v = {lo, hi}; bf16x2_t b = __builtin_convertvector(v, bf16x2_t); return __builtin_bit_cast(unsigned, b); }
__device__ __forceinline__ s16x4 vtr(LAS unsigned char* p) { return __builtin_bit_cast(s16x4, __builtin_amdgcn_ds_read_tr16_b64_v4i16((LAS v4i16_t*)p)); }

struct Wave { int lane, r32, hi, wid; LAS unsigned char* lds; LAS float* wsf; LAS unsigned char* ost; int vlo; };
__device__ __forceinline__ Wave make_wave(LAS unsigned char* lds, int tid, int wsf_off = L_WSF, int ost_off = L_OST) {
    Wave w; w.lane = tid & 63; w.r32 = w.lane & 31; w.hi = w.lane >> 5; w.wid = __builtin_amdgcn_readfirstlane(tid >> 6); w.lds = lds;
    w.wsf = (LAS float*)(lds + wsf_off) + w.wid * 64; w.ost = lds + ost_off + w.wid * 4096;
    w.vlo = ((w.lane >> 4) & 1) * 32 + (w.lane & 3) * 8 + (4 * w.hi + ((w.lane & 15) >> 2)) * 64;
    return w;
}
struct Stage { u32x4 k, v; };
template <class RowK, class RowV> __device__ __forceinline__ void stage_load(Stage& s, const Wave& w, const RowK& rowk, const RowV& rowv) {
    s.k = *(const u32x4*)(rowk(w.lane) + w.wid * 8);
    s.v = *(const u32x4*)(rowv(16 * (w.wid & 3) + (w.lane >> 2)) + (w.wid >> 2) * 32 + (w.lane & 3) * 8);
}
__device__ __forceinline__ void stage_write(const Stage& s, const Wave& w, int buf) {
    *(LAS u32x4*)(w.lds + buf * L_BUF + w.wid * 1024 + w.lane * 16) = s.k;
    *(LAS u32x4*)(w.lds + buf * L_BUF + 8192 + w.wid * 1024 + w.lane * 16) = s.v;
}
__device__ __forceinline__ f32x16 qk_sub(const Wave& w, int buf, int sub, const bf16x8 (&qf)[4], float init) {
    f32x16 acc;
#pragma unroll
    for (int r = 0; r < 16; ++r) acc[r] = init;
    LAS unsigned char* kp = w.lds + buf * L_BUF + w.hi * 1024 + (32 * sub + w.r32) * 16;
#pragma unroll
    for (int ks = 0; ks < 4; ++ks) { const bf16x8 kf = *(LAS bf16x8*)(kp + ks * 2048); acc = ATT_MFMA(kf, qf[ks], acc); }
    return acc;
}
__device__ __forceinline__ void pv_sub(const Wave& w, int buf, int sub, const f32x16& p, f32x16 (&o)[2]) {
    bf16x8 pk[2];
#pragma unroll
    for (int s = 0; s < 2; ++s) { u32x4 t; t.x = cvtpk(p[8 * s], p[8 * s + 1]); t.y = cvtpk(p[8 * s + 2], p[8 * s + 3]); t.z = cvtpk(p[8 * s + 4], p[8 * s + 5]); t.w = cvtpk(p[8 * s + 6], p[8 * s + 7]); pk[s] = __builtin_bit_cast(bf16x8, t); }
    LAS unsigned char* vb = w.lds + buf * L_BUF + 8192 + w.vlo;
#pragma unroll
    for (int db = 0; db < 2; ++db)
#pragma unroll
        for (int s = 0; s < 2; ++s) { LAS unsigned char* vp = vb + db * 4096 + (4 * sub + 2 * s) * 512;
            const s16x4 lo = vtr(vp), hh = vtr(vp + 512);
            const bf16x8 vf = __builtin_shufflevector(lo, hh, 0, 1, 2, 3, 4, 5, 6, 7);
            o[db] = ATT_MFMA(pk[s], vf, o[db]); }
}
struct VFrags { s16x4 f[2][2][2]; };
__device__ __forceinline__ void load_vfrags(const Wave& w, int buf, int sub, VFrags& v) {
    LAS unsigned char* vb = w.lds + buf * L_BUF + 8192 + w.vlo;
#pragma unroll
    for (int db = 0; db < 2; ++db)
#pragma unroll
        for (int s = 0; s < 2; ++s) { LAS unsigned char* vp = vb + db * 4096 + (4 * sub + 2 * s) * 512; v.f[db][s][0] = vtr(vp); v.f[db][s][1] = vtr(vp + 512); }
}
__device__ __forceinline__ void pv_frags(const VFrags& v, const f32x16& p, f32x16 (&o)[2]) {
    bf16x8 pk[2];
#pragma unroll
    for (int s = 0; s < 2; ++s) { u32x4 t; t.x = cvtpk(p[8 * s], p[8 * s + 1]); t.y = cvtpk(p[8 * s + 2], p[8 * s + 3]); t.z = cvtpk(p[8 * s + 4], p[8 * s + 5]); t.w = cvtpk(p[8 * s + 6], p[8 * s + 7]); pk[s] = __builtin_bit_cast(bf16x8, t); }
#pragma unroll
    for (int db = 0; db < 2; ++db)
#pragma unroll
        for (int s = 0; s < 2; ++s) { const bf16x8 vf = __builtin_shufflevector(v.f[db][s][0], v.f[db][s][1], 0, 1, 2, 3, 4, 5, 6, 7); o[db] = ATT_MFMA(pk[s], vf, o[db]); }
}
__device__ __forceinline__ void scale_rows(const Wave& w, f32x16 (&o)[2], float f) {
    if (w.hi == 0) w.wsf[w.r32] = f;
#pragma unroll
    for (int g = 0; g < 4; ++g) { const f32x4 fv = *(LAS f32x4*)(w.wsf + 8 * g + 4 * w.hi);
#pragma unroll
        for (int i = 0; i < 4; ++i) { o[0][4 * g + i] *= fv[i]; o[1][4 * g + i] *= fv[i]; } }
}
__device__ __forceinline__ void softmax_sub(const Wave& w, f32x16& s, float& m, float& lsum, f32x16 (&o)[2]) {
    float tm = fmaxf(fmaxf(s[0], s[1]), fmaxf(s[2], s[3]));
#pragma unroll
    for (int r = 4; r < 16; r += 4) tm = fmaxf(tm, fmaxf(fmaxf(s[r], s[r + 1]), fmaxf(s[r + 2], s[r + 3])));
    tm = max_xor32(tm);
    const float mn = fmaxf(m, tm);
    if (__any(mn > m)) { const float al = __builtin_amdgcn_exp2f(m - mn); lsum *= al; scale_rows(w, o, al); m = mn; }
    float acc = 0.f;
#pragma unroll
    for (int r = 0; r < 16; ++r) { s[r] = __builtin_amdgcn_exp2f(s[r] - m); acc += s[r]; }
    lsum += acc;
}
__device__ __forceinline__ void mask_band(f32x16& s, int delta0, int W) {
#pragma unroll
    for (int r = 0; r < 16; ++r) { const int dl = delta0 - ((r & 3) + 8 * (r >> 2)); if ((unsigned)dl > (unsigned)W) s[r] = -INFINITY; }
}
constexpr float SM_THR = 8.0f;
struct SubDesc { bool act; int delta; int W; };
template <int NSUB>
__device__ __forceinline__ void softmax_step(const Wave& w, int buf, const bf16x8 (&qf)[4], const bf16x8& kidx, const bf16x8& slp, float slope, const SubDesc (&sd)[NSUB],
                                             float& m, float& lsum, f32x16 (&o)[2], bool& first) {
    f32x16 s[NSUB];
    bool any_act = false;
#pragma unroll
    for (int i = 0; i < NSUB; ++i) if (sd[i].act) { any_act = true; s[i] = qk_sub(w, buf, i, qf, -slope * (float)sd[i].delta - m); s[i] = ATT_MFMA(kidx, slp, s[i]); }
    if (!any_act) return;
    float tm = -INFINITY;
#pragma unroll
    for (int i = 0; i < NSUB; ++i) if (sd[i].act) {
        if (sd[i].W >= 0) mask_band(s[i], sd[i].delta - 4 * w.hi, sd[i].W);
        float t = fmaxf(fmaxf(s[i][0], s[i][1]), fmaxf(s[i][2], s[i][3]));
#pragma unroll
        for (int r = 4; r < 16; r += 4) t = fmaxf(t, fmaxf(fmaxf(s[i][r], s[i][r + 1]), fmaxf(s[i][r + 2], s[i][r + 3])));
        tm = fmaxf(tm, t); }
    tm = max_xor32(tm);
    if (first || __any(tm > SM_THR)) {
        const float d = first ? (tm > -1.0e30f ? tm : 0.f) : fmaxf(tm, 0.f);
#pragma unroll
        for (int i = 0; i < NSUB; ++i) if (sd[i].act) {
#pragma unroll
            for (int r = 0; r < 16; ++r) s[i][r] -= d; }
        if (!first) { const float al = __builtin_amdgcn_exp2f(-d); lsum *= al; scale_rows(w, o, al); }
        m += d; first = false;
    }
    VFrags vf[NSUB];
#pragma unroll
    for (int i = 0; i < NSUB; ++i) if (sd[i].act) load_vfrags(w, buf, i, vf[i]);
#pragma unroll
    for (int i = 0; i < NSUB; ++i) if (sd[i].act) { float acc = 0.f;
#pragma unroll
        for (int r = 0; r < 16; ++r) { s[i][r] = __builtin_amdgcn_exp2f(s[i][r]); acc += s[i][r]; }
        lsum += acc; }
#pragma unroll
    for (int i = 0; i < NSUB; ++i) if (sd[i].act) pv_frags(vf[i], s[i], o);
}
__device__ __forceinline__ void bias_frags(const Wave& w, float slope, bf16x8& kidx, bf16x8& slp) {
    const unsigned kb = f2bf((float)w.r32), sh = f2bf(slope), sl = f2bf(slope - __builtin_bit_cast(float, sh << 16));
    const u32x4 a = {w.hi == 0 ? (kb | (kb << 16)) : 0u, 0u, 0u, 0u}, b = {w.hi == 0 ? (sh | (sl << 16)) : 0u, 0u, 0u, 0u};
    kidx = __builtin_bit_cast(bf16x8, a); slp = __builtin_bit_cast(bf16x8, b);
}
template <class RowO> __device__ __forceinline__ void store_o(const Wave& w, const f32x16 (&o)[2], const RowO& rowo) {
    LAS unsigned short* stg = (LAS unsigned short*)w.ost;
#pragma unroll
    for (int r = 0; r < 16; ++r) { const int q = (r & 3) + 8 * (r >> 2) + 4 * w.hi;
#pragma unroll
        for (int db = 0; db < 2; ++db) stg[q * 64 + db * 32 + w.r32] = (unsigned short)f2bf(o[db][r]); }
#pragma unroll
    for (int i = 0; i < 4; ++i) { const int row = i * 8 + (w.lane >> 3), ch = w.lane & 7; const u32x4 v = *(LAS u32x4*)((LAS unsigned char*)stg + row * 128 + ch * 16);
        bf16_t* dst = rowo(row); if (dst) *(u32x4*)(dst + ch * 8) = v; }
}
__device__ __forceinline__ void load_q(bf16x8 (&qf)[4], const bf16_t* qrow, int hi) {
#pragma unroll
    for (int ks = 0; ks < 4; ++ks) qf[ks] = *(const bf16x8*)(qrow + 16 * ks + 8 * hi);
}

constexpr int W_WSF = 98304, W_OST = W_WSF + 2048, W_ENUM = W_OST + 32768;
template <int NC> struct Pref { u32x4 k[NC], v[NC]; bf16x8 q[4]; };
template <int NC, class RowF> __device__ __forceinline__ void win_issue(Pref<NC>& P, const Wave& w, const bf16_t* kbase, const bf16_t* vbase, const RowF& rowoff, const bf16_t* qrow) {
#pragma unroll
    for (int c = 0; c < NC; ++c) { P.k[c] = *(const u32x4*)(kbase + rowoff(64 * c + 8 * w.wid + (w.lane >> 3)) + (w.lane & 7) * 8);
        P.v[c] = *(const u32x4*)(vbase + rowoff(64 * c + 16 * (w.wid & 3) + (w.lane >> 2)) + (w.wid >> 2) * 32 + (w.lane & 3) * 8); }
    load_q(P.q, qrow, w.hi);
}
template <int NC> __device__ __forceinline__ void win_commit(const Pref<NC>& P, const Wave& w) {
    constexpr int NK = 64 * NC;
#pragma unroll
    for (int c = 0; c < NC; ++c) { const int key = 64 * c + 8 * w.wid + (w.lane >> 3);
        *(LAS u32x4*)(w.lds + key * 128 + ((((w.lane & 7) ^ (key >> 1)) & 7) * 16)) = P.k[c];
        *(LAS u32x4*)(w.lds + NK * 128 + (w.wid >> 2) * (NK * 64) + (8 * c + 2 * (w.wid & 3)) * 512 + w.lane * 16) = P.v[c]; }
}
template <int NK> __device__ __forceinline__ f32x16 qk_win(const Wave& w, int u, const bf16x8 (&qf)[4], float init) {
    f32x16 acc;
#pragma unroll
    for (int r = 0; r < 16; ++r) acc[r] = init;
    LAS unsigned char* kp = w.lds + (32 * u + w.r32) * 128; const int x = (w.r32 >> 1) & 7;
#pragma unroll
    for (int ks = 0; ks < 4; ++ks) { const bf16x8 kf = *(LAS bf16x8*)(kp + (((2 * ks + w.hi) ^ x) * 16)); acc = ATT_MFMA(kf, qf[ks], acc); }
    return acc;
}
template <int NK> __device__ __forceinline__ void load_vfrags_win(const Wave& w, int u, VFrags& v) {
    LAS unsigned char* vb = w.lds + NK * 128 + w.vlo;
#pragma unroll
    for (int db = 0; db < 2; ++db)
#pragma unroll
        for (int s = 0; s < 2; ++s) { LAS unsigned char* vp = vb + db * (NK * 64) + (4 * u + 2 * s) * 512; v.f[db][s][0] = vtr(vp); v.f[db][s][1] = vtr(vp + 512); }
}
struct WSub { bool act; int u; int delta; int W; };
template <int NK>
__device__ __forceinline__ void softmax_win(const Wave& w, const bf16x8 (&qf)[4], const bf16x8& kidx, const bf16x8& slp, float slope, const WSub (&sd)[2], float& m, float& lsum, f32x16 (&o)[2], bool& first) {
    f32x16 s[2];
    bool any_act = false;
#pragma unroll
    for (int i = 0; i < 2; ++i) if (sd[i].act) { any_act = true; s[i] = qk_win<NK>(w, sd[i].u, qf, -slope * (float)sd[i].delta - m); s[i] = ATT_MFMA(kidx, slp, s[i]); }
    if (!any_act) return;
    float tm = -INFINITY;
#pragma unroll
    for (int i = 0; i < 2; ++i) if (sd[i].act) {
        if (sd[i].W >= 0) mask_band(s[i], sd[i].delta - 4 * w.hi, sd[i].W);
        float t = fmaxf(fmaxf(s[i][0], s[i][1]), fmaxf(s[i][2], s[i][3]));
#pragma unroll
        for (int r = 4; r < 16; r += 4) t = fmaxf(t, fmaxf(fmaxf(s[i][r], s[i][r + 1]), fmaxf(s[i][r + 2], s[i][r + 3])));
        tm = fmaxf(tm, t); }
    tm = max_xor32(tm);
    if (first || __any(tm > SM_THR)) {
        const float d = first ? (tm > -1.0e30f ? tm : 0.f) : fmaxf(tm, 0.f);
#pragma unroll
        for (int i = 0; i < 2; ++i) if (sd[i].act) {
#pragma unroll
            for (int r = 0; r < 16; ++r) s[i][r] -= d; }
        if (!first) { const float al = __builtin_amdgcn_exp2f(-d); lsum *= al; scale_rows(w, o, al); }
        m += d; first = false;
    }
#pragma unroll
    for (int i = 0; i < 2; ++i) if (sd[i].act) { VFrags vf; load_vfrags_win<NK>(w, sd[i].u, vf);
        float acc = 0.f;
#pragma unroll
        for (int r = 0; r < 16; ++r) { s[i][r] = __builtin_amdgcn_exp2f(s[i][r]); acc += s[i][r]; }
        lsum += acc;
        pv_frags(vf, s[i], o); }
}

__device__ __forceinline__ size_t ql_off(int bh, int j) { return (size_t)bh * QL_PER_BH + (size_t)(8192 * j - 128 * j * (j + 1)); }
__device__ __forceinline__ float* lsem_ptr(float* l0, float* l1, int slot) { return (slot < 2 ? l0 : l1) + (size_t)(slot & 1) * T * 4; }

struct Top3 { int i0, i1, i2; };
__device__ __forceinline__ Top3 moba_top3(const Wave& w, const bf16x8 (&qf)[4], const float* KMEAN, int b, int h, int own) {
    int i0 = -1, i1 = -1, i2 = -1;
    if (own > 0) {
    f32x16 g;
#pragma unroll
    for (int r = 0; r < 16; ++r) g[r] = 0.f;
    const float* km = KMEAN + ((size_t)(b * 4 + h) * 32 + w.r32) * HD + 8 * w.hi;
#pragma unroll
    for (int ks = 0; ks < 4; ++ks) { const f32x4 a0 = *(const f32x4*)(km + 16 * ks), a1 = *(const f32x4*)(km + 16 * ks + 4);
        const float x[8] = {a0.x, a0.y, a0.z, a0.w, a1.x, a1.y, a1.z, a1.w}; unsigned hw[4], lw[4];
#pragma unroll
        for (int j = 0; j < 4; ++j) { const unsigned h0 = f2bf(x[2 * j]), h1 = f2bf(x[2 * j + 1]); hw[j] = h0 | (h1 << 16);
            lw[j] = pk2(x[2 * j] - __builtin_bit_cast(float, h0 << 16), x[2 * j + 1] - __builtin_bit_cast(float, h1 << 16)); }
        const u32x4 hv = {hw[0], hw[1], hw[2], hw[3]}, lv = {lw[0], lw[1], lw[2], lw[3]};
        g = ATT_MFMA(__builtin_bit_cast(bf16x8, hv), qf[ks], g); g = ATT_MFMA(__builtin_bit_cast(bf16x8, lv), qf[ks], g); }
    float v0 = -INFINITY, v1 = -INFINITY, v2 = -INFINITY;
#pragma unroll
    for (int r = 0; r < 16; ++r) { const int blk = (r & 3) + 8 * (r >> 2) + 4 * w.hi; const float val = (blk < own) ? g[r] : -INFINITY;
        if (val > v0) { v2 = v1; i2 = i1; v1 = v0; i1 = i0; v0 = val; i0 = blk; } else if (val > v1) { v2 = v1; i2 = i1; v1 = val; i1 = blk; } else if (val > v2) { v2 = val; i2 = blk; } }
    const float pv_[3] = {get_xor32(v0, w.hi), get_xor32(v1, w.hi), get_xor32(v2, w.hi)}; const int pi_[3] = {get_xor32i(i0, w.hi), get_xor32i(i1, w.hi), get_xor32i(i2, w.hi)};
#pragma unroll
    for (int k = 0; k < 3; ++k) { const float val = pv_[k]; const int blk = pi_[k];
        if (val > v0 || (val == v0 && blk < i0)) { v2 = v1; i2 = i1; v1 = v0; i1 = i0; v0 = val; i0 = blk; }
        else if (val > v1 || (val == v1 && blk < i1)) { v2 = v1; i2 = i1; v1 = val; i1 = blk; }
        else if (val > v2 || (val == v2 && blk < i2)) { v2 = val; i2 = blk; } }
    }
    Top3 t; t.i0 = i0; t.i1 = i1; t.i2 = i2; return t;
}
__device__ __forceinline__ void moba_gate_unit(LAS unsigned char* lds, const bf16_t* QB, const float* KMEAN, unsigned* mcnt, unsigned* qlist, bf16_t* PM, float* LSEM0, float* LSEM1, int b, int h, int own, int tid) {
    const Wave w = make_wave(lds, tid);
    const size_t rowbase = (size_t)b * SEQ; const int qpos = own * 256 + 32 * w.wid + w.r32, bh = b * 4 + h;
    bf16x8 qf[4]; load_q(qf, QB + (rowbase + qpos) * DM + h * HD, w.hi);
    const Top3 t3 = moba_top3(w, qf, KMEAN, b, h, own); const int s0 = t3.i0, s1 = t3.i1, s2 = t3.i2;
    LAS unsigned* cl = (LAS unsigned*)(lds + W_ENUM);
    if (tid < 64) cl[tid] = 0u;
    __syncthreads();
    unsigned r0 = 0u, r1 = 0u, r2 = 0u;
    if (w.hi == 0) {
        if (s0 >= 0) r0 = __hip_atomic_fetch_add(cl + s0, 1u, __ATOMIC_RELAXED, __HIP_MEMORY_SCOPE_WORKGROUP);
        if (s1 >= 0) r1 = __hip_atomic_fetch_add(cl + s1, 1u, __ATOMIC_RELAXED, __HIP_MEMORY_SCOPE_WORKGROUP);
        if (s2 >= 0) r2 = __hip_atomic_fetch_add(cl + s2, 1u, __ATOMIC_RELAXED, __HIP_MEMORY_SCOPE_WORKGROUP);
    }
    __syncthreads();
    if (tid < 32) { const unsigned c = cl[tid]; cl[32 + tid] = c ? __hip_atomic_fetch_add(mcnt + bh * 32 + tid, c, __ATOMIC_RELAXED, __HIP_MEMORY_SCOPE_AGENT) : 0u; }
    __syncthreads();
    if (w.hi == 0) {
        const size_t tok = rowbase + qpos;
#define MOBA_EMIT(k, sk, rk) do { if (sk >= 0) qlist[ql_off(bh, sk) + cl[32 + sk] + rk] = (unsigned)qpos | ((unsigned)(k) << 13); \
            else { lsem_ptr(LSEM0, LSEM1, k)[tok * 4 + h] = -1.0e30f;          \
                u32x4* pz = (u32x4*)(PM + ((size_t)(k) * T + tok) * 256 + h * HD); const u32x4 z4 = {0u, 0u, 0u, 0u}; \
                _Pragma("unroll") for (int c = 0; c < 8; ++c) pz[c] = z4; } } while (0)
        MOBA_EMIT(0, s0, r0); MOBA_EMIT(1, s1, r1); MOBA_EMIT(2, s2, r2);
#undef MOBA_EMIT
    }
    __syncthreads();
}
struct OwnU { int b, h, own; };
__device__ __forceinline__ void own_issue(Pref<4>& P, const Wave& w, const OwnU& u, const bf16_t* QB, const bf16_t* KB, const bf16_t* VB) {
    const size_t rowbase = (size_t)u.b * SEQ; const int q0 = u.own * 256;
    win_issue<4>(P, w, KB + (rowbase + q0) * DM + u.h * HD, VB + (rowbase + q0) * DM + u.h * HD, [&](int key) { return (size_t)key * DM; }, QB + (rowbase + q0 + 32 * w.wid + w.r32) * DM + u.h * HD);
}
template <class F> __device__ __forceinline__ void own_compute(const Wave& w, const OwnU& u, const bf16x8 (&qf)[4], bf16_t* OB, float* LSEM0, float* LSEM1, const F& between) {
    const size_t rowbase = (size_t)u.b * SEQ; const int q0 = u.own * 256, ql = 32 * w.wid + w.r32;
    const float slope2 = exp2f(-2.0f * (float)(u.h + 1)) * LOG2E;
    bf16x8 kidx, slp; bias_frags(w, slope2, kidx, slp);
    f32x16 o[2];
#pragma unroll
    for (int r = 0; r < 16; ++r) { o[0][r] = 0.f; o[1][r] = 0.f; }
    float m = 0.f, lsum = 0.f; bool first = true;
#pragma unroll
    for (int p = 0; p < 4; ++p) { WSub sd[2];
#pragma unroll
        for (int i = 0; i < 2; ++i) { const int su = w.wid - 2 * p - i; sd[i].act = su >= 0; sd[i].u = su; sd[i].delta = ql - 32 * su; sd[i].W = (su == w.wid) ? 0x7fffffff : -1; }
        softmax_win<256>(w, qf, kidx, slp, slope2, sd, m, lsum, o, first); }
    between();
    const float l = sum_xor32(lsum);
    scale_rows(w, o, 1.0f / l);
    bf16_t* orow = OB + (rowbase + q0 + 32 * w.wid) * DM + u.h * HD;
    store_o(w, o, [&](int r) { return orow + (size_t)r * DM; });
    if (w.hi == 0) lsem_ptr(LSEM0, LSEM1, 3)[(rowbase + q0 + ql) * 4 + u.h] = m + __builtin_amdgcn_logf(l);
}
struct GatU { int b, h, j, cnt, chunk; const unsigned* ql; };
__device__ __forceinline__ unsigned gat_entry(const Wave& w, const GatU& u, bool& valid) { const int idx = u.chunk * 256 + 32 * w.wid + w.r32; valid = idx < u.cnt; return u.ql[valid ? idx : u.chunk * 256]; }
__device__ __forceinline__ void gat_issue(Pref<4>& P, const Wave& w, const GatU& u, const bf16_t* QB, const bf16_t* KB, const bf16_t* VB) {
    const size_t rowbase = (size_t)u.b * SEQ; bool valid; const unsigned e = gat_entry(w, u, valid);
    win_issue<4>(P, w, KB + (rowbase + u.j * 256) * DM + u.h * HD, VB + (rowbase + u.j * 256) * DM + u.h * HD, [&](int key) { return (size_t)key * DM; }, QB + (rowbase + (e & 8191u)) * DM + u.h * HD);
}
template <class F> __device__ __forceinline__ void gat_compute(const Wave& w, const GatU& u, const bf16x8 (&qf)[4], bf16_t* PM, float* LSEM0, float* LSEM1, const F& between) {
    const size_t rowbase = (size_t)u.b * SEQ; bool valid; const unsigned e = gat_entry(w, u, valid);
    const int qpos = (int)(e & 8191u), slot = (int)(e >> 13);
    const float slope2 = exp2f(-2.0f * (float)(u.h + 1)) * LOG2E;
    bf16x8 kidx, slp; bias_frags(w, slope2, kidx, slp);
    f32x16 o[2];
#pragma unroll
    for (int r = 0; r < 16; ++r) { o[0][r] = 0.f; o[1][r] = 0.f; }
    float m = 0.f, lsum = 0.f; bool first = true;
#pragma unroll
    for (int p = 0; p < 4; ++p) { WSub sd[2];
#pragma unroll
        for (int i = 0; i < 2; ++i) { const int su = 7 - 2 * p - i; sd[i].act = true; sd[i].u = su; sd[i].delta = qpos - (u.j * 256 + 32 * su); sd[i].W = -1; }
        softmax_win<256>(w, qf, kidx, slp, slope2, sd, m, lsum, o, first); }
    between();
    const float l = sum_xor32(lsum);
    scale_rows(w, o, l > 0.f ? 1.0f / l : 0.f);
    LAS int* code = (LAS int*)(w.wsf + 32);
    if (w.hi == 0) code[w.r32] = valid ? (int)((size_t)slot * T + rowbase + qpos) : -1;
    store_o(w, o, [&](int r) { const int c = code[r]; return c >= 0 ? PM + (size_t)c * 256 + u.h * HD : (bf16_t*)nullptr; });
    if (w.hi == 0 && valid) lsem_ptr(LSEM0, LSEM1, slot)[(rowbase + qpos) * 4 + u.h] = l > 0.f ? m + __builtin_amdgcn_logf(l) : -1.0e30f;
}

__device__ __forceinline__ void sb_unit(LAS unsigned char* lds, const bf16_t* QB, const bf16_t* KB, const bf16_t* VB, bf16_t* OB, int b, int h, int qt, int tid) {
    const Wave w = make_wave(lds, tid);
    const size_t rowbase = (size_t)b * SEQ; const int q0 = qt * 256, qpos = q0 + 32 * w.wid + w.r32;
    const bf16_t* kh = KB + rowbase * DM + h * HD; const bf16_t* vh = VB + rowbase * DM + h * HD;
    bf16x8 qf[4]; load_q(qf, QB + (rowbase + qpos) * DM + h * HD, w.hi);
    f32x16 o[2];
#pragma unroll
    for (int r = 0; r < 16; ++r) { o[0][r] = 0.f; o[1][r] = 0.f; }
    float carry = 0.f;
    bool done = false;
    volatile LAS unsigned* flg = (volatile LAS unsigned*)(lds + L_FLG);
    const int ti0 = q0 / 64 + 3;
    Stage sg;
    { const int kp = ti0 * 64; stage_load(sg, w, [&](int key) { return kh + (size_t)(kp + key) * DM; }, [&](int key) { return vh + (size_t)(kp + key) * DM; }); }
    stage_write(sg, w, 0);
    __syncthreads();
    for (int st = 0;; ++st) {
        const int buf = st & 1, ti = ti0 - st;
        if (ti > 0) { const int kp = (ti - 1) * 64; stage_load(sg, w, [&](int key) { return kh + (size_t)(kp + key) * DM; }, [&](int key) { return vh + (size_t)(kp + key) * DM; }); }
        if (!done) {
#pragma unroll
            for (int sub = 1; sub >= 0; --sub) {
                const int D = (q0 / 32 + w.wid) - (2 * ti + sub);
                if (D < 0) continue;
                const int delta0 = qpos - (64 * ti + 32 * sub) - 4 * w.hi;
                f32x16 z = qk_sub(w, buf, sub, qf, 0.f);
                f32x16 dd;
#pragma unroll
                for (int r = 0; r < 16; ++r) { z[r] = __builtin_amdgcn_exp2f(fminf(z[r], 30.f)); }
                if (D == 0) {
#pragma unroll
                    for (int r = 0; r < 16; ++r) { const int dl = delta0 - ((r & 3) + 8 * (r >> 2)); if (dl < 1) z[r] = 0.f; }
                }
#pragma unroll
                for (int r = 0; r < 16; ++r) dd[r] = 1.f + z[r];
                float G[4], PG[4];
#pragma unroll
                for (int g = 0; g < 4; ++g) { G[g] = (dd[4 * g] * dd[4 * g + 1]) * (dd[4 * g + 2] * dd[4 * g + 3]); PG[g] = get_xor32(G[g], w.hi); }
                const float cin = __builtin_amdgcn_exp2f(carry);
                float run = 1.f;
#pragma unroll
                for (int g = 3; g >= 0; --g) { const float x3 = run * (w.hi == 0 ? PG[g] : 1.f);
                    const float p0 = x3 * G[g];
                    const float r0 = __builtin_amdgcn_rcpf(p0) * cin, r1 = r0 * dd[4 * g], r2 = r1 * dd[4 * g + 1], r3 = r2 * dd[4 * g + 2];
                    z[4 * g] *= r0; z[4 * g + 1] *= r1; z[4 * g + 2] *= r2; z[4 * g + 3] *= r3;
                    run *= G[g] * PG[g]; }
                carry -= __builtin_amdgcn_logf(run);
                pv_sub(w, buf, sub, z, o);
            }
            done = __all(carry < -150.f);
        }
        if (w.lane == 0) flg[buf * 8 + w.wid] = done ? 1u : 0u;
        if (ti > 0) stage_write(sg, w, buf ^ 1);
        __syncthreads();
        unsigned all = 1u;
#pragma unroll
        for (int k = 0; k < 8; ++k) all &= flg[buf * 8 + k];
        if (all || ti == 0) break;
    }
    bf16_t* orow = OB + (rowbase + q0 + 32 * w.wid) * DM + h * HD;
    store_o(w, o, [&](int r) { return orow + (size_t)r * DM; });
    __syncthreads();
}

struct PrefK6 { u32x4 k[6]; bf16x8 q[4]; }; struct PrefV6 { u32x4 v[6]; };
template <class RowF> __device__ __forceinline__ void win_issue_k6(PrefK6& P, const Wave& w, const bf16_t* kbase, const RowF& rowoff, const bf16_t* qrow) {
#pragma unroll
    for (int c = 0; c < 6; ++c) P.k[c] = *(const u32x4*)(kbase + rowoff(64 * c + 8 * w.wid + (w.lane >> 3)) + (w.lane & 7) * 8);
    load_q(P.q, qrow, w.hi);
}
template <class RowF> __device__ __forceinline__ void win_issue_v6(PrefV6& P, const Wave& w, const bf16_t* vbase, const RowF& rowoff) {
#pragma unroll
    for (int c = 0; c < 6; ++c) P.v[c] = *(const u32x4*)(vbase + rowoff(64 * c + 16 * (w.wid & 3) + (w.lane >> 2)) + (w.wid >> 2) * 32 + (w.lane & 3) * 8);
}
__device__ __forceinline__ void win_commit_k6(const PrefK6& P, const Wave& w) {
#pragma unroll
    for (int c = 0; c < 6; ++c) { const int key = 64 * c + 8 * w.wid + (w.lane >> 3); *(LAS u32x4*)(w.lds + key * 128 + ((((w.lane & 7) ^ (key >> 1)) & 7) * 16)) = P.k[c]; }
}
__device__ __forceinline__ void win_commit_v6(const PrefV6& P, const Wave& w) {
    constexpr int NK = 384;
#pragma unroll
    for (int c = 0; c < 6; ++c) *(LAS u32x4*)(w.lds + NK * 128 + (w.wid >> 2) * (NK * 64) + (8 * c + 2 * (w.wid & 3)) * 512 + w.lane * 16) = P.v[c];
}
struct DilU { int b, h, dil, res, i2, c; };
__device__ __forceinline__ DilU dil_decode(int u) { const int n = ((u & 31) + (u >> 8)) & 31, bhc = u >> 5,
    c = bhc % 3, bh = bhc / 3; DilU d; d.b = bh >> 3; d.h = 8 + (bh & 7); d.c = c;
    d.dil = (c == 0) ? 1 : (c == 1) ? 4 : 16; d.res = (c == 0) ? 0 : (c == 1) ? (n >> 3) : (n >> 1); d.i2 = (c == 0) ? n : (c == 1) ? (n & 7) : (n & 1); return d; }
__device__ __forceinline__ void dil_issue_k(PrefK6& P, const Wave& w, const DilU& u, const bf16_t* QB, const bf16_t* KB) {
    const size_t rowbase = (size_t)u.b * SEQ; const int Q0 = 256 * u.i2, qj = Q0 + 32 * w.wid + w.r32; const size_t rstride = (size_t)u.dil * DM;
    win_issue_k6(P, w, KB + (rowbase + u.res) * DM + u.h * HD, [&](int key) { const int kj = Q0 - 128 + key; return (size_t)(kj < 0 ? 0 : kj) * rstride; },
                 QB + (rowbase + u.res + (size_t)qj * u.dil) * DM + u.h * HD);
}
__device__ __forceinline__ void dil_issue_v(PrefV6& P, const Wave& w, const DilU& u, const bf16_t* VB) {
    const size_t rowbase = (size_t)u.b * SEQ; const int Q0 = 256 * u.i2; const size_t rstride = (size_t)u.dil * DM;
    win_issue_v6(P, w, VB + (rowbase + u.res) * DM + u.h * HD, [&](int key) { const int kj = Q0 - 128 + key; return (size_t)(kj < 0 ? 0 : kj) * rstride; });
}
template <class F> __device__ __forceinline__ void dil_compute(const Wave& w, const DilU& u, const bf16x8 (&qf)[4], bf16_t* OB, bf16_t* HB2, float* LSE, const F& between) {
    const size_t rowbase = (size_t)u.b * SEQ; const int Q0 = 256 * u.i2, ql = 32 * w.wid + w.r32;
    const float slope2d = exp2f(-(float)(u.h - 8 + 1)) * LOG2E * (float)u.dil;
    bf16x8 kidx, slp; bias_frags(w, slope2d, kidx, slp);
    f32x16 o[2];
#pragma unroll
    for (int r = 0; r < 16; ++r) { o[0][r] = 0.f; o[1][r] = 0.f; }
    float m = 0.f, lsum = 0.f; bool first = true;
#pragma unroll
    for (int p = 0; p < 3; ++p) { WSub sd[2];
#pragma unroll
        for (int i = 0; i < 2; ++i) { const int D = 2 * p + i, su = w.wid + 4 - D; sd[i].act = (D <= 4) && (Q0 - 128 + 32 * su >= 0); sd[i].u = su; sd[i].delta = ql + 128 - 32 * su; sd[i].W = (D == 0 || D == 4) ? 128 : -1; }
        softmax_win<384>(w, qf, kidx, slp, slope2d, sd, m, lsum, o, first); }
    between();
    const float l = sum_xor32(lsum);
    scale_rows(w, o, 1.0f / l);
    bf16_t* PO = (u.c == 0) ? OB + 512 : HB2 + (u.c - 1) * 512;
    const size_t tok0 = rowbase + u.res + (size_t)(Q0 + 32 * w.wid) * u.dil;
    store_o(w, o, [&](int r) { return PO + (tok0 + (size_t)r * u.dil) * DM + (u.h - 8) * HD; });
    if (w.hi == 0) (LSE + (size_t)u.c * T * 8)[(tok0 + (size_t)w.r32 * u.dil) * 8 + (u.h - 8)] = m + __builtin_amdgcn_logf(l);
}

__device__ __forceinline__ void moba_gate_phase(LAS unsigned char* lds, const bf16_t* QB, const float* KMEAN, unsigned* mcnt, unsigned* qlist, bf16_t* PM, float* LSEM0, float* LSEM1, int v, int G, int tid) {
    for (int u = v; u < 512; u += G) { const int own = u & 31, bh = u >> 5; moba_gate_unit(lds, QB, KMEAN, mcnt, qlist, PM, LSEM0, LSEM1, bh >> 2, bh & 3, own, tid); }
}
struct AttnArgs { const bf16_t* QB; const bf16_t* KB; const bf16_t* VB; bf16_t* OB; bf16_t* HB2; float* LSE; unsigned* mcnt; unsigned* qlist; bf16_t* PM; float* LSEM0; float* LSEM1; const float* KMEAN; unsigned* gdone; };
__device__ __forceinline__ void attn_phase(LAS unsigned char* lds, const AttnArgs& A, int v, int G, int tid) {
    moba_gate_phase(lds, A.QB, A.KMEAN, A.mcnt, A.qlist, A.PM, A.LSEM0, A.LSEM1, v, G, tid);
    asm volatile("s_waitcnt vmcnt(0)" ::: "memory");
    __syncthreads();
    if (tid == 0) { __builtin_amdgcn_fence(__ATOMIC_RELEASE, "agent"); asm volatile("s_waitcnt vmcnt(0)" ::: "memory"); __hip_atomic_fetch_add(A.gdone, 1u, __ATOMIC_RELAXED, __HIP_MEMORY_SCOPE_AGENT); }
    const Wave w = make_wave(lds, tid, W_WSF, W_OST);
    {   Pref<4> P; int u = v; OwnU cur, nxt;
        auto dec = [&](int uu) { OwnU o_; const int bh = uu >> 5; o_.b = bh >> 2; o_.h = bh & 3; o_.own = uu & 31; return o_; };
        if (u < 512) { cur = dec(u); own_issue(P, w, cur, A.QB, A.KB, A.VB); }
        for (; u < 512; u += G) {
            __syncthreads();
            win_commit<4>(P, w); bf16x8 qf[4] = {P.q[0], P.q[1], P.q[2], P.q[3]};
            __syncthreads();
            const bool more = u + G < 512; if (more) nxt = dec(u + G);
            own_compute(w, cur, qf, A.OB, A.LSEM0, A.LSEM1, [&]() { if (more) own_issue(P, w, nxt, A.QB, A.KB, A.VB); });
            cur = nxt; } }
    {   PrefK6 P; int u = v; DilU cur, nxt;
        if (u < 3072) { cur = dil_decode(u); dil_issue_k(P, w, cur, A.QB, A.KB); }
        for (; u < 3072; u += G) {
            __syncthreads();
            bf16x8 qf[4] = {P.q[0], P.q[1], P.q[2], P.q[3]};
            { PrefV6 PV; dil_issue_v(PV, w, cur, A.VB); win_commit_k6(P, w); win_commit_v6(PV, w); }
            __syncthreads();
            const bool more = u + G < 3072; if (more) nxt = dil_decode(u + G);
            dil_compute(w, cur, qf, A.OB, A.HB2, A.LSE, [&]() { if (more) dil_issue_k(P, w, nxt, A.QB, A.KB); });
            cur = nxt; } }
    __syncthreads();
    for (int u = v; u < 512; u += G) { const int qt = ((u & 31) + (u >> 8)) & 31, bh = u >> 5; sb_unit(lds, A.QB, A.KB, A.VB, A.OB, bh >> 2, 4 + (bh & 3), qt, tid); }
    if (tid == 0) { unsigned polls = 0;
        while (__hip_atomic_load(A.gdone, __ATOMIC_RELAXED, __HIP_MEMORY_SCOPE_AGENT) < (unsigned)G) { if (++polls > (1u << 20)) break; __builtin_amdgcn_s_sleep(2); }
        __builtin_amdgcn_fence(__ATOMIC_ACQUIRE, "agent"); asm volatile("s_waitcnt vmcnt(0)" ::: "memory"); }
    __syncthreads();
    LAS int* cntl = (LAS int*)(lds + W_ENUM); LAS int* pa = cntl + 512; LAS int* pb = pa + 512;
    const int myc = (int)A.mcnt[tid], myu = (myc + 255) >> 8;
    cntl[tid] = myc; pa[tid] = myu;
    __syncthreads();
#pragma unroll 1
    for (int d = 1; d < 512; d <<= 1) { const int x = pa[tid] + (tid >= d ? pa[tid - d] : 0); pb[tid] = x; __syncthreads(); LAS int* t_ = pa; pa = pb; pb = t_; }
    const int total = pa[511];
    auto gat_decode = [&](int u) { int lo = 0, hi = 511;
        while (lo < hi) { const int mid = (lo + hi) >> 1; if (pa[mid] > u) hi = mid; else lo = mid + 1; }
        const int i = lo, c = cntl[i], bh = i >> 5; GatU g; g.b = bh >> 2; g.h = bh & 3; g.j = i & 31; g.cnt = c; g.chunk = u - (pa[i] - ((c + 255) >> 8)); g.ql = A.qlist + ql_off(bh, g.j); return g; };
    {   Pref<4> P; int u = v; GatU cur, nxt;
        if (u < total) { cur = gat_decode(u); gat_issue(P, w, cur, A.QB, A.KB, A.VB); }
        for (; u < total; u += G) {
            __syncthreads();
            win_commit<4>(P, w); bf16x8 qf[4] = {P.q[0], P.q[1], P.q[2], P.q[3]};
            __syncthreads();
            const bool more = u + G < total; if (more) nxt = gat_decode(u + G);
            gat_compute(w, cur, qf, A.PM, A.LSEM0, A.LSEM1, [&]() { if (more) gat_issue(P, w, nxt, A.QB, A.KB, A.VB); });
            cur = nxt; } }
}
}

constexpr int PH_PRO = 0, PH_L0 = 1, PH_PER_LAYER = 10, PH_FINAL = PH_L0 + DEPTH * PH_PER_LAYER, PH_COUNT = PH_FINAL + 1;
typedef const __attribute__((address_space(4))) Args* KArgP;
#define KARG() ({ KArgP p_ = (KArgP)__builtin_amdgcn_kernarg_segment_ptr(); asm volatile("" : "+s"(p_)); p_; })
#define PHASE_IDS int lane_p = (int)__builtin_amdgcn_mbcnt_hi(~0u, __builtin_amdgcn_mbcnt_lo(~0u, 0u)); LAUNDER_V(lane_p); int tid_p = wave * 64 + lane_p; int gw_p = gw, G_p = G, NGW_p = NGW; LAUNDER_S(gw_p); LAUNDER_S(G_p); LAUNDER_S(NGW_p)
__global__ void __launch_bounds__(NTHREADS, 2) fwd(Args a_unused) {
    extern __shared__ __attribute__((aligned(16))) unsigned char lds_raw[];
    LAS unsigned char* lds = (LAS unsigned char*)lds_raw;
    volatile LAS unsigned* MISC = (volatile LAS unsigned*)(lds + MISC_OFF);
    const int wave = __builtin_amdgcn_readfirstlane((int)threadIdx.x >> 6);
    const int G = gridDim.x, bx = blockIdx.x;
    const int vcu = (G % 8 == 0) ? (bx % 8) * (G / 8) + bx / 8 : bx;
    const int gw = vcu * NWAVES + wave, NGW = G * NWAVES;
    for (int u = threadIdx.x; u < (LDS_BYTES - LDSCTL_OFF) / 4; u += NTHREADS) ((LAS unsigned*)(lds + LDSCTL_OFF))[u] = 0u;
    __syncthreads();
    int lo, hi; XcdBarrier bar;
    { KArgP ka = KARG(); lo = ka->ph_lo; hi = ka->ph_hi; unsigned* ctl = (unsigned*)(ka->ws + WS_CTL); bar = xcd_barrier_post(ctl + CW_BAR + ka->li * XCD_BAR_WORDS, MISC + 8, wave); }
#define IN(k) (lo <= (k) && (k) < hi)
#define SEAM(k) do { if (IN(k) && IN((k) + 1)) xcd_barrier(bar); } while (0)
#define WSP(T_, off) ((T_*)(ws + (off)))

    if (IN(PH_PRO)) { KArgP ka = KARG(); PHASE_IDS; Args a; a.ws = ka->ws; a.w_in = ka->w_in; a.w_out = ka->w_out; a.w_gate = ka->w_gate; a.w_up = ka->w_up; a.w_down = ka->w_down; a.ln2_g = ka->ln2_g; a.ln1_g = ka->ln1_g; phase_prologue(a, lds, gw_p, NGW_p, wave, lane_p); } SEAM(PH_PRO);

    for (int l = 0; l < DEPTH; ++l) {
        const int p0 = PH_L0 + l * PH_PER_LAYER;
        if (hi <= p0 || lo >= p0 + PH_PER_LAYER) continue;
        if (l == 0) { if (IN(p0 + 0)) { KArgP ka = KARG(); PHASE_IDS; unsigned char* ws = ka->ws;
            phase_norm1(ka->x, gw_p, NGW_p, lane_p, WSP(float, WS_KMEAN), WSP(bf16_t, WS_XB), WSP(float, WS_SSQ)); } SEAM(p0 + 0); }
        if (IN(p0 + 1)) for (int rep_ = 0; rep_ < RPT(1); ++rep_) { if (rep_) xcd_barrier(bar); KArgP ka = KARG(); PHASE_IDS; unsigned char* ws = ka->ws;
            pg8::Gemm g{(const char*)(ws + WS_XB), (const char*)(ws + WS_WIN) + (size_t)l * NQKV * DM * 2, DM, DM, DM, (long)256 * DM * 2, (long)256 * DM * 2, (long)128 * DM * 2, WSP(float, WS_SSQ)};
            pg8::StaticOrder S; S.init(T / 256, NQKV / 256, G_p, bx);
            pg8::EpiQKV E{WSP(bf16_t, WS_Q), (size_t)(WS_K - WS_Q) / 2, QSCALE};
            pg8::gemm_phase<pg8::EpiQKV, pg8::StaticOrder>(lds, g, S, E, wave);
        } SEAM(p0 + 1);
        if (IN(p0 + 4)) for (int rep_ = 0; rep_ < RPT(4); ++rep_) { if (rep_) xcd_barrier(bar); KArgP ka = KARG(); PHASE_IDS; unsigned char* ws = ka->ws;
            const att::AttnArgs A{WSP(bf16_t, WS_Q), WSP(bf16_t, WS_K), WSP(bf16_t, WS_V), (bf16_t*)ka->out, WSP(bf16_t, WS_HB), WSP(float, WS_LSE), WSP(unsigned, WS_CTL) + CW_MCNT + l * 512, WSP(unsigned, WS_QLIST),
                                  WSP(bf16_t, WS_PM), WSP(float, WS_LSEM0), WSP(float, WS_LSEM1), WSP(float, WS_KMEAN), WSP(unsigned, WS_CTL) + CW_GDONE + l * 64};
            att::attn_phase(lds, A, vcu, G_p, tid_p);
        } SEAM(p0 + 4);
        if (IN(p0 + 5)) { KArgP ka = KARG(); PHASE_IDS; unsigned char* ws = ka->ws;
            phase_mixnorm((const bf16_t*)ka->out, WSP(bf16_t, WS_HB), WSP(float, WS_LSE), WSP(bf16_t, WS_PM), WSP(float, WS_LSEM0), WSP(float, WS_LSEM1), ka->mix_g + (size_t)l * DM, gw_p, NGW_p, lane_p); } SEAM(p0 + 5);
        if (IN(p0 + 6)) { KArgP ka = KARG(); PHASE_IDS; unsigned char* ws = ka->ws;
            pg8::Gemm g{(const char*)(ws + WS_HB), (const char*)(ws + WS_WOUT) + (size_t)l * DM * DM * 2, DM, DM, DM, (long)256 * DM * 2, (long)256 * DM * 2, (long)128 * DM * 2, nullptr};
            pg8::StaticOrder S; S.init(T / 256, DM / 256, G_p, bx);
            pg8::EpiResAdd E{WSP(bf16_t, WS_XB)};
            pg8::gemm_phase<pg8::EpiResAdd, pg8::StaticOrder>(lds, g, S, E, wave);
        } SEAM(p0 + 6);
        if (IN(p0 + 7)) { KArgP ka = KARG(); PHASE_IDS; unsigned char* ws = ka->ws;
            phase_route(WSP(bf16_t, WS_XB), ka->ln2_g + (size_t)l * DM, ka->w_gr + (size_t)l * DM * 4, ka->b_gr + l * 4, ka->w_er + (size_t)l * 4 * DM * 4, ka->b_er + l * 16, WSP(float, WS_LSE),
                        WSP(unsigned, WS_CTL) + CW_CNT + l * 32, WSP(unsigned, WS_LIST), WSP(float, WS_WLIST), lds, vcu, G_p, wave, lane_p, WSP(float, WS_KMEAN)); } SEAM(p0 + 7);
        if (IN(p0 + 8)) for (int rep_ = 0; rep_ < RPT(8); ++rep_) { if (rep_) xcd_barrier(bar); KArgP ka = KARG(); PHASE_IDS; unsigned char* ws = ka->ws;
            pg8::MoeProb<0> P{WSP(unsigned, WS_CTL) + CW_CNT + l * 32, WSP(unsigned, WS_LIST), (const char*)(ws + WS_XB), (const char*)(ws + WS_WG) + (size_t)l * NACT * DM * 2, DM, DM, DM, (long)(WS_WU - WS_WG), G_p, vcu, WSP(unsigned, WS_CTL) + CW_TCNT + l * 16384};
            pg8::EpiGateUpSparse E{WSP(bf16_t, WS_ACT), WSP(float, WS_WLIST), WSP(float, WS_LSE), WSP(unsigned, WS_CTL) + CW_TCNT + l * 16384};
            pg8::gemm_phase_x<pg8::EpiGateUpSparse, pg8::MoeProb<0>>(lds, P, E, wave);
        }
        if (IN(p0 + 9)) { KArgP ka = KARG(); PHASE_IDS; unsigned char* ws = ka->ws;
            pg8::MoeProb<1> P{WSP(unsigned, WS_CTL) + CW_CNT + l * 32, WSP(unsigned, WS_LIST), (const char*)(ws + WS_ACT), (const char*)(ws + WS_WD) + (size_t)l * DM * NACT * 2, 512, NACT, 512, (long)128 * NACT * 2, G_p, vcu, WSP(unsigned, WS_CTL) + CW_TCNT + l * 16384};
            pg8::EpiDownScatter E{WSP(bf16_t, WS_XB), WSP(unsigned, WS_LIST), WSP(float, WS_SSQ), lds};
            pg8::gemm_phase_x<pg8::EpiDownScatter, pg8::MoeProb<1>>(lds, P, E, wave);
        } SEAM(p0 + 9);
    }
    if (IN(PH_FINAL)) { KArgP ka = KARG(); PHASE_IDS; phase_final((const bf16_t*)(ka->ws + WS_XB), ka->fin_g, ka->out, gw_p, NGW_p, lane_p); }
#undef IN
#undef SEAM
#undef WSP
}

#ifndef N_LAUNCH_MODE
#define N_LAUNCH_MODE 1
#endif
extern "C" void kernel_launch(void* const* d_in, const int* in_sizes, int n_in, void* d_out, int out_size, void* d_ws, size_t ws_size, hipStream_t stream) {
    static int grid = 0;
    if (grid == 0) {
        if (n_in != 14 || in_sizes[0] != T * DM || out_size != T * DM || ws_size < WS_END) { fprintf(stderr, "kernel_launch: unexpected shapes (n_in %d in0 %d out %d ws %zu)\n", n_in, n_in > 0 ? in_sizes[0] : -1, out_size, ws_size); grid = -1; return; }
        int dev = 0, cus = 0, per_cu = 0;
        if (hipGetDevice(&dev) != hipSuccess || hipDeviceGetAttribute(&cus, hipDeviceAttributeMultiprocessorCount, dev) != hipSuccess) { grid = -1; return; }
        if (hipFuncSetAttribute((const void*)fwd, hipFuncAttributeMaxDynamicSharedMemorySize, LDS_BYTES) != hipSuccess) { fprintf(stderr, "kernel_launch: hipFuncSetAttribute failed\n"); grid = -1; return; }
        if (hipOccupancyMaxActiveBlocksPerMultiprocessor(&per_cu, (const void*)fwd, NTHREADS, LDS_BYTES) != hipSuccess || per_cu < 1) fprintf(stderr, "kernel_launch: occupancy query says %d\n", per_cu);
        (void)hipGetLastError();
        grid = cus;
    }
    if (grid < 0) return;
    if (hipMemsetAsync((char*)d_ws + WS_CTL, 0, CTL_ZERO_BYTES, stream) != hipSuccess) return;
    Args a{};
    a.x = (const float*)d_in[0]; a.ln1_g = (const float*)d_in[1]; a.w_in = (const float*)d_in[2]; a.mix_g = (const float*)d_in[3]; a.w_out = (const float*)d_in[4]; a.ln2_g = (const float*)d_in[5];
    a.w_gr = (const float*)d_in[6]; a.b_gr = (const float*)d_in[7]; a.w_er = (const float*)d_in[8]; a.b_er = (const float*)d_in[9]; a.w_gate = (const float*)d_in[10]; a.w_up = (const float*)d_in[11];
    a.w_down = (const float*)d_in[12]; a.fin_g = (const float*)d_in[13];
    a.out = (float*)d_out; a.ws = (unsigned char*)d_ws; a.pad = 0;
#if N_LAUNCH_MODE == 1
    a.ph_lo = 0; a.ph_hi = PH_COUNT; a.li = 0;
    hipLaunchKernelGGL(fwd, dim3(grid), dim3(NTHREADS), LDS_BYTES, stream, a);
#else
    for (int p = 0; p < PH_COUNT; ++p) { a.ph_lo = p; a.ph_hi = p + 1; a.li = p; hipLaunchKernelGGL(fwd, dim3(grid), dim3(NTHREADS), LDS_BYTES, stream, a); }
#endif
}
```

```cpp
#include <hip/hip_runtime.h>
#include <cstdio>
#include <cstdint>

#define LAS __attribute__((address_space(3)))
#define GAS __attribute__((address_space(1)))
typedef unsigned short bf16_t;
typedef short bf16x8 __attribute__((ext_vector_type(8)));
typedef float f32x4 __attribute__((ext_vector_type(4)));
typedef float f32x2 __attribute__((ext_vector_type(2)));
typedef unsigned u32x4 __attribute__((ext_vector_type(4)));
typedef unsigned u32x2 __attribute__((ext_vector_type(2)));

#ifndef PROBE_REPEAT
#define PROBE_REPEAT 0
#endif
#define RPT(k) ((((PROBE_REPEAT) >> (k)) & 1) ? 2 : 1)
#ifndef MOE_SPARSE
#define MOE_SPARSE 1
#endif
#ifndef ATT_MOBA
#define ATT_MOBA 1
#endif
#ifndef ATT_SB
#define ATT_SB 1
#endif
#ifndef ATT_DIL
#define ATT_DIL 1
#endif
constexpr int BATCH = 4, SEQ = 8192, DM = 1024, DEPTH = 4, T = BATCH * SEQ, NH = 16, HD = 64;
constexpr int NQKV = 3 * DM, NEXP = 16, DEXP = 256, NACT = NEXP * DEXP;
constexpr float NORM_EPS = 1e-6f;
constexpr float LOG2E = 1.4426950408889634f;
constexpr float QSCALE = 0.125f * LOG2E;
constexpr int NWAVES = 8, NTHREADS = 512;

constexpr size_t MiB = 1u << 20;
constexpr size_t WS_CTL = 0, CTL_ZERO_BYTES = 1 * MiB;
constexpr size_t WS_WIN = 2 * MiB;
constexpr size_t WS_WOUT = 26 * MiB;
constexpr size_t WS_WG = 34 * MiB;
constexpr size_t WS_WU = 66 * MiB;
constexpr size_t WS_WD = 98 * MiB;
constexpr size_t WS_LSEM0 = 1 * MiB;
constexpr size_t WS_KMEAN = 130 * MiB;
constexpr int RT_RP = 2064, RT_IMG = 2 * 20 * RT_RP;
constexpr size_t WS_RIMG = 130 * MiB + 128 * 1024;
constexpr size_t WS_HB = 131 * MiB;
constexpr size_t WS_Q = 195 * MiB, WS_K = 259 * MiB, WS_V = 323 * MiB, WS_XB = 387 * MiB;
constexpr size_t WS_ACT = WS_Q;
constexpr size_t WS_SSQ = 130 * MiB + 512 * 1024;
constexpr size_t WS_LSE = 451 * MiB;
constexpr size_t WS_LIST = 454 * MiB;
constexpr size_t WS_WLIST = 457 * MiB;
constexpr size_t WS_QLIST = WS_LIST;
constexpr size_t WS_PM = 463 * MiB;
constexpr size_t WS_LSEM1 = 511 * MiB;
constexpr size_t WS_END = 512 * MiB;
constexpr int QL_PER_BH = 126976;
constexpr int CW_GDONE = 1536;
constexpr int CW_MCNT = 2048;
constexpr int CW_CNT = 1024;
constexpr int CW_TCNT = 16384;
constexpr int CW_BAR = 4096;

constexpr int RING_BYTES = 131072;
constexpr int LDSCTL_OFF = 147456, MISC_OFF = LDSCTL_OFF + 320;
constexpr int LDS_BYTES = 148480;

__device__ __forceinline__ unsigned f2bf(float f) { unsigned u = __builtin_bit_cast(unsigned, f); return (u + 0x7fffu + ((u >> 16) & 1u)) >> 16; }
typedef __bf16 bf16pair_t __attribute__((ext_vector_type(2)));
__device__ __forceinline__ unsigned pk2(float lo, float hi) { f32x2 v = {lo, hi}; const bf16pair_t b = __builtin_convertvector(v, bf16pair_t); return __builtin_bit_cast(unsigned, b); }
__device__ __forceinline__ float bflo(unsigned w) { return __builtin_bit_cast(float, w << 16); }
__device__ __forceinline__ float bfhi(unsigned w) { return __builtin_bit_cast(float, w & 0xffff0000u); }
template <int M> __device__ __forceinline__ float swz_xor(float v) { return __builtin_bit_cast(float, __builtin_amdgcn_ds_swizzle(__builtin_bit_cast(int, v), 0x1f | (M << 10))); }
__device__ __forceinline__ void swap32(unsigned x, unsigned& lo_val, unsigned& hi_val) { unsigned y = x; asm volatile("" : "+v"(y)); auto rr = __builtin_amdgcn_permlane32_swap(x, y, false, false); lo_val = rr[0]; hi_val = rr[1]; }
__device__ __forceinline__ float sum_xor32(float v) { unsigned a, b; swap32(__builtin_bit_cast(unsigned, v), a, b); return __builtin_bit_cast(float, a) + __builtin_bit_cast(float, b); }
__device__ __forceinline__ float max_xor32(float v) { unsigned a, b; swap32(__builtin_bit_cast(unsigned, v), a, b); return fmaxf(__builtin_bit_cast(float, a), __builtin_bit_cast(float, b)); }
__device__ __forceinline__ float get_xor32(float v, int hi) { unsigned a, b; swap32(__builtin_bit_cast(unsigned, v), a, b); return __builtin_bit_cast(float, hi ? a : b); }
__device__ __forceinline__ int get_xor32i(int v, int hi) { unsigned a, b; swap32((unsigned)v, a, b); return (int)(hi ? a : b); }
template <int CTRL> __device__ __forceinline__ float dpp_mov(float v) { return __builtin_bit_cast(float, __builtin_amdgcn_update_dpp(0, __builtin_bit_cast(int, v), CTRL, 0xf, 0xf, false)); }
__device__ __forceinline__ float row_sum(float v) { v += dpp_mov<0xB1>(v); v += dpp_mov<0x4E>(v); v += dpp_mov<0x141>(v); v += dpp_mov<0x140>(v); return v; }
__device__ __forceinline__ float half_sum(float v) { v = row_sum(v); v += swz_xor<16>(v); return v; }
__device__ __forceinline__ float wave_sum(float v) { return sum_xor32(half_sum(v)); }
#define LDS_WAIT() asm volatile("s_waitcnt lgkmcnt(0)" ::: "memory")
#define LAUNDER_V(x) asm volatile("" : "+v"(x))
#define LAUNDER_S(x) asm volatile("" : "+s"(x))

namespace pg8 {
constexpr int BM = 256, BK = 64, HALF = 128, HTB = HALF * BK * 2, STAGE_BYTES = 8 * HTB, NXCD = 8, WGM = 8;
__host__ __device__ __forceinline__ int lds_byte(int r, int c) { const int st = (r >> 4) * 2 + (c >> 5), rr = r & 15, cc = c & 31, ob = rr * 64 + cc * 2; return st * 1024 + (ob ^ (((ob >> 9) & 1) << 5)); }
__host__ __device__ __forceinline__ void stage_rc(int b, int& R, int& C) { const int st = b / 1024, sb = b % 1024, swz = sb ^ (((sb >> 9) & 1) << 5); R = (st >> 1) * 16 + swz / 64; C = (st & 1) * 32 + (swz % 64) / 2; }
__host__ __device__ __forceinline__ int perm32(int rho) { const int n = rho >> 4, i = rho & 15; return 8 * (i >> 2) + 4 * n + (i & 3); }

struct Unit { int pm, pn, meta;
    __device__ __forceinline__ int bk() const { return meta & 31; } __device__ __forceinline__ int tib() const { return (meta >> 5) & 255; } __device__ __forceinline__ int nb() const { return meta >> 13; } };
struct Gemm { const char* A; const char* B; int lda, ldb, K; long tstepA, tstepB, hstepB; const float* rowvec; };
constexpr int RV_OFF = STAGE_BYTES + 1024;
constexpr int RED_OFF = 140288;

struct StaticOrder {
    int nM, nN, nwg, G, c;
    __host__ __device__ void init(int nM_, int nN_, int G_, int c_) { nM = nM_; nN = nN_; nwg = nM * nN; G = G_; c = c_; }
    __host__ __device__ bool next(int i, Unit& u) const {
        const long L = (long)i * G + c; if (L >= nwg) return false;
        int wgid = (int)L; { const int q = nwg / NXCD, r = nwg % NXCD, xcd = wgid % NXCD, off = wgid / NXCD; wgid = (xcd < r ? xcd * (q + 1) : r * (q + 1) + (xcd - r) * q) + off; }
        const int nig = WGM * nN, gid = wgid / nig, fm = gid * WGM, gsz = (nM - fm) < WGM ? (nM - fm) : WGM;
        u.pm = fm + ((wgid % nig) % gsz); u.pn = (wgid % nig) / gsz; return true;
    }
};

__device__ __forceinline__ unsigned cvt_pk_bf16(float lo, float hi) { return pk2(lo, hi); }

struct EpiQKV {
    static constexpr bool PERM = true, ROWVEC = true;
    bf16_t* O; size_t split_stride; float scale0;
    __device__ __forceinline__ void operator()(const f32x4 (&acc)[2][2][4][2], const Unit& u, int wr, int wc, int fr, int fq, const LAS float* rv) const {
        asm volatile("" : "+v"(fr), "+v"(fq));
        float rs[2][4];
#pragma unroll
        for (int ai = 0; ai < 2; ++ai)
#pragma unroll
            for (int m = 0; m < 4; ++m) { const int ri = ai * HALF + wr * 64 + m * 16 + fr; const f32x4 p4 = *(const LAS f32x4*)(rv + 4 * ri); const float ss = (p4.x + p4.y) + (p4.z + p4.w);
                rs[ai][m] = __builtin_amdgcn_rsqf(ss * (1.f / DM) + NORM_EPS); }
        const int row0 = u.pm * BM + wr * 64 + fr; int colt = u.pn * BM;
        const int t = colt / DM; bf16_t* base = O + (size_t)t * split_stride; colt -= t * DM; const float sc = (t == 0) ? scale0 : 1.f;
        const int col0 = colt + wc * 32 + 8 * fq;
#pragma unroll
        for (int ai = 0; ai < 2; ++ai)
#pragma unroll
            for (int m = 0; m < 4; ++m) { bf16_t* rowp = base + (size_t)(row0 + ai * HALF + m * 16) * DM + col0;
#pragma unroll
                for (int bj = 0; bj < 2; ++bj) { const float sr = sc * rs[ai][m]; f32x4 v0 = acc[ai][bj][m][0] * sr, v1 = acc[ai][bj][m][1] * sr;
                    u32x4 w; w.x = cvt_pk_bf16(v0[0], v0[1]); w.y = cvt_pk_bf16(v0[2], v0[3]); w.z = cvt_pk_bf16(v1[0], v1[1]); w.w = cvt_pk_bf16(v1[2], v1[3]);
                    *(u32x4*)(rowp + bj * HALF) = w; } }
        if (u.pn == 4) {
            float* kmean = (float*)((unsigned char*)O - WS_Q + WS_KMEAN) + ((size_t)((u.pm >> 5) * 4) * 32 + (u.pm & 31)) * HD;
#pragma unroll
            for (int bj = 0; bj < 2; ++bj)
#pragma unroll
                for (int n = 0; n < 2; ++n)
#pragma unroll
                    for (int j = 0; j < 4; ++j) { float cs = 0.f;
#pragma unroll
                        for (int ai = 0; ai < 2; ++ai)
#pragma unroll
                            for (int m = 0; m < 4; ++m) cs += acc[ai][bj][m][n][j] * rs[ai][m];
                        cs = row_sum(cs);
                        const int col = bj * HALF + wc * 32 + 8 * fq + 4 * n + j;
                        if (fr == 0) __hip_atomic_fetch_add(kmean + (size_t)(col >> 6) * 32 * HD + (col & 63), cs, __ATOMIC_RELAXED, __HIP_MEMORY_SCOPE_AGENT); }
        }
    }
};
struct EpiResAdd {
    static constexpr bool PERM = true, ROWVEC = false;
    bf16_t* xb;
    __device__ __forceinline__ void operator()(const f32x4 (&acc)[2][2][4][2], const Unit& u, int wr, int wc, int fr, int fq, const LAS float*) const {
        asm volatile("" : "+v"(fr), "+v"(fq));
        const int col0 = u.pn * BM + wc * 32 + 8 * fq;
#pragma unroll
        for (int ai = 0; ai < 2; ++ai) { u32x4 r[4][2];
#pragma unroll
            for (int m = 0; m < 4; ++m) { const bf16_t* rowp = xb + (size_t)(u.pm * BM + ai * HALF + wr * 64 + m * 16 + fr) * DM + col0;
#pragma unroll
                for (int bj = 0; bj < 2; ++bj) r[m][bj] = *(const u32x4*)(rowp + bj * HALF); }
#pragma unroll
            for (int m = 0; m < 4; ++m) { bf16_t* rowp = xb + (size_t)(u.pm * BM + ai * HALF + wr * 64 + m * 16 + fr) * DM + col0;
#pragma unroll
                for (int bj = 0; bj < 2; ++bj) { const f32x4 v0 = acc[ai][bj][m][0], v1 = acc[ai][bj][m][1]; const u32x4 q = r[m][bj];
                    u32x4 w; w.x = cvt_pk_bf16(bflo(q.x) + v0[0], bfhi(q.x) + v0[1]); w.y = cvt_pk_bf16(bflo(q.y) + v0[2], bfhi(q.y) + v0[3]);
                    w.z = cvt_pk_bf16(bflo(q.z) + v1[0], bfhi(q.z) + v1[1]); w.w = cvt_pk_bf16(bflo(q.w) + v1[2], bfhi(q.w) + v1[3]);
                    *(u32x4*)(rowp + bj * HALF) = w; } } }
    }
};
struct EpiGateUpDense {
    static constexpr bool PERM = true;
    bf16_t* act; const float* comb;
    __device__ __forceinline__ void operator()(const f32x4 (&acc)[2][2][4][2], const Unit& u, int wr, int wc, int fr, int fq) const {
        asm volatile("" : "+v"(fr), "+v"(fq));
        const int e = u.pn >> 1, c0 = (u.pn & 1) * HALF;
        const int col0 = e * DEXP + c0 + wc * 32 + 8 * fq;
#pragma unroll
        for (int ai = 0; ai < 2; ++ai)
#pragma unroll
            for (int m = 0; m < 4; ++m) { const int row = u.pm * BM + ai * HALF + wr * 64 + m * 16 + fr;
                const float cw = comb[(size_t)row * NEXP + e];
                float o[8];
#pragma unroll
                for (int n = 0; n < 2; ++n)
#pragma unroll
                    for (int j = 0; j < 4; ++j) { const float g = acc[ai][0][m][n][j], up = acc[ai][1][m][n][j];
                        const float sg = g * __builtin_amdgcn_rcpf(1.f + __builtin_amdgcn_exp2f(-g * LOG2E));
                        o[n * 4 + j] = sg * up * cw; }
                u32x4 w; w.x = cvt_pk_bf16(o[0], o[1]); w.y = cvt_pk_bf16(o[2], o[3]); w.z = cvt_pk_bf16(o[4], o[5]); w.w = cvt_pk_bf16(o[6], o[7]);
                *(u32x4*)(act + (size_t)row * NACT + col0) = w; }
    }
};

template <class Epi, class Sched>
__device__ __forceinline__ void gemm_phase(LAS unsigned char* lds, const Gemm g, const Sched& S, const Epi& E, int wave_id) {
    int lane_l = (int)__builtin_amdgcn_mbcnt_hi(~0u, __builtin_amdgcn_mbcnt_lo(~0u, 0u)); asm volatile("" : "+v"(lane_l));
    const int wid = wave_id, lane = lane_l, tid = wid * 64 + lane, wr = wid >> 2, wc = wid & 3, fr = lane & 15, fq = lane >> 4;
    const int K = g.K, nt = K / BK;
    unsigned voffA[2], voffB[2];
#pragma unroll
    for (int i = 0; i < 2; ++i) { int R, C; stage_rc(tid * 16 + i * 8192, R, C); const int Rb = Epi::PERM ? ((R & ~31) + perm32(R & 31)) : R;
        voffA[i] = (unsigned)(R * g.lda + C) * 2u; voffB[i] = (unsigned)(Rb * g.ldb + C) * 2u; }
    const size_t kstep = (size_t)(BK * 2);
    const size_t hstepA = (size_t)HALF * g.lda * 2;
    const long hstepB = g.hstepB;
    const unsigned ldsw = (unsigned)wid * 1024u;
    const int aoff = lds_byte(wr * 64 + fr, fq * 8), boff = lds_byte(wc * 32 + fr, fq * 8);
#define PG8_SA(b, h) (((b) * 2 + (h)) * HTB)
#define PG8_SB(b, h) ((4 + (b) * 2 + (h)) * HTB)
#define PG8_STAGE(bufoff, gbase, voff) do { _Pragma("unroll") for (int _i = 0; _i < 2; ++_i) \
        __builtin_amdgcn_global_load_lds((const unsigned*)((const char*)(gbase) + (voff)[_i]), (LAS unsigned*)(lds + (bufoff) + ldsw + _i * 8192), 16, 0, 0); } while (0)
#define PG8_LDA(dst, b, h) do { _Pragma("unroll") for (int m = 0; m < 4; ++m) _Pragma("unroll") for (int k = 0; k < 2; ++k) dst[m][k] = *(const LAS bf16x8*)(lds + PG8_SA(b, h) + aoff + m * 2048 + k * 1024); } while (0)
#define PG8_LDB(dst, b, h) do { _Pragma("unroll") for (int n = 0; n < 2; ++n) _Pragma("unroll") for (int k = 0; k < 2; ++k) dst[n][k] = *(const LAS bf16x8*)(lds + PG8_SB(b, h) + boff + n * 2048 + k * 1024); } while (0)
#define PG8_MMA(ai, bj, At, Bt) do { __builtin_amdgcn_s_setprio(1); _Pragma("unroll") for (int m = 0; m < 4; ++m) _Pragma("unroll") for (int n = 0; n < 2; ++n) _Pragma("unroll") for (int k = 0; k < 2; ++k) \
        acc[ai][bj][m][n] = __builtin_amdgcn_mfma_f32_16x16x32_bf16(Bt[n][k], At[m][k], acc[ai][bj][m][n], 0, 0, 0); __builtin_amdgcn_s_setprio(0); } while (0)
#define PG8_WAIT_V(n) asm volatile("s_waitcnt vmcnt(" #n ")" ::: "memory")
#define PG8_WAIT_L(n) asm volatile("s_waitcnt lgkmcnt(" #n ")" ::: "memory")
#define PG8_BAR __builtin_amdgcn_s_barrier()
#define PG8_SCHED __builtin_amdgcn_sched_barrier(0)
    Unit cur, nxt; int ui = 0;
    if (!S.next(0, cur)) return;
#define PG8_RV(u_, b_) do { if (Epi::ROWVEC && wid < 4) __builtin_amdgcn_global_load_lds((const unsigned*)(g.rowvec + 4 * ((size_t)(u_).pm * BM + wid * 64 + lane)), (LAS unsigned*)(lds + RV_OFF + (b_) * 4096 + wid * 1024), 16, 0, 0); } while (0)
    PG8_RV(cur, 0);
    f32x4 acc[2][2][4][2];
#pragma unroll
    for (int a = 0; a < 2; ++a)
#pragma unroll
        for (int b = 0; b < 2; ++b)
#pragma unroll
            for (int m = 0; m < 4; ++m)
#pragma unroll
                for (int n = 0; n < 2; ++n) acc[a][b][m][n] = (f32x4){0.f, 0.f, 0.f, 0.f};
    bf16x8 At[4][2], B0[2][2], B1[2][2];
    const char* cA = g.A + (size_t)cur.pm * g.tstepA; const char* cB = g.B + (size_t)cur.pn * g.tstepB;
    PG8_STAGE(PG8_SB(0, 0), cB, voffB); PG8_STAGE(PG8_SB(0, 1), cB + hstepB, voffB); PG8_STAGE(PG8_SA(0, 0), cA, voffA); PG8_STAGE(PG8_SA(0, 1), cA + hstepA, voffA);
    if (wr == 1) PG8_BAR;
    PG8_WAIT_V(2); PG8_BAR;
    PG8_STAGE(PG8_SB(1, 0), cB + kstep, voffB); PG8_STAGE(PG8_SA(1, 0), cA + kstep, voffA); PG8_STAGE(PG8_SB(1, 1), cB + hstepB + kstep, voffB);
    PG8_WAIT_V(6); PG8_BAR;
    for (;;) {
        const bool has_next = S.next(ui + 1, nxt);
        const char* nA = has_next ? g.A + (size_t)nxt.pm * g.tstepA : cA; const char* nB = has_next ? g.B + (size_t)nxt.pn * g.tstepB : cB;
        for (int t = 0; t < nt; t += 2) {
            const bool last = (t == nt - 2);
            const char* a1 = cA + (size_t)(t + 1) * kstep;
            const char* a2 = last ? nA : cA + (size_t)(t + 2) * kstep; const char* b2 = last ? nB : cB + (size_t)(t + 2) * kstep;
            const char* a3 = a2 + kstep; const char* b3 = b2 + kstep;
            PG8_LDB(B0, 0, 0); PG8_LDB(B1, 0, 1); PG8_SCHED; PG8_LDA(At, 0, 0); PG8_STAGE(PG8_SA(1, 1), a1 + hstepA, voffA);
            PG8_WAIT_V(8); PG8_WAIT_L(0); PG8_BAR; PG8_MMA(0, 0, At, B0); PG8_MMA(0, 1, At, B1); PG8_BAR; PG8_SCHED;
            PG8_LDA(At, 0, 1); PG8_STAGE(PG8_SB(0, 0), b2, voffB); PG8_STAGE(PG8_SB(0, 1), b2 + hstepB, voffB); PG8_STAGE(PG8_SA(0, 0), a2, voffA);
            PG8_WAIT_V(8); PG8_WAIT_L(0); PG8_BAR; PG8_MMA(1, 0, At, B0); PG8_MMA(1, 1, At, B1); PG8_BAR; PG8_SCHED;
            PG8_LDB(B0, 1, 0); PG8_LDB(B1, 1, 1); PG8_SCHED; PG8_LDA(At, 1, 0); PG8_STAGE(PG8_SA(0, 1), a2 + hstepA, voffA);
            PG8_WAIT_V(8); PG8_WAIT_L(0); PG8_BAR; PG8_MMA(0, 0, At, B0); PG8_MMA(0, 1, At, B1); PG8_BAR; PG8_SCHED;
            PG8_LDA(At, 1, 1); PG8_STAGE(PG8_SB(1, 0), b3, voffB); PG8_STAGE(PG8_SB(1, 1), b3 + hstepB, voffB); PG8_STAGE(PG8_SA(1, 0), a3, voffA);
            PG8_WAIT_V(8); PG8_WAIT_L(0); PG8_BAR; PG8_MMA(1, 0, At, B0); PG8_MMA(1, 1, At, B1); PG8_BAR; PG8_SCHED;
        }
        if (wr == 0) PG8_BAR;
        E(acc, cur, wr, wc, fr, fq, (const LAS float*)(lds + RV_OFF + (ui & 1) * 4096));
        if (!has_next) break;
#pragma unroll
        for (int a = 0; a < 2; ++a)
#pragma unroll
            for (int b = 0; b < 2; ++b)
#pragma unroll
                for (int m = 0; m < 4; ++m)
#pragma unroll
                    for (int n = 0; n < 2; ++n) acc[a][b][m][n] = (f32x4){0.f, 0.f, 0.f, 0.f};
        cur = nxt; cA = nA; cB = nB; ++ui;
        PG8_RV(cur, ui & 1);
        if (wr == 1) PG8_BAR;
    }
    PG8_WAIT_V(0);
    PG8_BAR;
#undef PG8_SA
#undef PG8_SB
#undef PG8_STAGE
#undef PG8_LDA
#undef PG8_LDB
#undef PG8_MMA
#undef PG8_WAIT_V
#undef PG8_WAIT_L
#undef PG8_BAR
#undef PG8_SCHED
#undef PG8_RV
}
template <class Epi, class Prob>
__device__ __forceinline__ void gemm_phase_x(LAS unsigned char* lds, const Prob& P, const Epi& E, int wave_id) {
    int lane_l = (int)__builtin_amdgcn_mbcnt_hi(~0u, __builtin_amdgcn_mbcnt_lo(~0u, 0u)); asm volatile("" : "+v"(lane_l));
    const int wid = wave_id, lane = lane_l, tid = wid * 64 + lane, wr = wid >> 2, wc = wid & 3, fr = lane & 15, fq = lane >> 4;
    const int K = P.K, nt = K / BK;
    unsigned voffB[2];
#pragma unroll
    for (int i = 0; i < 2; ++i) { int R, C; stage_rc(tid * 16 + i * 8192, R, C); const int Rb = Epi::PERM ? ((R & ~31) + perm32(R & 31)) : R; voffB[i] = (unsigned)(Rb * P.ldb + C) * 2u; }
    const size_t kstep = (size_t)(BK * 2);
    const long hstepB = P.hstepB;
    const unsigned ldsw = (unsigned)wid * 1024u;
    const int aoff = lds_byte(wr * 64 + fr, fq * 8), boff = lds_byte(wc * 32 + fr, fq * 8);
    LAS u32x4* stash = (LAS u32x4*)(lds + STAGE_BYTES + 1024) + tid;
#define PG8_SA(b, h) (((b) * 2 + (h)) * HTB)
#define PG8_SB(b, h) ((4 + (b) * 2 + (h)) * HTB)
#define PG8_STAGE(bufoff, gbase, voff) do { _Pragma("unroll") for (int _i = 0; _i < 2; ++_i) \
        __builtin_amdgcn_global_load_lds((const unsigned*)((const char*)(gbase) + (voff)[_i]), (LAS unsigned*)(lds + (bufoff) + ldsw + _i * 8192), 16, 0, 0); } while (0)
#define PG8_LDA(dst, b, h) do { _Pragma("unroll") for (int m = 0; m < 4; ++m) _Pragma("unroll") for (int k = 0; k < 2; ++k) dst[m][k] = *(const LAS bf16x8*)(lds + PG8_SA(b, h) + aoff + m * 2048 + k * 1024); } while (0)
#define PG8_LDB(dst, b, h) do { _Pragma("unroll") for (int n = 0; n < 2; ++n) _Pragma("unroll") for (int k = 0; k < 2; ++k) dst[n][k] = *(const LAS bf16x8*)(lds + PG8_SB(b, h) + boff + n * 2048 + k * 1024); } while (0)
#define PG8_MMA(ai, bj, At, Bt) do { __builtin_amdgcn_s_setprio(1); _Pragma("unroll") for (int m = 0; m < 4; ++m) _Pragma("unroll") for (int n = 0; n < 2; ++n) _Pragma("unroll") for (int k = 0; k < 2; ++k) \
        acc[ai][bj][m][n] = __builtin_amdgcn_mfma_f32_16x16x32_bf16(Bt[n][k], At[m][k], acc[ai][bj][m][n], 0, 0, 0); __builtin_amdgcn_s_setprio(0); } while (0)
#define PG8_WAIT_V(n) asm volatile("s_waitcnt vmcnt(" #n ")" ::: "memory")
#define PG8_WAIT_L(n) asm volatile("s_waitcnt lgkmcnt(" #n ")" ::: "memory")
#define PG8_BAR __builtin_amdgcn_s_barrier()
#define PG8_SCHED __builtin_amdgcn_sched_barrier(0)
#define PG8_AVOFF(dst, u) do { int t2_ = tid; asm volatile("" : "+v"(t2_)); _Pragma("unroll") for (int i_ = 0; i_ < 2; ++i_) { int R_, C_; stage_rc(t2_ * 16 + i_ * 8192, R_, C_); _Pragma("unroll") for (int h_ = 0; h_ < 2; ++h_) \
        dst[h_][i_] = (Prob::GATHER ? P.arow_off(u, h_, R_) : (unsigned)((h_ * HALF + R_) * P.lda) * 2u) + (unsigned)C_ * 2u; } } while (0)
    Unit cur, nxt; int ui = 0;
    if (!P.next(0, cur)) return;
    unsigned vA[2][2];
    PG8_AVOFF(vA, cur);
    f32x4 acc[2][2][4][2];
#pragma unroll
    for (int a = 0; a < 2; ++a)
#pragma unroll
        for (int b = 0; b < 2; ++b)
#pragma unroll
            for (int m = 0; m < 4; ++m)
#pragma unroll
                for (int n = 0; n < 2; ++n) acc[a][b][m][n] = (f32x4){0.f, 0.f, 0.f, 0.f};
    bf16x8 At[4][2], B0[2][2], B1[2][2];
    const char* cA = P.a_base(cur); const char* cB = P.b_base(cur);
    long csplit = Prob::KSPLIT ? P.bsplit(cur) : 0;
    if (Prob::WAITS) P.a_ready(cur, wid);
    PG8_STAGE(PG8_SB(0, 0), cB, voffB); PG8_STAGE(PG8_SB(0, 1), cB + hstepB, voffB); PG8_STAGE(PG8_SA(0, 0), cA, vA[0]); PG8_STAGE(PG8_SA(0, 1), cA, vA[1]);
    if (wr == 1) PG8_BAR;
    PG8_WAIT_V(2); PG8_BAR;
    PG8_STAGE(PG8_SB(1, 0), cB + kstep, voffB); PG8_STAGE(PG8_SA(1, 0), cA + kstep, vA[0]); PG8_STAGE(PG8_SB(1, 1), cB + hstepB + kstep, voffB);
    PG8_WAIT_V(6); PG8_BAR;
    for (;;) {
        const bool has_next = P.next(ui + 1, nxt);
        const char* nA = has_next ? P.a_base(nxt) : cA; const char* nB = has_next ? P.b_base(nxt) : cB;
        if (Prob::GATHER) { unsigned vN[2][2];
            if (has_next) { PG8_AVOFF(vN, nxt); } else { vN[0][0] = vA[0][0]; vN[0][1] = vA[0][1]; vN[1][0] = vA[1][0]; vN[1][1] = vA[1][1]; }
            *stash = (u32x4){vN[0][0], vN[0][1], vN[1][0], vN[1][1]}; }
        for (int t = 0; t < nt; t += 2) {
            const bool last = (t == nt - 2);
            if (Prob::WAITS && last && has_next) P.a_ready(nxt, wid);
            const char* a1 = cA + (size_t)(t + 1) * kstep;
            const char* a2 = last ? nA : cA + (size_t)(t + 2) * kstep;
            const char* b2 = last ? nB : cB + (size_t)(t + 2) * kstep + ((Prob::KSPLIT && (t + 2) >= (nt >> 1)) ? csplit : 0);
            const char* a3 = a2 + kstep; const char* b3 = b2 + kstep;
            PG8_LDB(B0, 0, 0); PG8_LDB(B1, 0, 1); PG8_SCHED; PG8_LDA(At, 0, 0); PG8_STAGE(PG8_SA(1, 1), a1, vA[1]);
            if (Prob::GATHER && last) { const u32x4 sv = *stash; vA[0][0] = sv.x; vA[0][1] = sv.y; vA[1][0] = sv.z; vA[1][1] = sv.w; }
            PG8_WAIT_V(8); PG8_WAIT_L(0); PG8_BAR; PG8_MMA(0, 0, At, B0); PG8_MMA(0, 1, At, B1); PG8_BAR; PG8_SCHED;
            PG8_LDA(At, 0, 1); PG8_STAGE(PG8_SB(0, 0), b2, voffB); PG8_STAGE(PG8_SB(0, 1), b2 + hstepB, voffB); PG8_STAGE(PG8_SA(0, 0), a2, vA[0]);
            PG8_WAIT_V(8); PG8_WAIT_L(0); PG8_BAR; PG8_MMA(1, 0, At, B0); PG8_MMA(1, 1, At, B1); PG8_BAR; PG8_SCHED;
            PG8_LDB(B0, 1, 0); PG8_LDB(B1, 1, 1); PG8_SCHED; PG8_LDA(At, 1, 0); PG8_STAGE(PG8_SA(0, 1), a2, vA[1]);
            PG8_WAIT_V(8); PG8_WAIT_L(0); PG8_BAR; PG8_MMA(0, 0, At, B0); PG8_MMA(0, 1, At, B1); PG8_BAR; PG8_SCHED;
            PG8_LDA(At, 1, 1); PG8_STAGE(PG8_SB(1, 0), b3, voffB); PG8_STAGE(PG8_SB(1, 1), b3 + hstepB, voffB); PG8_STAGE(PG8_SA(1, 0), a3, vA[0]);
            PG8_WAIT_V(8); PG8_WAIT_L(0); PG8_BAR; PG8_MMA(1, 0, At, B0); PG8_MMA(1, 1, At, B1); PG8_BAR; PG8_SCHED;
        }
        if (wr == 0) PG8_BAR;
        E(acc, cur, wr, wc, fr, fq);
        if (!has_next) break;
#pragma unroll
        for (int a = 0; a < 2; ++a)
#pragma unroll
            for (int b = 0; b < 2; ++b)
#pragma unroll
                for (int m = 0; m < 4; ++m)
#pragma unroll
                    for (int n = 0; n < 2; ++n) acc[a][b][m][n] = (f32x4){0.f, 0.f, 0.f, 0.f};
        cur = nxt; cA = nA; cB = nB; ++ui;
        if (Prob::KSPLIT) csplit = P.bsplit(cur);
        if (wr == 1) PG8_BAR;
    }
    PG8_WAIT_V(0);
    PG8_BAR;
#undef PG8_SA
#undef PG8_SB
#undef PG8_STAGE
#undef PG8_LDA
#undef PG8_LDB
#undef PG8_MMA
#undef PG8_WAIT_V
#undef PG8_WAIT_L
#undef PG8_BAR
#undef PG8_SCHED
#undef PG8_AVOFF
}

__device__ __forceinline__ int pair_a(int pi) { return pi < 3 ? 0 : (pi < 5 ? 1 : 2); }
__device__ __forceinline__ int pair_b(int pi) { return pi == 0 ? 1 : ((pi == 1 || pi == 3) ? 2 : 3); }
template <int MODE>
struct MoeProb {
    static constexpr bool GATHER = (MODE == 0), KSPLIT = (MODE == 1);
    const unsigned* cnt; const unsigned* list; const char* A; const char* B; int lda, ldb, K; long hstepB; int G, c; unsigned* tcnt;
    static constexpr bool WAITS = (MODE == 1);
    __device__ __forceinline__ void a_ready(const Unit& u, int wave) const {
        if (MODE == 1) {
            if (wave == 0) { unsigned polls = 0;
                while ((unsigned)__builtin_amdgcn_readfirstlane(__hip_atomic_load(tcnt + 64 * u.pm, __ATOMIC_RELAXED, __HIP_MEMORY_SCOPE_AGENT)) < 32u) {
                    if (++polls > (1u << 20)) break;
                    __builtin_amdgcn_s_sleep(2); }
                __builtin_amdgcn_fence(__ATOMIC_ACQUIRE, "agent");
                asm volatile("s_waitcnt vmcnt(0)" ::: "memory"); }
            asm volatile("" ::: "memory"); __builtin_amdgcn_s_barrier(); asm volatile("" ::: "memory");
        }
    }
    __device__ __forceinline__ bool next(int i, Unit& u) const {
        long L = (long)i * G + c;
        if (MODE == 1) {
            int tot = 0;
            for (int k = 0; k < 24; ++k) tot += ((int)cnt[k] + 255) >> 8;
            const int N = 4 * tot, R = N - 2 * G;
            if (R > 0 && R < G) { if (c < R) { if (i > 0) return false; L = c; } else L = (i == 0) ? c : (long)G + (c - R) + (long)(i - 1) * (G - R); }
            else L = (long)i * G + (G - 1 - c);
        }
        const int tileidx = (int)(L >> 2);
        int accu = 0, bk = -1, tib = 0, nb = 0;
        for (int k = 0; k < 24; ++k) { const int n = (int)cnt[k]; const int tl = (n + 255) >> 8; if (bk < 0 && tileidx < accu + tl) { bk = k; tib = tileidx - accu; nb = n; } accu += tl; }
        if (bk < 0) return false;
        u.pm = tileidx; u.pn = (int)(L & 3); u.meta = bk | (tib << 5) | (nb << 13); return true;
    }
    __device__ __forceinline__ int expert(const Unit& u, int s) const { const int g = u.bk() / 6, pi = u.bk() % 6; return g * 4 + (s ? pair_b(pi) : pair_a(pi)); }
    __device__ __forceinline__ const char* a_base(const Unit& u) const { return MODE == 0 ? A : A + (size_t)u.pm * 256 * lda * 2; }
    __device__ __forceinline__ const char* b_base(const Unit& u) const {
        if (MODE == 0) return B + ((size_t)expert(u, u.pn >> 1) * DEXP + (size_t)(u.pn & 1) * HALF) * ldb * 2;
        return B + (size_t)u.pn * 256 * ldb * 2 + (size_t)expert(u, 0) * DEXP * 2;
    }
    __device__ __forceinline__ unsigned arow_off(const Unit& u, int h, int R) const { const int pos = u.tib() * 256 + h * HALF + R; const unsigned tok = pos < u.nb() ? list[(size_t)u.bk() * T + pos] : 0u; return tok * (unsigned)(lda * 2); }
    __device__ __forceinline__ long bsplit(const Unit& u) const { return ((long)(expert(u, 1) - expert(u, 0)) * DEXP - DEXP) * 2; }
};
struct EpiGateUpSparse {
    static constexpr bool PERM = true;
    bf16_t* act; const float* wlist; const float* rlist; unsigned* tcnt;
    __device__ __forceinline__ void operator()(const f32x4 (&acc)[2][2][4][2], const Unit& u, int wr, int wc, int fr, int fq) const {
        asm volatile("" : "+v"(fr), "+v"(fq));
        const int s = u.pn >> 1, col0 = s * DEXP + (u.pn & 1) * HALF + wc * 32 + 8 * fq;
        const __amdgpu_buffer_rsrc_t rs_act = __builtin_amdgcn_make_buffer_rsrc((void*)act, (short)0, 0x7fffffff, 0x00020000);
#pragma unroll
        for (int ai = 0; ai < 2; ++ai)
#pragma unroll
            for (int m = 0; m < 4; ++m) { const int r = ai * HALF + wr * 64 + m * 16 + fr, pos = u.tib() * 256 + r;
                const float cw = pos < u.nb() ? wlist[((size_t)u.bk() * T + pos) * 2 + s] : 0.f; const float rs = pos < u.nb() ? rlist[(size_t)u.bk() * T + pos] : 0.f;
                const float kneg = -rs * LOG2E, c2 = rs * rs * cw;
                u32x4 w;
#pragma unroll
                for (int n = 0; n < 2; ++n)
#pragma unroll
                    for (int jp = 0; jp < 4; jp += 2) { const f32x2 g2 = {acc[ai][0][m][n][jp], acc[ai][0][m][n][jp + 1]}, u2 = {acc[ai][1][m][n][jp], acc[ai][1][m][n][jp + 1]};
                        const f32x2 t2 = g2 * kneg; f32x2 d2 = {__builtin_amdgcn_exp2f(t2.x), __builtin_amdgcn_exp2f(t2.y)}; d2 = d2 + 1.f;
                        const f32x2 r2 = {__builtin_amdgcn_rcpf(d2.x), __builtin_amdgcn_rcpf(d2.y)}; const f32x2 o2 = (g2 * u2) * (r2 * c2);
                        const unsigned pw = cvt_pk_bf16(o2.x, o2.y);
                        if (n == 0 && jp == 0) w.x = pw; else if (n == 0) w.y = pw; else if (jp == 0) w.z = pw; else w.w = pw; }
                __builtin_amdgcn_raw_buffer_store_b128(w, rs_act, (int)((((unsigned)u.pm * 256u + (unsigned)r) * 512u + (unsigned)col0) * 2u), 0, 16);
                if (m & 1) asm volatile("" ::: "memory"); }
        asm volatile("s_waitcnt vmcnt(0)" ::: "memory");
        if ((fr | fq) == 0) __hip_atomic_fetch_add(tcnt + 64 * u.pm, 1u, __ATOMIC_RELAXED, __HIP_MEMORY_SCOPE_AGENT);
    }
};
struct EpiDownScatter {
    static constexpr bool PERM = true;
    bf16_t* xb; const unsigned* list; float* ssq; LAS unsigned char* ldsb;
    __device__ __forceinline__ void operator()(const f32x4 (&acc)[2][2][4][2], const Unit& u, int wr, int wc, int fr, int fq) const {
        asm volatile("" : "+v"(fr), "+v"(fq));
        const int col0 = u.pn * BM + wc * 32 + 8 * fq;
        unsigned tok[8];
#pragma unroll
        for (int g = 0; g < 8; ++g) { const int pos = u.tib() * 256 + (g >> 2) * HALF + wr * 64 + (g & 3) * 16 + fr; tok[g] = pos < u.nb() ? list[(size_t)u.bk() * T + pos] : 0xffffffffu; }
#pragma unroll
        for (int ai = 0; ai < 2; ++ai) { u32x4 r[4][2];
#pragma unroll
            for (int m = 0; m < 4; ++m) { const unsigned tk = tok[ai * 4 + m]; const bf16_t* rowp = xb + (size_t)(tk != 0xffffffffu ? tk : 0u) * DM + col0;
#pragma unroll
                for (int bj = 0; bj < 2; ++bj) r[m][bj] = *(const u32x4*)(rowp + bj * HALF); }
#pragma unroll
            for (int m = 0; m < 4; ++m) { const unsigned tk = tok[ai * 4 + m]; float sq = 0.f;
                if (tk != 0xffffffffu) { bf16_t* rowp = xb + (size_t)tk * DM + col0;
#pragma unroll
                    for (int bj = 0; bj < 2; ++bj) { const f32x4 v0 = acc[ai][bj][m][0], v1 = acc[ai][bj][m][1]; const u32x4 q = r[m][bj];
                        u32x4 w; w.x = cvt_pk_bf16(bflo(q.x) + v0[0], bfhi(q.x) + v0[1]); w.y = cvt_pk_bf16(bflo(q.y) + v0[2], bfhi(q.y) + v0[3]);
                        w.z = cvt_pk_bf16(bflo(q.z) + v1[0], bfhi(q.z) + v1[1]); w.w = cvt_pk_bf16(bflo(q.w) + v1[2], bfhi(q.w) + v1[3]);
                        *(u32x4*)(rowp + bj * HALF) = w;
                        const float a0 = bflo(w.x), a1 = bfhi(w.x), a2 = bflo(w.y), a3 = bfhi(w.y), a4 = bflo(w.z), a5 = bfhi(w.z), a6 = bflo(w.w), a7 = bfhi(w.w);
                        sq += ((a0 * a0 + a1 * a1) + (a2 * a2 + a3 * a3)) + ((a4 * a4 + a5 * a5) + (a6 * a6 + a7 * a7)); } }
                sq += swz_xor<16>(sq); sq = sum_xor32(sq);
                if (fq == 0) { const int ri = ai * HALF + wr * 64 + m * 16 + fr; ((LAS float*)(ldsb + RED_OFF))[wc * 256 + ri] = sq; if (wc == 0) ((LAS unsigned*)(ldsb + RED_OFF + 4096))[ri] = tk; } } }
        asm volatile("s_waitcnt lgkmcnt(0)" ::: "memory"); __builtin_amdgcn_s_barrier(); asm volatile("" ::: "memory");
        { const int ri = (wr * 4 + wc) * 64 + fq * 16 + fr;
          if (ri < 256) { const LAS float* rp = (const LAS float*)(ldsb + RED_OFF) + ri; const unsigned tk = ((const LAS unsigned*)(ldsb + RED_OFF + 4096))[ri];
              if (tk != 0xffffffffu) ssq[(size_t)tk * 4 + u.pn] = (rp[0] + rp[256]) + (rp[512] + rp[768]); } }
    }
};
}

#define XB_TMO      128
#define XB_XCNT(j)  (256  + 64 * (j))
#define XB_XSUB(j)  (1280 + 64 * (j))
#define XB_XGEN(j)  (2304 + 64 * (j))
#define XB_TOP      3328
#define XB_TOPGEN   3392
#define XCD_BAR_WORDS 3456
#define XB_SPIN_CAP (1u << 18)
__device__ __forceinline__ unsigned xb_ld(unsigned* p)              { return __hip_atomic_load(p, __ATOMIC_RELAXED, __HIP_MEMORY_SCOPE_AGENT); }
__device__ __forceinline__ unsigned xb_add(unsigned* p, unsigned v) { return __hip_atomic_fetch_add(p, v, __ATOMIC_RELAXED, __HIP_MEMORY_SCOPE_AGENT); }
__device__ __forceinline__ unsigned xb_xcc_id() { return (unsigned)__builtin_amdgcn_s_getreg((3 << 11) | 20) & 0xFu; }
#define XB_SPIN(cond, bar) do { unsigned _sp = 0; while (cond) { __builtin_amdgcn_s_sleep(1); \
    if ((++_sp & 255u) == 0u) { if (xb_ld(&(bar)[XB_TMO])) break; if (_sp > XB_SPIN_CAP) { atomicAdd(&(bar)[XB_TMO], 1u); break; } } } } while (0)
struct XcdBarrier { unsigned* bar; unsigned x; volatile LAS unsigned* st; int wave; };
__device__ __forceinline__ bool xb_thread0(int wave) { return wave == 0 && __builtin_amdgcn_mbcnt_hi(~0u, __builtin_amdgcn_mbcnt_lo(~0u, 0u)) == 0u; }
__device__ __forceinline__ XcdBarrier xcd_barrier_post(unsigned* bar, volatile LAS unsigned* st, int wave) {
    XcdBarrier b; b.bar = bar; b.x = xb_xcc_id(); b.st = st; b.wave = wave;
    if (xb_thread0(wave)) (void)xb_add(&bar[XB_XCNT(b.x)], 1u);
    return b;
}
__device__ __forceinline__ void xcd_barrier_complete(unsigned* bar, unsigned x, unsigned& nloc, unsigned& nx) {
    const unsigned G = gridDim.x * gridDim.y * gridDim.z;
    unsigned sum, cnt, mine, sp = 0u;
    for (;;) {
        sum = 0u; cnt = 0u; mine = 0u;
#pragma unroll
        for (unsigned j = 0; j < 16; ++j) { const unsigned c = xb_ld(&bar[XB_XCNT(j)]); sum += c; cnt += (c > 0u) ? 1u : 0u; mine = (j == x) ? c : mine; }
        if (sum == G) break;
        __builtin_amdgcn_s_sleep(1);
        if ((++sp & 255u) == 0u) { if (xb_ld(&bar[XB_TMO])) break; if (sp > XB_SPIN_CAP) { atomicAdd(&bar[XB_TMO], 1u); break; } }
    }
    nloc = mine > 0u ? mine : 1u; nx = cnt > 0u ? cnt : 1u;
}
template <class F>
__device__ __forceinline__ void xcd_barrier_w(const XcdBarrier& b, const F& work) {
    asm volatile("s_waitcnt vmcnt(0)" ::: "memory");
    __syncthreads();
    if (b.wave != 0) work();
    else if (xb_thread0(b.wave)) {
        unsigned* bar = b.bar;
        __builtin_amdgcn_s_waitcnt(0);
        unsigned nloc = b.st[0], nx = b.st[1];
        if (nloc == 0u) { xcd_barrier_complete(bar, b.x, nloc, nx); b.st[0] = nloc; b.st[1] = nx; }
        const unsigned old = xb_add(&bar[XB_XSUB(b.x)], 1u);
        const unsigned gen = old / nloc;
        if (old + 1u == (gen + 1u) * nloc) {
            __builtin_amdgcn_fence(__ATOMIC_RELEASE, "agent");
            asm volatile("s_waitcnt vmcnt(0)" ::: "memory");
            const unsigned og = xb_add(&bar[XB_TOP], 1u);
            const unsigned tg = og / nx;
            if (og + 1u == (tg + 1u) * nx) xb_add(&bar[XB_TOPGEN], 1u);
            else XB_SPIN(xb_ld(&bar[XB_TOPGEN]) == tg, bar);
            __builtin_amdgcn_fence(__ATOMIC_ACQUIRE, "agent");
            xb_add(&bar[XB_XGEN(b.x)], 1u);
            asm volatile("s_waitcnt vmcnt(0)" ::: "memory");
        } else {
            XB_SPIN(xb_ld(&bar[XB_XGEN(b.x)]) == gen, bar);
            __builtin_amdgcn_fence(__ATOMIC_ACQUIRE, "agent");
            asm volatile("s_waitcnt vmcnt(0)" ::: "memory");
        }
    }
    __syncthreads();
}
__device__ __forceinline__ void xcd_barrier(const XcdBarrier& b) { xcd_barrier_w(b, []() {}); }

struct Args {
    const float* x; const float* ln1_g; const float* w_in; const float* mix_g; const float* w_out; const float* ln2_g;
    const float* w_gr; const float* b_gr; const float* w_er; const float* b_er; const float* w_gate; const float* w_up; const float* w_down; const float* fin_g;
    float* out; unsigned char* ws; int ph_lo, ph_hi, li, pad;
};

__device__ __forceinline__ void transpose_item(const float* W, int K, int N, bf16_t* WT, int dpitch, int dcol, int item, int lane, const float* ks) {
    const int nblk = N / 64, kb = item / nblk, nb = item % nblk, k0 = 64 * kb, n0 = 64 * nb;
    const int i = lane & 15, q = lane >> 4, ar = 8 * (i >> 2) + (i & 3);
    f32x4 v[2][2][2][2];
#pragma unroll
    for (int kh = 0; kh < 2; ++kh)
#pragma unroll
        for (int t = 0; t < 2; ++t)
#pragma unroll
            for (int c = 0; c < 2; ++c)
#pragma unroll
                for (int e2 = 0; e2 < 2; ++e2) v[kh][t][c][e2] = *(const f32x4*)(W + (size_t)(k0 + 32 * kh + ar + 4 * t) * N + n0 + 32 * c + 16 * e2 + 4 * q);
    float gk[2][2] = {{1.f, 1.f}, {1.f, 1.f}};
    if (ks) {
#pragma unroll
        for (int kh = 0; kh < 2; ++kh)
#pragma unroll
            for (int t = 0; t < 2; ++t) gk[kh][t] = ks[k0 + 32 * kh + ar + 4 * t]; }
    u32x4 s0 = {0u, 0u, 0u, 0u}, s1 = s0;
    if ((i >> 2) == q) { const unsigned one = (i & 1) ? 0x3f800000u : 0x00003f80u;
        if (i & 2) { s0.y = one; s1.w = one; } else { s0.x = one; s1.z = one; } }
    const bf16x8 sel0 = __builtin_bit_cast(bf16x8, s0), sel1 = __builtin_bit_cast(bf16x8, s1);
    const f32x4 z4 = {0.f, 0.f, 0.f, 0.f};
#pragma unroll
    for (int c = 0; c < 2; ++c) {
        bf16x8 A[2][2];
#pragma unroll
        for (int kh = 0; kh < 2; ++kh)
#pragma unroll
            for (int t = 0; t < 2; ++t) { const f32x4 lo = v[kh][t][c][0] * gk[kh][t], hi = v[kh][t][c][1] * gk[kh][t];
                u32x4 p; p.x = pk2(lo.x, lo.y); p.y = pk2(lo.z, lo.w); p.z = pk2(hi.x, hi.y); p.w = pk2(hi.z, hi.w); A[kh][t] = __builtin_bit_cast(bf16x8, p); }
#pragma unroll
        for (int h = 0; h < 2; ++h) { bf16_t* orow = WT + (size_t)(n0 + 32 * c + 16 * h + i) * dpitch + dcol + k0 + 8 * q;
#pragma unroll
            for (int kh = 0; kh < 2; ++kh) { const f32x4 d0 = __builtin_amdgcn_mfma_f32_16x16x32_bf16(A[kh][0], h ? sel1 : sel0, z4, 0, 0, 0), d1 = __builtin_amdgcn_mfma_f32_16x16x32_bf16(A[kh][1], h ? sel1 : sel0, z4, 0, 0, 0);
                const float e0 = d0.x, e1 = d0.y, e2 = d0.z, e3 = d0.w, e4 = d1.x, e5 = d1.y, e6 = d1.z, e7 = d1.w;
#define TP_PK(lo_, hi_) ((__builtin_bit_cast(unsigned, lo_) >> 16) | (__builtin_bit_cast(unsigned, hi_) & 0xffff0000u))
                u32x4 o; o.x = TP_PK(e0, e1); o.y = TP_PK(e2, e3); o.z = TP_PK(e4, e5); o.w = TP_PK(e6, e7);
#undef TP_PK
                *(u32x4*)(orow + 32 * kh) = o; } } }
}
constexpr int PRO_I_IN = (DM / 64) * (NQKV / 64), PRO_I_OUT = (DM / 64) * (DM / 64), PRO_I_G = (DM / 64) * (DEXP / 64), PRO_I_D = (DEXP / 64) * (DM / 64);
constexpr int PRO_PER_LAYER = PRO_I_IN + PRO_I_OUT + 3 * NEXP * PRO_I_G, PRO_NITEMS = DEPTH * PRO_PER_LAYER;
static_assert(PRO_I_D == PRO_I_G, "item counts");
__device__ __forceinline__ void prologue_item(const Args& a, int id, int lane) {
    bf16_t* WinT = (bf16_t*)(a.ws + WS_WIN); bf16_t* WoutT = (bf16_t*)(a.ws + WS_WOUT); bf16_t* WgT = (bf16_t*)(a.ws + WS_WG); bf16_t* WuT = (bf16_t*)(a.ws + WS_WU); bf16_t* WdT = (bf16_t*)(a.ws + WS_WD);
    const int l = id / PRO_PER_LAYER; int r = id % PRO_PER_LAYER;
    if (r < PRO_I_IN) { transpose_item(a.w_in + (size_t)l * DM * NQKV, DM, NQKV, WinT + (size_t)l * NQKV * DM, DM, 0, r, lane, a.ln1_g + (size_t)l * DM); return; } r -= PRO_I_IN;
    if (r < PRO_I_OUT) { transpose_item(a.w_out + (size_t)l * DM * DM, DM, DM, WoutT + (size_t)l * DM * DM, DM, 0, r, lane, nullptr); return; } r -= PRO_I_OUT;
    const int kind = r / (NEXP * PRO_I_G), e = (r % (NEXP * PRO_I_G)) / PRO_I_G, it = r % PRO_I_G, le = l * NEXP + e;
    if (kind == 0) transpose_item(a.w_gate + (size_t)le * DM * DEXP, DM, DEXP, WgT + (size_t)le * DEXP * DM, DM, 0, it, lane, a.ln2_g + (size_t)l * DM);
    else if (kind == 1) transpose_item(a.w_up + (size_t)le * DM * DEXP, DM, DEXP, WuT + (size_t)le * DEXP * DM, DM, 0, it, lane, a.ln2_g + (size_t)l * DM);
    else transpose_item(a.w_down + (size_t)le * DEXP * DM, DEXP, DM, WdT + (size_t)l * DM * NACT, NACT, e * DEXP, it, lane, nullptr);
}
__device__ __forceinline__ void router_image(const float* g, const float* wgr, const float* wer, unsigned char* img, int idx0, int tid) {
    { const int idx = idx0 + tid; const int mtx = idx >> 10, d = idx & 1023; const f32x4 wv = *(const f32x4*)((mtx == 0 ? wgr : wer + (size_t)(mtx - 1) * DM * 4) + d * 4) * g[d];
#pragma unroll
        for (int e = 0; e < 4; ++e) { const float w = wv[e]; const unsigned hi = f2bf(w); const float rem = w - __builtin_bit_cast(float, hi << 16);
            *(unsigned short*)(img + (mtx * 4 + e) * RT_RP + d * 2) = (unsigned short)hi; *(unsigned short*)(img + 20 * RT_RP + (mtx * 4 + e) * RT_RP + d * 2) = (unsigned short)f2bf(rem); } }
}
__device__ __forceinline__ void phase_prologue(const Args& a, int gw, int NGW, int lane, int n_items) {
    for (int it = gw; it < n_items; it += NGW) prologue_item(a, it, lane);
}

__device__ __forceinline__ void phase_norm1(const float* x, int gw, int NGW, int lane, float* kmean_zero, bf16_t* xb, float* ssq_out) {
    for (int i = gw * 64 + lane; i < BATCH * 4 * 32 * HD; i += NGW * 64) kmean_zero[i] = 0.f;
    for (int m = gw; m < T; m += NGW) {
        const f32x4* xr = (const f32x4*)(x + (size_t)m * DM) + lane;
        f32x4 v[4]; float s = 0.f;
#pragma unroll
        for (int j = 0; j < 4; ++j) v[j] = xr[64 * j];
        u32x2* x8 = (u32x2*)(xb + (size_t)m * DM) + lane;
#pragma unroll
        for (int j = 0; j < 4; ++j) { u32x2 c; c.x = pk2(v[j].x, v[j].y); c.y = pk2(v[j].z, v[j].w); x8[64 * j] = c;
            const float a0 = bflo(c.x), a1 = bfhi(c.x), a2 = bflo(c.y), a3 = bfhi(c.y); s += (a0 * a0 + a1 * a1) + (a2 * a2 + a3 * a3); }
        s = wave_sum(s);
        if (lane == 0) *(f32x4*)(ssq_out + (size_t)m * 4) = (f32x4){s, 0.f, 0.f, 0.f};
    }
}
__device__ __forceinline__ void unpack8(float (&f)[8], const u32x4 w) { f[0] = bflo(w.x); f[1] = bfhi(w.x); f[2] = bflo(w.y); f[3] = bfhi(w.y); f[4] = bflo(w.z); f[5] = bfhi(w.z); f[6] = bflo(w.w); f[7] = bfhi(w.w); }
struct MixRow { u32x4 a, c0, c1, c2, p0, p1, p2; float l0, l1, l2, e0, e1, e2, e3; };
__device__ __forceinline__ void mix_load(MixRow& r, int m, const bf16_t* ob, const bf16_t* hb, const float* lse, const bf16_t* pm, const float* lsem0, const float* lsem1, int lane, int hh) {
    r.a = *((const u32x4*)(ob + (size_t)m * DM) + lane); r.c0 = *((const u32x4*)(ob + (size_t)m * DM + 512) + lane);
    r.c1 = *((const u32x4*)(hb + (size_t)m * DM) + lane); r.c2 = *((const u32x4*)(hb + (size_t)m * DM + 512) + lane);
    r.l0 = lse[(size_t)m * 8 + hh]; r.l1 = lse[(size_t)T * 8 + (size_t)m * 8 + hh]; r.l2 = lse[(size_t)2 * T * 8 + (size_t)m * 8 + hh];
    if (lane < 32) {
        r.p0 = *((const u32x4*)(pm + (size_t)m * 256) + lane); r.p1 = *((const u32x4*)(pm + ((size_t)T + m) * 256) + lane); r.p2 = *((const u32x4*)(pm + ((size_t)2 * T + m) * 256) + lane);
        r.e0 = lsem0[(size_t)m * 4 + hh]; r.e1 = lsem0[(size_t)T * 4 + (size_t)m * 4 + hh]; r.e2 = lsem1[(size_t)m * 4 + hh]; r.e3 = lsem1[(size_t)T * 4 + (size_t)m * 4 + hh]; }
}
__device__ __forceinline__ void phase_mixnorm(const bf16_t* ob, bf16_t* hb, const float* lse, const bf16_t* pm, const float* lsem0, const float* lsem1, const float* g, int gw, int NGW, int lane) {
    float g0[8], g1[8];
#pragma unroll
    for (int j = 0; j < 8; ++j) { g0[j] = g[8 * lane + j]; g1[j] = g[512 + 8 * lane + j]; }
    const int hh = lane >> 3;
    MixRow cur, nxt;
    if (gw < T) mix_load(cur, gw, ob, hb, lse, pm, lsem0, lsem1, lane, hh);
    for (int m = gw; m < T; m += NGW) {
        if (m + NGW < T) mix_load(nxt, m + NGW, ob, hb, lse, pm, lsem0, lsem1, lane, hh);
        float va[8]; unpack8(va, cur.a);
        if (lane < 32) {
            const float mx = fmaxf(fmaxf(cur.e0, cur.e1), fmaxf(cur.e2, cur.e3));
            float u0 = __builtin_amdgcn_exp2f(cur.e0 - mx), u1 = __builtin_amdgcn_exp2f(cur.e1 - mx), u2 = __builtin_amdgcn_exp2f(cur.e2 - mx), u3 = __builtin_amdgcn_exp2f(cur.e3 - mx);
            const float inv = __builtin_amdgcn_rcpf((u0 + u1) + (u2 + u3)); u0 *= inv; u1 *= inv; u2 *= inv; u3 *= inv;
            float y0[8], y1[8], y2[8]; unpack8(y0, cur.p0); unpack8(y1, cur.p1); unpack8(y2, cur.p2);
#pragma unroll
            for (int j = 0; j < 8; ++j) va[j] = (u0 * y0[j] + u1 * y1[j]) + (u2 * y2[j] + u3 * va[j]);
        }
        const float mx = fmaxf(cur.l0, fmaxf(cur.l1, cur.l2));
        float w0 = __builtin_amdgcn_exp2f(cur.l0 - mx), w1 = __builtin_amdgcn_exp2f(cur.l1 - mx), w2 = __builtin_amdgcn_exp2f(cur.l2 - mx);
        const float inv = __builtin_amdgcn_rcpf(w0 + w1 + w2); w0 *= inv; w1 *= inv; w2 *= inv;
        float x0[8], x1[8], x2[8]; unpack8(x0, cur.c0); unpack8(x1, cur.c1); unpack8(x2, cur.c2);
        float vc[8];
        float sa = 0.f, sc = 0.f;
#pragma unroll
        for (int j = 0; j < 8; ++j) { vc[j] = w0 * x0[j] + w1 * x1[j] + w2 * x2[j]; sa += va[j] * va[j]; sc += vc[j] * vc[j]; }
        sa = half_sum(sa); sc = wave_sum(sc);
        const float ra = __builtin_amdgcn_rsqf(sa * (1.f / 256.f) + NORM_EPS), rc = __builtin_amdgcn_rsqf(sc * (1.f / 512.f) + NORM_EPS);
        u32x4 oa, oc;
        oa.x = pk2(va[0] * ra * g0[0], va[1] * ra * g0[1]); oa.y = pk2(va[2] * ra * g0[2], va[3] * ra * g0[3]); oa.z = pk2(va[4] * ra * g0[4], va[5] * ra * g0[5]); oa.w = pk2(va[6] * ra * g0[6], va[7] * ra * g0[7]);
        oc.x = pk2(vc[0] * rc * g1[0], vc[1] * rc * g1[1]); oc.y = pk2(vc[2] * rc * g1[2], vc[3] * rc * g1[3]); oc.z = pk2(vc[4] * rc * g1[4], vc[5] * rc * g1[5]); oc.w = pk2(vc[6] * rc * g1[6], vc[7] * rc * g1[7]);
        *((u32x4*)(hb + (size_t)m * DM) + lane) = oa; *((u32x4*)(hb + (size_t)m * DM + 512) + lane) = oc;
        cur = nxt;
    }
}
__device__ __forceinline__ void phase_route(const bf16_t* x, const float* g, const float* wgr, const float* bgr, const float* wer, const float* ber,
                                            float* rlist, unsigned* cnt, unsigned* list, float* wlist, LAS unsigned char* lds, int v, int G, int wave, int lane, float* kmean_zero, const unsigned char* rimg) {
    for (int i = (v * NWAVES + wave) * 64 + lane; i < BATCH * 4 * 32 * HD; i += G * NWAVES * 64) kmean_zero[i] = 0.f;
    const int tid = wave * 64 + lane;
    constexpr int RP = RT_RP;
    LAS unsigned char* WH = lds; LAS unsigned char* WL = lds + 20 * RP;
    LAS unsigned* cl = (LAS unsigned*)(lds + 86016);
    LAS u32x2* info = (LAS u32x2*)(lds + 86016 + 256);
    LAS f32x2* infw = (LAS f32x2*)(lds + 86016 + 256 + 4096);
    LAS float* infr = (LAS float*)(lds + 86016 + 256 + 8192);
    for (int p = tid; p < RT_IMG / 16; p += NTHREADS) __builtin_amdgcn_global_load_lds((const unsigned*)(rimg + (size_t)(p - lane) * 16 + (size_t)lane * 16), (LAS unsigned*)(lds + (p - lane) * 16), 16, 0, 0);
    asm volatile("s_waitcnt vmcnt(0)" ::: "memory");
    if (tid < 64) cl[tid] = 0u;
    __syncthreads();
    const int rpw = (T + G - 1) / G, row0 = v * rpw;
    const int m16 = lane & 15, q = lane >> 4;
    const f32x4 bg = *(const f32x4*)bgr;
    for (int t0 = wave * 16; t0 < rpw; t0 += NWAVES * 16) {
        const int r = t0 + m16; const bool valid = r < rpw && row0 + r < T;
        const u32x4* xp = (const u32x4*)(x + (size_t)(valid ? row0 + r : row0) * DM) + q;
        f32x4 a0 = (f32x4){0.f, 0.f, 0.f, 0.f}, a1 = a0; float ss = 0.f;
        LAS unsigned char* wh0 = WH + m16 * RP + q * 16; LAS unsigned char* wh1 = WH + (16 + (lane & 3)) * RP + q * 16;
#pragma unroll 1
        for (int sb = 0; sb < 32; sb += 8) { u32x4 xv[8];
#pragma unroll
            for (int s = 0; s < 8; ++s) xv[s] = xp[4 * (sb + s)];
#pragma unroll
            for (int s = 0; s < 8; ++s) { const int ko = (sb + s) * 64; const bf16x8 xf = __builtin_bit_cast(bf16x8, xv[s]);
                a0 = __builtin_amdgcn_mfma_f32_16x16x32_bf16(*(LAS bf16x8*)(wh0 + ko), xf, a0, 0, 0, 0);
                a0 = __builtin_amdgcn_mfma_f32_16x16x32_bf16(*(LAS bf16x8*)(wh0 + 20 * RP + ko), xf, a0, 0, 0, 0);
                a1 = __builtin_amdgcn_mfma_f32_16x16x32_bf16(*(LAS bf16x8*)(wh1 + ko), xf, a1, 0, 0, 0);
                a1 = __builtin_amdgcn_mfma_f32_16x16x32_bf16(*(LAS bf16x8*)(wh1 + 20 * RP + ko), xf, a1, 0, 0, 0);
                const float x0 = bflo(xv[s].x), x1 = bfhi(xv[s].x), x2 = bflo(xv[s].y), x3 = bfhi(xv[s].y), x4 = bflo(xv[s].z), x5 = bfhi(xv[s].z), x6 = bflo(xv[s].w), x7 = bfhi(xv[s].w);
                ss += ((x0 * x0 + x1 * x1) + (x2 * x2 + x3 * x3)) + ((x4 * x4 + x5 * x5) + (x6 * x6 + x7 * x7)); } }
        ss += swz_xor<16>(ss); ss = sum_xor32(ss);
        const float rstd = 1.0f / sqrtf(ss * (1.f / DM) + NORM_EPS);
        const int gc = (q == 0) ? 3 : q - 1;
        const f32x4 be = *(const f32x4*)(ber + gc * 4);
        const f32x4 ev = (q == 0) ? a1 : a0;
        const float e[4] = {ev.x * rstd + be.x, ev.y * rstd + be.y, ev.z * rstd + be.z, ev.w * rstd + be.w};
        int i1 = 0; float v1 = e[0];
#pragma unroll
        for (int k = 1; k < 4; ++k) if (e[k] > v1) { v1 = e[k]; i1 = k; }
        int i2 = -1; float v2 = -INFINITY;
#pragma unroll
        for (int k = 0; k < 4; ++k) if (k != i1 && e[k] > v2) { v2 = e[k]; i2 = k; }
        const float p2 = __expf(v2 - v1), inv = 1.0f / (1.0f + p2);
        const float w1 = inv, w2 = p2 * inv;
        const int ea = i1 < i2 ? i1 : i2, eb = i1 < i2 ? i2 : i1; const float wa0 = i1 < i2 ? w1 : w2, wb0 = i1 < i2 ? w2 : w1;
        const int pi0 = (ea == 0) ? (eb - 1) : (ea == 1 ? eb + 1 : 5);
        const f32x4 gl = (f32x4){a0.x * rstd + bg.x, a0.y * rstd + bg.y, a0.z * rstd + bg.z, a0.w * rstd + bg.w};
        int gi = 0; float gm = gl.x;
        if (gl.y > gm) { gm = gl.y; gi = 1; } if (gl.z > gm) { gm = gl.z; gi = 2; } if (gl.w > gm) { gm = gl.w; gi = 3; }
        const float gden = __expf(gl.x - gm) + __expf(gl.y - gm) + __expf(gl.z - gm) + __expf(gl.w - gm);
        const float gw_ = 1.0f / gden;
        const int src = (m16 + 16 * ((gi == 3) ? 0 : gi + 1)) * 4;
        const int pi = __builtin_amdgcn_ds_bpermute(src, pi0);
        const float wa = __builtin_bit_cast(float, __builtin_amdgcn_ds_bpermute(src, __builtin_bit_cast(int, wa0))) * gw_, wb = __builtin_bit_cast(float, __builtin_amdgcn_ds_bpermute(src, __builtin_bit_cast(int, wb0))) * gw_;
        if (q == 0 && valid) { int bk = gi * 6 + pi; bk = bk < 0 ? 0 : (bk > 23 ? 23 : bk);
            const unsigned rank = __hip_atomic_fetch_add(cl + bk, 1u, __ATOMIC_RELAXED, __HIP_MEMORY_SCOPE_WORKGROUP);
            info[r] = (u32x2){(unsigned)bk, rank}; infw[r] = (f32x2){wa, wb}; infr[r] = rstd; }
    }
    __syncthreads();
    if (tid < 24) cl[32 + tid] = __hip_atomic_fetch_add(cnt + tid, cl[tid], __ATOMIC_RELAXED, __HIP_MEMORY_SCOPE_AGENT);
    __syncthreads();
    if (tid < rpw && row0 + tid < T) { const u32x2 inf = info[tid]; const f32x2 wv = infw[tid]; const size_t slot = (size_t)inf.x * T + cl[32 + inf.x] + inf.y;
        list[slot] = (unsigned)(row0 + tid); *(f32x2*)(wlist + slot * 2) = wv; rlist[slot] = infr[tid]; }
    __syncthreads();
}
__device__ __forceinline__ void phase_final(const bf16_t* xb, const float* g, float* out, int gw, int NGW, int lane) {
    f32x4 gv[4];
#pragma unroll
    for (int j = 0; j < 2; ++j) { gv[2 * j] = *((const f32x4*)g + 2 * lane + 128 * j); gv[2 * j + 1] = *((const f32x4*)g + 2 * lane + 128 * j + 1); }
    for (int m = gw; m < T; m += NGW) {
        const u32x4* xr = (const u32x4*)(xb + (size_t)m * DM) + lane;
        u32x4 r[2]; float s = 0.f;
#pragma unroll
        for (int j = 0; j < 2; ++j) r[j] = xr[64 * j];
        f32x4 v[4];
#pragma unroll
        for (int j = 0; j < 2; ++j) { v[2 * j] = (f32x4){bflo(r[j].x), bfhi(r[j].x), bflo(r[j].y), bfhi(r[j].y)}; v[2 * j + 1] = (f32x4){bflo(r[j].z), bfhi(r[j].z), bflo(r[j].w), bfhi(r[j].w)}; }
#pragma unroll
        for (int j = 0; j < 4; ++j) s += (v[j].x * v[j].x + v[j].y * v[j].y) + (v[j].z * v[j].z + v[j].w * v[j].w);
        const float rstd = 1.0f / sqrtf(wave_sum(s) * (1.f / DM) + NORM_EPS);
        f32x4* orow = (f32x4*)(out + (size_t)m * DM) + 2 * lane;
#pragma unroll
        for (int j = 0; j < 2; ++j) { orow[128 * j] = v[2 * j] * rstd * gv[2 * j]; orow[128 * j + 1] = v[2 * j + 1] * rstd * gv[2 * j + 1]; }
    }
}
__device__ __forceinline__ void phase_kmean(const bf16_t* kb, float* kmean, int gw, int NGW, int lane) {
    for (int it = gw; it < BATCH * 4 * 32; it += NGW) {
        const int b = it >> 7, h = (it >> 5) & 3, blk = it & 31;
        const bf16_t* base = kb + ((size_t)b * SEQ + (size_t)blk * 256) * DM + h * HD + (lane & 7) * 8;
        float acc[8] = {0.f, 0.f, 0.f, 0.f, 0.f, 0.f, 0.f, 0.f};
#pragma unroll 4
        for (int i = 0; i < 32; ++i) { const u32x4 w = *(const u32x4*)(base + (size_t)((lane >> 3) + 8 * i) * DM);
            acc[0] += bflo(w.x); acc[1] += bfhi(w.x); acc[2] += bflo(w.y); acc[3] += bfhi(w.y); acc[4] += bflo(w.z); acc[5] += bfhi(w.z); acc[6] += bflo(w.w); acc[7] += bfhi(w.w); }
#pragma unroll
        for (int j = 0; j < 8; ++j) { acc[j] += swz_xor<8>(acc[j]); acc[j] += swz_xor<16>(acc[j]); acc[j] = sum_xor32(acc[j]); }
        if (lane < 8) {
            float* o = kmean + (size_t)it * HD + lane * 8;
#pragma unroll
            for (int j = 0; j < 8; ++j) o[j] = acc[j] * (1.f / 256.f);
        }
    }
}

__device__ __forceinline__ void ld_row64(float (&r)[64], const bf16_t* p) {
#pragma unroll
    for (int c = 0; c < 8; ++c) { const u32x4 w = *((const u32x4*)p + c);
        r[8 * c + 0] = bflo(w.x); r[8 * c + 1] = bfhi(w.x); r[8 * c + 2] = bflo(w.y); r[8 * c + 3] = bfhi(w.y); r[8 * c + 4] = bflo(w.z); r[8 * c + 5] = bfhi(w.z); r[8 * c + 6] = bflo(w.w); r[8 * c + 7] = bfhi(w.w); }
}
__device__ __forceinline__ float dot_row64(const float (&q)[64], const bf16_t* p) {
    float s0 = 0.f, s1 = 0.f;
#pragma unroll
    for (int c = 0; c < 8; ++c) { const u32x4 w = *((const u32x4*)p + c);
        s0 += q[8 * c + 0] * bflo(w.x); s1 += q[8 * c + 1] * bfhi(w.x); s0 += q[8 * c + 2] * bflo(w.y); s1 += q[8 * c + 3] * bfhi(w.y);
        s0 += q[8 * c + 4] * bflo(w.z); s1 += q[8 * c + 5] * bfhi(w.z); s0 += q[8 * c + 6] * bflo(w.w); s1 += q[8 * c + 7] * bfhi(w.w); }
    return s0 + s1;
}
__device__ __forceinline__ void axpy_row64(float (&o)[64], float p, const bf16_t* vp) {
#pragma unroll
    for (int c = 0; c < 8; ++c) { const u32x4 w = *((const u32x4*)vp + c);
        o[8 * c + 0] += p * bflo(w.x); o[8 * c + 1] += p * bfhi(w.x); o[8 * c + 2] += p * bflo(w.y); o[8 * c + 3] += p * bfhi(w.y);
        o[8 * c + 4] += p * bflo(w.z); o[8 * c + 5] += p * bfhi(w.z); o[8 * c + 6] += p * bflo(w.w); o[8 * c + 7] += p * bfhi(w.w); }
}
__device__ __forceinline__ void st_row64(bf16_t* p, const float (&o)[64], float sc) {
#pragma unroll
    for (int c = 0; c < 8; ++c) { u32x4 w; w.x = pk2(o[8 * c] * sc, o[8 * c + 1] * sc); w.y = pk2(o[8 * c + 2] * sc, o[8 * c + 3] * sc); w.z = pk2(o[8 * c + 4] * sc, o[8 * c + 5] * sc); w.w = pk2(o[8 * c + 6] * sc, o[8 * c + 7] * sc); *((u32x4*)p + c) = w; }
}
#define OSM_STEP(sc, vrow) do { const float sc_ = (sc); if (sc_ > m_) { const float al = __builtin_amdgcn_exp2f(m_ - sc_); l_ *= al; _Pragma("unroll") for (int d_ = 0; d_ < 64; ++d_) o_[d_] *= al; m_ = sc_; } \
    const float p_ = __builtin_amdgcn_exp2f(sc_ - m_); l_ += p_; axpy_row64(o_, p_, (vrow)); } while (0)

__device__ __forceinline__ void naive_moba(const bf16_t* qb, const bf16_t* kb, const bf16_t* vb, const float* kmean, bf16_t* ob, int item, int tid) {
    const int b = item >> 6, h = (item >> 4) & 3, t = (item & 15) * 512 + tid, own = t >> 8;
    const size_t rowq = ((size_t)b * SEQ + t) * DM + h * HD;
    const bf16_t* kh = kb + (size_t)b * SEQ * DM + h * HD; const bf16_t* vh = vb + (size_t)b * SEQ * DM + h * HD;
    const float slope2 = exp2f(-2.0f * (float)(h + 1)) * LOG2E;
    float q_[64]; ld_row64(q_, qb + rowq);
    float bv0 = -INFINITY, bv1 = -INFINITY, bv2 = -INFINITY; int bi0 = -1, bi1 = -1, bi2 = -1;
    const float* km = kmean + (size_t)(b * 4 + h) * 32 * HD;
    for (int n = 0; n < own; ++n) {
        float gsum = 0.f;
#pragma unroll
        for (int d = 0; d < 64; ++d) gsum += q_[d] * km[n * HD + d];
        if (gsum > bv0) { bv2 = bv1; bi2 = bi1; bv1 = bv0; bi1 = bi0; bv0 = gsum; bi0 = n; }
        else if (gsum > bv1) { bv2 = bv1; bi2 = bi1; bv1 = gsum; bi1 = n; }
        else if (gsum > bv2) { bv2 = gsum; bi2 = n; }
    }
    float o_[64];
#pragma unroll
    for (int d = 0; d < 64; ++d) o_[d] = 0.f;
    float m_ = -INFINITY, l_ = 0.f;
    for (int s = 0; s < 3; ++s) {
        const int blk = (s == 0) ? bi0 : (s == 1) ? bi1 : bi2;
        if (blk < 0) continue;
        for (int j = 0; j < 256; ++j) { const int pos = blk * 256 + j;
            const float sc = dot_row64(q_, kh + (size_t)pos * DM) - slope2 * (float)(t - pos);
            OSM_STEP(sc, vh + (size_t)pos * DM); }
    }
    for (int pos = own * 256; pos <= t; ++pos) {
        const float sc = dot_row64(q_, kh + (size_t)pos * DM) - slope2 * (float)(t - pos);
        OSM_STEP(sc, vh + (size_t)pos * DM); }
    st_row64(ob + rowq, o_, 1.0f / l_);
}
__device__ __forceinline__ void naive_sb(const bf16_t* qb, const bf16_t* kb, const bf16_t* vb, bf16_t* ob, int item, int tid) {
    const int b = item >> 6, h = 4 + ((item >> 4) & 3), t = (item & 15) * 512 + tid;
    const size_t rowq = ((size_t)b * SEQ + t) * DM + h * HD;
    const bf16_t* kh = kb + (size_t)b * SEQ * DM + h * HD; const bf16_t* vh = vb + (size_t)b * SEQ * DM + h * HD;
    float q_[64]; ld_row64(q_, qb + rowq);
    float o_[64];
#pragma unroll
    for (int d = 0; d < 64; ++d) o_[d] = 0.f;
    float tail = 0.f;
    for (int s = t - 1; s >= 0 && tail > -150.f; --s) {
        const float z = dot_row64(q_, kh + (size_t)s * DM);
        const float lp = __builtin_amdgcn_logf(1.0f + __builtin_amdgcn_exp2f(-fabsf(z)));
        const float lnot = -(fmaxf(z, 0.f) + lp);
        const float aw = __builtin_amdgcn_exp2f(z + lnot + tail);
        axpy_row64(o_, aw, vh + (size_t)s * DM);
        tail += lnot;
    }
    st_row64(ob + rowq, o_, 1.0f);
}
__device__ __forceinline__ void naive_dil(const bf16_t* qb, const bf16_t* kb, const bf16_t* vb, bf16_t* ob, bf16_t* hb2, float* lse, int item, int tid) {
    const int b = item >> 7, h = 8 + ((item >> 4) & 7), t = (item & 15) * 512 + tid;
    const size_t rowq = ((size_t)b * SEQ + t) * DM + h * HD;
    const bf16_t* kh = kb + (size_t)b * SEQ * DM + h * HD; const bf16_t* vh = vb + (size_t)b * SEQ * DM + h * HD;
    const float slope2 = exp2f(-(float)(h - 8 + 1)) * LOG2E;
    float q_[64]; ld_row64(q_, qb + rowq);
    float o_[64];
#pragma unroll
    for (int d = 0; d < 64; ++d) o_[d] = 0.f;
    float m_ = -INFINITY, l_ = 0.f;
    for (int c = 0; c < 3; ++c) {
        const int dil = (c == 0) ? 1 : (c == 1) ? 4 : 16;
        for (int dl = 0; dl <= 128; ++dl) { const int pos = t - dl * dil; if (pos < 0) break;
            const float sc = dot_row64(q_, kh + (size_t)pos * DM) - slope2 * (float)(dl * dil);
            OSM_STEP(sc, vh + (size_t)pos * DM); }
    }
    st_row64(ob + rowq, o_, 1.0f / l_);
    { const size_t tok = (size_t)b * SEQ + t; const u32x4 z4 = {0u, 0u, 0u, 0u};
#pragma unroll
      for (int c = 0; c < 8; ++c) { *((u32x4*)(hb2 + tok * DM + (h - 8) * HD) + c) = z4; *((u32x4*)(hb2 + tok * DM + 512 + (h - 8) * HD) + c) = z4; }
      lse[tok * 8 + (h - 8)] = 0.f; lse[(size_t)T * 8 + tok * 8 + (h - 8)] = -1.0e30f; lse[(size_t)2 * T * 8 + tok * 8 + (h - 8)] = -1.0e30f; }
}

namespace att {
typedef float f32x16 __attribute__((ext_vector_type(16)));
typedef short s16x4 __attribute__((ext_vector_type(4)));
typedef short v4i16_t __attribute__((ext_vector_type(4)));
typedef __bf16 bf16x2_t __attribute__((ext_vector_type(2)));
constexpr int L_BUF = 16384;
constexpr int L_WSF = 2 * L_BUF;
constexpr int L_OST = L_WSF + 8 * 256;
constexpr int L_FLG = L_OST + 8 * 4096;
constexpr int L_END = L_FLG + 64;
constexpr float M_INIT = -1.0e30f;
#define ATT_MFMA(a, b, c) __builtin_amdgcn_mfma_f32_32x32x16_bf16((a), (b), (c), 0, 0, 0)

__device__ __forceinline__ unsigned cvtpk(float lo, float hi) { f32x2 v = {lo, hi}; bf16x2_t b = __builtin_convertvector(v, bf16x2_t); return __builtin_bit_cast(unsigned, b); }
__device__ __forceinline__ s16x4 vtr(LAS unsigned char* p) { return __builtin_bit_cast(s16x4, __builtin_amdgcn_ds_read_tr16_b64_v4i16((LAS v4i16_t*)p)); }

struct Wave { int lane, r32, hi, wid; LAS unsigned char* lds; LAS float* wsf; LAS unsigned char* ost; int vlo; };
__device__ __forceinline__ Wave make_wave(LAS unsigned char* lds, int tid, int wsf_off = L_WSF, int ost_off = L_OST) {
    Wave w; w.lane = tid & 63; w.r32 = w.lane & 31; w.hi = w.lane >> 5; w.wid = __builtin_amdgcn_readfirstlane(tid >> 6); w.lds = lds;
    w.wsf = (LAS float*)(lds + wsf_off) + w.wid * 64; w.ost = lds + ost_off + w.wid * 4096;
    w.vlo = ((w.lane >> 4) & 1) * 32 + (w.lane & 3) * 8 + (4 * w.hi + ((w.lane & 15) >> 2)) * 64;
    return w;
}
struct Stage { u32x4 k, v; };
template <class RowK, class RowV> __device__ __forceinline__ void stage_load(Stage& s, const Wave& w, const RowK& rowk, const RowV& rowv) {
    s.k = *(const u32x4*)(rowk(w.lane) + w.wid * 8);
    s.v = *(const u32x4*)(rowv(16 * (w.wid & 3) + (w.lane >> 2)) + (w.wid >> 2) * 32 + (w.lane & 3) * 8);
}
__device__ __forceinline__ void stage_write(const Stage& s, const Wave& w, int buf) {
    *(LAS u32x4*)(w.lds + buf * L_BUF + w.wid * 1024 + w.lane * 16) = s.k;
    *(LAS u32x4*)(w.lds + buf * L_BUF + 8192 + w.wid * 1024 + w.lane * 16) = s.v;
}
__device__ __forceinline__ f32x16 qk_sub(const Wave& w, int buf, int sub, const bf16x8 (&qf)[4], float init) {
    f32x16 acc;
#pragma unroll
    for (int r = 0; r < 16; ++r) acc[r] = init;
    LAS unsigned char* kp = w.lds + buf * L_BUF + w.hi * 1024 + (32 * sub + w.r32) * 16;
#pragma unroll
    for (int ks = 0; ks < 4; ++ks) { const bf16x8 kf = *(LAS bf16x8*)(kp + ks * 2048); acc = ATT_MFMA(kf, qf[ks], acc); }
    return acc;
}
__device__ __forceinline__ void pv_sub(const Wave& w, int buf, int sub, const f32x16& p, f32x16 (&o)[2]) {
    bf16x8 pk[2];
#pragma unroll
    for (int s = 0; s < 2; ++s) { u32x4 t; t.x = cvtpk(p[8 * s], p[8 * s + 1]); t.y = cvtpk(p[8 * s + 2], p[8 * s + 3]); t.z = cvtpk(p[8 * s + 4], p[8 * s + 5]); t.w = cvtpk(p[8 * s + 6], p[8 * s + 7]); pk[s] = __builtin_bit_cast(bf16x8, t); }
    LAS unsigned char* vb = w.lds + buf * L_BUF + 8192 + w.vlo;
#pragma unroll
    for (int db = 0; db < 2; ++db)
#pragma unroll
        for (int s = 0; s < 2; ++s) { LAS unsigned char* vp = vb + db * 4096 + (4 * sub + 2 * s) * 512;
            const s16x4 lo = vtr(vp), hh = vtr(vp + 512);
            const bf16x8 vf = __builtin_shufflevector(lo, hh, 0, 1, 2, 3, 4, 5, 6, 7);
            o[db] = ATT_MFMA(pk[s], vf, o[db]); }
}
struct VFrags { s16x4 f[2][2][2]; };
__device__ __forceinline__ void load_vfrags(const Wave& w, int buf, int sub, VFrags& v) {
    LAS unsigned char* vb = w.lds + buf * L_BUF + 8192 + w.vlo;
#pragma unroll
    for (int db = 0; db < 2; ++db)
#pragma unroll
        for (int s = 0; s < 2; ++s) { LAS unsigned char* vp = vb + db * 4096 + (4 * sub + 2 * s) * 512; v.f[db][s][0] = vtr(vp); v.f[db][s][1] = vtr(vp + 512); }
}
__device__ __forceinline__ void pv_frags(const VFrags& v, const f32x16& p, f32x16 (&o)[2]) {
    bf16x8 pk[2];
#pragma unroll
    for (int s = 0; s < 2; ++s) { u32x4 t; t.x = cvtpk(p[8 * s], p[8 * s + 1]); t.y = cvtpk(p[8 * s + 2], p[8 * s + 3]); t.z = cvtpk(p[8 * s + 4], p[8 * s + 5]); t.w = cvtpk(p[8 * s + 6], p[8 * s + 7]); pk[s] = __builtin_bit_cast(bf16x8, t); }
#pragma unroll
    for (int db = 0; db < 2; ++db)
#pragma unroll
        for (int s = 0; s < 2; ++s) { const bf16x8 vf = __builtin_shufflevector(v.f[db][s][0], v.f[db][s][1], 0, 1, 2, 3, 4, 5, 6, 7); o[db] = ATT_MFMA(pk[s], vf, o[db]); }
}
__device__ __forceinline__ void scale_rows(const Wave& w, f32x16 (&o)[2], float f) {
    if (w.hi == 0) w.wsf[w.r32] = f;
#pragma unroll
    for (int g = 0; g < 4; ++g) { const f32x4 fv = *(LAS f32x4*)(w.wsf + 8 * g + 4 * w.hi);
#pragma unroll
        for (int i = 0; i < 4; ++i) { o[0][4 * g + i] *= fv[i]; o[1][4 * g + i] *= fv[i]; } }
}
__device__ __forceinline__ void softmax_sub(const Wave& w, f32x16& s, float& m, float& lsum, f32x16 (&o)[2]) {
    float tm = fmaxf(fmaxf(s[0], s[1]), fmaxf(s[2], s[3]));
#pragma unroll
    for (int r = 4; r < 16; r += 4) tm = fmaxf(tm, fmaxf(fmaxf(s[r], s[r + 1]), fmaxf(s[r + 2], s[r + 3])));
    tm = max_xor32(tm);
    const float mn = fmaxf(m, tm);
    if (__any(mn > m)) { const float al = __builtin_amdgcn_exp2f(m - mn); lsum *= al; scale_rows(w, o, al); m = mn; }
    float acc = 0.f;
#pragma unroll
    for (int r = 0; r < 16; ++r) { s[r] = __builtin_amdgcn_exp2f(s[r] - m); acc += s[r]; }
    lsum += acc;
}
__device__ __forceinline__ void mask_band(f32x16& s, int delta0, int W) {
#pragma unroll
    for (int r = 0; r < 16; ++r) { const int dl = delta0 - ((r & 3) + 8 * (r >> 2)); if ((unsigned)dl > (unsigned)W) s[r] = -INFINITY; }
}
constexpr float SM_THR = 8.0f;
struct SubDesc { bool act; int delta; int W; };
template <int NSUB>
__device__ __forceinline__ void softmax_step(const Wave& w, int buf, const bf16x8 (&qf)[4], const bf16x8& kidx, const bf16x8& slp, float slope, const SubDesc (&sd)[NSUB],
                                             float& m, float& lsum, f32x16 (&o)[2], bool& first) {
    f32x16 s[NSUB];
    bool any_act = false;
#pragma unroll
    for (int i = 0; i < NSUB; ++i) if (sd[i].act) { any_act = true; s[i] = qk_sub(w, buf, i, qf, -slope * (float)sd[i].delta - m); s[i] = ATT_MFMA(kidx, slp, s[i]); }
    if (!any_act) return;
    float tm = -INFINITY;
#pragma unroll
    for (int i = 0; i < NSUB; ++i) if (sd[i].act) {
        if (sd[i].W >= 0) mask_band(s[i], sd[i].delta - 4 * w.hi, sd[i].W);
        float t = fmaxf(fmaxf(s[i][0], s[i][1]), fmaxf(s[i][2], s[i][3]));
#pragma unroll
        for (int r = 4; r < 16; r += 4) t = fmaxf(t, fmaxf(fmaxf(s[i][r], s[i][r + 1]), fmaxf(s[i][r + 2], s[i][r + 3])));
        tm = fmaxf(tm, t); }
    tm = max_xor32(tm);
    if (first || __any(tm > SM_THR)) {
        const float d = first ? (tm > -1.0e30f ? tm : 0.f) : fmaxf(tm, 0.f);
#pragma unroll
        for (int i = 0; i < NSUB; ++i) if (sd[i].act) {
#pragma unroll
            for (int r = 0; r < 16; ++r) s[i][r] -= d; }
        if (!first) { const float al = __builtin_amdgcn_exp2f(-d); lsum *= al; scale_rows(w, o, al); }
        m += d; first = false;
    }
    VFrags vf[NSUB];
#pragma unroll
    for (int i = 0; i < NSUB; ++i) if (sd[i].act) load_vfrags(w, buf, i, vf[i]);
#pragma unroll
    for (int i = 0; i < NSUB; ++i) if (sd[i].act) { float acc = 0.f;
#pragma unroll
        for (int r = 0; r < 16; ++r) { s[i][r] = __builtin_amdgcn_exp2f(s[i][r]); acc += s[i][r]; }
        lsum += acc; }
#pragma unroll
    for (int i = 0; i < NSUB; ++i) if (sd[i].act) pv_frags(vf[i], s[i], o);
}
__device__ __forceinline__ void bias_frags(const Wave& w, float slope, bf16x8& kidx, bf16x8& slp) {
    const unsigned kb = f2bf((float)w.r32), sh = f2bf(slope), sl = f2bf(slope - __builtin_bit_cast(float, sh << 16));
    const u32x4 a = {w.hi == 0 ? (kb | (kb << 16)) : 0u, 0u, 0u, 0u}, b = {w.hi == 0 ? (sh | (sl << 16)) : 0u, 0u, 0u, 0u};
    kidx = __builtin_bit_cast(bf16x8, a); slp = __builtin_bit_cast(bf16x8, b);
}
template <class RowO> __device__ __forceinline__ void store_o(const Wave& w, const f32x16 (&o)[2], const RowO& rowo) {
    LAS unsigned short* stg = (LAS unsigned short*)w.ost;
#pragma unroll
    for (int r = 0; r < 16; r += 2) { const int q = (r & 3) + 8 * (r >> 2) + 4 * w.hi;
#pragma unroll
        for (int db = 0; db < 2; ++db) { const unsigned pr = pk2(o[db][r], o[db][r + 1]); stg[q * 64 + db * 32 + w.r32] = (unsigned short)pr; stg[(q + 1) * 64 + db * 32 + w.r32] = (unsigned short)(pr >> 16); } }
#pragma unroll
    for (int i = 0; i < 4; ++i) { const int row = i * 8 + (w.lane >> 3), ch = w.lane & 7; const u32x4 v = *(LAS u32x4*)((LAS unsigned char*)stg + row * 128 + ch * 16);
        bf16_t* dst = rowo(row); if (dst) *(u32x4*)(dst + ch * 8) = v; }
}
__device__ __forceinline__ void load_q(bf16x8 (&qf)[4], const bf16_t* qrow, int hi) {
#pragma unroll
    for (int ks = 0; ks < 4; ++ks) qf[ks] = *(const bf16x8*)(qrow + 16 * ks + 8 * hi);
}

constexpr int W_WSF = 98304, W_OST = W_WSF + 2048, W_ENUM = W_OST + 32768;
template <int NC> struct Pref { u32x4 k[NC], v[NC]; bf16x8 q[4]; };
template <int NC, class RowF> __device__ __forceinline__ void win_issue(Pref<NC>& P, const Wave& w, const bf16_t* kbase, const bf16_t* vbase, const RowF& rowoff, const bf16_t* qrow) {
#pragma unroll
    for (int c = 0; c < NC; ++c) { P.k[c] = *(const u32x4*)(kbase + rowoff(64 * c + 8 * w.wid + (w.lane >> 3)) + (w.lane & 7) * 8);
        P.v[c] = *(const u32x4*)(vbase + rowoff(64 * c + 16 * (w.wid & 3) + (w.lane >> 2)) + (w.wid >> 2) * 32 + (w.lane & 3) * 8); }
    load_q(P.q, qrow, w.hi);
}
template <int NC> __device__ __forceinline__ void win_commit(const Pref<NC>& P, const Wave& w) {
    constexpr int NK = 64 * NC;
#pragma unroll
    for (int c = 0; c < NC; ++c) { const int key = 64 * c + 8 * w.wid + (w.lane >> 3);
        *(LAS u32x4*)(w.lds + key * 128 + ((((w.lane & 7) ^ (key >> 1)) & 7) * 16)) = P.k[c];
        *(LAS u32x4*)(w.lds + NK * 128 + (w.wid >> 2) * (NK * 64) + (8 * c + 2 * (w.wid & 3)) * 512 + w.lane * 16) = P.v[c]; }
}
template <int NK> __device__ __forceinline__ f32x16 qk_win(const Wave& w, int u, const bf16x8 (&qf)[4], float init) {
    f32x16 acc;
#pragma unroll
    for (int r = 0; r < 16; ++r) acc[r] = init;
    LAS unsigned char* kp = w.lds + (32 * u + w.r32) * 128; const int x = (w.r32 >> 1) & 7;
#pragma unroll
    for (int ks = 0; ks < 4; ++ks) { const bf16x8 kf = *(LAS bf16x8*)(kp + (((2 * ks + w.hi) ^ x) * 16)); acc = ATT_MFMA(kf, qf[ks], acc); }
    return acc;
}
template <int NK> __device__ __forceinline__ void load_vfrags_win(const Wave& w, int u, VFrags& v) {
    LAS unsigned char* vb = w.lds + NK * 128 + w.vlo;
#pragma unroll
    for (int db = 0; db < 2; ++db)
#pragma unroll
        for (int s = 0; s < 2; ++s) { LAS unsigned char* vp = vb + db * (NK * 64) + (4 * u + 2 * s) * 512; v.f[db][s][0] = vtr(vp); v.f[db][s][1] = vtr(vp + 512); }
}
struct WSub { bool act; int u; int delta; int W; };
template <int NK>
__device__ __forceinline__ void softmax_win(const Wave& w, const bf16x8 (&qf)[4], const bf16x8& kidx, const bf16x8& slp, float slope, const WSub (&sd)[2], float& m, float& lsum, f32x16 (&o)[2], bool& first) {
    f32x16 s[2];
    bool any_act = false;
#pragma unroll
    for (int i = 0; i < 2; ++i) if (sd[i].act) { any_act = true; s[i] = qk_win<NK>(w, sd[i].u, qf, -slope * (float)sd[i].delta - m); s[i] = ATT_MFMA(kidx, slp, s[i]); }
    if (!any_act) return;
    float tm = -INFINITY;
#pragma unroll
    for (int i = 0; i < 2; ++i) if (sd[i].act) {
        if (sd[i].W >= 0) mask_band(s[i], sd[i].delta - 4 * w.hi, sd[i].W);
        float t = fmaxf(fmaxf(s[i][0], s[i][1]), fmaxf(s[i][2], s[i][3]));
#pragma unroll
        for (int r = 4; r < 16; r += 4) t = fmaxf(t, fmaxf(fmaxf(s[i][r], s[i][r + 1]), fmaxf(s[i][r + 2], s[i][r + 3])));
        tm = fmaxf(tm, t); }
    tm = max_xor32(tm);
    if (first || __any(tm > SM_THR)) {
        const float d = first ? (tm > -1.0e30f ? tm : 0.f) : fmaxf(tm, 0.f);
#pragma unroll
        for (int i = 0; i < 2; ++i) if (sd[i].act) {
#pragma unroll
            for (int r = 0; r < 16; ++r) s[i][r] -= d; }
        if (!first) { const float al = __builtin_amdgcn_exp2f(-d); lsum *= al; scale_rows(w, o, al); }
        m += d; first = false;
    }
#pragma unroll
    for (int i = 0; i < 2; ++i) if (sd[i].act) { VFrags vf; load_vfrags_win<NK>(w, sd[i].u, vf);
        float acc = 0.f;
#pragma unroll
        for (int r = 0; r < 16; ++r) { s[i][r] = __builtin_amdgcn_exp2f(s[i][r]); acc += s[i][r]; }
        lsum += acc;
        pv_frags(vf, s[i], o); }
}

__device__ __forceinline__ size_t ql_off(int bh, int j) { return (size_t)bh * QL_PER_BH + (size_t)(8192 * j - 128 * j * (j + 1)); }
__device__ __forceinline__ float* lsem_ptr(float* l0, float* l1, int slot) { return (slot < 2 ? l0 : l1) + (size_t)(slot & 1) * T * 4; }

struct Top3 { int i0, i1, i2; };
__device__ __forceinline__ Top3 moba_top3(const Wave& w, const bf16x8 (&qf)[4], const float* KMEAN, int b, int h, int own) {
    int i0 = -1, i1 = -1, i2 = -1;
    if (own > 0) {
    f32x16 g;
#pragma unroll
    for (int r = 0; r < 16; ++r) g[r] = 0.f;
    const float* km = KMEAN + ((size_t)(b * 4 + h) * 32 + w.r32) * HD + 8 * w.hi;
#pragma unroll
    for (int ks = 0; ks < 4; ++ks) { const f32x4 a0 = *(const f32x4*)(km + 16 * ks), a1 = *(const f32x4*)(km + 16 * ks + 4);
        const float x[8] = {a0.x, a0.y, a0.z, a0.w, a1.x, a1.y, a1.z, a1.w}; unsigned hw[4], lw[4];
#pragma unroll
        for (int j = 0; j < 4; ++j) { hw[j] = cvtpk(x[2 * j], x[2 * j + 1]);
            lw[j] = cvtpk(x[2 * j] - bflo(hw[j]), x[2 * j + 1] - bfhi(hw[j])); }
        const u32x4 hv = {hw[0], hw[1], hw[2], hw[3]}, lv = {lw[0], lw[1], lw[2], lw[3]};
        g = ATT_MFMA(__builtin_bit_cast(bf16x8, hv), qf[ks], g); g = ATT_MFMA(__builtin_bit_cast(bf16x8, lv), qf[ks], g); }
    float v0 = -INFINITY, v1 = -INFINITY, v2 = -INFINITY;
#pragma unroll
    for (int r = 0; r < 16; ++r) { const int blk = (r & 3) + 8 * (r >> 2) + 4 * w.hi; const float val = (blk < own) ? g[r] : -INFINITY;
        if (val > v0) { v2 = v1; i2 = i1; v1 = v0; i1 = i0; v0 = val; i0 = blk; } else if (val > v1) { v2 = v1; i2 = i1; v1 = val; i1 = blk; } else if (val > v2) { v2 = val; i2 = blk; } }
    const float pv_[3] = {get_xor32(v0, w.hi), get_xor32(v1, w.hi), get_xor32(v2, w.hi)}; const int pi_[3] = {get_xor32i(i0, w.hi), get_xor32i(i1, w.hi), get_xor32i(i2, w.hi)};
#pragma unroll
    for (int k = 0; k < 3; ++k) { const float val = pv_[k]; const int blk = pi_[k];
        if (val > v0 || (val == v0 && blk < i0)) { v2 = v1; i2 = i1; v1 = v0; i1 = i0; v0 = val; i0 = blk; }
        else if (val > v1 || (val == v1 && blk < i1)) { v2 = v1; i2 = i1; v1 = val; i1 = blk; }
        else if (val > v2 || (val == v2 && blk < i2)) { v2 = val; i2 = blk; } }
    }
    Top3 t; t.i0 = i0; t.i1 = i1; t.i2 = i2; return t;
}
__device__ __forceinline__ void moba_gate_unit(LAS unsigned char* lds, const bf16_t* QB, const float* KMEAN, unsigned* mcnt, unsigned* qlist, bf16_t* PM, float* LSEM0, float* LSEM1, int b, int h, int own, int tid) {
    const Wave w = make_wave(lds, tid);
    const size_t rowbase = (size_t)b * SEQ; const int qpos = own * 256 + 32 * w.wid + w.r32, bh = b * 4 + h;
    bf16x8 qf[4]; load_q(qf, QB + (rowbase + qpos) * DM + h * HD, w.hi);
    const Top3 t3 = moba_top3(w, qf, KMEAN, b, h, own); const int s0 = t3.i0, s1 = t3.i1, s2 = t3.i2;
    LAS unsigned* cl = (LAS unsigned*)(lds + W_ENUM);
    if (tid < 64) cl[tid] = 0u;
    __syncthreads();
    unsigned r0 = 0u, r1 = 0u, r2 = 0u;
    if (w.hi == 0) {
        if (s0 >= 0) r0 = __hip_atomic_fetch_add(cl + s0, 1u, __ATOMIC_RELAXED, __HIP_MEMORY_SCOPE_WORKGROUP);
        if (s1 >= 0) r1 = __hip_atomic_fetch_add(cl + s1, 1u, __ATOMIC_RELAXED, __HIP_MEMORY_SCOPE_WORKGROUP);
        if (s2 >= 0) r2 = __hip_atomic_fetch_add(cl + s2, 1u, __ATOMIC_RELAXED, __HIP_MEMORY_SCOPE_WORKGROUP);
    }
    __syncthreads();
    if (tid < 32) { const unsigned c = cl[tid]; cl[32 + tid] = c ? __hip_atomic_fetch_add(mcnt + bh * 32 + tid, c, __ATOMIC_RELAXED, __HIP_MEMORY_SCOPE_AGENT) : 0u; }
    __syncthreads();
    if (w.hi == 0) {
        const size_t tok = rowbase + qpos;
#define MOBA_EMIT(k, sk, rk) do { if (sk >= 0) qlist[ql_off(bh, sk) + cl[32 + sk] + rk] = (unsigned)qpos | ((unsigned)(k) << 13); \
            else { lsem_ptr(LSEM0, LSEM1, k)[tok * 4 + h] = -1.0e30f;          \
                u32x4* pz = (u32x4*)(PM + ((size_t)(k) * T + tok) * 256 + h * HD); const u32x4 z4 = {0u, 0u, 0u, 0u}; \
                _Pragma("unroll") for (int c = 0; c < 8; ++c) pz[c] = z4; } } while (0)
        MOBA_EMIT(0, s0, r0); MOBA_EMIT(1, s1, r1); MOBA_EMIT(2, s2, r2);
#undef MOBA_EMIT
    }
    __syncthreads();
}
struct OwnU { int b, h, own; };
__device__ __forceinline__ void own_issue(Pref<4>& P, const Wave& w, const OwnU& u, const bf16_t* QB, const bf16_t* KB, const bf16_t* VB) {
    const size_t rowbase = (size_t)u.b * SEQ; const int q0 = u.own * 256;
    win_issue<4>(P, w, KB + (rowbase + q0) * DM + u.h * HD, VB + (rowbase + q0) * DM + u.h * HD, [&](int key) { return (size_t)key * DM; }, QB + (rowbase + q0 + 32 * w.wid + w.r32) * DM + u.h * HD);
}
template <class F> __device__ __forceinline__ void own_compute(const Wave& w, const OwnU& u, const bf16x8 (&qf)[4], bf16_t* OB, float* LSEM0, float* LSEM1, const F& between) {
    const size_t rowbase = (size_t)u.b * SEQ; const int q0 = u.own * 256, ql = 32 * w.wid + w.r32;
    const float slope2 = exp2f(-2.0f * (float)(u.h + 1)) * LOG2E;
    bf16x8 kidx, slp; bias_frags(w, slope2, kidx, slp);
    f32x16 o[2];
#pragma unroll
    for (int r = 0; r < 16; ++r) { o[0][r] = 0.f; o[1][r] = 0.f; }
    float m = 0.f, lsum = 0.f; bool first = true;
#pragma unroll
    for (int p = 0; p < 4; ++p) { WSub sd[2];
#pragma unroll
        for (int i = 0; i < 2; ++i) { const int su = w.wid - 2 * p - i; sd[i].act = su >= 0; sd[i].u = su; sd[i].delta = ql - 32 * su; sd[i].W = (su == w.wid) ? 0x7fffffff : -1; }
        softmax_win<256>(w, qf, kidx, slp, slope2, sd, m, lsum, o, first); }
    between();
    const float l = sum_xor32(lsum);
    scale_rows(w, o, 1.0f / l);
    bf16_t* orow = OB + (rowbase + q0 + 32 * w.wid) * DM + u.h * HD;
    store_o(w, o, [&](int r) { return orow + (size_t)r * DM; });
    if (w.hi == 0) lsem_ptr(LSEM0, LSEM1, 3)[(rowbase + q0 + ql) * 4 + u.h] = m + __builtin_amdgcn_logf(l);
}
struct GatU { int b, h, j, cnt, chunk; const unsigned* ql; };
__device__ __forceinline__ unsigned gat_entry(const Wave& w, const GatU& u, bool& valid) { const int idx = u.chunk * 256 + 32 * w.wid + w.r32; valid = idx < u.cnt; return u.ql[valid ? idx : u.chunk * 256]; }
__device__ __forceinline__ void gat_issue(Pref<4>& P, const Wave& w, const GatU& u, const bf16_t* QB, const bf16_t* KB, const bf16_t* VB) {
    const size_t rowbase = (size_t)u.b * SEQ; bool valid; const unsigned e = gat_entry(w, u, valid);
    win_issue<4>(P, w, KB + (rowbase + u.j * 256) * DM + u.h * HD, VB + (rowbase + u.j * 256) * DM + u.h * HD, [&](int key) { return (size_t)key * DM; }, QB + (rowbase + (e & 8191u)) * DM + u.h * HD);
}
template <class F> __device__ __forceinline__ void gat_compute(const Wave& w, const GatU& u, const bf16x8 (&qf)[4], bf16_t* PM, float* LSEM0, float* LSEM1, const F& between) {
    const size_t rowbase = (size_t)u.b * SEQ; bool valid; const unsigned e = gat_entry(w, u, valid);
    const int qpos = (int)(e & 8191u), slot = (int)(e >> 13);
    const float slope2 = exp2f(-2.0f * (float)(u.h + 1)) * LOG2E;
    bf16x8 kidx, slp; bias_frags(w, slope2, kidx, slp);
    f32x16 o[2];
#pragma unroll
    for (int r = 0; r < 16; ++r) { o[0][r] = 0.f; o[1][r] = 0.f; }
    float m = 0.f, lsum = 0.f; bool first = true;
#pragma unroll
    for (int p = 0; p < 4; ++p) { WSub sd[2];
#pragma unroll
        for (int i = 0; i < 2; ++i) { const int su = 7 - 2 * p - i; sd[i].act = true; sd[i].u = su; sd[i].delta = qpos - (u.j * 256 + 32 * su); sd[i].W = -1; }
        softmax_win<256>(w, qf, kidx, slp, slope2, sd, m, lsum, o, first); }
    between();
    const float l = sum_xor32(lsum);
    scale_rows(w, o, l > 0.f ? 1.0f / l : 0.f);
    LAS int* code = (LAS int*)(w.wsf + 32);
    if (w.hi == 0) code[w.r32] = valid ? (int)((size_t)slot * T + rowbase + qpos) : -1;
    store_o(w, o, [&](int r) { const int c = code[r]; return c >= 0 ? PM + (size_t)c * 256 + u.h * HD : (bf16_t*)nullptr; });
    if (w.hi == 0 && valid) lsem_ptr(LSEM0, LSEM1, slot)[(rowbase + qpos) * 4 + u.h] = l > 0.f ? m + __builtin_amdgcn_logf(l) : -1.0e30f;
}

__device__ __forceinline__ void sb_unit(LAS unsigned char* lds, const bf16_t* QB, const bf16_t* KB, const bf16_t* VB, bf16_t* OB, int b, int h, int qt, int tid) {
    const Wave w = make_wave(lds, tid);
    const size_t rowbase = (size_t)b * SEQ; const int q0 = qt * 256, qpos = q0 + 32 * w.wid + w.r32;
    const bf16_t* kh = KB + rowbase * DM + h * HD; const bf16_t* vh = VB + rowbase * DM + h * HD;
    bf16x8 qf[4]; load_q(qf, QB + (rowbase + qpos) * DM + h * HD, w.hi);
    f32x16 o[2];
#pragma unroll
    for (int r = 0; r < 16; ++r) { o[0][r] = 0.f; o[1][r] = 0.f; }
    float carry = 0.f;
    bool done = false;
    volatile LAS unsigned* flg = (volatile LAS unsigned*)(lds + L_FLG);
    const int ti0 = q0 / 64 + 3;
    Stage sg;
    { const int kp = ti0 * 64; stage_load(sg, w, [&](int key) { return kh + (size_t)(kp + key) * DM; }, [&](int key) { return vh + (size_t)(kp + key) * DM; }); }
    stage_write(sg, w, 0);
    __syncthreads();
    for (int st = 0;; ++st) {
        const int buf = st & 1, ti = ti0 - st;
        if (ti > 0) { const int kp = (ti - 1) * 64; stage_load(sg, w, [&](int key) { return kh + (size_t)(kp + key) * DM; }, [&](int key) { return vh + (size_t)(kp + key) * DM; }); }
        if (!done) {
#pragma unroll
            for (int sub = 1; sub >= 0; --sub) {
                const int D = (q0 / 32 + w.wid) - (2 * ti + sub);
                if (D < 0) continue;
                const int delta0 = qpos - (64 * ti + 32 * sub) - 4 * w.hi;
                f32x16 z = qk_sub(w, buf, sub, qf, 0.f);
                f32x16 dd;
#pragma unroll
                for (int r = 0; r < 16; ++r) { const float zr = z[r]; const int zi = __builtin_bit_cast(int, zr); const int zc = zi < 0x41f00000 ? zi : 0x41f00000;
                    z[r] = __builtin_amdgcn_exp2f(__builtin_bit_cast(float, zc)); }
                if (D == 0) {
#pragma unroll
                    for (int r = 0; r < 16; ++r) { const int dl = delta0 - ((r & 3) + 8 * (r >> 2)); if (dl < 1) z[r] = 0.f; }
                }
#pragma unroll
                for (int r = 0; r < 16; ++r) dd[r] = 1.f + z[r];
                float G[4], PG[4];
#pragma unroll
                for (int g = 0; g < 4; ++g) { G[g] = (dd[4 * g] * dd[4 * g + 1]) * (dd[4 * g + 2] * dd[4 * g + 3]); PG[g] = get_xor32(G[g], w.hi); }
                const float cin = __builtin_amdgcn_exp2f(carry);
                float run = 1.f;
#pragma unroll
                for (int g = 3; g >= 0; --g) { const float x3 = run * (w.hi == 0 ? PG[g] : 1.f);
                    const float p0 = x3 * G[g];
                    const float r0 = __builtin_amdgcn_rcpf(p0) * cin, r1 = r0 * dd[4 * g], r2 = r1 * dd[4 * g + 1], r3 = r2 * dd[4 * g + 2];
                    z[4 * g] *= r0; z[4 * g + 1] *= r1; z[4 * g + 2] *= r2; z[4 * g + 3] *= r3;
                    run *= G[g] * PG[g]; }
                carry -= __builtin_amdgcn_logf(run);
                pv_sub(w, buf, sub, z, o);
            }
            done = __all(carry < -150.f);
        }
        if (w.lane == 0) flg[buf * 8 + w.wid] = done ? 1u : 0u;
        if (ti > 0) stage_write(sg, w, buf ^ 1);
        __syncthreads();
        unsigned all = 1u;
#pragma unroll
        for (int k = 0; k < 8; ++k) all &= flg[buf * 8 + k];
        if (all || ti == 0) break;
    }
    bf16_t* orow = OB + (rowbase + q0 + 32 * w.wid) * DM + h * HD;
    store_o(w, o, [&](int r) { return orow + (size_t)r * DM; });
    __syncthreads();
}

struct PrefK6 { u32x4 k[6]; bf16x8 q[4]; }; struct PrefV6 { u32x4 v[6]; };
template <class RowF> __device__ __forceinline__ void win_issue_k6(PrefK6& P, const Wave& w, const bf16_t* kbase, const RowF& rowoff, const bf16_t* qrow) {
#pragma unroll
    for (int c = 0; c < 6; ++c) P.k[c] = *(const u32x4*)(kbase + rowoff(64 * c + 8 * w.wid + (w.lane >> 3)) + (w.lane & 7) * 8);
    load_q(P.q, qrow, w.hi);
}
template <class RowF> __device__ __forceinline__ void win_issue_v6(PrefV6& P, const Wave& w, const bf16_t* vbase, const RowF& rowoff) {
#pragma unroll
    for (int c = 0; c < 6; ++c) P.v[c] = *(const u32x4*)(vbase + rowoff(64 * c + 16 * (w.wid & 3) + (w.lane >> 2)) + (w.wid >> 2) * 32 + (w.lane & 3) * 8);
}
__device__ __forceinline__ void win_commit_k6(const PrefK6& P, const Wave& w) {
#pragma unroll
    for (int c = 0; c < 6; ++c) { const int key = 64 * c + 8 * w.wid + (w.lane >> 3); *(LAS u32x4*)(w.lds + key * 128 + ((((w.lane & 7) ^ (key >> 1)) & 7) * 16)) = P.k[c]; }
}
__device__ __forceinline__ void win_commit_v6(const PrefV6& P, const Wave& w) {
    constexpr int NK = 384;
#pragma unroll
    for (int c = 0; c < 6; ++c) *(LAS u32x4*)(w.lds + NK * 128 + (w.wid >> 2) * (NK * 64) + (8 * c + 2 * (w.wid & 3)) * 512 + w.lane * 16) = P.v[c];
}
struct DilU { int b, h, dil, res, i2, c; };
__device__ __forceinline__ DilU dil_decode(int u) { const int n = ((u & 31) + (u >> 8)) & 31, bhc = u >> 5,
    c = bhc % 3, bh = bhc / 3; DilU d; d.b = bh >> 3; d.h = 8 + (bh & 7); d.c = c;
    d.dil = (c == 0) ? 1 : (c == 1) ? 4 : 16; d.res = (c == 0) ? 0 : (c == 1) ? (n >> 3) : (n >> 1); d.i2 = (c == 0) ? n : (c == 1) ? (n & 7) : (n & 1); return d; }
__device__ __forceinline__ void dil_issue_k(PrefK6& P, const Wave& w, const DilU& u, const bf16_t* QB, const bf16_t* KB) {
    const size_t rowbase = (size_t)u.b * SEQ; const int Q0 = 256 * u.i2, qj = Q0 + 32 * w.wid + w.r32; const size_t rstride = (size_t)u.dil * DM;
    win_issue_k6(P, w, KB + (rowbase + u.res) * DM + u.h * HD, [&](int key) { const int kj = Q0 - 128 + key; return (size_t)(kj < 0 ? 0 : kj) * rstride; },
                 QB + (rowbase + u.res + (size_t)qj * u.dil) * DM + u.h * HD);
}
__device__ __forceinline__ void dil_issue_v(PrefV6& P, const Wave& w, const DilU& u, const bf16_t* VB) {
    const size_t rowbase = (size_t)u.b * SEQ; const int Q0 = 256 * u.i2; const size_t rstride = (size_t)u.dil * DM;
    win_issue_v6(P, w, VB + (rowbase + u.res) * DM + u.h * HD, [&](int key) { const int kj = Q0 - 128 + key; return (size_t)(kj < 0 ? 0 : kj) * rstride; });
}
template <class F> __device__ __forceinline__ void dil_compute(const Wave& w, const DilU& u, const bf16x8 (&qf)[4], bf16_t* OB, bf16_t* HB2, float* LSE, const F& between) {
    const size_t rowbase = (size_t)u.b * SEQ; const int Q0 = 256 * u.i2, ql = 32 * w.wid + w.r32;
    const float slope2d = exp2f(-(float)(u.h - 8 + 1)) * LOG2E * (float)u.dil;
    bf16x8 kidx, slp; bias_frags(w, slope2d, kidx, slp);
    f32x16 o[2];
#pragma unroll
    for (int r = 0; r < 16; ++r) { o[0][r] = 0.f; o[1][r] = 0.f; }
    float m = 0.f, lsum = 0.f; bool first = true;
    if (w.wid >= 4) __builtin_amdgcn_s_sleep(9);
#pragma unroll
    for (int p = 0; p < 3; ++p) { WSub sd[2];
#pragma unroll
        for (int i = 0; i < 2; ++i) { const int D = 2 * p + i, su = w.wid + 4 - D; sd[i].act = (D <= 4) && (Q0 - 128 + 32 * su >= 0); sd[i].u = su; sd[i].delta = ql + 128 - 32 * su; sd[i].W = (D == 0 || D == 4) ? 128 : -1; }
        softmax_win<384>(w, qf, kidx, slp, slope2d, sd, m, lsum, o, first); }
    between();
    const float l = sum_xor32(lsum);
    scale_rows(w, o, 1.0f / l);
    bf16_t* PO = (u.c == 0) ? OB + 512 : HB2 + (u.c - 1) * 512;
    const size_t tok0 = rowbase + u.res + (size_t)(Q0 + 32 * w.wid) * u.dil;
    store_o(w, o, [&](int r) { return PO + (tok0 + (size_t)r * u.dil) * DM + (u.h - 8) * HD; });
    if (w.hi == 0) (LSE + (size_t)u.c * T * 8)[(tok0 + (size_t)w.r32 * u.dil) * 8 + (u.h - 8)] = m + __builtin_amdgcn_logf(l);
}

__device__ __forceinline__ void moba_gate_phase(LAS unsigned char* lds, const bf16_t* QB, const float* KMEAN, unsigned* mcnt, unsigned* qlist, bf16_t* PM, float* LSEM0, float* LSEM1, int v, int G, int tid) {
    for (int u = v; u < 512; u += G) { const int own = u & 31, bh = u >> 5; moba_gate_unit(lds, QB, KMEAN, mcnt, qlist, PM, LSEM0, LSEM1, bh >> 2, bh & 3, own, tid); }
}
struct AttnArgs { const bf16_t* QB; const bf16_t* KB; const bf16_t* VB; bf16_t* OB; bf16_t* HB2; float* LSE; unsigned* mcnt; unsigned* qlist; bf16_t* PM; float* LSEM0; float* LSEM1; const float* KMEAN; unsigned* gdone; };
__device__ __forceinline__ void attn_phase(LAS unsigned char* lds, const AttnArgs& A, int v, int G, int tid) {
    moba_gate_phase(lds, A.QB, A.KMEAN, A.mcnt, A.qlist, A.PM, A.LSEM0, A.LSEM1, v, G, tid);
    asm volatile("s_waitcnt vmcnt(0)" ::: "memory");
    __syncthreads();
    if (tid == 0) { __builtin_amdgcn_fence(__ATOMIC_RELEASE, "agent"); asm volatile("s_waitcnt vmcnt(0)" ::: "memory"); __hip_atomic_fetch_add(A.gdone, 1u, __ATOMIC_RELAXED, __HIP_MEMORY_SCOPE_AGENT); }
    const Wave w = make_wave(lds, tid, W_WSF, W_OST);
    {   Pref<4> P; int u = v; OwnU cur, nxt;
        auto dec = [&](int uu) { OwnU o_; const int bh = uu >> 5; o_.b = bh >> 2; o_.h = bh & 3; o_.own = uu & 31; return o_; };
        if (u < 512) { cur = dec(u); own_issue(P, w, cur, A.QB, A.KB, A.VB); }
        for (; u < 512; u += G) {
            __syncthreads();
            win_commit<4>(P, w); bf16x8 qf[4] = {P.q[0], P.q[1], P.q[2], P.q[3]};
            __syncthreads();
            const bool more = u + G < 512; if (more) nxt = dec(u + G);
            own_compute(w, cur, qf, A.OB, A.LSEM0, A.LSEM1, [&]() { if (more) own_issue(P, w, nxt, A.QB, A.KB, A.VB); });
            cur = nxt; } }
    {   PrefK6 P; int u = v; DilU cur, nxt;
        if (u < 3072) { cur = dil_decode(u); dil_issue_k(P, w, cur, A.QB, A.KB); }
        for (; u < 3072; u += G) {
            PrefV6 PV; dil_issue_v(PV, w, cur, A.VB);
            __syncthreads();
            bf16x8 qf[4] = {P.q[0], P.q[1], P.q[2], P.q[3]};
            win_commit_k6(P, w); win_commit_v6(PV, w);
            __syncthreads();
            const bool more = u + G < 3072; if (more) nxt = dil_decode(u + G);
            dil_compute(w, cur, qf, A.OB, A.HB2, A.LSE, [&]() { if (more) dil_issue_k(P, w, nxt, A.QB, A.KB); });
            cur = nxt; } }
    __syncthreads();
    for (int u = v; u < 512; u += G) { const int qt = ((u & 31) + (u >> 8)) & 31, bh = u >> 5; sb_unit(lds, A.QB, A.KB, A.VB, A.OB, bh >> 2, 4 + (bh & 3), qt, tid); }
    if (tid == 0) { unsigned polls = 0;
        while (__hip_atomic_load(A.gdone, __ATOMIC_RELAXED, __HIP_MEMORY_SCOPE_AGENT) < (unsigned)G) { if (++polls > (1u << 20)) break; __builtin_amdgcn_s_sleep(2); }
        __builtin_amdgcn_fence(__ATOMIC_ACQUIRE, "agent"); asm volatile("s_waitcnt vmcnt(0)" ::: "memory"); }
    __syncthreads();
    LAS int* cntl = (LAS int*)(lds + W_ENUM); LAS int* pa = cntl + 512; LAS int* pb = pa + 512;
    const int myc = (int)A.mcnt[tid], myu = (myc + 255) >> 8;
    cntl[tid] = myc; pa[tid] = myu;
    __syncthreads();
#pragma unroll 1
    for (int d = 1; d < 512; d <<= 1) { const int x = pa[tid] + (tid >= d ? pa[tid - d] : 0); pb[tid] = x; __syncthreads(); LAS int* t_ = pa; pa = pb; pb = t_; }
    const int total = pa[511];
    auto gat_decode = [&](int u) { int lo = 0, hi = 511;
        while (lo < hi) { const int mid = (lo + hi) >> 1; if (pa[mid] > u) hi = mid; else lo = mid + 1; }
        const int i = lo, c = cntl[i], bh = i >> 5; GatU g; g.b = bh >> 2; g.h = bh & 3; g.j = i & 31; g.cnt = c; g.chunk = u - (pa[i] - ((c + 255) >> 8)); g.ql = A.qlist + ql_off(bh, g.j); return g; };
    volatile LAS int* GT = (volatile LAS int*)(lds + LDSCTL_OFF + 832);
    const bool gtab = (total + G - 1) / G <= 32;
    if (gtab && tid < 32) { const int u_ = v + tid * G; if (u_ < total) { int lo = 0, hi = 511;
            while (lo < hi) { const int mid = (lo + hi) >> 1; if (pa[mid] > u_) hi = mid; else lo = mid + 1; }
            const int c_ = cntl[lo]; GT[tid] = lo | ((u_ - (pa[lo] - ((c_ + 255) >> 8))) << 16); } }
    __syncthreads();
    auto gat_decode_k = [&](int u, int k) { if (!gtab) return gat_decode(u);
        const int e = GT[k], i = e & 0xffff, c = cntl[i], bh = i >> 5; GatU g; g.b = bh >> 2; g.h = bh & 3; g.j = i & 31; g.cnt = c; g.chunk = e >> 16; g.ql = A.qlist + ql_off(bh, g.j); return g; };
    {   Pref<4> P; int u = v, k = 0; GatU cur, nxt;
        if (u < total) { cur = gat_decode_k(u, 0); gat_issue(P, w, cur, A.QB, A.KB, A.VB); }
        for (; u < total; u += G, ++k) {
            __syncthreads();
            win_commit<4>(P, w); bf16x8 qf[4] = {P.q[0], P.q[1], P.q[2], P.q[3]};
            __syncthreads();
            const bool more = u + G < total; if (more) nxt = gat_decode_k(u + G, k + 1);
            gat_compute(w, cur, qf, A.PM, A.LSEM0, A.LSEM1, [&]() { if (more) gat_issue(P, w, nxt, A.QB, A.KB, A.VB); });
            cur = nxt; } }
}
}

constexpr int PH_PRO = 0, PH_L0 = 1, PH_PER_LAYER = 10, PH_FINAL = PH_L0 + DEPTH * PH_PER_LAYER, PH_COUNT = PH_FINAL + 1;
typedef const __attribute__((address_space(4))) Args* KArgP;
#define KARG() ({ KArgP p_ = (KArgP)__builtin_amdgcn_kernarg_segment_ptr(); asm volatile("" : "+s"(p_)); p_; })
#define PHASE_IDS int lane_p = (int)__builtin_amdgcn_mbcnt_hi(~0u, __builtin_amdgcn_mbcnt_lo(~0u, 0u)); LAUNDER_V(lane_p); int tid_p = wave * 64 + lane_p; int gw_p = gw, G_p = G, NGW_p = NGW; LAUNDER_S(gw_p); LAUNDER_S(G_p); LAUNDER_S(NGW_p)
__global__ void __launch_bounds__(NTHREADS, 2) fwd(Args a_unused) {
    extern __shared__ __attribute__((aligned(16))) unsigned char lds_raw[];
    LAS unsigned char* lds = (LAS unsigned char*)lds_raw;
    volatile LAS unsigned* MISC = (volatile LAS unsigned*)(lds + MISC_OFF);
    const int wave = __builtin_amdgcn_readfirstlane((int)threadIdx.x >> 6);
    const int G = gridDim.x, bx = blockIdx.x;
    const int vcu = (G % 8 == 0) ? (bx % 8) * (G / 8) + bx / 8 : bx;
    const int gw = vcu * NWAVES + wave, NGW = G * NWAVES;
    for (int u = threadIdx.x; u < (LDS_BYTES - LDSCTL_OFF) / 4; u += NTHREADS) ((LAS unsigned*)(lds + LDSCTL_OFF))[u] = 0u;
    __syncthreads();
    int lo, hi; XcdBarrier bar;
    { KArgP ka = KARG(); lo = ka->ph_lo; hi = ka->ph_hi; unsigned* ctl = (unsigned*)(ka->ws + WS_CTL); bar = xcd_barrier_post(ctl + CW_BAR + ka->li * XCD_BAR_WORDS, MISC + 8, wave); }
#define IN(k) (lo <= (k) && (k) < hi)
    const bool bgw = (lo <= PH_PRO && hi >= PH_COUNT);
    constexpr int NBG = 4;
    int sidx = 0;
#define SEAM(k) do { if (IN(k) && IN((k) + 1)) { const int id_ = PRO_I_IN + sidx * (G * NBG) + vcu * NBG + (wave - 1); ++sidx; \
        if (bgw && G * NBG == 1024 && id_ < PRO_NITEMS + G * NBG) xcd_barrier_w(bar, [&]() { if (wave <= NBG && id_ < PRO_NITEMS) { KArgP ka = KARG(); Args a; a.ws = ka->ws; a.w_in = ka->w_in; a.w_out = ka->w_out; a.w_gate = ka->w_gate; a.w_up = ka->w_up; a.w_down = ka->w_down; a.ln2_g = ka->ln2_g; a.ln1_g = ka->ln1_g; \
            int lane_b = (int)__builtin_amdgcn_mbcnt_hi(~0u, __builtin_amdgcn_mbcnt_lo(~0u, 0u)); LAUNDER_V(lane_b); prologue_item(a, id_, lane_b); } }); \
        else xcd_barrier(bar); } } while (0)
#define WSP(T_, off) ((T_*)(ws + (off)))

    if (IN(PH_PRO)) { KArgP ka = KARG(); PHASE_IDS; Args a; a.ws = ka->ws; a.w_in = ka->w_in; a.w_out = ka->w_out; a.w_gate = ka->w_gate; a.w_up = ka->w_up; a.w_down = ka->w_down; a.ln2_g = ka->ln2_g; a.ln1_g = ka->ln1_g; phase_prologue(a, gw_p, NGW_p, lane_p, (bgw && G_p * NBG == 1024) ? PRO_I_IN : PRO_NITEMS);
        for (int j_ = vcu; j_ < DEPTH * 10; j_ += G_p) { const int l_ = j_ / 10; router_image(ka->ln2_g + (size_t)l_ * DM, ka->w_gr + (size_t)l_ * DM * 4, ka->w_er + (size_t)l_ * 4 * DM * 4, ka->ws + WS_RIMG + (size_t)l_ * RT_IMG, (j_ % 10) * NTHREADS, tid_p); } }

    for (int l = 0; l < DEPTH; ++l) {
        const int p0 = PH_L0 + l * PH_PER_LAYER;
        if (hi <= p0 || lo >= p0 + PH_PER_LAYER) continue;
        if (l == 0) { if (IN(p0 + 0)) { KArgP ka = KARG(); PHASE_IDS; unsigned char* ws = ka->ws;
            phase_norm1(ka->x, gw_p, NGW_p, lane_p, WSP(float, WS_KMEAN), WSP(bf16_t, WS_XB), WSP(float, WS_SSQ)); } SEAM(p0 + 0); }
        if (IN(p0 + 1)) for (int rep_ = 0; rep_ < RPT(1); ++rep_) { if (rep_) xcd_barrier(bar); KArgP ka = KARG(); PHASE_IDS; unsigned char* ws = ka->ws;
            pg8::Gemm g{(const char*)(ws + WS_XB), (const char*)(ws + WS_WIN) + (size_t)l * NQKV * DM * 2, DM, DM, DM, (long)256 * DM * 2, (long)256 * DM * 2, (long)128 * DM * 2, WSP(float, WS_SSQ)};
            pg8::StaticOrder S; S.init(T / 256, NQKV / 256, G_p, bx);
            pg8::EpiQKV E{WSP(bf16_t, WS_Q), (size_t)(WS_K - WS_Q) / 2, QSCALE};
            pg8::gemm_phase<pg8::EpiQKV, pg8::StaticOrder>(lds, g, S, E, wave);
        } SEAM(p0 + 1);
        if (IN(p0 + 4)) for (int rep_ = 0; rep_ < RPT(4); ++rep_) { if (rep_) xcd_barrier(bar); KArgP ka = KARG(); PHASE_IDS; unsigned char* ws = ka->ws;
            const att::AttnArgs A{WSP(bf16_t, WS_Q), WSP(bf16_t, WS_K), WSP(bf16_t, WS_V), (bf16_t*)ka->out, WSP(bf16_t, WS_HB), WSP(float, WS_LSE), WSP(unsigned, WS_CTL) + CW_MCNT + l * 512, WSP(unsigned, WS_QLIST),
                                  WSP(bf16_t, WS_PM), WSP(float, WS_LSEM0), WSP(float, WS_LSEM1), WSP(float, WS_KMEAN), WSP(unsigned, WS_CTL) + CW_GDONE + l * 64};
            att::attn_phase(lds, A, vcu, G_p, tid_p);
        } SEAM(p0 + 4);
        if (IN(p0 + 5)) { KArgP ka = KARG(); PHASE_IDS; unsigned char* ws = ka->ws;
            phase_mixnorm((const bf16_t*)ka->out, WSP(bf16_t, WS_HB), WSP(float, WS_LSE), WSP(bf16_t, WS_PM), WSP(float, WS_LSEM0), WSP(float, WS_LSEM1), ka->mix_g + (size_t)l * DM, gw_p, NGW_p, lane_p); } SEAM(p0 + 5);
        if (IN(p0 + 6)) { KArgP ka = KARG(); PHASE_IDS; unsigned char* ws = ka->ws;
            pg8::Gemm g{(const char*)(ws + WS_HB), (const char*)(ws + WS_WOUT) + (size_t)l * DM * DM * 2, DM, DM, DM, (long)256 * DM * 2, (long)256 * DM * 2, (long)128 * DM * 2, nullptr};
            pg8::StaticOrder S; S.init(T / 256, DM / 256, G_p, bx);
            pg8::EpiResAdd E{WSP(bf16_t, WS_XB)};
            pg8::gemm_phase<pg8::EpiResAdd, pg8::StaticOrder>(lds, g, S, E, wave);
        } SEAM(p0 + 6);
        if (IN(p0 + 7)) { KArgP ka = KARG(); PHASE_IDS; unsigned char* ws = ka->ws;
            phase_route(WSP(bf16_t, WS_XB), ka->ln2_g + (size_t)l * DM, ka->w_gr + (size_t)l * DM * 4, ka->b_gr + l * 4, ka->w_er + (size_t)l * 4 * DM * 4, ka->b_er + l * 16, WSP(float, WS_LSE),
                        WSP(unsigned, WS_CTL) + CW_CNT + l * 32, WSP(unsigned, WS_LIST), WSP(float, WS_WLIST), lds, vcu, G_p, wave, lane_p, WSP(float, WS_KMEAN), (const unsigned char*)(ws + WS_RIMG + (size_t)l * RT_IMG)); } SEAM(p0 + 7);
        if (IN(p0 + 8)) for (int rep_ = 0; rep_ < RPT(8); ++rep_) { if (rep_) xcd_barrier(bar); KArgP ka = KARG(); PHASE_IDS; unsigned char* ws = ka->ws;
            pg8::MoeProb<0> P{WSP(unsigned, WS_CTL) + CW_CNT + l * 32, WSP(unsigned, WS_LIST), (const char*)(ws + WS_XB), (const char*)(ws + WS_WG) + (size_t)l * NACT * DM * 2, DM, DM, DM, (long)(WS_WU - WS_WG), G_p, vcu, WSP(unsigned, WS_CTL) + CW_TCNT + l * 16384};
            pg8::EpiGateUpSparse E{WSP(bf16_t, WS_ACT), WSP(float, WS_WLIST), WSP(float, WS_LSE), WSP(unsigned, WS_CTL) + CW_TCNT + l * 16384};
            pg8::gemm_phase_x<pg8::EpiGateUpSparse, pg8::MoeProb<0>>(lds, P, E, wave);
        }
        if (IN(p0 + 9)) { KArgP ka = KARG(); PHASE_IDS; unsigned char* ws = ka->ws;
            pg8::MoeProb<1> P{WSP(unsigned, WS_CTL) + CW_CNT + l * 32, WSP(unsigned, WS_LIST), (const char*)(ws + WS_ACT), (const char*)(ws + WS_WD) + (size_t)l * DM * NACT * 2, 512, NACT, 512, (long)128 * NACT * 2, G_p, vcu, WSP(unsigned, WS_CTL) + CW_TCNT + l * 16384};
            pg8::EpiDownScatter E{WSP(bf16_t, WS_XB), WSP(unsigned, WS_LIST), WSP(float, WS_SSQ), lds};
            pg8::gemm_phase_x<pg8::EpiDownScatter, pg8::MoeProb<1>>(lds, P, E, wave);
        } SEAM(p0 + 9);
    }
    if (IN(PH_FINAL)) { KArgP ka = KARG(); PHASE_IDS; phase_final((const bf16_t*)(ka->ws + WS_XB), ka->fin_g, ka->out, gw_p, NGW_p, lane_p); }
#undef IN
#undef SEAM
#undef WSP
}

#ifndef N_LAUNCH_MODE
#define N_LAUNCH_MODE 1
#endif
extern "C" void kernel_launch(void* const* d_in, const int* in_sizes, int n_in, void* d_out, int out_size, void* d_ws, size_t ws_size, hipStream_t stream) {
    static int grid = 0;
    if (grid == 0) {
        if (n_in != 14 || in_sizes[0] != T * DM || out_size != T * DM || ws_size < WS_END) { fprintf(stderr, "kernel_launch: unexpected shapes (n_in %d in0 %d out %d ws %zu)\n", n_in, n_in > 0 ? in_sizes[0] : -1, out_size, ws_size); grid = -1; return; }
        int dev = 0, cus = 0, per_cu = 0;
        if (hipGetDevice(&dev) != hipSuccess || hipDeviceGetAttribute(&cus, hipDeviceAttributeMultiprocessorCount, dev) != hipSuccess) { grid = -1; return; }
        if (hipFuncSetAttribute((const void*)fwd, hipFuncAttributeMaxDynamicSharedMemorySize, LDS_BYTES) != hipSuccess) { fprintf(stderr, "kernel_launch: hipFuncSetAttribute failed\n"); grid = -1; return; }
        if (hipOccupancyMaxActiveBlocksPerMultiprocessor(&per_cu, (const void*)fwd, NTHREADS, LDS_BYTES) != hipSuccess || per_cu < 1) fprintf(stderr, "kernel_launch: occupancy query says %d\n", per_cu);
        (void)hipGetLastError();
        grid = cus;
    }
    if (grid < 0) return;
    if (hipMemsetAsync((char*)d_ws + WS_CTL, 0, CTL_ZERO_BYTES, stream) != hipSuccess) return;
    Args a{};
    a.x = (const float*)d_in[0]; a.ln1_g = (const float*)d_in[1]; a.w_in = (const float*)d_in[2]; a.mix_g = (const float*)d_in[3]; a.w_out = (const float*)d_in[4]; a.ln2_g = (const float*)d_in[5];
    a.w_gr = (const float*)d_in[6]; a.b_gr = (const float*)d_in[7]; a.w_er = (const float*)d_in[8]; a.b_er = (const float*)d_in[9]; a.w_gate = (const float*)d_in[10]; a.w_up = (const float*)d_in[11];
    a.w_down = (const float*)d_in[12]; a.fin_g = (const float*)d_in[13];
    a.out = (float*)d_out; a.ws = (unsigned char*)d_ws; a.pad = 0;
#if N_LAUNCH_MODE == 1
    a.ph_lo = 0; a.ph_hi = PH_COUNT; a.li = 0;
    hipLaunchKernelGGL(fwd, dim3(grid), dim3(NTHREADS), LDS_BYTES, stream, a);
#else
    for (int p = 0; p < PH_COUNT; ++p) { a.ph_lo = p; a.ph_hi = p + 1; a.li = p; hipLaunchKernelGGL(fwd, dim3(grid), dim3(NTHREADS), LDS_BYTES, stream, a); }
#endif
}
```
